# Optimizing an MI355X kernel written in HIP

```python
import math
import jax, jax.numpy as jnp
from jax import lax
import numpy as np

D_MODEL = 1024
BATCH = 8
SEQ = 4096
DEPTH = 4

GRID_W = 64
CTX_LEN = 256
N_EVEN = (DEPTH + 1) // 2
N_ODD = DEPTH // 2

HEAD_DIM = 64
RET_HEADS = 8
ATT_HEADS = 8
ATT_KV_HEADS = 2
ATT_GROUP = ATT_HEADS // ATT_KV_HEADS
RET_WIDTH = RET_HEADS * HEAD_DIM
ATT_WIDTH = ATT_HEADS * HEAD_DIM
ATT_KV_WIDTH = ATT_KV_HEADS * HEAD_DIM
MIX_WIDTH = RET_WIDTH + ATT_WIDTH
IN_SPLITS = (RET_WIDTH, 2 * RET_WIDTH, 3 * RET_WIDTH, 4 * RET_WIDTH,
             4 * RET_WIDTH + ATT_WIDTH, 4 * RET_WIDTH + ATT_WIDTH + ATT_KV_WIDTH)
IN_WIDTH = 4 * RET_WIDTH + ATT_WIDTH + 2 * ATT_KV_WIDTH
CHUNK = 128
Q_BLOCK = 128
ROPE_THETA = 10000.0
ROPE_AXIS_DIM = HEAD_DIM // 2

S5_GROUP = 16
S5_GROUPS = D_MODEL // S5_GROUP
S5_STATE = 64
S5_DT_MIN = 0.001
S5_DT_MAX = 0.1

N_EXPERTS = 16
CAPACITY_FACTOR = 2
D_FF_EXPERT = 2 * D_MODEL
EPS = 1e-6

kernel_name = "hybrid_retention_gqa_s5_ecmoe_diffusion_trunk"

F32 = jnp.float32


def rms_norm(x, g):
    x32 = x.astype(F32)
    y = x32 * lax.rsqrt(jnp.mean(x32 * x32, axis=-1, keepdims=True) + EPS)
    return y.astype(x.dtype) * g


def modulation(cond, w, b):
    m = jax.nn.silu(cond) @ w + b
    return jnp.split(m[..., None, :], 6, axis=-1)


def axial_rope_tables(n_rows):
    row = jnp.repeat(jnp.arange(n_rows, dtype=F32), GRID_W)
    col = jnp.tile(jnp.arange(GRID_W, dtype=F32), n_rows)
    inv = ROPE_THETA ** (-jnp.arange(0, ROPE_AXIS_DIM, 2, dtype=F32) / ROPE_AXIS_DIM)
    ang_r = row[:, None] * inv[None, :]
    ang_c = col[:, None] * inv[None, :]
    return (jnp.cos(ang_r)[:, None, :], jnp.sin(ang_r)[:, None, :],
            jnp.cos(ang_c)[:, None, :], jnp.sin(ang_c)[:, None, :])


def _rope_1d(x, cos, sin):
    half = x.shape[-1] // 2
    x1, x2 = x[..., :half], x[..., half:]
    return jnp.concatenate([x1 * cos - x2 * sin, x1 * sin + x2 * cos], axis=-1)


def apply_axial_rope(x, rope):
    cr, sr, cc, sc = rope
    xr = _rope_1d(x[..., :ROPE_AXIS_DIM].astype(F32), cr, sr)
    xc = _rope_1d(x[..., ROPE_AXIS_DIM:].astype(F32), cc, sc)
    return jnp.concatenate([xr, xc], axis=-1).astype(x.dtype)


def split_heads(t, n_heads):
    return t.reshape(t.shape[0], t.shape[1], n_heads, HEAD_DIM)


def retention_chunkwise(q, k, v, log_gamma, state0, strict):
    b, h, n, d = q.shape
    nc = n // CHUNK
    pos = jnp.arange(CHUNK, dtype=F32)
    diff = pos[:, None] - pos[None, :]
    mask = (diff > 0) if strict else (diff >= 0)
    lg = log_gamma[:, None, None]
    decay_intra = jnp.where(mask, jnp.exp(jnp.where(mask, diff, 0.0) * lg), 0.0)
    decay_q = jnp.exp((pos + 1.0)[None, :] * log_gamma[:, None])[..., None]
    decay_k = jnp.exp((CHUNK - 1.0 - pos)[None, :] * log_gamma[:, None])[..., None]
    decay_chunk = jnp.exp(CHUNK * log_gamma)[:, None, None]

    def to_chunks(t):
        return jnp.moveaxis(t.reshape(b, h, nc, CHUNK, d), 2, 0)

    def step(state, qkv):
        qc, kc, vc = qkv
        scores = jnp.einsum('bhid,bhjd->bhij', qc, kc) * decay_intra
        out = (jnp.einsum('bhij,bhjd->bhid', scores, vc)
               + jnp.einsum('bhid,bhde->bhie', qc * decay_q, state))
        state = decay_chunk * state + jnp.einsum('bhjd,bhje->bhde', kc * decay_k, vc)
        return state, out

    state, out = lax.scan(step, state0, (to_chunks(q), to_chunks(k), to_chunks(v)))
    return jnp.moveaxis(out, 0, 2).reshape(b, h, n, d), state


def bidir_retention(q, k, v, lg_f, lg_b, s_f, s_b):
    o_f, s_f_new = retention_chunkwise(q, k, v, lg_f, s_f, False)
    flip = lambda t: jnp.flip(t, axis=2)
    o_b, s_b_new = retention_chunkwise(flip(q), flip(k), flip(v), lg_b, s_b, True)
    return o_f + flip(o_b), s_f_new, s_b_new


def retention_output(o, gate_proj, gn_g):
    b, h, n, d = o.shape
    mu = jnp.mean(o, axis=-1, keepdims=True)
    var = jnp.mean(jnp.square(o - mu), axis=-1, keepdims=True)
    o = (o - mu) * lax.rsqrt(var + EPS)
    o = jnp.swapaxes(o, 1, 2).reshape(b, n, h * d).astype(gate_proj.dtype) * gn_g
    return jax.nn.silu(gate_proj) * o


def attend(q, k, v):
    s = jnp.einsum('bkgqd,bkmd->bkgqm', q, k).astype(F32) * (HEAD_DIM ** -0.5)
    p = jax.nn.softmax(s, axis=-1).astype(v.dtype)
    return jnp.einsum('bkgqm,bkmd->bkgqd', p, v)


def even_mixer(h_lat, h_ctx, w_in, w_out, ret_log_rate, ret_gn_g, qk_norm_g, rope, need_ctx):
    def project(h, pos):
        rq, rk, rv, rg, aq, ak, av = jnp.split(h @ w_in, IN_SPLITS, axis=-1)
        rq = split_heads(rq, RET_HEADS)
        rk = split_heads(rk, RET_HEADS) * (HEAD_DIM ** -0.5)
        aq = rms_norm(split_heads(aq, ATT_HEADS), qk_norm_g[0])
        ak = rms_norm(split_heads(ak, ATT_KV_HEADS), qk_norm_g[1])
        if pos is not None:
            rq, rk, aq, ak = [apply_axial_rope(t, pos) for t in (rq, rk, aq, ak)]
        hf = lambda t: jnp.swapaxes(t, 1, 2)
        return (hf(rq).astype(F32), hf(rk).astype(F32), hf(split_heads(rv, RET_HEADS)).astype(F32), rg,
                hf(aq), hf(ak), hf(split_heads(av, ATT_KV_HEADS)))

    b, n_lat, n_ctx = h_lat.shape[0], h_lat.shape[1], h_ctx.shape[1]
    lrq, lrk, lrv, lrg, laq, lak, lav = project(h_lat, rope)
    crq, crk, crv, crg, caq, cak, cav = project(h_ctx, None)

    lg_f = -jnp.exp(ret_log_rate[0].astype(F32))
    lg_b = -jnp.exp(ret_log_rate[1].astype(F32))
    zero = jnp.zeros((b, RET_HEADS, HEAD_DIM, HEAD_DIM), F32)
    o_ctx, s_f, s_b = bidir_retention(crq, crk, crv, lg_f, lg_b, zero, zero)
    o_lat, _, _ = bidir_retention(lrq, lrk, lrv, lg_f, lg_b, s_f, s_b)
    ret_lat = retention_output(o_lat, lrg, ret_gn_g)

    k_all = jnp.concatenate([cak, lak], axis=2)
    v_all = jnp.concatenate([cav, lav], axis=2)
    n_blocks = n_lat // Q_BLOCK
    q_lat = laq.reshape(b, ATT_KV_HEADS, ATT_GROUP, n_blocks, Q_BLOCK, HEAD_DIM)
    q_blocks = jnp.moveaxis(q_lat, 3, 0)
    o_blocks = lax.map(lambda qb: attend(qb, k_all, v_all), q_blocks)
    att_lat = o_blocks.transpose(1, 0, 4, 2, 3, 5).reshape(b, n_lat, ATT_WIDTH)

    y_lat = jnp.concatenate([ret_lat, att_lat], axis=-1) @ w_out
    if not need_ctx:
        return y_lat, None
    ret_ctx = retention_output(o_ctx, crg, ret_gn_g)
    q_ctx = caq.reshape(b, ATT_KV_HEADS, ATT_GROUP, n_ctx, HEAD_DIM)
    att_ctx = attend(q_ctx, cak, cav).transpose(0, 3, 1, 2, 4).reshape(b, n_ctx, ATT_WIDTH)
    y_ctx = jnp.concatenate([ret_ctx, att_ctx], axis=-1) @ w_out
    return y_lat, y_ctx


def _cmul(ar, ai, br, bi):
    return ar * br - ai * bi, ar * bi + ai * br


def _s5_combine(e1, e2):
    a1r, a1i, b1r, b1i = e1
    a2r, a2i, b2r, b2i = e2
    ar, ai = _cmul(a2r, a2i, a1r, a1i)
    br, bi = _cmul(a2r, a2i, b1r, b1i)
    return ar, ai, br + b2r, bi + b2i


def s5_discretize(a_re, a_im, log_dt, b_re, b_im):
    lam_re = jnp.minimum(a_re, -1e-4)
    lam_im = a_im
    dt = jnp.exp(log_dt)[:, None]
    mag = jnp.exp(lam_re * dt)
    bar_re = mag * jnp.cos(lam_im * dt)
    bar_im = mag * jnp.sin(lam_im * dt)
    den = lam_re * lam_re + lam_im * lam_im
    nr, ni = bar_re - 1.0, bar_im
    k_re = (nr * lam_re + ni * lam_im) / den
    k_im = (ni * lam_re - nr * lam_im) / den
    bb_re, bb_im = _cmul(k_re[..., None], k_im[..., None], b_re, b_im)
    return bar_re, bar_im, bb_re, bb_im


def s5_scan(u, bar_re, bar_im, bb_re, bb_im, cc_re, cc_im, x0):
    b, n, _ = u.shape
    nc = n // CHUNK
    u_chunks = jnp.moveaxis(u.reshape(b, nc, CHUNK, S5_GROUPS, S5_GROUP), 1, 0)

    def step(carry, uc):
        xr0, xi0 = carry
        br = jnp.einsum('bcgk,gpk->bcgp', uc, bb_re)
        bi = jnp.einsum('bcgk,gpk->bcgp', uc, bb_im)
        ar = jnp.broadcast_to(bar_re, br.shape)
        ai = jnp.broadcast_to(bar_im, br.shape)
        pr, pi, sr, si = lax.associative_scan(_s5_combine, (ar, ai, br, bi), axis=1)
        xr = pr * xr0[:, None] - pi * xi0[:, None] + sr
        xi = pr * xi0[:, None] + pi * xr0[:, None] + si
        y = jnp.einsum('bcgp,gkp->bcgk', xr, cc_re) - jnp.einsum('bcgp,gkp->bcgk', xi, cc_im)
        return (xr[:, -1], xi[:, -1]), y.reshape(b, CHUNK, D_MODEL)

    state, y = lax.scan(step, x0, u_chunks)
    return jnp.moveaxis(y, 0, 1).reshape(b, n, D_MODEL), state


def s5_mixer(h_lat, h_ctx, a_re, a_im, log_dt, b_re, b_im, c_re, c_im, d_skip, glu_w, glu_b, need_ctx):
    a_re, a_im, log_dt = a_re.astype(F32), a_im.astype(F32), log_dt.astype(F32)
    b_re, b_im, c_re, c_im = b_re.astype(F32), b_im.astype(F32), c_re.astype(F32), c_im.astype(F32)
    d32 = d_skip.astype(F32)
    disc_f = s5_discretize(a_re[0], a_im[0], log_dt[0], b_re, b_im)
    disc_b = s5_discretize(a_re[1], a_im[1], log_dt[1], b_re, b_im)

    def bidir(u, init_f, init_b):
        y_f, s_f = s5_scan(u, *disc_f, c_re[0], c_im[0], init_f)
        y_b, s_b = s5_scan(jnp.flip(u, axis=1), *disc_b, c_re[1], c_im[1], init_b)
        return y_f + jnp.flip(y_b, axis=1) + d32 * u, s_f, s_b

    def glu_out(y, dtype):
        z = jax.nn.gelu(y).astype(dtype)
        a, g = jnp.split(z @ glu_w + glu_b, 2, axis=-1)
        return a * jax.nn.sigmoid(g)

    b = h_lat.shape[0]
    zero = (jnp.zeros((b, S5_GROUPS, S5_STATE), F32), jnp.zeros((b, S5_GROUPS, S5_STATE), F32))
    y_ctx, s_f, s_b = bidir(h_ctx.astype(F32), zero, zero)
    y_lat, _, _ = bidir(h_lat.astype(F32), s_f, s_b)
    out_lat = glu_out(y_lat, h_lat.dtype)
    if not need_ctx:
        return out_lat, None
    return out_lat, glu_out(y_ctx, h_ctx.dtype)


def ec_moe(h, w_router, w1, w3, w2):
    b, n, _ = h.shape
    cap = (CAPACITY_FACTOR * n) // N_EXPERTS
    aff = jax.nn.softmax((h @ w_router).astype(F32), axis=-1)
    gate, idx = lax.top_k(jnp.swapaxes(aff, 1, 2), cap)
    bidx = jnp.arange(b)[:, None, None]
    xs = h[bidx, idx]
    hid = jax.nn.silu(jnp.einsum('becd,edf->becf', xs, w1)) * jnp.einsum('becd,edf->becf', xs, w3)
    ys = jnp.einsum('becf,efd->becd', hid, w2) * gate[..., None].astype(h.dtype)
    return jnp.zeros_like(h).at[bidx, idx].add(ys)


def setup_inputs(seed: int = 0) -> dict:
    key = jax.random.key(seed)
    ks = jax.random.split(key, 32)
    nrm = lambda k, shape, s: jax.random.normal(k, shape, F32) * s
    s5_shape = (N_ODD, 2, S5_GROUPS, S5_STATE)
    base_rate = -jnp.log1p(-(2.0 ** (-5.0 - jnp.arange(RET_HEADS, dtype=F32))))
    n_idx = jnp.arange(S5_STATE, dtype=F32)
    return {
        "x": nrm(ks[0], (BATCH, SEQ, D_MODEL), 1.0),
        "c": nrm(ks[1], (BATCH, D_MODEL), 1.0),
        "ctx": nrm(ks[2], (BATCH, CTX_LEN, D_MODEL), 1.0),
        "c_ctx": nrm(ks[3], (D_MODEL,), 1.0),
        "mod_w": nrm(ks[4], (DEPTH, D_MODEL, 6 * D_MODEL), 0.5 * D_MODEL ** -0.5),
        "mod_b": nrm(ks[5], (DEPTH, 6 * D_MODEL), 0.02),
        "norm_g": 1.0 + nrm(ks[6], (DEPTH, 2, D_MODEL), 0.02),
        "mix_in_w": nrm(ks[7], (N_EVEN, D_MODEL, IN_WIDTH), D_MODEL ** -0.5),
        "mix_out_w": nrm(ks[8], (N_EVEN, MIX_WIDTH, D_MODEL), MIX_WIDTH ** -0.5),
        "ret_log_rate": jnp.log(base_rate) + nrm(ks[9], (N_EVEN, 2, RET_HEADS), 0.05),
        "ret_gn_g": 1.0 + nrm(ks[10], (N_EVEN, RET_WIDTH), 0.02),
        "qk_norm_g": 1.0 + nrm(ks[11], (N_EVEN, 2, HEAD_DIM), 0.02),
        "s5_a_re": -0.5 + nrm(ks[12], s5_shape, 0.01),
        "s5_a_im": math.pi * n_idx + nrm(ks[13], s5_shape, 0.01),
        "s5_log_dt": jax.random.uniform(ks[14], (N_ODD, 2, S5_GROUPS), F32,
                                        math.log(S5_DT_MIN), math.log(S5_DT_MAX)),
        "s5_b_re": nrm(ks[15], (N_ODD, S5_GROUPS, S5_STATE, S5_GROUP), (2 * S5_GROUP) ** -0.5),
        "s5_b_im": nrm(ks[16], (N_ODD, S5_GROUPS, S5_STATE, S5_GROUP), (2 * S5_GROUP) ** -0.5),
        "s5_c_re": nrm(ks[17], (N_ODD, 2, S5_GROUPS, S5_GROUP, S5_STATE), S5_STATE ** -0.5),
        "s5_c_im": nrm(ks[18], (N_ODD, 2, S5_GROUPS, S5_GROUP, S5_STATE), S5_STATE ** -0.5),
        "s5_d": nrm(ks[19], (N_ODD, D_MODEL), 1.0),
        "s5_glu_w": nrm(ks[20], (N_ODD, D_MODEL, 2 * D_MODEL), D_MODEL ** -0.5),
        "s5_glu_b": nrm(ks[21], (N_ODD, 2 * D_MODEL), 0.02),
        "moe_router_w": nrm(ks[22], (DEPTH, D_MODEL, N_EXPERTS), D_MODEL ** -0.5),
        "moe_w1": nrm(ks[23], (DEPTH, N_EXPERTS, D_MODEL, D_FF_EXPERT), D_MODEL ** -0.5),
        "moe_w3": nrm(ks[24], (DEPTH, N_EXPERTS, D_MODEL, D_FF_EXPERT), D_MODEL ** -0.5),
        "moe_w2": nrm(ks[25], (DEPTH, N_EXPERTS, D_FF_EXPERT, D_MODEL), D_FF_EXPERT ** -0.5),
        "final_norm_g": 1.0 + nrm(ks[26], (D_MODEL,), 0.02),
    }


def reference(x, c, ctx, c_ctx, mod_w, mod_b, norm_g, mix_in_w, mix_out_w, ret_log_rate, ret_gn_g,
              qk_norm_g, s5_a_re, s5_a_im, s5_log_dt, s5_b_re, s5_b_im, s5_c_re, s5_c_im, s5_d,
              s5_glu_w, s5_glu_b, moe_router_w, moe_w1, moe_w3, moe_w2, final_norm_g):
    n_rows = x.shape[1] // GRID_W
    rope = axial_rope_tables(n_rows)
    x_lat, x_ctx = x, ctx
    for layer in range(DEPTH):
        last = layer == DEPTH - 1
        sh1, sc1, g1, sh2, sc2, g2 = modulation(c, mod_w[layer], mod_b[layer])
        csh1, csc1, cg1, csh2, csc2, cg2 = modulation(c_ctx, mod_w[layer], mod_b[layer])
        h_lat = rms_norm(x_lat, norm_g[layer, 0]) * (1.0 + sc1) + sh1
        h_ctx = rms_norm(x_ctx, norm_g[layer, 0]) * (1.0 + csc1) + csh1
        i = layer // 2
        if layer % 2 == 0:
            d_lat, d_ctx = even_mixer(h_lat, h_ctx, mix_in_w[i], mix_out_w[i], ret_log_rate[i],
                                      ret_gn_g[i], qk_norm_g[i], rope, not last)
        else:
            d_lat, d_ctx = s5_mixer(h_lat, h_ctx, s5_a_re[i], s5_a_im[i], s5_log_dt[i], s5_b_re[i],
                                    s5_b_im[i], s5_c_re[i], s5_c_im[i], s5_d[i], s5_glu_w[i],
                                    s5_glu_b[i], not last)
        x_lat = x_lat + g1 * d_lat
        f_lat = rms_norm(x_lat, norm_g[layer, 1]) * (1.0 + sc2) + sh2
        x_lat = x_lat + g2 * ec_moe(f_lat, moe_router_w[layer], moe_w1[layer], moe_w3[layer], moe_w2[layer])
        if not last:
            x_ctx = x_ctx + cg1 * d_ctx
            f_ctx = rms_norm(x_ctx, norm_g[layer, 1]) * (1.0 + csc2) + csh2
            x_ctx = x_ctx + cg2 * ec_moe(f_ctx, moe_router_w[layer], moe_w1[layer], moe_w3[layer], moe_w2[layer])
    return rms_norm(x_lat, final_norm_g)
```

```cpp
#include <hip/hip_runtime.h>
#include <cstdio>
#include <cstdint>

#define GAS __attribute__((address_space(1)))
#define LAS __attribute__((address_space(3)))
typedef float f32x4 __attribute__((ext_vector_type(4)));
typedef float f32x16 __attribute__((ext_vector_type(16)));

constexpr int NB = 8, T = 4096, D = 1024, CL = 256, RB = CL + T  , NROWS = NB * RB  ;
constexpr int DEPTH = 4, NE = 16, FF = 2048, INW = 2816;
constexpr int CAP_LAT = 512, CAP_CTX = 32, EROWS = NB * (CAP_LAT + CAP_CTX)  ;
constexpr float EPS = 1e-6f;
#ifndef MK_MULTI
#define MK_MULTI 0
#endif

constexpr size_t MiB = 1u << 20;
constexpr size_t WS_CTL = 0, CTL_ZERO_BYTES = 1 * MiB;
constexpr size_t WS_MOD = 1 * MiB;
constexpr size_t WS_ROPE = 2 * MiB;
constexpr size_t WS_SELROW = 3 * MiB;
constexpr size_t WS_SELGATE = 3 * MiB + 512 * 1024;
constexpr size_t WS_AFF = 4 * MiB;
constexpr size_t WS_SLOT = 7 * MiB;
constexpr size_t WS_X = 10 * MiB;
constexpr size_t WS_H = 146 * MiB;
constexpr size_t WS_BIG = 282 * MiB;
constexpr size_t WS_P = WS_BIG;
constexpr size_t WS_OF = WS_BIG + 374 * MiB;
constexpr size_t WS_OB = WS_BIG + 442 * MiB;
constexpr size_t WS_MIX = WS_BIG + 510 * MiB;
constexpr size_t WS_YF = WS_BIG;
constexpr size_t WS_YB = WS_BIG + 136 * MiB;
constexpr size_t WS_Z = WS_BIG + 272 * MiB;
constexpr size_t WS_HID = WS_BIG;
constexpr size_t WS_Y = WS_BIG + 544 * MiB;
constexpr size_t WS_END = WS_BIG + 816 * MiB;
constexpr int CW_BAR = 4096;

constexpr int LDS_BYTES = 147456;
constexpr int MISC_OFF = 131072 + 320;

constexpr int PH_PRO = 0, PH_PER_LAYER = 11, PH_FIN = 1 + DEPTH * PH_PER_LAYER, NPH = PH_FIN + 1;

#define XB_TMO      128
#define XB_XCNT(j)  (256  + 64 * (j))
#define XB_XSUB(j)  (1280 + 64 * (j))
#define XB_XGEN(j)  (2304 + 64 * (j))
#define XB_TOP      3328
#define XB_TOPGEN   3392
#define XCD_BAR_WORDS 3456
#define XB_SPIN_CAP (1u << 22)

__device__ __forceinline__ unsigned xb_ld(unsigned* p)              { return __hip_atomic_load(p, __ATOMIC_RELAXED, __HIP_MEMORY_SCOPE_AGENT); }
__device__ __forceinline__ unsigned xb_add(unsigned* p, unsigned v) { return __hip_atomic_fetch_add(p, v, __ATOMIC_RELAXED, __HIP_MEMORY_SCOPE_AGENT); }
__device__ __forceinline__ unsigned xb_xcc_id() { return (unsigned)__builtin_amdgcn_s_getreg((3 << 11) | 20) & 0xFu; }
#define XB_SPIN(cond, bar) do { unsigned _sp = 0; while (cond) { __builtin_amdgcn_s_sleep(1); \
    if ((++_sp & 255u) == 0u) { if (xb_ld(&(bar)[XB_TMO])) break; if (_sp > XB_SPIN_CAP) { atomicAdd(&(bar)[XB_TMO], 1u); break; } } } } while (0)

struct XcdBarrier { unsigned* bar; unsigned x; volatile LAS unsigned* st; };

__device__ __forceinline__ XcdBarrier xcd_barrier_post(unsigned* bar, volatile LAS unsigned* st) {
    XcdBarrier b; b.bar = bar; b.x = xb_xcc_id(); b.st = st;
    if (threadIdx.x == 0) (void)xb_add(&bar[XB_XCNT(b.x)], 1u);
    return b;
}
__device__ __forceinline__ void xcd_barrier_complete(unsigned* bar, unsigned x, unsigned& nloc, unsigned& nx) {
    const unsigned G = gridDim.x * gridDim.y * gridDim.z;
    unsigned sum, cnt, mine, sp = 0u;
    for (;;) {
        sum = 0u; cnt = 0u; mine = 0u;
#pragma unroll
        for (unsigned j = 0; j < 16; ++j) { const unsigned c = xb_ld(&bar[XB_XCNT(j)]); sum += c; cnt += (c > 0u) ? 1u : 0u; mine = (j == x) ? c : mine; }
        if (sum == G) break;
        __builtin_amdgcn_s_sleep(1);
        if ((++sp & 255u) == 0u) { if (xb_ld(&bar[XB_TMO])) break; if (sp > XB_SPIN_CAP) { atomicAdd(&bar[XB_TMO], 1u); break; } }
    }
    nloc = mine > 0u ? mine : 1u; nx = cnt > 0u ? cnt : 1u;
}
__device__ __forceinline__ void xcd_barrier(const XcdBarrier& b) {
    asm volatile("s_waitcnt vmcnt(0)" ::: "memory");
    __syncthreads();
    if (threadIdx.x == 0) {
        unsigned* bar = b.bar;
        __builtin_amdgcn_s_waitcnt(0);
        unsigned nloc = b.st[0], nx = b.st[1];
        if (nloc == 0u) { xcd_barrier_complete(bar, b.x, nloc, nx); b.st[0] = nloc; b.st[1] = nx; }
        const unsigned old = xb_add(&bar[XB_XSUB(b.x)], 1u);
        const unsigned gen = old / nloc;
        if (old + 1u == (gen + 1u) * nloc) {
            __builtin_amdgcn_fence(__ATOMIC_RELEASE, "agent");
            asm volatile("s_waitcnt vmcnt(0)" ::: "memory");
            const unsigned og = xb_add(&bar[XB_TOP], 1u);
            const unsigned tg = og / nx;
            if (og + 1u == (tg + 1u) * nx) xb_add(&bar[XB_TOPGEN], 1u);
            else XB_SPIN(xb_ld(&bar[XB_TOPGEN]) == tg, bar);
            __builtin_amdgcn_fence(__ATOMIC_ACQUIRE, "agent");
            xb_add(&bar[XB_XGEN(b.x)], 1u);
            asm volatile("s_waitcnt vmcnt(0)" ::: "memory");
        } else {
            XB_SPIN(xb_ld(&bar[XB_XGEN(b.x)]) == gen, bar);
            __builtin_amdgcn_fence(__ATOMIC_ACQUIRE, "agent");
            asm volatile("s_waitcnt vmcnt(0)" ::: "memory");
        }
    }
    __syncthreads();
}

struct Args { const float* in[27]; float* out; unsigned char* ws; int ph_lo, ph_hi; };

struct Ctx {
    const float* const* in; float* out; unsigned char* ws;
    int tid, lane, wave, gw, ngw, gt, ngt;
};
enum { IN_X = 0, IN_C, IN_CTX, IN_CCTX, IN_MODW, IN_MODB, IN_NORMG, IN_MIXIN, IN_MIXOUT, IN_RETRATE, IN_RETGN, IN_QKG,
       IN_S5ARE, IN_S5AIM, IN_S5DT, IN_S5BRE, IN_S5BIM, IN_S5CRE, IN_S5CIM, IN_S5D, IN_GLUW, IN_GLUB, IN_ROUTER, IN_W1, IN_W3, IN_W2, IN_FNG };

__device__ __forceinline__ float wave_sum(float v) {
#pragma unroll
    for (int o = 1; o < 64; o <<= 1) v += __shfl_xor(v, o);
    return v;
}
__device__ __forceinline__ float sigmoidf_(float x) { return 1.0f / (1.0f + expf(-x)); }
__device__ __forceinline__ float siluf_(float x) { return x * sigmoidf_(x); }
__device__ __forceinline__ float gelu_tanh(float x) { const float u = 0.7978845608028654f * (x + 0.044715f * x * x * x); return 0.5f * x * (1.0f + tanhf(u)); }
__device__ __forceinline__ const float* modp(const Ctx& c, int L, int j, int chunk) { return (const float*)(c.ws + WS_MOD) + ((size_t)(L * 9 + j) * 6 + chunk) * 1024; }
__device__ __forceinline__ int row_j(int row) { const int b = row / RB, s = row - b * RB; return s < CL ? 8 : b; }

__device__ __forceinline__ float reduce16(const float (&v)[16], int lane) {
    float a[8], b[4], c2[2], d;
    const bool b5 = (lane & 32) != 0, b4 = (lane & 16) != 0, b3 = (lane & 8) != 0, b2 = (lane & 4) != 0;
#pragma unroll
    for (int i = 0; i < 8; ++i) { const float keep = b5 ? v[8 + i] : v[i], send = b5 ? v[i] : v[8 + i]; a[i] = keep + __shfl_xor(send, 32); }
#pragma unroll
    for (int i = 0; i < 4; ++i) { const float keep = b4 ? a[4 + i] : a[i], send = b4 ? a[i] : a[4 + i]; b[i] = keep + __shfl_xor(send, 16); }
#pragma unroll
    for (int i = 0; i < 2; ++i) { const float keep = b3 ? b[2 + i] : b[i], send = b3 ? b[i] : b[2 + i]; c2[i] = keep + __shfl_xor(send, 8); }
    { const float keep = b2 ? c2[1] : c2[0], send = b2 ? c2[0] : c2[1]; d = keep + __shfl_xor(send, 4); }
    d += __shfl_xor(d, 2); d += __shfl_xor(d, 1);
    return d;
}
__device__ __forceinline__ int reduce16_k(int lane) { return ((lane >> 5) & 1) * 8 + ((lane >> 4) & 1) * 4 + ((lane >> 3) & 1) * 2 + ((lane >> 2) & 1); }

template <bool PAIRED, class AL, class BL, class EP>
__device__ __forceinline__ void gemm_f32(int groups, int M, int N, int K, const AL& al, const BL& bl, const EP& ep) {
    const int tid = threadIdx.x, lane = tid & 63, wave = tid >> 6, wm = wave >> 2, wn = wave & 3, r32 = lane & 31, h = lane >> 5;
    constexpr int TN = PAIRED ? 128 : 256;
    const int tilesM = M / 128, tilesN = N / TN, per = tilesM * tilesN, total = groups * per;
    const int ldb = bl.ldb;
    for (int t = blockIdx.x; t < total; t += gridDim.x) {
        const int g = t / per, r = t - g * per, tm = r / tilesN, tn = r - tm * tilesN;
        const int m0 = tm * 128 + wm * 64;
        const int n0 = PAIRED ? (tn * 128 + wn * 32) : (tn * 256 + wn * 64);
        const float* a0 = al.row(g, m0 + r32) + 4 * h;
        const float* a1 = al.row(g, m0 + 32 + r32) + 4 * h;
        const float* b0 = bl.ptr(g, 0) + n0 + r32 + (size_t)(4 * h) * ldb;
        const float* b1 = (PAIRED ? bl.ptr(g, 1) + n0 : bl.ptr(g, 0) + n0 + 32) + r32 + (size_t)(4 * h) * ldb;
        f32x16 acc00 = {}, acc01 = {}, acc10 = {}, acc11 = {};
#pragma unroll 2
        for (int k = 0; k < K; k += 8) {
            const f32x4 av0 = *(const f32x4*)(a0 + k), av1 = *(const f32x4*)(a1 + k);
            float bv0[4], bv1[4];
#pragma unroll
            for (int s = 0; s < 4; ++s) { bv0[s] = b0[(size_t)(k + s) * ldb]; bv1[s] = b1[(size_t)(k + s) * ldb]; }
#pragma unroll
            for (int s = 0; s < 4; ++s) {
                acc00 = __builtin_amdgcn_mfma_f32_32x32x2f32(av0[s], bv0[s], acc00, 0, 0, 0);
                acc01 = __builtin_amdgcn_mfma_f32_32x32x2f32(av0[s], bv1[s], acc01, 0, 0, 0);
                acc10 = __builtin_amdgcn_mfma_f32_32x32x2f32(av1[s], bv0[s], acc10, 0, 0, 0);
                acc11 = __builtin_amdgcn_mfma_f32_32x32x2f32(av1[s], bv1[s], acc11, 0, 0, 0);
            }
        }
#pragma unroll
        for (int rr = 0; rr < 16; ++rr) {
            const int ro = (rr & 3) + 8 * (rr >> 2) + 4 * h;
            if (PAIRED) {
                ep(g, m0 + ro, n0 + r32, acc00[rr], acc01[rr]);
                ep(g, m0 + 32 + ro, n0 + r32, acc10[rr], acc11[rr]);
            } else {
                ep(g, m0 + ro, n0 + r32, acc00[rr], 0.f); ep(g, m0 + ro, n0 + 32 + r32, acc01[rr], 0.f);
                ep(g, m0 + 32 + ro, n0 + r32, acc10[rr], 0.f); ep(g, m0 + 32 + ro, n0 + 32 + r32, acc11[rr], 0.f);
            }
        }
    }
}

__device__ __forceinline__ void phase_pro(const Ctx& c, LAS float* ldsf) {
    float* rope = (float*)(c.ws + WS_ROPE);
    for (int i = c.gt; i < 64 * 16; i += c.ngt) {
        const int pos = i >> 4, fi = i & 15; const float inv = powf(10000.0f, -(float)fi / 16.0f), ang = (float)pos * inv;
        rope[2 * i] = cosf(ang); rope[2 * i + 1] = sinf(ang);
    }
    LAS float* sil = ldsf; LAS float* red = ldsf + 9 * 1024;
    for (int i = c.tid; i < 9 * 1024; i += 512) { const int j = i >> 10, k = i & 1023; const float v = (j < 8) ? c.in[IN_C][j * 1024 + k] : c.in[IN_CCTX][k]; sil[i] = siluf_(v); }
    __syncthreads();
    float* MOD = (float*)(c.ws + WS_MOD);
    for (int task = blockIdx.x; task < DEPTH * 96; task += gridDim.x) {
        const int L = task / 96, cb = task - L * 96, col = cb * 64 + c.lane;
        const float* W = c.in[IN_MODW] + (size_t)L * 1024 * 6144;
        float acc[9];
#pragma unroll
        for (int j = 0; j < 9; ++j) acc[j] = 0.f;
        const int k0 = c.wave * 128;
#pragma unroll 4
        for (int k = k0; k < k0 + 128; ++k) { const float w = W[(size_t)k * 6144 + col];
#pragma unroll
            for (int j = 0; j < 9; ++j) acc[j] += sil[j * 1024 + k] * w; }
#pragma unroll
        for (int j = 0; j < 9; ++j) red[(c.wave * 9 + j) * 64 + c.lane] = acc[j];
        __syncthreads();
        if (c.wave == 0) {
            const float bias = c.in[IN_MODB][L * 6144 + col];
#pragma unroll
            for (int j = 0; j < 9; ++j) { float s = bias;
#pragma unroll
                for (int w = 0; w < 8; ++w) s += red[(w * 9 + j) * 64 + c.lane];
                MOD[(size_t)(L * 9 + j) * 6144 + col] = s; }
        }
        __syncthreads();
    }
    float* X = (float*)(c.ws + WS_X);
    for (int r = c.gw; r < NROWS; r += c.ngw) {
        const int b = r / RB, s = r - b * RB;
        const float* src = (s < CL) ? c.in[IN_CTX] + (size_t)(b * CL + s) * D : c.in[IN_X] + (size_t)(b * T + s - CL) * D;
        const f32x4* sp = (const f32x4*)src + c.lane; f32x4* dp = (f32x4*)(X + (size_t)r * D) + c.lane;
#pragma unroll
        for (int j = 0; j < 4; ++j) dp[64 * j] = sp[64 * j];
    }
}

template <bool FINAL>
__device__ __forceinline__ void phase_norm1(const Ctx& c, int L) {
    float* X = (float*)(c.ws + WS_X); float* H = (float*)(c.ws + WS_H);
    const int* SLOT = (const int*)(c.ws + WS_SLOT); const float* Y = (const float*)(c.ws + WS_Y);
    for (int r = c.gw; r < NROWS; r += c.ngw) {
        const int b = r / RB, s = r - b * RB, j = s < CL ? 8 : b;
        if (FINAL && s < CL) continue;
        f32x4* xp = (f32x4*)(X + (size_t)r * D) + c.lane;
        f32x4 v[4];
#pragma unroll
        for (int q = 0; q < 4; ++q) v[q] = xp[64 * q];
        if (L > 0) {
            f32x4 sum[4] = {};
            for (int e = 0; e < NE; ++e) {
                const int sp = SLOT[(size_t)r * NE + e];
                if (sp >= 0) { const f32x4* yp = (const f32x4*)(Y + ((size_t)e * EROWS + sp) * D) + c.lane;
#pragma unroll
                    for (int q = 0; q < 4; ++q) sum[q] += yp[64 * q]; }
            }
            const f32x4* g2 = (const f32x4*)modp(c, L - 1, j, 5) + c.lane;
#pragma unroll
            for (int q = 0; q < 4; ++q) { v[q] += g2[64 * q] * sum[q]; if (!FINAL) xp[64 * q] = v[q]; }
        }
        float ss = 0.f;
#pragma unroll
        for (int q = 0; q < 4; ++q) ss += v[q].x * v[q].x + v[q].y * v[q].y + v[q].z * v[q].z + v[q].w * v[q].w;
        const float rstd = rsqrtf(wave_sum(ss) * (1.0f / D) + EPS);
        if (FINAL) {
            const f32x4* g = (const f32x4*)c.in[IN_FNG] + c.lane; f32x4* op = (f32x4*)(c.out + (size_t)(b * T + s - CL) * D) + c.lane;
#pragma unroll
            for (int q = 0; q < 4; ++q) op[64 * q] = v[q] * rstd * g[64 * q];
        } else {
            const f32x4* g = (const f32x4*)(c.in[IN_NORMG] + (size_t)(L * 2 + 0) * D) + c.lane;
            const f32x4* sc = (const f32x4*)modp(c, L, j, 1) + c.lane; const f32x4* sh = (const f32x4*)modp(c, L, j, 0) + c.lane;
            f32x4* hp = (f32x4*)(H + (size_t)r * D) + c.lane;
#pragma unroll
            for (int q = 0; q < 4; ++q) hp[64 * q] = v[q] * rstd * g[64 * q] * (1.0f + sc[64 * q]) + sh[64 * q];
        }
    }
}

__device__ __forceinline__ void phase_norm2_router(const Ctx& c, int L) {
    const float* X = (const float*)(c.ws + WS_X); float* H = (float*)(c.ws + WS_H); float* AFF = (float*)(c.ws + WS_AFF);
    const float* WR = c.in[IN_ROUTER] + (size_t)L * D * NE;
    for (int r = c.gw; r < NROWS; r += c.ngw) {
        const int j = row_j(r);
        const f32x4* xp = (const f32x4*)(X + (size_t)r * D) + c.lane;
        f32x4 v[4]; float ss = 0.f;
#pragma unroll
        for (int q = 0; q < 4; ++q) { v[q] = xp[64 * q]; ss += v[q].x * v[q].x + v[q].y * v[q].y + v[q].z * v[q].z + v[q].w * v[q].w; }
        const float rstd = rsqrtf(wave_sum(ss) * (1.0f / D) + EPS);
        const f32x4* g = (const f32x4*)(c.in[IN_NORMG] + (size_t)(L * 2 + 1) * D) + c.lane;
        const f32x4* sc = (const f32x4*)modp(c, L, j, 4) + c.lane; const f32x4* sh = (const f32x4*)modp(c, L, j, 3) + c.lane;
        f32x4* hp = (f32x4*)(H + (size_t)r * D) + c.lane;
        float lg[16];
#pragma unroll
        for (int e = 0; e < 16; ++e) lg[e] = 0.f;
#pragma unroll
        for (int q = 0; q < 4; ++q) {
            const f32x4 f = v[q] * rstd * g[64 * q] * (1.0f + sc[64 * q]) + sh[64 * q];
            hp[64 * q] = f;
            const float* w = WR + (size_t)(4 * (c.lane + 64 * q)) * NE;
#pragma unroll
            for (int i = 0; i < 4; ++i) {
#pragma unroll
                for (int e4 = 0; e4 < 4; ++e4) { const f32x4 wv = *(const f32x4*)(w + i * NE + 4 * e4);
                    lg[4 * e4 + 0] += f[i] * wv.x; lg[4 * e4 + 1] += f[i] * wv.y; lg[4 * e4 + 2] += f[i] * wv.z; lg[4 * e4 + 3] += f[i] * wv.w; }
            }
        }
        const float mine = reduce16(lg, c.lane);
        const int k = reduce16_k(c.lane);
        float mx = mine;
#pragma unroll
        for (int o = 4; o < 64; o <<= 1) mx = fmaxf(mx, __shfl_xor(mx, o));
        const float ex = expf(mine - mx);
        float den = ex;
#pragma unroll
        for (int o = 4; o < 64; o <<= 1) den += __shfl_xor(den, o);
        if ((c.lane & 3) == 0) AFF[(size_t)r * NE + k] = ex / den;
    }
}

__device__ __forceinline__ void phase_topk(const Ctx& c, LAS float* vals) {
    const float* AFF = (const float*)(c.ws + WS_AFF);
    int* SELROW = (int*)(c.ws + WS_SELROW); float* SELGATE = (float*)(c.ws + WS_SELGATE); int* SLOT = (int*)(c.ws + WS_SLOT);
    for (int pid = blockIdx.x; pid < 256; pid += gridDim.x) {
        const bool lat = pid < 128; const int q = lat ? pid : pid - 128, b = q >> 4, e = q & 15;
        const int N = lat ? T : CL, C = lat ? CAP_LAT : CAP_CTX, row0 = b * RB + (lat ? CL : 0), base = lat ? b * CAP_LAT : NB * CAP_LAT + b * CAP_CTX;
        __syncthreads();
        for (int t = c.tid; t < N; t += 512) vals[t] = AFF[(size_t)(row0 + t) * NE + e];
        __syncthreads();
        if (lat) {
            float a[8]; int rk[8];
#pragma unroll
            for (int i = 0; i < 8; ++i) { a[i] = vals[c.tid + 512 * i]; rk[i] = 0; }
            for (int u = 0; u < N; ++u) { const float w = vals[u];
#pragma unroll
                for (int i = 0; i < 8; ++i) rk[i] += (w > a[i] || (w == a[i] && u < c.tid + 512 * i)) ? 1 : 0; }
#pragma unroll
            for (int i = 0; i < 8; ++i) { const int t = c.tid + 512 * i, row = row0 + t;
                if (rk[i] < C) { const int sp = base + rk[i]; SELROW[e * EROWS + sp] = row; SELGATE[e * EROWS + sp] = a[i]; SLOT[(size_t)row * NE + e] = sp; }
                else SLOT[(size_t)row * NE + e] = -1; }
        } else if (c.tid < N) {
            const float a = vals[c.tid]; int rk = 0;
            for (int u = 0; u < N; ++u) { const float w = vals[u]; rk += (w > a || (w == a && u < c.tid)) ? 1 : 0; }
            const int row = row0 + c.tid;
            if (rk < C) { const int sp = base + rk; SELROW[e * EROWS + sp] = row; SELGATE[e * EROWS + sp] = a; SLOT[(size_t)row * NE + e] = sp; }
            else SLOT[(size_t)row * NE + e] = -1;
        }
    }
}

__device__ __forceinline__ void phase_postproj(const Ctx& c, int i) {
    float* P = (float*)(c.ws + WS_P); const float* rope = (const float*)(c.ws + WS_ROPE);
    const float* qkg = c.in[IN_QKG] + (size_t)i * 2 * 64;
    for (int job = c.gt; job < NROWS * 26; job += c.ngt) {
        const int row = job / 26, hj = job - row * 26; const int s = row % RB;
        int col0, type;
        if (hj < 8) { col0 = hj * 64; type = 0; } else if (hj < 16) { col0 = 512 + (hj - 8) * 64; type = 1; }
        else if (hj < 24) { col0 = 2048 + (hj - 16) * 64; type = 2; } else { col0 = 2560 + (hj - 24) * 64; type = 3; }
        f32x4* p = (f32x4*)(P + (size_t)row * INW + col0);
        float v[64];
#pragma unroll
        for (int q = 0; q < 16; ++q) { const f32x4 t4 = p[q]; v[4 * q] = t4.x; v[4 * q + 1] = t4.y; v[4 * q + 2] = t4.z; v[4 * q + 3] = t4.w; }
        if (type == 1) {
#pragma unroll
            for (int d = 0; d < 64; ++d) v[d] *= 0.125f;
        }
        if (type >= 2) {
            float ss = 0.f;
#pragma unroll
            for (int d = 0; d < 64; ++d) ss += v[d] * v[d];
            const float rs = rsqrtf(ss * (1.0f / 64.0f) + EPS); const float* g = qkg + (type - 2) * 64;
#pragma unroll
            for (int d = 0; d < 64; ++d) v[d] = v[d] * rs * g[d];
        }
        if (s >= CL) {
            const int t = s - CL, pr = t >> 6, pc = t & 63;
#pragma unroll
            for (int f = 0; f < 16; ++f) {
                const float cr = rope[2 * (pr * 16 + f)], sr = rope[2 * (pr * 16 + f) + 1], cc = rope[2 * (pc * 16 + f)], sc = rope[2 * (pc * 16 + f) + 1];
                const float x1 = v[f], x2 = v[16 + f], y1 = v[32 + f], y2 = v[48 + f];
                v[f] = x1 * cr - x2 * sr; v[16 + f] = x1 * sr + x2 * cr; v[32 + f] = y1 * cc - y2 * sc; v[48 + f] = y1 * sc + y2 * cc;
            }
        }
#pragma unroll
        for (int q = 0; q < 16; ++q) p[q] = (f32x4){v[4 * q], v[4 * q + 1], v[4 * q + 2], v[4 * q + 3]};
    }
}

__device__ __forceinline__ void phase_retention(const Ctx& c, int i) {
    const float* P = (const float*)(c.ws + WS_P);
    for (int task = c.gw; task < NB * 8 * 2; task += c.ngw) {
        const int dir = task & 1, hh = (task >> 1) & 7, b = task >> 4;
        const float gam = expf(-expf(c.in[IN_RETRATE][(i * 2 + dir) * 8 + hh]));
        float* O = (float*)(c.ws + (dir ? WS_OB : WS_OF));
        float S[64];
#pragma unroll
        for (int d = 0; d < 64; ++d) S[d] = 0.f;
        auto seq_row = [&](int n) -> int { int s; if (dir == 0) s = n; else s = (n < CL) ? (CL - 1 - n) : (RB - 1 - (n - CL)); return b * RB + s; };
        int row = seq_row(0);
        float qv = P[(size_t)row * INW + hh * 64 + c.lane], kv = P[(size_t)row * INW + 512 + hh * 64 + c.lane], vv = P[(size_t)row * INW + 1024 + hh * 64 + c.lane];
        for (int n = 0; n < RB; ++n) {
            const int rown = seq_row(n + 1 < RB ? n + 1 : n);
            const float qn = P[(size_t)rown * INW + hh * 64 + c.lane], kn = P[(size_t)rown * INW + 512 + hh * 64 + c.lane], vn = P[(size_t)rown * INW + 1024 + hh * 64 + c.lane];
            float o = 0.f;
            if (dir == 0) {
#pragma unroll
                for (int d = 0; d < 64; ++d) { const float kd = __uint_as_float(__builtin_amdgcn_readlane(__float_as_uint(kv), d)), qd = __uint_as_float(__builtin_amdgcn_readlane(__float_as_uint(qv), d));
                    S[d] = gam * S[d] + kd * vv; o += qd * S[d]; }
            } else {
#pragma unroll
                for (int d = 0; d < 64; ++d) { const float kd = __uint_as_float(__builtin_amdgcn_readlane(__float_as_uint(kv), d)), qd = __uint_as_float(__builtin_amdgcn_readlane(__float_as_uint(qv), d));
                    const float sd = gam * S[d]; o += qd * sd; S[d] = sd + kd * vv; }
            }
            O[(size_t)row * 512 + hh * 64 + c.lane] = o;
            row = rown; qv = qn; kv = kn; vv = vn;
        }
    }
}

__device__ __forceinline__ void phase_ret_out(const Ctx& c, int i) {
    const float* P = (const float*)(c.ws + WS_P); const float* OF = (const float*)(c.ws + WS_OF); const float* OB = (const float*)(c.ws + WS_OB);
    float* MIX = (float*)(c.ws + WS_MIX); const float* gn = c.in[IN_RETGN] + (size_t)i * 512;
    for (int job = c.gt; job < NROWS * 8; job += c.ngt) {
        const int row = job >> 3, hh = job & 7;
        const f32x4* pf = (const f32x4*)(OF + (size_t)row * 512 + hh * 64); const f32x4* pb = (const f32x4*)(OB + (size_t)row * 512 + hh * 64);
        float v[64]; float mu = 0.f;
#pragma unroll
        for (int q = 0; q < 16; ++q) { const f32x4 t4 = pf[q] + pb[q]; v[4 * q] = t4.x; v[4 * q + 1] = t4.y; v[4 * q + 2] = t4.z; v[4 * q + 3] = t4.w; mu += t4.x + t4.y + t4.z + t4.w; }
        mu *= (1.0f / 64.0f); float var = 0.f;
#pragma unroll
        for (int d = 0; d < 64; ++d) { v[d] -= mu; var += v[d] * v[d]; }
        const float rs = rsqrtf(var * (1.0f / 64.0f) + EPS);
        const f32x4* pg = (const f32x4*)(P + (size_t)row * INW + 1536 + hh * 64); f32x4* po = (f32x4*)(MIX + (size_t)row * D + hh * 64);
#pragma unroll
        for (int q = 0; q < 16; ++q) { const f32x4 gt = pg[q]; f32x4 o;
            o.x = siluf_(gt.x) * (v[4 * q] * rs * gn[hh * 64 + 4 * q]); o.y = siluf_(gt.y) * (v[4 * q + 1] * rs * gn[hh * 64 + 4 * q + 1]);
            o.z = siluf_(gt.z) * (v[4 * q + 2] * rs * gn[hh * 64 + 4 * q + 2]); o.w = siluf_(gt.w) * (v[4 * q + 3] * rs * gn[hh * 64 + 4 * q + 3]);
            po[q] = o; }
    }
}

__device__ __forceinline__ void phase_attention(const Ctx& c) {
    const float* P = (const float*)(c.ws + WS_P); float* MIX = (float*)(c.ws + WS_MIX);
    for (int task = c.gw; task < NB * 8 * 68; task += c.ngw) {
        const int qg = task % 68, bh = task / 68, hh = bh & 7, b = bh >> 3, kvh = hh >> 2;
        const int s = qg * 64 + c.lane, row = b * RB + s;
        const int nkeys = (qg < 4) ? CL : RB;
        float q[64], acc[64];
        { const f32x4* qp = (const f32x4*)(P + (size_t)row * INW + 2048 + hh * 64);
#pragma unroll
          for (int t4 = 0; t4 < 16; ++t4) { const f32x4 x = qp[t4]; q[4 * t4] = x.x * 0.125f; q[4 * t4 + 1] = x.y * 0.125f; q[4 * t4 + 2] = x.z * 0.125f; q[4 * t4 + 3] = x.w * 0.125f; } }
#pragma unroll
        for (int d = 0; d < 64; ++d) acc[d] = 0.f;
        float m = -INFINITY, l = 0.f;
        const float* kbase = P + (size_t)(b * RB) * INW + 2560 + kvh * 64; const float* vbase = P + (size_t)(b * RB) * INW + 2688 + kvh * 64;
        for (int key = 0; key < nkeys; ++key) {
            const f32x4* kp = (const f32x4*)(kbase + (size_t)key * INW);
            float sc = 0.f;
#pragma unroll
            for (int t4 = 0; t4 < 16; ++t4) { const f32x4 x = kp[t4]; sc += q[4 * t4] * x.x + q[4 * t4 + 1] * x.y + q[4 * t4 + 2] * x.z + q[4 * t4 + 3] * x.w; }
            const float mn = fmaxf(m, sc), corr = expf(m - mn), p = expf(sc - mn);
            m = mn; l = l * corr + p;
            const f32x4* vp = (const f32x4*)(vbase + (size_t)key * INW);
#pragma unroll
            for (int t4 = 0; t4 < 16; ++t4) { const f32x4 x = vp[t4];
                acc[4 * t4] = acc[4 * t4] * corr + p * x.x; acc[4 * t4 + 1] = acc[4 * t4 + 1] * corr + p * x.y; acc[4 * t4 + 2] = acc[4 * t4 + 2] * corr + p * x.z; acc[4 * t4 + 3] = acc[4 * t4 + 3] * corr + p * x.w; }
        }
        const float il = 1.0f / l; f32x4* op = (f32x4*)(MIX + (size_t)row * D + 512 + hh * 64);
#pragma unroll
        for (int t4 = 0; t4 < 16; ++t4) op[t4] = (f32x4){acc[4 * t4] * il, acc[4 * t4 + 1] * il, acc[4 * t4 + 2] * il, acc[4 * t4 + 3] * il};
    }
}

__device__ __forceinline__ void phase_s5_scan(const Ctx& c, int i) {
    const float* H = (const float*)(c.ws + WS_H);
    for (int task = c.gw; task < NB * 64 * 2; task += c.ngw) {
        const int dir = task & 1, g = (task >> 1) & 63, b = task >> 7, p = c.lane;
        float* Yo = (float*)(c.ws + (dir ? WS_YB : WS_YF));
        const float a_re = c.in[IN_S5ARE][((i * 2 + dir) * 64 + g) * 64 + p], a_im = c.in[IN_S5AIM][((i * 2 + dir) * 64 + g) * 64 + p];
        const float dt = expf(c.in[IN_S5DT][(i * 2 + dir) * 64 + g]);
        const float lre = fminf(a_re, -1e-4f), lim = a_im;
        const float ea = lre * dt, eb = lim * dt, mag = expf(ea), cb = cosf(eb), sb = sinf(eb), sh = sinf(0.5f * eb);
        const float bar_re = mag * cb, bar_im = mag * sb;
        const float nr = expm1f(ea) * cb - 2.0f * sh * sh, ni = bar_im;
        const float den = lre * lre + lim * lim;
        const float k_re = (nr * lre + ni * lim) / den, k_im = (ni * lre - nr * lim) / den;
        float bbr[16], bbi[16], ccr[16], cci[16];
#pragma unroll
        for (int k = 0; k < 16; ++k) {
            const float br = c.in[IN_S5BRE][((size_t)(i * 64 + g) * 64 + p) * 16 + k], bi = c.in[IN_S5BIM][((size_t)(i * 64 + g) * 64 + p) * 16 + k];
            bbr[k] = k_re * br - k_im * bi; bbi[k] = k_re * bi + k_im * br;
            ccr[k] = c.in[IN_S5CRE][(((size_t)(i * 2 + dir) * 64 + g) * 16 + k) * 64 + p]; cci[k] = c.in[IN_S5CIM][(((size_t)(i * 2 + dir) * 64 + g) * 16 + k) * 64 + p];
        }
        float xr = 0.f, xi = 0.f;
        const int kk = reduce16_k(c.lane);
        auto seq_row = [&](int n) -> int { int s; if (dir == 0) s = n; else s = (n < CL) ? (CL - 1 - n) : (RB - 1 - (n - CL)); return b * RB + s; };
        for (int n = 0; n < RB; ++n) {
            const int row = seq_row(n);
            const f32x4* up = (const f32x4*)(H + (size_t)row * D + g * 16);
            const f32x4 u0 = up[0], u1 = up[1], u2 = up[2], u3 = up[3];
            const float u[16] = {u0.x, u0.y, u0.z, u0.w, u1.x, u1.y, u1.z, u1.w, u2.x, u2.y, u2.z, u2.w, u3.x, u3.y, u3.z, u3.w};
            float br = 0.f, bi = 0.f;
#pragma unroll
            for (int k = 0; k < 16; ++k) { br += bbr[k] * u[k]; bi += bbi[k] * u[k]; }
            const float nxr = bar_re * xr - bar_im * xi + br, nxi = bar_re * xi + bar_im * xr + bi;
            xr = nxr; xi = nxi;
            float tv[16];
#pragma unroll
            for (int k = 0; k < 16; ++k) tv[k] = ccr[k] * xr - cci[k] * xi;
            const float y = reduce16(tv, c.lane);
            if ((c.lane & 3) == 0) Yo[(size_t)row * D + g * 16 + kk] = y;
        }
    }
}
__device__ __forceinline__ void phase_s5_out(const Ctx& c, int i) {
    const f32x4* YF = (const f32x4*)(c.ws + WS_YF); const f32x4* YB = (const f32x4*)(c.ws + WS_YB); const f32x4* H = (const f32x4*)(c.ws + WS_H);
    f32x4* Z = (f32x4*)(c.ws + WS_Z); const f32x4* dsk = (const f32x4*)(c.in[IN_S5D] + (size_t)i * D);
    for (size_t idx = c.gt; idx < (size_t)NROWS * D / 4; idx += c.ngt) {
        const f32x4 y = YF[idx] + YB[idx] + dsk[idx & 255] * H[idx];
        Z[idx] = (f32x4){gelu_tanh(y.x), gelu_tanh(y.y), gelu_tanh(y.z), gelu_tanh(y.w)};
    }
}

struct ALDense { const float* A; int lda; size_t gstride; __device__ __forceinline__ const float* row(int g, int r) const { return A + (size_t)g * gstride + (size_t)r * lda; } };
struct ALGather { const float* A; const int* idx; __device__ __forceinline__ const float* row(int g, int r) const { return A + (size_t)idx[g * EROWS + r] * D; } };
struct BL1 { const float* B; int ldb; size_t gstride; __device__ __forceinline__ const float* ptr(int g, int) const { return B + (size_t)g * gstride; } };
struct BL2 { const float* Ba; const float* Bb; int ldb; size_t gstride; __device__ __forceinline__ const float* ptr(int g, int sub) const { return (sub ? Bb : Ba) + (size_t)g * gstride; } };
struct EPStore { float* O; int ldc; __device__ __forceinline__ void operator()(int, int row, int col, float v, float) const { O[(size_t)row * ldc + col] = v; } };
struct EPResid { float* X; const float* mod; int L; __device__ __forceinline__ void operator()(int, int row, int col, float v, float) const {
    const int j = row_j(row); const float g1 = mod[((size_t)(L * 9 + j) * 6 + 2) * 1024 + col]; X[(size_t)row * D + col] += g1 * v; } };
struct EPGlu { float* X; const float* mod; const float* bias; int L; __device__ __forceinline__ void operator()(int, int row, int col, float va, float vb) const {
    const int j = row_j(row); const float g1 = mod[((size_t)(L * 9 + j) * 6 + 2) * 1024 + col];
    const float o = (va + bias[col]) * sigmoidf_(vb + bias[1024 + col]); X[(size_t)row * D + col] += g1 * o; } };
struct EPSwiglu { float* HID; __device__ __forceinline__ void operator()(int g, int row, int col, float va, float vb) const { HID[((size_t)g * EROWS + row) * FF + col] = siluf_(va) * vb; } };
struct EPGate { float* Y; const float* gate; __device__ __forceinline__ void operator()(int g, int row, int col, float v, float) const { Y[((size_t)g * EROWS + row) * D + col] = gate[g * EROWS + row] * v; } };

__global__ void __launch_bounds__(512, 2) fwd(Args args) {
    extern __shared__ __attribute__((aligned(16))) unsigned char lds[];
    Ctx c; c.in = args.in; c.out = args.out; c.ws = args.ws;
    c.tid = threadIdx.x; c.lane = c.tid & 63; c.wave = __builtin_amdgcn_readfirstlane(c.tid >> 6);
    c.gw = blockIdx.x * 8 + c.wave; c.ngw = gridDim.x * 8; c.gt = blockIdx.x * 512 + c.tid; c.ngt = gridDim.x * 512;
    LAS float* ldsf = (LAS float*)lds;
    volatile LAS unsigned* MISC = (volatile LAS unsigned*)((LAS unsigned char*)lds + MISC_OFF);
    if (c.tid < 32) MISC[c.tid] = 0u;
    __syncthreads();
    const int lo = args.ph_lo, hi = args.ph_hi;
    const bool one_launch = (hi - lo) > 1;
    XcdBarrier bar; bar.bar = (unsigned*)(c.ws + WS_CTL) + CW_BAR; bar.x = 0; bar.st = MISC + 8;
    if (one_launch) bar = xcd_barrier_post((unsigned*)(c.ws + WS_CTL) + CW_BAR, MISC + 8);
#define IN(k) (lo <= (k) && (k) < hi)
#define SEAM(k) do { if ((k) + 1 < hi) xcd_barrier(bar); } while (0)
#define FRESH(cc) Ctx cc = c; unsigned zq; asm volatile("s_mov_b32 %0, 0" : "=s"(zq)); cc.ws = c.ws + zq; cc.out = c.out + zq; cc.in = (const float* const*)((const char*)c.in + zq); const int Lq = L + (int)zq, iq = Lq >> 1; const float* MOD = (const float*)(cc.ws + WS_MOD); (void)MOD; (void)iq

    if (IN(PH_PRO)) { const int L = 0; FRESH(cc); phase_pro(cc, ldsf); SEAM(PH_PRO); }

#define LAYER_BODY(LL) { constexpr int L = LL; \
        const int pb = 1 + L * PH_PER_LAYER; \
        if (IN(pb + 0)) { FRESH(cc); phase_norm1<false>(cc, Lq); SEAM(pb + 0); } \
        if ((L & 1) == 0) { \
            if (IN(pb + 1)) { \
                FRESH(cc); \
                ALDense al{(const float*)(cc.ws + WS_H), D, 0}; BL1 bl{cc.in[IN_MIXIN] + (size_t)iq * D * INW, INW, 0}; EPStore ep{(float*)(cc.ws + WS_P), INW}; \
                gemm_f32<false>(1, NROWS, INW, D, al, bl, ep); SEAM(pb + 1); } \
            if (IN(pb + 2)) { FRESH(cc); phase_postproj(cc, iq); SEAM(pb + 2); } \
            if (IN(pb + 3)) { FRESH(cc); phase_retention(cc, iq); SEAM(pb + 3); } \
            if (IN(pb + 4)) { FRESH(cc); phase_attention(cc); SEAM(pb + 4); } \
            if (IN(pb + 5)) { FRESH(cc); phase_ret_out(cc, iq); SEAM(pb + 5); } \
            if (IN(pb + 6)) { \
                FRESH(cc); \
                ALDense al{(const float*)(cc.ws + WS_MIX), D, 0}; BL1 bl{cc.in[IN_MIXOUT] + (size_t)iq * D * D, D, 0}; EPResid ep{(float*)(cc.ws + WS_X), MOD, Lq}; \
                gemm_f32<false>(1, NROWS, D, D, al, bl, ep); SEAM(pb + 6); } \
        } else { \
            if (IN(pb + 1)) { FRESH(cc); phase_s5_scan(cc, iq); SEAM(pb + 1); } \
            if (IN(pb + 2)) { FRESH(cc); phase_s5_out(cc, iq); SEAM(pb + 2); } \
            if (IN(pb + 3)) { \
                FRESH(cc); \
                ALDense al{(const float*)(cc.ws + WS_Z), D, 0}; const float* gw = cc.in[IN_GLUW] + (size_t)iq * D * 2048; \
                BL2 bl{gw, gw + 1024, 2048, 0}; EPGlu ep{(float*)(cc.ws + WS_X), MOD, cc.in[IN_GLUB] + (size_t)iq * 2048, Lq}; \
                gemm_f32<true>(1, NROWS, D, D, al, bl, ep); SEAM(pb + 3); } \
        } \
        if (IN(pb + 7)) { FRESH(cc); phase_norm2_router(cc, Lq); SEAM(pb + 7); } \
        if (IN(pb + 8)) { FRESH(cc); phase_topk(cc, ldsf); SEAM(pb + 8); } \
        if (IN(pb + 9)) { \
            FRESH(cc); \
            ALGather al{(const float*)(cc.ws + WS_H), (const int*)(cc.ws + WS_SELROW)}; \
            BL2 bl{cc.in[IN_W1] + (size_t)Lq * NE * D * FF, cc.in[IN_W3] + (size_t)Lq * NE * D * FF, FF, (size_t)D * FF}; EPSwiglu ep{(float*)(cc.ws + WS_HID)}; \
            gemm_f32<true>(NE, EROWS, FF, D, al, bl, ep); SEAM(pb + 9); } \
        if (IN(pb + 10)) { \
            FRESH(cc); \
            ALDense al{(const float*)(cc.ws + WS_HID), FF, (size_t)EROWS * FF}; BL1 bl{cc.in[IN_W2] + (size_t)Lq * NE * FF * D, D, (size_t)FF * D}; \
            EPGate ep{(float*)(cc.ws + WS_Y), (const float*)(cc.ws + WS_SELGATE)}; \
            gemm_f32<false>(NE, EROWS, D, FF, al, bl, ep); SEAM(pb + 10); } \
    }
    LAYER_BODY(0) LAYER_BODY(1) LAYER_BODY(2) LAYER_BODY(3)
#undef LAYER_BODY
    if (IN(PH_FIN)) { const int L = DEPTH; FRESH(cc); phase_norm1<true>(cc, DEPTH); }
#undef IN
#undef SEAM
}

static bool phase_valid(int ph) {
    if (ph == PH_PRO || ph == PH_FIN) return true;
    const int L = (ph - 1) / PH_PER_LAYER, k = (ph - 1) % PH_PER_LAYER;
    if (L & 1) return !(k >= 4 && k <= 6);
    return true;
}
extern "C" void kernel_launch(void* const* d_in, const int* in_sizes, int n_in, void* d_out, int out_size, void* d_ws, size_t ws_size, hipStream_t stream) {
    static int grid = 0;
    if (grid == 0) {
        if (n_in != 27 || out_size != NB * T * D || ws_size < WS_END) { fprintf(stderr, "kernel_launch: unexpected shapes (n_in %d out %d ws %zu)\n", n_in, out_size, ws_size); grid = -1; return; }
        int dev = 0, cus = 0;
        if (hipGetDevice(&dev) != hipSuccess || hipDeviceGetAttribute(&cus, hipDeviceAttributeMultiprocessorCount, dev) != hipSuccess) { grid = -1; return; }
        if (hipFuncSetAttribute((const void*)fwd, hipFuncAttributeMaxDynamicSharedMemorySize, LDS_BYTES) != hipSuccess) { grid = -1; return; }
        int per_cu = 0;
        if (hipOccupancyMaxActiveBlocksPerMultiprocessor(&per_cu, (const void*)fwd, 512, LDS_BYTES) != hipSuccess || per_cu < 1) fprintf(stderr, "kernel_launch: occupancy query says %d\n", per_cu);
        (void)hipGetLastError();
        grid = cus;
    }
    if (grid < 0) return;
    if (hipMemsetAsync((char*)d_ws + WS_CTL, 0, CTL_ZERO_BYTES, stream) != hipSuccess) return;
    Args a{};
    for (int i = 0; i < 27; ++i) a.in[i] = (const float*)d_in[i];
    a.out = (float*)d_out; a.ws = (unsigned char*)d_ws;
#if MK_MULTI
    for (int ph = 0; ph < NPH; ++ph) {
        if (!phase_valid(ph)) continue;
        a.ph_lo = ph; a.ph_hi = ph + 1;
        hipLaunchKernelGGL(fwd, dim3(grid), dim3(512), LDS_BYTES, stream, a);
    }
#else
    a.ph_lo = 0; a.ph_hi = NPH;
    hipLaunchKernelGGL(fwd, dim3(grid), dim3(512), LDS_BYTES, stream, a);
#endif
}
```

```cpp
#include <hip/hip_runtime.h>
#include <hip/hip_bf16.h>
#include <cstdio>
#include <cstdint>

#define GAS __attribute__((address_space(1)))
#define LAS __attribute__((address_space(3)))
typedef float f32x4 __attribute__((ext_vector_type(4)));
typedef float f32x16 __attribute__((ext_vector_type(16)));

constexpr int NB = 8, T = 4096, D = 1024, CL = 256, RB = CL + T  , NROWS = NB * RB  ;
constexpr int DEPTH = 4, NE = 16, FF = 2048, INW = 2816;
constexpr int CAP_LAT = 512, CAP_CTX = 32, EROWS = NB * (CAP_LAT + CAP_CTX)  ;
constexpr float EPS = 1e-6f;
#ifndef MK_MULTI
#define MK_MULTI 0
#endif

constexpr size_t MiB = 1u << 20;
constexpr size_t WS_CTL = 0, CTL_ZERO_BYTES = 1 * MiB;
constexpr size_t WS_MOD = 1 * MiB;
constexpr size_t WS_ROPE = 2 * MiB;
constexpr size_t WS_SELROW = 3 * MiB;
constexpr size_t WS_SELGATE = 3 * MiB + 512 * 1024;
constexpr size_t WS_AFF = 4 * MiB;
constexpr size_t WS_SLOT = 7 * MiB;
constexpr size_t WS_X = 10 * MiB;
constexpr size_t WS_H = 146 * MiB;
constexpr size_t WS_HB = 282 * MiB;
constexpr size_t WS_W13 = 350 * MiB;
constexpr size_t WS_W2 = 862 * MiB;
constexpr size_t WS_WIN = 1118 * MiB;
constexpr size_t WS_WOUT = 1130 * MiB;
constexpr size_t WS_WGLU = 1134 * MiB;
constexpr size_t WS_HB1 = 1144 * MiB;
constexpr size_t WS_BIG = 1212 * MiB;
constexpr size_t WS_P = WS_BIG;
constexpr size_t WS_OF = WS_BIG + 374 * MiB;
constexpr size_t WS_OB = WS_BIG + 442 * MiB;
constexpr size_t WS_MIX = WS_BIG + 510 * MiB;
constexpr size_t WS_QA = WS_BIG + 578 * MiB;
constexpr size_t WS_KA = WS_BIG + 612 * MiB;
constexpr size_t WS_VA = WS_BIG + 621 * MiB;
constexpr size_t WS_YF = WS_BIG;
constexpr size_t WS_YB = WS_BIG + 136 * MiB;
constexpr size_t WS_Z = WS_BIG + 272 * MiB;
constexpr size_t WS_HID = WS_BIG;
constexpr size_t WS_Y = WS_BIG + 272 * MiB;
constexpr size_t WS_END = WS_BIG + 646 * MiB;
constexpr int CW_BAR = 4096;

constexpr int LDS_BYTES = 147456;
constexpr int MISC_OFF = 131072 + 320;

constexpr int PH_PRO = 0, PH_PER_LAYER = 11, PH_FIN = 1 + DEPTH * PH_PER_LAYER, NPH = PH_FIN + 1;

#define XB_TMO      128
#define XB_XCNT(j)  (256  + 64 * (j))
#define XB_XSUB(j)  (1280 + 64 * (j))
#define XB_XGEN(j)  (2304 + 64 * (j))
#define XB_TOP      3328
#define XB_TOPGEN   3392
#define XCD_BAR_WORDS 3456
#define XB_SPIN_CAP (1u << 22)

__device__ __forceinline__ unsigned xb_ld(unsigned* p)              { return __hip_atomic_load(p, __ATOMIC_RELAXED, __HIP_MEMORY_SCOPE_AGENT); }
__device__ __forceinline__ unsigned xb_add(unsigned* p, unsigned v) { return __hip_atomic_fetch_add(p, v, __ATOMIC_RELAXED, __HIP_MEMORY_SCOPE_AGENT); }
__device__ __forceinline__ unsigned xb_xcc_id() { return (unsigned)__builtin_amdgcn_s_getreg((3 << 11) | 20) & 0xFu; }
#define XB_SPIN(cond, bar) do { unsigned _sp = 0; while (cond) { __builtin_amdgcn_s_sleep(1); \
    if ((++_sp & 255u) == 0u) { if (xb_ld(&(bar)[XB_TMO])) break; if (_sp > XB_SPIN_CAP) { atomicAdd(&(bar)[XB_TMO], 1u); break; } } } } while (0)

struct XcdBarrier { unsigned* bar; unsigned x; volatile LAS unsigned* st; };

__device__ __forceinline__ XcdBarrier xcd_barrier_post(unsigned* bar, volatile LAS unsigned* st) {
    XcdBarrier b; b.bar = bar; b.x = xb_xcc_id(); b.st = st;
    if (threadIdx.x == 0) (void)xb_add(&bar[XB_XCNT(b.x)], 1u);
    return b;
}
__device__ __forceinline__ void xcd_barrier_complete(unsigned* bar, unsigned x, unsigned& nloc, unsigned& nx) {
    const unsigned G = gridDim.x * gridDim.y * gridDim.z;
    unsigned sum, cnt, mine, sp = 0u;
    for (;;) {
        sum = 0u; cnt = 0u; mine = 0u;
#pragma unroll
        for (unsigned j = 0; j < 16; ++j) { const unsigned c = xb_ld(&bar[XB_XCNT(j)]); sum += c; cnt += (c > 0u) ? 1u : 0u; mine = (j == x) ? c : mine; }
        if (sum == G) break;
        __builtin_amdgcn_s_sleep(1);
        if ((++sp & 255u) == 0u) { if (xb_ld(&bar[XB_TMO])) break; if (sp > XB_SPIN_CAP) { atomicAdd(&bar[XB_TMO], 1u); break; } }
    }
    nloc = mine > 0u ? mine : 1u; nx = cnt > 0u ? cnt : 1u;
}
__device__ __forceinline__ void xcd_barrier(const XcdBarrier& b) {
    asm volatile("s_waitcnt vmcnt(0)" ::: "memory");
    __syncthreads();
    if (threadIdx.x == 0) {
        unsigned* bar = b.bar;
        __builtin_amdgcn_s_waitcnt(0);
        unsigned nloc = b.st[0], nx = b.st[1];
        if (nloc == 0u) { xcd_barrier_complete(bar, b.x, nloc, nx); b.st[0] = nloc; b.st[1] = nx; }
        const unsigned old = xb_add(&bar[XB_XSUB(b.x)], 1u);
        const unsigned gen = old / nloc;
        if (old + 1u == (gen + 1u) * nloc) {
            __builtin_amdgcn_fence(__ATOMIC_RELEASE, "agent");
            asm volatile("s_waitcnt vmcnt(0)" ::: "memory");
            const unsigned og = xb_add(&bar[XB_TOP], 1u);
            const unsigned tg = og / nx;
            if (og + 1u == (tg + 1u) * nx) xb_add(&bar[XB_TOPGEN], 1u);
            else XB_SPIN(xb_ld(&bar[XB_TOPGEN]) == tg, bar);
            __builtin_amdgcn_fence(__ATOMIC_ACQUIRE, "agent");
            xb_add(&bar[XB_XGEN(b.x)], 1u);
            asm volatile("s_waitcnt vmcnt(0)" ::: "memory");
        } else {
            XB_SPIN(xb_ld(&bar[XB_XGEN(b.x)]) == gen, bar);
            __builtin_amdgcn_fence(__ATOMIC_ACQUIRE, "agent");
            asm volatile("s_waitcnt vmcnt(0)" ::: "memory");
        }
    }
    __syncthreads();
}

struct Args { const float* in[27]; float* out; unsigned char* ws; int ph_lo, ph_hi; };

struct Ctx {
    const float* const* in; float* out; unsigned char* ws;
    int tid, lane, wave, gw, ngw, gt, ngt;
};
enum { IN_X = 0, IN_C, IN_CTX, IN_CCTX, IN_MODW, IN_MODB, IN_NORMG, IN_MIXIN, IN_MIXOUT, IN_RETRATE, IN_RETGN, IN_QKG,
       IN_S5ARE, IN_S5AIM, IN_S5DT, IN_S5BRE, IN_S5BIM, IN_S5CRE, IN_S5CIM, IN_S5D, IN_GLUW, IN_GLUB, IN_ROUTER, IN_W1, IN_W3, IN_W2, IN_FNG };

__device__ __forceinline__ float wave_sum(float v) {
#pragma unroll
    for (int o = 1; o < 64; o <<= 1) v += __shfl_xor(v, o);
    return v;
}
__device__ __forceinline__ float sigmoidf_(float x) { return 1.0f / (1.0f + expf(-x)); }
__device__ __forceinline__ float siluf_(float x) { return x * sigmoidf_(x); }
__device__ __forceinline__ float gelu_tanh(float x) { const float u = 0.7978845608028654f * (x + 0.044715f * x * x * x); return 0.5f * x * (1.0f + tanhf(u)); }
__device__ __forceinline__ const float* modp(const Ctx& c, int L, int j, int chunk) { return (const float*)(c.ws + WS_MOD) + ((size_t)(L * 9 + j) * 6 + chunk) * 1024; }
__device__ __forceinline__ int row_j(int row) { const int b = row / RB, s = row - b * RB; return s < CL ? 8 : b; }

__device__ __forceinline__ float reduce16(const float (&v)[16], int lane) {
    float a[8], b[4], c2[2], d;
    const bool b5 = (lane & 32) != 0, b4 = (lane & 16) != 0, b3 = (lane & 8) != 0, b2 = (lane & 4) != 0;
#pragma unroll
    for (int i = 0; i < 8; ++i) { const float keep = b5 ? v[8 + i] : v[i], send = b5 ? v[i] : v[8 + i]; a[i] = keep + __shfl_xor(send, 32); }
#pragma unroll
    for (int i = 0; i < 4; ++i) { const float keep = b4 ? a[4 + i] : a[i], send = b4 ? a[i] : a[4 + i]; b[i] = keep + __shfl_xor(send, 16); }
#pragma unroll
    for (int i = 0; i < 2; ++i) { const float keep = b3 ? b[2 + i] : b[i], send = b3 ? b[i] : b[2 + i]; c2[i] = keep + __shfl_xor(send, 8); }
    { const float keep = b2 ? c2[1] : c2[0], send = b2 ? c2[0] : c2[1]; d = keep + __shfl_xor(send, 4); }
    d += __shfl_xor(d, 2); d += __shfl_xor(d, 1);
    return d;
}
__device__ __forceinline__ int reduce16_k(int lane) { return ((lane >> 5) & 1) * 8 + ((lane >> 4) & 1) * 4 + ((lane >> 3) & 1) * 2 + ((lane >> 2) & 1); }

namespace pg8 {
typedef unsigned short bf16_t;
typedef short bf16x8 __attribute__((ext_vector_type(8)));
typedef unsigned u32x4 __attribute__((ext_vector_type(4)));
typedef unsigned u32x2 __attribute__((ext_vector_type(2)));
constexpr int BM = 256, BK = 64, HALF = 128, HTB = HALF * BK * 2, STAGE_BYTES = 8 * HTB, NXCD = 8, WGM = 8;
__host__ __device__ __forceinline__ int lds_byte(int r, int c) { const int st = (r >> 4) * 2 + (c >> 5), rr = r & 15, cc = c & 31, ob = rr * 64 + cc * 2; return st * 1024 + (ob ^ (((ob >> 9) & 1) << 5)); }
__host__ __device__ __forceinline__ void stage_rc(int b, int& R, int& C) { const int st = b / 1024, sb = b % 1024, swz = sb ^ (((sb >> 9) & 1) << 5); R = (st >> 1) * 16 + swz / 64; C = (st & 1) * 32 + (swz % 64) / 2; }
__host__ __device__ __forceinline__ int perm32(int rho) { const int n = rho >> 4, i = rho & 15; return 8 * (i >> 2) + 4 * n + (i & 3); }
__device__ __forceinline__ unsigned cvt_pk_bf16(float lo, float hi) { unsigned r; asm volatile("v_cvt_pk_bf16_f32 %0, %1, %2" : "=v"(r) : "v"(lo), "v"(hi)); return r; }

struct Unit { int pm, pn, g; };
struct GOrder {
    int nM, nN, per, nwg, G, c;
    __device__ __forceinline__ void init(int groups, int M, int N, int G_, int c_) { nM = M / BM; nN = N / BM; per = nM * nN; nwg = groups * per; G = G_; c = c_; }
    __device__ __forceinline__ bool next(int i, Unit& u) const {
        const long L = (long)i * G + c; if (L >= nwg) return false;
        int wgid = (int)L; { const int q = nwg / NXCD, r = nwg % NXCD, xcd = wgid % NXCD, off = wgid / NXCD; wgid = (xcd < r ? xcd * (q + 1) : r * (q + 1) + (xcd - r) * q) + off; }
        u.g = wgid / per; const int w = wgid - u.g * per;
        const int nig = WGM * nN, gid = w / nig, fm = gid * WGM, gsz = (nM - fm) < WGM ? (nM - fm) : WGM;
        u.pm = fm + ((w % nig) % gsz); u.pn = (w % nig) / gsz; return true;
    }
};
struct ADense  { static constexpr bool GATHER = false; const bf16_t* A; size_t gstride; const int* idx; int rpg; };
struct AGather { static constexpr bool GATHER = true;  const bf16_t* A; size_t gstride; const int* idx; int rpg; };

template <class Epi, class ALoc>
__device__ __forceinline__ void gemm_phase(LAS unsigned char* lds, const ALoc AL, const bf16_t* Bt, size_t gstrideB, int K, const GOrder& S, const Epi& E) {
    constexpr bool GATHER = ALoc::GATHER;
    const int tid = threadIdx.x, wid = __builtin_amdgcn_readfirstlane(tid >> 6), lane = tid & 63, wr = wid >> 2, wc = wid & 3, fr = lane & 15, fq = lane >> 4;
    const int nt = K / BK;
    unsigned voffA[2], voffB[2]; int RA[2]; unsigned CA2[2];
#pragma unroll
    for (int i = 0; i < 2; ++i) { int R, C; stage_rc(tid * 16 + i * 8192, R, C); const int Rb = Epi::PERM ? ((R & ~31) + perm32(R & 31)) : R;
        voffA[i] = (unsigned)(R * K + C) * 2u; voffB[i] = (unsigned)(Rb * K + C) * 2u; RA[i] = R; CA2[i] = (unsigned)C * 2u; }
    const size_t kstep = (size_t)(BK * 2);
    const size_t hstep = (size_t)HALF * K * 2;
    const size_t hstepA = GATHER ? 0 : hstep;
    const size_t tstep = 2 * hstep;
    const unsigned ldsw = (unsigned)wid * 1024u;
    const int aoff = lds_byte(wr * 64 + fr, fq * 8), boff = lds_byte(wc * 32 + fr, fq * 8);
    unsigned vAc[2][2], vAn[2][2];
#define PG8_SA(b, h) (((b) * 2 + (h)) * HTB)
#define PG8_SB(b, h) ((4 + (b) * 2 + (h)) * HTB)
#define PG8_STAGE(bufoff, gbase, voff) do { _Pragma("unroll") for (int _i = 0; _i < 2; ++_i) \
        __builtin_amdgcn_global_load_lds((const unsigned*)((const char*)(gbase) + (voff)[_i]), (LAS unsigned*)(lds + (bufoff) + ldsw + _i * 8192), 16, 0, 0); } while (0)
#define PG8_STAGE_A(bufoff, gbase, h, nx) do { _Pragma("unroll") for (int _i = 0; _i < 2; ++_i) { \
        const unsigned _o = GATHER ? ((nx) ? vAn[h][_i] : vAc[h][_i]) : voffA[_i]; \
        __builtin_amdgcn_global_load_lds((const unsigned*)((const char*)(gbase) + (size_t)(h) * hstepA + _o), (LAS unsigned*)(lds + (bufoff) + ldsw + _i * 8192), 16, 0, 0); } } while (0)
#define PG8_GIDX(u, v) do { if (GATHER) { _Pragma("unroll") for (int _h = 0; _h < 2; ++_h) _Pragma("unroll") for (int _i = 0; _i < 2; ++_i) \
        v[_h][_i] = (unsigned)AL.idx[(u).g * AL.rpg + (u).pm * BM + _h * HALF + RA[_i]] * (unsigned)(K * 2) + CA2[_i]; } } while (0)
#define PG8_ABASE(u) ((const char*)AL.A + (GATHER ? (size_t)0 : ((size_t)(u).g * AL.gstride * 2 + (size_t)(u).pm * tstep)))
#define PG8_BBASE(u) ((const char*)Bt + (size_t)(u).g * gstrideB * 2 + (size_t)(u).pn * tstep)
#define PG8_LDA(dst, b, h) do { _Pragma("unroll") for (int m = 0; m < 4; ++m) _Pragma("unroll") for (int k = 0; k < 2; ++k) dst[m][k] = *(const LAS bf16x8*)(lds + PG8_SA(b, h) + aoff + m * 2048 + k * 1024); } while (0)
#define PG8_LDB(dst, b, h) do { _Pragma("unroll") for (int n = 0; n < 2; ++n) _Pragma("unroll") for (int k = 0; k < 2; ++k) dst[n][k] = *(const LAS bf16x8*)(lds + PG8_SB(b, h) + boff + n * 2048 + k * 1024); } while (0)
#define PG8_MMA(ai, bj, At, Bt_) do { __builtin_amdgcn_s_setprio(1); _Pragma("unroll") for (int m = 0; m < 4; ++m) _Pragma("unroll") for (int n = 0; n < 2; ++n) _Pragma("unroll") for (int k = 0; k < 2; ++k) \
        acc[ai][bj][m][n] = __builtin_amdgcn_mfma_f32_16x16x32_bf16(Bt_[n][k], At[m][k], acc[ai][bj][m][n], 0, 0, 0); __builtin_amdgcn_s_setprio(0); } while (0)
#define PG8_WAIT_V(n) asm volatile("s_waitcnt vmcnt(" #n ")" ::: "memory")
#define PG8_WAIT_L(n) asm volatile("s_waitcnt lgkmcnt(" #n ")" ::: "memory")
#define PG8_BAR __builtin_amdgcn_s_barrier()
#define PG8_SCHED __builtin_amdgcn_sched_barrier(0)
    Unit cur, nxt; int ui = 0;
    if (!S.next(0, cur)) return;
    PG8_GIDX(cur, vAc);
    f32x4 acc[2][2][4][2];
#pragma unroll
    for (int a = 0; a < 2; ++a)
#pragma unroll
        for (int b = 0; b < 2; ++b)
#pragma unroll
            for (int m = 0; m < 4; ++m)
#pragma unroll
                for (int n = 0; n < 2; ++n) acc[a][b][m][n] = (f32x4){0.f, 0.f, 0.f, 0.f};
    bf16x8 At[4][2], B0[2][2], B1[2][2];
    const char* cA = PG8_ABASE(cur); const char* cB = PG8_BBASE(cur);
    PG8_STAGE(PG8_SB(0, 0), cB, voffB); PG8_STAGE(PG8_SB(0, 1), cB + hstep, voffB); PG8_STAGE_A(PG8_SA(0, 0), cA, 0, false); PG8_STAGE_A(PG8_SA(0, 1), cA, 1, false);
    if (wr == 1) PG8_BAR;
    PG8_WAIT_V(2); PG8_BAR;
    PG8_STAGE(PG8_SB(1, 0), cB + kstep, voffB); PG8_STAGE_A(PG8_SA(1, 0), cA + kstep, 0, false); PG8_STAGE(PG8_SB(1, 1), cB + hstep + kstep, voffB);
    PG8_WAIT_V(6); PG8_BAR;
    for (;;) {
        const bool has_next = S.next(ui + 1, nxt);
        if (GATHER) { if (has_next) { PG8_GIDX(nxt, vAn); } else {
#pragma unroll
            for (int _h = 0; _h < 2; ++_h)
#pragma unroll
                for (int _i = 0; _i < 2; ++_i) vAn[_h][_i] = vAc[_h][_i]; } }
        const char* nA = has_next ? PG8_ABASE(nxt) : cA; const char* nB = has_next ? PG8_BBASE(nxt) : cB;
        for (int t = 0; t < nt; t += 2) {
            const bool last = (t == nt - 2);
            const char* a1 = cA + (size_t)(t + 1) * kstep;
            const char* a2 = last ? nA : cA + (size_t)(t + 2) * kstep; const char* b2 = last ? nB : cB + (size_t)(t + 2) * kstep;
            const char* a3 = a2 + kstep; const char* b3 = b2 + kstep;
            PG8_LDB(B0, 0, 0); PG8_LDB(B1, 0, 1); PG8_SCHED; PG8_LDA(At, 0, 0); PG8_STAGE_A(PG8_SA(1, 1), a1, 1, false);
            PG8_WAIT_V(8); PG8_WAIT_L(0); PG8_BAR; PG8_MMA(0, 0, At, B0); PG8_MMA(0, 1, At, B1); PG8_BAR; PG8_SCHED;
            PG8_LDA(At, 0, 1); PG8_STAGE(PG8_SB(0, 0), b2, voffB); PG8_STAGE(PG8_SB(0, 1), b2 + hstep, voffB); PG8_STAGE_A(PG8_SA(0, 0), a2, 0, last);
            PG8_WAIT_V(8); PG8_WAIT_L(0); PG8_BAR; PG8_MMA(1, 0, At, B0); PG8_MMA(1, 1, At, B1); PG8_BAR; PG8_SCHED;
            PG8_LDB(B0, 1, 0); PG8_LDB(B1, 1, 1); PG8_SCHED; PG8_LDA(At, 1, 0); PG8_STAGE_A(PG8_SA(0, 1), a2, 1, last);
            PG8_WAIT_V(8); PG8_WAIT_L(0); PG8_BAR; PG8_MMA(0, 0, At, B0); PG8_MMA(0, 1, At, B1); PG8_BAR; PG8_SCHED;
            PG8_LDA(At, 1, 1); PG8_STAGE(PG8_SB(1, 0), b3, voffB); PG8_STAGE(PG8_SB(1, 1), b3 + hstep, voffB); PG8_STAGE_A(PG8_SA(1, 0), a3, 0, last);
            PG8_WAIT_V(8); PG8_WAIT_L(0); PG8_BAR; PG8_MMA(1, 0, At, B0); PG8_MMA(1, 1, At, B1); PG8_BAR; PG8_SCHED;
        }
        if (wr == 0) PG8_BAR;
        E(acc, cur, wr, wc, fr, fq);
        if (!has_next) break;
#pragma unroll
        for (int a = 0; a < 2; ++a)
#pragma unroll
            for (int b = 0; b < 2; ++b)
#pragma unroll
                for (int m = 0; m < 4; ++m)
#pragma unroll
                    for (int n = 0; n < 2; ++n) acc[a][b][m][n] = (f32x4){0.f, 0.f, 0.f, 0.f};
        cur = nxt; cA = nA; cB = nB; ++ui;
        if (GATHER) {
#pragma unroll
            for (int _h = 0; _h < 2; ++_h)
#pragma unroll
                for (int _i = 0; _i < 2; ++_i) vAc[_h][_i] = vAn[_h][_i]; }
        if (wr == 1) PG8_BAR;
    }
    PG8_WAIT_V(0);
    PG8_BAR;
#undef PG8_SA
#undef PG8_SB
#undef PG8_STAGE
#undef PG8_STAGE_A
#undef PG8_GIDX
#undef PG8_ABASE
#undef PG8_BBASE
#undef PG8_LDA
#undef PG8_LDB
#undef PG8_MMA
#undef PG8_WAIT_V
#undef PG8_WAIT_L
#undef PG8_BAR
#undef PG8_SCHED
}

__device__ __forceinline__ float fast_sigmoid(float x) { return __builtin_amdgcn_rcpf(1.0f + __builtin_amdgcn_exp2f(-1.4426950408889634f * x)); }
struct EpiSwiglu {
    static constexpr bool PERM = true;
    bf16_t* O; int ldc; size_t gstride;
    __device__ __forceinline__ void operator()(const f32x4 (&acc)[2][2][4][2], const Unit& u, int wr, int wc, int fr, int fq) const {
        const int row0 = u.pm * BM + wr * 64 + fr, col0 = u.pn * HALF + wc * 32 + 8 * fq;
        bf16_t* base = O + (size_t)u.g * gstride;
#pragma unroll
        for (int ai = 0; ai < 2; ++ai)
#pragma unroll
            for (int m = 0; m < 4; ++m) { bf16_t* rowp = base + (size_t)(row0 + ai * HALF + m * 16) * ldc + col0;
                float o[8];
#pragma unroll
                for (int n = 0; n < 2; ++n)
#pragma unroll
                    for (int q = 0; q < 4; ++q) { const float a = acc[ai][0][m][n][q], b = acc[ai][1][m][n][q]; o[4 * n + q] = a * fast_sigmoid(a) * b; }
                u32x4 w; w.x = cvt_pk_bf16(o[0], o[1]); w.y = cvt_pk_bf16(o[2], o[3]); w.z = cvt_pk_bf16(o[4], o[5]); w.w = cvt_pk_bf16(o[6], o[7]);
                *(u32x4*)rowp = w; }
    }
};
struct EpiGate {
    static constexpr bool PERM = true;
    bf16_t* O; int ldc; size_t gstride; const float* gate; int rpg;
    __device__ __forceinline__ void operator()(const f32x4 (&acc)[2][2][4][2], const Unit& u, int wr, int wc, int fr, int fq) const {
        const int row0 = u.pm * BM + wr * 64 + fr, col0 = u.pn * BM + wc * 32 + 8 * fq;
        bf16_t* base = O + (size_t)u.g * gstride;
#pragma unroll
        for (int ai = 0; ai < 2; ++ai)
#pragma unroll
            for (int m = 0; m < 4; ++m) { const int row = row0 + ai * HALF + m * 16; const float gt = gate[u.g * rpg + row]; bf16_t* rowp = base + (size_t)row * ldc + col0;
#pragma unroll
                for (int bj = 0; bj < 2; ++bj) { const f32x4 v0 = acc[ai][bj][m][0] * gt, v1 = acc[ai][bj][m][1] * gt;
                    u32x4 w; w.x = cvt_pk_bf16(v0[0], v0[1]); w.y = cvt_pk_bf16(v0[2], v0[3]); w.z = cvt_pk_bf16(v1[0], v1[1]); w.w = cvt_pk_bf16(v1[2], v1[3]);
                    *(u32x4*)(rowp + bj * HALF) = w; } }
    }
};
struct EpiF32 {
    static constexpr bool PERM = false;
    float* C; int ldc;
    __device__ __forceinline__ void operator()(const f32x4 (&acc)[2][2][4][2], const Unit& u, int wr, int wc, int fr, int fq) const {
        const int row0 = u.pm * BM + wr * 64 + fr, col0 = u.pn * BM + wc * 32 + 4 * fq;
#pragma unroll
        for (int ai = 0; ai < 2; ++ai)
#pragma unroll
            for (int m = 0; m < 4; ++m) { float* rowp = C + (size_t)(row0 + ai * HALF + m * 16) * ldc + col0;
#pragma unroll
                for (int bj = 0; bj < 2; ++bj)
#pragma unroll
                    for (int n = 0; n < 2; ++n) *(f32x4*)(rowp + bj * HALF + n * 16) = acc[ai][bj][m][n]; }
    }
};
struct EpiResid {
    static constexpr bool PERM = false;
    float* X; const float* modL;
    __device__ __forceinline__ void operator()(const f32x4 (&acc)[2][2][4][2], const Unit& u, int wr, int wc, int fr, int fq) const {
        const int row0 = u.pm * BM + wr * 64 + fr, col0 = u.pn * BM + wc * 32 + 4 * fq;
        const int b = u.pm / 17, j = (u.pm - b * 17 == 0) ? 8 : b;
        const float* g1 = modL + (size_t)(j * 6 + 2) * 1024 + col0;
        f32x4 gv[2][2];
#pragma unroll
        for (int bj = 0; bj < 2; ++bj)
#pragma unroll
            for (int n = 0; n < 2; ++n) gv[bj][n] = *(const f32x4*)(g1 + bj * HALF + n * 16);
#pragma unroll
        for (int ai = 0; ai < 2; ++ai)
#pragma unroll
            for (int m = 0; m < 4; ++m) { float* rowp = X + (size_t)(row0 + ai * HALF + m * 16) * D + col0;
#pragma unroll
                for (int bj = 0; bj < 2; ++bj)
#pragma unroll
                    for (int n = 0; n < 2; ++n) { f32x4* p = (f32x4*)(rowp + bj * HALF + n * 16); *p = *p + gv[bj][n] * acc[ai][bj][m][n]; } }
    }
};
struct EpiGluResid {
    static constexpr bool PERM = false;
    float* X; const float* modL; const float* bias;
    __device__ __forceinline__ void operator()(const f32x4 (&acc)[2][2][4][2], const Unit& u, int wr, int wc, int fr, int fq) const {
        const int row0 = u.pm * BM + wr * 64 + fr, col0 = u.pn * HALF + wc * 32 + 4 * fq;
        const int b = u.pm / 17, j = (u.pm - b * 17 == 0) ? 8 : b;
        const float* g1 = modL + (size_t)(j * 6 + 2) * 1024 + col0;
        f32x4 gv[2], ba[2], bg[2];
#pragma unroll
        for (int n = 0; n < 2; ++n) { gv[n] = *(const f32x4*)(g1 + n * 16); ba[n] = *(const f32x4*)(bias + col0 + n * 16); bg[n] = *(const f32x4*)(bias + 1024 + col0 + n * 16); }
#pragma unroll
        for (int ai = 0; ai < 2; ++ai)
#pragma unroll
            for (int m = 0; m < 4; ++m) { float* rowp = X + (size_t)(row0 + ai * HALF + m * 16) * D + col0;
#pragma unroll
                for (int n = 0; n < 2; ++n) { const f32x4 a = acc[ai][0][m][n] + ba[n], g = acc[ai][1][m][n] + bg[n];
                    f32x4 o; o.x = a.x * fast_sigmoid(g.x); o.y = a.y * fast_sigmoid(g.y); o.z = a.z * fast_sigmoid(g.z); o.w = a.w * fast_sigmoid(g.w);
                    f32x4* p = (f32x4*)(rowp + n * 16); *p = *p + gv[n] * o; } }
    }
};
}

namespace attn_body {
using bf16=__hip_bfloat16;
using bf16x8=__attribute__((ext_vector_type(8)))short;
using s16x4=__attribute__((ext_vector_type(4)))short;
using f32x16=__attribute__((ext_vector_type(16)))float;
using u32x4=__attribute__((ext_vector_type(4)))unsigned;
constexpr int D=64,QP=512,KP=128,OP=1024;
constexpr int NW=8,QBLK=32,QB=QBLK*NW,KVBLK=64;
__device__ __forceinline__ int crow(int r,int hi){return (r&3)+8*(r>>2)+4*hi;}
#define SBAR() __builtin_amdgcn_sched_barrier(0)
__device__ __forceinline__ void cmask(f32x16&p0,f32x16&p1,int jb,int qrel,int hi){
  const float NEG=-INFINITY; int kb=64*jb+4*hi;
  #pragma unroll
  for(int r=0;r<16;++r){int kv=kb+(r&3)+8*(r>>2); if(kv>qrel)p0[r]=NEG; if(kv+32>qrel)p1[r]=NEG;}
}

constexpr int NSLOT=3, SLOTB=8192;
constexpr int LDS_K=0, LDS_V=NSLOT*SLOTB, LDS_WS=2*NSLOT*SLOTB, LDS_OST=LDS_WS+NW*64*4, LDS_BYTES=LDS_OST+NW*4096;
constexpr float C2=0.125f*1.4426950408889634f;
__device__ __forceinline__ void glds16(const void*gsrc,unsigned lds_dst){unsigned keep;
  asm volatile("s_mov_b32 %0, m0\n\ts_mov_b32 m0, %2\n\ts_nop 0\n\tglobal_load_lds_dwordx4 %1, off\n\ts_mov_b32 m0, %0":"=&s"(keep):"v"(gsrc),"s"(lds_dst):"memory");}
__device__ __forceinline__ float max3f(float a,float b,float c){float r;asm("v_max3_f32 %0, %1, %2, %3":"=v"(r):"v"(a),"v"(b),"v"(c));return r;}
__device__ __forceinline__ float max2f(float a,float b){float r;asm("v_max_f32_e32 %0, %1, %2":"=v"(r):"v"(a),"v"(b));return r;}
__device__ __forceinline__ float fadd_s(float a,float b){float r;asm("v_add_f32_e32 %0, %1, %2":"=v"(r):"v"(a),"v"(b));return r;}
__device__ __forceinline__ float fsub_s(float a,float b){float r;asm("v_sub_f32_e32 %0, %1, %2":"=v"(r):"v"(a),"v"(b));return r;}
typedef float f32x2_t __attribute__((ext_vector_type(2))); typedef __bf16 bf16x2_t __attribute__((ext_vector_type(2)));
__device__ __forceinline__ unsigned cvtpk_s(float lo,float hi){f32x2_t v={lo,hi};bf16x2_t b=__builtin_convertvector(v,bf16x2_t);return __builtin_bit_cast(unsigned,b);}
#define WAIT_BAR(N) asm volatile("s_waitcnt vmcnt(" #N ") lgkmcnt(0)\n\ts_barrier":::"memory")

__device__ __forceinline__ void qkt(f32x16&p0,f32x16&p1,const char*Kslot,const bf16x8*qr,const f32x16&negm,int r32,int hi){
  const char*kb=Kslot+hi*1024+r32*16;
  #pragma unroll
  for(int d0=0;d0<4;++d0){
    const bf16x8 b0=*reinterpret_cast<const bf16x8*>(kb+d0*2048);
    const bf16x8 b1=*reinterpret_cast<const bf16x8*>(kb+d0*2048+512);
    if(d0==0){p0=__builtin_amdgcn_mfma_f32_32x32x16_bf16(b0,qr[0],negm,0,0,0);p1=__builtin_amdgcn_mfma_f32_32x32x16_bf16(b1,qr[0],negm,0,0,0);}
    else{p0=__builtin_amdgcn_mfma_f32_32x32x16_bf16(b0,qr[d0],p0,0,0,0);p1=__builtin_amdgcn_mfma_f32_32x32x16_bf16(b1,qr[d0],p1,0,0,0);}}
}
typedef __attribute__((address_space(3))) const char* lds_cptr;
typedef short v4i16_t __attribute__((ext_vector_type(4)));
__device__ __forceinline__ void kload8(bf16x8*kf,lds_cptr kp){
  kf[0]=*(const __attribute__((address_space(3))) bf16x8*)(kp);      kf[1]=*(const __attribute__((address_space(3))) bf16x8*)(kp+512);
  kf[2]=*(const __attribute__((address_space(3))) bf16x8*)(kp+2048); kf[3]=*(const __attribute__((address_space(3))) bf16x8*)(kp+2560);
  kf[4]=*(const __attribute__((address_space(3))) bf16x8*)(kp+4096); kf[5]=*(const __attribute__((address_space(3))) bf16x8*)(kp+4608);
  kf[6]=*(const __attribute__((address_space(3))) bf16x8*)(kp+6144); kf[7]=*(const __attribute__((address_space(3))) bf16x8*)(kp+6656);
}
__device__ __forceinline__ void kload2(bf16x8*kf,lds_cptr kp,int j){ kf[2*j]=*(const __attribute__((address_space(3))) bf16x8*)(kp+j*2048); kf[2*j+1]=*(const __attribute__((address_space(3))) bf16x8*)(kp+j*2048+512); }
__device__ __forceinline__ s16x4 vtr(lds_cptr p){ return __builtin_bit_cast(s16x4,__builtin_amdgcn_ds_read_tr16_b64_v4i16((__attribute__((address_space(3))) v4i16_t*)p)); }
__device__ __forceinline__ float rowmax(const f32x16&p0,const f32x16&p1){
  float a=max3f(p0[0],p0[1],p1[0]),b=max3f(p0[2],p0[3],p1[1]);a=max3f(a,p1[2],p1[3]);
  #pragma unroll
  for(int r=4;r<16;r+=4){a=max3f(a,p0[r],p0[r+1]);b=max3f(b,p0[r+2],p0[r+3]);a=max3f(a,p1[r],p1[r+1]);b=max3f(b,p1[r+2],p1[r+3]);}
  const float m=max2f(a,b);
  auto rr=__builtin_amdgcn_permlane32_swap(__float_as_uint(m),__float_as_uint(m),false,false);
  return max2f(__uint_as_float(rr[0]),__uint_as_float(rr[1]));
}
__device__ __forceinline__ void pv(f32x16*o,int vb,bf16x8 pa0,bf16x8 pa1,bf16x8 pa2,bf16x8 pa3){
  #pragma unroll
  for(int d0=0;d0<2;++d0){s16x4 lo[4],hi[4];
    #pragma unroll
    for(int ks=0;ks<4;++ks){
      asm volatile("ds_read_b64_tr_b16 %0,%1 offset:%c2":"=&v"(lo[ks]):"v"(vb),"i"(d0*4096+ks*1024):"memory");
      asm volatile("ds_read_b64_tr_b16 %0,%1 offset:%c2":"=&v"(hi[ks]):"v"(vb),"i"(d0*4096+ks*1024+512):"memory");}
    asm volatile("s_waitcnt lgkmcnt(0)":::"memory");SBAR();
    #define PK(k) (bf16x8){lo[k][0],lo[k][1],lo[k][2],lo[k][3],hi[k][0],hi[k][1],hi[k][2],hi[k][3]}
    o[d0]=__builtin_amdgcn_mfma_f32_32x32x16_bf16(pa0,PK(0),o[d0],0,0,0);
    o[d0]=__builtin_amdgcn_mfma_f32_32x32x16_bf16(pa1,PK(1),o[d0],0,0,0);
    o[d0]=__builtin_amdgcn_mfma_f32_32x32x16_bf16(pa2,PK(2),o[d0],0,0,0);
    o[d0]=__builtin_amdgcn_mfma_f32_32x32x16_bf16(pa3,PK(3),o[d0],0,0,0);
    #undef PK
  }
}

#ifndef ATTN_STORE16
#define ATTN_STORE16(p,v) (*(u32x4*)(p)=(v))
#endif
template<int THRL> __device__ __forceinline__ void attn_unit(const bf16*Qw0,const bf16*Kh,const bf16*Vh,bf16*Ow0,const int NT,char*shm){
  const int tid=threadIdx.x,lane=tid&63,r32=lane&31,hi=lane>>5; const int wid=__builtin_amdgcn_readfirstlane(tid>>6);
  const bf16*Qw=Qw0+(long)(wid*QBLK)*QP;
  const unsigned lds0=(unsigned)(uintptr_t)shm;
  float*wsf=(float*)(shm+LDS_WS)+wid*64;
  const bf16*ksrc=Kh+(long)lane*KP+wid*8;
  const bf16*vsrc=Vh+(long)(16*(wid&3)+(lane>>2))*KP+(wid>>2)*32+(lane&3)*8;
  const unsigned kdst=lds0+LDS_K+wid*1024, vdst=lds0+LDS_V+wid*1024;
  #define DMA_K(t,slot) glds16(ksrc+(long)(t)*KVBLK*KP,(unsigned)__builtin_amdgcn_readfirstlane(kdst+(slot)))
  #define DMA_V(t,slot) glds16(vsrc+(long)(t)*KVBLK*KP,(unsigned)__builtin_amdgcn_readfirstlane(vdst+(slot)))
  const int vb0=(int)(lds0+LDS_V)+((lane>>4)&1)*32+(lane&3)*8+(4*hi+((lane&15)>>2))*64;
  const char*Kbase=shm+LDS_K; bf16x8 kf[8];
  const lds_cptr shm3=(lds_cptr)shm; const lds_cptr kp0=shm3+LDS_K+hi*1024+r32*16; const lds_cptr vp0=shm3+LDS_V+((lane>>4)&1)*32+(lane&3)*8+(4*hi+((lane&15)>>2))*64;
  DMA_K(0,0);DMA_V(0,0);DMA_K(1,SLOTB);
  bf16x8 qr[4];
  #pragma unroll
  for(int d0=0;d0<4;++d0)qr[d0]=*reinterpret_cast<const bf16x8*>(&Qw[(long)r32*QP+d0*16+hi*8]);
  float mhat=0.f,l_reg=0.f;f32x16 o[2];o[0]=f32x16{};o[1]=f32x16{};f32x16 negm=f32x16{};asm volatile("":"+v"(negm));
  #define CMASK(P0,P1,t) do{}while(0)
  bool resc=false;
  #define START(P0,P1) do{ const float rm=rowmax(P0,P1); resc=false; \
    { const float dl=rm; mhat=fadd_s(mhat,dl); \
      _Pragma("unroll") for(int r=0;r<16;++r){P0[r]=fsub_s(P0[r],dl);P1[r]=fsub_s(P1[r],dl);} \
      _Pragma("unroll") for(int r=0;r<16;++r)negm[r]=-mhat; asm volatile("":"+v"(negm)); } \
    _Pragma("unroll") for(int r=0;r<16;++r)P0[r]=__builtin_amdgcn_exp2f(P0[r]); }while(0)
  #define RESC() do{ if(resc){ asm volatile("s_waitcnt lgkmcnt(0)":::"memory"); \
      _Pragma("unroll") for(int d_=0;d_<2;++d_) _Pragma("unroll") for(int r=0;r<16;++r)o[d_][r]*=wsf[crow(r,hi)]; } }while(0)
  f32x16 pA0,pA1,pB0,pB1;
  int sl_prev=0,sl_cur=0,sl_next=SLOTB;
  #define ROT() do{sl_prev=sl_cur;sl_cur=sl_next;sl_next=(sl_next==(NSLOT-1)*SLOTB)?0:sl_next+SLOTB;}while(0)
  DMA_K(2,2*SLOTB);
  WAIT_BAR(3);
  qkt(pA0,pA1,Kbase,qr,negm,r32,hi);asm volatile("s_nop 15\n\ts_nop 7":"+v"(pA0),"+v"(pA1));CMASK(pA0,pA1,0);
  START(pA0,pA1);
  _Pragma("unroll") for(int r=0;r<16;++r)pA1[r]=__builtin_amdgcn_exp2f(pA1[r]);
  WAIT_BAR(0);
  DMA_K(3,0);DMA_V(1,SLOTB);
  ROT();
  kload8(kf,kp0+sl_cur);
  WAIT_BAR(2);
  s16x4 vlo[8],vhi[8]; u32x4 pw0,pw1,pw2,pw3;
  #define PKW(P,B) cvtpk_s(P[B],P[B+1])
  #define PAF(k) __builtin_bit_cast(bf16x8,pw##k)
  #define VFR(i) (bf16x8){vlo[i][0],vlo[i][1],vlo[i][2],vlo[i][3],vhi[i][0],vhi[i][1],vhi[i][2],vhi[i][3]}
  #define PIN(x) asm volatile("":"+v"(x))
  #define MX3(a,b,c) __builtin_fmaxf(__builtin_fmaxf((a),(b)),(c))
  #define GAPA(MF,A0,A1,A2,A3,W0,W1,PW) do{ MF; sacc+=A0; sacc+=A1; sacc+=A2; sacc+=A3; PIN(sacc); W0; W1; PIN(PW); SBAR(); }while(0)
  #define EX(v) __builtin_amdgcn_exp2f(v)
  #define GAPB(MF,X,B) do{ MF; X[B]=EX(X[B]); X[B+1]=EX(X[B+1]); X[B+2]=EX(X[B+2]); X[B+3]=EX(X[B+3]); PIN(X); SBAR(); }while(0)
  #define VRD(i) do{ vlo[i]=vtr(vp_+(((i)>>2)*4096+((i)&3)*1024)); vhi[i]=vtr(vp_+(((i)>>2)*4096+((i)&3)*1024+512)); }while(0)
  #define KRD(G,j) do{ if(G){ kload2(kf,kp0+sl_next,j); SBAR(); } }while(0)
  #define STEP(C0,C1,P0,P1,t,GK,GV,GL) do{ SBAR(); \
    const lds_cptr vp_=vp0+sl_prev; \
    VRD(0); SBAR(); float sacc=(P0[0]+P0[1]); \
    GAPA(C0=__builtin_amdgcn_mfma_f32_32x32x16_bf16(kf[0],qr[0],negm,0,0,0), P0[2],P0[3],P0[4],P0[5],     pw0[0]=PKW(P0,0), pw0[1]=PKW(P0,2), pw0); \
    VRD(4); SBAR(); GAPA(C1=__builtin_amdgcn_mfma_f32_32x32x16_bf16(kf[1],qr[0],negm,0,0,0), P0[6],P0[7],P0[8],P0[9],     pw0[2]=PKW(P0,4), pw0[3]=PKW(P0,6), pw0); \
    VRD(1); SBAR(); GAPA(C0=__builtin_amdgcn_mfma_f32_32x32x16_bf16(kf[2],qr[1],C0,0,0,0),   P0[10],P0[11],P0[12],P0[13], pw1[0]=PKW(P0,8), pw1[1]=PKW(P0,10), pw1); \
    VRD(5); SBAR(); GAPA(C1=__builtin_amdgcn_mfma_f32_32x32x16_bf16(kf[3],qr[1],C1,0,0,0),   P0[14],P0[15],P1[0],P1[1],   pw1[2]=PKW(P0,12),pw1[3]=PKW(P0,14), pw1); \
    VRD(2); SBAR(); GAPA(C0=__builtin_amdgcn_mfma_f32_32x32x16_bf16(kf[4],qr[2],C0,0,0,0),   P1[2],P1[3],P1[4],P1[5],     pw2[0]=PKW(P1,0), pw2[1]=PKW(P1,2), pw2); \
    VRD(6); SBAR(); GAPA(C1=__builtin_amdgcn_mfma_f32_32x32x16_bf16(kf[5],qr[2],C1,0,0,0),   P1[6],P1[7],P1[8],P1[9],     pw2[2]=PKW(P1,4), pw2[3]=PKW(P1,6), pw2); \
    VRD(3); SBAR(); GAPA(C0=__builtin_amdgcn_mfma_f32_32x32x16_bf16(kf[6],qr[3],C0,0,0,0),   P1[10],P1[11],P1[12],P1[13], pw3[0]=PKW(P1,8), pw3[1]=PKW(P1,10), pw3); \
    VRD(7); SBAR(); GAPA(C1=__builtin_amdgcn_mfma_f32_32x32x16_bf16(kf[7],qr[3],C1,0,0,0),   P1[14],P1[15],0.f,0.f,       pw3[2]=PKW(P1,12),pw3[3]=PKW(P1,14), pw3); \
    l_reg+=sacc; \
    if(GK){DMA_K((t)+3,sl_cur);} if(GV){DMA_V((t)+1,sl_next);} \
    CMASK(C0,C1,t); \
    { float a=MX3(C0[0],C0[1],C1[0]),b=MX3(C0[2],C0[3],C1[1]); a=MX3(a,C1[2],C1[3]); \
      _Pragma("unroll") for(int r=4;r<16;r+=4){a=MX3(a,C0[r],C0[r+1]);b=MX3(b,C0[r+2],C0[r+3]);a=MX3(a,C1[r],C1[r+1]);b=MX3(b,C1[r+2],C1[r+3]);} \
      float rm=__builtin_fmaxf(a,b); { auto rr=__builtin_amdgcn_permlane32_swap(__float_as_uint(rm),__float_as_uint(rm),false,false); rm=__builtin_fmaxf(__uint_as_float(rr[0]),__uint_as_float(rr[1])); } \
      resc=false; \
      if(__builtin_expect(__any(rm>(float)THRL),0)){ const float dl=__builtin_fmaxf(rm,0.f); mhat+=dl; \
        _Pragma("unroll") for(int r=0;r<16;++r){C0[r]-=dl;C1[r]-=dl;} \
        _Pragma("unroll") for(int r=0;r<16;++r)negm[r]=-mhat; asm volatile("":"+v"(negm)); \
        const float f=__builtin_amdgcn_exp2f(-dl); l_reg*=f; if(hi==0)wsf[r32]=f; resc=true; } } \
    SBAR(); \
    GAPB(o[0]=__builtin_amdgcn_mfma_f32_32x32x16_bf16(PAF(0),VFR(0),o[0],0,0,0), C0,0); \
    GAPB(o[1]=__builtin_amdgcn_mfma_f32_32x32x16_bf16(PAF(0),VFR(4),o[1],0,0,0), C0,4); \
    KRD(GL,0); GAPB(o[0]=__builtin_amdgcn_mfma_f32_32x32x16_bf16(PAF(1),VFR(1),o[0],0,0,0), C0,8); \
    KRD(GL,1); GAPB(o[1]=__builtin_amdgcn_mfma_f32_32x32x16_bf16(PAF(1),VFR(5),o[1],0,0,0), C0,12); \
    KRD(GL,2); GAPB(o[0]=__builtin_amdgcn_mfma_f32_32x32x16_bf16(PAF(2),VFR(2),o[0],0,0,0), C1,0); \
    KRD(GL,3); GAPB(o[1]=__builtin_amdgcn_mfma_f32_32x32x16_bf16(PAF(2),VFR(6),o[1],0,0,0), C1,4); \
    GAPB(o[0]=__builtin_amdgcn_mfma_f32_32x32x16_bf16(PAF(3),VFR(3),o[0],0,0,0), C1,8); \
    GAPB(o[1]=__builtin_amdgcn_mfma_f32_32x32x16_bf16(PAF(3),VFR(7),o[1],0,0,0), C1,12); \
    }while(0)
  int t=1;
  #undef CMASK
  #define CMASK(P0,P1,t) do{}while(0)
  for(;t+5<NT;t+=2){
    STEP(pB0,pB1,pA0,pA1,t,true,true,true);     WAIT_BAR(2); RESC(); ROT();
    STEP(pA0,pA1,pB0,pB1,t+1,true,true,true);   WAIT_BAR(2); RESC(); ROT();
  }
  #undef CMASK
  #define CMASK(P0,P1,t) do{}while(0)
  #define ENDW(tt) do{ if((tt)+3<NT){WAIT_BAR(2);} else if((tt)+2<NT){WAIT_BAR(1);} else {WAIT_BAR(0);} }while(0)
  for(;t+1<NT;t+=2){
    STEP(pB0,pB1,pA0,pA1,t,(t+3<NT),(t+1<NT),(t+1<NT));       ENDW(t);   RESC(); ROT();
    STEP(pA0,pA1,pB0,pB1,t+1,(t+4<NT),(t+2<NT),(t+2<NT));     ENDW(t+1); RESC(); ROT();
  }
  STEP(pB0,pB1,pA0,pA1,NT-1,false,false,false); RESC();
  { float sacc=pB0[0]+pB0[1]; _Pragma("unroll") for(int r=2;r<16;++r)sacc+=pB0[r]; _Pragma("unroll") for(int r=0;r<16;++r)sacc+=pB1[r]; l_reg+=sacc;
    pw0=(u32x4){PKW(pB0,0),PKW(pB0,2),PKW(pB0,4),PKW(pB0,6)};pw1=(u32x4){PKW(pB0,8),PKW(pB0,10),PKW(pB0,12),PKW(pB0,14)};pw2=(u32x4){PKW(pB1,0),PKW(pB1,2),PKW(pB1,4),PKW(pB1,6)};pw3=(u32x4){PKW(pB1,8),PKW(pB1,10),PKW(pB1,12),PKW(pB1,14)};
    SBAR(); pv(o,vb0+sl_cur,PAF(0),PAF(1),PAF(2),PAF(3)); }
  #undef PKW
  #undef PAF
  #undef VFR
  #undef PIN
  #undef MX3
  #undef GAPA
  #undef GAPB
  #undef EX
  #undef VRD
  #undef KRD
  #undef STEP
  #undef ENDW
  {auto rr=__builtin_amdgcn_permlane32_swap(__float_as_uint(l_reg),__float_as_uint(l_reg),false,false);l_reg=__uint_as_float(rr[0])+__uint_as_float(rr[1]);}
  if(hi==0)wsf[32+r32]=l_reg;asm volatile("s_waitcnt lgkmcnt(0)":::"memory");
  float rli[16];
  #pragma unroll
  for(int r=0;r<16;++r)rli[r]=__builtin_amdgcn_rcpf(wsf[32+crow(r,hi)]);
  bf16*Ow=Ow0+(long)(wid*QBLK)*OP;
  { bf16*stg=(bf16*)(shm+LDS_OST)+wid*2048;
    #pragma unroll
    for(int r=0;r<16;++r){const int orow=crow(r,hi);
      #pragma unroll
      for(int d0=0;d0<2;++d0)stg[orow*64+d0*32+r32]=__float2bfloat16(o[d0][r]*rli[r]);}
    asm volatile("s_waitcnt lgkmcnt(0)":::"memory");
    #pragma unroll
    for(int i=0;i<4;++i){const int row=i*8+(lane>>3),ch=lane&7; const u32x4 v=*(const u32x4*)(stg+row*64+ch*8); ATTN_STORE16(Ow+(long)row*OP+ch*8,v);} }
  asm volatile("s_waitcnt lgkmcnt(0)\n\ts_barrier":::"memory");
  #undef DMA_K
  #undef DMA_V
  #undef CMASK
  #undef START
  #undef RESC
  #undef ROT
}
constexpr int ATTN_LDS_BYTES=LDS_BYTES;
#undef SBAR
#undef WAIT_BAR
}

template <bool PAIRED, class AL, class BL, class EP>
__device__ __forceinline__ void gemm_f32(int groups, int M, int N, int K, const AL& al, const BL& bl, const EP& ep) {
    const int tid = threadIdx.x, lane = tid & 63, wave = tid >> 6, wm = wave >> 2, wn = wave & 3, r32 = lane & 31, h = lane >> 5;
    constexpr int TN = PAIRED ? 128 : 256;
    const int tilesM = M / 128, tilesN = N / TN, per = tilesM * tilesN, total = groups * per;
    const int ldb = bl.ldb;
    for (int t = blockIdx.x; t < total; t += gridDim.x) {
        const int g = t / per, r = t - g * per, tm = r / tilesN, tn = r - tm * tilesN;
        const int m0 = tm * 128 + wm * 64;
        const int n0 = PAIRED ? (tn * 128 + wn * 32) : (tn * 256 + wn * 64);
        const float* a0 = al.row(g, m0 + r32) + 4 * h;
        const float* a1 = al.row(g, m0 + 32 + r32) + 4 * h;
        const float* b0 = bl.ptr(g, 0) + n0 + r32 + (size_t)(4 * h) * ldb;
        const float* b1 = (PAIRED ? bl.ptr(g, 1) + n0 : bl.ptr(g, 0) + n0 + 32) + r32 + (size_t)(4 * h) * ldb;
        f32x16 acc00 = {}, acc01 = {}, acc10 = {}, acc11 = {};
#pragma unroll 2
        for (int k = 0; k < K; k += 8) {
            const f32x4 av0 = *(const f32x4*)(a0 + k), av1 = *(const f32x4*)(a1 + k);
            float bv0[4], bv1[4];
#pragma unroll
            for (int s = 0; s < 4; ++s) { bv0[s] = b0[(size_t)(k + s) * ldb]; bv1[s] = b1[(size_t)(k + s) * ldb]; }
#pragma unroll
            for (int s = 0; s < 4; ++s) {
                acc00 = __builtin_amdgcn_mfma_f32_32x32x2f32(av0[s], bv0[s], acc00, 0, 0, 0);
                acc01 = __builtin_amdgcn_mfma_f32_32x32x2f32(av0[s], bv1[s], acc01, 0, 0, 0);
                acc10 = __builtin_amdgcn_mfma_f32_32x32x2f32(av1[s], bv0[s], acc10, 0, 0, 0);
                acc11 = __builtin_amdgcn_mfma_f32_32x32x2f32(av1[s], bv1[s], acc11, 0, 0, 0);
            }
        }
#pragma unroll
        for (int rr = 0; rr < 16; ++rr) {
            const int ro = (rr & 3) + 8 * (rr >> 2) + 4 * h;
            if (PAIRED) {
                ep(g, m0 + ro, n0 + r32, acc00[rr], acc01[rr]);
                ep(g, m0 + 32 + ro, n0 + r32, acc10[rr], acc11[rr]);
            } else {
                ep(g, m0 + ro, n0 + r32, acc00[rr], 0.f); ep(g, m0 + ro, n0 + 32 + r32, acc01[rr], 0.f);
                ep(g, m0 + 32 + ro, n0 + r32, acc10[rr], 0.f); ep(g, m0 + 32 + ro, n0 + 32 + r32, acc11[rr], 0.f);
            }
        }
    }
}

__device__ __forceinline__ void phase_pro(const Ctx& c, LAS float* ldsf) {
    float* rope = (float*)(c.ws + WS_ROPE);
    for (int i = c.gt; i < 64 * 16; i += c.ngt) {
        const int pos = i >> 4, fi = i & 15; const float inv = powf(10000.0f, -(float)fi / 16.0f), ang = (float)pos * inv;
        rope[2 * i] = cosf(ang); rope[2 * i + 1] = sinf(ang);
    }
    LAS float* sil = ldsf; LAS float* red = ldsf + 9 * 1024;
    for (int i = c.tid; i < 9 * 1024; i += 512) { const int j = i >> 10, k = i & 1023; const float v = (j < 8) ? c.in[IN_C][j * 1024 + k] : c.in[IN_CCTX][k]; sil[i] = siluf_(v); }
    __syncthreads();
    float* MOD = (float*)(c.ws + WS_MOD);
    for (int task = blockIdx.x; task < DEPTH * 96; task += gridDim.x) {
        const int L = task / 96, cb = task - L * 96, col = cb * 64 + c.lane;
        const float* W = c.in[IN_MODW] + (size_t)L * 1024 * 6144;
        float acc[9];
#pragma unroll
        for (int j = 0; j < 9; ++j) acc[j] = 0.f;
        const int k0 = c.wave * 128;
#pragma unroll 4
        for (int k = k0; k < k0 + 128; ++k) { const float w = W[(size_t)k * 6144 + col];
#pragma unroll
            for (int j = 0; j < 9; ++j) acc[j] += sil[j * 1024 + k] * w; }
#pragma unroll
        for (int j = 0; j < 9; ++j) red[(c.wave * 9 + j) * 64 + c.lane] = acc[j];
        __syncthreads();
        if (c.wave == 0) {
            const float bias = c.in[IN_MODB][L * 6144 + col];
#pragma unroll
            for (int j = 0; j < 9; ++j) { float s = bias;
#pragma unroll
                for (int w = 0; w < 8; ++w) s += red[(w * 9 + j) * 64 + c.lane];
                MOD[(size_t)(L * 9 + j) * 6144 + col] = s; }
        }
        __syncthreads();
    }
    float* X = (float*)(c.ws + WS_X);
    for (int r = c.gw; r < NROWS; r += c.ngw) {
        const int b = r / RB, s = r - b * RB;
        const float* src = (s < CL) ? c.in[IN_CTX] + (size_t)(b * CL + s) * D : c.in[IN_X] + (size_t)(b * T + s - CL) * D;
        const f32x4* sp = (const f32x4*)src + c.lane; f32x4* dp = (f32x4*)(X + (size_t)r * D) + c.lane;
#pragma unroll
        for (int j = 0; j < 4; ++j) dp[64 * j] = sp[64 * j];
    }
}

template <bool FINAL>
__device__ __forceinline__ void phase_norm1(const Ctx& c, int L) {
    float* X = (float*)(c.ws + WS_X); float* H = (float*)(c.ws + WS_H);
    const int* SLOT = (const int*)(c.ws + WS_SLOT); const unsigned short* Y = (const unsigned short*)(c.ws + WS_Y);
    for (int r = c.gw; r < NROWS; r += c.ngw) {
        const int b = r / RB, s = r - b * RB, j = s < CL ? 8 : b;
        if (FINAL && s < CL) continue;
        f32x4* xp = (f32x4*)(X + (size_t)r * D) + c.lane;
        f32x4 v[4];
#pragma unroll
        for (int q = 0; q < 4; ++q) v[q] = xp[64 * q];
        if (L > 0) {
            f32x4 sum[4] = {};
            for (int e = 0; e < NE; ++e) {
                const int sp = SLOT[(size_t)r * NE + e];
                if (sp >= 0) { const pg8::u32x2* yp = (const pg8::u32x2*)(Y + ((size_t)e * EROWS + sp) * D) + c.lane;
#pragma unroll
                    for (int q = 0; q < 4; ++q) { const pg8::u32x2 w = yp[64 * q];
                        sum[q] += (f32x4){__uint_as_float(w.x << 16), __uint_as_float(w.x & 0xffff0000u), __uint_as_float(w.y << 16), __uint_as_float(w.y & 0xffff0000u)}; } }
            }
            const f32x4* g2 = (const f32x4*)modp(c, L - 1, j, 5) + c.lane;
#pragma unroll
            for (int q = 0; q < 4; ++q) { v[q] += g2[64 * q] * sum[q]; if (!FINAL) xp[64 * q] = v[q]; }
        }
        float ss = 0.f;
#pragma unroll
        for (int q = 0; q < 4; ++q) ss += v[q].x * v[q].x + v[q].y * v[q].y + v[q].z * v[q].z + v[q].w * v[q].w;
        const float rstd = rsqrtf(wave_sum(ss) * (1.0f / D) + EPS);
        if (FINAL) {
            const f32x4* g = (const f32x4*)c.in[IN_FNG] + c.lane; f32x4* op = (f32x4*)(c.out + (size_t)(b * T + s - CL) * D) + c.lane;
#pragma unroll
            for (int q = 0; q < 4; ++q) op[64 * q] = v[q] * rstd * g[64 * q];
        } else {
            const f32x4* g = (const f32x4*)(c.in[IN_NORMG] + (size_t)(L * 2 + 0) * D) + c.lane;
            const f32x4* sc = (const f32x4*)modp(c, L, j, 1) + c.lane; const f32x4* sh = (const f32x4*)modp(c, L, j, 0) + c.lane;
            f32x4* hp = (f32x4*)(H + (size_t)r * D) + c.lane; pg8::u32x2* hb = (pg8::u32x2*)((unsigned short*)(c.ws + WS_HB1) + (size_t)r * D) + c.lane;
#pragma unroll
            for (int q = 0; q < 4; ++q) { const f32x4 hv = v[q] * rstd * g[64 * q] * (1.0f + sc[64 * q]) + sh[64 * q]; hp[64 * q] = hv;
                hb[64 * q] = (pg8::u32x2){pg8::cvt_pk_bf16(hv.x, hv.y), pg8::cvt_pk_bf16(hv.z, hv.w)}; }
        }
    }
}

__device__ __forceinline__ void phase_norm2_router(const Ctx& c, int L) {
    const float* X = (const float*)(c.ws + WS_X); unsigned short* HB = (unsigned short*)(c.ws + WS_HB); float* AFF = (float*)(c.ws + WS_AFF);
    const float* WR = c.in[IN_ROUTER] + (size_t)L * D * NE;
    for (int r = c.gw; r < NROWS; r += c.ngw) {
        const int j = row_j(r);
        const f32x4* xp = (const f32x4*)(X + (size_t)r * D) + c.lane;
        f32x4 v[4]; float ss = 0.f;
#pragma unroll
        for (int q = 0; q < 4; ++q) { v[q] = xp[64 * q]; ss += v[q].x * v[q].x + v[q].y * v[q].y + v[q].z * v[q].z + v[q].w * v[q].w; }
        const float rstd = rsqrtf(wave_sum(ss) * (1.0f / D) + EPS);
        const f32x4* g = (const f32x4*)(c.in[IN_NORMG] + (size_t)(L * 2 + 1) * D) + c.lane;
        const f32x4* sc = (const f32x4*)modp(c, L, j, 4) + c.lane; const f32x4* sh = (const f32x4*)modp(c, L, j, 3) + c.lane;
        pg8::u32x2* hp = (pg8::u32x2*)(HB + (size_t)r * D) + c.lane;
        float lg[16];
#pragma unroll
        for (int e = 0; e < 16; ++e) lg[e] = 0.f;
#pragma unroll
        for (int q = 0; q < 4; ++q) {
            const f32x4 f = v[q] * rstd * g[64 * q] * (1.0f + sc[64 * q]) + sh[64 * q];
            hp[64 * q] = (pg8::u32x2){pg8::cvt_pk_bf16(f.x, f.y), pg8::cvt_pk_bf16(f.z, f.w)};
            const float* w = WR + (size_t)(4 * (c.lane + 64 * q)) * NE;
#pragma unroll
            for (int i = 0; i < 4; ++i) {
#pragma unroll
                for (int e4 = 0; e4 < 4; ++e4) { const f32x4 wv = *(const f32x4*)(w + i * NE + 4 * e4);
                    lg[4 * e4 + 0] += f[i] * wv.x; lg[4 * e4 + 1] += f[i] * wv.y; lg[4 * e4 + 2] += f[i] * wv.z; lg[4 * e4 + 3] += f[i] * wv.w; }
            }
        }
        const float mine = reduce16(lg, c.lane);
        const int k = reduce16_k(c.lane);
        float mx = mine;
#pragma unroll
        for (int o = 4; o < 64; o <<= 1) mx = fmaxf(mx, __shfl_xor(mx, o));
        const float ex = expf(mine - mx);
        float den = ex;
#pragma unroll
        for (int o = 4; o < 64; o <<= 1) den += __shfl_xor(den, o);
        if ((c.lane & 3) == 0) AFF[(size_t)r * NE + k] = ex / den;
    }
}

__device__ __forceinline__ void phase_topk(const Ctx& c, LAS float* vals) {
    const float* AFF = (const float*)(c.ws + WS_AFF);
    int* SELROW = (int*)(c.ws + WS_SELROW); float* SELGATE = (float*)(c.ws + WS_SELGATE); int* SLOT = (int*)(c.ws + WS_SLOT);
    for (int pid = blockIdx.x; pid < 256; pid += gridDim.x) {
        const bool lat = pid < 128; const int q = lat ? pid : pid - 128, b = q >> 4, e = q & 15;
        const int N = lat ? T : CL, C = lat ? CAP_LAT : CAP_CTX, row0 = b * RB + (lat ? CL : 0), base = lat ? b * CAP_LAT : NB * CAP_LAT + b * CAP_CTX;
        __syncthreads();
        for (int t = c.tid; t < N; t += 512) vals[t] = AFF[(size_t)(row0 + t) * NE + e];
        __syncthreads();
        if (lat) {
            float a[8]; int rk[8];
#pragma unroll
            for (int i = 0; i < 8; ++i) { a[i] = vals[c.tid + 512 * i]; rk[i] = 0; }
            for (int u = 0; u < N; ++u) { const float w = vals[u];
#pragma unroll
                for (int i = 0; i < 8; ++i) rk[i] += (w > a[i] || (w == a[i] && u < c.tid + 512 * i)) ? 1 : 0; }
#pragma unroll
            for (int i = 0; i < 8; ++i) { const int t = c.tid + 512 * i, row = row0 + t;
                if (rk[i] < C) { const int sp = base + rk[i]; SELROW[e * EROWS + sp] = row; SELGATE[e * EROWS + sp] = a[i]; SLOT[(size_t)row * NE + e] = sp; }
                else SLOT[(size_t)row * NE + e] = -1; }
        } else if (c.tid < N) {
            const float a = vals[c.tid]; int rk = 0;
            for (int u = 0; u < N; ++u) { const float w = vals[u]; rk += (w > a || (w == a && u < c.tid)) ? 1 : 0; }
            const int row = row0 + c.tid;
            if (rk < C) { const int sp = base + rk; SELROW[e * EROWS + sp] = row; SELGATE[e * EROWS + sp] = a; SLOT[(size_t)row * NE + e] = sp; }
            else SLOT[(size_t)row * NE + e] = -1;
        }
    }
}

__device__ __forceinline__ void phase_postproj(const Ctx& c, int i) {
    float* P = (float*)(c.ws + WS_P); const float* rope = (const float*)(c.ws + WS_ROPE);
    unsigned short* QA = (unsigned short*)(c.ws + WS_QA); unsigned short* KA = (unsigned short*)(c.ws + WS_KA); unsigned short* VA = (unsigned short*)(c.ws + WS_VA);
    const float* qkg = c.in[IN_QKG] + (size_t)i * 2 * 64;
    for (int job = c.gt; job < NROWS * 28; job += c.ngt) {
        const int row = job / 28, hj = job - row * 28; const int s = row % RB;
        int col0, type; unsigned short* dst = nullptr;
        if (hj < 8) { col0 = hj * 64; type = 0; } else if (hj < 16) { col0 = 512 + (hj - 8) * 64; type = 1; }
        else if (hj < 24) { col0 = 2048 + (hj - 16) * 64; type = 2; dst = QA + (size_t)row * 512 + (hj - 16) * 64; }
        else if (hj < 26) { col0 = 2560 + (hj - 24) * 64; type = 3; dst = KA + (size_t)row * 128 + (hj - 24) * 64; }
        else { col0 = 2688 + (hj - 26) * 64; type = 4; dst = VA + (size_t)row * 128 + (hj - 26) * 64; }
        f32x4* p = (f32x4*)(P + (size_t)row * INW + col0);
        float v[64];
#pragma unroll
        for (int q = 0; q < 16; ++q) { const f32x4 t4 = p[q]; v[4 * q] = t4.x; v[4 * q + 1] = t4.y; v[4 * q + 2] = t4.z; v[4 * q + 3] = t4.w; }
        if (type == 1) {
#pragma unroll
            for (int d = 0; d < 64; ++d) v[d] *= 0.125f;
        }
        if (type == 2 || type == 3) {
            float ss = 0.f;
#pragma unroll
            for (int d = 0; d < 64; ++d) ss += v[d] * v[d];
            const float rs = rsqrtf(ss * (1.0f / 64.0f) + EPS); const float* g = qkg + (type - 2) * 64;
#pragma unroll
            for (int d = 0; d < 64; ++d) v[d] = v[d] * rs * g[d];
        }
        if (s >= CL && type != 4) {
            const int t = s - CL, pr = t >> 6, pc = t & 63;
#pragma unroll
            for (int f = 0; f < 16; ++f) {
                const float cr = rope[2 * (pr * 16 + f)], sr = rope[2 * (pr * 16 + f) + 1], cc = rope[2 * (pc * 16 + f)], sc = rope[2 * (pc * 16 + f) + 1];
                const float x1 = v[f], x2 = v[16 + f], y1 = v[32 + f], y2 = v[48 + f];
                v[f] = x1 * cr - x2 * sr; v[16 + f] = x1 * sr + x2 * cr; v[32 + f] = y1 * cc - y2 * sc; v[48 + f] = y1 * sc + y2 * cc;
            }
        }
        if (type < 2) {
#pragma unroll
            for (int q = 0; q < 16; ++q) p[q] = (f32x4){v[4 * q], v[4 * q + 1], v[4 * q + 2], v[4 * q + 3]};
        } else {
            const float sc = (type == 2) ? attn_body::C2 : 1.0f;
#pragma unroll
            for (int q = 0; q < 8; ++q) { pg8::u32x4 w; w.x = pg8::cvt_pk_bf16(v[8 * q] * sc, v[8 * q + 1] * sc); w.y = pg8::cvt_pk_bf16(v[8 * q + 2] * sc, v[8 * q + 3] * sc);
                w.z = pg8::cvt_pk_bf16(v[8 * q + 4] * sc, v[8 * q + 5] * sc); w.w = pg8::cvt_pk_bf16(v[8 * q + 6] * sc, v[8 * q + 7] * sc); ((pg8::u32x4*)dst)[q] = w; }
        }
    }
}

__device__ __forceinline__ void phase_retention(const Ctx& c, int i) {
    const float* P = (const float*)(c.ws + WS_P);
    for (int task = c.gw; task < NB * 8 * 2; task += c.ngw) {
        const int dir = task & 1, hh = (task >> 1) & 7, b = task >> 4;
        const float gam = expf(-expf(c.in[IN_RETRATE][(i * 2 + dir) * 8 + hh]));
        float* O = (float*)(c.ws + (dir ? WS_OB : WS_OF));
        float S[64];
#pragma unroll
        for (int d = 0; d < 64; ++d) S[d] = 0.f;
        auto seq_row = [&](int n) -> int { int s; if (dir == 0) s = n; else s = (n < CL) ? (CL - 1 - n) : (RB - 1 - (n - CL)); return b * RB + s; };
        int row = seq_row(0);
        float qv = P[(size_t)row * INW + hh * 64 + c.lane], kv = P[(size_t)row * INW + 512 + hh * 64 + c.lane], vv = P[(size_t)row * INW + 1024 + hh * 64 + c.lane];
        for (int n = 0; n < RB; ++n) {
            const int rown = seq_row(n + 1 < RB ? n + 1 : n);
            const float qn = P[(size_t)rown * INW + hh * 64 + c.lane], kn = P[(size_t)rown * INW + 512 + hh * 64 + c.lane], vn = P[(size_t)rown * INW + 1024 + hh * 64 + c.lane];
            float o = 0.f;
            if (dir == 0) {
#pragma unroll
                for (int d = 0; d < 64; ++d) { const float kd = __uint_as_float(__builtin_amdgcn_readlane(__float_as_uint(kv), d)), qd = __uint_as_float(__builtin_amdgcn_readlane(__float_as_uint(qv), d));
                    S[d] = gam * S[d] + kd * vv; o += qd * S[d]; }
            } else {
#pragma unroll
                for (int d = 0; d < 64; ++d) { const float kd = __uint_as_float(__builtin_amdgcn_readlane(__float_as_uint(kv), d)), qd = __uint_as_float(__builtin_amdgcn_readlane(__float_as_uint(qv), d));
                    const float sd = gam * S[d]; o += qd * sd; S[d] = sd + kd * vv; }
            }
            O[(size_t)row * 512 + hh * 64 + c.lane] = o;
            row = rown; qv = qn; kv = kn; vv = vn;
        }
    }
}

__device__ __forceinline__ void phase_ret_out(const Ctx& c, int i) {
    const float* P = (const float*)(c.ws + WS_P); const float* OF = (const float*)(c.ws + WS_OF); const float* OB = (const float*)(c.ws + WS_OB);
    unsigned short* MIX = (unsigned short*)(c.ws + WS_MIX); const float* gn = c.in[IN_RETGN] + (size_t)i * 512;
    for (int job = c.gt; job < NROWS * 8; job += c.ngt) {
        const int row = job >> 3, hh = job & 7;
        const f32x4* pf = (const f32x4*)(OF + (size_t)row * 512 + hh * 64); const f32x4* pb = (const f32x4*)(OB + (size_t)row * 512 + hh * 64);
        float v[64]; float mu = 0.f;
#pragma unroll
        for (int q = 0; q < 16; ++q) { const f32x4 t4 = pf[q] + pb[q]; v[4 * q] = t4.x; v[4 * q + 1] = t4.y; v[4 * q + 2] = t4.z; v[4 * q + 3] = t4.w; mu += t4.x + t4.y + t4.z + t4.w; }
        mu *= (1.0f / 64.0f); float var = 0.f;
#pragma unroll
        for (int d = 0; d < 64; ++d) { v[d] -= mu; var += v[d] * v[d]; }
        const float rs = rsqrtf(var * (1.0f / 64.0f) + EPS);
        const f32x4* pg = (const f32x4*)(P + (size_t)row * INW + 1536 + hh * 64); pg8::u32x2* po = (pg8::u32x2*)(MIX + (size_t)row * D + hh * 64);
#pragma unroll
        for (int q = 0; q < 16; ++q) { const f32x4 gt = pg[q]; f32x4 o;
            o.x = siluf_(gt.x) * (v[4 * q] * rs * gn[hh * 64 + 4 * q]); o.y = siluf_(gt.y) * (v[4 * q + 1] * rs * gn[hh * 64 + 4 * q + 1]);
            o.z = siluf_(gt.z) * (v[4 * q + 2] * rs * gn[hh * 64 + 4 * q + 2]); o.w = siluf_(gt.w) * (v[4 * q + 3] * rs * gn[hh * 64 + 4 * q + 3]);
            po[q] = (pg8::u32x2){pg8::cvt_pk_bf16(o.x, o.y), pg8::cvt_pk_bf16(o.z, o.w)}; }
    }
}

__device__ __forceinline__ void phase_attention(const Ctx& c, char* lds) {
    const attn_body::bf16* QA = (const attn_body::bf16*)(c.ws + WS_QA); const attn_body::bf16* KA = (const attn_body::bf16*)(c.ws + WS_KA); const attn_body::bf16* VA = (const attn_body::bf16*)(c.ws + WS_VA);
    attn_body::bf16* MIX = (attn_body::bf16*)(c.ws + WS_MIX);
    const int G = gridDim.x, bx = blockIdx.x, vcu = (G % 8 == 0) ? (bx % 8) * (G / 8) + bx / 8 : bx;
    for (int U = vcu; U < NB * 8 * 17; U += G) {
        int bh, qrow0, NT;
        if (U < NB * 8 * 16) { bh = U >> 4; qrow0 = (bh >> 3) * RB + CL + (U & 15) * 256; NT = RB / 64; }
        else { bh = U - NB * 8 * 16; qrow0 = (bh >> 3) * RB; NT = CL / 64; }
        const int b = bh >> 3, hh = bh & 7;
        attn_body::attn_unit<8>(QA + (size_t)qrow0 * 512 + hh * 64, KA + (size_t)(b * RB) * 128 + (hh >> 2) * 64, VA + (size_t)(b * RB) * 128 + (hh >> 2) * 64,
                                MIX + (size_t)qrow0 * 1024 + 512 + hh * 64, NT, lds);
    }
}

__device__ __forceinline__ void phase_s5_scan(const Ctx& c, int i) {
    const float* H = (const float*)(c.ws + WS_H);
    for (int task = c.gw; task < NB * 64 * 2; task += c.ngw) {
        const int dir = task & 1, g = (task >> 1) & 63, b = task >> 7, p = c.lane;
        float* Yo = (float*)(c.ws + (dir ? WS_YB : WS_YF));
        const float a_re = c.in[IN_S5ARE][((i * 2 + dir) * 64 + g) * 64 + p], a_im = c.in[IN_S5AIM][((i * 2 + dir) * 64 + g) * 64 + p];
        const float dt = expf(c.in[IN_S5DT][(i * 2 + dir) * 64 + g]);
        const float lre = fminf(a_re, -1e-4f), lim = a_im;
        const float ea = lre * dt, eb = lim * dt, mag = expf(ea), cb = cosf(eb), sb = sinf(eb), sh = sinf(0.5f * eb);
        const float bar_re = mag * cb, bar_im = mag * sb;
        const float nr = expm1f(ea) * cb - 2.0f * sh * sh, ni = bar_im;
        const float den = lre * lre + lim * lim;
        const float k_re = (nr * lre + ni * lim) / den, k_im = (ni * lre - nr * lim) / den;
        float bbr[16], bbi[16], ccr[16], cci[16];
#pragma unroll
        for (int k = 0; k < 16; ++k) {
            const float br = c.in[IN_S5BRE][((size_t)(i * 64 + g) * 64 + p) * 16 + k], bi = c.in[IN_S5BIM][((size_t)(i * 64 + g) * 64 + p) * 16 + k];
            bbr[k] = k_re * br - k_im * bi; bbi[k] = k_re * bi + k_im * br;
            ccr[k] = c.in[IN_S5CRE][(((size_t)(i * 2 + dir) * 64 + g) * 16 + k) * 64 + p]; cci[k] = c.in[IN_S5CIM][(((size_t)(i * 2 + dir) * 64 + g) * 16 + k) * 64 + p];
        }
        float xr = 0.f, xi = 0.f;
        const int kk = reduce16_k(c.lane);
        auto seq_row = [&](int n) -> int { int s; if (dir == 0) s = n; else s = (n < CL) ? (CL - 1 - n) : (RB - 1 - (n - CL)); return b * RB + s; };
        for (int n = 0; n < RB; ++n) {
            const int row = seq_row(n);
            const f32x4* up = (const f32x4*)(H + (size_t)row * D + g * 16);
            const f32x4 u0 = up[0], u1 = up[1], u2 = up[2], u3 = up[3];
            const float u[16] = {u0.x, u0.y, u0.z, u0.w, u1.x, u1.y, u1.z, u1.w, u2.x, u2.y, u2.z, u2.w, u3.x, u3.y, u3.z, u3.w};
            float br = 0.f, bi = 0.f;
#pragma unroll
            for (int k = 0; k < 16; ++k) { br += bbr[k] * u[k]; bi += bbi[k] * u[k]; }
            const float nxr = bar_re * xr - bar_im * xi + br, nxi = bar_re * xi + bar_im * xr + bi;
            xr = nxr; xi = nxi;
            float tv[16];
#pragma unroll
            for (int k = 0; k < 16; ++k) tv[k] = ccr[k] * xr - cci[k] * xi;
            const float y = reduce16(tv, c.lane);
            if ((c.lane & 3) == 0) Yo[(size_t)row * D + g * 16 + kk] = y;
        }
    }
}
__device__ __forceinline__ void phase_s5_out(const Ctx& c, int i) {
    const f32x4* YF = (const f32x4*)(c.ws + WS_YF); const f32x4* YB = (const f32x4*)(c.ws + WS_YB); const f32x4* H = (const f32x4*)(c.ws + WS_H);
    pg8::u32x2* Z = (pg8::u32x2*)(c.ws + WS_Z); const f32x4* dsk = (const f32x4*)(c.in[IN_S5D] + (size_t)i * D);
    for (size_t idx = c.gt; idx < (size_t)NROWS * D / 4; idx += c.ngt) {
        const f32x4 y = YF[idx] + YB[idx] + dsk[idx & 255] * H[idx];
        Z[idx] = (pg8::u32x2){pg8::cvt_pk_bf16(gelu_tanh(y.x), gelu_tanh(y.y)), pg8::cvt_pk_bf16(gelu_tanh(y.z), gelu_tanh(y.w))};
    }
}


__device__ __forceinline__ void cvt_item(const float* W, int ldw, int k0, int scol0, unsigned short* WT, int K, int drow0, LAS float* scr, int lane) {
#pragma unroll 8
    for (int i = 0; i < 32; ++i) { const int kk = 2 * i + (lane >> 5); scr[kk * 33 + (lane & 31)] = W[(size_t)(k0 + kk) * ldw + scol0 + (lane & 31)]; }
    asm volatile("s_waitcnt lgkmcnt(0)" ::: "memory");
    const int cc = lane & 7;
#pragma unroll
    for (int j = 0; j < 4; ++j) { const int n = (lane >> 3) + 8 * j; const LAS float* s = scr + (8 * cc) * 33 + n;
        pg8::u32x4 o; o.x = pg8::cvt_pk_bf16(s[0 * 33], s[1 * 33]); o.y = pg8::cvt_pk_bf16(s[2 * 33], s[3 * 33]); o.z = pg8::cvt_pk_bf16(s[4 * 33], s[5 * 33]); o.w = pg8::cvt_pk_bf16(s[6 * 33], s[7 * 33]);
        *(pg8::u32x4*)(WT + (size_t)(drow0 + n) * K + k0 + 8 * cc) = o; }
    asm volatile("s_waitcnt lgkmcnt(0)" ::: "memory");
}
__device__ __forceinline__ void phase_cvt_moe(const Ctx& c, LAS float* ldsf) {
    LAS float* scr = ldsf + c.wave * (64 * 33);
    unsigned short* W13 = (unsigned short*)(c.ws + WS_W13); unsigned short* W2T = (unsigned short*)(c.ws + WS_W2);
    for (int id = c.gw; id < DEPTH * NE * 3072; id += c.ngw) {
        const int le = id / 3072; int r = id - le * 3072;
        if (r < 2048) { const int kb = r >> 7, nb = r & 127, pn = nb >> 3, rr0 = (nb & 7) * 32;
            const float* srcm = (rr0 < 128 ? c.in[IN_W1] : c.in[IN_W3]) + (size_t)le * D * FF;
            cvt_item(srcm, FF, 64 * kb, 128 * pn + (rr0 & 127), W13 + (size_t)le * 4096 * D, D, 32 * nb, scr, c.lane);
        } else { r -= 2048; const int kb = r >> 5, nb = r & 31;
            cvt_item(c.in[IN_W2] + (size_t)le * FF * D, D, 64 * kb, 32 * nb, W2T + (size_t)le * D * FF, FF, 32 * nb, scr, c.lane); }
    }
    unsigned short* WIN = (unsigned short*)(c.ws + WS_WIN); unsigned short* WOUT = (unsigned short*)(c.ws + WS_WOUT); unsigned short* WGLU = (unsigned short*)(c.ws + WS_WGLU);
    for (int id = c.gw; id < 2 * (1408 + 512 + 1024); id += c.ngw) {
        const int i = id / 2944; int r = id - i * 2944;
        if (r < 1408) { const int kb = r / 88, nb = r - kb * 88; cvt_item(c.in[IN_MIXIN] + (size_t)i * D * INW, INW, 64 * kb, 32 * nb, WIN + (size_t)i * INW * D, D, 32 * nb, scr, c.lane); }
        else if (r < 1920) { r -= 1408; const int kb = r >> 5, nb = r & 31; cvt_item(c.in[IN_MIXOUT] + (size_t)i * D * D, D, 64 * kb, 32 * nb, WOUT + (size_t)i * D * D, D, 32 * nb, scr, c.lane); }
        else { r -= 1920; const int kb = r >> 6, nb = r & 63, pn = nb >> 3, rr0 = (nb & 7) * 32;
            cvt_item(c.in[IN_GLUW] + (size_t)i * D * 2048, 2048, 64 * kb, (rr0 < 128 ? 0 : 1024) + 128 * pn + (rr0 & 127), WGLU + (size_t)i * 2048 * D, D, 32 * nb, scr, c.lane); }
    }
}

struct ALDense { const float* A; int lda; size_t gstride; __device__ __forceinline__ const float* row(int g, int r) const { return A + (size_t)g * gstride + (size_t)r * lda; } };
struct ALGather { const float* A; const int* idx; __device__ __forceinline__ const float* row(int g, int r) const { return A + (size_t)idx[g * EROWS + r] * D; } };
struct BL1 { const float* B; int ldb; size_t gstride; __device__ __forceinline__ const float* ptr(int g, int) const { return B + (size_t)g * gstride; } };
struct BL2 { const float* Ba; const float* Bb; int ldb; size_t gstride; __device__ __forceinline__ const float* ptr(int g, int sub) const { return (sub ? Bb : Ba) + (size_t)g * gstride; } };
struct EPStore { float* O; int ldc; __device__ __forceinline__ void operator()(int, int row, int col, float v, float) const { O[(size_t)row * ldc + col] = v; } };
struct EPResid { float* X; const float* mod; int L; __device__ __forceinline__ void operator()(int, int row, int col, float v, float) const {
    const int j = row_j(row); const float g1 = mod[((size_t)(L * 9 + j) * 6 + 2) * 1024 + col]; X[(size_t)row * D + col] += g1 * v; } };
struct EPGlu { float* X; const float* mod; const float* bias; int L; __device__ __forceinline__ void operator()(int, int row, int col, float va, float vb) const {
    const int j = row_j(row); const float g1 = mod[((size_t)(L * 9 + j) * 6 + 2) * 1024 + col];
    const float o = (va + bias[col]) * sigmoidf_(vb + bias[1024 + col]); X[(size_t)row * D + col] += g1 * o; } };
struct EPSwiglu { float* HID; __device__ __forceinline__ void operator()(int g, int row, int col, float va, float vb) const { HID[((size_t)g * EROWS + row) * FF + col] = siluf_(va) * vb; } };
struct EPGate { float* Y; const float* gate; __device__ __forceinline__ void operator()(int g, int row, int col, float v, float) const { Y[((size_t)g * EROWS + row) * D + col] = gate[g * EROWS + row] * v; } };

__global__ void __launch_bounds__(512, 2) fwd(Args args) {
    extern __shared__ __attribute__((aligned(16))) unsigned char lds[];
    Ctx c; c.in = args.in; c.out = args.out; c.ws = args.ws;
    c.tid = threadIdx.x; c.lane = c.tid & 63; c.wave = __builtin_amdgcn_readfirstlane(c.tid >> 6);
    c.gw = blockIdx.x * 8 + c.wave; c.ngw = gridDim.x * 8; c.gt = blockIdx.x * 512 + c.tid; c.ngt = gridDim.x * 512;
    LAS float* ldsf = (LAS float*)lds; LAS unsigned char* ldsb = (LAS unsigned char*)lds;
    volatile LAS unsigned* MISC = (volatile LAS unsigned*)((LAS unsigned char*)lds + MISC_OFF);
    if (c.tid < 32) MISC[c.tid] = 0u;
    __syncthreads();
    const int lo = args.ph_lo, hi = args.ph_hi;
    const bool one_launch = (hi - lo) > 1;
    XcdBarrier bar; bar.bar = (unsigned*)(c.ws + WS_CTL) + CW_BAR; bar.x = 0; bar.st = MISC + 8;
    if (one_launch) bar = xcd_barrier_post((unsigned*)(c.ws + WS_CTL) + CW_BAR, MISC + 8);
#define IN(k) (lo <= (k) && (k) < hi)
#define SEAM(k) do { if ((k) + 1 < hi) xcd_barrier(bar); } while (0)
#define FRESH(cc) Ctx cc = c; unsigned zq; asm volatile("s_mov_b32 %0, 0" : "=s"(zq)); cc.ws = c.ws + zq; cc.out = c.out + zq; cc.in = (const float* const*)((const char*)c.in + zq); const int Lq = L + (int)zq, iq = Lq >> 1; const float* MOD = (const float*)(cc.ws + WS_MOD); (void)MOD; (void)iq

    if (IN(PH_PRO)) { const int L = 0; FRESH(cc); phase_pro(cc, ldsf); __syncthreads(); phase_cvt_moe(cc, ldsf); SEAM(PH_PRO); }

#define LAYER_BODY(LL) { constexpr int L = LL; \
        const int pb = 1 + L * PH_PER_LAYER; \
        if (IN(pb + 0)) { FRESH(cc); phase_norm1<false>(cc, Lq); SEAM(pb + 0); } \
        if ((L & 1) == 0) { \
            if (IN(pb + 1)) { \
                FRESH(cc); \
                pg8::GOrder S; S.init(1, NROWS, INW, (int)gridDim.x, (int)blockIdx.x); \
                pg8::ADense al{(const pg8::bf16_t*)(cc.ws + WS_HB1), 0, nullptr, 0}; pg8::EpiF32 ep{(float*)(cc.ws + WS_P), INW}; \
                pg8::gemm_phase(ldsb, al, (const pg8::bf16_t*)(cc.ws + WS_WIN) + (size_t)iq * INW * D, 0, D, S, ep); SEAM(pb + 1); } \
            if (IN(pb + 2)) { FRESH(cc); phase_postproj(cc, iq); SEAM(pb + 2); } \
            if (IN(pb + 3)) { FRESH(cc); phase_retention(cc, iq); SEAM(pb + 3); } \
            if (IN(pb + 4)) { FRESH(cc); phase_attention(cc, (char*)lds); SEAM(pb + 4); } \
            if (IN(pb + 5)) { FRESH(cc); phase_ret_out(cc, iq); SEAM(pb + 5); } \
            if (IN(pb + 6)) { \
                FRESH(cc); \
                pg8::GOrder S; S.init(1, NROWS, D, (int)gridDim.x, (int)blockIdx.x); \
                pg8::ADense al{(const pg8::bf16_t*)(cc.ws + WS_MIX), 0, nullptr, 0}; pg8::EpiResid ep{(float*)(cc.ws + WS_X), MOD + (size_t)Lq * 9 * 6144}; \
                pg8::gemm_phase(ldsb, al, (const pg8::bf16_t*)(cc.ws + WS_WOUT) + (size_t)iq * D * D, 0, D, S, ep); SEAM(pb + 6); } \
        } else { \
            if (IN(pb + 1)) { FRESH(cc); phase_s5_scan(cc, iq); SEAM(pb + 1); } \
            if (IN(pb + 2)) { FRESH(cc); phase_s5_out(cc, iq); SEAM(pb + 2); } \
            if (IN(pb + 3)) { \
                FRESH(cc); \
                pg8::GOrder S; S.init(1, NROWS, 2048, (int)gridDim.x, (int)blockIdx.x); \
                pg8::ADense al{(const pg8::bf16_t*)(cc.ws + WS_Z), 0, nullptr, 0}; pg8::EpiGluResid ep{(float*)(cc.ws + WS_X), MOD + (size_t)Lq * 9 * 6144, cc.in[IN_GLUB] + (size_t)iq * 2048}; \
                pg8::gemm_phase(ldsb, al, (const pg8::bf16_t*)(cc.ws + WS_WGLU) + (size_t)iq * 2048 * D, 0, D, S, ep); SEAM(pb + 3); } \
        } \
        if (IN(pb + 7)) { FRESH(cc); phase_norm2_router(cc, Lq); SEAM(pb + 7); } \
        if (IN(pb + 8)) { FRESH(cc); phase_topk(cc, ldsf); SEAM(pb + 8); } \
        if (IN(pb + 9)) { \
            FRESH(cc); \
            pg8::GOrder S; S.init(NE, EROWS, 2 * FF, (int)gridDim.x, (int)blockIdx.x); \
            pg8::AGather al{(const pg8::bf16_t*)(cc.ws + WS_HB), 0, (const int*)(cc.ws + WS_SELROW), EROWS}; \
            pg8::EpiSwiglu ep{(pg8::bf16_t*)(cc.ws + WS_HID), FF, (size_t)EROWS * FF}; \
            pg8::gemm_phase(ldsb, al, (const pg8::bf16_t*)(cc.ws + WS_W13) + (size_t)Lq * NE * 4096 * D, (size_t)4096 * D, D, S, ep); SEAM(pb + 9); } \
        if (IN(pb + 10)) { \
            FRESH(cc); \
            pg8::GOrder S; S.init(NE, EROWS, D, (int)gridDim.x, (int)blockIdx.x); \
            pg8::ADense al{(const pg8::bf16_t*)(cc.ws + WS_HID), (size_t)EROWS * FF, nullptr, 0}; \
            pg8::EpiGate ep{(pg8::bf16_t*)(cc.ws + WS_Y), D, (size_t)EROWS * D, (const float*)(cc.ws + WS_SELGATE), EROWS}; \
            pg8::gemm_phase(ldsb, al, (const pg8::bf16_t*)(cc.ws + WS_W2) + (size_t)Lq * NE * D * FF, (size_t)D * FF, FF, S, ep); SEAM(pb + 10); } \
    }
    LAYER_BODY(0) LAYER_BODY(1) LAYER_BODY(2) LAYER_BODY(3)
#undef LAYER_BODY
    if (IN(PH_FIN)) { const int L = DEPTH; FRESH(cc); phase_norm1<true>(cc, DEPTH); }
#undef IN
#undef SEAM
}

static bool phase_valid(int ph) {
    if (ph == PH_PRO || ph == PH_FIN) return true;
    const int L = (ph - 1) / PH_PER_LAYER, k = (ph - 1) % PH_PER_LAYER;
    if (L & 1) return !(k >= 4 && k <= 6);
    return true;
}
extern "C" void kernel_launch(void* const* d_in, const int* in_sizes, int n_in, void* d_out, int out_size, void* d_ws, size_t ws_size, hipStream_t stream) {
    static int grid = 0;
    if (grid == 0) {
        if (n_in != 27 || out_size != NB * T * D || ws_size < WS_END) { fprintf(stderr, "kernel_launch: unexpected shapes (n_in %d out %d ws %zu)\n", n_in, out_size, ws_size); grid = -1; return; }
        int dev = 0, cus = 0;
        if (hipGetDevice(&dev) != hipSuccess || hipDeviceGetAttribute(&cus, hipDeviceAttributeMultiprocessorCount, dev) != hipSuccess) { grid = -1; return; }
        if (hipFuncSetAttribute((const void*)fwd, hipFuncAttributeMaxDynamicSharedMemorySize, LDS_BYTES) != hipSuccess) { grid = -1; return; }
        int per_cu = 0;
        if (hipOccupancyMaxActiveBlocksPerMultiprocessor(&per_cu, (const void*)fwd, 512, LDS_BYTES) != hipSuccess || per_cu < 1) fprintf(stderr, "kernel_launch: occupancy query says %d\n", per_cu);
        (void)hipGetLastError();
        grid = cus;
    }
    if (grid < 0) return;
    if (hipMemsetAsync((char*)d_ws + WS_CTL, 0, CTL_ZERO_BYTES, stream) != hipSuccess) return;
    Args a{};
    for (int i = 0; i < 27; ++i) a.in[i] = (const float*)d_in[i];
    a.out = (float*)d_out; a.ws = (unsigned char*)d_ws;
#if MK_MULTI
    for (int ph = 0; ph < NPH; ++ph) {
        if (!phase_valid(ph)) continue;
        a.ph_lo = ph; a.ph_hi = ph + 1;
        hipLaunchKernelGGL(fwd, dim3(grid), dim3(512), LDS_BYTES, stream, a);
    }
#else
    a.ph_lo = 0; a.ph_hi = NPH;
    hipLaunchKernelGGL(fwd, dim3(grid), dim3(512), LDS_BYTES, stream, a);
#endif
}
```

```cpp
#include <hip/hip_runtime.h>
#include <hip/hip_bf16.h>
#include <cstdio>
#include <cstdint>

#define GAS __attribute__((address_space(1)))
#define LAS __attribute__((address_space(3)))
typedef float f32x4 __attribute__((ext_vector_type(4)));
typedef float f32x16 __attribute__((ext_vector_type(16)));

constexpr int NB = 8, T = 4096, D = 1024, CL = 256, RB = CL + T  , NROWS = NB * RB  ;
constexpr int DEPTH = 4, NE = 16, FF = 2048, INW = 2816;
constexpr int CAP_LAT = 512, CAP_CTX = 32, EROWS = NB * (CAP_LAT + CAP_CTX)  ;
constexpr float EPS = 1e-6f;
#ifndef MK_MULTI
#define MK_MULTI 0
#endif

constexpr size_t MiB = 1u << 20;
constexpr size_t WS_CTL = 0, CTL_ZERO_BYTES = 1 * MiB;
constexpr size_t WS_MOD = 1 * MiB;
constexpr size_t WS_ROPE = 2 * MiB;
constexpr size_t WS_SELROW = 3 * MiB;
constexpr size_t WS_SELGATE = 3 * MiB + 512 * 1024;
constexpr size_t WS_AFF = 4 * MiB;
constexpr size_t WS_SLOT = 7 * MiB;
constexpr size_t WS_X = 10 * MiB;
constexpr size_t WS_TV = 146 * MiB;
constexpr size_t WS_WS5 = 242 * MiB;
constexpr size_t WS_HB = 282 * MiB;
constexpr size_t WS_W13 = 350 * MiB;
constexpr size_t WS_W2 = 862 * MiB;
constexpr size_t WS_WIN = 1118 * MiB;
constexpr size_t WS_WOUT = 1130 * MiB;
constexpr size_t WS_WGLU = 1134 * MiB;
constexpr size_t WS_HB1 = 1144 * MiB;
constexpr size_t WS_BIG = 1212 * MiB;
constexpr size_t WS_P = WS_BIG;
constexpr size_t WS_RQ = WS_BIG + 374 * MiB;
constexpr size_t WS_RK = WS_BIG + 408 * MiB;
constexpr size_t WS_RV = WS_BIG + 442 * MiB;
constexpr size_t WS_ET = WS_BIG + 476 * MiB;
constexpr size_t WS_MIX = WS_BIG + 510 * MiB;
constexpr size_t WS_QA = WS_BIG + 578 * MiB;
constexpr size_t WS_KA = WS_BIG + 612 * MiB;
constexpr size_t WS_VA = WS_BIG + 621 * MiB;
constexpr size_t WS_U = WS_BIG + 630 * MiB;
constexpr size_t WS_AS5 = WS_BIG;
constexpr size_t WS_SL = WS_BIG + 120 * MiB;
constexpr size_t WS_ZG = WS_BIG + 200 * MiB;
constexpr size_t WS_HID = WS_BIG;
constexpr size_t WS_Y = WS_BIG + 272 * MiB;
constexpr size_t WS_END = WS_BIG + 698 * MiB;
constexpr int CW_BAR = 4096;

constexpr int LDS_BYTES = 147456;
constexpr int MISC_OFF = 131072 + 320;

constexpr int PH_PRO = 0, PH_PER_LAYER = 11, PH_FIN = 1 + DEPTH * PH_PER_LAYER, NPH = PH_FIN + 1;

#define XB_TMO      128
#define XB_XCNT(j)  (256  + 64 * (j))
#define XB_XSUB(j)  (1280 + 64 * (j))
#define XB_XGEN(j)  (2304 + 64 * (j))
#define XB_TOP      3328
#define XB_TOPGEN   3392
#define XCD_BAR_WORDS 3456
#define XB_SPIN_CAP (1u << 22)

__device__ __forceinline__ unsigned xb_ld(unsigned* p)              { return __hip_atomic_load(p, __ATOMIC_RELAXED, __HIP_MEMORY_SCOPE_AGENT); }
__device__ __forceinline__ unsigned xb_add(unsigned* p, unsigned v) { return __hip_atomic_fetch_add(p, v, __ATOMIC_RELAXED, __HIP_MEMORY_SCOPE_AGENT); }
__device__ __forceinline__ unsigned xb_xcc_id() { return (unsigned)__builtin_amdgcn_s_getreg((3 << 11) | 20) & 0xFu; }
#define XB_SPIN(cond, bar) do { unsigned _sp = 0; while (cond) { __builtin_amdgcn_s_sleep(1); \
    if ((++_sp & 255u) == 0u) { if (xb_ld(&(bar)[XB_TMO])) break; if (_sp > XB_SPIN_CAP) { atomicAdd(&(bar)[XB_TMO], 1u); break; } } } } while (0)

struct XcdBarrier { unsigned* bar; unsigned x; volatile LAS unsigned* st; };

__device__ __forceinline__ XcdBarrier xcd_barrier_post(unsigned* bar, volatile LAS unsigned* st) {
    XcdBarrier b; b.bar = bar; b.x = xb_xcc_id(); b.st = st;
    if (threadIdx.x == 0) (void)xb_add(&bar[XB_XCNT(b.x)], 1u);
    return b;
}
__device__ __forceinline__ void xcd_barrier_complete(unsigned* bar, unsigned x, unsigned& nloc, unsigned& nx) {
    const unsigned G = gridDim.x * gridDim.y * gridDim.z;
    unsigned sum, cnt, mine, sp = 0u;
    for (;;) {
        sum = 0u; cnt = 0u; mine = 0u;
#pragma unroll
        for (unsigned j = 0; j < 16; ++j) { const unsigned c = xb_ld(&bar[XB_XCNT(j)]); sum += c; cnt += (c > 0u) ? 1u : 0u; mine = (j == x) ? c : mine; }
        if (sum == G) break;
        __builtin_amdgcn_s_sleep(1);
        if ((++sp & 255u) == 0u) { if (xb_ld(&bar[XB_TMO])) break; if (sp > XB_SPIN_CAP) { atomicAdd(&bar[XB_TMO], 1u); break; } }
    }
    nloc = mine > 0u ? mine : 1u; nx = cnt > 0u ? cnt : 1u;
}
__device__ __forceinline__ void xcd_barrier(const XcdBarrier& b) {
    asm volatile("s_waitcnt vmcnt(0)" ::: "memory");
    __syncthreads();
    if (threadIdx.x == 0) {
        unsigned* bar = b.bar;
        __builtin_amdgcn_s_waitcnt(0);
        unsigned nloc = b.st[0], nx = b.st[1];
        if (nloc == 0u) { xcd_barrier_complete(bar, b.x, nloc, nx); b.st[0] = nloc; b.st[1] = nx; }
        const unsigned old = xb_add(&bar[XB_XSUB(b.x)], 1u);
        const unsigned gen = old / nloc;
        if (old + 1u == (gen + 1u) * nloc) {
            __builtin_amdgcn_fence(__ATOMIC_RELEASE, "agent");
            asm volatile("s_waitcnt vmcnt(0)" ::: "memory");
            const unsigned og = xb_add(&bar[XB_TOP], 1u);
            const unsigned tg = og / nx;
            if (og + 1u == (tg + 1u) * nx) xb_add(&bar[XB_TOPGEN], 1u);
            else XB_SPIN(xb_ld(&bar[XB_TOPGEN]) == tg, bar);
            __builtin_amdgcn_fence(__ATOMIC_ACQUIRE, "agent");
            xb_add(&bar[XB_XGEN(b.x)], 1u);
            asm volatile("s_waitcnt vmcnt(0)" ::: "memory");
        } else {
            XB_SPIN(xb_ld(&bar[XB_XGEN(b.x)]) == gen, bar);
            __builtin_amdgcn_fence(__ATOMIC_ACQUIRE, "agent");
            asm volatile("s_waitcnt vmcnt(0)" ::: "memory");
        }
    }
    __syncthreads();
}

struct Args { const float* in[27]; float* out; unsigned char* ws; int ph_lo, ph_hi; };

struct Ctx {
    const float* const* in; float* out; unsigned char* ws;
    int tid, lane, wave, gw, ngw, gt, ngt;
};
enum { IN_X = 0, IN_C, IN_CTX, IN_CCTX, IN_MODW, IN_MODB, IN_NORMG, IN_MIXIN, IN_MIXOUT, IN_RETRATE, IN_RETGN, IN_QKG,
       IN_S5ARE, IN_S5AIM, IN_S5DT, IN_S5BRE, IN_S5BIM, IN_S5CRE, IN_S5CIM, IN_S5D, IN_GLUW, IN_GLUB, IN_ROUTER, IN_W1, IN_W3, IN_W2, IN_FNG };

__device__ __forceinline__ float wave_sum(float v) {
#pragma unroll
    for (int o = 1; o < 64; o <<= 1) v += __shfl_xor(v, o);
    return v;
}
__device__ __forceinline__ float sigmoidf_(float x) { return 1.0f / (1.0f + expf(-x)); }
__device__ __forceinline__ float siluf_(float x) { return x * sigmoidf_(x); }
__device__ __forceinline__ float gelu_tanh(float x) { const float u = 0.7978845608028654f * (x + 0.044715f * x * x * x); return 0.5f * x * (1.0f + tanhf(u)); }
__device__ __forceinline__ const float* modp(const Ctx& c, int L, int j, int chunk) { return (const float*)(c.ws + WS_MOD) + ((size_t)(L * 9 + j) * 6 + chunk) * 1024; }
__device__ __forceinline__ int row_j(int row) { const int b = row / RB, s = row - b * RB; return s < CL ? 8 : b; }

__device__ __forceinline__ float reduce16(const float (&v)[16], int lane) {
    float a[8], b[4], c2[2], d;
    const bool b5 = (lane & 32) != 0, b4 = (lane & 16) != 0, b3 = (lane & 8) != 0, b2 = (lane & 4) != 0;
#pragma unroll
    for (int i = 0; i < 8; ++i) { const float keep = b5 ? v[8 + i] : v[i], send = b5 ? v[i] : v[8 + i]; a[i] = keep + __shfl_xor(send, 32); }
#pragma unroll
    for (int i = 0; i < 4; ++i) { const float keep = b4 ? a[4 + i] : a[i], send = b4 ? a[i] : a[4 + i]; b[i] = keep + __shfl_xor(send, 16); }
#pragma unroll
    for (int i = 0; i < 2; ++i) { const float keep = b3 ? b[2 + i] : b[i], send = b3 ? b[i] : b[2 + i]; c2[i] = keep + __shfl_xor(send, 8); }
    { const float keep = b2 ? c2[1] : c2[0], send = b2 ? c2[0] : c2[1]; d = keep + __shfl_xor(send, 4); }
    d += __shfl_xor(d, 2); d += __shfl_xor(d, 1);
    return d;
}
__device__ __forceinline__ int reduce16_k(int lane) { return ((lane >> 5) & 1) * 8 + ((lane >> 4) & 1) * 4 + ((lane >> 3) & 1) * 2 + ((lane >> 2) & 1); }

namespace pg8 {
typedef unsigned short bf16_t;
typedef short bf16x8 __attribute__((ext_vector_type(8)));
typedef unsigned u32x4 __attribute__((ext_vector_type(4)));
typedef unsigned u32x2 __attribute__((ext_vector_type(2)));
constexpr int BM = 256, BK = 64, HALF = 128, HTB = HALF * BK * 2, STAGE_BYTES = 8 * HTB, NXCD = 8, WGM = 8;
__host__ __device__ __forceinline__ int lds_byte(int r, int c) { const int st = (r >> 4) * 2 + (c >> 5), rr = r & 15, cc = c & 31, ob = rr * 64 + cc * 2; return st * 1024 + (ob ^ (((ob >> 9) & 1) << 5)); }
__host__ __device__ __forceinline__ void stage_rc(int b, int& R, int& C) { const int st = b / 1024, sb = b % 1024, swz = sb ^ (((sb >> 9) & 1) << 5); R = (st >> 1) * 16 + swz / 64; C = (st & 1) * 32 + (swz % 64) / 2; }
__host__ __device__ __forceinline__ int perm32(int rho) { const int n = rho >> 4, i = rho & 15; return 8 * (i >> 2) + 4 * n + (i & 3); }
__device__ __forceinline__ unsigned cvt_pk_bf16(float lo, float hi) { unsigned r; asm volatile("v_cvt_pk_bf16_f32 %0, %1, %2" : "=v"(r) : "v"(lo), "v"(hi)); return r; }

struct Unit { int pm, pn, g; };
struct GOrder {
    int nM, nN, per, nwg, G, c;
    __device__ __forceinline__ void init(int groups, int M, int N, int G_, int c_) { nM = M / BM; nN = N / BM; per = nM * nN; nwg = groups * per; G = G_; c = c_; }
    __device__ __forceinline__ bool next(int i, Unit& u) const {
        const long L = (long)i * G + c; if (L >= nwg) return false;
        int wgid = (int)L; { const int q = nwg / NXCD, r = nwg % NXCD, xcd = wgid % NXCD, off = wgid / NXCD; wgid = (xcd < r ? xcd * (q + 1) : r * (q + 1) + (xcd - r) * q) + off; }
        u.g = wgid / per; const int w = wgid - u.g * per;
        const int nig = WGM * nN, gid = w / nig, fm = gid * WGM, gsz = (nM - fm) < WGM ? (nM - fm) : WGM;
        u.pm = fm + ((w % nig) % gsz); u.pn = (w % nig) / gsz; return true;
    }
};
struct ADense  { static constexpr bool GATHER = false; const bf16_t* A; size_t gstride; const int* idx; int rpg; unsigned rowpitch; unsigned cgrp; size_t kstep; };
struct AGather { static constexpr bool GATHER = true;  const bf16_t* A; size_t gstride; const int* idx; int rpg; unsigned rowpitch; unsigned cgrp; size_t kstep; };

template <class Epi, class ALoc>
__device__ __forceinline__ void gemm_phase(LAS unsigned char* lds, const ALoc AL, const bf16_t* Bt, size_t gstrideB, int K, const GOrder& S, const Epi& E) {
    constexpr bool GATHER = ALoc::GATHER;
    const int tid = threadIdx.x, wid = __builtin_amdgcn_readfirstlane(tid >> 6), lane = tid & 63, wr = wid >> 2, wc = wid & 3, fr = lane & 15, fq = lane >> 4;
    const int nt = K / BK;
    unsigned voffA[2], voffB[2]; int RA[2]; unsigned CA2[2];
#pragma unroll
    for (int i = 0; i < 2; ++i) { int R, C; stage_rc(tid * 16 + i * 8192, R, C); const int Rb = Epi::PERM ? ((R & ~31) + perm32(R & 31)) : R;
        const unsigned cofs = AL.cgrp ? (unsigned)(C >> 4) * AL.cgrp + (unsigned)(C & 15) : (unsigned)C;
        voffA[i] = ((unsigned)R * AL.rowpitch + cofs) * 2u; voffB[i] = (unsigned)(Rb * K + C) * 2u; RA[i] = R; CA2[i] = cofs * 2u; }
    const size_t kstep = (size_t)(BK * 2), kstepA = AL.kstep * 2;
    const size_t hstep = (size_t)HALF * K * 2;
    const size_t hstepA = GATHER ? 0 : (size_t)HALF * AL.rowpitch * 2, tstepA = 2 * (size_t)HALF * AL.rowpitch * 2;
    const size_t tstep = 2 * hstep;
    const unsigned ldsw = (unsigned)wid * 1024u;
    const int aoff = lds_byte(wr * 64 + fr, fq * 8), boff = lds_byte(wc * 32 + fr, fq * 8);
    unsigned vAc[2][2], vAn[2][2];
#define PG8_SA(b, h) (((b) * 2 + (h)) * HTB)
#define PG8_SB(b, h) ((4 + (b) * 2 + (h)) * HTB)
#define PG8_STAGE(bufoff, gbase, voff) do { _Pragma("unroll") for (int _i = 0; _i < 2; ++_i) \
        __builtin_amdgcn_global_load_lds((const unsigned*)((const char*)(gbase) + (voff)[_i]), (LAS unsigned*)(lds + (bufoff) + ldsw + _i * 8192), 16, 0, 0); } while (0)
#define PG8_STAGE_A(bufoff, gbase, h, nx) do { _Pragma("unroll") for (int _i = 0; _i < 2; ++_i) { \
        const unsigned _o = GATHER ? ((nx) ? vAn[h][_i] : vAc[h][_i]) : voffA[_i]; \
        __builtin_amdgcn_global_load_lds((const unsigned*)((const char*)(gbase) + (size_t)(h) * hstepA + _o), (LAS unsigned*)(lds + (bufoff) + ldsw + _i * 8192), 16, 0, 0); } } while (0)
#define PG8_GIDX(u, v) do { if (GATHER) { _Pragma("unroll") for (int _h = 0; _h < 2; ++_h) _Pragma("unroll") for (int _i = 0; _i < 2; ++_i) \
        v[_h][_i] = (unsigned)AL.idx[(u).g * AL.rpg + (u).pm * BM + _h * HALF + RA[_i]] * (AL.rowpitch * 2u) + CA2[_i]; } } while (0)
#define PG8_ABASE(u) ((const char*)AL.A + (GATHER ? (size_t)0 : ((size_t)(u).g * AL.gstride * 2 + (size_t)(u).pm * tstepA)))
#define PG8_BBASE(u) ((const char*)Bt + (size_t)(u).g * gstrideB * 2 + (size_t)(u).pn * tstep)
#define PG8_LDA(dst, b, h) do { _Pragma("unroll") for (int m = 0; m < 4; ++m) _Pragma("unroll") for (int k = 0; k < 2; ++k) dst[m][k] = *(const LAS bf16x8*)(lds + PG8_SA(b, h) + aoff + m * 2048 + k * 1024); } while (0)
#define PG8_LDB(dst, b, h) do { _Pragma("unroll") for (int n = 0; n < 2; ++n) _Pragma("unroll") for (int k = 0; k < 2; ++k) dst[n][k] = *(const LAS bf16x8*)(lds + PG8_SB(b, h) + boff + n * 2048 + k * 1024); } while (0)
#define PG8_MMA(ai, bj, At, Bt_) do { __builtin_amdgcn_s_setprio(1); _Pragma("unroll") for (int m = 0; m < 4; ++m) _Pragma("unroll") for (int n = 0; n < 2; ++n) _Pragma("unroll") for (int k = 0; k < 2; ++k) \
        acc[ai][bj][m][n] = __builtin_amdgcn_mfma_f32_16x16x32_bf16(Bt_[n][k], At[m][k], acc[ai][bj][m][n], 0, 0, 0); __builtin_amdgcn_s_setprio(0); } while (0)
#define PG8_WAIT_V(n) asm volatile("s_waitcnt vmcnt(" #n ")" ::: "memory")
#define PG8_WAIT_L(n) asm volatile("s_waitcnt lgkmcnt(" #n ")" ::: "memory")
#define PG8_BAR __builtin_amdgcn_s_barrier()
#define PG8_SCHED __builtin_amdgcn_sched_barrier(0)
    Unit cur, nxt; int ui = 0;
    if (!S.next(0, cur)) return;
    PG8_GIDX(cur, vAc);
    f32x4 acc[2][2][4][2];
#pragma unroll
    for (int a = 0; a < 2; ++a)
#pragma unroll
        for (int b = 0; b < 2; ++b)
#pragma unroll
            for (int m = 0; m < 4; ++m)
#pragma unroll
                for (int n = 0; n < 2; ++n) acc[a][b][m][n] = (f32x4){0.f, 0.f, 0.f, 0.f};
    bf16x8 At[4][2], B0[2][2], B1[2][2];
    const char* cA = PG8_ABASE(cur); const char* cB = PG8_BBASE(cur);
    PG8_STAGE(PG8_SB(0, 0), cB, voffB); PG8_STAGE(PG8_SB(0, 1), cB + hstep, voffB); PG8_STAGE_A(PG8_SA(0, 0), cA, 0, false); PG8_STAGE_A(PG8_SA(0, 1), cA, 1, false);
    if (wr == 1) PG8_BAR;
    PG8_WAIT_V(2); PG8_BAR;
    PG8_STAGE(PG8_SB(1, 0), cB + kstep, voffB); PG8_STAGE_A(PG8_SA(1, 0), cA + kstepA, 0, false); PG8_STAGE(PG8_SB(1, 1), cB + hstep + kstep, voffB);
    PG8_WAIT_V(6); PG8_BAR;
    for (;;) {
        const bool has_next = S.next(ui + 1, nxt);
        if (GATHER) { if (has_next) { PG8_GIDX(nxt, vAn); } else {
#pragma unroll
            for (int _h = 0; _h < 2; ++_h)
#pragma unroll
                for (int _i = 0; _i < 2; ++_i) vAn[_h][_i] = vAc[_h][_i]; } }
        const char* nA = has_next ? PG8_ABASE(nxt) : cA; const char* nB = has_next ? PG8_BBASE(nxt) : cB;
        for (int t = 0; t < nt; t += 2) {
            const bool last = (t == nt - 2);
            const char* a1 = cA + (size_t)(t + 1) * kstepA;
            const char* a2 = last ? nA : cA + (size_t)(t + 2) * kstepA; const char* b2 = last ? nB : cB + (size_t)(t + 2) * kstep;
            const char* a3 = a2 + kstepA; const char* b3 = b2 + kstep;
            PG8_LDB(B0, 0, 0); PG8_LDB(B1, 0, 1); PG8_SCHED; PG8_LDA(At, 0, 0); PG8_STAGE_A(PG8_SA(1, 1), a1, 1, false);
            PG8_WAIT_V(8); PG8_WAIT_L(0); PG8_BAR; PG8_MMA(0, 0, At, B0); PG8_MMA(0, 1, At, B1); PG8_BAR; PG8_SCHED;
            PG8_LDA(At, 0, 1); PG8_STAGE(PG8_SB(0, 0), b2, voffB); PG8_STAGE(PG8_SB(0, 1), b2 + hstep, voffB); PG8_STAGE_A(PG8_SA(0, 0), a2, 0, last);
            PG8_WAIT_V(8); PG8_WAIT_L(0); PG8_BAR; PG8_MMA(1, 0, At, B0); PG8_MMA(1, 1, At, B1); PG8_BAR; PG8_SCHED;
            PG8_LDB(B0, 1, 0); PG8_LDB(B1, 1, 1); PG8_SCHED; PG8_LDA(At, 1, 0); PG8_STAGE_A(PG8_SA(0, 1), a2, 1, last);
            PG8_WAIT_V(8); PG8_WAIT_L(0); PG8_BAR; PG8_MMA(0, 0, At, B0); PG8_MMA(0, 1, At, B1); PG8_BAR; PG8_SCHED;
            PG8_LDA(At, 1, 1); PG8_STAGE(PG8_SB(1, 0), b3, voffB); PG8_STAGE(PG8_SB(1, 1), b3 + hstep, voffB); PG8_STAGE_A(PG8_SA(1, 0), a3, 0, last);
            PG8_WAIT_V(8); PG8_WAIT_L(0); PG8_BAR; PG8_MMA(1, 0, At, B0); PG8_MMA(1, 1, At, B1); PG8_BAR; PG8_SCHED;
        }
        if (wr == 0) PG8_BAR;
        E(acc, cur, wr, wc, fr, fq);
        if (!has_next) break;
#pragma unroll
        for (int a = 0; a < 2; ++a)
#pragma unroll
            for (int b = 0; b < 2; ++b)
#pragma unroll
                for (int m = 0; m < 4; ++m)
#pragma unroll
                    for (int n = 0; n < 2; ++n) acc[a][b][m][n] = (f32x4){0.f, 0.f, 0.f, 0.f};
        cur = nxt; cA = nA; cB = nB; ++ui;
        if (GATHER) {
#pragma unroll
            for (int _h = 0; _h < 2; ++_h)
#pragma unroll
                for (int _i = 0; _i < 2; ++_i) vAc[_h][_i] = vAn[_h][_i]; }
        if (wr == 1) PG8_BAR;
    }
    PG8_WAIT_V(0);
    PG8_BAR;
#undef PG8_SA
#undef PG8_SB
#undef PG8_STAGE
#undef PG8_STAGE_A
#undef PG8_GIDX
#undef PG8_ABASE
#undef PG8_BBASE
#undef PG8_LDA
#undef PG8_LDB
#undef PG8_MMA
#undef PG8_WAIT_V
#undef PG8_WAIT_L
#undef PG8_BAR
#undef PG8_SCHED
}

__device__ __forceinline__ float fast_sigmoid(float x) { return __builtin_amdgcn_rcpf(1.0f + __builtin_amdgcn_exp2f(-1.4426950408889634f * x)); }
struct EpiSwiglu {
    static constexpr bool PERM = true;
    bf16_t* O; int ldc; size_t gstride;
    __device__ __forceinline__ void operator()(const f32x4 (&acc)[2][2][4][2], const Unit& u, int wr, int wc, int fr, int fq) const {
        const int row0 = u.pm * BM + wr * 64 + fr, col0 = u.pn * HALF + wc * 32 + 8 * fq;
        bf16_t* base = O + (size_t)u.g * gstride;
#pragma unroll
        for (int ai = 0; ai < 2; ++ai)
#pragma unroll
            for (int m = 0; m < 4; ++m) { bf16_t* rowp = base + (size_t)(row0 + ai * HALF + m * 16) * ldc + col0;
                float o[8];
#pragma unroll
                for (int n = 0; n < 2; ++n)
#pragma unroll
                    for (int q = 0; q < 4; ++q) { const float a = acc[ai][0][m][n][q], b = acc[ai][1][m][n][q]; o[4 * n + q] = a * fast_sigmoid(a) * b; }
                u32x4 w; w.x = cvt_pk_bf16(o[0], o[1]); w.y = cvt_pk_bf16(o[2], o[3]); w.z = cvt_pk_bf16(o[4], o[5]); w.w = cvt_pk_bf16(o[6], o[7]);
                *(u32x4*)rowp = w; }
    }
};
struct EpiGeluBf16 {
    static constexpr bool PERM = true;
    bf16_t* O; int ldc; size_t gstride;
    __device__ __forceinline__ void operator()(const f32x4 (&acc)[2][2][4][2], const Unit& u, int wr, int wc, int fr, int fq) const {
        const int row0 = u.pm * BM + wr * 64 + fr, col0 = u.pn * BM + wc * 32 + 8 * fq;
        bf16_t* base = O + (size_t)u.g * gstride;
#pragma unroll
        for (int ai = 0; ai < 2; ++ai)
#pragma unroll
            for (int m = 0; m < 4; ++m) { bf16_t* rowp = base + (size_t)(row0 + ai * HALF + m * 16) * ldc + col0;
#pragma unroll
                for (int bj = 0; bj < 2; ++bj) { float o[8];
#pragma unroll
                    for (int n = 0; n < 2; ++n)
#pragma unroll
                        for (int q = 0; q < 4; ++q) { const float x = acc[ai][bj][m][n][q]; o[4 * n + q] = x * fast_sigmoid(1.5957691216057308f * (x + 0.044715f * x * x * x)); }
                    u32x4 w; w.x = cvt_pk_bf16(o[0], o[1]); w.y = cvt_pk_bf16(o[2], o[3]); w.z = cvt_pk_bf16(o[4], o[5]); w.w = cvt_pk_bf16(o[6], o[7]);
                    *(u32x4*)(rowp + bj * HALF) = w; } }
    }
};
struct EpiGate {
    static constexpr bool PERM = true;
    bf16_t* O; int ldc; size_t gstride; const float* gate; int rpg;
    __device__ __forceinline__ void operator()(const f32x4 (&acc)[2][2][4][2], const Unit& u, int wr, int wc, int fr, int fq) const {
        const int row0 = u.pm * BM + wr * 64 + fr, col0 = u.pn * BM + wc * 32 + 8 * fq;
        bf16_t* base = O + (size_t)u.g * gstride;
#pragma unroll
        for (int ai = 0; ai < 2; ++ai)
#pragma unroll
            for (int m = 0; m < 4; ++m) { const int row = row0 + ai * HALF + m * 16; const float gt = gate[u.g * rpg + row]; bf16_t* rowp = base + (size_t)row * ldc + col0;
#pragma unroll
                for (int bj = 0; bj < 2; ++bj) { const f32x4 v0 = acc[ai][bj][m][0] * gt, v1 = acc[ai][bj][m][1] * gt;
                    u32x4 w; w.x = cvt_pk_bf16(v0[0], v0[1]); w.y = cvt_pk_bf16(v0[2], v0[3]); w.z = cvt_pk_bf16(v1[0], v1[1]); w.w = cvt_pk_bf16(v1[2], v1[3]);
                    *(u32x4*)(rowp + bj * HALF) = w; } }
    }
};
struct EpiF32 {
    static constexpr bool PERM = false;
    float* C; int ldc; size_t gstride;
    __device__ __forceinline__ void operator()(const f32x4 (&acc)[2][2][4][2], const Unit& u, int wr, int wc, int fr, int fq) const {
        const int row0 = u.pm * BM + wr * 64 + fr, col0 = u.pn * BM + wc * 32 + 4 * fq;
#pragma unroll
        for (int ai = 0; ai < 2; ++ai)
#pragma unroll
            for (int m = 0; m < 4; ++m) { float* rowp = C + (size_t)u.g * gstride + (size_t)(row0 + ai * HALF + m * 16) * ldc + col0;
#pragma unroll
                for (int bj = 0; bj < 2; ++bj)
#pragma unroll
                    for (int n = 0; n < 2; ++n) *(f32x4*)(rowp + bj * HALF + n * 16) = acc[ai][bj][m][n]; }
    }
};
struct EpiResid {
    static constexpr bool PERM = false;
    float* X; const float* modL;
    __device__ __forceinline__ void operator()(const f32x4 (&acc)[2][2][4][2], const Unit& u, int wr, int wc, int fr, int fq) const {
        const int row0 = u.pm * BM + wr * 64 + fr, col0 = u.pn * BM + wc * 32 + 4 * fq;
        const int b = u.pm / 17, j = (u.pm - b * 17 == 0) ? 8 : b;
        const float* g1 = modL + (size_t)(j * 6 + 2) * 1024 + col0;
        f32x4 gv[2][2];
#pragma unroll
        for (int bj = 0; bj < 2; ++bj)
#pragma unroll
            for (int n = 0; n < 2; ++n) gv[bj][n] = *(const f32x4*)(g1 + bj * HALF + n * 16);
#pragma unroll
        for (int ai = 0; ai < 2; ++ai)
#pragma unroll
            for (int m = 0; m < 4; ++m) { float* rowp = X + (size_t)(row0 + ai * HALF + m * 16) * D + col0;
#pragma unroll
                for (int bj = 0; bj < 2; ++bj)
#pragma unroll
                    for (int n = 0; n < 2; ++n) { f32x4* p = (f32x4*)(rowp + bj * HALF + n * 16); *p = *p + gv[bj][n] * acc[ai][bj][m][n]; } }
    }
};
struct EpiGluResid {
    static constexpr bool PERM = false;
    float* X; const float* modL; const float* bias;
    __device__ __forceinline__ void operator()(const f32x4 (&acc)[2][2][4][2], const Unit& u, int wr, int wc, int fr, int fq) const {
        const int row0 = u.pm * BM + wr * 64 + fr, col0 = u.pn * HALF + wc * 32 + 4 * fq;
        const int b = u.pm / 17, j = (u.pm - b * 17 == 0) ? 8 : b;
        const float* g1 = modL + (size_t)(j * 6 + 2) * 1024 + col0;
        f32x4 gv[2], ba[2], bg[2];
#pragma unroll
        for (int n = 0; n < 2; ++n) { gv[n] = *(const f32x4*)(g1 + n * 16); ba[n] = *(const f32x4*)(bias + col0 + n * 16); bg[n] = *(const f32x4*)(bias + 1024 + col0 + n * 16); }
#pragma unroll
        for (int ai = 0; ai < 2; ++ai)
#pragma unroll
            for (int m = 0; m < 4; ++m) { float* rowp = X + (size_t)(row0 + ai * HALF + m * 16) * D + col0;
#pragma unroll
                for (int n = 0; n < 2; ++n) { const f32x4 a = acc[ai][0][m][n] + ba[n], g = acc[ai][1][m][n] + bg[n];
                    f32x4 o; o.x = a.x * fast_sigmoid(g.x); o.y = a.y * fast_sigmoid(g.y); o.z = a.z * fast_sigmoid(g.z); o.w = a.w * fast_sigmoid(g.w);
                    f32x4* p = (f32x4*)(rowp + n * 16); *p = *p + gv[n] * o; } }
    }
};
}

namespace attn_body {
using bf16=__hip_bfloat16;
using bf16x8=__attribute__((ext_vector_type(8)))short;
using s16x4=__attribute__((ext_vector_type(4)))short;
using f32x16=__attribute__((ext_vector_type(16)))float;
using u32x4=__attribute__((ext_vector_type(4)))unsigned;
constexpr int D=64,QP=512,KP=128,OP=1024;
constexpr int NW=8,QBLK=32,QB=QBLK*NW,KVBLK=64;
__device__ __forceinline__ int crow(int r,int hi){return (r&3)+8*(r>>2)+4*hi;}
#define SBAR() __builtin_amdgcn_sched_barrier(0)
__device__ __forceinline__ void cmask(f32x16&p0,f32x16&p1,int jb,int qrel,int hi){
  const float NEG=-INFINITY; int kb=64*jb+4*hi;
  #pragma unroll
  for(int r=0;r<16;++r){int kv=kb+(r&3)+8*(r>>2); if(kv>qrel)p0[r]=NEG; if(kv+32>qrel)p1[r]=NEG;}
}

constexpr int NSLOT=3, SLOTB=8192;
constexpr int LDS_K=0, LDS_V=NSLOT*SLOTB, LDS_WS=2*NSLOT*SLOTB, LDS_OST=LDS_WS+NW*64*4, LDS_BYTES=LDS_OST+NW*4096;
constexpr float C2=0.125f*1.4426950408889634f;
__device__ __forceinline__ void glds16(const void*gsrc,unsigned lds_dst){unsigned keep;
  asm volatile("s_mov_b32 %0, m0\n\ts_mov_b32 m0, %2\n\ts_nop 0\n\tglobal_load_lds_dwordx4 %1, off\n\ts_mov_b32 m0, %0":"=&s"(keep):"v"(gsrc),"s"(lds_dst):"memory");}
__device__ __forceinline__ float max3f(float a,float b,float c){float r;asm("v_max3_f32 %0, %1, %2, %3":"=v"(r):"v"(a),"v"(b),"v"(c));return r;}
__device__ __forceinline__ float max2f(float a,float b){float r;asm("v_max_f32_e32 %0, %1, %2":"=v"(r):"v"(a),"v"(b));return r;}
__device__ __forceinline__ float fadd_s(float a,float b){float r;asm("v_add_f32_e32 %0, %1, %2":"=v"(r):"v"(a),"v"(b));return r;}
__device__ __forceinline__ float fsub_s(float a,float b){float r;asm("v_sub_f32_e32 %0, %1, %2":"=v"(r):"v"(a),"v"(b));return r;}
typedef float f32x2_t __attribute__((ext_vector_type(2))); typedef __bf16 bf16x2_t __attribute__((ext_vector_type(2)));
__device__ __forceinline__ unsigned cvtpk_s(float lo,float hi){f32x2_t v={lo,hi};bf16x2_t b=__builtin_convertvector(v,bf16x2_t);return __builtin_bit_cast(unsigned,b);}
#define WAIT_BAR(N) asm volatile("s_waitcnt vmcnt(" #N ") lgkmcnt(0)\n\ts_barrier":::"memory")

__device__ __forceinline__ void qkt(f32x16&p0,f32x16&p1,const char*Kslot,const bf16x8*qr,const f32x16&negm,int r32,int hi){
  const char*kb=Kslot+hi*1024+r32*16;
  #pragma unroll
  for(int d0=0;d0<4;++d0){
    const bf16x8 b0=*reinterpret_cast<const bf16x8*>(kb+d0*2048);
    const bf16x8 b1=*reinterpret_cast<const bf16x8*>(kb+d0*2048+512);
    if(d0==0){p0=__builtin_amdgcn_mfma_f32_32x32x16_bf16(b0,qr[0],negm,0,0,0);p1=__builtin_amdgcn_mfma_f32_32x32x16_bf16(b1,qr[0],negm,0,0,0);}
    else{p0=__builtin_amdgcn_mfma_f32_32x32x16_bf16(b0,qr[d0],p0,0,0,0);p1=__builtin_amdgcn_mfma_f32_32x32x16_bf16(b1,qr[d0],p1,0,0,0);}}
}
typedef __attribute__((address_space(3))) const char* lds_cptr;
typedef short v4i16_t __attribute__((ext_vector_type(4)));
__device__ __forceinline__ void kload8(bf16x8*kf,lds_cptr kp){
  kf[0]=*(const __attribute__((address_space(3))) bf16x8*)(kp);      kf[1]=*(const __attribute__((address_space(3))) bf16x8*)(kp+512);
  kf[2]=*(const __attribute__((address_space(3))) bf16x8*)(kp+2048); kf[3]=*(const __attribute__((address_space(3))) bf16x8*)(kp+2560);
  kf[4]=*(const __attribute__((address_space(3))) bf16x8*)(kp+4096); kf[5]=*(const __attribute__((address_space(3))) bf16x8*)(kp+4608);
  kf[6]=*(const __attribute__((address_space(3))) bf16x8*)(kp+6144); kf[7]=*(const __attribute__((address_space(3))) bf16x8*)(kp+6656);
}
__device__ __forceinline__ void kload2(bf16x8*kf,lds_cptr kp,int j){ kf[2*j]=*(const __attribute__((address_space(3))) bf16x8*)(kp+j*2048); kf[2*j+1]=*(const __attribute__((address_space(3))) bf16x8*)(kp+j*2048+512); }
__device__ __forceinline__ s16x4 vtr(lds_cptr p){ return __builtin_bit_cast(s16x4,__builtin_amdgcn_ds_read_tr16_b64_v4i16((__attribute__((address_space(3))) v4i16_t*)p)); }
__device__ __forceinline__ float rowmax(const f32x16&p0,const f32x16&p1){
  float a=max3f(p0[0],p0[1],p1[0]),b=max3f(p0[2],p0[3],p1[1]);a=max3f(a,p1[2],p1[3]);
  #pragma unroll
  for(int r=4;r<16;r+=4){a=max3f(a,p0[r],p0[r+1]);b=max3f(b,p0[r+2],p0[r+3]);a=max3f(a,p1[r],p1[r+1]);b=max3f(b,p1[r+2],p1[r+3]);}
  const float m=max2f(a,b);
  auto rr=__builtin_amdgcn_permlane32_swap(__float_as_uint(m),__float_as_uint(m),false,false);
  return max2f(__uint_as_float(rr[0]),__uint_as_float(rr[1]));
}
__device__ __forceinline__ void pv(f32x16*o,int vb,bf16x8 pa0,bf16x8 pa1,bf16x8 pa2,bf16x8 pa3){
  #pragma unroll
  for(int d0=0;d0<2;++d0){s16x4 lo[4],hi[4];
    #pragma unroll
    for(int ks=0;ks<4;++ks){
      asm volatile("ds_read_b64_tr_b16 %0,%1 offset:%c2":"=&v"(lo[ks]):"v"(vb),"i"(d0*4096+ks*1024):"memory");
      asm volatile("ds_read_b64_tr_b16 %0,%1 offset:%c2":"=&v"(hi[ks]):"v"(vb),"i"(d0*4096+ks*1024+512):"memory");}
    asm volatile("s_waitcnt lgkmcnt(0)":::"memory");SBAR();
    #define PK(k) (bf16x8){lo[k][0],lo[k][1],lo[k][2],lo[k][3],hi[k][0],hi[k][1],hi[k][2],hi[k][3]}
    o[d0]=__builtin_amdgcn_mfma_f32_32x32x16_bf16(pa0,PK(0),o[d0],0,0,0);
    o[d0]=__builtin_amdgcn_mfma_f32_32x32x16_bf16(pa1,PK(1),o[d0],0,0,0);
    o[d0]=__builtin_amdgcn_mfma_f32_32x32x16_bf16(pa2,PK(2),o[d0],0,0,0);
    o[d0]=__builtin_amdgcn_mfma_f32_32x32x16_bf16(pa3,PK(3),o[d0],0,0,0);
    #undef PK
  }
}

#ifndef ATTN_STORE16
#define ATTN_STORE16(p,v) (*(u32x4*)(p)=(v))
#endif
template<int THRL> __device__ __forceinline__ void attn_unit(const bf16*Qw0,const bf16*Kh,const bf16*Vh,bf16*Ow0,const int NT,char*shm){
  const int tid=threadIdx.x,lane=tid&63,r32=lane&31,hi=lane>>5; const int wid=__builtin_amdgcn_readfirstlane(tid>>6);
  const bf16*Qw=Qw0+(long)(wid*QBLK)*QP;
  const unsigned lds0=(unsigned)(uintptr_t)shm;
  float*wsf=(float*)(shm+LDS_WS)+wid*64;
  const bf16*ksrc=Kh+(long)lane*KP+wid*8;
  const bf16*vsrc=Vh+(long)(16*(wid&3)+(lane>>2))*KP+(wid>>2)*32+(lane&3)*8;
  const unsigned kdst=lds0+LDS_K+wid*1024, vdst=lds0+LDS_V+wid*1024;
  #define DMA_K(t,slot) glds16(ksrc+(long)(t)*KVBLK*KP,(unsigned)__builtin_amdgcn_readfirstlane(kdst+(slot)))
  #define DMA_V(t,slot) glds16(vsrc+(long)(t)*KVBLK*KP,(unsigned)__builtin_amdgcn_readfirstlane(vdst+(slot)))
  const int vb0=(int)(lds0+LDS_V)+((lane>>4)&1)*32+(lane&3)*8+(4*hi+((lane&15)>>2))*64;
  const char*Kbase=shm+LDS_K; bf16x8 kf[8];
  const lds_cptr shm3=(lds_cptr)shm; const lds_cptr kp0=shm3+LDS_K+hi*1024+r32*16; const lds_cptr vp0=shm3+LDS_V+((lane>>4)&1)*32+(lane&3)*8+(4*hi+((lane&15)>>2))*64;
  DMA_K(0,0);DMA_V(0,0);DMA_K(1,SLOTB);
  bf16x8 qr[4];
  #pragma unroll
  for(int d0=0;d0<4;++d0)qr[d0]=*reinterpret_cast<const bf16x8*>(&Qw[(long)r32*QP+d0*16+hi*8]);
  float mhat=0.f,l_reg=0.f;f32x16 o[2];o[0]=f32x16{};o[1]=f32x16{};f32x16 negm=f32x16{};asm volatile("":"+v"(negm));
  #define CMASK(P0,P1,t) do{}while(0)
  bool resc=false;
  #define START(P0,P1) do{ const float rm=rowmax(P0,P1); resc=false; \
    { const float dl=rm; mhat=fadd_s(mhat,dl); \
      _Pragma("unroll") for(int r=0;r<16;++r){P0[r]=fsub_s(P0[r],dl);P1[r]=fsub_s(P1[r],dl);} \
      _Pragma("unroll") for(int r=0;r<16;++r)negm[r]=-mhat; asm volatile("":"+v"(negm)); } \
    _Pragma("unroll") for(int r=0;r<16;++r)P0[r]=__builtin_amdgcn_exp2f(P0[r]); }while(0)
  #define RESC() do{ if(resc){ asm volatile("s_waitcnt lgkmcnt(0)":::"memory"); \
      _Pragma("unroll") for(int d_=0;d_<2;++d_) _Pragma("unroll") for(int r=0;r<16;++r)o[d_][r]*=wsf[crow(r,hi)]; } }while(0)
  f32x16 pA0,pA1,pB0,pB1;
  int sl_prev=0,sl_cur=0,sl_next=SLOTB;
  #define ROT() do{sl_prev=sl_cur;sl_cur=sl_next;sl_next=(sl_next==(NSLOT-1)*SLOTB)?0:sl_next+SLOTB;}while(0)
  DMA_K(2,2*SLOTB);
  WAIT_BAR(3);
  qkt(pA0,pA1,Kbase,qr,negm,r32,hi);asm volatile("s_nop 15\n\ts_nop 7":"+v"(pA0),"+v"(pA1));CMASK(pA0,pA1,0);
  START(pA0,pA1);
  _Pragma("unroll") for(int r=0;r<16;++r)pA1[r]=__builtin_amdgcn_exp2f(pA1[r]);
  WAIT_BAR(0);
  DMA_K(3,0);DMA_V(1,SLOTB);
  ROT();
  kload8(kf,kp0+sl_cur);
  WAIT_BAR(2);
  s16x4 vlo[8],vhi[8]; u32x4 pw0,pw1,pw2,pw3;
  #define PKW(P,B) cvtpk_s(P[B],P[B+1])
  #define PAF(k) __builtin_bit_cast(bf16x8,pw##k)
  #define VFR(i) (bf16x8){vlo[i][0],vlo[i][1],vlo[i][2],vlo[i][3],vhi[i][0],vhi[i][1],vhi[i][2],vhi[i][3]}
  #define PIN(x) asm volatile("":"+v"(x))
  #define MX3(a,b,c) __builtin_fmaxf(__builtin_fmaxf((a),(b)),(c))
  #define GAPA(MF,A0,A1,A2,A3,W0,W1,PW) do{ MF; sacc+=A0; sacc+=A1; sacc+=A2; sacc+=A3; PIN(sacc); W0; W1; PIN(PW); SBAR(); }while(0)
  #define EX(v) __builtin_amdgcn_exp2f(v)
  #define GAPB(MF,X,B) do{ MF; X[B]=EX(X[B]); X[B+1]=EX(X[B+1]); X[B+2]=EX(X[B+2]); X[B+3]=EX(X[B+3]); PIN(X); SBAR(); }while(0)
  #define VRD(i) do{ vlo[i]=vtr(vp_+(((i)>>2)*4096+((i)&3)*1024)); vhi[i]=vtr(vp_+(((i)>>2)*4096+((i)&3)*1024+512)); }while(0)
  #define KRD(G,j) do{ if(G){ kload2(kf,kp0+sl_next,j); SBAR(); } }while(0)
  #define STEP(C0,C1,P0,P1,t,GK,GV,GL) do{ SBAR(); \
    const lds_cptr vp_=vp0+sl_prev; \
    VRD(0); SBAR(); float sacc=(P0[0]+P0[1]); \
    GAPA(C0=__builtin_amdgcn_mfma_f32_32x32x16_bf16(kf[0],qr[0],negm,0,0,0), P0[2],P0[3],P0[4],P0[5],     pw0[0]=PKW(P0,0), pw0[1]=PKW(P0,2), pw0); \
    VRD(4); SBAR(); GAPA(C1=__builtin_amdgcn_mfma_f32_32x32x16_bf16(kf[1],qr[0],negm,0,0,0), P0[6],P0[7],P0[8],P0[9],     pw0[2]=PKW(P0,4), pw0[3]=PKW(P0,6), pw0); \
    VRD(1); SBAR(); GAPA(C0=__builtin_amdgcn_mfma_f32_32x32x16_bf16(kf[2],qr[1],C0,0,0,0),   P0[10],P0[11],P0[12],P0[13], pw1[0]=PKW(P0,8), pw1[1]=PKW(P0,10), pw1); \
    VRD(5); SBAR(); GAPA(C1=__builtin_amdgcn_mfma_f32_32x32x16_bf16(kf[3],qr[1],C1,0,0,0),   P0[14],P0[15],P1[0],P1[1],   pw1[2]=PKW(P0,12),pw1[3]=PKW(P0,14), pw1); \
    VRD(2); SBAR(); GAPA(C0=__builtin_amdgcn_mfma_f32_32x32x16_bf16(kf[4],qr[2],C0,0,0,0),   P1[2],P1[3],P1[4],P1[5],     pw2[0]=PKW(P1,0), pw2[1]=PKW(P1,2), pw2); \
    VRD(6); SBAR(); GAPA(C1=__builtin_amdgcn_mfma_f32_32x32x16_bf16(kf[5],qr[2],C1,0,0,0),   P1[6],P1[7],P1[8],P1[9],     pw2[2]=PKW(P1,4), pw2[3]=PKW(P1,6), pw2); \
    VRD(3); SBAR(); GAPA(C0=__builtin_amdgcn_mfma_f32_32x32x16_bf16(kf[6],qr[3],C0,0,0,0),   P1[10],P1[11],P1[12],P1[13], pw3[0]=PKW(P1,8), pw3[1]=PKW(P1,10), pw3); \
    VRD(7); SBAR(); GAPA(C1=__builtin_amdgcn_mfma_f32_32x32x16_bf16(kf[7],qr[3],C1,0,0,0),   P1[14],P1[15],0.f,0.f,       pw3[2]=PKW(P1,12),pw3[3]=PKW(P1,14), pw3); \
    l_reg+=sacc; \
    if(GK){DMA_K((t)+3,sl_cur);} if(GV){DMA_V((t)+1,sl_next);} \
    CMASK(C0,C1,t); \
    { float a=MX3(C0[0],C0[1],C1[0]),b=MX3(C0[2],C0[3],C1[1]); a=MX3(a,C1[2],C1[3]); \
      _Pragma("unroll") for(int r=4;r<16;r+=4){a=MX3(a,C0[r],C0[r+1]);b=MX3(b,C0[r+2],C0[r+3]);a=MX3(a,C1[r],C1[r+1]);b=MX3(b,C1[r+2],C1[r+3]);} \
      float rm=__builtin_fmaxf(a,b); { auto rr=__builtin_amdgcn_permlane32_swap(__float_as_uint(rm),__float_as_uint(rm),false,false); rm=__builtin_fmaxf(__uint_as_float(rr[0]),__uint_as_float(rr[1])); } \
      resc=false; \
      if(__builtin_expect(__any(rm>(float)THRL),0)){ const float dl=__builtin_fmaxf(rm,0.f); mhat+=dl; \
        _Pragma("unroll") for(int r=0;r<16;++r){C0[r]-=dl;C1[r]-=dl;} \
        _Pragma("unroll") for(int r=0;r<16;++r)negm[r]=-mhat; asm volatile("":"+v"(negm)); \
        const float f=__builtin_amdgcn_exp2f(-dl); l_reg*=f; if(hi==0)wsf[r32]=f; resc=true; } } \
    SBAR(); \
    GAPB(o[0]=__builtin_amdgcn_mfma_f32_32x32x16_bf16(PAF(0),VFR(0),o[0],0,0,0), C0,0); \
    GAPB(o[1]=__builtin_amdgcn_mfma_f32_32x32x16_bf16(PAF(0),VFR(4),o[1],0,0,0), C0,4); \
    KRD(GL,0); GAPB(o[0]=__builtin_amdgcn_mfma_f32_32x32x16_bf16(PAF(1),VFR(1),o[0],0,0,0), C0,8); \
    KRD(GL,1); GAPB(o[1]=__builtin_amdgcn_mfma_f32_32x32x16_bf16(PAF(1),VFR(5),o[1],0,0,0), C0,12); \
    KRD(GL,2); GAPB(o[0]=__builtin_amdgcn_mfma_f32_32x32x16_bf16(PAF(2),VFR(2),o[0],0,0,0), C1,0); \
    KRD(GL,3); GAPB(o[1]=__builtin_amdgcn_mfma_f32_32x32x16_bf16(PAF(2),VFR(6),o[1],0,0,0), C1,4); \
    GAPB(o[0]=__builtin_amdgcn_mfma_f32_32x32x16_bf16(PAF(3),VFR(3),o[0],0,0,0), C1,8); \
    GAPB(o[1]=__builtin_amdgcn_mfma_f32_32x32x16_bf16(PAF(3),VFR(7),o[1],0,0,0), C1,12); \
    }while(0)
  int t=1;
  #undef CMASK
  #define CMASK(P0,P1,t) do{}while(0)
  for(;t+5<NT;t+=2){
    STEP(pB0,pB1,pA0,pA1,t,true,true,true);     WAIT_BAR(2); RESC(); ROT();
    STEP(pA0,pA1,pB0,pB1,t+1,true,true,true);   WAIT_BAR(2); RESC(); ROT();
  }
  #undef CMASK
  #define CMASK(P0,P1,t) do{}while(0)
  #define ENDW(tt) do{ if((tt)+3<NT){WAIT_BAR(2);} else if((tt)+2<NT){WAIT_BAR(1);} else {WAIT_BAR(0);} }while(0)
  for(;t+1<NT;t+=2){
    STEP(pB0,pB1,pA0,pA1,t,(t+3<NT),(t+1<NT),(t+1<NT));       ENDW(t);   RESC(); ROT();
    STEP(pA0,pA1,pB0,pB1,t+1,(t+4<NT),(t+2<NT),(t+2<NT));     ENDW(t+1); RESC(); ROT();
  }
  STEP(pB0,pB1,pA0,pA1,NT-1,false,false,false); RESC();
  { float sacc=pB0[0]+pB0[1]; _Pragma("unroll") for(int r=2;r<16;++r)sacc+=pB0[r]; _Pragma("unroll") for(int r=0;r<16;++r)sacc+=pB1[r]; l_reg+=sacc;
    pw0=(u32x4){PKW(pB0,0),PKW(pB0,2),PKW(pB0,4),PKW(pB0,6)};pw1=(u32x4){PKW(pB0,8),PKW(pB0,10),PKW(pB0,12),PKW(pB0,14)};pw2=(u32x4){PKW(pB1,0),PKW(pB1,2),PKW(pB1,4),PKW(pB1,6)};pw3=(u32x4){PKW(pB1,8),PKW(pB1,10),PKW(pB1,12),PKW(pB1,14)};
    SBAR(); pv(o,vb0+sl_cur,PAF(0),PAF(1),PAF(2),PAF(3)); }
  #undef PKW
  #undef PAF
  #undef VFR
  #undef PIN
  #undef MX3
  #undef GAPA
  #undef GAPB
  #undef EX
  #undef VRD
  #undef KRD
  #undef STEP
  #undef ENDW
  {auto rr=__builtin_amdgcn_permlane32_swap(__float_as_uint(l_reg),__float_as_uint(l_reg),false,false);l_reg=__uint_as_float(rr[0])+__uint_as_float(rr[1]);}
  if(hi==0)wsf[32+r32]=l_reg;asm volatile("s_waitcnt lgkmcnt(0)":::"memory");
  float rli[16];
  #pragma unroll
  for(int r=0;r<16;++r)rli[r]=__builtin_amdgcn_rcpf(wsf[32+crow(r,hi)]);
  bf16*Ow=Ow0+(long)(wid*QBLK)*OP;
  { bf16*stg=(bf16*)(shm+LDS_OST)+wid*2048;
    #pragma unroll
    for(int r=0;r<16;++r){const int orow=crow(r,hi);
      #pragma unroll
      for(int d0=0;d0<2;++d0)stg[orow*64+d0*32+r32]=__float2bfloat16(o[d0][r]*rli[r]);}
    asm volatile("s_waitcnt lgkmcnt(0)":::"memory");
    #pragma unroll
    for(int i=0;i<4;++i){const int row=i*8+(lane>>3),ch=lane&7; const u32x4 v=*(const u32x4*)(stg+row*64+ch*8); ATTN_STORE16(Ow+(long)row*OP+ch*8,v);} }
  asm volatile("s_waitcnt lgkmcnt(0)\n\ts_barrier":::"memory");
  #undef DMA_K
  #undef DMA_V
  #undef CMASK
  #undef START
  #undef RESC
  #undef ROT
}
constexpr int ATTN_LDS_BYTES=LDS_BYTES;
#undef SBAR
#undef WAIT_BAR
}

template <bool PAIRED, class AL, class BL, class EP>
__device__ __forceinline__ void gemm_f32(int groups, int M, int N, int K, const AL& al, const BL& bl, const EP& ep) {
    const int tid = threadIdx.x, lane = tid & 63, wave = tid >> 6, wm = wave >> 2, wn = wave & 3, r32 = lane & 31, h = lane >> 5;
    constexpr int TN = PAIRED ? 128 : 256;
    const int tilesM = M / 128, tilesN = N / TN, per = tilesM * tilesN, total = groups * per;
    const int ldb = bl.ldb;
    for (int t = blockIdx.x; t < total; t += gridDim.x) {
        const int g = t / per, r = t - g * per, tm = r / tilesN, tn = r - tm * tilesN;
        const int m0 = tm * 128 + wm * 64;
        const int n0 = PAIRED ? (tn * 128 + wn * 32) : (tn * 256 + wn * 64);
        const float* a0 = al.row(g, m0 + r32) + 4 * h;
        const float* a1 = al.row(g, m0 + 32 + r32) + 4 * h;
        const float* b0 = bl.ptr(g, 0) + n0 + r32 + (size_t)(4 * h) * ldb;
        const float* b1 = (PAIRED ? bl.ptr(g, 1) + n0 : bl.ptr(g, 0) + n0 + 32) + r32 + (size_t)(4 * h) * ldb;
        f32x16 acc00 = {}, acc01 = {}, acc10 = {}, acc11 = {};
#pragma unroll 2
        for (int k = 0; k < K; k += 8) {
            const f32x4 av0 = *(const f32x4*)(a0 + k), av1 = *(const f32x4*)(a1 + k);
            float bv0[4], bv1[4];
#pragma unroll
            for (int s = 0; s < 4; ++s) { bv0[s] = b0[(size_t)(k + s) * ldb]; bv1[s] = b1[(size_t)(k + s) * ldb]; }
#pragma unroll
            for (int s = 0; s < 4; ++s) {
                acc00 = __builtin_amdgcn_mfma_f32_32x32x2f32(av0[s], bv0[s], acc00, 0, 0, 0);
                acc01 = __builtin_amdgcn_mfma_f32_32x32x2f32(av0[s], bv1[s], acc01, 0, 0, 0);
                acc10 = __builtin_amdgcn_mfma_f32_32x32x2f32(av1[s], bv0[s], acc10, 0, 0, 0);
                acc11 = __builtin_amdgcn_mfma_f32_32x32x2f32(av1[s], bv1[s], acc11, 0, 0, 0);
            }
        }
#pragma unroll
        for (int rr = 0; rr < 16; ++rr) {
            const int ro = (rr & 3) + 8 * (rr >> 2) + 4 * h;
            if (PAIRED) {
                ep(g, m0 + ro, n0 + r32, acc00[rr], acc01[rr]);
                ep(g, m0 + 32 + ro, n0 + r32, acc10[rr], acc11[rr]);
            } else {
                ep(g, m0 + ro, n0 + r32, acc00[rr], 0.f); ep(g, m0 + ro, n0 + 32 + r32, acc01[rr], 0.f);
                ep(g, m0 + 32 + ro, n0 + r32, acc10[rr], 0.f); ep(g, m0 + 32 + ro, n0 + 32 + r32, acc11[rr], 0.f);
            }
        }
    }
}

__device__ __forceinline__ void phase_pro(const Ctx& c, LAS float* ldsf) {
    float* rope = (float*)(c.ws + WS_ROPE);
    for (int i = c.gt; i < 64 * 16; i += c.ngt) {
        const int pos = i >> 4, fi = i & 15; const float inv = powf(10000.0f, -(float)fi / 16.0f), ang = (float)pos * inv;
        rope[2 * i] = cosf(ang); rope[2 * i + 1] = sinf(ang);
    }
    LAS float* sil = ldsf; LAS float* red = ldsf + 9 * 1024;
    for (int i = c.tid; i < 9 * 1024; i += 512) { const int j = i >> 10, k = i & 1023; const float v = (j < 8) ? c.in[IN_C][j * 1024 + k] : c.in[IN_CCTX][k]; sil[i] = siluf_(v); }
    __syncthreads();
    float* MOD = (float*)(c.ws + WS_MOD);
    for (int task = blockIdx.x; task < DEPTH * 96; task += gridDim.x) {
        const int L = task / 96, cb = task - L * 96, col = cb * 64 + c.lane;
        const float* W = c.in[IN_MODW] + (size_t)L * 1024 * 6144;
        float acc[9];
#pragma unroll
        for (int j = 0; j < 9; ++j) acc[j] = 0.f;
        const int k0 = c.wave * 128;
#pragma unroll 4
        for (int k = k0; k < k0 + 128; ++k) { const float w = W[(size_t)k * 6144 + col];
#pragma unroll
            for (int j = 0; j < 9; ++j) acc[j] += sil[j * 1024 + k] * w; }
#pragma unroll
        for (int j = 0; j < 9; ++j) red[(c.wave * 9 + j) * 64 + c.lane] = acc[j];
        __syncthreads();
        if (c.wave == 0) {
            const float bias = c.in[IN_MODB][L * 6144 + col];
#pragma unroll
            for (int j = 0; j < 9; ++j) { float s = bias;
#pragma unroll
                for (int w = 0; w < 8; ++w) s += red[(w * 9 + j) * 64 + c.lane];
                MOD[(size_t)(L * 9 + j) * 6144 + col] = s; }
        }
        __syncthreads();
    }
    float* X = (float*)(c.ws + WS_X);
    for (int r = c.gw; r < NROWS; r += c.ngw) {
        const int b = r / RB, s = r - b * RB;
        const float* src = (s < CL) ? c.in[IN_CTX] + (size_t)(b * CL + s) * D : c.in[IN_X] + (size_t)(b * T + s - CL) * D;
        const f32x4* sp = (const f32x4*)src + c.lane; f32x4* dp = (f32x4*)(X + (size_t)r * D) + c.lane;
#pragma unroll
        for (int j = 0; j < 4; ++j) dp[64 * j] = sp[64 * j];
    }
}

template <bool FINAL, bool GM>
__device__ __forceinline__ void phase_norm1(const Ctx& c, int L) {
    float* X = (float*)(c.ws + WS_X);
    const int* SLOT = (const int*)(c.ws + WS_SLOT); const unsigned short* Y = (const unsigned short*)(c.ws + WS_Y);
    int ch[4];
#pragma unroll
    for (int q = 0; q < 4; ++q) ch[q] = GM ? 16 * c.lane + 4 * q : 4 * (c.lane + 64 * q);
    for (int r = c.gw; r < NROWS; r += c.ngw) {
        const int b = r / RB, s = r - b * RB, j = s < CL ? 8 : b;
        if (FINAL && s < CL) continue;
        float* xr = X + (size_t)r * D;
        f32x4 v[4];
#pragma unroll
        for (int q = 0; q < 4; ++q) v[q] = *(const f32x4*)(xr + ch[q]);
        if (L > 0) {
            f32x4 sum[4] = {};
            for (int e = 0; e < NE; ++e) {
                const int sp = SLOT[(size_t)r * NE + e];
                if (sp >= 0) { const unsigned short* yr = Y + ((size_t)e * EROWS + sp) * D;
#pragma unroll
                    for (int q = 0; q < 4; ++q) { const pg8::u32x2 w = *(const pg8::u32x2*)(yr + ch[q]);
                        sum[q] += (f32x4){__uint_as_float(w.x << 16), __uint_as_float(w.x & 0xffff0000u), __uint_as_float(w.y << 16), __uint_as_float(w.y & 0xffff0000u)}; } }
            }
            const float* g2 = modp(c, L - 1, j, 5);
#pragma unroll
            for (int q = 0; q < 4; ++q) { v[q] += *(const f32x4*)(g2 + ch[q]) * sum[q]; if (!FINAL) *(f32x4*)(xr + ch[q]) = v[q]; }
        }
        float ss = 0.f;
#pragma unroll
        for (int q = 0; q < 4; ++q) ss += v[q].x * v[q].x + v[q].y * v[q].y + v[q].z * v[q].z + v[q].w * v[q].w;
        const float rstd = rsqrtf(wave_sum(ss) * (1.0f / D) + EPS);
        if (FINAL) {
            const float* g = c.in[IN_FNG]; float* op = c.out + (size_t)(b * T + s - CL) * D;
#pragma unroll
            for (int q = 0; q < 4; ++q) *(f32x4*)(op + ch[q]) = v[q] * rstd * *(const f32x4*)(g + ch[q]);
        } else {
            const float* g = c.in[IN_NORMG] + (size_t)(L * 2 + 0) * D; const float* sc = modp(c, L, j, 1); const float* sh = modp(c, L, j, 0);
            unsigned hw[8];
#pragma unroll
            for (int q = 0; q < 4; ++q) { const f32x4 hv = v[q] * rstd * *(const f32x4*)(g + ch[q]) * (1.0f + *(const f32x4*)(sc + ch[q])) + *(const f32x4*)(sh + ch[q]);
                hw[2 * q] = pg8::cvt_pk_bf16(hv.x, hv.y); hw[2 * q + 1] = pg8::cvt_pk_bf16(hv.z, hv.w); }
            if (GM) { unsigned short* o = (unsigned short*)(c.ws + WS_AS5) + ((size_t)c.lane * 1280 + (r >> 5)) * 768 + (r & 31) * 16;
                *(pg8::u32x4*)o = (pg8::u32x4){hw[0], hw[1], hw[2], hw[3]}; *(pg8::u32x4*)(o + 8) = (pg8::u32x4){hw[4], hw[5], hw[6], hw[7]}; }
            else { unsigned short* o = (unsigned short*)(c.ws + WS_HB1) + (size_t)r * D;
#pragma unroll
                for (int q = 0; q < 4; ++q) *(pg8::u32x2*)(o + ch[q]) = (pg8::u32x2){hw[2 * q], hw[2 * q + 1]}; }
        }
    }
}

__device__ __forceinline__ void phase_norm2_router(const Ctx& c, int L) {
    const float* X = (const float*)(c.ws + WS_X); unsigned short* HB = (unsigned short*)(c.ws + WS_HB); float* AFF = (float*)(c.ws + WS_AFF);
    const float* WR = c.in[IN_ROUTER] + (size_t)L * D * NE;
    for (int r = c.gw; r < NROWS; r += c.ngw) {
        const int j = row_j(r);
        const f32x4* xp = (const f32x4*)(X + (size_t)r * D) + c.lane;
        f32x4 v[4]; float ss = 0.f;
#pragma unroll
        for (int q = 0; q < 4; ++q) { v[q] = xp[64 * q]; ss += v[q].x * v[q].x + v[q].y * v[q].y + v[q].z * v[q].z + v[q].w * v[q].w; }
        const float rstd = rsqrtf(wave_sum(ss) * (1.0f / D) + EPS);
        const f32x4* g = (const f32x4*)(c.in[IN_NORMG] + (size_t)(L * 2 + 1) * D) + c.lane;
        const f32x4* sc = (const f32x4*)modp(c, L, j, 4) + c.lane; const f32x4* sh = (const f32x4*)modp(c, L, j, 3) + c.lane;
        pg8::u32x2* hp = (pg8::u32x2*)(HB + (size_t)r * D) + c.lane;
        float lg[16];
#pragma unroll
        for (int e = 0; e < 16; ++e) lg[e] = 0.f;
#pragma unroll
        for (int q = 0; q < 4; ++q) {
            const f32x4 f = v[q] * rstd * g[64 * q] * (1.0f + sc[64 * q]) + sh[64 * q];
            hp[64 * q] = (pg8::u32x2){pg8::cvt_pk_bf16(f.x, f.y), pg8::cvt_pk_bf16(f.z, f.w)};
            const float* w = WR + (size_t)(4 * (c.lane + 64 * q)) * NE;
#pragma unroll
            for (int i = 0; i < 4; ++i) {
#pragma unroll
                for (int e4 = 0; e4 < 4; ++e4) { const f32x4 wv = *(const f32x4*)(w + i * NE + 4 * e4);
                    lg[4 * e4 + 0] += f[i] * wv.x; lg[4 * e4 + 1] += f[i] * wv.y; lg[4 * e4 + 2] += f[i] * wv.z; lg[4 * e4 + 3] += f[i] * wv.w; }
            }
        }
        const float mine = reduce16(lg, c.lane);
        const int k = reduce16_k(c.lane);
        float mx = mine;
#pragma unroll
        for (int o = 4; o < 64; o <<= 1) mx = fmaxf(mx, __shfl_xor(mx, o));
        const float ex = expf(mine - mx);
        float den = ex;
#pragma unroll
        for (int o = 4; o < 64; o <<= 1) den += __shfl_xor(den, o);
        if ((c.lane & 3) == 0) AFF[(size_t)r * NE + k] = ex / den;
    }
}

__device__ __forceinline__ void phase_topk(const Ctx& c, LAS float* vals) {
    const float* AFF = (const float*)(c.ws + WS_AFF);
    int* SELROW = (int*)(c.ws + WS_SELROW); float* SELGATE = (float*)(c.ws + WS_SELGATE); int* SLOT = (int*)(c.ws + WS_SLOT);
    for (int pid = blockIdx.x; pid < 256; pid += gridDim.x) {
        const bool lat = pid < 128; const int q = lat ? pid : pid - 128, b = q >> 4, e = q & 15;
        const int N = lat ? T : CL, C = lat ? CAP_LAT : CAP_CTX, row0 = b * RB + (lat ? CL : 0), base = lat ? b * CAP_LAT : NB * CAP_LAT + b * CAP_CTX;
        __syncthreads();
        for (int t = c.tid; t < N; t += 512) vals[t] = AFF[(size_t)(row0 + t) * NE + e];
        __syncthreads();
        if (lat) {
            float a[8]; int rk[8];
#pragma unroll
            for (int i = 0; i < 8; ++i) { a[i] = vals[c.tid + 512 * i]; rk[i] = 0; }
            for (int u = 0; u < N; ++u) { const float w = vals[u];
#pragma unroll
                for (int i = 0; i < 8; ++i) rk[i] += (w > a[i] || (w == a[i] && u < c.tid + 512 * i)) ? 1 : 0; }
#pragma unroll
            for (int i = 0; i < 8; ++i) { const int t = c.tid + 512 * i, row = row0 + t;
                if (rk[i] < C) { const int sp = base + rk[i]; SELROW[e * EROWS + sp] = row; SELGATE[e * EROWS + sp] = a[i]; SLOT[(size_t)row * NE + e] = sp; }
                else SLOT[(size_t)row * NE + e] = -1; }
        } else if (c.tid < N) {
            const float a = vals[c.tid]; int rk = 0;
            for (int u = 0; u < N; ++u) { const float w = vals[u]; rk += (w > a || (w == a && u < c.tid)) ? 1 : 0; }
            const int row = row0 + c.tid;
            if (rk < C) { const int sp = base + rk; SELROW[e * EROWS + sp] = row; SELGATE[e * EROWS + sp] = a; SLOT[(size_t)row * NE + e] = sp; }
            else SLOT[(size_t)row * NE + e] = -1;
        }
    }
}

__device__ __forceinline__ void phase_postproj(const Ctx& c, int i) {
    float* P = (float*)(c.ws + WS_P); const float* rope = (const float*)(c.ws + WS_ROPE);
    unsigned short* QA = (unsigned short*)(c.ws + WS_QA); unsigned short* KA = (unsigned short*)(c.ws + WS_KA); unsigned short* VA = (unsigned short*)(c.ws + WS_VA);
    unsigned short* RQ = (unsigned short*)(c.ws + WS_RQ); unsigned short* RK = (unsigned short*)(c.ws + WS_RK); unsigned short* RV = (unsigned short*)(c.ws + WS_RV);
    const float* qkg = c.in[IN_QKG] + (size_t)i * 2 * 64;
    for (int job = c.gt; job < NROWS * 36; job += c.ngt) {
        const int row = job / 36, hj = job - row * 36; const int s = row % RB;
        int col0, type; unsigned short* dst = nullptr;
        if (hj >= 28) { col0 = 1024 + (hj - 28) * 64; type = 4; dst = RV + (size_t)row * 512 + (hj - 28) * 64; }
        else if (hj < 8) { col0 = hj * 64; type = 0; dst = RQ + (size_t)row * 512 + hj * 64; } else if (hj < 16) { col0 = 512 + (hj - 8) * 64; type = 1; dst = RK + (size_t)row * 512 + (hj - 8) * 64; }
        else if (hj < 24) { col0 = 2048 + (hj - 16) * 64; type = 2; dst = QA + (size_t)row * 512 + (hj - 16) * 64; }
        else if (hj < 26) { col0 = 2560 + (hj - 24) * 64; type = 3; dst = KA + (size_t)row * 128 + (hj - 24) * 64; }
        else { col0 = 2688 + (hj - 26) * 64; type = 4; dst = VA + (size_t)row * 128 + (hj - 26) * 64; }
        f32x4* p = (f32x4*)(P + (size_t)row * INW + col0);
        float v[64];
#pragma unroll
        for (int q = 0; q < 16; ++q) { const f32x4 t4 = p[q]; v[4 * q] = t4.x; v[4 * q + 1] = t4.y; v[4 * q + 2] = t4.z; v[4 * q + 3] = t4.w; }
        if (type == 1) {
#pragma unroll
            for (int d = 0; d < 64; ++d) v[d] *= 0.125f;
        }
        if (type == 2 || type == 3) {
            float ss = 0.f;
#pragma unroll
            for (int d = 0; d < 64; ++d) ss += v[d] * v[d];
            const float rs = rsqrtf(ss * (1.0f / 64.0f) + EPS); const float* g = qkg + (type - 2) * 64;
#pragma unroll
            for (int d = 0; d < 64; ++d) v[d] = v[d] * rs * g[d];
        }
        if (s >= CL && type != 4) {
            const int t = s - CL, pr = t >> 6, pc = t & 63;
#pragma unroll
            for (int f = 0; f < 16; ++f) {
                const float cr = rope[2 * (pr * 16 + f)], sr = rope[2 * (pr * 16 + f) + 1], cc = rope[2 * (pc * 16 + f)], sc = rope[2 * (pc * 16 + f) + 1];
                const float x1 = v[f], x2 = v[16 + f], y1 = v[32 + f], y2 = v[48 + f];
                v[f] = x1 * cr - x2 * sr; v[16 + f] = x1 * sr + x2 * cr; v[32 + f] = y1 * cc - y2 * sc; v[48 + f] = y1 * sc + y2 * cc;
            }
        }
        {
            const float sc = (type == 2) ? attn_body::C2 : 1.0f;
#pragma unroll
            for (int q = 0; q < 8; ++q) { pg8::u32x4 w; w.x = pg8::cvt_pk_bf16(v[8 * q] * sc, v[8 * q + 1] * sc); w.y = pg8::cvt_pk_bf16(v[8 * q + 2] * sc, v[8 * q + 3] * sc);
                w.z = pg8::cvt_pk_bf16(v[8 * q + 4] * sc, v[8 * q + 5] * sc); w.w = pg8::cvt_pk_bf16(v[8 * q + 6] * sc, v[8 * q + 7] * sc); ((pg8::u32x4*)dst)[q] = w; }
        }
    }
}

__device__ __forceinline__ void phase_ret_state(const Ctx& c, int i, LAS float* ldsf) {
    const unsigned short* RK = (const unsigned short*)(c.ws + WS_RK); const unsigned short* RV = (const unsigned short*)(c.ws + WS_RV); float* U = (float*)(c.ws + WS_U);
    LAS float* Ks = ldsf; LAS float* Vs = ldsf + 128 * 64; LAS float* wf = ldsf + 2 * 128 * 64; LAS float* wb = wf + 128;
    for (int unit = blockIdx.x; unit < 64 * 34; unit += gridDim.x) {
        const int bh = unit / 34, cch = unit - bh * 34, b = bh >> 3, hh = bh & 7, row0 = b * RB + cch * 128;
        const float lgf = -expf(c.in[IN_RETRATE][(i * 2 + 0) * 8 + hh]) * 1.4426950408889634f, lgb = -expf(c.in[IN_RETRATE][(i * 2 + 1) * 8 + hh]) * 1.4426950408889634f;
        __syncthreads();
        for (int pc = c.tid; pc < 1024; pc += 512) { const int r = pc >> 3, ch = pc & 7;
            const pg8::u32x4 kw = *(const pg8::u32x4*)(RK + (size_t)(row0 + r) * 512 + hh * 64 + ch * 8), vw = *(const pg8::u32x4*)(RV + (size_t)(row0 + r) * 512 + hh * 64 + ch * 8);
#pragma unroll
            for (int e = 0; e < 4; ++e) { Ks[r * 64 + ch * 8 + 2 * e] = __uint_as_float(kw[e] << 16); Ks[r * 64 + ch * 8 + 2 * e + 1] = __uint_as_float(kw[e] & 0xffff0000u);
                Vs[r * 64 + ch * 8 + 2 * e] = __uint_as_float(vw[e] << 16); Vs[r * 64 + ch * 8 + 2 * e + 1] = __uint_as_float(vw[e] & 0xffff0000u); } }
        if (c.tid < 128) { wf[c.tid] = exp2f(lgf * (float)(127 - c.tid)); wb[c.tid] = exp2f(lgb * (float)c.tid); }
        __syncthreads();
        const int dv = c.tid & 63, dkg = c.tid >> 6;
        float uf[8], ub[8];
#pragma unroll
        for (int q = 0; q < 8; ++q) { uf[q] = 0.f; ub[q] = 0.f; }
#pragma unroll 4
        for (int j = 0; j < 128; ++j) {
            const float v = Vs[j * 64 + dv], vf = v * wf[j], vb = v * wb[j];
            const f32x4 k0 = *(const LAS f32x4*)(Ks + j * 64 + dkg * 8), k1 = *(const LAS f32x4*)(Ks + j * 64 + dkg * 8 + 4);
            uf[0] += k0.x * vf; uf[1] += k0.y * vf; uf[2] += k0.z * vf; uf[3] += k0.w * vf; uf[4] += k1.x * vf; uf[5] += k1.y * vf; uf[6] += k1.z * vf; uf[7] += k1.w * vf;
            ub[0] += k0.x * vb; ub[1] += k0.y * vb; ub[2] += k0.z * vb; ub[3] += k0.w * vb; ub[4] += k1.x * vb; ub[5] += k1.y * vb; ub[6] += k1.z * vb; ub[7] += k1.w * vb;
        }
        float* uo = U + ((size_t)(bh * 34 + cch) * 2) * 4096 + dv * 64 + dkg * 8;
        *(f32x4*)uo = (f32x4){uf[0], uf[1], uf[2], uf[3]}; *(f32x4*)(uo + 4) = (f32x4){uf[4], uf[5], uf[6], uf[7]};
        *(f32x4*)(uo + 4096) = (f32x4){ub[0], ub[1], ub[2], ub[3]}; *(f32x4*)(uo + 4096 + 4) = (f32x4){ub[4], ub[5], ub[6], ub[7]};
    }
}
__device__ __forceinline__ void phase_ret_prefix(const Ctx& c, int i) {
    const float* U = (const float*)(c.ws + WS_U); unsigned short* ET = (unsigned short*)(c.ws + WS_ET);
    for (int chain = c.gt; chain < 64 * 2 * 4096; chain += c.ngt) {
        const int bh = chain >> 13, dir = (chain >> 12) & 1, el = chain & 4095, hh = bh & 7;
        const float g128 = expf(-expf(c.in[IN_RETRATE][(i * 2 + dir) * 8 + hh]) * 128.0f);
        float S = 0.f;
#pragma unroll
        for (int st = 0; st < 34; ++st) {
            const int cch = dir == 0 ? st : (st < 2 ? 1 - st : 35 - st);
            const size_t o = ((size_t)(bh * 34 + cch) * 2 + dir) * 4096 + el;
            ET[o] = (unsigned short)(pg8::cvt_pk_bf16(S, 0.f) & 0xffffu);
            S = g128 * S + U[o];
        }
    }
}
__device__ __forceinline__ void phase_ret_main(const Ctx& c, int i, LAS unsigned char* lds) {
    typedef pg8::bf16x8 bf16x8;
    const unsigned short* RQ = (const unsigned short*)(c.ws + WS_RQ); const unsigned short* RK = (const unsigned short*)(c.ws + WS_RK); const unsigned short* RV = (const unsigned short*)(c.ws + WS_RV);
    const unsigned short* ET = (const unsigned short*)(c.ws + WS_ET); const float* P = (const float*)(c.ws + WS_P); unsigned short* MIX = (unsigned short*)(c.ws + WS_MIX);
    const float* gn = c.in[IN_RETGN] + (size_t)i * 512;
    constexpr int QS = 0, KS = 18432, VTS = 36864, EF = 54272, EB = 63488;
    const int li = c.lane & 15, q4 = c.lane >> 4, i0 = 16 * c.wave, ig = i0 + li;
    for (int unit = blockIdx.x; unit < 64 * 34; unit += gridDim.x) {
        const int bh = unit / 34, cch = unit - bh * 34, b = bh >> 3, hh = bh & 7, row0 = b * RB + cch * 128;
        const float lgf = -expf(c.in[IN_RETRATE][(i * 2 + 0) * 8 + hh]) * 1.4426950408889634f, lgb = -expf(c.in[IN_RETRATE][(i * 2 + 1) * 8 + hh]) * 1.4426950408889634f;
        __syncthreads();
        for (int pc = c.tid; pc < 1024; pc += 512) { const int r = pc >> 3, ch = pc & 7; const size_t go = (size_t)(row0 + r) * 512 + hh * 64 + ch * 8;
            *(LAS pg8::u32x4*)(lds + QS + r * 144 + ch * 16) = *(const pg8::u32x4*)(RQ + go);
            *(LAS pg8::u32x4*)(lds + KS + r * 144 + ch * 16) = *(const pg8::u32x4*)(RK + go);
            const pg8::u32x4 vw = *(const pg8::u32x4*)(RV + go);
#pragma unroll
            for (int e = 0; e < 4; ++e) { *(LAS unsigned short*)(lds + VTS + (ch * 8 + 2 * e) * 272 + r * 2) = (unsigned short)(vw[e] & 0xffffu); *(LAS unsigned short*)(lds + VTS + (ch * 8 + 2 * e + 1) * 272 + r * 2) = (unsigned short)(vw[e] >> 16); } }
        { const int r = c.tid >> 3, ch = c.tid & 7; const size_t go = ((size_t)(bh * 34 + cch) * 2) * 4096 + r * 64 + ch * 8;
            *(LAS pg8::u32x4*)(lds + EF + r * 144 + ch * 16) = *(const pg8::u32x4*)(ET + go); *(LAS pg8::u32x4*)(lds + EB + r * 144 + ch * 16) = *(const pg8::u32x4*)(ET + go + 4096); }
        __syncthreads();
        bf16x8 qf[2];
#pragma unroll
        for (int s = 0; s < 2; ++s) qf[s] = *(const LAS bf16x8*)(lds + QS + (i0 + li) * 144 + (32 * s + 8 * q4) * 2);
        pg8::u32x2 pk[8];
#pragma unroll
        for (int jt = 0; jt < 8; ++jt) {
            f32x4 a = {0.f, 0.f, 0.f, 0.f};
#pragma unroll
            for (int s = 0; s < 2; ++s) { const bf16x8 kf = *(const LAS bf16x8*)(lds + KS + (16 * jt + li) * 144 + (32 * s + 8 * q4) * 2); a = __builtin_amdgcn_mfma_f32_16x16x32_bf16(kf, qf[s], a, 0, 0, 0); }
            float pv[4];
#pragma unroll
            for (int r = 0; r < 4; ++r) { const int dl = ig - (16 * jt + 4 * q4 + r); const float w = dl >= 0 ? exp2f(lgf * (float)dl) : exp2f(lgb * (float)(-dl)); pv[r] = a[r] * w; }
            pk[jt] = (pg8::u32x2){pg8::cvt_pk_bf16(pv[0], pv[1]), pg8::cvt_pk_bf16(pv[2], pv[3])};
        }
        const float sf = exp2f(lgf * (float)(ig + 1)), sb = exp2f(lgb * (float)(128 - ig));
        f32x4 oacc[4];
#pragma unroll
        for (int dvt = 0; dvt < 4; ++dvt) {
            f32x4 o = {0.f, 0.f, 0.f, 0.f};
#pragma unroll
            for (int u = 0; u < 4; ++u) {
                const pg8::u32x2 vlo = *(const LAS pg8::u32x2*)(lds + VTS + (16 * dvt + li) * 272 + (32 * u + 4 * q4) * 2), vhi = *(const LAS pg8::u32x2*)(lds + VTS + (16 * dvt + li) * 272 + (32 * u + 16 + 4 * q4) * 2);
                const pg8::u32x4 av = {vlo.x, vlo.y, vhi.x, vhi.y}, bv = {pk[2 * u].x, pk[2 * u].y, pk[2 * u + 1].x, pk[2 * u + 1].y};
                o = __builtin_amdgcn_mfma_f32_16x16x32_bf16(__builtin_bit_cast(bf16x8, av), __builtin_bit_cast(bf16x8, bv), o, 0, 0, 0);
            }
            f32x4 tf = {0.f, 0.f, 0.f, 0.f}, tb = {0.f, 0.f, 0.f, 0.f};
#pragma unroll
            for (int s = 0; s < 2; ++s) {
                const bf16x8 ef = *(const LAS bf16x8*)(lds + EF + (16 * dvt + li) * 144 + (32 * s + 8 * q4) * 2), eb = *(const LAS bf16x8*)(lds + EB + (16 * dvt + li) * 144 + (32 * s + 8 * q4) * 2);
                tf = __builtin_amdgcn_mfma_f32_16x16x32_bf16(ef, qf[s], tf, 0, 0, 0); tb = __builtin_amdgcn_mfma_f32_16x16x32_bf16(eb, qf[s], tb, 0, 0, 0);
            }
            oacc[dvt] = o + tf * sf + tb * sb;
        }
        float sm = 0.f;
#pragma unroll
        for (int dvt = 0; dvt < 4; ++dvt) sm += (oacc[dvt].x + oacc[dvt].y) + (oacc[dvt].z + oacc[dvt].w);
        sm += __shfl_xor(sm, 16); sm += __shfl_xor(sm, 32);
        const float mu = sm * (1.0f / 64.0f); float vr = 0.f;
#pragma unroll
        for (int dvt = 0; dvt < 4; ++dvt) { oacc[dvt] = oacc[dvt] - mu; vr += (oacc[dvt].x * oacc[dvt].x + oacc[dvt].y * oacc[dvt].y) + (oacc[dvt].z * oacc[dvt].z + oacc[dvt].w * oacc[dvt].w); }
        vr += __shfl_xor(vr, 16); vr += __shfl_xor(vr, 32);
        const float rs = rsqrtf(vr * (1.0f / 64.0f) + EPS);
        const size_t row = (size_t)(row0 + ig);
#pragma unroll
        for (int dvt = 0; dvt < 4; ++dvt) { const int dvc = hh * 64 + 16 * dvt + 4 * q4;
            const f32x4 gt = *(const f32x4*)(P + row * INW + 1536 + dvc), gg = *(const f32x4*)(gn + dvc); const f32x4 y = oacc[dvt] * rs * gg;
            *(pg8::u32x2*)(MIX + row * D + dvc) = (pg8::u32x2){pg8::cvt_pk_bf16(gt.x * pg8::fast_sigmoid(gt.x) * y.x, gt.y * pg8::fast_sigmoid(gt.y) * y.y), pg8::cvt_pk_bf16(gt.z * pg8::fast_sigmoid(gt.z) * y.z, gt.w * pg8::fast_sigmoid(gt.w) * y.w)}; }
    }
}

__device__ __forceinline__ void phase_attention(const Ctx& c, char* lds) {
    const attn_body::bf16* QA = (const attn_body::bf16*)(c.ws + WS_QA); const attn_body::bf16* KA = (const attn_body::bf16*)(c.ws + WS_KA); const attn_body::bf16* VA = (const attn_body::bf16*)(c.ws + WS_VA);
    attn_body::bf16* MIX = (attn_body::bf16*)(c.ws + WS_MIX);
    const int G = gridDim.x, bx = blockIdx.x, vcu = (G % 8 == 0) ? (bx % 8) * (G / 8) + bx / 8 : bx;
    for (int U = vcu; U < NB * 8 * 17; U += G) {
        int bh, qrow0, NT;
        if (U < NB * 8 * 16) { bh = U >> 4; qrow0 = (bh >> 3) * RB + CL + (U & 15) * 256; NT = RB / 64; }
        else { bh = U - NB * 8 * 16; qrow0 = (bh >> 3) * RB; NT = CL / 64; }
        const int b = bh >> 3, hh = bh & 7;
        attn_body::attn_unit<8>(QA + (size_t)qrow0 * 512 + hh * 64, KA + (size_t)(b * RB) * 128 + (hh >> 2) * 64, VA + (size_t)(b * RB) * 128 + (hh >> 2) * 64,
                                MIX + (size_t)qrow0 * 1024 + 512 + hh * 64, NT, lds);
    }
}

__device__ __forceinline__ void phase_s5_ops(const Ctx& c, LAS float* ldsf) {
    LAS float* Pre = ldsf; LAS float* Pim = ldsf + 4224; LAS float* KZr = ldsf + 8448; LAS float* KZi = ldsf + 8576;
    LAS float* Bre = ldsf + 8704; LAS float* Bim = ldsf + 9728; LAS float* Cre = ldsf + 10752; LAS float* Cim = ldsf + 12800;
    LAS float* KV = ldsf + 14848;
    for (int task = blockIdx.x; task < 2 * 64; task += gridDim.x) {
        const int i = task >> 6, g = task & 63;
        __syncthreads();
        if (c.tid < 128) {
            const int dir = c.tid >> 6, p = c.tid & 63;
            const float a_re = c.in[IN_S5ARE][((i * 2 + dir) * 64 + g) * 64 + p], a_im = c.in[IN_S5AIM][((i * 2 + dir) * 64 + g) * 64 + p];
            const float dt = expf(c.in[IN_S5DT][(i * 2 + dir) * 64 + g]);
            const float lre = fminf(a_re, -1e-4f), lim = a_im, ea = lre * dt, eb = lim * dt;
            for (int dl = 0; dl <= 32; ++dl) { const float m = expf(ea * (float)dl), an = eb * (float)dl; Pre[(dir * 33 + dl) * 64 + p] = m * cosf(an); Pim[(dir * 33 + dl) * 64 + p] = m * sinf(an); }
            const float cb = cosf(eb), sb = sinf(eb), sh = sinf(0.5f * eb), mag = expf(ea);
            const float nr = expm1f(ea) * cb - 2.0f * sh * sh, ni = mag * sb, den = lre * lre + lim * lim;
            KZr[dir * 64 + p] = (nr * lre + ni * lim) / den; KZi[dir * 64 + p] = (ni * lre - nr * lim) / den;
        }
        for (int idx = c.tid; idx < 1024; idx += 512) { Bre[idx] = c.in[IN_S5BRE][(size_t)(i * 64 + g) * 1024 + idx]; Bim[idx] = c.in[IN_S5BIM][(size_t)(i * 64 + g) * 1024 + idx]; }
        for (int idx = c.tid; idx < 2048; idx += 512) { const int dir = idx >> 10, rem = idx & 1023;
            Cre[idx] = c.in[IN_S5CRE][((size_t)(i * 2 + dir) * 64 + g) * 1024 + rem]; Cim[idx] = c.in[IN_S5CIM][((size_t)(i * 2 + dir) * 64 + g) * 1024 + rem]; }
        __syncthreads();
        for (int e = c.tid; e < 16384; e += 512) {
            const int dir = e >> 13, dl = (e >> 8) & 31, ko = (e >> 4) & 15, ki = e & 15;
            float acc = 0.f;
            for (int p = 0; p < 64; ++p) {
                const float pr = Pre[(dir * 33 + dl) * 64 + p], pi = Pim[(dir * 33 + dl) * 64 + p], kr = KZr[dir * 64 + p], kq = KZi[dir * 64 + p];
                const float gr = pr * kr - pi * kq, gi = pr * kq + pi * kr, br = Bre[p * 16 + ki], bi = Bim[p * 16 + ki];
                const float mr = gr * br - gi * bi, mi = gr * bi + gi * br;
                acc += Cre[(dir * 16 + ko) * 64 + p] * mr - Cim[(dir * 16 + ko) * 64 + p] * mi;
            }
            KV[e] = acc;
        }
        __syncthreads();
        unsigned* TV = (unsigned*)(c.ws + WS_TV) + ((size_t)(i * 64 + g) * 512 * 768) / 2;
        const float* dsk = c.in[IN_S5D] + (size_t)i * D + 16 * g;
        for (int e = c.tid; e < 512 * 384; e += 512) {
            const int nn = e / 384, kp = e - nn * 384, it = nn >> 4, ko = nn & 15;
            float val[2];
#pragma unroll
            for (int z = 0; z < 2; ++z) {
                const int kk = 2 * kp + z;
                if (kk < 512) { const int j = kk >> 4, ki = kk & 15;
                    if (j < it) val[z] = KV[((0 * 32 + (it - j)) * 16 + ko) * 16 + ki];
                    else if (j > it) val[z] = KV[((1 * 32 + (j - it)) * 16 + ko) * 16 + ki];
                    else val[z] = KV[(0 * 16 + ko) * 16 + ki] + KV[((1 * 32) * 16 + ko) * 16 + ki] + (ko == ki ? dsk[ko] : 0.f);
                } else { const int q = kk - 512, dir = q >> 7, part = (q >> 6) & 1, p = q & 63, pw = dir == 0 ? it + 1 : 32 - it;
                    const float pr = Pre[(dir * 33 + pw) * 64 + p], pi = Pim[(dir * 33 + pw) * 64 + p], cr = Cre[(dir * 16 + ko) * 64 + p], ci = Cim[(dir * 16 + ko) * 64 + p];
                    val[z] = part == 0 ? (cr * pr - ci * pi) : -(cr * pi + ci * pr); }
            }
            TV[e] = pg8::cvt_pk_bf16(val[0], val[1]);
        }
        unsigned* WS5 = (unsigned*)(c.ws + WS_WS5) + ((size_t)(i * 64 + g) * 256 * 512) / 2;
        for (int e = c.tid; e < 256 * 256; e += 512) {
            const int q = e >> 8, kp = e & 255, dir = q >> 7, part = (q >> 6) & 1, p = q & 63;
            float val[2];
#pragma unroll
            for (int z = 0; z < 2; ++z) {
                const int kk = 2 * kp + z, j = kk >> 4, ki = kk & 15, pw = dir == 0 ? 31 - j : j;
                const float pr = Pre[(dir * 33 + pw) * 64 + p], pi = Pim[(dir * 33 + pw) * 64 + p], kr = KZr[dir * 64 + p], kq = KZi[dir * 64 + p];
                const float gr = pr * kr - pi * kq, gi = pr * kq + pi * kr, br = Bre[p * 16 + ki], bi = Bim[p * 16 + ki];
                val[z] = part == 0 ? (gr * br - gi * bi) : (gr * bi + gi * br);
            }
            WS5[e] = pg8::cvt_pk_bf16(val[0], val[1]);
        }
    }
}
__device__ __forceinline__ void phase_s5_carry(const Ctx& c, int i) {
    const float* SL = (const float*)(c.ws + WS_SL); unsigned short* AS5 = (unsigned short*)(c.ws + WS_AS5);
    for (int id = c.gt; id < 64 * 8 * 2 * 64; id += c.ngt) {
        const int p = id & 63, dir = (id >> 6) & 1, b = (id >> 7) & 7, g = id >> 10;
        const float a_re = c.in[IN_S5ARE][((i * 2 + dir) * 64 + g) * 64 + p], a_im = c.in[IN_S5AIM][((i * 2 + dir) * 64 + g) * 64 + p];
        const float dt = expf(c.in[IN_S5DT][(i * 2 + dir) * 64 + g]);
        const float lre = fminf(a_re, -1e-4f), m32 = expf(lre * dt * 32.0f), an = a_im * dt * 32.0f, ar = m32 * cosf(an), ai = m32 * sinf(an);
        float xr = 0.f, xi = 0.f;
#pragma unroll 8
        for (int st = 0; st < 136; ++st) {
            const int cch = dir == 0 ? st : (st < 8 ? 7 - st : 143 - st);
            const size_t r = (size_t)g * 1280 + b * 136 + cch;
            unsigned short* xo = AS5 + r * 768 + 512 + dir * 128 + p;
            xo[0] = (unsigned short)(pg8::cvt_pk_bf16(xr, 0.f) & 0xffffu); xo[64] = (unsigned short)(pg8::cvt_pk_bf16(xi, 0.f) & 0xffffu);
            const float sr = SL[r * 256 + dir * 128 + p], si = SL[r * 256 + dir * 128 + 64 + p];
            const float nxr = ar * xr - ai * xi + sr, nxi = ar * xi + ai * xr + si;
            xr = nxr; xi = nxi;
        }
    }
}

__device__ __forceinline__ void cvt_item(const float* W, int ldw, int k0, int scol0, unsigned short* WT, int K, int drow0, LAS float* scr, int lane) {
#pragma unroll 8
    for (int i = 0; i < 32; ++i) { const int kk = 2 * i + (lane >> 5); scr[kk * 33 + (lane & 31)] = W[(size_t)(k0 + kk) * ldw + scol0 + (lane & 31)]; }
    asm volatile("s_waitcnt lgkmcnt(0)" ::: "memory");
    const int cc = lane & 7;
#pragma unroll
    for (int j = 0; j < 4; ++j) { const int n = (lane >> 3) + 8 * j; const LAS float* s = scr + (8 * cc) * 33 + n;
        pg8::u32x4 o; o.x = pg8::cvt_pk_bf16(s[0 * 33], s[1 * 33]); o.y = pg8::cvt_pk_bf16(s[2 * 33], s[3 * 33]); o.z = pg8::cvt_pk_bf16(s[4 * 33], s[5 * 33]); o.w = pg8::cvt_pk_bf16(s[6 * 33], s[7 * 33]);
        *(pg8::u32x4*)(WT + (size_t)(drow0 + n) * K + k0 + 8 * cc) = o; }
    asm volatile("s_waitcnt lgkmcnt(0)" ::: "memory");
}
__device__ __forceinline__ void phase_cvt_moe(const Ctx& c, LAS float* ldsf) {
    LAS float* scr = ldsf + c.wave * (64 * 33);
    unsigned short* W13 = (unsigned short*)(c.ws + WS_W13); unsigned short* W2T = (unsigned short*)(c.ws + WS_W2);
    for (int id = c.gw; id < DEPTH * NE * 3072; id += c.ngw) {
        const int le = id / 3072; int r = id - le * 3072;
        if (r < 2048) { const int kb = r >> 7, nb = r & 127, pn = nb >> 3, rr0 = (nb & 7) * 32;
            const float* srcm = (rr0 < 128 ? c.in[IN_W1] : c.in[IN_W3]) + (size_t)le * D * FF;
            cvt_item(srcm, FF, 64 * kb, 128 * pn + (rr0 & 127), W13 + (size_t)le * 4096 * D, D, 32 * nb, scr, c.lane);
        } else { r -= 2048; const int kb = r >> 5, nb = r & 31;
            cvt_item(c.in[IN_W2] + (size_t)le * FF * D, D, 64 * kb, 32 * nb, W2T + (size_t)le * D * FF, FF, 32 * nb, scr, c.lane); }
    }
    unsigned short* WIN = (unsigned short*)(c.ws + WS_WIN); unsigned short* WOUT = (unsigned short*)(c.ws + WS_WOUT); unsigned short* WGLU = (unsigned short*)(c.ws + WS_WGLU);
    for (int id = c.gw; id < 2 * (1408 + 512 + 1024); id += c.ngw) {
        const int i = id / 2944; int r = id - i * 2944;
        if (r < 1408) { const int kb = r / 88, nb = r - kb * 88; cvt_item(c.in[IN_MIXIN] + (size_t)i * D * INW, INW, 64 * kb, 32 * nb, WIN + (size_t)i * INW * D, D, 32 * nb, scr, c.lane); }
        else if (r < 1920) { r -= 1408; const int kb = r >> 5, nb = r & 31; cvt_item(c.in[IN_MIXOUT] + (size_t)i * D * D, D, 64 * kb, 32 * nb, WOUT + (size_t)i * D * D, D, 32 * nb, scr, c.lane); }
        else { r -= 1920; const int kb = r >> 6, nb = r & 63, pn = nb >> 3, rr0 = (nb & 7) * 32;
            cvt_item(c.in[IN_GLUW] + (size_t)i * D * 2048, 2048, 64 * kb, (rr0 < 128 ? 0 : 1024) + 128 * pn + (rr0 & 127), WGLU + (size_t)i * 2048 * D, D, 32 * nb, scr, c.lane); }
    }
}

struct ALDense { const float* A; int lda; size_t gstride; __device__ __forceinline__ const float* row(int g, int r) const { return A + (size_t)g * gstride + (size_t)r * lda; } };
struct ALGather { const float* A; const int* idx; __device__ __forceinline__ const float* row(int g, int r) const { return A + (size_t)idx[g * EROWS + r] * D; } };
struct BL1 { const float* B; int ldb; size_t gstride; __device__ __forceinline__ const float* ptr(int g, int) const { return B + (size_t)g * gstride; } };
struct BL2 { const float* Ba; const float* Bb; int ldb; size_t gstride; __device__ __forceinline__ const float* ptr(int g, int sub) const { return (sub ? Bb : Ba) + (size_t)g * gstride; } };
struct EPStore { float* O; int ldc; __device__ __forceinline__ void operator()(int, int row, int col, float v, float) const { O[(size_t)row * ldc + col] = v; } };
struct EPResid { float* X; const float* mod; int L; __device__ __forceinline__ void operator()(int, int row, int col, float v, float) const {
    const int j = row_j(row); const float g1 = mod[((size_t)(L * 9 + j) * 6 + 2) * 1024 + col]; X[(size_t)row * D + col] += g1 * v; } };
struct EPGlu { float* X; const float* mod; const float* bias; int L; __device__ __forceinline__ void operator()(int, int row, int col, float va, float vb) const {
    const int j = row_j(row); const float g1 = mod[((size_t)(L * 9 + j) * 6 + 2) * 1024 + col];
    const float o = (va + bias[col]) * sigmoidf_(vb + bias[1024 + col]); X[(size_t)row * D + col] += g1 * o; } };
struct EPSwiglu { float* HID; __device__ __forceinline__ void operator()(int g, int row, int col, float va, float vb) const { HID[((size_t)g * EROWS + row) * FF + col] = siluf_(va) * vb; } };
struct EPGate { float* Y; const float* gate; __device__ __forceinline__ void operator()(int g, int row, int col, float v, float) const { Y[((size_t)g * EROWS + row) * D + col] = gate[g * EROWS + row] * v; } };

__global__ void __launch_bounds__(512, 2) fwd(Args args) {
    extern __shared__ __attribute__((aligned(16))) unsigned char lds[];
    Ctx c; c.in = args.in; c.out = args.out; c.ws = args.ws;
    c.tid = threadIdx.x; c.lane = c.tid & 63; c.wave = __builtin_amdgcn_readfirstlane(c.tid >> 6);
    c.gw = blockIdx.x * 8 + c.wave; c.ngw = gridDim.x * 8; c.gt = blockIdx.x * 512 + c.tid; c.ngt = gridDim.x * 512;
    LAS float* ldsf = (LAS float*)lds; LAS unsigned char* ldsb = (LAS unsigned char*)lds;
    volatile LAS unsigned* MISC = (volatile LAS unsigned*)((LAS unsigned char*)lds + MISC_OFF);
    if (c.tid < 32) MISC[c.tid] = 0u;
    __syncthreads();
    const int lo = args.ph_lo, hi = args.ph_hi;
    const bool one_launch = (hi - lo) > 1;
    XcdBarrier bar; bar.bar = (unsigned*)(c.ws + WS_CTL) + CW_BAR; bar.x = 0; bar.st = MISC + 8;
    if (one_launch) bar = xcd_barrier_post((unsigned*)(c.ws + WS_CTL) + CW_BAR, MISC + 8);
#define IN(k) (lo <= (k) && (k) < hi)
#define SEAM(k) do { if ((k) + 1 < hi) xcd_barrier(bar); } while (0)
#define FRESH(cc) Ctx cc = c; unsigned zq; asm volatile("s_mov_b32 %0, 0" : "=s"(zq)); cc.ws = c.ws + zq; cc.out = c.out + zq; cc.in = (const float* const*)((const char*)c.in + zq); const int Lq = L + (int)zq, iq = Lq >> 1; const float* MOD = (const float*)(cc.ws + WS_MOD); (void)MOD; (void)iq

    if (IN(PH_PRO)) { const int L = 0; FRESH(cc); phase_pro(cc, ldsf); __syncthreads(); phase_s5_ops(cc, ldsf); __syncthreads(); phase_cvt_moe(cc, ldsf); SEAM(PH_PRO); }

#define LAYER_BODY(LL) { constexpr int L = LL; \
        const int pb = 1 + L * PH_PER_LAYER; \
        if (IN(pb + 0)) { FRESH(cc); phase_norm1<false, (L & 1) != 0>(cc, Lq); SEAM(pb + 0); } \
        if ((L & 1) == 0) { \
            if (IN(pb + 1)) { \
                FRESH(cc); \
                pg8::GOrder S; S.init(1, NROWS, INW, (int)gridDim.x, (int)blockIdx.x); \
                pg8::ADense al{(const pg8::bf16_t*)(cc.ws + WS_HB1), 0, nullptr, 0, D, 0, 64}; pg8::EpiF32 ep{(float*)(cc.ws + WS_P), INW, 0}; \
                pg8::gemm_phase(ldsb, al, (const pg8::bf16_t*)(cc.ws + WS_WIN) + (size_t)iq * INW * D, 0, D, S, ep); SEAM(pb + 1); } \
            if (IN(pb + 2)) { FRESH(cc); phase_postproj(cc, iq); SEAM(pb + 2); } \
            if (IN(pb + 3)) { FRESH(cc); phase_ret_state(cc, iq, ldsf); SEAM(pb + 3); } \
            if (IN(pb + 4)) { FRESH(cc); phase_ret_prefix(cc, iq); phase_attention(cc, (char*)lds); SEAM(pb + 4); } \
            if (IN(pb + 5)) { FRESH(cc); phase_ret_main(cc, iq, ldsb); SEAM(pb + 5); } \
            if (IN(pb + 6)) { \
                FRESH(cc); \
                pg8::GOrder S; S.init(1, NROWS, D, (int)gridDim.x, (int)blockIdx.x); \
                pg8::ADense al{(const pg8::bf16_t*)(cc.ws + WS_MIX), 0, nullptr, 0, D, 0, 64}; pg8::EpiResid ep{(float*)(cc.ws + WS_X), MOD + (size_t)Lq * 9 * 6144}; \
                pg8::gemm_phase(ldsb, al, (const pg8::bf16_t*)(cc.ws + WS_WOUT) + (size_t)iq * D * D, 0, D, S, ep); SEAM(pb + 6); } \
        } else { \
            if (IN(pb + 1)) { \
                FRESH(cc); \
                pg8::GOrder S; S.init(64, 1280, 256, (int)gridDim.x, (int)blockIdx.x); \
                pg8::ADense al{(const pg8::bf16_t*)(cc.ws + WS_AS5), (size_t)1280 * 768, nullptr, 0, 768, 0, 64}; pg8::EpiF32 ep{(float*)(cc.ws + WS_SL), 256, (size_t)1280 * 256}; \
                pg8::gemm_phase(ldsb, al, (const pg8::bf16_t*)(cc.ws + WS_WS5) + (size_t)iq * 64 * 256 * 512, (size_t)256 * 512, 512, S, ep); SEAM(pb + 1); } \
            if (IN(pb + 2)) { FRESH(cc); phase_s5_carry(cc, iq); SEAM(pb + 2); } \
            if (IN(pb + 3)) { \
                FRESH(cc); \
                pg8::GOrder S; S.init(64, 1280, 512, (int)gridDim.x, (int)blockIdx.x); \
                pg8::ADense al{(const pg8::bf16_t*)(cc.ws + WS_AS5), (size_t)1280 * 768, nullptr, 0, 768, 0, 64}; pg8::EpiGeluBf16 ep{(pg8::bf16_t*)(cc.ws + WS_ZG), 512, (size_t)1280 * 512}; \
                pg8::gemm_phase(ldsb, al, (const pg8::bf16_t*)(cc.ws + WS_TV) + (size_t)iq * 64 * 512 * 768, (size_t)512 * 768, 768, S, ep); SEAM(pb + 3); } \
            if (IN(pb + 4)) { \
                FRESH(cc); \
                pg8::GOrder S; S.init(1, NROWS, 2048, (int)gridDim.x, (int)blockIdx.x); \
                pg8::ADense al{(const pg8::bf16_t*)(cc.ws + WS_ZG), 0, nullptr, 0, 16, 1280 * 512, (size_t)4 * 1280 * 512}; pg8::EpiGluResid ep{(float*)(cc.ws + WS_X), MOD + (size_t)Lq * 9 * 6144, cc.in[IN_GLUB] + (size_t)iq * 2048}; \
                pg8::gemm_phase(ldsb, al, (const pg8::bf16_t*)(cc.ws + WS_WGLU) + (size_t)iq * 2048 * D, 0, D, S, ep); SEAM(pb + 4); } \
        } \
        if (IN(pb + 7)) { FRESH(cc); phase_norm2_router(cc, Lq); SEAM(pb + 7); } \
        if (IN(pb + 8)) { FRESH(cc); phase_topk(cc, ldsf); SEAM(pb + 8); } \
        if (IN(pb + 9)) { \
            FRESH(cc); \
            pg8::GOrder S; S.init(NE, EROWS, 2 * FF, (int)gridDim.x, (int)blockIdx.x); \
            pg8::AGather al{(const pg8::bf16_t*)(cc.ws + WS_HB), 0, (const int*)(cc.ws + WS_SELROW), EROWS, D, 0, 64}; \
            pg8::EpiSwiglu ep{(pg8::bf16_t*)(cc.ws + WS_HID), FF, (size_t)EROWS * FF}; \
            pg8::gemm_phase(ldsb, al, (const pg8::bf16_t*)(cc.ws + WS_W13) + (size_t)Lq * NE * 4096 * D, (size_t)4096 * D, D, S, ep); SEAM(pb + 9); } \
        if (IN(pb + 10)) { \
            FRESH(cc); \
            pg8::GOrder S; S.init(NE, EROWS, D, (int)gridDim.x, (int)blockIdx.x); \
            pg8::ADense al{(const pg8::bf16_t*)(cc.ws + WS_HID), (size_t)EROWS * FF, nullptr, 0, FF, 0, 64}; \
            pg8::EpiGate ep{(pg8::bf16_t*)(cc.ws + WS_Y), D, (size_t)EROWS * D, (const float*)(cc.ws + WS_SELGATE), EROWS}; \
            pg8::gemm_phase(ldsb, al, (const pg8::bf16_t*)(cc.ws + WS_W2) + (size_t)Lq * NE * D * FF, (size_t)D * FF, FF, S, ep); SEAM(pb + 10); } \
    }
    LAYER_BODY(0) LAYER_BODY(1) LAYER_BODY(2) LAYER_BODY(3)
#undef LAYER_BODY
    if (IN(PH_FIN)) { const int L = DEPTH; FRESH(cc); phase_norm1<true, false>(cc, DEPTH); }
#undef IN
#undef SEAM
}

static bool phase_valid(int ph) {
    if (ph == PH_PRO || ph == PH_FIN) return true;
    const int L = (ph - 1) / PH_PER_LAYER, k = (ph - 1) % PH_PER_LAYER;
    if (L & 1) return !(k >= 5 && k <= 6);
    return true;
}
extern "C" void kernel_launch(void* const* d_in, const int* in_sizes, int n_in, void* d_out, int out_size, void* d_ws, size_t ws_size, hipStream_t stream) {
    static int grid = 0;
    if (grid == 0) {
        if (n_in != 27 || out_size != NB * T * D || ws_size < WS_END) { fprintf(stderr, "kernel_launch: unexpected shapes (n_in %d out %d ws %zu)\n", n_in, out_size, ws_size); grid = -1; return; }
        int dev = 0, cus = 0;
        if (hipGetDevice(&dev) != hipSuccess || hipDeviceGetAttribute(&cus, hipDeviceAttributeMultiprocessorCount, dev) != hipSuccess) { grid = -1; return; }
        if (hipFuncSetAttribute((const void*)fwd, hipFuncAttributeMaxDynamicSharedMemorySize, LDS_BYTES) != hipSuccess) { grid = -1; return; }
        int per_cu = 0;
        if (hipOccupancyMaxActiveBlocksPerMultiprocessor(&per_cu, (const void*)fwd, 512, LDS_BYTES) != hipSuccess || per_cu < 1) fprintf(stderr, "kernel_launch: occupancy query says %d\n", per_cu);
        (void)hipGetLastError();
        grid = cus;
    }
    if (grid < 0) return;
    if (hipMemsetAsync((char*)d_ws + WS_CTL, 0, CTL_ZERO_BYTES, stream) != hipSuccess) return;
    Args a{};
    for (int i = 0; i < 27; ++i) a.in[i] = (const float*)d_in[i];
    a.out = (float*)d_out; a.ws = (unsigned char*)d_ws;
#if MK_MULTI
    for (int ph = 0; ph < NPH; ++ph) {
        if (!phase_valid(ph)) continue;
        a.ph_lo = ph; a.ph_hi = ph + 1;
        hipLaunchKernelGGL(fwd, dim3(grid), dim3(512), LDS_BYTES, stream, a);
    }
#else
    a.ph_lo = 0; a.ph_hi = NPH;
    hipLaunchKernelGGL(fwd, dim3(grid), dim3(512), LDS_BYTES, stream, a);
#endif
}
```

```cpp
#include <hip/hip_runtime.h>
#include <hip/hip_bf16.h>
#include <cstdio>
#include <cstdint>

#define GAS __attribute__((address_space(1)))
#define LAS __attribute__((address_space(3)))
typedef float f32x4 __attribute__((ext_vector_type(4)));
typedef float f32x16 __attribute__((ext_vector_type(16)));

constexpr int NB = 8, T = 4096, D = 1024, CL = 256, RB = CL + T  , NROWS = NB * RB  ;
constexpr int DEPTH = 4, NE = 16, FF = 2048, INW = 2816;
constexpr int CAP_LAT = 512, CAP_CTX = 32, EROWS = NB * (CAP_LAT + CAP_CTX)  ;
constexpr float EPS = 1e-6f;
#ifndef MK_MULTI
#define MK_MULTI 0
#endif

constexpr size_t MiB = 1u << 20;
constexpr size_t WS_CTL = 0, CTL_ZERO_BYTES = 1 * MiB;
constexpr size_t WS_MOD = 1 * MiB;
constexpr size_t WS_ROPE = 2 * MiB;
constexpr size_t WS_SELROW = 3 * MiB;
constexpr size_t WS_SELGATE = 3 * MiB + 512 * 1024;
constexpr size_t WS_AFF = 4 * MiB;
constexpr size_t WS_SLOT = 7 * MiB;
constexpr size_t WS_X = 10 * MiB;
constexpr size_t WS_TV = 146 * MiB;
constexpr size_t WS_WS5 = 242 * MiB;
constexpr size_t WS_HB = 282 * MiB;
constexpr size_t WS_W13 = 350 * MiB;
constexpr size_t WS_W2 = 862 * MiB;
constexpr size_t WS_WIN = 1118 * MiB;
constexpr size_t WS_WOUT = 1130 * MiB;
constexpr size_t WS_WGLU = 1134 * MiB;
constexpr size_t WS_HB1 = 1144 * MiB;
constexpr size_t WS_BIG = 1212 * MiB;
constexpr size_t WS_P = WS_BIG;
constexpr size_t WS_RQ = WS_BIG + 374 * MiB;
constexpr size_t WS_RK = WS_BIG + 408 * MiB;
constexpr size_t WS_RV = WS_BIG + 442 * MiB;
constexpr size_t WS_ET = WS_BIG + 476 * MiB;
constexpr size_t WS_MIX = WS_BIG + 510 * MiB;
constexpr size_t WS_QA = WS_BIG + 578 * MiB;
constexpr size_t WS_KA = WS_BIG + 612 * MiB;
constexpr size_t WS_VA = WS_BIG + 621 * MiB;
constexpr size_t WS_U = WS_BIG + 630 * MiB;
constexpr size_t WS_AS5 = WS_BIG;
constexpr size_t WS_SL = WS_BIG + 120 * MiB;
constexpr size_t WS_ZG = WS_BIG + 200 * MiB;
constexpr size_t WS_HID = WS_BIG;
constexpr size_t WS_Y = WS_BIG + 272 * MiB;
constexpr size_t WS_END = WS_BIG + 698 * MiB;
constexpr int CW_BAR = 4096;

constexpr int LDS_BYTES = 147456;
constexpr int MISC_OFF = 131072 + 320;

constexpr int PH_PRO = 0, PH_PER_LAYER = 11, PH_FIN = 1 + DEPTH * PH_PER_LAYER, NPH = PH_FIN + 1;

#define XB_TMO      128
#define XB_XCNT(j)  (256  + 64 * (j))
#define XB_XSUB(j)  (1280 + 64 * (j))
#define XB_XGEN(j)  (2304 + 64 * (j))
#define XB_TOP      3328
#define XB_TOPGEN   3392
#define XCD_BAR_WORDS 3456
#define XB_SPIN_CAP (1u << 22)

__device__ __forceinline__ unsigned xb_ld(unsigned* p)              { return __hip_atomic_load(p, __ATOMIC_RELAXED, __HIP_MEMORY_SCOPE_AGENT); }
__device__ __forceinline__ unsigned xb_add(unsigned* p, unsigned v) { return __hip_atomic_fetch_add(p, v, __ATOMIC_RELAXED, __HIP_MEMORY_SCOPE_AGENT); }
__device__ __forceinline__ unsigned xb_xcc_id() { return (unsigned)__builtin_amdgcn_s_getreg((3 << 11) | 20) & 0xFu; }
#define XB_SPIN(cond, bar) do { unsigned _sp = 0; while (cond) { __builtin_amdgcn_s_sleep(1); \
    if ((++_sp & 255u) == 0u) { if (xb_ld(&(bar)[XB_TMO])) break; if (_sp > XB_SPIN_CAP) { atomicAdd(&(bar)[XB_TMO], 1u); break; } } } } while (0)

struct XcdBarrier { unsigned* bar; unsigned x; volatile LAS unsigned* st; };

__device__ __forceinline__ XcdBarrier xcd_barrier_post(unsigned* bar, volatile LAS unsigned* st) {
    XcdBarrier b; b.bar = bar; b.x = xb_xcc_id(); b.st = st;
    if (threadIdx.x == 0) (void)xb_add(&bar[XB_XCNT(b.x)], 1u);
    return b;
}
__device__ __forceinline__ void xcd_barrier_complete(unsigned* bar, unsigned x, unsigned& nloc, unsigned& nx) {
    const unsigned G = gridDim.x * gridDim.y * gridDim.z;
    unsigned sum, cnt, mine, sp = 0u;
    for (;;) {
        sum = 0u; cnt = 0u; mine = 0u;
#pragma unroll
        for (unsigned j = 0; j < 16; ++j) { const unsigned c = xb_ld(&bar[XB_XCNT(j)]); sum += c; cnt += (c > 0u) ? 1u : 0u; mine = (j == x) ? c : mine; }
        if (sum == G) break;
        __builtin_amdgcn_s_sleep(1);
        if ((++sp & 255u) == 0u) { if (xb_ld(&bar[XB_TMO])) break; if (sp > XB_SPIN_CAP) { atomicAdd(&bar[XB_TMO], 1u); break; } }
    }
    nloc = mine > 0u ? mine : 1u; nx = cnt > 0u ? cnt : 1u;
}
__device__ __forceinline__ void xcd_barrier(const XcdBarrier& b) {
    asm volatile("s_waitcnt vmcnt(0)" ::: "memory");
    __syncthreads();
    if (threadIdx.x == 0) {
        unsigned* bar = b.bar;
        __builtin_amdgcn_s_waitcnt(0);
        unsigned nloc = b.st[0], nx = b.st[1];
        if (nloc == 0u) { xcd_barrier_complete(bar, b.x, nloc, nx); b.st[0] = nloc; b.st[1] = nx; }
        const unsigned old = xb_add(&bar[XB_XSUB(b.x)], 1u);
        const unsigned gen = old / nloc;
        if (old + 1u == (gen + 1u) * nloc) {
            __builtin_amdgcn_fence(__ATOMIC_RELEASE, "agent");
            asm volatile("s_waitcnt vmcnt(0)" ::: "memory");
            const unsigned og = xb_add(&bar[XB_TOP], 1u);
            const unsigned tg = og / nx;
            if (og + 1u == (tg + 1u) * nx) xb_add(&bar[XB_TOPGEN], 1u);
            else XB_SPIN(xb_ld(&bar[XB_TOPGEN]) == tg, bar);
            __builtin_amdgcn_fence(__ATOMIC_ACQUIRE, "agent");
            xb_add(&bar[XB_XGEN(b.x)], 1u);
            asm volatile("s_waitcnt vmcnt(0)" ::: "memory");
        } else {
            XB_SPIN(xb_ld(&bar[XB_XGEN(b.x)]) == gen, bar);
            __builtin_amdgcn_fence(__ATOMIC_ACQUIRE, "agent");
            asm volatile("s_waitcnt vmcnt(0)" ::: "memory");
        }
    }
    __syncthreads();
}

struct Args { const float* in[27]; float* out; unsigned char* ws; int ph_lo, ph_hi; };

struct Ctx {
    const float* const* in; float* out; unsigned char* ws;
    int tid, lane, wave, gw, ngw, gt, ngt;
};
enum { IN_X = 0, IN_C, IN_CTX, IN_CCTX, IN_MODW, IN_MODB, IN_NORMG, IN_MIXIN, IN_MIXOUT, IN_RETRATE, IN_RETGN, IN_QKG,
       IN_S5ARE, IN_S5AIM, IN_S5DT, IN_S5BRE, IN_S5BIM, IN_S5CRE, IN_S5CIM, IN_S5D, IN_GLUW, IN_GLUB, IN_ROUTER, IN_W1, IN_W3, IN_W2, IN_FNG };

__device__ __forceinline__ float wave_sum(float v) {
#pragma unroll
    for (int o = 1; o < 64; o <<= 1) v += __shfl_xor(v, o);
    return v;
}
__device__ __forceinline__ float sigmoidf_(float x) { return 1.0f / (1.0f + expf(-x)); }
__device__ __forceinline__ float siluf_(float x) { return x * sigmoidf_(x); }
__device__ __forceinline__ float gelu_tanh(float x) { const float u = 0.7978845608028654f * (x + 0.044715f * x * x * x); return 0.5f * x * (1.0f + tanhf(u)); }
__device__ __forceinline__ const float* modp(const Ctx& c, int L, int j, int chunk) { return (const float*)(c.ws + WS_MOD) + ((size_t)(L * 9 + j) * 6 + chunk) * 1024; }
__device__ __forceinline__ int row_j(int row) { const int b = row / RB, s = row - b * RB; return s < CL ? 8 : b; }

__device__ __forceinline__ float reduce16(const float (&v)[16], int lane) {
    float a[8], b[4], c2[2], d;
    const bool b5 = (lane & 32) != 0, b4 = (lane & 16) != 0, b3 = (lane & 8) != 0, b2 = (lane & 4) != 0;
#pragma unroll
    for (int i = 0; i < 8; ++i) { const float keep = b5 ? v[8 + i] : v[i], send = b5 ? v[i] : v[8 + i]; a[i] = keep + __shfl_xor(send, 32); }
#pragma unroll
    for (int i = 0; i < 4; ++i) { const float keep = b4 ? a[4 + i] : a[i], send = b4 ? a[i] : a[4 + i]; b[i] = keep + __shfl_xor(send, 16); }
#pragma unroll
    for (int i = 0; i < 2; ++i) { const float keep = b3 ? b[2 + i] : b[i], send = b3 ? b[i] : b[2 + i]; c2[i] = keep + __shfl_xor(send, 8); }
    { const float keep = b2 ? c2[1] : c2[0], send = b2 ? c2[0] : c2[1]; d = keep + __shfl_xor(send, 4); }
    d += __shfl_xor(d, 2); d += __shfl_xor(d, 1);
    return d;
}
__device__ __forceinline__ int reduce16_k(int lane) { return ((lane >> 5) & 1) * 8 + ((lane >> 4) & 1) * 4 + ((lane >> 3) & 1) * 2 + ((lane >> 2) & 1); }

namespace pg8 {
typedef unsigned short bf16_t;
typedef short bf16x8 __attribute__((ext_vector_type(8)));
typedef unsigned u32x4 __attribute__((ext_vector_type(4)));
typedef unsigned u32x2 __attribute__((ext_vector_type(2)));
constexpr int BM = 256, BK = 64, HALF = 128, HTB = HALF * BK * 2, STAGE_BYTES = 8 * HTB, NXCD = 8, WGM = 8;
__host__ __device__ __forceinline__ int lds_byte(int r, int c) { const int st = (r >> 4) * 2 + (c >> 5), rr = r & 15, cc = c & 31, ob = rr * 64 + cc * 2; return st * 1024 + (ob ^ (((ob >> 9) & 1) << 5)); }
__host__ __device__ __forceinline__ void stage_rc(int b, int& R, int& C) { const int st = b / 1024, sb = b % 1024, swz = sb ^ (((sb >> 9) & 1) << 5); R = (st >> 1) * 16 + swz / 64; C = (st & 1) * 32 + (swz % 64) / 2; }
__host__ __device__ __forceinline__ int perm32(int rho) { const int n = rho >> 4, i = rho & 15; return 8 * (i >> 2) + 4 * n + (i & 3); }
__device__ __forceinline__ unsigned cvt_pk_bf16(float lo, float hi) { unsigned r; asm volatile("v_cvt_pk_bf16_f32 %0, %1, %2" : "=v"(r) : "v"(lo), "v"(hi)); return r; }

struct Unit { int pm, pn, g; };
struct GOrder {
    int nM, nN, per, nwg, G, c;
    __device__ __forceinline__ void init(int groups, int M, int N, int G_, int c_) { nM = M / BM; nN = N / BM; per = nM * nN; nwg = groups * per; G = G_; c = c_; }
    __device__ __forceinline__ bool next(int i, Unit& u) const {
        const long L = (long)i * G + c; if (L >= nwg) return false;
        int wgid = (int)L; { const int q = nwg / NXCD, r = nwg % NXCD, xcd = wgid % NXCD, off = wgid / NXCD; wgid = (xcd < r ? xcd * (q + 1) : r * (q + 1) + (xcd - r) * q) + off; }
        u.g = wgid / per; const int w = wgid - u.g * per;
        const int nig = WGM * nN, gid = w / nig, fm = gid * WGM, gsz = (nM - fm) < WGM ? (nM - fm) : WGM;
        u.pm = fm + ((w % nig) % gsz); u.pn = (w % nig) / gsz; return true;
    }
};
struct ADense  { static constexpr bool GATHER = false; const bf16_t* A; size_t gstride; const int* idx; int rpg; unsigned rowpitch; unsigned cgrp; size_t kstep; };
struct AGather { static constexpr bool GATHER = true;  const bf16_t* A; size_t gstride; const int* idx; int rpg; unsigned rowpitch; unsigned cgrp; size_t kstep; };

template <class Epi, class ALoc>
__device__ __forceinline__ void gemm_phase(LAS unsigned char* lds, const ALoc AL, const bf16_t* Bt, size_t gstrideB, int K, const GOrder& S, const Epi& E) {
    constexpr bool GATHER = ALoc::GATHER;
    const int tid = threadIdx.x, wid = __builtin_amdgcn_readfirstlane(tid >> 6), lane = tid & 63, wr = wid >> 2, wc = wid & 3, fr = lane & 15, fq = lane >> 4;
    const int nt = K / BK;
    unsigned voffA[2], voffB[2]; int RA[2]; unsigned CA2[2];
#pragma unroll
    for (int i = 0; i < 2; ++i) { int R, C; stage_rc(tid * 16 + i * 8192, R, C); const int Rb = Epi::PERM ? ((R & ~31) + perm32(R & 31)) : R;
        const unsigned cofs = AL.cgrp ? (unsigned)(C >> 4) * AL.cgrp + (unsigned)(C & 15) : (unsigned)C;
        voffA[i] = ((unsigned)R * AL.rowpitch + cofs) * 2u; voffB[i] = (unsigned)(Rb * K + C) * 2u; RA[i] = R; CA2[i] = cofs * 2u; }
    const size_t kstep = (size_t)(BK * 2), kstepA = AL.kstep * 2;
    const size_t hstep = (size_t)HALF * K * 2;
    const size_t hstepA = GATHER ? 0 : (size_t)HALF * AL.rowpitch * 2, tstepA = 2 * (size_t)HALF * AL.rowpitch * 2;
    const size_t tstep = 2 * hstep;
    const unsigned ldsw = (unsigned)wid * 1024u;
    const int aoff = lds_byte(wr * 64 + fr, fq * 8), boff = lds_byte(wc * 32 + fr, fq * 8);
    unsigned vAc[2][2], vAn[2][2];
#define PG8_SA(b, h) (((b) * 2 + (h)) * HTB)
#define PG8_SB(b, h) ((4 + (b) * 2 + (h)) * HTB)
#define PG8_STAGE(bufoff, gbase, voff) do { _Pragma("unroll") for (int _i = 0; _i < 2; ++_i) \
        __builtin_amdgcn_global_load_lds((const unsigned*)((const char*)(gbase) + (voff)[_i]), (LAS unsigned*)(lds + (bufoff) + ldsw + _i * 8192), 16, 0, 0); } while (0)
#define PG8_STAGE_A(bufoff, gbase, h, nx) do { _Pragma("unroll") for (int _i = 0; _i < 2; ++_i) { \
        const unsigned _o = GATHER ? ((nx) ? vAn[h][_i] : vAc[h][_i]) : voffA[_i]; \
        __builtin_amdgcn_global_load_lds((const unsigned*)((const char*)(gbase) + (size_t)(h) * hstepA + _o), (LAS unsigned*)(lds + (bufoff) + ldsw + _i * 8192), 16, 0, 0); } } while (0)
#define PG8_GIDX(u, v) do { if (GATHER) { _Pragma("unroll") for (int _h = 0; _h < 2; ++_h) _Pragma("unroll") for (int _i = 0; _i < 2; ++_i) \
        v[_h][_i] = (unsigned)AL.idx[(u).g * AL.rpg + (u).pm * BM + _h * HALF + RA[_i]] * (AL.rowpitch * 2u) + CA2[_i]; } } while (0)
#define PG8_ABASE(u) ((const char*)AL.A + (GATHER ? (size_t)0 : ((size_t)(u).g * AL.gstride * 2 + (size_t)(u).pm * tstepA)))
#define PG8_BBASE(u) ((const char*)Bt + (size_t)(u).g * gstrideB * 2 + (size_t)(u).pn * tstep)
#define PG8_LDA(dst, b, h) do { _Pragma("unroll") for (int m = 0; m < 4; ++m) _Pragma("unroll") for (int k = 0; k < 2; ++k) dst[m][k] = *(const LAS bf16x8*)(lds + PG8_SA(b, h) + aoff + m * 2048 + k * 1024); } while (0)
#define PG8_LDB(dst, b, h) do { _Pragma("unroll") for (int n = 0; n < 2; ++n) _Pragma("unroll") for (int k = 0; k < 2; ++k) dst[n][k] = *(const LAS bf16x8*)(lds + PG8_SB(b, h) + boff + n * 2048 + k * 1024); } while (0)
#define PG8_MMA(ai, bj, At, Bt_) do { __builtin_amdgcn_s_setprio(1); _Pragma("unroll") for (int m = 0; m < 4; ++m) _Pragma("unroll") for (int n = 0; n < 2; ++n) _Pragma("unroll") for (int k = 0; k < 2; ++k) \
        acc[ai][bj][m][n] = __builtin_amdgcn_mfma_f32_16x16x32_bf16(Bt_[n][k], At[m][k], acc[ai][bj][m][n], 0, 0, 0); __builtin_amdgcn_s_setprio(0); } while (0)
#define PG8_WAIT_V(n) asm volatile("s_waitcnt vmcnt(" #n ")" ::: "memory")
#define PG8_WAIT_L(n) asm volatile("s_waitcnt lgkmcnt(" #n ")" ::: "memory")
#define PG8_BAR __builtin_amdgcn_s_barrier()
#define PG8_SCHED __builtin_amdgcn_sched_barrier(0)
    Unit cur, nxt; int ui = 0;
    if (!S.next(0, cur)) return;
    PG8_GIDX(cur, vAc);
    f32x4 acc[2][2][4][2];
#pragma unroll
    for (int a = 0; a < 2; ++a)
#pragma unroll
        for (int b = 0; b < 2; ++b)
#pragma unroll
            for (int m = 0; m < 4; ++m)
#pragma unroll
                for (int n = 0; n < 2; ++n) acc[a][b][m][n] = (f32x4){0.f, 0.f, 0.f, 0.f};
    bf16x8 At[4][2], B0[2][2], B1[2][2];
    const char* cA = PG8_ABASE(cur); const char* cB = PG8_BBASE(cur);
    PG8_STAGE(PG8_SB(0, 0), cB, voffB); PG8_STAGE(PG8_SB(0, 1), cB + hstep, voffB); PG8_STAGE_A(PG8_SA(0, 0), cA, 0, false); PG8_STAGE_A(PG8_SA(0, 1), cA, 1, false);
    if (wr == 1) PG8_BAR;
    PG8_WAIT_V(2); PG8_BAR;
    PG8_STAGE(PG8_SB(1, 0), cB + kstep, voffB); PG8_STAGE_A(PG8_SA(1, 0), cA + kstepA, 0, false); PG8_STAGE(PG8_SB(1, 1), cB + hstep + kstep, voffB);
    PG8_WAIT_V(6); PG8_BAR;
    for (;;) {
        const bool has_next = S.next(ui + 1, nxt);
        if (GATHER) { if (has_next) { PG8_GIDX(nxt, vAn); } else {
#pragma unroll
            for (int _h = 0; _h < 2; ++_h)
#pragma unroll
                for (int _i = 0; _i < 2; ++_i) vAn[_h][_i] = vAc[_h][_i]; } }
        const char* nA = has_next ? PG8_ABASE(nxt) : cA; const char* nB = has_next ? PG8_BBASE(nxt) : cB;
        for (int t = 0; t < nt; t += 2) {
            const bool last = (t == nt - 2);
            const char* a1 = cA + (size_t)(t + 1) * kstepA;
            const char* a2 = last ? nA : cA + (size_t)(t + 2) * kstepA; const char* b2 = last ? nB : cB + (size_t)(t + 2) * kstep;
            const char* a3 = a2 + kstepA; const char* b3 = b2 + kstep;
            PG8_LDB(B0, 0, 0); PG8_LDB(B1, 0, 1); PG8_SCHED; PG8_LDA(At, 0, 0); PG8_STAGE_A(PG8_SA(1, 1), a1, 1, false);
            PG8_WAIT_V(8); PG8_WAIT_L(0); PG8_BAR; PG8_MMA(0, 0, At, B0); PG8_MMA(0, 1, At, B1); PG8_BAR; PG8_SCHED;
            PG8_LDA(At, 0, 1); PG8_STAGE(PG8_SB(0, 0), b2, voffB); PG8_STAGE(PG8_SB(0, 1), b2 + hstep, voffB); PG8_STAGE_A(PG8_SA(0, 0), a2, 0, last);
            PG8_WAIT_V(8); PG8_WAIT_L(0); PG8_BAR; PG8_MMA(1, 0, At, B0); PG8_MMA(1, 1, At, B1); PG8_BAR; PG8_SCHED;
            PG8_LDB(B0, 1, 0); PG8_LDB(B1, 1, 1); PG8_SCHED; PG8_LDA(At, 1, 0); PG8_STAGE_A(PG8_SA(0, 1), a2, 1, last);
            PG8_WAIT_V(8); PG8_WAIT_L(0); PG8_BAR; PG8_MMA(0, 0, At, B0); PG8_MMA(0, 1, At, B1); PG8_BAR; PG8_SCHED;
            PG8_LDA(At, 1, 1); PG8_STAGE(PG8_SB(1, 0), b3, voffB); PG8_STAGE(PG8_SB(1, 1), b3 + hstep, voffB); PG8_STAGE_A(PG8_SA(1, 0), a3, 0, last);
            PG8_WAIT_V(8); PG8_WAIT_L(0); PG8_BAR; PG8_MMA(1, 0, At, B0); PG8_MMA(1, 1, At, B1); PG8_BAR; PG8_SCHED;
        }
        if (wr == 0) PG8_BAR;
        E(acc, cur, wr, wc, fr, fq);
        if (!has_next) break;
#pragma unroll
        for (int a = 0; a < 2; ++a)
#pragma unroll
            for (int b = 0; b < 2; ++b)
#pragma unroll
                for (int m = 0; m < 4; ++m)
#pragma unroll
                    for (int n = 0; n < 2; ++n) acc[a][b][m][n] = (f32x4){0.f, 0.f, 0.f, 0.f};
        cur = nxt; cA = nA; cB = nB; ++ui;
        if (GATHER) {
#pragma unroll
            for (int _h = 0; _h < 2; ++_h)
#pragma unroll
                for (int _i = 0; _i < 2; ++_i) vAc[_h][_i] = vAn[_h][_i]; }
        if (wr == 1) PG8_BAR;
    }
    PG8_WAIT_V(0);
    PG8_BAR;
#undef PG8_SA
#undef PG8_SB
#undef PG8_STAGE
#undef PG8_STAGE_A
#undef PG8_GIDX
#undef PG8_ABASE
#undef PG8_BBASE
#undef PG8_LDA
#undef PG8_LDB
#undef PG8_MMA
#undef PG8_WAIT_V
#undef PG8_WAIT_L
#undef PG8_BAR
#undef PG8_SCHED
}

__device__ __forceinline__ float fast_sigmoid(float x) { return __builtin_amdgcn_rcpf(1.0f + __builtin_amdgcn_exp2f(-1.4426950408889634f * x)); }
struct EpiSwiglu {
    static constexpr bool PERM = true;
    bf16_t* O; int ldc; size_t gstride;
    __device__ __forceinline__ void operator()(const f32x4 (&acc)[2][2][4][2], const Unit& u, int wr, int wc, int fr, int fq) const {
        const int row0 = u.pm * BM + wr * 64 + fr, col0 = u.pn * HALF + wc * 32 + 8 * fq;
        bf16_t* base = O + (size_t)u.g * gstride;
#pragma unroll
        for (int ai = 0; ai < 2; ++ai)
#pragma unroll
            for (int m = 0; m < 4; ++m) { bf16_t* rowp = base + (size_t)(row0 + ai * HALF + m * 16) * ldc + col0;
                float o[8];
#pragma unroll
                for (int n = 0; n < 2; ++n)
#pragma unroll
                    for (int q = 0; q < 4; ++q) { const float a = acc[ai][0][m][n][q], b = acc[ai][1][m][n][q]; o[4 * n + q] = a * fast_sigmoid(a) * b; }
                u32x4 w; w.x = cvt_pk_bf16(o[0], o[1]); w.y = cvt_pk_bf16(o[2], o[3]); w.z = cvt_pk_bf16(o[4], o[5]); w.w = cvt_pk_bf16(o[6], o[7]);
                *(u32x4*)rowp = w; }
    }
};
struct EpiGeluBf16 {
    static constexpr bool PERM = true;
    bf16_t* O; int ldc; size_t gstride;
    __device__ __forceinline__ void operator()(const f32x4 (&acc)[2][2][4][2], const Unit& u, int wr, int wc, int fr, int fq) const {
        const int row0 = u.pm * BM + wr * 64 + fr, col0 = u.pn * BM + wc * 32 + 8 * fq;
        bf16_t* base = O + (size_t)u.g * gstride;
#pragma unroll
        for (int ai = 0; ai < 2; ++ai)
#pragma unroll
            for (int m = 0; m < 4; ++m) { bf16_t* rowp = base + (size_t)(row0 + ai * HALF + m * 16) * ldc + col0;
#pragma unroll
                for (int bj = 0; bj < 2; ++bj) { float o[8];
#pragma unroll
                    for (int n = 0; n < 2; ++n)
#pragma unroll
                        for (int q = 0; q < 4; ++q) { const float x = acc[ai][bj][m][n][q]; o[4 * n + q] = x * fast_sigmoid(1.5957691216057308f * (x + 0.044715f * x * x * x)); }
                    u32x4 w; w.x = cvt_pk_bf16(o[0], o[1]); w.y = cvt_pk_bf16(o[2], o[3]); w.z = cvt_pk_bf16(o[4], o[5]); w.w = cvt_pk_bf16(o[6], o[7]);
                    *(u32x4*)(rowp + bj * HALF) = w; } }
    }
};
struct EpiGate {
    static constexpr bool PERM = true;
    bf16_t* O; int ldc; size_t gstride; const float* gate; int rpg;
    __device__ __forceinline__ void operator()(const f32x4 (&acc)[2][2][4][2], const Unit& u, int wr, int wc, int fr, int fq) const {
        const int row0 = u.pm * BM + wr * 64 + fr, col0 = u.pn * BM + wc * 32 + 8 * fq;
        bf16_t* base = O + (size_t)u.g * gstride;
#pragma unroll
        for (int ai = 0; ai < 2; ++ai)
#pragma unroll
            for (int m = 0; m < 4; ++m) { const int row = row0 + ai * HALF + m * 16; const float gt = gate[u.g * rpg + row]; bf16_t* rowp = base + (size_t)row * ldc + col0;
#pragma unroll
                for (int bj = 0; bj < 2; ++bj) { const f32x4 v0 = acc[ai][bj][m][0] * gt, v1 = acc[ai][bj][m][1] * gt;
                    u32x4 w; w.x = cvt_pk_bf16(v0[0], v0[1]); w.y = cvt_pk_bf16(v0[2], v0[3]); w.z = cvt_pk_bf16(v1[0], v1[1]); w.w = cvt_pk_bf16(v1[2], v1[3]);
                    *(u32x4*)(rowp + bj * HALF) = w; } }
    }
};
struct EpiF32 {
    static constexpr bool PERM = false;
    float* C; int ldc; size_t gstride;
    __device__ __forceinline__ void operator()(const f32x4 (&acc)[2][2][4][2], const Unit& u, int wr, int wc, int fr, int fq) const {
        const int row0 = u.pm * BM + wr * 64 + fr, col0 = u.pn * BM + wc * 32 + 4 * fq;
#pragma unroll
        for (int ai = 0; ai < 2; ++ai)
#pragma unroll
            for (int m = 0; m < 4; ++m) { float* rowp = C + (size_t)u.g * gstride + (size_t)(row0 + ai * HALF + m * 16) * ldc + col0;
#pragma unroll
                for (int bj = 0; bj < 2; ++bj)
#pragma unroll
                    for (int n = 0; n < 2; ++n) *(f32x4*)(rowp + bj * HALF + n * 16) = acc[ai][bj][m][n]; }
    }
};
struct EpiResid {
    static constexpr bool PERM = false;
    float* X; const float* modL;
    __device__ __forceinline__ void operator()(const f32x4 (&acc)[2][2][4][2], const Unit& u, int wr, int wc, int fr, int fq) const {
        const int row0 = u.pm * BM + wr * 64 + fr, col0 = u.pn * BM + wc * 32 + 4 * fq;
        const int b = u.pm / 17, j = (u.pm - b * 17 == 0) ? 8 : b;
        const float* g1 = modL + (size_t)(j * 6 + 2) * 1024 + col0;
        f32x4 gv[2][2];
#pragma unroll
        for (int bj = 0; bj < 2; ++bj)
#pragma unroll
            for (int n = 0; n < 2; ++n) gv[bj][n] = *(const f32x4*)(g1 + bj * HALF + n * 16);
#pragma unroll
        for (int ai = 0; ai < 2; ++ai)
#pragma unroll
            for (int m = 0; m < 4; ++m) { float* rowp = X + (size_t)(row0 + ai * HALF + m * 16) * D + col0;
#pragma unroll
                for (int bj = 0; bj < 2; ++bj)
#pragma unroll
                    for (int n = 0; n < 2; ++n) { f32x4* p = (f32x4*)(rowp + bj * HALF + n * 16); *p = *p + gv[bj][n] * acc[ai][bj][m][n]; } }
    }
};
struct EpiGluResid {
    static constexpr bool PERM = false;
    float* X; const float* modL; const float* bias;
    __device__ __forceinline__ void operator()(const f32x4 (&acc)[2][2][4][2], const Unit& u, int wr, int wc, int fr, int fq) const {
        const int row0 = u.pm * BM + wr * 64 + fr, col0 = u.pn * HALF + wc * 32 + 4 * fq;
        const int b = u.pm / 17, j = (u.pm - b * 17 == 0) ? 8 : b;
        const float* g1 = modL + (size_t)(j * 6 + 2) * 1024 + col0;
        f32x4 gv[2], ba[2], bg[2];
#pragma unroll
        for (int n = 0; n < 2; ++n) { gv[n] = *(const f32x4*)(g1 + n * 16); ba[n] = *(const f32x4*)(bias + col0 + n * 16); bg[n] = *(const f32x4*)(bias + 1024 + col0 + n * 16); }
#pragma unroll
        for (int ai = 0; ai < 2; ++ai)
#pragma unroll
            for (int m = 0; m < 4; ++m) { float* rowp = X + (size_t)(row0 + ai * HALF + m * 16) * D + col0;
#pragma unroll
                for (int n = 0; n < 2; ++n) { const f32x4 a = acc[ai][0][m][n] + ba[n], g = acc[ai][1][m][n] + bg[n];
                    f32x4 o; o.x = a.x * fast_sigmoid(g.x); o.y = a.y * fast_sigmoid(g.y); o.z = a.z * fast_sigmoid(g.z); o.w = a.w * fast_sigmoid(g.w);
                    f32x4* p = (f32x4*)(rowp + n * 16); *p = *p + gv[n] * o; } }
    }
};
}

namespace attn_body {
using bf16=__hip_bfloat16;
using bf16x8=__attribute__((ext_vector_type(8)))short;
using s16x4=__attribute__((ext_vector_type(4)))short;
using f32x16=__attribute__((ext_vector_type(16)))float;
using u32x4=__attribute__((ext_vector_type(4)))unsigned;
constexpr int D=64,QP=512,KP=128,OP=1024;
constexpr int NW=8,QBLK=32,QB=QBLK*NW,KVBLK=64;
__device__ __forceinline__ int crow(int r,int hi){return (r&3)+8*(r>>2)+4*hi;}
#define SBAR() __builtin_amdgcn_sched_barrier(0)
__device__ __forceinline__ void cmask(f32x16&p0,f32x16&p1,int jb,int qrel,int hi){
  const float NEG=-INFINITY; int kb=64*jb+4*hi;
  #pragma unroll
  for(int r=0;r<16;++r){int kv=kb+(r&3)+8*(r>>2); if(kv>qrel)p0[r]=NEG; if(kv+32>qrel)p1[r]=NEG;}
}

constexpr int NSLOT=3, SLOTB=8192;
constexpr int LDS_K=0, LDS_V=NSLOT*SLOTB, LDS_WS=2*NSLOT*SLOTB, LDS_OST=LDS_WS+NW*64*4, LDS_BYTES=LDS_OST+NW*4096;
constexpr float C2=0.125f*1.4426950408889634f;
__device__ __forceinline__ void glds16(const void*gsrc,unsigned lds_dst){unsigned keep;
  asm volatile("s_mov_b32 %0, m0\n\ts_mov_b32 m0, %2\n\ts_nop 0\n\tglobal_load_lds_dwordx4 %1, off\n\ts_mov_b32 m0, %0":"=&s"(keep):"v"(gsrc),"s"(lds_dst):"memory");}
__device__ __forceinline__ float max3f(float a,float b,float c){float r;asm("v_max3_f32 %0, %1, %2, %3":"=v"(r):"v"(a),"v"(b),"v"(c));return r;}
__device__ __forceinline__ float max2f(float a,float b){float r;asm("v_max_f32_e32 %0, %1, %2":"=v"(r):"v"(a),"v"(b));return r;}
__device__ __forceinline__ float fadd_s(float a,float b){float r;asm("v_add_f32_e32 %0, %1, %2":"=v"(r):"v"(a),"v"(b));return r;}
__device__ __forceinline__ float fsub_s(float a,float b){float r;asm("v_sub_f32_e32 %0, %1, %2":"=v"(r):"v"(a),"v"(b));return r;}
typedef float f32x2_t __attribute__((ext_vector_type(2))); typedef __bf16 bf16x2_t __attribute__((ext_vector_type(2)));
__device__ __forceinline__ unsigned cvtpk_s(float lo,float hi){f32x2_t v={lo,hi};bf16x2_t b=__builtin_convertvector(v,bf16x2_t);return __builtin_bit_cast(unsigned,b);}
#define WAIT_BAR(N) asm volatile("s_waitcnt vmcnt(" #N ") lgkmcnt(0)\n\ts_barrier":::"memory")

__device__ __forceinline__ void qkt(f32x16&p0,f32x16&p1,const char*Kslot,const bf16x8*qr,const f32x16&negm,int r32,int hi){
  const char*kb=Kslot+hi*1024+r32*16;
  #pragma unroll
  for(int d0=0;d0<4;++d0){
    const bf16x8 b0=*reinterpret_cast<const bf16x8*>(kb+d0*2048);
    const bf16x8 b1=*reinterpret_cast<const bf16x8*>(kb+d0*2048+512);
    if(d0==0){p0=__builtin_amdgcn_mfma_f32_32x32x16_bf16(b0,qr[0],negm,0,0,0);p1=__builtin_amdgcn_mfma_f32_32x32x16_bf16(b1,qr[0],negm,0,0,0);}
    else{p0=__builtin_amdgcn_mfma_f32_32x32x16_bf16(b0,qr[d0],p0,0,0,0);p1=__builtin_amdgcn_mfma_f32_32x32x16_bf16(b1,qr[d0],p1,0,0,0);}}
}
typedef __attribute__((address_space(3))) const char* lds_cptr;
typedef short v4i16_t __attribute__((ext_vector_type(4)));
__device__ __forceinline__ void kload8(bf16x8*kf,lds_cptr kp){
  kf[0]=*(const __attribute__((address_space(3))) bf16x8*)(kp);      kf[1]=*(const __attribute__((address_space(3))) bf16x8*)(kp+512);
  kf[2]=*(const __attribute__((address_space(3))) bf16x8*)(kp+2048); kf[3]=*(const __attribute__((address_space(3))) bf16x8*)(kp+2560);
  kf[4]=*(const __attribute__((address_space(3))) bf16x8*)(kp+4096); kf[5]=*(const __attribute__((address_space(3))) bf16x8*)(kp+4608);
  kf[6]=*(const __attribute__((address_space(3))) bf16x8*)(kp+6144); kf[7]=*(const __attribute__((address_space(3))) bf16x8*)(kp+6656);
}
__device__ __forceinline__ void kload2(bf16x8*kf,lds_cptr kp,int j){ kf[2*j]=*(const __attribute__((address_space(3))) bf16x8*)(kp+j*2048); kf[2*j+1]=*(const __attribute__((address_space(3))) bf16x8*)(kp+j*2048+512); }
__device__ __forceinline__ s16x4 vtr(lds_cptr p){ return __builtin_bit_cast(s16x4,__builtin_amdgcn_ds_read_tr16_b64_v4i16((__attribute__((address_space(3))) v4i16_t*)p)); }
__device__ __forceinline__ float rowmax(const f32x16&p0,const f32x16&p1){
  float a=max3f(p0[0],p0[1],p1[0]),b=max3f(p0[2],p0[3],p1[1]);a=max3f(a,p1[2],p1[3]);
  #pragma unroll
  for(int r=4;r<16;r+=4){a=max3f(a,p0[r],p0[r+1]);b=max3f(b,p0[r+2],p0[r+3]);a=max3f(a,p1[r],p1[r+1]);b=max3f(b,p1[r+2],p1[r+3]);}
  const float m=max2f(a,b);
  auto rr=__builtin_amdgcn_permlane32_swap(__float_as_uint(m),__float_as_uint(m),false,false);
  return max2f(__uint_as_float(rr[0]),__uint_as_float(rr[1]));
}
__device__ __forceinline__ void pv(f32x16*o,int vb,bf16x8 pa0,bf16x8 pa1,bf16x8 pa2,bf16x8 pa3){
  #pragma unroll
  for(int d0=0;d0<2;++d0){s16x4 lo[4],hi[4];
    #pragma unroll
    for(int ks=0;ks<4;++ks){
      asm volatile("ds_read_b64_tr_b16 %0,%1 offset:%c2":"=&v"(lo[ks]):"v"(vb),"i"(d0*4096+ks*1024):"memory");
      asm volatile("ds_read_b64_tr_b16 %0,%1 offset:%c2":"=&v"(hi[ks]):"v"(vb),"i"(d0*4096+ks*1024+512):"memory");}
    asm volatile("s_waitcnt lgkmcnt(0)":::"memory");SBAR();
    #define PK(k) (bf16x8){lo[k][0],lo[k][1],lo[k][2],lo[k][3],hi[k][0],hi[k][1],hi[k][2],hi[k][3]}
    o[d0]=__builtin_amdgcn_mfma_f32_32x32x16_bf16(pa0,PK(0),o[d0],0,0,0);
    o[d0]=__builtin_amdgcn_mfma_f32_32x32x16_bf16(pa1,PK(1),o[d0],0,0,0);
    o[d0]=__builtin_amdgcn_mfma_f32_32x32x16_bf16(pa2,PK(2),o[d0],0,0,0);
    o[d0]=__builtin_amdgcn_mfma_f32_32x32x16_bf16(pa3,PK(3),o[d0],0,0,0);
    #undef PK
  }
}

#ifndef ATTN_STORE16
#define ATTN_STORE16(p,v) (*(u32x4*)(p)=(v))
#endif
template<int THRL> __device__ __forceinline__ void attn_unit(const bf16*Qw0,const bf16*Kh,const bf16*Vh,bf16*Ow0,const int NT,char*shm){
  const int tid=threadIdx.x,lane=tid&63,r32=lane&31,hi=lane>>5; const int wid=__builtin_amdgcn_readfirstlane(tid>>6);
  const bf16*Qw=Qw0+(long)(wid*QBLK)*QP;
  const unsigned lds0=(unsigned)(uintptr_t)shm;
  float*wsf=(float*)(shm+LDS_WS)+wid*64;
  const bf16*ksrc=Kh+(long)lane*KP+wid*8;
  const bf16*vsrc=Vh+(long)(16*(wid&3)+(lane>>2))*KP+(wid>>2)*32+(lane&3)*8;
  const unsigned kdst=lds0+LDS_K+wid*1024, vdst=lds0+LDS_V+wid*1024;
  #define DMA_K(t,slot) glds16(ksrc+(long)(t)*KVBLK*KP,(unsigned)__builtin_amdgcn_readfirstlane(kdst+(slot)))
  #define DMA_V(t,slot) glds16(vsrc+(long)(t)*KVBLK*KP,(unsigned)__builtin_amdgcn_readfirstlane(vdst+(slot)))
  const int vb0=(int)(lds0+LDS_V)+((lane>>4)&1)*32+(lane&3)*8+(4*hi+((lane&15)>>2))*64;
  const char*Kbase=shm+LDS_K; bf16x8 kf[8];
  const lds_cptr shm3=(lds_cptr)shm; const lds_cptr kp0=shm3+LDS_K+hi*1024+r32*16; const lds_cptr vp0=shm3+LDS_V+((lane>>4)&1)*32+(lane&3)*8+(4*hi+((lane&15)>>2))*64;
  DMA_K(0,0);DMA_V(0,0);DMA_K(1,SLOTB);
  bf16x8 qr[4];
  #pragma unroll
  for(int d0=0;d0<4;++d0)qr[d0]=*reinterpret_cast<const bf16x8*>(&Qw[(long)r32*QP+d0*16+hi*8]);
  float mhat=0.f,l_reg=0.f;f32x16 o[2];o[0]=f32x16{};o[1]=f32x16{};f32x16 negm=f32x16{};asm volatile("":"+v"(negm));
  #define CMASK(P0,P1,t) do{}while(0)
  bool resc=false;
  #define START(P0,P1) do{ const float rm=rowmax(P0,P1); resc=false; \
    { const float dl=rm; mhat=fadd_s(mhat,dl); \
      _Pragma("unroll") for(int r=0;r<16;++r){P0[r]=fsub_s(P0[r],dl);P1[r]=fsub_s(P1[r],dl);} \
      _Pragma("unroll") for(int r=0;r<16;++r)negm[r]=-mhat; asm volatile("":"+v"(negm)); } \
    _Pragma("unroll") for(int r=0;r<16;++r)P0[r]=__builtin_amdgcn_exp2f(P0[r]); }while(0)
  #define RESC() do{ if(resc){ asm volatile("s_waitcnt lgkmcnt(0)":::"memory"); \
      _Pragma("unroll") for(int d_=0;d_<2;++d_) _Pragma("unroll") for(int r=0;r<16;++r)o[d_][r]*=wsf[crow(r,hi)]; } }while(0)
  f32x16 pA0,pA1,pB0,pB1;
  int sl_prev=0,sl_cur=0,sl_next=SLOTB;
  #define ROT() do{sl_prev=sl_cur;sl_cur=sl_next;sl_next=(sl_next==(NSLOT-1)*SLOTB)?0:sl_next+SLOTB;}while(0)
  DMA_K(2,2*SLOTB);
  WAIT_BAR(3);
  qkt(pA0,pA1,Kbase,qr,negm,r32,hi);asm volatile("s_nop 15\n\ts_nop 7":"+v"(pA0),"+v"(pA1));CMASK(pA0,pA1,0);
  START(pA0,pA1);
  _Pragma("unroll") for(int r=0;r<16;++r)pA1[r]=__builtin_amdgcn_exp2f(pA1[r]);
  WAIT_BAR(0);
  DMA_K(3,0);DMA_V(1,SLOTB);
  ROT();
  kload8(kf,kp0+sl_cur);
  WAIT_BAR(2);
  s16x4 vlo[8],vhi[8]; u32x4 pw0,pw1,pw2,pw3;
  #define PKW(P,B) cvtpk_s(P[B],P[B+1])
  #define PAF(k) __builtin_bit_cast(bf16x8,pw##k)
  #define VFR(i) (bf16x8){vlo[i][0],vlo[i][1],vlo[i][2],vlo[i][3],vhi[i][0],vhi[i][1],vhi[i][2],vhi[i][3]}
  #define PIN(x) asm volatile("":"+v"(x))
  #define MX3(a,b,c) __builtin_fmaxf(__builtin_fmaxf((a),(b)),(c))
  #define GAPA(MF,A0,A1,A2,A3,W0,W1,PW) do{ MF; sacc+=A0; sacc+=A1; sacc+=A2; sacc+=A3; PIN(sacc); W0; W1; PIN(PW); SBAR(); }while(0)
  #define EX(v) __builtin_amdgcn_exp2f(v)
  #define GAPB(MF,X,B) do{ MF; X[B]=EX(X[B]); X[B+1]=EX(X[B+1]); X[B+2]=EX(X[B+2]); X[B+3]=EX(X[B+3]); PIN(X); SBAR(); }while(0)
  #define VRD(i) do{ vlo[i]=vtr(vp_+(((i)>>2)*4096+((i)&3)*1024)); vhi[i]=vtr(vp_+(((i)>>2)*4096+((i)&3)*1024+512)); }while(0)
  #define KRD(G,j) do{ if(G){ kload2(kf,kp0+sl_next,j); SBAR(); } }while(0)
  #define STEP(C0,C1,P0,P1,t,GK,GV,GL) do{ SBAR(); \
    const lds_cptr vp_=vp0+sl_prev; \
    VRD(0); SBAR(); float sacc=(P0[0]+P0[1]); \
    GAPA(C0=__builtin_amdgcn_mfma_f32_32x32x16_bf16(kf[0],qr[0],negm,0,0,0), P0[2],P0[3],P0[4],P0[5],     pw0[0]=PKW(P0,0), pw0[1]=PKW(P0,2), pw0); \
    VRD(4); SBAR(); GAPA(C1=__builtin_amdgcn_mfma_f32_32x32x16_bf16(kf[1],qr[0],negm,0,0,0), P0[6],P0[7],P0[8],P0[9],     pw0[2]=PKW(P0,4), pw0[3]=PKW(P0,6), pw0); \
    VRD(1); SBAR(); GAPA(C0=__builtin_amdgcn_mfma_f32_32x32x16_bf16(kf[2],qr[1],C0,0,0,0),   P0[10],P0[11],P0[12],P0[13], pw1[0]=PKW(P0,8), pw1[1]=PKW(P0,10), pw1); \
    VRD(5); SBAR(); GAPA(C1=__builtin_amdgcn_mfma_f32_32x32x16_bf16(kf[3],qr[1],C1,0,0,0),   P0[14],P0[15],P1[0],P1[1],   pw1[2]=PKW(P0,12),pw1[3]=PKW(P0,14), pw1); \
    VRD(2); SBAR(); GAPA(C0=__builtin_amdgcn_mfma_f32_32x32x16_bf16(kf[4],qr[2],C0,0,0,0),   P1[2],P1[3],P1[4],P1[5],     pw2[0]=PKW(P1,0), pw2[1]=PKW(P1,2), pw2); \
    VRD(6); SBAR(); GAPA(C1=__builtin_amdgcn_mfma_f32_32x32x16_bf16(kf[5],qr[2],C1,0,0,0),   P1[6],P1[7],P1[8],P1[9],     pw2[2]=PKW(P1,4), pw2[3]=PKW(P1,6), pw2); \
    VRD(3); SBAR(); GAPA(C0=__builtin_amdgcn_mfma_f32_32x32x16_bf16(kf[6],qr[3],C0,0,0,0),   P1[10],P1[11],P1[12],P1[13], pw3[0]=PKW(P1,8), pw3[1]=PKW(P1,10), pw3); \
    VRD(7); SBAR(); GAPA(C1=__builtin_amdgcn_mfma_f32_32x32x16_bf16(kf[7],qr[3],C1,0,0,0),   P1[14],P1[15],0.f,0.f,       pw3[2]=PKW(P1,12),pw3[3]=PKW(P1,14), pw3); \
    l_reg+=sacc; \
    if(GK){DMA_K((t)+3,sl_cur);} if(GV){DMA_V((t)+1,sl_next);} \
    CMASK(C0,C1,t); \
    { float a=MX3(C0[0],C0[1],C1[0]),b=MX3(C0[2],C0[3],C1[1]); a=MX3(a,C1[2],C1[3]); \
      _Pragma("unroll") for(int r=4;r<16;r+=4){a=MX3(a,C0[r],C0[r+1]);b=MX3(b,C0[r+2],C0[r+3]);a=MX3(a,C1[r],C1[r+1]);b=MX3(b,C1[r+2],C1[r+3]);} \
      float rm=__builtin_fmaxf(a,b); { auto rr=__builtin_amdgcn_permlane32_swap(__float_as_uint(rm),__float_as_uint(rm),false,false); rm=__builtin_fmaxf(__uint_as_float(rr[0]),__uint_as_float(rr[1])); } \
      resc=false; \
      if(__builtin_expect(__any(rm>(float)THRL),0)){ const float dl=__builtin_fmaxf(rm,0.f); mhat+=dl; \
        _Pragma("unroll") for(int r=0;r<16;++r){C0[r]-=dl;C1[r]-=dl;} \
        _Pragma("unroll") for(int r=0;r<16;++r)negm[r]=-mhat; asm volatile("":"+v"(negm)); \
        const float f=__builtin_amdgcn_exp2f(-dl); l_reg*=f; if(hi==0)wsf[r32]=f; resc=true; } } \
    SBAR(); \
    GAPB(o[0]=__builtin_amdgcn_mfma_f32_32x32x16_bf16(PAF(0),VFR(0),o[0],0,0,0), C0,0); \
    GAPB(o[1]=__builtin_amdgcn_mfma_f32_32x32x16_bf16(PAF(0),VFR(4),o[1],0,0,0), C0,4); \
    KRD(GL,0); GAPB(o[0]=__builtin_amdgcn_mfma_f32_32x32x16_bf16(PAF(1),VFR(1),o[0],0,0,0), C0,8); \
    KRD(GL,1); GAPB(o[1]=__builtin_amdgcn_mfma_f32_32x32x16_bf16(PAF(1),VFR(5),o[1],0,0,0), C0,12); \
    KRD(GL,2); GAPB(o[0]=__builtin_amdgcn_mfma_f32_32x32x16_bf16(PAF(2),VFR(2),o[0],0,0,0), C1,0); \
    KRD(GL,3); GAPB(o[1]=__builtin_amdgcn_mfma_f32_32x32x16_bf16(PAF(2),VFR(6),o[1],0,0,0), C1,4); \
    GAPB(o[0]=__builtin_amdgcn_mfma_f32_32x32x16_bf16(PAF(3),VFR(3),o[0],0,0,0), C1,8); \
    GAPB(o[1]=__builtin_amdgcn_mfma_f32_32x32x16_bf16(PAF(3),VFR(7),o[1],0,0,0), C1,12); \
    }while(0)
  int t=1;
  #undef CMASK
  #define CMASK(P0,P1,t) do{}while(0)
  for(;t+5<NT;t+=2){
    STEP(pB0,pB1,pA0,pA1,t,true,true,true);     WAIT_BAR(2); RESC(); ROT();
    STEP(pA0,pA1,pB0,pB1,t+1,true,true,true);   WAIT_BAR(2); RESC(); ROT();
  }
  #undef CMASK
  #define CMASK(P0,P1,t) do{}while(0)
  #define ENDW(tt) do{ if((tt)+3<NT){WAIT_BAR(2);} else if((tt)+2<NT){WAIT_BAR(1);} else {WAIT_BAR(0);} }while(0)
  for(;t+1<NT;t+=2){
    STEP(pB0,pB1,pA0,pA1,t,(t+3<NT),(t+1<NT),(t+1<NT));       ENDW(t);   RESC(); ROT();
    STEP(pA0,pA1,pB0,pB1,t+1,(t+4<NT),(t+2<NT),(t+2<NT));     ENDW(t+1); RESC(); ROT();
  }
  STEP(pB0,pB1,pA0,pA1,NT-1,false,false,false); RESC();
  { float sacc=pB0[0]+pB0[1]; _Pragma("unroll") for(int r=2;r<16;++r)sacc+=pB0[r]; _Pragma("unroll") for(int r=0;r<16;++r)sacc+=pB1[r]; l_reg+=sacc;
    pw0=(u32x4){PKW(pB0,0),PKW(pB0,2),PKW(pB0,4),PKW(pB0,6)};pw1=(u32x4){PKW(pB0,8),PKW(pB0,10),PKW(pB0,12),PKW(pB0,14)};pw2=(u32x4){PKW(pB1,0),PKW(pB1,2),PKW(pB1,4),PKW(pB1,6)};pw3=(u32x4){PKW(pB1,8),PKW(pB1,10),PKW(pB1,12),PKW(pB1,14)};
    SBAR(); pv(o,vb0+sl_cur,PAF(0),PAF(1),PAF(2),PAF(3)); }
  #undef PKW
  #undef PAF
  #undef VFR
  #undef PIN
  #undef MX3
  #undef GAPA
  #undef GAPB
  #undef EX
  #undef VRD
  #undef KRD
  #undef STEP
  #undef ENDW
  {auto rr=__builtin_amdgcn_permlane32_swap(__float_as_uint(l_reg),__float_as_uint(l_reg),false,false);l_reg=__uint_as_float(rr[0])+__uint_as_float(rr[1]);}
  if(hi==0)wsf[32+r32]=l_reg;asm volatile("s_waitcnt lgkmcnt(0)":::"memory");
  float rli[16];
  #pragma unroll
  for(int r=0;r<16;++r)rli[r]=__builtin_amdgcn_rcpf(wsf[32+crow(r,hi)]);
  bf16*Ow=Ow0+(long)(wid*QBLK)*OP;
  { bf16*stg=(bf16*)(shm+LDS_OST)+wid*2048;
    #pragma unroll
    for(int r=0;r<16;++r){const int orow=crow(r,hi);
      #pragma unroll
      for(int d0=0;d0<2;++d0)stg[orow*64+d0*32+r32]=__float2bfloat16(o[d0][r]*rli[r]);}
    asm volatile("s_waitcnt lgkmcnt(0)":::"memory");
    #pragma unroll
    for(int i=0;i<4;++i){const int row=i*8+(lane>>3),ch=lane&7; const u32x4 v=*(const u32x4*)(stg+row*64+ch*8); ATTN_STORE16(Ow+(long)row*OP+ch*8,v);} }
  asm volatile("s_waitcnt lgkmcnt(0)\n\ts_barrier":::"memory");
  #undef DMA_K
  #undef DMA_V
  #undef CMASK
  #undef START
  #undef RESC
  #undef ROT
}
constexpr int ATTN_LDS_BYTES=LDS_BYTES;
#undef SBAR
#undef WAIT_BAR
}

template <bool PAIRED, class AL, class BL, class EP>
__device__ __forceinline__ void gemm_f32(int groups, int M, int N, int K, const AL& al, const BL& bl, const EP& ep) {
    const int tid = threadIdx.x, lane = tid & 63, wave = tid >> 6, wm = wave >> 2, wn = wave & 3, r32 = lane & 31, h = lane >> 5;
    constexpr int TN = PAIRED ? 128 : 256;
    const int tilesM = M / 128, tilesN = N / TN, per = tilesM * tilesN, total = groups * per;
    const int ldb = bl.ldb;
    for (int t = blockIdx.x; t < total; t += gridDim.x) {
        const int g = t / per, r = t - g * per, tm = r / tilesN, tn = r - tm * tilesN;
        const int m0 = tm * 128 + wm * 64;
        const int n0 = PAIRED ? (tn * 128 + wn * 32) : (tn * 256 + wn * 64);
        const float* a0 = al.row(g, m0 + r32) + 4 * h;
        const float* a1 = al.row(g, m0 + 32 + r32) + 4 * h;
        const float* b0 = bl.ptr(g, 0) + n0 + r32 + (size_t)(4 * h) * ldb;
        const float* b1 = (PAIRED ? bl.ptr(g, 1) + n0 : bl.ptr(g, 0) + n0 + 32) + r32 + (size_t)(4 * h) * ldb;
        f32x16 acc00 = {}, acc01 = {}, acc10 = {}, acc11 = {};
#pragma unroll 2
        for (int k = 0; k < K; k += 8) {
            const f32x4 av0 = *(const f32x4*)(a0 + k), av1 = *(const f32x4*)(a1 + k);
            float bv0[4], bv1[4];
#pragma unroll
            for (int s = 0; s < 4; ++s) { bv0[s] = b0[(size_t)(k + s) * ldb]; bv1[s] = b1[(size_t)(k + s) * ldb]; }
#pragma unroll
            for (int s = 0; s < 4; ++s) {
                acc00 = __builtin_amdgcn_mfma_f32_32x32x2f32(av0[s], bv0[s], acc00, 0, 0, 0);
                acc01 = __builtin_amdgcn_mfma_f32_32x32x2f32(av0[s], bv1[s], acc01, 0, 0, 0);
                acc10 = __builtin_amdgcn_mfma_f32_32x32x2f32(av1[s], bv0[s], acc10, 0, 0, 0);
                acc11 = __builtin_amdgcn_mfma_f32_32x32x2f32(av1[s], bv1[s], acc11, 0, 0, 0);
            }
        }
#pragma unroll
        for (int rr = 0; rr < 16; ++rr) {
            const int ro = (rr & 3) + 8 * (rr >> 2) + 4 * h;
            if (PAIRED) {
                ep(g, m0 + ro, n0 + r32, acc00[rr], acc01[rr]);
                ep(g, m0 + 32 + ro, n0 + r32, acc10[rr], acc11[rr]);
            } else {
                ep(g, m0 + ro, n0 + r32, acc00[rr], 0.f); ep(g, m0 + ro, n0 + 32 + r32, acc01[rr], 0.f);
                ep(g, m0 + 32 + ro, n0 + r32, acc10[rr], 0.f); ep(g, m0 + 32 + ro, n0 + 32 + r32, acc11[rr], 0.f);
            }
        }
    }
}

__device__ __forceinline__ void phase_pro(const Ctx& c, LAS float* ldsf) {
    float* rope = (float*)(c.ws + WS_ROPE);
    for (int i = c.gt; i < 64 * 16; i += c.ngt) {
        const int pos = i >> 4, fi = i & 15; const float inv = powf(10000.0f, -(float)fi / 16.0f), ang = (float)pos * inv;
        rope[2 * i] = cosf(ang); rope[2 * i + 1] = sinf(ang);
    }
    LAS float* sil = ldsf; LAS float* red = ldsf + 9 * 1024;
    for (int i = c.tid; i < 9 * 1024; i += 512) { const int j = i >> 10, k = i & 1023; const float v = (j < 8) ? c.in[IN_C][j * 1024 + k] : c.in[IN_CCTX][k]; sil[i] = siluf_(v); }
    __syncthreads();
    float* MOD = (float*)(c.ws + WS_MOD);
    for (int task = blockIdx.x; task < DEPTH * 96; task += gridDim.x) {
        const int L = task / 96, cb = task - L * 96, col = cb * 64 + c.lane;
        const float* W = c.in[IN_MODW] + (size_t)L * 1024 * 6144;
        float acc[9];
#pragma unroll
        for (int j = 0; j < 9; ++j) acc[j] = 0.f;
        const int k0 = c.wave * 128;
#pragma unroll 4
        for (int k = k0; k < k0 + 128; ++k) { const float w = W[(size_t)k * 6144 + col];
#pragma unroll
            for (int j = 0; j < 9; ++j) acc[j] += sil[j * 1024 + k] * w; }
#pragma unroll
        for (int j = 0; j < 9; ++j) red[(c.wave * 9 + j) * 64 + c.lane] = acc[j];
        __syncthreads();
        if (c.wave == 0) {
            const float bias = c.in[IN_MODB][L * 6144 + col];
#pragma unroll
            for (int j = 0; j < 9; ++j) { float s = bias;
#pragma unroll
                for (int w = 0; w < 8; ++w) s += red[(w * 9 + j) * 64 + c.lane];
                MOD[(size_t)(L * 9 + j) * 6144 + col] = s; }
        }
        __syncthreads();
    }
    float* X = (float*)(c.ws + WS_X);
    for (int r = c.gw; r < NROWS; r += c.ngw) {
        const int b = r / RB, s = r - b * RB;
        const float* src = (s < CL) ? c.in[IN_CTX] + (size_t)(b * CL + s) * D : c.in[IN_X] + (size_t)(b * T + s - CL) * D;
        const f32x4* sp = (const f32x4*)src + c.lane; f32x4* dp = (f32x4*)(X + (size_t)r * D) + c.lane;
#pragma unroll
        for (int j = 0; j < 4; ++j) dp[64 * j] = sp[64 * j];
    }
}

template <bool FINAL, bool GM>
__device__ __forceinline__ void phase_norm1(const Ctx& c, int L) {
    float* X = (float*)(c.ws + WS_X);
    const int* SLOT = (const int*)(c.ws + WS_SLOT); const unsigned short* Y = (const unsigned short*)(c.ws + WS_Y);
    int ch[4];
#pragma unroll
    for (int q = 0; q < 4; ++q) ch[q] = GM ? 16 * c.lane + 4 * q : 4 * (c.lane + 64 * q);
    for (int r = c.gw; r < NROWS; r += c.ngw) {
        const int b = r / RB, s = r - b * RB, j = s < CL ? 8 : b;
        if (FINAL && s < CL) continue;
        float* xr = X + (size_t)r * D;
        f32x4 v[4];
#pragma unroll
        for (int q = 0; q < 4; ++q) v[q] = *(const f32x4*)(xr + ch[q]);
        if (L > 0) {
            f32x4 sum[4] = {};
            for (int e = 0; e < NE; ++e) {
                const int sp = SLOT[(size_t)r * NE + e];
                if (sp >= 0) { const unsigned short* yr = Y + ((size_t)e * EROWS + sp) * D;
#pragma unroll
                    for (int q = 0; q < 4; ++q) { const pg8::u32x2 w = *(const pg8::u32x2*)(yr + ch[q]);
                        sum[q] += (f32x4){__uint_as_float(w.x << 16), __uint_as_float(w.x & 0xffff0000u), __uint_as_float(w.y << 16), __uint_as_float(w.y & 0xffff0000u)}; } }
            }
            const float* g2 = modp(c, L - 1, j, 5);
#pragma unroll
            for (int q = 0; q < 4; ++q) { v[q] += *(const f32x4*)(g2 + ch[q]) * sum[q]; if (!FINAL) *(f32x4*)(xr + ch[q]) = v[q]; }
        }
        float ss = 0.f;
#pragma unroll
        for (int q = 0; q < 4; ++q) ss += v[q].x * v[q].x + v[q].y * v[q].y + v[q].z * v[q].z + v[q].w * v[q].w;
        const float rstd = rsqrtf(wave_sum(ss) * (1.0f / D) + EPS);
        if (FINAL) {
            const float* g = c.in[IN_FNG]; float* op = c.out + (size_t)(b * T + s - CL) * D;
#pragma unroll
            for (int q = 0; q < 4; ++q) *(f32x4*)(op + ch[q]) = v[q] * rstd * *(const f32x4*)(g + ch[q]);
        } else {
            const float* g = c.in[IN_NORMG] + (size_t)(L * 2 + 0) * D; const float* sc = modp(c, L, j, 1); const float* sh = modp(c, L, j, 0);
            unsigned hw[8];
#pragma unroll
            for (int q = 0; q < 4; ++q) { const f32x4 hv = v[q] * rstd * *(const f32x4*)(g + ch[q]) * (1.0f + *(const f32x4*)(sc + ch[q])) + *(const f32x4*)(sh + ch[q]);
                hw[2 * q] = pg8::cvt_pk_bf16(hv.x, hv.y); hw[2 * q + 1] = pg8::cvt_pk_bf16(hv.z, hv.w); }
            if (GM) { unsigned short* o = (unsigned short*)(c.ws + WS_AS5) + ((size_t)c.lane * 1280 + (r >> 5)) * 768 + (r & 31) * 16;
                *(pg8::u32x4*)o = (pg8::u32x4){hw[0], hw[1], hw[2], hw[3]}; *(pg8::u32x4*)(o + 8) = (pg8::u32x4){hw[4], hw[5], hw[6], hw[7]}; }
            else { unsigned short* o = (unsigned short*)(c.ws + WS_HB1) + (size_t)r * D;
#pragma unroll
                for (int q = 0; q < 4; ++q) *(pg8::u32x2*)(o + ch[q]) = (pg8::u32x2){hw[2 * q], hw[2 * q + 1]}; }
        }
    }
}

__device__ __forceinline__ void phase_norm2_router(const Ctx& c, int L, LAS float* wT) {
    const float* X = (const float*)(c.ws + WS_X); unsigned short* HB = (unsigned short*)(c.ws + WS_HB); float* AFF = (float*)(c.ws + WS_AFF);
    const float* WR = c.in[IN_ROUTER] + (size_t)L * D * NE;
    __syncthreads();
    for (int idx = c.tid; idx < D * 4; idx += 512) { const int ch = idx >> 2, e4 = idx & 3; const f32x4 w = *(const f32x4*)(WR + (size_t)ch * NE + 4 * e4);
        wT[(4 * e4 + 0) * D + ch] = w.x; wT[(4 * e4 + 1) * D + ch] = w.y; wT[(4 * e4 + 2) * D + ch] = w.z; wT[(4 * e4 + 3) * D + ch] = w.w; }
    __syncthreads();
    for (int r = c.gw; r < NROWS; r += c.ngw) {
        const int j = row_j(r);
        const f32x4* xp = (const f32x4*)(X + (size_t)r * D) + c.lane;
        f32x4 v[4]; float ss = 0.f;
#pragma unroll
        for (int q = 0; q < 4; ++q) { v[q] = xp[64 * q]; ss += v[q].x * v[q].x + v[q].y * v[q].y + v[q].z * v[q].z + v[q].w * v[q].w; }
        const float rstd = rsqrtf(wave_sum(ss) * (1.0f / D) + EPS);
        const f32x4* g = (const f32x4*)(c.in[IN_NORMG] + (size_t)(L * 2 + 1) * D) + c.lane;
        const f32x4* sc = (const f32x4*)modp(c, L, j, 4) + c.lane; const f32x4* sh = (const f32x4*)modp(c, L, j, 3) + c.lane;
        pg8::u32x2* hp = (pg8::u32x2*)(HB + (size_t)r * D) + c.lane;
        float lg[16];
#pragma unroll
        for (int e = 0; e < 16; ++e) lg[e] = 0.f;
#pragma unroll
        for (int q = 0; q < 4; ++q) {
            const f32x4 f = v[q] * rstd * g[64 * q] * (1.0f + sc[64 * q]) + sh[64 * q];
            hp[64 * q] = (pg8::u32x2){pg8::cvt_pk_bf16(f.x, f.y), pg8::cvt_pk_bf16(f.z, f.w)};
#pragma unroll
            for (int e = 0; e < 16; ++e) { const f32x4 wv = *(const LAS f32x4*)(wT + e * D + 4 * (c.lane + 64 * q)); lg[e] += (f.x * wv.x + f.y * wv.y) + (f.z * wv.z + f.w * wv.w); }
        }
        const float mine = reduce16(lg, c.lane);
        const int k = reduce16_k(c.lane);
        float mx = mine;
#pragma unroll
        for (int o = 4; o < 64; o <<= 1) mx = fmaxf(mx, __shfl_xor(mx, o));
        const float ex = expf(mine - mx);
        float den = ex;
#pragma unroll
        for (int o = 4; o < 64; o <<= 1) den += __shfl_xor(den, o);
        if ((c.lane & 3) == 0) AFF[(size_t)r * NE + k] = ex / den;
    }
}

__device__ __forceinline__ void phase_topk(const Ctx& c, LAS unsigned* lds32) {
    const float* AFF = (const float*)(c.ws + WS_AFF);
    int* SELROW = (int*)(c.ws + WS_SELROW); float* SELGATE = (float*)(c.ws + WS_SELGATE); int* SLOT = (int*)(c.ws + WS_SLOT);
    LAS unsigned* hist = lds32; LAS unsigned* wsum = lds32 + 256; LAS unsigned* res = lds32 + 272;
    for (int pid = blockIdx.x; pid < 256; pid += gridDim.x) {
        const bool lat = pid < 128; const int q = lat ? pid : pid - 128, b = q >> 4, e = q & 15;
        const int N = lat ? T : CL, C = lat ? CAP_LAT : CAP_CTX, row0 = b * RB + (lat ? CL : 0), base = lat ? b * CAP_LAT : NB * CAP_LAT + b * CAP_CTX;
        const int t0 = c.tid * 8; const bool valid = t0 < N;
        unsigned k[8];
#pragma unroll
        for (int i = 0; i < 8; ++i) k[i] = valid ? __float_as_uint(AFF[(size_t)(row0 + t0 + i) * NE + e]) : 0u;
        unsigned prefix = 0u, want = (unsigned)C;
#pragma unroll
        for (int r = 0; r < 4; ++r) {
            const int shift = 24 - 8 * r;
            __syncthreads();
            if (c.tid < 256) hist[c.tid] = 0u;
            __syncthreads();
            if (valid) {
#pragma unroll
                for (int i = 0; i < 8; ++i) if (r == 0 || (k[i] >> (shift + 8)) == prefix) __hip_atomic_fetch_add(&hist[(k[i] >> shift) & 255u], 1u, __ATOMIC_RELAXED, __HIP_MEMORY_SCOPE_WORKGROUP);
            }
            __syncthreads();
            if (c.wave == 0) {
                const unsigned h0 = hist[4 * c.lane], h1 = hist[4 * c.lane + 1], h2 = hist[4 * c.lane + 2], h3 = hist[4 * c.lane + 3];
                unsigned suf = h0 + h1 + h2 + h3;
#pragma unroll
                for (int off = 1; off < 64; off <<= 1) { const unsigned o = __shfl_down(suf, off); if (c.lane + off < 64) suf += o; }
                unsigned nxt = __shfl_down(suf, 1); if (c.lane == 63) nxt = 0u;
                if (suf >= want && nxt < want) {
                    unsigned above = nxt; int d;
                    if (above + h3 >= want) d = 3; else { above += h3; if (above + h2 >= want) d = 2; else { above += h2; if (above + h1 >= want) d = 1; else { above += h1; d = 0; } } }
                    res[0] = (unsigned)(4 * c.lane + d); res[1] = want - above;
                }
            }
            __syncthreads();
            prefix = (prefix << 8) | res[0]; want = res[1];
        }
        const unsigned thr = prefix, need_eq = want;
        unsigned cg = 0u, ce = 0u;
#pragma unroll
        for (int i = 0; i < 8; ++i) { cg += (valid && k[i] > thr) ? 1u : 0u; ce += (valid && k[i] == thr) ? 1u : 0u; }
        unsigned incl = cg | (ce << 16);
#pragma unroll
        for (int off = 1; off < 64; off <<= 1) { const unsigned o = __shfl_up(incl, off); if (c.lane >= off) incl += o; }
        __syncthreads();
        if (c.lane == 63) wsum[c.wave] = incl;
        __syncthreads();
        unsigned wbase = 0u;
#pragma unroll
        for (int w = 0; w < 8; ++w) if (w < c.wave) wbase += wsum[w];
        const unsigned excl = wbase + incl - (cg | (ce << 16));
        unsigned gb = excl & 0xffffu, eb = excl >> 16;
        if (valid) {
#pragma unroll
            for (int i = 0; i < 8; ++i) {
                const int row = row0 + t0 + i; const bool isg = k[i] > thr, ise = k[i] == thr;
                const bool sel = isg || (ise && eb < need_eq);
                const unsigned sp = (unsigned)base + gb + (eb < need_eq ? eb : need_eq);
                if (sel) { SELROW[e * EROWS + sp] = row; SELGATE[e * EROWS + sp] = __uint_as_float(k[i]); SLOT[(size_t)row * NE + e] = (int)sp; }
                else SLOT[(size_t)row * NE + e] = -1;
                gb += isg ? 1u : 0u; eb += ise ? 1u : 0u;
            }
        }
    }
}

__device__ __forceinline__ void phase_postproj(const Ctx& c, int i) {
    float* P = (float*)(c.ws + WS_P); const float* rope = (const float*)(c.ws + WS_ROPE);
    unsigned short* QA = (unsigned short*)(c.ws + WS_QA); unsigned short* KA = (unsigned short*)(c.ws + WS_KA); unsigned short* VA = (unsigned short*)(c.ws + WS_VA);
    unsigned short* RQ = (unsigned short*)(c.ws + WS_RQ); unsigned short* RK = (unsigned short*)(c.ws + WS_RK); unsigned short* RV = (unsigned short*)(c.ws + WS_RV);
    const float* qkg = c.in[IN_QKG] + (size_t)i * 2 * 64;
    for (int job = c.gt; job < NROWS * 36; job += c.ngt) {
        const int row = job / 36, hj = job - row * 36; const int s = row % RB;
        int col0, type; unsigned short* dst = nullptr;
        if (hj >= 28) { col0 = 1024 + (hj - 28) * 64; type = 4; dst = RV + (size_t)row * 512 + (hj - 28) * 64; }
        else if (hj < 8) { col0 = hj * 64; type = 0; dst = RQ + (size_t)row * 512 + hj * 64; } else if (hj < 16) { col0 = 512 + (hj - 8) * 64; type = 1; dst = RK + (size_t)row * 512 + (hj - 8) * 64; }
        else if (hj < 24) { col0 = 2048 + (hj - 16) * 64; type = 2; dst = QA + (size_t)row * 512 + (hj - 16) * 64; }
        else if (hj < 26) { col0 = 2560 + (hj - 24) * 64; type = 3; dst = KA + (size_t)row * 128 + (hj - 24) * 64; }
        else { col0 = 2688 + (hj - 26) * 64; type = 4; dst = VA + (size_t)row * 128 + (hj - 26) * 64; }
        f32x4* p = (f32x4*)(P + (size_t)row * INW + col0);
        float v[64];
#pragma unroll
        for (int q = 0; q < 16; ++q) { const f32x4 t4 = p[q]; v[4 * q] = t4.x; v[4 * q + 1] = t4.y; v[4 * q + 2] = t4.z; v[4 * q + 3] = t4.w; }
        if (type == 1) {
#pragma unroll
            for (int d = 0; d < 64; ++d) v[d] *= 0.125f;
        }
        if (type == 2 || type == 3) {
            float ss = 0.f;
#pragma unroll
            for (int d = 0; d < 64; ++d) ss += v[d] * v[d];
            const float rs = rsqrtf(ss * (1.0f / 64.0f) + EPS); const float* g = qkg + (type - 2) * 64;
#pragma unroll
            for (int d = 0; d < 64; ++d) v[d] = v[d] * rs * g[d];
        }
        if (s >= CL && type != 4) {
            const int t = s - CL, pr = t >> 6, pc = t & 63;
#pragma unroll
            for (int f = 0; f < 16; ++f) {
                const float cr = rope[2 * (pr * 16 + f)], sr = rope[2 * (pr * 16 + f) + 1], cc = rope[2 * (pc * 16 + f)], sc = rope[2 * (pc * 16 + f) + 1];
                const float x1 = v[f], x2 = v[16 + f], y1 = v[32 + f], y2 = v[48 + f];
                v[f] = x1 * cr - x2 * sr; v[16 + f] = x1 * sr + x2 * cr; v[32 + f] = y1 * cc - y2 * sc; v[48 + f] = y1 * sc + y2 * cc;
            }
        }
        {
            const float sc = (type == 2) ? attn_body::C2 : 1.0f;
#pragma unroll
            for (int q = 0; q < 8; ++q) { pg8::u32x4 w; w.x = pg8::cvt_pk_bf16(v[8 * q] * sc, v[8 * q + 1] * sc); w.y = pg8::cvt_pk_bf16(v[8 * q + 2] * sc, v[8 * q + 3] * sc);
                w.z = pg8::cvt_pk_bf16(v[8 * q + 4] * sc, v[8 * q + 5] * sc); w.w = pg8::cvt_pk_bf16(v[8 * q + 6] * sc, v[8 * q + 7] * sc); ((pg8::u32x4*)dst)[q] = w; }
        }
    }
}

__device__ __forceinline__ void phase_ret_state(const Ctx& c, int i, LAS float* ldsf) {
    const unsigned short* RK = (const unsigned short*)(c.ws + WS_RK); const unsigned short* RV = (const unsigned short*)(c.ws + WS_RV); float* U = (float*)(c.ws + WS_U);
    LAS float* Ks = ldsf; LAS float* Vs = ldsf + 128 * 64; LAS float* wf = ldsf + 2 * 128 * 64; LAS float* wb = wf + 128;
    for (int unit = blockIdx.x; unit < 64 * 34; unit += gridDim.x) {
        const int bh = unit / 34, cch = unit - bh * 34, b = bh >> 3, hh = bh & 7, row0 = b * RB + cch * 128;
        const float lgf = -expf(c.in[IN_RETRATE][(i * 2 + 0) * 8 + hh]) * 1.4426950408889634f, lgb = -expf(c.in[IN_RETRATE][(i * 2 + 1) * 8 + hh]) * 1.4426950408889634f;
        __syncthreads();
        for (int pc = c.tid; pc < 1024; pc += 512) { const int r = pc >> 3, ch = pc & 7;
            const pg8::u32x4 kw = *(const pg8::u32x4*)(RK + (size_t)(row0 + r) * 512 + hh * 64 + ch * 8), vw = *(const pg8::u32x4*)(RV + (size_t)(row0 + r) * 512 + hh * 64 + ch * 8);
#pragma unroll
            for (int e = 0; e < 4; ++e) { Ks[r * 64 + ch * 8 + 2 * e] = __uint_as_float(kw[e] << 16); Ks[r * 64 + ch * 8 + 2 * e + 1] = __uint_as_float(kw[e] & 0xffff0000u);
                Vs[r * 64 + ch * 8 + 2 * e] = __uint_as_float(vw[e] << 16); Vs[r * 64 + ch * 8 + 2 * e + 1] = __uint_as_float(vw[e] & 0xffff0000u); } }
        if (c.tid < 128) { wf[c.tid] = exp2f(lgf * (float)(127 - c.tid)); wb[c.tid] = exp2f(lgb * (float)c.tid); }
        __syncthreads();
        const int dv = c.tid & 63, dkg = c.tid >> 6;
        float uf[8], ub[8];
#pragma unroll
        for (int q = 0; q < 8; ++q) { uf[q] = 0.f; ub[q] = 0.f; }
#pragma unroll 4
        for (int j = 0; j < 128; ++j) {
            const float v = Vs[j * 64 + dv], vf = v * wf[j], vb = v * wb[j];
            const f32x4 k0 = *(const LAS f32x4*)(Ks + j * 64 + dkg * 8), k1 = *(const LAS f32x4*)(Ks + j * 64 + dkg * 8 + 4);
            uf[0] += k0.x * vf; uf[1] += k0.y * vf; uf[2] += k0.z * vf; uf[3] += k0.w * vf; uf[4] += k1.x * vf; uf[5] += k1.y * vf; uf[6] += k1.z * vf; uf[7] += k1.w * vf;
            ub[0] += k0.x * vb; ub[1] += k0.y * vb; ub[2] += k0.z * vb; ub[3] += k0.w * vb; ub[4] += k1.x * vb; ub[5] += k1.y * vb; ub[6] += k1.z * vb; ub[7] += k1.w * vb;
        }
        float* uo = U + ((size_t)(bh * 34 + cch) * 2) * 4096 + dv * 64 + dkg * 8;
        *(f32x4*)uo = (f32x4){uf[0], uf[1], uf[2], uf[3]}; *(f32x4*)(uo + 4) = (f32x4){uf[4], uf[5], uf[6], uf[7]};
        *(f32x4*)(uo + 4096) = (f32x4){ub[0], ub[1], ub[2], ub[3]}; *(f32x4*)(uo + 4096 + 4) = (f32x4){ub[4], ub[5], ub[6], ub[7]};
    }
}
__device__ __forceinline__ void phase_ret_prefix(const Ctx& c, int i) {
    const float* U = (const float*)(c.ws + WS_U); unsigned short* ET = (unsigned short*)(c.ws + WS_ET);
    for (int chain = c.gt; chain < 64 * 2 * 4096; chain += c.ngt) {
        const int bh = chain >> 13, dir = (chain >> 12) & 1, el = chain & 4095, hh = bh & 7;
        const float g128 = expf(-expf(c.in[IN_RETRATE][(i * 2 + dir) * 8 + hh]) * 128.0f);
        float S = 0.f;
#pragma unroll
        for (int st = 0; st < 34; ++st) {
            const int cch = dir == 0 ? st : (st < 2 ? 1 - st : 35 - st);
            const size_t o = ((size_t)(bh * 34 + cch) * 2 + dir) * 4096 + el;
            ET[o] = (unsigned short)(pg8::cvt_pk_bf16(S, 0.f) & 0xffffu);
            S = g128 * S + U[o];
        }
    }
}
__device__ __forceinline__ void phase_ret_main(const Ctx& c, int i, LAS unsigned char* lds) {
    typedef pg8::bf16x8 bf16x8;
    const unsigned short* RQ = (const unsigned short*)(c.ws + WS_RQ); const unsigned short* RK = (const unsigned short*)(c.ws + WS_RK); const unsigned short* RV = (const unsigned short*)(c.ws + WS_RV);
    const unsigned short* ET = (const unsigned short*)(c.ws + WS_ET); const float* P = (const float*)(c.ws + WS_P); unsigned short* MIX = (unsigned short*)(c.ws + WS_MIX);
    const float* gn = c.in[IN_RETGN] + (size_t)i * 512;
    constexpr int QS = 0, KS = 18432, VTS = 36864, EF = 54272, EB = 63488;
    const int li = c.lane & 15, q4 = c.lane >> 4, i0 = 16 * c.wave, ig = i0 + li;
    for (int unit = blockIdx.x; unit < 64 * 34; unit += gridDim.x) {
        const int bh = unit / 34, cch = unit - bh * 34, b = bh >> 3, hh = bh & 7, row0 = b * RB + cch * 128;
        const float lgf = -expf(c.in[IN_RETRATE][(i * 2 + 0) * 8 + hh]) * 1.4426950408889634f, lgb = -expf(c.in[IN_RETRATE][(i * 2 + 1) * 8 + hh]) * 1.4426950408889634f;
        __syncthreads();
        for (int pc = c.tid; pc < 1024; pc += 512) { const int r = pc >> 3, ch = pc & 7; const size_t go = (size_t)(row0 + r) * 512 + hh * 64 + ch * 8;
            *(LAS pg8::u32x4*)(lds + QS + r * 144 + ch * 16) = *(const pg8::u32x4*)(RQ + go);
            *(LAS pg8::u32x4*)(lds + KS + r * 144 + ch * 16) = *(const pg8::u32x4*)(RK + go);
            const pg8::u32x4 vw = *(const pg8::u32x4*)(RV + go);
#pragma unroll
            for (int e = 0; e < 4; ++e) { *(LAS unsigned short*)(lds + VTS + (ch * 8 + 2 * e) * 272 + r * 2) = (unsigned short)(vw[e] & 0xffffu); *(LAS unsigned short*)(lds + VTS + (ch * 8 + 2 * e + 1) * 272 + r * 2) = (unsigned short)(vw[e] >> 16); } }
        { const int r = c.tid >> 3, ch = c.tid & 7; const size_t go = ((size_t)(bh * 34 + cch) * 2) * 4096 + r * 64 + ch * 8;
            *(LAS pg8::u32x4*)(lds + EF + r * 144 + ch * 16) = *(const pg8::u32x4*)(ET + go); *(LAS pg8::u32x4*)(lds + EB + r * 144 + ch * 16) = *(const pg8::u32x4*)(ET + go + 4096); }
        __syncthreads();
        bf16x8 qf[2];
#pragma unroll
        for (int s = 0; s < 2; ++s) qf[s] = *(const LAS bf16x8*)(lds + QS + (i0 + li) * 144 + (32 * s + 8 * q4) * 2);
        pg8::u32x2 pk[8];
#pragma unroll
        for (int jt = 0; jt < 8; ++jt) {
            f32x4 a = {0.f, 0.f, 0.f, 0.f};
#pragma unroll
            for (int s = 0; s < 2; ++s) { const bf16x8 kf = *(const LAS bf16x8*)(lds + KS + (16 * jt + li) * 144 + (32 * s + 8 * q4) * 2); a = __builtin_amdgcn_mfma_f32_16x16x32_bf16(kf, qf[s], a, 0, 0, 0); }
            float pv[4];
#pragma unroll
            for (int r = 0; r < 4; ++r) { const int dl = ig - (16 * jt + 4 * q4 + r); const float w = dl >= 0 ? exp2f(lgf * (float)dl) : exp2f(lgb * (float)(-dl)); pv[r] = a[r] * w; }
            pk[jt] = (pg8::u32x2){pg8::cvt_pk_bf16(pv[0], pv[1]), pg8::cvt_pk_bf16(pv[2], pv[3])};
        }
        const float sf = exp2f(lgf * (float)(ig + 1)), sb = exp2f(lgb * (float)(128 - ig));
        f32x4 oacc[4];
#pragma unroll
        for (int dvt = 0; dvt < 4; ++dvt) {
            f32x4 o = {0.f, 0.f, 0.f, 0.f};
#pragma unroll
            for (int u = 0; u < 4; ++u) {
                const pg8::u32x2 vlo = *(const LAS pg8::u32x2*)(lds + VTS + (16 * dvt + li) * 272 + (32 * u + 4 * q4) * 2), vhi = *(const LAS pg8::u32x2*)(lds + VTS + (16 * dvt + li) * 272 + (32 * u + 16 + 4 * q4) * 2);
                const pg8::u32x4 av = {vlo.x, vlo.y, vhi.x, vhi.y}, bv = {pk[2 * u].x, pk[2 * u].y, pk[2 * u + 1].x, pk[2 * u + 1].y};
                o = __builtin_amdgcn_mfma_f32_16x16x32_bf16(__builtin_bit_cast(bf16x8, av), __builtin_bit_cast(bf16x8, bv), o, 0, 0, 0);
            }
            f32x4 tf = {0.f, 0.f, 0.f, 0.f}, tb = {0.f, 0.f, 0.f, 0.f};
#pragma unroll
            for (int s = 0; s < 2; ++s) {
                const bf16x8 ef = *(const LAS bf16x8*)(lds + EF + (16 * dvt + li) * 144 + (32 * s + 8 * q4) * 2), eb = *(const LAS bf16x8*)(lds + EB + (16 * dvt + li) * 144 + (32 * s + 8 * q4) * 2);
                tf = __builtin_amdgcn_mfma_f32_16x16x32_bf16(ef, qf[s], tf, 0, 0, 0); tb = __builtin_amdgcn_mfma_f32_16x16x32_bf16(eb, qf[s], tb, 0, 0, 0);
            }
            oacc[dvt] = o + tf * sf + tb * sb;
        }
        float sm = 0.f;
#pragma unroll
        for (int dvt = 0; dvt < 4; ++dvt) sm += (oacc[dvt].x + oacc[dvt].y) + (oacc[dvt].z + oacc[dvt].w);
        sm += __shfl_xor(sm, 16); sm += __shfl_xor(sm, 32);
        const float mu = sm * (1.0f / 64.0f); float vr = 0.f;
#pragma unroll
        for (int dvt = 0; dvt < 4; ++dvt) { oacc[dvt] = oacc[dvt] - mu; vr += (oacc[dvt].x * oacc[dvt].x + oacc[dvt].y * oacc[dvt].y) + (oacc[dvt].z * oacc[dvt].z + oacc[dvt].w * oacc[dvt].w); }
        vr += __shfl_xor(vr, 16); vr += __shfl_xor(vr, 32);
        const float rs = rsqrtf(vr * (1.0f / 64.0f) + EPS);
        const size_t row = (size_t)(row0 + ig);
#pragma unroll
        for (int dvt = 0; dvt < 4; ++dvt) { const int dvc = hh * 64 + 16 * dvt + 4 * q4;
            const f32x4 gt = *(const f32x4*)(P + row * INW + 1536 + dvc), gg = *(const f32x4*)(gn + dvc); const f32x4 y = oacc[dvt] * rs * gg;
            *(pg8::u32x2*)(MIX + row * D + dvc) = (pg8::u32x2){pg8::cvt_pk_bf16(gt.x * pg8::fast_sigmoid(gt.x) * y.x, gt.y * pg8::fast_sigmoid(gt.y) * y.y), pg8::cvt_pk_bf16(gt.z * pg8::fast_sigmoid(gt.z) * y.z, gt.w * pg8::fast_sigmoid(gt.w) * y.w)}; }
    }
}

__device__ __forceinline__ void phase_attention(const Ctx& c, char* lds) {
    const attn_body::bf16* QA = (const attn_body::bf16*)(c.ws + WS_QA); const attn_body::bf16* KA = (const attn_body::bf16*)(c.ws + WS_KA); const attn_body::bf16* VA = (const attn_body::bf16*)(c.ws + WS_VA);
    attn_body::bf16* MIX = (attn_body::bf16*)(c.ws + WS_MIX);
    const int G = gridDim.x, bx = blockIdx.x, vcu = (G % 8 == 0) ? (bx % 8) * (G / 8) + bx / 8 : bx;
    for (int U = vcu; U < NB * 8 * 17; U += G) {
        int bh, qrow0, NT;
        if (U < NB * 8 * 16) { bh = U >> 4; qrow0 = (bh >> 3) * RB + CL + (U & 15) * 256; NT = RB / 64; }
        else { bh = U - NB * 8 * 16; qrow0 = (bh >> 3) * RB; NT = CL / 64; }
        const int b = bh >> 3, hh = bh & 7;
        attn_body::attn_unit<8>(QA + (size_t)qrow0 * 512 + hh * 64, KA + (size_t)(b * RB) * 128 + (hh >> 2) * 64, VA + (size_t)(b * RB) * 128 + (hh >> 2) * 64,
                                MIX + (size_t)qrow0 * 1024 + 512 + hh * 64, NT, lds);
    }
}

__device__ __forceinline__ void phase_s5_ops(const Ctx& c, LAS float* ldsf) {
    LAS float* Pre = ldsf; LAS float* Pim = ldsf + 4224; LAS float* KZr = ldsf + 8448; LAS float* KZi = ldsf + 8576;
    LAS float* Bre = ldsf + 8704; LAS float* Bim = ldsf + 9728; LAS float* Cre = ldsf + 10752; LAS float* Cim = ldsf + 12800;
    LAS float* KV = ldsf + 14848;
    for (int task = blockIdx.x; task < 2 * 64; task += gridDim.x) {
        const int i = task >> 6, g = task & 63;
        __syncthreads();
        if (c.tid < 128) {
            const int dir = c.tid >> 6, p = c.tid & 63;
            const float a_re = c.in[IN_S5ARE][((i * 2 + dir) * 64 + g) * 64 + p], a_im = c.in[IN_S5AIM][((i * 2 + dir) * 64 + g) * 64 + p];
            const float dt = expf(c.in[IN_S5DT][(i * 2 + dir) * 64 + g]);
            const float lre = fminf(a_re, -1e-4f), lim = a_im, ea = lre * dt, eb = lim * dt;
            for (int dl = 0; dl <= 32; ++dl) { const float m = expf(ea * (float)dl), an = eb * (float)dl; Pre[(dir * 33 + dl) * 64 + p] = m * cosf(an); Pim[(dir * 33 + dl) * 64 + p] = m * sinf(an); }
            const float cb = cosf(eb), sb = sinf(eb), sh = sinf(0.5f * eb), mag = expf(ea);
            const float nr = expm1f(ea) * cb - 2.0f * sh * sh, ni = mag * sb, den = lre * lre + lim * lim;
            KZr[dir * 64 + p] = (nr * lre + ni * lim) / den; KZi[dir * 64 + p] = (ni * lre - nr * lim) / den;
        }
        for (int idx = c.tid; idx < 1024; idx += 512) { Bre[idx] = c.in[IN_S5BRE][(size_t)(i * 64 + g) * 1024 + idx]; Bim[idx] = c.in[IN_S5BIM][(size_t)(i * 64 + g) * 1024 + idx]; }
        for (int idx = c.tid; idx < 2048; idx += 512) { const int dir = idx >> 10, rem = idx & 1023;
            Cre[idx] = c.in[IN_S5CRE][((size_t)(i * 2 + dir) * 64 + g) * 1024 + rem]; Cim[idx] = c.in[IN_S5CIM][((size_t)(i * 2 + dir) * 64 + g) * 1024 + rem]; }
        __syncthreads();
        for (int e = c.tid; e < 16384; e += 512) {
            const int dir = e >> 13, dl = (e >> 8) & 31, ko = (e >> 4) & 15, ki = e & 15;
            float acc = 0.f;
            for (int p = 0; p < 64; ++p) {
                const float pr = Pre[(dir * 33 + dl) * 64 + p], pi = Pim[(dir * 33 + dl) * 64 + p], kr = KZr[dir * 64 + p], kq = KZi[dir * 64 + p];
                const float gr = pr * kr - pi * kq, gi = pr * kq + pi * kr, br = Bre[p * 16 + ki], bi = Bim[p * 16 + ki];
                const float mr = gr * br - gi * bi, mi = gr * bi + gi * br;
                acc += Cre[(dir * 16 + ko) * 64 + p] * mr - Cim[(dir * 16 + ko) * 64 + p] * mi;
            }
            KV[e] = acc;
        }
        __syncthreads();
        unsigned* TV = (unsigned*)(c.ws + WS_TV) + ((size_t)(i * 64 + g) * 512 * 768) / 2;
        const float* dsk = c.in[IN_S5D] + (size_t)i * D + 16 * g;
        for (int e = c.tid; e < 512 * 384; e += 512) {
            const int nn = e / 384, kp = e - nn * 384, it = nn >> 4, ko = nn & 15;
            float val[2];
#pragma unroll
            for (int z = 0; z < 2; ++z) {
                const int kk = 2 * kp + z;
                if (kk < 512) { const int j = kk >> 4, ki = kk & 15;
                    if (j < it) val[z] = KV[((0 * 32 + (it - j)) * 16 + ko) * 16 + ki];
                    else if (j > it) val[z] = KV[((1 * 32 + (j - it)) * 16 + ko) * 16 + ki];
                    else val[z] = KV[(0 * 16 + ko) * 16 + ki] + KV[((1 * 32) * 16 + ko) * 16 + ki] + (ko == ki ? dsk[ko] : 0.f);
                } else { const int q = kk - 512, dir = q >> 7, part = (q >> 6) & 1, p = q & 63, pw = dir == 0 ? it + 1 : 32 - it;
                    const float pr = Pre[(dir * 33 + pw) * 64 + p], pi = Pim[(dir * 33 + pw) * 64 + p], cr = Cre[(dir * 16 + ko) * 64 + p], ci = Cim[(dir * 16 + ko) * 64 + p];
                    val[z] = part == 0 ? (cr * pr - ci * pi) : -(cr * pi + ci * pr); }
            }
            TV[e] = pg8::cvt_pk_bf16(val[0], val[1]);
        }
        unsigned* WS5 = (unsigned*)(c.ws + WS_WS5) + ((size_t)(i * 64 + g) * 256 * 512) / 2;
        for (int e = c.tid; e < 256 * 256; e += 512) {
            const int q = e >> 8, kp = e & 255, dir = q >> 7, part = (q >> 6) & 1, p = q & 63;
            float val[2];
#pragma unroll
            for (int z = 0; z < 2; ++z) {
                const int kk = 2 * kp + z, j = kk >> 4, ki = kk & 15, pw = dir == 0 ? 31 - j : j;
                const float pr = Pre[(dir * 33 + pw) * 64 + p], pi = Pim[(dir * 33 + pw) * 64 + p], kr = KZr[dir * 64 + p], kq = KZi[dir * 64 + p];
                const float gr = pr * kr - pi * kq, gi = pr * kq + pi * kr, br = Bre[p * 16 + ki], bi = Bim[p * 16 + ki];
                val[z] = part == 0 ? (gr * br - gi * bi) : (gr * bi + gi * br);
            }
            WS5[e] = pg8::cvt_pk_bf16(val[0], val[1]);
        }
    }
}
__device__ __forceinline__ void phase_s5_carry(const Ctx& c, int i) {
    const float* SL = (const float*)(c.ws + WS_SL); unsigned short* AS5 = (unsigned short*)(c.ws + WS_AS5);
    for (int id = c.gt; id < 64 * 8 * 2 * 64; id += c.ngt) {
        const int p = id & 63, dir = (id >> 6) & 1, b = (id >> 7) & 7, g = id >> 10;
        const float a_re = c.in[IN_S5ARE][((i * 2 + dir) * 64 + g) * 64 + p], a_im = c.in[IN_S5AIM][((i * 2 + dir) * 64 + g) * 64 + p];
        const float dt = expf(c.in[IN_S5DT][(i * 2 + dir) * 64 + g]);
        const float lre = fminf(a_re, -1e-4f), m32 = expf(lre * dt * 32.0f), an = a_im * dt * 32.0f, ar = m32 * cosf(an), ai = m32 * sinf(an);
        float xr = 0.f, xi = 0.f;
#pragma unroll 8
        for (int st = 0; st < 136; ++st) {
            const int cch = dir == 0 ? st : (st < 8 ? 7 - st : 143 - st);
            const size_t r = (size_t)g * 1280 + b * 136 + cch;
            unsigned short* xo = AS5 + r * 768 + 512 + dir * 128 + p;
            xo[0] = (unsigned short)(pg8::cvt_pk_bf16(xr, 0.f) & 0xffffu); xo[64] = (unsigned short)(pg8::cvt_pk_bf16(xi, 0.f) & 0xffffu);
            const float sr = SL[r * 256 + dir * 128 + p], si = SL[r * 256 + dir * 128 + 64 + p];
            const float nxr = ar * xr - ai * xi + sr, nxi = ar * xi + ai * xr + si;
            xr = nxr; xi = nxi;
        }
    }
}

__device__ __forceinline__ void cvt_item(const float* W, int ldw, int k0, int scol0, unsigned short* WT, int K, int drow0, LAS float* scr, int lane) {
#pragma unroll 8
    for (int i = 0; i < 32; ++i) { const int kk = 2 * i + (lane >> 5); scr[kk * 33 + (lane & 31)] = W[(size_t)(k0 + kk) * ldw + scol0 + (lane & 31)]; }
    asm volatile("s_waitcnt lgkmcnt(0)" ::: "memory");
    const int cc = lane & 7;
#pragma unroll
    for (int j = 0; j < 4; ++j) { const int n = (lane >> 3) + 8 * j; const LAS float* s = scr + (8 * cc) * 33 + n;
        pg8::u32x4 o; o.x = pg8::cvt_pk_bf16(s[0 * 33], s[1 * 33]); o.y = pg8::cvt_pk_bf16(s[2 * 33], s[3 * 33]); o.z = pg8::cvt_pk_bf16(s[4 * 33], s[5 * 33]); o.w = pg8::cvt_pk_bf16(s[6 * 33], s[7 * 33]);
        *(pg8::u32x4*)(WT + (size_t)(drow0 + n) * K + k0 + 8 * cc) = o; }
    asm volatile("s_waitcnt lgkmcnt(0)" ::: "memory");
}
__device__ __forceinline__ void phase_cvt_moe(const Ctx& c, LAS float* ldsf) {
    LAS float* scr = ldsf + c.wave * (64 * 33);
    unsigned short* W13 = (unsigned short*)(c.ws + WS_W13); unsigned short* W2T = (unsigned short*)(c.ws + WS_W2);
    for (int id = c.gw; id < DEPTH * NE * 3072; id += c.ngw) {
        const int le = id / 3072; int r = id - le * 3072;
        if (r < 2048) { const int kb = r >> 7, nb = r & 127, pn = nb >> 3, rr0 = (nb & 7) * 32;
            const float* srcm = (rr0 < 128 ? c.in[IN_W1] : c.in[IN_W3]) + (size_t)le * D * FF;
            cvt_item(srcm, FF, 64 * kb, 128 * pn + (rr0 & 127), W13 + (size_t)le * 4096 * D, D, 32 * nb, scr, c.lane);
        } else { r -= 2048; const int kb = r >> 5, nb = r & 31;
            cvt_item(c.in[IN_W2] + (size_t)le * FF * D, D, 64 * kb, 32 * nb, W2T + (size_t)le * D * FF, FF, 32 * nb, scr, c.lane); }
    }
    unsigned short* WIN = (unsigned short*)(c.ws + WS_WIN); unsigned short* WOUT = (unsigned short*)(c.ws + WS_WOUT); unsigned short* WGLU = (unsigned short*)(c.ws + WS_WGLU);
    for (int id = c.gw; id < 2 * (1408 + 512 + 1024); id += c.ngw) {
        const int i = id / 2944; int r = id - i * 2944;
        if (r < 1408) { const int kb = r / 88, nb = r - kb * 88; cvt_item(c.in[IN_MIXIN] + (size_t)i * D * INW, INW, 64 * kb, 32 * nb, WIN + (size_t)i * INW * D, D, 32 * nb, scr, c.lane); }
        else if (r < 1920) { r -= 1408; const int kb = r >> 5, nb = r & 31; cvt_item(c.in[IN_MIXOUT] + (size_t)i * D * D, D, 64 * kb, 32 * nb, WOUT + (size_t)i * D * D, D, 32 * nb, scr, c.lane); }
        else { r -= 1920; const int kb = r >> 6, nb = r & 63, pn = nb >> 3, rr0 = (nb & 7) * 32;
            cvt_item(c.in[IN_GLUW] + (size_t)i * D * 2048, 2048, 64 * kb, (rr0 < 128 ? 0 : 1024) + 128 * pn + (rr0 & 127), WGLU + (size_t)i * 2048 * D, D, 32 * nb, scr, c.lane); }
    }
}

struct ALDense { const float* A; int lda; size_t gstride; __device__ __forceinline__ const float* row(int g, int r) const { return A + (size_t)g * gstride + (size_t)r * lda; } };
struct ALGather { const float* A; const int* idx; __device__ __forceinline__ const float* row(int g, int r) const { return A + (size_t)idx[g * EROWS + r] * D; } };
struct BL1 { const float* B; int ldb; size_t gstride; __device__ __forceinline__ const float* ptr(int g, int) const { return B + (size_t)g * gstride; } };
struct BL2 { const float* Ba; const float* Bb; int ldb; size_t gstride; __device__ __forceinline__ const float* ptr(int g, int sub) const { return (sub ? Bb : Ba) + (size_t)g * gstride; } };
struct EPStore { float* O; int ldc; __device__ __forceinline__ void operator()(int, int row, int col, float v, float) const { O[(size_t)row * ldc + col] = v; } };
struct EPResid { float* X; const float* mod; int L; __device__ __forceinline__ void operator()(int, int row, int col, float v, float) const {
    const int j = row_j(row); const float g1 = mod[((size_t)(L * 9 + j) * 6 + 2) * 1024 + col]; X[(size_t)row * D + col] += g1 * v; } };
struct EPGlu { float* X; const float* mod; const float* bias; int L; __device__ __forceinline__ void operator()(int, int row, int col, float va, float vb) const {
    const int j = row_j(row); const float g1 = mod[((size_t)(L * 9 + j) * 6 + 2) * 1024 + col];
    const float o = (va + bias[col]) * sigmoidf_(vb + bias[1024 + col]); X[(size_t)row * D + col] += g1 * o; } };
struct EPSwiglu { float* HID; __device__ __forceinline__ void operator()(int g, int row, int col, float va, float vb) const { HID[((size_t)g * EROWS + row) * FF + col] = siluf_(va) * vb; } };
struct EPGate { float* Y; const float* gate; __device__ __forceinline__ void operator()(int g, int row, int col, float v, float) const { Y[((size_t)g * EROWS + row) * D + col] = gate[g * EROWS + row] * v; } };

__global__ void __launch_bounds__(512, 2) fwd(Args args) {
    extern __shared__ __attribute__((aligned(16))) unsigned char lds[];
    Ctx c; c.in = args.in; c.out = args.out; c.ws = args.ws;
    c.tid = threadIdx.x; c.lane = c.tid & 63; c.wave = __builtin_amdgcn_readfirstlane(c.tid >> 6);
    c.gw = blockIdx.x * 8 + c.wave; c.ngw = gridDim.x * 8; c.gt = blockIdx.x * 512 + c.tid; c.ngt = gridDim.x * 512;
    LAS float* ldsf = (LAS float*)lds; LAS unsigned char* ldsb = (LAS unsigned char*)lds;
    volatile LAS unsigned* MISC = (volatile LAS unsigned*)((LAS unsigned char*)lds + MISC_OFF);
    if (c.tid < 32) MISC[c.tid] = 0u;
    __syncthreads();
    const int lo = args.ph_lo, hi = args.ph_hi;
    const bool one_launch = (hi - lo) > 1;
    XcdBarrier bar; bar.bar = (unsigned*)(c.ws + WS_CTL) + CW_BAR; bar.x = 0; bar.st = MISC + 8;
    if (one_launch) bar = xcd_barrier_post((unsigned*)(c.ws + WS_CTL) + CW_BAR, MISC + 8);
#define IN(k) (lo <= (k) && (k) < hi)
#define SEAM(k) do { if ((k) + 1 < hi) xcd_barrier(bar); } while (0)
#define FRESH(cc) Ctx cc = c; unsigned zq; asm volatile("s_mov_b32 %0, 0" : "=s"(zq)); cc.ws = c.ws + zq; cc.out = c.out + zq; cc.in = (const float* const*)((const char*)c.in + zq); const int Lq = L + (int)zq, iq = Lq >> 1; const float* MOD = (const float*)(cc.ws + WS_MOD); (void)MOD; (void)iq

    if (IN(PH_PRO)) { const int L = 0; FRESH(cc); phase_pro(cc, ldsf); __syncthreads(); phase_s5_ops(cc, ldsf); __syncthreads(); phase_cvt_moe(cc, ldsf); SEAM(PH_PRO); }

#define LAYER_BODY(LL) { constexpr int L = LL; \
        const int pb = 1 + L * PH_PER_LAYER; \
        if (IN(pb + 0)) { FRESH(cc); phase_norm1<false, (L & 1) != 0>(cc, Lq); SEAM(pb + 0); } \
        if ((L & 1) == 0) { \
            if (IN(pb + 1)) { \
                FRESH(cc); \
                pg8::GOrder S; S.init(1, NROWS, INW, (int)gridDim.x, (int)blockIdx.x); \
                pg8::ADense al{(const pg8::bf16_t*)(cc.ws + WS_HB1), 0, nullptr, 0, D, 0, 64}; pg8::EpiF32 ep{(float*)(cc.ws + WS_P), INW, 0}; \
                pg8::gemm_phase(ldsb, al, (const pg8::bf16_t*)(cc.ws + WS_WIN) + (size_t)iq * INW * D, 0, D, S, ep); SEAM(pb + 1); } \
            if (IN(pb + 2)) { FRESH(cc); phase_postproj(cc, iq); SEAM(pb + 2); } \
            if (IN(pb + 3)) { FRESH(cc); phase_ret_state(cc, iq, ldsf); SEAM(pb + 3); } \
            if (IN(pb + 4)) { FRESH(cc); phase_ret_prefix(cc, iq); phase_attention(cc, (char*)lds); SEAM(pb + 4); } \
            if (IN(pb + 5)) { FRESH(cc); phase_ret_main(cc, iq, ldsb); SEAM(pb + 5); } \
            if (IN(pb + 6)) { \
                FRESH(cc); \
                pg8::GOrder S; S.init(1, NROWS, D, (int)gridDim.x, (int)blockIdx.x); \
                pg8::ADense al{(const pg8::bf16_t*)(cc.ws + WS_MIX), 0, nullptr, 0, D, 0, 64}; pg8::EpiResid ep{(float*)(cc.ws + WS_X), MOD + (size_t)Lq * 9 * 6144}; \
                pg8::gemm_phase(ldsb, al, (const pg8::bf16_t*)(cc.ws + WS_WOUT) + (size_t)iq * D * D, 0, D, S, ep); SEAM(pb + 6); } \
        } else { \
            if (IN(pb + 1)) { \
                FRESH(cc); \
                pg8::GOrder S; S.init(64, 1280, 256, (int)gridDim.x, (int)blockIdx.x); \
                pg8::ADense al{(const pg8::bf16_t*)(cc.ws + WS_AS5), (size_t)1280 * 768, nullptr, 0, 768, 0, 64}; pg8::EpiF32 ep{(float*)(cc.ws + WS_SL), 256, (size_t)1280 * 256}; \
                pg8::gemm_phase(ldsb, al, (const pg8::bf16_t*)(cc.ws + WS_WS5) + (size_t)iq * 64 * 256 * 512, (size_t)256 * 512, 512, S, ep); SEAM(pb + 1); } \
            if (IN(pb + 2)) { FRESH(cc); phase_s5_carry(cc, iq); SEAM(pb + 2); } \
            if (IN(pb + 3)) { \
                FRESH(cc); \
                pg8::GOrder S; S.init(64, 1280, 512, (int)gridDim.x, (int)blockIdx.x); \
                pg8::ADense al{(const pg8::bf16_t*)(cc.ws + WS_AS5), (size_t)1280 * 768, nullptr, 0, 768, 0, 64}; pg8::EpiGeluBf16 ep{(pg8::bf16_t*)(cc.ws + WS_ZG), 512, (size_t)1280 * 512}; \
                pg8::gemm_phase(ldsb, al, (const pg8::bf16_t*)(cc.ws + WS_TV) + (size_t)iq * 64 * 512 * 768, (size_t)512 * 768, 768, S, ep); SEAM(pb + 3); } \
            if (IN(pb + 4)) { \
                FRESH(cc); \
                pg8::GOrder S; S.init(1, NROWS, 2048, (int)gridDim.x, (int)blockIdx.x); \
                pg8::ADense al{(const pg8::bf16_t*)(cc.ws + WS_ZG), 0, nullptr, 0, 16, 1280 * 512, (size_t)4 * 1280 * 512}; pg8::EpiGluResid ep{(float*)(cc.ws + WS_X), MOD + (size_t)Lq * 9 * 6144, cc.in[IN_GLUB] + (size_t)iq * 2048}; \
                pg8::gemm_phase(ldsb, al, (const pg8::bf16_t*)(cc.ws + WS_WGLU) + (size_t)iq * 2048 * D, 0, D, S, ep); SEAM(pb + 4); } \
        } \
        if (IN(pb + 7)) { FRESH(cc); phase_norm2_router(cc, Lq, ldsf); SEAM(pb + 7); } \
        if (IN(pb + 8)) { FRESH(cc); phase_topk(cc, (LAS unsigned*)lds); SEAM(pb + 8); } \
        if (IN(pb + 9)) { \
            FRESH(cc); \
            pg8::GOrder S; S.init(NE, EROWS, 2 * FF, (int)gridDim.x, (int)blockIdx.x); \
            pg8::AGather al{(const pg8::bf16_t*)(cc.ws + WS_HB), 0, (const int*)(cc.ws + WS_SELROW), EROWS, D, 0, 64}; \
            pg8::EpiSwiglu ep{(pg8::bf16_t*)(cc.ws + WS_HID), FF, (size_t)EROWS * FF}; \
            pg8::gemm_phase(ldsb, al, (const pg8::bf16_t*)(cc.ws + WS_W13) + (size_t)Lq * NE * 4096 * D, (size_t)4096 * D, D, S, ep); SEAM(pb + 9); } \
        if (IN(pb + 10)) { \
            FRESH(cc); \
            pg8::GOrder S; S.init(NE, EROWS, D, (int)gridDim.x, (int)blockIdx.x); \
            pg8::ADense al{(const pg8::bf16_t*)(cc.ws + WS_HID), (size_t)EROWS * FF, nullptr, 0, FF, 0, 64}; \
            pg8::EpiGate ep{(pg8::bf16_t*)(cc.ws + WS_Y), D, (size_t)EROWS * D, (const float*)(cc.ws + WS_SELGATE), EROWS}; \
            pg8::gemm_phase(ldsb, al, (const pg8::bf16_t*)(cc.ws + WS_W2) + (size_t)Lq * NE * D * FF, (size_t)D * FF, FF, S, ep); SEAM(pb + 10); } \
    }
    LAYER_BODY(0) LAYER_BODY(1) LAYER_BODY(2) LAYER_BODY(3)
#undef LAYER_BODY
    if (IN(PH_FIN)) { const int L = DEPTH; FRESH(cc); phase_norm1<true, false>(cc, DEPTH); }
#undef IN
#undef SEAM
}

static bool phase_valid(int ph) {
    if (ph == PH_PRO || ph == PH_FIN) return true;
    const int L = (ph - 1) / PH_PER_LAYER, k = (ph - 1) % PH_PER_LAYER;
    if (L & 1) return !(k >= 5 && k <= 6);
    return true;
}
extern "C" void kernel_launch(void* const* d_in, const int* in_sizes, int n_in, void* d_out, int out_size, void* d_ws, size_t ws_size, hipStream_t stream) {
    static int grid = 0;
    if (grid == 0) {
        if (n_in != 27 || out_size != NB * T * D || ws_size < WS_END) { fprintf(stderr, "kernel_launch: unexpected shapes (n_in %d out %d ws %zu)\n", n_in, out_size, ws_size); grid = -1; return; }
        int dev = 0, cus = 0;
        if (hipGetDevice(&dev) != hipSuccess || hipDeviceGetAttribute(&cus, hipDeviceAttributeMultiprocessorCount, dev) != hipSuccess) { grid = -1; return; }
        if (hipFuncSetAttribute((const void*)fwd, hipFuncAttributeMaxDynamicSharedMemorySize, LDS_BYTES) != hipSuccess) { grid = -1; return; }
        int per_cu = 0;
        if (hipOccupancyMaxActiveBlocksPerMultiprocessor(&per_cu, (const void*)fwd, 512, LDS_BYTES) != hipSuccess || per_cu < 1) fprintf(stderr, "kernel_launch: occupancy query says %d\n", per_cu);
        (void)hipGetLastError();
        grid = cus;
    }
    if (grid < 0) return;
    if (hipMemsetAsync((char*)d_ws + WS_CTL, 0, CTL_ZERO_BYTES, stream) != hipSuccess) return;
    Args a{};
    for (int i = 0; i < 27; ++i) a.in[i] = (const float*)d_in[i];
    a.out = (float*)d_out; a.ws = (unsigned char*)d_ws;
#if MK_MULTI
    for (int ph = 0; ph < NPH; ++ph) {
        if (!phase_valid(ph)) continue;
        a.ph_lo = ph; a.ph_hi = ph + 1;
        hipLaunchKernelGGL(fwd, dim3(grid), dim3(512), LDS_BYTES, stream, a);
    }
#else
    a.ph_lo = 0; a.ph_hi = NPH;
    hipLaunchKernelGGL(fwd, dim3(grid), dim3(512), LDS_BYTES, stream, a);
#ifdef PROBE_PHASES
    { static const int probe[] = {PROBE_PHASES}; for (unsigned q = 0; q < sizeof(probe) / sizeof(probe[0]); ++q) { a.ph_lo = probe[q]; a.ph_hi = probe[q] + 1; hipLaunchKernelGGL(fwd, dim3(grid), dim3(512), LDS_BYTES, stream, a); } }
#endif
#endif
}
```

```cpp
#include <hip/hip_runtime.h>
#include <hip/hip_bf16.h>
#include <cstdio>
#include <cstdint>

#define GAS __attribute__((address_space(1)))
#define LAS __attribute__((address_space(3)))
typedef float f32x4 __attribute__((ext_vector_type(4)));
typedef float f32x16 __attribute__((ext_vector_type(16)));

constexpr int NB = 8, T = 4096, D = 1024, CL = 256, RB = CL + T  , NROWS = NB * RB  ;
constexpr int DEPTH = 4, NE = 16, FF = 2048, INW = 2816;
constexpr int CAP_LAT = 512, CAP_CTX = 32, EROWS = NB * (CAP_LAT + CAP_CTX)  ;
constexpr float EPS = 1e-6f;
#ifndef MK_MULTI
#define MK_MULTI 0
#endif

constexpr size_t MiB = 1u << 20;
constexpr size_t WS_CTL = 0, CTL_ZERO_BYTES = 1 * MiB;
constexpr size_t WS_MOD = 1 * MiB;
constexpr size_t WS_ROPE = 2 * MiB;
constexpr size_t WS_SELROW = 3 * MiB;
constexpr size_t WS_SELGATE = 3 * MiB + 512 * 1024;
constexpr size_t WS_AFF = 4 * MiB;
constexpr size_t WS_SLOT = 7 * MiB;
constexpr size_t WS_X = 10 * MiB;
constexpr size_t WS_TV = 146 * MiB;
constexpr size_t WS_WS5 = 242 * MiB;
constexpr size_t WS_HB = 282 * MiB;
constexpr size_t WS_W13 = 350 * MiB;
constexpr size_t WS_W2 = 862 * MiB;
constexpr size_t WS_WIN = 1118 * MiB;
constexpr size_t WS_WOUT = 1130 * MiB;
constexpr size_t WS_WGLU = 1134 * MiB;
constexpr size_t WS_HB1 = 1144 * MiB;
constexpr size_t WS_BIG = 1212 * MiB;
constexpr size_t WS_P = WS_BIG;
constexpr size_t WS_RQ = WS_BIG + 374 * MiB;
constexpr size_t WS_RK = WS_BIG + 408 * MiB;
constexpr size_t WS_RV = WS_BIG + 442 * MiB;
constexpr size_t WS_ET = WS_BIG + 476 * MiB;
constexpr size_t WS_MIX = WS_BIG + 510 * MiB;
constexpr size_t WS_QA = WS_BIG + 578 * MiB;
constexpr size_t WS_KA = WS_BIG + 612 * MiB;
constexpr size_t WS_VA = WS_BIG + 621 * MiB;
constexpr size_t WS_U = WS_BIG + 630 * MiB;
constexpr size_t WS_AS5 = WS_BIG;
constexpr size_t WS_SL = WS_BIG + 120 * MiB;
constexpr size_t WS_ZG = WS_BIG + 200 * MiB;
constexpr size_t WS_HID = WS_BIG;
constexpr size_t WS_XS = WS_BIG + 136 * MiB;
constexpr size_t WS_Y = WS_BIG + 272 * MiB;
constexpr size_t WS_END = WS_BIG + 698 * MiB;
constexpr int CW_BAR = 4096;

constexpr int LDS_BYTES = 147456;
constexpr int MISC_OFF = 131072 + 320;

constexpr int PH_PRO = 0, PH_PER_LAYER = 11, PH_FIN = 1 + DEPTH * PH_PER_LAYER, NPH = PH_FIN + 1;

#define XB_TMO      128
#define XB_XCNT(j)  (256  + 64 * (j))
#define XB_XSUB(j)  (1280 + 64 * (j))
#define XB_XGEN(j)  (2304 + 64 * (j))
#define XB_TOP      3328
#define XB_TOPGEN   3392
#define XCD_BAR_WORDS 3456
#define XB_SPIN_CAP (1u << 22)

__device__ __forceinline__ unsigned xb_ld(unsigned* p)              { return __hip_atomic_load(p, __ATOMIC_RELAXED, __HIP_MEMORY_SCOPE_AGENT); }
__device__ __forceinline__ unsigned xb_add(unsigned* p, unsigned v) { return __hip_atomic_fetch_add(p, v, __ATOMIC_RELAXED, __HIP_MEMORY_SCOPE_AGENT); }
__device__ __forceinline__ unsigned xb_xcc_id() { return (unsigned)__builtin_amdgcn_s_getreg((3 << 11) | 20) & 0xFu; }
#define XB_SPIN(cond, bar) do { unsigned _sp = 0; while (cond) { __builtin_amdgcn_s_sleep(1); \
    if ((++_sp & 255u) == 0u) { if (xb_ld(&(bar)[XB_TMO])) break; if (_sp > XB_SPIN_CAP) { atomicAdd(&(bar)[XB_TMO], 1u); break; } } } } while (0)

struct XcdBarrier { unsigned* bar; unsigned x; volatile LAS unsigned* st; };

__device__ __forceinline__ XcdBarrier xcd_barrier_post(unsigned* bar, volatile LAS unsigned* st) {
    XcdBarrier b; b.bar = bar; b.x = xb_xcc_id(); b.st = st;
    if (threadIdx.x == 0) (void)xb_add(&bar[XB_XCNT(b.x)], 1u);
    return b;
}
__device__ __forceinline__ void xcd_barrier_complete(unsigned* bar, unsigned x, unsigned& nloc, unsigned& nx) {
    const unsigned G = gridDim.x * gridDim.y * gridDim.z;
    unsigned sum, cnt, mine, sp = 0u;
    for (;;) {
        sum = 0u; cnt = 0u; mine = 0u;
#pragma unroll
        for (unsigned j = 0; j < 16; ++j) { const unsigned c = xb_ld(&bar[XB_XCNT(j)]); sum += c; cnt += (c > 0u) ? 1u : 0u; mine = (j == x) ? c : mine; }
        if (sum == G) break;
        __builtin_amdgcn_s_sleep(1);
        if ((++sp & 255u) == 0u) { if (xb_ld(&bar[XB_TMO])) break; if (sp > XB_SPIN_CAP) { atomicAdd(&bar[XB_TMO], 1u); break; } }
    }
    nloc = mine > 0u ? mine : 1u; nx = cnt > 0u ? cnt : 1u;
}
__device__ __forceinline__ void xcd_barrier(const XcdBarrier& b) {
    asm volatile("s_waitcnt vmcnt(0)" ::: "memory");
    __syncthreads();
    if (threadIdx.x == 0) {
        unsigned* bar = b.bar;
        __builtin_amdgcn_s_waitcnt(0);
        unsigned nloc = b.st[0], nx = b.st[1];
        if (nloc == 0u) { xcd_barrier_complete(bar, b.x, nloc, nx); b.st[0] = nloc; b.st[1] = nx; }
        const unsigned old = xb_add(&bar[XB_XSUB(b.x)], 1u);
        const unsigned gen = old / nloc;
        if (old + 1u == (gen + 1u) * nloc) {
            __builtin_amdgcn_fence(__ATOMIC_RELEASE, "agent");
            asm volatile("s_waitcnt vmcnt(0)" ::: "memory");
            const unsigned og = xb_add(&bar[XB_TOP], 1u);
            const unsigned tg = og / nx;
            if (og + 1u == (tg + 1u) * nx) xb_add(&bar[XB_TOPGEN], 1u);
            else XB_SPIN(xb_ld(&bar[XB_TOPGEN]) == tg, bar);
            __builtin_amdgcn_fence(__ATOMIC_ACQUIRE, "agent");
            xb_add(&bar[XB_XGEN(b.x)], 1u);
            asm volatile("s_waitcnt vmcnt(0)" ::: "memory");
        } else {
            XB_SPIN(xb_ld(&bar[XB_XGEN(b.x)]) == gen, bar);
            __builtin_amdgcn_fence(__ATOMIC_ACQUIRE, "agent");
            asm volatile("s_waitcnt vmcnt(0)" ::: "memory");
        }
    }
    __syncthreads();
}

struct Args { const float* in[27]; float* out; unsigned char* ws; int ph_lo, ph_hi; };

struct Ctx {
    const float* const* in; float* out; unsigned char* ws;
    int tid, lane, wave, gw, ngw, gt, ngt;
};
enum { IN_X = 0, IN_C, IN_CTX, IN_CCTX, IN_MODW, IN_MODB, IN_NORMG, IN_MIXIN, IN_MIXOUT, IN_RETRATE, IN_RETGN, IN_QKG,
       IN_S5ARE, IN_S5AIM, IN_S5DT, IN_S5BRE, IN_S5BIM, IN_S5CRE, IN_S5CIM, IN_S5D, IN_GLUW, IN_GLUB, IN_ROUTER, IN_W1, IN_W3, IN_W2, IN_FNG };

__device__ __forceinline__ float wave_sum(float v) {
#pragma unroll
    for (int o = 1; o < 64; o <<= 1) v += __shfl_xor(v, o);
    return v;
}
__device__ __forceinline__ float sigmoidf_(float x) { return 1.0f / (1.0f + expf(-x)); }
__device__ __forceinline__ float siluf_(float x) { return x * sigmoidf_(x); }
__device__ __forceinline__ float gelu_tanh(float x) { const float u = 0.7978845608028654f * (x + 0.044715f * x * x * x); return 0.5f * x * (1.0f + tanhf(u)); }
__device__ __forceinline__ const float* modp(const Ctx& c, int L, int j, int chunk) { return (const float*)(c.ws + WS_MOD) + ((size_t)(L * 9 + j) * 6 + chunk) * 1024; }
__device__ __forceinline__ int row_j(int row) { const int b = row / RB, s = row - b * RB; return s < CL ? 8 : b; }

__device__ __forceinline__ float reduce16(const float (&v)[16], int lane) {
    float a[8], b[4], c2[2], d;
    const bool b5 = (lane & 32) != 0, b4 = (lane & 16) != 0, b3 = (lane & 8) != 0, b2 = (lane & 4) != 0;
#pragma unroll
    for (int i = 0; i < 8; ++i) { const float keep = b5 ? v[8 + i] : v[i], send = b5 ? v[i] : v[8 + i]; a[i] = keep + __shfl_xor(send, 32); }
#pragma unroll
    for (int i = 0; i < 4; ++i) { const float keep = b4 ? a[4 + i] : a[i], send = b4 ? a[i] : a[4 + i]; b[i] = keep + __shfl_xor(send, 16); }
#pragma unroll
    for (int i = 0; i < 2; ++i) { const float keep = b3 ? b[2 + i] : b[i], send = b3 ? b[i] : b[2 + i]; c2[i] = keep + __shfl_xor(send, 8); }
    { const float keep = b2 ? c2[1] : c2[0], send = b2 ? c2[0] : c2[1]; d = keep + __shfl_xor(send, 4); }
    d += __shfl_xor(d, 2); d += __shfl_xor(d, 1);
    return d;
}
__device__ __forceinline__ int reduce16_k(int lane) { return ((lane >> 5) & 1) * 8 + ((lane >> 4) & 1) * 4 + ((lane >> 3) & 1) * 2 + ((lane >> 2) & 1); }

namespace pg8 {
typedef unsigned short bf16_t;
typedef short bf16x8 __attribute__((ext_vector_type(8)));
typedef unsigned u32x4 __attribute__((ext_vector_type(4)));
typedef unsigned u32x2 __attribute__((ext_vector_type(2)));
typedef int v8i32 __attribute__((ext_vector_type(8)));
typedef int v4i32 __attribute__((ext_vector_type(4)));
constexpr int BM = 256, BK = 64, HALF = 128, HTB = HALF * BK * 2, STAGE_BYTES = 8 * HTB, NXCD = 8, WGM = 8;
__host__ __device__ __forceinline__ int lds_byte(int r, int c) { const int st = (r >> 4) * 2 + (c >> 5), rr = r & 15, cc = c & 31, ob = rr * 64 + cc * 2; return st * 1024 + (ob ^ (((ob >> 9) & 1) << 5)); }
__host__ __device__ __forceinline__ void stage_rc(int b, int& R, int& C) { const int st = b / 1024, sb = b % 1024, swz = sb ^ (((sb >> 9) & 1) << 5); R = (st >> 1) * 16 + swz / 64; C = (st & 1) * 32 + (swz % 64) / 2; }
__host__ __device__ __forceinline__ int perm32(int rho) { const int n = rho >> 4, i = rho & 15; return 8 * (i >> 2) + 4 * n + (i & 3); }
__device__ __forceinline__ unsigned cvt_pk_bf16(float lo, float hi) { unsigned r; asm volatile("v_cvt_pk_bf16_f32 %0, %1, %2" : "=v"(r) : "v"(lo), "v"(hi)); return r; }

__device__ __forceinline__ unsigned pk4_fp8(float a, float b, float c, float d) {
    a = __builtin_fminf(__builtin_fmaxf(a, -448.f), 448.f); b = __builtin_fminf(__builtin_fmaxf(b, -448.f), 448.f); c = __builtin_fminf(__builtin_fmaxf(c, -448.f), 448.f); d = __builtin_fminf(__builtin_fmaxf(d, -448.f), 448.f);
    unsigned w = 0u; w = (unsigned)__builtin_amdgcn_cvt_pk_fp8_f32(a, b, (int)w, false); w = (unsigned)__builtin_amdgcn_cvt_pk_fp8_f32(c, d, (int)w, true); return w; }
constexpr float W8_SCALE = 32.0f, W8_INV = 1.0f / 32.0f;
struct Unit { int pm, pn, g; };
struct GOrder {
    int nM, nN, per, nwg, G, c;
    __device__ __forceinline__ void init(int groups, int M, int N, int G_, int c_) { nM = M / BM; nN = N / BM; per = nM * nN; nwg = groups * per; G = G_; c = c_; }
    __device__ __forceinline__ bool next(int i, Unit& u) const {
        const long L = (long)i * G + c; if (L >= nwg) return false;
        int wgid = (int)L; { const int q = nwg / NXCD, r = nwg % NXCD, xcd = wgid % NXCD, off = wgid / NXCD; wgid = (xcd < r ? xcd * (q + 1) : r * (q + 1) + (xcd - r) * q) + off; }
        u.g = wgid / per; const int w = wgid - u.g * per;
        const int nig = WGM * nN, gid = w / nig, fm = gid * WGM, gsz = (nM - fm) < WGM ? (nM - fm) : WGM;
        u.pm = fm + ((w % nig) % gsz); u.pn = (w % nig) / gsz; return true;
    }
};
struct ADense  { static constexpr bool GATHER = false; const bf16_t* A; size_t gstride; const int* idx; int rpg; unsigned rowpitch; unsigned cgrp; size_t kstep; };
struct AGather { static constexpr bool GATHER = true;  const bf16_t* A; size_t gstride; const int* idx; int rpg; unsigned rowpitch; unsigned cgrp; size_t kstep; };

template <bool FP8 = false, class Epi, class ALoc>
__device__ __forceinline__ void gemm_phase(LAS unsigned char* lds, const ALoc AL, const void* Bt, size_t gstrideB, int K, const GOrder& S, const Epi& E) {
    constexpr bool GATHER = ALoc::GATHER; constexpr unsigned ESZ = FP8 ? 1u : 2u;
    const int tid = threadIdx.x, wid = __builtin_amdgcn_readfirstlane(tid >> 6), lane = tid & 63, wr = wid >> 2, wc = wid & 3, fr = lane & 15, fq = lane >> 4;
    const int nt = (int)((unsigned)K * ESZ / 128u);
    unsigned voffA[2], voffB[2];
#pragma unroll
    for (int i = 0; i < 2; ++i) { int R, C; stage_rc(tid * 16 + i * 8192, R, C); const int Rb = Epi::PERM ? ((R & ~31) + perm32(R & 31)) : R;
        const unsigned cbytes = AL.cgrp ? ((unsigned)(C >> 4) * AL.cgrp + (unsigned)(C & 15)) * 2u : (unsigned)C * 2u;
        voffA[i] = (unsigned)R * AL.rowpitch * ESZ + cbytes; voffB[i] = (unsigned)Rb * (unsigned)K * ESZ + (unsigned)C * 2u; }
    const size_t kstep = 128, kstepA = AL.kstep * ESZ;
    const size_t hstep = (size_t)HALF * K * ESZ;
    const size_t hstepA = GATHER ? 0 : (size_t)HALF * AL.rowpitch * ESZ, tstepA = 2 * (size_t)HALF * AL.rowpitch * ESZ;
    const size_t tstep = 2 * hstep;
    const unsigned ldsw = (unsigned)wid * 1024u;
    const int aoff0 = FP8 ? lds_byte(wr * 64 + fr, 16 * fq) : lds_byte(wr * 64 + fr, fq * 8);
    const int boff0 = FP8 ? lds_byte(wc * 32 + fr, 16 * fq) : lds_byte(wc * 32 + fr, fq * 8);
    constexpr int KOFF = FP8 ? 16 : 1024;
    unsigned vAc[2][2], vAn[2][2];
#define PG8_SA(b, h) (((b) * 2 + (h)) * HTB)
#define PG8_SB(b, h) ((4 + (b) * 2 + (h)) * HTB)
#define PG8_SBR(b, h) (((b) * 2 + (h)) * HTB)
#define PG8_OPQ(x) do { if constexpr (FP8) asm volatile("" : "+v"(x)); } while (0)
#define PG8_STAGE(bufoff, gbase, voff) do { _Pragma("unroll") for (int _i = 0; _i < 2; ++_i) { unsigned _o = (voff)[_i]; PG8_OPQ(_o); \
        __builtin_amdgcn_global_load_lds((const unsigned*)((const char*)(gbase) + _o), (LAS unsigned*)(lds + (bufoff) + ldsw + _i * 8192), 16, 0, 0); } } while (0)
#define PG8_STAGE_A(bufoff, gbase, h, nx) do { _Pragma("unroll") for (int _i = 0; _i < 2; ++_i) { \
        unsigned _o = GATHER ? ((nx) ? vAn[h][_i] : vAc[h][_i]) : voffA[_i]; PG8_OPQ(_o); \
        __builtin_amdgcn_global_load_lds((const unsigned*)((const char*)(gbase) + (size_t)(h) * hstepA + _o), (LAS unsigned*)(lds + (bufoff) + ldsw + _i * 8192), 16, 0, 0); } } while (0)
#define PG8_GIDX(u, v) do { if (GATHER) { int _t = tid; asm volatile("" : "+v"(_t));   \
        _Pragma("unroll") for (int _i = 0; _i < 2; ++_i) { int _R, _C; stage_rc(_t * 16 + _i * 8192, _R, _C); \
        _Pragma("unroll") for (int _h = 0; _h < 2; ++_h) v[_h][_i] = (unsigned)AL.idx[(u).g * AL.rpg + (u).pm * BM + _h * HALF + _R] * (AL.rowpitch * ESZ) + (unsigned)_C * 2u; } } } while (0)
#define PG8_ABASE(u) ((const char*)AL.A + (GATHER ? (size_t)0 : ((size_t)(u).g * AL.gstride * ESZ + (size_t)(u).pm * tstepA)))
#define PG8_BBASE(u) ((const char*)Bt + (size_t)(u).g * gstrideB * ESZ + (size_t)(u).pn * tstep)
#define PG8_LDA(dst, b, h) do { _Pragma("unroll") for (int m = 0; m < 4; ++m) _Pragma("unroll") for (int k = 0; k < 2; ++k) dst[m][k] = *(const LAS bf16x8*)(lds + PG8_SA(b, h) + aoff0 + k * KOFF + m * 2048); } while (0)
#define PG8_LDB(dst, b, h) do { _Pragma("unroll") for (int n = 0; n < 2; ++n) _Pragma("unroll") for (int k = 0; k < 2; ++k) dst[n][k] = *(const LAS bf16x8*)(lds + PG8_SB(b, h) + boff0 + k * KOFF + n * 2048); } while (0)
#define PG8_CAT8(x) __builtin_shufflevector(__builtin_bit_cast(v4i32, x[0]), __builtin_bit_cast(v4i32, x[1]), 0, 1, 2, 3, 4, 5, 6, 7)
#define PG8_MMA(ai, bj, At, Bt_) do { __builtin_amdgcn_s_setprio(1); _Pragma("unroll") for (int m = 0; m < 4; ++m) _Pragma("unroll") for (int n = 0; n < 2; ++n) { \
        if constexpr (FP8) acc[ai][bj][m][n] = __builtin_amdgcn_mfma_scale_f32_16x16x128_f8f6f4(PG8_CAT8(Bt_[n]), PG8_CAT8(At[m]), acc[ai][bj][m][n], 0, 0, 0, 0x7f7f7f7f, 0, 0x7f7f7f7f); \
        else { _Pragma("unroll") for (int k = 0; k < 2; ++k) acc[ai][bj][m][n] = __builtin_amdgcn_mfma_f32_16x16x32_bf16(Bt_[n][k], At[m][k], acc[ai][bj][m][n], 0, 0, 0); } } \
        __builtin_amdgcn_s_setprio(0); } while (0)
#define PG8_WAIT_V(n) asm volatile("s_waitcnt vmcnt(" #n ")" ::: "memory")
#define PG8_WAIT_L(n) asm volatile("s_waitcnt lgkmcnt(" #n ")" ::: "memory")
#define PG8_BAR __builtin_amdgcn_s_barrier()
#define PG8_SCHED __builtin_amdgcn_sched_barrier(0)
    Unit cur, nxt; int ui = 0;
    if (!S.next(0, cur)) return;
    PG8_GIDX(cur, vAc);
    f32x4 acc[2][2][4][2];
#pragma unroll
    for (int a = 0; a < 2; ++a)
#pragma unroll
        for (int b = 0; b < 2; ++b)
#pragma unroll
            for (int m = 0; m < 4; ++m)
#pragma unroll
                for (int n = 0; n < 2; ++n) acc[a][b][m][n] = (f32x4){0.f, 0.f, 0.f, 0.f};
    bf16x8 At[4][2], B0[2][2], B1[2][2];
    const char* cA = PG8_ABASE(cur); const char* cB = PG8_BBASE(cur);
    PG8_STAGE(PG8_SB(0, 0), cB, voffB); PG8_STAGE(PG8_SB(0, 1), cB + hstep, voffB); PG8_STAGE_A(PG8_SA(0, 0), cA, 0, false); PG8_STAGE_A(PG8_SA(0, 1), cA, 1, false);
    if (wr == 1) PG8_BAR;
    PG8_WAIT_V(2); PG8_BAR;
    PG8_STAGE(PG8_SB(1, 0), cB + kstep, voffB); PG8_STAGE_A(PG8_SA(1, 0), cA + kstepA, 0, false); PG8_STAGE(PG8_SB(1, 1), cB + hstep + kstep, voffB);
    PG8_WAIT_V(6); PG8_BAR;
    for (;;) {
        const bool has_next = S.next(ui + 1, nxt);
        if (GATHER) { if (has_next) { PG8_GIDX(nxt, vAn); } }
        const char* nA = has_next ? PG8_ABASE(nxt) : cA; const char* nB = has_next ? PG8_BBASE(nxt) : cB;
        for (int t = 0; t < nt; t += 2) {
            const bool last = (t == nt - 2), lastn = last && has_next;
            const char* a1 = cA + (size_t)(t + 1) * kstepA;
            const char* a2 = last ? nA : cA + (size_t)(t + 2) * kstepA; const char* b2 = last ? nB : cB + (size_t)(t + 2) * kstep;
            const char* a3 = a2 + kstepA; const char* b3 = b2 + kstep;
            PG8_LDB(B0, 0, 0); PG8_LDB(B1, 0, 1); PG8_SCHED; PG8_LDA(At, 0, 0); PG8_STAGE_A(PG8_SA(1, 1), a1, 1, false);
            PG8_WAIT_V(8); PG8_WAIT_L(0); PG8_BAR; PG8_MMA(0, 0, At, B0); PG8_MMA(0, 1, At, B1); PG8_BAR; PG8_SCHED;
            PG8_LDA(At, 0, 1); PG8_STAGE(PG8_SB(0, 0), b2, voffB); PG8_STAGE(PG8_SB(0, 1), b2 + hstep, voffB); PG8_STAGE_A(PG8_SA(0, 0), a2, 0, lastn);
            PG8_WAIT_V(8); PG8_WAIT_L(0); PG8_BAR; PG8_MMA(1, 0, At, B0); PG8_MMA(1, 1, At, B1); PG8_BAR; PG8_SCHED;
            PG8_LDB(B0, 1, 0); PG8_LDB(B1, 1, 1); PG8_SCHED; PG8_LDA(At, 1, 0); PG8_STAGE_A(PG8_SA(0, 1), a2, 1, lastn);
            PG8_WAIT_V(8); PG8_WAIT_L(0); PG8_BAR; PG8_MMA(0, 0, At, B0); PG8_MMA(0, 1, At, B1); PG8_BAR; PG8_SCHED;
            PG8_LDA(At, 1, 1); PG8_STAGE(PG8_SB(1, 0), b3, voffB); PG8_STAGE(PG8_SB(1, 1), b3 + hstep, voffB); PG8_STAGE_A(PG8_SA(1, 0), a3, 0, lastn);
            PG8_WAIT_V(8); PG8_WAIT_L(0); PG8_BAR; PG8_MMA(1, 0, At, B0); PG8_MMA(1, 1, At, B1); PG8_BAR; PG8_SCHED;
        }
        if (wr == 0) PG8_BAR;
        E(acc, cur, wr, wc, fr, fq);
        if (!has_next) break;
#pragma unroll
        for (int a = 0; a < 2; ++a)
#pragma unroll
            for (int b = 0; b < 2; ++b)
#pragma unroll
                for (int m = 0; m < 4; ++m)
#pragma unroll
                    for (int n = 0; n < 2; ++n) acc[a][b][m][n] = (f32x4){0.f, 0.f, 0.f, 0.f};
        cur = nxt; cA = nA; cB = nB; ++ui;
        if (GATHER) {
#pragma unroll
            for (int _h = 0; _h < 2; ++_h)
#pragma unroll
                for (int _i = 0; _i < 2; ++_i) vAc[_h][_i] = vAn[_h][_i]; }
        if (wr == 1) PG8_BAR;
    }
    PG8_WAIT_V(0);
    PG8_BAR;
#undef PG8_SA
#undef PG8_SB
#undef PG8_SBR
#undef PG8_STAGE
#undef PG8_OPQ
#undef PG8_STAGE_A
#undef PG8_GIDX
#undef PG8_ABASE
#undef PG8_BBASE
#undef PG8_LDA
#undef PG8_CAT8
#undef PG8_LDB
#undef PG8_MMA
#undef PG8_WAIT_V
#undef PG8_WAIT_L
#undef PG8_BAR
#undef PG8_SCHED
}

__device__ __forceinline__ float fast_sigmoid(float x) { return __builtin_amdgcn_rcpf(1.0f + __builtin_amdgcn_exp2f(-1.4426950408889634f * x)); }
struct EpiSwiglu {
    static constexpr bool PERM = true;
    unsigned char* O; int ldc; size_t gstride;
    __device__ __forceinline__ void operator()(const f32x4 (&acc)[2][2][4][2], const Unit& u, int wr, int wc, int fr, int fq) const {
        const int row0 = u.pm * BM + wr * 64 + fr, col0 = u.pn * HALF + wc * 32 + 8 * fq;
        unsigned char* base = O + (size_t)u.g * gstride;
#pragma unroll
        for (int ai = 0; ai < 2; ++ai)
#pragma unroll
            for (int m = 0; m < 4; ++m) { unsigned char* rowp = base + (size_t)(row0 + ai * HALF + m * 16) * ldc + col0;
                float o[8];
#pragma unroll
                for (int n = 0; n < 2; ++n)
#pragma unroll
                    for (int q = 0; q < 4; ++q) { const float a = acc[ai][0][m][n][q] * W8_INV, b = acc[ai][1][m][n][q] * W8_INV; o[4 * n + q] = a * fast_sigmoid(a) * b; }
                *(u32x2*)rowp = (u32x2){pk4_fp8(o[0], o[1], o[2], o[3]), pk4_fp8(o[4], o[5], o[6], o[7])}; }
    }
};
struct EpiBf16 {
    static constexpr bool PERM = true;
    bf16_t* O; int ldc;
    __device__ __forceinline__ void operator()(const f32x4 (&acc)[2][2][4][2], const Unit& u, int wr, int wc, int fr, int fq) const {
        const int row0 = u.pm * BM + wr * 64 + fr, col0 = u.pn * BM + wc * 32 + 8 * fq;
#pragma unroll
        for (int ai = 0; ai < 2; ++ai)
#pragma unroll
            for (int m = 0; m < 4; ++m) { bf16_t* rowp = O + (size_t)(row0 + ai * HALF + m * 16) * ldc + col0;
#pragma unroll
                for (int bj = 0; bj < 2; ++bj) { const f32x4 v0 = acc[ai][bj][m][0], v1 = acc[ai][bj][m][1];
                    u32x4 w; w.x = cvt_pk_bf16(v0[0], v0[1]); w.y = cvt_pk_bf16(v0[2], v0[3]); w.z = cvt_pk_bf16(v1[0], v1[1]); w.w = cvt_pk_bf16(v1[2], v1[3]);
                    *(u32x4*)(rowp + bj * HALF) = w; } }
    }
};
struct EpiGeluBf16 {
    static constexpr bool PERM = true;
    bf16_t* O; int ldc; size_t gstride;
    __device__ __forceinline__ void operator()(const f32x4 (&acc)[2][2][4][2], const Unit& u, int wr, int wc, int fr, int fq) const {
        const int row0 = u.pm * BM + wr * 64 + fr, col0 = u.pn * BM + wc * 32 + 8 * fq;
        bf16_t* base = O + (size_t)u.g * gstride;
#pragma unroll
        for (int ai = 0; ai < 2; ++ai)
#pragma unroll
            for (int m = 0; m < 4; ++m) { bf16_t* rowp = base + (size_t)(row0 + ai * HALF + m * 16) * ldc + col0;
#pragma unroll
                for (int bj = 0; bj < 2; ++bj) { float o[8];
#pragma unroll
                    for (int n = 0; n < 2; ++n)
#pragma unroll
                        for (int q = 0; q < 4; ++q) { const float x = acc[ai][bj][m][n][q]; o[4 * n + q] = x * fast_sigmoid(1.5957691216057308f * (x + 0.044715f * x * x * x)); }
                    u32x4 w; w.x = cvt_pk_bf16(o[0], o[1]); w.y = cvt_pk_bf16(o[2], o[3]); w.z = cvt_pk_bf16(o[4], o[5]); w.w = cvt_pk_bf16(o[6], o[7]);
                    *(u32x4*)(rowp + bj * HALF) = w; } }
    }
};
struct EpiGate {
    static constexpr bool PERM = true;
    bf16_t* O; int ldc; size_t gstride; const float* gate; int rpg;
    __device__ __forceinline__ void operator()(const f32x4 (&acc)[2][2][4][2], const Unit& u, int wr, int wc, int fr, int fq) const {
        const int row0 = u.pm * BM + wr * 64 + fr, col0 = u.pn * BM + wc * 32 + 8 * fq;
        bf16_t* base = O + (size_t)u.g * gstride;
#pragma unroll
        for (int ai = 0; ai < 2; ++ai)
#pragma unroll
            for (int m = 0; m < 4; ++m) { const int row = row0 + ai * HALF + m * 16; const float gt = gate[u.g * rpg + row] * W8_INV; bf16_t* rowp = base + (size_t)row * ldc + col0;
#pragma unroll
                for (int bj = 0; bj < 2; ++bj) { const f32x4 v0 = acc[ai][bj][m][0] * gt, v1 = acc[ai][bj][m][1] * gt;
                    u32x4 w; w.x = cvt_pk_bf16(v0[0], v0[1]); w.y = cvt_pk_bf16(v0[2], v0[3]); w.z = cvt_pk_bf16(v1[0], v1[1]); w.w = cvt_pk_bf16(v1[2], v1[3]);
                    *(u32x4*)(rowp + bj * HALF) = w; } }
    }
};
struct EpiF32 {
    static constexpr bool PERM = false;
    float* C; int ldc; size_t gstride;
    __device__ __forceinline__ void operator()(const f32x4 (&acc)[2][2][4][2], const Unit& u, int wr, int wc, int fr, int fq) const {
        const int row0 = u.pm * BM + wr * 64 + fr, col0 = u.pn * BM + wc * 32 + 4 * fq;
#pragma unroll
        for (int ai = 0; ai < 2; ++ai)
#pragma unroll
            for (int m = 0; m < 4; ++m) { float* rowp = C + (size_t)u.g * gstride + (size_t)(row0 + ai * HALF + m * 16) * ldc + col0;
#pragma unroll
                for (int bj = 0; bj < 2; ++bj)
#pragma unroll
                    for (int n = 0; n < 2; ++n) *(f32x4*)(rowp + bj * HALF + n * 16) = acc[ai][bj][m][n]; }
    }
};
struct EpiResid {
    static constexpr bool PERM = false;
    float* X; const float* modL;
    __device__ __forceinline__ void operator()(const f32x4 (&acc)[2][2][4][2], const Unit& u, int wr, int wc, int fr, int fq) const {
        const int row0 = u.pm * BM + wr * 64 + fr, col0 = u.pn * BM + wc * 32 + 4 * fq;
        const int b = u.pm / 17, j = (u.pm - b * 17 == 0) ? 8 : b;
        const float* g1 = modL + (size_t)(j * 6 + 2) * 1024 + col0;
        f32x4 gv[2][2];
#pragma unroll
        for (int bj = 0; bj < 2; ++bj)
#pragma unroll
            for (int n = 0; n < 2; ++n) gv[bj][n] = *(const f32x4*)(g1 + bj * HALF + n * 16);
#pragma unroll
        for (int ai = 0; ai < 2; ++ai)
#pragma unroll
            for (int m = 0; m < 4; ++m) { float* rowp = X + (size_t)(row0 + ai * HALF + m * 16) * D + col0;
#pragma unroll
                for (int bj = 0; bj < 2; ++bj)
#pragma unroll
                    for (int n = 0; n < 2; ++n) { f32x4* p = (f32x4*)(rowp + bj * HALF + n * 16); *p = *p + gv[bj][n] * acc[ai][bj][m][n]; } }
    }
};
struct EpiGluResid {
    static constexpr bool PERM = false;
    float* X; const float* modL; const float* bias;
    __device__ __forceinline__ void operator()(const f32x4 (&acc)[2][2][4][2], const Unit& u, int wr, int wc, int fr, int fq) const {
        const int row0 = u.pm * BM + wr * 64 + fr, col0 = u.pn * HALF + wc * 32 + 4 * fq;
        const int b = u.pm / 17, j = (u.pm - b * 17 == 0) ? 8 : b;
        const float* g1 = modL + (size_t)(j * 6 + 2) * 1024 + col0;
        f32x4 gv[2], ba[2], bg[2];
#pragma unroll
        for (int n = 0; n < 2; ++n) { gv[n] = *(const f32x4*)(g1 + n * 16); ba[n] = *(const f32x4*)(bias + col0 + n * 16); bg[n] = *(const f32x4*)(bias + 1024 + col0 + n * 16); }
#pragma unroll
        for (int ai = 0; ai < 2; ++ai)
#pragma unroll
            for (int m = 0; m < 4; ++m) { float* rowp = X + (size_t)(row0 + ai * HALF + m * 16) * D + col0;
#pragma unroll
                for (int n = 0; n < 2; ++n) { const f32x4 a = acc[ai][0][m][n] + ba[n], g = acc[ai][1][m][n] + bg[n];
                    f32x4 o; o.x = a.x * fast_sigmoid(g.x); o.y = a.y * fast_sigmoid(g.y); o.z = a.z * fast_sigmoid(g.z); o.w = a.w * fast_sigmoid(g.w);
                    f32x4* p = (f32x4*)(rowp + n * 16); *p = *p + gv[n] * o; } }
    }
};
}

namespace attn_body {
using bf16=__hip_bfloat16;
using bf16x8=__attribute__((ext_vector_type(8)))short;
using s16x4=__attribute__((ext_vector_type(4)))short;
using f32x16=__attribute__((ext_vector_type(16)))float;
using u32x4=__attribute__((ext_vector_type(4)))unsigned;
constexpr int D=64,QP=512,KP=128,OP=1024;
constexpr int NW=8,QBLK=32,QB=QBLK*NW,KVBLK=64;
__device__ __forceinline__ int crow(int r,int hi){return (r&3)+8*(r>>2)+4*hi;}
#define SBAR() __builtin_amdgcn_sched_barrier(0)
__device__ __forceinline__ void cmask(f32x16&p0,f32x16&p1,int jb,int qrel,int hi){
  const float NEG=-INFINITY; int kb=64*jb+4*hi;
  #pragma unroll
  for(int r=0;r<16;++r){int kv=kb+(r&3)+8*(r>>2); if(kv>qrel)p0[r]=NEG; if(kv+32>qrel)p1[r]=NEG;}
}

constexpr int NSLOT=3, SLOTB=8192;
constexpr int LDS_K=0, LDS_V=NSLOT*SLOTB, LDS_WS=2*NSLOT*SLOTB, LDS_OST=LDS_WS+NW*64*4, LDS_BYTES=LDS_OST+NW*4096;
constexpr float C2=0.125f*1.4426950408889634f;
__device__ __forceinline__ void glds16(const void*gsrc,unsigned lds_dst){unsigned keep;
  asm volatile("s_mov_b32 %0, m0\n\ts_mov_b32 m0, %2\n\ts_nop 0\n\tglobal_load_lds_dwordx4 %1, off\n\ts_mov_b32 m0, %0":"=&s"(keep):"v"(gsrc),"s"(lds_dst):"memory");}
__device__ __forceinline__ float max3f(float a,float b,float c){float r;asm("v_max3_f32 %0, %1, %2, %3":"=v"(r):"v"(a),"v"(b),"v"(c));return r;}
__device__ __forceinline__ float max2f(float a,float b){float r;asm("v_max_f32_e32 %0, %1, %2":"=v"(r):"v"(a),"v"(b));return r;}
__device__ __forceinline__ float fadd_s(float a,float b){float r;asm("v_add_f32_e32 %0, %1, %2":"=v"(r):"v"(a),"v"(b));return r;}
__device__ __forceinline__ float fsub_s(float a,float b){float r;asm("v_sub_f32_e32 %0, %1, %2":"=v"(r):"v"(a),"v"(b));return r;}
typedef float f32x2_t __attribute__((ext_vector_type(2))); typedef __bf16 bf16x2_t __attribute__((ext_vector_type(2)));
__device__ __forceinline__ unsigned cvtpk_s(float lo,float hi){f32x2_t v={lo,hi};bf16x2_t b=__builtin_convertvector(v,bf16x2_t);return __builtin_bit_cast(unsigned,b);}
#define WAIT_BAR(N) asm volatile("s_waitcnt vmcnt(" #N ") lgkmcnt(0)\n\ts_barrier":::"memory")

__device__ __forceinline__ void qkt(f32x16&p0,f32x16&p1,const char*Kslot,const bf16x8*qr,const f32x16&negm,int r32,int hi){
  const char*kb=Kslot+hi*1024+r32*16;
  #pragma unroll
  for(int d0=0;d0<4;++d0){
    const bf16x8 b0=*reinterpret_cast<const bf16x8*>(kb+d0*2048);
    const bf16x8 b1=*reinterpret_cast<const bf16x8*>(kb+d0*2048+512);
    if(d0==0){p0=__builtin_amdgcn_mfma_f32_32x32x16_bf16(b0,qr[0],negm,0,0,0);p1=__builtin_amdgcn_mfma_f32_32x32x16_bf16(b1,qr[0],negm,0,0,0);}
    else{p0=__builtin_amdgcn_mfma_f32_32x32x16_bf16(b0,qr[d0],p0,0,0,0);p1=__builtin_amdgcn_mfma_f32_32x32x16_bf16(b1,qr[d0],p1,0,0,0);}}
}
typedef __attribute__((address_space(3))) const char* lds_cptr;
typedef short v4i16_t __attribute__((ext_vector_type(4)));
__device__ __forceinline__ void kload8(bf16x8*kf,lds_cptr kp){
  kf[0]=*(const __attribute__((address_space(3))) bf16x8*)(kp);      kf[1]=*(const __attribute__((address_space(3))) bf16x8*)(kp+512);
  kf[2]=*(const __attribute__((address_space(3))) bf16x8*)(kp+2048); kf[3]=*(const __attribute__((address_space(3))) bf16x8*)(kp+2560);
  kf[4]=*(const __attribute__((address_space(3))) bf16x8*)(kp+4096); kf[5]=*(const __attribute__((address_space(3))) bf16x8*)(kp+4608);
  kf[6]=*(const __attribute__((address_space(3))) bf16x8*)(kp+6144); kf[7]=*(const __attribute__((address_space(3))) bf16x8*)(kp+6656);
}
__device__ __forceinline__ void kload2(bf16x8*kf,lds_cptr kp,int j){ kf[2*j]=*(const __attribute__((address_space(3))) bf16x8*)(kp+j*2048); kf[2*j+1]=*(const __attribute__((address_space(3))) bf16x8*)(kp+j*2048+512); }
__device__ __forceinline__ s16x4 vtr(lds_cptr p){ return __builtin_bit_cast(s16x4,__builtin_amdgcn_ds_read_tr16_b64_v4i16((__attribute__((address_space(3))) v4i16_t*)p)); }
__device__ __forceinline__ float rowmax(const f32x16&p0,const f32x16&p1){
  float a=max3f(p0[0],p0[1],p1[0]),b=max3f(p0[2],p0[3],p1[1]);a=max3f(a,p1[2],p1[3]);
  #pragma unroll
  for(int r=4;r<16;r+=4){a=max3f(a,p0[r],p0[r+1]);b=max3f(b,p0[r+2],p0[r+3]);a=max3f(a,p1[r],p1[r+1]);b=max3f(b,p1[r+2],p1[r+3]);}
  const float m=max2f(a,b);
  auto rr=__builtin_amdgcn_permlane32_swap(__float_as_uint(m),__float_as_uint(m),false,false);
  return max2f(__uint_as_float(rr[0]),__uint_as_float(rr[1]));
}
__device__ __forceinline__ void pv(f32x16*o,int vb,bf16x8 pa0,bf16x8 pa1,bf16x8 pa2,bf16x8 pa3){
  #pragma unroll
  for(int d0=0;d0<2;++d0){s16x4 lo[4],hi[4];
    #pragma unroll
    for(int ks=0;ks<4;++ks){
      asm volatile("ds_read_b64_tr_b16 %0,%1 offset:%c2":"=&v"(lo[ks]):"v"(vb),"i"(d0*4096+ks*1024):"memory");
      asm volatile("ds_read_b64_tr_b16 %0,%1 offset:%c2":"=&v"(hi[ks]):"v"(vb),"i"(d0*4096+ks*1024+512):"memory");}
    asm volatile("s_waitcnt lgkmcnt(0)":::"memory");SBAR();
    #define PK(k) (bf16x8){lo[k][0],lo[k][1],lo[k][2],lo[k][3],hi[k][0],hi[k][1],hi[k][2],hi[k][3]}
    o[d0]=__builtin_amdgcn_mfma_f32_32x32x16_bf16(pa0,PK(0),o[d0],0,0,0);
    o[d0]=__builtin_amdgcn_mfma_f32_32x32x16_bf16(pa1,PK(1),o[d0],0,0,0);
    o[d0]=__builtin_amdgcn_mfma_f32_32x32x16_bf16(pa2,PK(2),o[d0],0,0,0);
    o[d0]=__builtin_amdgcn_mfma_f32_32x32x16_bf16(pa3,PK(3),o[d0],0,0,0);
    #undef PK
  }
}

#ifndef ATTN_STORE16
#define ATTN_STORE16(p,v) (*(u32x4*)(p)=(v))
#endif
template<int THRL> __device__ __forceinline__ void attn_unit(const bf16*Qw0,const bf16*Kh,const bf16*Vh,bf16*Ow0,const int NT,char*shm){
  const int tid=threadIdx.x,lane=tid&63,r32=lane&31,hi=lane>>5; const int wid=__builtin_amdgcn_readfirstlane(tid>>6);
  const bf16*Qw=Qw0+(long)(wid*QBLK)*QP;
  const unsigned lds0=(unsigned)(uintptr_t)shm;
  float*wsf=(float*)(shm+LDS_WS)+wid*64;
  const bf16*ksrc=Kh+(long)lane*KP+wid*8;
  const bf16*vsrc=Vh+(long)(16*(wid&3)+(lane>>2))*KP+(wid>>2)*32+(lane&3)*8;
  const unsigned kdst=lds0+LDS_K+wid*1024, vdst=lds0+LDS_V+wid*1024;
  #define DMA_K(t,slot) glds16(ksrc+(long)(t)*KVBLK*KP,(unsigned)__builtin_amdgcn_readfirstlane(kdst+(slot)))
  #define DMA_V(t,slot) glds16(vsrc+(long)(t)*KVBLK*KP,(unsigned)__builtin_amdgcn_readfirstlane(vdst+(slot)))
  const int vb0=(int)(lds0+LDS_V)+((lane>>4)&1)*32+(lane&3)*8+(4*hi+((lane&15)>>2))*64;
  const char*Kbase=shm+LDS_K; bf16x8 kf[8];
  const lds_cptr shm3=(lds_cptr)shm; const lds_cptr kp0=shm3+LDS_K+hi*1024+r32*16; const lds_cptr vp0=shm3+LDS_V+((lane>>4)&1)*32+(lane&3)*8+(4*hi+((lane&15)>>2))*64;
  DMA_K(0,0);DMA_V(0,0);DMA_K(1,SLOTB);
  bf16x8 qr[4];
  #pragma unroll
  for(int d0=0;d0<4;++d0)qr[d0]=*reinterpret_cast<const bf16x8*>(&Qw[(long)r32*QP+d0*16+hi*8]);
  float mhat=0.f,l_reg=0.f;f32x16 o[2];o[0]=f32x16{};o[1]=f32x16{};f32x16 negm=f32x16{};asm volatile("":"+v"(negm));
  #define CMASK(P0,P1,t) do{}while(0)
  bool resc=false;
  #define START(P0,P1) do{ const float rm=rowmax(P0,P1); resc=false; \
    { const float dl=rm; mhat=fadd_s(mhat,dl); \
      _Pragma("unroll") for(int r=0;r<16;++r){P0[r]=fsub_s(P0[r],dl);P1[r]=fsub_s(P1[r],dl);} \
      _Pragma("unroll") for(int r=0;r<16;++r)negm[r]=-mhat; asm volatile("":"+v"(negm)); } \
    _Pragma("unroll") for(int r=0;r<16;++r)P0[r]=__builtin_amdgcn_exp2f(P0[r]); }while(0)
  #define RESC() do{ if(resc){ asm volatile("s_waitcnt lgkmcnt(0)":::"memory"); \
      _Pragma("unroll") for(int d_=0;d_<2;++d_) _Pragma("unroll") for(int r=0;r<16;++r)o[d_][r]*=wsf[crow(r,hi)]; } }while(0)
  f32x16 pA0,pA1,pB0,pB1;
  int sl_prev=0,sl_cur=0,sl_next=SLOTB;
  #define ROT() do{sl_prev=sl_cur;sl_cur=sl_next;sl_next=(sl_next==(NSLOT-1)*SLOTB)?0:sl_next+SLOTB;}while(0)
  DMA_K(2,2*SLOTB);
  WAIT_BAR(3);
  qkt(pA0,pA1,Kbase,qr,negm,r32,hi);asm volatile("s_nop 15\n\ts_nop 7":"+v"(pA0),"+v"(pA1));CMASK(pA0,pA1,0);
  START(pA0,pA1);
  _Pragma("unroll") for(int r=0;r<16;++r)pA1[r]=__builtin_amdgcn_exp2f(pA1[r]);
  WAIT_BAR(0);
  DMA_K(3,0);DMA_V(1,SLOTB);
  ROT();
  kload8(kf,kp0+sl_cur);
  WAIT_BAR(2);
  s16x4 vlo[8],vhi[8]; u32x4 pw0,pw1,pw2,pw3;
  #define PKW(P,B) cvtpk_s(P[B],P[B+1])
  #define PAF(k) __builtin_bit_cast(bf16x8,pw##k)
  #define VFR(i) (bf16x8){vlo[i][0],vlo[i][1],vlo[i][2],vlo[i][3],vhi[i][0],vhi[i][1],vhi[i][2],vhi[i][3]}
  #define PIN(x) asm volatile("":"+v"(x))
  #define MX3(a,b,c) __builtin_fmaxf(__builtin_fmaxf((a),(b)),(c))
  #define GAPA(MF,A0,A1,A2,A3,W0,W1,PW) do{ MF; sacc+=A0; sacc+=A1; sacc+=A2; sacc+=A3; PIN(sacc); W0; W1; PIN(PW); SBAR(); }while(0)
  #define EX(v) __builtin_amdgcn_exp2f(v)
  #define GAPB(MF,X,B) do{ MF; X[B]=EX(X[B]); X[B+1]=EX(X[B+1]); X[B+2]=EX(X[B+2]); X[B+3]=EX(X[B+3]); PIN(X); SBAR(); }while(0)
  #define VRD(i) do{ vlo[i]=vtr(vp_+(((i)>>2)*4096+((i)&3)*1024)); vhi[i]=vtr(vp_+(((i)>>2)*4096+((i)&3)*1024+512)); }while(0)
  #define KRD(G,j) do{ if(G){ kload2(kf,kp0+sl_next,j); SBAR(); } }while(0)
  #define STEP(C0,C1,P0,P1,t,GK,GV,GL) do{ SBAR(); \
    const lds_cptr vp_=vp0+sl_prev; \
    VRD(0); SBAR(); float sacc=(P0[0]+P0[1]); \
    GAPA(C0=__builtin_amdgcn_mfma_f32_32x32x16_bf16(kf[0],qr[0],negm,0,0,0), P0[2],P0[3],P0[4],P0[5],     pw0[0]=PKW(P0,0), pw0[1]=PKW(P0,2), pw0); \
    VRD(4); SBAR(); GAPA(C1=__builtin_amdgcn_mfma_f32_32x32x16_bf16(kf[1],qr[0],negm,0,0,0), P0[6],P0[7],P0[8],P0[9],     pw0[2]=PKW(P0,4), pw0[3]=PKW(P0,6), pw0); \
    VRD(1); SBAR(); GAPA(C0=__builtin_amdgcn_mfma_f32_32x32x16_bf16(kf[2],qr[1],C0,0,0,0),   P0[10],P0[11],P0[12],P0[13], pw1[0]=PKW(P0,8), pw1[1]=PKW(P0,10), pw1); \
    VRD(5); SBAR(); GAPA(C1=__builtin_amdgcn_mfma_f32_32x32x16_bf16(kf[3],qr[1],C1,0,0,0),   P0[14],P0[15],P1[0],P1[1],   pw1[2]=PKW(P0,12),pw1[3]=PKW(P0,14), pw1); \
    VRD(2); SBAR(); GAPA(C0=__builtin_amdgcn_mfma_f32_32x32x16_bf16(kf[4],qr[2],C0,0,0,0),   P1[2],P1[3],P1[4],P1[5],     pw2[0]=PKW(P1,0), pw2[1]=PKW(P1,2), pw2); \
    VRD(6); SBAR(); GAPA(C1=__builtin_amdgcn_mfma_f32_32x32x16_bf16(kf[5],qr[2],C1,0,0,0),   P1[6],P1[7],P1[8],P1[9],     pw2[2]=PKW(P1,4), pw2[3]=PKW(P1,6), pw2); \
    VRD(3); SBAR(); GAPA(C0=__builtin_amdgcn_mfma_f32_32x32x16_bf16(kf[6],qr[3],C0,0,0,0),   P1[10],P1[11],P1[12],P1[13], pw3[0]=PKW(P1,8), pw3[1]=PKW(P1,10), pw3); \
    VRD(7); SBAR(); GAPA(C1=__builtin_amdgcn_mfma_f32_32x32x16_bf16(kf[7],qr[3],C1,0,0,0),   P1[14],P1[15],0.f,0.f,       pw3[2]=PKW(P1,12),pw3[3]=PKW(P1,14), pw3); \
    l_reg+=sacc; \
    if(GK){DMA_K((t)+3,sl_cur);} if(GV){DMA_V((t)+1,sl_next);} \
    CMASK(C0,C1,t); \
    { float a=MX3(C0[0],C0[1],C1[0]),b=MX3(C0[2],C0[3],C1[1]); a=MX3(a,C1[2],C1[3]); \
      _Pragma("unroll") for(int r=4;r<16;r+=4){a=MX3(a,C0[r],C0[r+1]);b=MX3(b,C0[r+2],C0[r+3]);a=MX3(a,C1[r],C1[r+1]);b=MX3(b,C1[r+2],C1[r+3]);} \
      float rm=__builtin_fmaxf(a,b); { auto rr=__builtin_amdgcn_permlane32_swap(__float_as_uint(rm),__float_as_uint(rm),false,false); rm=__builtin_fmaxf(__uint_as_float(rr[0]),__uint_as_float(rr[1])); } \
      resc=false; \
      if(__builtin_expect(__any(rm>(float)THRL),0)){ const float dl=__builtin_fmaxf(rm,0.f); mhat+=dl; \
        _Pragma("unroll") for(int r=0;r<16;++r){C0[r]-=dl;C1[r]-=dl;} \
        _Pragma("unroll") for(int r=0;r<16;++r)negm[r]=-mhat; asm volatile("":"+v"(negm)); \
        const float f=__builtin_amdgcn_exp2f(-dl); l_reg*=f; if(hi==0)wsf[r32]=f; resc=true; } } \
    SBAR(); \
    GAPB(o[0]=__builtin_amdgcn_mfma_f32_32x32x16_bf16(PAF(0),VFR(0),o[0],0,0,0), C0,0); \
    GAPB(o[1]=__builtin_amdgcn_mfma_f32_32x32x16_bf16(PAF(0),VFR(4),o[1],0,0,0), C0,4); \
    KRD(GL,0); GAPB(o[0]=__builtin_amdgcn_mfma_f32_32x32x16_bf16(PAF(1),VFR(1),o[0],0,0,0), C0,8); \
    KRD(GL,1); GAPB(o[1]=__builtin_amdgcn_mfma_f32_32x32x16_bf16(PAF(1),VFR(5),o[1],0,0,0), C0,12); \
    KRD(GL,2); GAPB(o[0]=__builtin_amdgcn_mfma_f32_32x32x16_bf16(PAF(2),VFR(2),o[0],0,0,0), C1,0); \
    KRD(GL,3); GAPB(o[1]=__builtin_amdgcn_mfma_f32_32x32x16_bf16(PAF(2),VFR(6),o[1],0,0,0), C1,4); \
    GAPB(o[0]=__builtin_amdgcn_mfma_f32_32x32x16_bf16(PAF(3),VFR(3),o[0],0,0,0), C1,8); \
    GAPB(o[1]=__builtin_amdgcn_mfma_f32_32x32x16_bf16(PAF(3),VFR(7),o[1],0,0,0), C1,12); \
    }while(0)
  int t=1;
  #undef CMASK
  #define CMASK(P0,P1,t) do{}while(0)
  for(;t+5<NT;t+=2){
    STEP(pB0,pB1,pA0,pA1,t,true,true,true);     WAIT_BAR(2); RESC(); ROT();
    STEP(pA0,pA1,pB0,pB1,t+1,true,true,true);   WAIT_BAR(2); RESC(); ROT();
  }
  #undef CMASK
  #define CMASK(P0,P1,t) do{}while(0)
  #define ENDW(tt) do{ if((tt)+3<NT){WAIT_BAR(2);} else if((tt)+2<NT){WAIT_BAR(1);} else {WAIT_BAR(0);} }while(0)
  for(;t+1<NT;t+=2){
    STEP(pB0,pB1,pA0,pA1,t,(t+3<NT),(t+1<NT),(t+1<NT));       ENDW(t);   RESC(); ROT();
    STEP(pA0,pA1,pB0,pB1,t+1,(t+4<NT),(t+2<NT),(t+2<NT));     ENDW(t+1); RESC(); ROT();
  }
  STEP(pB0,pB1,pA0,pA1,NT-1,false,false,false); RESC();
  { float sacc=pB0[0]+pB0[1]; _Pragma("unroll") for(int r=2;r<16;++r)sacc+=pB0[r]; _Pragma("unroll") for(int r=0;r<16;++r)sacc+=pB1[r]; l_reg+=sacc;
    pw0=(u32x4){PKW(pB0,0),PKW(pB0,2),PKW(pB0,4),PKW(pB0,6)};pw1=(u32x4){PKW(pB0,8),PKW(pB0,10),PKW(pB0,12),PKW(pB0,14)};pw2=(u32x4){PKW(pB1,0),PKW(pB1,2),PKW(pB1,4),PKW(pB1,6)};pw3=(u32x4){PKW(pB1,8),PKW(pB1,10),PKW(pB1,12),PKW(pB1,14)};
    SBAR(); pv(o,vb0+sl_cur,PAF(0),PAF(1),PAF(2),PAF(3)); }
  #undef PKW
  #undef PAF
  #undef VFR
  #undef PIN
  #undef MX3
  #undef GAPA
  #undef GAPB
  #undef EX
  #undef VRD
  #undef KRD
  #undef STEP
  #undef ENDW
  {auto rr=__builtin_amdgcn_permlane32_swap(__float_as_uint(l_reg),__float_as_uint(l_reg),false,false);l_reg=__uint_as_float(rr[0])+__uint_as_float(rr[1]);}
  if(hi==0)wsf[32+r32]=l_reg;asm volatile("s_waitcnt lgkmcnt(0)":::"memory");
  float rli[16];
  #pragma unroll
  for(int r=0;r<16;++r)rli[r]=__builtin_amdgcn_rcpf(wsf[32+crow(r,hi)]);
  bf16*Ow=Ow0+(long)(wid*QBLK)*OP;
  { bf16*stg=(bf16*)(shm+LDS_OST)+wid*2048;
    #pragma unroll
    for(int r=0;r<16;++r){const int orow=crow(r,hi);
      #pragma unroll
      for(int d0=0;d0<2;++d0)stg[orow*64+d0*32+r32]=__float2bfloat16(o[d0][r]*rli[r]);}
    asm volatile("s_waitcnt lgkmcnt(0)":::"memory");
    #pragma unroll
    for(int i=0;i<4;++i){const int row=i*8+(lane>>3),ch=lane&7; const u32x4 v=*(const u32x4*)(stg+row*64+ch*8); ATTN_STORE16(Ow+(long)row*OP+ch*8,v);} }
  asm volatile("s_waitcnt lgkmcnt(0)\n\ts_barrier":::"memory");
  #undef DMA_K
  #undef DMA_V
  #undef CMASK
  #undef START
  #undef RESC
  #undef ROT
}
constexpr int ATTN_LDS_BYTES=LDS_BYTES;
#undef SBAR
#undef WAIT_BAR
}

template <bool PAIRED, class AL, class BL, class EP>
__device__ __forceinline__ void gemm_f32(int groups, int M, int N, int K, const AL& al, const BL& bl, const EP& ep) {
    const int tid = threadIdx.x, lane = tid & 63, wave = tid >> 6, wm = wave >> 2, wn = wave & 3, r32 = lane & 31, h = lane >> 5;
    constexpr int TN = PAIRED ? 128 : 256;
    const int tilesM = M / 128, tilesN = N / TN, per = tilesM * tilesN, total = groups * per;
    const int ldb = bl.ldb;
    for (int t = blockIdx.x; t < total; t += gridDim.x) {
        const int g = t / per, r = t - g * per, tm = r / tilesN, tn = r - tm * tilesN;
        const int m0 = tm * 128 + wm * 64;
        const int n0 = PAIRED ? (tn * 128 + wn * 32) : (tn * 256 + wn * 64);
        const float* a0 = al.row(g, m0 + r32) + 4 * h;
        const float* a1 = al.row(g, m0 + 32 + r32) + 4 * h;
        const float* b0 = bl.ptr(g, 0) + n0 + r32 + (size_t)(4 * h) * ldb;
        const float* b1 = (PAIRED ? bl.ptr(g, 1) + n0 : bl.ptr(g, 0) + n0 + 32) + r32 + (size_t)(4 * h) * ldb;
        f32x16 acc00 = {}, acc01 = {}, acc10 = {}, acc11 = {};
#pragma unroll 2
        for (int k = 0; k < K; k += 8) {
            const f32x4 av0 = *(const f32x4*)(a0 + k), av1 = *(const f32x4*)(a1 + k);
            float bv0[4], bv1[4];
#pragma unroll
            for (int s = 0; s < 4; ++s) { bv0[s] = b0[(size_t)(k + s) * ldb]; bv1[s] = b1[(size_t)(k + s) * ldb]; }
#pragma unroll
            for (int s = 0; s < 4; ++s) {
                acc00 = __builtin_amdgcn_mfma_f32_32x32x2f32(av0[s], bv0[s], acc00, 0, 0, 0);
                acc01 = __builtin_amdgcn_mfma_f32_32x32x2f32(av0[s], bv1[s], acc01, 0, 0, 0);
                acc10 = __builtin_amdgcn_mfma_f32_32x32x2f32(av1[s], bv0[s], acc10, 0, 0, 0);
                acc11 = __builtin_amdgcn_mfma_f32_32x32x2f32(av1[s], bv1[s], acc11, 0, 0, 0);
            }
        }
#pragma unroll
        for (int rr = 0; rr < 16; ++rr) {
            const int ro = (rr & 3) + 8 * (rr >> 2) + 4 * h;
            if (PAIRED) {
                ep(g, m0 + ro, n0 + r32, acc00[rr], acc01[rr]);
                ep(g, m0 + 32 + ro, n0 + r32, acc10[rr], acc11[rr]);
            } else {
                ep(g, m0 + ro, n0 + r32, acc00[rr], 0.f); ep(g, m0 + ro, n0 + 32 + r32, acc01[rr], 0.f);
                ep(g, m0 + 32 + ro, n0 + r32, acc10[rr], 0.f); ep(g, m0 + 32 + ro, n0 + 32 + r32, acc11[rr], 0.f);
            }
        }
    }
}

__device__ __forceinline__ void phase_pro(const Ctx& c, LAS float* ldsf) {
    float* rope = (float*)(c.ws + WS_ROPE);
    for (int i = c.gt; i < 64 * 16; i += c.ngt) {
        const int pos = i >> 4, fi = i & 15; const float inv = powf(10000.0f, -(float)fi / 16.0f), ang = (float)pos * inv;
        rope[2 * i] = cosf(ang); rope[2 * i + 1] = sinf(ang);
    }
    LAS float* sil = ldsf; LAS float* red = ldsf + 9 * 1024;
    for (int i = c.tid; i < 9 * 1024; i += 512) { const int j = i >> 10, k = i & 1023; const float v = (j < 8) ? c.in[IN_C][j * 1024 + k] : c.in[IN_CCTX][k]; sil[i] = siluf_(v); }
    __syncthreads();
    float* MOD = (float*)(c.ws + WS_MOD);
    for (int task = blockIdx.x; task < DEPTH * 96; task += gridDim.x) {
        const int L = task / 96, cb = task - L * 96, col = cb * 64 + c.lane;
        const float* W = c.in[IN_MODW] + (size_t)L * 1024 * 6144;
        float acc[9];
#pragma unroll
        for (int j = 0; j < 9; ++j) acc[j] = 0.f;
        const int k0 = c.wave * 128;
#pragma unroll 4
        for (int k = k0; k < k0 + 128; ++k) { const float w = W[(size_t)k * 6144 + col];
#pragma unroll
            for (int j = 0; j < 9; ++j) acc[j] += sil[j * 1024 + k] * w; }
#pragma unroll
        for (int j = 0; j < 9; ++j) red[(c.wave * 9 + j) * 64 + c.lane] = acc[j];
        __syncthreads();
        if (c.wave == 0) {
            const float bias = c.in[IN_MODB][L * 6144 + col];
#pragma unroll
            for (int j = 0; j < 9; ++j) { float s = bias;
#pragma unroll
                for (int w = 0; w < 8; ++w) s += red[(w * 9 + j) * 64 + c.lane];
                MOD[(size_t)(L * 9 + j) * 6144 + col] = s; }
        }
        __syncthreads();
    }
    float* X = (float*)(c.ws + WS_X);
    for (int r = c.gw; r < NROWS; r += c.ngw) {
        const int b = r / RB, s = r - b * RB;
        const float* src = (s < CL) ? c.in[IN_CTX] + (size_t)(b * CL + s) * D : c.in[IN_X] + (size_t)(b * T + s - CL) * D;
        const f32x4* sp = (const f32x4*)src + c.lane; f32x4* dp = (f32x4*)(X + (size_t)r * D) + c.lane;
#pragma unroll
        for (int j = 0; j < 4; ++j) dp[64 * j] = sp[64 * j];
    }
}

template <bool FINAL, bool GM>
__device__ __forceinline__ void phase_norm1(const Ctx& c, int L) {
    float* X = (float*)(c.ws + WS_X);
    const int* SLOT = (const int*)(c.ws + WS_SLOT); const unsigned short* Y = (const unsigned short*)(c.ws + WS_Y);
    int ch[4];
#pragma unroll
    for (int q = 0; q < 4; ++q) ch[q] = GM ? 16 * c.lane + 4 * q : 4 * (c.lane + 64 * q);
    int r = c.gw;
    f32x4 vn[4]; int spn = -1;
    if (r < NROWS) {
#pragma unroll
        for (int q = 0; q < 4; ++q) vn[q] = *(const f32x4*)(X + (size_t)r * D + ch[q]);
        if (L > 0 && c.lane < NE) spn = SLOT[(size_t)r * NE + c.lane];
    }
    for (; r < NROWS; r += c.ngw) {
        const int b = r / RB, s = r - b * RB, j = s < CL ? 8 : b;
        float* xr = X + (size_t)r * D;
        f32x4 v[4]; const int spl = spn;
#pragma unroll
        for (int q = 0; q < 4; ++q) v[q] = vn[q];
        { const int rn = r + c.ngw;
            if (rn < NROWS) {
#pragma unroll
                for (int q = 0; q < 4; ++q) vn[q] = *(const f32x4*)(X + (size_t)rn * D + ch[q]);
                if (L > 0 && c.lane < NE) spn = SLOT[(size_t)rn * NE + c.lane];
            } }
        if (FINAL && s < CL) continue;
        if (L > 0) {
            f32x4 sum[4] = {};
            unsigned long long mask = __ballot(spl >= 0 && c.lane < NE);
            while (mask) {
                const int e0 = __builtin_ctzll(mask); mask &= mask - 1;
                const bool two = mask != 0ull; const int e1 = two ? __builtin_ctzll(mask) : e0; if (two) mask &= mask - 1;
                const int sp0 = __builtin_amdgcn_readlane(spl, e0), sp1 = __builtin_amdgcn_readlane(spl, e1);
                const unsigned short* y0 = Y + ((size_t)e0 * EROWS + sp0) * D; const unsigned short* y1 = Y + ((size_t)e1 * EROWS + sp1) * D;
                pg8::u32x2 w0[4], w1[4];
#pragma unroll
                for (int q = 0; q < 4; ++q) { w0[q] = *(const pg8::u32x2*)(y0 + ch[q]); w1[q] = *(const pg8::u32x2*)(y1 + ch[q]); }
#pragma unroll
                for (int q = 0; q < 4; ++q) {
                    sum[q] += (f32x4){__uint_as_float(w0[q].x << 16), __uint_as_float(w0[q].x & 0xffff0000u), __uint_as_float(w0[q].y << 16), __uint_as_float(w0[q].y & 0xffff0000u)};
                    if (two) sum[q] += (f32x4){__uint_as_float(w1[q].x << 16), __uint_as_float(w1[q].x & 0xffff0000u), __uint_as_float(w1[q].y << 16), __uint_as_float(w1[q].y & 0xffff0000u)}; }
            }
            const float* g2 = modp(c, L - 1, j, 5);
#pragma unroll
            for (int q = 0; q < 4; ++q) { v[q] += *(const f32x4*)(g2 + ch[q]) * sum[q]; if (!FINAL) *(f32x4*)(xr + ch[q]) = v[q]; }
        }
        float ss = 0.f;
#pragma unroll
        for (int q = 0; q < 4; ++q) ss += v[q].x * v[q].x + v[q].y * v[q].y + v[q].z * v[q].z + v[q].w * v[q].w;
        const float rstd = rsqrtf(wave_sum(ss) * (1.0f / D) + EPS);
        if (FINAL) {
            const float* g = c.in[IN_FNG]; float* op = c.out + (size_t)(b * T + s - CL) * D;
#pragma unroll
            for (int q = 0; q < 4; ++q) *(f32x4*)(op + ch[q]) = v[q] * rstd * *(const f32x4*)(g + ch[q]);
        } else {
            const float* g = c.in[IN_NORMG] + (size_t)(L * 2 + 0) * D; const float* sc = modp(c, L, j, 1); const float* sh = modp(c, L, j, 0);
            unsigned hw[8];
#pragma unroll
            for (int q = 0; q < 4; ++q) { const f32x4 hv = v[q] * rstd * *(const f32x4*)(g + ch[q]) * (1.0f + *(const f32x4*)(sc + ch[q])) + *(const f32x4*)(sh + ch[q]);
                hw[2 * q] = pg8::cvt_pk_bf16(hv.x, hv.y); hw[2 * q + 1] = pg8::cvt_pk_bf16(hv.z, hv.w); }
            if (GM) { unsigned short* o = (unsigned short*)(c.ws + WS_AS5) + ((size_t)c.lane * 1280 + (r >> 5)) * 768 + (r & 31) * 16;
                *(pg8::u32x4*)o = (pg8::u32x4){hw[0], hw[1], hw[2], hw[3]}; *(pg8::u32x4*)(o + 8) = (pg8::u32x4){hw[4], hw[5], hw[6], hw[7]}; }
            else { unsigned short* o = (unsigned short*)(c.ws + WS_HB1) + (size_t)r * D;
#pragma unroll
                for (int q = 0; q < 4; ++q) *(pg8::u32x2*)(o + ch[q]) = (pg8::u32x2){hw[2 * q], hw[2 * q + 1]}; }
        }
    }
}

__device__ __forceinline__ void phase_norm2_router(const Ctx& c, int L, LAS float* wT) {
    const float* X = (const float*)(c.ws + WS_X); unsigned char* HB = (unsigned char*)(c.ws + WS_HB); float* AFF = (float*)(c.ws + WS_AFF);
    const float* WR = c.in[IN_ROUTER] + (size_t)L * D * NE;
    __syncthreads();
    for (int idx = c.tid; idx < D * 4; idx += 512) { const int ch = idx >> 2, e4 = idx & 3; const f32x4 w = *(const f32x4*)(WR + (size_t)ch * NE + 4 * e4);
        wT[(4 * e4 + 0) * D + ch] = w.x; wT[(4 * e4 + 1) * D + ch] = w.y; wT[(4 * e4 + 2) * D + ch] = w.z; wT[(4 * e4 + 3) * D + ch] = w.w; }
    __syncthreads();
    for (int r = c.gw; r < NROWS; r += c.ngw) {
        const int j = row_j(r);
        const f32x4* xp = (const f32x4*)(X + (size_t)r * D) + c.lane;
        f32x4 v[4]; float ss = 0.f;
#pragma unroll
        for (int q = 0; q < 4; ++q) { v[q] = xp[64 * q]; ss += v[q].x * v[q].x + v[q].y * v[q].y + v[q].z * v[q].z + v[q].w * v[q].w; }
        const float rstd = rsqrtf(wave_sum(ss) * (1.0f / D) + EPS);
        const f32x4* g = (const f32x4*)(c.in[IN_NORMG] + (size_t)(L * 2 + 1) * D) + c.lane;
        const f32x4* sc = (const f32x4*)modp(c, L, j, 4) + c.lane; const f32x4* sh = (const f32x4*)modp(c, L, j, 3) + c.lane;
        unsigned* hp = (unsigned*)(HB + (size_t)r * D) + c.lane;
        float lg[16];
#pragma unroll
        for (int e = 0; e < 16; ++e) lg[e] = 0.f;
#pragma unroll
        for (int q = 0; q < 4; ++q) {
            const f32x4 f = v[q] * rstd * g[64 * q] * (1.0f + sc[64 * q]) + sh[64 * q];
            hp[64 * q] = pg8::pk4_fp8(f.x, f.y, f.z, f.w);
#pragma unroll
            for (int e = 0; e < 16; ++e) { const f32x4 wv = *(const LAS f32x4*)(wT + e * D + 4 * (c.lane + 64 * q)); lg[e] += (f.x * wv.x + f.y * wv.y) + (f.z * wv.z + f.w * wv.w); }
            __builtin_amdgcn_sched_barrier(0);
        }
        const float mine = reduce16(lg, c.lane);
        const int k = reduce16_k(c.lane);
        float mx = mine;
#pragma unroll
        for (int o = 4; o < 64; o <<= 1) mx = fmaxf(mx, __shfl_xor(mx, o));
        const float ex = expf(mine - mx);
        float den = ex;
#pragma unroll
        for (int o = 4; o < 64; o <<= 1) den += __shfl_xor(den, o);
        if ((c.lane & 3) == 0) AFF[(size_t)r * NE + k] = ex / den;
    }
}

__device__ __forceinline__ void phase_topk(const Ctx& c, LAS unsigned* lds32) {
    const float* AFF = (const float*)(c.ws + WS_AFF);
    int* SELROW = (int*)(c.ws + WS_SELROW); float* SELGATE = (float*)(c.ws + WS_SELGATE); int* SLOT = (int*)(c.ws + WS_SLOT);
    LAS unsigned* hist = lds32; LAS unsigned* wsum = lds32 + 256; LAS unsigned* res = lds32 + 272;
    LAS int* srow = (LAS int*)(lds32 + 512);
    const unsigned char* HB = (const unsigned char*)(c.ws + WS_HB); unsigned char* XS = (unsigned char*)(c.ws + WS_XS);
    for (int pid = blockIdx.x; pid < 256; pid += gridDim.x) {
        const bool lat = pid < 128; const int q = lat ? pid : pid - 128, b = q >> 4, e = q & 15;
        const int N = lat ? T : CL, C = lat ? CAP_LAT : CAP_CTX, row0 = b * RB + (lat ? CL : 0), base = lat ? b * CAP_LAT : NB * CAP_LAT + b * CAP_CTX;
        const int t0 = c.tid * 8; const bool valid = t0 < N;
        unsigned k[8];
#pragma unroll
        for (int i = 0; i < 8; ++i) k[i] = valid ? __float_as_uint(AFF[(size_t)(row0 + t0 + i) * NE + e]) : 0u;
        unsigned prefix = 0u, want = (unsigned)C;
#pragma unroll
        for (int r = 0; r < 4; ++r) {
            const int shift = 24 - 8 * r;
            __syncthreads();
            if (c.tid < 256) hist[c.tid] = 0u;
            __syncthreads();
            if (valid) {
#pragma unroll
                for (int i = 0; i < 8; ++i) if (r == 0 || (k[i] >> (shift + 8)) == prefix) __hip_atomic_fetch_add(&hist[(k[i] >> shift) & 255u], 1u, __ATOMIC_RELAXED, __HIP_MEMORY_SCOPE_WORKGROUP);
            }
            __syncthreads();
            if (c.wave == 0) {
                const unsigned h0 = hist[4 * c.lane], h1 = hist[4 * c.lane + 1], h2 = hist[4 * c.lane + 2], h3 = hist[4 * c.lane + 3];
                unsigned suf = h0 + h1 + h2 + h3;
#pragma unroll
                for (int off = 1; off < 64; off <<= 1) { const unsigned o = __shfl_down(suf, off); if (c.lane + off < 64) suf += o; }
                unsigned nxt = __shfl_down(suf, 1); if (c.lane == 63) nxt = 0u;
                if (suf >= want && nxt < want) {
                    unsigned above = nxt; int d;
                    if (above + h3 >= want) d = 3; else { above += h3; if (above + h2 >= want) d = 2; else { above += h2; if (above + h1 >= want) d = 1; else { above += h1; d = 0; } } }
                    res[0] = (unsigned)(4 * c.lane + d); res[1] = want - above;
                }
            }
            __syncthreads();
            prefix = (prefix << 8) | res[0]; want = res[1];
        }
        const unsigned thr = prefix, need_eq = want;
        unsigned cg = 0u, ce = 0u;
#pragma unroll
        for (int i = 0; i < 8; ++i) { cg += (valid && k[i] > thr) ? 1u : 0u; ce += (valid && k[i] == thr) ? 1u : 0u; }
        unsigned incl = cg | (ce << 16);
#pragma unroll
        for (int off = 1; off < 64; off <<= 1) { const unsigned o = __shfl_up(incl, off); if (c.lane >= off) incl += o; }
        __syncthreads();
        if (c.lane == 63) wsum[c.wave] = incl;
        __syncthreads();
        unsigned wbase = 0u;
#pragma unroll
        for (int w = 0; w < 8; ++w) if (w < c.wave) wbase += wsum[w];
        const unsigned excl = wbase + incl - (cg | (ce << 16));
        unsigned gb = excl & 0xffffu, eb = excl >> 16;
        if (valid) {
#pragma unroll
            for (int i = 0; i < 8; ++i) {
                const int row = row0 + t0 + i; const bool isg = k[i] > thr, ise = k[i] == thr;
                const bool sel = isg || (ise && eb < need_eq);
                const unsigned sp = (unsigned)base + gb + (eb < need_eq ? eb : need_eq);
                if (sel) { SELROW[e * EROWS + sp] = row; SELGATE[e * EROWS + sp] = __uint_as_float(k[i]); SLOT[(size_t)row * NE + e] = (int)sp; srow[sp - (unsigned)base] = row; }
                else SLOT[(size_t)row * NE + e] = -1;
                gb += isg ? 1u : 0u; eb += ise ? 1u : 0u;
            }
        }
        __syncthreads();
        for (int s0 = c.wave * 4; s0 < C; s0 += 32) {
            pg8::u32x4 v4[4];
#pragma unroll
            for (int j = 0; j < 4; ++j) v4[j] = *(const pg8::u32x4*)(HB + (size_t)srow[s0 + j] * D + c.lane * 16);
#pragma unroll
            for (int j = 0; j < 4; ++j) *(pg8::u32x4*)(XS + ((size_t)e * EROWS + base + s0 + j) * D + c.lane * 16) = v4[j];
        }
    }
}

__device__ __forceinline__ void post_ld32(const unsigned short* p, float (&v)[32]) {
#pragma unroll
    for (int q = 0; q < 4; ++q) { const pg8::u32x4 w = ((const pg8::u32x4*)p)[q];
#pragma unroll
        for (int e = 0; e < 4; ++e) { v[8 * q + 2 * e] = __uint_as_float(w[e] << 16); v[8 * q + 2 * e + 1] = __uint_as_float(w[e] & 0xffff0000u); } }
}
__device__ __forceinline__ void post_st32(unsigned short* p, const float (&v)[32], float sc) {
#pragma unroll
    for (int q = 0; q < 4; ++q) { pg8::u32x4 w;
#pragma unroll
        for (int e = 0; e < 4; ++e) w[e] = pg8::cvt_pk_bf16(v[8 * q + 2 * e] * sc, v[8 * q + 2 * e + 1] * sc);
        ((pg8::u32x4*)p)[q] = w; }
}
__device__ __forceinline__ void post_rope(float (&v)[32], const float* cs  ) {
#pragma unroll
    for (int f4 = 0; f4 < 8; ++f4) { const f32x4 t4 = ((const f32x4*)cs)[f4];
        { const float x1 = v[2 * f4], x2 = v[16 + 2 * f4]; v[2 * f4] = x1 * t4.x - x2 * t4.y; v[16 + 2 * f4] = x1 * t4.y + x2 * t4.x; }
        { const float x1 = v[2 * f4 + 1], x2 = v[16 + 2 * f4 + 1]; v[2 * f4 + 1] = x1 * t4.z - x2 * t4.w; v[16 + 2 * f4 + 1] = x1 * t4.w + x2 * t4.z; } }
}
__device__ __forceinline__ void phase_post(const Ctx& c, int i, LAS unsigned char* lds) {
    typedef pg8::bf16x8 bf16x8;
    const unsigned short* P = (const unsigned short*)(c.ws + WS_P); const float* rope = (const float*)(c.ws + WS_ROPE);
    unsigned short* QA = (unsigned short*)(c.ws + WS_QA); unsigned short* KA = (unsigned short*)(c.ws + WS_KA); unsigned short* VA = (unsigned short*)(c.ws + WS_VA);
    unsigned short* RQ = (unsigned short*)(c.ws + WS_RQ); unsigned short* RK = (unsigned short*)(c.ws + WS_RK); unsigned short* RV = (unsigned short*)(c.ws + WS_RV);
    float* U = (float*)(c.ws + WS_U);
    const float* qkg = c.in[IN_QKG] + (size_t)i * 2 * 64;
    constexpr int VTS = 0, KTF = 17408, KTB = 34816;
    const int grp = c.tid >> 8, r = (c.tid & 255) >> 1, half = c.tid & 1;
    const int li = c.lane & 15, q4 = c.lane >> 4;
    for (int unit = blockIdx.x; unit < NB * 34 * 8; unit += gridDim.x) {
        const int hh = unit & 7, bc = unit >> 3, b = bc / 34, cch = bc - b * 34, row0 = b * RB + cch * 128, bh = b * 8 + hh;
        const bool latent = cch >= 2;
        const size_t row = (size_t)(row0 + r);
        const int tpos = cch * 128 + r - CL;
        const float* cs = rope + (size_t)((half == 0 ? (tpos >> 6) : (tpos & 63)) * 16) * 2;
        const float lgf = -expf(c.in[IN_RETRATE][(i * 2 + 0) * 8 + hh]) * 1.4426950408889634f, lgb = -expf(c.in[IN_RETRATE][(i * 2 + 1) * 8 + hh]) * 1.4426950408889634f;
        __syncthreads();
        float v[32];
        post_ld32(P + row * INW + (grp ? 512 : 0) + hh * 64 + 32 * half, v);
        if (grp) {
#pragma unroll
            for (int d = 0; d < 32; ++d) v[d] *= 0.125f; }
        if (latent) post_rope(v, cs);
        post_st32((grp ? RK : RQ) + row * 512 + hh * 64 + 32 * half, v, 1.0f);
        if (grp) { const float wf = exp2f(lgf * (float)(127 - r)), wb = exp2f(lgb * (float)r);
#pragma unroll
            for (int d = 0; d < 32; d += 2) { const unsigned pf = pg8::cvt_pk_bf16(v[d] * wf, v[d + 1] * wf), pb = pg8::cvt_pk_bf16(v[d] * wb, v[d + 1] * wb);
                *(LAS unsigned short*)(lds + KTF + (32 * half + d) * 272 + r * 2) = (unsigned short)(pf & 0xffffu); *(LAS unsigned short*)(lds + KTF + (32 * half + d + 1) * 272 + r * 2) = (unsigned short)(pf >> 16);
                *(LAS unsigned short*)(lds + KTB + (32 * half + d) * 272 + r * 2) = (unsigned short)(pb & 0xffffu); *(LAS unsigned short*)(lds + KTB + (32 * half + d + 1) * 272 + r * 2) = (unsigned short)(pb >> 16); } }
        post_ld32(P + row * INW + (grp ? 2048 : 1024) + hh * 64 + 32 * half, v);
        if (grp == 0) { post_st32(RV + row * 512 + hh * 64 + 32 * half, v, 1.0f);
#pragma unroll
            for (int d = 0; d < 32; d += 2) { const unsigned pv = pg8::cvt_pk_bf16(v[d], v[d + 1]);
                *(LAS unsigned short*)(lds + VTS + (32 * half + d) * 272 + r * 2) = (unsigned short)(pv & 0xffffu); *(LAS unsigned short*)(lds + VTS + (32 * half + d + 1) * 272 + r * 2) = (unsigned short)(pv >> 16); }
        } else {
            float ss = 0.f;
#pragma unroll
            for (int d = 0; d < 32; ++d) ss += v[d] * v[d];
            ss += __shfl_xor(ss, 1);
            const float rs = rsqrtf(ss * (1.0f / 64.0f) + EPS);
#pragma unroll
            for (int d = 0; d < 32; ++d) v[d] = v[d] * rs * qkg[32 * half + d];
            if (latent) post_rope(v, cs);
            post_st32(QA + row * 512 + hh * 64 + 32 * half, v, attn_body::C2);
        }
        if (hh < 2) {
            post_ld32(P + row * INW + (grp ? 2688 : 2560) + hh * 64 + 32 * half, v);
            if (grp == 0) {
                float ss = 0.f;
#pragma unroll
                for (int d = 0; d < 32; ++d) ss += v[d] * v[d];
                ss += __shfl_xor(ss, 1);
                const float rs = rsqrtf(ss * (1.0f / 64.0f) + EPS);
#pragma unroll
                for (int d = 0; d < 32; ++d) v[d] = v[d] * rs * qkg[64 + 32 * half + d];
                if (latent) post_rope(v, cs);
                post_st32(KA + row * 128 + hh * 64 + 32 * half, v, 1.0f);
            } else post_st32(VA + row * 128 + hh * 64 + 32 * half, v, 1.0f);
        }
        __syncthreads();
        { const int dir = c.wave >> 2, dvt = c.wave & 3;
            bf16x8 af[4];
#pragma unroll
            for (int u = 0; u < 4; ++u) af[u] = *(const LAS bf16x8*)(lds + VTS + (16 * dvt + li) * 272 + (32 * u + 8 * q4) * 2);
            float* uo = U + ((size_t)(bh * 34 + cch) * 2 + dir) * 4096;
#pragma unroll
            for (int dkt = 0; dkt < 4; ++dkt) {
                f32x4 a = {0.f, 0.f, 0.f, 0.f};
#pragma unroll
                for (int u = 0; u < 4; ++u) { const bf16x8 kf = *(const LAS bf16x8*)(lds + (dir ? KTB : KTF) + (16 * dkt + li) * 272 + (32 * u + 8 * q4) * 2); a = __builtin_amdgcn_mfma_f32_16x16x32_bf16(af[u], kf, a, 0, 0, 0); }
#pragma unroll
                for (int rr = 0; rr < 4; ++rr) uo[(16 * dvt + 4 * q4 + rr) * 64 + 16 * dkt + li] = a[rr];
            } }
    }
}

__device__ __forceinline__ void phase_ret_prefix(const Ctx& c, int i) {
    const float* U = (const float*)(c.ws + WS_U); unsigned short* ET = (unsigned short*)(c.ws + WS_ET);
    for (int chain = c.gt; chain < 64 * 2 * 4096; chain += c.ngt) {
        const int bh = chain >> 13, dir = (chain >> 12) & 1, el = chain & 4095, hh = bh & 7;
        const float g128 = expf(-expf(c.in[IN_RETRATE][(i * 2 + dir) * 8 + hh]) * 128.0f);
        float S = 0.f;
#pragma unroll
        for (int st = 0; st < 34; ++st) {
            const int cch = dir == 0 ? st : (st < 2 ? 1 - st : 35 - st);
            const size_t o = ((size_t)(bh * 34 + cch) * 2 + dir) * 4096 + el;
            ET[o] = (unsigned short)(pg8::cvt_pk_bf16(S, 0.f) & 0xffffu);
            S = g128 * S + U[o];
        }
    }
}
__device__ __forceinline__ void phase_ret_main(const Ctx& c, int i, LAS unsigned char* lds) {
    typedef pg8::bf16x8 bf16x8;
    const unsigned short* RQ = (const unsigned short*)(c.ws + WS_RQ); const unsigned short* RK = (const unsigned short*)(c.ws + WS_RK); const unsigned short* RV = (const unsigned short*)(c.ws + WS_RV);
    const unsigned short* ET = (const unsigned short*)(c.ws + WS_ET); const unsigned short* P = (const unsigned short*)(c.ws + WS_P); unsigned short* MIX = (unsigned short*)(c.ws + WS_MIX);
    const float* gn = c.in[IN_RETGN] + (size_t)i * 512;
    constexpr int QS = 0, KS = 18432, VTS = 36864, EF = 54272, EB = 63488;
    const int li = c.lane & 15, q4 = c.lane >> 4, i0 = 16 * c.wave, ig = i0 + li;
    for (int unit = blockIdx.x; unit < 64 * 34; unit += gridDim.x) {
        const int bh = unit / 34, cch = unit - bh * 34, b = bh >> 3, hh = bh & 7, row0 = b * RB + cch * 128;
        const float lgf = -expf(c.in[IN_RETRATE][(i * 2 + 0) * 8 + hh]) * 1.4426950408889634f, lgb = -expf(c.in[IN_RETRATE][(i * 2 + 1) * 8 + hh]) * 1.4426950408889634f;
        __syncthreads();
        for (int pc = c.tid; pc < 1024; pc += 512) { const int r = pc >> 3, ch = pc & 7; const size_t go = (size_t)(row0 + r) * 512 + hh * 64 + ch * 8;
            *(LAS pg8::u32x4*)(lds + QS + r * 144 + ch * 16) = *(const pg8::u32x4*)(RQ + go);
            *(LAS pg8::u32x4*)(lds + KS + r * 144 + ch * 16) = *(const pg8::u32x4*)(RK + go);
            const pg8::u32x4 vw = *(const pg8::u32x4*)(RV + go);
#pragma unroll
            for (int e = 0; e < 4; ++e) { *(LAS unsigned short*)(lds + VTS + (ch * 8 + 2 * e) * 272 + r * 2) = (unsigned short)(vw[e] & 0xffffu); *(LAS unsigned short*)(lds + VTS + (ch * 8 + 2 * e + 1) * 272 + r * 2) = (unsigned short)(vw[e] >> 16); } }
        { const int r = c.tid >> 3, ch = c.tid & 7; const size_t go = ((size_t)(bh * 34 + cch) * 2) * 4096 + r * 64 + ch * 8;
            *(LAS pg8::u32x4*)(lds + EF + r * 144 + ch * 16) = *(const pg8::u32x4*)(ET + go); *(LAS pg8::u32x4*)(lds + EB + r * 144 + ch * 16) = *(const pg8::u32x4*)(ET + go + 4096); }
        __syncthreads();
        bf16x8 qf[2];
#pragma unroll
        for (int s = 0; s < 2; ++s) qf[s] = *(const LAS bf16x8*)(lds + QS + (i0 + li) * 144 + (32 * s + 8 * q4) * 2);
        pg8::u32x2 pk[8];
#pragma unroll
        for (int jt = 0; jt < 8; ++jt) {
            f32x4 a = {0.f, 0.f, 0.f, 0.f};
#pragma unroll
            for (int s = 0; s < 2; ++s) { const bf16x8 kf = *(const LAS bf16x8*)(lds + KS + (16 * jt + li) * 144 + (32 * s + 8 * q4) * 2); a = __builtin_amdgcn_mfma_f32_16x16x32_bf16(kf, qf[s], a, 0, 0, 0); }
            float pv[4];
#pragma unroll
            for (int r = 0; r < 4; ++r) { const int dl = ig - (16 * jt + 4 * q4 + r); const float w = dl >= 0 ? exp2f(lgf * (float)dl) : exp2f(lgb * (float)(-dl)); pv[r] = a[r] * w; }
            pk[jt] = (pg8::u32x2){pg8::cvt_pk_bf16(pv[0], pv[1]), pg8::cvt_pk_bf16(pv[2], pv[3])};
        }
        const float sf = exp2f(lgf * (float)(ig + 1)), sb = exp2f(lgb * (float)(128 - ig));
        f32x4 oacc[4];
#pragma unroll
        for (int dvt = 0; dvt < 4; ++dvt) {
            f32x4 o = {0.f, 0.f, 0.f, 0.f};
#pragma unroll
            for (int u = 0; u < 4; ++u) {
                const pg8::u32x2 vlo = *(const LAS pg8::u32x2*)(lds + VTS + (16 * dvt + li) * 272 + (32 * u + 4 * q4) * 2), vhi = *(const LAS pg8::u32x2*)(lds + VTS + (16 * dvt + li) * 272 + (32 * u + 16 + 4 * q4) * 2);
                const pg8::u32x4 av = {vlo.x, vlo.y, vhi.x, vhi.y}, bv = {pk[2 * u].x, pk[2 * u].y, pk[2 * u + 1].x, pk[2 * u + 1].y};
                o = __builtin_amdgcn_mfma_f32_16x16x32_bf16(__builtin_bit_cast(bf16x8, av), __builtin_bit_cast(bf16x8, bv), o, 0, 0, 0);
            }
            f32x4 tf = {0.f, 0.f, 0.f, 0.f}, tb = {0.f, 0.f, 0.f, 0.f};
#pragma unroll
            for (int s = 0; s < 2; ++s) {
                const bf16x8 ef = *(const LAS bf16x8*)(lds + EF + (16 * dvt + li) * 144 + (32 * s + 8 * q4) * 2), eb = *(const LAS bf16x8*)(lds + EB + (16 * dvt + li) * 144 + (32 * s + 8 * q4) * 2);
                tf = __builtin_amdgcn_mfma_f32_16x16x32_bf16(ef, qf[s], tf, 0, 0, 0); tb = __builtin_amdgcn_mfma_f32_16x16x32_bf16(eb, qf[s], tb, 0, 0, 0);
            }
            oacc[dvt] = o + tf * sf + tb * sb;
        }
        float sm = 0.f;
#pragma unroll
        for (int dvt = 0; dvt < 4; ++dvt) sm += (oacc[dvt].x + oacc[dvt].y) + (oacc[dvt].z + oacc[dvt].w);
        sm += __shfl_xor(sm, 16); sm += __shfl_xor(sm, 32);
        const float mu = sm * (1.0f / 64.0f); float vr = 0.f;
#pragma unroll
        for (int dvt = 0; dvt < 4; ++dvt) { oacc[dvt] = oacc[dvt] - mu; vr += (oacc[dvt].x * oacc[dvt].x + oacc[dvt].y * oacc[dvt].y) + (oacc[dvt].z * oacc[dvt].z + oacc[dvt].w * oacc[dvt].w); }
        vr += __shfl_xor(vr, 16); vr += __shfl_xor(vr, 32);
        const float rs = rsqrtf(vr * (1.0f / 64.0f) + EPS);
        const size_t row = (size_t)(row0 + ig);
#pragma unroll
        for (int dvt = 0; dvt < 4; ++dvt) { const int dvc = hh * 64 + 16 * dvt + 4 * q4;
            const pg8::u32x2 gw = *(const pg8::u32x2*)(P + row * INW + 1536 + dvc); const f32x4 gt = {__uint_as_float(gw.x << 16), __uint_as_float(gw.x & 0xffff0000u), __uint_as_float(gw.y << 16), __uint_as_float(gw.y & 0xffff0000u)}, gg = *(const f32x4*)(gn + dvc); const f32x4 y = oacc[dvt] * rs * gg;
            *(pg8::u32x2*)(MIX + row * D + dvc) = (pg8::u32x2){pg8::cvt_pk_bf16(gt.x * pg8::fast_sigmoid(gt.x) * y.x, gt.y * pg8::fast_sigmoid(gt.y) * y.y), pg8::cvt_pk_bf16(gt.z * pg8::fast_sigmoid(gt.z) * y.z, gt.w * pg8::fast_sigmoid(gt.w) * y.w)}; }
    }
}

__device__ __forceinline__ void phase_attention(const Ctx& c, char* lds) {
    const attn_body::bf16* QA = (const attn_body::bf16*)(c.ws + WS_QA); const attn_body::bf16* KA = (const attn_body::bf16*)(c.ws + WS_KA); const attn_body::bf16* VA = (const attn_body::bf16*)(c.ws + WS_VA);
    attn_body::bf16* MIX = (attn_body::bf16*)(c.ws + WS_MIX);
    const int G = gridDim.x, bx = blockIdx.x, vcu = (G % 8 == 0) ? (bx % 8) * (G / 8) + bx / 8 : bx;
    for (int U = vcu; U < NB * 8 * 17; U += G) {
        int bh, qrow0, NT;
        if (U < NB * 8 * 16) { bh = U >> 4; qrow0 = (bh >> 3) * RB + CL + (U & 15) * 256; NT = RB / 64; }
        else { bh = U - NB * 8 * 16; qrow0 = (bh >> 3) * RB; NT = CL / 64; }
        const int b = bh >> 3, hh = bh & 7;
        attn_body::attn_unit<8>(QA + (size_t)qrow0 * 512 + hh * 64, KA + (size_t)(b * RB) * 128 + (hh >> 2) * 64, VA + (size_t)(b * RB) * 128 + (hh >> 2) * 64,
                                MIX + (size_t)qrow0 * 1024 + 512 + hh * 64, NT, lds);
    }
}

__device__ __forceinline__ void phase_s5_ops(const Ctx& c, LAS float* ldsf) {
    LAS float* Pre = ldsf; LAS float* Pim = ldsf + 4224; LAS float* KZr = ldsf + 8448; LAS float* KZi = ldsf + 8576;
    LAS float* Bre = ldsf + 8704; LAS float* Bim = ldsf + 9728; LAS float* Cre = ldsf + 10752; LAS float* Cim = ldsf + 12800;
    LAS float* KV = ldsf + 14848;
    for (int task = blockIdx.x; task < 2 * 64; task += gridDim.x) {
        const int i = task >> 6, g = task & 63;
        __syncthreads();
        if (c.tid < 128) {
            const int dir = c.tid >> 6, p = c.tid & 63;
            const float a_re = c.in[IN_S5ARE][((i * 2 + dir) * 64 + g) * 64 + p], a_im = c.in[IN_S5AIM][((i * 2 + dir) * 64 + g) * 64 + p];
            const float dt = expf(c.in[IN_S5DT][(i * 2 + dir) * 64 + g]);
            const float lre = fminf(a_re, -1e-4f), lim = a_im, ea = lre * dt, eb = lim * dt;
            for (int dl = 0; dl <= 32; ++dl) { const float m = expf(ea * (float)dl), an = eb * (float)dl; Pre[(dir * 33 + dl) * 64 + p] = m * cosf(an); Pim[(dir * 33 + dl) * 64 + p] = m * sinf(an); }
            const float cb = cosf(eb), sb = sinf(eb), sh = sinf(0.5f * eb), mag = expf(ea);
            const float nr = expm1f(ea) * cb - 2.0f * sh * sh, ni = mag * sb, den = lre * lre + lim * lim;
            KZr[dir * 64 + p] = (nr * lre + ni * lim) / den; KZi[dir * 64 + p] = (ni * lre - nr * lim) / den;
        }
        for (int idx = c.tid; idx < 1024; idx += 512) { Bre[idx] = c.in[IN_S5BRE][(size_t)(i * 64 + g) * 1024 + idx]; Bim[idx] = c.in[IN_S5BIM][(size_t)(i * 64 + g) * 1024 + idx]; }
        for (int idx = c.tid; idx < 2048; idx += 512) { const int dir = idx >> 10, rem = idx & 1023;
            Cre[idx] = c.in[IN_S5CRE][((size_t)(i * 2 + dir) * 64 + g) * 1024 + rem]; Cim[idx] = c.in[IN_S5CIM][((size_t)(i * 2 + dir) * 64 + g) * 1024 + rem]; }
        __syncthreads();
        for (int e = c.tid; e < 16384; e += 512) {
            const int dir = e >> 13, dl = (e >> 8) & 31, ko = (e >> 4) & 15, ki = e & 15;
            float acc = 0.f;
            for (int p = 0; p < 64; ++p) {
                const float pr = Pre[(dir * 33 + dl) * 64 + p], pi = Pim[(dir * 33 + dl) * 64 + p], kr = KZr[dir * 64 + p], kq = KZi[dir * 64 + p];
                const float gr = pr * kr - pi * kq, gi = pr * kq + pi * kr, br = Bre[p * 16 + ki], bi = Bim[p * 16 + ki];
                const float mr = gr * br - gi * bi, mi = gr * bi + gi * br;
                acc += Cre[(dir * 16 + ko) * 64 + p] * mr - Cim[(dir * 16 + ko) * 64 + p] * mi;
            }
            KV[e] = acc;
        }
        __syncthreads();
        unsigned* TV = (unsigned*)(c.ws + WS_TV) + ((size_t)(i * 64 + g) * 512 * 768) / 2;
        const float* dsk = c.in[IN_S5D] + (size_t)i * D + 16 * g;
        for (int e = c.tid; e < 512 * 384; e += 512) {
            const int nn = e / 384, kp = e - nn * 384, it = nn >> 4, ko = nn & 15;
            float val[2];
#pragma unroll
            for (int z = 0; z < 2; ++z) {
                const int kk = 2 * kp + z;
                if (kk < 512) { const int j = kk >> 4, ki = kk & 15;
                    if (j < it) val[z] = KV[((0 * 32 + (it - j)) * 16 + ko) * 16 + ki];
                    else if (j > it) val[z] = KV[((1 * 32 + (j - it)) * 16 + ko) * 16 + ki];
                    else val[z] = KV[(0 * 16 + ko) * 16 + ki] + KV[((1 * 32) * 16 + ko) * 16 + ki] + (ko == ki ? dsk[ko] : 0.f);
                } else { const int q = kk - 512, dir = q >> 7, part = (q >> 6) & 1, p = q & 63, pw = dir == 0 ? it + 1 : 32 - it;
                    const float pr = Pre[(dir * 33 + pw) * 64 + p], pi = Pim[(dir * 33 + pw) * 64 + p], cr = Cre[(dir * 16 + ko) * 64 + p], ci = Cim[(dir * 16 + ko) * 64 + p];
                    val[z] = part == 0 ? (cr * pr - ci * pi) : -(cr * pi + ci * pr); }
            }
            TV[e] = pg8::cvt_pk_bf16(val[0], val[1]);
        }
        unsigned* WS5 = (unsigned*)(c.ws + WS_WS5) + ((size_t)(i * 64 + g) * 256 * 512) / 2;
        for (int e = c.tid; e < 256 * 256; e += 512) {
            const int q = e >> 8, kp = e & 255, dir = q >> 7, part = (q >> 6) & 1, p = q & 63;
            float val[2];
#pragma unroll
            for (int z = 0; z < 2; ++z) {
                const int kk = 2 * kp + z, j = kk >> 4, ki = kk & 15, pw = dir == 0 ? 31 - j : j;
                const float pr = Pre[(dir * 33 + pw) * 64 + p], pi = Pim[(dir * 33 + pw) * 64 + p], kr = KZr[dir * 64 + p], kq = KZi[dir * 64 + p];
                const float gr = pr * kr - pi * kq, gi = pr * kq + pi * kr, br = Bre[p * 16 + ki], bi = Bim[p * 16 + ki];
                val[z] = part == 0 ? (gr * br - gi * bi) : (gr * bi + gi * br);
            }
            WS5[e] = pg8::cvt_pk_bf16(val[0], val[1]);
        }
    }
}
__device__ __forceinline__ void phase_s5_carry(const Ctx& c, int i) {
    const float* SL = (const float*)(c.ws + WS_SL); unsigned short* AS5 = (unsigned short*)(c.ws + WS_AS5);
    for (int id = c.gt; id < 64 * 8 * 2 * 64; id += c.ngt) {
        const int p = id & 63, dir = (id >> 6) & 1, b = (id >> 7) & 7, g = id >> 10;
        const float a_re = c.in[IN_S5ARE][((i * 2 + dir) * 64 + g) * 64 + p], a_im = c.in[IN_S5AIM][((i * 2 + dir) * 64 + g) * 64 + p];
        const float dt = expf(c.in[IN_S5DT][(i * 2 + dir) * 64 + g]);
        const float lre = fminf(a_re, -1e-4f), m32 = expf(lre * dt * 32.0f), an = a_im * dt * 32.0f, ar = m32 * cosf(an), ai = m32 * sinf(an);
        float xr = 0.f, xi = 0.f;
#pragma unroll 8
        for (int st = 0; st < 136; ++st) {
            const int cch = dir == 0 ? st : (st < 8 ? 7 - st : 143 - st);
            const size_t r = (size_t)g * 1280 + b * 136 + cch;
            unsigned short* xo = AS5 + r * 768 + 512 + dir * 128 + p;
            xo[0] = (unsigned short)(pg8::cvt_pk_bf16(xr, 0.f) & 0xffffu); xo[64] = (unsigned short)(pg8::cvt_pk_bf16(xi, 0.f) & 0xffffu);
            const float sr = SL[r * 256 + dir * 128 + p], si = SL[r * 256 + dir * 128 + 64 + p];
            const float nxr = ar * xr - ai * xi + sr, nxi = ar * xi + ai * xr + si;
            xr = nxr; xi = nxi;
        }
    }
}

__device__ __forceinline__ void cvt_item(const float* W, int ldw, int k0, int scol0, unsigned short* WT, int K, int drow0, LAS float* scr, int lane) {
#pragma unroll 8
    for (int i = 0; i < 32; ++i) { const int kk = 2 * i + (lane >> 5); scr[kk * 33 + (lane & 31)] = W[(size_t)(k0 + kk) * ldw + scol0 + (lane & 31)]; }
    asm volatile("s_waitcnt lgkmcnt(0)" ::: "memory");
    const int cc = lane & 7;
#pragma unroll
    for (int j = 0; j < 4; ++j) { const int n = (lane >> 3) + 8 * j; const LAS float* s = scr + (8 * cc) * 33 + n;
        pg8::u32x4 o; o.x = pg8::cvt_pk_bf16(s[0 * 33], s[1 * 33]); o.y = pg8::cvt_pk_bf16(s[2 * 33], s[3 * 33]); o.z = pg8::cvt_pk_bf16(s[4 * 33], s[5 * 33]); o.w = pg8::cvt_pk_bf16(s[6 * 33], s[7 * 33]);
        *(pg8::u32x4*)(WT + (size_t)(drow0 + n) * K + k0 + 8 * cc) = o; }
    asm volatile("s_waitcnt lgkmcnt(0)" ::: "memory");
}
__device__ __forceinline__ void cvt_item8(const float* W, int ldw, int k0, int scol0, unsigned char* WT, int K, int drow0, LAS float* scr, int lane) {
#pragma unroll 8
    for (int i = 0; i < 32; ++i) { const int kk = 2 * i + (lane >> 5); scr[kk * 33 + (lane & 31)] = W[(size_t)(k0 + kk) * ldw + scol0 + (lane & 31)] * pg8::W8_SCALE; }
    asm volatile("s_waitcnt lgkmcnt(0)" ::: "memory");
    const int n = lane >> 1, kh = lane & 1; const LAS float* s = scr + (32 * kh) * 33 + n;
    unsigned w[8];
#pragma unroll
    for (int j = 0; j < 8; ++j) w[j] = pg8::pk4_fp8(s[(4 * j) * 33], s[(4 * j + 1) * 33], s[(4 * j + 2) * 33], s[(4 * j + 3) * 33]);
    unsigned char* o = WT + (size_t)(drow0 + n) * K + k0 + 32 * kh;
    *(pg8::u32x4*)o = (pg8::u32x4){w[0], w[1], w[2], w[3]}; *(pg8::u32x4*)(o + 16) = (pg8::u32x4){w[4], w[5], w[6], w[7]};
    asm volatile("s_waitcnt lgkmcnt(0)" ::: "memory");
}
__device__ __forceinline__ void phase_cvt_moe(const Ctx& c, LAS float* ldsf) {
    LAS float* scr = ldsf + c.wave * (64 * 33);
    unsigned char* W13 = (unsigned char*)(c.ws + WS_W13); unsigned char* W2T = (unsigned char*)(c.ws + WS_W2);
    for (int id = c.gw; id < DEPTH * NE * 3072; id += c.ngw) {
        const int le = id / 3072; int r = id - le * 3072;
        if (r < 2048) { const int kb = r >> 7, nb = r & 127, pn = nb >> 3, rr0 = (nb & 7) * 32;
            const float* srcm = (rr0 < 128 ? c.in[IN_W1] : c.in[IN_W3]) + (size_t)le * D * FF;
            cvt_item8(srcm, FF, 64 * kb, 128 * pn + (rr0 & 127), W13 + (size_t)le * 4096 * D, D, 32 * nb, scr, c.lane);
        } else { r -= 2048; const int kb = r >> 5, nb = r & 31;
            cvt_item8(c.in[IN_W2] + (size_t)le * FF * D, D, 64 * kb, 32 * nb, W2T + (size_t)le * D * FF, FF, 32 * nb, scr, c.lane); }
    }
    unsigned short* WIN = (unsigned short*)(c.ws + WS_WIN); unsigned short* WOUT = (unsigned short*)(c.ws + WS_WOUT); unsigned short* WGLU = (unsigned short*)(c.ws + WS_WGLU);
    for (int id = c.gw; id < 2 * (1408 + 512 + 1024); id += c.ngw) {
        const int i = id / 2944; int r = id - i * 2944;
        if (r < 1408) { const int kb = r / 88, nb = r - kb * 88; cvt_item(c.in[IN_MIXIN] + (size_t)i * D * INW, INW, 64 * kb, 32 * nb, WIN + (size_t)i * INW * D, D, 32 * nb, scr, c.lane); }
        else if (r < 1920) { r -= 1408; const int kb = r >> 5, nb = r & 31; cvt_item(c.in[IN_MIXOUT] + (size_t)i * D * D, D, 64 * kb, 32 * nb, WOUT + (size_t)i * D * D, D, 32 * nb, scr, c.lane); }
        else { r -= 1920; const int kb = r >> 6, nb = r & 63, pn = nb >> 3, rr0 = (nb & 7) * 32;
            cvt_item(c.in[IN_GLUW] + (size_t)i * D * 2048, 2048, 64 * kb, (rr0 < 128 ? 0 : 1024) + 128 * pn + (rr0 & 127), WGLU + (size_t)i * 2048 * D, D, 32 * nb, scr, c.lane); }
    }
}

struct ALDense { const float* A; int lda; size_t gstride; __device__ __forceinline__ const float* row(int g, int r) const { return A + (size_t)g * gstride + (size_t)r * lda; } };
struct ALGather { const float* A; const int* idx; __device__ __forceinline__ const float* row(int g, int r) const { return A + (size_t)idx[g * EROWS + r] * D; } };
struct BL1 { const float* B; int ldb; size_t gstride; __device__ __forceinline__ const float* ptr(int g, int) const { return B + (size_t)g * gstride; } };
struct BL2 { const float* Ba; const float* Bb; int ldb; size_t gstride; __device__ __forceinline__ const float* ptr(int g, int sub) const { return (sub ? Bb : Ba) + (size_t)g * gstride; } };
struct EPStore { float* O; int ldc; __device__ __forceinline__ void operator()(int, int row, int col, float v, float) const { O[(size_t)row * ldc + col] = v; } };
struct EPResid { float* X; const float* mod; int L; __device__ __forceinline__ void operator()(int, int row, int col, float v, float) const {
    const int j = row_j(row); const float g1 = mod[((size_t)(L * 9 + j) * 6 + 2) * 1024 + col]; X[(size_t)row * D + col] += g1 * v; } };
struct EPGlu { float* X; const float* mod; const float* bias; int L; __device__ __forceinline__ void operator()(int, int row, int col, float va, float vb) const {
    const int j = row_j(row); const float g1 = mod[((size_t)(L * 9 + j) * 6 + 2) * 1024 + col];
    const float o = (va + bias[col]) * sigmoidf_(vb + bias[1024 + col]); X[(size_t)row * D + col] += g1 * o; } };
struct EPSwiglu { float* HID; __device__ __forceinline__ void operator()(int g, int row, int col, float va, float vb) const { HID[((size_t)g * EROWS + row) * FF + col] = siluf_(va) * vb; } };
struct EPGate { float* Y; const float* gate; __device__ __forceinline__ void operator()(int g, int row, int col, float v, float) const { Y[((size_t)g * EROWS + row) * D + col] = gate[g * EROWS + row] * v; } };

__global__ void __launch_bounds__(512, 2) fwd(Args args) {
    extern __shared__ __attribute__((aligned(16))) unsigned char lds[];
    Ctx c; c.in = args.in; c.out = args.out; c.ws = args.ws;
    c.tid = threadIdx.x; c.lane = c.tid & 63; c.wave = __builtin_amdgcn_readfirstlane(c.tid >> 6);
    c.gw = blockIdx.x * 8 + c.wave; c.ngw = gridDim.x * 8; c.gt = blockIdx.x * 512 + c.tid; c.ngt = gridDim.x * 512;
    LAS float* ldsf = (LAS float*)lds; LAS unsigned char* ldsb = (LAS unsigned char*)lds;
    volatile LAS unsigned* MISC = (volatile LAS unsigned*)((LAS unsigned char*)lds + MISC_OFF);
    if (c.tid < 32) MISC[c.tid] = 0u;
    __syncthreads();
    const int lo = args.ph_lo, hi = args.ph_hi;
    const bool one_launch = (hi - lo) > 1;
    XcdBarrier bar; bar.bar = (unsigned*)(c.ws + WS_CTL) + CW_BAR; bar.x = 0; bar.st = MISC + 8;
    if (one_launch) bar = xcd_barrier_post((unsigned*)(c.ws + WS_CTL) + CW_BAR, MISC + 8);
#define IN(k) (lo <= (k) && (k) < hi)
#define SEAM(k) do { if ((k) + 1 < hi) xcd_barrier(bar); } while (0)
#define FRESH(cc) Ctx cc; unsigned zq; asm volatile("s_mov_b32 %0, 0" : "=s"(zq)); cc.ws = c.ws + zq; cc.out = c.out + zq; cc.in = (const float* const*)((const char*)c.in + zq); \
    { int tq = threadIdx.x; asm volatile("" : "+v"(tq)); cc.tid = tq; cc.lane = tq & 63; cc.wave = __builtin_amdgcn_readfirstlane(tq >> 6); cc.gw = blockIdx.x * 8 + cc.wave; cc.ngw = gridDim.x * 8; cc.gt = blockIdx.x * 512 + tq; cc.ngt = gridDim.x * 512; } \
    const int Lq = L + (int)zq, iq = Lq >> 1; const float* MOD = (const float*)(cc.ws + WS_MOD); (void)MOD; (void)iq

    if (IN(PH_PRO)) { const int L = 0; FRESH(cc); phase_pro(cc, ldsf); __syncthreads(); phase_s5_ops(cc, ldsf); __syncthreads(); phase_cvt_moe(cc, ldsf); SEAM(PH_PRO); }

#define LAYER_BODY(LL) { constexpr int L = LL; \
        const int pb = 1 + L * PH_PER_LAYER; \
        if (IN(pb + 0)) { FRESH(cc); phase_norm1<false, (L & 1) != 0>(cc, Lq); SEAM(pb + 0); } \
        if ((L & 1) == 0) { \
            if (IN(pb + 1)) { \
                FRESH(cc); \
                pg8::GOrder S; S.init(1, NROWS, INW, (int)gridDim.x, (int)blockIdx.x); \
                pg8::ADense al{(const pg8::bf16_t*)(cc.ws + WS_HB1), 0, nullptr, 0, D, 0, 64}; pg8::EpiBf16 ep{(pg8::bf16_t*)(cc.ws + WS_P), INW}; \
                pg8::gemm_phase(ldsb, al, (const pg8::bf16_t*)(cc.ws + WS_WIN) + (size_t)iq * INW * D, 0, D, S, ep); SEAM(pb + 1); } \
            if (IN(pb + 2)) { FRESH(cc); phase_post(cc, iq, ldsb); SEAM(pb + 2); } \
            if (IN(pb + 4)) { FRESH(cc); phase_ret_prefix(cc, iq); phase_attention(cc, (char*)lds); SEAM(pb + 4); } \
            if (IN(pb + 5)) { FRESH(cc); phase_ret_main(cc, iq, ldsb); SEAM(pb + 5); } \
            if (IN(pb + 6)) { \
                FRESH(cc); \
                pg8::GOrder S; S.init(1, NROWS, D, (int)gridDim.x, (int)blockIdx.x); \
                pg8::ADense al{(const pg8::bf16_t*)(cc.ws + WS_MIX), 0, nullptr, 0, D, 0, 64}; pg8::EpiResid ep{(float*)(cc.ws + WS_X), MOD + (size_t)Lq * 9 * 6144}; \
                pg8::gemm_phase(ldsb, al, (const pg8::bf16_t*)(cc.ws + WS_WOUT) + (size_t)iq * D * D, 0, D, S, ep); SEAM(pb + 6); } \
        } else { \
            if (IN(pb + 1)) { \
                FRESH(cc); \
                pg8::GOrder S; S.init(64, 1280, 256, (int)gridDim.x, (int)blockIdx.x); \
                pg8::ADense al{(const pg8::bf16_t*)(cc.ws + WS_AS5), (size_t)1280 * 768, nullptr, 0, 768, 0, 64}; pg8::EpiF32 ep{(float*)(cc.ws + WS_SL), 256, (size_t)1280 * 256}; \
                pg8::gemm_phase(ldsb, al, (const pg8::bf16_t*)(cc.ws + WS_WS5) + (size_t)iq * 64 * 256 * 512, (size_t)256 * 512, 512, S, ep); SEAM(pb + 1); } \
            if (IN(pb + 2)) { FRESH(cc); phase_s5_carry(cc, iq); SEAM(pb + 2); } \
            if (IN(pb + 3)) { \
                FRESH(cc); \
                pg8::GOrder S; S.init(64, 1280, 512, (int)gridDim.x, (int)blockIdx.x); \
                pg8::ADense al{(const pg8::bf16_t*)(cc.ws + WS_AS5), (size_t)1280 * 768, nullptr, 0, 768, 0, 64}; pg8::EpiGeluBf16 ep{(pg8::bf16_t*)(cc.ws + WS_ZG), 512, (size_t)1280 * 512}; \
                pg8::gemm_phase(ldsb, al, (const pg8::bf16_t*)(cc.ws + WS_TV) + (size_t)iq * 64 * 512 * 768, (size_t)512 * 768, 768, S, ep); SEAM(pb + 3); } \
            if (IN(pb + 4)) { \
                FRESH(cc); \
                pg8::GOrder S; S.init(1, NROWS, 2048, (int)gridDim.x, (int)blockIdx.x); \
                pg8::ADense al{(const pg8::bf16_t*)(cc.ws + WS_ZG), 0, nullptr, 0, 16, 1280 * 512, (size_t)4 * 1280 * 512}; pg8::EpiGluResid ep{(float*)(cc.ws + WS_X), MOD + (size_t)Lq * 9 * 6144, cc.in[IN_GLUB] + (size_t)iq * 2048}; \
                pg8::gemm_phase(ldsb, al, (const pg8::bf16_t*)(cc.ws + WS_WGLU) + (size_t)iq * 2048 * D, 0, D, S, ep); SEAM(pb + 4); } \
        } \
        if (IN(pb + 7)) { FRESH(cc); phase_norm2_router(cc, Lq, ldsf); SEAM(pb + 7); } \
        if (IN(pb + 8)) { FRESH(cc); phase_topk(cc, (LAS unsigned*)lds); SEAM(pb + 8); } \
        if (IN(pb + 9)) { \
            FRESH(cc); \
            pg8::GOrder S; S.init(NE, EROWS, 2 * FF, (int)gridDim.x, (int)blockIdx.x); \
            pg8::ADense al{(const pg8::bf16_t*)(cc.ws + WS_XS), (size_t)EROWS * D, nullptr, 0, D, 0, 128}; \
            pg8::EpiSwiglu ep{(unsigned char*)(cc.ws + WS_HID), FF, (size_t)EROWS * FF}; \
            pg8::gemm_phase<true>(ldsb, al, (const unsigned char*)(cc.ws + WS_W13) + (size_t)Lq * NE * 4096 * D, (size_t)4096 * D, D, S, ep); SEAM(pb + 9); } \
        if (IN(pb + 10)) { \
            FRESH(cc); \
            pg8::GOrder S; S.init(NE, EROWS, D, (int)gridDim.x, (int)blockIdx.x); \
            pg8::ADense al{(const pg8::bf16_t*)(cc.ws + WS_HID), (size_t)EROWS * FF, nullptr, 0, FF, 0, 128}; \
            pg8::EpiGate ep{(pg8::bf16_t*)(cc.ws + WS_Y), D, (size_t)EROWS * D, (const float*)(cc.ws + WS_SELGATE), EROWS}; \
            pg8::gemm_phase<true>(ldsb, al, (const unsigned char*)(cc.ws + WS_W2) + (size_t)Lq * NE * D * FF, (size_t)D * FF, FF, S, ep); SEAM(pb + 10); } \
    }
    LAYER_BODY(0) LAYER_BODY(1) LAYER_BODY(2) LAYER_BODY(3)
#undef LAYER_BODY
    if (IN(PH_FIN)) { const int L = DEPTH; FRESH(cc); phase_norm1<true, false>(cc, DEPTH); }
#undef IN
#undef SEAM
}

static bool phase_valid(int ph) {
    if (ph == PH_PRO || ph == PH_FIN) return true;
    const int L = (ph - 1) / PH_PER_LAYER, k = (ph - 1) % PH_PER_LAYER;
    if (L & 1) return !(k >= 5 && k <= 6);
    return k != 3;
}
extern "C" void kernel_launch(void* const* d_in, const int* in_sizes, int n_in, void* d_out, int out_size, void* d_ws, size_t ws_size, hipStream_t stream) {
    static int grid = 0;
    if (grid == 0) {
        if (n_in != 27 || out_size != NB * T * D || ws_size < WS_END) { fprintf(stderr, "kernel_launch: unexpected shapes (n_in %d out %d ws %zu)\n", n_in, out_size, ws_size); grid = -1; return; }
        int dev = 0, cus = 0;
        if (hipGetDevice(&dev) != hipSuccess || hipDeviceGetAttribute(&cus, hipDeviceAttributeMultiprocessorCount, dev) != hipSuccess) { grid = -1; return; }
        if (hipFuncSetAttribute((const void*)fwd, hipFuncAttributeMaxDynamicSharedMemorySize, LDS_BYTES) != hipSuccess) { grid = -1; return; }
        int per_cu = 0;
        if (hipOccupancyMaxActiveBlocksPerMultiprocessor(&per_cu, (const void*)fwd, 512, LDS_BYTES) != hipSuccess || per_cu < 1) fprintf(stderr, "kernel_launch: occupancy query says %d\n", per_cu);
        (void)hipGetLastError();
        grid = cus;
    }
    if (grid < 0) return;
    if (hipMemsetAsync((char*)d_ws + WS_CTL, 0, CTL_ZERO_BYTES, stream) != hipSuccess) return;
    Args a{};
    for (int i = 0; i < 27; ++i) a.in[i] = (const float*)d_in[i];
    a.out = (float*)d_out; a.ws = (unsigned char*)d_ws;
#if MK_MULTI
    for (int ph = 0; ph < NPH; ++ph) {
        if (!phase_valid(ph)) continue;
        a.ph_lo = ph; a.ph_hi = ph + 1;
        hipLaunchKernelGGL(fwd, dim3(grid), dim3(512), LDS_BYTES, stream, a);
    }
#else
    a.ph_lo = 0; a.ph_hi = NPH;
    hipLaunchKernelGGL(fwd, dim3(grid), dim3(512), LDS_BYTES, stream, a);
#ifdef PROBE_PHASES
    { static const int probe[] = {PROBE_PHASES}; for (unsigned q = 0; q < sizeof(probe) / sizeof(probe[0]); ++q) { a.ph_lo = probe[q]; a.ph_hi = probe[q] + 1; hipLaunchKernelGGL(fwd, dim3(grid), dim3(512), LDS_BYTES, stream, a); } }
#endif
#endif
}
```

```cpp
#include <hip/hip_runtime.h>
#include <hip/hip_bf16.h>
#include <cstdio>
#include <cstdint>

#define GAS __attribute__((address_space(1)))
#define LAS __attribute__((address_space(3)))
typedef float f32x4 __attribute__((ext_vector_type(4)));
typedef float f32x16 __attribute__((ext_vector_type(16)));

constexpr int NB = 8, T = 4096, D = 1024, CL = 256, RB = CL + T  , NROWS = NB * RB  ;
constexpr int DEPTH = 4, NE = 16, FF = 2048, INW = 2816;
constexpr int CAP_LAT = 512, CAP_CTX = 32, EROWS = NB * (CAP_LAT + CAP_CTX)  ;
constexpr float EPS = 1e-6f;
#ifndef MK_MULTI
#define MK_MULTI 0
#endif

constexpr size_t MiB = 1u << 20;
constexpr size_t WS_CTL = 0, CTL_ZERO_BYTES = 1 * MiB;
constexpr size_t WS_MOD = 1 * MiB;
constexpr size_t WS_ROPE = 2 * MiB;
constexpr size_t WS_SELROW = 3 * MiB;
constexpr size_t WS_SELGATE = 3 * MiB + 512 * 1024;
constexpr size_t WS_AFF = 4 * MiB;
constexpr size_t WS_SLOT = 7 * MiB;
constexpr size_t WS_X = 10 * MiB;
constexpr size_t WS_TV = 146 * MiB;
constexpr size_t WS_WS5 = 242 * MiB;
constexpr size_t WS_HB = 282 * MiB;
constexpr size_t WS_W13 = 350 * MiB;
constexpr size_t WS_W2 = 862 * MiB;
constexpr size_t WS_WIN = 1118 * MiB;
constexpr size_t WS_WOUT = 1130 * MiB;
constexpr size_t WS_WGLU = 1134 * MiB;
constexpr size_t WS_HB1 = 1144 * MiB;
constexpr size_t WS_BIG = 1212 * MiB;
constexpr size_t WS_P = WS_BIG;
constexpr size_t WS_RQ = WS_BIG + 374 * MiB;
constexpr size_t WS_RK = WS_BIG + 408 * MiB;
constexpr size_t WS_RV = WS_BIG + 442 * MiB;
constexpr size_t WS_ET = WS_BIG + 476 * MiB;
constexpr size_t WS_MIX = WS_BIG + 510 * MiB;
constexpr size_t WS_QA = WS_BIG + 578 * MiB;
constexpr size_t WS_KA = WS_BIG + 612 * MiB;
constexpr size_t WS_VA = WS_BIG + 621 * MiB;
constexpr size_t WS_U = WS_BIG + 630 * MiB;
constexpr size_t WS_AS5 = WS_BIG;
constexpr size_t WS_SL = WS_BIG + 120 * MiB;
constexpr size_t WS_ZG = WS_BIG + 200 * MiB;
constexpr size_t WS_HID = WS_BIG;
constexpr size_t WS_XS = WS_BIG + 136 * MiB;
constexpr size_t WS_Y = WS_BIG + 272 * MiB;
constexpr size_t WS_END = WS_BIG + 698 * MiB;
constexpr int CW_BAR = 4096, CW_CNT = 8192;

constexpr int LDS_BYTES = 147456;
constexpr int MISC_OFF = 131072 + 320;

constexpr int PH_PRO = 0, PH_PER_LAYER = 11, PH_FIN = 1 + DEPTH * PH_PER_LAYER, NPH = PH_FIN + 1;

#define XB_TMO      128
#define XB_XCNT(j)  (256  + 64 * (j))
#define XB_XSUB(j)  (1280 + 64 * (j))
#define XB_XGEN(j)  (2304 + 64 * (j))
#define XB_TOP      3328
#define XB_TOPGEN   3392
#define XCD_BAR_WORDS 3456
#define XB_SPIN_CAP (1u << 22)

__device__ __forceinline__ unsigned xb_ld(unsigned* p)              { return __hip_atomic_load(p, __ATOMIC_RELAXED, __HIP_MEMORY_SCOPE_AGENT); }
__device__ __forceinline__ unsigned xb_add(unsigned* p, unsigned v) { return __hip_atomic_fetch_add(p, v, __ATOMIC_RELAXED, __HIP_MEMORY_SCOPE_AGENT); }
__device__ __forceinline__ unsigned xb_xcc_id() { return (unsigned)__builtin_amdgcn_s_getreg((3 << 11) | 20) & 0xFu; }
#define XB_SPIN(cond, bar) do { unsigned _sp = 0; while (cond) { __builtin_amdgcn_s_sleep(1); \
    if ((++_sp & 255u) == 0u) { if (xb_ld(&(bar)[XB_TMO])) break; if (_sp > XB_SPIN_CAP) { atomicAdd(&(bar)[XB_TMO], 1u); break; } } } } while (0)

__device__ __forceinline__ int lane_id() { return (int)__builtin_amdgcn_mbcnt_hi(~0u, __builtin_amdgcn_mbcnt_lo(~0u, 0u)); }
struct XcdBarrier { unsigned* bar; unsigned x; volatile LAS unsigned* st; int wave; };

__device__ __forceinline__ XcdBarrier xcd_barrier_post(unsigned* bar, volatile LAS unsigned* st) {
    XcdBarrier b; b.bar = bar; b.x = xb_xcc_id(); b.st = st; b.wave = __builtin_amdgcn_readfirstlane((int)threadIdx.x >> 6);
    if (threadIdx.x == 0) (void)xb_add(&bar[XB_XCNT(b.x)], 1u);
    return b;
}
__device__ __forceinline__ void xcd_barrier_complete(unsigned* bar, unsigned x, unsigned& nloc, unsigned& nx) {
    const unsigned G = gridDim.x * gridDim.y * gridDim.z;
    unsigned sum, cnt, mine, sp = 0u;
    for (;;) {
        sum = 0u; cnt = 0u; mine = 0u;
#pragma unroll
        for (unsigned j = 0; j < 16; ++j) { const unsigned c = xb_ld(&bar[XB_XCNT(j)]); sum += c; cnt += (c > 0u) ? 1u : 0u; mine = (j == x) ? c : mine; }
        if (sum == G) break;
        __builtin_amdgcn_s_sleep(1);
        if ((++sp & 255u) == 0u) { if (xb_ld(&bar[XB_TMO])) break; if (sp > XB_SPIN_CAP) { atomicAdd(&bar[XB_TMO], 1u); break; } }
    }
    nloc = mine > 0u ? mine : 1u; nx = cnt > 0u ? cnt : 1u;
}
__device__ __forceinline__ void xcd_barrier(const XcdBarrier& b) {
    asm volatile("s_waitcnt vmcnt(0)" ::: "memory");
    __syncthreads();
    if (b.wave == 0 && lane_id() == 0) {
        unsigned* bar = b.bar;
        __builtin_amdgcn_s_waitcnt(0);
        unsigned nloc = b.st[0], nx = b.st[1];
        if (nloc == 0u) { xcd_barrier_complete(bar, b.x, nloc, nx); b.st[0] = nloc; b.st[1] = nx; }
        const unsigned old = xb_add(&bar[XB_XSUB(b.x)], 1u);
        const unsigned gen = old / nloc;
        if (old + 1u == (gen + 1u) * nloc) {
            __builtin_amdgcn_fence(__ATOMIC_RELEASE, "agent");
            asm volatile("s_waitcnt vmcnt(0)" ::: "memory");
            const unsigned og = xb_add(&bar[XB_TOP], 1u);
            const unsigned tg = og / nx;
            if (og + 1u == (tg + 1u) * nx) xb_add(&bar[XB_TOPGEN], 1u);
            else XB_SPIN(xb_ld(&bar[XB_TOPGEN]) == tg, bar);
            __builtin_amdgcn_fence(__ATOMIC_ACQUIRE, "agent");
            xb_add(&bar[XB_XGEN(b.x)], 1u);
            asm volatile("s_waitcnt vmcnt(0)" ::: "memory");
        } else {
            XB_SPIN(xb_ld(&bar[XB_XGEN(b.x)]) == gen, bar);
            __builtin_amdgcn_fence(__ATOMIC_ACQUIRE, "agent");
            asm volatile("s_waitcnt vmcnt(0)" ::: "memory");
        }
    }
    __syncthreads();
}

struct Args { const float* in[27]; float* out; unsigned char* ws; int ph_lo, ph_hi; };

struct Ctx {
    const float* const* in; float* out; unsigned char* ws;
    int tid, lane, wave, gw, ngw, gt, ngt;
};
enum { IN_X = 0, IN_C, IN_CTX, IN_CCTX, IN_MODW, IN_MODB, IN_NORMG, IN_MIXIN, IN_MIXOUT, IN_RETRATE, IN_RETGN, IN_QKG,
       IN_S5ARE, IN_S5AIM, IN_S5DT, IN_S5BRE, IN_S5BIM, IN_S5CRE, IN_S5CIM, IN_S5D, IN_GLUW, IN_GLUB, IN_ROUTER, IN_W1, IN_W3, IN_W2, IN_FNG };

__device__ __forceinline__ float wave_sum(float v) {
#pragma unroll
    for (int o = 1; o < 64; o <<= 1) v += __shfl_xor(v, o);
    return v;
}
__device__ __forceinline__ float sigmoidf_(float x) { return 1.0f / (1.0f + expf(-x)); }
__device__ __forceinline__ float siluf_(float x) { return x * sigmoidf_(x); }
__device__ __forceinline__ float gelu_tanh(float x) { const float u = 0.7978845608028654f * (x + 0.044715f * x * x * x); return 0.5f * x * (1.0f + tanhf(u)); }
__device__ __forceinline__ const float* modp(const Ctx& c, int L, int j, int chunk) { return (const float*)(c.ws + WS_MOD) + ((size_t)(L * 9 + j) * 6 + chunk) * 1024; }
__device__ __forceinline__ int row_j(int row) { const int b = row / RB, s = row - b * RB; return s < CL ? 8 : b; }

__device__ __forceinline__ float reduce16(const float (&v)[16], int lane) {
    float a[8], b[4], c2[2], d;
    const bool b5 = (lane & 32) != 0, b4 = (lane & 16) != 0, b3 = (lane & 8) != 0, b2 = (lane & 4) != 0;
#pragma unroll
    for (int i = 0; i < 8; ++i) { const float keep = b5 ? v[8 + i] : v[i], send = b5 ? v[i] : v[8 + i]; a[i] = keep + __shfl_xor(send, 32); }
#pragma unroll
    for (int i = 0; i < 4; ++i) { const float keep = b4 ? a[4 + i] : a[i], send = b4 ? a[i] : a[4 + i]; b[i] = keep + __shfl_xor(send, 16); }
#pragma unroll
    for (int i = 0; i < 2; ++i) { const float keep = b3 ? b[2 + i] : b[i], send = b3 ? b[i] : b[2 + i]; c2[i] = keep + __shfl_xor(send, 8); }
    { const float keep = b2 ? c2[1] : c2[0], send = b2 ? c2[0] : c2[1]; d = keep + __shfl_xor(send, 4); }
    d += __shfl_xor(d, 2); d += __shfl_xor(d, 1);
    return d;
}
__device__ __forceinline__ int reduce16_k(int lane) { return ((lane >> 5) & 1) * 8 + ((lane >> 4) & 1) * 4 + ((lane >> 3) & 1) * 2 + ((lane >> 2) & 1); }

namespace pg8 {
typedef unsigned short bf16_t;
typedef short bf16x8 __attribute__((ext_vector_type(8)));
typedef unsigned u32x4 __attribute__((ext_vector_type(4)));
typedef unsigned u32x2 __attribute__((ext_vector_type(2)));
typedef int v8i32 __attribute__((ext_vector_type(8)));
typedef int v4i32 __attribute__((ext_vector_type(4)));
constexpr int BM = 256, BK = 64, HALF = 128, HTB = HALF * BK * 2, STAGE_BYTES = 8 * HTB, NXCD = 8, WGM = 8;
__host__ __device__ __forceinline__ int lds_byte(int r, int c) { const int st = (r >> 4) * 2 + (c >> 5), rr = r & 15, cc = c & 31, ob = rr * 64 + cc * 2; return st * 1024 + (ob ^ (((ob >> 9) & 1) << 5)); }
__host__ __device__ __forceinline__ void stage_rc(int b, int& R, int& C) { const int st = b / 1024, sb = b % 1024, swz = sb ^ (((sb >> 9) & 1) << 5); R = (st >> 1) * 16 + swz / 64; C = (st & 1) * 32 + (swz % 64) / 2; }
__host__ __device__ __forceinline__ int perm32(int rho) { const int n = rho >> 4, i = rho & 15; return 8 * (i >> 2) + 4 * n + (i & 3); }
__device__ __forceinline__ unsigned cvt_pk_bf16(float lo, float hi) { unsigned r; asm volatile("v_cvt_pk_bf16_f32 %0, %1, %2" : "=v"(r) : "v"(lo), "v"(hi)); return r; }

__device__ __forceinline__ unsigned pk4_fp8(float a, float b, float c, float d) {
    a = __builtin_amdgcn_fmed3f(a, -448.f, 448.f); b = __builtin_amdgcn_fmed3f(b, -448.f, 448.f); c = __builtin_amdgcn_fmed3f(c, -448.f, 448.f); d = __builtin_amdgcn_fmed3f(d, -448.f, 448.f);
    unsigned w = 0u; w = (unsigned)__builtin_amdgcn_cvt_pk_fp8_f32(a, b, (int)w, false); w = (unsigned)__builtin_amdgcn_cvt_pk_fp8_f32(c, d, (int)w, true); return w; }
__device__ __forceinline__ f32x4 bf4_to_f32(u32x2 w) { return (f32x4){__uint_as_float(w.x << 16), __uint_as_float(w.x & 0xffff0000u), __uint_as_float(w.y << 16), __uint_as_float(w.y & 0xffff0000u)}; }
__device__ __forceinline__ u32x2 f32_to_bf4(f32x4 v) { return (u32x2){cvt_pk_bf16(v.x, v.y), cvt_pk_bf16(v.z, v.w)}; }
constexpr float W8_SCALE = 32.0f, W8_INV = 1.0f / 32.0f;
struct Unit { int pm, pn, g; };
struct GOrder {
    int nM, nN, per, nwg, G, c, skipctx;
    __device__ __forceinline__ void init(int groups, int M, int N, int G_, int c_, int skipctx_ = 0) { nM = M / BM; if (skipctx_) nM -= nM / 17; nN = N / BM; per = nM * nN; nwg = groups * per; G = G_; c = c_; skipctx = skipctx_; }
    __device__ __forceinline__ bool next(int i, Unit& u) const {
        const long L = (long)i * G + c; if (L >= nwg) return false;
        int wgid = (int)L; { const int q = nwg / NXCD, r = nwg % NXCD, xcd = wgid % NXCD, off = wgid / NXCD; wgid = (xcd < r ? xcd * (q + 1) : r * (q + 1) + (xcd - r) * q) + off; }
        u.g = wgid / per; const int w = wgid - u.g * per;
        const int nig = WGM * nN, gid = w / nig, fm = gid * WGM, gsz = (nM - fm) < WGM ? (nM - fm) : WGM;
        u.pm = fm + ((w % nig) % gsz); u.pn = (w % nig) / gsz; if (skipctx) u.pm += (u.pm >> 4) + 1;
        return true;
    }
};
struct ADense  { static constexpr bool GATHER = false; const bf16_t* A; size_t gstride; const int* idx; int rpg; unsigned rowpitch; unsigned cgrp; size_t kstep; };
struct AGather { static constexpr bool GATHER = true;  const bf16_t* A; size_t gstride; const int* idx; int rpg; unsigned rowpitch; unsigned cgrp; size_t kstep; };

template <bool FP8 = false, class Epi, class ALoc>
__device__ __forceinline__ void gemm_phase(LAS unsigned char* lds, const ALoc AL, const void* Bt, size_t gstrideB, int K, const GOrder& S, const Epi& E, int wave_) {
    constexpr bool GATHER = ALoc::GATHER; constexpr unsigned ESZ = FP8 ? 1u : 2u;
    const int wid = wave_, lane = lane_id(), tid = wid * 64 + lane, wr = wid >> 2, wc = wid & 3, fr = lane & 15, fq = lane >> 4;
    const int nt = (int)((unsigned)K * ESZ / 128u);
    unsigned voffA[2], voffB[2];
#pragma unroll
    for (int i = 0; i < 2; ++i) { int R, C; stage_rc(tid * 16 + i * 8192, R, C); const int Rb = Epi::PERM ? ((R & ~31) + perm32(R & 31)) : R;
        const unsigned cbytes = AL.cgrp ? ((unsigned)(C >> 4) * AL.cgrp + (unsigned)(C & 15)) * 2u : (unsigned)C * 2u;
        voffA[i] = (unsigned)R * AL.rowpitch * ESZ + cbytes; voffB[i] = (unsigned)Rb * (unsigned)K * ESZ + (unsigned)C * 2u; }
    const size_t kstep = 128, kstepA = AL.kstep * ESZ;
    const size_t hstep = (size_t)HALF * K * ESZ;
    const size_t hstepA = GATHER ? 0 : (size_t)HALF * AL.rowpitch * ESZ, tstepA = 2 * (size_t)HALF * AL.rowpitch * ESZ;
    const size_t tstep = 2 * hstep;
    const unsigned ldsw = (unsigned)wid * 1024u;
    const int aoff0 = FP8 ? lds_byte(wr * 64 + fr, 16 * fq) : lds_byte(wr * 64 + fr, fq * 8);
    const int boff0 = FP8 ? lds_byte(wc * 32 + fr, 16 * fq) : lds_byte(wc * 32 + fr, fq * 8);
    constexpr int KOFF = FP8 ? 16 : 1024;
    unsigned vAc[2][2], vAn[2][2];
#define PG8_SA(b, h) (((b) * 2 + (h)) * HTB)
#define PG8_SB(b, h) ((4 + (b) * 2 + (h)) * HTB)
#define PG8_SBR(b, h) (((b) * 2 + (h)) * HTB)
#define PG8_OPQ(x) do { if constexpr (FP8) asm volatile("" : "+v"(x)); } while (0)
#define PG8_STAGE(bufoff, gbase, voff) do { _Pragma("unroll") for (int _i = 0; _i < 2; ++_i) { unsigned _o = (voff)[_i]; PG8_OPQ(_o); \
        __builtin_amdgcn_global_load_lds((const unsigned*)((const char*)(gbase) + _o), (LAS unsigned*)(lds + (bufoff) + ldsw + _i * 8192), 16, 0, 0); } } while (0)
#define PG8_STAGE_A(bufoff, gbase, h, nx) do { _Pragma("unroll") for (int _i = 0; _i < 2; ++_i) { \
        unsigned _o = GATHER ? ((nx) ? vAn[h][_i] : vAc[h][_i]) : voffA[_i]; PG8_OPQ(_o); \
        __builtin_amdgcn_global_load_lds((const unsigned*)((const char*)(gbase) + (size_t)(h) * hstepA + _o), (LAS unsigned*)(lds + (bufoff) + ldsw + _i * 8192), 16, 0, 0); } } while (0)
#define PG8_GIDX(u, v) do { if (GATHER) { int _t = tid; asm volatile("" : "+v"(_t));   \
        _Pragma("unroll") for (int _i = 0; _i < 2; ++_i) { int _R, _C; stage_rc(_t * 16 + _i * 8192, _R, _C); \
        _Pragma("unroll") for (int _h = 0; _h < 2; ++_h) v[_h][_i] = (unsigned)AL.idx[(u).g * AL.rpg + (u).pm * BM + _h * HALF + _R] * (AL.rowpitch * ESZ) + (unsigned)_C * 2u; } } } while (0)
#define PG8_ABASE(u) ((const char*)AL.A + (GATHER ? (size_t)0 : ((size_t)(u).g * AL.gstride * ESZ + (size_t)(u).pm * tstepA)))
#define PG8_BBASE(u) ((const char*)Bt + (size_t)(u).g * gstrideB * ESZ + (size_t)(u).pn * tstep)
#define PG8_LDA(dst, b, h) do { _Pragma("unroll") for (int m = 0; m < 4; ++m) _Pragma("unroll") for (int k = 0; k < 2; ++k) dst[m][k] = *(const LAS bf16x8*)(lds + PG8_SA(b, h) + aoff0 + k * KOFF + m * 2048); } while (0)
#define PG8_LDB(dst, b, h) do { _Pragma("unroll") for (int n = 0; n < 2; ++n) _Pragma("unroll") for (int k = 0; k < 2; ++k) dst[n][k] = *(const LAS bf16x8*)(lds + PG8_SB(b, h) + boff0 + k * KOFF + n * 2048); } while (0)
#define PG8_CAT8(x) __builtin_shufflevector(__builtin_bit_cast(v4i32, x[0]), __builtin_bit_cast(v4i32, x[1]), 0, 1, 2, 3, 4, 5, 6, 7)
#define PG8_MMA(ai, bj, At, Bt_) do { __builtin_amdgcn_s_setprio(1); _Pragma("unroll") for (int m = 0; m < 4; ++m) _Pragma("unroll") for (int n = 0; n < 2; ++n) { \
        if constexpr (FP8) acc[ai][bj][m][n] = __builtin_amdgcn_mfma_scale_f32_16x16x128_f8f6f4(PG8_CAT8(Bt_[n]), PG8_CAT8(At[m]), acc[ai][bj][m][n], 0, 0, 0, 0x7f7f7f7f, 0, 0x7f7f7f7f); \
        else { _Pragma("unroll") for (int k = 0; k < 2; ++k) acc[ai][bj][m][n] = __builtin_amdgcn_mfma_f32_16x16x32_bf16(Bt_[n][k], At[m][k], acc[ai][bj][m][n], 0, 0, 0); } } \
        __builtin_amdgcn_s_setprio(0); } while (0)
#define PG8_WAIT_V(n) asm volatile("s_waitcnt vmcnt(" #n ")" ::: "memory")
#define PG8_WAIT_L(n) asm volatile("s_waitcnt lgkmcnt(" #n ")" ::: "memory")
#define PG8_BAR __builtin_amdgcn_s_barrier()
#define PG8_SCHED __builtin_amdgcn_sched_barrier(0)
    Unit cur, nxt; int ui = 0;
    if (!S.next(0, cur)) return;
    PG8_GIDX(cur, vAc);
    f32x4 acc[2][2][4][2];
#pragma unroll
    for (int a = 0; a < 2; ++a)
#pragma unroll
        for (int b = 0; b < 2; ++b)
#pragma unroll
            for (int m = 0; m < 4; ++m)
#pragma unroll
                for (int n = 0; n < 2; ++n) acc[a][b][m][n] = (f32x4){0.f, 0.f, 0.f, 0.f};
    bf16x8 At[4][2], B0[2][2], B1[2][2];
    const char* cA = PG8_ABASE(cur); const char* cB = PG8_BBASE(cur);
    PG8_STAGE(PG8_SB(0, 0), cB, voffB); PG8_STAGE(PG8_SB(0, 1), cB + hstep, voffB); PG8_STAGE_A(PG8_SA(0, 0), cA, 0, false); PG8_STAGE_A(PG8_SA(0, 1), cA, 1, false);
    if (wr == 1) PG8_BAR;
    PG8_WAIT_V(2); PG8_BAR;
    PG8_STAGE(PG8_SB(1, 0), cB + kstep, voffB); PG8_STAGE_A(PG8_SA(1, 0), cA + kstepA, 0, false); PG8_STAGE(PG8_SB(1, 1), cB + hstep + kstep, voffB);
    PG8_WAIT_V(6); PG8_BAR;
    for (;;) {
        const bool has_next = S.next(ui + 1, nxt);
        if (GATHER) { if (has_next) { PG8_GIDX(nxt, vAn); } }
        const char* nA = has_next ? PG8_ABASE(nxt) : cA; const char* nB = has_next ? PG8_BBASE(nxt) : cB;
        for (int t = 0; t < nt; t += 2) {
            const bool last = (t == nt - 2), lastn = last && has_next;
            const char* a1 = cA + (size_t)(t + 1) * kstepA;
            const char* a2 = last ? nA : cA + (size_t)(t + 2) * kstepA; const char* b2 = last ? nB : cB + (size_t)(t + 2) * kstep;
            const char* a3 = a2 + kstepA; const char* b3 = b2 + kstep;
            PG8_LDB(B0, 0, 0); PG8_LDB(B1, 0, 1); PG8_SCHED; PG8_LDA(At, 0, 0); PG8_STAGE_A(PG8_SA(1, 1), a1, 1, false);
            PG8_WAIT_V(8); PG8_WAIT_L(0); PG8_BAR; PG8_MMA(0, 0, At, B0); PG8_MMA(0, 1, At, B1); PG8_BAR; PG8_SCHED;
            PG8_LDA(At, 0, 1); PG8_STAGE(PG8_SB(0, 0), b2, voffB); PG8_STAGE(PG8_SB(0, 1), b2 + hstep, voffB); PG8_STAGE_A(PG8_SA(0, 0), a2, 0, lastn);
            PG8_WAIT_V(8); PG8_WAIT_L(0); PG8_BAR; PG8_MMA(1, 0, At, B0); PG8_MMA(1, 1, At, B1); PG8_BAR; PG8_SCHED;
            PG8_LDB(B0, 1, 0); PG8_LDB(B1, 1, 1); PG8_SCHED; PG8_LDA(At, 1, 0); PG8_STAGE_A(PG8_SA(0, 1), a2, 1, lastn);
            PG8_WAIT_V(8); PG8_WAIT_L(0); PG8_BAR; PG8_MMA(0, 0, At, B0); PG8_MMA(0, 1, At, B1); PG8_BAR; PG8_SCHED;
            PG8_LDA(At, 1, 1); PG8_STAGE(PG8_SB(1, 0), b3, voffB); PG8_STAGE(PG8_SB(1, 1), b3 + hstep, voffB); PG8_STAGE_A(PG8_SA(1, 0), a3, 0, lastn);
            PG8_WAIT_V(8); PG8_WAIT_L(0); PG8_BAR; PG8_MMA(1, 0, At, B0); PG8_MMA(1, 1, At, B1); PG8_BAR; PG8_SCHED;
        }
        if (wr == 0) PG8_BAR;
        E(acc, cur, wr, wc, fr, fq);
        if (!has_next) break;
#pragma unroll
        for (int a = 0; a < 2; ++a)
#pragma unroll
            for (int b = 0; b < 2; ++b)
#pragma unroll
                for (int m = 0; m < 4; ++m)
#pragma unroll
                    for (int n = 0; n < 2; ++n) acc[a][b][m][n] = (f32x4){0.f, 0.f, 0.f, 0.f};
        cur = nxt; cA = nA; cB = nB; ++ui;
        if (GATHER) {
#pragma unroll
            for (int _h = 0; _h < 2; ++_h)
#pragma unroll
                for (int _i = 0; _i < 2; ++_i) vAc[_h][_i] = vAn[_h][_i]; }
        if (wr == 1) PG8_BAR;
    }
    PG8_WAIT_V(0);
    PG8_BAR;
#undef PG8_SA
#undef PG8_SB
#undef PG8_SBR
#undef PG8_STAGE
#undef PG8_OPQ
#undef PG8_STAGE_A
#undef PG8_GIDX
#undef PG8_ABASE
#undef PG8_BBASE
#undef PG8_LDA
#undef PG8_CAT8
#undef PG8_LDB
#undef PG8_MMA
#undef PG8_WAIT_V
#undef PG8_WAIT_L
#undef PG8_BAR
#undef PG8_SCHED
}

__device__ __forceinline__ float fast_sigmoid(float x) { return __builtin_amdgcn_rcpf(1.0f + __builtin_amdgcn_exp2f(-1.4426950408889634f * x)); }
struct EpiSwiglu {
    static constexpr bool PERM = true;
    unsigned char* O; int ldc; size_t gstride;
    __device__ __forceinline__ void operator()(const f32x4 (&acc)[2][2][4][2], const Unit& u, int wr, int wc, int fr, int fq) const {
        const int row0 = u.pm * BM + wr * 64 + fr, col0 = u.pn * HALF + wc * 32 + 8 * fq;
        unsigned char* base = O + (size_t)u.g * gstride;
#pragma unroll
        for (int ai = 0; ai < 2; ++ai)
#pragma unroll
            for (int m = 0; m < 4; ++m) { unsigned char* rowp = base + (size_t)(row0 + ai * HALF + m * 16) * ldc + col0;
                f32x4 o[2];
#pragma unroll
                for (int n = 0; n < 2; ++n) {
                    const f32x4 a = acc[ai][0][m][n] * W8_INV, b = acc[ai][1][m][n] * W8_INV, t = a * (-1.4426950408889634f);
                    f32x4 e; e.x = __builtin_amdgcn_exp2f(t.x); e.y = __builtin_amdgcn_exp2f(t.y); e.z = __builtin_amdgcn_exp2f(t.z); e.w = __builtin_amdgcn_exp2f(t.w);
                    e = e + 1.0f;
                    f32x4 r; r.x = __builtin_amdgcn_rcpf(e.x); r.y = __builtin_amdgcn_rcpf(e.y); r.z = __builtin_amdgcn_rcpf(e.z); r.w = __builtin_amdgcn_rcpf(e.w);
                    o[n] = (a * b) * r; }
                *(u32x2*)rowp = (u32x2){pk4_fp8(o[0].x, o[0].y, o[0].z, o[0].w), pk4_fp8(o[1].x, o[1].y, o[1].z, o[1].w)}; }
    }
};
struct EpiBf16 {
    static constexpr bool PERM = true;
    bf16_t* O; int ldc;
    __device__ __forceinline__ void operator()(const f32x4 (&acc)[2][2][4][2], const Unit& u, int wr, int wc, int fr, int fq) const {
        const int row0 = u.pm * BM + wr * 64 + fr, col0 = u.pn * BM + wc * 32 + 8 * fq;
#pragma unroll
        for (int ai = 0; ai < 2; ++ai)
#pragma unroll
            for (int m = 0; m < 4; ++m) { bf16_t* rowp = O + (size_t)(row0 + ai * HALF + m * 16) * ldc + col0;
#pragma unroll
                for (int bj = 0; bj < 2; ++bj) { const f32x4 v0 = acc[ai][bj][m][0], v1 = acc[ai][bj][m][1];
                    u32x4 w; w.x = cvt_pk_bf16(v0[0], v0[1]); w.y = cvt_pk_bf16(v0[2], v0[3]); w.z = cvt_pk_bf16(v1[0], v1[1]); w.w = cvt_pk_bf16(v1[2], v1[3]);
                    *(u32x4*)(rowp + bj * HALF) = w; } }
    }
};
struct EpiGeluBf16 {
    static constexpr bool PERM = true;
    bf16_t* O; int ldc; size_t gstride;
    __device__ __forceinline__ void operator()(const f32x4 (&acc)[2][2][4][2], const Unit& u, int wr, int wc, int fr, int fq) const {
        const int row0 = u.pm * BM + wr * 64 + fr, col0 = u.pn * BM + wc * 32 + 8 * fq;
        bf16_t* base = O + (size_t)u.g * gstride;
#pragma unroll
        for (int ai = 0; ai < 2; ++ai)
#pragma unroll
            for (int m = 0; m < 4; ++m) { bf16_t* rowp = base + (size_t)(row0 + ai * HALF + m * 16) * ldc + col0;
#pragma unroll
                for (int bj = 0; bj < 2; ++bj) { float o[8];
#pragma unroll
                    for (int n = 0; n < 2; ++n)
#pragma unroll
                        for (int q = 0; q < 4; ++q) { const float x = acc[ai][bj][m][n][q]; o[4 * n + q] = x * fast_sigmoid(1.5957691216057308f * (x + 0.044715f * x * x * x)); }
                    u32x4 w; w.x = cvt_pk_bf16(o[0], o[1]); w.y = cvt_pk_bf16(o[2], o[3]); w.z = cvt_pk_bf16(o[4], o[5]); w.w = cvt_pk_bf16(o[6], o[7]);
                    *(u32x4*)(rowp + bj * HALF) = w; } }
    }
};
struct EpiGate {
    static constexpr bool PERM = true;
    bf16_t* O; int ldc; size_t gstride; const float* gate; int rpg;
    __device__ __forceinline__ void operator()(const f32x4 (&acc)[2][2][4][2], const Unit& u, int wr, int wc, int fr, int fq) const {
        const int row0 = u.pm * BM + wr * 64 + fr, col0 = u.pn * BM + wc * 32 + 8 * fq;
        bf16_t* base = O + (size_t)u.g * gstride;
#pragma unroll
        for (int ai = 0; ai < 2; ++ai)
#pragma unroll
            for (int m = 0; m < 4; ++m) { const int row = row0 + ai * HALF + m * 16; const float gt = gate[u.g * rpg + row] * W8_INV; bf16_t* rowp = base + (size_t)row * ldc + col0;
#pragma unroll
                for (int bj = 0; bj < 2; ++bj) { const f32x4 v0 = acc[ai][bj][m][0] * gt, v1 = acc[ai][bj][m][1] * gt;
                    u32x4 w; w.x = cvt_pk_bf16(v0[0], v0[1]); w.y = cvt_pk_bf16(v0[2], v0[3]); w.z = cvt_pk_bf16(v1[0], v1[1]); w.w = cvt_pk_bf16(v1[2], v1[3]);
                    *(u32x4*)(rowp + bj * HALF) = w; } }
    }
};
struct EpiF32 {
    static constexpr bool PERM = false;
    float* C; int ldc; size_t gstride;
    __device__ __forceinline__ void operator()(const f32x4 (&acc)[2][2][4][2], const Unit& u, int wr, int wc, int fr, int fq) const {
        const int row0 = u.pm * BM + wr * 64 + fr, col0 = u.pn * BM + wc * 32 + 4 * fq;
#pragma unroll
        for (int ai = 0; ai < 2; ++ai)
#pragma unroll
            for (int m = 0; m < 4; ++m) { float* rowp = C + (size_t)u.g * gstride + (size_t)(row0 + ai * HALF + m * 16) * ldc + col0;
#pragma unroll
                for (int bj = 0; bj < 2; ++bj)
#pragma unroll
                    for (int n = 0; n < 2; ++n) *(f32x4*)(rowp + bj * HALF + n * 16) = acc[ai][bj][m][n]; }
    }
};
struct EpiResid {
    static constexpr bool PERM = true;
    bf16_t* X; const float* modL;
    __device__ __forceinline__ void operator()(const f32x4 (&acc)[2][2][4][2], const Unit& u, int wr, int wc, int fr, int fq) const {
        const int row0 = u.pm * BM + wr * 64 + fr, col0 = u.pn * BM + wc * 32 + 8 * fq;
        const int b = u.pm / 17, j = (u.pm - b * 17 == 0) ? 8 : b;
        const float* g1 = modL + (size_t)(j * 6 + 2) * 1024 + col0;
        f32x4 gv[2][2];
#pragma unroll
        for (int bj = 0; bj < 2; ++bj)
#pragma unroll
            for (int n = 0; n < 2; ++n) gv[bj][n] = *(const f32x4*)(g1 + bj * HALF + n * 4);
#pragma unroll
        for (int ai = 0; ai < 2; ++ai)
#pragma unroll
            for (int m = 0; m < 4; ++m) { bf16_t* rowp = X + (size_t)(row0 + ai * HALF + m * 16) * D + col0;
#pragma unroll
                for (int bj = 0; bj < 2; ++bj) { u32x4* p = (u32x4*)(rowp + bj * HALF); const u32x4 w = *p;
                    const f32x4 x0 = bf4_to_f32((u32x2){w.x, w.y}) + gv[bj][0] * acc[ai][bj][m][0], x1 = bf4_to_f32((u32x2){w.z, w.w}) + gv[bj][1] * acc[ai][bj][m][1];
                    const u32x2 o0 = f32_to_bf4(x0), o1 = f32_to_bf4(x1); *p = (u32x4){o0.x, o0.y, o1.x, o1.y}; } }
    }
};
struct EpiGluResid {
    static constexpr bool PERM = true;
    bf16_t* X; const float* modL; const float* bias;
    __device__ __forceinline__ void operator()(const f32x4 (&acc)[2][2][4][2], const Unit& u, int wr, int wc, int fr, int fq) const {
        const int row0 = u.pm * BM + wr * 64 + fr, col0 = u.pn * HALF + wc * 32 + 8 * fq;
        const int b = u.pm / 17, j = (u.pm - b * 17 == 0) ? 8 : b;
        const float* g1 = modL + (size_t)(j * 6 + 2) * 1024 + col0;
        f32x4 gv[2], ba[2], bg[2];
#pragma unroll
        for (int n = 0; n < 2; ++n) { gv[n] = *(const f32x4*)(g1 + n * 4); ba[n] = *(const f32x4*)(bias + col0 + n * 4); bg[n] = *(const f32x4*)(bias + 1024 + col0 + n * 4); }
#pragma unroll
        for (int ai = 0; ai < 2; ++ai)
#pragma unroll
            for (int m = 0; m < 4; ++m) { u32x4* p = (u32x4*)(X + (size_t)(row0 + ai * HALF + m * 16) * D + col0); const u32x4 w = *p;
                f32x4 xo[2] = {bf4_to_f32((u32x2){w.x, w.y}), bf4_to_f32((u32x2){w.z, w.w})};
#pragma unroll
                for (int n = 0; n < 2; ++n) { const f32x4 a = acc[ai][0][m][n] + ba[n], g = acc[ai][1][m][n] + bg[n];
                    f32x4 o; o.x = a.x * fast_sigmoid(g.x); o.y = a.y * fast_sigmoid(g.y); o.z = a.z * fast_sigmoid(g.z); o.w = a.w * fast_sigmoid(g.w);
                    xo[n] = xo[n] + gv[n] * o; }
                const u32x2 o0 = f32_to_bf4(xo[0]), o1 = f32_to_bf4(xo[1]); *p = (u32x4){o0.x, o0.y, o1.x, o1.y}; }
    }
};
}

namespace attn_body {
using bf16=__hip_bfloat16;
using bf16x8=__attribute__((ext_vector_type(8)))short;
using s16x4=__attribute__((ext_vector_type(4)))short;
using f32x16=__attribute__((ext_vector_type(16)))float;
using u32x4=__attribute__((ext_vector_type(4)))unsigned;
constexpr int D=64,QP=512,KP=128,OP=1024;
constexpr int NW=8,QBLK=32,QB=QBLK*NW,KVBLK=64;
__device__ __forceinline__ int crow(int r,int hi){return (r&3)+8*(r>>2)+4*hi;}
#define SBAR() __builtin_amdgcn_sched_barrier(0)
__device__ __forceinline__ void cmask(f32x16&p0,f32x16&p1,int jb,int qrel,int hi){
  const float NEG=-INFINITY; int kb=64*jb+4*hi;
  #pragma unroll
  for(int r=0;r<16;++r){int kv=kb+(r&3)+8*(r>>2); if(kv>qrel)p0[r]=NEG; if(kv+32>qrel)p1[r]=NEG;}
}

constexpr int NSLOT=3, SLOTB=8192;
constexpr int LDS_K=0, LDS_V=NSLOT*SLOTB, LDS_WS=2*NSLOT*SLOTB, LDS_OST=LDS_WS+NW*64*4, LDS_BYTES=LDS_OST+NW*4096;
constexpr float C2=0.125f*1.4426950408889634f;
__device__ __forceinline__ void glds16(const void*gsrc,unsigned lds_dst){unsigned keep;
  asm volatile("s_mov_b32 %0, m0\n\ts_mov_b32 m0, %2\n\ts_nop 0\n\tglobal_load_lds_dwordx4 %1, off\n\ts_mov_b32 m0, %0":"=&s"(keep):"v"(gsrc),"s"(lds_dst):"memory");}
__device__ __forceinline__ float max3f(float a,float b,float c){float r;asm("v_max3_f32 %0, %1, %2, %3":"=v"(r):"v"(a),"v"(b),"v"(c));return r;}
__device__ __forceinline__ float max2f(float a,float b){float r;asm("v_max_f32_e32 %0, %1, %2":"=v"(r):"v"(a),"v"(b));return r;}
__device__ __forceinline__ float fadd_s(float a,float b){float r;asm("v_add_f32_e32 %0, %1, %2":"=v"(r):"v"(a),"v"(b));return r;}
__device__ __forceinline__ float fsub_s(float a,float b){float r;asm("v_sub_f32_e32 %0, %1, %2":"=v"(r):"v"(a),"v"(b));return r;}
typedef float f32x2_t __attribute__((ext_vector_type(2))); typedef __bf16 bf16x2_t __attribute__((ext_vector_type(2)));
__device__ __forceinline__ unsigned cvtpk_s(float lo,float hi){f32x2_t v={lo,hi};bf16x2_t b=__builtin_convertvector(v,bf16x2_t);return __builtin_bit_cast(unsigned,b);}
#define WAIT_BAR(N) asm volatile("s_waitcnt vmcnt(" #N ") lgkmcnt(0)\n\ts_barrier":::"memory")

__device__ __forceinline__ void qkt(f32x16&p0,f32x16&p1,const char*Kslot,const bf16x8*qr,const f32x16&negm,int r32,int hi){
  const char*kb=Kslot+hi*1024+r32*16;
  #pragma unroll
  for(int d0=0;d0<4;++d0){
    const bf16x8 b0=*reinterpret_cast<const bf16x8*>(kb+d0*2048);
    const bf16x8 b1=*reinterpret_cast<const bf16x8*>(kb+d0*2048+512);
    if(d0==0){p0=__builtin_amdgcn_mfma_f32_32x32x16_bf16(b0,qr[0],negm,0,0,0);p1=__builtin_amdgcn_mfma_f32_32x32x16_bf16(b1,qr[0],negm,0,0,0);}
    else{p0=__builtin_amdgcn_mfma_f32_32x32x16_bf16(b0,qr[d0],p0,0,0,0);p1=__builtin_amdgcn_mfma_f32_32x32x16_bf16(b1,qr[d0],p1,0,0,0);}}
}
typedef __attribute__((address_space(3))) const char* lds_cptr;
typedef short v4i16_t __attribute__((ext_vector_type(4)));
__device__ __forceinline__ void kload8(bf16x8*kf,lds_cptr kp){
  kf[0]=*(const __attribute__((address_space(3))) bf16x8*)(kp);      kf[1]=*(const __attribute__((address_space(3))) bf16x8*)(kp+512);
  kf[2]=*(const __attribute__((address_space(3))) bf16x8*)(kp+2048); kf[3]=*(const __attribute__((address_space(3))) bf16x8*)(kp+2560);
  kf[4]=*(const __attribute__((address_space(3))) bf16x8*)(kp+4096); kf[5]=*(const __attribute__((address_space(3))) bf16x8*)(kp+4608);
  kf[6]=*(const __attribute__((address_space(3))) bf16x8*)(kp+6144); kf[7]=*(const __attribute__((address_space(3))) bf16x8*)(kp+6656);
}
__device__ __forceinline__ void kload2(bf16x8*kf,lds_cptr kp,int j){ kf[2*j]=*(const __attribute__((address_space(3))) bf16x8*)(kp+j*2048); kf[2*j+1]=*(const __attribute__((address_space(3))) bf16x8*)(kp+j*2048+512); }
__device__ __forceinline__ s16x4 vtr(lds_cptr p){ return __builtin_bit_cast(s16x4,__builtin_amdgcn_ds_read_tr16_b64_v4i16((__attribute__((address_space(3))) v4i16_t*)p)); }
__device__ __forceinline__ float rowmax(const f32x16&p0,const f32x16&p1){
  float a=max3f(p0[0],p0[1],p1[0]),b=max3f(p0[2],p0[3],p1[1]);a=max3f(a,p1[2],p1[3]);
  #pragma unroll
  for(int r=4;r<16;r+=4){a=max3f(a,p0[r],p0[r+1]);b=max3f(b,p0[r+2],p0[r+3]);a=max3f(a,p1[r],p1[r+1]);b=max3f(b,p1[r+2],p1[r+3]);}
  const float m=max2f(a,b);
  auto rr=__builtin_amdgcn_permlane32_swap(__float_as_uint(m),__float_as_uint(m),false,false);
  return max2f(__uint_as_float(rr[0]),__uint_as_float(rr[1]));
}
__device__ __forceinline__ void pv(f32x16*o,int vb,bf16x8 pa0,bf16x8 pa1,bf16x8 pa2,bf16x8 pa3){
  #pragma unroll
  for(int d0=0;d0<2;++d0){s16x4 lo[4],hi[4];
    #pragma unroll
    for(int ks=0;ks<4;++ks){
      asm volatile("ds_read_b64_tr_b16 %0,%1 offset:%c2":"=&v"(lo[ks]):"v"(vb),"i"(d0*4096+ks*1024):"memory");
      asm volatile("ds_read_b64_tr_b16 %0,%1 offset:%c2":"=&v"(hi[ks]):"v"(vb),"i"(d0*4096+ks*1024+512):"memory");}
    asm volatile("s_waitcnt lgkmcnt(0)":::"memory");SBAR();
    #define PK(k) (bf16x8){lo[k][0],lo[k][1],lo[k][2],lo[k][3],hi[k][0],hi[k][1],hi[k][2],hi[k][3]}
    o[d0]=__builtin_amdgcn_mfma_f32_32x32x16_bf16(pa0,PK(0),o[d0],0,0,0);
    o[d0]=__builtin_amdgcn_mfma_f32_32x32x16_bf16(pa1,PK(1),o[d0],0,0,0);
    o[d0]=__builtin_amdgcn_mfma_f32_32x32x16_bf16(pa2,PK(2),o[d0],0,0,0);
    o[d0]=__builtin_amdgcn_mfma_f32_32x32x16_bf16(pa3,PK(3),o[d0],0,0,0);
    #undef PK
  }
}

#ifndef ATTN_STORE16
#define ATTN_STORE16(p,v) (*(u32x4*)(p)=(v))
#endif
template<int THRL> __device__ __forceinline__ void attn_unit(const bf16*Qw0,const bf16*Kh,const bf16*Vh,bf16*Ow0,const int NT,char*shm,const int wid){
  const int lane=lane_id(),r32=lane&31,hi=lane>>5;
  const bf16*Qw=Qw0+(long)(wid*QBLK)*QP;
  const unsigned lds0=(unsigned)(uintptr_t)shm;
  float*wsf=(float*)(shm+LDS_WS)+wid*64;
  const bf16*ksrc=Kh+(long)lane*KP+wid*8;
  const bf16*vsrc=Vh+(long)(16*(wid&3)+(lane>>2))*KP+(wid>>2)*32+(lane&3)*8;
  const unsigned kdst=lds0+LDS_K+wid*1024, vdst=lds0+LDS_V+wid*1024;
  #define DMA_K(t,slot) glds16(ksrc+(long)(t)*KVBLK*KP,(unsigned)__builtin_amdgcn_readfirstlane(kdst+(slot)))
  #define DMA_V(t,slot) glds16(vsrc+(long)(t)*KVBLK*KP,(unsigned)__builtin_amdgcn_readfirstlane(vdst+(slot)))
  const int vb0=(int)(lds0+LDS_V)+((lane>>4)&1)*32+(lane&3)*8+(4*hi+((lane&15)>>2))*64;
  const char*Kbase=shm+LDS_K; bf16x8 kf[8];
  const lds_cptr shm3=(lds_cptr)shm; const lds_cptr kp0=shm3+LDS_K+hi*1024+r32*16; const lds_cptr vp0=shm3+LDS_V+((lane>>4)&1)*32+(lane&3)*8+(4*hi+((lane&15)>>2))*64;
  DMA_K(0,0);DMA_V(0,0);DMA_K(1,SLOTB);
  bf16x8 qr[4];
  #pragma unroll
  for(int d0=0;d0<4;++d0)qr[d0]=*reinterpret_cast<const bf16x8*>(&Qw[(long)r32*QP+d0*16+hi*8]);
  float mhat=0.f,l_reg=0.f;f32x16 o[2];o[0]=f32x16{};o[1]=f32x16{};f32x16 negm=f32x16{};asm volatile("":"+v"(negm));
  #define CMASK(P0,P1,t) do{}while(0)
  bool resc=false;
  #define START(P0,P1) do{ const float rm=rowmax(P0,P1); resc=false; \
    { const float dl=rm; mhat=fadd_s(mhat,dl); \
      _Pragma("unroll") for(int r=0;r<16;++r){P0[r]=fsub_s(P0[r],dl);P1[r]=fsub_s(P1[r],dl);} \
      _Pragma("unroll") for(int r=0;r<16;++r)negm[r]=-mhat; asm volatile("":"+v"(negm)); } \
    _Pragma("unroll") for(int r=0;r<16;++r)P0[r]=__builtin_amdgcn_exp2f(P0[r]); }while(0)
  #define RESC() do{ if(resc){ asm volatile("s_waitcnt lgkmcnt(0)":::"memory"); \
      _Pragma("unroll") for(int d_=0;d_<2;++d_) _Pragma("unroll") for(int r=0;r<16;++r)o[d_][r]*=wsf[crow(r,hi)]; } }while(0)
  f32x16 pA0,pA1,pB0,pB1;
  int sl_prev=0,sl_cur=0,sl_next=SLOTB;
  #define ROT() do{sl_prev=sl_cur;sl_cur=sl_next;sl_next=(sl_next==(NSLOT-1)*SLOTB)?0:sl_next+SLOTB;}while(0)
  DMA_K(2,2*SLOTB);
  WAIT_BAR(3);
  qkt(pA0,pA1,Kbase,qr,negm,r32,hi);asm volatile("s_nop 15\n\ts_nop 7":"+v"(pA0),"+v"(pA1));CMASK(pA0,pA1,0);
  START(pA0,pA1);
  _Pragma("unroll") for(int r=0;r<16;++r)pA1[r]=__builtin_amdgcn_exp2f(pA1[r]);
  WAIT_BAR(0);
  DMA_K(3,0);DMA_V(1,SLOTB);
  ROT();
  kload8(kf,kp0+sl_cur);
  WAIT_BAR(2);
  s16x4 vlo[8],vhi[8]; u32x4 pw0,pw1,pw2,pw3;
  #define PKW(P,B) cvtpk_s(P[B],P[B+1])
  #define PAF(k) __builtin_bit_cast(bf16x8,pw##k)
  #define VFR(i) (bf16x8){vlo[i][0],vlo[i][1],vlo[i][2],vlo[i][3],vhi[i][0],vhi[i][1],vhi[i][2],vhi[i][3]}
  #define PIN(x) asm volatile("":"+v"(x))
  #define MX3(a,b,c) __builtin_fmaxf(__builtin_fmaxf((a),(b)),(c))
  #define GAPA(MF,A0,A1,A2,A3,W0,W1,PW) do{ MF; sacc+=A0; sacc+=A1; sacc+=A2; sacc+=A3; PIN(sacc); W0; W1; PIN(PW); SBAR(); }while(0)
  #define EX(v) __builtin_amdgcn_exp2f(v)
  #define GAPB(MF,X,B) do{ MF; X[B]=EX(X[B]); X[B+1]=EX(X[B+1]); X[B+2]=EX(X[B+2]); X[B+3]=EX(X[B+3]); PIN(X); SBAR(); }while(0)
  #define VRD(i) do{ vlo[i]=vtr(vp_+(((i)>>2)*4096+((i)&3)*1024)); vhi[i]=vtr(vp_+(((i)>>2)*4096+((i)&3)*1024+512)); }while(0)
  #define KRD(G,j) do{ if(G){ kload2(kf,kp0+sl_next,j); SBAR(); } }while(0)
  #define STEP(C0,C1,P0,P1,t,GK,GV,GL) do{ SBAR(); \
    const lds_cptr vp_=vp0+sl_prev; \
    VRD(0); SBAR(); float sacc=(P0[0]+P0[1]); \
    GAPA(C0=__builtin_amdgcn_mfma_f32_32x32x16_bf16(kf[0],qr[0],negm,0,0,0), P0[2],P0[3],P0[4],P0[5],     pw0[0]=PKW(P0,0), pw0[1]=PKW(P0,2), pw0); \
    VRD(4); SBAR(); GAPA(C1=__builtin_amdgcn_mfma_f32_32x32x16_bf16(kf[1],qr[0],negm,0,0,0), P0[6],P0[7],P0[8],P0[9],     pw0[2]=PKW(P0,4), pw0[3]=PKW(P0,6), pw0); \
    VRD(1); SBAR(); GAPA(C0=__builtin_amdgcn_mfma_f32_32x32x16_bf16(kf[2],qr[1],C0,0,0,0),   P0[10],P0[11],P0[12],P0[13], pw1[0]=PKW(P0,8), pw1[1]=PKW(P0,10), pw1); \
    VRD(5); SBAR(); GAPA(C1=__builtin_amdgcn_mfma_f32_32x32x16_bf16(kf[3],qr[1],C1,0,0,0),   P0[14],P0[15],P1[0],P1[1],   pw1[2]=PKW(P0,12),pw1[3]=PKW(P0,14), pw1); \
    VRD(2); SBAR(); GAPA(C0=__builtin_amdgcn_mfma_f32_32x32x16_bf16(kf[4],qr[2],C0,0,0,0),   P1[2],P1[3],P1[4],P1[5],     pw2[0]=PKW(P1,0), pw2[1]=PKW(P1,2), pw2); \
    VRD(6); SBAR(); GAPA(C1=__builtin_amdgcn_mfma_f32_32x32x16_bf16(kf[5],qr[2],C1,0,0,0),   P1[6],P1[7],P1[8],P1[9],     pw2[2]=PKW(P1,4), pw2[3]=PKW(P1,6), pw2); \
    VRD(3); SBAR(); GAPA(C0=__builtin_amdgcn_mfma_f32_32x32x16_bf16(kf[6],qr[3],C0,0,0,0),   P1[10],P1[11],P1[12],P1[13], pw3[0]=PKW(P1,8), pw3[1]=PKW(P1,10), pw3); \
    VRD(7); SBAR(); GAPA(C1=__builtin_amdgcn_mfma_f32_32x32x16_bf16(kf[7],qr[3],C1,0,0,0),   P1[14],P1[15],0.f,0.f,       pw3[2]=PKW(P1,12),pw3[3]=PKW(P1,14), pw3); \
    l_reg+=sacc; \
    if(GK){DMA_K((t)+3,sl_cur);} if(GV){DMA_V((t)+1,sl_next);} \
    CMASK(C0,C1,t); \
    { float a=MX3(C0[0],C0[1],C1[0]),b=MX3(C0[2],C0[3],C1[1]); a=MX3(a,C1[2],C1[3]); \
      _Pragma("unroll") for(int r=4;r<16;r+=4){a=MX3(a,C0[r],C0[r+1]);b=MX3(b,C0[r+2],C0[r+3]);a=MX3(a,C1[r],C1[r+1]);b=MX3(b,C1[r+2],C1[r+3]);} \
      float rm=__builtin_fmaxf(a,b); { auto rr=__builtin_amdgcn_permlane32_swap(__float_as_uint(rm),__float_as_uint(rm),false,false); rm=__builtin_fmaxf(__uint_as_float(rr[0]),__uint_as_float(rr[1])); } \
      resc=false; \
      if(__builtin_expect(__any(rm>(float)THRL),0)){ const float dl=__builtin_fmaxf(rm,0.f); mhat+=dl; \
        _Pragma("unroll") for(int r=0;r<16;++r){C0[r]-=dl;C1[r]-=dl;} \
        _Pragma("unroll") for(int r=0;r<16;++r)negm[r]=-mhat; asm volatile("":"+v"(negm)); \
        const float f=__builtin_amdgcn_exp2f(-dl); l_reg*=f; if(hi==0)wsf[r32]=f; resc=true; } } \
    SBAR(); \
    GAPB(o[0]=__builtin_amdgcn_mfma_f32_32x32x16_bf16(PAF(0),VFR(0),o[0],0,0,0), C0,0); \
    GAPB(o[1]=__builtin_amdgcn_mfma_f32_32x32x16_bf16(PAF(0),VFR(4),o[1],0,0,0), C0,4); \
    KRD(GL,0); GAPB(o[0]=__builtin_amdgcn_mfma_f32_32x32x16_bf16(PAF(1),VFR(1),o[0],0,0,0), C0,8); \
    KRD(GL,1); GAPB(o[1]=__builtin_amdgcn_mfma_f32_32x32x16_bf16(PAF(1),VFR(5),o[1],0,0,0), C0,12); \
    KRD(GL,2); GAPB(o[0]=__builtin_amdgcn_mfma_f32_32x32x16_bf16(PAF(2),VFR(2),o[0],0,0,0), C1,0); \
    KRD(GL,3); GAPB(o[1]=__builtin_amdgcn_mfma_f32_32x32x16_bf16(PAF(2),VFR(6),o[1],0,0,0), C1,4); \
    GAPB(o[0]=__builtin_amdgcn_mfma_f32_32x32x16_bf16(PAF(3),VFR(3),o[0],0,0,0), C1,8); \
    GAPB(o[1]=__builtin_amdgcn_mfma_f32_32x32x16_bf16(PAF(3),VFR(7),o[1],0,0,0), C1,12); \
    }while(0)
  int t=1;
  #undef CMASK
  #define CMASK(P0,P1,t) do{}while(0)
  for(;t+5<NT;t+=2){
    STEP(pB0,pB1,pA0,pA1,t,true,true,true);     WAIT_BAR(2); RESC(); ROT();
    STEP(pA0,pA1,pB0,pB1,t+1,true,true,true);   WAIT_BAR(2); RESC(); ROT();
  }
  #undef CMASK
  #define CMASK(P0,P1,t) do{}while(0)
  #define ENDW(tt) do{ if((tt)+3<NT){WAIT_BAR(2);} else if((tt)+2<NT){WAIT_BAR(1);} else {WAIT_BAR(0);} }while(0)
  for(;t+1<NT;t+=2){
    STEP(pB0,pB1,pA0,pA1,t,(t+3<NT),(t+1<NT),(t+1<NT));       ENDW(t);   RESC(); ROT();
    STEP(pA0,pA1,pB0,pB1,t+1,(t+4<NT),(t+2<NT),(t+2<NT));     ENDW(t+1); RESC(); ROT();
  }
  STEP(pB0,pB1,pA0,pA1,NT-1,false,false,false); RESC();
  { float sacc=pB0[0]+pB0[1]; _Pragma("unroll") for(int r=2;r<16;++r)sacc+=pB0[r]; _Pragma("unroll") for(int r=0;r<16;++r)sacc+=pB1[r]; l_reg+=sacc;
    pw0=(u32x4){PKW(pB0,0),PKW(pB0,2),PKW(pB0,4),PKW(pB0,6)};pw1=(u32x4){PKW(pB0,8),PKW(pB0,10),PKW(pB0,12),PKW(pB0,14)};pw2=(u32x4){PKW(pB1,0),PKW(pB1,2),PKW(pB1,4),PKW(pB1,6)};pw3=(u32x4){PKW(pB1,8),PKW(pB1,10),PKW(pB1,12),PKW(pB1,14)};
    SBAR(); pv(o,vb0+sl_cur,PAF(0),PAF(1),PAF(2),PAF(3)); }
  #undef PKW
  #undef PAF
  #undef VFR
  #undef PIN
  #undef MX3
  #undef GAPA
  #undef GAPB
  #undef EX
  #undef VRD
  #undef KRD
  #undef STEP
  #undef ENDW
  {auto rr=__builtin_amdgcn_permlane32_swap(__float_as_uint(l_reg),__float_as_uint(l_reg),false,false);l_reg=__uint_as_float(rr[0])+__uint_as_float(rr[1]);}
  if(hi==0)wsf[32+r32]=l_reg;asm volatile("s_waitcnt lgkmcnt(0)":::"memory");
  float rli[16];
  #pragma unroll
  for(int r=0;r<16;++r)rli[r]=__builtin_amdgcn_rcpf(wsf[32+crow(r,hi)]);
  bf16*Ow=Ow0+(long)(wid*QBLK)*OP;
  { bf16*stg=(bf16*)(shm+LDS_OST)+wid*2048;
    #pragma unroll
    for(int r=0;r<16;++r){const int orow=crow(r,hi);
      #pragma unroll
      for(int d0=0;d0<2;++d0)stg[orow*64+d0*32+r32]=__float2bfloat16(o[d0][r]*rli[r]);}
    asm volatile("s_waitcnt lgkmcnt(0)":::"memory");
    #pragma unroll
    for(int i=0;i<4;++i){const int row=i*8+(lane>>3),ch=lane&7; const u32x4 v=*(const u32x4*)(stg+row*64+ch*8); ATTN_STORE16(Ow+(long)row*OP+ch*8,v);} }
  asm volatile("s_waitcnt lgkmcnt(0)\n\ts_barrier":::"memory");
  #undef DMA_K
  #undef DMA_V
  #undef CMASK
  #undef START
  #undef RESC
  #undef ROT
}
constexpr int ATTN_LDS_BYTES=LDS_BYTES;
#undef SBAR
#undef WAIT_BAR
}

template <bool PAIRED, class AL, class BL, class EP>
__device__ __forceinline__ void gemm_f32(int groups, int M, int N, int K, const AL& al, const BL& bl, const EP& ep) {
    const int tid = threadIdx.x, lane = tid & 63, wave = tid >> 6, wm = wave >> 2, wn = wave & 3, r32 = lane & 31, h = lane >> 5;
    constexpr int TN = PAIRED ? 128 : 256;
    const int tilesM = M / 128, tilesN = N / TN, per = tilesM * tilesN, total = groups * per;
    const int ldb = bl.ldb;
    for (int t = blockIdx.x; t < total; t += gridDim.x) {
        const int g = t / per, r = t - g * per, tm = r / tilesN, tn = r - tm * tilesN;
        const int m0 = tm * 128 + wm * 64;
        const int n0 = PAIRED ? (tn * 128 + wn * 32) : (tn * 256 + wn * 64);
        const float* a0 = al.row(g, m0 + r32) + 4 * h;
        const float* a1 = al.row(g, m0 + 32 + r32) + 4 * h;
        const float* b0 = bl.ptr(g, 0) + n0 + r32 + (size_t)(4 * h) * ldb;
        const float* b1 = (PAIRED ? bl.ptr(g, 1) + n0 : bl.ptr(g, 0) + n0 + 32) + r32 + (size_t)(4 * h) * ldb;
        f32x16 acc00 = {}, acc01 = {}, acc10 = {}, acc11 = {};
#pragma unroll 2
        for (int k = 0; k < K; k += 8) {
            const f32x4 av0 = *(const f32x4*)(a0 + k), av1 = *(const f32x4*)(a1 + k);
            float bv0[4], bv1[4];
#pragma unroll
            for (int s = 0; s < 4; ++s) { bv0[s] = b0[(size_t)(k + s) * ldb]; bv1[s] = b1[(size_t)(k + s) * ldb]; }
#pragma unroll
            for (int s = 0; s < 4; ++s) {
                acc00 = __builtin_amdgcn_mfma_f32_32x32x2f32(av0[s], bv0[s], acc00, 0, 0, 0);
                acc01 = __builtin_amdgcn_mfma_f32_32x32x2f32(av0[s], bv1[s], acc01, 0, 0, 0);
                acc10 = __builtin_amdgcn_mfma_f32_32x32x2f32(av1[s], bv0[s], acc10, 0, 0, 0);
                acc11 = __builtin_amdgcn_mfma_f32_32x32x2f32(av1[s], bv1[s], acc11, 0, 0, 0);
            }
        }
#pragma unroll
        for (int rr = 0; rr < 16; ++rr) {
            const int ro = (rr & 3) + 8 * (rr >> 2) + 4 * h;
            if (PAIRED) {
                ep(g, m0 + ro, n0 + r32, acc00[rr], acc01[rr]);
                ep(g, m0 + 32 + ro, n0 + r32, acc10[rr], acc11[rr]);
            } else {
                ep(g, m0 + ro, n0 + r32, acc00[rr], 0.f); ep(g, m0 + ro, n0 + 32 + r32, acc01[rr], 0.f);
                ep(g, m0 + 32 + ro, n0 + r32, acc10[rr], 0.f); ep(g, m0 + 32 + ro, n0 + 32 + r32, acc11[rr], 0.f);
            }
        }
    }
}

__device__ __forceinline__ void phase_pro(const Ctx& c, LAS float* ldsf) {
    float* rope = (float*)(c.ws + WS_ROPE);
    for (int i = c.gt; i < 64 * 16; i += c.ngt) {
        const int pos = i >> 4, fi = i & 15; const float inv = powf(10000.0f, -(float)fi / 16.0f), ang = (float)pos * inv;
        rope[2 * i] = cosf(ang); rope[2 * i + 1] = sinf(ang);
    }
    LAS float* sil = ldsf; LAS float* red = ldsf + 9 * 1024;
    for (int i = c.tid; i < 9 * 1024; i += 512) { const int j = i >> 10, k = i & 1023; const float v = (j < 8) ? c.in[IN_C][j * 1024 + k] : c.in[IN_CCTX][k]; sil[i] = siluf_(v); }
    __syncthreads();
    float* MOD = (float*)(c.ws + WS_MOD);
    for (int task = blockIdx.x; task < DEPTH * 96; task += gridDim.x) {
        const int L = task / 96, cb = task - L * 96, col = cb * 64 + c.lane;
        const float* W = c.in[IN_MODW] + (size_t)L * 1024 * 6144;
        float acc[9];
#pragma unroll
        for (int j = 0; j < 9; ++j) acc[j] = 0.f;
        const int k0 = c.wave * 128;
#pragma unroll 4
        for (int k = k0; k < k0 + 128; ++k) { const float w = W[(size_t)k * 6144 + col];
#pragma unroll
            for (int j = 0; j < 9; ++j) acc[j] += sil[j * 1024 + k] * w; }
#pragma unroll
        for (int j = 0; j < 9; ++j) red[(c.wave * 9 + j) * 64 + c.lane] = acc[j];
        __syncthreads();
        if (c.wave == 0) {
            const float bias = c.in[IN_MODB][L * 6144 + col];
#pragma unroll
            for (int j = 0; j < 9; ++j) { float s = bias;
#pragma unroll
                for (int w = 0; w < 8; ++w) s += red[(w * 9 + j) * 64 + c.lane];
                MOD[(size_t)(L * 9 + j) * 6144 + col] = s; }
        }
        __syncthreads();
    }
    unsigned short* X = (unsigned short*)(c.ws + WS_X);
    for (int r = c.gw; r < NROWS; r += c.ngw) {
        const int b = r / RB, s = r - b * RB;
        const float* src = (s < CL) ? c.in[IN_CTX] + (size_t)(b * CL + s) * D : c.in[IN_X] + (size_t)(b * T + s - CL) * D;
        const f32x4* sp = (const f32x4*)src + c.lane; pg8::u32x2* dp = (pg8::u32x2*)(X + (size_t)r * D) + c.lane;
#pragma unroll
        for (int j = 0; j < 4; ++j) dp[64 * j] = pg8::f32_to_bf4(sp[64 * j]);
    }
}

template <bool FINAL, bool GM>
__device__ __forceinline__ void phase_norm1(const Ctx& c, int L) {
    unsigned short* X = (unsigned short*)(c.ws + WS_X);
    const int* SLOT = (const int*)(c.ws + WS_SLOT); const unsigned short* Y = (const unsigned short*)(c.ws + WS_Y);
    int ch[4];
#pragma unroll
    for (int q = 0; q < 4; ++q) ch[q] = GM ? 16 * c.lane + 4 * q : 4 * (c.lane + 64 * q);
    int r = c.gw;
    f32x4 vn[4]; int spn = -1;
    if (r < NROWS) {
#pragma unroll
        for (int q = 0; q < 4; ++q) vn[q] = pg8::bf4_to_f32(*(const pg8::u32x2*)(X + (size_t)r * D + ch[q]));
        if (L > 0 && c.lane < NE) spn = SLOT[(size_t)r * NE + c.lane];
    }
    for (; r < NROWS; r += c.ngw) {
        const int b = r / RB, s = r - b * RB, j = s < CL ? 8 : b;
        unsigned short* xr = X + (size_t)r * D;
        f32x4 v[4]; const int spl = spn;
#pragma unroll
        for (int q = 0; q < 4; ++q) v[q] = vn[q];
        { const int rn = r + c.ngw;
            if (rn < NROWS) {
#pragma unroll
                for (int q = 0; q < 4; ++q) vn[q] = pg8::bf4_to_f32(*(const pg8::u32x2*)(X + (size_t)rn * D + ch[q]));
                if (L > 0 && c.lane < NE) spn = SLOT[(size_t)rn * NE + c.lane];
            } }
        if (FINAL && s < CL) continue;
        if (L > 0) {
            f32x4 sum[4] = {};
            unsigned long long mask = __ballot(spl >= 0 && c.lane < NE);
            while (mask) {
                const int e0 = __builtin_ctzll(mask); mask &= mask - 1;
                const bool two = mask != 0ull; const int e1 = two ? __builtin_ctzll(mask) : e0; if (two) mask &= mask - 1;
                const int sp0 = __builtin_amdgcn_readlane(spl, e0), sp1 = __builtin_amdgcn_readlane(spl, e1);
                const unsigned short* y0 = Y + ((size_t)e0 * EROWS + sp0) * D; const unsigned short* y1 = Y + ((size_t)e1 * EROWS + sp1) * D;
                pg8::u32x2 w0[4], w1[4];
#pragma unroll
                for (int q = 0; q < 4; ++q) { w0[q] = *(const pg8::u32x2*)(y0 + ch[q]); w1[q] = *(const pg8::u32x2*)(y1 + ch[q]); }
#pragma unroll
                for (int q = 0; q < 4; ++q) {
                    sum[q] += (f32x4){__uint_as_float(w0[q].x << 16), __uint_as_float(w0[q].x & 0xffff0000u), __uint_as_float(w0[q].y << 16), __uint_as_float(w0[q].y & 0xffff0000u)};
                    if (two) sum[q] += (f32x4){__uint_as_float(w1[q].x << 16), __uint_as_float(w1[q].x & 0xffff0000u), __uint_as_float(w1[q].y << 16), __uint_as_float(w1[q].y & 0xffff0000u)}; }
            }
            const float* g2 = modp(c, L - 1, j, 5);
#pragma unroll
            for (int q = 0; q < 4; ++q) { v[q] += *(const f32x4*)(g2 + ch[q]) * sum[q]; if (!FINAL) { const pg8::u32x2 w = pg8::f32_to_bf4(v[q]); *(pg8::u32x2*)(xr + ch[q]) = w; v[q] = pg8::bf4_to_f32(w); } }
        }
        float ss = 0.f;
#pragma unroll
        for (int q = 0; q < 4; ++q) ss += v[q].x * v[q].x + v[q].y * v[q].y + v[q].z * v[q].z + v[q].w * v[q].w;
        const float rstd = rsqrtf(wave_sum(ss) * (1.0f / D) + EPS);
        if (FINAL) {
            const float* g = c.in[IN_FNG]; float* op = c.out + (size_t)(b * T + s - CL) * D;
#pragma unroll
            for (int q = 0; q < 4; ++q) *(f32x4*)(op + ch[q]) = v[q] * rstd * *(const f32x4*)(g + ch[q]);
        } else {
            const float* g = c.in[IN_NORMG] + (size_t)(L * 2 + 0) * D; const float* sc = modp(c, L, j, 1); const float* sh = modp(c, L, j, 0);
            unsigned hw[8];
#pragma unroll
            for (int q = 0; q < 4; ++q) { const f32x4 hv = v[q] * rstd * *(const f32x4*)(g + ch[q]) * (1.0f + *(const f32x4*)(sc + ch[q])) + *(const f32x4*)(sh + ch[q]);
                hw[2 * q] = pg8::cvt_pk_bf16(hv.x, hv.y); hw[2 * q + 1] = pg8::cvt_pk_bf16(hv.z, hv.w); }
            if (GM) { unsigned short* o = (unsigned short*)(c.ws + WS_AS5) + ((size_t)c.lane * 1280 + (r >> 5)) * 768 + (r & 31) * 16;
                *(pg8::u32x4*)o = (pg8::u32x4){hw[0], hw[1], hw[2], hw[3]}; *(pg8::u32x4*)(o + 8) = (pg8::u32x4){hw[4], hw[5], hw[6], hw[7]}; }
            else { unsigned short* o = (unsigned short*)(c.ws + WS_HB1) + (size_t)r * D;
#pragma unroll
                for (int q = 0; q < 4; ++q) *(pg8::u32x2*)(o + ch[q]) = (pg8::u32x2){hw[2 * q], hw[2 * q + 1]}; }
        }
    }
}

template <bool SKIPCTX>
__device__ __forceinline__ void phase_norm2_router(const Ctx& c, int L, LAS float* wT) {
    const unsigned short* X = (const unsigned short*)(c.ws + WS_X); unsigned char* HB = (unsigned char*)(c.ws + WS_HB); float* AFF = (float*)(c.ws + WS_AFF);
    const float* WR = c.in[IN_ROUTER] + (size_t)L * D * NE;
    __syncthreads();
    for (int idx = c.tid; idx < D * 4; idx += 512) { const int ch = idx >> 2, e4 = idx & 3; const f32x4 w = *(const f32x4*)(WR + (size_t)ch * NE + 4 * e4);
        wT[(4 * e4 + 0) * D + ch] = w.x; wT[(4 * e4 + 1) * D + ch] = w.y; wT[(4 * e4 + 2) * D + ch] = w.z; wT[(4 * e4 + 3) * D + ch] = w.w; }
    __syncthreads();
    for (int r = c.gw; r < NROWS; r += c.ngw) {
        const int j = row_j(r);
        if (SKIPCTX && j == 8) continue;
        const pg8::u32x2* xp = (const pg8::u32x2*)(X + (size_t)r * D) + c.lane;
        f32x4 v[4]; float ss = 0.f;
#pragma unroll
        for (int q = 0; q < 4; ++q) { v[q] = pg8::bf4_to_f32(xp[64 * q]); ss += v[q].x * v[q].x + v[q].y * v[q].y + v[q].z * v[q].z + v[q].w * v[q].w; }
        const float rstd = rsqrtf(wave_sum(ss) * (1.0f / D) + EPS);
        const f32x4* g = (const f32x4*)(c.in[IN_NORMG] + (size_t)(L * 2 + 1) * D) + c.lane;
        const f32x4* sc = (const f32x4*)modp(c, L, j, 4) + c.lane; const f32x4* sh = (const f32x4*)modp(c, L, j, 3) + c.lane;
        unsigned* hp = (unsigned*)(HB + (size_t)r * D) + c.lane;
        float lg[16];
#pragma unroll
        for (int e = 0; e < 16; ++e) lg[e] = 0.f;
#pragma unroll
        for (int q = 0; q < 4; ++q) {
            const f32x4 f = v[q] * rstd * g[64 * q] * (1.0f + sc[64 * q]) + sh[64 * q];
            hp[64 * q] = pg8::pk4_fp8(f.x, f.y, f.z, f.w);
#pragma unroll
            for (int e = 0; e < 16; ++e) { const f32x4 wv = *(const LAS f32x4*)(wT + e * D + 4 * (c.lane + 64 * q)); lg[e] += (f.x * wv.x + f.y * wv.y) + (f.z * wv.z + f.w * wv.w); }
            __builtin_amdgcn_sched_barrier(0);
        }
        const float mine = reduce16(lg, c.lane);
        const int k = reduce16_k(c.lane);
        float mx = mine;
#pragma unroll
        for (int o = 4; o < 64; o <<= 1) mx = fmaxf(mx, __shfl_xor(mx, o));
        const float ex = expf(mine - mx);
        float den = ex;
#pragma unroll
        for (int o = 4; o < 64; o <<= 1) den += __shfl_xor(den, o);
        if ((c.lane & 3) == 0) AFF[(size_t)r * NE + k] = ex / den;
    }
}

__device__ __forceinline__ void phase_topk(const Ctx& c, LAS unsigned* lds32, int nprob) {
    const float* AFF = (const float*)(c.ws + WS_AFF);
    int* SELROW = (int*)(c.ws + WS_SELROW); float* SELGATE = (float*)(c.ws + WS_SELGATE); int* SLOT = (int*)(c.ws + WS_SLOT);
    LAS unsigned* hist = lds32; LAS unsigned* wsum = lds32 + 256; LAS unsigned* res = lds32 + 272;
    LAS int* srow = (LAS int*)(lds32 + 512);
    const unsigned char* HB = (const unsigned char*)(c.ws + WS_HB); unsigned char* XS = (unsigned char*)(c.ws + WS_XS);
    for (int pid = blockIdx.x; pid < nprob; pid += gridDim.x) {
        const bool lat = pid < 128; const int q = lat ? pid : pid - 128, b = q >> 4, e = q & 15;
        const int N = lat ? T : CL, C = lat ? CAP_LAT : CAP_CTX, row0 = b * RB + (lat ? CL : 0), base = lat ? b * CAP_LAT : NB * CAP_LAT + b * CAP_CTX;
        const int t0 = c.tid * 8; const bool valid = t0 < N;
        unsigned k[8];
#pragma unroll
        for (int i = 0; i < 8; ++i) k[i] = valid ? __float_as_uint(AFF[(size_t)(row0 + t0 + i) * NE + e]) : 0u;
        unsigned prefix = 0u, want = (unsigned)C;
#pragma unroll
        for (int r = 0; r < 4; ++r) {
            const int shift = 24 - 8 * r;
            __syncthreads();
            if (c.tid < 256) hist[c.tid] = 0u;
            __syncthreads();
            if (valid) {
#pragma unroll
                for (int i = 0; i < 8; ++i) if (r == 0 || (k[i] >> (shift + 8)) == prefix) __hip_atomic_fetch_add(&hist[(k[i] >> shift) & 255u], 1u, __ATOMIC_RELAXED, __HIP_MEMORY_SCOPE_WORKGROUP);
            }
            __syncthreads();
            if (c.wave == 0) {
                const unsigned h0 = hist[4 * c.lane], h1 = hist[4 * c.lane + 1], h2 = hist[4 * c.lane + 2], h3 = hist[4 * c.lane + 3];
                unsigned suf = h0 + h1 + h2 + h3;
#pragma unroll
                for (int off = 1; off < 64; off <<= 1) { const unsigned o = __shfl_down(suf, off); if (c.lane + off < 64) suf += o; }
                unsigned nxt = __shfl_down(suf, 1); if (c.lane == 63) nxt = 0u;
                if (suf >= want && nxt < want) {
                    unsigned above = nxt; int d;
                    if (above + h3 >= want) d = 3; else { above += h3; if (above + h2 >= want) d = 2; else { above += h2; if (above + h1 >= want) d = 1; else { above += h1; d = 0; } } }
                    res[0] = (unsigned)(4 * c.lane + d); res[1] = want - above;
                }
            }
            __syncthreads();
            prefix = (prefix << 8) | res[0]; want = res[1];
        }
        const unsigned thr = prefix, need_eq = want;
        unsigned cg = 0u, ce = 0u;
#pragma unroll
        for (int i = 0; i < 8; ++i) { cg += (valid && k[i] > thr) ? 1u : 0u; ce += (valid && k[i] == thr) ? 1u : 0u; }
        unsigned incl = cg | (ce << 16);
#pragma unroll
        for (int off = 1; off < 64; off <<= 1) { const unsigned o = __shfl_up(incl, off); if (c.lane >= off) incl += o; }
        __syncthreads();
        if (c.lane == 63) wsum[c.wave] = incl;
        __syncthreads();
        unsigned wbase = 0u;
#pragma unroll
        for (int w = 0; w < 8; ++w) if (w < c.wave) wbase += wsum[w];
        const unsigned excl = wbase + incl - (cg | (ce << 16));
        unsigned gb = excl & 0xffffu, eb = excl >> 16;
        if (valid) {
#pragma unroll
            for (int i = 0; i < 8; ++i) {
                const int row = row0 + t0 + i; const bool isg = k[i] > thr, ise = k[i] == thr;
                const bool sel = isg || (ise && eb < need_eq);
                const unsigned sp = (unsigned)base + gb + (eb < need_eq ? eb : need_eq);
                if (sel) { SELROW[e * EROWS + sp] = row; SELGATE[e * EROWS + sp] = __uint_as_float(k[i]); SLOT[(size_t)row * NE + e] = (int)sp; srow[sp - (unsigned)base] = row; }
                else SLOT[(size_t)row * NE + e] = -1;
                gb += isg ? 1u : 0u; eb += ise ? 1u : 0u;
            }
        }
        __syncthreads();
        for (int s0 = c.wave * 4; s0 < C; s0 += 32) {
            pg8::u32x4 v4[4];
#pragma unroll
            for (int j = 0; j < 4; ++j) v4[j] = *(const pg8::u32x4*)(HB + (size_t)srow[s0 + j] * D + c.lane * 16);
#pragma unroll
            for (int j = 0; j < 4; ++j) *(pg8::u32x4*)(XS + ((size_t)e * EROWS + base + s0 + j) * D + c.lane * 16) = v4[j];
        }
    }
}

__device__ __forceinline__ void post_ld32(const unsigned short* p, float (&v)[32]) {
#pragma unroll
    for (int q = 0; q < 4; ++q) { const pg8::u32x4 w = ((const pg8::u32x4*)p)[q];
#pragma unroll
        for (int e = 0; e < 4; ++e) { v[8 * q + 2 * e] = __uint_as_float(w[e] << 16); v[8 * q + 2 * e + 1] = __uint_as_float(w[e] & 0xffff0000u); } }
}
__device__ __forceinline__ void post_st32(unsigned short* p, const float (&v)[32], float sc) {
#pragma unroll
    for (int q = 0; q < 4; ++q) { pg8::u32x4 w;
#pragma unroll
        for (int e = 0; e < 4; ++e) w[e] = pg8::cvt_pk_bf16(v[8 * q + 2 * e] * sc, v[8 * q + 2 * e + 1] * sc);
        ((pg8::u32x4*)p)[q] = w; }
}
__device__ __forceinline__ void post_rope(float (&v)[32], const float* cs  ) {
#pragma unroll
    for (int f4 = 0; f4 < 8; ++f4) { const f32x4 t4 = ((const f32x4*)cs)[f4];
        { const float x1 = v[2 * f4], x2 = v[16 + 2 * f4]; v[2 * f4] = x1 * t4.x - x2 * t4.y; v[16 + 2 * f4] = x1 * t4.y + x2 * t4.x; }
        { const float x1 = v[2 * f4 + 1], x2 = v[16 + 2 * f4 + 1]; v[2 * f4 + 1] = x1 * t4.z - x2 * t4.w; v[16 + 2 * f4 + 1] = x1 * t4.w + x2 * t4.z; } }
}
__device__ __forceinline__ void phase_post(const Ctx& c, int i, LAS unsigned char* lds) {
    typedef pg8::bf16x8 bf16x8;
    const unsigned short* P = (const unsigned short*)(c.ws + WS_P); const float* rope = (const float*)(c.ws + WS_ROPE);
    unsigned short* QA = (unsigned short*)(c.ws + WS_QA); unsigned short* KA = (unsigned short*)(c.ws + WS_KA); unsigned short* VA = (unsigned short*)(c.ws + WS_VA);
    unsigned short* RQ = (unsigned short*)(c.ws + WS_RQ); unsigned short* RK = (unsigned short*)(c.ws + WS_RK); unsigned short* RV = (unsigned short*)(c.ws + WS_RV);
    float* U = (float*)(c.ws + WS_U);
    const float* qkg = c.in[IN_QKG] + (size_t)i * 2 * 64;
    constexpr int VTS = 0, KTF = 17408, KTB = 34816;
    const int grp = c.tid >> 8, r = (c.tid & 255) >> 1, half = c.tid & 1;
    const int li = c.lane & 15, q4 = c.lane >> 4;
    for (int unit = blockIdx.x; unit < NB * 34 * 8; unit += gridDim.x) {
        const int hh = unit & 7, bc = unit >> 3, b = bc / 34, cch = bc - b * 34, row0 = b * RB + cch * 128, bh = b * 8 + hh;
        const bool latent = cch >= 2;
        const size_t row = (size_t)(row0 + r);
        const int tpos = cch * 128 + r - CL;
        const float* cs = rope + (size_t)((half == 0 ? (tpos >> 6) : (tpos & 63)) * 16) * 2;
        const float lgf = -expf(c.in[IN_RETRATE][(i * 2 + 0) * 8 + hh]) * 1.4426950408889634f, lgb = -expf(c.in[IN_RETRATE][(i * 2 + 1) * 8 + hh]) * 1.4426950408889634f;
        __syncthreads();
        float v[32];
        post_ld32(P + row * INW + (grp ? 512 : 0) + hh * 64 + 32 * half, v);
        if (grp) {
#pragma unroll
            for (int d = 0; d < 32; ++d) v[d] *= 0.125f; }
        if (latent) post_rope(v, cs);
        post_st32((grp ? RK : RQ) + row * 512 + hh * 64 + 32 * half, v, 1.0f);
        if (grp) { const float wf = exp2f(lgf * (float)(127 - r)), wb = exp2f(lgb * (float)r);
#pragma unroll
            for (int d = 0; d < 32; d += 2) { const unsigned pf = pg8::cvt_pk_bf16(v[d] * wf, v[d + 1] * wf), pb = pg8::cvt_pk_bf16(v[d] * wb, v[d + 1] * wb);
                *(LAS unsigned short*)(lds + KTF + (32 * half + d) * 272 + r * 2) = (unsigned short)(pf & 0xffffu); *(LAS unsigned short*)(lds + KTF + (32 * half + d + 1) * 272 + r * 2) = (unsigned short)(pf >> 16);
                *(LAS unsigned short*)(lds + KTB + (32 * half + d) * 272 + r * 2) = (unsigned short)(pb & 0xffffu); *(LAS unsigned short*)(lds + KTB + (32 * half + d + 1) * 272 + r * 2) = (unsigned short)(pb >> 16); } }
        post_ld32(P + row * INW + (grp ? 2048 : 1024) + hh * 64 + 32 * half, v);
        if (grp == 0) { post_st32(RV + row * 512 + hh * 64 + 32 * half, v, 1.0f);
#pragma unroll
            for (int d = 0; d < 32; d += 2) { const unsigned pv = pg8::cvt_pk_bf16(v[d], v[d + 1]);
                *(LAS unsigned short*)(lds + VTS + (32 * half + d) * 272 + r * 2) = (unsigned short)(pv & 0xffffu); *(LAS unsigned short*)(lds + VTS + (32 * half + d + 1) * 272 + r * 2) = (unsigned short)(pv >> 16); }
        } else {
            float ss = 0.f;
#pragma unroll
            for (int d = 0; d < 32; ++d) ss += v[d] * v[d];
            ss += __shfl_xor(ss, 1);
            const float rs = rsqrtf(ss * (1.0f / 64.0f) + EPS);
#pragma unroll
            for (int d = 0; d < 32; ++d) v[d] = v[d] * rs * qkg[32 * half + d];
            if (latent) post_rope(v, cs);
            post_st32(QA + row * 512 + hh * 64 + 32 * half, v, attn_body::C2);
        }
        if (hh < 2) {
            post_ld32(P + row * INW + (grp ? 2688 : 2560) + hh * 64 + 32 * half, v);
            if (grp == 0) {
                float ss = 0.f;
#pragma unroll
                for (int d = 0; d < 32; ++d) ss += v[d] * v[d];
                ss += __shfl_xor(ss, 1);
                const float rs = rsqrtf(ss * (1.0f / 64.0f) + EPS);
#pragma unroll
                for (int d = 0; d < 32; ++d) v[d] = v[d] * rs * qkg[64 + 32 * half + d];
                if (latent) post_rope(v, cs);
                post_st32(KA + row * 128 + hh * 64 + 32 * half, v, 1.0f);
            } else post_st32(VA + row * 128 + hh * 64 + 32 * half, v, 1.0f);
        }
        __syncthreads();
        { const int dir = c.wave >> 2, dvt = c.wave & 3;
            bf16x8 af[4];
#pragma unroll
            for (int u = 0; u < 4; ++u) af[u] = *(const LAS bf16x8*)(lds + VTS + (16 * dvt + li) * 272 + (32 * u + 8 * q4) * 2);
            float* uo = U + ((size_t)(bh * 34 + cch) * 2 + dir) * 4096;
#pragma unroll
            for (int dkt = 0; dkt < 4; ++dkt) {
                f32x4 a = {0.f, 0.f, 0.f, 0.f};
#pragma unroll
                for (int u = 0; u < 4; ++u) { const bf16x8 kf = *(const LAS bf16x8*)(lds + (dir ? KTB : KTF) + (16 * dkt + li) * 272 + (32 * u + 8 * q4) * 2); a = __builtin_amdgcn_mfma_f32_16x16x32_bf16(af[u], kf, a, 0, 0, 0); }
#pragma unroll
                for (int rr = 0; rr < 4; ++rr) uo[(16 * dvt + 4 * q4 + rr) * 64 + 16 * dkt + li] = a[rr];
            } }
    }
}

__device__ __forceinline__ void phase_ret_prefix(const Ctx& c, int i) {
    const float* U = (const float*)(c.ws + WS_U); unsigned short* ET = (unsigned short*)(c.ws + WS_ET);
    for (int chain = c.gt; chain < 64 * 2 * 4096; chain += c.ngt) {
        const int bh = chain >> 13, dir = (chain >> 12) & 1, el = chain & 4095, hh = bh & 7;
        const float g128 = expf(-expf(c.in[IN_RETRATE][(i * 2 + dir) * 8 + hh]) * 128.0f);
        float S = 0.f;
#pragma unroll
        for (int st = 0; st < 34; ++st) {
            const int cch = dir == 0 ? st : (st < 2 ? 1 - st : 35 - st);
            const size_t o = ((size_t)(bh * 34 + cch) * 2 + dir) * 4096 + el;
            ET[o] = (unsigned short)(pg8::cvt_pk_bf16(S, 0.f) & 0xffffu);
            S = g128 * S + U[o];
        }
    }
}
__device__ __forceinline__ void phase_ret_main(const Ctx& c, int i, LAS unsigned char* lds) {
    typedef pg8::bf16x8 bf16x8;
    const unsigned short* RQ = (const unsigned short*)(c.ws + WS_RQ); const unsigned short* RK = (const unsigned short*)(c.ws + WS_RK); const unsigned short* RV = (const unsigned short*)(c.ws + WS_RV);
    const unsigned short* ET = (const unsigned short*)(c.ws + WS_ET); const unsigned short* P = (const unsigned short*)(c.ws + WS_P); unsigned short* MIX = (unsigned short*)(c.ws + WS_MIX);
    const float* gn = c.in[IN_RETGN] + (size_t)i * 512;
    constexpr int QS = 0, KS = 18432, VTS = 36864, EF = 54272, EB = 63488;
    const int li = c.lane & 15, q4 = c.lane >> 4, i0 = 16 * c.wave, ig = i0 + li;
    for (int unit = blockIdx.x; unit < 64 * 34; unit += gridDim.x) {
        const int bh = unit / 34, cch = unit - bh * 34, b = bh >> 3, hh = bh & 7, row0 = b * RB + cch * 128;
        const float lgf = -expf(c.in[IN_RETRATE][(i * 2 + 0) * 8 + hh]) * 1.4426950408889634f, lgb = -expf(c.in[IN_RETRATE][(i * 2 + 1) * 8 + hh]) * 1.4426950408889634f;
        __syncthreads();
        for (int pc = c.tid; pc < 1024; pc += 512) { const int r = pc >> 3, ch = pc & 7; const size_t go = (size_t)(row0 + r) * 512 + hh * 64 + ch * 8;
            *(LAS pg8::u32x4*)(lds + QS + r * 144 + ch * 16) = *(const pg8::u32x4*)(RQ + go);
            *(LAS pg8::u32x4*)(lds + KS + r * 144 + ch * 16) = *(const pg8::u32x4*)(RK + go);
            const pg8::u32x4 vw = *(const pg8::u32x4*)(RV + go);
#pragma unroll
            for (int e = 0; e < 4; ++e) { *(LAS unsigned short*)(lds + VTS + (ch * 8 + 2 * e) * 272 + r * 2) = (unsigned short)(vw[e] & 0xffffu); *(LAS unsigned short*)(lds + VTS + (ch * 8 + 2 * e + 1) * 272 + r * 2) = (unsigned short)(vw[e] >> 16); } }
        { const int r = c.tid >> 3, ch = c.tid & 7; const size_t go = ((size_t)(bh * 34 + cch) * 2) * 4096 + r * 64 + ch * 8;
            *(LAS pg8::u32x4*)(lds + EF + r * 144 + ch * 16) = *(const pg8::u32x4*)(ET + go); *(LAS pg8::u32x4*)(lds + EB + r * 144 + ch * 16) = *(const pg8::u32x4*)(ET + go + 4096); }
        __syncthreads();
        bf16x8 qf[2];
#pragma unroll
        for (int s = 0; s < 2; ++s) qf[s] = *(const LAS bf16x8*)(lds + QS + (i0 + li) * 144 + (32 * s + 8 * q4) * 2);
        pg8::u32x2 pk[8];
#pragma unroll
        for (int jt = 0; jt < 8; ++jt) {
            f32x4 a = {0.f, 0.f, 0.f, 0.f};
#pragma unroll
            for (int s = 0; s < 2; ++s) { const bf16x8 kf = *(const LAS bf16x8*)(lds + KS + (16 * jt + li) * 144 + (32 * s + 8 * q4) * 2); a = __builtin_amdgcn_mfma_f32_16x16x32_bf16(kf, qf[s], a, 0, 0, 0); }
            float pv[4];
#pragma unroll
            for (int r = 0; r < 4; ++r) { const int dl = ig - (16 * jt + 4 * q4 + r); const float w = dl >= 0 ? exp2f(lgf * (float)dl) : exp2f(lgb * (float)(-dl)); pv[r] = a[r] * w; }
            pk[jt] = (pg8::u32x2){pg8::cvt_pk_bf16(pv[0], pv[1]), pg8::cvt_pk_bf16(pv[2], pv[3])};
        }
        const float sf = exp2f(lgf * (float)(ig + 1)), sb = exp2f(lgb * (float)(128 - ig));
        f32x4 oacc[4];
#pragma unroll
        for (int dvt = 0; dvt < 4; ++dvt) {
            f32x4 o = {0.f, 0.f, 0.f, 0.f};
#pragma unroll
            for (int u = 0; u < 4; ++u) {
                const pg8::u32x2 vlo = *(const LAS pg8::u32x2*)(lds + VTS + (16 * dvt + li) * 272 + (32 * u + 4 * q4) * 2), vhi = *(const LAS pg8::u32x2*)(lds + VTS + (16 * dvt + li) * 272 + (32 * u + 16 + 4 * q4) * 2);
                const pg8::u32x4 av = {vlo.x, vlo.y, vhi.x, vhi.y}, bv = {pk[2 * u].x, pk[2 * u].y, pk[2 * u + 1].x, pk[2 * u + 1].y};
                o = __builtin_amdgcn_mfma_f32_16x16x32_bf16(__builtin_bit_cast(bf16x8, av), __builtin_bit_cast(bf16x8, bv), o, 0, 0, 0);
            }
            f32x4 tf = {0.f, 0.f, 0.f, 0.f}, tb = {0.f, 0.f, 0.f, 0.f};
#pragma unroll
            for (int s = 0; s < 2; ++s) {
                const bf16x8 ef = *(const LAS bf16x8*)(lds + EF + (16 * dvt + li) * 144 + (32 * s + 8 * q4) * 2), eb = *(const LAS bf16x8*)(lds + EB + (16 * dvt + li) * 144 + (32 * s + 8 * q4) * 2);
                tf = __builtin_amdgcn_mfma_f32_16x16x32_bf16(ef, qf[s], tf, 0, 0, 0); tb = __builtin_amdgcn_mfma_f32_16x16x32_bf16(eb, qf[s], tb, 0, 0, 0);
            }
            oacc[dvt] = o + tf * sf + tb * sb;
        }
        float sm = 0.f;
#pragma unroll
        for (int dvt = 0; dvt < 4; ++dvt) sm += (oacc[dvt].x + oacc[dvt].y) + (oacc[dvt].z + oacc[dvt].w);
        sm += __shfl_xor(sm, 16); sm += __shfl_xor(sm, 32);
        const float mu = sm * (1.0f / 64.0f); float vr = 0.f;
#pragma unroll
        for (int dvt = 0; dvt < 4; ++dvt) { oacc[dvt] = oacc[dvt] - mu; vr += (oacc[dvt].x * oacc[dvt].x + oacc[dvt].y * oacc[dvt].y) + (oacc[dvt].z * oacc[dvt].z + oacc[dvt].w * oacc[dvt].w); }
        vr += __shfl_xor(vr, 16); vr += __shfl_xor(vr, 32);
        const float rs = rsqrtf(vr * (1.0f / 64.0f) + EPS);
        const size_t row = (size_t)(row0 + ig);
#pragma unroll
        for (int dvt = 0; dvt < 4; ++dvt) { const int dvc = hh * 64 + 16 * dvt + 4 * q4;
            const pg8::u32x2 gw = *(const pg8::u32x2*)(P + row * INW + 1536 + dvc); const f32x4 gt = {__uint_as_float(gw.x << 16), __uint_as_float(gw.x & 0xffff0000u), __uint_as_float(gw.y << 16), __uint_as_float(gw.y & 0xffff0000u)}, gg = *(const f32x4*)(gn + dvc); const f32x4 y = oacc[dvt] * rs * gg;
            *(pg8::u32x2*)(MIX + row * D + dvc) = (pg8::u32x2){pg8::cvt_pk_bf16(gt.x * pg8::fast_sigmoid(gt.x) * y.x, gt.y * pg8::fast_sigmoid(gt.y) * y.y), pg8::cvt_pk_bf16(gt.z * pg8::fast_sigmoid(gt.z) * y.z, gt.w * pg8::fast_sigmoid(gt.w) * y.w)}; }
    }
}

__device__ __forceinline__ void phase_attention(const Ctx& c, char* lds) {
    const attn_body::bf16* QA = (const attn_body::bf16*)(c.ws + WS_QA); const attn_body::bf16* KA = (const attn_body::bf16*)(c.ws + WS_KA); const attn_body::bf16* VA = (const attn_body::bf16*)(c.ws + WS_VA);
    attn_body::bf16* MIX = (attn_body::bf16*)(c.ws + WS_MIX);
    const int G = gridDim.x, bx = blockIdx.x, vcu = (G % 8 == 0) ? (bx % 8) * (G / 8) + bx / 8 : bx;
    for (int U = vcu; U < NB * 8 * 17; U += G) {
        int bh, qrow0, NT;
        if (U < NB * 8 * 16) { bh = U >> 4; qrow0 = (bh >> 3) * RB + CL + (U & 15) * 256; NT = RB / 64; }
        else { bh = U - NB * 8 * 16; qrow0 = (bh >> 3) * RB; NT = CL / 64; }
        const int b = bh >> 3, hh = bh & 7;
        attn_body::attn_unit<8>(QA + (size_t)qrow0 * 512 + hh * 64, KA + (size_t)(b * RB) * 128 + (hh >> 2) * 64, VA + (size_t)(b * RB) * 128 + (hh >> 2) * 64,
                                MIX + (size_t)qrow0 * 1024 + 512 + hh * 64, NT, lds, c.wave);
    }
}

__device__ __forceinline__ void phase_s5_ops(const Ctx& c, LAS float* ldsf) {
    LAS float* Pre = ldsf; LAS float* Pim = ldsf + 4608; LAS float* KZr = ldsf + 9216; LAS float* KZi = ldsf + 9344;
    LAS float* Bre = ldsf + 9472; LAS float* Bim = ldsf + 10496; LAS float* Cre = ldsf + 11520; LAS float* Cim = ldsf + 13568;
    LAS float* KV = ldsf + 15616;
#define S5P(dir, pw, p) (((dir) * 64 + (p)) * 36 + (pw))
    for (int task = blockIdx.x; task < 2 * 64 * 2; task += gridDim.x) {
        const int i = task >> 7, g = (task >> 1) & 63, hf = task & 1;
        __syncthreads();
        if (c.tid < 128) {
            const int dir = c.tid >> 6, p = c.tid & 63;
            const float a_re = c.in[IN_S5ARE][((i * 2 + dir) * 64 + g) * 64 + p], a_im = c.in[IN_S5AIM][((i * 2 + dir) * 64 + g) * 64 + p];
            const float dt = expf(c.in[IN_S5DT][(i * 2 + dir) * 64 + g]);
            const float lre = fminf(a_re, -1e-4f), lim = a_im, ea = lre * dt, eb = lim * dt;
            for (int dl = 0; dl <= 32; ++dl) { const float m = expf(ea * (float)dl), an = eb * (float)dl; Pre[S5P(dir, dl, p)] = m * cosf(an); Pim[S5P(dir, dl, p)] = m * sinf(an); }
            const float cb = cosf(eb), sb = sinf(eb), sh = sinf(0.5f * eb), mag = expf(ea);
            const float nr = expm1f(ea) * cb - 2.0f * sh * sh, ni = mag * sb, den = lre * lre + lim * lim;
            KZr[dir * 64 + p] = (nr * lre + ni * lim) / den; KZi[dir * 64 + p] = (ni * lre - nr * lim) / den;
        }
        for (int idx = c.tid; idx < 1024; idx += 512) { Bre[idx] = c.in[IN_S5BRE][(size_t)(i * 64 + g) * 1024 + idx]; Bim[idx] = c.in[IN_S5BIM][(size_t)(i * 64 + g) * 1024 + idx]; }
        for (int idx = c.tid; idx < 2048; idx += 512) { const int dir = idx >> 10, rem = idx & 1023;
            Cre[idx] = c.in[IN_S5CRE][((size_t)(i * 2 + dir) * 64 + g) * 1024 + rem]; Cim[idx] = c.in[IN_S5CIM][((size_t)(i * 2 + dir) * 64 + g) * 1024 + rem]; }
        __syncthreads();
        {
            const int dir = c.tid >> 8, ko = (c.tid >> 4) & 15, ki = c.tid & 15;
            float acc[32];
#pragma unroll
            for (int dl = 0; dl < 32; ++dl) acc[dl] = 0.f;
            for (int p = 0; p < 64; ++p) {
                const float kr = KZr[dir * 64 + p], kq = KZi[dir * 64 + p], br = Bre[p * 16 + ki], bi = Bim[p * 16 + ki], cr = Cre[(dir * 16 + ko) * 64 + p], ci = Cim[(dir * 16 + ko) * 64 + p];
                const float gr = kr * br - kq * bi, gi = kr * bi + kq * br, tr = cr * gr - ci * gi, ti = cr * gi + ci * gr;
#pragma unroll
                for (int d4 = 0; d4 < 8; ++d4) { const f32x4 pr = *(const LAS f32x4*)(Pre + S5P(dir, 4 * d4, p)), pi = *(const LAS f32x4*)(Pim + S5P(dir, 4 * d4, p));
                    acc[4 * d4] += tr * pr.x - ti * pi.x; acc[4 * d4 + 1] += tr * pr.y - ti * pi.y; acc[4 * d4 + 2] += tr * pr.z - ti * pi.z; acc[4 * d4 + 3] += tr * pr.w - ti * pi.w; }
            }
#pragma unroll
            for (int dl = 0; dl < 32; ++dl) KV[((dir * 32 + dl) * 16 + ko) * 16 + ki] = acc[dl];
        }
        __syncthreads();
        unsigned* TV = (unsigned*)(c.ws + WS_TV) + ((size_t)(i * 64 + g) * 512 * 768) / 2;
        const float* dsk = c.in[IN_S5D] + (size_t)i * D + 16 * g;
        if (c.tid < 384) {
            const int kp = c.tid, kk = 2 * kp;
            if (kk < 512) {
                const int j = kk >> 4, ki = kk & 15;
                for (int it = 16 * hf; it < 16 * hf + 16; ++it) {
                    const int dl = it > j ? it - j : j - it, dir = it > j ? 0 : 1;
                    for (int ko = 0; ko < 16; ++ko) {
                        float v0, v1;
                        if (it != j) { v0 = KV[((dir * 32 + dl) * 16 + ko) * 16 + ki]; v1 = KV[((dir * 32 + dl) * 16 + ko) * 16 + ki + 1]; }
                        else { v0 = KV[(ko) * 16 + ki] + KV[((32) * 16 + ko) * 16 + ki] + (ko == ki ? dsk[ko] : 0.f); v1 = KV[(ko) * 16 + ki + 1] + KV[((32) * 16 + ko) * 16 + ki + 1] + (ko == ki + 1 ? dsk[ko] : 0.f); }
                        TV[(size_t)(it * 16 + ko) * 384 + kp] = pg8::cvt_pk_bf16(v0, v1);
                    }
                }
            } else {
                const int q = kk - 512, dir = q >> 7, part = (q >> 6) & 1, p = q & 63;
                for (int it = 16 * hf; it < 16 * hf + 16; ++it) {
                    const int pw = dir == 0 ? it + 1 : 32 - it;
                    const float pr0 = Pre[S5P(dir, pw, p)], pi0 = Pim[S5P(dir, pw, p)], pr1 = Pre[S5P(dir, pw, p + 1)], pi1 = Pim[S5P(dir, pw, p + 1)];
                    for (int ko = 0; ko < 16; ++ko) {
                        const float cr0 = Cre[(dir * 16 + ko) * 64 + p], ci0 = Cim[(dir * 16 + ko) * 64 + p], cr1 = Cre[(dir * 16 + ko) * 64 + p + 1], ci1 = Cim[(dir * 16 + ko) * 64 + p + 1];
                        const float v0 = part == 0 ? (cr0 * pr0 - ci0 * pi0) : -(cr0 * pi0 + ci0 * pr0), v1 = part == 0 ? (cr1 * pr1 - ci1 * pi1) : -(cr1 * pi1 + ci1 * pr1);
                        TV[(size_t)(it * 16 + ko) * 384 + kp] = pg8::cvt_pk_bf16(v0, v1);
                    }
                }
            }
        }
        unsigned* WS5 = (unsigned*)(c.ws + WS_WS5) + ((size_t)(i * 64 + g) * 256 * 512) / 2;
        if (c.tid < 256) {
            const int kp = c.tid, kk = 2 * kp, j = kk >> 4, ki = kk & 15, dir = hf, pw = dir == 0 ? 31 - j : j;
            for (int pp = 0; pp < 128; ++pp) {
                const int part = pp >> 6, p = pp & 63;
                const float pr = Pre[S5P(dir, pw, p)], pi = Pim[S5P(dir, pw, p)], kr = KZr[dir * 64 + p], kq = KZi[dir * 64 + p];
                const float gr = pr * kr - pi * kq, gi = pr * kq + pi * kr, br0 = Bre[p * 16 + ki], bi0 = Bim[p * 16 + ki], br1 = Bre[p * 16 + ki + 1], bi1 = Bim[p * 16 + ki + 1];
                const float v0 = part == 0 ? (gr * br0 - gi * bi0) : (gr * bi0 + gi * br0), v1 = part == 0 ? (gr * br1 - gi * bi1) : (gr * bi1 + gi * br1);
                WS5[(size_t)(128 * hf + pp) * 256 + kp] = pg8::cvt_pk_bf16(v0, v1);
            }
        }
    }
#undef S5P
}
__device__ __forceinline__ void phase_s5_carry(const Ctx& c, int i) {
    const float* SL = (const float*)(c.ws + WS_SL); unsigned short* AS5 = (unsigned short*)(c.ws + WS_AS5);
    for (int id = c.gt; id < 64 * 8 * 2 * 64; id += c.ngt) {
        const int p = id & 63, dir = (id >> 6) & 1, b = (id >> 7) & 7, g = id >> 10;
        const float a_re = c.in[IN_S5ARE][((i * 2 + dir) * 64 + g) * 64 + p], a_im = c.in[IN_S5AIM][((i * 2 + dir) * 64 + g) * 64 + p];
        const float dt = expf(c.in[IN_S5DT][(i * 2 + dir) * 64 + g]);
        const float lre = fminf(a_re, -1e-4f), m32 = expf(lre * dt * 32.0f), an = a_im * dt * 32.0f, ar = m32 * cosf(an), ai = m32 * sinf(an);
        float xr = 0.f, xi = 0.f;
#pragma unroll 8
        for (int st = 0; st < 136; ++st) {
            const int cch = dir == 0 ? st : (st < 8 ? 7 - st : 143 - st);
            const size_t r = (size_t)g * 1280 + b * 136 + cch;
            unsigned short* xo = AS5 + r * 768 + 512 + dir * 128 + p;
            xo[0] = (unsigned short)(pg8::cvt_pk_bf16(xr, 0.f) & 0xffffu); xo[64] = (unsigned short)(pg8::cvt_pk_bf16(xi, 0.f) & 0xffffu);
            const float sr = SL[r * 256 + dir * 128 + p], si = SL[r * 256 + dir * 128 + 64 + p];
            const float nxr = ar * xr - ai * xi + sr, nxi = ar * xi + ai * xr + si;
            xr = nxr; xi = nxi;
        }
    }
}

__device__ __forceinline__ void cvt_item(const float* W, int ldw, int k0, int scol0, unsigned short* WT, int K, int drow0, LAS float* scr, int lane) {
    float wv[32];
#pragma unroll
    for (int i = 0; i < 32; ++i) wv[i] = W[(size_t)(k0 + 2 * i + (lane >> 5)) * ldw + scol0 + (lane & 31)];
#pragma unroll
    for (int i = 0; i < 32; ++i) scr[(2 * i + (lane >> 5)) * 33 + (lane & 31)] = wv[i];
    asm volatile("s_waitcnt lgkmcnt(0)" ::: "memory");
    const int cc = lane & 7;
#pragma unroll
    for (int j = 0; j < 4; ++j) { const int n = (lane >> 3) + 8 * j; const LAS float* s = scr + (8 * cc) * 33 + n;
        pg8::u32x4 o; o.x = pg8::cvt_pk_bf16(s[0 * 33], s[1 * 33]); o.y = pg8::cvt_pk_bf16(s[2 * 33], s[3 * 33]); o.z = pg8::cvt_pk_bf16(s[4 * 33], s[5 * 33]); o.w = pg8::cvt_pk_bf16(s[6 * 33], s[7 * 33]);
        *(pg8::u32x4*)(WT + (size_t)(drow0 + n) * K + k0 + 8 * cc) = o; }
    asm volatile("s_waitcnt lgkmcnt(0)" ::: "memory");
}
__device__ __forceinline__ void cvt_item8(const float* W, int ldw, int k0, int scol0, unsigned char* WT, int K, int drow0, LAS float* scr, int lane) {
    float wv[32];
#pragma unroll
    for (int i = 0; i < 32; ++i) wv[i] = W[(size_t)(k0 + 2 * i + (lane >> 5)) * ldw + scol0 + (lane & 31)];
#pragma unroll
    for (int i = 0; i < 32; ++i) scr[(2 * i + (lane >> 5)) * 33 + (lane & 31)] = wv[i] * pg8::W8_SCALE;
    asm volatile("s_waitcnt lgkmcnt(0)" ::: "memory");
    const int n = lane >> 1, kh = lane & 1; const LAS float* s = scr + (32 * kh) * 33 + n;
    unsigned w[8];
#pragma unroll
    for (int j = 0; j < 8; ++j) w[j] = pg8::pk4_fp8(s[(4 * j) * 33], s[(4 * j + 1) * 33], s[(4 * j + 2) * 33], s[(4 * j + 3) * 33]);
    unsigned char* o = WT + (size_t)(drow0 + n) * K + k0 + 32 * kh;
    *(pg8::u32x4*)o = (pg8::u32x4){w[0], w[1], w[2], w[3]}; *(pg8::u32x4*)(o + 16) = (pg8::u32x4){w[4], w[5], w[6], w[7]};
    asm volatile("s_waitcnt lgkmcnt(0)" ::: "memory");
}
__device__ __forceinline__ void phase_cvt_moe(const Ctx& c, LAS float* ldsf) {
    LAS float* scr = ldsf + c.wave * (64 * 33);
    unsigned char* W13 = (unsigned char*)(c.ws + WS_W13); unsigned char* W2T = (unsigned char*)(c.ws + WS_W2);
    for (int id = c.gw; id < DEPTH * NE * 3072; id += c.ngw) {
        const int le = id / 3072; int r = id - le * 3072;
        if (r < 2048) { const int kb = r >> 7, nb = r & 127, pn = nb >> 3, rr0 = (nb & 7) * 32;
            const float* srcm = (rr0 < 128 ? c.in[IN_W1] : c.in[IN_W3]) + (size_t)le * D * FF;
            cvt_item8(srcm, FF, 64 * kb, 128 * pn + (rr0 & 127), W13 + (size_t)le * 4096 * D, D, 32 * nb, scr, c.lane);
        } else { r -= 2048; const int kb = r >> 5, nb = r & 31;
            cvt_item8(c.in[IN_W2] + (size_t)le * FF * D, D, 64 * kb, 32 * nb, W2T + (size_t)le * D * FF, FF, 32 * nb, scr, c.lane); }
    }
    unsigned short* WIN = (unsigned short*)(c.ws + WS_WIN); unsigned short* WOUT = (unsigned short*)(c.ws + WS_WOUT); unsigned short* WGLU = (unsigned short*)(c.ws + WS_WGLU);
    for (int id = c.gw; id < 2 * (1408 + 512 + 1024); id += c.ngw) {
        const int i = id / 2944; int r = id - i * 2944;
        if (r < 1408) { const int kb = r / 88, nb = r - kb * 88; cvt_item(c.in[IN_MIXIN] + (size_t)i * D * INW, INW, 64 * kb, 32 * nb, WIN + (size_t)i * INW * D, D, 32 * nb, scr, c.lane); }
        else if (r < 1920) { r -= 1408; const int kb = r >> 5, nb = r & 31; cvt_item(c.in[IN_MIXOUT] + (size_t)i * D * D, D, 64 * kb, 32 * nb, WOUT + (size_t)i * D * D, D, 32 * nb, scr, c.lane); }
        else { r -= 1920; const int kb = r >> 6, nb = r & 63, pn = nb >> 3, rr0 = (nb & 7) * 32;
            cvt_item(c.in[IN_GLUW] + (size_t)i * D * 2048, 2048, 64 * kb, (rr0 < 128 ? 0 : 1024) + 128 * pn + (rr0 & 127), WGLU + (size_t)i * 2048 * D, D, 32 * nb, scr, c.lane); }
    }
}

struct ALDense { const float* A; int lda; size_t gstride; __device__ __forceinline__ const float* row(int g, int r) const { return A + (size_t)g * gstride + (size_t)r * lda; } };
struct ALGather { const float* A; const int* idx; __device__ __forceinline__ const float* row(int g, int r) const { return A + (size_t)idx[g * EROWS + r] * D; } };
struct BL1 { const float* B; int ldb; size_t gstride; __device__ __forceinline__ const float* ptr(int g, int) const { return B + (size_t)g * gstride; } };
struct BL2 { const float* Ba; const float* Bb; int ldb; size_t gstride; __device__ __forceinline__ const float* ptr(int g, int sub) const { return (sub ? Bb : Ba) + (size_t)g * gstride; } };
struct EPStore { float* O; int ldc; __device__ __forceinline__ void operator()(int, int row, int col, float v, float) const { O[(size_t)row * ldc + col] = v; } };
struct EPResid { float* X; const float* mod; int L; __device__ __forceinline__ void operator()(int, int row, int col, float v, float) const {
    const int j = row_j(row); const float g1 = mod[((size_t)(L * 9 + j) * 6 + 2) * 1024 + col]; X[(size_t)row * D + col] += g1 * v; } };
struct EPGlu { float* X; const float* mod; const float* bias; int L; __device__ __forceinline__ void operator()(int, int row, int col, float va, float vb) const {
    const int j = row_j(row); const float g1 = mod[((size_t)(L * 9 + j) * 6 + 2) * 1024 + col];
    const float o = (va + bias[col]) * sigmoidf_(vb + bias[1024 + col]); X[(size_t)row * D + col] += g1 * o; } };
struct EPSwiglu { float* HID; __device__ __forceinline__ void operator()(int g, int row, int col, float va, float vb) const { HID[((size_t)g * EROWS + row) * FF + col] = siluf_(va) * vb; } };
struct EPGate { float* Y; const float* gate; __device__ __forceinline__ void operator()(int g, int row, int col, float v, float) const { Y[((size_t)g * EROWS + row) * D + col] = gate[g * EROWS + row] * v; } };

__global__ void __launch_bounds__(512, 2) fwd(Args args) {
    extern __shared__ __attribute__((aligned(16))) unsigned char lds[];
    Ctx c; c.in = args.in; c.out = args.out; c.ws = args.ws;
    c.wave = __builtin_amdgcn_readfirstlane((int)threadIdx.x >> 6); c.lane = lane_id(); c.tid = c.wave * 64 + c.lane;
    c.gw = blockIdx.x * 8 + c.wave; c.ngw = gridDim.x * 8; c.gt = blockIdx.x * 512 + c.tid; c.ngt = gridDim.x * 512;
    LAS float* ldsf = (LAS float*)lds; LAS unsigned char* ldsb = (LAS unsigned char*)lds;
    volatile LAS unsigned* MISC = (volatile LAS unsigned*)((LAS unsigned char*)lds + MISC_OFF);
    if (c.tid < 32) MISC[c.tid] = 0u;
    __syncthreads();
    const int lo = args.ph_lo, hi = args.ph_hi;
    const bool one_launch = (hi - lo) > 1;
    XcdBarrier bar; bar.bar = (unsigned*)(c.ws + WS_CTL) + CW_BAR; bar.x = 0; bar.st = MISC + 8; bar.wave = c.wave;
    if (one_launch) bar = xcd_barrier_post((unsigned*)(c.ws + WS_CTL) + CW_BAR, MISC + 8);
#define IN(k) (lo <= (k) && (k) < hi)
#define SEAM(k) do { if ((k) + 1 < hi) xcd_barrier(bar); } while (0)
#define FRESH(cc) Ctx cc; unsigned zq; asm volatile("s_mov_b32 %0, 0" : "=s"(zq)); cc.ws = c.ws + zq; cc.out = c.out + zq; cc.in = (const float* const*)((const char*)c.in + zq); \
    { int lq = lane_id(); asm volatile("" : "+v"(lq)); cc.wave = c.wave + (int)zq; cc.lane = lq; cc.tid = cc.wave * 64 + lq; const int tq = cc.tid; cc.gw = blockIdx.x * 8 + cc.wave; cc.ngw = gridDim.x * 8; cc.gt = blockIdx.x * 512 + tq; cc.ngt = gridDim.x * 512; } \
    const int Lq = L + (int)zq, iq = Lq >> 1; const float* MOD = (const float*)(cc.ws + WS_MOD); (void)MOD; (void)iq

    if (IN(PH_PRO)) { const int L = 0; FRESH(cc); phase_pro(cc, ldsf); __syncthreads(); phase_s5_ops(cc, ldsf); __syncthreads(); phase_cvt_moe(cc, ldsf); SEAM(PH_PRO); }

#define LAYER_BODY(LL) { constexpr int L = LL; \
        const int pb = 1 + L * PH_PER_LAYER; \
        if (IN(pb + 0)) { FRESH(cc); phase_norm1<false, (L & 1) != 0>(cc, Lq); SEAM(pb + 0); } \
        if ((L & 1) == 0) { \
            if (IN(pb + 1)) { \
                FRESH(cc); \
                pg8::GOrder S; S.init(1, NROWS, INW, (int)gridDim.x, (int)blockIdx.x); \
                pg8::ADense al{(const pg8::bf16_t*)(cc.ws + WS_HB1), 0, nullptr, 0, D, 0, 64}; pg8::EpiBf16 ep{(pg8::bf16_t*)(cc.ws + WS_P), INW}; \
                pg8::gemm_phase(ldsb, al, (const pg8::bf16_t*)(cc.ws + WS_WIN) + (size_t)iq * INW * D, 0, D, S, ep, cc.wave); SEAM(pb + 1); } \
            if (IN(pb + 2)) { FRESH(cc); phase_post(cc, iq, ldsb); SEAM(pb + 2); } \
            if (IN(pb + 4)) { FRESH(cc); phase_ret_prefix(cc, iq); \
                  \
                unsigned* cnt = (unsigned*)(cc.ws + WS_CTL) + CW_CNT + 64 * L; \
                asm volatile("s_waitcnt vmcnt(0)" ::: "memory"); __syncthreads(); \
                if (cc.tid == 0) { __builtin_amdgcn_fence(__ATOMIC_RELEASE, "agent"); asm volatile("s_waitcnt vmcnt(0)" ::: "memory"); (void)xb_add(cnt, 1u); } \
                phase_attention(cc, (char*)lds); \
                if (cc.tid == 0) { unsigned* tb = (unsigned*)(cc.ws + WS_CTL) + CW_BAR; XB_SPIN(xb_ld(cnt) < gridDim.x, tb); __builtin_amdgcn_fence(__ATOMIC_ACQUIRE, "agent"); asm volatile("s_waitcnt vmcnt(0)" ::: "memory"); } \
                __syncthreads(); \
                phase_ret_main(cc, iq, ldsb); SEAM(pb + 4); } \
            if (IN(pb + 6)) { \
                FRESH(cc); \
                pg8::GOrder S; S.init(1, NROWS, D, (int)gridDim.x, (int)blockIdx.x); \
                pg8::ADense al{(const pg8::bf16_t*)(cc.ws + WS_MIX), 0, nullptr, 0, D, 0, 64}; pg8::EpiResid ep{(pg8::bf16_t*)(cc.ws + WS_X), MOD + (size_t)Lq * 9 * 6144}; \
                pg8::gemm_phase(ldsb, al, (const pg8::bf16_t*)(cc.ws + WS_WOUT) + (size_t)iq * D * D, 0, D, S, ep, cc.wave); SEAM(pb + 6); } \
        } else { \
            if (IN(pb + 1)) { \
                FRESH(cc); \
                pg8::GOrder S; S.init(64, 1280, 256, (int)gridDim.x, (int)blockIdx.x); \
                pg8::ADense al{(const pg8::bf16_t*)(cc.ws + WS_AS5), (size_t)1280 * 768, nullptr, 0, 768, 0, 64}; pg8::EpiF32 ep{(float*)(cc.ws + WS_SL), 256, (size_t)1280 * 256}; \
                pg8::gemm_phase(ldsb, al, (const pg8::bf16_t*)(cc.ws + WS_WS5) + (size_t)iq * 64 * 256 * 512, (size_t)256 * 512, 512, S, ep, cc.wave); SEAM(pb + 1); } \
            if (IN(pb + 2)) { FRESH(cc); phase_s5_carry(cc, iq); SEAM(pb + 2); } \
            if (IN(pb + 3)) { \
                FRESH(cc); \
                pg8::GOrder S; S.init(64, 1280, 512, (int)gridDim.x, (int)blockIdx.x); \
                pg8::ADense al{(const pg8::bf16_t*)(cc.ws + WS_AS5), (size_t)1280 * 768, nullptr, 0, 768, 0, 64}; pg8::EpiGeluBf16 ep{(pg8::bf16_t*)(cc.ws + WS_ZG), 512, (size_t)1280 * 512}; \
                pg8::gemm_phase(ldsb, al, (const pg8::bf16_t*)(cc.ws + WS_TV) + (size_t)iq * 64 * 512 * 768, (size_t)512 * 768, 768, S, ep, cc.wave); SEAM(pb + 3); } \
            if (IN(pb + 4)) { \
                FRESH(cc); \
                pg8::GOrder S; S.init(1, NROWS, 2048, (int)gridDim.x, (int)blockIdx.x, L == DEPTH - 1); \
                pg8::ADense al{(const pg8::bf16_t*)(cc.ws + WS_ZG), 0, nullptr, 0, 16, 1280 * 512, (size_t)4 * 1280 * 512}; pg8::EpiGluResid ep{(pg8::bf16_t*)(cc.ws + WS_X), MOD + (size_t)Lq * 9 * 6144, cc.in[IN_GLUB] + (size_t)iq * 2048}; \
                pg8::gemm_phase(ldsb, al, (const pg8::bf16_t*)(cc.ws + WS_WGLU) + (size_t)iq * 2048 * D, 0, D, S, ep, cc.wave); SEAM(pb + 4); } \
        } \
        if (IN(pb + 7)) { FRESH(cc); phase_norm2_router<L == DEPTH - 1>(cc, Lq, ldsf); SEAM(pb + 7); } \
        if (IN(pb + 8)) { FRESH(cc); phase_topk(cc, (LAS unsigned*)lds, L == DEPTH - 1 ? 128 : 256); SEAM(pb + 8); } \
        if (IN(pb + 9)) { \
            FRESH(cc); \
            pg8::GOrder S; S.init(NE, L == DEPTH - 1 ? NB * CAP_LAT : EROWS, 2 * FF, (int)gridDim.x, (int)blockIdx.x); \
            pg8::ADense al{(const pg8::bf16_t*)(cc.ws + WS_XS), (size_t)EROWS * D, nullptr, 0, D, 0, 128}; \
            pg8::EpiSwiglu ep{(unsigned char*)(cc.ws + WS_HID), FF, (size_t)EROWS * FF}; \
            pg8::gemm_phase<true>(ldsb, al, (const unsigned char*)(cc.ws + WS_W13) + (size_t)Lq * NE * 4096 * D, (size_t)4096 * D, D, S, ep, cc.wave); SEAM(pb + 9); } \
        if (IN(pb + 10)) { \
            FRESH(cc); \
            pg8::GOrder S; S.init(NE, L == DEPTH - 1 ? NB * CAP_LAT : EROWS, D, (int)gridDim.x, (int)blockIdx.x); \
            pg8::ADense al{(const pg8::bf16_t*)(cc.ws + WS_HID), (size_t)EROWS * FF, nullptr, 0, FF, 0, 128}; \
            pg8::EpiGate ep{(pg8::bf16_t*)(cc.ws + WS_Y), D, (size_t)EROWS * D, (const float*)(cc.ws + WS_SELGATE), EROWS}; \
            pg8::gemm_phase<true>(ldsb, al, (const unsigned char*)(cc.ws + WS_W2) + (size_t)Lq * NE * D * FF, (size_t)D * FF, FF, S, ep, cc.wave); SEAM(pb + 10); } \
    }
    LAYER_BODY(0) LAYER_BODY(1) LAYER_BODY(2) LAYER_BODY(3)
#undef LAYER_BODY
    if (IN(PH_FIN)) { const int L = DEPTH; FRESH(cc); phase_norm1<true, false>(cc, DEPTH); }
#undef IN
#undef SEAM
}

static bool phase_valid(int ph) {
    if (ph == PH_PRO || ph == PH_FIN) return true;
    const int L = (ph - 1) / PH_PER_LAYER, k = (ph - 1) % PH_PER_LAYER;
    if (L & 1) return !(k >= 5 && k <= 6);
    return k != 3 && k != 5;
}
extern "C" void kernel_launch(void* const* d_in, const int* in_sizes, int n_in, void* d_out, int out_size, void* d_ws, size_t ws_size, hipStream_t stream) {
    static int grid = 0;
    if (grid == 0) {
        if (n_in != 27 || out_size != NB * T * D || ws_size < WS_END) { fprintf(stderr, "kernel_launch: unexpected shapes (n_in %d out %d ws %zu)\n", n_in, out_size, ws_size); grid = -1; return; }
        int dev = 0, cus = 0;
        if (hipGetDevice(&dev) != hipSuccess || hipDeviceGetAttribute(&cus, hipDeviceAttributeMultiprocessorCount, dev) != hipSuccess) { grid = -1; return; }
        if (hipFuncSetAttribute((const void*)fwd, hipFuncAttributeMaxDynamicSharedMemorySize, LDS_BYTES) != hipSuccess) { grid = -1; return; }
        int per_cu = 0;
        if (hipOccupancyMaxActiveBlocksPerMultiprocessor(&per_cu, (const void*)fwd, 512, LDS_BYTES) != hipSuccess || per_cu < 1) fprintf(stderr, "kernel_launch: occupancy query says %d\n", per_cu);
        (void)hipGetLastError();
        grid = cus;
    }
    if (grid < 0) return;
    if (hipMemsetAsync((char*)d_ws + WS_CTL, 0, CTL_ZERO_BYTES, stream) != hipSuccess) return;
    Args a{};
    for (int i = 0; i < 27; ++i) a.in[i] = (const float*)d_in[i];
    a.out = (float*)d_out; a.ws = (unsigned char*)d_ws;
#if MK_MULTI
    for (int ph = 0; ph < NPH; ++ph) {
        if (!phase_valid(ph)) continue;
        a.ph_lo = ph; a.ph_hi = ph + 1;
        hipLaunchKernelGGL(fwd, dim3(grid), dim3(512), LDS_BYTES, stream, a);
    }
#else
    a.ph_lo = 0; a.ph_hi = NPH;
    hipLaunchKernelGGL(fwd, dim3(grid), dim3(512), LDS_BYTES, stream, a);
#ifdef PROBE_PHASES
    { static const int probe[] = {PROBE_PHASES}; for (unsigned q = 0; q < sizeof(probe) / sizeof(probe[0]); ++q) { a.ph_lo = probe[q]; a.ph_hi = probe[q] + 1; hipLaunchKernelGGL(fwd, dim3(grid), dim3(512), LDS_BYTES, stream, a); } }
#endif
#endif
}
```

```cpp
#include <hip/hip_runtime.h>
#include <hip/hip_bf16.h>
#include <cstdio>
#include <cstdint>

#define GAS __attribute__((address_space(1)))
#define LAS __attribute__((address_space(3)))
typedef float f32x4 __attribute__((ext_vector_type(4)));
typedef float f32x16 __attribute__((ext_vector_type(16)));

constexpr int NB = 8, T = 4096, D = 1024, CL = 256, RB = CL + T  , NROWS = NB * RB  ;
constexpr int DEPTH = 4, NE = 16, FF = 2048, INW = 2816;
constexpr int CAP_LAT = 512, CAP_CTX = 32, EROWS = NB * (CAP_LAT + CAP_CTX)  ;
constexpr float EPS = 1e-6f;
#ifndef MK_MULTI
#define MK_MULTI 0
#endif

constexpr size_t MiB = 1u << 20;
constexpr size_t WS_CTL = 0, CTL_ZERO_BYTES = 1 * MiB;
constexpr size_t WS_MOD = 1 * MiB;
constexpr size_t WS_ROPE = 2 * MiB;
constexpr size_t WS_SELROW = 3 * MiB;
constexpr size_t WS_SELGATE = 3 * MiB + 512 * 1024;
constexpr size_t WS_AFF = 4 * MiB;
constexpr size_t WS_SLOT = 7 * MiB;
constexpr size_t WS_X = 10 * MiB;
constexpr size_t WS_TV = 146 * MiB;
constexpr size_t WS_WS5 = 242 * MiB;
constexpr size_t WS_HB = 282 * MiB;
constexpr size_t WS_W13 = 350 * MiB;
constexpr size_t WS_W2 = 862 * MiB;
constexpr size_t WS_WIN = 1118 * MiB;
constexpr size_t WS_WOUT = 1130 * MiB;
constexpr size_t WS_WGLU = 1134 * MiB;
constexpr size_t WS_HB1 = 1144 * MiB;
constexpr size_t WS_BIG = 1212 * MiB;
constexpr size_t WS_P = WS_BIG;
constexpr size_t WS_RQ = WS_BIG + 374 * MiB;
constexpr size_t WS_RK = WS_BIG + 408 * MiB;
constexpr size_t WS_RV = WS_BIG + 442 * MiB;
constexpr size_t WS_ET = WS_BIG + 476 * MiB;
constexpr size_t WS_MIX = WS_BIG + 510 * MiB;
constexpr size_t WS_QA = WS_BIG + 578 * MiB;
constexpr size_t WS_KA = WS_BIG + 612 * MiB;
constexpr size_t WS_VA = WS_BIG + 621 * MiB;
constexpr size_t WS_U = WS_BIG + 630 * MiB;
constexpr size_t WS_AS5 = WS_BIG;
constexpr size_t WS_SL = WS_BIG + 120 * MiB;
constexpr size_t WS_ZG = WS_BIG + 200 * MiB;
constexpr size_t WS_HID = WS_BIG;
constexpr size_t WS_XS = WS_BIG + 136 * MiB;
constexpr size_t WS_Y = WS_BIG + 272 * MiB;
constexpr size_t WS_END = WS_BIG + 698 * MiB;
constexpr int CW_BAR = 4096, CW_CNT = 8192;

constexpr int LDS_BYTES = 147456;
constexpr int MISC_OFF = 131072 + 320;

constexpr int PH_PRO = 0, PH_PER_LAYER = 11, PH_FIN = 1 + DEPTH * PH_PER_LAYER, NPH = PH_FIN + 1;

#define XB_TMO      128
#define XB_XCNT(j)  (256  + 64 * (j))
#define XB_XSUB(j)  (1280 + 64 * (j))
#define XB_XGEN(j)  (2304 + 64 * (j))
#define XB_TOP      3328
#define XB_TOPGEN   3392
#define XCD_BAR_WORDS 3456
#define XB_SPIN_CAP (1u << 22)

__device__ __forceinline__ unsigned xb_ld(unsigned* p)              { return __hip_atomic_load(p, __ATOMIC_RELAXED, __HIP_MEMORY_SCOPE_AGENT); }
__device__ __forceinline__ unsigned xb_add(unsigned* p, unsigned v) { return __hip_atomic_fetch_add(p, v, __ATOMIC_RELAXED, __HIP_MEMORY_SCOPE_AGENT); }
__device__ __forceinline__ unsigned xb_xcc_id() { return (unsigned)__builtin_amdgcn_s_getreg((3 << 11) | 20) & 0xFu; }
#define XB_SPIN(cond, bar) do { unsigned _sp = 0; while (cond) { __builtin_amdgcn_s_sleep(1); \
    if ((++_sp & 255u) == 0u) { if (xb_ld(&(bar)[XB_TMO])) break; if (_sp > XB_SPIN_CAP) { atomicAdd(&(bar)[XB_TMO], 1u); break; } } } } while (0)

__device__ __forceinline__ int lane_id() { int l; asm volatile("v_mbcnt_lo_u32_b32 %0, -1, 0\n\tv_mbcnt_hi_u32_b32 %0, -1, %0" : "=v"(l)); return l; }
struct XcdBarrier { unsigned* bar; unsigned x; volatile LAS unsigned* st; int wave; };

__device__ __forceinline__ XcdBarrier xcd_barrier_post(unsigned* bar, volatile LAS unsigned* st) {
    XcdBarrier b; b.bar = bar; b.x = xb_xcc_id(); b.st = st; b.wave = __builtin_amdgcn_readfirstlane((int)threadIdx.x >> 6);
    if (threadIdx.x == 0) (void)xb_add(&bar[XB_XCNT(b.x)], 1u);
    return b;
}
__device__ __forceinline__ void xcd_barrier_complete(unsigned* bar, unsigned x, unsigned& nloc, unsigned& nx) {
    const unsigned G = gridDim.x * gridDim.y * gridDim.z;
    unsigned sum, cnt, mine, sp = 0u;
    for (;;) {
        sum = 0u; cnt = 0u; mine = 0u;
#pragma unroll
        for (unsigned j = 0; j < 16; ++j) { const unsigned c = xb_ld(&bar[XB_XCNT(j)]); sum += c; cnt += (c > 0u) ? 1u : 0u; mine = (j == x) ? c : mine; }
        if (sum == G) break;
        __builtin_amdgcn_s_sleep(1);
        if ((++sp & 255u) == 0u) { if (xb_ld(&bar[XB_TMO])) break; if (sp > XB_SPIN_CAP) { atomicAdd(&bar[XB_TMO], 1u); break; } }
    }
    nloc = mine > 0u ? mine : 1u; nx = cnt > 0u ? cnt : 1u;
}
__device__ __forceinline__ void xcd_barrier(const XcdBarrier& b) {
    asm volatile("s_waitcnt vmcnt(0)" ::: "memory");
    __syncthreads();
    if (b.wave == 0 && lane_id() == 0) {
        unsigned* bar = b.bar;
        __builtin_amdgcn_s_waitcnt(0);
        unsigned nloc = b.st[0], nx = b.st[1];
        if (nloc == 0u) { xcd_barrier_complete(bar, b.x, nloc, nx); b.st[0] = nloc; b.st[1] = nx; }
        const unsigned old = xb_add(&bar[XB_XSUB(b.x)], 1u);
        const unsigned gen = old / nloc;
        if (old + 1u == (gen + 1u) * nloc) {
            __builtin_amdgcn_fence(__ATOMIC_RELEASE, "agent");
            asm volatile("s_waitcnt vmcnt(0)" ::: "memory");
            const unsigned og = xb_add(&bar[XB_TOP], 1u);
            const unsigned tg = og / nx;
            if (og + 1u == (tg + 1u) * nx) xb_add(&bar[XB_TOPGEN], 1u);
            else XB_SPIN(xb_ld(&bar[XB_TOPGEN]) == tg, bar);
            __builtin_amdgcn_fence(__ATOMIC_ACQUIRE, "agent");
            xb_add(&bar[XB_XGEN(b.x)], 1u);
            asm volatile("s_waitcnt vmcnt(0)" ::: "memory");
        } else {
            XB_SPIN(xb_ld(&bar[XB_XGEN(b.x)]) == gen, bar);
            __builtin_amdgcn_fence(__ATOMIC_ACQUIRE, "agent");
            asm volatile("s_waitcnt vmcnt(0)" ::: "memory");
        }
    }
    __syncthreads();
}

struct Args { const float* in[27]; float* out; unsigned char* ws; int ph_lo, ph_hi; };

struct Ctx {
    const float* const* in; float* out; unsigned char* ws;
    int tid, lane, wave, gw, ngw, gt, ngt;
};
enum { IN_X = 0, IN_C, IN_CTX, IN_CCTX, IN_MODW, IN_MODB, IN_NORMG, IN_MIXIN, IN_MIXOUT, IN_RETRATE, IN_RETGN, IN_QKG,
       IN_S5ARE, IN_S5AIM, IN_S5DT, IN_S5BRE, IN_S5BIM, IN_S5CRE, IN_S5CIM, IN_S5D, IN_GLUW, IN_GLUB, IN_ROUTER, IN_W1, IN_W3, IN_W2, IN_FNG };

__device__ __forceinline__ float wave_sum(float v) {
#pragma unroll
    for (int o = 1; o < 64; o <<= 1) v += __shfl_xor(v, o);
    return v;
}
__device__ __forceinline__ float sigmoidf_(float x) { return 1.0f / (1.0f + expf(-x)); }
__device__ __forceinline__ float siluf_(float x) { return x * sigmoidf_(x); }
__device__ __forceinline__ float gelu_tanh(float x) { const float u = 0.7978845608028654f * (x + 0.044715f * x * x * x); return 0.5f * x * (1.0f + tanhf(u)); }
__device__ __forceinline__ const float* modp(const Ctx& c, int L, int j, int chunk) { return (const float*)(c.ws + WS_MOD) + ((size_t)(L * 9 + j) * 6 + chunk) * 1024; }
__device__ __forceinline__ int row_j(int row) { const int b = row / RB, s = row - b * RB; return s < CL ? 8 : b; }

__device__ __forceinline__ float reduce16(const float (&v)[16], int lane) {
    float a[8], b[4], c2[2], d;
    const bool b5 = (lane & 32) != 0, b4 = (lane & 16) != 0, b3 = (lane & 8) != 0, b2 = (lane & 4) != 0;
#pragma unroll
    for (int i = 0; i < 8; ++i) { const float keep = b5 ? v[8 + i] : v[i], send = b5 ? v[i] : v[8 + i]; a[i] = keep + __shfl_xor(send, 32); }
#pragma unroll
    for (int i = 0; i < 4; ++i) { const float keep = b4 ? a[4 + i] : a[i], send = b4 ? a[i] : a[4 + i]; b[i] = keep + __shfl_xor(send, 16); }
#pragma unroll
    for (int i = 0; i < 2; ++i) { const float keep = b3 ? b[2 + i] : b[i], send = b3 ? b[i] : b[2 + i]; c2[i] = keep + __shfl_xor(send, 8); }
    { const float keep = b2 ? c2[1] : c2[0], send = b2 ? c2[0] : c2[1]; d = keep + __shfl_xor(send, 4); }
    d += __shfl_xor(d, 2); d += __shfl_xor(d, 1);
    return d;
}
__device__ __forceinline__ int reduce16_k(int lane) { return ((lane >> 5) & 1) * 8 + ((lane >> 4) & 1) * 4 + ((lane >> 3) & 1) * 2 + ((lane >> 2) & 1); }

namespace pg8 {
typedef unsigned short bf16_t;
typedef short bf16x8 __attribute__((ext_vector_type(8)));
typedef unsigned u32x4 __attribute__((ext_vector_type(4)));
typedef unsigned u32x2 __attribute__((ext_vector_type(2)));
typedef int v8i32 __attribute__((ext_vector_type(8)));
typedef int v4i32 __attribute__((ext_vector_type(4)));
constexpr int BM = 256, BK = 64, HALF = 128, HTB = HALF * BK * 2, STAGE_BYTES = 8 * HTB, NXCD = 8, WGM = 8;
__host__ __device__ __forceinline__ int lds_byte(int r, int c) { const int st = (r >> 4) * 2 + (c >> 5), rr = r & 15, cc = c & 31, ob = rr * 64 + cc * 2; return st * 1024 + (ob ^ (((ob >> 9) & 1) << 5)); }
__host__ __device__ __forceinline__ void stage_rc(int b, int& R, int& C) { const int st = b / 1024, sb = b % 1024, swz = sb ^ (((sb >> 9) & 1) << 5); R = (st >> 1) * 16 + swz / 64; C = (st & 1) * 32 + (swz % 64) / 2; }
__host__ __device__ __forceinline__ int perm32(int rho) { const int n = rho >> 4, i = rho & 15; return 8 * (i >> 2) + 4 * n + (i & 3); }
__device__ __forceinline__ unsigned cvt_pk_bf16(float lo, float hi) { unsigned r; asm volatile("v_cvt_pk_bf16_f32 %0, %1, %2" : "=v"(r) : "v"(lo), "v"(hi)); return r; }

__device__ __forceinline__ unsigned pk4_fp8(float a, float b, float c, float d) {
    a = __builtin_amdgcn_fmed3f(a, -448.f, 448.f); b = __builtin_amdgcn_fmed3f(b, -448.f, 448.f); c = __builtin_amdgcn_fmed3f(c, -448.f, 448.f); d = __builtin_amdgcn_fmed3f(d, -448.f, 448.f);
    unsigned w = 0u; w = (unsigned)__builtin_amdgcn_cvt_pk_fp8_f32(a, b, (int)w, false); w = (unsigned)__builtin_amdgcn_cvt_pk_fp8_f32(c, d, (int)w, true); return w; }
__device__ __forceinline__ f32x4 bf4_to_f32(u32x2 w) { return (f32x4){__uint_as_float(w.x << 16), __uint_as_float(w.x & 0xffff0000u), __uint_as_float(w.y << 16), __uint_as_float(w.y & 0xffff0000u)}; }
__device__ __forceinline__ u32x2 f32_to_bf4(f32x4 v) { return (u32x2){cvt_pk_bf16(v.x, v.y), cvt_pk_bf16(v.z, v.w)}; }
constexpr float W8_SCALE = 32.0f, W8_INV = 1.0f / 32.0f;
struct Unit { int pm, pn, g; };
struct GOrder {
    int nM, nN, per, nwg, G, c, skipctx;
    __device__ __forceinline__ void init(int groups, int M, int N, int G_, int c_, int skipctx_ = 0) { nM = M / BM; if (skipctx_) nM -= nM / 17; nN = N / BM; per = nM * nN; nwg = groups * per; G = G_; c = c_; skipctx = skipctx_; }
    __device__ __forceinline__ bool next(int i, Unit& u) const {
        const long L = (long)i * G + c; if (L >= nwg) return false;
        int wgid = (int)L; { const int q = nwg / NXCD, r = nwg % NXCD, xcd = wgid % NXCD, off = wgid / NXCD; wgid = (xcd < r ? xcd * (q + 1) : r * (q + 1) + (xcd - r) * q) + off; }
        u.g = wgid / per; const int w = wgid - u.g * per;
        const int nig = WGM * nN, gid = w / nig, fm = gid * WGM, gsz = (nM - fm) < WGM ? (nM - fm) : WGM;
        u.pm = fm + ((w % nig) % gsz); u.pn = (w % nig) / gsz; if (skipctx) u.pm += (u.pm >> 4) + 1;
        return true;
    }
};
struct ADense  { static constexpr bool GATHER = false; const bf16_t* A; size_t gstride; const int* idx; int rpg; unsigned rowpitch; unsigned cgrp; size_t kstep; };
struct AGather { static constexpr bool GATHER = true;  const bf16_t* A; size_t gstride; const int* idx; int rpg; unsigned rowpitch; unsigned cgrp; size_t kstep; };

template <bool FP8 = false, class Epi, class ALoc>
__device__ __forceinline__ void gemm_phase(LAS unsigned char* lds, const ALoc AL, const void* Bt, size_t gstrideB, int K, const GOrder& S, const Epi& E, int wave_) {
    constexpr bool GATHER = ALoc::GATHER; constexpr unsigned ESZ = FP8 ? 1u : 2u;
    const int wid = wave_, lane = lane_id(), tid = wid * 64 + lane, wr = wid >> 2, wc = wid & 3, fr = lane & 15, fq = lane >> 4;
    const int nt = (int)((unsigned)K * ESZ / 128u);
    unsigned voffA[2], voffB[2];
#pragma unroll
    for (int i = 0; i < 2; ++i) { int R, C; stage_rc(tid * 16 + i * 8192, R, C); const int Rb = Epi::PERM ? ((R & ~31) + perm32(R & 31)) : R;
        const unsigned cbytes = AL.cgrp ? ((unsigned)(C >> 4) * AL.cgrp + (unsigned)(C & 15)) * 2u : (unsigned)C * 2u;
        voffA[i] = (unsigned)R * AL.rowpitch * ESZ + cbytes; voffB[i] = (unsigned)Rb * (unsigned)K * ESZ + (unsigned)C * 2u; }
    const size_t kstep = 128, kstepA = AL.kstep * ESZ;
    const size_t hstep = (size_t)HALF * K * ESZ;
    const size_t hstepA = GATHER ? 0 : (size_t)HALF * AL.rowpitch * ESZ, tstepA = 2 * (size_t)HALF * AL.rowpitch * ESZ;
    const size_t tstep = 2 * hstep;
    const unsigned ldsw = (unsigned)wid * 1024u;
    const int aoff0 = FP8 ? lds_byte(wr * 64 + fr, 16 * fq) : lds_byte(wr * 64 + fr, fq * 8);
    const int boff0 = FP8 ? lds_byte(wc * 32 + fr, 16 * fq) : lds_byte(wc * 32 + fr, fq * 8);
    constexpr int KOFF = FP8 ? 16 : 1024;
    unsigned vAc[2][2], vAn[2][2];
#define PG8_SA(b, h) (((b) * 2 + (h)) * HTB)
#define PG8_SB(b, h) ((4 + (b) * 2 + (h)) * HTB)
#define PG8_SBR(b, h) (((b) * 2 + (h)) * HTB)
#define PG8_OPQ(x) do { if constexpr (FP8) asm volatile("" : "+v"(x)); } while (0)
#define PG8_STAGE(bufoff, gbase, voff) do { _Pragma("unroll") for (int _i = 0; _i < 2; ++_i) { unsigned _o = (voff)[_i]; PG8_OPQ(_o); \
        __builtin_amdgcn_global_load_lds((const unsigned*)((const char*)(gbase) + _o), (LAS unsigned*)(lds + (bufoff) + ldsw + _i * 8192), 16, 0, 0); } } while (0)
#define PG8_STAGE_A(bufoff, gbase, h, nx) do { _Pragma("unroll") for (int _i = 0; _i < 2; ++_i) { \
        unsigned _o = GATHER ? ((nx) ? vAn[h][_i] : vAc[h][_i]) : voffA[_i]; PG8_OPQ(_o); \
        __builtin_amdgcn_global_load_lds((const unsigned*)((const char*)(gbase) + (size_t)(h) * hstepA + _o), (LAS unsigned*)(lds + (bufoff) + ldsw + _i * 8192), 16, 0, 0); } } while (0)
#define PG8_GIDX(u, v) do { if (GATHER) { int _t = tid; asm volatile("" : "+v"(_t));   \
        _Pragma("unroll") for (int _i = 0; _i < 2; ++_i) { int _R, _C; stage_rc(_t * 16 + _i * 8192, _R, _C); \
        _Pragma("unroll") for (int _h = 0; _h < 2; ++_h) v[_h][_i] = (unsigned)AL.idx[(u).g * AL.rpg + (u).pm * BM + _h * HALF + _R] * (AL.rowpitch * ESZ) + (unsigned)_C * 2u; } } } while (0)
#define PG8_ABASE(u) ((const char*)AL.A + (GATHER ? (size_t)0 : ((size_t)(u).g * AL.gstride * ESZ + (size_t)(u).pm * tstepA)))
#define PG8_BBASE(u) ((const char*)Bt + (size_t)(u).g * gstrideB * ESZ + (size_t)(u).pn * tstep)
#define PG8_LDA(dst, b, h) do { _Pragma("unroll") for (int m = 0; m < 4; ++m) _Pragma("unroll") for (int k = 0; k < 2; ++k) dst[m][k] = *(const LAS bf16x8*)(lds + PG8_SA(b, h) + aoff0 + k * KOFF + m * 2048); } while (0)
#define PG8_LDB(dst, b, h) do { _Pragma("unroll") for (int n = 0; n < 2; ++n) _Pragma("unroll") for (int k = 0; k < 2; ++k) dst[n][k] = *(const LAS bf16x8*)(lds + PG8_SB(b, h) + boff0 + k * KOFF + n * 2048); } while (0)
#define PG8_CAT8(x) __builtin_shufflevector(__builtin_bit_cast(v4i32, x[0]), __builtin_bit_cast(v4i32, x[1]), 0, 1, 2, 3, 4, 5, 6, 7)
#define PG8_MMA(ai, bj, At, Bt_) do { __builtin_amdgcn_s_setprio(1); _Pragma("unroll") for (int m = 0; m < 4; ++m) _Pragma("unroll") for (int n = 0; n < 2; ++n) { \
        if constexpr (FP8) acc[ai][bj][m][n] = __builtin_amdgcn_mfma_scale_f32_16x16x128_f8f6f4(PG8_CAT8(Bt_[n]), PG8_CAT8(At[m]), acc[ai][bj][m][n], 0, 0, 0, 0x7f7f7f7f, 0, 0x7f7f7f7f); \
        else { _Pragma("unroll") for (int k = 0; k < 2; ++k) acc[ai][bj][m][n] = __builtin_amdgcn_mfma_f32_16x16x32_bf16(Bt_[n][k], At[m][k], acc[ai][bj][m][n], 0, 0, 0); } } \
        __builtin_amdgcn_s_setprio(0); } while (0)
#define PG8_WAIT_V(n) asm volatile("s_waitcnt vmcnt(" #n ")" ::: "memory")
#define PG8_WAIT_L(n) asm volatile("s_waitcnt lgkmcnt(" #n ")" ::: "memory")
#define PG8_BAR __builtin_amdgcn_s_barrier()
#define PG8_SCHED __builtin_amdgcn_sched_barrier(0)
    Unit cur, nxt; int ui = 0;
    if (!S.next(0, cur)) return;
    PG8_GIDX(cur, vAc);
    f32x4 acc[2][2][4][2];
#pragma unroll
    for (int a = 0; a < 2; ++a)
#pragma unroll
        for (int b = 0; b < 2; ++b)
#pragma unroll
            for (int m = 0; m < 4; ++m)
#pragma unroll
                for (int n = 0; n < 2; ++n) acc[a][b][m][n] = (f32x4){0.f, 0.f, 0.f, 0.f};
    bf16x8 At[4][2], B0[2][2], B1[2][2];
    const char* cA = PG8_ABASE(cur); const char* cB = PG8_BBASE(cur);
    PG8_STAGE(PG8_SB(0, 0), cB, voffB); PG8_STAGE(PG8_SB(0, 1), cB + hstep, voffB); PG8_STAGE_A(PG8_SA(0, 0), cA, 0, false); PG8_STAGE_A(PG8_SA(0, 1), cA, 1, false);
    if (wr == 1) PG8_BAR;
    PG8_WAIT_V(2); PG8_BAR;
    PG8_STAGE(PG8_SB(1, 0), cB + kstep, voffB); PG8_STAGE_A(PG8_SA(1, 0), cA + kstepA, 0, false); PG8_STAGE(PG8_SB(1, 1), cB + hstep + kstep, voffB);
    PG8_WAIT_V(6); PG8_BAR;
    for (;;) {
        const bool has_next = S.next(ui + 1, nxt);
        if (GATHER) { if (has_next) { PG8_GIDX(nxt, vAn); } }
        const char* nA = has_next ? PG8_ABASE(nxt) : cA; const char* nB = has_next ? PG8_BBASE(nxt) : cB;
        for (int t = 0; t < nt; t += 2) {
            const bool last = (t == nt - 2), lastn = last && has_next;
            const char* a1 = cA + (size_t)(t + 1) * kstepA;
            const char* a2 = last ? nA : cA + (size_t)(t + 2) * kstepA; const char* b2 = last ? nB : cB + (size_t)(t + 2) * kstep;
            const char* a3 = a2 + kstepA; const char* b3 = b2 + kstep;
            PG8_LDB(B0, 0, 0); PG8_LDB(B1, 0, 1); PG8_SCHED; PG8_LDA(At, 0, 0); PG8_STAGE_A(PG8_SA(1, 1), a1, 1, false);
            PG8_WAIT_V(8); PG8_WAIT_L(0); PG8_BAR; PG8_MMA(0, 0, At, B0); PG8_MMA(0, 1, At, B1); PG8_BAR; PG8_SCHED;
            PG8_LDA(At, 0, 1); PG8_STAGE(PG8_SB(0, 0), b2, voffB); PG8_STAGE(PG8_SB(0, 1), b2 + hstep, voffB); PG8_STAGE_A(PG8_SA(0, 0), a2, 0, lastn);
            PG8_WAIT_V(8); PG8_WAIT_L(0); PG8_BAR; PG8_MMA(1, 0, At, B0); PG8_MMA(1, 1, At, B1); PG8_BAR; PG8_SCHED;
            PG8_LDB(B0, 1, 0); PG8_LDB(B1, 1, 1); PG8_SCHED; PG8_LDA(At, 1, 0); PG8_STAGE_A(PG8_SA(0, 1), a2, 1, lastn);
            PG8_WAIT_V(8); PG8_WAIT_L(0); PG8_BAR; PG8_MMA(0, 0, At, B0); PG8_MMA(0, 1, At, B1); PG8_BAR; PG8_SCHED;
            PG8_LDA(At, 1, 1); PG8_STAGE(PG8_SB(1, 0), b3, voffB); PG8_STAGE(PG8_SB(1, 1), b3 + hstep, voffB); PG8_STAGE_A(PG8_SA(1, 0), a3, 0, lastn);
            PG8_WAIT_V(8); PG8_WAIT_L(0); PG8_BAR; PG8_MMA(1, 0, At, B0); PG8_MMA(1, 1, At, B1); PG8_BAR; PG8_SCHED;
        }
        if (wr == 0) PG8_BAR;
        E(acc, cur, wr, wc, fr, fq);
        if (!has_next) break;
#pragma unroll
        for (int a = 0; a < 2; ++a)
#pragma unroll
            for (int b = 0; b < 2; ++b)
#pragma unroll
                for (int m = 0; m < 4; ++m)
#pragma unroll
                    for (int n = 0; n < 2; ++n) acc[a][b][m][n] = (f32x4){0.f, 0.f, 0.f, 0.f};
        cur = nxt; cA = nA; cB = nB; ++ui;
        if (GATHER) {
#pragma unroll
            for (int _h = 0; _h < 2; ++_h)
#pragma unroll
                for (int _i = 0; _i < 2; ++_i) vAc[_h][_i] = vAn[_h][_i]; }
        if (wr == 1) PG8_BAR;
    }
    PG8_WAIT_V(0);
    PG8_BAR;
#undef PG8_SA
#undef PG8_SB
#undef PG8_SBR
#undef PG8_STAGE
#undef PG8_OPQ
#undef PG8_STAGE_A
#undef PG8_GIDX
#undef PG8_ABASE
#undef PG8_BBASE
#undef PG8_LDA
#undef PG8_CAT8
#undef PG8_LDB
#undef PG8_MMA
#undef PG8_WAIT_V
#undef PG8_WAIT_L
#undef PG8_BAR
#undef PG8_SCHED
}

__device__ __forceinline__ float fast_sigmoid(float x) { return __builtin_amdgcn_rcpf(1.0f + __builtin_amdgcn_exp2f(-1.4426950408889634f * x)); }
struct EpiSwiglu {
    static constexpr bool PERM = true;
    unsigned char* O; int ldc; size_t gstride;
    __device__ __forceinline__ void operator()(const f32x4 (&acc)[2][2][4][2], const Unit& u, int wr, int wc, int fr, int fq) const {
        const int row0 = u.pm * BM + wr * 64 + fr, col0 = u.pn * HALF + wc * 32 + 8 * fq;
        unsigned char* base = O + (size_t)u.g * gstride;
#pragma unroll
        for (int ai = 0; ai < 2; ++ai)
#pragma unroll
            for (int m = 0; m < 4; ++m) { unsigned char* rowp = base + (size_t)(row0 + ai * HALF + m * 16) * ldc + col0;
                f32x4 o[2];
#pragma unroll
                for (int n = 0; n < 2; ++n) {
                    const f32x4 a = acc[ai][0][m][n] * W8_INV, b = acc[ai][1][m][n] * W8_INV, t = a * (-1.4426950408889634f);
                    f32x4 e; e.x = __builtin_amdgcn_exp2f(t.x); e.y = __builtin_amdgcn_exp2f(t.y); e.z = __builtin_amdgcn_exp2f(t.z); e.w = __builtin_amdgcn_exp2f(t.w);
                    e = e + 1.0f;
                    f32x4 r; r.x = __builtin_amdgcn_rcpf(e.x); r.y = __builtin_amdgcn_rcpf(e.y); r.z = __builtin_amdgcn_rcpf(e.z); r.w = __builtin_amdgcn_rcpf(e.w);
                    o[n] = (a * b) * r; }
                *(u32x2*)rowp = (u32x2){pk4_fp8(o[0].x, o[0].y, o[0].z, o[0].w), pk4_fp8(o[1].x, o[1].y, o[1].z, o[1].w)}; }
    }
};
struct EpiBf16 {
    static constexpr bool PERM = true;
    bf16_t* O; int ldc;
    __device__ __forceinline__ void operator()(const f32x4 (&acc)[2][2][4][2], const Unit& u, int wr, int wc, int fr, int fq) const {
        const int row0 = u.pm * BM + wr * 64 + fr, col0 = u.pn * BM + wc * 32 + 8 * fq;
#pragma unroll
        for (int ai = 0; ai < 2; ++ai)
#pragma unroll
            for (int m = 0; m < 4; ++m) { bf16_t* rowp = O + (size_t)(row0 + ai * HALF + m * 16) * ldc + col0;
#pragma unroll
                for (int bj = 0; bj < 2; ++bj) { const f32x4 v0 = acc[ai][bj][m][0], v1 = acc[ai][bj][m][1];
                    u32x4 w; w.x = cvt_pk_bf16(v0[0], v0[1]); w.y = cvt_pk_bf16(v0[2], v0[3]); w.z = cvt_pk_bf16(v1[0], v1[1]); w.w = cvt_pk_bf16(v1[2], v1[3]);
                    *(u32x4*)(rowp + bj * HALF) = w; } }
    }
};
struct EpiGeluBf16 {
    static constexpr bool PERM = true;
    bf16_t* O; int ldc; size_t gstride;
    __device__ __forceinline__ void operator()(const f32x4 (&acc)[2][2][4][2], const Unit& u, int wr, int wc, int fr, int fq) const {
        const int row0 = u.pm * BM + wr * 64 + fr, col0 = u.pn * BM + wc * 32 + 8 * fq;
        bf16_t* base = O + (size_t)u.g * gstride;
#pragma unroll
        for (int ai = 0; ai < 2; ++ai)
#pragma unroll
            for (int m = 0; m < 4; ++m) { bf16_t* rowp = base + (size_t)(row0 + ai * HALF + m * 16) * ldc + col0;
#pragma unroll
                for (int bj = 0; bj < 2; ++bj) { float o[8];
#pragma unroll
                    for (int n = 0; n < 2; ++n)
#pragma unroll
                        for (int q = 0; q < 4; ++q) { const float x = acc[ai][bj][m][n][q]; o[4 * n + q] = x * fast_sigmoid(1.5957691216057308f * (x + 0.044715f * x * x * x)); }
                    u32x4 w; w.x = cvt_pk_bf16(o[0], o[1]); w.y = cvt_pk_bf16(o[2], o[3]); w.z = cvt_pk_bf16(o[4], o[5]); w.w = cvt_pk_bf16(o[6], o[7]);
                    *(u32x4*)(rowp + bj * HALF) = w; } }
    }
};
constexpr float Y8_SCALE = 16.0f, Y8_INV = 1.0f / 16.0f;
struct EpiGate {
    static constexpr bool PERM = true;
    unsigned char* O; int ldc; size_t gstride; const float* gate; int rpg;
    __device__ __forceinline__ void operator()(const f32x4 (&acc)[2][2][4][2], const Unit& u, int wr, int wc, int fr, int fq) const {
        const int row0 = u.pm * BM + wr * 64 + fr, col0 = u.pn * BM + wc * 32 + 8 * fq;
        unsigned char* base = O + (size_t)u.g * gstride;
#pragma unroll
        for (int ai = 0; ai < 2; ++ai)
#pragma unroll
            for (int m = 0; m < 4; ++m) { const int row = row0 + ai * HALF + m * 16; const float gt = gate[u.g * rpg + row] * (W8_INV * Y8_SCALE); unsigned char* rowp = base + (size_t)row * ldc + col0;
#pragma unroll
                for (int bj = 0; bj < 2; ++bj) { const f32x4 v0 = acc[ai][bj][m][0] * gt, v1 = acc[ai][bj][m][1] * gt;
                    *(u32x2*)(rowp + bj * HALF) = (u32x2){pk4_fp8(v0[0], v0[1], v0[2], v0[3]), pk4_fp8(v1[0], v1[1], v1[2], v1[3])}; } }
    }
};
struct EpiF32 {
    static constexpr bool PERM = false;
    float* C; int ldc; size_t gstride;
    __device__ __forceinline__ void operator()(const f32x4 (&acc)[2][2][4][2], const Unit& u, int wr, int wc, int fr, int fq) const {
        const int row0 = u.pm * BM + wr * 64 + fr, col0 = u.pn * BM + wc * 32 + 4 * fq;
#pragma unroll
        for (int ai = 0; ai < 2; ++ai)
#pragma unroll
            for (int m = 0; m < 4; ++m) { float* rowp = C + (size_t)u.g * gstride + (size_t)(row0 + ai * HALF + m * 16) * ldc + col0;
#pragma unroll
                for (int bj = 0; bj < 2; ++bj)
#pragma unroll
                    for (int n = 0; n < 2; ++n) *(f32x4*)(rowp + bj * HALF + n * 16) = acc[ai][bj][m][n]; }
    }
};
struct EpiResid {
    static constexpr bool PERM = true;
    bf16_t* X; const float* modL;
    __device__ __forceinline__ void operator()(const f32x4 (&acc)[2][2][4][2], const Unit& u, int wr, int wc, int fr, int fq) const {
        const int row0 = u.pm * BM + wr * 64 + fr, col0 = u.pn * BM + wc * 32 + 8 * fq;
        const int b = u.pm / 17, j = (u.pm - b * 17 == 0) ? 8 : b;
        const float* g1 = modL + (size_t)(j * 6 + 2) * 1024 + col0;
        f32x4 gv[2][2];
#pragma unroll
        for (int bj = 0; bj < 2; ++bj)
#pragma unroll
            for (int n = 0; n < 2; ++n) gv[bj][n] = *(const f32x4*)(g1 + bj * HALF + n * 4);
#pragma unroll
        for (int ai = 0; ai < 2; ++ai)
#pragma unroll
            for (int m = 0; m < 4; ++m) { bf16_t* rowp = X + (size_t)(row0 + ai * HALF + m * 16) * D + col0;
#pragma unroll
                for (int bj = 0; bj < 2; ++bj) { u32x4* p = (u32x4*)(rowp + bj * HALF); const u32x4 w = *p;
                    const f32x4 x0 = bf4_to_f32((u32x2){w.x, w.y}) + gv[bj][0] * acc[ai][bj][m][0], x1 = bf4_to_f32((u32x2){w.z, w.w}) + gv[bj][1] * acc[ai][bj][m][1];
                    const u32x2 o0 = f32_to_bf4(x0), o1 = f32_to_bf4(x1); *p = (u32x4){o0.x, o0.y, o1.x, o1.y}; } }
    }
};
struct EpiGluResid {
    static constexpr bool PERM = true;
    bf16_t* X; const float* modL; const float* bias;
    __device__ __forceinline__ void operator()(const f32x4 (&acc)[2][2][4][2], const Unit& u, int wr, int wc, int fr, int fq) const {
        const int row0 = u.pm * BM + wr * 64 + fr, col0 = u.pn * HALF + wc * 32 + 8 * fq;
        const int b = u.pm / 17, j = (u.pm - b * 17 == 0) ? 8 : b;
        const float* g1 = modL + (size_t)(j * 6 + 2) * 1024 + col0;
        f32x4 gv[2], ba[2], bg[2];
#pragma unroll
        for (int n = 0; n < 2; ++n) { gv[n] = *(const f32x4*)(g1 + n * 4); ba[n] = *(const f32x4*)(bias + col0 + n * 4); bg[n] = *(const f32x4*)(bias + 1024 + col0 + n * 4); }
#pragma unroll
        for (int ai = 0; ai < 2; ++ai)
#pragma unroll
            for (int m = 0; m < 4; ++m) { u32x4* p = (u32x4*)(X + (size_t)(row0 + ai * HALF + m * 16) * D + col0); const u32x4 w = *p;
                f32x4 xo[2] = {bf4_to_f32((u32x2){w.x, w.y}), bf4_to_f32((u32x2){w.z, w.w})};
#pragma unroll
                for (int n = 0; n < 2; ++n) { const f32x4 a = acc[ai][0][m][n] + ba[n], g = acc[ai][1][m][n] + bg[n];
                    f32x4 o; o.x = a.x * fast_sigmoid(g.x); o.y = a.y * fast_sigmoid(g.y); o.z = a.z * fast_sigmoid(g.z); o.w = a.w * fast_sigmoid(g.w);
                    xo[n] = xo[n] + gv[n] * o; }
                const u32x2 o0 = f32_to_bf4(xo[0]), o1 = f32_to_bf4(xo[1]); *p = (u32x4){o0.x, o0.y, o1.x, o1.y}; }
    }
};
}

namespace attn_body {
using bf16=__hip_bfloat16;
using bf16x8=__attribute__((ext_vector_type(8)))short;
using s16x4=__attribute__((ext_vector_type(4)))short;
using f32x16=__attribute__((ext_vector_type(16)))float;
using u32x4=__attribute__((ext_vector_type(4)))unsigned;
constexpr int D=64,QP=512,KP=128,OP=1024;
constexpr int NW=8,QBLK=32,QB=QBLK*NW,KVBLK=64;
__device__ __forceinline__ int crow(int r,int hi){return (r&3)+8*(r>>2)+4*hi;}
#define SBAR() __builtin_amdgcn_sched_barrier(0)
__device__ __forceinline__ void cmask(f32x16&p0,f32x16&p1,int jb,int qrel,int hi){
  const float NEG=-INFINITY; int kb=64*jb+4*hi;
  #pragma unroll
  for(int r=0;r<16;++r){int kv=kb+(r&3)+8*(r>>2); if(kv>qrel)p0[r]=NEG; if(kv+32>qrel)p1[r]=NEG;}
}

constexpr int NSLOT=3, SLOTB=8192;
constexpr int LDS_K=0, LDS_V=NSLOT*SLOTB, LDS_WS=2*NSLOT*SLOTB, LDS_OST=LDS_WS+NW*64*4, LDS_BYTES=LDS_OST+NW*4096;
constexpr float C2=0.125f*1.4426950408889634f;
__device__ __forceinline__ void glds16(const void*gsrc,unsigned lds_dst){unsigned keep;
  asm volatile("s_mov_b32 %0, m0\n\ts_mov_b32 m0, %2\n\ts_nop 0\n\tglobal_load_lds_dwordx4 %1, off\n\ts_mov_b32 m0, %0":"=&s"(keep):"v"(gsrc),"s"(lds_dst):"memory");}
__device__ __forceinline__ float max3f(float a,float b,float c){float r;asm("v_max3_f32 %0, %1, %2, %3":"=v"(r):"v"(a),"v"(b),"v"(c));return r;}
__device__ __forceinline__ float max2f(float a,float b){float r;asm("v_max_f32_e32 %0, %1, %2":"=v"(r):"v"(a),"v"(b));return r;}
__device__ __forceinline__ float fadd_s(float a,float b){float r;asm("v_add_f32_e32 %0, %1, %2":"=v"(r):"v"(a),"v"(b));return r;}
__device__ __forceinline__ float fsub_s(float a,float b){float r;asm("v_sub_f32_e32 %0, %1, %2":"=v"(r):"v"(a),"v"(b));return r;}
typedef float f32x2_t __attribute__((ext_vector_type(2))); typedef __bf16 bf16x2_t __attribute__((ext_vector_type(2)));
__device__ __forceinline__ unsigned cvtpk_s(float lo,float hi){f32x2_t v={lo,hi};bf16x2_t b=__builtin_convertvector(v,bf16x2_t);return __builtin_bit_cast(unsigned,b);}
#define WAIT_BAR(N) asm volatile("s_waitcnt vmcnt(" #N ") lgkmcnt(0)\n\ts_barrier":::"memory")

__device__ __forceinline__ void qkt(f32x16&p0,f32x16&p1,const char*Kslot,const bf16x8*qr,const f32x16&negm,int r32,int hi){
  const char*kb=Kslot+hi*1024+r32*16;
  #pragma unroll
  for(int d0=0;d0<4;++d0){
    const bf16x8 b0=*reinterpret_cast<const bf16x8*>(kb+d0*2048);
    const bf16x8 b1=*reinterpret_cast<const bf16x8*>(kb+d0*2048+512);
    if(d0==0){p0=__builtin_amdgcn_mfma_f32_32x32x16_bf16(b0,qr[0],negm,0,0,0);p1=__builtin_amdgcn_mfma_f32_32x32x16_bf16(b1,qr[0],negm,0,0,0);}
    else{p0=__builtin_amdgcn_mfma_f32_32x32x16_bf16(b0,qr[d0],p0,0,0,0);p1=__builtin_amdgcn_mfma_f32_32x32x16_bf16(b1,qr[d0],p1,0,0,0);}}
}
typedef __attribute__((address_space(3))) const char* lds_cptr;
typedef short v4i16_t __attribute__((ext_vector_type(4)));
__device__ __forceinline__ void kload8(bf16x8*kf,lds_cptr kp){
  kf[0]=*(const __attribute__((address_space(3))) bf16x8*)(kp);      kf[1]=*(const __attribute__((address_space(3))) bf16x8*)(kp+512);
  kf[2]=*(const __attribute__((address_space(3))) bf16x8*)(kp+2048); kf[3]=*(const __attribute__((address_space(3))) bf16x8*)(kp+2560);
  kf[4]=*(const __attribute__((address_space(3))) bf16x8*)(kp+4096); kf[5]=*(const __attribute__((address_space(3))) bf16x8*)(kp+4608);
  kf[6]=*(const __attribute__((address_space(3))) bf16x8*)(kp+6144); kf[7]=*(const __attribute__((address_space(3))) bf16x8*)(kp+6656);
}
__device__ __forceinline__ void kload2(bf16x8*kf,lds_cptr kp,int j){ kf[2*j]=*(const __attribute__((address_space(3))) bf16x8*)(kp+j*2048); kf[2*j+1]=*(const __attribute__((address_space(3))) bf16x8*)(kp+j*2048+512); }
__device__ __forceinline__ s16x4 vtr(lds_cptr p){ return __builtin_bit_cast(s16x4,__builtin_amdgcn_ds_read_tr16_b64_v4i16((__attribute__((address_space(3))) v4i16_t*)p)); }
__device__ __forceinline__ float rowmax(const f32x16&p0,const f32x16&p1){
  float a=max3f(p0[0],p0[1],p1[0]),b=max3f(p0[2],p0[3],p1[1]);a=max3f(a,p1[2],p1[3]);
  #pragma unroll
  for(int r=4;r<16;r+=4){a=max3f(a,p0[r],p0[r+1]);b=max3f(b,p0[r+2],p0[r+3]);a=max3f(a,p1[r],p1[r+1]);b=max3f(b,p1[r+2],p1[r+3]);}
  const float m=max2f(a,b);
  auto rr=__builtin_amdgcn_permlane32_swap(__float_as_uint(m),__float_as_uint(m),false,false);
  return max2f(__uint_as_float(rr[0]),__uint_as_float(rr[1]));
}
__device__ __forceinline__ void pv(f32x16*o,int vb,bf16x8 pa0,bf16x8 pa1,bf16x8 pa2,bf16x8 pa3){
  #pragma unroll
  for(int d0=0;d0<2;++d0){s16x4 lo[4],hi[4];
    #pragma unroll
    for(int ks=0;ks<4;++ks){
      asm volatile("ds_read_b64_tr_b16 %0,%1 offset:%c2":"=&v"(lo[ks]):"v"(vb),"i"(d0*4096+ks*1024):"memory");
      asm volatile("ds_read_b64_tr_b16 %0,%1 offset:%c2":"=&v"(hi[ks]):"v"(vb),"i"(d0*4096+ks*1024+512):"memory");}
    asm volatile("s_waitcnt lgkmcnt(0)":::"memory");SBAR();
    #define PK(k) (bf16x8){lo[k][0],lo[k][1],lo[k][2],lo[k][3],hi[k][0],hi[k][1],hi[k][2],hi[k][3]}
    o[d0]=__builtin_amdgcn_mfma_f32_32x32x16_bf16(pa0,PK(0),o[d0],0,0,0);
    o[d0]=__builtin_amdgcn_mfma_f32_32x32x16_bf16(pa1,PK(1),o[d0],0,0,0);
    o[d0]=__builtin_amdgcn_mfma_f32_32x32x16_bf16(pa2,PK(2),o[d0],0,0,0);
    o[d0]=__builtin_amdgcn_mfma_f32_32x32x16_bf16(pa3,PK(3),o[d0],0,0,0);
    #undef PK
  }
}

#ifndef ATTN_STORE16
#define ATTN_STORE16(p,v) (*(u32x4*)(p)=(v))
#endif
template<int THRL> __device__ __forceinline__ void attn_unit(const bf16*Qw0,const bf16*Kh,const bf16*Vh,bf16*Ow0,const int NT,char*shm,const int wid){
  const int lane=lane_id(),r32=lane&31,hi=lane>>5;
  const bf16*Qw=Qw0+(long)(wid*QBLK)*QP;
  const unsigned lds0=(unsigned)(uintptr_t)shm;
  float*wsf=(float*)(shm+LDS_WS)+wid*64;
  const bf16*ksrc=Kh+(long)lane*KP+wid*8;
  const bf16*vsrc=Vh+(long)(16*(wid&3)+(lane>>2))*KP+(wid>>2)*32+(lane&3)*8;
  const unsigned kdst=lds0+LDS_K+wid*1024, vdst=lds0+LDS_V+wid*1024;
  #define DMA_K(t,slot) glds16(ksrc+(long)(t)*KVBLK*KP,(unsigned)__builtin_amdgcn_readfirstlane(kdst+(slot)))
  #define DMA_V(t,slot) glds16(vsrc+(long)(t)*KVBLK*KP,(unsigned)__builtin_amdgcn_readfirstlane(vdst+(slot)))
  const int vb0=(int)(lds0+LDS_V)+((lane>>4)&1)*32+(lane&3)*8+(4*hi+((lane&15)>>2))*64;
  const char*Kbase=shm+LDS_K; bf16x8 kf[8];
  const lds_cptr shm3=(lds_cptr)shm; const lds_cptr kp0=shm3+LDS_K+hi*1024+r32*16; const lds_cptr vp0=shm3+LDS_V+((lane>>4)&1)*32+(lane&3)*8+(4*hi+((lane&15)>>2))*64;
  DMA_K(0,0);DMA_V(0,0);DMA_K(1,SLOTB);
  bf16x8 qr[4];
  #pragma unroll
  for(int d0=0;d0<4;++d0)qr[d0]=*reinterpret_cast<const bf16x8*>(&Qw[(long)r32*QP+d0*16+hi*8]);
  float mhat=0.f,l_reg=0.f;f32x16 o[2];o[0]=f32x16{};o[1]=f32x16{};f32x16 negm=f32x16{};asm volatile("":"+v"(negm));
  #define CMASK(P0,P1,t) do{}while(0)
  bool resc=false;
  #define START(P0,P1) do{ const float rm=rowmax(P0,P1); resc=false; \
    { const float dl=rm; mhat=fadd_s(mhat,dl); \
      _Pragma("unroll") for(int r=0;r<16;++r){P0[r]=fsub_s(P0[r],dl);P1[r]=fsub_s(P1[r],dl);} \
      _Pragma("unroll") for(int r=0;r<16;++r)negm[r]=-mhat; asm volatile("":"+v"(negm)); } \
    _Pragma("unroll") for(int r=0;r<16;++r)P0[r]=__builtin_amdgcn_exp2f(P0[r]); }while(0)
  #define RESC() do{ if(resc){ asm volatile("s_waitcnt lgkmcnt(0)":::"memory"); \
      _Pragma("unroll") for(int d_=0;d_<2;++d_) _Pragma("unroll") for(int r=0;r<16;++r)o[d_][r]*=wsf[crow(r,hi)]; } }while(0)
  f32x16 pA0,pA1,pB0,pB1;
  int sl_prev=0,sl_cur=0,sl_next=SLOTB;
  #define ROT() do{sl_prev=sl_cur;sl_cur=sl_next;sl_next=(sl_next==(NSLOT-1)*SLOTB)?0:sl_next+SLOTB;}while(0)
  DMA_K(2,2*SLOTB);
  WAIT_BAR(3);
  qkt(pA0,pA1,Kbase,qr,negm,r32,hi);asm volatile("s_nop 15\n\ts_nop 7":"+v"(pA0),"+v"(pA1));CMASK(pA0,pA1,0);
  START(pA0,pA1);
  _Pragma("unroll") for(int r=0;r<16;++r)pA1[r]=__builtin_amdgcn_exp2f(pA1[r]);
  WAIT_BAR(0);
  DMA_K(3,0);DMA_V(1,SLOTB);
  ROT();
  kload8(kf,kp0+sl_cur);
  WAIT_BAR(2);
  s16x4 vlo[8],vhi[8]; u32x4 pw0,pw1,pw2,pw3;
  #define PKW(P,B) cvtpk_s(P[B],P[B+1])
  #define PAF(k) __builtin_bit_cast(bf16x8,pw##k)
  #define VFR(i) (bf16x8){vlo[i][0],vlo[i][1],vlo[i][2],vlo[i][3],vhi[i][0],vhi[i][1],vhi[i][2],vhi[i][3]}
  #define PIN(x) asm volatile("":"+v"(x))
  #define MX3(a,b,c) __builtin_fmaxf(__builtin_fmaxf((a),(b)),(c))
  #define GAPA(MF,A0,A1,A2,A3,W0,W1,PW) do{ MF; sacc+=A0; sacc+=A1; sacc+=A2; sacc+=A3; PIN(sacc); W0; W1; PIN(PW); SBAR(); }while(0)
  #define EX(v) __builtin_amdgcn_exp2f(v)
  #define GAPB(MF,X,B) do{ MF; X[B]=EX(X[B]); X[B+1]=EX(X[B+1]); X[B+2]=EX(X[B+2]); X[B+3]=EX(X[B+3]); PIN(X); SBAR(); }while(0)
  #define VRD(i) do{ vlo[i]=vtr(vp_+(((i)>>2)*4096+((i)&3)*1024)); vhi[i]=vtr(vp_+(((i)>>2)*4096+((i)&3)*1024+512)); }while(0)
  #define KRD(G,j) do{ if(G){ kload2(kf,kp0+sl_next,j); SBAR(); } }while(0)
  #define STEP(C0,C1,P0,P1,t,GK,GV,GL) do{ SBAR(); \
    const lds_cptr vp_=vp0+sl_prev; \
    VRD(0); SBAR(); float sacc=(P0[0]+P0[1]); \
    GAPA(C0=__builtin_amdgcn_mfma_f32_32x32x16_bf16(kf[0],qr[0],negm,0,0,0), P0[2],P0[3],P0[4],P0[5],     pw0[0]=PKW(P0,0), pw0[1]=PKW(P0,2), pw0); \
    VRD(4); SBAR(); GAPA(C1=__builtin_amdgcn_mfma_f32_32x32x16_bf16(kf[1],qr[0],negm,0,0,0), P0[6],P0[7],P0[8],P0[9],     pw0[2]=PKW(P0,4), pw0[3]=PKW(P0,6), pw0); \
    VRD(1); SBAR(); GAPA(C0=__builtin_amdgcn_mfma_f32_32x32x16_bf16(kf[2],qr[1],C0,0,0,0),   P0[10],P0[11],P0[12],P0[13], pw1[0]=PKW(P0,8), pw1[1]=PKW(P0,10), pw1); \
    VRD(5); SBAR(); GAPA(C1=__builtin_amdgcn_mfma_f32_32x32x16_bf16(kf[3],qr[1],C1,0,0,0),   P0[14],P0[15],P1[0],P1[1],   pw1[2]=PKW(P0,12),pw1[3]=PKW(P0,14), pw1); \
    VRD(2); SBAR(); GAPA(C0=__builtin_amdgcn_mfma_f32_32x32x16_bf16(kf[4],qr[2],C0,0,0,0),   P1[2],P1[3],P1[4],P1[5],     pw2[0]=PKW(P1,0), pw2[1]=PKW(P1,2), pw2); \
    VRD(6); SBAR(); GAPA(C1=__builtin_amdgcn_mfma_f32_32x32x16_bf16(kf[5],qr[2],C1,0,0,0),   P1[6],P1[7],P1[8],P1[9],     pw2[2]=PKW(P1,4), pw2[3]=PKW(P1,6), pw2); \
    VRD(3); SBAR(); GAPA(C0=__builtin_amdgcn_mfma_f32_32x32x16_bf16(kf[6],qr[3],C0,0,0,0),   P1[10],P1[11],P1[12],P1[13], pw3[0]=PKW(P1,8), pw3[1]=PKW(P1,10), pw3); \
    VRD(7); SBAR(); GAPA(C1=__builtin_amdgcn_mfma_f32_32x32x16_bf16(kf[7],qr[3],C1,0,0,0),   P1[14],P1[15],0.f,0.f,       pw3[2]=PKW(P1,12),pw3[3]=PKW(P1,14), pw3); \
    l_reg+=sacc; \
    if(GK){DMA_K((t)+3,sl_cur);} if(GV){DMA_V((t)+1,sl_next);} \
    CMASK(C0,C1,t); \
    { float a=MX3(C0[0],C0[1],C1[0]),b=MX3(C0[2],C0[3],C1[1]); a=MX3(a,C1[2],C1[3]); \
      _Pragma("unroll") for(int r=4;r<16;r+=4){a=MX3(a,C0[r],C0[r+1]);b=MX3(b,C0[r+2],C0[r+3]);a=MX3(a,C1[r],C1[r+1]);b=MX3(b,C1[r+2],C1[r+3]);} \
      float rm=__builtin_fmaxf(a,b); { auto rr=__builtin_amdgcn_permlane32_swap(__float_as_uint(rm),__float_as_uint(rm),false,false); rm=__builtin_fmaxf(__uint_as_float(rr[0]),__uint_as_float(rr[1])); } \
      resc=false; \
      if(__builtin_expect(__any(rm>(float)THRL),0)){ const float dl=__builtin_fmaxf(rm,0.f); mhat+=dl; \
        _Pragma("unroll") for(int r=0;r<16;++r){C0[r]-=dl;C1[r]-=dl;} \
        _Pragma("unroll") for(int r=0;r<16;++r)negm[r]=-mhat; asm volatile("":"+v"(negm)); \
        const float f=__builtin_amdgcn_exp2f(-dl); l_reg*=f; if(hi==0)wsf[r32]=f; resc=true; } } \
    SBAR(); \
    GAPB(o[0]=__builtin_amdgcn_mfma_f32_32x32x16_bf16(PAF(0),VFR(0),o[0],0,0,0), C0,0); \
    GAPB(o[1]=__builtin_amdgcn_mfma_f32_32x32x16_bf16(PAF(0),VFR(4),o[1],0,0,0), C0,4); \
    KRD(GL,0); GAPB(o[0]=__builtin_amdgcn_mfma_f32_32x32x16_bf16(PAF(1),VFR(1),o[0],0,0,0), C0,8); \
    KRD(GL,1); GAPB(o[1]=__builtin_amdgcn_mfma_f32_32x32x16_bf16(PAF(1),VFR(5),o[1],0,0,0), C0,12); \
    KRD(GL,2); GAPB(o[0]=__builtin_amdgcn_mfma_f32_32x32x16_bf16(PAF(2),VFR(2),o[0],0,0,0), C1,0); \
    KRD(GL,3); GAPB(o[1]=__builtin_amdgcn_mfma_f32_32x32x16_bf16(PAF(2),VFR(6),o[1],0,0,0), C1,4); \
    GAPB(o[0]=__builtin_amdgcn_mfma_f32_32x32x16_bf16(PAF(3),VFR(3),o[0],0,0,0), C1,8); \
    GAPB(o[1]=__builtin_amdgcn_mfma_f32_32x32x16_bf16(PAF(3),VFR(7),o[1],0,0,0), C1,12); \
    }while(0)
  int t=1;
  #undef CMASK
  #define CMASK(P0,P1,t) do{}while(0)
  for(;t+5<NT;t+=2){
    STEP(pB0,pB1,pA0,pA1,t,true,true,true);     WAIT_BAR(2); RESC(); ROT();
    STEP(pA0,pA1,pB0,pB1,t+1,true,true,true);   WAIT_BAR(2); RESC(); ROT();
  }
  #undef CMASK
  #define CMASK(P0,P1,t) do{}while(0)
  #define ENDW(tt) do{ if((tt)+3<NT){WAIT_BAR(2);} else if((tt)+2<NT){WAIT_BAR(1);} else {WAIT_BAR(0);} }while(0)
  for(;t+1<NT;t+=2){
    STEP(pB0,pB1,pA0,pA1,t,(t+3<NT),(t+1<NT),(t+1<NT));       ENDW(t);   RESC(); ROT();
    STEP(pA0,pA1,pB0,pB1,t+1,(t+4<NT),(t+2<NT),(t+2<NT));     ENDW(t+1); RESC(); ROT();
  }
  STEP(pB0,pB1,pA0,pA1,NT-1,false,false,false); RESC();
  { float sacc=pB0[0]+pB0[1]; _Pragma("unroll") for(int r=2;r<16;++r)sacc+=pB0[r]; _Pragma("unroll") for(int r=0;r<16;++r)sacc+=pB1[r]; l_reg+=sacc;
    pw0=(u32x4){PKW(pB0,0),PKW(pB0,2),PKW(pB0,4),PKW(pB0,6)};pw1=(u32x4){PKW(pB0,8),PKW(pB0,10),PKW(pB0,12),PKW(pB0,14)};pw2=(u32x4){PKW(pB1,0),PKW(pB1,2),PKW(pB1,4),PKW(pB1,6)};pw3=(u32x4){PKW(pB1,8),PKW(pB1,10),PKW(pB1,12),PKW(pB1,14)};
    SBAR(); pv(o,vb0+sl_cur,PAF(0),PAF(1),PAF(2),PAF(3)); }
  #undef PKW
  #undef PAF
  #undef VFR
  #undef PIN
  #undef MX3
  #undef GAPA
  #undef GAPB
  #undef EX
  #undef VRD
  #undef KRD
  #undef STEP
  #undef ENDW
  {auto rr=__builtin_amdgcn_permlane32_swap(__float_as_uint(l_reg),__float_as_uint(l_reg),false,false);l_reg=__uint_as_float(rr[0])+__uint_as_float(rr[1]);}
  if(hi==0)wsf[32+r32]=l_reg;asm volatile("s_waitcnt lgkmcnt(0)":::"memory");
  float rli[16];
  #pragma unroll
  for(int r=0;r<16;++r)rli[r]=__builtin_amdgcn_rcpf(wsf[32+crow(r,hi)]);
  bf16*Ow=Ow0+(long)(wid*QBLK)*OP;
  { bf16*stg=(bf16*)(shm+LDS_OST)+wid*2048;
    #pragma unroll
    for(int r=0;r<16;++r){const int orow=crow(r,hi);
      #pragma unroll
      for(int d0=0;d0<2;++d0)stg[orow*64+d0*32+r32]=__float2bfloat16(o[d0][r]*rli[r]);}
    asm volatile("s_waitcnt lgkmcnt(0)":::"memory");
    #pragma unroll
    for(int i=0;i<4;++i){const int row=i*8+(lane>>3),ch=lane&7; const u32x4 v=*(const u32x4*)(stg+row*64+ch*8); ATTN_STORE16(Ow+(long)row*OP+ch*8,v);} }
  asm volatile("s_waitcnt lgkmcnt(0)\n\ts_barrier":::"memory");
  #undef DMA_K
  #undef DMA_V
  #undef CMASK
  #undef START
  #undef RESC
  #undef ROT
}
constexpr int ATTN_LDS_BYTES=LDS_BYTES;
#undef SBAR
#undef WAIT_BAR
}

template <bool PAIRED, class AL, class BL, class EP>
__device__ __forceinline__ void gemm_f32(int groups, int M, int N, int K, const AL& al, const BL& bl, const EP& ep) {
    const int tid = threadIdx.x, lane = tid & 63, wave = tid >> 6, wm = wave >> 2, wn = wave & 3, r32 = lane & 31, h = lane >> 5;
    constexpr int TN = PAIRED ? 128 : 256;
    const int tilesM = M / 128, tilesN = N / TN, per = tilesM * tilesN, total = groups * per;
    const int ldb = bl.ldb;
    for (int t = blockIdx.x; t < total; t += gridDim.x) {
        const int g = t / per, r = t - g * per, tm = r / tilesN, tn = r - tm * tilesN;
        const int m0 = tm * 128 + wm * 64;
        const int n0 = PAIRED ? (tn * 128 + wn * 32) : (tn * 256 + wn * 64);
        const float* a0 = al.row(g, m0 + r32) + 4 * h;
        const float* a1 = al.row(g, m0 + 32 + r32) + 4 * h;
        const float* b0 = bl.ptr(g, 0) + n0 + r32 + (size_t)(4 * h) * ldb;
        const float* b1 = (PAIRED ? bl.ptr(g, 1) + n0 : bl.ptr(g, 0) + n0 + 32) + r32 + (size_t)(4 * h) * ldb;
        f32x16 acc00 = {}, acc01 = {}, acc10 = {}, acc11 = {};
#pragma unroll 2
        for (int k = 0; k < K; k += 8) {
            const f32x4 av0 = *(const f32x4*)(a0 + k), av1 = *(const f32x4*)(a1 + k);
            float bv0[4], bv1[4];
#pragma unroll
            for (int s = 0; s < 4; ++s) { bv0[s] = b0[(size_t)(k + s) * ldb]; bv1[s] = b1[(size_t)(k + s) * ldb]; }
#pragma unroll
            for (int s = 0; s < 4; ++s) {
                acc00 = __builtin_amdgcn_mfma_f32_32x32x2f32(av0[s], bv0[s], acc00, 0, 0, 0);
                acc01 = __builtin_amdgcn_mfma_f32_32x32x2f32(av0[s], bv1[s], acc01, 0, 0, 0);
                acc10 = __builtin_amdgcn_mfma_f32_32x32x2f32(av1[s], bv0[s], acc10, 0, 0, 0);
                acc11 = __builtin_amdgcn_mfma_f32_32x32x2f32(av1[s], bv1[s], acc11, 0, 0, 0);
            }
        }
#pragma unroll
        for (int rr = 0; rr < 16; ++rr) {
            const int ro = (rr & 3) + 8 * (rr >> 2) + 4 * h;
            if (PAIRED) {
                ep(g, m0 + ro, n0 + r32, acc00[rr], acc01[rr]);
                ep(g, m0 + 32 + ro, n0 + r32, acc10[rr], acc11[rr]);
            } else {
                ep(g, m0 + ro, n0 + r32, acc00[rr], 0.f); ep(g, m0 + ro, n0 + 32 + r32, acc01[rr], 0.f);
                ep(g, m0 + 32 + ro, n0 + r32, acc10[rr], 0.f); ep(g, m0 + 32 + ro, n0 + 32 + r32, acc11[rr], 0.f);
            }
        }
    }
}

__device__ __forceinline__ void phase_pro(const Ctx& c, LAS float* ldsf) {
    float* rope = (float*)(c.ws + WS_ROPE);
    for (int i = c.gt; i < 64 * 16; i += c.ngt) {
        const int pos = i >> 4, fi = i & 15; const float inv = powf(10000.0f, -(float)fi / 16.0f), ang = (float)pos * inv;
        rope[2 * i] = cosf(ang); rope[2 * i + 1] = sinf(ang);
    }
    LAS float* sil = ldsf; LAS float* red = ldsf + 9 * 1024;
    for (int i = c.tid; i < 9 * 1024; i += 512) { const int j = i >> 10, k = i & 1023; const float v = (j < 8) ? c.in[IN_C][j * 1024 + k] : c.in[IN_CCTX][k]; sil[i] = siluf_(v); }
    __syncthreads();
    float* MOD = (float*)(c.ws + WS_MOD);
    for (int task = blockIdx.x; task < DEPTH * 96; task += gridDim.x) {
        const int L = task / 96, cb = task - L * 96, col = cb * 64 + c.lane;
        const float* W = c.in[IN_MODW] + (size_t)L * 1024 * 6144;
        float acc[9];
#pragma unroll
        for (int j = 0; j < 9; ++j) acc[j] = 0.f;
        const int k0 = c.wave * 128;
#pragma unroll 4
        for (int k = k0; k < k0 + 128; ++k) { const float w = W[(size_t)k * 6144 + col];
#pragma unroll
            for (int j = 0; j < 9; ++j) acc[j] += sil[j * 1024 + k] * w; }
#pragma unroll
        for (int j = 0; j < 9; ++j) red[(c.wave * 9 + j) * 64 + c.lane] = acc[j];
        __syncthreads();
        if (c.wave == 0) {
            const float bias = c.in[IN_MODB][L * 6144 + col];
#pragma unroll
            for (int j = 0; j < 9; ++j) { float s = bias;
#pragma unroll
                for (int w = 0; w < 8; ++w) s += red[(w * 9 + j) * 64 + c.lane];
                MOD[(size_t)(L * 9 + j) * 6144 + col] = s; }
        }
        __syncthreads();
    }
    unsigned short* X = (unsigned short*)(c.ws + WS_X);
    for (int r = c.gw; r < NROWS; r += c.ngw) {
        const int b = r / RB, s = r - b * RB;
        const float* src = (s < CL) ? c.in[IN_CTX] + (size_t)(b * CL + s) * D : c.in[IN_X] + (size_t)(b * T + s - CL) * D;
        const f32x4* sp = (const f32x4*)src + c.lane; pg8::u32x2* dp = (pg8::u32x2*)(X + (size_t)r * D) + c.lane;
#pragma unroll
        for (int j = 0; j < 4; ++j) dp[64 * j] = pg8::f32_to_bf4(sp[64 * j]);
    }
}

template <bool FINAL, bool GM>
__device__ __forceinline__ void phase_norm1(const Ctx& c, int L) {
    unsigned short* X = (unsigned short*)(c.ws + WS_X);
    const int* SLOT = (const int*)(c.ws + WS_SLOT); const unsigned char* Y = (const unsigned char*)(c.ws + WS_Y);
    int ch[4];
#pragma unroll
    for (int q = 0; q < 4; ++q) ch[q] = GM ? 16 * c.lane + 4 * q : 4 * (c.lane + 64 * q);
    int r = c.gw;
    f32x4 vn[4]; int spn = -1;
    if (r < NROWS) {
#pragma unroll
        for (int q = 0; q < 4; ++q) vn[q] = pg8::bf4_to_f32(*(const pg8::u32x2*)(X + (size_t)r * D + ch[q]));
        if (L > 0 && c.lane < NE) spn = SLOT[(size_t)r * NE + c.lane];
    }
    for (; r < NROWS; r += c.ngw) {
        const int b = r / RB, s = r - b * RB, j = s < CL ? 8 : b;
        unsigned short* xr = X + (size_t)r * D;
        f32x4 v[4]; const int spl = spn;
#pragma unroll
        for (int q = 0; q < 4; ++q) v[q] = vn[q];
        { const int rn = r + c.ngw;
            if (rn < NROWS) {
#pragma unroll
                for (int q = 0; q < 4; ++q) vn[q] = pg8::bf4_to_f32(*(const pg8::u32x2*)(X + (size_t)rn * D + ch[q]));
                if (L > 0 && c.lane < NE) spn = SLOT[(size_t)rn * NE + c.lane];
            } }
        if (FINAL && s < CL) continue;
        if (L > 0) {
            f32x4 sum[4] = {};
            unsigned long long mask = __ballot(spl >= 0 && c.lane < NE);
            while (mask) {
                const int e0 = __builtin_ctzll(mask); mask &= mask - 1;
                const bool two = mask != 0ull; const int e1 = two ? __builtin_ctzll(mask) : e0; if (two) mask &= mask - 1;
                const int sp0 = __builtin_amdgcn_readlane(spl, e0), sp1 = __builtin_amdgcn_readlane(spl, e1);
                const unsigned char* y0 = Y + ((size_t)e0 * EROWS + sp0) * D; const unsigned char* y1 = Y + ((size_t)e1 * EROWS + sp1) * D;
                unsigned w0[4], w1[4];
#pragma unroll
                for (int q = 0; q < 4; ++q) { w0[q] = *(const unsigned*)(y0 + ch[q]); w1[q] = *(const unsigned*)(y1 + ch[q]); }
#pragma unroll
                for (int q = 0; q < 4; ++q) {
                    { const auto lo = __builtin_amdgcn_cvt_pk_f32_fp8((int)w0[q], false), hi = __builtin_amdgcn_cvt_pk_f32_fp8((int)w0[q], true); sum[q] += (f32x4){lo[0], lo[1], hi[0], hi[1]}; }
                    if (two) { const auto lo = __builtin_amdgcn_cvt_pk_f32_fp8((int)w1[q], false), hi = __builtin_amdgcn_cvt_pk_f32_fp8((int)w1[q], true); sum[q] += (f32x4){lo[0], lo[1], hi[0], hi[1]}; } }
            }
            const float* g2 = modp(c, L - 1, j, 5);
#pragma unroll
            for (int q = 0; q < 4; ++q) { v[q] += *(const f32x4*)(g2 + ch[q]) * (sum[q] * pg8::Y8_INV); if (!FINAL) { const pg8::u32x2 w = pg8::f32_to_bf4(v[q]); *(pg8::u32x2*)(xr + ch[q]) = w; v[q] = pg8::bf4_to_f32(w); } }
        }
        float ss = 0.f;
#pragma unroll
        for (int q = 0; q < 4; ++q) ss += v[q].x * v[q].x + v[q].y * v[q].y + v[q].z * v[q].z + v[q].w * v[q].w;
        const float rstd = rsqrtf(wave_sum(ss) * (1.0f / D) + EPS);
        if (FINAL) {
            const float* g = c.in[IN_FNG]; float* op = c.out + (size_t)(b * T + s - CL) * D;
#pragma unroll
            for (int q = 0; q < 4; ++q) *(f32x4*)(op + ch[q]) = v[q] * rstd * *(const f32x4*)(g + ch[q]);
        } else {
            const float* g = c.in[IN_NORMG] + (size_t)(L * 2 + 0) * D; const float* sc = modp(c, L, j, 1); const float* sh = modp(c, L, j, 0);
            unsigned hw[8];
#pragma unroll
            for (int q = 0; q < 4; ++q) { const f32x4 hv = v[q] * rstd * *(const f32x4*)(g + ch[q]) * (1.0f + *(const f32x4*)(sc + ch[q])) + *(const f32x4*)(sh + ch[q]);
                hw[2 * q] = pg8::cvt_pk_bf16(hv.x, hv.y); hw[2 * q + 1] = pg8::cvt_pk_bf16(hv.z, hv.w); }
            if (GM) { unsigned short* o = (unsigned short*)(c.ws + WS_AS5) + ((size_t)c.lane * 1280 + (r >> 5)) * 768 + (r & 31) * 16;
                *(pg8::u32x4*)o = (pg8::u32x4){hw[0], hw[1], hw[2], hw[3]}; *(pg8::u32x4*)(o + 8) = (pg8::u32x4){hw[4], hw[5], hw[6], hw[7]}; }
            else { unsigned short* o = (unsigned short*)(c.ws + WS_HB1) + (size_t)r * D;
#pragma unroll
                for (int q = 0; q < 4; ++q) *(pg8::u32x2*)(o + ch[q]) = (pg8::u32x2){hw[2 * q], hw[2 * q + 1]}; }
        }
    }
}

template <bool SKIPCTX>
__device__ __forceinline__ void phase_norm2_router(const Ctx& c, int L, LAS float* wT) {
    const unsigned short* X = (const unsigned short*)(c.ws + WS_X); unsigned char* HB = (unsigned char*)(c.ws + WS_HB); float* AFF = (float*)(c.ws + WS_AFF);
    const float* WR = c.in[IN_ROUTER] + (size_t)L * D * NE;
    __syncthreads();
    for (int idx = c.tid; idx < D * 4; idx += 512) { const int ch = idx >> 2, e4 = idx & 3; const f32x4 w = *(const f32x4*)(WR + (size_t)ch * NE + 4 * e4);
        wT[(4 * e4 + 0) * D + ch] = w.x; wT[(4 * e4 + 1) * D + ch] = w.y; wT[(4 * e4 + 2) * D + ch] = w.z; wT[(4 * e4 + 3) * D + ch] = w.w; }
    __syncthreads();
    pg8::u32x2 xn[4];
    if (c.gw < NROWS) {
#pragma unroll
        for (int q = 0; q < 4; ++q) xn[q] = ((const pg8::u32x2*)(X + (size_t)c.gw * D) + c.lane)[64 * q];
    }
    for (int r = c.gw; r < NROWS; r += c.ngw) {
        const int j = row_j(r);
        f32x4 v[4]; float ss = 0.f;
#pragma unroll
        for (int q = 0; q < 4; ++q) { v[q] = pg8::bf4_to_f32(xn[q]); ss += v[q].x * v[q].x + v[q].y * v[q].y + v[q].z * v[q].z + v[q].w * v[q].w; }
        if (r + c.ngw < NROWS) {
#pragma unroll
            for (int q = 0; q < 4; ++q) xn[q] = ((const pg8::u32x2*)(X + (size_t)(r + c.ngw) * D) + c.lane)[64 * q];
        }
        if (SKIPCTX && j == 8) continue;
        const float rstd = rsqrtf(wave_sum(ss) * (1.0f / D) + EPS);
        const f32x4* g = (const f32x4*)(c.in[IN_NORMG] + (size_t)(L * 2 + 1) * D) + c.lane;
        const f32x4* sc = (const f32x4*)modp(c, L, j, 4) + c.lane; const f32x4* sh = (const f32x4*)modp(c, L, j, 3) + c.lane;
        unsigned* hp = (unsigned*)(HB + (size_t)r * D) + c.lane;
        float lg[16]; f32x4 f[4];
#pragma unroll
        for (int q = 0; q < 4; ++q) { f[q] = v[q] * rstd * g[64 * q] * (1.0f + sc[64 * q]) + sh[64 * q]; hp[64 * q] = pg8::pk4_fp8(f[q].x, f[q].y, f[q].z, f[q].w); }
        __builtin_amdgcn_sched_barrier(0);
#pragma unroll
        for (int e = 0; e < 16; ++e) {
            float a = 0.f;
#pragma unroll
            for (int q = 0; q < 4; ++q) { const f32x4 wv = *(const LAS f32x4*)(wT + e * D + 4 * (c.lane + 64 * q)); a += (f[q].x * wv.x + f[q].y * wv.y) + (f[q].z * wv.z + f[q].w * wv.w); }
            lg[e] = a;
            if (e & 1) __builtin_amdgcn_sched_barrier(0);
        }
        const float mine = reduce16(lg, c.lane);
        const int k = reduce16_k(c.lane);
        float mx = mine;
#pragma unroll
        for (int o = 4; o < 64; o <<= 1) mx = fmaxf(mx, __shfl_xor(mx, o));
        const float ex = expf(mine - mx);
        float den = ex;
#pragma unroll
        for (int o = 4; o < 64; o <<= 1) den += __shfl_xor(den, o);
        if ((c.lane & 3) == 0) AFF[(size_t)r * NE + k] = ex / den;
    }
}

__device__ __forceinline__ void phase_topk(const Ctx& c, LAS unsigned* lds32, int nprob) {
    const float* AFF = (const float*)(c.ws + WS_AFF);
    int* SELROW = (int*)(c.ws + WS_SELROW); float* SELGATE = (float*)(c.ws + WS_SELGATE); int* SLOT = (int*)(c.ws + WS_SLOT);
    LAS unsigned* hist = lds32; LAS unsigned* wsum = lds32 + 256; LAS unsigned* res = lds32 + 272;
    LAS int* srow = (LAS int*)(lds32 + 512);
    const unsigned char* HB = (const unsigned char*)(c.ws + WS_HB); unsigned char* XS = (unsigned char*)(c.ws + WS_XS);
    for (int pid = blockIdx.x; pid < nprob; pid += gridDim.x) {
        const bool lat = pid < 128; const int q = lat ? pid : pid - 128, b = q >> 4, e = q & 15;
        const int N = lat ? T : CL, C = lat ? CAP_LAT : CAP_CTX, row0 = b * RB + (lat ? CL : 0), base = lat ? b * CAP_LAT : NB * CAP_LAT + b * CAP_CTX;
        const int t0 = c.tid * 8; const bool valid = t0 < N;
        unsigned k[8];
#pragma unroll
        for (int i = 0; i < 8; ++i) k[i] = valid ? __float_as_uint(AFF[(size_t)(row0 + t0 + i) * NE + e]) : 0u;
        unsigned prefix = 0u, want = (unsigned)C;
#pragma unroll
        for (int r = 0; r < 4; ++r) {
            const int shift = 24 - 8 * r;
            __syncthreads();
            if (c.tid < 256) hist[c.tid] = 0u;
            __syncthreads();
            if (valid) {
#pragma unroll
                for (int i = 0; i < 8; ++i) if (r == 0 || (k[i] >> (shift + 8)) == prefix) __hip_atomic_fetch_add(&hist[(k[i] >> shift) & 255u], 1u, __ATOMIC_RELAXED, __HIP_MEMORY_SCOPE_WORKGROUP);
            }
            __syncthreads();
            if (c.wave == 0) {
                const unsigned h0 = hist[4 * c.lane], h1 = hist[4 * c.lane + 1], h2 = hist[4 * c.lane + 2], h3 = hist[4 * c.lane + 3];
                unsigned suf = h0 + h1 + h2 + h3;
#pragma unroll
                for (int off = 1; off < 64; off <<= 1) { const unsigned o = __shfl_down(suf, off); if (c.lane + off < 64) suf += o; }
                unsigned nxt = __shfl_down(suf, 1); if (c.lane == 63) nxt = 0u;
                if (suf >= want && nxt < want) {
                    unsigned above = nxt; int d;
                    if (above + h3 >= want) d = 3; else { above += h3; if (above + h2 >= want) d = 2; else { above += h2; if (above + h1 >= want) d = 1; else { above += h1; d = 0; } } }
                    res[0] = (unsigned)(4 * c.lane + d); res[1] = want - above;
                }
            }
            __syncthreads();
            prefix = (prefix << 8) | res[0]; want = res[1];
        }
        const unsigned thr = prefix, need_eq = want;
        unsigned cg = 0u, ce = 0u;
#pragma unroll
        for (int i = 0; i < 8; ++i) { cg += (valid && k[i] > thr) ? 1u : 0u; ce += (valid && k[i] == thr) ? 1u : 0u; }
        unsigned incl = cg | (ce << 16);
#pragma unroll
        for (int off = 1; off < 64; off <<= 1) { const unsigned o = __shfl_up(incl, off); if (c.lane >= off) incl += o; }
        __syncthreads();
        if (c.lane == 63) wsum[c.wave] = incl;
        __syncthreads();
        unsigned wbase = 0u;
#pragma unroll
        for (int w = 0; w < 8; ++w) if (w < c.wave) wbase += wsum[w];
        const unsigned excl = wbase + incl - (cg | (ce << 16));
        unsigned gb = excl & 0xffffu, eb = excl >> 16;
        if (valid) {
#pragma unroll
            for (int i = 0; i < 8; ++i) {
                const int row = row0 + t0 + i; const bool isg = k[i] > thr, ise = k[i] == thr;
                const bool sel = isg || (ise && eb < need_eq);
                const unsigned sp = (unsigned)base + gb + (eb < need_eq ? eb : need_eq);
                if (sel) { SELROW[e * EROWS + sp] = row; SELGATE[e * EROWS + sp] = __uint_as_float(k[i]); SLOT[(size_t)row * NE + e] = (int)sp; srow[sp - (unsigned)base] = row; }
                else SLOT[(size_t)row * NE + e] = -1;
                gb += isg ? 1u : 0u; eb += ise ? 1u : 0u;
            }
        }
        __syncthreads();
        for (int s0 = c.wave * 4; s0 < C; s0 += 32) {
            pg8::u32x4 v4[4];
#pragma unroll
            for (int j = 0; j < 4; ++j) v4[j] = *(const pg8::u32x4*)(HB + (size_t)srow[s0 + j] * D + c.lane * 16);
#pragma unroll
            for (int j = 0; j < 4; ++j) *(pg8::u32x4*)(XS + ((size_t)e * EROWS + base + s0 + j) * D + c.lane * 16) = v4[j];
        }
    }
}

__device__ __forceinline__ void post_ld32(const unsigned short* p, float (&v)[32]) {
#pragma unroll
    for (int q = 0; q < 4; ++q) { const pg8::u32x4 w = ((const pg8::u32x4*)p)[q];
#pragma unroll
        for (int e = 0; e < 4; ++e) { v[8 * q + 2 * e] = __uint_as_float(w[e] << 16); v[8 * q + 2 * e + 1] = __uint_as_float(w[e] & 0xffff0000u); } }
}
__device__ __forceinline__ void post_st32(unsigned short* p, const float (&v)[32], float sc) {
#pragma unroll
    for (int q = 0; q < 4; ++q) { pg8::u32x4 w;
#pragma unroll
        for (int e = 0; e < 4; ++e) w[e] = pg8::cvt_pk_bf16(v[8 * q + 2 * e] * sc, v[8 * q + 2 * e + 1] * sc);
        ((pg8::u32x4*)p)[q] = w; }
}
__device__ __forceinline__ void post_rope(float (&v)[32], const float* cs  ) {
#pragma unroll
    for (int f4 = 0; f4 < 8; ++f4) { const f32x4 t4 = ((const f32x4*)cs)[f4];
        { const float x1 = v[2 * f4], x2 = v[16 + 2 * f4]; v[2 * f4] = x1 * t4.x - x2 * t4.y; v[16 + 2 * f4] = x1 * t4.y + x2 * t4.x; }
        { const float x1 = v[2 * f4 + 1], x2 = v[16 + 2 * f4 + 1]; v[2 * f4 + 1] = x1 * t4.z - x2 * t4.w; v[16 + 2 * f4 + 1] = x1 * t4.w + x2 * t4.z; } }
}
__device__ __forceinline__ void phase_post(const Ctx& c, int i, LAS unsigned char* lds) {
    typedef pg8::bf16x8 bf16x8;
    const unsigned short* P = (const unsigned short*)(c.ws + WS_P); const float* rope = (const float*)(c.ws + WS_ROPE);
    unsigned short* QA = (unsigned short*)(c.ws + WS_QA); unsigned short* KA = (unsigned short*)(c.ws + WS_KA); unsigned short* VA = (unsigned short*)(c.ws + WS_VA);
    unsigned short* RQ = (unsigned short*)(c.ws + WS_RQ); unsigned short* RK = (unsigned short*)(c.ws + WS_RK); unsigned short* RV = (unsigned short*)(c.ws + WS_RV);
    float* U = (float*)(c.ws + WS_U);
    const float* qkg = c.in[IN_QKG] + (size_t)i * 2 * 64;
    constexpr int VTS = 0, KTF = 17408, KTB = 34816;
    const int grp = c.tid >> 8, r = (c.tid & 255) >> 1, half = c.tid & 1;
    const int li = c.lane & 15, q4 = c.lane >> 4;
    for (int unit = blockIdx.x; unit < NB * 34 * 8; unit += gridDim.x) {
        const int hh = unit & 7, bc = unit >> 3, b = bc / 34, cch = bc - b * 34, row0 = b * RB + cch * 128, bh = b * 8 + hh;
        const bool latent = cch >= 2;
        const size_t row = (size_t)(row0 + r);
        const int tpos = cch * 128 + r - CL;
        const float* cs = rope + (size_t)((half == 0 ? (tpos >> 6) : (tpos & 63)) * 16) * 2;
        const float lgf = -expf(c.in[IN_RETRATE][(i * 2 + 0) * 8 + hh]) * 1.4426950408889634f, lgb = -expf(c.in[IN_RETRATE][(i * 2 + 1) * 8 + hh]) * 1.4426950408889634f;
        __syncthreads();
        float v[32];
        post_ld32(P + row * INW + (grp ? 512 : 0) + hh * 64 + 32 * half, v);
        if (grp) {
#pragma unroll
            for (int d = 0; d < 32; ++d) v[d] *= 0.125f; }
        if (latent) post_rope(v, cs);
        post_st32((grp ? RK : RQ) + row * 512 + hh * 64 + 32 * half, v, 1.0f);
        if (grp) { const float wf = exp2f(lgf * (float)(127 - r)), wb = exp2f(lgb * (float)r);
#pragma unroll
            for (int d = 0; d < 32; d += 2) { const unsigned pf = pg8::cvt_pk_bf16(v[d] * wf, v[d + 1] * wf), pb = pg8::cvt_pk_bf16(v[d] * wb, v[d + 1] * wb);
                *(LAS unsigned short*)(lds + KTF + (32 * half + d) * 272 + r * 2) = (unsigned short)(pf & 0xffffu); *(LAS unsigned short*)(lds + KTF + (32 * half + d + 1) * 272 + r * 2) = (unsigned short)(pf >> 16);
                *(LAS unsigned short*)(lds + KTB + (32 * half + d) * 272 + r * 2) = (unsigned short)(pb & 0xffffu); *(LAS unsigned short*)(lds + KTB + (32 * half + d + 1) * 272 + r * 2) = (unsigned short)(pb >> 16); } }
        post_ld32(P + row * INW + (grp ? 2048 : 1024) + hh * 64 + 32 * half, v);
        if (grp == 0) { post_st32(RV + row * 512 + hh * 64 + 32 * half, v, 1.0f);
#pragma unroll
            for (int d = 0; d < 32; d += 2) { const unsigned pv = pg8::cvt_pk_bf16(v[d], v[d + 1]);
                *(LAS unsigned short*)(lds + VTS + (32 * half + d) * 272 + r * 2) = (unsigned short)(pv & 0xffffu); *(LAS unsigned short*)(lds + VTS + (32 * half + d + 1) * 272 + r * 2) = (unsigned short)(pv >> 16); }
        } else {
            float ss = 0.f;
#pragma unroll
            for (int d = 0; d < 32; ++d) ss += v[d] * v[d];
            ss += __shfl_xor(ss, 1);
            const float rs = rsqrtf(ss * (1.0f / 64.0f) + EPS);
#pragma unroll
            for (int d = 0; d < 32; ++d) v[d] = v[d] * rs * qkg[32 * half + d];
            if (latent) post_rope(v, cs);
            post_st32(QA + row * 512 + hh * 64 + 32 * half, v, attn_body::C2);
        }
        if (hh < 2) {
            post_ld32(P + row * INW + (grp ? 2688 : 2560) + hh * 64 + 32 * half, v);
            if (grp == 0) {
                float ss = 0.f;
#pragma unroll
                for (int d = 0; d < 32; ++d) ss += v[d] * v[d];
                ss += __shfl_xor(ss, 1);
                const float rs = rsqrtf(ss * (1.0f / 64.0f) + EPS);
#pragma unroll
                for (int d = 0; d < 32; ++d) v[d] = v[d] * rs * qkg[64 + 32 * half + d];
                if (latent) post_rope(v, cs);
                post_st32(KA + row * 128 + hh * 64 + 32 * half, v, 1.0f);
            } else post_st32(VA + row * 128 + hh * 64 + 32 * half, v, 1.0f);
        }
        __syncthreads();
        { const int dir = c.wave >> 2, dvt = c.wave & 3;
            bf16x8 af[4];
#pragma unroll
            for (int u = 0; u < 4; ++u) af[u] = *(const LAS bf16x8*)(lds + VTS + (16 * dvt + li) * 272 + (32 * u + 8 * q4) * 2);
            float* uo = U + ((size_t)(bh * 34 + cch) * 2 + dir) * 4096;
#pragma unroll
            for (int dkt = 0; dkt < 4; ++dkt) {
                f32x4 a = {0.f, 0.f, 0.f, 0.f};
#pragma unroll
                for (int u = 0; u < 4; ++u) { const bf16x8 kf = *(const LAS bf16x8*)(lds + (dir ? KTB : KTF) + (16 * dkt + li) * 272 + (32 * u + 8 * q4) * 2); a = __builtin_amdgcn_mfma_f32_16x16x32_bf16(af[u], kf, a, 0, 0, 0); }
#pragma unroll
                for (int rr = 0; rr < 4; ++rr) uo[(16 * dvt + 4 * q4 + rr) * 64 + 16 * dkt + li] = a[rr];
            } }
    }
}

__device__ __forceinline__ void phase_ret_prefix(const Ctx& c, int i) {
    const float* U = (const float*)(c.ws + WS_U); unsigned short* ET = (unsigned short*)(c.ws + WS_ET);
    for (int chain = c.gt; chain < 64 * 2 * 4096; chain += c.ngt) {
        const int bh = chain >> 13, dir = (chain >> 12) & 1, el = chain & 4095, hh = bh & 7;
        const float g128 = expf(-expf(c.in[IN_RETRATE][(i * 2 + dir) * 8 + hh]) * 128.0f);
        float S = 0.f;
#pragma unroll
        for (int st = 0; st < 34; ++st) {
            const int cch = dir == 0 ? st : (st < 2 ? 1 - st : 35 - st);
            const size_t o = ((size_t)(bh * 34 + cch) * 2 + dir) * 4096 + el;
            ET[o] = (unsigned short)(pg8::cvt_pk_bf16(S, 0.f) & 0xffffu);
            S = g128 * S + U[o];
        }
    }
}
__device__ __forceinline__ void phase_ret_main(const Ctx& c, int i, LAS unsigned char* lds) {
    typedef pg8::bf16x8 bf16x8;
    const unsigned short* RQ = (const unsigned short*)(c.ws + WS_RQ); const unsigned short* RK = (const unsigned short*)(c.ws + WS_RK); const unsigned short* RV = (const unsigned short*)(c.ws + WS_RV);
    const unsigned short* ET = (const unsigned short*)(c.ws + WS_ET); const unsigned short* P = (const unsigned short*)(c.ws + WS_P); unsigned short* MIX = (unsigned short*)(c.ws + WS_MIX);
    const float* gn = c.in[IN_RETGN] + (size_t)i * 512;
    constexpr int QS = 0, KS = 18432, VTS = 36864, EF = 54272, EB = 63488;
    const int li = c.lane & 15, q4 = c.lane >> 4, i0 = 16 * c.wave, ig = i0 + li;
    for (int unit = blockIdx.x; unit < 64 * 34; unit += gridDim.x) {
        const int bh = unit / 34, cch = unit - bh * 34, b = bh >> 3, hh = bh & 7, row0 = b * RB + cch * 128;
        const float lgf = -expf(c.in[IN_RETRATE][(i * 2 + 0) * 8 + hh]) * 1.4426950408889634f, lgb = -expf(c.in[IN_RETRATE][(i * 2 + 1) * 8 + hh]) * 1.4426950408889634f;
        __syncthreads();
        for (int pc = c.tid; pc < 1024; pc += 512) { const int r = pc >> 3, ch = pc & 7; const size_t go = (size_t)(row0 + r) * 512 + hh * 64 + ch * 8;
            *(LAS pg8::u32x4*)(lds + QS + r * 144 + ch * 16) = *(const pg8::u32x4*)(RQ + go);
            *(LAS pg8::u32x4*)(lds + KS + r * 144 + ch * 16) = *(const pg8::u32x4*)(RK + go);
            const pg8::u32x4 vw = *(const pg8::u32x4*)(RV + go);
#pragma unroll
            for (int e = 0; e < 4; ++e) { *(LAS unsigned short*)(lds + VTS + (ch * 8 + 2 * e) * 272 + r * 2) = (unsigned short)(vw[e] & 0xffffu); *(LAS unsigned short*)(lds + VTS + (ch * 8 + 2 * e + 1) * 272 + r * 2) = (unsigned short)(vw[e] >> 16); } }
        { const int r = c.tid >> 3, ch = c.tid & 7; const size_t go = ((size_t)(bh * 34 + cch) * 2) * 4096 + r * 64 + ch * 8;
            *(LAS pg8::u32x4*)(lds + EF + r * 144 + ch * 16) = *(const pg8::u32x4*)(ET + go); *(LAS pg8::u32x4*)(lds + EB + r * 144 + ch * 16) = *(const pg8::u32x4*)(ET + go + 4096); }
        __syncthreads();
        bf16x8 qf[2];
#pragma unroll
        for (int s = 0; s < 2; ++s) qf[s] = *(const LAS bf16x8*)(lds + QS + (i0 + li) * 144 + (32 * s + 8 * q4) * 2);
        pg8::u32x2 pk[8];
#pragma unroll
        for (int jt = 0; jt < 8; ++jt) {
            f32x4 a = {0.f, 0.f, 0.f, 0.f};
#pragma unroll
            for (int s = 0; s < 2; ++s) { const bf16x8 kf = *(const LAS bf16x8*)(lds + KS + (16 * jt + li) * 144 + (32 * s + 8 * q4) * 2); a = __builtin_amdgcn_mfma_f32_16x16x32_bf16(kf, qf[s], a, 0, 0, 0); }
            float pv[4];
#pragma unroll
            for (int r = 0; r < 4; ++r) { const int dl = ig - (16 * jt + 4 * q4 + r); const float w = dl >= 0 ? exp2f(lgf * (float)dl) : exp2f(lgb * (float)(-dl)); pv[r] = a[r] * w; }
            pk[jt] = (pg8::u32x2){pg8::cvt_pk_bf16(pv[0], pv[1]), pg8::cvt_pk_bf16(pv[2], pv[3])};
        }
        const float sf = exp2f(lgf * (float)(ig + 1)), sb = exp2f(lgb * (float)(128 - ig));
        f32x4 oacc[4];
#pragma unroll
        for (int dvt = 0; dvt < 4; ++dvt) {
            f32x4 o = {0.f, 0.f, 0.f, 0.f};
#pragma unroll
            for (int u = 0; u < 4; ++u) {
                const pg8::u32x2 vlo = *(const LAS pg8::u32x2*)(lds + VTS + (16 * dvt + li) * 272 + (32 * u + 4 * q4) * 2), vhi = *(const LAS pg8::u32x2*)(lds + VTS + (16 * dvt + li) * 272 + (32 * u + 16 + 4 * q4) * 2);
                const pg8::u32x4 av = {vlo.x, vlo.y, vhi.x, vhi.y}, bv = {pk[2 * u].x, pk[2 * u].y, pk[2 * u + 1].x, pk[2 * u + 1].y};
                o = __builtin_amdgcn_mfma_f32_16x16x32_bf16(__builtin_bit_cast(bf16x8, av), __builtin_bit_cast(bf16x8, bv), o, 0, 0, 0);
            }
            f32x4 tf = {0.f, 0.f, 0.f, 0.f}, tb = {0.f, 0.f, 0.f, 0.f};
#pragma unroll
            for (int s = 0; s < 2; ++s) {
                const bf16x8 ef = *(const LAS bf16x8*)(lds + EF + (16 * dvt + li) * 144 + (32 * s + 8 * q4) * 2), eb = *(const LAS bf16x8*)(lds + EB + (16 * dvt + li) * 144 + (32 * s + 8 * q4) * 2);
                tf = __builtin_amdgcn_mfma_f32_16x16x32_bf16(ef, qf[s], tf, 0, 0, 0); tb = __builtin_amdgcn_mfma_f32_16x16x32_bf16(eb, qf[s], tb, 0, 0, 0);
            }
            oacc[dvt] = o + tf * sf + tb * sb;
        }
        float sm = 0.f;
#pragma unroll
        for (int dvt = 0; dvt < 4; ++dvt) sm += (oacc[dvt].x + oacc[dvt].y) + (oacc[dvt].z + oacc[dvt].w);
        sm += __shfl_xor(sm, 16); sm += __shfl_xor(sm, 32);
        const float mu = sm * (1.0f / 64.0f); float vr = 0.f;
#pragma unroll
        for (int dvt = 0; dvt < 4; ++dvt) { oacc[dvt] = oacc[dvt] - mu; vr += (oacc[dvt].x * oacc[dvt].x + oacc[dvt].y * oacc[dvt].y) + (oacc[dvt].z * oacc[dvt].z + oacc[dvt].w * oacc[dvt].w); }
        vr += __shfl_xor(vr, 16); vr += __shfl_xor(vr, 32);
        const float rs = rsqrtf(vr * (1.0f / 64.0f) + EPS);
        const size_t row = (size_t)(row0 + ig);
#pragma unroll
        for (int dvt = 0; dvt < 4; ++dvt) { const int dvc = hh * 64 + 16 * dvt + 4 * q4;
            const pg8::u32x2 gw = *(const pg8::u32x2*)(P + row * INW + 1536 + dvc); const f32x4 gt = {__uint_as_float(gw.x << 16), __uint_as_float(gw.x & 0xffff0000u), __uint_as_float(gw.y << 16), __uint_as_float(gw.y & 0xffff0000u)}, gg = *(const f32x4*)(gn + dvc); const f32x4 y = oacc[dvt] * rs * gg;
            *(pg8::u32x2*)(MIX + row * D + dvc) = (pg8::u32x2){pg8::cvt_pk_bf16(gt.x * pg8::fast_sigmoid(gt.x) * y.x, gt.y * pg8::fast_sigmoid(gt.y) * y.y), pg8::cvt_pk_bf16(gt.z * pg8::fast_sigmoid(gt.z) * y.z, gt.w * pg8::fast_sigmoid(gt.w) * y.w)}; }
    }
}

__device__ __forceinline__ void phase_attention(const Ctx& c, char* lds) {
    const attn_body::bf16* QA = (const attn_body::bf16*)(c.ws + WS_QA); const attn_body::bf16* KA = (const attn_body::bf16*)(c.ws + WS_KA); const attn_body::bf16* VA = (const attn_body::bf16*)(c.ws + WS_VA);
    attn_body::bf16* MIX = (attn_body::bf16*)(c.ws + WS_MIX);
    const int G = gridDim.x, bx = blockIdx.x, vcu = (G % 8 == 0) ? (bx % 8) * (G / 8) + bx / 8 : bx;
    for (int U = vcu; U < NB * 8 * 17; U += G) {
        int bh, qrow0, NT;
        if (U < NB * 8 * 16) { bh = U >> 4; qrow0 = (bh >> 3) * RB + CL + (U & 15) * 256; NT = RB / 64; }
        else { bh = U - NB * 8 * 16; qrow0 = (bh >> 3) * RB; NT = CL / 64; }
        const int b = bh >> 3, hh = bh & 7;
        attn_body::attn_unit<8>(QA + (size_t)qrow0 * 512 + hh * 64, KA + (size_t)(b * RB) * 128 + (hh >> 2) * 64, VA + (size_t)(b * RB) * 128 + (hh >> 2) * 64,
                                MIX + (size_t)qrow0 * 1024 + 512 + hh * 64, NT, lds, c.wave);
    }
}

__device__ __forceinline__ void phase_s5_ops(const Ctx& c, LAS float* ldsf) {
    LAS float* Pre = ldsf; LAS float* Pim = ldsf + 4608; LAS float* KZr = ldsf + 9216; LAS float* KZi = ldsf + 9344;
    LAS float* Bre = ldsf + 9472; LAS float* Bim = ldsf + 10496; LAS float* Cre = ldsf + 11520; LAS float* Cim = ldsf + 13568;
    LAS float* KV = ldsf + 15616;
#define S5P(dir, pw, p) (((dir) * 64 + (p)) * 36 + (pw))
    for (int task = blockIdx.x; task < 2 * 64 * 2; task += gridDim.x) {
        const int i = task >> 7, g = (task >> 1) & 63, hf = task & 1;
        __syncthreads();
        if (c.tid < 128) {
            const int dir = c.tid >> 6, p = c.tid & 63;
            const float a_re = c.in[IN_S5ARE][((i * 2 + dir) * 64 + g) * 64 + p], a_im = c.in[IN_S5AIM][((i * 2 + dir) * 64 + g) * 64 + p];
            const float dt = expf(c.in[IN_S5DT][(i * 2 + dir) * 64 + g]);
            const float lre = fminf(a_re, -1e-4f), lim = a_im, ea = lre * dt, eb = lim * dt;
            for (int dl = 0; dl <= 32; ++dl) { const float m = expf(ea * (float)dl), an = eb * (float)dl; Pre[S5P(dir, dl, p)] = m * cosf(an); Pim[S5P(dir, dl, p)] = m * sinf(an); }
            const float cb = cosf(eb), sb = sinf(eb), sh = sinf(0.5f * eb), mag = expf(ea);
            const float nr = expm1f(ea) * cb - 2.0f * sh * sh, ni = mag * sb, den = lre * lre + lim * lim;
            KZr[dir * 64 + p] = (nr * lre + ni * lim) / den; KZi[dir * 64 + p] = (ni * lre - nr * lim) / den;
        }
        for (int idx = c.tid; idx < 1024; idx += 512) { Bre[idx] = c.in[IN_S5BRE][(size_t)(i * 64 + g) * 1024 + idx]; Bim[idx] = c.in[IN_S5BIM][(size_t)(i * 64 + g) * 1024 + idx]; }
        for (int idx = c.tid; idx < 2048; idx += 512) { const int dir = idx >> 10, rem = idx & 1023;
            Cre[idx] = c.in[IN_S5CRE][((size_t)(i * 2 + dir) * 64 + g) * 1024 + rem]; Cim[idx] = c.in[IN_S5CIM][((size_t)(i * 2 + dir) * 64 + g) * 1024 + rem]; }
        __syncthreads();
        {
            const int dir = c.tid >> 8, ko = (c.tid >> 4) & 15, ki = c.tid & 15;
            float acc[32];
#pragma unroll
            for (int dl = 0; dl < 32; ++dl) acc[dl] = 0.f;
            for (int p = 0; p < 64; ++p) {
                const float kr = KZr[dir * 64 + p], kq = KZi[dir * 64 + p], br = Bre[p * 16 + ki], bi = Bim[p * 16 + ki], cr = Cre[(dir * 16 + ko) * 64 + p], ci = Cim[(dir * 16 + ko) * 64 + p];
                const float gr = kr * br - kq * bi, gi = kr * bi + kq * br, tr = cr * gr - ci * gi, ti = cr * gi + ci * gr;
#pragma unroll
                for (int d4 = 0; d4 < 8; ++d4) { const f32x4 pr = *(const LAS f32x4*)(Pre + S5P(dir, 4 * d4, p)), pi = *(const LAS f32x4*)(Pim + S5P(dir, 4 * d4, p));
                    acc[4 * d4] += tr * pr.x - ti * pi.x; acc[4 * d4 + 1] += tr * pr.y - ti * pi.y; acc[4 * d4 + 2] += tr * pr.z - ti * pi.z; acc[4 * d4 + 3] += tr * pr.w - ti * pi.w; }
            }
#pragma unroll
            for (int dl = 0; dl < 32; ++dl) KV[((dir * 32 + dl) * 16 + ko) * 16 + ki] = acc[dl];
        }
        __syncthreads();
        unsigned* TV = (unsigned*)(c.ws + WS_TV) + ((size_t)(i * 64 + g) * 512 * 768) / 2;
        const float* dsk = c.in[IN_S5D] + (size_t)i * D + 16 * g;
        if (c.tid < 384) {
            const int kp = c.tid, kk = 2 * kp;
            if (kk < 512) {
                const int j = kk >> 4, ki = kk & 15;
                for (int it = 16 * hf; it < 16 * hf + 16; ++it) {
                    const int dl = it > j ? it - j : j - it, dir = it > j ? 0 : 1;
                    for (int ko = 0; ko < 16; ++ko) {
                        float v0, v1;
                        if (it != j) { v0 = KV[((dir * 32 + dl) * 16 + ko) * 16 + ki]; v1 = KV[((dir * 32 + dl) * 16 + ko) * 16 + ki + 1]; }
                        else { v0 = KV[(ko) * 16 + ki] + KV[((32) * 16 + ko) * 16 + ki] + (ko == ki ? dsk[ko] : 0.f); v1 = KV[(ko) * 16 + ki + 1] + KV[((32) * 16 + ko) * 16 + ki + 1] + (ko == ki + 1 ? dsk[ko] : 0.f); }
                        TV[(size_t)(it * 16 + ko) * 384 + kp] = pg8::cvt_pk_bf16(v0, v1);
                    }
                }
            } else {
                const int q = kk - 512, dir = q >> 7, part = (q >> 6) & 1, p = q & 63;
                for (int it = 16 * hf; it < 16 * hf + 16; ++it) {
                    const int pw = dir == 0 ? it + 1 : 32 - it;
                    const float pr0 = Pre[S5P(dir, pw, p)], pi0 = Pim[S5P(dir, pw, p)], pr1 = Pre[S5P(dir, pw, p + 1)], pi1 = Pim[S5P(dir, pw, p + 1)];
                    for (int ko = 0; ko < 16; ++ko) {
                        const float cr0 = Cre[(dir * 16 + ko) * 64 + p], ci0 = Cim[(dir * 16 + ko) * 64 + p], cr1 = Cre[(dir * 16 + ko) * 64 + p + 1], ci1 = Cim[(dir * 16 + ko) * 64 + p + 1];
                        const float v0 = part == 0 ? (cr0 * pr0 - ci0 * pi0) : -(cr0 * pi0 + ci0 * pr0), v1 = part == 0 ? (cr1 * pr1 - ci1 * pi1) : -(cr1 * pi1 + ci1 * pr1);
                        TV[(size_t)(it * 16 + ko) * 384 + kp] = pg8::cvt_pk_bf16(v0, v1);
                    }
                }
            }
        }
        unsigned* WS5 = (unsigned*)(c.ws + WS_WS5) + ((size_t)(i * 64 + g) * 256 * 512) / 2;
        if (c.tid < 256) {
            const int kp = c.tid, kk = 2 * kp, j = kk >> 4, ki = kk & 15, dir = hf, pw = dir == 0 ? 31 - j : j;
            for (int pp = 0; pp < 128; ++pp) {
                const int part = pp >> 6, p = pp & 63;
                const float pr = Pre[S5P(dir, pw, p)], pi = Pim[S5P(dir, pw, p)], kr = KZr[dir * 64 + p], kq = KZi[dir * 64 + p];
                const float gr = pr * kr - pi * kq, gi = pr * kq + pi * kr, br0 = Bre[p * 16 + ki], bi0 = Bim[p * 16 + ki], br1 = Bre[p * 16 + ki + 1], bi1 = Bim[p * 16 + ki + 1];
                const float v0 = part == 0 ? (gr * br0 - gi * bi0) : (gr * bi0 + gi * br0), v1 = part == 0 ? (gr * br1 - gi * bi1) : (gr * bi1 + gi * br1);
                WS5[(size_t)(128 * hf + pp) * 256 + kp] = pg8::cvt_pk_bf16(v0, v1);
            }
        }
    }
#undef S5P
}
__device__ __forceinline__ void phase_s5_carry(const Ctx& c, int i) {
    const float* SL = (const float*)(c.ws + WS_SL); unsigned short* AS5 = (unsigned short*)(c.ws + WS_AS5);
    for (int id = c.gt; id < 64 * 8 * 2 * 64; id += c.ngt) {
        const int p = id & 63, dir = (id >> 6) & 1, b = (id >> 7) & 7, g = id >> 10;
        const float a_re = c.in[IN_S5ARE][((i * 2 + dir) * 64 + g) * 64 + p], a_im = c.in[IN_S5AIM][((i * 2 + dir) * 64 + g) * 64 + p];
        const float dt = expf(c.in[IN_S5DT][(i * 2 + dir) * 64 + g]);
        const float lre = fminf(a_re, -1e-4f), m32 = expf(lre * dt * 32.0f), an = a_im * dt * 32.0f, ar = m32 * cosf(an), ai = m32 * sinf(an);
        float xr = 0.f, xi = 0.f;
#pragma unroll 8
        for (int st = 0; st < 136; ++st) {
            const int cch = dir == 0 ? st : (st < 8 ? 7 - st : 143 - st);
            const size_t r = (size_t)g * 1280 + b * 136 + cch;
            unsigned short* xo = AS5 + r * 768 + 512 + dir * 128 + p;
            xo[0] = (unsigned short)(pg8::cvt_pk_bf16(xr, 0.f) & 0xffffu); xo[64] = (unsigned short)(pg8::cvt_pk_bf16(xi, 0.f) & 0xffffu);
            const float sr = SL[r * 256 + dir * 128 + p], si = SL[r * 256 + dir * 128 + 64 + p];
            const float nxr = ar * xr - ai * xi + sr, nxi = ar * xi + ai * xr + si;
            xr = nxr; xi = nxi;
        }
    }
}

__device__ __forceinline__ void cvt_item(const float* W, int ldw, int k0, int scol0, unsigned short* WT, int K, int drow0, LAS float* scr, int lane) {
    float wv[32];
#pragma unroll
    for (int i = 0; i < 32; ++i) wv[i] = W[(size_t)(k0 + 2 * i + (lane >> 5)) * ldw + scol0 + (lane & 31)];
#pragma unroll
    for (int i = 0; i < 32; ++i) scr[(2 * i + (lane >> 5)) * 33 + (lane & 31)] = wv[i];
    asm volatile("s_waitcnt lgkmcnt(0)" ::: "memory");
    const int cc = lane & 7;
#pragma unroll
    for (int j = 0; j < 4; ++j) { const int n = (lane >> 3) + 8 * j; const LAS float* s = scr + (8 * cc) * 33 + n;
        pg8::u32x4 o; o.x = pg8::cvt_pk_bf16(s[0 * 33], s[1 * 33]); o.y = pg8::cvt_pk_bf16(s[2 * 33], s[3 * 33]); o.z = pg8::cvt_pk_bf16(s[4 * 33], s[5 * 33]); o.w = pg8::cvt_pk_bf16(s[6 * 33], s[7 * 33]);
        *(pg8::u32x4*)(WT + (size_t)(drow0 + n) * K + k0 + 8 * cc) = o; }
    asm volatile("s_waitcnt lgkmcnt(0)" ::: "memory");
}
__device__ __forceinline__ void cvt_item8(const float* W, int ldw, int k0, int scol0, unsigned char* WT, int K, int drow0, LAS float* scr, int lane) {
    float wv[32];
#pragma unroll
    for (int i = 0; i < 32; ++i) wv[i] = W[(size_t)(k0 + 2 * i + (lane >> 5)) * ldw + scol0 + (lane & 31)];
#pragma unroll
    for (int i = 0; i < 32; ++i) scr[(2 * i + (lane >> 5)) * 33 + (lane & 31)] = wv[i] * pg8::W8_SCALE;
    asm volatile("s_waitcnt lgkmcnt(0)" ::: "memory");
    const int n = lane >> 1, kh = lane & 1; const LAS float* s = scr + (32 * kh) * 33 + n;
    unsigned w[8];
#pragma unroll
    for (int j = 0; j < 8; ++j) w[j] = pg8::pk4_fp8(s[(4 * j) * 33], s[(4 * j + 1) * 33], s[(4 * j + 2) * 33], s[(4 * j + 3) * 33]);
    unsigned char* o = WT + (size_t)(drow0 + n) * K + k0 + 32 * kh;
    *(pg8::u32x4*)o = (pg8::u32x4){w[0], w[1], w[2], w[3]}; *(pg8::u32x4*)(o + 16) = (pg8::u32x4){w[4], w[5], w[6], w[7]};
    asm volatile("s_waitcnt lgkmcnt(0)" ::: "memory");
}
__device__ __forceinline__ void phase_cvt_moe(const Ctx& c, LAS float* ldsf) {
    LAS unsigned char* img = (LAS unsigned char*)ldsf;
    unsigned char* W13 = (unsigned char*)(c.ws + WS_W13); unsigned char* W2T = (unsigned char*)(c.ws + WS_W2);
    for (int id = blockIdx.x; id < DEPTH * NE * 192; id += gridDim.x) {
        const int le = id / 192; int r = id - le * 192;
        const float* sp; int ldw, K; unsigned char* dst; int rowl;
        if (r < 128) { const int kt = r >> 4, pn = r & 15, half = c.lane >> 5, n4 = c.lane & 31;
            sp = (half ? c.in[IN_W3] : c.in[IN_W1]) + (size_t)le * D * FF + (size_t)(128 * kt + 16 * c.wave) * FF + 128 * pn + 4 * n4; ldw = FF; K = D;
            dst = W13 + (size_t)le * 4096 * D + (size_t)(256 * pn) * D + 128 * kt; rowl = 128 * half + 4 * n4;
        } else { r -= 128; const int kt = r >> 2, pn = r & 3;
            sp = c.in[IN_W2] + (size_t)le * FF * D + (size_t)(128 * kt + 16 * c.wave) * D + 256 * pn + 4 * c.lane; ldw = D; K = FF;
            dst = W2T + (size_t)le * D * FF + (size_t)(256 * pn) * FF + 128 * kt; rowl = 4 * c.lane; }
        f32x4 v[16];
#pragma unroll
        for (int q = 0; q < 16; ++q) v[q] = *(const f32x4*)(sp + (size_t)q * ldw);
        __syncthreads();
#pragma unroll
        for (int j = 0; j < 4; ++j) {
            pg8::u32x4 w;
#pragma unroll
            for (int q4 = 0; q4 < 4; ++q4) w[q4] = pg8::pk4_fp8(v[4 * q4][j] * pg8::W8_SCALE, v[4 * q4 + 1][j] * pg8::W8_SCALE, v[4 * q4 + 2][j] * pg8::W8_SCALE, v[4 * q4 + 3][j] * pg8::W8_SCALE);
            const int row = rowl + j;
            *(LAS pg8::u32x4*)(img + row * 128 + ((c.wave ^ ((row >> 2) & 7)) * 16)) = w;
        }
        __syncthreads();
#pragma unroll
        for (int i4 = 0; i4 < 4; ++i4) { const int p = c.tid + 512 * i4, row = p >> 3, ch = p & 7;
            *(pg8::u32x4*)(dst + (size_t)row * K + 16 * ch) = *(const LAS pg8::u32x4*)(img + row * 128 + ((ch ^ ((row >> 2) & 7)) * 16)); }
    }
    __syncthreads();
    LAS float* scr = ldsf + c.wave * (64 * 33);
    unsigned short* WIN = (unsigned short*)(c.ws + WS_WIN); unsigned short* WOUT = (unsigned short*)(c.ws + WS_WOUT); unsigned short* WGLU = (unsigned short*)(c.ws + WS_WGLU);
    for (int id = c.gw; id < 2 * (1408 + 512 + 1024); id += c.ngw) {
        const int i = id / 2944; int r = id - i * 2944;
        if (r < 1408) { const int kb = r / 88, nb = r - kb * 88; cvt_item(c.in[IN_MIXIN] + (size_t)i * D * INW, INW, 64 * kb, 32 * nb, WIN + (size_t)i * INW * D, D, 32 * nb, scr, c.lane); }
        else if (r < 1920) { r -= 1408; const int kb = r >> 5, nb = r & 31; cvt_item(c.in[IN_MIXOUT] + (size_t)i * D * D, D, 64 * kb, 32 * nb, WOUT + (size_t)i * D * D, D, 32 * nb, scr, c.lane); }
        else { r -= 1920; const int kb = r >> 6, nb = r & 63, pn = nb >> 3, rr0 = (nb & 7) * 32;
            cvt_item(c.in[IN_GLUW] + (size_t)i * D * 2048, 2048, 64 * kb, (rr0 < 128 ? 0 : 1024) + 128 * pn + (rr0 & 127), WGLU + (size_t)i * 2048 * D, D, 32 * nb, scr, c.lane); }
    }
}

struct ALDense { const float* A; int lda; size_t gstride; __device__ __forceinline__ const float* row(int g, int r) const { return A + (size_t)g * gstride + (size_t)r * lda; } };
struct ALGather { const float* A; const int* idx; __device__ __forceinline__ const float* row(int g, int r) const { return A + (size_t)idx[g * EROWS + r] * D; } };
struct BL1 { const float* B; int ldb; size_t gstride; __device__ __forceinline__ const float* ptr(int g, int) const { return B + (size_t)g * gstride; } };
struct BL2 { const float* Ba; const float* Bb; int ldb; size_t gstride; __device__ __forceinline__ const float* ptr(int g, int sub) const { return (sub ? Bb : Ba) + (size_t)g * gstride; } };
struct EPStore { float* O; int ldc; __device__ __forceinline__ void operator()(int, int row, int col, float v, float) const { O[(size_t)row * ldc + col] = v; } };
struct EPResid { float* X; const float* mod; int L; __device__ __forceinline__ void operator()(int, int row, int col, float v, float) const {
    const int j = row_j(row); const float g1 = mod[((size_t)(L * 9 + j) * 6 + 2) * 1024 + col]; X[(size_t)row * D + col] += g1 * v; } };
struct EPGlu { float* X; const float* mod; const float* bias; int L; __device__ __forceinline__ void operator()(int, int row, int col, float va, float vb) const {
    const int j = row_j(row); const float g1 = mod[((size_t)(L * 9 + j) * 6 + 2) * 1024 + col];
    const float o = (va + bias[col]) * sigmoidf_(vb + bias[1024 + col]); X[(size_t)row * D + col] += g1 * o; } };
struct EPSwiglu { float* HID; __device__ __forceinline__ void operator()(int g, int row, int col, float va, float vb) const { HID[((size_t)g * EROWS + row) * FF + col] = siluf_(va) * vb; } };
struct EPGate { float* Y; const float* gate; __device__ __forceinline__ void operator()(int g, int row, int col, float v, float) const { Y[((size_t)g * EROWS + row) * D + col] = gate[g * EROWS + row] * v; } };

__global__ void __launch_bounds__(512, 2) fwd(Args args) {
    extern __shared__ __attribute__((aligned(16))) unsigned char lds[];
    Ctx c; c.in = args.in; c.out = args.out; c.ws = args.ws;
    c.wave = __builtin_amdgcn_readfirstlane((int)threadIdx.x >> 6); c.lane = lane_id(); c.tid = c.wave * 64 + c.lane;
    c.gw = blockIdx.x * 8 + c.wave; c.ngw = gridDim.x * 8; c.gt = blockIdx.x * 512 + c.tid; c.ngt = gridDim.x * 512;
    LAS float* ldsf = (LAS float*)lds; LAS unsigned char* ldsb = (LAS unsigned char*)lds;
    volatile LAS unsigned* MISC = (volatile LAS unsigned*)((LAS unsigned char*)lds + MISC_OFF);
    if (c.tid < 32) MISC[c.tid] = 0u;
    __syncthreads();
    const int lo = args.ph_lo, hi = args.ph_hi;
    const bool one_launch = (hi - lo) > 1;
    XcdBarrier bar; bar.bar = (unsigned*)(c.ws + WS_CTL) + CW_BAR; bar.x = 0; bar.st = MISC + 8; bar.wave = c.wave;
    if (one_launch) bar = xcd_barrier_post((unsigned*)(c.ws + WS_CTL) + CW_BAR, MISC + 8);
#define IN(k) (lo <= (k) && (k) < hi)
#define SEAM(k) do { if ((k) + 1 < hi) xcd_barrier(bar); } while (0)
#define FRESH(cc) Ctx cc; unsigned zq; asm volatile("s_mov_b32 %0, 0" : "=s"(zq)); cc.ws = c.ws + zq; cc.out = c.out + zq; cc.in = (const float* const*)((const char*)c.in + zq); \
    { int lq = lane_id(); asm volatile("" : "+v"(lq)); cc.wave = c.wave + (int)zq; cc.lane = lq; cc.tid = cc.wave * 64 + lq; const int tq = cc.tid; cc.gw = blockIdx.x * 8 + cc.wave; cc.ngw = gridDim.x * 8; cc.gt = blockIdx.x * 512 + tq; cc.ngt = gridDim.x * 512; } \
    const int Lq = L + (int)zq, iq = Lq >> 1; const float* MOD = (const float*)(cc.ws + WS_MOD); (void)MOD; (void)iq

    if (IN(PH_PRO)) { const int L = 0; FRESH(cc); phase_pro(cc, ldsf); __syncthreads(); phase_s5_ops(cc, ldsf); __syncthreads(); phase_cvt_moe(cc, ldsf); SEAM(PH_PRO); }

#define LAYER_BODY(LL) { constexpr int L = LL; \
        const int pb = 1 + L * PH_PER_LAYER; \
        if (IN(pb + 0)) { FRESH(cc); phase_norm1<false, (L & 1) != 0>(cc, Lq); SEAM(pb + 0); } \
        if ((L & 1) == 0) { \
            if (IN(pb + 1)) { \
                FRESH(cc); \
                pg8::GOrder S; S.init(1, NROWS, INW, (int)gridDim.x, (int)blockIdx.x); \
                pg8::ADense al{(const pg8::bf16_t*)(cc.ws + WS_HB1), 0, nullptr, 0, D, 0, 64}; pg8::EpiBf16 ep{(pg8::bf16_t*)(cc.ws + WS_P), INW}; \
                pg8::gemm_phase(ldsb, al, (const pg8::bf16_t*)(cc.ws + WS_WIN) + (size_t)iq * INW * D, 0, D, S, ep, cc.wave); SEAM(pb + 1); } \
            if (IN(pb + 2)) { FRESH(cc); phase_post(cc, iq, ldsb); SEAM(pb + 2); } \
            if (IN(pb + 4)) { FRESH(cc); phase_ret_prefix(cc, iq); \
                  \
                unsigned* cnt = (unsigned*)(cc.ws + WS_CTL) + CW_CNT + 64 * L; \
                asm volatile("s_waitcnt vmcnt(0)" ::: "memory"); __syncthreads(); \
                if (cc.tid == 0) { __builtin_amdgcn_fence(__ATOMIC_RELEASE, "agent"); asm volatile("s_waitcnt vmcnt(0)" ::: "memory"); (void)xb_add(cnt, 1u); } \
                phase_attention(cc, (char*)lds); \
                if (cc.tid == 0) { unsigned* tb = (unsigned*)(cc.ws + WS_CTL) + CW_BAR; XB_SPIN(xb_ld(cnt) < gridDim.x, tb); __builtin_amdgcn_fence(__ATOMIC_ACQUIRE, "agent"); asm volatile("s_waitcnt vmcnt(0)" ::: "memory"); } \
                __syncthreads(); \
                phase_ret_main(cc, iq, ldsb); SEAM(pb + 4); } \
            if (IN(pb + 6)) { \
                FRESH(cc); \
                pg8::GOrder S; S.init(1, NROWS, D, (int)gridDim.x, (int)blockIdx.x); \
                pg8::ADense al{(const pg8::bf16_t*)(cc.ws + WS_MIX), 0, nullptr, 0, D, 0, 64}; pg8::EpiResid ep{(pg8::bf16_t*)(cc.ws + WS_X), MOD + (size_t)Lq * 9 * 6144}; \
                pg8::gemm_phase(ldsb, al, (const pg8::bf16_t*)(cc.ws + WS_WOUT) + (size_t)iq * D * D, 0, D, S, ep, cc.wave); SEAM(pb + 6); } \
        } else { \
            if (IN(pb + 1)) { \
                FRESH(cc); \
                pg8::GOrder S; S.init(64, 1280, 256, (int)gridDim.x, (int)blockIdx.x); \
                pg8::ADense al{(const pg8::bf16_t*)(cc.ws + WS_AS5), (size_t)1280 * 768, nullptr, 0, 768, 0, 64}; pg8::EpiF32 ep{(float*)(cc.ws + WS_SL), 256, (size_t)1280 * 256}; \
                pg8::gemm_phase(ldsb, al, (const pg8::bf16_t*)(cc.ws + WS_WS5) + (size_t)iq * 64 * 256 * 512, (size_t)256 * 512, 512, S, ep, cc.wave); SEAM(pb + 1); } \
            if (IN(pb + 2)) { FRESH(cc); phase_s5_carry(cc, iq); SEAM(pb + 2); } \
            if (IN(pb + 3)) { \
                FRESH(cc); \
                pg8::GOrder S; S.init(64, 1280, 512, (int)gridDim.x, (int)blockIdx.x); \
                pg8::ADense al{(const pg8::bf16_t*)(cc.ws + WS_AS5), (size_t)1280 * 768, nullptr, 0, 768, 0, 64}; pg8::EpiGeluBf16 ep{(pg8::bf16_t*)(cc.ws + WS_ZG), 512, (size_t)1280 * 512}; \
                pg8::gemm_phase(ldsb, al, (const pg8::bf16_t*)(cc.ws + WS_TV) + (size_t)iq * 64 * 512 * 768, (size_t)512 * 768, 768, S, ep, cc.wave); SEAM(pb + 3); } \
            if (IN(pb + 4)) { \
                FRESH(cc); \
                pg8::GOrder S; S.init(1, NROWS, 2048, (int)gridDim.x, (int)blockIdx.x, L == DEPTH - 1); \
                pg8::ADense al{(const pg8::bf16_t*)(cc.ws + WS_ZG), 0, nullptr, 0, 16, 1280 * 512, (size_t)4 * 1280 * 512}; pg8::EpiGluResid ep{(pg8::bf16_t*)(cc.ws + WS_X), MOD + (size_t)Lq * 9 * 6144, cc.in[IN_GLUB] + (size_t)iq * 2048}; \
                pg8::gemm_phase(ldsb, al, (const pg8::bf16_t*)(cc.ws + WS_WGLU) + (size_t)iq * 2048 * D, 0, D, S, ep, cc.wave); SEAM(pb + 4); } \
        } \
        if (IN(pb + 7)) { FRESH(cc); phase_norm2_router<L == DEPTH - 1>(cc, Lq, ldsf); SEAM(pb + 7); } \
        if (IN(pb + 8)) { FRESH(cc); phase_topk(cc, (LAS unsigned*)lds, L == DEPTH - 1 ? 128 : 256); SEAM(pb + 8); } \
        if (IN(pb + 9)) { \
            FRESH(cc); \
            pg8::GOrder S; S.init(NE, L == DEPTH - 1 ? NB * CAP_LAT : EROWS, 2 * FF, (int)gridDim.x, (int)blockIdx.x); \
            pg8::ADense al{(const pg8::bf16_t*)(cc.ws + WS_XS), (size_t)EROWS * D, nullptr, 0, D, 0, 128}; \
            pg8::EpiSwiglu ep{(unsigned char*)(cc.ws + WS_HID), FF, (size_t)EROWS * FF}; \
            pg8::gemm_phase<true>(ldsb, al, (const unsigned char*)(cc.ws + WS_W13) + (size_t)Lq * NE * 4096 * D, (size_t)4096 * D, D, S, ep, cc.wave); SEAM(pb + 9); } \
        if (IN(pb + 10)) { \
            FRESH(cc); \
            pg8::GOrder S; S.init(NE, L == DEPTH - 1 ? NB * CAP_LAT : EROWS, D, (int)gridDim.x, (int)blockIdx.x); \
            pg8::ADense al{(const pg8::bf16_t*)(cc.ws + WS_HID), (size_t)EROWS * FF, nullptr, 0, FF, 0, 128}; \
            pg8::EpiGate ep{(unsigned char*)(cc.ws + WS_Y), D, (size_t)EROWS * D, (const float*)(cc.ws + WS_SELGATE), EROWS}; \
            pg8::gemm_phase<true>(ldsb, al, (const unsigned char*)(cc.ws + WS_W2) + (size_t)Lq * NE * D * FF, (size_t)D * FF, FF, S, ep, cc.wave); SEAM(pb + 10); } \
    }
    LAYER_BODY(0) LAYER_BODY(1) LAYER_BODY(2) LAYER_BODY(3)
#undef LAYER_BODY
    if (IN(PH_FIN)) { const int L = DEPTH; FRESH(cc); phase_norm1<true, false>(cc, DEPTH); }
#undef IN
#undef SEAM
}

static bool phase_valid(int ph) {
    if (ph == PH_PRO || ph == PH_FIN) return true;
    const int L = (ph - 1) / PH_PER_LAYER, k = (ph - 1) % PH_PER_LAYER;
    if (L & 1) return !(k >= 5 && k <= 6);
    return k != 3 && k != 5;
}
extern "C" void kernel_launch(void* const* d_in, const int* in_sizes, int n_in, void* d_out, int out_size, void* d_ws, size_t ws_size, hipStream_t stream) {
    static int grid = 0;
    if (grid == 0) {
        if (n_in != 27 || out_size != NB * T * D || ws_size < WS_END) { fprintf(stderr, "kernel_launch: unexpected shapes (n_in %d out %d ws %zu)\n", n_in, out_size, ws_size); grid = -1; return; }
        int dev = 0, cus = 0;
        if (hipGetDevice(&dev) != hipSuccess || hipDeviceGetAttribute(&cus, hipDeviceAttributeMultiprocessorCount, dev) != hipSuccess) { grid = -1; return; }
        if (hipFuncSetAttribute((const void*)fwd, hipFuncAttributeMaxDynamicSharedMemorySize, LDS_BYTES) != hipSuccess) { grid = -1; return; }
        int per_cu = 0;
        if (hipOccupancyMaxActiveBlocksPerMultiprocessor(&per_cu, (const void*)fwd, 512, LDS_BYTES) != hipSuccess || per_cu < 1) fprintf(stderr, "kernel_launch: occupancy query says %d\n", per_cu);
        (void)hipGetLastError();
        grid = cus;
    }
    if (grid < 0) return;
    if (hipMemsetAsync((char*)d_ws + WS_CTL, 0, CTL_ZERO_BYTES, stream) != hipSuccess) return;
    Args a{};
    for (int i = 0; i < 27; ++i) a.in[i] = (const float*)d_in[i];
    a.out = (float*)d_out; a.ws = (unsigned char*)d_ws;
#if MK_MULTI
    for (int ph = 0; ph < NPH; ++ph) {
        if (!phase_valid(ph)) continue;
        a.ph_lo = ph; a.ph_hi = ph + 1;
        hipLaunchKernelGGL(fwd, dim3(grid), dim3(512), LDS_BYTES, stream, a);
    }
#else
    a.ph_lo = 0; a.ph_hi = NPH;
    hipLaunchKernelGGL(fwd, dim3(grid), dim3(512), LDS_BYTES, stream, a);
#ifdef PROBE_PHASES
    { static const int probe[] = {PROBE_PHASES}; for (unsigned q = 0; q < sizeof(probe) / sizeof(probe[0]); ++q) { a.ph_lo = probe[q]; a.ph_hi = probe[q] + 1; hipLaunchKernelGGL(fwd, dim3(grid), dim3(512), LDS_BYTES, stream, a); } }
#endif
#endif
}
```

```cpp
#include <hip/hip_runtime.h>
#include <hip/hip_bf16.h>
#include <cstdio>
#include <cstdint>

#define GAS __attribute__((address_space(1)))
#define LAS __attribute__((address_space(3)))
typedef float f32x4 __attribute__((ext_vector_type(4)));
typedef float f32x16 __attribute__((ext_vector_type(16)));

constexpr int NB = 8, T = 4096, D = 1024, CL = 256, RB = CL + T  , NROWS = NB * RB  ;
constexpr int DEPTH = 4, NE = 16, FF = 2048, INW = 2816;
constexpr int CAP_LAT = 512, CAP_CTX = 32, EROWS = NB * (CAP_LAT + CAP_CTX)  ;
constexpr float EPS = 1e-6f;
#ifndef MK_MULTI
#define MK_MULTI 0
#endif

constexpr size_t MiB = 1u << 20;
constexpr size_t WS_CTL = 0, CTL_ZERO_BYTES = 1 * MiB;
constexpr size_t WS_MOD = 1 * MiB;
constexpr size_t WS_ROPE = 2 * MiB;
constexpr size_t WS_SELROW = 3 * MiB;
constexpr size_t WS_SELGATE = 3 * MiB + 512 * 1024;
constexpr size_t WS_AFF = 4 * MiB;
constexpr size_t WS_SLOT = 7 * MiB;
constexpr size_t WS_X = 10 * MiB;
constexpr size_t WS_TV = 146 * MiB;
constexpr size_t WS_WS5 = 242 * MiB;
constexpr size_t WS_HB = 282 * MiB;
constexpr size_t WS_W13 = 350 * MiB;
constexpr size_t WS_W2 = 862 * MiB;
constexpr size_t WS_WIN = 1118 * MiB;
constexpr size_t WS_WOUT = 1130 * MiB;
constexpr size_t WS_WGLU = 1134 * MiB;
constexpr size_t WS_HB1 = 1144 * MiB;
constexpr size_t WS_BIG = 1212 * MiB;
constexpr size_t WS_P = WS_BIG;
constexpr size_t WS_RQ = WS_BIG + 374 * MiB;
constexpr size_t WS_RK = WS_BIG + 408 * MiB;
constexpr size_t WS_RV = WS_BIG + 442 * MiB;
constexpr size_t WS_ET = WS_BIG + 476 * MiB;
constexpr size_t WS_MIX = WS_BIG + 510 * MiB;
constexpr size_t WS_QA = WS_BIG + 578 * MiB;
constexpr size_t WS_KA = WS_BIG + 612 * MiB;
constexpr size_t WS_VA = WS_BIG + 621 * MiB;
constexpr size_t WS_U = WS_BIG + 630 * MiB;
constexpr size_t WS_AS5 = WS_BIG;
constexpr size_t WS_SL = WS_BIG + 120 * MiB;
constexpr size_t WS_ZG = WS_BIG + 200 * MiB;
constexpr size_t WS_HID = WS_BIG;
constexpr size_t WS_XS = WS_BIG + 136 * MiB;
constexpr size_t WS_Y = WS_BIG + 272 * MiB;
constexpr size_t WS_END = WS_BIG + 698 * MiB;
constexpr int CW_BAR = 4096, CW_CNT = 8192;

constexpr int LDS_BYTES = 147456;
constexpr int MISC_OFF = 131072 + 320;

constexpr int PH_PRO = 0, PH_PER_LAYER = 11, PH_FIN = 1 + DEPTH * PH_PER_LAYER, NPH = PH_FIN + 1;

#define XB_TMO      128
#define XB_XCNT(j)  (256  + 64 * (j))
#define XB_XSUB(j)  (1280 + 64 * (j))
#define XB_XGEN(j)  (2304 + 64 * (j))
#define XB_TOP      3328
#define XB_TOPGEN   3392
#define XCD_BAR_WORDS 3456
#define XB_SPIN_CAP (1u << 22)

__device__ __forceinline__ unsigned xb_ld(unsigned* p)              { return __hip_atomic_load(p, __ATOMIC_RELAXED, __HIP_MEMORY_SCOPE_AGENT); }
__device__ __forceinline__ unsigned xb_add(unsigned* p, unsigned v) { return __hip_atomic_fetch_add(p, v, __ATOMIC_RELAXED, __HIP_MEMORY_SCOPE_AGENT); }
__device__ __forceinline__ unsigned xb_xcc_id() { return (unsigned)__builtin_amdgcn_s_getreg((3 << 11) | 20) & 0xFu; }
#define XB_SPIN(cond, bar) do { unsigned _sp = 0; while (cond) { __builtin_amdgcn_s_sleep(1); \
    if ((++_sp & 255u) == 0u) { if (xb_ld(&(bar)[XB_TMO])) break; if (_sp > XB_SPIN_CAP) { atomicAdd(&(bar)[XB_TMO], 1u); break; } } } } while (0)

__device__ __forceinline__ int lane_id() { int l; asm volatile("v_mbcnt_lo_u32_b32 %0, -1, 0\n\tv_mbcnt_hi_u32_b32 %0, -1, %0" : "=v"(l)); return l; }
struct XcdBarrier { unsigned* bar; unsigned x; volatile LAS unsigned* st; int wave; };

__device__ __forceinline__ XcdBarrier xcd_barrier_post(unsigned* bar, volatile LAS unsigned* st) {
    XcdBarrier b; b.bar = bar; b.x = xb_xcc_id(); b.st = st; b.wave = __builtin_amdgcn_readfirstlane((int)threadIdx.x >> 6);
    if (threadIdx.x == 0) (void)xb_add(&bar[XB_XCNT(b.x)], 1u);
    return b;
}
__device__ __forceinline__ void xcd_barrier_complete(unsigned* bar, unsigned x, unsigned& nloc, unsigned& nx) {
    const unsigned G = gridDim.x * gridDim.y * gridDim.z;
    unsigned sum, cnt, mine, sp = 0u;
    for (;;) {
        sum = 0u; cnt = 0u; mine = 0u;
#pragma unroll
        for (unsigned j = 0; j < 16; ++j) { const unsigned c = xb_ld(&bar[XB_XCNT(j)]); sum += c; cnt += (c > 0u) ? 1u : 0u; mine = (j == x) ? c : mine; }
        if (sum == G) break;
        __builtin_amdgcn_s_sleep(1);
        if ((++sp & 255u) == 0u) { if (xb_ld(&bar[XB_TMO])) break; if (sp > XB_SPIN_CAP) { atomicAdd(&bar[XB_TMO], 1u); break; } }
    }
    nloc = mine > 0u ? mine : 1u; nx = cnt > 0u ? cnt : 1u;
}
__device__ __forceinline__ void xcd_barrier(const XcdBarrier& b) {
    asm volatile("s_waitcnt vmcnt(0)" ::: "memory");
    __syncthreads();
    if (b.wave == 0 && lane_id() == 0) {
        unsigned* bar = b.bar;
        __builtin_amdgcn_s_waitcnt(0);
        unsigned nloc = b.st[0], nx = b.st[1];
        if (nloc == 0u) { xcd_barrier_complete(bar, b.x, nloc, nx); b.st[0] = nloc; b.st[1] = nx; }
        const unsigned old = xb_add(&bar[XB_XSUB(b.x)], 1u);
        const unsigned gen = old / nloc;
        if (old + 1u == (gen + 1u) * nloc) {
            __builtin_amdgcn_fence(__ATOMIC_RELEASE, "agent");
            asm volatile("s_waitcnt vmcnt(0)" ::: "memory");
            const unsigned og = xb_add(&bar[XB_TOP], 1u);
            const unsigned tg = og / nx;
            if (og + 1u == (tg + 1u) * nx) xb_add(&bar[XB_TOPGEN], 1u);
            else XB_SPIN(xb_ld(&bar[XB_TOPGEN]) == tg, bar);
            __builtin_amdgcn_fence(__ATOMIC_ACQUIRE, "agent");
            xb_add(&bar[XB_XGEN(b.x)], 1u);
            asm volatile("s_waitcnt vmcnt(0)" ::: "memory");
        } else {
            XB_SPIN(xb_ld(&bar[XB_XGEN(b.x)]) == gen, bar);
            __builtin_amdgcn_fence(__ATOMIC_ACQUIRE, "agent");
            asm volatile("s_waitcnt vmcnt(0)" ::: "memory");
        }
    }
    __syncthreads();
}

struct Args { const float* in[27]; float* out; unsigned char* ws; int ph_lo, ph_hi; };

struct Ctx {
    const float* const* in; float* out; unsigned char* ws;
    int tid, lane, wave, gw, ngw, gt, ngt;
};
enum { IN_X = 0, IN_C, IN_CTX, IN_CCTX, IN_MODW, IN_MODB, IN_NORMG, IN_MIXIN, IN_MIXOUT, IN_RETRATE, IN_RETGN, IN_QKG,
       IN_S5ARE, IN_S5AIM, IN_S5DT, IN_S5BRE, IN_S5BIM, IN_S5CRE, IN_S5CIM, IN_S5D, IN_GLUW, IN_GLUB, IN_ROUTER, IN_W1, IN_W3, IN_W2, IN_FNG };

__device__ __forceinline__ float wave_sum(float v) {
#pragma unroll
    for (int o = 1; o < 64; o <<= 1) v += __shfl_xor(v, o);
    return v;
}
__device__ __forceinline__ float sigmoidf_(float x) { return 1.0f / (1.0f + expf(-x)); }
__device__ __forceinline__ float siluf_(float x) { return x * sigmoidf_(x); }
__device__ __forceinline__ float gelu_tanh(float x) { const float u = 0.7978845608028654f * (x + 0.044715f * x * x * x); return 0.5f * x * (1.0f + tanhf(u)); }
__device__ __forceinline__ const float* modp(const Ctx& c, int L, int j, int chunk) { return (const float*)(c.ws + WS_MOD) + ((size_t)(L * 9 + j) * 6 + chunk) * 1024; }
__device__ __forceinline__ int row_j(int row) { const int b = row / RB, s = row - b * RB; return s < CL ? 8 : b; }

__device__ __forceinline__ float reduce16(const float (&v)[16], int lane) {
    float a[8], b[4], c2[2], d;
    const bool b5 = (lane & 32) != 0, b4 = (lane & 16) != 0, b3 = (lane & 8) != 0, b2 = (lane & 4) != 0;
#pragma unroll
    for (int i = 0; i < 8; ++i) { const float keep = b5 ? v[8 + i] : v[i], send = b5 ? v[i] : v[8 + i]; a[i] = keep + __shfl_xor(send, 32); }
#pragma unroll
    for (int i = 0; i < 4; ++i) { const float keep = b4 ? a[4 + i] : a[i], send = b4 ? a[i] : a[4 + i]; b[i] = keep + __shfl_xor(send, 16); }
#pragma unroll
    for (int i = 0; i < 2; ++i) { const float keep = b3 ? b[2 + i] : b[i], send = b3 ? b[i] : b[2 + i]; c2[i] = keep + __shfl_xor(send, 8); }
    { const float keep = b2 ? c2[1] : c2[0], send = b2 ? c2[0] : c2[1]; d = keep + __shfl_xor(send, 4); }
    d += __shfl_xor(d, 2); d += __shfl_xor(d, 1);
    return d;
}
__device__ __forceinline__ int reduce16_k(int lane) { return ((lane >> 5) & 1) * 8 + ((lane >> 4) & 1) * 4 + ((lane >> 3) & 1) * 2 + ((lane >> 2) & 1); }

namespace pg8 {
typedef unsigned short bf16_t;
typedef short bf16x8 __attribute__((ext_vector_type(8)));
typedef unsigned u32x4 __attribute__((ext_vector_type(4)));
typedef unsigned u32x2 __attribute__((ext_vector_type(2)));
typedef int v8i32 __attribute__((ext_vector_type(8)));
typedef int v4i32 __attribute__((ext_vector_type(4)));
constexpr int BM = 256, BK = 64, HALF = 128, HTB = HALF * BK * 2, STAGE_BYTES = 8 * HTB, NXCD = 8, WGM = 8;
__host__ __device__ __forceinline__ int lds_byte(int r, int c) { const int st = (r >> 4) * 2 + (c >> 5), rr = r & 15, cc = c & 31, ob = rr * 64 + cc * 2; return st * 1024 + (ob ^ (((ob >> 9) & 1) << 5)); }
__host__ __device__ __forceinline__ void stage_rc(int b, int& R, int& C) { const int st = b / 1024, sb = b % 1024, swz = sb ^ (((sb >> 9) & 1) << 5); R = (st >> 1) * 16 + swz / 64; C = (st & 1) * 32 + (swz % 64) / 2; }
__host__ __device__ __forceinline__ int perm32(int rho) { const int n = rho >> 4, i = rho & 15; return 8 * (i >> 2) + 4 * n + (i & 3); }
__device__ __forceinline__ unsigned cvt_pk_bf16(float lo, float hi) { unsigned r; asm volatile("v_cvt_pk_bf16_f32 %0, %1, %2" : "=v"(r) : "v"(lo), "v"(hi)); return r; }

__device__ __forceinline__ unsigned pk4_fp8(float a, float b, float c, float d) {
    a = __builtin_amdgcn_fmed3f(a, -448.f, 448.f); b = __builtin_amdgcn_fmed3f(b, -448.f, 448.f); c = __builtin_amdgcn_fmed3f(c, -448.f, 448.f); d = __builtin_amdgcn_fmed3f(d, -448.f, 448.f);
    unsigned w = 0u; w = (unsigned)__builtin_amdgcn_cvt_pk_fp8_f32(a, b, (int)w, false); w = (unsigned)__builtin_amdgcn_cvt_pk_fp8_f32(c, d, (int)w, true); return w; }
__device__ __forceinline__ f32x4 bf4_to_f32(u32x2 w) { return (f32x4){__uint_as_float(w.x << 16), __uint_as_float(w.x & 0xffff0000u), __uint_as_float(w.y << 16), __uint_as_float(w.y & 0xffff0000u)}; }
__device__ __forceinline__ u32x2 f32_to_bf4(f32x4 v) { return (u32x2){cvt_pk_bf16(v.x, v.y), cvt_pk_bf16(v.z, v.w)}; }
constexpr float W8_SCALE = 32.0f, W8_INV = 1.0f / 32.0f;
struct Unit { int pm, pn, g; };
struct GOrder {
    int nM, nN, per, nwg, G, c, skipctx;
    __device__ __forceinline__ void init(int groups, int M, int N, int G_, int c_, int skipctx_ = 0) { nM = M / BM; if (skipctx_) nM -= nM / 17; nN = N / BM; per = nM * nN; nwg = groups * per; G = G_; c = c_; skipctx = skipctx_; }
    __device__ __forceinline__ bool next(int i, Unit& u) const {
        const long L = (long)i * G + c; if (L >= nwg) return false;
        int wgid = (int)L; { const int q = nwg / NXCD, r = nwg % NXCD, xcd = wgid % NXCD, off = wgid / NXCD; wgid = (xcd < r ? xcd * (q + 1) : r * (q + 1) + (xcd - r) * q) + off; }
        u.g = wgid / per; const int w = wgid - u.g * per;
        const int nig = WGM * nN, gid = w / nig, fm = gid * WGM, gsz = (nM - fm) < WGM ? (nM - fm) : WGM;
        u.pm = fm + ((w % nig) % gsz); u.pn = (w % nig) / gsz; if (skipctx) u.pm += (u.pm >> 4) + 1;
        return true;
    }
};
struct ADense  { static constexpr bool GATHER = false; const bf16_t* A; size_t gstride; const int* idx; int rpg; unsigned rowpitch; unsigned cgrp; size_t kstep; };
struct AGather { static constexpr bool GATHER = true;  const bf16_t* A; size_t gstride; const int* idx; int rpg; unsigned rowpitch; unsigned cgrp; size_t kstep; };

template <bool FP8 = false, class Epi, class ALoc>
__device__ __forceinline__ void gemm_phase(LAS unsigned char* lds, const ALoc AL, const void* Bt, size_t gstrideB, int K, const GOrder& S, const Epi& E, int wave_) {
    constexpr bool GATHER = ALoc::GATHER; constexpr unsigned ESZ = FP8 ? 1u : 2u;
    const int wid = wave_, lane = lane_id(), tid = wid * 64 + lane, wr = wid >> 2, wc = wid & 3, fr = lane & 15, fq = lane >> 4;
    const int nt = (int)((unsigned)K * ESZ / 128u);
    unsigned voffA[2], voffB[2];
#pragma unroll
    for (int i = 0; i < 2; ++i) { int R, C; stage_rc(tid * 16 + i * 8192, R, C); const int Rb = Epi::PERM ? ((R & ~31) + perm32(R & 31)) : R;
        const unsigned cbytes = AL.cgrp ? ((unsigned)(C >> 4) * AL.cgrp + (unsigned)(C & 15)) * 2u : (unsigned)C * 2u;
        voffA[i] = (unsigned)R * AL.rowpitch * ESZ + cbytes; voffB[i] = (unsigned)Rb * (unsigned)K * ESZ + (unsigned)C * 2u; }
    const size_t kstep = 128, kstepA = AL.kstep * ESZ;
    const size_t hstep = (size_t)HALF * K * ESZ;
    const size_t hstepA = GATHER ? 0 : (size_t)HALF * AL.rowpitch * ESZ, tstepA = 2 * (size_t)HALF * AL.rowpitch * ESZ;
    const size_t tstep = 2 * hstep;
    const unsigned ldsw = (unsigned)wid * 1024u;
    const int aoff0 = FP8 ? lds_byte(wr * 64 + fr, 16 * fq) : lds_byte(wr * 64 + fr, fq * 8);
    const int boff0 = FP8 ? lds_byte(wc * 32 + fr, 16 * fq) : lds_byte(wc * 32 + fr, fq * 8);
    constexpr int KOFF = FP8 ? 16 : 1024;
    unsigned vAc[2][2], vAn[2][2];
#define PG8_SA(b, h) (((b) * 2 + (h)) * HTB)
#define PG8_SB(b, h) ((4 + (b) * 2 + (h)) * HTB)
#define PG8_SBR(b, h) (((b) * 2 + (h)) * HTB)
#define PG8_OPQ(x) do { if constexpr (FP8) asm volatile("" : "+v"(x)); } while (0)
#define PG8_STAGE(bufoff, gbase, voff) do { _Pragma("unroll") for (int _i = 0; _i < 2; ++_i) { unsigned _o = (voff)[_i]; PG8_OPQ(_o); \
        __builtin_amdgcn_global_load_lds((const unsigned*)((const char*)(gbase) + _o), (LAS unsigned*)(lds + (bufoff) + ldsw + _i * 8192), 16, 0, 0); } } while (0)
#define PG8_STAGE_A(bufoff, gbase, h, nx) do { _Pragma("unroll") for (int _i = 0; _i < 2; ++_i) { \
        unsigned _o = GATHER ? ((nx) ? vAn[h][_i] : vAc[h][_i]) : voffA[_i]; PG8_OPQ(_o); \
        __builtin_amdgcn_global_load_lds((const unsigned*)((const char*)(gbase) + (size_t)(h) * hstepA + _o), (LAS unsigned*)(lds + (bufoff) + ldsw + _i * 8192), 16, 0, 0); } } while (0)
#define PG8_GIDX(u, v) do { if (GATHER) { int _t = tid; asm volatile("" : "+v"(_t));   \
        _Pragma("unroll") for (int _i = 0; _i < 2; ++_i) { int _R, _C; stage_rc(_t * 16 + _i * 8192, _R, _C); \
        _Pragma("unroll") for (int _h = 0; _h < 2; ++_h) v[_h][_i] = (unsigned)AL.idx[(u).g * AL.rpg + (u).pm * BM + _h * HALF + _R] * (AL.rowpitch * ESZ) + (unsigned)_C * 2u; } } } while (0)
#define PG8_ABASE(u) ((const char*)AL.A + (GATHER ? (size_t)0 : ((size_t)(u).g * AL.gstride * ESZ + (size_t)(u).pm * tstepA)))
#define PG8_BBASE(u) ((const char*)Bt + (size_t)(u).g * gstrideB * ESZ + (size_t)(u).pn * tstep)
#define PG8_LDA(dst, b, h) do { _Pragma("unroll") for (int m = 0; m < 4; ++m) _Pragma("unroll") for (int k = 0; k < 2; ++k) dst[m][k] = *(const LAS bf16x8*)(lds + PG8_SA(b, h) + aoff0 + k * KOFF + m * 2048); } while (0)
#define PG8_LDB(dst, b, h) do { _Pragma("unroll") for (int n = 0; n < 2; ++n) _Pragma("unroll") for (int k = 0; k < 2; ++k) dst[n][k] = *(const LAS bf16x8*)(lds + PG8_SB(b, h) + boff0 + k * KOFF + n * 2048); } while (0)
#define PG8_CAT8(x) __builtin_shufflevector(__builtin_bit_cast(v4i32, x[0]), __builtin_bit_cast(v4i32, x[1]), 0, 1, 2, 3, 4, 5, 6, 7)
#define PG8_MMA(ai, bj, At, Bt_) do { __builtin_amdgcn_s_setprio(1); _Pragma("unroll") for (int m = 0; m < 4; ++m) _Pragma("unroll") for (int n = 0; n < 2; ++n) { \
        if constexpr (FP8) acc[ai][bj][m][n] = __builtin_amdgcn_mfma_scale_f32_16x16x128_f8f6f4(PG8_CAT8(Bt_[n]), PG8_CAT8(At[m]), acc[ai][bj][m][n], 0, 0, 0, 0x7f7f7f7f, 0, 0x7f7f7f7f); \
        else { _Pragma("unroll") for (int k = 0; k < 2; ++k) acc[ai][bj][m][n] = __builtin_amdgcn_mfma_f32_16x16x32_bf16(Bt_[n][k], At[m][k], acc[ai][bj][m][n], 0, 0, 0); } } \
        __builtin_amdgcn_s_setprio(0); } while (0)
#define PG8_WAIT_V(n) asm volatile("s_waitcnt vmcnt(" #n ")" ::: "memory")
#define PG8_WAIT_L(n) asm volatile("s_waitcnt lgkmcnt(" #n ")" ::: "memory")
#define PG8_BAR __builtin_amdgcn_s_barrier()
#define PG8_SCHED __builtin_amdgcn_sched_barrier(0)
    Unit cur, nxt; int ui = 0;
    if (!S.next(0, cur)) return;
    PG8_GIDX(cur, vAc);
    f32x4 acc[2][2][4][2];
#pragma unroll
    for (int a = 0; a < 2; ++a)
#pragma unroll
        for (int b = 0; b < 2; ++b)
#pragma unroll
            for (int m = 0; m < 4; ++m)
#pragma unroll
                for (int n = 0; n < 2; ++n) acc[a][b][m][n] = (f32x4){0.f, 0.f, 0.f, 0.f};
    bf16x8 At[4][2], B0[2][2], B1[2][2];
    const char* cA = PG8_ABASE(cur); const char* cB = PG8_BBASE(cur);
    PG8_STAGE(PG8_SB(0, 0), cB, voffB); PG8_STAGE(PG8_SB(0, 1), cB + hstep, voffB); PG8_STAGE_A(PG8_SA(0, 0), cA, 0, false); PG8_STAGE_A(PG8_SA(0, 1), cA, 1, false);
    if (wr == 1) PG8_BAR;
    PG8_WAIT_V(2); PG8_BAR;
    PG8_STAGE(PG8_SB(1, 0), cB + kstep, voffB); PG8_STAGE_A(PG8_SA(1, 0), cA + kstepA, 0, false); PG8_STAGE(PG8_SB(1, 1), cB + hstep + kstep, voffB);
    PG8_WAIT_V(6); PG8_BAR;
    for (;;) {
        const bool has_next = S.next(ui + 1, nxt);
        if (GATHER) { if (has_next) { PG8_GIDX(nxt, vAn); } }
        const char* nA = has_next ? PG8_ABASE(nxt) : cA; const char* nB = has_next ? PG8_BBASE(nxt) : cB;
        for (int t = 0; t < nt; t += 2) {
            const bool last = (t == nt - 2), lastn = last && has_next;
            const char* a1 = cA + (size_t)(t + 1) * kstepA;
            const char* a2 = last ? nA : cA + (size_t)(t + 2) * kstepA; const char* b2 = last ? nB : cB + (size_t)(t + 2) * kstep;
            const char* a3 = a2 + kstepA; const char* b3 = b2 + kstep;
            PG8_LDB(B0, 0, 0); PG8_LDB(B1, 0, 1); PG8_SCHED; PG8_LDA(At, 0, 0); PG8_STAGE_A(PG8_SA(1, 1), a1, 1, false);
            PG8_WAIT_V(8); PG8_WAIT_L(0); PG8_BAR; PG8_MMA(0, 0, At, B0); PG8_MMA(0, 1, At, B1); PG8_BAR; PG8_SCHED;
            PG8_LDA(At, 0, 1); PG8_STAGE(PG8_SB(0, 0), b2, voffB); PG8_STAGE(PG8_SB(0, 1), b2 + hstep, voffB); PG8_STAGE_A(PG8_SA(0, 0), a2, 0, lastn);
            PG8_WAIT_V(8); PG8_WAIT_L(0); PG8_BAR; PG8_MMA(1, 0, At, B0); PG8_MMA(1, 1, At, B1); PG8_BAR; PG8_SCHED;
            PG8_LDB(B0, 1, 0); PG8_LDB(B1, 1, 1); PG8_SCHED; PG8_LDA(At, 1, 0); PG8_STAGE_A(PG8_SA(0, 1), a2, 1, lastn);
            PG8_WAIT_V(8); PG8_WAIT_L(0); PG8_BAR; PG8_MMA(0, 0, At, B0); PG8_MMA(0, 1, At, B1); PG8_BAR; PG8_SCHED;
            PG8_LDA(At, 1, 1); PG8_STAGE(PG8_SB(1, 0), b3, voffB); PG8_STAGE(PG8_SB(1, 1), b3 + hstep, voffB); PG8_STAGE_A(PG8_SA(1, 0), a3, 0, lastn);
            PG8_WAIT_V(8); PG8_WAIT_L(0); PG8_BAR; PG8_MMA(1, 0, At, B0); PG8_MMA(1, 1, At, B1); PG8_BAR; PG8_SCHED;
        }
        if (wr == 0) PG8_BAR;
        E(acc, cur, wr, wc, fr, fq);
        if (!has_next) break;
#pragma unroll
        for (int a = 0; a < 2; ++a)
#pragma unroll
            for (int b = 0; b < 2; ++b)
#pragma unroll
                for (int m = 0; m < 4; ++m)
#pragma unroll
                    for (int n = 0; n < 2; ++n) acc[a][b][m][n] = (f32x4){0.f, 0.f, 0.f, 0.f};
        cur = nxt; cA = nA; cB = nB; ++ui;
        if (GATHER) {
#pragma unroll
            for (int _h = 0; _h < 2; ++_h)
#pragma unroll
                for (int _i = 0; _i < 2; ++_i) vAc[_h][_i] = vAn[_h][_i]; }
        if (wr == 1) PG8_BAR;
    }
    PG8_WAIT_V(0);
    PG8_BAR;
#undef PG8_SA
#undef PG8_SB
#undef PG8_SBR
#undef PG8_STAGE
#undef PG8_OPQ
#undef PG8_STAGE_A
#undef PG8_GIDX
#undef PG8_ABASE
#undef PG8_BBASE
#undef PG8_LDA
#undef PG8_CAT8
#undef PG8_LDB
#undef PG8_MMA
#undef PG8_WAIT_V
#undef PG8_WAIT_L
#undef PG8_BAR
#undef PG8_SCHED
}

__device__ __forceinline__ float fast_sigmoid(float x) { return __builtin_amdgcn_rcpf(1.0f + __builtin_amdgcn_exp2f(-1.4426950408889634f * x)); }
struct EpiSwiglu {
    static constexpr bool PERM = true;
    unsigned char* O; int ldc; size_t gstride;
    __device__ __forceinline__ void operator()(const f32x4 (&acc)[2][2][4][2], const Unit& u, int wr, int wc, int fr, int fq) const {
        const int row0 = u.pm * BM + wr * 64 + fr, col0 = u.pn * HALF + wc * 32 + 8 * fq;
        unsigned char* base = O + (size_t)u.g * gstride;
#pragma unroll
        for (int ai = 0; ai < 2; ++ai)
#pragma unroll
            for (int m = 0; m < 4; ++m) { unsigned char* rowp = base + (size_t)(row0 + ai * HALF + m * 16) * ldc + col0;
                f32x4 o[2];
#pragma unroll
                for (int n = 0; n < 2; ++n) {
                    const f32x4 a = acc[ai][0][m][n] * W8_INV, b = acc[ai][1][m][n] * W8_INV, t = a * (-1.4426950408889634f);
                    f32x4 e; e.x = __builtin_amdgcn_exp2f(t.x); e.y = __builtin_amdgcn_exp2f(t.y); e.z = __builtin_amdgcn_exp2f(t.z); e.w = __builtin_amdgcn_exp2f(t.w);
                    e = e + 1.0f;
                    f32x4 r; r.x = __builtin_amdgcn_rcpf(e.x); r.y = __builtin_amdgcn_rcpf(e.y); r.z = __builtin_amdgcn_rcpf(e.z); r.w = __builtin_amdgcn_rcpf(e.w);
                    o[n] = (a * b) * r; }
                *(u32x2*)rowp = (u32x2){pk4_fp8(o[0].x, o[0].y, o[0].z, o[0].w), pk4_fp8(o[1].x, o[1].y, o[1].z, o[1].w)}; }
    }
};
struct EpiBf16 {
    static constexpr bool PERM = true;
    bf16_t* O; int ldc;
    __device__ __forceinline__ void operator()(const f32x4 (&acc)[2][2][4][2], const Unit& u, int wr, int wc, int fr, int fq) const {
        const int row0 = u.pm * BM + wr * 64 + fr, col0 = u.pn * BM + wc * 32 + 8 * fq;
#pragma unroll
        for (int ai = 0; ai < 2; ++ai)
#pragma unroll
            for (int m = 0; m < 4; ++m) { bf16_t* rowp = O + (size_t)(row0 + ai * HALF + m * 16) * ldc + col0;
#pragma unroll
                for (int bj = 0; bj < 2; ++bj) { const f32x4 v0 = acc[ai][bj][m][0], v1 = acc[ai][bj][m][1];
                    u32x4 w; w.x = cvt_pk_bf16(v0[0], v0[1]); w.y = cvt_pk_bf16(v0[2], v0[3]); w.z = cvt_pk_bf16(v1[0], v1[1]); w.w = cvt_pk_bf16(v1[2], v1[3]);
                    *(u32x4*)(rowp + bj * HALF) = w; } }
    }
};
struct EpiGeluBf16 {
    static constexpr bool PERM = true;
    bf16_t* O; int ldc; size_t gstride;
    __device__ __forceinline__ void operator()(const f32x4 (&acc)[2][2][4][2], const Unit& u, int wr, int wc, int fr, int fq) const {
        const int row0 = u.pm * BM + wr * 64 + fr, col0 = u.pn * BM + wc * 32 + 8 * fq;
        bf16_t* base = O + (size_t)u.g * gstride;
#pragma unroll
        for (int ai = 0; ai < 2; ++ai)
#pragma unroll
            for (int m = 0; m < 4; ++m) { bf16_t* rowp = base + (size_t)(row0 + ai * HALF + m * 16) * ldc + col0;
#pragma unroll
                for (int bj = 0; bj < 2; ++bj) { float o[8];
#pragma unroll
                    for (int n = 0; n < 2; ++n)
#pragma unroll
                        for (int q = 0; q < 4; ++q) { const float x = acc[ai][bj][m][n][q]; o[4 * n + q] = x * fast_sigmoid(1.5957691216057308f * (x + 0.044715f * x * x * x)); }
                    u32x4 w; w.x = cvt_pk_bf16(o[0], o[1]); w.y = cvt_pk_bf16(o[2], o[3]); w.z = cvt_pk_bf16(o[4], o[5]); w.w = cvt_pk_bf16(o[6], o[7]);
                    *(u32x4*)(rowp + bj * HALF) = w; } }
    }
};
constexpr float Y8_SCALE = 16.0f, Y8_INV = 1.0f / 16.0f;
struct EpiGate {
    static constexpr bool PERM = true;
    unsigned char* O; int ldc; size_t gstride; const float* gate; int rpg;
    __device__ __forceinline__ void operator()(const f32x4 (&acc)[2][2][4][2], const Unit& u, int wr, int wc, int fr, int fq) const {
        const int row0 = u.pm * BM + wr * 64 + fr, col0 = u.pn * BM + wc * 32 + 8 * fq;
        unsigned char* base = O + (size_t)u.g * gstride;
#pragma unroll
        for (int ai = 0; ai < 2; ++ai)
#pragma unroll
            for (int m = 0; m < 4; ++m) { const int row = row0 + ai * HALF + m * 16; const float gt = gate[u.g * rpg + row] * (W8_INV * Y8_SCALE); unsigned char* rowp = base + (size_t)row * ldc + col0;
#pragma unroll
                for (int bj = 0; bj < 2; ++bj) { const f32x4 v0 = acc[ai][bj][m][0] * gt, v1 = acc[ai][bj][m][1] * gt;
                    *(u32x2*)(rowp + bj * HALF) = (u32x2){pk4_fp8(v0[0], v0[1], v0[2], v0[3]), pk4_fp8(v1[0], v1[1], v1[2], v1[3])}; } }
    }
};
struct EpiF32 {
    static constexpr bool PERM = false;
    float* C; int ldc; size_t gstride;
    __device__ __forceinline__ void operator()(const f32x4 (&acc)[2][2][4][2], const Unit& u, int wr, int wc, int fr, int fq) const {
        const int row0 = u.pm * BM + wr * 64 + fr, col0 = u.pn * BM + wc * 32 + 4 * fq;
#pragma unroll
        for (int ai = 0; ai < 2; ++ai)
#pragma unroll
            for (int m = 0; m < 4; ++m) { float* rowp = C + (size_t)u.g * gstride + (size_t)(row0 + ai * HALF + m * 16) * ldc + col0;
#pragma unroll
                for (int bj = 0; bj < 2; ++bj)
#pragma unroll
                    for (int n = 0; n < 2; ++n) *(f32x4*)(rowp + bj * HALF + n * 16) = acc[ai][bj][m][n]; }
    }
};
struct EpiResid {
    static constexpr bool PERM = true;
    bf16_t* X; const float* modL;
    __device__ __forceinline__ void operator()(const f32x4 (&acc)[2][2][4][2], const Unit& u, int wr, int wc, int fr, int fq) const {
        const int row0 = u.pm * BM + wr * 64 + fr, col0 = u.pn * BM + wc * 32 + 8 * fq;
        const int b = u.pm / 17, j = (u.pm - b * 17 == 0) ? 8 : b;
        const float* g1 = modL + (size_t)(j * 6 + 2) * 1024 + col0;
        f32x4 gv[2][2];
#pragma unroll
        for (int bj = 0; bj < 2; ++bj)
#pragma unroll
            for (int n = 0; n < 2; ++n) gv[bj][n] = *(const f32x4*)(g1 + bj * HALF + n * 4);
#pragma unroll
        for (int ai = 0; ai < 2; ++ai)
#pragma unroll
            for (int m = 0; m < 4; ++m) { bf16_t* rowp = X + (size_t)(row0 + ai * HALF + m * 16) * D + col0;
#pragma unroll
                for (int bj = 0; bj < 2; ++bj) { u32x4* p = (u32x4*)(rowp + bj * HALF); const u32x4 w = *p;
                    const f32x4 x0 = bf4_to_f32((u32x2){w.x, w.y}) + gv[bj][0] * acc[ai][bj][m][0], x1 = bf4_to_f32((u32x2){w.z, w.w}) + gv[bj][1] * acc[ai][bj][m][1];
                    const u32x2 o0 = f32_to_bf4(x0), o1 = f32_to_bf4(x1); *p = (u32x4){o0.x, o0.y, o1.x, o1.y}; } }
    }
};
struct EpiGluResid {
    static constexpr bool PERM = true;
    bf16_t* X; const float* modL; const float* bias;
    __device__ __forceinline__ void operator()(const f32x4 (&acc)[2][2][4][2], const Unit& u, int wr, int wc, int fr, int fq) const {
        const int row0 = u.pm * BM + wr * 64 + fr, col0 = u.pn * HALF + wc * 32 + 8 * fq;
        const int b = u.pm / 17, j = (u.pm - b * 17 == 0) ? 8 : b;
        const float* g1 = modL + (size_t)(j * 6 + 2) * 1024 + col0;
        f32x4 gv[2], ba[2], bg[2];
#pragma unroll
        for (int n = 0; n < 2; ++n) { gv[n] = *(const f32x4*)(g1 + n * 4); ba[n] = *(const f32x4*)(bias + col0 + n * 4); bg[n] = *(const f32x4*)(bias + 1024 + col0 + n * 4); }
#pragma unroll
        for (int ai = 0; ai < 2; ++ai)
#pragma unroll
            for (int m = 0; m < 4; ++m) { u32x4* p = (u32x4*)(X + (size_t)(row0 + ai * HALF + m * 16) * D + col0); const u32x4 w = *p;
                f32x4 xo[2] = {bf4_to_f32((u32x2){w.x, w.y}), bf4_to_f32((u32x2){w.z, w.w})};
#pragma unroll
                for (int n = 0; n < 2; ++n) { const f32x4 a = acc[ai][0][m][n] + ba[n], g = acc[ai][1][m][n] + bg[n];
                    f32x4 o; o.x = a.x * fast_sigmoid(g.x); o.y = a.y * fast_sigmoid(g.y); o.z = a.z * fast_sigmoid(g.z); o.w = a.w * fast_sigmoid(g.w);
                    xo[n] = xo[n] + gv[n] * o; }
                const u32x2 o0 = f32_to_bf4(xo[0]), o1 = f32_to_bf4(xo[1]); *p = (u32x4){o0.x, o0.y, o1.x, o1.y}; }
    }
};
}

namespace attn_body {
using bf16=__hip_bfloat16;
using bf16x8=__attribute__((ext_vector_type(8)))short;
using s16x4=__attribute__((ext_vector_type(4)))short;
using f32x16=__attribute__((ext_vector_type(16)))float;
using u32x4=__attribute__((ext_vector_type(4)))unsigned;
constexpr int D=64,QP=512,KP=128,OP=1024;
constexpr int NW=8,QBLK=32,QB=QBLK*NW,KVBLK=64;
__device__ __forceinline__ int crow(int r,int hi){return (r&3)+8*(r>>2)+4*hi;}
#define SBAR() __builtin_amdgcn_sched_barrier(0)
__device__ __forceinline__ void cmask(f32x16&p0,f32x16&p1,int jb,int qrel,int hi){
  const float NEG=-INFINITY; int kb=64*jb+4*hi;
  #pragma unroll
  for(int r=0;r<16;++r){int kv=kb+(r&3)+8*(r>>2); if(kv>qrel)p0[r]=NEG; if(kv+32>qrel)p1[r]=NEG;}
}

constexpr int NSLOT=3, SLOTB=8192;
constexpr int LDS_K=0, LDS_V=NSLOT*SLOTB, LDS_WS=2*NSLOT*SLOTB, LDS_OST=LDS_WS+NW*64*4, LDS_BYTES=LDS_OST+NW*4096;
constexpr float C2=0.125f*1.4426950408889634f;
__device__ __forceinline__ void glds16(const void*gsrc,unsigned lds_dst){unsigned keep;
  asm volatile("s_mov_b32 %0, m0\n\ts_mov_b32 m0, %2\n\ts_nop 0\n\tglobal_load_lds_dwordx4 %1, off\n\ts_mov_b32 m0, %0":"=&s"(keep):"v"(gsrc),"s"(lds_dst):"memory");}
__device__ __forceinline__ float max3f(float a,float b,float c){float r;asm("v_max3_f32 %0, %1, %2, %3":"=v"(r):"v"(a),"v"(b),"v"(c));return r;}
__device__ __forceinline__ float max2f(float a,float b){float r;asm("v_max_f32_e32 %0, %1, %2":"=v"(r):"v"(a),"v"(b));return r;}
__device__ __forceinline__ float fadd_s(float a,float b){float r;asm("v_add_f32_e32 %0, %1, %2":"=v"(r):"v"(a),"v"(b));return r;}
__device__ __forceinline__ float fsub_s(float a,float b){float r;asm("v_sub_f32_e32 %0, %1, %2":"=v"(r):"v"(a),"v"(b));return r;}
typedef float f32x2_t __attribute__((ext_vector_type(2))); typedef __bf16 bf16x2_t __attribute__((ext_vector_type(2)));
__device__ __forceinline__ unsigned cvtpk_s(float lo,float hi){f32x2_t v={lo,hi};bf16x2_t b=__builtin_convertvector(v,bf16x2_t);return __builtin_bit_cast(unsigned,b);}
#define WAIT_BAR(N) asm volatile("s_waitcnt vmcnt(" #N ") lgkmcnt(0)\n\ts_barrier":::"memory")

__device__ __forceinline__ void qkt(f32x16&p0,f32x16&p1,const char*Kslot,const bf16x8*qr,const f32x16&negm,int r32,int hi){
  const char*kb=Kslot+hi*1024+r32*16;
  #pragma unroll
  for(int d0=0;d0<4;++d0){
    const bf16x8 b0=*reinterpret_cast<const bf16x8*>(kb+d0*2048);
    const bf16x8 b1=*reinterpret_cast<const bf16x8*>(kb+d0*2048+512);
    if(d0==0){p0=__builtin_amdgcn_mfma_f32_32x32x16_bf16(b0,qr[0],negm,0,0,0);p1=__builtin_amdgcn_mfma_f32_32x32x16_bf16(b1,qr[0],negm,0,0,0);}
    else{p0=__builtin_amdgcn_mfma_f32_32x32x16_bf16(b0,qr[d0],p0,0,0,0);p1=__builtin_amdgcn_mfma_f32_32x32x16_bf16(b1,qr[d0],p1,0,0,0);}}
}
typedef __attribute__((address_space(3))) const char* lds_cptr;
typedef short v4i16_t __attribute__((ext_vector_type(4)));
__device__ __forceinline__ void kload8(bf16x8*kf,lds_cptr kp){
  kf[0]=*(const __attribute__((address_space(3))) bf16x8*)(kp);      kf[1]=*(const __attribute__((address_space(3))) bf16x8*)(kp+512);
  kf[2]=*(const __attribute__((address_space(3))) bf16x8*)(kp+2048); kf[3]=*(const __attribute__((address_space(3))) bf16x8*)(kp+2560);
  kf[4]=*(const __attribute__((address_space(3))) bf16x8*)(kp+4096); kf[5]=*(const __attribute__((address_space(3))) bf16x8*)(kp+4608);
  kf[6]=*(const __attribute__((address_space(3))) bf16x8*)(kp+6144); kf[7]=*(const __attribute__((address_space(3))) bf16x8*)(kp+6656);
}
__device__ __forceinline__ void kload2(bf16x8*kf,lds_cptr kp,int j){ kf[2*j]=*(const __attribute__((address_space(3))) bf16x8*)(kp+j*2048); kf[2*j+1]=*(const __attribute__((address_space(3))) bf16x8*)(kp+j*2048+512); }
__device__ __forceinline__ s16x4 vtr(lds_cptr p){ return __builtin_bit_cast(s16x4,__builtin_amdgcn_ds_read_tr16_b64_v4i16((__attribute__((address_space(3))) v4i16_t*)p)); }
__device__ __forceinline__ float rowmax(const f32x16&p0,const f32x16&p1){
  float a=max3f(p0[0],p0[1],p1[0]),b=max3f(p0[2],p0[3],p1[1]);a=max3f(a,p1[2],p1[3]);
  #pragma unroll
  for(int r=4;r<16;r+=4){a=max3f(a,p0[r],p0[r+1]);b=max3f(b,p0[r+2],p0[r+3]);a=max3f(a,p1[r],p1[r+1]);b=max3f(b,p1[r+2],p1[r+3]);}
  const float m=max2f(a,b);
  auto rr=__builtin_amdgcn_permlane32_swap(__float_as_uint(m),__float_as_uint(m),false,false);
  return max2f(__uint_as_float(rr[0]),__uint_as_float(rr[1]));
}
__device__ __forceinline__ void pv(f32x16*o,int vb,bf16x8 pa0,bf16x8 pa1,bf16x8 pa2,bf16x8 pa3){
  #pragma unroll
  for(int d0=0;d0<2;++d0){s16x4 lo[4],hi[4];
    #pragma unroll
    for(int ks=0;ks<4;++ks){
      asm volatile("ds_read_b64_tr_b16 %0,%1 offset:%c2":"=&v"(lo[ks]):"v"(vb),"i"(d0*4096+ks*1024):"memory");
      asm volatile("ds_read_b64_tr_b16 %0,%1 offset:%c2":"=&v"(hi[ks]):"v"(vb),"i"(d0*4096+ks*1024+512):"memory");}
    asm volatile("s_waitcnt lgkmcnt(0)":::"memory");SBAR();
    #define PK(k) (bf16x8){lo[k][0],lo[k][1],lo[k][2],lo[k][3],hi[k][0],hi[k][1],hi[k][2],hi[k][3]}
    o[d0]=__builtin_amdgcn_mfma_f32_32x32x16_bf16(pa0,PK(0),o[d0],0,0,0);
    o[d0]=__builtin_amdgcn_mfma_f32_32x32x16_bf16(pa1,PK(1),o[d0],0,0,0);
    o[d0]=__builtin_amdgcn_mfma_f32_32x32x16_bf16(pa2,PK(2),o[d0],0,0,0);
    o[d0]=__builtin_amdgcn_mfma_f32_32x32x16_bf16(pa3,PK(3),o[d0],0,0,0);
    #undef PK
  }
}

#ifndef ATTN_STORE16
#define ATTN_STORE16(p,v) (*(u32x4*)(p)=(v))
#endif
template<int THRL> __device__ __forceinline__ void attn_unit(const bf16*Qw0,const bf16*Kh,const bf16*Vh,bf16*Ow0,const int NT,char*shm,const int wid){
  const int lane=lane_id(),r32=lane&31,hi=lane>>5;
  const bf16*Qw=Qw0+(long)(wid*QBLK)*QP;
  const unsigned lds0=(unsigned)(uintptr_t)shm;
  float*wsf=(float*)(shm+LDS_WS)+wid*64;
  const bf16*ksrc=Kh+(long)lane*KP+wid*8;
  const bf16*vsrc=Vh+(long)(16*(wid&3)+(lane>>2))*KP+(wid>>2)*32+(lane&3)*8;
  const unsigned kdst=lds0+LDS_K+wid*1024, vdst=lds0+LDS_V+wid*1024;
  #define DMA_K(t,slot) glds16(ksrc+(long)(t)*KVBLK*KP,(unsigned)__builtin_amdgcn_readfirstlane(kdst+(slot)))
  #define DMA_V(t,slot) glds16(vsrc+(long)(t)*KVBLK*KP,(unsigned)__builtin_amdgcn_readfirstlane(vdst+(slot)))
  const int vb0=(int)(lds0+LDS_V)+((lane>>4)&1)*32+(lane&3)*8+(4*hi+((lane&15)>>2))*64;
  const char*Kbase=shm+LDS_K; bf16x8 kf[8];
  const lds_cptr shm3=(lds_cptr)shm; const lds_cptr kp0=shm3+LDS_K+hi*1024+r32*16; const lds_cptr vp0=shm3+LDS_V+((lane>>4)&1)*32+(lane&3)*8+(4*hi+((lane&15)>>2))*64;
  DMA_K(0,0);DMA_V(0,0);DMA_K(1,SLOTB);
  bf16x8 qr[4];
  #pragma unroll
  for(int d0=0;d0<4;++d0)qr[d0]=*reinterpret_cast<const bf16x8*>(&Qw[(long)r32*QP+d0*16+hi*8]);
  float mhat=0.f,l_reg=0.f;f32x16 o[2];o[0]=f32x16{};o[1]=f32x16{};f32x16 negm=f32x16{};asm volatile("":"+v"(negm));
  #define CMASK(P0,P1,t) do{}while(0)
  bool resc=false;
  #define START(P0,P1) do{ const float rm=rowmax(P0,P1); resc=false; \
    { const float dl=rm; mhat=fadd_s(mhat,dl); \
      _Pragma("unroll") for(int r=0;r<16;++r){P0[r]=fsub_s(P0[r],dl);P1[r]=fsub_s(P1[r],dl);} \
      _Pragma("unroll") for(int r=0;r<16;++r)negm[r]=-mhat; asm volatile("":"+v"(negm)); } \
    _Pragma("unroll") for(int r=0;r<16;++r)P0[r]=__builtin_amdgcn_exp2f(P0[r]); }while(0)
  #define RESC() do{ if(resc){ asm volatile("s_waitcnt lgkmcnt(0)":::"memory"); \
      _Pragma("unroll") for(int d_=0;d_<2;++d_) _Pragma("unroll") for(int r=0;r<16;++r)o[d_][r]*=wsf[crow(r,hi)]; } }while(0)
  f32x16 pA0,pA1,pB0,pB1;
  int sl_prev=0,sl_cur=0,sl_next=SLOTB;
  #define ROT() do{sl_prev=sl_cur;sl_cur=sl_next;sl_next=(sl_next==(NSLOT-1)*SLOTB)?0:sl_next+SLOTB;}while(0)
  DMA_K(2,2*SLOTB);
  WAIT_BAR(3);
  qkt(pA0,pA1,Kbase,qr,negm,r32,hi);asm volatile("s_nop 15\n\ts_nop 7":"+v"(pA0),"+v"(pA1));CMASK(pA0,pA1,0);
  START(pA0,pA1);
  _Pragma("unroll") for(int r=0;r<16;++r)pA1[r]=__builtin_amdgcn_exp2f(pA1[r]);
  WAIT_BAR(0);
  DMA_K(3,0);DMA_V(1,SLOTB);
  ROT();
  kload8(kf,kp0+sl_cur);
  WAIT_BAR(2);
  s16x4 vlo[8],vhi[8]; u32x4 pw0,pw1,pw2,pw3;
  #define PKW(P,B) cvtpk_s(P[B],P[B+1])
  #define PAF(k) __builtin_bit_cast(bf16x8,pw##k)
  #define VFR(i) (bf16x8){vlo[i][0],vlo[i][1],vlo[i][2],vlo[i][3],vhi[i][0],vhi[i][1],vhi[i][2],vhi[i][3]}
  #define PIN(x) asm volatile("":"+v"(x))
  #define MX3(a,b,c) __builtin_fmaxf(__builtin_fmaxf((a),(b)),(c))
  #define GAPA(MF,A0,A1,A2,A3,W0,W1,PW) do{ MF; sacc+=A0; sacc+=A1; sacc+=A2; sacc+=A3; PIN(sacc); W0; W1; PIN(PW); SBAR(); }while(0)
  #define EX(v) __builtin_amdgcn_exp2f(v)
  #define GAPB(MF,X,B) do{ MF; X[B]=EX(X[B]); X[B+1]=EX(X[B+1]); X[B+2]=EX(X[B+2]); X[B+3]=EX(X[B+3]); PIN(X); SBAR(); }while(0)
  #define VRD(i) do{ vlo[i]=vtr(vp_+(((i)>>2)*4096+((i)&3)*1024)); vhi[i]=vtr(vp_+(((i)>>2)*4096+((i)&3)*1024+512)); }while(0)
  #define KRD(G,j) do{ if(G){ kload2(kf,kp0+sl_next,j); SBAR(); } }while(0)
  #define STEP(C0,C1,P0,P1,t,GK,GV,GL) do{ SBAR(); \
    const lds_cptr vp_=vp0+sl_prev; \
    VRD(0); SBAR(); float sacc=(P0[0]+P0[1]); \
    GAPA(C0=__builtin_amdgcn_mfma_f32_32x32x16_bf16(kf[0],qr[0],negm,0,0,0), P0[2],P0[3],P0[4],P0[5],     pw0[0]=PKW(P0,0), pw0[1]=PKW(P0,2), pw0); \
    VRD(4); SBAR(); GAPA(C1=__builtin_amdgcn_mfma_f32_32x32x16_bf16(kf[1],qr[0],negm,0,0,0), P0[6],P0[7],P0[8],P0[9],     pw0[2]=PKW(P0,4), pw0[3]=PKW(P0,6), pw0); \
    VRD(1); SBAR(); GAPA(C0=__builtin_amdgcn_mfma_f32_32x32x16_bf16(kf[2],qr[1],C0,0,0,0),   P0[10],P0[11],P0[12],P0[13], pw1[0]=PKW(P0,8), pw1[1]=PKW(P0,10), pw1); \
    VRD(5); SBAR(); GAPA(C1=__builtin_amdgcn_mfma_f32_32x32x16_bf16(kf[3],qr[1],C1,0,0,0),   P0[14],P0[15],P1[0],P1[1],   pw1[2]=PKW(P0,12),pw1[3]=PKW(P0,14), pw1); \
    VRD(2); SBAR(); GAPA(C0=__builtin_amdgcn_mfma_f32_32x32x16_bf16(kf[4],qr[2],C0,0,0,0),   P1[2],P1[3],P1[4],P1[5],     pw2[0]=PKW(P1,0), pw2[1]=PKW(P1,2), pw2); \
    VRD(6); SBAR(); GAPA(C1=__builtin_amdgcn_mfma_f32_32x32x16_bf16(kf[5],qr[2],C1,0,0,0),   P1[6],P1[7],P1[8],P1[9],     pw2[2]=PKW(P1,4), pw2[3]=PKW(P1,6), pw2); \
    VRD(3); SBAR(); GAPA(C0=__builtin_amdgcn_mfma_f32_32x32x16_bf16(kf[6],qr[3],C0,0,0,0),   P1[10],P1[11],P1[12],P1[13], pw3[0]=PKW(P1,8), pw3[1]=PKW(P1,10), pw3); \
    VRD(7); SBAR(); GAPA(C1=__builtin_amdgcn_mfma_f32_32x32x16_bf16(kf[7],qr[3],C1,0,0,0),   P1[14],P1[15],0.f,0.f,       pw3[2]=PKW(P1,12),pw3[3]=PKW(P1,14), pw3); \
    l_reg+=sacc; \
    if(GK){DMA_K((t)+3,sl_cur);} if(GV){DMA_V((t)+1,sl_next);} \
    CMASK(C0,C1,t); \
    { float a=MX3(C0[0],C0[1],C1[0]),b=MX3(C0[2],C0[3],C1[1]); a=MX3(a,C1[2],C1[3]); \
      _Pragma("unroll") for(int r=4;r<16;r+=4){a=MX3(a,C0[r],C0[r+1]);b=MX3(b,C0[r+2],C0[r+3]);a=MX3(a,C1[r],C1[r+1]);b=MX3(b,C1[r+2],C1[r+3]);} \
      float rm=__builtin_fmaxf(a,b); { auto rr=__builtin_amdgcn_permlane32_swap(__float_as_uint(rm),__float_as_uint(rm),false,false); rm=__builtin_fmaxf(__uint_as_float(rr[0]),__uint_as_float(rr[1])); } \
      resc=false; \
      if(__builtin_expect(__any(rm>(float)THRL),0)){ const float dl=__builtin_fmaxf(rm,0.f); mhat+=dl; \
        _Pragma("unroll") for(int r=0;r<16;++r){C0[r]-=dl;C1[r]-=dl;} \
        _Pragma("unroll") for(int r=0;r<16;++r)negm[r]=-mhat; asm volatile("":"+v"(negm)); \
        const float f=__builtin_amdgcn_exp2f(-dl); l_reg*=f; if(hi==0)wsf[r32]=f; resc=true; } } \
    SBAR(); \
    GAPB(o[0]=__builtin_amdgcn_mfma_f32_32x32x16_bf16(PAF(0),VFR(0),o[0],0,0,0), C0,0); \
    GAPB(o[1]=__builtin_amdgcn_mfma_f32_32x32x16_bf16(PAF(0),VFR(4),o[1],0,0,0), C0,4); \
    KRD(GL,0); GAPB(o[0]=__builtin_amdgcn_mfma_f32_32x32x16_bf16(PAF(1),VFR(1),o[0],0,0,0), C0,8); \
    KRD(GL,1); GAPB(o[1]=__builtin_amdgcn_mfma_f32_32x32x16_bf16(PAF(1),VFR(5),o[1],0,0,0), C0,12); \
    KRD(GL,2); GAPB(o[0]=__builtin_amdgcn_mfma_f32_32x32x16_bf16(PAF(2),VFR(2),o[0],0,0,0), C1,0); \
    KRD(GL,3); GAPB(o[1]=__builtin_amdgcn_mfma_f32_32x32x16_bf16(PAF(2),VFR(6),o[1],0,0,0), C1,4); \
    GAPB(o[0]=__builtin_amdgcn_mfma_f32_32x32x16_bf16(PAF(3),VFR(3),o[0],0,0,0), C1,8); \
    GAPB(o[1]=__builtin_amdgcn_mfma_f32_32x32x16_bf16(PAF(3),VFR(7),o[1],0,0,0), C1,12); \
    }while(0)
  int t=1;
  #undef CMASK
  #define CMASK(P0,P1,t) do{}while(0)
  for(;t+5<NT;t+=2){
    STEP(pB0,pB1,pA0,pA1,t,true,true,true);     WAIT_BAR(2); RESC(); ROT();
    STEP(pA0,pA1,pB0,pB1,t+1,true,true,true);   WAIT_BAR(2); RESC(); ROT();
  }
  #undef CMASK
  #define CMASK(P0,P1,t) do{}while(0)
  #define ENDW(tt) do{ if((tt)+3<NT){WAIT_BAR(2);} else if((tt)+2<NT){WAIT_BAR(1);} else {WAIT_BAR(0);} }while(0)
  for(;t+1<NT;t+=2){
    STEP(pB0,pB1,pA0,pA1,t,(t+3<NT),(t+1<NT),(t+1<NT));       ENDW(t);   RESC(); ROT();
    STEP(pA0,pA1,pB0,pB1,t+1,(t+4<NT),(t+2<NT),(t+2<NT));     ENDW(t+1); RESC(); ROT();
  }
  STEP(pB0,pB1,pA0,pA1,NT-1,false,false,false); RESC();
  { float sacc=pB0[0]+pB0[1]; _Pragma("unroll") for(int r=2;r<16;++r)sacc+=pB0[r]; _Pragma("unroll") for(int r=0;r<16;++r)sacc+=pB1[r]; l_reg+=sacc;
    pw0=(u32x4){PKW(pB0,0),PKW(pB0,2),PKW(pB0,4),PKW(pB0,6)};pw1=(u32x4){PKW(pB0,8),PKW(pB0,10),PKW(pB0,12),PKW(pB0,14)};pw2=(u32x4){PKW(pB1,0),PKW(pB1,2),PKW(pB1,4),PKW(pB1,6)};pw3=(u32x4){PKW(pB1,8),PKW(pB1,10),PKW(pB1,12),PKW(pB1,14)};
    SBAR(); pv(o,vb0+sl_cur,PAF(0),PAF(1),PAF(2),PAF(3)); }
  #undef PKW
  #undef PAF
  #undef VFR
  #undef PIN
  #undef MX3
  #undef GAPA
  #undef GAPB
  #undef EX
  #undef VRD
  #undef KRD
  #undef STEP
  #undef ENDW
  {auto rr=__builtin_amdgcn_permlane32_swap(__float_as_uint(l_reg),__float_as_uint(l_reg),false,false);l_reg=__uint_as_float(rr[0])+__uint_as_float(rr[1]);}
  if(hi==0)wsf[32+r32]=l_reg;asm volatile("s_waitcnt lgkmcnt(0)":::"memory");
  float rli[16];
  #pragma unroll
  for(int r=0;r<16;++r)rli[r]=__builtin_amdgcn_rcpf(wsf[32+crow(r,hi)]);
  bf16*Ow=Ow0+(long)(wid*QBLK)*OP;
  { bf16*stg=(bf16*)(shm+LDS_OST)+wid*2048;
    #pragma unroll
    for(int r=0;r<16;++r){const int orow=crow(r,hi);
      #pragma unroll
      for(int d0=0;d0<2;++d0)stg[orow*64+d0*32+r32]=__float2bfloat16(o[d0][r]*rli[r]);}
    asm volatile("s_waitcnt lgkmcnt(0)":::"memory");
    #pragma unroll
    for(int i=0;i<4;++i){const int row=i*8+(lane>>3),ch=lane&7; const u32x4 v=*(const u32x4*)(stg+row*64+ch*8); ATTN_STORE16(Ow+(long)row*OP+ch*8,v);} }
  asm volatile("s_waitcnt lgkmcnt(0)\n\ts_barrier":::"memory");
  #undef DMA_K
  #undef DMA_V
  #undef CMASK
  #undef START
  #undef RESC
  #undef ROT
}
constexpr int ATTN_LDS_BYTES=LDS_BYTES;
#undef SBAR
#undef WAIT_BAR
}

template <bool PAIRED, class AL, class BL, class EP>
__device__ __forceinline__ void gemm_f32(int groups, int M, int N, int K, const AL& al, const BL& bl, const EP& ep) {
    const int tid = threadIdx.x, lane = tid & 63, wave = tid >> 6, wm = wave >> 2, wn = wave & 3, r32 = lane & 31, h = lane >> 5;
    constexpr int TN = PAIRED ? 128 : 256;
    const int tilesM = M / 128, tilesN = N / TN, per = tilesM * tilesN, total = groups * per;
    const int ldb = bl.ldb;
    for (int t = blockIdx.x; t < total; t += gridDim.x) {
        const int g = t / per, r = t - g * per, tm = r / tilesN, tn = r - tm * tilesN;
        const int m0 = tm * 128 + wm * 64;
        const int n0 = PAIRED ? (tn * 128 + wn * 32) : (tn * 256 + wn * 64);
        const float* a0 = al.row(g, m0 + r32) + 4 * h;
        const float* a1 = al.row(g, m0 + 32 + r32) + 4 * h;
        const float* b0 = bl.ptr(g, 0) + n0 + r32 + (size_t)(4 * h) * ldb;
        const float* b1 = (PAIRED ? bl.ptr(g, 1) + n0 : bl.ptr(g, 0) + n0 + 32) + r32 + (size_t)(4 * h) * ldb;
        f32x16 acc00 = {}, acc01 = {}, acc10 = {}, acc11 = {};
#pragma unroll 2
        for (int k = 0; k < K; k += 8) {
            const f32x4 av0 = *(const f32x4*)(a0 + k), av1 = *(const f32x4*)(a1 + k);
            float bv0[4], bv1[4];
#pragma unroll
            for (int s = 0; s < 4; ++s) { bv0[s] = b0[(size_t)(k + s) * ldb]; bv1[s] = b1[(size_t)(k + s) * ldb]; }
#pragma unroll
            for (int s = 0; s < 4; ++s) {
                acc00 = __builtin_amdgcn_mfma_f32_32x32x2f32(av0[s], bv0[s], acc00, 0, 0, 0);
                acc01 = __builtin_amdgcn_mfma_f32_32x32x2f32(av0[s], bv1[s], acc01, 0, 0, 0);
                acc10 = __builtin_amdgcn_mfma_f32_32x32x2f32(av1[s], bv0[s], acc10, 0, 0, 0);
                acc11 = __builtin_amdgcn_mfma_f32_32x32x2f32(av1[s], bv1[s], acc11, 0, 0, 0);
            }
        }
#pragma unroll
        for (int rr = 0; rr < 16; ++rr) {
            const int ro = (rr & 3) + 8 * (rr >> 2) + 4 * h;
            if (PAIRED) {
                ep(g, m0 + ro, n0 + r32, acc00[rr], acc01[rr]);
                ep(g, m0 + 32 + ro, n0 + r32, acc10[rr], acc11[rr]);
            } else {
                ep(g, m0 + ro, n0 + r32, acc00[rr], 0.f); ep(g, m0 + ro, n0 + 32 + r32, acc01[rr], 0.f);
                ep(g, m0 + 32 + ro, n0 + r32, acc10[rr], 0.f); ep(g, m0 + 32 + ro, n0 + 32 + r32, acc11[rr], 0.f);
            }
        }
    }
}

__device__ __forceinline__ void phase_pro(const Ctx& c, LAS float* ldsf) {
    float* rope = (float*)(c.ws + WS_ROPE);
    for (int i = c.gt; i < 64 * 16; i += c.ngt) {
        const int pos = i >> 4, fi = i & 15; const float inv = powf(10000.0f, -(float)fi / 16.0f), ang = (float)pos * inv;
        rope[2 * i] = cosf(ang); rope[2 * i + 1] = sinf(ang);
    }
    LAS float* sil = ldsf; LAS float* red = ldsf + 9 * 1024;
    for (int i = c.tid; i < 9 * 1024; i += 512) { const int j = i >> 10, k = i & 1023; const float v = (j < 8) ? c.in[IN_C][j * 1024 + k] : c.in[IN_CCTX][k]; sil[i] = siluf_(v); }
    __syncthreads();
    float* MOD = (float*)(c.ws + WS_MOD);
    for (int task = blockIdx.x; task < DEPTH * 96; task += gridDim.x) {
        const int L = task / 96, cb = task - L * 96, col = cb * 64 + c.lane;
        const float* W = c.in[IN_MODW] + (size_t)L * 1024 * 6144;
        float acc[9];
#pragma unroll
        for (int j = 0; j < 9; ++j) acc[j] = 0.f;
        const int k0 = c.wave * 128;
#pragma unroll 4
        for (int k = k0; k < k0 + 128; ++k) { const float w = W[(size_t)k * 6144 + col];
#pragma unroll
            for (int j = 0; j < 9; ++j) acc[j] += sil[j * 1024 + k] * w; }
#pragma unroll
        for (int j = 0; j < 9; ++j) red[(c.wave * 9 + j) * 64 + c.lane] = acc[j];
        __syncthreads();
        if (c.wave == 0) {
            const float bias = c.in[IN_MODB][L * 6144 + col];
#pragma unroll
            for (int j = 0; j < 9; ++j) { float s = bias;
#pragma unroll
                for (int w = 0; w < 8; ++w) s += red[(w * 9 + j) * 64 + c.lane];
                MOD[(size_t)(L * 9 + j) * 6144 + col] = s; }
        }
        __syncthreads();
    }
    unsigned short* X = (unsigned short*)(c.ws + WS_X);
    for (int r = c.gw; r < NROWS; r += c.ngw) {
        const int b = r / RB, s = r - b * RB;
        const float* src = (s < CL) ? c.in[IN_CTX] + (size_t)(b * CL + s) * D : c.in[IN_X] + (size_t)(b * T + s - CL) * D;
        const f32x4* sp = (const f32x4*)src + c.lane; pg8::u32x2* dp = (pg8::u32x2*)(X + (size_t)r * D) + c.lane;
#pragma unroll
        for (int j = 0; j < 4; ++j) dp[64 * j] = pg8::f32_to_bf4(sp[64 * j]);
    }
}

template <bool FINAL, bool GM>
__device__ __forceinline__ void phase_norm1(const Ctx& c, int L) {
    unsigned short* X = (unsigned short*)(c.ws + WS_X);
    const int* SLOT = (const int*)(c.ws + WS_SLOT); const unsigned char* Y = (const unsigned char*)(c.ws + WS_Y);
    int ch[4];
#pragma unroll
    for (int q = 0; q < 4; ++q) ch[q] = GM ? 16 * c.lane + 4 * q : 4 * (c.lane + 64 * q);
#define N1_DEC(w) ((f32x4){__builtin_amdgcn_cvt_pk_f32_fp8((int)(w), false)[0], __builtin_amdgcn_cvt_pk_f32_fp8((int)(w), false)[1], __builtin_amdgcn_cvt_pk_f32_fp8((int)(w), true)[0], __builtin_amdgcn_cvt_pk_f32_fp8((int)(w), true)[1]})
#define N1_YPF(spv, msk, A0, A1, TWO) do { (msk) = __ballot((spv) >= 0 && c.lane < NE); if (msk) { \
        const int e0_ = __builtin_ctzll(msk); (msk) &= (msk) - 1; (TWO) = (msk) != 0ull; const int e1_ = (TWO) ? __builtin_ctzll(msk) : e0_; if (TWO) (msk) &= (msk) - 1; \
        const unsigned char* y0_ = Y + ((size_t)e0_ * EROWS + __builtin_amdgcn_readlane((spv), e0_)) * D; const unsigned char* y1_ = Y + ((size_t)e1_ * EROWS + __builtin_amdgcn_readlane((spv), e1_)) * D; \
        _Pragma("unroll") for (int q = 0; q < 4; ++q) { (A0)[q] = *(const unsigned*)(y0_ + ch[q]); (A1)[q] = *(const unsigned*)(y1_ + ch[q]); } } } while (0)
    int r = c.gw;
    f32x4 vn[4]; int spn = -1;
    unsigned yp0[4], yp1[4]; unsigned long long maskn = 0ull; bool hasn = false, twon = false;
    if (r < NROWS) {
#pragma unroll
        for (int q = 0; q < 4; ++q) vn[q] = pg8::bf4_to_f32(*(const pg8::u32x2*)(X + (size_t)r * D + ch[q]));
        if (L > 0) { if (c.lane < NE) spn = SLOT[(size_t)r * NE + c.lane]; unsigned long long m0 = 0ull; N1_YPF(spn, m0, yp0, yp1, twon); hasn = __ballot(spn >= 0 && c.lane < NE) != 0ull; maskn = m0; }
    }
    for (; r < NROWS; r += c.ngw) {
        const int b = r / RB, s = r - b * RB, j = s < CL ? 8 : b;
        unsigned short* xr = X + (size_t)r * D;
        f32x4 v[4]; const int spl = spn; unsigned w0[4], w1[4]; unsigned long long mask = maskn; const bool has = hasn, two0 = twon;
#pragma unroll
        for (int q = 0; q < 4; ++q) { v[q] = vn[q]; w0[q] = yp0[q]; w1[q] = yp1[q]; }
        const int rn = r + c.ngw;
        if (rn < NROWS) {
#pragma unroll
            for (int q = 0; q < 4; ++q) vn[q] = pg8::bf4_to_f32(*(const pg8::u32x2*)(X + (size_t)rn * D + ch[q]));
            if (L > 0 && c.lane < NE) spn = SLOT[(size_t)rn * NE + c.lane];
        }
        if (!(FINAL && s < CL)) {
        if (L > 0) {
            f32x4 sum[4] = {};
            if (has) {
#pragma unroll
                for (int q = 0; q < 4; ++q) { sum[q] += N1_DEC(w0[q]); if (two0) sum[q] += N1_DEC(w1[q]); }
            }
            while (mask) {
                const int e0 = __builtin_ctzll(mask); mask &= mask - 1;
                const bool two = mask != 0ull; const int e1 = two ? __builtin_ctzll(mask) : e0; if (two) mask &= mask - 1;
                const int sp0 = __builtin_amdgcn_readlane(spl, e0), sp1 = __builtin_amdgcn_readlane(spl, e1);
                const unsigned char* y0 = Y + ((size_t)e0 * EROWS + sp0) * D; const unsigned char* y1 = Y + ((size_t)e1 * EROWS + sp1) * D;
#pragma unroll
                for (int q = 0; q < 4; ++q) { w0[q] = *(const unsigned*)(y0 + ch[q]); w1[q] = *(const unsigned*)(y1 + ch[q]); }
#pragma unroll
                for (int q = 0; q < 4; ++q) { sum[q] += N1_DEC(w0[q]); if (two) sum[q] += N1_DEC(w1[q]); }
            }
            const float* g2 = modp(c, L - 1, j, 5);
#pragma unroll
            for (int q = 0; q < 4; ++q) { v[q] += *(const f32x4*)(g2 + ch[q]) * (sum[q] * pg8::Y8_INV); if (!FINAL) { const pg8::u32x2 w = pg8::f32_to_bf4(v[q]); *(pg8::u32x2*)(xr + ch[q]) = w; v[q] = pg8::bf4_to_f32(w); } }
        }
        float ss = 0.f;
#pragma unroll
        for (int q = 0; q < 4; ++q) ss += v[q].x * v[q].x + v[q].y * v[q].y + v[q].z * v[q].z + v[q].w * v[q].w;
        const float rstd = rsqrtf(wave_sum(ss) * (1.0f / D) + EPS);
        if (FINAL) {
            const float* g = c.in[IN_FNG]; float* op = c.out + (size_t)(b * T + s - CL) * D;
#pragma unroll
            for (int q = 0; q < 4; ++q) *(f32x4*)(op + ch[q]) = v[q] * rstd * *(const f32x4*)(g + ch[q]);
        } else {
            const float* g = c.in[IN_NORMG] + (size_t)(L * 2 + 0) * D; const float* sc = modp(c, L, j, 1); const float* sh = modp(c, L, j, 0);
            unsigned hw[8];
#pragma unroll
            for (int q = 0; q < 4; ++q) { const f32x4 hv = v[q] * rstd * *(const f32x4*)(g + ch[q]) * (1.0f + *(const f32x4*)(sc + ch[q])) + *(const f32x4*)(sh + ch[q]);
                hw[2 * q] = pg8::cvt_pk_bf16(hv.x, hv.y); hw[2 * q + 1] = pg8::cvt_pk_bf16(hv.z, hv.w); }
            if (GM) { unsigned short* o = (unsigned short*)(c.ws + WS_AS5) + ((size_t)c.lane * 1280 + (r >> 5)) * 768 + (r & 31) * 16;
                *(pg8::u32x4*)o = (pg8::u32x4){hw[0], hw[1], hw[2], hw[3]}; *(pg8::u32x4*)(o + 8) = (pg8::u32x4){hw[4], hw[5], hw[6], hw[7]}; }
            else { unsigned short* o = (unsigned short*)(c.ws + WS_HB1) + (size_t)r * D;
#pragma unroll
                for (int q = 0; q < 4; ++q) *(pg8::u32x2*)(o + ch[q]) = (pg8::u32x2){hw[2 * q], hw[2 * q + 1]}; }
        }
        }
        if (L > 0 && rn < NROWS) { unsigned long long m0 = 0ull; hasn = __ballot(spn >= 0 && c.lane < NE) != 0ull; N1_YPF(spn, m0, yp0, yp1, twon); maskn = m0; }
    }
#undef N1_DEC
#undef N1_YPF
}

template <bool SKIPCTX>
__device__ __forceinline__ void phase_norm2_router(const Ctx& c, int L, LAS float* wT) {
    const unsigned short* X = (const unsigned short*)(c.ws + WS_X); unsigned char* HB = (unsigned char*)(c.ws + WS_HB); float* AFF = (float*)(c.ws + WS_AFF);
    const float* WR = c.in[IN_ROUTER] + (size_t)L * D * NE;
    __syncthreads();
    for (int idx = c.tid; idx < D * 4; idx += 512) { const int ch = idx >> 2, e4 = idx & 3; const f32x4 w = *(const f32x4*)(WR + (size_t)ch * NE + 4 * e4);
        wT[(4 * e4 + 0) * D + ch] = w.x; wT[(4 * e4 + 1) * D + ch] = w.y; wT[(4 * e4 + 2) * D + ch] = w.z; wT[(4 * e4 + 3) * D + ch] = w.w; }
    __syncthreads();
    pg8::u32x2 xn[4];
    if (c.gw < NROWS) {
#pragma unroll
        for (int q = 0; q < 4; ++q) xn[q] = ((const pg8::u32x2*)(X + (size_t)c.gw * D) + c.lane)[64 * q];
    }
    for (int r = c.gw; r < NROWS; r += c.ngw) {
        const int j = row_j(r);
        f32x4 v[4]; float ss = 0.f;
#pragma unroll
        for (int q = 0; q < 4; ++q) { v[q] = pg8::bf4_to_f32(xn[q]); ss += v[q].x * v[q].x + v[q].y * v[q].y + v[q].z * v[q].z + v[q].w * v[q].w; }
        if (r + c.ngw < NROWS) {
#pragma unroll
            for (int q = 0; q < 4; ++q) xn[q] = ((const pg8::u32x2*)(X + (size_t)(r + c.ngw) * D) + c.lane)[64 * q];
        }
        if (SKIPCTX && j == 8) continue;
        const float rstd = rsqrtf(wave_sum(ss) * (1.0f / D) + EPS);
        const f32x4* g = (const f32x4*)(c.in[IN_NORMG] + (size_t)(L * 2 + 1) * D) + c.lane;
        const f32x4* sc = (const f32x4*)modp(c, L, j, 4) + c.lane; const f32x4* sh = (const f32x4*)modp(c, L, j, 3) + c.lane;
        unsigned* hp = (unsigned*)(HB + (size_t)r * D) + c.lane;
        float lg[16]; f32x4 f[4];
#pragma unroll
        for (int q = 0; q < 4; ++q) { f[q] = v[q] * rstd * g[64 * q] * (1.0f + sc[64 * q]) + sh[64 * q]; hp[64 * q] = pg8::pk4_fp8(f[q].x, f[q].y, f[q].z, f[q].w); }
        __builtin_amdgcn_sched_barrier(0);
#pragma unroll
        for (int e = 0; e < 16; ++e) {
            float a = 0.f;
#pragma unroll
            for (int q = 0; q < 4; ++q) { const f32x4 wv = *(const LAS f32x4*)(wT + e * D + 4 * (c.lane + 64 * q)); a += (f[q].x * wv.x + f[q].y * wv.y) + (f[q].z * wv.z + f[q].w * wv.w); }
            lg[e] = a;
            if (e & 1) __builtin_amdgcn_sched_barrier(0);
        }
        const float mine = reduce16(lg, c.lane);
        const int k = reduce16_k(c.lane);
        float mx = mine;
#pragma unroll
        for (int o = 4; o < 64; o <<= 1) mx = fmaxf(mx, __shfl_xor(mx, o));
        const float ex = expf(mine - mx);
        float den = ex;
#pragma unroll
        for (int o = 4; o < 64; o <<= 1) den += __shfl_xor(den, o);
        if ((c.lane & 3) == 0) AFF[(size_t)r * NE + k] = ex / den;
    }
}

__device__ __forceinline__ void phase_topk(const Ctx& c, LAS unsigned* lds32, int nprob) {
    const float* AFF = (const float*)(c.ws + WS_AFF);
    int* SELROW = (int*)(c.ws + WS_SELROW); float* SELGATE = (float*)(c.ws + WS_SELGATE); int* SLOT = (int*)(c.ws + WS_SLOT);
    LAS unsigned* hist = lds32; LAS unsigned* wsum = lds32 + 256; LAS unsigned* res = lds32 + 272;
    LAS int* srow = (LAS int*)(lds32 + 512);
    const unsigned char* HB = (const unsigned char*)(c.ws + WS_HB); unsigned char* XS = (unsigned char*)(c.ws + WS_XS);
    for (int pid = blockIdx.x; pid < nprob; pid += gridDim.x) {
        const bool lat = pid < 128; const int q = lat ? pid : pid - 128, b = q >> 4, e = q & 15;
        const int N = lat ? T : CL, C = lat ? CAP_LAT : CAP_CTX, row0 = b * RB + (lat ? CL : 0), base = lat ? b * CAP_LAT : NB * CAP_LAT + b * CAP_CTX;
        const int t0 = c.tid * 8; const bool valid = t0 < N;
        unsigned k[8];
#pragma unroll
        for (int i = 0; i < 8; ++i) k[i] = valid ? __float_as_uint(AFF[(size_t)(row0 + t0 + i) * NE + e]) : 0u;
        unsigned prefix = 0u, want = (unsigned)C;
#pragma unroll
        for (int r = 0; r < 4; ++r) {
            const int shift = 24 - 8 * r;
            __syncthreads();
            if (c.tid < 256) hist[c.tid] = 0u;
            __syncthreads();
            if (valid) {
#pragma unroll
                for (int i = 0; i < 8; ++i) if (r == 0 || (k[i] >> (shift + 8)) == prefix) __hip_atomic_fetch_add(&hist[(k[i] >> shift) & 255u], 1u, __ATOMIC_RELAXED, __HIP_MEMORY_SCOPE_WORKGROUP);
            }
            __syncthreads();
            if (c.wave == 0) {
                const unsigned h0 = hist[4 * c.lane], h1 = hist[4 * c.lane + 1], h2 = hist[4 * c.lane + 2], h3 = hist[4 * c.lane + 3];
                unsigned suf = h0 + h1 + h2 + h3;
#pragma unroll
                for (int off = 1; off < 64; off <<= 1) { const unsigned o = __shfl_down(suf, off); if (c.lane + off < 64) suf += o; }
                unsigned nxt = __shfl_down(suf, 1); if (c.lane == 63) nxt = 0u;
                if (suf >= want && nxt < want) {
                    unsigned above = nxt; int d;
                    if (above + h3 >= want) d = 3; else { above += h3; if (above + h2 >= want) d = 2; else { above += h2; if (above + h1 >= want) d = 1; else { above += h1; d = 0; } } }
                    res[0] = (unsigned)(4 * c.lane + d); res[1] = want - above;
                }
            }
            __syncthreads();
            prefix = (prefix << 8) | res[0]; want = res[1];
        }
        const unsigned thr = prefix, need_eq = want;
        unsigned cg = 0u, ce = 0u;
#pragma unroll
        for (int i = 0; i < 8; ++i) { cg += (valid && k[i] > thr) ? 1u : 0u; ce += (valid && k[i] == thr) ? 1u : 0u; }
        unsigned incl = cg | (ce << 16);
#pragma unroll
        for (int off = 1; off < 64; off <<= 1) { const unsigned o = __shfl_up(incl, off); if (c.lane >= off) incl += o; }
        __syncthreads();
        if (c.lane == 63) wsum[c.wave] = incl;
        __syncthreads();
        unsigned wbase = 0u;
#pragma unroll
        for (int w = 0; w < 8; ++w) if (w < c.wave) wbase += wsum[w];
        const unsigned excl = wbase + incl - (cg | (ce << 16));
        unsigned gb = excl & 0xffffu, eb = excl >> 16;
        if (valid) {
#pragma unroll
            for (int i = 0; i < 8; ++i) {
                const int row = row0 + t0 + i; const bool isg = k[i] > thr, ise = k[i] == thr;
                const bool sel = isg || (ise && eb < need_eq);
                const unsigned sp = (unsigned)base + gb + (eb < need_eq ? eb : need_eq);
                if (sel) { SELROW[e * EROWS + sp] = row; SELGATE[e * EROWS + sp] = __uint_as_float(k[i]); SLOT[(size_t)row * NE + e] = (int)sp; srow[sp - (unsigned)base] = row; }
                else SLOT[(size_t)row * NE + e] = -1;
                gb += isg ? 1u : 0u; eb += ise ? 1u : 0u;
            }
        }
        __syncthreads();
        for (int s0 = c.wave * 8; s0 < C; s0 += 64) {
            pg8::u32x4 v4[8];
#pragma unroll
            for (int j = 0; j < 8; ++j) v4[j] = *(const pg8::u32x4*)(HB + (size_t)srow[s0 + j] * D + c.lane * 16);
#pragma unroll
            for (int j = 0; j < 8; ++j) *(pg8::u32x4*)(XS + ((size_t)e * EROWS + base + s0 + j) * D + c.lane * 16) = v4[j];
        }
    }
}

__device__ __forceinline__ void post_ld32(const unsigned short* p, float (&v)[32]) {
#pragma unroll
    for (int q = 0; q < 4; ++q) { const pg8::u32x4 w = ((const pg8::u32x4*)p)[q];
#pragma unroll
        for (int e = 0; e < 4; ++e) { v[8 * q + 2 * e] = __uint_as_float(w[e] << 16); v[8 * q + 2 * e + 1] = __uint_as_float(w[e] & 0xffff0000u); } }
}
__device__ __forceinline__ void post_raw(const unsigned short* p, pg8::u32x4 (&w)[4]) {
#pragma unroll
    for (int q = 0; q < 4; ++q) w[q] = ((const pg8::u32x4*)p)[q];
}
__device__ __forceinline__ void post_cvt(const pg8::u32x4 (&w)[4], float (&v)[32]) {
#pragma unroll
    for (int q = 0; q < 4; ++q)
#pragma unroll
        for (int e = 0; e < 4; ++e) { v[8 * q + 2 * e] = __uint_as_float(w[q][e] << 16); v[8 * q + 2 * e + 1] = __uint_as_float(w[q][e] & 0xffff0000u); }
}
__device__ __forceinline__ void post_st32(unsigned short* p, const float (&v)[32], float sc) {
#pragma unroll
    for (int q = 0; q < 4; ++q) { pg8::u32x4 w;
#pragma unroll
        for (int e = 0; e < 4; ++e) w[e] = pg8::cvt_pk_bf16(v[8 * q + 2 * e] * sc, v[8 * q + 2 * e + 1] * sc);
        ((pg8::u32x4*)p)[q] = w; }
}
__device__ __forceinline__ void post_rope(float (&v)[32], const float* cs  ) {
#pragma unroll
    for (int f4 = 0; f4 < 8; ++f4) { const f32x4 t4 = ((const f32x4*)cs)[f4];
        { const float x1 = v[2 * f4], x2 = v[16 + 2 * f4]; v[2 * f4] = x1 * t4.x - x2 * t4.y; v[16 + 2 * f4] = x1 * t4.y + x2 * t4.x; }
        { const float x1 = v[2 * f4 + 1], x2 = v[16 + 2 * f4 + 1]; v[2 * f4 + 1] = x1 * t4.z - x2 * t4.w; v[16 + 2 * f4 + 1] = x1 * t4.w + x2 * t4.z; } }
}
__device__ __forceinline__ void phase_post(const Ctx& c, int i, LAS unsigned char* lds) {
    typedef pg8::bf16x8 bf16x8;
    const unsigned short* P = (const unsigned short*)(c.ws + WS_P); const float* rope = (const float*)(c.ws + WS_ROPE);
    unsigned short* QA = (unsigned short*)(c.ws + WS_QA); unsigned short* KA = (unsigned short*)(c.ws + WS_KA); unsigned short* VA = (unsigned short*)(c.ws + WS_VA);
    unsigned short* RQ = (unsigned short*)(c.ws + WS_RQ); unsigned short* RK = (unsigned short*)(c.ws + WS_RK); unsigned short* RV = (unsigned short*)(c.ws + WS_RV);
    float* U = (float*)(c.ws + WS_U);
    const float* qkg = c.in[IN_QKG] + (size_t)i * 2 * 64;
    constexpr int VTS = 0, KTF = 17408, KTB = 34816;
    const int grp = c.tid >> 8, r = (c.tid & 255) >> 1, half = c.tid & 1;
    const int li = c.lane & 15, q4 = c.lane >> 4;
    pg8::u32x4 ra[4], rb[4], rc[4];
#define PP_LOAD(u_) do { const int hh_ = (u_) & 7, bc_ = (u_) >> 3, b_ = bc_ / 34, cch_ = bc_ - b_ * 34; const size_t row_ = (size_t)(b_ * RB + cch_ * 128 + r); \
        post_raw(P + row_ * INW + (grp ? 512 : 0) + hh_ * 64 + 32 * half, ra); post_raw(P + row_ * INW + (grp ? 2048 : 1024) + hh_ * 64 + 32 * half, rb); \
        if (hh_ < 2) post_raw(P + row_ * INW + (grp ? 2688 : 2560) + hh_ * 64 + 32 * half, rc); } while (0)
    if ((int)blockIdx.x < NB * 34 * 8) PP_LOAD((int)blockIdx.x);
    for (int unit = blockIdx.x; unit < NB * 34 * 8; unit += gridDim.x) {
        const int hh = unit & 7, bc = unit >> 3, b = bc / 34, cch = bc - b * 34, row0 = b * RB + cch * 128, bh = b * 8 + hh;
        const bool latent = cch >= 2;
        const size_t row = (size_t)(row0 + r);
        const int tpos = cch * 128 + r - CL;
        const float* cs = rope + (size_t)((half == 0 ? (tpos >> 6) : (tpos & 63)) * 16) * 2;
        const float lgf = -expf(c.in[IN_RETRATE][(i * 2 + 0) * 8 + hh]) * 1.4426950408889634f, lgb = -expf(c.in[IN_RETRATE][(i * 2 + 1) * 8 + hh]) * 1.4426950408889634f;
        __syncthreads();
        float v[32];
        post_cvt(ra, v);
        if (grp) {
#pragma unroll
            for (int d = 0; d < 32; ++d) v[d] *= 0.125f; }
        if (latent) post_rope(v, cs);
        post_st32((grp ? RK : RQ) + row * 512 + hh * 64 + 32 * half, v, 1.0f);
        if (grp) { const float wf = exp2f(lgf * (float)(127 - r)), wb = exp2f(lgb * (float)r);
#pragma unroll
            for (int d = 0; d < 32; d += 2) { const unsigned pf = pg8::cvt_pk_bf16(v[d] * wf, v[d + 1] * wf), pb = pg8::cvt_pk_bf16(v[d] * wb, v[d + 1] * wb);
                *(LAS unsigned short*)(lds + KTF + (32 * half + d) * 272 + r * 2) = (unsigned short)(pf & 0xffffu); *(LAS unsigned short*)(lds + KTF + (32 * half + d + 1) * 272 + r * 2) = (unsigned short)(pf >> 16);
                *(LAS unsigned short*)(lds + KTB + (32 * half + d) * 272 + r * 2) = (unsigned short)(pb & 0xffffu); *(LAS unsigned short*)(lds + KTB + (32 * half + d + 1) * 272 + r * 2) = (unsigned short)(pb >> 16); } }
        post_cvt(rb, v);
        if (grp == 0) { post_st32(RV + row * 512 + hh * 64 + 32 * half, v, 1.0f);
#pragma unroll
            for (int d = 0; d < 32; d += 2) { const unsigned pv = pg8::cvt_pk_bf16(v[d], v[d + 1]);
                *(LAS unsigned short*)(lds + VTS + (32 * half + d) * 272 + r * 2) = (unsigned short)(pv & 0xffffu); *(LAS unsigned short*)(lds + VTS + (32 * half + d + 1) * 272 + r * 2) = (unsigned short)(pv >> 16); }
        } else {
            float ss = 0.f;
#pragma unroll
            for (int d = 0; d < 32; ++d) ss += v[d] * v[d];
            ss += __shfl_xor(ss, 1);
            const float rs = rsqrtf(ss * (1.0f / 64.0f) + EPS);
#pragma unroll
            for (int d = 0; d < 32; ++d) v[d] = v[d] * rs * qkg[32 * half + d];
            if (latent) post_rope(v, cs);
            post_st32(QA + row * 512 + hh * 64 + 32 * half, v, attn_body::C2);
        }
        if (hh < 2) {
            post_cvt(rc, v);
            if (grp == 0) {
                float ss = 0.f;
#pragma unroll
                for (int d = 0; d < 32; ++d) ss += v[d] * v[d];
                ss += __shfl_xor(ss, 1);
                const float rs = rsqrtf(ss * (1.0f / 64.0f) + EPS);
#pragma unroll
                for (int d = 0; d < 32; ++d) v[d] = v[d] * rs * qkg[64 + 32 * half + d];
                if (latent) post_rope(v, cs);
                post_st32(KA + row * 128 + hh * 64 + 32 * half, v, 1.0f);
            } else post_st32(VA + row * 128 + hh * 64 + 32 * half, v, 1.0f);
        }
        if (unit + (int)gridDim.x < NB * 34 * 8) PP_LOAD(unit + (int)gridDim.x);
        __syncthreads();
        { const int dir = c.wave >> 2, dvt = c.wave & 3;
            bf16x8 af[4];
#pragma unroll
            for (int u = 0; u < 4; ++u) af[u] = *(const LAS bf16x8*)(lds + VTS + (16 * dvt + li) * 272 + (32 * u + 8 * q4) * 2);
            float* uo = U + ((size_t)(bh * 34 + cch) * 2 + dir) * 4096;
#pragma unroll
            for (int dkt = 0; dkt < 4; ++dkt) {
                f32x4 a = {0.f, 0.f, 0.f, 0.f};
#pragma unroll
                for (int u = 0; u < 4; ++u) { const bf16x8 kf = *(const LAS bf16x8*)(lds + (dir ? KTB : KTF) + (16 * dkt + li) * 272 + (32 * u + 8 * q4) * 2); a = __builtin_amdgcn_mfma_f32_16x16x32_bf16(af[u], kf, a, 0, 0, 0); }
#pragma unroll
                for (int rr = 0; rr < 4; ++rr) uo[(16 * dvt + 4 * q4 + rr) * 64 + 16 * dkt + li] = a[rr];
            } }
    }
}

#undef PP_LOAD
__device__ __forceinline__ void phase_ret_prefix(const Ctx& c, int i) {
    const float* U = (const float*)(c.ws + WS_U); unsigned short* ET = (unsigned short*)(c.ws + WS_ET);
    for (int chain = c.gt; chain < 64 * 2 * 4096; chain += c.ngt) {
        const int bh = chain >> 13, dir = (chain >> 12) & 1, el = chain & 4095, hh = bh & 7;
        const float g128 = expf(-expf(c.in[IN_RETRATE][(i * 2 + dir) * 8 + hh]) * 128.0f);
        float S = 0.f;
#pragma unroll
        for (int st = 0; st < 34; ++st) {
            const int cch = dir == 0 ? st : (st < 2 ? 1 - st : 35 - st);
            const size_t o = ((size_t)(bh * 34 + cch) * 2 + dir) * 4096 + el;
            ET[o] = (unsigned short)(pg8::cvt_pk_bf16(S, 0.f) & 0xffffu);
            S = g128 * S + U[o];
        }
    }
}
__device__ __forceinline__ void phase_ret_main(const Ctx& c, int i, LAS unsigned char* lds) {
    typedef pg8::bf16x8 bf16x8;
    const unsigned short* RQ = (const unsigned short*)(c.ws + WS_RQ); const unsigned short* RK = (const unsigned short*)(c.ws + WS_RK); const unsigned short* RV = (const unsigned short*)(c.ws + WS_RV);
    const unsigned short* ET = (const unsigned short*)(c.ws + WS_ET); const unsigned short* P = (const unsigned short*)(c.ws + WS_P); unsigned short* MIX = (unsigned short*)(c.ws + WS_MIX);
    const float* gn = c.in[IN_RETGN] + (size_t)i * 512;
    constexpr int QS = 0, KS = 18432, VTS = 36864, EF = 54272, EB = 63488;
    const int li = c.lane & 15, q4 = c.lane >> 4, i0 = 16 * c.wave, ig = i0 + li;
    pg8::u32x4 gq[2], gk[2], gv[2], gef, geb;
#define RM_LOAD(u_) do { const int bh_ = (u_) / 34, cch_ = (u_) - bh_ * 34, row0_ = (bh_ >> 3) * RB + cch_ * 128, hh_ = bh_ & 7; \
        _Pragma("unroll") for (int t2 = 0; t2 < 2; ++t2) { const int pc = c.tid + 512 * t2, r = pc >> 3, ch = pc & 7; const size_t go = (size_t)(row0_ + r) * 512 + hh_ * 64 + ch * 8; \
            gq[t2] = *(const pg8::u32x4*)(RQ + go); gk[t2] = *(const pg8::u32x4*)(RK + go); gv[t2] = *(const pg8::u32x4*)(RV + go); } \
        { const int r = c.tid >> 3, ch = c.tid & 7; const size_t go = ((size_t)(bh_ * 34 + cch_) * 2) * 4096 + r * 64 + ch * 8; gef = *(const pg8::u32x4*)(ET + go); geb = *(const pg8::u32x4*)(ET + go + 4096); } } while (0)
    if ((int)blockIdx.x < 64 * 34) RM_LOAD((int)blockIdx.x);
    for (int unit = blockIdx.x; unit < 64 * 34; unit += gridDim.x) {
        const int bh = unit / 34, cch = unit - bh * 34, b = bh >> 3, hh = bh & 7, row0 = b * RB + cch * 128;
        const float lgf = -expf(c.in[IN_RETRATE][(i * 2 + 0) * 8 + hh]) * 1.4426950408889634f, lgb = -expf(c.in[IN_RETRATE][(i * 2 + 1) * 8 + hh]) * 1.4426950408889634f;
        __syncthreads();
#pragma unroll
        for (int t2 = 0; t2 < 2; ++t2) { const int pc = c.tid + 512 * t2, r = pc >> 3, ch = pc & 7;
            *(LAS pg8::u32x4*)(lds + QS + r * 144 + ch * 16) = gq[t2];
            *(LAS pg8::u32x4*)(lds + KS + r * 144 + ch * 16) = gk[t2];
            const pg8::u32x4 vw = gv[t2];
#pragma unroll
            for (int e = 0; e < 4; ++e) { *(LAS unsigned short*)(lds + VTS + (ch * 8 + 2 * e) * 272 + r * 2) = (unsigned short)(vw[e] & 0xffffu); *(LAS unsigned short*)(lds + VTS + (ch * 8 + 2 * e + 1) * 272 + r * 2) = (unsigned short)(vw[e] >> 16); } }
        { const int r = c.tid >> 3, ch = c.tid & 7; *(LAS pg8::u32x4*)(lds + EF + r * 144 + ch * 16) = gef; *(LAS pg8::u32x4*)(lds + EB + r * 144 + ch * 16) = geb; }
        if (unit + (int)gridDim.x < 64 * 34) RM_LOAD(unit + (int)gridDim.x);
        __syncthreads();
        bf16x8 qf[2];
#pragma unroll
        for (int s = 0; s < 2; ++s) qf[s] = *(const LAS bf16x8*)(lds + QS + (i0 + li) * 144 + (32 * s + 8 * q4) * 2);
        pg8::u32x2 pk[8];
#pragma unroll
        for (int jt = 0; jt < 8; ++jt) {
            f32x4 a = {0.f, 0.f, 0.f, 0.f};
#pragma unroll
            for (int s = 0; s < 2; ++s) { const bf16x8 kf = *(const LAS bf16x8*)(lds + KS + (16 * jt + li) * 144 + (32 * s + 8 * q4) * 2); a = __builtin_amdgcn_mfma_f32_16x16x32_bf16(kf, qf[s], a, 0, 0, 0); }
            float pv[4];
#pragma unroll
            for (int r = 0; r < 4; ++r) { const int dl = ig - (16 * jt + 4 * q4 + r); const float w = dl >= 0 ? exp2f(lgf * (float)dl) : exp2f(lgb * (float)(-dl)); pv[r] = a[r] * w; }
            pk[jt] = (pg8::u32x2){pg8::cvt_pk_bf16(pv[0], pv[1]), pg8::cvt_pk_bf16(pv[2], pv[3])};
        }
        const float sf = exp2f(lgf * (float)(ig + 1)), sb = exp2f(lgb * (float)(128 - ig));
        f32x4 oacc[4];
#pragma unroll
        for (int dvt = 0; dvt < 4; ++dvt) {
            f32x4 o = {0.f, 0.f, 0.f, 0.f};
#pragma unroll
            for (int u = 0; u < 4; ++u) {
                const pg8::u32x2 vlo = *(const LAS pg8::u32x2*)(lds + VTS + (16 * dvt + li) * 272 + (32 * u + 4 * q4) * 2), vhi = *(const LAS pg8::u32x2*)(lds + VTS + (16 * dvt + li) * 272 + (32 * u + 16 + 4 * q4) * 2);
                const pg8::u32x4 av = {vlo.x, vlo.y, vhi.x, vhi.y}, bv = {pk[2 * u].x, pk[2 * u].y, pk[2 * u + 1].x, pk[2 * u + 1].y};
                o = __builtin_amdgcn_mfma_f32_16x16x32_bf16(__builtin_bit_cast(bf16x8, av), __builtin_bit_cast(bf16x8, bv), o, 0, 0, 0);
            }
            f32x4 tf = {0.f, 0.f, 0.f, 0.f}, tb = {0.f, 0.f, 0.f, 0.f};
#pragma unroll
            for (int s = 0; s < 2; ++s) {
                const bf16x8 ef = *(const LAS bf16x8*)(lds + EF + (16 * dvt + li) * 144 + (32 * s + 8 * q4) * 2), eb = *(const LAS bf16x8*)(lds + EB + (16 * dvt + li) * 144 + (32 * s + 8 * q4) * 2);
                tf = __builtin_amdgcn_mfma_f32_16x16x32_bf16(ef, qf[s], tf, 0, 0, 0); tb = __builtin_amdgcn_mfma_f32_16x16x32_bf16(eb, qf[s], tb, 0, 0, 0);
            }
            oacc[dvt] = o + tf * sf + tb * sb;
        }
        float sm = 0.f;
#pragma unroll
        for (int dvt = 0; dvt < 4; ++dvt) sm += (oacc[dvt].x + oacc[dvt].y) + (oacc[dvt].z + oacc[dvt].w);
        sm += __shfl_xor(sm, 16); sm += __shfl_xor(sm, 32);
        const float mu = sm * (1.0f / 64.0f); float vr = 0.f;
#pragma unroll
        for (int dvt = 0; dvt < 4; ++dvt) { oacc[dvt] = oacc[dvt] - mu; vr += (oacc[dvt].x * oacc[dvt].x + oacc[dvt].y * oacc[dvt].y) + (oacc[dvt].z * oacc[dvt].z + oacc[dvt].w * oacc[dvt].w); }
        vr += __shfl_xor(vr, 16); vr += __shfl_xor(vr, 32);
        const float rs = rsqrtf(vr * (1.0f / 64.0f) + EPS);
        const size_t row = (size_t)(row0 + ig);
#pragma unroll
        for (int dvt = 0; dvt < 4; ++dvt) { const int dvc = hh * 64 + 16 * dvt + 4 * q4;
            const pg8::u32x2 gw = *(const pg8::u32x2*)(P + row * INW + 1536 + dvc); const f32x4 gt = {__uint_as_float(gw.x << 16), __uint_as_float(gw.x & 0xffff0000u), __uint_as_float(gw.y << 16), __uint_as_float(gw.y & 0xffff0000u)}, gg = *(const f32x4*)(gn + dvc); const f32x4 y = oacc[dvt] * rs * gg;
            *(pg8::u32x2*)(MIX + row * D + dvc) = (pg8::u32x2){pg8::cvt_pk_bf16(gt.x * pg8::fast_sigmoid(gt.x) * y.x, gt.y * pg8::fast_sigmoid(gt.y) * y.y), pg8::cvt_pk_bf16(gt.z * pg8::fast_sigmoid(gt.z) * y.z, gt.w * pg8::fast_sigmoid(gt.w) * y.w)}; }
    }
}

#undef RM_LOAD
__device__ __forceinline__ void phase_attention(const Ctx& c, char* lds) {
    const attn_body::bf16* QA = (const attn_body::bf16*)(c.ws + WS_QA); const attn_body::bf16* KA = (const attn_body::bf16*)(c.ws + WS_KA); const attn_body::bf16* VA = (const attn_body::bf16*)(c.ws + WS_VA);
    attn_body::bf16* MIX = (attn_body::bf16*)(c.ws + WS_MIX);
    const int G = gridDim.x, bx = blockIdx.x, vcu = (G % 8 == 0) ? (bx % 8) * (G / 8) + bx / 8 : bx;
    for (int U = vcu; U < NB * 8 * 17; U += G) {
        int bh, qrow0, NT;
        if (U < NB * 8 * 16) { bh = U >> 4; qrow0 = (bh >> 3) * RB + CL + (U & 15) * 256; NT = RB / 64; }
        else { bh = U - NB * 8 * 16; qrow0 = (bh >> 3) * RB; NT = CL / 64; }
        const int b = bh >> 3, hh = bh & 7;
        attn_body::attn_unit<8>(QA + (size_t)qrow0 * 512 + hh * 64, KA + (size_t)(b * RB) * 128 + (hh >> 2) * 64, VA + (size_t)(b * RB) * 128 + (hh >> 2) * 64,
                                MIX + (size_t)qrow0 * 1024 + 512 + hh * 64, NT, lds, c.wave);
    }
}

__device__ __forceinline__ void phase_s5_ops(const Ctx& c, LAS float* ldsf) {
    LAS float* Pre = ldsf; LAS float* Pim = ldsf + 4608; LAS float* KZr = ldsf + 9216; LAS float* KZi = ldsf + 9344;
    LAS float* Bre = ldsf + 9472; LAS float* Bim = ldsf + 10496; LAS float* Cre = ldsf + 11520; LAS float* Cim = ldsf + 13568;
    LAS float* KV = ldsf + 15616;
#define S5P(dir, pw, p) (((dir) * 64 + (p)) * 36 + (pw))
    for (int task = blockIdx.x; task < 2 * 64 * 2; task += gridDim.x) {
        const int i = task >> 7, g = (task >> 1) & 63, hf = task & 1;
        __syncthreads();
        if (c.tid < 128) {
            const int dir = c.tid >> 6, p = c.tid & 63;
            const float a_re = c.in[IN_S5ARE][((i * 2 + dir) * 64 + g) * 64 + p], a_im = c.in[IN_S5AIM][((i * 2 + dir) * 64 + g) * 64 + p];
            const float dt = expf(c.in[IN_S5DT][(i * 2 + dir) * 64 + g]);
            const float lre = fminf(a_re, -1e-4f), lim = a_im, ea = lre * dt, eb = lim * dt;
            for (int dl = 0; dl <= 32; ++dl) { const float m = expf(ea * (float)dl), an = eb * (float)dl; Pre[S5P(dir, dl, p)] = m * cosf(an); Pim[S5P(dir, dl, p)] = m * sinf(an); }
            const float cb = cosf(eb), sb = sinf(eb), sh = sinf(0.5f * eb), mag = expf(ea);
            const float nr = expm1f(ea) * cb - 2.0f * sh * sh, ni = mag * sb, den = lre * lre + lim * lim;
            KZr[dir * 64 + p] = (nr * lre + ni * lim) / den; KZi[dir * 64 + p] = (ni * lre - nr * lim) / den;
        }
        for (int idx = c.tid; idx < 1024; idx += 512) { Bre[idx] = c.in[IN_S5BRE][(size_t)(i * 64 + g) * 1024 + idx]; Bim[idx] = c.in[IN_S5BIM][(size_t)(i * 64 + g) * 1024 + idx]; }
        for (int idx = c.tid; idx < 2048; idx += 512) { const int dir = idx >> 10, rem = idx & 1023;
            Cre[idx] = c.in[IN_S5CRE][((size_t)(i * 2 + dir) * 64 + g) * 1024 + rem]; Cim[idx] = c.in[IN_S5CIM][((size_t)(i * 2 + dir) * 64 + g) * 1024 + rem]; }
        __syncthreads();
        {
            const int dir = c.tid >> 8, ko = (c.tid >> 4) & 15, ki = c.tid & 15;
            float acc[32];
#pragma unroll
            for (int dl = 0; dl < 32; ++dl) acc[dl] = 0.f;
            for (int p = 0; p < 64; ++p) {
                const float kr = KZr[dir * 64 + p], kq = KZi[dir * 64 + p], br = Bre[p * 16 + ki], bi = Bim[p * 16 + ki], cr = Cre[(dir * 16 + ko) * 64 + p], ci = Cim[(dir * 16 + ko) * 64 + p];
                const float gr = kr * br - kq * bi, gi = kr * bi + kq * br, tr = cr * gr - ci * gi, ti = cr * gi + ci * gr;
#pragma unroll
                for (int d4 = 0; d4 < 8; ++d4) { const f32x4 pr = *(const LAS f32x4*)(Pre + S5P(dir, 4 * d4, p)), pi = *(const LAS f32x4*)(Pim + S5P(dir, 4 * d4, p));
                    acc[4 * d4] += tr * pr.x - ti * pi.x; acc[4 * d4 + 1] += tr * pr.y - ti * pi.y; acc[4 * d4 + 2] += tr * pr.z - ti * pi.z; acc[4 * d4 + 3] += tr * pr.w - ti * pi.w; }
            }
#pragma unroll
            for (int dl = 0; dl < 32; ++dl) KV[((dir * 32 + dl) * 16 + ko) * 16 + ki] = acc[dl];
        }
        __syncthreads();
        unsigned* TV = (unsigned*)(c.ws + WS_TV) + ((size_t)(i * 64 + g) * 512 * 768) / 2;
        const float* dsk = c.in[IN_S5D] + (size_t)i * D + 16 * g;
        if (c.tid < 384) {
            const int kp = c.tid, kk = 2 * kp;
            if (kk < 512) {
                const int j = kk >> 4, ki = kk & 15;
                for (int it = 16 * hf; it < 16 * hf + 16; ++it) {
                    const int dl = it > j ? it - j : j - it, dir = it > j ? 0 : 1;
                    for (int ko = 0; ko < 16; ++ko) {
                        float v0, v1;
                        if (it != j) { v0 = KV[((dir * 32 + dl) * 16 + ko) * 16 + ki]; v1 = KV[((dir * 32 + dl) * 16 + ko) * 16 + ki + 1]; }
                        else { v0 = KV[(ko) * 16 + ki] + KV[((32) * 16 + ko) * 16 + ki] + (ko == ki ? dsk[ko] : 0.f); v1 = KV[(ko) * 16 + ki + 1] + KV[((32) * 16 + ko) * 16 + ki + 1] + (ko == ki + 1 ? dsk[ko] : 0.f); }
                        TV[(size_t)(it * 16 + ko) * 384 + kp] = pg8::cvt_pk_bf16(v0, v1);
                    }
                }
            } else {
                const int q = kk - 512, dir = q >> 7, part = (q >> 6) & 1, p = q & 63;
                for (int it = 16 * hf; it < 16 * hf + 16; ++it) {
                    const int pw = dir == 0 ? it + 1 : 32 - it;
                    const float pr0 = Pre[S5P(dir, pw, p)], pi0 = Pim[S5P(dir, pw, p)], pr1 = Pre[S5P(dir, pw, p + 1)], pi1 = Pim[S5P(dir, pw, p + 1)];
                    for (int ko = 0; ko < 16; ++ko) {
                        const float cr0 = Cre[(dir * 16 + ko) * 64 + p], ci0 = Cim[(dir * 16 + ko) * 64 + p], cr1 = Cre[(dir * 16 + ko) * 64 + p + 1], ci1 = Cim[(dir * 16 + ko) * 64 + p + 1];
                        const float v0 = part == 0 ? (cr0 * pr0 - ci0 * pi0) : -(cr0 * pi0 + ci0 * pr0), v1 = part == 0 ? (cr1 * pr1 - ci1 * pi1) : -(cr1 * pi1 + ci1 * pr1);
                        TV[(size_t)(it * 16 + ko) * 384 + kp] = pg8::cvt_pk_bf16(v0, v1);
                    }
                }
            }
        }
        unsigned* WS5 = (unsigned*)(c.ws + WS_WS5) + ((size_t)(i * 64 + g) * 256 * 512) / 2;
        if (c.tid < 256) {
            const int kp = c.tid, kk = 2 * kp, j = kk >> 4, ki = kk & 15, dir = hf, pw = dir == 0 ? 31 - j : j;
            for (int pp = 0; pp < 128; ++pp) {
                const int part = pp >> 6, p = pp & 63;
                const float pr = Pre[S5P(dir, pw, p)], pi = Pim[S5P(dir, pw, p)], kr = KZr[dir * 64 + p], kq = KZi[dir * 64 + p];
                const float gr = pr * kr - pi * kq, gi = pr * kq + pi * kr, br0 = Bre[p * 16 + ki], bi0 = Bim[p * 16 + ki], br1 = Bre[p * 16 + ki + 1], bi1 = Bim[p * 16 + ki + 1];
                const float v0 = part == 0 ? (gr * br0 - gi * bi0) : (gr * bi0 + gi * br0), v1 = part == 0 ? (gr * br1 - gi * bi1) : (gr * bi1 + gi * br1);
                WS5[(size_t)(128 * hf + pp) * 256 + kp] = pg8::cvt_pk_bf16(v0, v1);
            }
        }
    }
#undef S5P
}
__device__ __forceinline__ void phase_s5_carry(const Ctx& c, int i) {
    const float* SL = (const float*)(c.ws + WS_SL); unsigned short* AS5 = (unsigned short*)(c.ws + WS_AS5);
    for (int id = c.gt; id < 64 * 8 * 2 * 64; id += c.ngt) {
        const int p = id & 63, dir = (id >> 6) & 1, b = (id >> 7) & 7, g = id >> 10;
        const float a_re = c.in[IN_S5ARE][((i * 2 + dir) * 64 + g) * 64 + p], a_im = c.in[IN_S5AIM][((i * 2 + dir) * 64 + g) * 64 + p];
        const float dt = expf(c.in[IN_S5DT][(i * 2 + dir) * 64 + g]);
        const float lre = fminf(a_re, -1e-4f), m32 = expf(lre * dt * 32.0f), an = a_im * dt * 32.0f, ar = m32 * cosf(an), ai = m32 * sinf(an);
        float xr = 0.f, xi = 0.f;
        for (int s0 = 0; s0 < 136; s0 += 17) {
            float sr[17], si[17]; size_t rr[17];
#pragma unroll
            for (int k = 0; k < 17; ++k) { const int st = s0 + k, cch = dir == 0 ? st : (st < 8 ? 7 - st : 143 - st);
                rr[k] = (size_t)g * 1280 + b * 136 + cch; sr[k] = SL[rr[k] * 256 + dir * 128 + p]; si[k] = SL[rr[k] * 256 + dir * 128 + 64 + p]; }
#pragma unroll
            for (int k = 0; k < 17; ++k) {
                unsigned short* xo = AS5 + rr[k] * 768 + 512 + dir * 128 + p;
                xo[0] = (unsigned short)(pg8::cvt_pk_bf16(xr, 0.f) & 0xffffu); xo[64] = (unsigned short)(pg8::cvt_pk_bf16(xi, 0.f) & 0xffffu);
                const float nxr = ar * xr - ai * xi + sr[k], nxi = ar * xi + ai * xr + si[k];
                xr = nxr; xi = nxi;
            }
        }
    }
}

__device__ __forceinline__ void cvt_item(const float* W, int ldw, int k0, int scol0, unsigned short* WT, int K, int drow0, LAS float* scr, int lane) {
    float wv[32];
#pragma unroll
    for (int i = 0; i < 32; ++i) wv[i] = W[(size_t)(k0 + 2 * i + (lane >> 5)) * ldw + scol0 + (lane & 31)];
#pragma unroll
    for (int i = 0; i < 32; ++i) scr[(2 * i + (lane >> 5)) * 33 + (lane & 31)] = wv[i];
    asm volatile("s_waitcnt lgkmcnt(0)" ::: "memory");
    const int cc = lane & 7;
#pragma unroll
    for (int j = 0; j < 4; ++j) { const int n = (lane >> 3) + 8 * j; const LAS float* s = scr + (8 * cc) * 33 + n;
        pg8::u32x4 o; o.x = pg8::cvt_pk_bf16(s[0 * 33], s[1 * 33]); o.y = pg8::cvt_pk_bf16(s[2 * 33], s[3 * 33]); o.z = pg8::cvt_pk_bf16(s[4 * 33], s[5 * 33]); o.w = pg8::cvt_pk_bf16(s[6 * 33], s[7 * 33]);
        *(pg8::u32x4*)(WT + (size_t)(drow0 + n) * K + k0 + 8 * cc) = o; }
    asm volatile("s_waitcnt lgkmcnt(0)" ::: "memory");
}
__device__ __forceinline__ void cvt_item8(const float* W, int ldw, int k0, int scol0, unsigned char* WT, int K, int drow0, LAS float* scr, int lane) {
    float wv[32];
#pragma unroll
    for (int i = 0; i < 32; ++i) wv[i] = W[(size_t)(k0 + 2 * i + (lane >> 5)) * ldw + scol0 + (lane & 31)];
#pragma unroll
    for (int i = 0; i < 32; ++i) scr[(2 * i + (lane >> 5)) * 33 + (lane & 31)] = wv[i] * pg8::W8_SCALE;
    asm volatile("s_waitcnt lgkmcnt(0)" ::: "memory");
    const int n = lane >> 1, kh = lane & 1; const LAS float* s = scr + (32 * kh) * 33 + n;
    unsigned w[8];
#pragma unroll
    for (int j = 0; j < 8; ++j) w[j] = pg8::pk4_fp8(s[(4 * j) * 33], s[(4 * j + 1) * 33], s[(4 * j + 2) * 33], s[(4 * j + 3) * 33]);
    unsigned char* o = WT + (size_t)(drow0 + n) * K + k0 + 32 * kh;
    *(pg8::u32x4*)o = (pg8::u32x4){w[0], w[1], w[2], w[3]}; *(pg8::u32x4*)(o + 16) = (pg8::u32x4){w[4], w[5], w[6], w[7]};
    asm volatile("s_waitcnt lgkmcnt(0)" ::: "memory");
}
__device__ __forceinline__ void phase_cvt_moe(const Ctx& c, LAS float* ldsf) {
    LAS unsigned char* img = (LAS unsigned char*)ldsf;
    unsigned char* W13 = (unsigned char*)(c.ws + WS_W13); unsigned char* W2T = (unsigned char*)(c.ws + WS_W2);
    for (int id = blockIdx.x; id < DEPTH * NE * 192; id += gridDim.x) {
        const int le = id / 192; int r = id - le * 192;
        const float* sp; int ldw, K; unsigned char* dst; int rowl;
        if (r < 128) { const int kt = r >> 4, pn = r & 15, half = c.lane >> 5, n4 = c.lane & 31;
            sp = (half ? c.in[IN_W3] : c.in[IN_W1]) + (size_t)le * D * FF + (size_t)(128 * kt + 16 * c.wave) * FF + 128 * pn + 4 * n4; ldw = FF; K = D;
            dst = W13 + (size_t)le * 4096 * D + (size_t)(256 * pn) * D + 128 * kt; rowl = 128 * half + 4 * n4;
        } else { r -= 128; const int kt = r >> 2, pn = r & 3;
            sp = c.in[IN_W2] + (size_t)le * FF * D + (size_t)(128 * kt + 16 * c.wave) * D + 256 * pn + 4 * c.lane; ldw = D; K = FF;
            dst = W2T + (size_t)le * D * FF + (size_t)(256 * pn) * FF + 128 * kt; rowl = 4 * c.lane; }
        f32x4 v[16];
#pragma unroll
        for (int q = 0; q < 16; ++q) v[q] = *(const f32x4*)(sp + (size_t)q * ldw);
        __syncthreads();
#pragma unroll
        for (int j = 0; j < 4; ++j) {
            pg8::u32x4 w;
#pragma unroll
            for (int q4 = 0; q4 < 4; ++q4) w[q4] = pg8::pk4_fp8(v[4 * q4][j] * pg8::W8_SCALE, v[4 * q4 + 1][j] * pg8::W8_SCALE, v[4 * q4 + 2][j] * pg8::W8_SCALE, v[4 * q4 + 3][j] * pg8::W8_SCALE);
            const int row = rowl + j;
            *(LAS pg8::u32x4*)(img + row * 128 + ((c.wave ^ ((row >> 2) & 7)) * 16)) = w;
        }
        __syncthreads();
#pragma unroll
        for (int i4 = 0; i4 < 4; ++i4) { const int p = c.tid + 512 * i4, row = p >> 3, ch = p & 7;
            *(pg8::u32x4*)(dst + (size_t)row * K + 16 * ch) = *(const LAS pg8::u32x4*)(img + row * 128 + ((ch ^ ((row >> 2) & 7)) * 16)); }
    }
    __syncthreads();
    LAS float* scr = ldsf + c.wave * (64 * 33);
    unsigned short* WIN = (unsigned short*)(c.ws + WS_WIN); unsigned short* WOUT = (unsigned short*)(c.ws + WS_WOUT); unsigned short* WGLU = (unsigned short*)(c.ws + WS_WGLU);
    for (int id = c.gw; id < 2 * (1408 + 512 + 1024); id += c.ngw) {
        const int i = id / 2944; int r = id - i * 2944;
        if (r < 1408) { const int kb = r / 88, nb = r - kb * 88; cvt_item(c.in[IN_MIXIN] + (size_t)i * D * INW, INW, 64 * kb, 32 * nb, WIN + (size_t)i * INW * D, D, 32 * nb, scr, c.lane); }
        else if (r < 1920) { r -= 1408; const int kb = r >> 5, nb = r & 31; cvt_item(c.in[IN_MIXOUT] + (size_t)i * D * D, D, 64 * kb, 32 * nb, WOUT + (size_t)i * D * D, D, 32 * nb, scr, c.lane); }
        else { r -= 1920; const int kb = r >> 6, nb = r & 63, pn = nb >> 3, rr0 = (nb & 7) * 32;
            cvt_item(c.in[IN_GLUW] + (size_t)i * D * 2048, 2048, 64 * kb, (rr0 < 128 ? 0 : 1024) + 128 * pn + (rr0 & 127), WGLU + (size_t)i * 2048 * D, D, 32 * nb, scr, c.lane); }
    }
}

struct ALDense { const float* A; int lda; size_t gstride; __device__ __forceinline__ const float* row(int g, int r) const { return A + (size_t)g * gstride + (size_t)r * lda; } };
struct ALGather { const float* A; const int* idx; __device__ __forceinline__ const float* row(int g, int r) const { return A + (size_t)idx[g * EROWS + r] * D; } };
struct BL1 { const float* B; int ldb; size_t gstride; __device__ __forceinline__ const float* ptr(int g, int) const { return B + (size_t)g * gstride; } };
struct BL2 { const float* Ba; const float* Bb; int ldb; size_t gstride; __device__ __forceinline__ const float* ptr(int g, int sub) const { return (sub ? Bb : Ba) + (size_t)g * gstride; } };
struct EPStore { float* O; int ldc; __device__ __forceinline__ void operator()(int, int row, int col, float v, float) const { O[(size_t)row * ldc + col] = v; } };
struct EPResid { float* X; const float* mod; int L; __device__ __forceinline__ void operator()(int, int row, int col, float v, float) const {
    const int j = row_j(row); const float g1 = mod[((size_t)(L * 9 + j) * 6 + 2) * 1024 + col]; X[(size_t)row * D + col] += g1 * v; } };
struct EPGlu { float* X; const float* mod; const float* bias; int L; __device__ __forceinline__ void operator()(int, int row, int col, float va, float vb) const {
    const int j = row_j(row); const float g1 = mod[((size_t)(L * 9 + j) * 6 + 2) * 1024 + col];
    const float o = (va + bias[col]) * sigmoidf_(vb + bias[1024 + col]); X[(size_t)row * D + col] += g1 * o; } };
struct EPSwiglu { float* HID; __device__ __forceinline__ void operator()(int g, int row, int col, float va, float vb) const { HID[((size_t)g * EROWS + row) * FF + col] = siluf_(va) * vb; } };
struct EPGate { float* Y; const float* gate; __device__ __forceinline__ void operator()(int g, int row, int col, float v, float) const { Y[((size_t)g * EROWS + row) * D + col] = gate[g * EROWS + row] * v; } };

__global__ void __launch_bounds__(512, 2) fwd(Args args) {
    extern __shared__ __attribute__((aligned(16))) unsigned char lds[];
    Ctx c; c.in = args.in; c.out = args.out; c.ws = args.ws;
    c.wave = __builtin_amdgcn_readfirstlane((int)threadIdx.x >> 6); c.lane = lane_id(); c.tid = c.wave * 64 + c.lane;
    c.gw = blockIdx.x * 8 + c.wave; c.ngw = gridDim.x * 8; c.gt = blockIdx.x * 512 + c.tid; c.ngt = gridDim.x * 512;
    LAS float* ldsf = (LAS float*)lds; LAS unsigned char* ldsb = (LAS unsigned char*)lds;
    volatile LAS unsigned* MISC = (volatile LAS unsigned*)((LAS unsigned char*)lds + MISC_OFF);
    if (c.tid < 32) MISC[c.tid] = 0u;
    __syncthreads();
    const int lo = args.ph_lo, hi = args.ph_hi;
    const bool one_launch = (hi - lo) > 1;
    XcdBarrier bar; bar.bar = (unsigned*)(c.ws + WS_CTL) + CW_BAR; bar.x = 0; bar.st = MISC + 8; bar.wave = c.wave;
    if (one_launch) bar = xcd_barrier_post((unsigned*)(c.ws + WS_CTL) + CW_BAR, MISC + 8);
#define IN(k) (lo <= (k) && (k) < hi)
#define SEAM(k) do { if ((k) + 1 < hi) xcd_barrier(bar); } while (0)
#define FRESH(cc) Ctx cc; unsigned zq; asm volatile("s_mov_b32 %0, 0" : "=s"(zq)); cc.ws = c.ws + zq; cc.out = c.out + zq; cc.in = (const float* const*)((const char*)c.in + zq); \
    { int lq = lane_id(); asm volatile("" : "+v"(lq)); cc.wave = c.wave + (int)zq; cc.lane = lq; cc.tid = cc.wave * 64 + lq; const int tq = cc.tid; cc.gw = blockIdx.x * 8 + cc.wave; cc.ngw = gridDim.x * 8; cc.gt = blockIdx.x * 512 + tq; cc.ngt = gridDim.x * 512; } \
    const int Lq = L + (int)zq, iq = Lq >> 1; const float* MOD = (const float*)(cc.ws + WS_MOD); (void)MOD; (void)iq

    if (IN(PH_PRO)) { const int L = 0; FRESH(cc); phase_pro(cc, ldsf); __syncthreads(); phase_s5_ops(cc, ldsf); __syncthreads(); phase_cvt_moe(cc, ldsf); SEAM(PH_PRO); }

#define LAYER_BODY(LL) { constexpr int L = LL; \
        const int pb = 1 + L * PH_PER_LAYER; \
        if (IN(pb + 0)) { FRESH(cc); phase_norm1<false, (L & 1) != 0>(cc, Lq); SEAM(pb + 0); } \
        if ((L & 1) == 0) { \
            if (IN(pb + 1)) { \
                FRESH(cc); \
                pg8::GOrder S; S.init(1, NROWS, INW, (int)gridDim.x, (int)blockIdx.x); \
                pg8::ADense al{(const pg8::bf16_t*)(cc.ws + WS_HB1), 0, nullptr, 0, D, 0, 64}; pg8::EpiBf16 ep{(pg8::bf16_t*)(cc.ws + WS_P), INW}; \
                pg8::gemm_phase(ldsb, al, (const pg8::bf16_t*)(cc.ws + WS_WIN) + (size_t)iq * INW * D, 0, D, S, ep, cc.wave); SEAM(pb + 1); } \
            if (IN(pb + 2)) { FRESH(cc); phase_post(cc, iq, ldsb); SEAM(pb + 2); } \
            if (IN(pb + 4)) { FRESH(cc); phase_ret_prefix(cc, iq); \
                  \
                unsigned* cnt = (unsigned*)(cc.ws + WS_CTL) + CW_CNT + 64 * L; \
                asm volatile("s_waitcnt vmcnt(0)" ::: "memory"); __syncthreads(); \
                if (cc.tid == 0) { __builtin_amdgcn_fence(__ATOMIC_RELEASE, "agent"); asm volatile("s_waitcnt vmcnt(0)" ::: "memory"); (void)xb_add(cnt, 1u); } \
                phase_attention(cc, (char*)lds); \
                if (cc.tid == 0) { unsigned* tb = (unsigned*)(cc.ws + WS_CTL) + CW_BAR; XB_SPIN(xb_ld(cnt) < gridDim.x, tb); __builtin_amdgcn_fence(__ATOMIC_ACQUIRE, "agent"); asm volatile("s_waitcnt vmcnt(0)" ::: "memory"); } \
                __syncthreads(); \
                phase_ret_main(cc, iq, ldsb); SEAM(pb + 4); } \
            if (IN(pb + 6)) { \
                FRESH(cc); \
                pg8::GOrder S; S.init(1, NROWS, D, (int)gridDim.x, (int)blockIdx.x); \
                pg8::ADense al{(const pg8::bf16_t*)(cc.ws + WS_MIX), 0, nullptr, 0, D, 0, 64}; pg8::EpiResid ep{(pg8::bf16_t*)(cc.ws + WS_X), MOD + (size_t)Lq * 9 * 6144}; \
                pg8::gemm_phase(ldsb, al, (const pg8::bf16_t*)(cc.ws + WS_WOUT) + (size_t)iq * D * D, 0, D, S, ep, cc.wave); SEAM(pb + 6); } \
        } else { \
            if (IN(pb + 1)) { \
                FRESH(cc); \
                pg8::GOrder S; S.init(64, 1280, 256, (int)gridDim.x, (int)blockIdx.x); \
                pg8::ADense al{(const pg8::bf16_t*)(cc.ws + WS_AS5), (size_t)1280 * 768, nullptr, 0, 768, 0, 64}; pg8::EpiF32 ep{(float*)(cc.ws + WS_SL), 256, (size_t)1280 * 256}; \
                pg8::gemm_phase(ldsb, al, (const pg8::bf16_t*)(cc.ws + WS_WS5) + (size_t)iq * 64 * 256 * 512, (size_t)256 * 512, 512, S, ep, cc.wave); SEAM(pb + 1); } \
            if (IN(pb + 2)) { FRESH(cc); phase_s5_carry(cc, iq); SEAM(pb + 2); } \
            if (IN(pb + 3)) { \
                FRESH(cc); \
                pg8::GOrder S; S.init(64, 1280, 512, (int)gridDim.x, (int)blockIdx.x); \
                pg8::ADense al{(const pg8::bf16_t*)(cc.ws + WS_AS5), (size_t)1280 * 768, nullptr, 0, 768, 0, 64}; pg8::EpiGeluBf16 ep{(pg8::bf16_t*)(cc.ws + WS_ZG), 512, (size_t)1280 * 512}; \
                pg8::gemm_phase(ldsb, al, (const pg8::bf16_t*)(cc.ws + WS_TV) + (size_t)iq * 64 * 512 * 768, (size_t)512 * 768, 768, S, ep, cc.wave); SEAM(pb + 3); } \
            if (IN(pb + 4)) { \
                FRESH(cc); \
                pg8::GOrder S; S.init(1, NROWS, 2048, (int)gridDim.x, (int)blockIdx.x, L == DEPTH - 1); \
                pg8::ADense al{(const pg8::bf16_t*)(cc.ws + WS_ZG), 0, nullptr, 0, 16, 1280 * 512, (size_t)4 * 1280 * 512}; pg8::EpiGluResid ep{(pg8::bf16_t*)(cc.ws + WS_X), MOD + (size_t)Lq * 9 * 6144, cc.in[IN_GLUB] + (size_t)iq * 2048}; \
                pg8::gemm_phase(ldsb, al, (const pg8::bf16_t*)(cc.ws + WS_WGLU) + (size_t)iq * 2048 * D, 0, D, S, ep, cc.wave); SEAM(pb + 4); } \
        } \
        if (IN(pb + 7)) { FRESH(cc); phase_norm2_router<L == DEPTH - 1>(cc, Lq, ldsf); SEAM(pb + 7); } \
        if (IN(pb + 8)) { FRESH(cc); phase_topk(cc, (LAS unsigned*)lds, L == DEPTH - 1 ? 128 : 256); SEAM(pb + 8); } \
        if (IN(pb + 9)) { \
            FRESH(cc); \
            pg8::GOrder S; S.init(NE, L == DEPTH - 1 ? NB * CAP_LAT : EROWS, 2 * FF, (int)gridDim.x, (int)blockIdx.x); \
            pg8::ADense al{(const pg8::bf16_t*)(cc.ws + WS_XS), (size_t)EROWS * D, nullptr, 0, D, 0, 128}; \
            pg8::EpiSwiglu ep{(unsigned char*)(cc.ws + WS_HID), FF, (size_t)EROWS * FF}; \
            pg8::gemm_phase<true>(ldsb, al, (const unsigned char*)(cc.ws + WS_W13) + (size_t)Lq * NE * 4096 * D, (size_t)4096 * D, D, S, ep, cc.wave); SEAM(pb + 9); } \
        if (IN(pb + 10)) { \
            FRESH(cc); \
            pg8::GOrder S; S.init(NE, L == DEPTH - 1 ? NB * CAP_LAT : EROWS, D, (int)gridDim.x, (int)blockIdx.x); \
            pg8::ADense al{(const pg8::bf16_t*)(cc.ws + WS_HID), (size_t)EROWS * FF, nullptr, 0, FF, 0, 128}; \
            pg8::EpiGate ep{(unsigned char*)(cc.ws + WS_Y), D, (size_t)EROWS * D, (const float*)(cc.ws + WS_SELGATE), EROWS}; \
            pg8::gemm_phase<true>(ldsb, al, (const unsigned char*)(cc.ws + WS_W2) + (size_t)Lq * NE * D * FF, (size_t)D * FF, FF, S, ep, cc.wave); SEAM(pb + 10); } \
    }
    LAYER_BODY(0) LAYER_BODY(1) LAYER_BODY(2) LAYER_BODY(3)
#undef LAYER_BODY
    if (IN(PH_FIN)) { const int L = DEPTH; FRESH(cc); phase_norm1<true, false>(cc, DEPTH); }
#undef IN
#undef SEAM
}

static bool phase_valid(int ph) {
    if (ph == PH_PRO || ph == PH_FIN) return true;
    const int L = (ph - 1) / PH_PER_LAYER, k = (ph - 1) % PH_PER_LAYER;
    if (L & 1) return !(k >= 5 && k <= 6);
    return k != 3 && k != 5;
}
extern "C" void kernel_launch(void* const* d_in, const int* in_sizes, int n_in, void* d_out, int out_size, void* d_ws, size_t ws_size, hipStream_t stream) {
    static int grid = 0;
    if (grid == 0) {
        if (n_in != 27 || out_size != NB * T * D || ws_size < WS_END) { fprintf(stderr, "kernel_launch: unexpected shapes (n_in %d out %d ws %zu)\n", n_in, out_size, ws_size); grid = -1; return; }
        int dev = 0, cus = 0;
        if (hipGetDevice(&dev) != hipSuccess || hipDeviceGetAttribute(&cus, hipDeviceAttributeMultiprocessorCount, dev) != hipSuccess) { grid = -1; return; }
        if (hipFuncSetAttribute((const void*)fwd, hipFuncAttributeMaxDynamicSharedMemorySize, LDS_BYTES) != hipSuccess) { grid = -1; return; }
        int per_cu = 0;
        if (hipOccupancyMaxActiveBlocksPerMultiprocessor(&per_cu, (const void*)fwd, 512, LDS_BYTES) != hipSuccess || per_cu < 1) fprintf(stderr, "kernel_launch: occupancy query says %d\n", per_cu);
        (void)hipGetLastError();
        grid = cus;
    }
    if (grid < 0) return;
    if (hipMemsetAsync((char*)d_ws + WS_CTL, 0, CTL_ZERO_BYTES, stream) != hipSuccess) return;
    Args a{};
    for (int i = 0; i < 27; ++i) a.in[i] = (const float*)d_in[i];
    a.out = (float*)d_out; a.ws = (unsigned char*)d_ws;
#if MK_MULTI
    for (int ph = 0; ph < NPH; ++ph) {
        if (!phase_valid(ph)) continue;
        a.ph_lo = ph; a.ph_hi = ph + 1;
        hipLaunchKernelGGL(fwd, dim3(grid), dim3(512), LDS_BYTES, stream, a);
    }
#else
    a.ph_lo = 0; a.ph_hi = NPH;
    hipLaunchKernelGGL(fwd, dim3(grid), dim3(512), LDS_BYTES, stream, a);
#ifdef PROBE_PHASES
    { static const int probe[] = {PROBE_PHASES}; for (unsigned q = 0; q < sizeof(probe) / sizeof(probe[0]); ++q) { a.ph_lo = probe[q]; a.ph_hi = probe[q] + 1; hipLaunchKernelGGL(fwd, dim3(grid), dim3(512), LDS_BYTES, stream, a); } }
#endif
#endif
}
```

```cpp
#include <hip/hip_runtime.h>
#include <hip/hip_bf16.h>
#include <cstdio>
#include <cstdint>

#define GAS __attribute__((address_space(1)))
#define LAS __attribute__((address_space(3)))
typedef float f32x4 __attribute__((ext_vector_type(4)));
typedef float f32x16 __attribute__((ext_vector_type(16)));

constexpr int NB = 8, T = 4096, D = 1024, CL = 256, RB = CL + T  , NROWS = NB * RB  ;
constexpr int DEPTH = 4, NE = 16, FF = 2048, INW = 2816;
constexpr int CAP_LAT = 512, CAP_CTX = 32, EROWS = NB * (CAP_LAT + CAP_CTX)  ;
constexpr float EPS = 1e-6f;
#ifndef MK_MULTI
#define MK_MULTI 0
#endif

constexpr size_t MiB = 1u << 20;
constexpr size_t WS_CTL = 0, CTL_ZERO_BYTES = 1 * MiB;
constexpr size_t WS_MOD = 1 * MiB;
constexpr size_t WS_ROPE = 2 * MiB;
constexpr size_t WS_SELROW = 3 * MiB;
constexpr size_t WS_SELGATE = 3 * MiB + 512 * 1024;
constexpr size_t WS_AFF = 4 * MiB;
constexpr size_t WS_SLOT = 7 * MiB;
constexpr size_t WS_X = 10 * MiB;
constexpr size_t WS_TV = 146 * MiB;
constexpr size_t WS_WS5 = 242 * MiB;
constexpr size_t WS_HB = 282 * MiB;
constexpr size_t WS_W13 = 350 * MiB;
constexpr size_t WS_W2 = 862 * MiB;
constexpr size_t WS_WIN = 1118 * MiB;
constexpr size_t WS_WOUT = 1130 * MiB;
constexpr size_t WS_WGLU = 1134 * MiB;
constexpr size_t WS_HB1 = 1144 * MiB;
constexpr size_t WS_BIG = 1212 * MiB;
constexpr size_t WS_P = WS_BIG;
constexpr size_t WS_RQ = WS_BIG + 374 * MiB;
constexpr size_t WS_RK = WS_BIG + 408 * MiB;
constexpr size_t WS_RV = WS_BIG + 442 * MiB;
constexpr size_t WS_ET = WS_BIG + 476 * MiB;
constexpr size_t WS_MIX = WS_BIG + 510 * MiB;
constexpr size_t WS_QA = WS_BIG + 578 * MiB;
constexpr size_t WS_KA = WS_BIG + 612 * MiB;
constexpr size_t WS_VA = WS_BIG + 621 * MiB;
constexpr size_t WS_U = WS_BIG + 630 * MiB;
constexpr size_t WS_AS5 = WS_BIG;
constexpr size_t WS_SL = WS_BIG + 120 * MiB;
constexpr size_t WS_ZG = WS_BIG + 200 * MiB;
constexpr size_t WS_HID = WS_BIG;
constexpr size_t WS_XS = WS_BIG + 136 * MiB;
constexpr size_t WS_Y = WS_BIG + 272 * MiB;
constexpr size_t WS_END = WS_BIG + 698 * MiB;
constexpr int CW_BAR = 4096, CW_CNT = 8192;

constexpr int LDS_BYTES = 147456;
constexpr int MISC_OFF = 131072 + 320;

constexpr int PH_PRO = 0, PH_PER_LAYER = 11, PH_FIN = 1 + DEPTH * PH_PER_LAYER, NPH = PH_FIN + 1;

#define XB_TMO      128
#define XB_XCNT(j)  (256  + 64 * (j))
#define XB_XSUB(j)  (1280 + 64 * (j))
#define XB_XGEN(j)  (2304 + 64 * (j))
#define XB_TOP      3328
#define XB_TOPGEN   3392
#define XCD_BAR_WORDS 3456
#define XB_SPIN_CAP (1u << 22)

__device__ __forceinline__ unsigned xb_ld(unsigned* p)              { return __hip_atomic_load(p, __ATOMIC_RELAXED, __HIP_MEMORY_SCOPE_AGENT); }
__device__ __forceinline__ unsigned xb_add(unsigned* p, unsigned v) { return __hip_atomic_fetch_add(p, v, __ATOMIC_RELAXED, __HIP_MEMORY_SCOPE_AGENT); }
__device__ __forceinline__ unsigned xb_xcc_id() { return (unsigned)__builtin_amdgcn_s_getreg((3 << 11) | 20) & 0xFu; }
#define XB_SPIN(cond, bar) do { unsigned _sp = 0; while (cond) { __builtin_amdgcn_s_sleep(1); \
    if ((++_sp & 255u) == 0u) { if (xb_ld(&(bar)[XB_TMO])) break; if (_sp > XB_SPIN_CAP) { atomicAdd(&(bar)[XB_TMO], 1u); break; } } } } while (0)

__device__ __forceinline__ int lane_id() { int l; asm volatile("v_mbcnt_lo_u32_b32 %0, -1, 0\n\tv_mbcnt_hi_u32_b32 %0, -1, %0" : "=v"(l)); return l; }
struct XcdBarrier { unsigned* bar; unsigned x; volatile LAS unsigned* st; int wave; };

__device__ __forceinline__ XcdBarrier xcd_barrier_post(unsigned* bar, volatile LAS unsigned* st) {
    XcdBarrier b; b.bar = bar; b.x = xb_xcc_id(); b.st = st; b.wave = __builtin_amdgcn_readfirstlane((int)threadIdx.x >> 6);
    if (threadIdx.x == 0) (void)xb_add(&bar[XB_XCNT(b.x)], 1u);
    return b;
}
__device__ __forceinline__ void xcd_barrier_complete(unsigned* bar, unsigned x, unsigned& nloc, unsigned& nx) {
    const unsigned G = gridDim.x * gridDim.y * gridDim.z;
    unsigned sum, cnt, mine, sp = 0u;
    for (;;) {
        sum = 0u; cnt = 0u; mine = 0u;
#pragma unroll
        for (unsigned j = 0; j < 16; ++j) { const unsigned c = xb_ld(&bar[XB_XCNT(j)]); sum += c; cnt += (c > 0u) ? 1u : 0u; mine = (j == x) ? c : mine; }
        if (sum == G) break;
        __builtin_amdgcn_s_sleep(1);
        if ((++sp & 255u) == 0u) { if (xb_ld(&bar[XB_TMO])) break; if (sp > XB_SPIN_CAP) { atomicAdd(&bar[XB_TMO], 1u); break; } }
    }
    nloc = mine > 0u ? mine : 1u; nx = cnt > 0u ? cnt : 1u;
}
__device__ __forceinline__ void xcd_barrier(const XcdBarrier& b) {
    asm volatile("s_waitcnt vmcnt(0)" ::: "memory");
    __syncthreads();
    if (b.wave == 0 && lane_id() == 0) {
        unsigned* bar = b.bar;
        __builtin_amdgcn_s_waitcnt(0);
        unsigned nloc = b.st[0], nx = b.st[1];
        if (nloc == 0u) { xcd_barrier_complete(bar, b.x, nloc, nx); b.st[0] = nloc; b.st[1] = nx; }
        const unsigned old = xb_add(&bar[XB_XSUB(b.x)], 1u);
        const unsigned gen = old / nloc;
        if (old + 1u == (gen + 1u) * nloc) {
            __builtin_amdgcn_fence(__ATOMIC_RELEASE, "agent");
            asm volatile("s_waitcnt vmcnt(0)" ::: "memory");
            const unsigned og = xb_add(&bar[XB_TOP], 1u);
            const unsigned tg = og / nx;
            if (og + 1u == (tg + 1u) * nx) xb_add(&bar[XB_TOPGEN], 1u);
            else XB_SPIN(xb_ld(&bar[XB_TOPGEN]) == tg, bar);
            __builtin_amdgcn_fence(__ATOMIC_ACQUIRE, "agent");
            xb_add(&bar[XB_XGEN(b.x)], 1u);
            asm volatile("s_waitcnt vmcnt(0)" ::: "memory");
        } else {
            XB_SPIN(xb_ld(&bar[XB_XGEN(b.x)]) == gen, bar);
            __builtin_amdgcn_fence(__ATOMIC_ACQUIRE, "agent");
            asm volatile("s_waitcnt vmcnt(0)" ::: "memory");
        }
    }
    __syncthreads();
}

struct Args { const float* in[27]; float* out; unsigned char* ws; int ph_lo, ph_hi; };

struct Ctx {
    const float* const* in; float* out; unsigned char* ws;
    int tid, lane, wave, gw, ngw, gt, ngt;
};
enum { IN_X = 0, IN_C, IN_CTX, IN_CCTX, IN_MODW, IN_MODB, IN_NORMG, IN_MIXIN, IN_MIXOUT, IN_RETRATE, IN_RETGN, IN_QKG,
       IN_S5ARE, IN_S5AIM, IN_S5DT, IN_S5BRE, IN_S5BIM, IN_S5CRE, IN_S5CIM, IN_S5D, IN_GLUW, IN_GLUB, IN_ROUTER, IN_W1, IN_W3, IN_W2, IN_FNG };

__device__ __forceinline__ float wave_sum(float v) {
#pragma unroll
    for (int o = 1; o < 64; o <<= 1) v += __shfl_xor(v, o);
    return v;
}
__device__ __forceinline__ float sigmoidf_(float x) { return 1.0f / (1.0f + expf(-x)); }
__device__ __forceinline__ float siluf_(float x) { return x * sigmoidf_(x); }
__device__ __forceinline__ float gelu_tanh(float x) { const float u = 0.7978845608028654f * (x + 0.044715f * x * x * x); return 0.5f * x * (1.0f + tanhf(u)); }
__device__ __forceinline__ const float* modp(const Ctx& c, int L, int j, int chunk) { return (const float*)(c.ws + WS_MOD) + ((size_t)(L * 9 + j) * 6 + chunk) * 1024; }
__device__ __forceinline__ int row_j(int row) { const int b = row / RB, s = row - b * RB; return s < CL ? 8 : b; }

__device__ __forceinline__ float reduce16(const float (&v)[16], int lane) {
    float a[8], b[4], c2[2], d;
    const bool b5 = (lane & 32) != 0, b4 = (lane & 16) != 0, b3 = (lane & 8) != 0, b2 = (lane & 4) != 0;
#pragma unroll
    for (int i = 0; i < 8; ++i) { const float keep = b5 ? v[8 + i] : v[i], send = b5 ? v[i] : v[8 + i]; a[i] = keep + __shfl_xor(send, 32); }
#pragma unroll
    for (int i = 0; i < 4; ++i) { const float keep = b4 ? a[4 + i] : a[i], send = b4 ? a[i] : a[4 + i]; b[i] = keep + __shfl_xor(send, 16); }
#pragma unroll
    for (int i = 0; i < 2; ++i) { const float keep = b3 ? b[2 + i] : b[i], send = b3 ? b[i] : b[2 + i]; c2[i] = keep + __shfl_xor(send, 8); }
    { const float keep = b2 ? c2[1] : c2[0], send = b2 ? c2[0] : c2[1]; d = keep + __shfl_xor(send, 4); }
    d += __shfl_xor(d, 2); d += __shfl_xor(d, 1);
    return d;
}
__device__ __forceinline__ int reduce16_k(int lane) { return ((lane >> 5) & 1) * 8 + ((lane >> 4) & 1) * 4 + ((lane >> 3) & 1) * 2 + ((lane >> 2) & 1); }

namespace pg8 {
typedef unsigned short bf16_t;
typedef short bf16x8 __attribute__((ext_vector_type(8)));
typedef unsigned u32x4 __attribute__((ext_vector_type(4)));
typedef unsigned u32x2 __attribute__((ext_vector_type(2)));
typedef int v8i32 __attribute__((ext_vector_type(8)));
typedef int v4i32 __attribute__((ext_vector_type(4)));
constexpr int BM = 256, BK = 64, HALF = 128, HTB = HALF * BK * 2, STAGE_BYTES = 8 * HTB, NXCD = 8, WGM = 8;
__host__ __device__ __forceinline__ int lds_byte(int r, int c) { const int st = (r >> 4) * 2 + (c >> 5), rr = r & 15, cc = c & 31, ob = rr * 64 + cc * 2; return st * 1024 + (ob ^ (((ob >> 9) & 1) << 5)); }
__host__ __device__ __forceinline__ void stage_rc(int b, int& R, int& C) { const int st = b / 1024, sb = b % 1024, swz = sb ^ (((sb >> 9) & 1) << 5); R = (st >> 1) * 16 + swz / 64; C = (st & 1) * 32 + (swz % 64) / 2; }
__host__ __device__ __forceinline__ int perm32(int rho) { const int n = rho >> 4, i = rho & 15; return 8 * (i >> 2) + 4 * n + (i & 3); }
__device__ __forceinline__ unsigned cvt_pk_bf16(float lo, float hi) { unsigned r; asm volatile("v_cvt_pk_bf16_f32 %0, %1, %2" : "=v"(r) : "v"(lo), "v"(hi)); return r; }

__device__ __forceinline__ unsigned pk4_fp8(float a, float b, float c, float d) {
    a = __builtin_amdgcn_fmed3f(a, -448.f, 448.f); b = __builtin_amdgcn_fmed3f(b, -448.f, 448.f); c = __builtin_amdgcn_fmed3f(c, -448.f, 448.f); d = __builtin_amdgcn_fmed3f(d, -448.f, 448.f);
    unsigned w = 0u; w = (unsigned)__builtin_amdgcn_cvt_pk_fp8_f32(a, b, (int)w, false); w = (unsigned)__builtin_amdgcn_cvt_pk_fp8_f32(c, d, (int)w, true); return w; }
__device__ __forceinline__ f32x4 bf4_to_f32(u32x2 w) { return (f32x4){__uint_as_float(w.x << 16), __uint_as_float(w.x & 0xffff0000u), __uint_as_float(w.y << 16), __uint_as_float(w.y & 0xffff0000u)}; }
__device__ __forceinline__ u32x2 f32_to_bf4(f32x4 v) { return (u32x2){cvt_pk_bf16(v.x, v.y), cvt_pk_bf16(v.z, v.w)}; }
constexpr float W8_SCALE = 32.0f, W8_INV = 1.0f / 32.0f;
struct Unit { int pm, pn, g; };
struct GOrder {
    int nM, nN, per, nwg, G, c, skipctx;
    __device__ __forceinline__ void init(int groups, int M, int N, int G_, int c_, int skipctx_ = 0) { nM = M / BM; if (skipctx_) nM -= nM / 17; nN = N / BM; per = nM * nN; nwg = groups * per; G = G_; c = c_; skipctx = skipctx_; }
    __device__ __forceinline__ bool next(int i, Unit& u) const {
        const long L = (long)i * G + c; if (L >= nwg) return false;
        int wgid = (int)L; { const int q = nwg / NXCD, r = nwg % NXCD, xcd = wgid % NXCD, off = wgid / NXCD; wgid = (xcd < r ? xcd * (q + 1) : r * (q + 1) + (xcd - r) * q) + off; }
        u.g = wgid / per; const int w = wgid - u.g * per;
        const int nig = WGM * nN, gid = w / nig, fm = gid * WGM, gsz = (nM - fm) < WGM ? (nM - fm) : WGM;
        u.pm = fm + ((w % nig) % gsz); u.pn = (w % nig) / gsz; if (skipctx) u.pm += (u.pm >> 4) + 1;
        return true;
    }
};
struct ADense  { static constexpr bool GATHER = false; const bf16_t* A; size_t gstride; const int* idx; int rpg; unsigned rowpitch; unsigned cgrp; size_t kstep; };
struct AGather { static constexpr bool GATHER = true;  const bf16_t* A; size_t gstride; const int* idx; int rpg; unsigned rowpitch; unsigned cgrp; size_t kstep; };

template <bool FP8 = false, class Epi, class ALoc>
__device__ __forceinline__ void gemm_phase(LAS unsigned char* lds, const ALoc AL, const void* Bt, size_t gstrideB, int K, const GOrder& S, const Epi& E, int wave_) {
    constexpr bool GATHER = ALoc::GATHER; constexpr unsigned ESZ = FP8 ? 1u : 2u;
    const int wid = wave_, lane = lane_id(), tid = wid * 64 + lane, wr = wid >> 2, wc = wid & 3, fr = lane & 15, fq = lane >> 4;
    const int nt = (int)((unsigned)K * ESZ / 128u);
    unsigned voffA[2], voffB[2];
#pragma unroll
    for (int i = 0; i < 2; ++i) { int R, C; stage_rc(tid * 16 + i * 8192, R, C); const int Rb = Epi::PERM ? ((R & ~31) + perm32(R & 31)) : R;
        const unsigned cbytes = AL.cgrp ? ((unsigned)(C >> 4) * AL.cgrp + (unsigned)(C & 15)) * 2u : (unsigned)C * 2u;
        voffA[i] = (unsigned)R * AL.rowpitch * ESZ + cbytes; voffB[i] = (unsigned)Rb * (unsigned)K * ESZ + (unsigned)C * 2u; }
    const size_t kstep = 128, kstepA = AL.kstep * ESZ;
    const size_t hstep = (size_t)HALF * K * ESZ;
    const size_t hstepA = GATHER ? 0 : (size_t)HALF * AL.rowpitch * ESZ, tstepA = 2 * (size_t)HALF * AL.rowpitch * ESZ;
    const size_t tstep = 2 * hstep;
    const unsigned ldsw = (unsigned)wid * 1024u;
    const int aoff0 = FP8 ? lds_byte(wr * 64 + fr, 16 * fq) : lds_byte(wr * 64 + fr, fq * 8);
    const int boff0 = FP8 ? lds_byte(wc * 32 + fr, 16 * fq) : lds_byte(wc * 32 + fr, fq * 8);
    constexpr int KOFF = FP8 ? 16 : 1024;
    unsigned vAc[2][2], vAn[2][2];
#define PG8_SA(b, h) (((b) * 2 + (h)) * HTB)
#define PG8_SB(b, h) ((4 + (b) * 2 + (h)) * HTB)
#define PG8_SBR(b, h) (((b) * 2 + (h)) * HTB)
#define PG8_OPQ(x) do { if constexpr (FP8) asm volatile("" : "+v"(x)); } while (0)
#define PG8_STAGE(bufoff, gbase, voff) do { _Pragma("unroll") for (int _i = 0; _i < 2; ++_i) { unsigned _o = (voff)[_i]; PG8_OPQ(_o); \
        __builtin_amdgcn_global_load_lds((const unsigned*)((const char*)(gbase) + _o), (LAS unsigned*)(lds + (bufoff) + ldsw + _i * 8192), 16, 0, 0); } } while (0)
#define PG8_STAGE_A(bufoff, gbase, h, nx) do { _Pragma("unroll") for (int _i = 0; _i < 2; ++_i) { \
        unsigned _o = GATHER ? ((nx) ? vAn[h][_i] : vAc[h][_i]) : voffA[_i]; PG8_OPQ(_o); \
        __builtin_amdgcn_global_load_lds((const unsigned*)((const char*)(gbase) + (size_t)(h) * hstepA + _o), (LAS unsigned*)(lds + (bufoff) + ldsw + _i * 8192), 16, 0, 0); } } while (0)
#define PG8_GIDX(u, v) do { if (GATHER) { int _t = tid; asm volatile("" : "+v"(_t));   \
        _Pragma("unroll") for (int _i = 0; _i < 2; ++_i) { int _R, _C; stage_rc(_t * 16 + _i * 8192, _R, _C); \
        _Pragma("unroll") for (int _h = 0; _h < 2; ++_h) v[_h][_i] = (unsigned)AL.idx[(u).g * AL.rpg + (u).pm * BM + _h * HALF + _R] * (AL.rowpitch * ESZ) + (unsigned)_C * 2u; } } } while (0)
#define PG8_ABASE(u) ((const char*)AL.A + (GATHER ? (size_t)0 : ((size_t)(u).g * AL.gstride * ESZ + (size_t)(u).pm * tstepA)))
#define PG8_BBASE(u) ((const char*)Bt + (size_t)(u).g * gstrideB * ESZ + (size_t)(u).pn * tstep)
#define PG8_LDA(dst, b, h) do { _Pragma("unroll") for (int m = 0; m < 4; ++m) _Pragma("unroll") for (int k = 0; k < 2; ++k) dst[m][k] = *(const LAS bf16x8*)(lds + PG8_SA(b, h) + aoff0 + k * KOFF + m * 2048); } while (0)
#define PG8_LDB(dst, b, h) do { _Pragma("unroll") for (int n = 0; n < 2; ++n) _Pragma("unroll") for (int k = 0; k < 2; ++k) dst[n][k] = *(const LAS bf16x8*)(lds + PG8_SB(b, h) + boff0 + k * KOFF + n * 2048); } while (0)
#define PG8_CAT8(x) __builtin_shufflevector(__builtin_bit_cast(v4i32, x[0]), __builtin_bit_cast(v4i32, x[1]), 0, 1, 2, 3, 4, 5, 6, 7)
#define PG8_MMA(ai, bj, At, Bt_) do { __builtin_amdgcn_s_setprio(1); _Pragma("unroll") for (int m = 0; m < 4; ++m) _Pragma("unroll") for (int n = 0; n < 2; ++n) { \
        if constexpr (FP8) acc[ai][bj][m][n] = __builtin_amdgcn_mfma_scale_f32_16x16x128_f8f6f4(PG8_CAT8(Bt_[n]), PG8_CAT8(At[m]), acc[ai][bj][m][n], 0, 0, 0, 0x7f7f7f7f, 0, 0x7f7f7f7f); \
        else { _Pragma("unroll") for (int k = 0; k < 2; ++k) acc[ai][bj][m][n] = __builtin_amdgcn_mfma_f32_16x16x32_bf16(Bt_[n][k], At[m][k], acc[ai][bj][m][n], 0, 0, 0); } } \
        __builtin_amdgcn_s_setprio(0); } while (0)
#define PG8_WAIT_V(n) asm volatile("s_waitcnt vmcnt(" #n ")" ::: "memory")
#define PG8_WAIT_L(n) asm volatile("s_waitcnt lgkmcnt(" #n ")" ::: "memory")
#define PG8_BAR __builtin_amdgcn_s_barrier()
#define PG8_SCHED __builtin_amdgcn_sched_barrier(0)
    Unit cur, nxt; int ui = 0;
    if (!S.next(0, cur)) return;
    PG8_GIDX(cur, vAc);
    f32x4 acc[2][2][4][2];
#pragma unroll
    for (int a = 0; a < 2; ++a)
#pragma unroll
        for (int b = 0; b < 2; ++b)
#pragma unroll
            for (int m = 0; m < 4; ++m)
#pragma unroll
                for (int n = 0; n < 2; ++n) acc[a][b][m][n] = (f32x4){0.f, 0.f, 0.f, 0.f};
    bf16x8 At[4][2], B0[2][2], B1[2][2];
    const char* cA = PG8_ABASE(cur); const char* cB = PG8_BBASE(cur);
    PG8_STAGE(PG8_SB(0, 0), cB, voffB); PG8_STAGE(PG8_SB(0, 1), cB + hstep, voffB); PG8_STAGE_A(PG8_SA(0, 0), cA, 0, false); PG8_STAGE_A(PG8_SA(0, 1), cA, 1, false);
    if (wr == 1) PG8_BAR;
    PG8_WAIT_V(2); PG8_BAR;
    PG8_STAGE(PG8_SB(1, 0), cB + kstep, voffB); PG8_STAGE_A(PG8_SA(1, 0), cA + kstepA, 0, false); PG8_STAGE(PG8_SB(1, 1), cB + hstep + kstep, voffB);
    PG8_WAIT_V(6); PG8_BAR;
    for (;;) {
        const bool has_next = S.next(ui + 1, nxt);
        if (GATHER) { if (has_next) { PG8_GIDX(nxt, vAn); } }
        const char* nA = has_next ? PG8_ABASE(nxt) : cA; const char* nB = has_next ? PG8_BBASE(nxt) : cB;
        for (int t = 0; t < nt; t += 2) {
            const bool last = (t == nt - 2), lastn = last && has_next;
            const char* a1 = cA + (size_t)(t + 1) * kstepA;
            const char* a2 = last ? nA : cA + (size_t)(t + 2) * kstepA; const char* b2 = last ? nB : cB + (size_t)(t + 2) * kstep;
            const char* a3 = a2 + kstepA; const char* b3 = b2 + kstep;
            PG8_LDB(B0, 0, 0); PG8_LDB(B1, 0, 1); PG8_SCHED; PG8_LDA(At, 0, 0); PG8_STAGE_A(PG8_SA(1, 1), a1, 1, false);
            PG8_WAIT_V(8); PG8_WAIT_L(0); PG8_BAR; PG8_MMA(0, 0, At, B0); PG8_MMA(0, 1, At, B1); PG8_BAR; PG8_SCHED;
            PG8_LDA(At, 0, 1); PG8_STAGE(PG8_SB(0, 0), b2, voffB); PG8_STAGE(PG8_SB(0, 1), b2 + hstep, voffB); PG8_STAGE_A(PG8_SA(0, 0), a2, 0, lastn);
            PG8_WAIT_V(8); PG8_WAIT_L(0); PG8_BAR; PG8_MMA(1, 0, At, B0); PG8_MMA(1, 1, At, B1); PG8_BAR; PG8_SCHED;
            PG8_LDB(B0, 1, 0); PG8_LDB(B1, 1, 1); PG8_SCHED; PG8_LDA(At, 1, 0); PG8_STAGE_A(PG8_SA(0, 1), a2, 1, lastn);
            PG8_WAIT_V(8); PG8_WAIT_L(0); PG8_BAR; PG8_MMA(0, 0, At, B0); PG8_MMA(0, 1, At, B1); PG8_BAR; PG8_SCHED;
            PG8_LDA(At, 1, 1); PG8_STAGE(PG8_SB(1, 0), b3, voffB); PG8_STAGE(PG8_SB(1, 1), b3 + hstep, voffB); PG8_STAGE_A(PG8_SA(1, 0), a3, 0, lastn);
            PG8_WAIT_V(8); PG8_WAIT_L(0); PG8_BAR; PG8_MMA(1, 0, At, B0); PG8_MMA(1, 1, At, B1); PG8_BAR; PG8_SCHED;
        }
        if (wr == 0) PG8_BAR;
        E(acc, cur, wr, wc, fr, fq);
        if (!has_next) break;
#pragma unroll
        for (int a = 0; a < 2; ++a)
#pragma unroll
            for (int b = 0; b < 2; ++b)
#pragma unroll
                for (int m = 0; m < 4; ++m)
#pragma unroll
                    for (int n = 0; n < 2; ++n) acc[a][b][m][n] = (f32x4){0.f, 0.f, 0.f, 0.f};
        cur = nxt; cA = nA; cB = nB; ++ui;
        if (GATHER) {
#pragma unroll
            for (int _h = 0; _h < 2; ++_h)
#pragma unroll
                for (int _i = 0; _i < 2; ++_i) vAc[_h][_i] = vAn[_h][_i]; }
        if (wr == 1) PG8_BAR;
    }
    PG8_WAIT_V(0);
    PG8_BAR;
#undef PG8_SA
#undef PG8_SB
#undef PG8_SBR
#undef PG8_STAGE
#undef PG8_OPQ
#undef PG8_STAGE_A
#undef PG8_GIDX
#undef PG8_ABASE
#undef PG8_BBASE
#undef PG8_LDA
#undef PG8_CAT8
#undef PG8_LDB
#undef PG8_MMA
#undef PG8_WAIT_V
#undef PG8_WAIT_L
#undef PG8_BAR
#undef PG8_SCHED
}

__device__ __forceinline__ float fast_sigmoid(float x) { return __builtin_amdgcn_rcpf(1.0f + __builtin_amdgcn_exp2f(-1.4426950408889634f * x)); }
struct EpiSwiglu {
    static constexpr bool PERM = true;
    unsigned char* O; int ldc; size_t gstride;
    __device__ __forceinline__ void operator()(const f32x4 (&acc)[2][2][4][2], const Unit& u, int wr, int wc, int fr, int fq) const {
        const int row0 = u.pm * BM + wr * 64 + fr, col0 = u.pn * HALF + wc * 32 + 8 * fq;
        unsigned char* base = O + (size_t)u.g * gstride;
#pragma unroll
        for (int ai = 0; ai < 2; ++ai)
#pragma unroll
            for (int m = 0; m < 4; ++m) { unsigned char* rowp = base + (size_t)(row0 + ai * HALF + m * 16) * ldc + col0;
                f32x4 o[2];
#pragma unroll
                for (int n = 0; n < 2; ++n) {
                    const f32x4 a = acc[ai][0][m][n] * W8_INV, b = acc[ai][1][m][n] * W8_INV, t = a * (-1.4426950408889634f);
                    f32x4 e; e.x = __builtin_amdgcn_exp2f(t.x); e.y = __builtin_amdgcn_exp2f(t.y); e.z = __builtin_amdgcn_exp2f(t.z); e.w = __builtin_amdgcn_exp2f(t.w);
                    e = e + 1.0f;
                    f32x4 r; r.x = __builtin_amdgcn_rcpf(e.x); r.y = __builtin_amdgcn_rcpf(e.y); r.z = __builtin_amdgcn_rcpf(e.z); r.w = __builtin_amdgcn_rcpf(e.w);
                    o[n] = (a * b) * r; }
                *(u32x2*)rowp = (u32x2){pk4_fp8(o[0].x, o[0].y, o[0].z, o[0].w), pk4_fp8(o[1].x, o[1].y, o[1].z, o[1].w)}; }
    }
};
struct EpiBf16 {
    static constexpr bool PERM = true;
    bf16_t* O; int ldc;
    __device__ __forceinline__ void operator()(const f32x4 (&acc)[2][2][4][2], const Unit& u, int wr, int wc, int fr, int fq) const {
        const int row0 = u.pm * BM + wr * 64 + fr, col0 = u.pn * BM + wc * 32 + 8 * fq;
#pragma unroll
        for (int ai = 0; ai < 2; ++ai)
#pragma unroll
            for (int m = 0; m < 4; ++m) { bf16_t* rowp = O + (size_t)(row0 + ai * HALF + m * 16) * ldc + col0;
#pragma unroll
                for (int bj = 0; bj < 2; ++bj) { const f32x4 v0 = acc[ai][bj][m][0], v1 = acc[ai][bj][m][1];
                    u32x4 w; w.x = cvt_pk_bf16(v0[0], v0[1]); w.y = cvt_pk_bf16(v0[2], v0[3]); w.z = cvt_pk_bf16(v1[0], v1[1]); w.w = cvt_pk_bf16(v1[2], v1[3]);
                    *(u32x4*)(rowp + bj * HALF) = w; } }
    }
};
struct EpiGeluBf16 {
    static constexpr bool PERM = true;
    bf16_t* O; int ldc; size_t gstride;
    __device__ __forceinline__ void operator()(const f32x4 (&acc)[2][2][4][2], const Unit& u, int wr, int wc, int fr, int fq) const {
        const int row0 = u.pm * BM + wr * 64 + fr, col0 = u.pn * BM + wc * 32 + 8 * fq;
        bf16_t* base = O + (size_t)u.g * gstride;
#pragma unroll
        for (int ai = 0; ai < 2; ++ai)
#pragma unroll
            for (int m = 0; m < 4; ++m) { bf16_t* rowp = base + (size_t)(row0 + ai * HALF + m * 16) * ldc + col0;
#pragma unroll
                for (int bj = 0; bj < 2; ++bj) { float o[8];
#pragma unroll
                    for (int n = 0; n < 2; ++n)
#pragma unroll
                        for (int q = 0; q < 4; ++q) { const float x = acc[ai][bj][m][n][q]; o[4 * n + q] = x * fast_sigmoid(1.5957691216057308f * (x + 0.044715f * x * x * x)); }
                    u32x4 w; w.x = cvt_pk_bf16(o[0], o[1]); w.y = cvt_pk_bf16(o[2], o[3]); w.z = cvt_pk_bf16(o[4], o[5]); w.w = cvt_pk_bf16(o[6], o[7]);
                    *(u32x4*)(rowp + bj * HALF) = w; } }
    }
};
constexpr float Y8_SCALE = 16.0f, Y8_INV = 1.0f / 16.0f;
struct EpiGate {
    static constexpr bool PERM = true;
    unsigned char* O; int ldc; size_t gstride; const float* gate; int rpg;
    __device__ __forceinline__ void operator()(const f32x4 (&acc)[2][2][4][2], const Unit& u, int wr, int wc, int fr, int fq) const {
        const int row0 = u.pm * BM + wr * 64 + fr, col0 = u.pn * BM + wc * 32 + 8 * fq;
        unsigned char* base = O + (size_t)u.g * gstride;
#pragma unroll
        for (int ai = 0; ai < 2; ++ai)
#pragma unroll
            for (int m = 0; m < 4; ++m) { const int row = row0 + ai * HALF + m * 16; const float gt = gate[u.g * rpg + row] * (W8_INV * Y8_SCALE); unsigned char* rowp = base + (size_t)row * ldc + col0;
#pragma unroll
                for (int bj = 0; bj < 2; ++bj) { const f32x4 v0 = acc[ai][bj][m][0] * gt, v1 = acc[ai][bj][m][1] * gt;
                    *(u32x2*)(rowp + bj * HALF) = (u32x2){pk4_fp8(v0[0], v0[1], v0[2], v0[3]), pk4_fp8(v1[0], v1[1], v1[2], v1[3])}; } }
    }
};
struct EpiF32 {
    static constexpr bool PERM = false;
    float* C; int ldc; size_t gstride;
    __device__ __forceinline__ void operator()(const f32x4 (&acc)[2][2][4][2], const Unit& u, int wr, int wc, int fr, int fq) const {
        const int row0 = u.pm * BM + wr * 64 + fr, col0 = u.pn * BM + wc * 32 + 4 * fq;
#pragma unroll
        for (int ai = 0; ai < 2; ++ai)
#pragma unroll
            for (int m = 0; m < 4; ++m) { float* rowp = C + (size_t)u.g * gstride + (size_t)(row0 + ai * HALF + m * 16) * ldc + col0;
#pragma unroll
                for (int bj = 0; bj < 2; ++bj)
#pragma unroll
                    for (int n = 0; n < 2; ++n) *(f32x4*)(rowp + bj * HALF + n * 16) = acc[ai][bj][m][n]; }
    }
};
struct EpiResid {
    static constexpr bool PERM = true;
    bf16_t* X; const float* modL;
    __device__ __forceinline__ void operator()(const f32x4 (&acc)[2][2][4][2], const Unit& u, int wr, int wc, int fr, int fq) const {
        const int row0 = u.pm * BM + wr * 64 + fr, col0 = u.pn * BM + wc * 32 + 8 * fq;
        const int b = u.pm / 17, j = (u.pm - b * 17 == 0) ? 8 : b;
        const float* g1 = modL + (size_t)(j * 6 + 2) * 1024 + col0;
        f32x4 gv[2][2];
#pragma unroll
        for (int bj = 0; bj < 2; ++bj)
#pragma unroll
            for (int n = 0; n < 2; ++n) gv[bj][n] = *(const f32x4*)(g1 + bj * HALF + n * 4);
#pragma unroll
        for (int ai = 0; ai < 2; ++ai)
#pragma unroll
            for (int m = 0; m < 4; ++m) { bf16_t* rowp = X + (size_t)(row0 + ai * HALF + m * 16) * D + col0;
#pragma unroll
                for (int bj = 0; bj < 2; ++bj) { u32x4* p = (u32x4*)(rowp + bj * HALF); const u32x4 w = *p;
                    const f32x4 x0 = bf4_to_f32((u32x2){w.x, w.y}) + gv[bj][0] * acc[ai][bj][m][0], x1 = bf4_to_f32((u32x2){w.z, w.w}) + gv[bj][1] * acc[ai][bj][m][1];
                    const u32x2 o0 = f32_to_bf4(x0), o1 = f32_to_bf4(x1); *p = (u32x4){o0.x, o0.y, o1.x, o1.y}; } }
    }
};
struct EpiGluResid {
    static constexpr bool PERM = true;
    bf16_t* X; const float* modL; const float* bias;
    __device__ __forceinline__ void operator()(const f32x4 (&acc)[2][2][4][2], const Unit& u, int wr, int wc, int fr, int fq) const {
        const int row0 = u.pm * BM + wr * 64 + fr, col0 = u.pn * HALF + wc * 32 + 8 * fq;
        const int b = u.pm / 17, j = (u.pm - b * 17 == 0) ? 8 : b;
        const float* g1 = modL + (size_t)(j * 6 + 2) * 1024 + col0;
        f32x4 gv[2], ba[2], bg[2];
#pragma unroll
        for (int n = 0; n < 2; ++n) { gv[n] = *(const f32x4*)(g1 + n * 4); ba[n] = *(const f32x4*)(bias + col0 + n * 4); bg[n] = *(const f32x4*)(bias + 1024 + col0 + n * 4); }
#pragma unroll
        for (int ai = 0; ai < 2; ++ai)
#pragma unroll
            for (int m = 0; m < 4; ++m) { u32x4* p = (u32x4*)(X + (size_t)(row0 + ai * HALF + m * 16) * D + col0); const u32x4 w = *p;
                f32x4 xo[2] = {bf4_to_f32((u32x2){w.x, w.y}), bf4_to_f32((u32x2){w.z, w.w})};
#pragma unroll
                for (int n = 0; n < 2; ++n) { const f32x4 a = acc[ai][0][m][n] + ba[n], g = acc[ai][1][m][n] + bg[n];
                    f32x4 o; o.x = a.x * fast_sigmoid(g.x); o.y = a.y * fast_sigmoid(g.y); o.z = a.z * fast_sigmoid(g.z); o.w = a.w * fast_sigmoid(g.w);
                    xo[n] = xo[n] + gv[n] * o; }
                const u32x2 o0 = f32_to_bf4(xo[0]), o1 = f32_to_bf4(xo[1]); *p = (u32x4){o0.x, o0.y, o1.x, o1.y}; }
    }
};
}

namespace attn_body {
using bf16=__hip_bfloat16;
using bf16x8=__attribute__((ext_vector_type(8)))short;
using s16x4=__attribute__((ext_vector_type(4)))short;
using f32x16=__attribute__((ext_vector_type(16)))float;
using u32x4=__attribute__((ext_vector_type(4)))unsigned;
constexpr int D=64,QP=512,KP=128,OP=1024;
constexpr int NW=8,QBLK=32,QB=QBLK*NW,KVBLK=64;
__device__ __forceinline__ int crow(int r,int hi){return (r&3)+8*(r>>2)+4*hi;}
#define SBAR() __builtin_amdgcn_sched_barrier(0)
__device__ __forceinline__ void cmask(f32x16&p0,f32x16&p1,int jb,int qrel,int hi){
  const float NEG=-INFINITY; int kb=64*jb+4*hi;
  #pragma unroll
  for(int r=0;r<16;++r){int kv=kb+(r&3)+8*(r>>2); if(kv>qrel)p0[r]=NEG; if(kv+32>qrel)p1[r]=NEG;}
}

constexpr int NSLOT=3, SLOTB=8192;
constexpr int LDS_K=0, LDS_V=NSLOT*SLOTB, LDS_WS=2*NSLOT*SLOTB, LDS_OST=LDS_WS+NW*64*4, LDS_BYTES=LDS_OST+NW*4096;
constexpr float C2=0.125f*1.4426950408889634f;
__device__ __forceinline__ void glds16(const void*gsrc,unsigned lds_dst){unsigned keep;
  asm volatile("s_mov_b32 %0, m0\n\ts_mov_b32 m0, %2\n\ts_nop 0\n\tglobal_load_lds_dwordx4 %1, off\n\ts_mov_b32 m0, %0":"=&s"(keep):"v"(gsrc),"s"(lds_dst):"memory");}
__device__ __forceinline__ float max3f(float a,float b,float c){float r;asm("v_max3_f32 %0, %1, %2, %3":"=v"(r):"v"(a),"v"(b),"v"(c));return r;}
__device__ __forceinline__ float max2f(float a,float b){float r;asm("v_max_f32_e32 %0, %1, %2":"=v"(r):"v"(a),"v"(b));return r;}
__device__ __forceinline__ float fadd_s(float a,float b){float r;asm("v_add_f32_e32 %0, %1, %2":"=v"(r):"v"(a),"v"(b));return r;}
__device__ __forceinline__ float fsub_s(float a,float b){float r;asm("v_sub_f32_e32 %0, %1, %2":"=v"(r):"v"(a),"v"(b));return r;}
typedef float f32x2_t __attribute__((ext_vector_type(2))); typedef __bf16 bf16x2_t __attribute__((ext_vector_type(2)));
__device__ __forceinline__ unsigned cvtpk_s(float lo,float hi){f32x2_t v={lo,hi};bf16x2_t b=__builtin_convertvector(v,bf16x2_t);return __builtin_bit_cast(unsigned,b);}
#define WAIT_BAR(N) asm volatile("s_waitcnt vmcnt(" #N ") lgkmcnt(0)\n\ts_barrier":::"memory")

__device__ __forceinline__ void qkt(f32x16&p0,f32x16&p1,const char*Kslot,const bf16x8*qr,const f32x16&negm,int r32,int hi){
  const char*kb=Kslot+hi*1024+r32*16;
  #pragma unroll
  for(int d0=0;d0<4;++d0){
    const bf16x8 b0=*reinterpret_cast<const bf16x8*>(kb+d0*2048);
    const bf16x8 b1=*reinterpret_cast<const bf16x8*>(kb+d0*2048+512);
    if(d0==0){p0=__builtin_amdgcn_mfma_f32_32x32x16_bf16(b0,qr[0],negm,0,0,0);p1=__builtin_amdgcn_mfma_f32_32x32x16_bf16(b1,qr[0],negm,0,0,0);}
    else{p0=__builtin_amdgcn_mfma_f32_32x32x16_bf16(b0,qr[d0],p0,0,0,0);p1=__builtin_amdgcn_mfma_f32_32x32x16_bf16(b1,qr[d0],p1,0,0,0);}}
}
typedef __attribute__((address_space(3))) const char* lds_cptr;
typedef short v4i16_t __attribute__((ext_vector_type(4)));
__device__ __forceinline__ void kload8(bf16x8*kf,lds_cptr kp){
  kf[0]=*(const __attribute__((address_space(3))) bf16x8*)(kp);      kf[1]=*(const __attribute__((address_space(3))) bf16x8*)(kp+512);
  kf[2]=*(const __attribute__((address_space(3))) bf16x8*)(kp+2048); kf[3]=*(const __attribute__((address_space(3))) bf16x8*)(kp+2560);
  kf[4]=*(const __attribute__((address_space(3))) bf16x8*)(kp+4096); kf[5]=*(const __attribute__((address_space(3))) bf16x8*)(kp+4608);
  kf[6]=*(const __attribute__((address_space(3))) bf16x8*)(kp+6144); kf[7]=*(const __attribute__((address_space(3))) bf16x8*)(kp+6656);
}
__device__ __forceinline__ void kload2(bf16x8*kf,lds_cptr kp,int j){ kf[2*j]=*(const __attribute__((address_space(3))) bf16x8*)(kp+j*2048); kf[2*j+1]=*(const __attribute__((address_space(3))) bf16x8*)(kp+j*2048+512); }
__device__ __forceinline__ s16x4 vtr(lds_cptr p){ return __builtin_bit_cast(s16x4,__builtin_amdgcn_ds_read_tr16_b64_v4i16((__attribute__((address_space(3))) v4i16_t*)p)); }
__device__ __forceinline__ float rowmax(const f32x16&p0,const f32x16&p1){
  float a=max3f(p0[0],p0[1],p1[0]),b=max3f(p0[2],p0[3],p1[1]);a=max3f(a,p1[2],p1[3]);
  #pragma unroll
  for(int r=4;r<16;r+=4){a=max3f(a,p0[r],p0[r+1]);b=max3f(b,p0[r+2],p0[r+3]);a=max3f(a,p1[r],p1[r+1]);b=max3f(b,p1[r+2],p1[r+3]);}
  const float m=max2f(a,b);
  auto rr=__builtin_amdgcn_permlane32_swap(__float_as_uint(m),__float_as_uint(m),false,false);
  return max2f(__uint_as_float(rr[0]),__uint_as_float(rr[1]));
}
__device__ __forceinline__ void pv(f32x16*o,int vb,bf16x8 pa0,bf16x8 pa1,bf16x8 pa2,bf16x8 pa3){
  #pragma unroll
  for(int d0=0;d0<2;++d0){s16x4 lo[4],hi[4];
    #pragma unroll
    for(int ks=0;ks<4;++ks){
      asm volatile("ds_read_b64_tr_b16 %0,%1 offset:%c2":"=&v"(lo[ks]):"v"(vb),"i"(d0*4096+ks*1024):"memory");
      asm volatile("ds_read_b64_tr_b16 %0,%1 offset:%c2":"=&v"(hi[ks]):"v"(vb),"i"(d0*4096+ks*1024+512):"memory");}
    asm volatile("s_waitcnt lgkmcnt(0)":::"memory");SBAR();
    #define PK(k) (bf16x8){lo[k][0],lo[k][1],lo[k][2],lo[k][3],hi[k][0],hi[k][1],hi[k][2],hi[k][3]}
    o[d0]=__builtin_amdgcn_mfma_f32_32x32x16_bf16(pa0,PK(0),o[d0],0,0,0);
    o[d0]=__builtin_amdgcn_mfma_f32_32x32x16_bf16(pa1,PK(1),o[d0],0,0,0);
    o[d0]=__builtin_amdgcn_mfma_f32_32x32x16_bf16(pa2,PK(2),o[d0],0,0,0);
    o[d0]=__builtin_amdgcn_mfma_f32_32x32x16_bf16(pa3,PK(3),o[d0],0,0,0);
    #undef PK
  }
}

#ifndef ATTN_STORE16
#define ATTN_STORE16(p,v) (*(u32x4*)(p)=(v))
#endif
template<int THRL> __device__ __forceinline__ void attn_unit(const bf16*Qw0,const bf16*Kh,const bf16*Vh,bf16*Ow0,const int NT,char*shm,const int wid){
  const int lane=lane_id(),r32=lane&31,hi=lane>>5;
  const bf16*Qw=Qw0+(long)(wid*QBLK)*QP;
  const unsigned lds0=(unsigned)(uintptr_t)shm;
  float*wsf=(float*)(shm+LDS_WS)+wid*64;
  const bf16*ksrc=Kh+(long)lane*KP+wid*8;
  const bf16*vsrc=Vh+(long)(16*(wid&3)+(lane>>2))*KP+(wid>>2)*32+(lane&3)*8;
  const unsigned kdst=lds0+LDS_K+wid*1024, vdst=lds0+LDS_V+wid*1024;
  #define DMA_K(t,slot) glds16(ksrc+(long)(t)*KVBLK*KP,(unsigned)__builtin_amdgcn_readfirstlane(kdst+(slot)))
  #define DMA_V(t,slot) glds16(vsrc+(long)(t)*KVBLK*KP,(unsigned)__builtin_amdgcn_readfirstlane(vdst+(slot)))
  const int vb0=(int)(lds0+LDS_V)+((lane>>4)&1)*32+(lane&3)*8+(4*hi+((lane&15)>>2))*64;
  const char*Kbase=shm+LDS_K; bf16x8 kf[8];
  const lds_cptr shm3=(lds_cptr)shm; const lds_cptr kp0=shm3+LDS_K+hi*1024+r32*16; const lds_cptr vp0=shm3+LDS_V+((lane>>4)&1)*32+(lane&3)*8+(4*hi+((lane&15)>>2))*64;
  DMA_K(0,0);DMA_V(0,0);DMA_K(1,SLOTB);
  bf16x8 qr[4];
  #pragma unroll
  for(int d0=0;d0<4;++d0)qr[d0]=*reinterpret_cast<const bf16x8*>(&Qw[(long)r32*QP+d0*16+hi*8]);
  float mhat=0.f,l_reg=0.f;f32x16 o[2];o[0]=f32x16{};o[1]=f32x16{};f32x16 negm=f32x16{};asm volatile("":"+v"(negm));
  #define CMASK(P0,P1,t) do{}while(0)
  bool resc=false;
  #define START(P0,P1) do{ const float rm=rowmax(P0,P1); resc=false; \
    { const float dl=rm; mhat=fadd_s(mhat,dl); \
      _Pragma("unroll") for(int r=0;r<16;++r){P0[r]=fsub_s(P0[r],dl);P1[r]=fsub_s(P1[r],dl);} \
      _Pragma("unroll") for(int r=0;r<16;++r)negm[r]=-mhat; asm volatile("":"+v"(negm)); } \
    _Pragma("unroll") for(int r=0;r<16;++r)P0[r]=__builtin_amdgcn_exp2f(P0[r]); }while(0)
  #define RESC() do{ if(resc){ asm volatile("s_waitcnt lgkmcnt(0)":::"memory"); \
      _Pragma("unroll") for(int d_=0;d_<2;++d_) _Pragma("unroll") for(int r=0;r<16;++r)o[d_][r]*=wsf[crow(r,hi)]; } }while(0)
  f32x16 pA0,pA1,pB0,pB1;
  int sl_prev=0,sl_cur=0,sl_next=SLOTB;
  #define ROT() do{sl_prev=sl_cur;sl_cur=sl_next;sl_next=(sl_next==(NSLOT-1)*SLOTB)?0:sl_next+SLOTB;}while(0)
  DMA_K(2,2*SLOTB);
  WAIT_BAR(3);
  qkt(pA0,pA1,Kbase,qr,negm,r32,hi);asm volatile("s_nop 15\n\ts_nop 7":"+v"(pA0),"+v"(pA1));CMASK(pA0,pA1,0);
  START(pA0,pA1);
  _Pragma("unroll") for(int r=0;r<16;++r)pA1[r]=__builtin_amdgcn_exp2f(pA1[r]);
  WAIT_BAR(0);
  DMA_K(3,0);DMA_V(1,SLOTB);
  ROT();
  kload8(kf,kp0+sl_cur);
  WAIT_BAR(2);
  s16x4 vlo[8],vhi[8]; u32x4 pw0,pw1,pw2,pw3;
  #define PKW(P,B) cvtpk_s(P[B],P[B+1])
  #define PAF(k) __builtin_bit_cast(bf16x8,pw##k)
  #define VFR(i) (bf16x8){vlo[i][0],vlo[i][1],vlo[i][2],vlo[i][3],vhi[i][0],vhi[i][1],vhi[i][2],vhi[i][3]}
  #define PIN(x) asm volatile("":"+v"(x))
  #define MX3(a,b,c) __builtin_fmaxf(__builtin_fmaxf((a),(b)),(c))
  #define GAPA(MF,A0,A1,A2,A3,W0,W1,PW) do{ MF; sacc+=A0; sacc+=A1; sacc+=A2; sacc+=A3; PIN(sacc); W0; W1; PIN(PW); SBAR(); }while(0)
  #define EX(v) __builtin_amdgcn_exp2f(v)
  #define GAPB(MF,X,B) do{ MF; X[B]=EX(X[B]); X[B+1]=EX(X[B+1]); X[B+2]=EX(X[B+2]); X[B+3]=EX(X[B+3]); PIN(X); SBAR(); }while(0)
  #define VRD(i) do{ vlo[i]=vtr(vp_+(((i)>>2)*4096+((i)&3)*1024)); vhi[i]=vtr(vp_+(((i)>>2)*4096+((i)&3)*1024+512)); }while(0)
  #define KRD(G,j) do{ if(G){ kload2(kf,kp0+sl_next,j); SBAR(); } }while(0)
  #define STEP(C0,C1,P0,P1,t,GK,GV,GL) do{ SBAR(); \
    const lds_cptr vp_=vp0+sl_prev; \
    VRD(0); SBAR(); float sacc=(P0[0]+P0[1]); \
    GAPA(C0=__builtin_amdgcn_mfma_f32_32x32x16_bf16(kf[0],qr[0],negm,0,0,0), P0[2],P0[3],P0[4],P0[5],     pw0[0]=PKW(P0,0), pw0[1]=PKW(P0,2), pw0); \
    VRD(4); SBAR(); GAPA(C1=__builtin_amdgcn_mfma_f32_32x32x16_bf16(kf[1],qr[0],negm,0,0,0), P0[6],P0[7],P0[8],P0[9],     pw0[2]=PKW(P0,4), pw0[3]=PKW(P0,6), pw0); \
    VRD(1); SBAR(); GAPA(C0=__builtin_amdgcn_mfma_f32_32x32x16_bf16(kf[2],qr[1],C0,0,0,0),   P0[10],P0[11],P0[12],P0[13], pw1[0]=PKW(P0,8), pw1[1]=PKW(P0,10), pw1); \
    VRD(5); SBAR(); GAPA(C1=__builtin_amdgcn_mfma_f32_32x32x16_bf16(kf[3],qr[1],C1,0,0,0),   P0[14],P0[15],P1[0],P1[1],   pw1[2]=PKW(P0,12),pw1[3]=PKW(P0,14), pw1); \
    VRD(2); SBAR(); GAPA(C0=__builtin_amdgcn_mfma_f32_32x32x16_bf16(kf[4],qr[2],C0,0,0,0),   P1[2],P1[3],P1[4],P1[5],     pw2[0]=PKW(P1,0), pw2[1]=PKW(P1,2), pw2); \
    VRD(6); SBAR(); GAPA(C1=__builtin_amdgcn_mfma_f32_32x32x16_bf16(kf[5],qr[2],C1,0,0,0),   P1[6],P1[7],P1[8],P1[9],     pw2[2]=PKW(P1,4), pw2[3]=PKW(P1,6), pw2); \
    VRD(3); SBAR(); GAPA(C0=__builtin_amdgcn_mfma_f32_32x32x16_bf16(kf[6],qr[3],C0,0,0,0),   P1[10],P1[11],P1[12],P1[13], pw3[0]=PKW(P1,8), pw3[1]=PKW(P1,10), pw3); \
    VRD(7); SBAR(); GAPA(C1=__builtin_amdgcn_mfma_f32_32x32x16_bf16(kf[7],qr[3],C1,0,0,0),   P1[14],P1[15],0.f,0.f,       pw3[2]=PKW(P1,12),pw3[3]=PKW(P1,14), pw3); \
    l_reg+=sacc; \
    if(GK){DMA_K((t)+3,sl_cur);} if(GV){DMA_V((t)+1,sl_next);} \
    CMASK(C0,C1,t); \
    { float a=MX3(C0[0],C0[1],C1[0]),b=MX3(C0[2],C0[3],C1[1]); a=MX3(a,C1[2],C1[3]); \
      _Pragma("unroll") for(int r=4;r<16;r+=4){a=MX3(a,C0[r],C0[r+1]);b=MX3(b,C0[r+2],C0[r+3]);a=MX3(a,C1[r],C1[r+1]);b=MX3(b,C1[r+2],C1[r+3]);} \
      float rm=__builtin_fmaxf(a,b); { auto rr=__builtin_amdgcn_permlane32_swap(__float_as_uint(rm),__float_as_uint(rm),false,false); rm=__builtin_fmaxf(__uint_as_float(rr[0]),__uint_as_float(rr[1])); } \
      resc=false; \
      if(__builtin_expect(__any(rm>(float)THRL),0)){ const float dl=__builtin_fmaxf(rm,0.f); mhat+=dl; \
        _Pragma("unroll") for(int r=0;r<16;++r){C0[r]-=dl;C1[r]-=dl;} \
        _Pragma("unroll") for(int r=0;r<16;++r)negm[r]=-mhat; asm volatile("":"+v"(negm)); \
        const float f=__builtin_amdgcn_exp2f(-dl); l_reg*=f; if(hi==0)wsf[r32]=f; resc=true; } } \
    SBAR(); \
    GAPB(o[0]=__builtin_amdgcn_mfma_f32_32x32x16_bf16(PAF(0),VFR(0),o[0],0,0,0), C0,0); \
    GAPB(o[1]=__builtin_amdgcn_mfma_f32_32x32x16_bf16(PAF(0),VFR(4),o[1],0,0,0), C0,4); \
    KRD(GL,0); GAPB(o[0]=__builtin_amdgcn_mfma_f32_32x32x16_bf16(PAF(1),VFR(1),o[0],0,0,0), C0,8); \
    KRD(GL,1); GAPB(o[1]=__builtin_amdgcn_mfma_f32_32x32x16_bf16(PAF(1),VFR(5),o[1],0,0,0), C0,12); \
    KRD(GL,2); GAPB(o[0]=__builtin_amdgcn_mfma_f32_32x32x16_bf16(PAF(2),VFR(2),o[0],0,0,0), C1,0); \
    KRD(GL,3); GAPB(o[1]=__builtin_amdgcn_mfma_f32_32x32x16_bf16(PAF(2),VFR(6),o[1],0,0,0), C1,4); \
    GAPB(o[0]=__builtin_amdgcn_mfma_f32_32x32x16_bf16(PAF(3),VFR(3),o[0],0,0,0), C1,8); \
    GAPB(o[1]=__builtin_amdgcn_mfma_f32_32x32x16_bf16(PAF(3),VFR(7),o[1],0,0,0), C1,12); \
    }while(0)
  int t=1;
  #undef CMASK
  #define CMASK(P0,P1,t) do{}while(0)
  for(;t+5<NT;t+=2){
    STEP(pB0,pB1,pA0,pA1,t,true,true,true);     WAIT_BAR(2); RESC(); ROT();
    STEP(pA0,pA1,pB0,pB1,t+1,true,true,true);   WAIT_BAR(2); RESC(); ROT();
  }
  #undef CMASK
  #define CMASK(P0,P1,t) do{}while(0)
  #define ENDW(tt) do{ if((tt)+3<NT){WAIT_BAR(2);} else if((tt)+2<NT){WAIT_BAR(1);} else {WAIT_BAR(0);} }while(0)
  for(;t+1<NT;t+=2){
    STEP(pB0,pB1,pA0,pA1,t,(t+3<NT),(t+1<NT),(t+1<NT));       ENDW(t);   RESC(); ROT();
    STEP(pA0,pA1,pB0,pB1,t+1,(t+4<NT),(t+2<NT),(t+2<NT));     ENDW(t+1); RESC(); ROT();
  }
  STEP(pB0,pB1,pA0,pA1,NT-1,false,false,false); RESC();
  { float sacc=pB0[0]+pB0[1]; _Pragma("unroll") for(int r=2;r<16;++r)sacc+=pB0[r]; _Pragma("unroll") for(int r=0;r<16;++r)sacc+=pB1[r]; l_reg+=sacc;
    pw0=(u32x4){PKW(pB0,0),PKW(pB0,2),PKW(pB0,4),PKW(pB0,6)};pw1=(u32x4){PKW(pB0,8),PKW(pB0,10),PKW(pB0,12),PKW(pB0,14)};pw2=(u32x4){PKW(pB1,0),PKW(pB1,2),PKW(pB1,4),PKW(pB1,6)};pw3=(u32x4){PKW(pB1,8),PKW(pB1,10),PKW(pB1,12),PKW(pB1,14)};
    SBAR(); pv(o,vb0+sl_cur,PAF(0),PAF(1),PAF(2),PAF(3)); }
  #undef PKW
  #undef PAF
  #undef VFR
  #undef PIN
  #undef MX3
  #undef GAPA
  #undef GAPB
  #undef EX
  #undef VRD
  #undef KRD
  #undef STEP
  #undef ENDW
  {auto rr=__builtin_amdgcn_permlane32_swap(__float_as_uint(l_reg),__float_as_uint(l_reg),false,false);l_reg=__uint_as_float(rr[0])+__uint_as_float(rr[1]);}
  if(hi==0)wsf[32+r32]=l_reg;asm volatile("s_waitcnt lgkmcnt(0)":::"memory");
  float rli[16];
  #pragma unroll
  for(int r=0;r<16;++r)rli[r]=__builtin_amdgcn_rcpf(wsf[32+crow(r,hi)]);
  bf16*Ow=Ow0+(long)(wid*QBLK)*OP;
  { bf16*stg=(bf16*)(shm+LDS_OST)+wid*2048;
    #pragma unroll
    for(int r=0;r<16;++r){const int orow=crow(r,hi);
      #pragma unroll
      for(int d0=0;d0<2;++d0)stg[orow*64+d0*32+r32]=__float2bfloat16(o[d0][r]*rli[r]);}
    asm volatile("s_waitcnt lgkmcnt(0)":::"memory");
    #pragma unroll
    for(int i=0;i<4;++i){const int row=i*8+(lane>>3),ch=lane&7; const u32x4 v=*(const u32x4*)(stg+row*64+ch*8); ATTN_STORE16(Ow+(long)row*OP+ch*8,v);} }
  asm volatile("s_waitcnt lgkmcnt(0)\n\ts_barrier":::"memory");
  #undef DMA_K
  #undef DMA_V
  #undef CMASK
  #undef START
  #undef RESC
  #undef ROT
}
constexpr int ATTN_LDS_BYTES=LDS_BYTES;
#undef SBAR
#undef WAIT_BAR
}

template <bool PAIRED, class AL, class BL, class EP>
__device__ __forceinline__ void gemm_f32(int groups, int M, int N, int K, const AL& al, const BL& bl, const EP& ep) {
    const int tid = threadIdx.x, lane = tid & 63, wave = tid >> 6, wm = wave >> 2, wn = wave & 3, r32 = lane & 31, h = lane >> 5;
    constexpr int TN = PAIRED ? 128 : 256;
    const int tilesM = M / 128, tilesN = N / TN, per = tilesM * tilesN, total = groups * per;
    const int ldb = bl.ldb;
    for (int t = blockIdx.x; t < total; t += gridDim.x) {
        const int g = t / per, r = t - g * per, tm = r / tilesN, tn = r - tm * tilesN;
        const int m0 = tm * 128 + wm * 64;
        const int n0 = PAIRED ? (tn * 128 + wn * 32) : (tn * 256 + wn * 64);
        const float* a0 = al.row(g, m0 + r32) + 4 * h;
        const float* a1 = al.row(g, m0 + 32 + r32) + 4 * h;
        const float* b0 = bl.ptr(g, 0) + n0 + r32 + (size_t)(4 * h) * ldb;
        const float* b1 = (PAIRED ? bl.ptr(g, 1) + n0 : bl.ptr(g, 0) + n0 + 32) + r32 + (size_t)(4 * h) * ldb;
        f32x16 acc00 = {}, acc01 = {}, acc10 = {}, acc11 = {};
#pragma unroll 2
        for (int k = 0; k < K; k += 8) {
            const f32x4 av0 = *(const f32x4*)(a0 + k), av1 = *(const f32x4*)(a1 + k);
            float bv0[4], bv1[4];
#pragma unroll
            for (int s = 0; s < 4; ++s) { bv0[s] = b0[(size_t)(k + s) * ldb]; bv1[s] = b1[(size_t)(k + s) * ldb]; }
#pragma unroll
            for (int s = 0; s < 4; ++s) {
                acc00 = __builtin_amdgcn_mfma_f32_32x32x2f32(av0[s], bv0[s], acc00, 0, 0, 0);
                acc01 = __builtin_amdgcn_mfma_f32_32x32x2f32(av0[s], bv1[s], acc01, 0, 0, 0);
                acc10 = __builtin_amdgcn_mfma_f32_32x32x2f32(av1[s], bv0[s], acc10, 0, 0, 0);
                acc11 = __builtin_amdgcn_mfma_f32_32x32x2f32(av1[s], bv1[s], acc11, 0, 0, 0);
            }
        }
#pragma unroll
        for (int rr = 0; rr < 16; ++rr) {
            const int ro = (rr & 3) + 8 * (rr >> 2) + 4 * h;
            if (PAIRED) {
                ep(g, m0 + ro, n0 + r32, acc00[rr], acc01[rr]);
                ep(g, m0 + 32 + ro, n0 + r32, acc10[rr], acc11[rr]);
            } else {
                ep(g, m0 + ro, n0 + r32, acc00[rr], 0.f); ep(g, m0 + ro, n0 + 32 + r32, acc01[rr], 0.f);
                ep(g, m0 + 32 + ro, n0 + r32, acc10[rr], 0.f); ep(g, m0 + 32 + ro, n0 + 32 + r32, acc11[rr], 0.f);
            }
        }
    }
}

__device__ __forceinline__ void phase_pro(const Ctx& c, LAS float* ldsf) {
    float* rope = (float*)(c.ws + WS_ROPE);
    for (int i = c.gt; i < 64 * 16; i += c.ngt) {
        const int pos = i >> 4, fi = i & 15; const float inv = powf(10000.0f, -(float)fi / 16.0f), ang = (float)pos * inv;
        rope[2 * i] = cosf(ang); rope[2 * i + 1] = sinf(ang);
    }
    LAS float* sil = ldsf; LAS float* red = ldsf + 9 * 1024;
    for (int i = c.tid; i < 9 * 1024; i += 512) { const int j = i >> 10, k = i & 1023; const float v = (j < 8) ? c.in[IN_C][j * 1024 + k] : c.in[IN_CCTX][k]; sil[i] = siluf_(v); }
    __syncthreads();
    float* MOD = (float*)(c.ws + WS_MOD);
    for (int task = blockIdx.x; task < DEPTH * 96; task += gridDim.x) {
        const int L = task / 96, cb = task - L * 96, col = cb * 64 + c.lane;
        const float* W = c.in[IN_MODW] + (size_t)L * 1024 * 6144;
        float acc[9];
#pragma unroll
        for (int j = 0; j < 9; ++j) acc[j] = 0.f;
        const int k0 = c.wave * 128;
#pragma unroll 4
        for (int k = k0; k < k0 + 128; ++k) { const float w = W[(size_t)k * 6144 + col];
#pragma unroll
            for (int j = 0; j < 9; ++j) acc[j] += sil[j * 1024 + k] * w; }
#pragma unroll
        for (int j = 0; j < 9; ++j) red[(c.wave * 9 + j) * 64 + c.lane] = acc[j];
        __syncthreads();
        if (c.wave == 0) {
            const float bias = c.in[IN_MODB][L * 6144 + col];
#pragma unroll
            for (int j = 0; j < 9; ++j) { float s = bias;
#pragma unroll
                for (int w = 0; w < 8; ++w) s += red[(w * 9 + j) * 64 + c.lane];
                MOD[(size_t)(L * 9 + j) * 6144 + col] = s; }
        }
        __syncthreads();
    }
    unsigned short* X = (unsigned short*)(c.ws + WS_X);
    for (int r = c.gw; r < NROWS; r += c.ngw) {
        const int b = r / RB, s = r - b * RB;
        const float* src = (s < CL) ? c.in[IN_CTX] + (size_t)(b * CL + s) * D : c.in[IN_X] + (size_t)(b * T + s - CL) * D;
        const f32x4* sp = (const f32x4*)src + c.lane; pg8::u32x2* dp = (pg8::u32x2*)(X + (size_t)r * D) + c.lane;
#pragma unroll
        for (int j = 0; j < 4; ++j) dp[64 * j] = pg8::f32_to_bf4(sp[64 * j]);
    }
}

template <bool FINAL, bool GM>
__device__ __forceinline__ void phase_norm1(const Ctx& c, int L) {
    unsigned short* X = (unsigned short*)(c.ws + WS_X);
    const int* SLOT = (const int*)(c.ws + WS_SLOT); const unsigned char* Y = (const unsigned char*)(c.ws + WS_Y);
    int ch[4];
#pragma unroll
    for (int q = 0; q < 4; ++q) ch[q] = GM ? 16 * c.lane + 4 * q : 4 * (c.lane + 64 * q);
#define N1_DEC(w) ((f32x4){__builtin_amdgcn_cvt_pk_f32_fp8((int)(w), false)[0], __builtin_amdgcn_cvt_pk_f32_fp8((int)(w), false)[1], __builtin_amdgcn_cvt_pk_f32_fp8((int)(w), true)[0], __builtin_amdgcn_cvt_pk_f32_fp8((int)(w), true)[1]})
#define N1_YPF(spv, msk, A0, A1, TWO) do { (msk) = __ballot((spv) >= 0 && c.lane < NE); if (msk) { \
        const int e0_ = __builtin_ctzll(msk); (msk) &= (msk) - 1; (TWO) = (msk) != 0ull; const int e1_ = (TWO) ? __builtin_ctzll(msk) : e0_; if (TWO) (msk) &= (msk) - 1; \
        const unsigned char* y0_ = Y + ((size_t)e0_ * EROWS + __builtin_amdgcn_readlane((spv), e0_)) * D; const unsigned char* y1_ = Y + ((size_t)e1_ * EROWS + __builtin_amdgcn_readlane((spv), e1_)) * D; \
        _Pragma("unroll") for (int q = 0; q < 4; ++q) { (A0)[q] = *(const unsigned*)(y0_ + ch[q]); (A1)[q] = *(const unsigned*)(y1_ + ch[q]); } } } while (0)
    int r = c.gw;
    f32x4 vn[4]; int spn = -1;
    unsigned yp0[4], yp1[4]; unsigned long long maskn = 0ull; bool hasn = false, twon = false;
    if (r < NROWS) {
#pragma unroll
        for (int q = 0; q < 4; ++q) vn[q] = pg8::bf4_to_f32(*(const pg8::u32x2*)(X + (size_t)r * D + ch[q]));
        if (L > 0) { if (c.lane < NE) spn = SLOT[(size_t)r * NE + c.lane]; unsigned long long m0 = 0ull; N1_YPF(spn, m0, yp0, yp1, twon); hasn = __ballot(spn >= 0 && c.lane < NE) != 0ull; maskn = m0; }
    }
    for (; r < NROWS; r += c.ngw) {
        const int b = r / RB, s = r - b * RB, j = s < CL ? 8 : b;
        unsigned short* xr = X + (size_t)r * D;
        f32x4 v[4]; const int spl = spn; unsigned w0[4], w1[4]; unsigned long long mask = maskn; const bool has = hasn, two0 = twon;
#pragma unroll
        for (int q = 0; q < 4; ++q) { v[q] = vn[q]; w0[q] = yp0[q]; w1[q] = yp1[q]; }
        const int rn = r + c.ngw;
        if (rn < NROWS) {
#pragma unroll
            for (int q = 0; q < 4; ++q) vn[q] = pg8::bf4_to_f32(*(const pg8::u32x2*)(X + (size_t)rn * D + ch[q]));
            if (L > 0 && c.lane < NE) spn = SLOT[(size_t)rn * NE + c.lane];
        }
        if (!(FINAL && s < CL)) {
        if (L > 0) {
            f32x4 sum[4] = {};
            if (has) {
#pragma unroll
                for (int q = 0; q < 4; ++q) { sum[q] += N1_DEC(w0[q]); if (two0) sum[q] += N1_DEC(w1[q]); }
            }
            while (mask) {
                const int e0 = __builtin_ctzll(mask); mask &= mask - 1;
                const bool two = mask != 0ull; const int e1 = two ? __builtin_ctzll(mask) : e0; if (two) mask &= mask - 1;
                const int sp0 = __builtin_amdgcn_readlane(spl, e0), sp1 = __builtin_amdgcn_readlane(spl, e1);
                const unsigned char* y0 = Y + ((size_t)e0 * EROWS + sp0) * D; const unsigned char* y1 = Y + ((size_t)e1 * EROWS + sp1) * D;
#pragma unroll
                for (int q = 0; q < 4; ++q) { w0[q] = *(const unsigned*)(y0 + ch[q]); w1[q] = *(const unsigned*)(y1 + ch[q]); }
#pragma unroll
                for (int q = 0; q < 4; ++q) { sum[q] += N1_DEC(w0[q]); if (two) sum[q] += N1_DEC(w1[q]); }
            }
            const float* g2 = modp(c, L - 1, j, 5);
#pragma unroll
            for (int q = 0; q < 4; ++q) { v[q] += *(const f32x4*)(g2 + ch[q]) * (sum[q] * pg8::Y8_INV); if (!FINAL) { const pg8::u32x2 w = pg8::f32_to_bf4(v[q]); *(pg8::u32x2*)(xr + ch[q]) = w; v[q] = pg8::bf4_to_f32(w); } }
        }
        float ss = 0.f;
#pragma unroll
        for (int q = 0; q < 4; ++q) ss += v[q].x * v[q].x + v[q].y * v[q].y + v[q].z * v[q].z + v[q].w * v[q].w;
        const float rstd = rsqrtf(wave_sum(ss) * (1.0f / D) + EPS);
        if (FINAL) {
            const float* g = c.in[IN_FNG]; float* op = c.out + (size_t)(b * T + s - CL) * D;
#pragma unroll
            for (int q = 0; q < 4; ++q) *(f32x4*)(op + ch[q]) = v[q] * rstd * *(const f32x4*)(g + ch[q]);
        } else {
            const float* g = c.in[IN_NORMG] + (size_t)(L * 2 + 0) * D; const float* sc = modp(c, L, j, 1); const float* sh = modp(c, L, j, 0);
            unsigned hw[8];
#pragma unroll
            for (int q = 0; q < 4; ++q) { const f32x4 hv = v[q] * rstd * *(const f32x4*)(g + ch[q]) * (1.0f + *(const f32x4*)(sc + ch[q])) + *(const f32x4*)(sh + ch[q]);
                hw[2 * q] = pg8::cvt_pk_bf16(hv.x, hv.y); hw[2 * q + 1] = pg8::cvt_pk_bf16(hv.z, hv.w); }
            if (GM) { unsigned short* o = (unsigned short*)(c.ws + WS_AS5) + ((size_t)c.lane * 1280 + (r >> 5)) * 768 + (r & 31) * 16;
                *(pg8::u32x4*)o = (pg8::u32x4){hw[0], hw[1], hw[2], hw[3]}; *(pg8::u32x4*)(o + 8) = (pg8::u32x4){hw[4], hw[5], hw[6], hw[7]}; }
            else { unsigned short* o = (unsigned short*)(c.ws + WS_HB1) + (size_t)r * D;
#pragma unroll
                for (int q = 0; q < 4; ++q) *(pg8::u32x2*)(o + ch[q]) = (pg8::u32x2){hw[2 * q], hw[2 * q + 1]}; }
        }
        }
        if (L > 0 && rn < NROWS) { unsigned long long m0 = 0ull; hasn = __ballot(spn >= 0 && c.lane < NE) != 0ull; N1_YPF(spn, m0, yp0, yp1, twon); maskn = m0; }
    }
#undef N1_DEC
#undef N1_YPF
}

template <bool SKIPCTX>
__device__ __forceinline__ void phase_norm2_router(const Ctx& c, int L, LAS float* wT) {
    const unsigned short* X = (const unsigned short*)(c.ws + WS_X); unsigned char* HB = (unsigned char*)(c.ws + WS_HB); float* AFF = (float*)(c.ws + WS_AFF);
    const float* WR = c.in[IN_ROUTER] + (size_t)L * D * NE;
    __syncthreads();
    for (int idx = c.tid; idx < D * 4; idx += 512) { const int ch = idx >> 2, e4 = idx & 3; const f32x4 w = *(const f32x4*)(WR + (size_t)ch * NE + 4 * e4);
        wT[(4 * e4 + 0) * D + ch] = w.x; wT[(4 * e4 + 1) * D + ch] = w.y; wT[(4 * e4 + 2) * D + ch] = w.z; wT[(4 * e4 + 3) * D + ch] = w.w; }
    __syncthreads();
    pg8::u32x2 xn[4];
    if (c.gw < NROWS) {
#pragma unroll
        for (int q = 0; q < 4; ++q) xn[q] = ((const pg8::u32x2*)(X + (size_t)c.gw * D) + c.lane)[64 * q];
    }
    for (int r = c.gw; r < NROWS; r += c.ngw) {
        const int j = row_j(r);
        f32x4 v[4]; float ss = 0.f;
#pragma unroll
        for (int q = 0; q < 4; ++q) { v[q] = pg8::bf4_to_f32(xn[q]); ss += v[q].x * v[q].x + v[q].y * v[q].y + v[q].z * v[q].z + v[q].w * v[q].w; }
        if (r + c.ngw < NROWS) {
#pragma unroll
            for (int q = 0; q < 4; ++q) xn[q] = ((const pg8::u32x2*)(X + (size_t)(r + c.ngw) * D) + c.lane)[64 * q];
        }
        if (SKIPCTX && j == 8) continue;
        const float rstd = rsqrtf(wave_sum(ss) * (1.0f / D) + EPS);
        const f32x4* g = (const f32x4*)(c.in[IN_NORMG] + (size_t)(L * 2 + 1) * D) + c.lane;
        const f32x4* sc = (const f32x4*)modp(c, L, j, 4) + c.lane; const f32x4* sh = (const f32x4*)modp(c, L, j, 3) + c.lane;
        unsigned* hp = (unsigned*)(HB + (size_t)r * D) + c.lane;
        float lg[16]; f32x4 f[4];
#pragma unroll
        for (int q = 0; q < 4; ++q) { f[q] = v[q] * rstd * g[64 * q] * (1.0f + sc[64 * q]) + sh[64 * q]; hp[64 * q] = pg8::pk4_fp8(f[q].x, f[q].y, f[q].z, f[q].w); }
        __builtin_amdgcn_sched_barrier(0);
#pragma unroll
        for (int e = 0; e < 16; ++e) {
            float a = 0.f;
#pragma unroll
            for (int q = 0; q < 4; ++q) { const f32x4 wv = *(const LAS f32x4*)(wT + e * D + 4 * (c.lane + 64 * q)); a += (f[q].x * wv.x + f[q].y * wv.y) + (f[q].z * wv.z + f[q].w * wv.w); }
            lg[e] = a;
            if (e & 1) __builtin_amdgcn_sched_barrier(0);
        }
        const float mine = reduce16(lg, c.lane);
        const int k = reduce16_k(c.lane);
        float mx = mine;
#pragma unroll
        for (int o = 4; o < 64; o <<= 1) mx = fmaxf(mx, __shfl_xor(mx, o));
        const float ex = expf(mine - mx);
        float den = ex;
#pragma unroll
        for (int o = 4; o < 64; o <<= 1) den += __shfl_xor(den, o);
        if ((c.lane & 3) == 0) AFF[(size_t)r * NE + k] = ex / den;
    }
}

__device__ __forceinline__ void phase_topk(const Ctx& c, LAS unsigned* lds32, int nprob) {
    const float* AFF = (const float*)(c.ws + WS_AFF);
    int* SELROW = (int*)(c.ws + WS_SELROW); float* SELGATE = (float*)(c.ws + WS_SELGATE); int* SLOT = (int*)(c.ws + WS_SLOT);
    LAS unsigned* hist = lds32; LAS unsigned* wsum = lds32 + 256; LAS unsigned* res = lds32 + 272;
    LAS int* srow = (LAS int*)(lds32 + 512);
    const unsigned char* HB = (const unsigned char*)(c.ws + WS_HB); unsigned char* XS = (unsigned char*)(c.ws + WS_XS);
    for (int pid = blockIdx.x; pid < nprob; pid += gridDim.x) {
        const bool lat = pid < 128; const int q = lat ? pid : pid - 128, b = q >> 4, e = q & 15;
        const int N = lat ? T : CL, C = lat ? CAP_LAT : CAP_CTX, row0 = b * RB + (lat ? CL : 0), base = lat ? b * CAP_LAT : NB * CAP_LAT + b * CAP_CTX;
        const int t0 = c.tid * 8; const bool valid = t0 < N;
        unsigned k[8];
#pragma unroll
        for (int i = 0; i < 8; ++i) k[i] = valid ? __float_as_uint(AFF[(size_t)(row0 + t0 + i) * NE + e]) : 0u;
        unsigned prefix = 0u, want = (unsigned)C;
#pragma unroll
        for (int r = 0; r < 4; ++r) {
            const int shift = 24 - 8 * r;
            __syncthreads();
            if (c.tid < 256) hist[c.tid] = 0u;
            __syncthreads();
            if (valid) {
#pragma unroll
                for (int i = 0; i < 8; ++i) if (r == 0 || (k[i] >> (shift + 8)) == prefix) __hip_atomic_fetch_add(&hist[(k[i] >> shift) & 255u], 1u, __ATOMIC_RELAXED, __HIP_MEMORY_SCOPE_WORKGROUP);
            }
            __syncthreads();
            if (c.wave == 0) {
                const unsigned h0 = hist[4 * c.lane], h1 = hist[4 * c.lane + 1], h2 = hist[4 * c.lane + 2], h3 = hist[4 * c.lane + 3];
                unsigned suf = h0 + h1 + h2 + h3;
#pragma unroll
                for (int off = 1; off < 64; off <<= 1) { const unsigned o = __shfl_down(suf, off); if (c.lane + off < 64) suf += o; }
                unsigned nxt = __shfl_down(suf, 1); if (c.lane == 63) nxt = 0u;
                if (suf >= want && nxt < want) {
                    unsigned above = nxt; int d;
                    if (above + h3 >= want) d = 3; else { above += h3; if (above + h2 >= want) d = 2; else { above += h2; if (above + h1 >= want) d = 1; else { above += h1; d = 0; } } }
                    res[0] = (unsigned)(4 * c.lane + d); res[1] = want - above;
                }
            }
            __syncthreads();
            prefix = (prefix << 8) | res[0]; want = res[1];
        }
        const unsigned thr = prefix, need_eq = want;
        unsigned cg = 0u, ce = 0u;
#pragma unroll
        for (int i = 0; i < 8; ++i) { cg += (valid && k[i] > thr) ? 1u : 0u; ce += (valid && k[i] == thr) ? 1u : 0u; }
        unsigned incl = cg | (ce << 16);
#pragma unroll
        for (int off = 1; off < 64; off <<= 1) { const unsigned o = __shfl_up(incl, off); if (c.lane >= off) incl += o; }
        __syncthreads();
        if (c.lane == 63) wsum[c.wave] = incl;
        __syncthreads();
        unsigned wbase = 0u;
#pragma unroll
        for (int w = 0; w < 8; ++w) if (w < c.wave) wbase += wsum[w];
        const unsigned excl = wbase + incl - (cg | (ce << 16));
        unsigned gb = excl & 0xffffu, eb = excl >> 16;
        if (valid) {
#pragma unroll
            for (int i = 0; i < 8; ++i) {
                const int row = row0 + t0 + i; const bool isg = k[i] > thr, ise = k[i] == thr;
                const bool sel = isg || (ise && eb < need_eq);
                const unsigned sp = (unsigned)base + gb + (eb < need_eq ? eb : need_eq);
                if (sel) { SELROW[e * EROWS + sp] = row; SELGATE[e * EROWS + sp] = __uint_as_float(k[i]); SLOT[(size_t)row * NE + e] = (int)sp; srow[sp - (unsigned)base] = row; }
                else SLOT[(size_t)row * NE + e] = -1;
                gb += isg ? 1u : 0u; eb += ise ? 1u : 0u;
            }
        }
        __syncthreads();
        for (int s0 = c.wave * 8; s0 < C; s0 += 64) {
            pg8::u32x4 v4[8];
#pragma unroll
            for (int j = 0; j < 8; ++j) v4[j] = *(const pg8::u32x4*)(HB + (size_t)srow[s0 + j] * D + c.lane * 16);
#pragma unroll
            for (int j = 0; j < 8; ++j) *(pg8::u32x4*)(XS + ((size_t)e * EROWS + base + s0 + j) * D + c.lane * 16) = v4[j];
        }
    }
}

__device__ __forceinline__ void post_ld32(const unsigned short* p, float (&v)[32]) {
#pragma unroll
    for (int q = 0; q < 4; ++q) { const pg8::u32x4 w = ((const pg8::u32x4*)p)[q];
#pragma unroll
        for (int e = 0; e < 4; ++e) { v[8 * q + 2 * e] = __uint_as_float(w[e] << 16); v[8 * q + 2 * e + 1] = __uint_as_float(w[e] & 0xffff0000u); } }
}
__device__ __forceinline__ void post_raw(const unsigned short* p, pg8::u32x4 (&w)[4]) {
#pragma unroll
    for (int q = 0; q < 4; ++q) w[q] = ((const pg8::u32x4*)p)[q];
}
__device__ __forceinline__ void post_cvt(const pg8::u32x4 (&w)[4], float (&v)[32]) {
#pragma unroll
    for (int q = 0; q < 4; ++q)
#pragma unroll
        for (int e = 0; e < 4; ++e) { v[8 * q + 2 * e] = __uint_as_float(w[q][e] << 16); v[8 * q + 2 * e + 1] = __uint_as_float(w[q][e] & 0xffff0000u); }
}
__device__ __forceinline__ void post_st32(unsigned short* p, const float (&v)[32], float sc) {
#pragma unroll
    for (int q = 0; q < 4; ++q) { pg8::u32x4 w;
#pragma unroll
        for (int e = 0; e < 4; ++e) w[e] = pg8::cvt_pk_bf16(v[8 * q + 2 * e] * sc, v[8 * q + 2 * e + 1] * sc);
        ((pg8::u32x4*)p)[q] = w; }
}
__device__ __forceinline__ void post_rope(float (&v)[32], const float* cs  ) {
#pragma unroll
    for (int f4 = 0; f4 < 8; ++f4) { const f32x4 t4 = ((const f32x4*)cs)[f4];
        { const float x1 = v[2 * f4], x2 = v[16 + 2 * f4]; v[2 * f4] = x1 * t4.x - x2 * t4.y; v[16 + 2 * f4] = x1 * t4.y + x2 * t4.x; }
        { const float x1 = v[2 * f4 + 1], x2 = v[16 + 2 * f4 + 1]; v[2 * f4 + 1] = x1 * t4.z - x2 * t4.w; v[16 + 2 * f4 + 1] = x1 * t4.w + x2 * t4.z; } }
}
__device__ __forceinline__ void phase_post(const Ctx& c, int i, LAS unsigned char* lds) {
    typedef pg8::bf16x8 bf16x8;
    const unsigned short* P = (const unsigned short*)(c.ws + WS_P); const float* rope = (const float*)(c.ws + WS_ROPE);
    unsigned short* QA = (unsigned short*)(c.ws + WS_QA); unsigned short* KA = (unsigned short*)(c.ws + WS_KA); unsigned short* VA = (unsigned short*)(c.ws + WS_VA);
    unsigned short* RQ = (unsigned short*)(c.ws + WS_RQ); unsigned short* RK = (unsigned short*)(c.ws + WS_RK); unsigned short* RV = (unsigned short*)(c.ws + WS_RV);
    float* U = (float*)(c.ws + WS_U);
    const float* qkg = c.in[IN_QKG] + (size_t)i * 2 * 64;
    constexpr int VTS = 0, KTF = 17408, KTB = 34816;
    const int grp = c.tid >> 8, r = (c.tid & 255) >> 1, half = c.tid & 1;
    const int li = c.lane & 15, q4 = c.lane >> 4;
    pg8::u32x4 ra[4], rb[4], rc[4];
#define PP_LOAD(u_) do { const int hh_ = (u_) & 7, bc_ = (u_) >> 3, b_ = bc_ / 34, cch_ = bc_ - b_ * 34; const size_t row_ = (size_t)(b_ * RB + cch_ * 128 + r); \
        post_raw(P + row_ * INW + (grp ? 512 : 0) + hh_ * 64 + 32 * half, ra); post_raw(P + row_ * INW + (grp ? 2048 : 1024) + hh_ * 64 + 32 * half, rb); \
        if (hh_ < 2) post_raw(P + row_ * INW + (grp ? 2688 : 2560) + hh_ * 64 + 32 * half, rc); } while (0)
    if ((int)blockIdx.x < NB * 34 * 8) PP_LOAD((int)blockIdx.x);
    for (int unit = blockIdx.x; unit < NB * 34 * 8; unit += gridDim.x) {
        const int hh = unit & 7, bc = unit >> 3, b = bc / 34, cch = bc - b * 34, row0 = b * RB + cch * 128, bh = b * 8 + hh;
        const bool latent = cch >= 2;
        const size_t row = (size_t)(row0 + r);
        const int tpos = cch * 128 + r - CL;
        const float* cs = rope + (size_t)((half == 0 ? (tpos >> 6) : (tpos & 63)) * 16) * 2;
        const float lgf = -expf(c.in[IN_RETRATE][(i * 2 + 0) * 8 + hh]) * 1.4426950408889634f, lgb = -expf(c.in[IN_RETRATE][(i * 2 + 1) * 8 + hh]) * 1.4426950408889634f;
        __syncthreads();
        float v[32];
        post_cvt(ra, v);
        if (grp) {
#pragma unroll
            for (int d = 0; d < 32; ++d) v[d] *= 0.125f; }
        if (latent) post_rope(v, cs);
        post_st32((grp ? RK : RQ) + row * 512 + hh * 64 + 32 * half, v, 1.0f);
        if (grp) { const float wf = exp2f(lgf * (float)(127 - r)), wb = exp2f(lgb * (float)r);
#pragma unroll
            for (int d = 0; d < 32; d += 2) { const unsigned pf = pg8::cvt_pk_bf16(v[d] * wf, v[d + 1] * wf), pb = pg8::cvt_pk_bf16(v[d] * wb, v[d + 1] * wb);
                *(LAS unsigned short*)(lds + KTF + (32 * half + d) * 272 + r * 2) = (unsigned short)(pf & 0xffffu); *(LAS unsigned short*)(lds + KTF + (32 * half + d + 1) * 272 + r * 2) = (unsigned short)(pf >> 16);
                *(LAS unsigned short*)(lds + KTB + (32 * half + d) * 272 + r * 2) = (unsigned short)(pb & 0xffffu); *(LAS unsigned short*)(lds + KTB + (32 * half + d + 1) * 272 + r * 2) = (unsigned short)(pb >> 16); } }
        post_cvt(rb, v);
        if (grp == 0) { post_st32(RV + row * 512 + hh * 64 + 32 * half, v, 1.0f);
#pragma unroll
            for (int d = 0; d < 32; d += 2) { const unsigned pv = pg8::cvt_pk_bf16(v[d], v[d + 1]);
                *(LAS unsigned short*)(lds + VTS + (32 * half + d) * 272 + r * 2) = (unsigned short)(pv & 0xffffu); *(LAS unsigned short*)(lds + VTS + (32 * half + d + 1) * 272 + r * 2) = (unsigned short)(pv >> 16); }
        } else {
            float ss = 0.f;
#pragma unroll
            for (int d = 0; d < 32; ++d) ss += v[d] * v[d];
            ss += __shfl_xor(ss, 1);
            const float rs = rsqrtf(ss * (1.0f / 64.0f) + EPS);
#pragma unroll
            for (int d = 0; d < 32; ++d) v[d] = v[d] * rs * qkg[32 * half + d];
            if (latent) post_rope(v, cs);
            post_st32(QA + row * 512 + hh * 64 + 32 * half, v, attn_body::C2);
        }
        if (hh < 2) {
            post_cvt(rc, v);
            if (grp == 0) {
                float ss = 0.f;
#pragma unroll
                for (int d = 0; d < 32; ++d) ss += v[d] * v[d];
                ss += __shfl_xor(ss, 1);
                const float rs = rsqrtf(ss * (1.0f / 64.0f) + EPS);
#pragma unroll
                for (int d = 0; d < 32; ++d) v[d] = v[d] * rs * qkg[64 + 32 * half + d];
                if (latent) post_rope(v, cs);
                post_st32(KA + row * 128 + hh * 64 + 32 * half, v, 1.0f);
            } else post_st32(VA + row * 128 + hh * 64 + 32 * half, v, 1.0f);
        }
        if (unit + (int)gridDim.x < NB * 34 * 8) PP_LOAD(unit + (int)gridDim.x);
        __syncthreads();
        { const int dir = c.wave >> 2, dvt = c.wave & 3;
            bf16x8 af[4];
#pragma unroll
            for (int u = 0; u < 4; ++u) af[u] = *(const LAS bf16x8*)(lds + VTS + (16 * dvt + li) * 272 + (32 * u + 8 * q4) * 2);
            float* uo = U + ((size_t)(bh * 34 + cch) * 2 + dir) * 4096;
#pragma unroll
            for (int dkt = 0; dkt < 4; ++dkt) {
                f32x4 a = {0.f, 0.f, 0.f, 0.f};
#pragma unroll
                for (int u = 0; u < 4; ++u) { const bf16x8 kf = *(const LAS bf16x8*)(lds + (dir ? KTB : KTF) + (16 * dkt + li) * 272 + (32 * u + 8 * q4) * 2); a = __builtin_amdgcn_mfma_f32_16x16x32_bf16(af[u], kf, a, 0, 0, 0); }
#pragma unroll
                for (int rr = 0; rr < 4; ++rr) uo[(16 * dvt + 4 * q4 + rr) * 64 + 16 * dkt + li] = a[rr];
            } }
    }
}

#undef PP_LOAD
__device__ __forceinline__ void phase_ret_prefix(const Ctx& c, int i) {
    const float* U = (const float*)(c.ws + WS_U); unsigned short* ET = (unsigned short*)(c.ws + WS_ET);
    for (int chain = c.gt; chain < 64 * 2 * 4096; chain += c.ngt) {
        const int bh = chain >> 13, dir = (chain >> 12) & 1, el = chain & 4095, hh = bh & 7;
        const float g128 = expf(-expf(c.in[IN_RETRATE][(i * 2 + dir) * 8 + hh]) * 128.0f);
        float S = 0.f;
#pragma unroll
        for (int st = 0; st < 34; ++st) {
            const int cch = dir == 0 ? st : (st < 2 ? 1 - st : 35 - st);
            const size_t o = ((size_t)(bh * 34 + cch) * 2 + dir) * 4096 + el;
            ET[o] = (unsigned short)(pg8::cvt_pk_bf16(S, 0.f) & 0xffffu);
            S = g128 * S + U[o];
        }
    }
}
__device__ __forceinline__ void phase_ret_main(const Ctx& c, int i, LAS unsigned char* lds) {
    typedef pg8::bf16x8 bf16x8;
    const unsigned short* RQ = (const unsigned short*)(c.ws + WS_RQ); const unsigned short* RK = (const unsigned short*)(c.ws + WS_RK); const unsigned short* RV = (const unsigned short*)(c.ws + WS_RV);
    const unsigned short* ET = (const unsigned short*)(c.ws + WS_ET); const unsigned short* P = (const unsigned short*)(c.ws + WS_P); unsigned short* MIX = (unsigned short*)(c.ws + WS_MIX);
    const float* gn = c.in[IN_RETGN] + (size_t)i * 512;
    constexpr int QS = 0, KS = 18432, VTS = 36864, EF = 54272, EB = 63488;
    const int li = c.lane & 15, q4 = c.lane >> 4, i0 = 16 * c.wave, ig = i0 + li;
    pg8::u32x4 gq[2], gk[2], gv[2], gef, geb;
#define RM_LOAD(u_) do { const int bh_ = (u_) / 34, cch_ = (u_) - bh_ * 34, row0_ = (bh_ >> 3) * RB + cch_ * 128, hh_ = bh_ & 7; \
        _Pragma("unroll") for (int t2 = 0; t2 < 2; ++t2) { const int pc = c.tid + 512 * t2, r = pc >> 3, ch = pc & 7; const size_t go = (size_t)(row0_ + r) * 512 + hh_ * 64 + ch * 8; \
            gq[t2] = *(const pg8::u32x4*)(RQ + go); gk[t2] = *(const pg8::u32x4*)(RK + go); gv[t2] = *(const pg8::u32x4*)(RV + go); } \
        { const int r = c.tid >> 3, ch = c.tid & 7; const size_t go = ((size_t)(bh_ * 34 + cch_) * 2) * 4096 + r * 64 + ch * 8; gef = *(const pg8::u32x4*)(ET + go); geb = *(const pg8::u32x4*)(ET + go + 4096); } } while (0)
    if ((int)blockIdx.x < 64 * 34) RM_LOAD((int)blockIdx.x);
    for (int unit = blockIdx.x; unit < 64 * 34; unit += gridDim.x) {
        const int bh = unit / 34, cch = unit - bh * 34, b = bh >> 3, hh = bh & 7, row0 = b * RB + cch * 128;
        const float lgf = -expf(c.in[IN_RETRATE][(i * 2 + 0) * 8 + hh]) * 1.4426950408889634f, lgb = -expf(c.in[IN_RETRATE][(i * 2 + 1) * 8 + hh]) * 1.4426950408889634f;
        __syncthreads();
#pragma unroll
        for (int t2 = 0; t2 < 2; ++t2) { const int pc = c.tid + 512 * t2, r = pc >> 3, ch = pc & 7;
            *(LAS pg8::u32x4*)(lds + QS + r * 144 + ch * 16) = gq[t2];
            *(LAS pg8::u32x4*)(lds + KS + r * 144 + ch * 16) = gk[t2];
            const pg8::u32x4 vw = gv[t2];
#pragma unroll
            for (int e = 0; e < 4; ++e) { *(LAS unsigned short*)(lds + VTS + (ch * 8 + 2 * e) * 272 + r * 2) = (unsigned short)(vw[e] & 0xffffu); *(LAS unsigned short*)(lds + VTS + (ch * 8 + 2 * e + 1) * 272 + r * 2) = (unsigned short)(vw[e] >> 16); } }
        { const int r = c.tid >> 3, ch = c.tid & 7; *(LAS pg8::u32x4*)(lds + EF + r * 144 + ch * 16) = gef; *(LAS pg8::u32x4*)(lds + EB + r * 144 + ch * 16) = geb; }
        if (unit + (int)gridDim.x < 64 * 34) RM_LOAD(unit + (int)gridDim.x);
        __syncthreads();
        bf16x8 qf[2];
#pragma unroll
        for (int s = 0; s < 2; ++s) qf[s] = *(const LAS bf16x8*)(lds + QS + (i0 + li) * 144 + (32 * s + 8 * q4) * 2);
        pg8::u32x2 pk[8];
#pragma unroll
        for (int jt = 0; jt < 8; ++jt) {
            f32x4 a = {0.f, 0.f, 0.f, 0.f};
#pragma unroll
            for (int s = 0; s < 2; ++s) { const bf16x8 kf = *(const LAS bf16x8*)(lds + KS + (16 * jt + li) * 144 + (32 * s + 8 * q4) * 2); a = __builtin_amdgcn_mfma_f32_16x16x32_bf16(kf, qf[s], a, 0, 0, 0); }
            float pv[4];
#pragma unroll
            for (int r = 0; r < 4; ++r) { const int dl = ig - (16 * jt + 4 * q4 + r); const float w = dl >= 0 ? exp2f(lgf * (float)dl) : exp2f(lgb * (float)(-dl)); pv[r] = a[r] * w; }
            pk[jt] = (pg8::u32x2){pg8::cvt_pk_bf16(pv[0], pv[1]), pg8::cvt_pk_bf16(pv[2], pv[3])};
        }
        const float sf = exp2f(lgf * (float)(ig + 1)), sb = exp2f(lgb * (float)(128 - ig));
        f32x4 oacc[4];
#pragma unroll
        for (int dvt = 0; dvt < 4; ++dvt) {
            f32x4 o = {0.f, 0.f, 0.f, 0.f};
#pragma unroll
            for (int u = 0; u < 4; ++u) {
                const pg8::u32x2 vlo = *(const LAS pg8::u32x2*)(lds + VTS + (16 * dvt + li) * 272 + (32 * u + 4 * q4) * 2), vhi = *(const LAS pg8::u32x2*)(lds + VTS + (16 * dvt + li) * 272 + (32 * u + 16 + 4 * q4) * 2);
                const pg8::u32x4 av = {vlo.x, vlo.y, vhi.x, vhi.y}, bv = {pk[2 * u].x, pk[2 * u].y, pk[2 * u + 1].x, pk[2 * u + 1].y};
                o = __builtin_amdgcn_mfma_f32_16x16x32_bf16(__builtin_bit_cast(bf16x8, av), __builtin_bit_cast(bf16x8, bv), o, 0, 0, 0);
            }
            f32x4 tf = {0.f, 0.f, 0.f, 0.f}, tb = {0.f, 0.f, 0.f, 0.f};
#pragma unroll
            for (int s = 0; s < 2; ++s) {
                const bf16x8 ef = *(const LAS bf16x8*)(lds + EF + (16 * dvt + li) * 144 + (32 * s + 8 * q4) * 2), eb = *(const LAS bf16x8*)(lds + EB + (16 * dvt + li) * 144 + (32 * s + 8 * q4) * 2);
                tf = __builtin_amdgcn_mfma_f32_16x16x32_bf16(ef, qf[s], tf, 0, 0, 0); tb = __builtin_amdgcn_mfma_f32_16x16x32_bf16(eb, qf[s], tb, 0, 0, 0);
            }
            oacc[dvt] = o + tf * sf + tb * sb;
        }
        float sm = 0.f;
#pragma unroll
        for (int dvt = 0; dvt < 4; ++dvt) sm += (oacc[dvt].x + oacc[dvt].y) + (oacc[dvt].z + oacc[dvt].w);
        sm += __shfl_xor(sm, 16); sm += __shfl_xor(sm, 32);
        const float mu = sm * (1.0f / 64.0f); float vr = 0.f;
#pragma unroll
        for (int dvt = 0; dvt < 4; ++dvt) { oacc[dvt] = oacc[dvt] - mu; vr += (oacc[dvt].x * oacc[dvt].x + oacc[dvt].y * oacc[dvt].y) + (oacc[dvt].z * oacc[dvt].z + oacc[dvt].w * oacc[dvt].w); }
        vr += __shfl_xor(vr, 16); vr += __shfl_xor(vr, 32);
        const float rs = rsqrtf(vr * (1.0f / 64.0f) + EPS);
        const size_t row = (size_t)(row0 + ig);
#pragma unroll
        for (int dvt = 0; dvt < 4; ++dvt) { const int dvc = hh * 64 + 16 * dvt + 4 * q4;
            const pg8::u32x2 gw = *(const pg8::u32x2*)(P + row * INW + 1536 + dvc); const f32x4 gt = {__uint_as_float(gw.x << 16), __uint_as_float(gw.x & 0xffff0000u), __uint_as_float(gw.y << 16), __uint_as_float(gw.y & 0xffff0000u)}, gg = *(const f32x4*)(gn + dvc); const f32x4 y = oacc[dvt] * rs * gg;
            *(pg8::u32x2*)(MIX + row * D + dvc) = (pg8::u32x2){pg8::cvt_pk_bf16(gt.x * pg8::fast_sigmoid(gt.x) * y.x, gt.y * pg8::fast_sigmoid(gt.y) * y.y), pg8::cvt_pk_bf16(gt.z * pg8::fast_sigmoid(gt.z) * y.z, gt.w * pg8::fast_sigmoid(gt.w) * y.w)}; }
    }
}

#undef RM_LOAD
__device__ __forceinline__ void phase_attention(const Ctx& c, char* lds) {
    const attn_body::bf16* QA = (const attn_body::bf16*)(c.ws + WS_QA); const attn_body::bf16* KA = (const attn_body::bf16*)(c.ws + WS_KA); const attn_body::bf16* VA = (const attn_body::bf16*)(c.ws + WS_VA);
    attn_body::bf16* MIX = (attn_body::bf16*)(c.ws + WS_MIX);
    const int G = gridDim.x, bx = blockIdx.x, vcu = (G % 8 == 0) ? (bx % 8) * (G / 8) + bx / 8 : bx;
    for (int U = vcu; U < NB * 8 * 17; U += G) {
        int bh, qrow0, NT;
        if (U < NB * 8 * 16) { bh = U >> 4; qrow0 = (bh >> 3) * RB + CL + (U & 15) * 256; NT = RB / 64; }
        else { bh = U - NB * 8 * 16; qrow0 = (bh >> 3) * RB; NT = CL / 64; }
        const int b = bh >> 3, hh = bh & 7;
        attn_body::attn_unit<8>(QA + (size_t)qrow0 * 512 + hh * 64, KA + (size_t)(b * RB) * 128 + (hh >> 2) * 64, VA + (size_t)(b * RB) * 128 + (hh >> 2) * 64,
                                MIX + (size_t)qrow0 * 1024 + 512 + hh * 64, NT, lds, c.wave);
    }
}

__device__ __forceinline__ void phase_s5_ops(const Ctx& c, LAS float* ldsf) {
    LAS float* Pre = ldsf; LAS float* Pim = ldsf + 4608; LAS float* KZr = ldsf + 9216; LAS float* KZi = ldsf + 9344;
    LAS float* Bre = ldsf + 9472; LAS float* Bim = ldsf + 10496; LAS float* Cre = ldsf + 11520; LAS float* Cim = ldsf + 13568;
    LAS float* KV = ldsf + 15616;
#define S5P(dir, pw, p) (((dir) * 64 + (p)) * 36 + (pw))
    for (int task = blockIdx.x; task < 2 * 64 * 2; task += gridDim.x) {
        const int i = task >> 7, g = (task >> 1) & 63, hf = task & 1;
        __syncthreads();
        if (c.tid < 128) {
            const int dir = c.tid >> 6, p = c.tid & 63;
            const float a_re = c.in[IN_S5ARE][((i * 2 + dir) * 64 + g) * 64 + p], a_im = c.in[IN_S5AIM][((i * 2 + dir) * 64 + g) * 64 + p];
            const float dt = expf(c.in[IN_S5DT][(i * 2 + dir) * 64 + g]);
            const float lre = fminf(a_re, -1e-4f), lim = a_im, ea = lre * dt, eb = lim * dt;
            for (int dl = 0; dl <= 32; ++dl) { const float m = expf(ea * (float)dl), an = eb * (float)dl; Pre[S5P(dir, dl, p)] = m * cosf(an); Pim[S5P(dir, dl, p)] = m * sinf(an); }
            const float cb = cosf(eb), sb = sinf(eb), sh = sinf(0.5f * eb), mag = expf(ea);
            const float nr = expm1f(ea) * cb - 2.0f * sh * sh, ni = mag * sb, den = lre * lre + lim * lim;
            KZr[dir * 64 + p] = (nr * lre + ni * lim) / den; KZi[dir * 64 + p] = (ni * lre - nr * lim) / den;
        }
        for (int idx = c.tid; idx < 1024; idx += 512) { Bre[idx] = c.in[IN_S5BRE][(size_t)(i * 64 + g) * 1024 + idx]; Bim[idx] = c.in[IN_S5BIM][(size_t)(i * 64 + g) * 1024 + idx]; }
        for (int idx = c.tid; idx < 2048; idx += 512) { const int dir = idx >> 10, rem = idx & 1023;
            Cre[idx] = c.in[IN_S5CRE][((size_t)(i * 2 + dir) * 64 + g) * 1024 + rem]; Cim[idx] = c.in[IN_S5CIM][((size_t)(i * 2 + dir) * 64 + g) * 1024 + rem]; }
        __syncthreads();
        {
            const int dir = c.tid >> 8, ko = (c.tid >> 4) & 15, ki = c.tid & 15;
            float acc[32];
#pragma unroll
            for (int dl = 0; dl < 32; ++dl) acc[dl] = 0.f;
            for (int p = 0; p < 64; ++p) {
                const float kr = KZr[dir * 64 + p], kq = KZi[dir * 64 + p], br = Bre[p * 16 + ki], bi = Bim[p * 16 + ki], cr = Cre[(dir * 16 + ko) * 64 + p], ci = Cim[(dir * 16 + ko) * 64 + p];
                const float gr = kr * br - kq * bi, gi = kr * bi + kq * br, tr = cr * gr - ci * gi, ti = cr * gi + ci * gr;
#pragma unroll
                for (int d4 = 0; d4 < 8; ++d4) { const f32x4 pr = *(const LAS f32x4*)(Pre + S5P(dir, 4 * d4, p)), pi = *(const LAS f32x4*)(Pim + S5P(dir, 4 * d4, p));
                    acc[4 * d4] += tr * pr.x - ti * pi.x; acc[4 * d4 + 1] += tr * pr.y - ti * pi.y; acc[4 * d4 + 2] += tr * pr.z - ti * pi.z; acc[4 * d4 + 3] += tr * pr.w - ti * pi.w; }
            }
#pragma unroll
            for (int dl = 0; dl < 32; ++dl) KV[((dir * 32 + dl) * 16 + ko) * 16 + ki] = acc[dl];
        }
        __syncthreads();
        unsigned* TV = (unsigned*)(c.ws + WS_TV) + ((size_t)(i * 64 + g) * 512 * 768) / 2;
        const float* dsk = c.in[IN_S5D] + (size_t)i * D + 16 * g;
        if (c.tid < 384) {
            const int kp = c.tid, kk = 2 * kp;
            if (kk < 512) {
                const int j = kk >> 4, ki = kk & 15;
                for (int it = 16 * hf; it < 16 * hf + 16; ++it) {
                    const int dl = it > j ? it - j : j - it, dir = it > j ? 0 : 1;
                    for (int ko = 0; ko < 16; ++ko) {
                        float v0, v1;
                        if (it != j) { v0 = KV[((dir * 32 + dl) * 16 + ko) * 16 + ki]; v1 = KV[((dir * 32 + dl) * 16 + ko) * 16 + ki + 1]; }
                        else { v0 = KV[(ko) * 16 + ki] + KV[((32) * 16 + ko) * 16 + ki] + (ko == ki ? dsk[ko] : 0.f); v1 = KV[(ko) * 16 + ki + 1] + KV[((32) * 16 + ko) * 16 + ki + 1] + (ko == ki + 1 ? dsk[ko] : 0.f); }
                        TV[(size_t)(it * 16 + ko) * 384 + kp] = pg8::cvt_pk_bf16(v0, v1);
                    }
                }
            } else {
                const int q = kk - 512, dir = q >> 7, part = (q >> 6) & 1, p = q & 63;
                for (int it = 16 * hf; it < 16 * hf + 16; ++it) {
                    const int pw = dir == 0 ? it + 1 : 32 - it;
                    const float pr0 = Pre[S5P(dir, pw, p)], pi0 = Pim[S5P(dir, pw, p)], pr1 = Pre[S5P(dir, pw, p + 1)], pi1 = Pim[S5P(dir, pw, p + 1)];
                    for (int ko = 0; ko < 16; ++ko) {
                        const float cr0 = Cre[(dir * 16 + ko) * 64 + p], ci0 = Cim[(dir * 16 + ko) * 64 + p], cr1 = Cre[(dir * 16 + ko) * 64 + p + 1], ci1 = Cim[(dir * 16 + ko) * 64 + p + 1];
                        const float v0 = part == 0 ? (cr0 * pr0 - ci0 * pi0) : -(cr0 * pi0 + ci0 * pr0), v1 = part == 0 ? (cr1 * pr1 - ci1 * pi1) : -(cr1 * pi1 + ci1 * pr1);
                        TV[(size_t)(it * 16 + ko) * 384 + kp] = pg8::cvt_pk_bf16(v0, v1);
                    }
                }
            }
        }
        unsigned* WS5 = (unsigned*)(c.ws + WS_WS5) + ((size_t)(i * 64 + g) * 256 * 512) / 2;
        if (c.tid < 256) {
            const int kp = c.tid, kk = 2 * kp, j = kk >> 4, ki = kk & 15, dir = hf, pw = dir == 0 ? 31 - j : j;
            for (int pp = 0; pp < 128; ++pp) {
                const int part = pp >> 6, p = pp & 63;
                const float pr = Pre[S5P(dir, pw, p)], pi = Pim[S5P(dir, pw, p)], kr = KZr[dir * 64 + p], kq = KZi[dir * 64 + p];
                const float gr = pr * kr - pi * kq, gi = pr * kq + pi * kr, br0 = Bre[p * 16 + ki], bi0 = Bim[p * 16 + ki], br1 = Bre[p * 16 + ki + 1], bi1 = Bim[p * 16 + ki + 1];
                const float v0 = part == 0 ? (gr * br0 - gi * bi0) : (gr * bi0 + gi * br0), v1 = part == 0 ? (gr * br1 - gi * bi1) : (gr * bi1 + gi * br1);
                WS5[(size_t)(128 * hf + pp) * 256 + kp] = pg8::cvt_pk_bf16(v0, v1);
            }
        }
    }
#undef S5P
}
__device__ __forceinline__ void phase_s5_carry(const Ctx& c, int i) {
    const float* SL = (const float*)(c.ws + WS_SL); unsigned short* AS5 = (unsigned short*)(c.ws + WS_AS5);
    for (int id = c.gt; id < 64 * 8 * 2 * 64; id += c.ngt) {
        const int p = id & 63, dir = (id >> 6) & 1, b = (id >> 7) & 7, g = id >> 10;
        const float a_re = c.in[IN_S5ARE][((i * 2 + dir) * 64 + g) * 64 + p], a_im = c.in[IN_S5AIM][((i * 2 + dir) * 64 + g) * 64 + p];
        const float dt = expf(c.in[IN_S5DT][(i * 2 + dir) * 64 + g]);
        const float lre = fminf(a_re, -1e-4f), m32 = expf(lre * dt * 32.0f), an = a_im * dt * 32.0f, ar = m32 * cosf(an), ai = m32 * sinf(an);
        float xr = 0.f, xi = 0.f;
        for (int s0 = 0; s0 < 136; s0 += 17) {
            float sr[17], si[17]; size_t rr[17];
#pragma unroll
            for (int k = 0; k < 17; ++k) { const int st = s0 + k, cch = dir == 0 ? st : (st < 8 ? 7 - st : 143 - st);
                rr[k] = (size_t)g * 1280 + b * 136 + cch; sr[k] = SL[rr[k] * 256 + dir * 128 + p]; si[k] = SL[rr[k] * 256 + dir * 128 + 64 + p]; }
#pragma unroll
            for (int k = 0; k < 17; ++k) {
                unsigned short* xo = AS5 + rr[k] * 768 + 512 + dir * 128 + p;
                xo[0] = (unsigned short)(pg8::cvt_pk_bf16(xr, 0.f) & 0xffffu); xo[64] = (unsigned short)(pg8::cvt_pk_bf16(xi, 0.f) & 0xffffu);
                const float nxr = ar * xr - ai * xi + sr[k], nxi = ar * xi + ai * xr + si[k];
                xr = nxr; xi = nxi;
            }
        }
    }
}

__device__ __forceinline__ void cvt_item(const float* W, int ldw, int k0, int scol0, unsigned short* WT, int K, int drow0, LAS float* scr, int lane) {
    float wv[32];
#pragma unroll
    for (int i = 0; i < 32; ++i) wv[i] = W[(size_t)(k0 + 2 * i + (lane >> 5)) * ldw + scol0 + (lane & 31)];
#pragma unroll
    for (int i = 0; i < 32; ++i) scr[(2 * i + (lane >> 5)) * 33 + (lane & 31)] = wv[i];
    asm volatile("s_waitcnt lgkmcnt(0)" ::: "memory");
    const int cc = lane & 7;
#pragma unroll
    for (int j = 0; j < 4; ++j) { const int n = (lane >> 3) + 8 * j; const LAS float* s = scr + (8 * cc) * 33 + n;
        pg8::u32x4 o; o.x = pg8::cvt_pk_bf16(s[0 * 33], s[1 * 33]); o.y = pg8::cvt_pk_bf16(s[2 * 33], s[3 * 33]); o.z = pg8::cvt_pk_bf16(s[4 * 33], s[5 * 33]); o.w = pg8::cvt_pk_bf16(s[6 * 33], s[7 * 33]);
        *(pg8::u32x4*)(WT + (size_t)(drow0 + n) * K + k0 + 8 * cc) = o; }
    asm volatile("s_waitcnt lgkmcnt(0)" ::: "memory");
}
__device__ __forceinline__ void cvt_item8(const float* W, int ldw, int k0, int scol0, unsigned char* WT, int K, int drow0, LAS float* scr, int lane) {
    float wv[32];
#pragma unroll
    for (int i = 0; i < 32; ++i) wv[i] = W[(size_t)(k0 + 2 * i + (lane >> 5)) * ldw + scol0 + (lane & 31)];
#pragma unroll
    for (int i = 0; i < 32; ++i) scr[(2 * i + (lane >> 5)) * 33 + (lane & 31)] = wv[i] * pg8::W8_SCALE;
    asm volatile("s_waitcnt lgkmcnt(0)" ::: "memory");
    const int n = lane >> 1, kh = lane & 1; const LAS float* s = scr + (32 * kh) * 33 + n;
    unsigned w[8];
#pragma unroll
    for (int j = 0; j < 8; ++j) w[j] = pg8::pk4_fp8(s[(4 * j) * 33], s[(4 * j + 1) * 33], s[(4 * j + 2) * 33], s[(4 * j + 3) * 33]);
    unsigned char* o = WT + (size_t)(drow0 + n) * K + k0 + 32 * kh;
    *(pg8::u32x4*)o = (pg8::u32x4){w[0], w[1], w[2], w[3]}; *(pg8::u32x4*)(o + 16) = (pg8::u32x4){w[4], w[5], w[6], w[7]};
    asm volatile("s_waitcnt lgkmcnt(0)" ::: "memory");
}
__device__ __forceinline__ void cvt_moe_tile(const Ctx& c, LAS unsigned char* img, int id) {
    unsigned char* W13 = (unsigned char*)(c.ws + WS_W13); unsigned char* W2T = (unsigned char*)(c.ws + WS_W2);
    const int le = id / 192; int r = id - le * 192;
    const float* sp; int ldw, K; unsigned char* dst; int rowl;
    if (r < 128) { const int kt = r >> 4, pn = r & 15, half = c.lane >> 5, n4 = c.lane & 31;
        sp = (half ? c.in[IN_W3] : c.in[IN_W1]) + (size_t)le * D * FF + (size_t)(128 * kt + 16 * c.wave) * FF + 128 * pn + 4 * n4; ldw = FF; K = D;
        dst = W13 + (size_t)le * 4096 * D + (size_t)(256 * pn) * D + 128 * kt; rowl = 128 * half + 4 * n4;
    } else { r -= 128; const int kt = r >> 2, pn = r & 3;
        sp = c.in[IN_W2] + (size_t)le * FF * D + (size_t)(128 * kt + 16 * c.wave) * D + 256 * pn + 4 * c.lane; ldw = D; K = FF;
        dst = W2T + (size_t)le * D * FF + (size_t)(256 * pn) * FF + 128 * kt; rowl = 4 * c.lane; }
    f32x4 v[16];
#pragma unroll
    for (int q = 0; q < 16; ++q) v[q] = *(const f32x4*)(sp + (size_t)q * ldw);
    __syncthreads();
#pragma unroll
    for (int j = 0; j < 4; ++j) {
        pg8::u32x4 w;
#pragma unroll
        for (int q4 = 0; q4 < 4; ++q4) w[q4] = pg8::pk4_fp8(v[4 * q4][j] * pg8::W8_SCALE, v[4 * q4 + 1][j] * pg8::W8_SCALE, v[4 * q4 + 2][j] * pg8::W8_SCALE, v[4 * q4 + 3][j] * pg8::W8_SCALE);
        const int row = rowl + j;
        *(LAS pg8::u32x4*)(img + row * 128 + ((c.wave ^ ((row >> 2) & 7)) * 16)) = w;
    }
    __syncthreads();
#pragma unroll
    for (int i4 = 0; i4 < 4; ++i4) { const int p = c.tid + 512 * i4, row = p >> 3, ch = p & 7;
        *(pg8::u32x4*)(dst + (size_t)row * K + 16 * ch) = *(const LAS pg8::u32x4*)(img + row * 128 + ((ch ^ ((row >> 2) & 7)) * 16)); }
}
constexpr int HS_N = 10, HS_L0 = 1792, HS_L3 = 2688;
__device__ __forceinline__ void host_slot(int gs, int& rem, int& quota) {
    constexpr int REM[HS_N] = {32, 64, 64, 128, 64, 64, 32, 64, 64, 128}, Q[HS_N] = {8, 7, 3, 5, 5, 5, 8, 7, 3, 5};
    rem = 0; quota = 0;
#pragma unroll
    for (int i = 0; i < HS_N; ++i) if (i == gs) { rem = REM[i]; quota = Q[i]; }
}
__device__ __forceinline__ int host_tile_id(int u) {
    if (u < HS_L0) return u;
    u -= HS_L0; if (u < 3072) return 3072 + u;
    u -= 3072; if (u < 3072) return 2 * 3072 + u;
    u -= 3072; if (u < HS_L3) return 3 * 3072 + u;
    return -1;
}
__device__ __forceinline__ void hosted_cvt(const Ctx& c, LAS unsigned char* img, int L, int slot) {
    if (gridDim.x != 256) return;
    const int gs = (L == 0) ? slot : (L == 1) ? 2 + slot : (L == 2) ? 6 + slot : 8 + slot;
    if (gs >= HS_N || (L == 3 && slot >= 2)) return;
    int off = 0;
    for (int s = 0; s < gs; ++s) { int r0, q0; host_slot(s, r0, q0); off += (256 - r0) * q0; }
    int rem, q; host_slot(gs, rem, q);
    if ((int)blockIdx.x < rem) return;
    const int idle = 256 - rem, rank = (int)blockIdx.x - rem;
    for (int k = 0; k < q; ++k) { const int id = host_tile_id(off + rank + k * idle); if (id >= 0) cvt_moe_tile(c, img, id); }
    __syncthreads();
}
__device__ __forceinline__ void phase_cvt_moe(const Ctx& c, LAS float* ldsf) {
    LAS unsigned char* img = (LAS unsigned char*)ldsf;
    const int G = gridDim.x;
    if (G == 256) {
        const int n0 = 3072 - HS_L0, n3 = 3072 - HS_L3;
        for (int j = blockIdx.x; j < n0 + n3; j += G) cvt_moe_tile(c, img, j < n0 ? HS_L0 + j : 3 * 3072 + HS_L3 + (j - n0));
    } else {
        for (int j = blockIdx.x; j < DEPTH * 3072; j += G) cvt_moe_tile(c, img, j);
    }
    __syncthreads();
    LAS float* scr = ldsf + c.wave * (64 * 33);
    unsigned short* WIN = (unsigned short*)(c.ws + WS_WIN); unsigned short* WOUT = (unsigned short*)(c.ws + WS_WOUT); unsigned short* WGLU = (unsigned short*)(c.ws + WS_WGLU);
    for (int id = c.gw; id < 2 * (1408 + 512 + 1024); id += c.ngw) {
        const int i = id / 2944; int r = id - i * 2944;
        if (r < 1408) { const int kb = r / 88, nb = r - kb * 88; cvt_item(c.in[IN_MIXIN] + (size_t)i * D * INW, INW, 64 * kb, 32 * nb, WIN + (size_t)i * INW * D, D, 32 * nb, scr, c.lane); }
        else if (r < 1920) { r -= 1408; const int kb = r >> 5, nb = r & 31; cvt_item(c.in[IN_MIXOUT] + (size_t)i * D * D, D, 64 * kb, 32 * nb, WOUT + (size_t)i * D * D, D, 32 * nb, scr, c.lane); }
        else { r -= 1920; const int kb = r >> 6, nb = r & 63, pn = nb >> 3, rr0 = (nb & 7) * 32;
            cvt_item(c.in[IN_GLUW] + (size_t)i * D * 2048, 2048, 64 * kb, (rr0 < 128 ? 0 : 1024) + 128 * pn + (rr0 & 127), WGLU + (size_t)i * 2048 * D, D, 32 * nb, scr, c.lane); }
    }
}

struct ALDense { const float* A; int lda; size_t gstride; __device__ __forceinline__ const float* row(int g, int r) const { return A + (size_t)g * gstride + (size_t)r * lda; } };
struct ALGather { const float* A; const int* idx; __device__ __forceinline__ const float* row(int g, int r) const { return A + (size_t)idx[g * EROWS + r] * D; } };
struct BL1 { const float* B; int ldb; size_t gstride; __device__ __forceinline__ const float* ptr(int g, int) const { return B + (size_t)g * gstride; } };
struct BL2 { const float* Ba; const float* Bb; int ldb; size_t gstride; __device__ __forceinline__ const float* ptr(int g, int sub) const { return (sub ? Bb : Ba) + (size_t)g * gstride; } };
struct EPStore { float* O; int ldc; __device__ __forceinline__ void operator()(int, int row, int col, float v, float) const { O[(size_t)row * ldc + col] = v; } };
struct EPResid { float* X; const float* mod; int L; __device__ __forceinline__ void operator()(int, int row, int col, float v, float) const {
    const int j = row_j(row); const float g1 = mod[((size_t)(L * 9 + j) * 6 + 2) * 1024 + col]; X[(size_t)row * D + col] += g1 * v; } };
struct EPGlu { float* X; const float* mod; const float* bias; int L; __device__ __forceinline__ void operator()(int, int row, int col, float va, float vb) const {
    const int j = row_j(row); const float g1 = mod[((size_t)(L * 9 + j) * 6 + 2) * 1024 + col];
    const float o = (va + bias[col]) * sigmoidf_(vb + bias[1024 + col]); X[(size_t)row * D + col] += g1 * o; } };
struct EPSwiglu { float* HID; __device__ __forceinline__ void operator()(int g, int row, int col, float va, float vb) const { HID[((size_t)g * EROWS + row) * FF + col] = siluf_(va) * vb; } };
struct EPGate { float* Y; const float* gate; __device__ __forceinline__ void operator()(int g, int row, int col, float v, float) const { Y[((size_t)g * EROWS + row) * D + col] = gate[g * EROWS + row] * v; } };

__global__ void __launch_bounds__(512, 2) fwd(Args args) {
    extern __shared__ __attribute__((aligned(16))) unsigned char lds[];
    Ctx c; c.in = args.in; c.out = args.out; c.ws = args.ws;
    c.wave = __builtin_amdgcn_readfirstlane((int)threadIdx.x >> 6); c.lane = lane_id(); c.tid = c.wave * 64 + c.lane;
    c.gw = blockIdx.x * 8 + c.wave; c.ngw = gridDim.x * 8; c.gt = blockIdx.x * 512 + c.tid; c.ngt = gridDim.x * 512;
    LAS float* ldsf = (LAS float*)lds; LAS unsigned char* ldsb = (LAS unsigned char*)lds;
    volatile LAS unsigned* MISC = (volatile LAS unsigned*)((LAS unsigned char*)lds + MISC_OFF);
    if (c.tid < 32) MISC[c.tid] = 0u;
    __syncthreads();
    const int lo = args.ph_lo, hi = args.ph_hi;
    const bool one_launch = (hi - lo) > 1;
    XcdBarrier bar; bar.bar = (unsigned*)(c.ws + WS_CTL) + CW_BAR; bar.x = 0; bar.st = MISC + 8; bar.wave = c.wave;
    if (one_launch) bar = xcd_barrier_post((unsigned*)(c.ws + WS_CTL) + CW_BAR, MISC + 8);
#define IN(k) (lo <= (k) && (k) < hi)
#define SEAM(k) do { if ((k) + 1 < hi) xcd_barrier(bar); } while (0)
#define FRESH(cc) Ctx cc; unsigned zq; asm volatile("s_mov_b32 %0, 0" : "=s"(zq)); cc.ws = c.ws + zq; cc.out = c.out + zq; cc.in = (const float* const*)((const char*)c.in + zq); \
    { int lq = lane_id(); asm volatile("" : "+v"(lq)); cc.wave = c.wave + (int)zq; cc.lane = lq; cc.tid = cc.wave * 64 + lq; const int tq = cc.tid; cc.gw = blockIdx.x * 8 + cc.wave; cc.ngw = gridDim.x * 8; cc.gt = blockIdx.x * 512 + tq; cc.ngt = gridDim.x * 512; } \
    const int Lq = L + (int)zq, iq = Lq >> 1; const float* MOD = (const float*)(cc.ws + WS_MOD); (void)MOD; (void)iq

    if (IN(PH_PRO)) { const int L = 0; FRESH(cc); phase_pro(cc, ldsf); __syncthreads(); phase_s5_ops(cc, ldsf); __syncthreads(); phase_cvt_moe(cc, ldsf); SEAM(PH_PRO); }

#define LAYER_BODY(LL) { constexpr int L = LL; \
        const int pb = 1 + L * PH_PER_LAYER; \
        if (IN(pb + 0)) { FRESH(cc); phase_norm1<false, (L & 1) != 0>(cc, Lq); SEAM(pb + 0); } \
        if ((L & 1) == 0) { \
            if (IN(pb + 1)) { \
                FRESH(cc); \
                pg8::GOrder S; S.init(1, NROWS, INW, (int)gridDim.x, (int)blockIdx.x); \
                pg8::ADense al{(const pg8::bf16_t*)(cc.ws + WS_HB1), 0, nullptr, 0, D, 0, 64}; pg8::EpiBf16 ep{(pg8::bf16_t*)(cc.ws + WS_P), INW}; \
                pg8::gemm_phase(ldsb, al, (const pg8::bf16_t*)(cc.ws + WS_WIN) + (size_t)iq * INW * D, 0, D, S, ep, cc.wave); SEAM(pb + 1); } \
            if (IN(pb + 2)) { FRESH(cc); phase_post(cc, iq, ldsb); SEAM(pb + 2); } \
            if (IN(pb + 4)) { FRESH(cc); phase_ret_prefix(cc, iq); \
                  \
                unsigned* cnt = (unsigned*)(cc.ws + WS_CTL) + CW_CNT + 64 * L; \
                asm volatile("s_waitcnt vmcnt(0)" ::: "memory"); __syncthreads(); \
                if (cc.tid == 0) { __builtin_amdgcn_fence(__ATOMIC_RELEASE, "agent"); asm volatile("s_waitcnt vmcnt(0)" ::: "memory"); (void)xb_add(cnt, 1u); } \
                phase_attention(cc, (char*)lds); \
                if (cc.tid == 0) { unsigned* tb = (unsigned*)(cc.ws + WS_CTL) + CW_BAR; XB_SPIN(xb_ld(cnt) < gridDim.x, tb); __builtin_amdgcn_fence(__ATOMIC_ACQUIRE, "agent"); asm volatile("s_waitcnt vmcnt(0)" ::: "memory"); } \
                __syncthreads(); \
                phase_ret_main(cc, iq, ldsb); SEAM(pb + 4); } \
            if (IN(pb + 6)) { \
                FRESH(cc); \
                pg8::GOrder S; S.init(1, NROWS, D, (int)gridDim.x, (int)blockIdx.x); \
                pg8::ADense al{(const pg8::bf16_t*)(cc.ws + WS_MIX), 0, nullptr, 0, D, 0, 64}; pg8::EpiResid ep{(pg8::bf16_t*)(cc.ws + WS_X), MOD + (size_t)Lq * 9 * 6144}; \
                pg8::gemm_phase(ldsb, al, (const pg8::bf16_t*)(cc.ws + WS_WOUT) + (size_t)iq * D * D, 0, D, S, ep, cc.wave); hosted_cvt(cc, ldsb, L, 0); SEAM(pb + 6); } \
        } else { \
            if (IN(pb + 1)) { \
                FRESH(cc); \
                pg8::GOrder S; S.init(64, 1280, 256, (int)gridDim.x, (int)blockIdx.x); \
                pg8::ADense al{(const pg8::bf16_t*)(cc.ws + WS_AS5), (size_t)1280 * 768, nullptr, 0, 768, 0, 64}; pg8::EpiF32 ep{(float*)(cc.ws + WS_SL), 256, (size_t)1280 * 256}; \
                pg8::gemm_phase(ldsb, al, (const pg8::bf16_t*)(cc.ws + WS_WS5) + (size_t)iq * 64 * 256 * 512, (size_t)256 * 512, 512, S, ep, cc.wave); hosted_cvt(cc, ldsb, L, 0); SEAM(pb + 1); } \
            if (IN(pb + 2)) { FRESH(cc); phase_s5_carry(cc, iq); SEAM(pb + 2); } \
            if (IN(pb + 3)) { \
                FRESH(cc); \
                pg8::GOrder S; S.init(64, 1280, 512, (int)gridDim.x, (int)blockIdx.x); \
                pg8::ADense al{(const pg8::bf16_t*)(cc.ws + WS_AS5), (size_t)1280 * 768, nullptr, 0, 768, 0, 64}; pg8::EpiGeluBf16 ep{(pg8::bf16_t*)(cc.ws + WS_ZG), 512, (size_t)1280 * 512}; \
                pg8::gemm_phase(ldsb, al, (const pg8::bf16_t*)(cc.ws + WS_TV) + (size_t)iq * 64 * 512 * 768, (size_t)512 * 768, 768, S, ep, cc.wave); hosted_cvt(cc, ldsb, L, 1); SEAM(pb + 3); } \
            if (IN(pb + 4)) { \
                FRESH(cc); \
                pg8::GOrder S; S.init(1, NROWS, 2048, (int)gridDim.x, (int)blockIdx.x, L == DEPTH - 1); \
                pg8::ADense al{(const pg8::bf16_t*)(cc.ws + WS_ZG), 0, nullptr, 0, 16, 1280 * 512, (size_t)4 * 1280 * 512}; pg8::EpiGluResid ep{(pg8::bf16_t*)(cc.ws + WS_X), MOD + (size_t)Lq * 9 * 6144, cc.in[IN_GLUB] + (size_t)iq * 2048}; \
                pg8::gemm_phase(ldsb, al, (const pg8::bf16_t*)(cc.ws + WS_WGLU) + (size_t)iq * 2048 * D, 0, D, S, ep, cc.wave); hosted_cvt(cc, ldsb, L, 2); SEAM(pb + 4); } \
        } \
        if (IN(pb + 7)) { FRESH(cc); phase_norm2_router<L == DEPTH - 1>(cc, Lq, ldsf); SEAM(pb + 7); } \
        if (IN(pb + 8)) { FRESH(cc); phase_topk(cc, (LAS unsigned*)lds, L == DEPTH - 1 ? 128 : 256); SEAM(pb + 8); } \
        if (IN(pb + 9)) { \
            FRESH(cc); \
            pg8::GOrder S; S.init(NE, L == DEPTH - 1 ? NB * CAP_LAT : EROWS, 2 * FF, (int)gridDim.x, (int)blockIdx.x); \
            pg8::ADense al{(const pg8::bf16_t*)(cc.ws + WS_XS), (size_t)EROWS * D, nullptr, 0, D, 0, 128}; \
            pg8::EpiSwiglu ep{(unsigned char*)(cc.ws + WS_HID), FF, (size_t)EROWS * FF}; \
            pg8::gemm_phase<true>(ldsb, al, (const unsigned char*)(cc.ws + WS_W13) + (size_t)Lq * NE * 4096 * D, (size_t)4096 * D, D, S, ep, cc.wave); SEAM(pb + 9); } \
        if (IN(pb + 10)) { \
            FRESH(cc); \
            pg8::GOrder S; S.init(NE, L == DEPTH - 1 ? NB * CAP_LAT : EROWS, D, (int)gridDim.x, (int)blockIdx.x); \
            pg8::ADense al{(const pg8::bf16_t*)(cc.ws + WS_HID), (size_t)EROWS * FF, nullptr, 0, FF, 0, 128}; \
            pg8::EpiGate ep{(unsigned char*)(cc.ws + WS_Y), D, (size_t)EROWS * D, (const float*)(cc.ws + WS_SELGATE), EROWS}; \
            pg8::gemm_phase<true>(ldsb, al, (const unsigned char*)(cc.ws + WS_W2) + (size_t)Lq * NE * D * FF, (size_t)D * FF, FF, S, ep, cc.wave); hosted_cvt(cc, ldsb, L, (L & 1) ? 3 : 1); SEAM(pb + 10); } \
    }
    LAYER_BODY(0) LAYER_BODY(1) LAYER_BODY(2) LAYER_BODY(3)
#undef LAYER_BODY
    if (IN(PH_FIN)) { const int L = DEPTH; FRESH(cc); phase_norm1<true, false>(cc, DEPTH); }
#undef IN
#undef SEAM
}

static bool phase_valid(int ph) {
    if (ph == PH_PRO || ph == PH_FIN) return true;
    const int L = (ph - 1) / PH_PER_LAYER, k = (ph - 1) % PH_PER_LAYER;
    if (L & 1) return !(k >= 5 && k <= 6);
    return k != 3 && k != 5;
}
extern "C" void kernel_launch(void* const* d_in, const int* in_sizes, int n_in, void* d_out, int out_size, void* d_ws, size_t ws_size, hipStream_t stream) {
    static int grid = 0;
    if (grid == 0) {
        if (n_in != 27 || out_size != NB * T * D || ws_size < WS_END) { fprintf(stderr, "kernel_launch: unexpected shapes (n_in %d out %d ws %zu)\n", n_in, out_size, ws_size); grid = -1; return; }
        int dev = 0, cus = 0;
        if (hipGetDevice(&dev) != hipSuccess || hipDeviceGetAttribute(&cus, hipDeviceAttributeMultiprocessorCount, dev) != hipSuccess) { grid = -1; return; }
        if (hipFuncSetAttribute((const void*)fwd, hipFuncAttributeMaxDynamicSharedMemorySize, LDS_BYTES) != hipSuccess) { grid = -1; return; }
        int per_cu = 0;
        if (hipOccupancyMaxActiveBlocksPerMultiprocessor(&per_cu, (const void*)fwd, 512, LDS_BYTES) != hipSuccess || per_cu < 1) fprintf(stderr, "kernel_launch: occupancy query says %d\n", per_cu);
        (void)hipGetLastError();
        grid = cus;
    }
    if (grid < 0) return;
    if (hipMemsetAsync((char*)d_ws + WS_CTL, 0, CTL_ZERO_BYTES, stream) != hipSuccess) return;
    Args a{};
    for (int i = 0; i < 27; ++i) a.in[i] = (const float*)d_in[i];
    a.out = (float*)d_out; a.ws = (unsigned char*)d_ws;
#if MK_MULTI
    for (int ph = 0; ph < NPH; ++ph) {
        if (!phase_valid(ph)) continue;
        a.ph_lo = ph; a.ph_hi = ph + 1;
        hipLaunchKernelGGL(fwd, dim3(grid), dim3(512), LDS_BYTES, stream, a);
    }
#else
    a.ph_lo = 0; a.ph_hi = NPH;
    hipLaunchKernelGGL(fwd, dim3(grid), dim3(512), LDS_BYTES, stream, a);
#ifdef PROBE_PHASES
    { static const int probe[] = {PROBE_PHASES}; for (unsigned q = 0; q < sizeof(probe) / sizeof(probe[0]); ++q) { a.ph_lo = probe[q]; a.ph_hi = probe[q] + 1; hipLaunchKernelGGL(fwd, dim3(grid), dim3(512), LDS_BYTES, stream, a); } }
#endif
#endif
}
```

```cpp
#include <hip/hip_runtime.h>
#include <hip/hip_bf16.h>
#include <cstdio>
#include <cstdint>

#define GAS __attribute__((address_space(1)))
#define LAS __attribute__((address_space(3)))
typedef float f32x4 __attribute__((ext_vector_type(4)));
typedef float f32x2 __attribute__((ext_vector_type(2)));
typedef float f32x16 __attribute__((ext_vector_type(16)));

constexpr int NB = 8, T = 4096, D = 1024, CL = 256, RB = CL + T  , NROWS = NB * RB  ;
constexpr int DEPTH = 4, NE = 16, FF = 2048, INW = 2816;
constexpr int CAP_LAT = 512, CAP_CTX = 32, EROWS = NB * (CAP_LAT + CAP_CTX)  ;
constexpr float EPS = 1e-6f;
#ifndef MK_MULTI
#define MK_MULTI 0
#endif

constexpr size_t MiB = 1u << 20;
constexpr size_t WS_CTL = 0, CTL_ZERO_BYTES = 1 * MiB;
constexpr size_t WS_MOD = 1 * MiB;
constexpr size_t WS_ROPE = 2 * MiB;
constexpr size_t WS_SELROW = 3 * MiB;
constexpr size_t WS_SELGATE = 3 * MiB + 512 * 1024;
constexpr size_t WS_AFF = 4 * MiB;
constexpr size_t WS_SLOT = 7 * MiB;
constexpr size_t WS_X = 10 * MiB;
constexpr size_t WS_TV = 146 * MiB;
constexpr size_t WS_WS5 = 242 * MiB;
constexpr size_t WS_HB = 282 * MiB;
constexpr size_t WS_W13 = 350 * MiB;
constexpr size_t WS_W2 = 862 * MiB;
constexpr size_t WS_WIN = 1118 * MiB;
constexpr size_t WS_WOUT = 1130 * MiB;
constexpr size_t WS_WGLU = 1134 * MiB;
constexpr size_t WS_HB1 = 1144 * MiB;
constexpr size_t WS_BIG = 1212 * MiB;
constexpr size_t WS_P = WS_BIG;
constexpr size_t WS_RQ = WS_BIG + 374 * MiB;
constexpr size_t WS_RK = WS_BIG + 408 * MiB;
constexpr size_t WS_RV = WS_BIG + 442 * MiB;
constexpr size_t WS_ET = WS_BIG + 476 * MiB;
constexpr size_t WS_MIX = WS_BIG + 510 * MiB;
constexpr size_t WS_QA = WS_BIG + 578 * MiB;
constexpr size_t WS_KA = WS_BIG + 612 * MiB;
constexpr size_t WS_VA = WS_BIG + 621 * MiB;
constexpr size_t WS_U = WS_BIG + 630 * MiB;
constexpr size_t WS_AS5 = WS_BIG;
constexpr size_t WS_SL = WS_BIG + 120 * MiB;
constexpr size_t WS_ZG = WS_BIG + 200 * MiB;
constexpr size_t WS_HID = WS_BIG;
constexpr size_t WS_XS = WS_BIG + 136 * MiB;
constexpr size_t WS_Y = WS_BIG + 272 * MiB;
constexpr size_t WS_END = WS_BIG + 698 * MiB;
constexpr int CW_BAR = 4096, CW_CNT = 8192;

constexpr int LDS_BYTES = 147456;
constexpr int MISC_OFF = 131072 + 320;

constexpr int PH_PRO = 0, PH_PER_LAYER = 11, PH_FIN = 1 + DEPTH * PH_PER_LAYER, NPH = PH_FIN + 1;

#define XB_TMO      128
#define XB_XCNT(j)  (256  + 64 * (j))
#define XB_XSUB(j)  (1280 + 64 * (j))
#define XB_XGEN(j)  (2304 + 64 * (j))
#define XB_TOP      3328
#define XB_TOPGEN   3392
#define XCD_BAR_WORDS 3456
#define XB_SPIN_CAP (1u << 22)

__device__ __forceinline__ unsigned xb_ld(unsigned* p)              { return __hip_atomic_load(p, __ATOMIC_RELAXED, __HIP_MEMORY_SCOPE_AGENT); }
__device__ __forceinline__ unsigned xb_add(unsigned* p, unsigned v) { return __hip_atomic_fetch_add(p, v, __ATOMIC_RELAXED, __HIP_MEMORY_SCOPE_AGENT); }
__device__ __forceinline__ unsigned xb_xcc_id() { return (unsigned)__builtin_amdgcn_s_getreg((3 << 11) | 20) & 0xFu; }
#define XB_SPIN(cond, bar) do { unsigned _sp = 0; while (cond) { __builtin_amdgcn_s_sleep(1); \
    if ((++_sp & 255u) == 0u) { if (xb_ld(&(bar)[XB_TMO])) break; if (_sp > XB_SPIN_CAP) { atomicAdd(&(bar)[XB_TMO], 1u); break; } } } } while (0)

__device__ __forceinline__ int lane_id() { int l; asm volatile("v_mbcnt_lo_u32_b32 %0, -1, 0\n\tv_mbcnt_hi_u32_b32 %0, -1, %0" : "=v"(l)); return l; }
struct XcdBarrier { unsigned* bar; unsigned x; volatile LAS unsigned* st; int wave; };

__device__ __forceinline__ XcdBarrier xcd_barrier_post(unsigned* bar, volatile LAS unsigned* st) {
    XcdBarrier b; b.bar = bar; b.x = xb_xcc_id(); b.st = st; b.wave = __builtin_amdgcn_readfirstlane((int)threadIdx.x >> 6);
    if (threadIdx.x == 0) (void)xb_add(&bar[XB_XCNT(b.x)], 1u);
    return b;
}
__device__ __forceinline__ void xcd_barrier_complete(unsigned* bar, unsigned x, unsigned& nloc, unsigned& nx) {
    const unsigned G = gridDim.x * gridDim.y * gridDim.z;
    unsigned sum, cnt, mine, sp = 0u;
    for (;;) {
        sum = 0u; cnt = 0u; mine = 0u;
#pragma unroll
        for (unsigned j = 0; j < 16; ++j) { const unsigned c = xb_ld(&bar[XB_XCNT(j)]); sum += c; cnt += (c > 0u) ? 1u : 0u; mine = (j == x) ? c : mine; }
        if (sum == G) break;
        __builtin_amdgcn_s_sleep(1);
        if ((++sp & 255u) == 0u) { if (xb_ld(&bar[XB_TMO])) break; if (sp > XB_SPIN_CAP) { atomicAdd(&bar[XB_TMO], 1u); break; } }
    }
    nloc = mine > 0u ? mine : 1u; nx = cnt > 0u ? cnt : 1u;
}
__device__ __forceinline__ void xcd_barrier(const XcdBarrier& b) {
    asm volatile("s_waitcnt vmcnt(0)" ::: "memory");
    __syncthreads();
    if (b.wave == 0 && lane_id() == 0) {
        unsigned* bar = b.bar;
        __builtin_amdgcn_s_waitcnt(0);
        unsigned nloc = b.st[0], nx = b.st[1];
        if (nloc == 0u) { xcd_barrier_complete(bar, b.x, nloc, nx); b.st[0] = nloc; b.st[1] = nx; }
        const unsigned old = xb_add(&bar[XB_XSUB(b.x)], 1u);
        const unsigned gen = old / nloc;
        if (old + 1u == (gen + 1u) * nloc) {
            __builtin_amdgcn_fence(__ATOMIC_RELEASE, "agent");
            asm volatile("s_waitcnt vmcnt(0)" ::: "memory");
            const unsigned og = xb_add(&bar[XB_TOP], 1u);
            const unsigned tg = og / nx;
            if (og + 1u == (tg + 1u) * nx) xb_add(&bar[XB_TOPGEN], 1u);
            else XB_SPIN(xb_ld(&bar[XB_TOPGEN]) == tg, bar);
            __builtin_amdgcn_fence(__ATOMIC_ACQUIRE, "agent");
            xb_add(&bar[XB_XGEN(b.x)], 1u);
            asm volatile("s_waitcnt vmcnt(0)" ::: "memory");
        } else {
            XB_SPIN(xb_ld(&bar[XB_XGEN(b.x)]) == gen, bar);
            __builtin_amdgcn_fence(__ATOMIC_ACQUIRE, "agent");
            asm volatile("s_waitcnt vmcnt(0)" ::: "memory");
        }
    }
    __syncthreads();
}

struct Args { const float* in[27]; float* out; unsigned char* ws; int ph_lo, ph_hi; };

struct Ctx {
    const float* const* in; float* out; unsigned char* ws;
    int tid, lane, wave, gw, ngw, gt, ngt;
    int vb, vg;
};
enum { IN_X = 0, IN_C, IN_CTX, IN_CCTX, IN_MODW, IN_MODB, IN_NORMG, IN_MIXIN, IN_MIXOUT, IN_RETRATE, IN_RETGN, IN_QKG,
       IN_S5ARE, IN_S5AIM, IN_S5DT, IN_S5BRE, IN_S5BIM, IN_S5CRE, IN_S5CIM, IN_S5D, IN_GLUW, IN_GLUB, IN_ROUTER, IN_W1, IN_W3, IN_W2, IN_FNG };

__device__ __forceinline__ float wave_sum(float v) {
#pragma unroll
    for (int o = 1; o < 64; o <<= 1) v += __shfl_xor(v, o);
    return v;
}
__device__ __forceinline__ float sigmoidf_(float x) { return 1.0f / (1.0f + expf(-x)); }
__device__ __forceinline__ float siluf_(float x) { return x * sigmoidf_(x); }
__device__ __forceinline__ float gelu_tanh(float x) { const float u = 0.7978845608028654f * (x + 0.044715f * x * x * x); return 0.5f * x * (1.0f + tanhf(u)); }
__device__ __forceinline__ const float* modp(const Ctx& c, int L, int j, int chunk) { return (const float*)(c.ws + WS_MOD) + ((size_t)(L * 9 + j) * 6 + chunk) * 1024; }
__device__ __forceinline__ int row_j(int row) { const int b = row / RB, s = row - b * RB; return s < CL ? 8 : b; }

__device__ __forceinline__ float reduce16(const float (&v)[16], int lane) {
    float a[8], b[4], c2[2], d;
    const bool b5 = (lane & 32) != 0, b4 = (lane & 16) != 0, b3 = (lane & 8) != 0, b2 = (lane & 4) != 0;
#pragma unroll
    for (int i = 0; i < 8; ++i) { const float keep = b5 ? v[8 + i] : v[i], send = b5 ? v[i] : v[8 + i]; a[i] = keep + __shfl_xor(send, 32); }
#pragma unroll
    for (int i = 0; i < 4; ++i) { const float keep = b4 ? a[4 + i] : a[i], send = b4 ? a[i] : a[4 + i]; b[i] = keep + __shfl_xor(send, 16); }
#pragma unroll
    for (int i = 0; i < 2; ++i) { const float keep = b3 ? b[2 + i] : b[i], send = b3 ? b[i] : b[2 + i]; c2[i] = keep + __shfl_xor(send, 8); }
    { const float keep = b2 ? c2[1] : c2[0], send = b2 ? c2[0] : c2[1]; d = keep + __shfl_xor(send, 4); }
    d += __shfl_xor(d, 2); d += __shfl_xor(d, 1);
    return d;
}
__device__ __forceinline__ int reduce16_k(int lane) { return ((lane >> 5) & 1) * 8 + ((lane >> 4) & 1) * 4 + ((lane >> 3) & 1) * 2 + ((lane >> 2) & 1); }

namespace pg8 {
typedef unsigned short bf16_t;
typedef short bf16x8 __attribute__((ext_vector_type(8)));
typedef unsigned u32x4 __attribute__((ext_vector_type(4)));
typedef unsigned u32x2 __attribute__((ext_vector_type(2)));
typedef int v8i32 __attribute__((ext_vector_type(8)));
typedef int v4i32 __attribute__((ext_vector_type(4)));
constexpr int BM = 256, BK = 64, HALF = 128, HTB = HALF * BK * 2, STAGE_BYTES = 8 * HTB, NXCD = 8, WGM = 8;
__host__ __device__ __forceinline__ int lds_byte(int r, int c) { const int st = (r >> 4) * 2 + (c >> 5), rr = r & 15, cc = c & 31, ob = rr * 64 + cc * 2; return st * 1024 + (ob ^ (((ob >> 9) & 1) << 5)); }
__host__ __device__ __forceinline__ void stage_rc(int b, int& R, int& C) { const int st = b / 1024, sb = b % 1024, swz = sb ^ (((sb >> 9) & 1) << 5); R = (st >> 1) * 16 + swz / 64; C = (st & 1) * 32 + (swz % 64) / 2; }
__host__ __device__ __forceinline__ int perm32(int rho) { const int n = rho >> 4, i = rho & 15; return 8 * (i >> 2) + 4 * n + (i & 3); }
__device__ __forceinline__ unsigned cvt_pk_bf16(float lo, float hi) { unsigned r; asm volatile("v_cvt_pk_bf16_f32 %0, %1, %2" : "=v"(r) : "v"(lo), "v"(hi)); return r; }

__device__ __forceinline__ unsigned pk4_fp8(float a, float b, float c, float d) {
    a = __builtin_amdgcn_fmed3f(a, -448.f, 448.f); b = __builtin_amdgcn_fmed3f(b, -448.f, 448.f); c = __builtin_amdgcn_fmed3f(c, -448.f, 448.f); d = __builtin_amdgcn_fmed3f(d, -448.f, 448.f);
    unsigned w = 0u; w = (unsigned)__builtin_amdgcn_cvt_pk_fp8_f32(a, b, (int)w, false); w = (unsigned)__builtin_amdgcn_cvt_pk_fp8_f32(c, d, (int)w, true); return w; }
__device__ __forceinline__ f32x4 bf4_to_f32(u32x2 w) { return (f32x4){__uint_as_float(w.x << 16), __uint_as_float(w.x & 0xffff0000u), __uint_as_float(w.y << 16), __uint_as_float(w.y & 0xffff0000u)}; }
__device__ __forceinline__ u32x2 f32_to_bf4(f32x4 v) { return (u32x2){cvt_pk_bf16(v.x, v.y), cvt_pk_bf16(v.z, v.w)}; }
constexpr float W8_SCALE = 32.0f, W8_INV = 1.0f / 32.0f;
struct Unit { int pm, pn, g; };
struct GOrder {
    int nM, nN, per, nwg, G, c, skipctx;
    __device__ __forceinline__ void init(int groups, int M, int N, int G_, int c_, int skipctx_ = 0) { nM = M / BM; if (skipctx_) nM -= nM / 17; nN = N / BM; per = nM * nN; nwg = groups * per; G = G_; c = c_; skipctx = skipctx_; }
    __device__ __forceinline__ bool next(int i, Unit& u) const {
        const long L = (long)i * G + c; if (L >= nwg) return false;
        int wgid = (int)L; { const int q = nwg / NXCD, r = nwg % NXCD, xcd = wgid % NXCD, off = wgid / NXCD; wgid = (xcd < r ? xcd * (q + 1) : r * (q + 1) + (xcd - r) * q) + off; }
        u.g = wgid / per; const int w = wgid - u.g * per;
        const int nig = WGM * nN, gid = w / nig, fm = gid * WGM, gsz = (nM - fm) < WGM ? (nM - fm) : WGM;
        u.pm = fm + ((w % nig) % gsz); u.pn = (w % nig) / gsz; if (skipctx) u.pm += (u.pm >> 4) + 1;
        return true;
    }
};
struct ADense  { static constexpr bool GATHER = false; const bf16_t* A; size_t gstride; const int* idx; int rpg; unsigned rowpitch; unsigned cgrp; size_t kstep; };
struct AGather { static constexpr bool GATHER = true;  const bf16_t* A; size_t gstride; const int* idx; int rpg; unsigned rowpitch; unsigned cgrp; size_t kstep; };

template <bool FP8 = false, class Epi, class ALoc>
__device__ __forceinline__ void gemm_phase(LAS unsigned char* lds, const ALoc AL, const void* Bt, size_t gstrideB, int K, const GOrder& S, const Epi& E, int wave_) {
    constexpr bool GATHER = ALoc::GATHER; constexpr unsigned ESZ = FP8 ? 1u : 2u;
    const int wid = wave_, lane = lane_id(), tid = wid * 64 + lane, wr = wid >> 2, wc = wid & 3, fr = lane & 15, fq = lane >> 4;
    const int nt = (int)((unsigned)K * ESZ / 128u);
    unsigned voffA[2], voffB[2];
#pragma unroll
    for (int i = 0; i < 2; ++i) { int R, C; stage_rc(tid * 16 + i * 8192, R, C); const int Rb = Epi::PERM ? ((R & ~31) + perm32(R & 31)) : R;
        const unsigned cbytes = AL.cgrp ? (FP8 ? (unsigned)(C >> 3) * AL.cgrp : ((unsigned)(C >> 4) * AL.cgrp + (unsigned)(C & 15)) * 2u) : (unsigned)C * 2u;
        voffA[i] = (unsigned)R * AL.rowpitch * ESZ + cbytes; voffB[i] = (unsigned)Rb * (unsigned)K * ESZ + (unsigned)C * 2u; }
    const size_t kstep = 128, kstepA = AL.kstep * ESZ;
    const size_t hstep = (size_t)HALF * K * ESZ;
    const size_t hstepA = GATHER ? 0 : (size_t)HALF * AL.rowpitch * ESZ, tstepA = 2 * (size_t)HALF * AL.rowpitch * ESZ;
    const size_t tstep = 2 * hstep;
    const unsigned ldsw = (unsigned)wid * 1024u;
    const int aoff0 = lds_byte(wr * 64 + fr, fq * 8);
    const int boff0 = lds_byte(wc * 32 + fr, fq * 8);
    constexpr int KOFF = 1024;
    unsigned vAc[2][2], vAn[2][2];
#define PG8_SA(b, h) (((b) * 2 + (h)) * HTB)
#define PG8_SB(b, h) ((4 + (b) * 2 + (h)) * HTB)
#define PG8_SBR(b, h) (((b) * 2 + (h)) * HTB)
#define PG8_OPQ(x) do { if constexpr (FP8) asm volatile("" : "+v"(x)); } while (0)
#define PG8_STAGE(bufoff, gbase, voff) do { _Pragma("unroll") for (int _i = 0; _i < 2; ++_i) { unsigned _o = (voff)[_i]; PG8_OPQ(_o); \
        __builtin_amdgcn_global_load_lds((const unsigned*)((const char*)(gbase) + _o), (LAS unsigned*)(lds + (bufoff) + ldsw + _i * 8192), 16, 0, 0); } } while (0)
#define PG8_STAGE_A(bufoff, gbase, h, nx) do { _Pragma("unroll") for (int _i = 0; _i < 2; ++_i) { \
        unsigned _o = GATHER ? ((nx) ? vAn[h][_i] : vAc[h][_i]) : voffA[_i]; PG8_OPQ(_o); \
        __builtin_amdgcn_global_load_lds((const unsigned*)((const char*)(gbase) + (size_t)(h) * hstepA + _o), (LAS unsigned*)(lds + (bufoff) + ldsw + _i * 8192), 16, 0, 0); } } while (0)
#define PG8_GIDX(u, v) do { if (GATHER) { int _t = tid; asm volatile("" : "+v"(_t));   \
        _Pragma("unroll") for (int _i = 0; _i < 2; ++_i) { int _R, _C; stage_rc(_t * 16 + _i * 8192, _R, _C); \
        _Pragma("unroll") for (int _h = 0; _h < 2; ++_h) v[_h][_i] = (unsigned)AL.idx[(u).g * AL.rpg + (u).pm * BM + _h * HALF + _R] * (AL.rowpitch * ESZ) + (unsigned)_C * 2u; } } } while (0)
#define PG8_ABASE(u) ((const char*)AL.A + (GATHER ? (size_t)0 : ((size_t)(u).g * AL.gstride * ESZ + (size_t)(u).pm * tstepA)))
#define PG8_BBASE(u) ((const char*)Bt + (size_t)(u).g * gstrideB * ESZ + (size_t)(u).pn * tstep)
#define PG8_LDA(dst, b, h) do { _Pragma("unroll") for (int m = 0; m < 4; ++m) _Pragma("unroll") for (int k = 0; k < 2; ++k) dst[m][k] = *(const LAS bf16x8*)(lds + PG8_SA(b, h) + aoff0 + k * KOFF + m * 2048); } while (0)
#define PG8_LDB(dst, b, h) do { _Pragma("unroll") for (int n = 0; n < 2; ++n) _Pragma("unroll") for (int k = 0; k < 2; ++k) dst[n][k] = *(const LAS bf16x8*)(lds + PG8_SB(b, h) + boff0 + k * KOFF + n * 2048); } while (0)
#define PG8_CAT8(x) __builtin_shufflevector(__builtin_bit_cast(v4i32, x[0]), __builtin_bit_cast(v4i32, x[1]), 0, 1, 2, 3, 4, 5, 6, 7)
#define PG8_MMA(ai, bj, At, Bt_) do { __builtin_amdgcn_s_setprio(1); _Pragma("unroll") for (int m = 0; m < 4; ++m) _Pragma("unroll") for (int n = 0; n < 2; ++n) { \
        if constexpr (FP8) acc[ai][bj][m][n] = __builtin_amdgcn_mfma_scale_f32_16x16x128_f8f6f4(PG8_CAT8(Bt_[n]), PG8_CAT8(At[m]), acc[ai][bj][m][n], 0, 0, 0, 0x7f7f7f7f, 0, 0x7f7f7f7f); \
        else { _Pragma("unroll") for (int k = 0; k < 2; ++k) acc[ai][bj][m][n] = __builtin_amdgcn_mfma_f32_16x16x32_bf16(Bt_[n][k], At[m][k], acc[ai][bj][m][n], 0, 0, 0); } } \
        __builtin_amdgcn_s_setprio(0); } while (0)
#define PG8_WAIT_V(n) asm volatile("s_waitcnt vmcnt(" #n ")" ::: "memory")
#define PG8_WAIT_L(n) asm volatile("s_waitcnt lgkmcnt(" #n ")" ::: "memory")
#define PG8_BAR __builtin_amdgcn_s_barrier()
#define PG8_SCHED __builtin_amdgcn_sched_barrier(0)
    Unit cur, nxt; int ui = 0;
    if (!S.next(0, cur)) return;
    PG8_GIDX(cur, vAc);
    f32x4 acc[2][2][4][2];
#pragma unroll
    for (int a = 0; a < 2; ++a)
#pragma unroll
        for (int b = 0; b < 2; ++b)
#pragma unroll
            for (int m = 0; m < 4; ++m)
#pragma unroll
                for (int n = 0; n < 2; ++n) acc[a][b][m][n] = (f32x4){0.f, 0.f, 0.f, 0.f};
    bf16x8 At[4][2], B0[2][2], B1[2][2];
    const char* cA = PG8_ABASE(cur); const char* cB = PG8_BBASE(cur);
    PG8_STAGE(PG8_SB(0, 0), cB, voffB); PG8_STAGE(PG8_SB(0, 1), cB + hstep, voffB); PG8_STAGE_A(PG8_SA(0, 0), cA, 0, false); PG8_STAGE_A(PG8_SA(0, 1), cA, 1, false);
    if (wr == 1) PG8_BAR;
    PG8_WAIT_V(2); PG8_BAR;
    PG8_STAGE(PG8_SB(1, 0), cB + kstep, voffB); PG8_STAGE_A(PG8_SA(1, 0), cA + kstepA, 0, false); PG8_STAGE(PG8_SB(1, 1), cB + hstep + kstep, voffB);
    PG8_WAIT_V(6); PG8_BAR;
    for (;;) {
        const bool has_next = S.next(ui + 1, nxt);
        if (GATHER) { if (has_next) { PG8_GIDX(nxt, vAn); } }
        const char* nA = has_next ? PG8_ABASE(nxt) : cA; const char* nB = has_next ? PG8_BBASE(nxt) : cB;
        for (int t = 0; t < nt; t += 2) {
            const bool last = (t == nt - 2), lastn = last && has_next;
            const char* a1 = cA + (size_t)(t + 1) * kstepA;
            const char* a2 = last ? nA : cA + (size_t)(t + 2) * kstepA; const char* b2 = last ? nB : cB + (size_t)(t + 2) * kstep;
            const char* a3 = a2 + kstepA; const char* b3 = b2 + kstep;
            PG8_LDB(B0, 0, 0); PG8_LDB(B1, 0, 1); PG8_SCHED; PG8_LDA(At, 0, 0); PG8_STAGE_A(PG8_SA(1, 1), a1, 1, false);
            PG8_WAIT_V(8); PG8_WAIT_L(0); PG8_BAR; PG8_MMA(0, 0, At, B0); PG8_MMA(0, 1, At, B1); PG8_BAR; PG8_SCHED;
            PG8_LDA(At, 0, 1); PG8_STAGE(PG8_SB(0, 0), b2, voffB); PG8_STAGE(PG8_SB(0, 1), b2 + hstep, voffB); PG8_STAGE_A(PG8_SA(0, 0), a2, 0, lastn);
            PG8_WAIT_V(8); PG8_WAIT_L(0); PG8_BAR; PG8_MMA(1, 0, At, B0); PG8_MMA(1, 1, At, B1); PG8_BAR; PG8_SCHED;
            PG8_LDB(B0, 1, 0); PG8_LDB(B1, 1, 1); PG8_SCHED; PG8_LDA(At, 1, 0); PG8_STAGE_A(PG8_SA(0, 1), a2, 1, lastn);
            PG8_WAIT_V(8); PG8_WAIT_L(0); PG8_BAR; PG8_MMA(0, 0, At, B0); PG8_MMA(0, 1, At, B1); PG8_BAR; PG8_SCHED;
            PG8_LDA(At, 1, 1); PG8_STAGE(PG8_SB(1, 0), b3, voffB); PG8_STAGE(PG8_SB(1, 1), b3 + hstep, voffB); PG8_STAGE_A(PG8_SA(1, 0), a3, 0, lastn);
            PG8_WAIT_V(8); PG8_WAIT_L(0); PG8_BAR; PG8_MMA(1, 0, At, B0); PG8_MMA(1, 1, At, B1); PG8_BAR; PG8_SCHED;
        }
        if (wr == 0) PG8_BAR;
        E(acc, cur, wr, wc, fr, fq);
        if (!has_next) break;
#pragma unroll
        for (int a = 0; a < 2; ++a)
#pragma unroll
            for (int b = 0; b < 2; ++b)
#pragma unroll
                for (int m = 0; m < 4; ++m)
#pragma unroll
                    for (int n = 0; n < 2; ++n) acc[a][b][m][n] = (f32x4){0.f, 0.f, 0.f, 0.f};
        cur = nxt; cA = nA; cB = nB; ++ui;
        if (GATHER) {
#pragma unroll
            for (int _h = 0; _h < 2; ++_h)
#pragma unroll
                for (int _i = 0; _i < 2; ++_i) vAc[_h][_i] = vAn[_h][_i]; }
        if (wr == 1) PG8_BAR;
    }
    PG8_WAIT_V(0);
    PG8_BAR;
#undef PG8_SA
#undef PG8_SB
#undef PG8_SBR
#undef PG8_STAGE
#undef PG8_OPQ
#undef PG8_STAGE_A
#undef PG8_GIDX
#undef PG8_ABASE
#undef PG8_BBASE
#undef PG8_LDA
#undef PG8_CAT8
#undef PG8_LDB
#undef PG8_MMA
#undef PG8_WAIT_V
#undef PG8_WAIT_L
#undef PG8_BAR
#undef PG8_SCHED
}

__device__ __forceinline__ float fast_sigmoid(float x) { return __builtin_amdgcn_rcpf(1.0f + __builtin_amdgcn_exp2f(-1.4426950408889634f * x)); }
struct EpiSwiglu {
    static constexpr bool PERM = true;
    unsigned char* O; int ldc; size_t gstride;
    __device__ __forceinline__ void operator()(const f32x4 (&acc)[2][2][4][2], const Unit& u, int wr, int wc, int fr, int fq) const {
        const int row0 = u.pm * BM + wr * 64 + fr, col0 = u.pn * HALF + wc * 32 + 8 * fq;
        unsigned char* base = O + (size_t)u.g * gstride;
#pragma unroll
        for (int ai = 0; ai < 2; ++ai)
#pragma unroll
            for (int m = 0; m < 4; ++m) { unsigned char* rowp = base + (size_t)(row0 + ai * HALF + m * 16) * ldc + col0;
                f32x4 o[2];
#pragma unroll
                for (int n = 0; n < 2; ++n) {
                    const f32x4 a = acc[ai][0][m][n] * W8_INV, b = acc[ai][1][m][n] * W8_INV, t = a * (-1.4426950408889634f);
                    f32x4 e; e.x = __builtin_amdgcn_exp2f(t.x); e.y = __builtin_amdgcn_exp2f(t.y); e.z = __builtin_amdgcn_exp2f(t.z); e.w = __builtin_amdgcn_exp2f(t.w);
                    e = e + 1.0f;
                    f32x4 r; r.x = __builtin_amdgcn_rcpf(e.x); r.y = __builtin_amdgcn_rcpf(e.y); r.z = __builtin_amdgcn_rcpf(e.z); r.w = __builtin_amdgcn_rcpf(e.w);
                    o[n] = (a * b) * r; }
                *(u32x2*)rowp = (u32x2){pk4_fp8(o[0].x, o[0].y, o[0].z, o[0].w), pk4_fp8(o[1].x, o[1].y, o[1].z, o[1].w)}; }
    }
};
struct EpiBf16 {
    static constexpr bool PERM = true;
    bf16_t* O; int ldc; size_t gstride;
    __device__ __forceinline__ void operator()(const f32x4 (&acc)[2][2][4][2], const Unit& u, int wr, int wc, int fr, int fq) const {
        const int row0 = u.pm * BM + wr * 64 + fr, col0 = u.pn * BM + wc * 32 + 8 * fq;
#pragma unroll
        for (int ai = 0; ai < 2; ++ai)
#pragma unroll
            for (int m = 0; m < 4; ++m) { bf16_t* rowp = O + (size_t)u.g * gstride + (size_t)(row0 + ai * HALF + m * 16) * ldc + col0;
#pragma unroll
                for (int bj = 0; bj < 2; ++bj) { const f32x4 v0 = acc[ai][bj][m][0], v1 = acc[ai][bj][m][1];
                    u32x4 w; w.x = cvt_pk_bf16(v0[0], v0[1]); w.y = cvt_pk_bf16(v0[2], v0[3]); w.z = cvt_pk_bf16(v1[0], v1[1]); w.w = cvt_pk_bf16(v1[2], v1[3]);
                    *(u32x4*)(rowp + bj * HALF) = w; } }
    }
};
constexpr float Z8_SCALE = 2.0f;
struct EpiGeluFp8 {
    static constexpr bool PERM = true;
    unsigned char* O; int ldc; size_t gstride;
    __device__ __forceinline__ void operator()(const f32x4 (&acc)[2][2][4][2], const Unit& u, int wr, int wc, int fr, int fq) const {
        const int row0 = u.pm * BM + wr * 64 + fr, col0 = u.pn * BM + wc * 32 + 8 * fq;
        unsigned char* base = O + (size_t)u.g * gstride;
#pragma unroll
        for (int ai = 0; ai < 2; ++ai)
#pragma unroll
            for (int m = 0; m < 4; ++m) { unsigned char* rowp = base + (size_t)(row0 + ai * HALF + m * 16) * ldc + col0;
#pragma unroll
                for (int bj = 0; bj < 2; ++bj) { float o[8];
#pragma unroll
                    for (int n = 0; n < 2; ++n)
#pragma unroll
                        for (int q = 0; q < 4; ++q) { const float x = acc[ai][bj][m][n][q]; o[4 * n + q] = (Z8_SCALE * x) * fast_sigmoid(1.5957691216057308f * (x + 0.044715f * x * x * x)); }
                    *(u32x2*)(rowp + bj * HALF) = (u32x2){pk4_fp8(o[0], o[1], o[2], o[3]), pk4_fp8(o[4], o[5], o[6], o[7])}; } }
    }
};
constexpr float Y8_SCALE = 16.0f, Y8_INV = 1.0f / 16.0f;
struct EpiGate {
    static constexpr bool PERM = true;
    unsigned char* O; int ldc; size_t gstride; const float* gate; int rpg;
    __device__ __forceinline__ void operator()(const f32x4 (&acc)[2][2][4][2], const Unit& u, int wr, int wc, int fr, int fq) const {
        const int row0 = u.pm * BM + wr * 64 + fr, col0 = u.pn * BM + wc * 32 + 8 * fq;
        unsigned char* base = O + (size_t)u.g * gstride;
#pragma unroll
        for (int ai = 0; ai < 2; ++ai)
#pragma unroll
            for (int m = 0; m < 4; ++m) { const int row = row0 + ai * HALF + m * 16; const float gt = gate[u.g * rpg + row] * (W8_INV * Y8_SCALE); unsigned char* rowp = base + (size_t)row * ldc + col0;
#pragma unroll
                for (int bj = 0; bj < 2; ++bj) { const f32x4 v0 = acc[ai][bj][m][0] * gt, v1 = acc[ai][bj][m][1] * gt;
                    *(u32x2*)(rowp + bj * HALF) = (u32x2){pk4_fp8(v0[0], v0[1], v0[2], v0[3]), pk4_fp8(v1[0], v1[1], v1[2], v1[3])}; } }
    }
};
struct EpiF32 {
    static constexpr bool PERM = false;
    float* C; int ldc; size_t gstride;
    __device__ __forceinline__ void operator()(const f32x4 (&acc)[2][2][4][2], const Unit& u, int wr, int wc, int fr, int fq) const {
        const int row0 = u.pm * BM + wr * 64 + fr, col0 = u.pn * BM + wc * 32 + 4 * fq;
#pragma unroll
        for (int ai = 0; ai < 2; ++ai)
#pragma unroll
            for (int m = 0; m < 4; ++m) { float* rowp = C + (size_t)u.g * gstride + (size_t)(row0 + ai * HALF + m * 16) * ldc + col0;
#pragma unroll
                for (int bj = 0; bj < 2; ++bj)
#pragma unroll
                    for (int n = 0; n < 2; ++n) *(f32x4*)(rowp + bj * HALF + n * 16) = acc[ai][bj][m][n]; }
    }
};
struct EpiResid {
    static constexpr bool PERM = true;
    bf16_t* X; const float* modL;
    __device__ __forceinline__ void operator()(const f32x4 (&acc)[2][2][4][2], const Unit& u, int wr, int wc, int fr, int fq) const {
        const int row0 = u.pm * BM + wr * 64 + fr, col0 = u.pn * BM + wc * 32 + 8 * fq;
        const int b = u.pm / 17, j = (u.pm - b * 17 == 0) ? 8 : b;
        const float* g1 = modL + (size_t)(j * 6 + 2) * 1024 + col0;
        f32x4 gv[2][2];
#pragma unroll
        for (int bj = 0; bj < 2; ++bj)
#pragma unroll
            for (int n = 0; n < 2; ++n) gv[bj][n] = *(const f32x4*)(g1 + bj * HALF + n * 4);
#pragma unroll
        for (int ai = 0; ai < 2; ++ai)
#pragma unroll
            for (int m = 0; m < 4; ++m) { bf16_t* rowp = X + (size_t)(row0 + ai * HALF + m * 16) * D + col0;
#pragma unroll
                for (int bj = 0; bj < 2; ++bj) { u32x4* p = (u32x4*)(rowp + bj * HALF); const u32x4 w = *p;
                    const f32x4 x0 = bf4_to_f32((u32x2){w.x, w.y}) + gv[bj][0] * acc[ai][bj][m][0], x1 = bf4_to_f32((u32x2){w.z, w.w}) + gv[bj][1] * acc[ai][bj][m][1];
                    const u32x2 o0 = f32_to_bf4(x0), o1 = f32_to_bf4(x1); *p = (u32x4){o0.x, o0.y, o1.x, o1.y}; } }
    }
};
struct EpiGluResid {
    static constexpr bool PERM = true;
    bf16_t* X; const float* modL; const float* bias;
    __device__ __forceinline__ void operator()(const f32x4 (&acc)[2][2][4][2], const Unit& u, int wr, int wc, int fr, int fq) const {
        const int row0 = u.pm * BM + wr * 64 + fr, col0 = u.pn * HALF + wc * 32 + 8 * fq;
        const int b = u.pm / 17, j = (u.pm - b * 17 == 0) ? 8 : b;
        const float* g1 = modL + (size_t)(j * 6 + 2) * 1024 + col0;
        f32x4 gv[2], ba[2], bg[2];
#pragma unroll
        for (int n = 0; n < 2; ++n) { gv[n] = *(const f32x4*)(g1 + n * 4); ba[n] = *(const f32x4*)(bias + col0 + n * 4); bg[n] = *(const f32x4*)(bias + 1024 + col0 + n * 4); }
#pragma unroll
        for (int ai = 0; ai < 2; ++ai)
#pragma unroll
            for (int m = 0; m < 4; ++m) { u32x4* p = (u32x4*)(X + (size_t)(row0 + ai * HALF + m * 16) * D + col0); const u32x4 w = *p;
                f32x4 xo[2] = {bf4_to_f32((u32x2){w.x, w.y}), bf4_to_f32((u32x2){w.z, w.w})};
#pragma unroll
                for (int n = 0; n < 2; ++n) { const f32x4 a = acc[ai][0][m][n] * (W8_INV / Z8_SCALE) + ba[n], g = acc[ai][1][m][n] * (W8_INV / Z8_SCALE) + bg[n];
                    f32x4 o; o.x = a.x * fast_sigmoid(g.x); o.y = a.y * fast_sigmoid(g.y); o.z = a.z * fast_sigmoid(g.z); o.w = a.w * fast_sigmoid(g.w);
                    xo[n] = xo[n] + gv[n] * o; }
                const u32x2 o0 = f32_to_bf4(xo[0]), o1 = f32_to_bf4(xo[1]); *p = (u32x4){o0.x, o0.y, o1.x, o1.y}; }
    }
};
}

namespace attn_body {
using bf16=__hip_bfloat16;
using bf16x8=__attribute__((ext_vector_type(8)))short;
using s16x4=__attribute__((ext_vector_type(4)))short;
using f32x16=__attribute__((ext_vector_type(16)))float;
using u32x4=__attribute__((ext_vector_type(4)))unsigned;
constexpr int D=64,QP=512,KP=128,VP=2816,OP=1024;
constexpr int NW=8,QBLK=32,QB=QBLK*NW,KVBLK=64;
__device__ __forceinline__ int crow(int r,int hi){return (r&3)+8*(r>>2)+4*hi;}
#define SBAR() __builtin_amdgcn_sched_barrier(0)
__device__ __forceinline__ void cmask(f32x16&p0,f32x16&p1,int jb,int qrel,int hi){
  const float NEG=-INFINITY; int kb=64*jb+4*hi;
  #pragma unroll
  for(int r=0;r<16;++r){int kv=kb+(r&3)+8*(r>>2); if(kv>qrel)p0[r]=NEG; if(kv+32>qrel)p1[r]=NEG;}
}

constexpr int NSLOT=3, SLOTB=8192;
constexpr int LDS_K=0, LDS_V=NSLOT*SLOTB, LDS_WS=2*NSLOT*SLOTB, LDS_OST=LDS_WS+NW*64*4, LDS_BYTES=LDS_OST+NW*4096;
constexpr float C2=0.125f*1.4426950408889634f;
__device__ __forceinline__ void glds16(const void*gsrc,unsigned lds_dst){unsigned keep;
  asm volatile("s_mov_b32 %0, m0\n\ts_mov_b32 m0, %2\n\ts_nop 0\n\tglobal_load_lds_dwordx4 %1, off\n\ts_mov_b32 m0, %0":"=&s"(keep):"v"(gsrc),"s"(lds_dst):"memory");}
__device__ __forceinline__ float max3f(float a,float b,float c){float r;asm("v_max3_f32 %0, %1, %2, %3":"=v"(r):"v"(a),"v"(b),"v"(c));return r;}
__device__ __forceinline__ float max2f(float a,float b){float r;asm("v_max_f32_e32 %0, %1, %2":"=v"(r):"v"(a),"v"(b));return r;}
__device__ __forceinline__ float fadd_s(float a,float b){float r;asm("v_add_f32_e32 %0, %1, %2":"=v"(r):"v"(a),"v"(b));return r;}
__device__ __forceinline__ float fsub_s(float a,float b){float r;asm("v_sub_f32_e32 %0, %1, %2":"=v"(r):"v"(a),"v"(b));return r;}
typedef float f32x2_t __attribute__((ext_vector_type(2))); typedef __bf16 bf16x2_t __attribute__((ext_vector_type(2)));
__device__ __forceinline__ unsigned cvtpk_s(float lo,float hi){f32x2_t v={lo,hi};bf16x2_t b=__builtin_convertvector(v,bf16x2_t);return __builtin_bit_cast(unsigned,b);}
#define WAIT_BAR(N) asm volatile("s_waitcnt vmcnt(" #N ") lgkmcnt(0)\n\ts_barrier":::"memory")

__device__ __forceinline__ void qkt(f32x16&p0,f32x16&p1,const char*Kslot,const bf16x8*qr,const f32x16&negm,int r32,int hi){
  const char*kb=Kslot+hi*1024+r32*16;
  #pragma unroll
  for(int d0=0;d0<4;++d0){
    const bf16x8 b0=*reinterpret_cast<const bf16x8*>(kb+d0*2048);
    const bf16x8 b1=*reinterpret_cast<const bf16x8*>(kb+d0*2048+512);
    if(d0==0){p0=__builtin_amdgcn_mfma_f32_32x32x16_bf16(b0,qr[0],negm,0,0,0);p1=__builtin_amdgcn_mfma_f32_32x32x16_bf16(b1,qr[0],negm,0,0,0);}
    else{p0=__builtin_amdgcn_mfma_f32_32x32x16_bf16(b0,qr[d0],p0,0,0,0);p1=__builtin_amdgcn_mfma_f32_32x32x16_bf16(b1,qr[d0],p1,0,0,0);}}
}
typedef __attribute__((address_space(3))) const char* lds_cptr;
typedef short v4i16_t __attribute__((ext_vector_type(4)));
__device__ __forceinline__ void kload8(bf16x8*kf,lds_cptr kp){
  kf[0]=*(const __attribute__((address_space(3))) bf16x8*)(kp);      kf[1]=*(const __attribute__((address_space(3))) bf16x8*)(kp+512);
  kf[2]=*(const __attribute__((address_space(3))) bf16x8*)(kp+2048); kf[3]=*(const __attribute__((address_space(3))) bf16x8*)(kp+2560);
  kf[4]=*(const __attribute__((address_space(3))) bf16x8*)(kp+4096); kf[5]=*(const __attribute__((address_space(3))) bf16x8*)(kp+4608);
  kf[6]=*(const __attribute__((address_space(3))) bf16x8*)(kp+6144); kf[7]=*(const __attribute__((address_space(3))) bf16x8*)(kp+6656);
}
__device__ __forceinline__ void kload2(bf16x8*kf,lds_cptr kp,int j){ kf[2*j]=*(const __attribute__((address_space(3))) bf16x8*)(kp+j*2048); kf[2*j+1]=*(const __attribute__((address_space(3))) bf16x8*)(kp+j*2048+512); }
__device__ __forceinline__ s16x4 vtr(lds_cptr p){ return __builtin_bit_cast(s16x4,__builtin_amdgcn_ds_read_tr16_b64_v4i16((__attribute__((address_space(3))) v4i16_t*)p)); }
__device__ __forceinline__ float rowmax(const f32x16&p0,const f32x16&p1){
  float a=max3f(p0[0],p0[1],p1[0]),b=max3f(p0[2],p0[3],p1[1]);a=max3f(a,p1[2],p1[3]);
  #pragma unroll
  for(int r=4;r<16;r+=4){a=max3f(a,p0[r],p0[r+1]);b=max3f(b,p0[r+2],p0[r+3]);a=max3f(a,p1[r],p1[r+1]);b=max3f(b,p1[r+2],p1[r+3]);}
  const float m=max2f(a,b);
  auto rr=__builtin_amdgcn_permlane32_swap(__float_as_uint(m),__float_as_uint(m),false,false);
  return max2f(__uint_as_float(rr[0]),__uint_as_float(rr[1]));
}
__device__ __forceinline__ void pv(f32x16*o,int vb,bf16x8 pa0,bf16x8 pa1,bf16x8 pa2,bf16x8 pa3){
  #pragma unroll
  for(int d0=0;d0<2;++d0){s16x4 lo[4],hi[4];
    #pragma unroll
    for(int ks=0;ks<4;++ks){
      asm volatile("ds_read_b64_tr_b16 %0,%1 offset:%c2":"=&v"(lo[ks]):"v"(vb),"i"(d0*4096+ks*1024):"memory");
      asm volatile("ds_read_b64_tr_b16 %0,%1 offset:%c2":"=&v"(hi[ks]):"v"(vb),"i"(d0*4096+ks*1024+512):"memory");}
    asm volatile("s_waitcnt lgkmcnt(0)":::"memory");SBAR();
    #define PK(k) (bf16x8){lo[k][0],lo[k][1],lo[k][2],lo[k][3],hi[k][0],hi[k][1],hi[k][2],hi[k][3]}
    o[d0]=__builtin_amdgcn_mfma_f32_32x32x16_bf16(pa0,PK(0),o[d0],0,0,0);
    o[d0]=__builtin_amdgcn_mfma_f32_32x32x16_bf16(pa1,PK(1),o[d0],0,0,0);
    o[d0]=__builtin_amdgcn_mfma_f32_32x32x16_bf16(pa2,PK(2),o[d0],0,0,0);
    o[d0]=__builtin_amdgcn_mfma_f32_32x32x16_bf16(pa3,PK(3),o[d0],0,0,0);
    #undef PK
  }
}

#ifndef ATTN_STORE16
#define ATTN_STORE16(p,v) (*(u32x4*)(p)=(v))
#endif
template<int THRL,bool NOMAX> __device__ __forceinline__ void attn_unit(const bf16*Qw0,const bf16*Kh,const bf16*Vh,bf16*Ow0,const int NT,char*shm,const int wid){
  const int lane=lane_id(),r32=lane&31,hi=lane>>5;
  const bf16*Qw=Qw0+(long)(wid*QBLK)*QP;
  const unsigned lds0=(unsigned)(uintptr_t)shm;
  float*wsf=(float*)(shm+LDS_WS)+wid*64;
  const bf16*ksrc=Kh+(long)lane*KP+wid*8;
  const bf16*vsrc=Vh+(long)(16*(wid&3)+(lane>>2))*VP+(wid>>2)*32+(lane&3)*8;
  const unsigned kdst=lds0+LDS_K+wid*1024, vdst=lds0+LDS_V+wid*1024;
  #define DMA_K(t,slot) glds16(ksrc+(long)(t)*KVBLK*KP,(unsigned)__builtin_amdgcn_readfirstlane(kdst+(slot)))
  #define DMA_V(t,slot) glds16(vsrc+(long)(t)*KVBLK*VP,(unsigned)__builtin_amdgcn_readfirstlane(vdst+(slot)))
  const int vb0=(int)(lds0+LDS_V)+((lane>>4)&1)*32+(lane&3)*8+(4*hi+((lane&15)>>2))*64;
  const char*Kbase=shm+LDS_K; bf16x8 kf[8];
  const lds_cptr shm3=(lds_cptr)shm; const lds_cptr kp0=shm3+LDS_K+hi*1024+r32*16; const lds_cptr vp0=shm3+LDS_V+((lane>>4)&1)*32+(lane&3)*8+(4*hi+((lane&15)>>2))*64;
  DMA_K(0,0);DMA_V(0,0);DMA_K(1,SLOTB);
  bf16x8 qr[4];
  #pragma unroll
  for(int d0=0;d0<4;++d0)qr[d0]=*reinterpret_cast<const bf16x8*>(&Qw[(long)r32*QP+d0*16+hi*8]);
  float mhat=0.f,l_reg=0.f;f32x16 o[2];o[0]=f32x16{};o[1]=f32x16{};f32x16 negm=f32x16{};asm volatile("":"+v"(negm));
  #define CMASK(P0,P1,t) do{}while(0)
  bool resc=false;
  #define START(P0,P1) do{ resc=false; if constexpr(!NOMAX){ const float rm=rowmax(P0,P1); \
    { const float dl=rm; mhat=fadd_s(mhat,dl); \
      _Pragma("unroll") for(int r=0;r<16;++r){P0[r]=fsub_s(P0[r],dl);P1[r]=fsub_s(P1[r],dl);} \
      _Pragma("unroll") for(int r=0;r<16;++r)negm[r]=-mhat; asm volatile("":"+v"(negm)); } } \
    _Pragma("unroll") for(int r=0;r<16;++r)P0[r]=__builtin_amdgcn_exp2f(P0[r]); }while(0)
  #define RESC() do{ if(resc){ asm volatile("s_waitcnt lgkmcnt(0)":::"memory"); \
      _Pragma("unroll") for(int d_=0;d_<2;++d_) _Pragma("unroll") for(int r=0;r<16;++r)o[d_][r]*=wsf[crow(r,hi)]; } }while(0)
  f32x16 pA0,pA1,pB0,pB1;
  int sl_prev=0,sl_cur=0,sl_next=SLOTB;
  #define ROT() do{sl_prev=sl_cur;sl_cur=sl_next;sl_next=(sl_next==(NSLOT-1)*SLOTB)?0:sl_next+SLOTB;}while(0)
  DMA_K(2,2*SLOTB);
  WAIT_BAR(3);
  qkt(pA0,pA1,Kbase,qr,negm,r32,hi);asm volatile("s_nop 15\n\ts_nop 7":"+v"(pA0),"+v"(pA1));CMASK(pA0,pA1,0);
  START(pA0,pA1);
  _Pragma("unroll") for(int r=0;r<16;++r)pA1[r]=__builtin_amdgcn_exp2f(pA1[r]);
  WAIT_BAR(0);
  DMA_K(3,0);DMA_V(1,SLOTB);
  ROT();
  kload8(kf,kp0+sl_cur);
  WAIT_BAR(2);
  s16x4 vlo[8],vhi[8]; u32x4 pw0,pw1,pw2,pw3;
  #define PKW(P,B) cvtpk_s(P[B],P[B+1])
  #define PAF(k) __builtin_bit_cast(bf16x8,pw##k)
  #define VFR(i) (bf16x8){vlo[i][0],vlo[i][1],vlo[i][2],vlo[i][3],vhi[i][0],vhi[i][1],vhi[i][2],vhi[i][3]}
  #define PIN(x) asm volatile("":"+v"(x))
  #define MX3(a,b,c) __builtin_fmaxf(__builtin_fmaxf((a),(b)),(c))
  #define GAPA(MF,A0,A1,A2,A3,W0,W1,PW) do{ MF; sacc+=A0; sacc+=A1; sacc+=A2; sacc+=A3; PIN(sacc); W0; W1; PIN(PW); SBAR(); }while(0)
  #define EX(v) __builtin_amdgcn_exp2f(v)
  #define GAPB(MF,X,B) do{ MF; X[B]=EX(X[B]); X[B+1]=EX(X[B+1]); X[B+2]=EX(X[B+2]); X[B+3]=EX(X[B+3]); PIN(X); SBAR(); }while(0)
  #define VRD(i) do{ vlo[i]=vtr(vp_+(((i)>>2)*4096+((i)&3)*1024)); vhi[i]=vtr(vp_+(((i)>>2)*4096+((i)&3)*1024+512)); }while(0)
  #define KRD(G,j) do{ if(G){ kload2(kf,kp0+sl_next,j); SBAR(); } }while(0)
  #define STEP(C0,C1,P0,P1,t,GK,GV,GL) do{ SBAR(); \
    const lds_cptr vp_=vp0+sl_prev; \
    VRD(0); SBAR(); float sacc=(P0[0]+P0[1]); \
    GAPA(C0=__builtin_amdgcn_mfma_f32_32x32x16_bf16(kf[0],qr[0],negm,0,0,0), P0[2],P0[3],P0[4],P0[5],     pw0[0]=PKW(P0,0), pw0[1]=PKW(P0,2), pw0); \
    VRD(4); SBAR(); GAPA(C1=__builtin_amdgcn_mfma_f32_32x32x16_bf16(kf[1],qr[0],negm,0,0,0), P0[6],P0[7],P0[8],P0[9],     pw0[2]=PKW(P0,4), pw0[3]=PKW(P0,6), pw0); \
    VRD(1); SBAR(); GAPA(C0=__builtin_amdgcn_mfma_f32_32x32x16_bf16(kf[2],qr[1],C0,0,0,0),   P0[10],P0[11],P0[12],P0[13], pw1[0]=PKW(P0,8), pw1[1]=PKW(P0,10), pw1); \
    VRD(5); SBAR(); GAPA(C1=__builtin_amdgcn_mfma_f32_32x32x16_bf16(kf[3],qr[1],C1,0,0,0),   P0[14],P0[15],P1[0],P1[1],   pw1[2]=PKW(P0,12),pw1[3]=PKW(P0,14), pw1); \
    VRD(2); SBAR(); GAPA(C0=__builtin_amdgcn_mfma_f32_32x32x16_bf16(kf[4],qr[2],C0,0,0,0),   P1[2],P1[3],P1[4],P1[5],     pw2[0]=PKW(P1,0), pw2[1]=PKW(P1,2), pw2); \
    VRD(6); SBAR(); GAPA(C1=__builtin_amdgcn_mfma_f32_32x32x16_bf16(kf[5],qr[2],C1,0,0,0),   P1[6],P1[7],P1[8],P1[9],     pw2[2]=PKW(P1,4), pw2[3]=PKW(P1,6), pw2); \
    VRD(3); SBAR(); GAPA(C0=__builtin_amdgcn_mfma_f32_32x32x16_bf16(kf[6],qr[3],C0,0,0,0),   P1[10],P1[11],P1[12],P1[13], pw3[0]=PKW(P1,8), pw3[1]=PKW(P1,10), pw3); \
    VRD(7); SBAR(); GAPA(C1=__builtin_amdgcn_mfma_f32_32x32x16_bf16(kf[7],qr[3],C1,0,0,0),   P1[14],P1[15],0.f,0.f,       pw3[2]=PKW(P1,12),pw3[3]=PKW(P1,14), pw3); \
    l_reg+=sacc; \
    if(GK){DMA_K((t)+3,sl_cur);} if(GV){DMA_V((t)+1,sl_next);} \
    CMASK(C0,C1,t); \
    if constexpr(!NOMAX) { float a=MX3(C0[0],C0[1],C1[0]),b=MX3(C0[2],C0[3],C1[1]); a=MX3(a,C1[2],C1[3]); \
      _Pragma("unroll") for(int r=4;r<16;r+=4){a=MX3(a,C0[r],C0[r+1]);b=MX3(b,C0[r+2],C0[r+3]);a=MX3(a,C1[r],C1[r+1]);b=MX3(b,C1[r+2],C1[r+3]);} \
      float rm=__builtin_fmaxf(a,b); { auto rr=__builtin_amdgcn_permlane32_swap(__float_as_uint(rm),__float_as_uint(rm),false,false); rm=__builtin_fmaxf(__uint_as_float(rr[0]),__uint_as_float(rr[1])); } \
      resc=false; \
      if(__builtin_expect(__any(rm>(float)THRL),0)){ const float dl=__builtin_fmaxf(rm,0.f); mhat+=dl; \
        _Pragma("unroll") for(int r=0;r<16;++r){C0[r]-=dl;C1[r]-=dl;} \
        _Pragma("unroll") for(int r=0;r<16;++r)negm[r]=-mhat; asm volatile("":"+v"(negm)); \
        const float f=__builtin_amdgcn_exp2f(-dl); l_reg*=f; if(hi==0)wsf[r32]=f; resc=true; } } \
    SBAR(); \
    GAPB(o[0]=__builtin_amdgcn_mfma_f32_32x32x16_bf16(PAF(0),VFR(0),o[0],0,0,0), C0,0); \
    GAPB(o[1]=__builtin_amdgcn_mfma_f32_32x32x16_bf16(PAF(0),VFR(4),o[1],0,0,0), C0,4); \
    KRD(GL,0); GAPB(o[0]=__builtin_amdgcn_mfma_f32_32x32x16_bf16(PAF(1),VFR(1),o[0],0,0,0), C0,8); \
    KRD(GL,1); GAPB(o[1]=__builtin_amdgcn_mfma_f32_32x32x16_bf16(PAF(1),VFR(5),o[1],0,0,0), C0,12); \
    KRD(GL,2); GAPB(o[0]=__builtin_amdgcn_mfma_f32_32x32x16_bf16(PAF(2),VFR(2),o[0],0,0,0), C1,0); \
    KRD(GL,3); GAPB(o[1]=__builtin_amdgcn_mfma_f32_32x32x16_bf16(PAF(2),VFR(6),o[1],0,0,0), C1,4); \
    GAPB(o[0]=__builtin_amdgcn_mfma_f32_32x32x16_bf16(PAF(3),VFR(3),o[0],0,0,0), C1,8); \
    GAPB(o[1]=__builtin_amdgcn_mfma_f32_32x32x16_bf16(PAF(3),VFR(7),o[1],0,0,0), C1,12); \
    }while(0)
  int t=1;
  #undef CMASK
  #define CMASK(P0,P1,t) do{}while(0)
  for(;t+5<NT;t+=2){
    STEP(pB0,pB1,pA0,pA1,t,true,true,true);     WAIT_BAR(2); RESC(); ROT();
    STEP(pA0,pA1,pB0,pB1,t+1,true,true,true);   WAIT_BAR(2); RESC(); ROT();
  }
  #undef CMASK
  #define CMASK(P0,P1,t) do{}while(0)
  #define ENDW(tt) do{ if((tt)+3<NT){WAIT_BAR(2);} else if((tt)+2<NT){WAIT_BAR(1);} else {WAIT_BAR(0);} }while(0)
  for(;t+1<NT;t+=2){
    STEP(pB0,pB1,pA0,pA1,t,(t+3<NT),(t+1<NT),(t+1<NT));       ENDW(t);   RESC(); ROT();
    STEP(pA0,pA1,pB0,pB1,t+1,(t+4<NT),(t+2<NT),(t+2<NT));     ENDW(t+1); RESC(); ROT();
  }
  STEP(pB0,pB1,pA0,pA1,NT-1,false,false,false); RESC();
  { float sacc=pB0[0]+pB0[1]; _Pragma("unroll") for(int r=2;r<16;++r)sacc+=pB0[r]; _Pragma("unroll") for(int r=0;r<16;++r)sacc+=pB1[r]; l_reg+=sacc;
    pw0=(u32x4){PKW(pB0,0),PKW(pB0,2),PKW(pB0,4),PKW(pB0,6)};pw1=(u32x4){PKW(pB0,8),PKW(pB0,10),PKW(pB0,12),PKW(pB0,14)};pw2=(u32x4){PKW(pB1,0),PKW(pB1,2),PKW(pB1,4),PKW(pB1,6)};pw3=(u32x4){PKW(pB1,8),PKW(pB1,10),PKW(pB1,12),PKW(pB1,14)};
    SBAR(); pv(o,vb0+sl_cur,PAF(0),PAF(1),PAF(2),PAF(3)); }
  #undef PKW
  #undef PAF
  #undef VFR
  #undef PIN
  #undef MX3
  #undef GAPA
  #undef GAPB
  #undef EX
  #undef VRD
  #undef KRD
  #undef STEP
  #undef ENDW
  {auto rr=__builtin_amdgcn_permlane32_swap(__float_as_uint(l_reg),__float_as_uint(l_reg),false,false);l_reg=__uint_as_float(rr[0])+__uint_as_float(rr[1]);}
  if(hi==0)wsf[32+r32]=l_reg;asm volatile("s_waitcnt lgkmcnt(0)":::"memory");
  float rli[16];
  #pragma unroll
  for(int r=0;r<16;++r)rli[r]=__builtin_amdgcn_rcpf(wsf[32+crow(r,hi)]);
  bf16*Ow=Ow0+(long)(wid*QBLK)*OP;
  { bf16*stg=(bf16*)(shm+LDS_OST)+wid*2048;
    #pragma unroll
    for(int r=0;r<16;++r){const int orow=crow(r,hi);
      #pragma unroll
      for(int d0=0;d0<2;++d0)stg[orow*64+d0*32+r32]=__float2bfloat16(o[d0][r]*rli[r]);}
    asm volatile("s_waitcnt lgkmcnt(0)":::"memory");
    #pragma unroll
    for(int i=0;i<4;++i){const int row=i*8+(lane>>3),ch=lane&7; const u32x4 v=*(const u32x4*)(stg+row*64+ch*8); ATTN_STORE16(Ow+(long)row*OP+ch*8,v);} }
  asm volatile("s_waitcnt lgkmcnt(0)\n\ts_barrier":::"memory");
  #undef DMA_K
  #undef DMA_V
  #undef CMASK
  #undef START
  #undef RESC
  #undef ROT
}
constexpr int ATTN_LDS_BYTES=LDS_BYTES;
#undef SBAR
#undef WAIT_BAR
}

__device__ __forceinline__ void phase_pro(const Ctx& c, LAS float* ldsf) {
    float* rope = (float*)(c.ws + WS_ROPE);
    for (int i = c.gt; i < 64 * 16; i += c.ngt) {
        const int pos = i >> 4, fi = i & 15; const float inv = powf(10000.0f, -(float)fi / 16.0f), ang = (float)pos * inv;
        rope[2 * i] = cosf(ang); rope[2 * i + 1] = sinf(ang);
    }
    LAS float* sil = ldsf; LAS float* red = ldsf + 9 * 1024;
    for (int i = c.tid; i < 9 * 1024; i += 512) { const int j = i >> 10, k = i & 1023; const float v = (j < 8) ? c.in[IN_C][j * 1024 + k] : c.in[IN_CCTX][k]; sil[i] = siluf_(v); }
    __syncthreads();
    float* MOD = (float*)(c.ws + WS_MOD);
    for (int task = c.vb; task < DEPTH * 192; task += c.vg) {
        const int L = task / 192, cb = task - L * 192, col = cb * 32 + (c.lane & 31);
        const float* W = c.in[IN_MODW] + (size_t)L * 1024 * 6144 + col;
        float acc[9];
#pragma unroll
        for (int j = 0; j < 9; ++j) acc[j] = 0.f;
        const int k0 = c.wave * 128 + (c.lane >> 5);
        for (int kb = 0; kb < 128; kb += 32) {
            float w[16];
#pragma unroll
            for (int u = 0; u < 16; ++u) w[u] = __builtin_nontemporal_load(W + (size_t)(k0 + kb + 2 * u) * 6144);
#pragma unroll
            for (int u = 0; u < 16; ++u)
#pragma unroll
                for (int j = 0; j < 9; ++j) acc[j] += sil[j * 1024 + k0 + kb + 2 * u] * w[u];
        }
#pragma unroll
        for (int j = 0; j < 9; ++j) { acc[j] += __shfl_xor(acc[j], 32); if (c.lane < 32) red[(c.wave * 9 + j) * 32 + c.lane] = acc[j]; }
        __syncthreads();
        if (c.wave == 0 && c.lane < 32) {
            const float bias = c.in[IN_MODB][L * 6144 + col];
#pragma unroll
            for (int j = 0; j < 9; ++j) { float s = bias;
#pragma unroll
                for (int w = 0; w < 8; ++w) s += red[(w * 9 + j) * 32 + c.lane];
                MOD[(size_t)(L * 9 + j) * 6144 + col] = s; }
        }
        __syncthreads();
    }
}

template <bool FINAL, bool GM, int NR>
__device__ __forceinline__ void norm1_rows(const Ctx& c, int L, int rbeg, int rend) {
    unsigned short* X = (unsigned short*)(c.ws + WS_X);
    const int* SLOT = (const int*)(c.ws + WS_SLOT); const unsigned char* Y = (const unsigned char*)(c.ws + WS_Y);
    int ch[4];
#pragma unroll
    for (int q = 0; q < 4; ++q) ch[q] = GM ? 16 * c.lane + 4 * q : 4 * (c.lane + 64 * q);
#define N1_DEC(w) ((f32x4){__builtin_amdgcn_cvt_pk_f32_fp8((int)(w), false)[0], __builtin_amdgcn_cvt_pk_f32_fp8((int)(w), false)[1], __builtin_amdgcn_cvt_pk_f32_fp8((int)(w), true)[0], __builtin_amdgcn_cvt_pk_f32_fp8((int)(w), true)[1]})
    pg8::u32x2 xn[NR][4]; int spn[NR]; unsigned yp0[NR][4], yp1[NR][4]; unsigned long long maskn[NR]; bool hasn[NR], twon[NR];
#pragma unroll
    for (int k = 0; k < NR; ++k) { spn[k] = -1; maskn[k] = 0ull; hasn[k] = false; twon[k] = false; }
#define N1_LOADX(k, row) do { _Pragma("unroll") for (int q = 0; q < 4; ++q) xn[k][q] = *(const pg8::u32x2*)(X + (size_t)(row) * D + ch[q]); \
        if (L > 0 && c.lane < NE) spn[k] = SLOT[(size_t)(row) * NE + c.lane]; } while (0)
#define N1_YPF(k) do { unsigned long long m_ = __ballot(spn[k] >= 0 && c.lane < NE); hasn[k] = m_ != 0ull; twon[k] = false; if (m_) { \
        const int e0_ = __builtin_ctzll(m_); m_ &= m_ - 1; twon[k] = m_ != 0ull; const int e1_ = twon[k] ? __builtin_ctzll(m_) : e0_; if (twon[k]) m_ &= m_ - 1; \
        const unsigned char* y0_ = Y + ((size_t)e0_ * EROWS + __builtin_amdgcn_readlane(spn[k], e0_)) * D; const unsigned char* y1_ = Y + ((size_t)e1_ * EROWS + __builtin_amdgcn_readlane(spn[k], e1_)) * D; \
        _Pragma("unroll") for (int q = 0; q < 4; ++q) { yp0[k][q] = __builtin_nontemporal_load((const unsigned*)(y0_ + ch[q])); yp1[k][q] = __builtin_nontemporal_load((const unsigned*)(y1_ + ch[q])); } } maskn[k] = m_; } while (0)
    const int gall = rend / NR, gper = (gall - rbeg / NR + c.ngw - 1) / c.ngw;
    int gidx = rbeg / NR + c.gw * gper;
    const int ngrp = (gidx + gper < gall) ? gidx + gper : gall;
    if (gidx < ngrp) {
#pragma unroll
        for (int k = 0; k < NR; ++k) N1_LOADX(k, gidx * NR + k);
        if (L > 0) {
#pragma unroll
            for (int k = 0; k < NR; ++k) N1_YPF(k);
        }
    }
    int jprev = -1; f32x4 gmv[4] = {}, shv[4] = {}, g2v[4] = {};
    for (; gidx < ngrp; ++gidx) {
        const int r0 = gidx * NR;
        const int b = r0 / RB, s0 = r0 - b * RB, j = s0 < CL ? 8 : b;
        pg8::u32x2 xc[NR][4]; int spc[NR]; unsigned w0[NR][4], w1[NR][4]; unsigned long long mask[NR]; bool has[NR], two0[NR];
#pragma unroll
        for (int k = 0; k < NR; ++k) { spc[k] = spn[k]; mask[k] = maskn[k]; has[k] = hasn[k]; two0[k] = twon[k];
#pragma unroll
            for (int q = 0; q < 4; ++q) { xc[k][q] = xn[k][q]; w0[k][q] = yp0[k][q]; w1[k][q] = yp1[k][q]; } }
        const int gn = gidx + 1;
        if (gn < ngrp) {
#pragma unroll
            for (int k = 0; k < NR; ++k) N1_LOADX(k, gn * NR + k);
        }
        if (!(FINAL && s0 < CL)) {
            unsigned hw[NR][8];
            if (NR > 1 && j != jprev) { jprev = j;
#pragma unroll
                for (int q = 0; q < 4; ++q) {
                    if (FINAL) gmv[q] = *(const f32x4*)(c.in[IN_FNG] + ch[q]);
                    else { gmv[q] = *(const f32x4*)(c.in[IN_NORMG] + (size_t)(L * 2 + 0) * D + ch[q]) * (1.0f + *(const f32x4*)(modp(c, L, j, 1) + ch[q])); shv[q] = *(const f32x4*)(modp(c, L, j, 0) + ch[q]); }
                    if (L > 0) g2v[q] = *(const f32x4*)(modp(c, L - 1, j, 5) + ch[q]);
                }
            }
#pragma unroll
            for (int k = 0; k < NR; ++k) {
                const int r = r0 + k, s = s0 + k;
                unsigned short* xr = X + (size_t)r * D;
                f32x4 v[4];
#pragma unroll
                for (int q = 0; q < 4; ++q) v[q] = pg8::bf4_to_f32(xc[k][q]);
                if (L > 0) {
                    f32x4 sum[4] = {};
                    if (has[k]) {
#pragma unroll
                        for (int q = 0; q < 4; ++q) { sum[q] += N1_DEC(w0[k][q]); if (two0[k]) sum[q] += N1_DEC(w1[k][q]); }
                    }
                    unsigned long long mk = mask[k];
                    while (mk) {
                        const int e0 = __builtin_ctzll(mk); mk &= mk - 1;
                        const bool two = mk != 0ull; const int e1 = two ? __builtin_ctzll(mk) : e0; if (two) mk &= mk - 1;
                        const int sp0 = __builtin_amdgcn_readlane(spc[k], e0), sp1 = __builtin_amdgcn_readlane(spc[k], e1);
                        const unsigned char* y0 = Y + ((size_t)e0 * EROWS + sp0) * D; const unsigned char* y1 = Y + ((size_t)e1 * EROWS + sp1) * D;
                        unsigned u0[4], u1[4];
#pragma unroll
                        for (int q = 0; q < 4; ++q) { u0[q] = __builtin_nontemporal_load((const unsigned*)(y0 + ch[q])); u1[q] = __builtin_nontemporal_load((const unsigned*)(y1 + ch[q])); }
#pragma unroll
                        for (int q = 0; q < 4; ++q) { sum[q] += N1_DEC(u0[q]); if (two) sum[q] += N1_DEC(u1[q]); }
                    }
                    const float* g2 = modp(c, L - 1, j, 5);
#pragma unroll
                    for (int q = 0; q < 4; ++q) { v[q] += (NR > 1 ? g2v[q] : *(const f32x4*)(g2 + ch[q])) * (sum[q] * pg8::Y8_INV); if (!FINAL) { const pg8::u32x2 w = pg8::f32_to_bf4(v[q]); *(pg8::u32x2*)(xr + ch[q]) = w; v[q] = pg8::bf4_to_f32(w); } }
                }
                float ss = 0.f;
#pragma unroll
                for (int q = 0; q < 4; ++q) ss += v[q].x * v[q].x + v[q].y * v[q].y + v[q].z * v[q].z + v[q].w * v[q].w;
                const float rstd = rsqrtf(wave_sum(ss) * (1.0f / D) + EPS);
                if (FINAL) {
                    const float* g = c.in[IN_FNG]; float* op = c.out + (size_t)(b * T + s - CL) * D;
#pragma unroll
                    for (int q = 0; q < 4; ++q) *(f32x4*)(op + ch[q]) = v[q] * rstd * (NR > 1 ? gmv[q] : *(const f32x4*)(g + ch[q]));
                } else {
                    const float* g = c.in[IN_NORMG] + (size_t)(L * 2 + 0) * D; const float* sc = modp(c, L, j, 1); const float* sh = modp(c, L, j, 0);
#pragma unroll
                    for (int q = 0; q < 4; ++q) { const f32x4 hv = NR > 1 ? v[q] * rstd * gmv[q] + shv[q] : v[q] * rstd * *(const f32x4*)(g + ch[q]) * (1.0f + *(const f32x4*)(sc + ch[q])) + *(const f32x4*)(sh + ch[q]);
                        hw[k][2 * q] = pg8::cvt_pk_bf16(hv.x, hv.y); hw[k][2 * q + 1] = pg8::cvt_pk_bf16(hv.z, hv.w); }
                    if (!GM) { unsigned short* o = (unsigned short*)(c.ws + WS_HB1) + (size_t)r * D;
#pragma unroll
                        for (int q = 0; q < 4; ++q) *(pg8::u32x2*)(o + ch[q]) = (pg8::u32x2){hw[k][2 * q], hw[k][2 * q + 1]}; }
                }
            }
            if (!FINAL && GM) {
                unsigned short* o = (unsigned short*)(c.ws + WS_AS5) + ((size_t)c.lane * 1280 + (r0 >> 5)) * 768 + (r0 & 31) * 16;
#pragma unroll
                for (int k = 0; k < NR; ++k) { *(pg8::u32x4*)(o + 16 * k) = (pg8::u32x4){hw[k][0], hw[k][1], hw[k][2], hw[k][3]}; *(pg8::u32x4*)(o + 16 * k + 8) = (pg8::u32x4){hw[k][4], hw[k][5], hw[k][6], hw[k][7]}; }
            }
        }
        if (L > 0 && gn < ngrp) {
#pragma unroll
            for (int k = 0; k < NR; ++k) N1_YPF(k);
        }
    }
#undef N1_DEC
#undef N1_LOADX
#undef N1_YPF
}
template <int NR>
__device__ __forceinline__ void norm1_first_rows(const Ctx& c, int rbeg, int rend) {
    unsigned short* X = (unsigned short*)(c.ws + WS_X); unsigned short* H = (unsigned short*)(c.ws + WS_HB1);
    f32x4 xn[NR][4];
#define NF_LOAD(k, row) do { const int b_ = (row) / RB, s_ = (row) - b_ * RB; \
        const f32x4* sp_ = (const f32x4*)((s_ < CL) ? c.in[IN_CTX] + (size_t)(b_ * CL + s_) * D : c.in[IN_X] + (size_t)(b_ * T + s_ - CL) * D) + c.lane; \
        _Pragma("unroll") for (int q = 0; q < 4; ++q) xn[k][q] = __builtin_nontemporal_load(sp_ + 64 * q); } while (0)
    const int gall = rend / NR, gper = (gall - rbeg / NR + c.ngw - 1) / c.ngw;
    int gidx = rbeg / NR + c.gw * gper;
    const int ngrp = (gidx + gper < gall) ? gidx + gper : gall;
    if (gidx < ngrp) {
#pragma unroll
        for (int k = 0; k < NR; ++k) NF_LOAD(k, gidx * NR + k);
    }
    const float* g = c.in[IN_NORMG];
    int jprev = -1; f32x4 gmv[4] = {}, shv[4] = {}, g2v[4] = {};
    for (; gidx < ngrp; ++gidx) {
        const int r0 = gidx * NR, b = r0 / RB, s0 = r0 - b * RB, j = s0 < CL ? 8 : b;
        f32x4 xc[NR][4];
#pragma unroll
        for (int k = 0; k < NR; ++k)
#pragma unroll
            for (int q = 0; q < 4; ++q) xc[k][q] = xn[k][q];
        const int gn = gidx + 1;
        if (gn < ngrp) {
#pragma unroll
            for (int k = 0; k < NR; ++k) NF_LOAD(k, gn * NR + k);
        }
        const float* sc = modp(c, 0, j, 1); const float* sh = modp(c, 0, j, 0);
        if (j != jprev) { jprev = j;
#pragma unroll
            for (int q = 0; q < 4; ++q) { const int ch = 4 * (c.lane + 64 * q); gmv[q] = *(const f32x4*)(g + ch) * (1.0f + *(const f32x4*)(sc + ch)); shv[q] = *(const f32x4*)(sh + ch); } }
#pragma unroll
        for (int k = 0; k < NR; ++k) {
            const size_t r = (size_t)(r0 + k);
            f32x4 v[4]; float ss = 0.f;
#pragma unroll
            for (int q = 0; q < 4; ++q) { const pg8::u32x2 w = pg8::f32_to_bf4(xc[k][q]); *((pg8::u32x2*)(X + r * D) + c.lane + 64 * q) = w; v[q] = pg8::bf4_to_f32(w);
                ss += v[q].x * v[q].x + v[q].y * v[q].y + v[q].z * v[q].z + v[q].w * v[q].w; }
            const float rstd = rsqrtf(wave_sum(ss) * (1.0f / D) + EPS);
#pragma unroll
            for (int q = 0; q < 4; ++q) { const int ch = 4 * (c.lane + 64 * q);
                const f32x4 hv = v[q] * rstd * gmv[q] + shv[q];
                *((pg8::u32x2*)(H + r * D) + c.lane + 64 * q) = (pg8::u32x2){pg8::cvt_pk_bf16(hv.x, hv.y), pg8::cvt_pk_bf16(hv.z, hv.w)}; }
        }
    }
#undef NF_LOAD
}
__device__ __forceinline__ void phase_norm1_first(const Ctx& c) {
    norm1_first_rows<4>(c, 0, 32768);
    norm1_first_rows<1>(c, 32768, NROWS);
}
template <bool FINAL, bool GM>
__device__ __forceinline__ void phase_norm1(const Ctx& c, int L) {
    norm1_rows<FINAL, GM, 4>(c, L, 0, 32768);
    norm1_rows<FINAL, GM, 1>(c, L, 32768, NROWS);
}

template <bool SKIPCTX>
__device__ __forceinline__ void router_pairs(const Ctx& c, int L, const LAS float* wT, int rend) {
    const unsigned short* X = (const unsigned short*)(c.ws + WS_X); unsigned char* HB = (unsigned char*)(c.ws + WS_HB); float* AFF = (float*)(c.ws + WS_AFF);
    const int npair = rend >> 1, per = (npair + c.ngw - 1) / c.ngw, p0 = c.gw * per, p1 = (p0 + per < npair) ? p0 + per : npair;
    pg8::u32x2 xA[4], xB[4];
    if (p0 < p1) {
#pragma unroll
        for (int q = 0; q < 4; ++q) { xA[q] = ((const pg8::u32x2*)(X + (size_t)(2 * p0) * D) + c.lane)[64 * q]; xB[q] = ((const pg8::u32x2*)(X + (size_t)(2 * p0 + 1) * D) + c.lane)[64 * q]; }
    }
    int jprev = -1; f32x4 gmr[4] = {}, svr[4] = {};
    for (int p = p0; p < p1; ++p) {
        const int r0 = 2 * p, j = row_j(r0);
        f32x4 fA[4], fB[4]; float ssA = 0.f, ssB = 0.f;
#pragma unroll
        for (int q = 0; q < 4; ++q) { fA[q] = pg8::bf4_to_f32(xA[q]); fB[q] = pg8::bf4_to_f32(xB[q]);
            ssA += fA[q].x * fA[q].x + fA[q].y * fA[q].y + fA[q].z * fA[q].z + fA[q].w * fA[q].w; ssB += fB[q].x * fB[q].x + fB[q].y * fB[q].y + fB[q].z * fB[q].z + fB[q].w * fB[q].w; }
        if (p + 1 < p1) {
#pragma unroll
            for (int q = 0; q < 4; ++q) { xA[q] = ((const pg8::u32x2*)(X + (size_t)(2 * (p + 1)) * D) + c.lane)[64 * q]; xB[q] = ((const pg8::u32x2*)(X + (size_t)(2 * (p + 1) + 1) * D) + c.lane)[64 * q]; }
        }
        if (!(SKIPCTX && j == 8)) {
            const float rsA = rsqrtf(wave_sum(ssA) * (1.0f / D) + EPS), rsB = rsqrtf(wave_sum(ssB) * (1.0f / D) + EPS);
            const f32x4* g = (const f32x4*)(c.in[IN_NORMG] + (size_t)(L * 2 + 1) * D) + c.lane;
            const f32x4* sc = (const f32x4*)modp(c, L, j, 4) + c.lane; const f32x4* sh = (const f32x4*)modp(c, L, j, 3) + c.lane;
            unsigned* hA = (unsigned*)(HB + (size_t)r0 * D) + c.lane; unsigned* hB = (unsigned*)(HB + (size_t)(r0 + 1) * D) + c.lane;
            if (j != jprev) { jprev = j;
#pragma unroll
                for (int q = 0; q < 4; ++q) { gmr[q] = g[64 * q] * (1.0f + sc[64 * q]); svr[q] = sh[64 * q]; } }
#pragma unroll
            for (int q = 0; q < 4; ++q) { const f32x4 gm = gmr[q], sv = svr[q];
                fA[q] = fA[q] * rsA * gm + sv; fB[q] = fB[q] * rsB * gm + sv;
                hA[64 * q] = pg8::pk4_fp8(fA[q].x, fA[q].y, fA[q].z, fA[q].w); hB[64 * q] = pg8::pk4_fp8(fB[q].x, fB[q].y, fB[q].z, fB[q].w); }
            __builtin_amdgcn_sched_barrier(0);
            float lgA[16], lgB[16];
#pragma unroll
            for (int e = 0; e < 16; ++e) {
                f32x2 a2 = {0.f, 0.f}, b2 = {0.f, 0.f};
#pragma unroll
                for (int q = 0; q < 4; ++q) { const f32x4 wv = *(const LAS f32x4*)(wT + e * D + 4 * (c.lane + 64 * q));
                    a2 += fA[q].xy * wv.xy; a2 += fA[q].zw * wv.zw; b2 += fB[q].xy * wv.xy; b2 += fB[q].zw * wv.zw; }
                float a = a2.x + a2.y, b = b2.x + b2.y;
                asm volatile("" : "+v"(a), "+v"(b));
                lgA[e] = a; lgB[e] = b;
                if (e & 1) __builtin_amdgcn_sched_barrier(0);
            }
            const int kk = reduce16_k(c.lane);
            { const float mine = reduce16(lgA, c.lane); float mx = mine;
#pragma unroll
              for (int o = 4; o < 64; o <<= 1) mx = fmaxf(mx, __shfl_xor(mx, o));
              const float ex = expf(mine - mx); float den = ex;
#pragma unroll
              for (int o = 4; o < 64; o <<= 1) den += __shfl_xor(den, o);
              if ((c.lane & 3) == 0) AFF[(size_t)r0 * NE + kk] = ex / den; }
            { const float mine = reduce16(lgB, c.lane); float mx = mine;
#pragma unroll
              for (int o = 4; o < 64; o <<= 1) mx = fmaxf(mx, __shfl_xor(mx, o));
              const float ex = expf(mine - mx); float den = ex;
#pragma unroll
              for (int o = 4; o < 64; o <<= 1) den += __shfl_xor(den, o);
              if ((c.lane & 3) == 0) AFF[(size_t)(r0 + 1) * NE + kk] = ex / den; }
        }
    }
}
template <bool SKIPCTX>
__device__ __forceinline__ void phase_norm2_router(const Ctx& c, int L, LAS float* wT) {
    const unsigned short* X = (const unsigned short*)(c.ws + WS_X); unsigned char* HB = (unsigned char*)(c.ws + WS_HB); float* AFF = (float*)(c.ws + WS_AFF);
    const float* WR = c.in[IN_ROUTER] + (size_t)L * D * NE;
    __syncthreads();
    for (int idx = c.tid; idx < D * 4; idx += 512) { const int ch = idx >> 2, e4 = idx & 3; const f32x4 w = *(const f32x4*)(WR + (size_t)ch * NE + 4 * e4);
        wT[(4 * e4 + 0) * D + ch] = w.x; wT[(4 * e4 + 1) * D + ch] = w.y; wT[(4 * e4 + 2) * D + ch] = w.z; wT[(4 * e4 + 3) * D + ch] = w.w; }
    __syncthreads();
    router_pairs<SKIPCTX>(c, L, wT, 32768);
    constexpr int RB0 = 32768;
    pg8::u32x2 xn[4];
    if (RB0 + c.gw < NROWS) {
#pragma unroll
        for (int q = 0; q < 4; ++q) xn[q] = ((const pg8::u32x2*)(X + (size_t)(RB0 + c.gw) * D) + c.lane)[64 * q];
    }
    for (int r = RB0 + c.gw; r < NROWS; r += c.ngw) {
        const int j = row_j(r);
        f32x4 v[4]; float ss = 0.f;
#pragma unroll
        for (int q = 0; q < 4; ++q) { v[q] = pg8::bf4_to_f32(xn[q]); ss += v[q].x * v[q].x + v[q].y * v[q].y + v[q].z * v[q].z + v[q].w * v[q].w; }
        if (r + c.ngw < NROWS) {
#pragma unroll
            for (int q = 0; q < 4; ++q) xn[q] = ((const pg8::u32x2*)(X + (size_t)(r + c.ngw) * D) + c.lane)[64 * q];
        }
        if (SKIPCTX && j == 8) continue;
        const float rstd = rsqrtf(wave_sum(ss) * (1.0f / D) + EPS);
        const f32x4* g = (const f32x4*)(c.in[IN_NORMG] + (size_t)(L * 2 + 1) * D) + c.lane;
        const f32x4* sc = (const f32x4*)modp(c, L, j, 4) + c.lane; const f32x4* sh = (const f32x4*)modp(c, L, j, 3) + c.lane;
        unsigned* hp = (unsigned*)(HB + (size_t)r * D) + c.lane;
        float lg[16]; f32x4 f[4];
#pragma unroll
        for (int q = 0; q < 4; ++q) { f[q] = v[q] * rstd * g[64 * q] * (1.0f + sc[64 * q]) + sh[64 * q]; hp[64 * q] = pg8::pk4_fp8(f[q].x, f[q].y, f[q].z, f[q].w); }
        __builtin_amdgcn_sched_barrier(0);
#pragma unroll
        for (int e = 0; e < 16; ++e) {
            f32x2 a2 = {0.f, 0.f};
#pragma unroll
            for (int q = 0; q < 4; ++q) { const f32x4 wv = *(const LAS f32x4*)(wT + e * D + 4 * (c.lane + 64 * q)); a2 += f[q].xy * wv.xy; a2 += f[q].zw * wv.zw; }
            lg[e] = a2.x + a2.y;
            if (e & 1) __builtin_amdgcn_sched_barrier(0);
        }
        const float mine = reduce16(lg, c.lane);
        const int k = reduce16_k(c.lane);
        float mx = mine;
#pragma unroll
        for (int o = 4; o < 64; o <<= 1) mx = fmaxf(mx, __shfl_xor(mx, o));
        const float ex = expf(mine - mx);
        float den = ex;
#pragma unroll
        for (int o = 4; o < 64; o <<= 1) den += __shfl_xor(den, o);
        if ((c.lane & 3) == 0) AFF[(size_t)r * NE + k] = ex / den;
    }
}

__device__ __forceinline__ void phase_topk(const Ctx& c, LAS unsigned* lds32, int nprob) {
    const float* AFF = (const float*)(c.ws + WS_AFF);
    int* SELROW = (int*)(c.ws + WS_SELROW); float* SELGATE = (float*)(c.ws + WS_SELGATE); int* SLOT = (int*)(c.ws + WS_SLOT);
    LAS unsigned* hist = lds32; LAS unsigned* wsum = lds32 + 256; LAS unsigned* res = lds32 + 272;
    LAS int* srow = (LAS int*)(lds32 + 512);
    const unsigned char* HB = (const unsigned char*)(c.ws + WS_HB); unsigned char* XS = (unsigned char*)(c.ws + WS_XS);
    for (int pid = blockIdx.x; pid < nprob; pid += gridDim.x) {
        const bool lat = pid < 128; const int q = lat ? pid : pid - 128, b = q >> 4, e = q & 15;
        const int N = lat ? T : CL, C = lat ? CAP_LAT : CAP_CTX, row0 = b * RB + (lat ? CL : 0), base = lat ? b * CAP_LAT : NB * CAP_LAT + b * CAP_CTX;
        const int t0 = c.tid * 8; const bool valid = t0 < N;
        unsigned k[8];
#pragma unroll
        for (int i = 0; i < 8; ++i) k[i] = valid ? __float_as_uint(AFF[(size_t)(row0 + t0 + i) * NE + e]) : 0u;
        unsigned prefix = 0u, want = (unsigned)C;
#pragma unroll
        for (int r = 0; r < 4; ++r) {
            const int shift = 24 - 8 * r;
            __syncthreads();
            if (c.tid < 256) hist[c.tid] = 0u;
            __syncthreads();
            if (valid) {
#pragma unroll
                for (int i = 0; i < 8; ++i) if (r == 0 || (k[i] >> (shift + 8)) == prefix) __hip_atomic_fetch_add(&hist[(k[i] >> shift) & 255u], 1u, __ATOMIC_RELAXED, __HIP_MEMORY_SCOPE_WORKGROUP);
            }
            __syncthreads();
            if (c.wave == 0) {
                const unsigned h0 = hist[4 * c.lane], h1 = hist[4 * c.lane + 1], h2 = hist[4 * c.lane + 2], h3 = hist[4 * c.lane + 3];
                unsigned suf = h0 + h1 + h2 + h3;
#pragma unroll
                for (int off = 1; off < 64; off <<= 1) { const unsigned o = __shfl_down(suf, off); if (c.lane + off < 64) suf += o; }
                unsigned nxt = __shfl_down(suf, 1); if (c.lane == 63) nxt = 0u;
                if (suf >= want && nxt < want) {
                    unsigned above = nxt; int d;
                    if (above + h3 >= want) d = 3; else { above += h3; if (above + h2 >= want) d = 2; else { above += h2; if (above + h1 >= want) d = 1; else { above += h1; d = 0; } } }
                    res[0] = (unsigned)(4 * c.lane + d); res[1] = want - above;
                }
            }
            __syncthreads();
            prefix = (prefix << 8) | res[0]; want = res[1];
        }
        const unsigned thr = prefix, need_eq = want;
        unsigned cg = 0u, ce = 0u;
#pragma unroll
        for (int i = 0; i < 8; ++i) { cg += (valid && k[i] > thr) ? 1u : 0u; ce += (valid && k[i] == thr) ? 1u : 0u; }
        unsigned incl = cg | (ce << 16);
#pragma unroll
        for (int off = 1; off < 64; off <<= 1) { const unsigned o = __shfl_up(incl, off); if (c.lane >= off) incl += o; }
        __syncthreads();
        if (c.lane == 63) wsum[c.wave] = incl;
        __syncthreads();
        unsigned wbase = 0u;
#pragma unroll
        for (int w = 0; w < 8; ++w) if (w < c.wave) wbase += wsum[w];
        const unsigned excl = wbase + incl - (cg | (ce << 16));
        unsigned gb = excl & 0xffffu, eb = excl >> 16;
        if (valid) {
#pragma unroll
            for (int i = 0; i < 8; ++i) {
                const int row = row0 + t0 + i; const bool isg = k[i] > thr, ise = k[i] == thr;
                const bool sel = isg || (ise && eb < need_eq);
                const unsigned sp = (unsigned)base + gb + (eb < need_eq ? eb : need_eq);
                if (sel) { SELROW[e * EROWS + sp] = row; SELGATE[e * EROWS + sp] = __uint_as_float(k[i]); SLOT[(size_t)row * NE + e] = (int)sp; srow[sp - (unsigned)base] = row; }
                else SLOT[(size_t)row * NE + e] = -1;
                gb += isg ? 1u : 0u; eb += ise ? 1u : 0u;
            }
        }
        __syncthreads();
        for (int s0 = c.wave * 8; s0 < C; s0 += 64) {
            pg8::u32x4 v4[8];
#pragma unroll
            for (int j = 0; j < 8; ++j) v4[j] = *(const pg8::u32x4*)(HB + (size_t)srow[s0 + j] * D + c.lane * 16);
#pragma unroll
            for (int j = 0; j < 8; ++j) *(pg8::u32x4*)(XS + ((size_t)e * EROWS + base + s0 + j) * D + c.lane * 16) = v4[j];
        }
    }
}

__device__ __forceinline__ void post_ld32(const unsigned short* p, float (&v)[32]) {
#pragma unroll
    for (int q = 0; q < 4; ++q) { const pg8::u32x4 w = ((const pg8::u32x4*)p)[q];
#pragma unroll
        for (int e = 0; e < 4; ++e) { v[8 * q + 2 * e] = __uint_as_float(w[e] << 16); v[8 * q + 2 * e + 1] = __uint_as_float(w[e] & 0xffff0000u); } }
}
__device__ __forceinline__ void post_raw(const unsigned short* p, pg8::u32x4 (&w)[4]) {
#pragma unroll
    for (int q = 0; q < 4; ++q) w[q] = ((const pg8::u32x4*)p)[q];
}
__device__ __forceinline__ void post_cvt(const pg8::u32x4 (&w)[4], float (&v)[32]) {
#pragma unroll
    for (int q = 0; q < 4; ++q)
#pragma unroll
        for (int e = 0; e < 4; ++e) { v[8 * q + 2 * e] = __uint_as_float(w[q][e] << 16); v[8 * q + 2 * e + 1] = __uint_as_float(w[q][e] & 0xffff0000u); }
}
__device__ __forceinline__ void post_st32(unsigned short* p, const float (&v)[32], float sc) {
#pragma unroll
    for (int q = 0; q < 4; ++q) { pg8::u32x4 w;
#pragma unroll
        for (int e = 0; e < 4; ++e) w[e] = pg8::cvt_pk_bf16(v[8 * q + 2 * e] * sc, v[8 * q + 2 * e + 1] * sc);
        ((pg8::u32x4*)p)[q] = w; }
}
__device__ __forceinline__ void post_rope_l(float (&v)[32], const LAS float* cs  ) {
#pragma unroll
    for (int f4 = 0; f4 < 8; ++f4) { const f32x4 t4 = ((const LAS f32x4*)cs)[f4];
        { const float x1 = v[2 * f4], x2 = v[16 + 2 * f4]; v[2 * f4] = x1 * t4.x - x2 * t4.y; v[16 + 2 * f4] = x1 * t4.y + x2 * t4.x; }
        { const float x1 = v[2 * f4 + 1], x2 = v[16 + 2 * f4 + 1]; v[2 * f4 + 1] = x1 * t4.z - x2 * t4.w; v[16 + 2 * f4 + 1] = x1 * t4.w + x2 * t4.z; } }
}
__device__ __forceinline__ void post_rope(float (&v)[32], const float* cs  ) {
#pragma unroll
    for (int f4 = 0; f4 < 8; ++f4) { const f32x4 t4 = ((const f32x4*)cs)[f4];
        { const float x1 = v[2 * f4], x2 = v[16 + 2 * f4]; v[2 * f4] = x1 * t4.x - x2 * t4.y; v[16 + 2 * f4] = x1 * t4.y + x2 * t4.x; }
        { const float x1 = v[2 * f4 + 1], x2 = v[16 + 2 * f4 + 1]; v[2 * f4 + 1] = x1 * t4.z - x2 * t4.w; v[16 + 2 * f4 + 1] = x1 * t4.w + x2 * t4.z; } }
}
__device__ __forceinline__ void phase_post(const Ctx& c, int i, LAS unsigned char* lds) {
    typedef pg8::bf16x8 bf16x8;
    const unsigned short* P = (const unsigned short*)(c.ws + WS_P); const float* rope = (const float*)(c.ws + WS_ROPE);
    unsigned short* QA = (unsigned short*)(c.ws + WS_QA); unsigned short* KA = (unsigned short*)(c.ws + WS_KA); unsigned short* VA = (unsigned short*)(c.ws + WS_VA);
    unsigned short* RQ = (unsigned short*)(c.ws + WS_RQ); unsigned short* RK = (unsigned short*)(c.ws + WS_RK); unsigned short* RV = (unsigned short*)(c.ws + WS_RV);
    float* U = (float*)(c.ws + WS_U);
    const float* qkg = c.in[IN_QKG] + (size_t)i * 2 * 64;
    constexpr int VTS = 0, KTF = 17408, KTB = 34816;
    const int grp = c.tid >> 8, r = (c.tid & 255) >> 1, half = c.tid & 1;
    const int li = c.lane & 15, q4 = c.lane >> 4;
    pg8::u32x4 ra[4], rb[4], rc[4];
#define PP_LOAD(u_) do { const int hh_ = (u_) & 7, bc_ = (u_) >> 3, b_ = bc_ / 34, cch_ = bc_ - b_ * 34; const size_t row_ = (size_t)(b_ * RB + cch_ * 128 + r); \
        post_raw(P + row_ * INW + (grp ? 512 : 0) + hh_ * 64 + 32 * half, ra); post_raw(P + row_ * INW + (grp ? 2048 : 1024) + hh_ * 64 + 32 * half, rb); \
        if (hh_ < 2 && grp == 0) post_raw(P + row_ * INW + 2560 + hh_ * 64 + 32 * half, rc); } while (0)
    if ((int)blockIdx.x < NB * 34 * 8) PP_LOAD((int)blockIdx.x);
    LAS float* ropeL = (LAS float*)(lds + 53248); LAS float* qkL = ropeL + 64 * 36;
    for (int i2 = c.tid; i2 < 64 * 32; i2 += 512) ropeL[(i2 >> 5) * 36 + (i2 & 31)] = rope[i2];
    if (c.tid < 128) qkL[c.tid] = qkg[c.tid];
    __syncthreads();
    for (int unit = blockIdx.x; unit < NB * 34 * 8; unit += gridDim.x) {
        const int hh = unit & 7, bc = unit >> 3, b = bc / 34, cch = bc - b * 34, row0 = b * RB + cch * 128, bh = b * 8 + hh;
        const bool latent = cch >= 2;
        const size_t row = (size_t)(row0 + r);
        const int tpos = cch * 128 + r - CL;
        const LAS float* cs = ropeL + (half == 0 ? (tpos >> 6) : (tpos & 63)) * 36;
        const float lgf = -expf(c.in[IN_RETRATE][(i * 2 + 0) * 8 + hh]) * 1.4426950408889634f, lgb = -expf(c.in[IN_RETRATE][(i * 2 + 1) * 8 + hh]) * 1.4426950408889634f;
        __syncthreads();
        float v[32];
        post_cvt(ra, v);
        if (grp) {
#pragma unroll
            for (int d = 0; d < 32; ++d) v[d] *= 0.125f; }
        if (latent) post_rope_l(v, cs);
        post_st32((grp ? RK : RQ) + row * 512 + hh * 64 + 32 * half, v, 1.0f);
        if (grp) { const float wf = exp2f(lgf * (float)(127 - r)), wb = exp2f(lgb * (float)r);
#pragma unroll
            for (int d = 0; d < 32; d += 2) { const unsigned pf = pg8::cvt_pk_bf16(v[d] * wf, v[d + 1] * wf), pb = pg8::cvt_pk_bf16(v[d] * wb, v[d + 1] * wb);
                *(LAS unsigned short*)(lds + KTF + (32 * half + d) * 272 + r * 2) = (unsigned short)(pf & 0xffffu); *(LAS unsigned short*)(lds + KTF + (32 * half + d + 1) * 272 + r * 2) = (unsigned short)(pf >> 16);
                *(LAS unsigned short*)(lds + KTB + (32 * half + d) * 272 + r * 2) = (unsigned short)(pb & 0xffffu); *(LAS unsigned short*)(lds + KTB + (32 * half + d + 1) * 272 + r * 2) = (unsigned short)(pb >> 16); } }
        post_cvt(rb, v);
        if (grp == 0) {
#pragma unroll
            for (int d = 0; d < 32; d += 2) { const unsigned pv = pg8::cvt_pk_bf16(v[d], v[d + 1]);
                *(LAS unsigned short*)(lds + VTS + (32 * half + d) * 272 + r * 2) = (unsigned short)(pv & 0xffffu); *(LAS unsigned short*)(lds + VTS + (32 * half + d + 1) * 272 + r * 2) = (unsigned short)(pv >> 16); }
        } else {
            float ss = 0.f;
#pragma unroll
            for (int d = 0; d < 32; ++d) ss += v[d] * v[d];
            ss += __shfl_xor(ss, 1);
            const float rs = rsqrtf(ss * (1.0f / 64.0f) + EPS);
#pragma unroll
            for (int d = 0; d < 32; ++d) v[d] = v[d] * rs * qkL[32 * half + d];
            if (latent) post_rope_l(v, cs);
            post_st32(QA + row * 512 + hh * 64 + 32 * half, v, attn_body::C2);
        }
        if (hh < 2 && grp == 0) {
            post_cvt(rc, v);
            {
                float ss = 0.f;
#pragma unroll
                for (int d = 0; d < 32; ++d) ss += v[d] * v[d];
                ss += __shfl_xor(ss, 1);
                const float rs = rsqrtf(ss * (1.0f / 64.0f) + EPS);
#pragma unroll
                for (int d = 0; d < 32; ++d) v[d] = v[d] * rs * qkL[64 + 32 * half + d];
                if (latent) post_rope_l(v, cs);
                post_st32(KA + row * 128 + hh * 64 + 32 * half, v, 1.0f);
            }
        }
        if (unit + (int)gridDim.x < NB * 34 * 8) PP_LOAD(unit + (int)gridDim.x);
        __syncthreads();
        { const int dir = c.wave >> 2, dvt = c.wave & 3;
            bf16x8 af[4];
#pragma unroll
            for (int u = 0; u < 4; ++u) af[u] = *(const LAS bf16x8*)(lds + VTS + (16 * dvt + li) * 272 + (32 * u + 8 * q4) * 2);
            float* uo = U + ((size_t)(bh * 34 + cch) * 2 + dir) * 4096;
#pragma unroll
            for (int dkt = 0; dkt < 4; ++dkt) {
                f32x4 a = {0.f, 0.f, 0.f, 0.f};
#pragma unroll
                for (int u = 0; u < 4; ++u) { const bf16x8 kf = *(const LAS bf16x8*)(lds + (dir ? KTB : KTF) + (16 * dkt + li) * 272 + (32 * u + 8 * q4) * 2); a = __builtin_amdgcn_mfma_f32_16x16x32_bf16(af[u], kf, a, 0, 0, 0); }
#pragma unroll
                for (int rr = 0; rr < 4; ++rr) uo[(16 * dvt + 4 * q4 + rr) * 64 + 16 * dkt + li] = a[rr];
            } }
    }
}

#undef PP_LOAD
__device__ __forceinline__ void phase_ret_prefix(const Ctx& c, int i) {
    const float* U = (const float*)(c.ws + WS_U); unsigned short* ET = (unsigned short*)(c.ws + WS_ET);
    for (int chain = c.gt; chain < 64 * 2 * 4096; chain += c.ngt) {
        const int bh = chain >> 13, dir = (chain >> 12) & 1, el = chain & 4095, hh = bh & 7;
        const float g128 = expf(-expf(c.in[IN_RETRATE][(i * 2 + dir) * 8 + hh]) * 128.0f);
        float S = 0.f;
#pragma unroll
        for (int st = 0; st < 34; ++st) {
            const int cch = dir == 0 ? st : (st < 2 ? 1 - st : 35 - st);
            const size_t o = ((size_t)(bh * 34 + cch) * 2 + dir) * 4096 + el;
            ET[o] = (unsigned short)(pg8::cvt_pk_bf16(S, 0.f) & 0xffffu);
            S = g128 * S + U[o];
        }
    }
}
__device__ __forceinline__ void phase_ret_main(const Ctx& c, int i, LAS unsigned char* lds) {
    typedef pg8::bf16x8 bf16x8;
    const unsigned short* RQ = (const unsigned short*)(c.ws + WS_RQ); const unsigned short* RK = (const unsigned short*)(c.ws + WS_RK); const unsigned short* RV = (const unsigned short*)(c.ws + WS_RV);
    const unsigned short* ET = (const unsigned short*)(c.ws + WS_ET); const unsigned short* P = (const unsigned short*)(c.ws + WS_P); unsigned short* MIX = (unsigned short*)(c.ws + WS_MIX);
    const float* gn = c.in[IN_RETGN] + (size_t)i * 512;
    constexpr int QS = 0, KS = 18432, VTS = 36864, EF = 54272, EB = 63488;
    const int li = c.lane & 15, q4 = c.lane >> 4, i0 = 16 * c.wave, ig = i0 + li;
    pg8::u32x4 gq[2], gk[2], gv[2], gef, geb;
#define RM_LOAD(u_) do { const int bh_ = (u_) / 34, cch_ = (u_) - bh_ * 34, row0_ = (bh_ >> 3) * RB + cch_ * 128, hh_ = bh_ & 7; \
        _Pragma("unroll") for (int t2 = 0; t2 < 2; ++t2) { const int pc = c.tid + 512 * t2, r = pc >> 3, ch = pc & 7; const size_t go = (size_t)(row0_ + r) * 512 + hh_ * 64 + ch * 8; \
            gq[t2] = *(const pg8::u32x4*)(RQ + go); gk[t2] = *(const pg8::u32x4*)(RK + go); gv[t2] = *(const pg8::u32x4*)(P + (size_t)(row0_ + r) * INW + 1024 + hh_ * 64 + ch * 8); } \
        { const int r = c.tid >> 3, ch = c.tid & 7; const size_t go = ((size_t)(bh_ * 34 + cch_) * 2) * 4096 + r * 64 + ch * 8; gef = *(const pg8::u32x4*)(ET + go); geb = *(const pg8::u32x4*)(ET + go + 4096); } } while (0)
    if ((int)blockIdx.x < 64 * 34) RM_LOAD((int)blockIdx.x);
    for (int unit = blockIdx.x; unit < 64 * 34; unit += gridDim.x) {
        const int bh = unit / 34, cch = unit - bh * 34, b = bh >> 3, hh = bh & 7, row0 = b * RB + cch * 128;
        const float lgf = -expf(c.in[IN_RETRATE][(i * 2 + 0) * 8 + hh]) * 1.4426950408889634f, lgb = -expf(c.in[IN_RETRATE][(i * 2 + 1) * 8 + hh]) * 1.4426950408889634f;
        __syncthreads();
#pragma unroll
        for (int t2 = 0; t2 < 2; ++t2) { const int pc = c.tid + 512 * t2, r = pc >> 3, ch = pc & 7;
            *(LAS pg8::u32x4*)(lds + QS + r * 144 + ch * 16) = gq[t2];
            *(LAS pg8::u32x4*)(lds + KS + r * 144 + ch * 16) = gk[t2];
            const pg8::u32x4 vw = gv[t2];
#pragma unroll
            for (int e = 0; e < 4; ++e) { *(LAS unsigned short*)(lds + VTS + (ch * 8 + 2 * e) * 272 + r * 2) = (unsigned short)(vw[e] & 0xffffu); *(LAS unsigned short*)(lds + VTS + (ch * 8 + 2 * e + 1) * 272 + r * 2) = (unsigned short)(vw[e] >> 16); } }
        { const int r = c.tid >> 3, ch = c.tid & 7; *(LAS pg8::u32x4*)(lds + EF + r * 144 + ch * 16) = gef; *(LAS pg8::u32x4*)(lds + EB + r * 144 + ch * 16) = geb; }
        if (unit + (int)gridDim.x < 64 * 34) RM_LOAD(unit + (int)gridDim.x);
        __syncthreads();
        bf16x8 qf[2];
#pragma unroll
        for (int s = 0; s < 2; ++s) qf[s] = *(const LAS bf16x8*)(lds + QS + (i0 + li) * 144 + (32 * s + 8 * q4) * 2);
        pg8::u32x2 pk[8];
#pragma unroll
        for (int jt = 0; jt < 8; ++jt) {
            f32x4 a = {0.f, 0.f, 0.f, 0.f};
#pragma unroll
            for (int s = 0; s < 2; ++s) { const bf16x8 kf = *(const LAS bf16x8*)(lds + KS + (16 * jt + li) * 144 + (32 * s + 8 * q4) * 2); a = __builtin_amdgcn_mfma_f32_16x16x32_bf16(kf, qf[s], a, 0, 0, 0); }
            float pv[4];
#pragma unroll
            for (int r = 0; r < 4; ++r) { const int dl = ig - (16 * jt + 4 * q4 + r); const float w = dl >= 0 ? exp2f(lgf * (float)dl) : exp2f(lgb * (float)(-dl)); pv[r] = a[r] * w; }
            pk[jt] = (pg8::u32x2){pg8::cvt_pk_bf16(pv[0], pv[1]), pg8::cvt_pk_bf16(pv[2], pv[3])};
        }
        const float sf = exp2f(lgf * (float)(ig + 1)), sb = exp2f(lgb * (float)(128 - ig));
        f32x4 oacc[4];
#pragma unroll
        for (int dvt = 0; dvt < 4; ++dvt) {
            f32x4 o = {0.f, 0.f, 0.f, 0.f};
#pragma unroll
            for (int u = 0; u < 4; ++u) {
                const pg8::u32x2 vlo = *(const LAS pg8::u32x2*)(lds + VTS + (16 * dvt + li) * 272 + (32 * u + 4 * q4) * 2), vhi = *(const LAS pg8::u32x2*)(lds + VTS + (16 * dvt + li) * 272 + (32 * u + 16 + 4 * q4) * 2);
                const pg8::u32x4 av = {vlo.x, vlo.y, vhi.x, vhi.y}, bv = {pk[2 * u].x, pk[2 * u].y, pk[2 * u + 1].x, pk[2 * u + 1].y};
                o = __builtin_amdgcn_mfma_f32_16x16x32_bf16(__builtin_bit_cast(bf16x8, av), __builtin_bit_cast(bf16x8, bv), o, 0, 0, 0);
            }
            f32x4 tf = {0.f, 0.f, 0.f, 0.f}, tb = {0.f, 0.f, 0.f, 0.f};
#pragma unroll
            for (int s = 0; s < 2; ++s) {
                const bf16x8 ef = *(const LAS bf16x8*)(lds + EF + (16 * dvt + li) * 144 + (32 * s + 8 * q4) * 2), eb = *(const LAS bf16x8*)(lds + EB + (16 * dvt + li) * 144 + (32 * s + 8 * q4) * 2);
                tf = __builtin_amdgcn_mfma_f32_16x16x32_bf16(ef, qf[s], tf, 0, 0, 0); tb = __builtin_amdgcn_mfma_f32_16x16x32_bf16(eb, qf[s], tb, 0, 0, 0);
            }
            oacc[dvt] = o + tf * sf + tb * sb;
        }
        float sm = 0.f;
#pragma unroll
        for (int dvt = 0; dvt < 4; ++dvt) sm += (oacc[dvt].x + oacc[dvt].y) + (oacc[dvt].z + oacc[dvt].w);
        sm += __shfl_xor(sm, 16); sm += __shfl_xor(sm, 32);
        const float mu = sm * (1.0f / 64.0f); float vr = 0.f;
#pragma unroll
        for (int dvt = 0; dvt < 4; ++dvt) { oacc[dvt] = oacc[dvt] - mu; vr += (oacc[dvt].x * oacc[dvt].x + oacc[dvt].y * oacc[dvt].y) + (oacc[dvt].z * oacc[dvt].z + oacc[dvt].w * oacc[dvt].w); }
        vr += __shfl_xor(vr, 16); vr += __shfl_xor(vr, 32);
        const float rs = rsqrtf(vr * (1.0f / 64.0f) + EPS);
        const size_t row = (size_t)(row0 + ig);
#pragma unroll
        for (int dvt = 0; dvt < 4; ++dvt) { const int dvc = hh * 64 + 16 * dvt + 4 * q4;
            const pg8::u32x2 gw = *(const pg8::u32x2*)(P + row * INW + 1536 + dvc); const f32x4 gt = {__uint_as_float(gw.x << 16), __uint_as_float(gw.x & 0xffff0000u), __uint_as_float(gw.y << 16), __uint_as_float(gw.y & 0xffff0000u)}, gg = *(const f32x4*)(gn + dvc); const f32x4 y = oacc[dvt] * rs * gg;
            *(pg8::u32x2*)(MIX + row * D + dvc) = (pg8::u32x2){pg8::cvt_pk_bf16(gt.x * pg8::fast_sigmoid(gt.x) * y.x, gt.y * pg8::fast_sigmoid(gt.y) * y.y), pg8::cvt_pk_bf16(gt.z * pg8::fast_sigmoid(gt.z) * y.z, gt.w * pg8::fast_sigmoid(gt.w) * y.w)}; }
    }
}

#undef RM_LOAD
__device__ __forceinline__ void phase_attention(const Ctx& c, int i, char* lds) {
    const attn_body::bf16* QA = (const attn_body::bf16*)(c.ws + WS_QA); const attn_body::bf16* KA = (const attn_body::bf16*)(c.ws + WS_KA); const attn_body::bf16* VA = (const attn_body::bf16*)(c.ws + WS_P) + 2688;
    attn_body::bf16* MIX = (attn_body::bf16*)(c.ws + WS_MIX);
    const int G = gridDim.x, bx = blockIdx.x, vcu = (G % 8 == 0) ? (bx % 8) * (G / 8) + bx / 8 : bx;
    float gq = fabsf(c.in[IN_QKG][(size_t)i * 128 + c.lane]), gk = fabsf(c.in[IN_QKG][(size_t)i * 128 + 64 + c.lane]);
#pragma unroll
    for (int o = 1; o < 64; o <<= 1) { gq = fmaxf(gq, __shfl_xor(gq, o)); gk = fmaxf(gk, __shfl_xor(gk, o)); }
    const bool bounded = __builtin_amdgcn_readfirstlane(64.0f * gq * gk * attn_body::C2 < 40.0f ? 1 : 0) != 0;
    for (int U = vcu; U < NB * 8 * 17; U += G) {
        int bh, qrow0, NT;
        if (U < NB * 8 * 16) { bh = U >> 4; qrow0 = (bh >> 3) * RB + CL + (U & 15) * 256; NT = RB / 64; }
        else { bh = U - NB * 8 * 16; qrow0 = (bh >> 3) * RB; NT = CL / 64; }
        const int b = bh >> 3, hh = bh & 7;
        if (bounded) attn_body::attn_unit<8, true>(QA + (size_t)qrow0 * 512 + hh * 64, KA + (size_t)(b * RB) * 128 + (hh >> 2) * 64, VA + (size_t)(b * RB) * INW + (hh >> 2) * 64,
                                MIX + (size_t)qrow0 * 1024 + 512 + hh * 64, NT, lds, c.wave);
        else attn_body::attn_unit<8, false>(QA + (size_t)qrow0 * 512 + hh * 64, KA + (size_t)(b * RB) * 128 + (hh >> 2) * 64, VA + (size_t)(b * RB) * INW + (hh >> 2) * 64,
                                MIX + (size_t)qrow0 * 1024 + 512 + hh * 64, NT, lds, c.wave);
    }
}

__device__ __forceinline__ void phase_s5_ops(const Ctx& c, LAS float* ldsf) {
    LAS float* Pre = ldsf; LAS float* Pim = ldsf + 4608; LAS float* KZr = ldsf + 9216; LAS float* KZi = ldsf + 9344;
    LAS float* Bre = ldsf + 9472; LAS float* Bim = ldsf + 10496; LAS float* Cre = ldsf + 11520; LAS float* Cim = ldsf + 13568;
    LAS float* KV = ldsf + 15616;
#define S5P(dir, pw, p) (((dir) * 64 + (p)) * 36 + (pw))
    for (int task = c.vb; task < 2 * 64 * 2; task += c.vg) {
        const int i = task >> 7, g = (task >> 1) & 63, hf = task & 1;
        __syncthreads();
        if (c.tid < 128) {
            const int dir = c.tid >> 6, p = c.tid & 63;
            const float a_re = c.in[IN_S5ARE][((i * 2 + dir) * 64 + g) * 64 + p], a_im = c.in[IN_S5AIM][((i * 2 + dir) * 64 + g) * 64 + p];
            const float dt = expf(c.in[IN_S5DT][(i * 2 + dir) * 64 + g]);
            const float lre = fminf(a_re, -1e-4f), lim = a_im, ea = lre * dt, eb = lim * dt;
            const float cb = cosf(eb), sb = sinf(eb), sh = sinf(0.5f * eb), mag = expf(ea);
            { float pr = 1.0f, pi = 0.0f; const float ar = mag * cb, ai = mag * sb;
                for (int dl = 0; dl <= 32; ++dl) { Pre[S5P(dir, dl, p)] = pr; Pim[S5P(dir, dl, p)] = pi; const float nr_ = pr * ar - pi * ai, ni_ = pr * ai + pi * ar; pr = nr_; pi = ni_; } }
            const float nr = expm1f(ea) * cb - 2.0f * sh * sh, ni = mag * sb, den = lre * lre + lim * lim;
            KZr[dir * 64 + p] = (nr * lre + ni * lim) / den; KZi[dir * 64 + p] = (ni * lre - nr * lim) / den;
        }
        for (int idx = c.tid; idx < 1024; idx += 512) { Bre[idx] = c.in[IN_S5BRE][(size_t)(i * 64 + g) * 1024 + idx]; Bim[idx] = c.in[IN_S5BIM][(size_t)(i * 64 + g) * 1024 + idx]; }
        for (int idx = c.tid; idx < 2048; idx += 512) { const int dir = idx >> 10, rem = idx & 1023;
            Cre[idx] = c.in[IN_S5CRE][((size_t)(i * 2 + dir) * 64 + g) * 1024 + rem]; Cim[idx] = c.in[IN_S5CIM][((size_t)(i * 2 + dir) * 64 + g) * 1024 + rem]; }
        __syncthreads();
        {
            const int dir = c.tid >> 8, ko = (c.tid >> 4) & 15, ki = c.tid & 15;
            float acc[32];
#pragma unroll
            for (int dl = 0; dl < 32; ++dl) acc[dl] = 0.f;
            for (int p = 0; p < 64; ++p) {
                const float kr = KZr[dir * 64 + p], kq = KZi[dir * 64 + p], br = Bre[p * 16 + ki], bi = Bim[p * 16 + ki], cr = Cre[(dir * 16 + ko) * 64 + p], ci = Cim[(dir * 16 + ko) * 64 + p];
                const float gr = kr * br - kq * bi, gi = kr * bi + kq * br, tr = cr * gr - ci * gi, ti = cr * gi + ci * gr;
#pragma unroll
                for (int d4 = 0; d4 < 8; ++d4) { const f32x4 pr = *(const LAS f32x4*)(Pre + S5P(dir, 4 * d4, p)), pi = *(const LAS f32x4*)(Pim + S5P(dir, 4 * d4, p));
                    acc[4 * d4] += tr * pr.x - ti * pi.x; acc[4 * d4 + 1] += tr * pr.y - ti * pi.y; acc[4 * d4 + 2] += tr * pr.z - ti * pi.z; acc[4 * d4 + 3] += tr * pr.w - ti * pi.w; }
            }
#pragma unroll
            for (int dl = 0; dl < 32; ++dl) KV[((dir * 32 + dl) * 16 + ko) * 16 + ki] = acc[dl];
        }
        __syncthreads();
        unsigned* TV = (unsigned*)(c.ws + WS_TV) + ((size_t)(i * 64 + g) * 512 * 768) / 2;
        const float* dsk = c.in[IN_S5D] + (size_t)i * D + 16 * g;
        if (c.tid < 384) {
            const int kp = c.tid, kk = 2 * kp;
            if (kk < 512) {
                const int j = kk >> 4, ki = kk & 15;
                for (int it = 16 * hf; it < 16 * hf + 16; ++it) {
                    const int dl = it > j ? it - j : j - it, dir = it > j ? 0 : 1;
                    for (int ko = 0; ko < 16; ++ko) {
                        float v0, v1;
                        if (it != j) { v0 = KV[((dir * 32 + dl) * 16 + ko) * 16 + ki]; v1 = KV[((dir * 32 + dl) * 16 + ko) * 16 + ki + 1]; }
                        else { v0 = KV[(ko) * 16 + ki] + KV[((32) * 16 + ko) * 16 + ki] + (ko == ki ? dsk[ko] : 0.f); v1 = KV[(ko) * 16 + ki + 1] + KV[((32) * 16 + ko) * 16 + ki + 1] + (ko == ki + 1 ? dsk[ko] : 0.f); }
                        TV[(size_t)(it * 16 + ko) * 384 + kp] = pg8::cvt_pk_bf16(v0, v1);
                    }
                }
            } else {
                const int q = kk - 512, dir = q >> 7, part = (q >> 6) & 1, p = q & 63;
                for (int it = 16 * hf; it < 16 * hf + 16; ++it) {
                    const int pw = dir == 0 ? it + 1 : 32 - it;
                    const float pr0 = Pre[S5P(dir, pw, p)], pi0 = Pim[S5P(dir, pw, p)], pr1 = Pre[S5P(dir, pw, p + 1)], pi1 = Pim[S5P(dir, pw, p + 1)];
                    for (int ko = 0; ko < 16; ++ko) {
                        const float cr0 = Cre[(dir * 16 + ko) * 64 + p], ci0 = Cim[(dir * 16 + ko) * 64 + p], cr1 = Cre[(dir * 16 + ko) * 64 + p + 1], ci1 = Cim[(dir * 16 + ko) * 64 + p + 1];
                        const float v0 = part == 0 ? (cr0 * pr0 - ci0 * pi0) : -(cr0 * pi0 + ci0 * pr0), v1 = part == 0 ? (cr1 * pr1 - ci1 * pi1) : -(cr1 * pi1 + ci1 * pr1);
                        TV[(size_t)(it * 16 + ko) * 384 + kp] = pg8::cvt_pk_bf16(v0, v1);
                    }
                }
            }
        }
        unsigned* WS5 = (unsigned*)(c.ws + WS_WS5) + ((size_t)(i * 64 + g) * 256 * 512) / 2;
        if (c.tid < 256) {
            const int kp = c.tid, kk = 2 * kp, j = kk >> 4, ki = kk & 15, dir = hf, pw = dir == 0 ? 31 - j : j;
            for (int pp = 0; pp < 128; ++pp) {
                const int part = pp >> 6, p = pp & 63;
                const float pr = Pre[S5P(dir, pw, p)], pi = Pim[S5P(dir, pw, p)], kr = KZr[dir * 64 + p], kq = KZi[dir * 64 + p];
                const float gr = pr * kr - pi * kq, gi = pr * kq + pi * kr, br0 = Bre[p * 16 + ki], bi0 = Bim[p * 16 + ki], br1 = Bre[p * 16 + ki + 1], bi1 = Bim[p * 16 + ki + 1];
                const float v0 = part == 0 ? (gr * br0 - gi * bi0) : (gr * bi0 + gi * br0), v1 = part == 0 ? (gr * br1 - gi * bi1) : (gr * bi1 + gi * br1);
                WS5[(size_t)(128 * hf + pp) * 256 + kp] = pg8::cvt_pk_bf16(v0, v1);
            }
        }
    }
#undef S5P
}
__device__ __forceinline__ void phase_s5_carry(const Ctx& c, int i) {
    const unsigned short* SL = (const unsigned short*)(c.ws + WS_SL); unsigned short* AS5 = (unsigned short*)(c.ws + WS_AS5);
    for (int id = c.gt; id < 64 * 8 * 2 * 64; id += c.ngt) {
        const int p = id & 63, dir = (id >> 6) & 1, b = (id >> 7) & 7, g = id >> 10;
        const float a_re = c.in[IN_S5ARE][((i * 2 + dir) * 64 + g) * 64 + p], a_im = c.in[IN_S5AIM][((i * 2 + dir) * 64 + g) * 64 + p];
        const float dt = expf(c.in[IN_S5DT][(i * 2 + dir) * 64 + g]);
        const float lre = fminf(a_re, -1e-4f), m32 = expf(lre * dt * 32.0f), an = a_im * dt * 32.0f, ar = m32 * cosf(an), ai = m32 * sinf(an);
        float xr = 0.f, xi = 0.f;
        for (int s0 = 0; s0 < 136; s0 += 17) {
            float sr[17], si[17]; size_t rr[17];
#pragma unroll
            for (int k = 0; k < 17; ++k) { const int st = s0 + k, cch = dir == 0 ? st : (st < 8 ? 7 - st : 143 - st);
                rr[k] = (size_t)g * 1280 + b * 136 + cch; sr[k] = __uint_as_float((unsigned)SL[rr[k] * 256 + dir * 128 + p] << 16); si[k] = __uint_as_float((unsigned)SL[rr[k] * 256 + dir * 128 + 64 + p] << 16); }
#pragma unroll
            for (int k = 0; k < 17; ++k) {
                unsigned short* xo = AS5 + rr[k] * 768 + 512 + dir * 128 + p;
                xo[0] = (unsigned short)(pg8::cvt_pk_bf16(xr, 0.f) & 0xffffu); xo[64] = (unsigned short)(pg8::cvt_pk_bf16(xi, 0.f) & 0xffffu);
                const float nxr = ar * xr - ai * xi + sr[k], nxi = ar * xi + ai * xr + si[k];
                xr = nxr; xi = nxi;
            }
        }
    }
}

__device__ __forceinline__ void cvt_item(const float* W, int ldw, int k0, int scol0, unsigned short* WT, int K, int drow0, LAS float* scr, int lane) {
    float wv[32];
#pragma unroll
    for (int i = 0; i < 32; ++i) wv[i] = W[(size_t)(k0 + 2 * i + (lane >> 5)) * ldw + scol0 + (lane & 31)];
#pragma unroll
    for (int i = 0; i < 32; ++i) scr[(2 * i + (lane >> 5)) * 33 + (lane & 31)] = wv[i];
    asm volatile("s_waitcnt lgkmcnt(0)" ::: "memory");
    const int cc = lane & 7;
#pragma unroll
    for (int j = 0; j < 4; ++j) { const int n = (lane >> 3) + 8 * j; const LAS float* s = scr + (8 * cc) * 33 + n;
        pg8::u32x4 o; o.x = pg8::cvt_pk_bf16(s[0 * 33], s[1 * 33]); o.y = pg8::cvt_pk_bf16(s[2 * 33], s[3 * 33]); o.z = pg8::cvt_pk_bf16(s[4 * 33], s[5 * 33]); o.w = pg8::cvt_pk_bf16(s[6 * 33], s[7 * 33]);
        *(pg8::u32x4*)(WT + (size_t)(drow0 + n) * K + k0 + 8 * cc) = o; }
    asm volatile("s_waitcnt lgkmcnt(0)" ::: "memory");
}
__device__ __forceinline__ void cvt_item8(const float* W, int ldw, int k0, int scol0, unsigned char* WT, int K, int drow0, LAS float* scr, int lane) {
    float wv[32];
#pragma unroll
    for (int i = 0; i < 32; ++i) wv[i] = W[(size_t)(k0 + 2 * i + (lane >> 5)) * ldw + scol0 + (lane & 31)];
#pragma unroll
    for (int i = 0; i < 32; ++i) scr[(2 * i + (lane >> 5)) * 33 + (lane & 31)] = wv[i] * pg8::W8_SCALE;
    asm volatile("s_waitcnt lgkmcnt(0)" ::: "memory");
    const int n = lane >> 1, kh = lane & 1; const LAS float* s = scr + (32 * kh) * 33 + n;
    unsigned w[8];
#pragma unroll
    for (int j = 0; j < 8; ++j) w[j] = pg8::pk4_fp8(s[(4 * j) * 33], s[(4 * j + 1) * 33], s[(4 * j + 2) * 33], s[(4 * j + 3) * 33]);
    unsigned char* o = WT + (size_t)(drow0 + n) * K + k0 + 32 * kh;
    *(pg8::u32x4*)o = (pg8::u32x4){w[0], w[1], w[2], w[3]}; *(pg8::u32x4*)(o + 16) = (pg8::u32x4){w[4], w[5], w[6], w[7]};
    asm volatile("s_waitcnt lgkmcnt(0)" ::: "memory");
}
__device__ __forceinline__ void cvt_moe_tile(const Ctx& c, LAS unsigned char* img, int id) {
    unsigned char* W13 = (unsigned char*)(c.ws + WS_W13); unsigned char* W2T = (unsigned char*)(c.ws + WS_W2);
    const int le = id / 192; int r = id - le * 192;
    const float* sp; int ldw, K; unsigned char* dst; int rowl;
    if (r < 128) { const int kt = r >> 4, pn = r & 15, half = c.lane >> 5, n4 = c.lane & 31;
        sp = (half ? c.in[IN_W3] : c.in[IN_W1]) + (size_t)le * D * FF + (size_t)(128 * kt + 16 * c.wave) * FF + 128 * pn + 4 * n4; ldw = FF; K = D;
        dst = W13 + (size_t)le * 4096 * D + (size_t)(256 * pn) * D + 128 * kt; rowl = 128 * half + 4 * n4;
    } else { r -= 128; const int kt = r >> 2, pn = r & 3;
        sp = c.in[IN_W2] + (size_t)le * FF * D + (size_t)(128 * kt + 16 * c.wave) * D + 256 * pn + 4 * c.lane; ldw = D; K = FF;
        dst = W2T + (size_t)le * D * FF + (size_t)(256 * pn) * FF + 128 * kt; rowl = 4 * c.lane; }
    f32x4 v[16];
#pragma unroll
    for (int q = 0; q < 16; ++q) v[q] = __builtin_nontemporal_load((const f32x4*)(sp + (size_t)q * ldw));
    __syncthreads();
#pragma unroll
    for (int j = 0; j < 4; ++j) {
        pg8::u32x4 w;
#pragma unroll
        for (int q4 = 0; q4 < 4; ++q4) w[q4] = pg8::pk4_fp8(v[4 * q4][j] * pg8::W8_SCALE, v[4 * q4 + 1][j] * pg8::W8_SCALE, v[4 * q4 + 2][j] * pg8::W8_SCALE, v[4 * q4 + 3][j] * pg8::W8_SCALE);
        const int row = rowl + j;
        *(LAS pg8::u32x4*)(img + row * 128 + ((c.wave ^ ((row >> 2) & 7)) * 16)) = w;
    }
    __syncthreads();
#pragma unroll
    for (int i4 = 0; i4 < 4; ++i4) { const int p = c.tid + 512 * i4, row = p >> 3, ch = p & 7;
        *(pg8::u32x4*)(dst + (size_t)row * K + 16 * ch) = *(const LAS pg8::u32x4*)(img + row * 128 + ((ch ^ ((row >> 2) & 7)) * 16)); }
}
constexpr int HS_N = 14, HS_L0 = 2304, HS_L3 = 3072;
enum { HK_OUT = 0, HK_TOPK, HK_GEMM2, HK_S1, HK_S3, HK_GLU };
__device__ __forceinline__ constexpr int host_gs(int L, int kind) {
    return L == 0 ? (kind == HK_OUT ? 0 : kind == HK_TOPK ? 1 : kind == HK_GEMM2 ? 2 : -1)
         : L == 1 ? (kind == HK_S1 ? 3 : kind == HK_S3 ? 4 : kind == HK_GLU ? 5 : kind == HK_TOPK ? 6 : kind == HK_GEMM2 ? 7 : -1)
         : L == 2 ? (kind == HK_OUT ? 8 : kind == HK_TOPK ? 9 : kind == HK_GEMM2 ? 10 : -1)
         : (kind == HK_S1 ? 11 : kind == HK_S3 ? 12 : kind == HK_TOPK ? 13 : -1);
}
__device__ __forceinline__ void host_slot(int gs, int& rem, int& quota) {
    constexpr int REM[HS_N] = {32, 128, 64, 64, 128, 64, 128, 64, 32, 128, 64, 64, 128, 128}, Q[HS_N] = {8, 4, 6, 3, 5, 3, 4, 5, 8, 4, 6, 3, 5, 4};
    rem = 0; quota = 0;
#pragma unroll
    for (int i = 0; i < HS_N; ++i) if (i == gs) { rem = REM[i]; quota = Q[i]; }
}
__device__ __forceinline__ int host_tile_id(int u) {
    if (u < HS_L0) return u;
    u -= HS_L0; if (u < 3072) return 3072 + u;
    u -= 3072; if (u < 3072) return 2 * 3072 + u;
    u -= 3072; if (u < HS_L3) return 3 * 3072 + u;
    return -1;
}
__device__ __forceinline__ void hosted_cvt(const Ctx& c, LAS unsigned char* img, int L, int kind) {
    if (gridDim.x != 256) return;
    const int gs = host_gs(L, kind);
    if (gs < 0) return;
    int off = 0;
    for (int s = 0; s < gs; ++s) { int r0, q0; host_slot(s, r0, q0); off += (256 - r0) * q0; }
    int rem, q; host_slot(gs, rem, q);
    if ((int)blockIdx.x < rem) return;
    const int idle = 256 - rem, rank = (int)blockIdx.x - rem;
    for (int k = 0; k < q; ++k) { const int id = host_tile_id(off + rank + k * idle); if (id >= 0) cvt_moe_tile(c, img, id); }
    __syncthreads();
}
__device__ __forceinline__ void phase_cvt_moe(const Ctx& c, LAS float* ldsf) {
    LAS unsigned char* img = (LAS unsigned char*)ldsf;
    const int G = gridDim.x;
    if (G == 256) {
        const int n0 = 3072 - HS_L0, n3 = 3072 - HS_L3;
        for (int j = c.vb; j < n0 + n3; j += c.vg) cvt_moe_tile(c, img, j < n0 ? HS_L0 + j : 3 * 3072 + HS_L3 + (j - n0));
    } else {
        for (int j = c.vb; j < DEPTH * 3072; j += c.vg) cvt_moe_tile(c, img, j);
    }
    __syncthreads();
    LAS float* scr = ldsf + c.wave * (64 * 33);
    unsigned short* WIN = (unsigned short*)(c.ws + WS_WIN); unsigned short* WOUT = (unsigned short*)(c.ws + WS_WOUT); unsigned short* WGLU = (unsigned short*)(c.ws + WS_WGLU);
    for (int id = c.gw; id < 2 * (1408 + 512 + 1024); id += c.ngw) {
        const int i = id / 2944; int r = id - i * 2944;
        if (r < 1408) { const int kb = r / 88, nb = r - kb * 88; cvt_item(c.in[IN_MIXIN] + (size_t)i * D * INW, INW, 64 * kb, 32 * nb, WIN + (size_t)i * INW * D, D, 32 * nb, scr, c.lane); }
        else if (r < 1920) { r -= 1408; const int kb = r >> 5, nb = r & 31; cvt_item(c.in[IN_MIXOUT] + (size_t)i * D * D, D, 64 * kb, 32 * nb, WOUT + (size_t)i * D * D, D, 32 * nb, scr, c.lane); }
        else { r -= 1920; const int kb = r >> 6, nb = r & 63, pn = nb >> 3, rr0 = (nb & 7) * 32;
            cvt_item8(c.in[IN_GLUW] + (size_t)i * D * 2048, 2048, 64 * kb, (rr0 < 128 ? 0 : 1024) + 128 * pn + (rr0 & 127), (unsigned char*)WGLU + (size_t)i * 2048 * D, D, 32 * nb, scr, c.lane); }
    }
}

__global__ void __launch_bounds__(512, 2) fwd(Args args) {
    extern __shared__ __attribute__((aligned(16))) unsigned char lds[];
    Ctx c; c.in = args.in; c.out = args.out; c.ws = args.ws;
    c.wave = __builtin_amdgcn_readfirstlane((int)threadIdx.x >> 6); c.lane = lane_id(); c.tid = c.wave * 64 + c.lane;
    c.gw = blockIdx.x * 8 + c.wave; c.ngw = gridDim.x * 8; c.gt = blockIdx.x * 512 + c.tid; c.ngt = gridDim.x * 512;
    LAS float* ldsf = (LAS float*)lds; LAS unsigned char* ldsb = (LAS unsigned char*)lds;
    volatile LAS unsigned* MISC = (volatile LAS unsigned*)((LAS unsigned char*)lds + MISC_OFF);
    if (c.tid < 32) MISC[c.tid] = 0u;
    __syncthreads();
    const int lo = args.ph_lo, hi = args.ph_hi;
    const bool one_launch = (hi - lo) > 1;
    XcdBarrier bar; bar.bar = (unsigned*)(c.ws + WS_CTL) + CW_BAR; bar.x = 0; bar.st = MISC + 8; bar.wave = c.wave;
    if (one_launch) bar = xcd_barrier_post((unsigned*)(c.ws + WS_CTL) + CW_BAR, MISC + 8);
#define IN(k) (lo <= (k) && (k) < hi)
#define SEAM(k) do { if ((k) + 1 < hi) xcd_barrier(bar); } while (0)
#define FRESH(cc) Ctx cc; unsigned zq; asm volatile("s_mov_b32 %0, 0" : "=s"(zq)); cc.ws = c.ws + zq; cc.out = c.out + zq; cc.in = (const float* const*)((const char*)c.in + zq); \
    { int lq = lane_id(); asm volatile("" : "+v"(lq)); cc.wave = c.wave + (int)zq; cc.lane = lq; cc.tid = cc.wave * 64 + lq; const int tq = cc.tid; cc.gw = blockIdx.x * 8 + cc.wave; cc.ngw = gridDim.x * 8; cc.gt = blockIdx.x * 512 + tq; cc.ngt = gridDim.x * 512; cc.vb = blockIdx.x; cc.vg = gridDim.x; } \
    const int Lq = L + (int)zq, iq = Lq >> 1; const float* MOD = (const float*)(cc.ws + WS_MOD); (void)MOD; (void)iq

    if (IN(PH_PRO)) { const int L = 0; FRESH(cc);
        if (blockIdx.x & 1) { phase_s5_ops(cc, ldsf); __syncthreads(); phase_pro(cc, ldsf); __syncthreads(); phase_cvt_moe(cc, ldsf); }
        else { phase_pro(cc, ldsf); __syncthreads(); phase_cvt_moe(cc, ldsf); __syncthreads(); phase_s5_ops(cc, ldsf); }
        SEAM(PH_PRO); }

#define LAYER_BODY(LL) { constexpr int L = LL; \
        const int pb = 1 + L * PH_PER_LAYER; \
        if (IN(pb + 0)) { FRESH(cc); if constexpr (L == 0) phase_norm1_first(cc); else phase_norm1<false, (L & 1) != 0>(cc, Lq); SEAM(pb + 0); } \
        if ((L & 1) == 0) { \
            if (IN(pb + 1)) { \
                FRESH(cc); \
                pg8::GOrder S; S.init(1, NROWS, INW, (int)gridDim.x, (int)blockIdx.x); \
                pg8::ADense al{(const pg8::bf16_t*)(cc.ws + WS_HB1), 0, nullptr, 0, D, 0, 64}; pg8::EpiBf16 ep{(pg8::bf16_t*)(cc.ws + WS_P), INW, 0}; \
                pg8::gemm_phase(ldsb, al, (const pg8::bf16_t*)(cc.ws + WS_WIN) + (size_t)iq * INW * D, 0, D, S, ep, cc.wave); SEAM(pb + 1); } \
            if (IN(pb + 2)) { FRESH(cc); phase_post(cc, iq, ldsb); SEAM(pb + 2); } \
            if (IN(pb + 4)) { FRESH(cc); phase_ret_prefix(cc, iq); \
                  \
                unsigned* cnt = (unsigned*)(cc.ws + WS_CTL) + CW_CNT + 64 * L; \
                asm volatile("s_waitcnt vmcnt(0)" ::: "memory"); __syncthreads(); \
                if (cc.tid == 0) { __builtin_amdgcn_fence(__ATOMIC_RELEASE, "agent"); asm volatile("s_waitcnt vmcnt(0)" ::: "memory"); (void)xb_add(cnt, 1u); } \
                phase_attention(cc, iq, (char*)lds); \
                if (cc.tid == 0) { unsigned* tb = (unsigned*)(cc.ws + WS_CTL) + CW_BAR; XB_SPIN(xb_ld(cnt) < gridDim.x, tb); __builtin_amdgcn_fence(__ATOMIC_ACQUIRE, "agent"); asm volatile("s_waitcnt vmcnt(0)" ::: "memory"); } \
                __syncthreads(); \
                phase_ret_main(cc, iq, ldsb); SEAM(pb + 4); } \
            if (IN(pb + 6)) { \
                FRESH(cc); \
                pg8::GOrder S; S.init(1, NROWS, D, (int)gridDim.x, (int)blockIdx.x); \
                pg8::ADense al{(const pg8::bf16_t*)(cc.ws + WS_MIX), 0, nullptr, 0, D, 0, 64}; pg8::EpiResid ep{(pg8::bf16_t*)(cc.ws + WS_X), MOD + (size_t)Lq * 9 * 6144}; \
                pg8::gemm_phase(ldsb, al, (const pg8::bf16_t*)(cc.ws + WS_WOUT) + (size_t)iq * D * D, 0, D, S, ep, cc.wave); hosted_cvt(cc, ldsb, L, HK_OUT); SEAM(pb + 6); } \
        } else { \
            if (IN(pb + 1)) { \
                FRESH(cc); \
                pg8::GOrder S; S.init(64, 1280, 256, (int)gridDim.x, (int)blockIdx.x); \
                pg8::ADense al{(const pg8::bf16_t*)(cc.ws + WS_AS5), (size_t)1280 * 768, nullptr, 0, 768, 0, 64}; pg8::EpiBf16 ep{(pg8::bf16_t*)(cc.ws + WS_SL), 256, (size_t)1280 * 256}; \
                pg8::gemm_phase(ldsb, al, (const pg8::bf16_t*)(cc.ws + WS_WS5) + (size_t)iq * 64 * 256 * 512, (size_t)256 * 512, 512, S, ep, cc.wave); hosted_cvt(cc, ldsb, L, HK_S1); SEAM(pb + 1); } \
            if (IN(pb + 2)) { FRESH(cc); phase_s5_carry(cc, iq); SEAM(pb + 2); } \
            if (IN(pb + 3)) { \
                FRESH(cc); \
                pg8::GOrder S; S.init(64, 1280, 512, (int)gridDim.x, (int)blockIdx.x); \
                pg8::ADense al{(const pg8::bf16_t*)(cc.ws + WS_AS5), (size_t)1280 * 768, nullptr, 0, 768, 0, 64}; pg8::EpiGeluFp8 ep{(unsigned char*)(cc.ws + WS_ZG), 512, (size_t)1280 * 512}; \
                pg8::gemm_phase(ldsb, al, (const pg8::bf16_t*)(cc.ws + WS_TV) + (size_t)iq * 64 * 512 * 768, (size_t)512 * 768, 768, S, ep, cc.wave); hosted_cvt(cc, ldsb, L, HK_S3); SEAM(pb + 3); } \
            if (IN(pb + 4)) { \
                FRESH(cc); \
                pg8::GOrder S; S.init(1, NROWS, 2048, (int)gridDim.x, (int)blockIdx.x, L == DEPTH - 1); \
                pg8::ADense al{(const pg8::bf16_t*)(cc.ws + WS_ZG), 0, nullptr, 0, 16, 1280 * 512, (size_t)8 * 1280 * 512}; pg8::EpiGluResid ep{(pg8::bf16_t*)(cc.ws + WS_X), MOD + (size_t)Lq * 9 * 6144, cc.in[IN_GLUB] + (size_t)iq * 2048}; \
                pg8::gemm_phase<true>(ldsb, al, (const unsigned char*)(cc.ws + WS_WGLU) + (size_t)iq * 2048 * D, 0, D, S, ep, cc.wave); hosted_cvt(cc, ldsb, L, HK_GLU); SEAM(pb + 4); } \
        } \
        if (IN(pb + 7)) { FRESH(cc); phase_norm2_router<L == DEPTH - 1>(cc, Lq, ldsf); SEAM(pb + 7); } \
        if (IN(pb + 8)) { FRESH(cc); phase_topk(cc, (LAS unsigned*)lds, L == DEPTH - 1 ? 128 : 256); __syncthreads(); hosted_cvt(cc, ldsb, L, HK_TOPK); SEAM(pb + 8); } \
        if (IN(pb + 9)) { \
            FRESH(cc); \
            pg8::GOrder S; S.init(NE, L == DEPTH - 1 ? NB * CAP_LAT : EROWS, 2 * FF, (int)gridDim.x, (int)blockIdx.x); \
            pg8::ADense al{(const pg8::bf16_t*)(cc.ws + WS_XS), (size_t)EROWS * D, nullptr, 0, D, 0, 128}; \
            pg8::EpiSwiglu ep{(unsigned char*)(cc.ws + WS_HID), FF, (size_t)EROWS * FF}; \
            pg8::gemm_phase<true>(ldsb, al, (const unsigned char*)(cc.ws + WS_W13) + (size_t)Lq * NE * 4096 * D, (size_t)4096 * D, D, S, ep, cc.wave); SEAM(pb + 9); } \
        if (IN(pb + 10)) { \
            FRESH(cc); \
            pg8::GOrder S; S.init(NE, L == DEPTH - 1 ? NB * CAP_LAT : EROWS, D, (int)gridDim.x, (int)blockIdx.x); \
            pg8::ADense al{(const pg8::bf16_t*)(cc.ws + WS_HID), (size_t)EROWS * FF, nullptr, 0, FF, 0, 128}; \
            pg8::EpiGate ep{(unsigned char*)(cc.ws + WS_Y), D, (size_t)EROWS * D, (const float*)(cc.ws + WS_SELGATE), EROWS}; \
            pg8::gemm_phase<true>(ldsb, al, (const unsigned char*)(cc.ws + WS_W2) + (size_t)Lq * NE * D * FF, (size_t)D * FF, FF, S, ep, cc.wave); hosted_cvt(cc, ldsb, L, HK_GEMM2); SEAM(pb + 10); } \
    }
    LAYER_BODY(0) LAYER_BODY(1) LAYER_BODY(2) LAYER_BODY(3)
#undef LAYER_BODY
    if (IN(PH_FIN)) { const int L = DEPTH; FRESH(cc); phase_norm1<true, false>(cc, DEPTH); }
#undef IN
#undef SEAM
}

static bool phase_valid(int ph) {
    if (ph == PH_PRO || ph == PH_FIN) return true;
    const int L = (ph - 1) / PH_PER_LAYER, k = (ph - 1) % PH_PER_LAYER;
    if (L & 1) return !(k >= 5 && k <= 6);
    return k != 3 && k != 5;
}
extern "C" void kernel_launch(void* const* d_in, const int* in_sizes, int n_in, void* d_out, int out_size, void* d_ws, size_t ws_size, hipStream_t stream) {
    static int grid = 0;
    if (grid == 0) {
        if (n_in != 27 || out_size != NB * T * D || ws_size < WS_END) { fprintf(stderr, "kernel_launch: unexpected shapes (n_in %d out %d ws %zu)\n", n_in, out_size, ws_size); grid = -1; return; }
        int dev = 0, cus = 0;
        if (hipGetDevice(&dev) != hipSuccess || hipDeviceGetAttribute(&cus, hipDeviceAttributeMultiprocessorCount, dev) != hipSuccess) { grid = -1; return; }
        if (hipFuncSetAttribute((const void*)fwd, hipFuncAttributeMaxDynamicSharedMemorySize, LDS_BYTES) != hipSuccess) { grid = -1; return; }
        int per_cu = 0;
        if (hipOccupancyMaxActiveBlocksPerMultiprocessor(&per_cu, (const void*)fwd, 512, LDS_BYTES) != hipSuccess || per_cu < 1) fprintf(stderr, "kernel_launch: occupancy query says %d\n", per_cu);
        (void)hipGetLastError();
        grid = cus;
    }
    if (grid < 0) return;
    if (hipMemsetAsync((char*)d_ws + WS_CTL, 0, CTL_ZERO_BYTES, stream) != hipSuccess) return;
    Args a{};
    for (int i = 0; i < 27; ++i) a.in[i] = (const float*)d_in[i];
    a.out = (float*)d_out; a.ws = (unsigned char*)d_ws;
#if MK_MULTI
    for (int ph = 0; ph < NPH; ++ph) {
        if (!phase_valid(ph)) continue;
        a.ph_lo = ph; a.ph_hi = ph + 1;
        hipLaunchKernelGGL(fwd, dim3(grid), dim3(512), LDS_BYTES, stream, a);
    }
#else
    a.ph_lo = 0; a.ph_hi = NPH;
    hipLaunchKernelGGL(fwd, dim3(grid), dim3(512), LDS_BYTES, stream, a);
#ifdef PROBE_PHASES
    { static const int probe[] = {PROBE_PHASES}; for (unsigned q = 0; q < sizeof(probe) / sizeof(probe[0]); ++q) { a.ph_lo = probe[q]; a.ph_hi = probe[q] + 1; hipLaunchKernelGGL(fwd, dim3(grid), dim3(512), LDS_BYTES, stream, a); } }
#endif
#endif
}
```

```cpp
#include <hip/hip_runtime.h>
#include <hip/hip_bf16.h>
#include <cstdio>
#include <cstdint>

#define GAS __attribute__((address_space(1)))
#define LAS __attribute__((address_space(3)))
typedef float f32x4 __attribute__((ext_vector_type(4)));
typedef float f32x2 __attribute__((ext_vector_type(2)));
typedef float f32x16 __attribute__((ext_vector_type(16)));

constexpr int NB = 8, T = 4096, D = 1024, CL = 256, RB = CL + T  , NROWS = NB * RB  ;
constexpr int DEPTH = 4, NE = 16, FF = 2048, INW = 2816;
constexpr int CAP_LAT = 512, CAP_CTX = 32, EROWS = NB * (CAP_LAT + CAP_CTX)  ;
constexpr float EPS = 1e-6f;
#ifndef MK_MULTI
#define MK_MULTI 0
#endif

constexpr size_t MiB = 1u << 20;
constexpr size_t WS_CTL = 0, CTL_ZERO_BYTES = 1 * MiB;
constexpr size_t WS_MOD = 1 * MiB;
constexpr size_t WS_ROPE = 2 * MiB;
constexpr size_t WS_SELROW = 3 * MiB;
constexpr size_t WS_SELGATE = 3 * MiB + 512 * 1024;
constexpr size_t WS_AFF = 4 * MiB;
constexpr size_t WS_SLOT = 7 * MiB;
constexpr size_t WS_X = 10 * MiB;
constexpr size_t WS_TV = 146 * MiB;
constexpr size_t WS_WS5 = 242 * MiB;
constexpr size_t WS_HB = 282 * MiB;
constexpr size_t WS_W13 = 350 * MiB;
constexpr size_t WS_W2 = 862 * MiB;
constexpr size_t WS_WIN = 1118 * MiB;
constexpr size_t WS_WOUT = 1130 * MiB;
constexpr size_t WS_WGLU = 1134 * MiB;
constexpr size_t WS_HB1 = 1144 * MiB;
constexpr size_t WS_BIG = 1212 * MiB;
constexpr size_t WS_P = WS_BIG;
constexpr size_t WS_RQ = WS_BIG + 374 * MiB;
constexpr size_t WS_RK = WS_BIG + 408 * MiB;
constexpr size_t WS_RV = WS_BIG + 442 * MiB;
constexpr size_t WS_ET = WS_BIG + 476 * MiB;
constexpr size_t WS_MIX = WS_BIG + 510 * MiB;
constexpr size_t WS_QA = WS_BIG + 578 * MiB;
constexpr size_t WS_KA = WS_BIG + 612 * MiB;
constexpr size_t WS_VA = WS_BIG + 621 * MiB;
constexpr size_t WS_U = WS_BIG + 630 * MiB;
constexpr size_t WS_AS5 = WS_BIG;
constexpr size_t WS_SL = WS_BIG + 120 * MiB;
constexpr size_t WS_ZG = WS_BIG + 200 * MiB;
constexpr size_t WS_HID = WS_BIG;
constexpr size_t WS_XS = WS_BIG + 136 * MiB;
constexpr size_t WS_Y = WS_BIG + 272 * MiB;
constexpr size_t WS_END = WS_BIG + 698 * MiB;
constexpr int CW_BAR = 4096, CW_CNT = 8192;

constexpr int LDS_BYTES = 147456;
constexpr int MISC_OFF = 131072 + 320;

constexpr int PH_PRO = 0, PH_PER_LAYER = 11, PH_FIN = 1 + DEPTH * PH_PER_LAYER, NPH = PH_FIN + 1;

#define XB_TMO      128
#define XB_XCNT(j)  (256  + 64 * (j))
#define XB_XSUB(j)  (1280 + 64 * (j))
#define XB_XGEN(j)  (2304 + 64 * (j))
#define XB_TOP      3328
#define XB_TOPGEN   3392
#define XCD_BAR_WORDS 3456
#define XB_SPIN_CAP (1u << 22)

__device__ __forceinline__ unsigned xb_ld(unsigned* p)              { return __hip_atomic_load(p, __ATOMIC_RELAXED, __HIP_MEMORY_SCOPE_AGENT); }
__device__ __forceinline__ unsigned xb_add(unsigned* p, unsigned v) { return __hip_atomic_fetch_add(p, v, __ATOMIC_RELAXED, __HIP_MEMORY_SCOPE_AGENT); }
__device__ __forceinline__ unsigned xb_xcc_id() { return (unsigned)__builtin_amdgcn_s_getreg((3 << 11) | 20) & 0xFu; }
#define XB_SPIN(cond, bar) do { unsigned _sp = 0; while (cond) { __builtin_amdgcn_s_sleep(1); \
    if ((++_sp & 255u) == 0u) { if (xb_ld(&(bar)[XB_TMO])) break; if (_sp > XB_SPIN_CAP) { atomicAdd(&(bar)[XB_TMO], 1u); break; } } } } while (0)

__device__ __forceinline__ int lane_id() { int l; asm volatile("v_mbcnt_lo_u32_b32 %0, -1, 0\n\tv_mbcnt_hi_u32_b32 %0, -1, %0" : "=v"(l)); return l; }
struct XcdBarrier { unsigned* bar; unsigned x; volatile LAS unsigned* st; int wave; };

__device__ __forceinline__ XcdBarrier xcd_barrier_post(unsigned* bar, volatile LAS unsigned* st) {
    XcdBarrier b; b.bar = bar; b.x = xb_xcc_id(); b.st = st; b.wave = __builtin_amdgcn_readfirstlane((int)threadIdx.x >> 6);
    if (threadIdx.x == 0) (void)xb_add(&bar[XB_XCNT(b.x)], 1u);
    return b;
}
__device__ __forceinline__ void xcd_barrier_complete(unsigned* bar, unsigned x, unsigned& nloc, unsigned& nx) {
    const unsigned G = gridDim.x * gridDim.y * gridDim.z;
    unsigned sum, cnt, mine, sp = 0u;
    for (;;) {
        sum = 0u; cnt = 0u; mine = 0u;
#pragma unroll
        for (unsigned j = 0; j < 16; ++j) { const unsigned c = xb_ld(&bar[XB_XCNT(j)]); sum += c; cnt += (c > 0u) ? 1u : 0u; mine = (j == x) ? c : mine; }
        if (sum == G) break;
        __builtin_amdgcn_s_sleep(1);
        if ((++sp & 255u) == 0u) { if (xb_ld(&bar[XB_TMO])) break; if (sp > XB_SPIN_CAP) { atomicAdd(&bar[XB_TMO], 1u); break; } }
    }
    nloc = mine > 0u ? mine : 1u; nx = cnt > 0u ? cnt : 1u;
}
__device__ __forceinline__ void xcd_barrier(const XcdBarrier& b) {
    asm volatile("s_waitcnt vmcnt(0)" ::: "memory");
    __syncthreads();
    if (b.wave == 0 && lane_id() == 0) {
        unsigned* bar = b.bar;
        __builtin_amdgcn_s_waitcnt(0);
        unsigned nloc = b.st[0], nx = b.st[1];
        if (nloc == 0u) { xcd_barrier_complete(bar, b.x, nloc, nx); b.st[0] = nloc; b.st[1] = nx; }
        const unsigned old = xb_add(&bar[XB_XSUB(b.x)], 1u);
        const unsigned gen = old / nloc;
        if (old + 1u == (gen + 1u) * nloc) {
            __builtin_amdgcn_fence(__ATOMIC_RELEASE, "agent");
            asm volatile("s_waitcnt vmcnt(0)" ::: "memory");
            const unsigned og = xb_add(&bar[XB_TOP], 1u);
            const unsigned tg = og / nx;
            if (og + 1u == (tg + 1u) * nx) xb_add(&bar[XB_TOPGEN], 1u);
            else XB_SPIN(xb_ld(&bar[XB_TOPGEN]) == tg, bar);
            __builtin_amdgcn_fence(__ATOMIC_ACQUIRE, "agent");
            xb_add(&bar[XB_XGEN(b.x)], 1u);
            asm volatile("s_waitcnt vmcnt(0)" ::: "memory");
        } else {
            XB_SPIN(xb_ld(&bar[XB_XGEN(b.x)]) == gen, bar);
            __builtin_amdgcn_fence(__ATOMIC_ACQUIRE, "agent");
            asm volatile("s_waitcnt vmcnt(0)" ::: "memory");
        }
    }
    __syncthreads();
}

struct Args { const float* in[27]; float* out; unsigned char* ws; int ph_lo, ph_hi; };

struct Ctx {
    const float* const* in; float* out; unsigned char* ws;
    int tid, lane, wave, gw, ngw, gt, ngt;
    int vb, vg;
};
enum { IN_X = 0, IN_C, IN_CTX, IN_CCTX, IN_MODW, IN_MODB, IN_NORMG, IN_MIXIN, IN_MIXOUT, IN_RETRATE, IN_RETGN, IN_QKG,
       IN_S5ARE, IN_S5AIM, IN_S5DT, IN_S5BRE, IN_S5BIM, IN_S5CRE, IN_S5CIM, IN_S5D, IN_GLUW, IN_GLUB, IN_ROUTER, IN_W1, IN_W3, IN_W2, IN_FNG };

__device__ __forceinline__ float wave_sum(float v) {
#pragma unroll
    for (int o = 1; o < 64; o <<= 1) v += __shfl_xor(v, o);
    return v;
}
__device__ __forceinline__ float sigmoidf_(float x) { return 1.0f / (1.0f + expf(-x)); }
__device__ __forceinline__ float siluf_(float x) { return x * sigmoidf_(x); }
__device__ __forceinline__ float gelu_tanh(float x) { const float u = 0.7978845608028654f * (x + 0.044715f * x * x * x); return 0.5f * x * (1.0f + tanhf(u)); }
__device__ __forceinline__ const float* modp(const Ctx& c, int L, int j, int chunk) { return (const float*)(c.ws + WS_MOD) + ((size_t)(L * 9 + j) * 6 + chunk) * 1024; }
__device__ __forceinline__ int row_j(int row) { const int b = row / RB, s = row - b * RB; return s < CL ? 8 : b; }

__device__ __forceinline__ float reduce16(const float (&v)[16], int lane) {
    float a[8], b[4], c2[2], d;
    const bool b5 = (lane & 32) != 0, b4 = (lane & 16) != 0, b3 = (lane & 8) != 0, b2 = (lane & 4) != 0;
#pragma unroll
    for (int i = 0; i < 8; ++i) { const float keep = b5 ? v[8 + i] : v[i], send = b5 ? v[i] : v[8 + i]; a[i] = keep + __shfl_xor(send, 32); }
#pragma unroll
    for (int i = 0; i < 4; ++i) { const float keep = b4 ? a[4 + i] : a[i], send = b4 ? a[i] : a[4 + i]; b[i] = keep + __shfl_xor(send, 16); }
#pragma unroll
    for (int i = 0; i < 2; ++i) { const float keep = b3 ? b[2 + i] : b[i], send = b3 ? b[i] : b[2 + i]; c2[i] = keep + __shfl_xor(send, 8); }
    { const float keep = b2 ? c2[1] : c2[0], send = b2 ? c2[0] : c2[1]; d = keep + __shfl_xor(send, 4); }
    d += __shfl_xor(d, 2); d += __shfl_xor(d, 1);
    return d;
}
__device__ __forceinline__ int reduce16_k(int lane) { return ((lane >> 5) & 1) * 8 + ((lane >> 4) & 1) * 4 + ((lane >> 3) & 1) * 2 + ((lane >> 2) & 1); }

namespace pg8 {
typedef unsigned short bf16_t;
typedef short bf16x8 __attribute__((ext_vector_type(8)));
typedef unsigned u32x4 __attribute__((ext_vector_type(4)));
typedef unsigned u32x2 __attribute__((ext_vector_type(2)));
typedef int v8i32 __attribute__((ext_vector_type(8)));
typedef int v4i32 __attribute__((ext_vector_type(4)));
constexpr int BM = 256, BK = 64, HALF = 128, HTB = HALF * BK * 2, STAGE_BYTES = 8 * HTB, NXCD = 8, WGM = 8;
__host__ __device__ __forceinline__ int lds_byte(int r, int c) { const int st = (r >> 4) * 2 + (c >> 5), rr = r & 15, cc = c & 31, ob = rr * 64 + cc * 2; return st * 1024 + (ob ^ (((ob >> 9) & 1) << 5)); }
__host__ __device__ __forceinline__ void stage_rc(int b, int& R, int& C) { const int st = b / 1024, sb = b % 1024, swz = sb ^ (((sb >> 9) & 1) << 5); R = (st >> 1) * 16 + swz / 64; C = (st & 1) * 32 + (swz % 64) / 2; }
__host__ __device__ __forceinline__ int perm32(int rho) { const int n = rho >> 4, i = rho & 15; return 8 * (i >> 2) + 4 * n + (i & 3); }
__device__ __forceinline__ unsigned cvt_pk_bf16(float lo, float hi) { unsigned r; asm volatile("v_cvt_pk_bf16_f32 %0, %1, %2" : "=v"(r) : "v"(lo), "v"(hi)); return r; }

__device__ __forceinline__ unsigned pk4_fp8(float a, float b, float c, float d) {
    a = __builtin_amdgcn_fmed3f(a, -448.f, 448.f); b = __builtin_amdgcn_fmed3f(b, -448.f, 448.f); c = __builtin_amdgcn_fmed3f(c, -448.f, 448.f); d = __builtin_amdgcn_fmed3f(d, -448.f, 448.f);
    unsigned w = 0u; w = (unsigned)__builtin_amdgcn_cvt_pk_fp8_f32(a, b, (int)w, false); w = (unsigned)__builtin_amdgcn_cvt_pk_fp8_f32(c, d, (int)w, true); return w; }
__device__ __forceinline__ f32x4 bf4_to_f32(u32x2 w) { return (f32x4){__uint_as_float(w.x << 16), __uint_as_float(w.x & 0xffff0000u), __uint_as_float(w.y << 16), __uint_as_float(w.y & 0xffff0000u)}; }
__device__ __forceinline__ u32x2 f32_to_bf4(f32x4 v) { return (u32x2){cvt_pk_bf16(v.x, v.y), cvt_pk_bf16(v.z, v.w)}; }
constexpr float W8_SCALE = 32.0f, W8_INV = 1.0f / 32.0f;
struct Unit { int pm, pn, g; };
struct GOrder {
    int nM, nN, per, nwg, G, c, skipctx;
    __device__ __forceinline__ void init(int groups, int M, int N, int G_, int c_, int skipctx_ = 0) { nM = M / BM; if (skipctx_) nM -= nM / 17; nN = N / BM; per = nM * nN; nwg = groups * per; G = G_; c = c_; skipctx = skipctx_; }
    __device__ __forceinline__ bool next(int i, Unit& u) const {
        const long L = (long)i * G + c; if (L >= nwg) return false;
        int wgid = (int)L; { const int q = nwg / NXCD, r = nwg % NXCD, xcd = wgid % NXCD, off = wgid / NXCD; wgid = (xcd < r ? xcd * (q + 1) : r * (q + 1) + (xcd - r) * q) + off; }
        u.g = wgid / per; const int w = wgid - u.g * per;
        const int nig = WGM * nN, gid = w / nig, fm = gid * WGM, gsz = (nM - fm) < WGM ? (nM - fm) : WGM;
        u.pm = fm + ((w % nig) % gsz); u.pn = (w % nig) / gsz; if (skipctx) u.pm += (u.pm >> 4) + 1;
        return true;
    }
};
struct ADense  { static constexpr bool GATHER = false; const bf16_t* A; size_t gstride; const int* idx; int rpg; unsigned rowpitch; unsigned cgrp; size_t kstep; };
struct AGather { static constexpr bool GATHER = true;  const bf16_t* A; size_t gstride; const int* idx; int rpg; unsigned rowpitch; unsigned cgrp; size_t kstep; };

template <bool FP8 = false, class Epi, class ALoc>
__device__ __forceinline__ void gemm_phase(LAS unsigned char* lds, const ALoc AL, const void* Bt, size_t gstrideB, int K, const GOrder& S, const Epi& E, int wave_) {
    constexpr bool GATHER = ALoc::GATHER; constexpr unsigned ESZ = FP8 ? 1u : 2u;
    const int wid = wave_, lane = lane_id(), tid = wid * 64 + lane, wr = wid >> 2, wc = wid & 3, fr = lane & 15, fq = lane >> 4;
    const int nt = (int)((unsigned)K * ESZ / 128u);
    unsigned voffA[2], voffB[2];
#pragma unroll
    for (int i = 0; i < 2; ++i) { int R, C; stage_rc(tid * 16 + i * 8192, R, C); const int Rb = Epi::PERM ? ((R & ~31) + perm32(R & 31)) : R;
        const unsigned cbytes = AL.cgrp ? (FP8 ? (unsigned)(C >> 3) * AL.cgrp : ((unsigned)(C >> 4) * AL.cgrp + (unsigned)(C & 15)) * 2u) : (unsigned)C * 2u;
        voffA[i] = (unsigned)R * AL.rowpitch * ESZ + cbytes; voffB[i] = (unsigned)Rb * (unsigned)K * ESZ + (unsigned)C * 2u; }
    const size_t kstep = 128, kstepA = AL.kstep * ESZ;
    const size_t hstep = (size_t)HALF * K * ESZ;
    const size_t hstepA = GATHER ? 0 : (size_t)HALF * AL.rowpitch * ESZ, tstepA = 2 * (size_t)HALF * AL.rowpitch * ESZ;
    const size_t tstep = 2 * hstep;
    const unsigned ldsw = (unsigned)wid * 1024u;
    const int aoff0 = lds_byte(wr * 64 + fr, fq * 8);
    const int boff0 = lds_byte(wc * 32 + fr, fq * 8);
    constexpr int KOFF = 1024;
    unsigned vAc[2][2], vAn[2][2];
#define PG8_SA(b, h) (((b) * 2 + (h)) * HTB)
#define PG8_SB(b, h) ((4 + (b) * 2 + (h)) * HTB)
#define PG8_SBR(b, h) (((b) * 2 + (h)) * HTB)
#define PG8_OPQ(x) do { if constexpr (FP8) asm volatile("" : "+v"(x)); } while (0)
#define PG8_STAGE(bufoff, gbase, voff) do { _Pragma("unroll") for (int _i = 0; _i < 2; ++_i) { unsigned _o = (voff)[_i]; PG8_OPQ(_o); \
        __builtin_amdgcn_global_load_lds((const unsigned*)((const char*)(gbase) + _o), (LAS unsigned*)(lds + (bufoff) + ldsw + _i * 8192), 16, 0, 0); } } while (0)
#define PG8_STAGE_A(bufoff, gbase, h, nx) do { _Pragma("unroll") for (int _i = 0; _i < 2; ++_i) { \
        unsigned _o = GATHER ? ((nx) ? vAn[h][_i] : vAc[h][_i]) : voffA[_i]; PG8_OPQ(_o); \
        __builtin_amdgcn_global_load_lds((const unsigned*)((const char*)(gbase) + (size_t)(h) * hstepA + _o), (LAS unsigned*)(lds + (bufoff) + ldsw + _i * 8192), 16, 0, 0); } } while (0)
#define PG8_GIDX(u, v) do { if (GATHER) { int _t = tid; asm volatile("" : "+v"(_t));   \
        _Pragma("unroll") for (int _i = 0; _i < 2; ++_i) { int _R, _C; stage_rc(_t * 16 + _i * 8192, _R, _C); \
        _Pragma("unroll") for (int _h = 0; _h < 2; ++_h) v[_h][_i] = (unsigned)AL.idx[(u).g * AL.rpg + (u).pm * BM + _h * HALF + _R] * (AL.rowpitch * ESZ) + (unsigned)_C * 2u; } } } while (0)
#define PG8_ABASE(u) ((const char*)AL.A + (GATHER ? (size_t)0 : ((size_t)(u).g * AL.gstride * ESZ + (size_t)(u).pm * tstepA)))
#define PG8_BBASE(u) ((const char*)Bt + (size_t)(u).g * gstrideB * ESZ + (size_t)(u).pn * tstep)
#define PG8_LDA(dst, b, h) do { _Pragma("unroll") for (int m = 0; m < 4; ++m) _Pragma("unroll") for (int k = 0; k < 2; ++k) dst[m][k] = *(const LAS bf16x8*)(lds + PG8_SA(b, h) + aoff0 + k * KOFF + m * 2048); } while (0)
#define PG8_LDB(dst, b, h) do { _Pragma("unroll") for (int n = 0; n < 2; ++n) _Pragma("unroll") for (int k = 0; k < 2; ++k) dst[n][k] = *(const LAS bf16x8*)(lds + PG8_SB(b, h) + boff0 + k * KOFF + n * 2048); } while (0)
#define PG8_CAT8(x) __builtin_shufflevector(__builtin_bit_cast(v4i32, x[0]), __builtin_bit_cast(v4i32, x[1]), 0, 1, 2, 3, 4, 5, 6, 7)
#define PG8_MMA(ai, bj, At, Bt_) do { __builtin_amdgcn_s_setprio(1); _Pragma("unroll") for (int m = 0; m < 4; ++m) _Pragma("unroll") for (int n = 0; n < 2; ++n) { \
        if constexpr (FP8) acc[ai][bj][m][n] = __builtin_amdgcn_mfma_scale_f32_16x16x128_f8f6f4(PG8_CAT8(Bt_[n]), PG8_CAT8(At[m]), acc[ai][bj][m][n], 0, 0, 0, 0x7f7f7f7f, 0, 0x7f7f7f7f); \
        else { _Pragma("unroll") for (int k = 0; k < 2; ++k) acc[ai][bj][m][n] = __builtin_amdgcn_mfma_f32_16x16x32_bf16(Bt_[n][k], At[m][k], acc[ai][bj][m][n], 0, 0, 0); } } \
        __builtin_amdgcn_s_setprio(0); } while (0)
#define PG8_WAIT_V(n) asm volatile("s_waitcnt vmcnt(" #n ")" ::: "memory")
#define PG8_WAIT_L(n) asm volatile("s_waitcnt lgkmcnt(" #n ")" ::: "memory")
#define PG8_BAR __builtin_amdgcn_s_barrier()
#define PG8_SCHED __builtin_amdgcn_sched_barrier(0)
    Unit cur, nxt; int ui = 0;
    if (!S.next(0, cur)) return;
    PG8_GIDX(cur, vAc);
    f32x4 acc[2][2][4][2];
#pragma unroll
    for (int a = 0; a < 2; ++a)
#pragma unroll
        for (int b = 0; b < 2; ++b)
#pragma unroll
            for (int m = 0; m < 4; ++m)
#pragma unroll
                for (int n = 0; n < 2; ++n) acc[a][b][m][n] = (f32x4){0.f, 0.f, 0.f, 0.f};
    bf16x8 At[4][2], B0[2][2], B1[2][2];
    const char* cA = PG8_ABASE(cur); const char* cB = PG8_BBASE(cur);
    PG8_STAGE(PG8_SB(0, 0), cB, voffB); PG8_STAGE(PG8_SB(0, 1), cB + hstep, voffB); PG8_STAGE_A(PG8_SA(0, 0), cA, 0, false); PG8_STAGE_A(PG8_SA(0, 1), cA, 1, false);
    if (wr == 1) PG8_BAR;
    PG8_WAIT_V(2); PG8_BAR;
    PG8_STAGE(PG8_SB(1, 0), cB + kstep, voffB); PG8_STAGE_A(PG8_SA(1, 0), cA + kstepA, 0, false); PG8_STAGE(PG8_SB(1, 1), cB + hstep + kstep, voffB);
    PG8_WAIT_V(6); PG8_BAR;
    for (;;) {
        const bool has_next = S.next(ui + 1, nxt);
        if (GATHER) { if (has_next) { PG8_GIDX(nxt, vAn); } }
        const char* nA = has_next ? PG8_ABASE(nxt) : cA; const char* nB = has_next ? PG8_BBASE(nxt) : cB;
        for (int t = 0; t < nt; t += 2) {
            const bool last = (t == nt - 2), lastn = last && has_next;
            const char* a1 = cA + (size_t)(t + 1) * kstepA;
            const char* a2 = last ? nA : cA + (size_t)(t + 2) * kstepA; const char* b2 = last ? nB : cB + (size_t)(t + 2) * kstep;
            const char* a3 = a2 + kstepA; const char* b3 = b2 + kstep;
            PG8_LDB(B0, 0, 0); PG8_LDB(B1, 0, 1); PG8_SCHED; PG8_LDA(At, 0, 0); PG8_STAGE_A(PG8_SA(1, 1), a1, 1, false);
            PG8_WAIT_V(8); PG8_WAIT_L(0); PG8_BAR; PG8_MMA(0, 0, At, B0); PG8_MMA(0, 1, At, B1); PG8_BAR; PG8_SCHED;
            PG8_LDA(At, 0, 1); PG8_STAGE(PG8_SB(0, 0), b2, voffB); PG8_STAGE(PG8_SB(0, 1), b2 + hstep, voffB); PG8_STAGE_A(PG8_SA(0, 0), a2, 0, lastn);
            PG8_WAIT_V(8); PG8_WAIT_L(0); PG8_BAR; PG8_MMA(1, 0, At, B0); PG8_MMA(1, 1, At, B1); PG8_BAR; PG8_SCHED;
            PG8_LDB(B0, 1, 0); PG8_LDB(B1, 1, 1); PG8_SCHED; PG8_LDA(At, 1, 0); PG8_STAGE_A(PG8_SA(0, 1), a2, 1, lastn);
            PG8_WAIT_V(8); PG8_WAIT_L(0); PG8_BAR; PG8_MMA(0, 0, At, B0); PG8_MMA(0, 1, At, B1); PG8_BAR; PG8_SCHED;
            PG8_LDA(At, 1, 1); PG8_STAGE(PG8_SB(1, 0), b3, voffB); PG8_STAGE(PG8_SB(1, 1), b3 + hstep, voffB); PG8_STAGE_A(PG8_SA(1, 0), a3, 0, lastn);
            PG8_WAIT_V(8); PG8_WAIT_L(0); PG8_BAR; PG8_MMA(1, 0, At, B0); PG8_MMA(1, 1, At, B1); PG8_BAR; PG8_SCHED;
        }
        if (wr == 0) PG8_BAR;
        E(acc, cur, wr, wc, fr, fq);
        if (!has_next) break;
#pragma unroll
        for (int a = 0; a < 2; ++a)
#pragma unroll
            for (int b = 0; b < 2; ++b)
#pragma unroll
                for (int m = 0; m < 4; ++m)
#pragma unroll
                    for (int n = 0; n < 2; ++n) acc[a][b][m][n] = (f32x4){0.f, 0.f, 0.f, 0.f};
        cur = nxt; cA = nA; cB = nB; ++ui;
        if (GATHER) {
#pragma unroll
            for (int _h = 0; _h < 2; ++_h)
#pragma unroll
                for (int _i = 0; _i < 2; ++_i) vAc[_h][_i] = vAn[_h][_i]; }
        if (wr == 1) PG8_BAR;
    }
    PG8_WAIT_V(0);
    PG8_BAR;
#undef PG8_SA
#undef PG8_SB
#undef PG8_SBR
#undef PG8_STAGE
#undef PG8_OPQ
#undef PG8_STAGE_A
#undef PG8_GIDX
#undef PG8_ABASE
#undef PG8_BBASE
#undef PG8_LDA
#undef PG8_CAT8
#undef PG8_LDB
#undef PG8_MMA
#undef PG8_WAIT_V
#undef PG8_WAIT_L
#undef PG8_BAR
#undef PG8_SCHED
}

__device__ __forceinline__ float fast_sigmoid(float x) { return __builtin_amdgcn_rcpf(1.0f + __builtin_amdgcn_exp2f(-1.4426950408889634f * x)); }
struct EpiSwiglu {
    static constexpr bool PERM = true;
    unsigned char* O; int ldc; size_t gstride;
    __device__ __forceinline__ void operator()(const f32x4 (&acc)[2][2][4][2], const Unit& u, int wr, int wc, int fr, int fq) const {
        const int row0 = u.pm * BM + wr * 64 + fr, col0 = u.pn * HALF + wc * 32 + 8 * fq;
        unsigned char* base = O + (size_t)u.g * gstride;
#pragma unroll
        for (int ai = 0; ai < 2; ++ai)
#pragma unroll
            for (int m = 0; m < 4; ++m) { unsigned char* rowp = base + (size_t)(row0 + ai * HALF + m * 16) * ldc + col0;
                f32x4 o[2];
#pragma unroll
                for (int n = 0; n < 2; ++n) {
                    const f32x4 a = acc[ai][0][m][n] * W8_INV, b = acc[ai][1][m][n] * W8_INV, t = a * (-1.4426950408889634f);
                    f32x4 e; e.x = __builtin_amdgcn_exp2f(t.x); e.y = __builtin_amdgcn_exp2f(t.y); e.z = __builtin_amdgcn_exp2f(t.z); e.w = __builtin_amdgcn_exp2f(t.w);
                    e = e + 1.0f;
                    f32x4 r; r.x = __builtin_amdgcn_rcpf(e.x); r.y = __builtin_amdgcn_rcpf(e.y); r.z = __builtin_amdgcn_rcpf(e.z); r.w = __builtin_amdgcn_rcpf(e.w);
                    o[n] = (a * b) * r; }
                *(u32x2*)rowp = (u32x2){pk4_fp8(o[0].x, o[0].y, o[0].z, o[0].w), pk4_fp8(o[1].x, o[1].y, o[1].z, o[1].w)}; }
    }
};
struct EpiBf16 {
    static constexpr bool PERM = true;
    bf16_t* O; int ldc; size_t gstride;
    __device__ __forceinline__ void operator()(const f32x4 (&acc)[2][2][4][2], const Unit& u, int wr, int wc, int fr, int fq) const {
        const int row0 = u.pm * BM + wr * 64 + fr, col0 = u.pn * BM + wc * 32 + 8 * fq;
#pragma unroll
        for (int ai = 0; ai < 2; ++ai)
#pragma unroll
            for (int m = 0; m < 4; ++m) { bf16_t* rowp = O + (size_t)u.g * gstride + (size_t)(row0 + ai * HALF + m * 16) * ldc + col0;
#pragma unroll
                for (int bj = 0; bj < 2; ++bj) { const f32x4 v0 = acc[ai][bj][m][0], v1 = acc[ai][bj][m][1];
                    u32x4 w; w.x = cvt_pk_bf16(v0[0], v0[1]); w.y = cvt_pk_bf16(v0[2], v0[3]); w.z = cvt_pk_bf16(v1[0], v1[1]); w.w = cvt_pk_bf16(v1[2], v1[3]);
                    *(u32x4*)(rowp + bj * HALF) = w; } }
    }
};
constexpr float Z8_SCALE = 2.0f;
struct EpiGeluFp8 {
    static constexpr bool PERM = true;
    unsigned char* O; int ldc; size_t gstride;
    __device__ __forceinline__ void operator()(const f32x4 (&acc)[2][2][4][2], const Unit& u, int wr, int wc, int fr, int fq) const {
        const int row0 = u.pm * BM + wr * 64 + fr, col0 = u.pn * BM + wc * 32 + 8 * fq;
        unsigned char* base = O + (size_t)u.g * gstride;
#pragma unroll
        for (int ai = 0; ai < 2; ++ai)
#pragma unroll
            for (int m = 0; m < 4; ++m) { unsigned char* rowp = base + (size_t)(row0 + ai * HALF + m * 16) * ldc + col0;
#pragma unroll
                for (int bj = 0; bj < 2; ++bj) { float o[8];
#pragma unroll
                    for (int n = 0; n < 2; ++n)
#pragma unroll
                        for (int q = 0; q < 4; ++q) { const float x = acc[ai][bj][m][n][q]; o[4 * n + q] = (Z8_SCALE * x) * fast_sigmoid(1.5957691216057308f * (x + 0.044715f * x * x * x)); }
                    *(u32x2*)(rowp + bj * HALF) = (u32x2){pk4_fp8(o[0], o[1], o[2], o[3]), pk4_fp8(o[4], o[5], o[6], o[7])}; } }
    }
};
constexpr float Y8_SCALE = 16.0f, Y8_INV = 1.0f / 16.0f;
struct EpiGate {
    static constexpr bool PERM = true;
    unsigned char* O; int ldc; size_t gstride; const float* gate; int rpg;
    __device__ __forceinline__ void operator()(const f32x4 (&acc)[2][2][4][2], const Unit& u, int wr, int wc, int fr, int fq) const {
        const int row0 = u.pm * BM + wr * 64 + fr, col0 = u.pn * BM + wc * 32 + 8 * fq;
        unsigned char* base = O + (size_t)u.g * gstride;
#pragma unroll
        for (int ai = 0; ai < 2; ++ai)
#pragma unroll
            for (int m = 0; m < 4; ++m) { const int row = row0 + ai * HALF + m * 16; const float gt = gate[u.g * rpg + row] * (W8_INV * Y8_SCALE); unsigned char* rowp = base + (size_t)row * ldc + col0;
#pragma unroll
                for (int bj = 0; bj < 2; ++bj) { const f32x4 v0 = acc[ai][bj][m][0] * gt, v1 = acc[ai][bj][m][1] * gt;
                    *(u32x2*)(rowp + bj * HALF) = (u32x2){pk4_fp8(v0[0], v0[1], v0[2], v0[3]), pk4_fp8(v1[0], v1[1], v1[2], v1[3])}; } }
    }
};
struct EpiF32 {
    static constexpr bool PERM = false;
    float* C; int ldc; size_t gstride;
    __device__ __forceinline__ void operator()(const f32x4 (&acc)[2][2][4][2], const Unit& u, int wr, int wc, int fr, int fq) const {
        const int row0 = u.pm * BM + wr * 64 + fr, col0 = u.pn * BM + wc * 32 + 4 * fq;
#pragma unroll
        for (int ai = 0; ai < 2; ++ai)
#pragma unroll
            for (int m = 0; m < 4; ++m) { float* rowp = C + (size_t)u.g * gstride + (size_t)(row0 + ai * HALF + m * 16) * ldc + col0;
#pragma unroll
                for (int bj = 0; bj < 2; ++bj)
#pragma unroll
                    for (int n = 0; n < 2; ++n) *(f32x4*)(rowp + bj * HALF + n * 16) = acc[ai][bj][m][n]; }
    }
};
struct EpiResid {
    static constexpr bool PERM = true;
    bf16_t* X; const float* modL;
    __device__ __forceinline__ void operator()(const f32x4 (&acc)[2][2][4][2], const Unit& u, int wr, int wc, int fr, int fq) const {
        const int row0 = u.pm * BM + wr * 64 + fr, col0 = u.pn * BM + wc * 32 + 8 * fq;
        const int b = u.pm / 17, j = (u.pm - b * 17 == 0) ? 8 : b;
        const float* g1 = modL + (size_t)(j * 6 + 2) * 1024 + col0;
        f32x4 gv[2][2];
#pragma unroll
        for (int bj = 0; bj < 2; ++bj)
#pragma unroll
            for (int n = 0; n < 2; ++n) gv[bj][n] = *(const f32x4*)(g1 + bj * HALF + n * 4);
#pragma unroll
        for (int ai = 0; ai < 2; ++ai)
#pragma unroll
            for (int m = 0; m < 4; ++m) { bf16_t* rowp = X + (size_t)(row0 + ai * HALF + m * 16) * D + col0;
#pragma unroll
                for (int bj = 0; bj < 2; ++bj) { u32x4* p = (u32x4*)(rowp + bj * HALF); const u32x4 w = *p;
                    const f32x4 x0 = bf4_to_f32((u32x2){w.x, w.y}) + gv[bj][0] * acc[ai][bj][m][0], x1 = bf4_to_f32((u32x2){w.z, w.w}) + gv[bj][1] * acc[ai][bj][m][1];
                    const u32x2 o0 = f32_to_bf4(x0), o1 = f32_to_bf4(x1); *p = (u32x4){o0.x, o0.y, o1.x, o1.y}; } }
    }
};
struct EpiGluResid {
    static constexpr bool PERM = true;
    bf16_t* X; const float* modL; const float* bias;
    __device__ __forceinline__ void operator()(const f32x4 (&acc)[2][2][4][2], const Unit& u, int wr, int wc, int fr, int fq) const {
        const int row0 = u.pm * BM + wr * 64 + fr, col0 = u.pn * HALF + wc * 32 + 8 * fq;
        const int b = u.pm / 17, j = (u.pm - b * 17 == 0) ? 8 : b;
        const float* g1 = modL + (size_t)(j * 6 + 2) * 1024 + col0;
        f32x4 gv[2], ba[2], bg[2];
#pragma unroll
        for (int n = 0; n < 2; ++n) { gv[n] = *(const f32x4*)(g1 + n * 4); ba[n] = *(const f32x4*)(bias + col0 + n * 4); bg[n] = *(const f32x4*)(bias + 1024 + col0 + n * 4); }
#pragma unroll
        for (int ai = 0; ai < 2; ++ai)
#pragma unroll
            for (int m = 0; m < 4; ++m) { u32x4* p = (u32x4*)(X + (size_t)(row0 + ai * HALF + m * 16) * D + col0); const u32x4 w = *p;
                f32x4 xo[2] = {bf4_to_f32((u32x2){w.x, w.y}), bf4_to_f32((u32x2){w.z, w.w})};
#pragma unroll
                for (int n = 0; n < 2; ++n) { const f32x4 a = acc[ai][0][m][n] * (W8_INV / Z8_SCALE) + ba[n], g = acc[ai][1][m][n] * (W8_INV / Z8_SCALE) + bg[n];
                    f32x4 o; o.x = a.x * fast_sigmoid(g.x); o.y = a.y * fast_sigmoid(g.y); o.z = a.z * fast_sigmoid(g.z); o.w = a.w * fast_sigmoid(g.w);
                    xo[n] = xo[n] + gv[n] * o; }
                const u32x2 o0 = f32_to_bf4(xo[0]), o1 = f32_to_bf4(xo[1]); *p = (u32x4){o0.x, o0.y, o1.x, o1.y}; }
    }
};
}

namespace attn_body {
using bf16=__hip_bfloat16;
using bf16x8=__attribute__((ext_vector_type(8)))short;
using s16x4=__attribute__((ext_vector_type(4)))short;
using f32x16=__attribute__((ext_vector_type(16)))float;
using u32x4=__attribute__((ext_vector_type(4)))unsigned;
constexpr int D=64,QP=512,KP=128,VP=2816,OP=1024;
constexpr int NW=8,QBLK=32,QB=QBLK*NW,KVBLK=64;
__device__ __forceinline__ int crow(int r,int hi){return (r&3)+8*(r>>2)+4*hi;}
#define SBAR() __builtin_amdgcn_sched_barrier(0)
__device__ __forceinline__ void cmask(f32x16&p0,f32x16&p1,int jb,int qrel,int hi){
  const float NEG=-INFINITY; int kb=64*jb+4*hi;
  #pragma unroll
  for(int r=0;r<16;++r){int kv=kb+(r&3)+8*(r>>2); if(kv>qrel)p0[r]=NEG; if(kv+32>qrel)p1[r]=NEG;}
}

constexpr int NSLOT=3, SLOTB=8192;
constexpr int LDS_K=0, LDS_V=NSLOT*SLOTB, LDS_WS=2*NSLOT*SLOTB, LDS_OST=LDS_WS+NW*64*4, LDS_BYTES=LDS_OST+NW*4096;
constexpr float C2=0.125f*1.4426950408889634f;
__device__ __forceinline__ void glds16(const void*gsrc,unsigned lds_dst){unsigned keep;
  asm volatile("s_mov_b32 %0, m0\n\ts_mov_b32 m0, %2\n\ts_nop 0\n\tglobal_load_lds_dwordx4 %1, off\n\ts_mov_b32 m0, %0":"=&s"(keep):"v"(gsrc),"s"(lds_dst):"memory");}
__device__ __forceinline__ float max3f(float a,float b,float c){float r;asm("v_max3_f32 %0, %1, %2, %3":"=v"(r):"v"(a),"v"(b),"v"(c));return r;}
__device__ __forceinline__ float max2f(float a,float b){float r;asm("v_max_f32_e32 %0, %1, %2":"=v"(r):"v"(a),"v"(b));return r;}
__device__ __forceinline__ float fadd_s(float a,float b){float r;asm("v_add_f32_e32 %0, %1, %2":"=v"(r):"v"(a),"v"(b));return r;}
__device__ __forceinline__ float fsub_s(float a,float b){float r;asm("v_sub_f32_e32 %0, %1, %2":"=v"(r):"v"(a),"v"(b));return r;}
typedef float f32x2_t __attribute__((ext_vector_type(2))); typedef __bf16 bf16x2_t __attribute__((ext_vector_type(2)));
__device__ __forceinline__ unsigned cvtpk_s(float lo,float hi){f32x2_t v={lo,hi};bf16x2_t b=__builtin_convertvector(v,bf16x2_t);return __builtin_bit_cast(unsigned,b);}
#define WAIT_BAR(N) asm volatile("s_waitcnt vmcnt(" #N ") lgkmcnt(0)\n\ts_barrier":::"memory")

__device__ __forceinline__ void qkt(f32x16&p0,f32x16&p1,const char*Kslot,const bf16x8*qr,const f32x16&negm,int r32,int hi){
  const char*kb=Kslot+hi*1024+r32*16;
  #pragma unroll
  for(int d0=0;d0<4;++d0){
    const bf16x8 b0=*reinterpret_cast<const bf16x8*>(kb+d0*2048);
    const bf16x8 b1=*reinterpret_cast<const bf16x8*>(kb+d0*2048+512);
    if(d0==0){p0=__builtin_amdgcn_mfma_f32_32x32x16_bf16(b0,qr[0],negm,0,0,0);p1=__builtin_amdgcn_mfma_f32_32x32x16_bf16(b1,qr[0],negm,0,0,0);}
    else{p0=__builtin_amdgcn_mfma_f32_32x32x16_bf16(b0,qr[d0],p0,0,0,0);p1=__builtin_amdgcn_mfma_f32_32x32x16_bf16(b1,qr[d0],p1,0,0,0);}}
}
typedef __attribute__((address_space(3))) const char* lds_cptr;
typedef short v4i16_t __attribute__((ext_vector_type(4)));
__device__ __forceinline__ void kload8(bf16x8*kf,lds_cptr kp){
  kf[0]=*(const __attribute__((address_space(3))) bf16x8*)(kp);      kf[1]=*(const __attribute__((address_space(3))) bf16x8*)(kp+512);
  kf[2]=*(const __attribute__((address_space(3))) bf16x8*)(kp+2048); kf[3]=*(const __attribute__((address_space(3))) bf16x8*)(kp+2560);
  kf[4]=*(const __attribute__((address_space(3))) bf16x8*)(kp+4096); kf[5]=*(const __attribute__((address_space(3))) bf16x8*)(kp+4608);
  kf[6]=*(const __attribute__((address_space(3))) bf16x8*)(kp+6144); kf[7]=*(const __attribute__((address_space(3))) bf16x8*)(kp+6656);
}
__device__ __forceinline__ void kload2(bf16x8*kf,lds_cptr kp,int j){ kf[2*j]=*(const __attribute__((address_space(3))) bf16x8*)(kp+j*2048); kf[2*j+1]=*(const __attribute__((address_space(3))) bf16x8*)(kp+j*2048+512); }
__device__ __forceinline__ s16x4 vtr(lds_cptr p){ return __builtin_bit_cast(s16x4,__builtin_amdgcn_ds_read_tr16_b64_v4i16((__attribute__((address_space(3))) v4i16_t*)p)); }
__device__ __forceinline__ float rowmax(const f32x16&p0,const f32x16&p1){
  float a=max3f(p0[0],p0[1],p1[0]),b=max3f(p0[2],p0[3],p1[1]);a=max3f(a,p1[2],p1[3]);
  #pragma unroll
  for(int r=4;r<16;r+=4){a=max3f(a,p0[r],p0[r+1]);b=max3f(b,p0[r+2],p0[r+3]);a=max3f(a,p1[r],p1[r+1]);b=max3f(b,p1[r+2],p1[r+3]);}
  const float m=max2f(a,b);
  auto rr=__builtin_amdgcn_permlane32_swap(__float_as_uint(m),__float_as_uint(m),false,false);
  return max2f(__uint_as_float(rr[0]),__uint_as_float(rr[1]));
}
__device__ __forceinline__ void pv(f32x16*o,int vb,bf16x8 pa0,bf16x8 pa1,bf16x8 pa2,bf16x8 pa3){
  #pragma unroll
  for(int d0=0;d0<2;++d0){s16x4 lo[4],hi[4];
    #pragma unroll
    for(int ks=0;ks<4;++ks){
      asm volatile("ds_read_b64_tr_b16 %0,%1 offset:%c2":"=&v"(lo[ks]):"v"(vb),"i"(d0*4096+ks*1024):"memory");
      asm volatile("ds_read_b64_tr_b16 %0,%1 offset:%c2":"=&v"(hi[ks]):"v"(vb),"i"(d0*4096+ks*1024+512):"memory");}
    asm volatile("s_waitcnt lgkmcnt(0)":::"memory");SBAR();
    #define PK(k) (bf16x8){lo[k][0],lo[k][1],lo[k][2],lo[k][3],hi[k][0],hi[k][1],hi[k][2],hi[k][3]}
    o[d0]=__builtin_amdgcn_mfma_f32_32x32x16_bf16(pa0,PK(0),o[d0],0,0,0);
    o[d0]=__builtin_amdgcn_mfma_f32_32x32x16_bf16(pa1,PK(1),o[d0],0,0,0);
    o[d0]=__builtin_amdgcn_mfma_f32_32x32x16_bf16(pa2,PK(2),o[d0],0,0,0);
    o[d0]=__builtin_amdgcn_mfma_f32_32x32x16_bf16(pa3,PK(3),o[d0],0,0,0);
    #undef PK
  }
}

#ifndef ATTN_STORE16
#define ATTN_STORE16(p,v) (*(u32x4*)(p)=(v))
#endif
template<int THRL,bool NOMAX> __device__ __forceinline__ void attn_unit(const bf16*Qw0,const bf16*Kh,const bf16*Vh,bf16*Ow0,const int NT,char*shm,const int wid){
  const int lane=lane_id(),r32=lane&31,hi=lane>>5;
  const bf16*Qw=Qw0+(long)(wid*QBLK)*QP;
  const unsigned lds0=(unsigned)(uintptr_t)shm;
  float*wsf=(float*)(shm+LDS_WS)+wid*64;
  const bf16*ksrc=Kh+(long)lane*KP+wid*8;
  const bf16*vsrc=Vh+(long)(16*(wid&3)+(lane>>2))*VP+(wid>>2)*32+(lane&3)*8;
  const unsigned kdst=lds0+LDS_K+wid*1024, vdst=lds0+LDS_V+wid*1024;
  #define DMA_K(t,slot) glds16(ksrc+(long)(t)*KVBLK*KP,(unsigned)__builtin_amdgcn_readfirstlane(kdst+(slot)))
  #define DMA_V(t,slot) glds16(vsrc+(long)(t)*KVBLK*VP,(unsigned)__builtin_amdgcn_readfirstlane(vdst+(slot)))
  const int vb0=(int)(lds0+LDS_V)+((lane>>4)&1)*32+(lane&3)*8+(4*hi+((lane&15)>>2))*64;
  const char*Kbase=shm+LDS_K; bf16x8 kf[8];
  const lds_cptr shm3=(lds_cptr)shm; const lds_cptr kp0=shm3+LDS_K+hi*1024+r32*16; const lds_cptr vp0=shm3+LDS_V+((lane>>4)&1)*32+(lane&3)*8+(4*hi+((lane&15)>>2))*64;
  DMA_K(0,0);DMA_V(0,0);DMA_K(1,SLOTB);
  bf16x8 qr[4];
  #pragma unroll
  for(int d0=0;d0<4;++d0)qr[d0]=*reinterpret_cast<const bf16x8*>(&Qw[(long)r32*QP+d0*16+hi*8]);
  float mhat=0.f,l_reg=0.f;f32x16 o[2];o[0]=f32x16{};o[1]=f32x16{};f32x16 negm=f32x16{};asm volatile("":"+v"(negm));
  #define CMASK(P0,P1,t) do{}while(0)
  bool resc=false;
  #define START(P0,P1) do{ resc=false; if constexpr(!NOMAX){ const float rm=rowmax(P0,P1); \
    { const float dl=rm; mhat=fadd_s(mhat,dl); \
      _Pragma("unroll") for(int r=0;r<16;++r){P0[r]=fsub_s(P0[r],dl);P1[r]=fsub_s(P1[r],dl);} \
      _Pragma("unroll") for(int r=0;r<16;++r)negm[r]=-mhat; asm volatile("":"+v"(negm)); } } \
    _Pragma("unroll") for(int r=0;r<16;++r)P0[r]=__builtin_amdgcn_exp2f(P0[r]); }while(0)
  #define RESC() do{ if(resc){ asm volatile("s_waitcnt lgkmcnt(0)":::"memory"); \
      _Pragma("unroll") for(int d_=0;d_<2;++d_) _Pragma("unroll") for(int r=0;r<16;++r)o[d_][r]*=wsf[crow(r,hi)]; } }while(0)
  f32x16 pA0,pA1,pB0,pB1;
  int sl_prev=0,sl_cur=0,sl_next=SLOTB;
  #define ROT() do{sl_prev=sl_cur;sl_cur=sl_next;sl_next=(sl_next==(NSLOT-1)*SLOTB)?0:sl_next+SLOTB;}while(0)
  DMA_K(2,2*SLOTB);
  WAIT_BAR(3);
  qkt(pA0,pA1,Kbase,qr,negm,r32,hi);asm volatile("s_nop 15\n\ts_nop 7":"+v"(pA0),"+v"(pA1));CMASK(pA0,pA1,0);
  START(pA0,pA1);
  _Pragma("unroll") for(int r=0;r<16;++r)pA1[r]=__builtin_amdgcn_exp2f(pA1[r]);
  WAIT_BAR(0);
  DMA_K(3,0);DMA_V(1,SLOTB);
  ROT();
  kload8(kf,kp0+sl_cur);
  WAIT_BAR(2);
  s16x4 vlo[8],vhi[8]; u32x4 pw0,pw1,pw2,pw3;
  #define PKW(P,B) cvtpk_s(P[B],P[B+1])
  #define PAF(k) __builtin_bit_cast(bf16x8,pw##k)
  #define VFR(i) (bf16x8){vlo[i][0],vlo[i][1],vlo[i][2],vlo[i][3],vhi[i][0],vhi[i][1],vhi[i][2],vhi[i][3]}
  #define PIN(x) asm volatile("":"+v"(x))
  #define MX3(a,b,c) __builtin_fmaxf(__builtin_fmaxf((a),(b)),(c))
  #define GAPA(MF,A0,A1,A2,A3,W0,W1,PW) do{ MF; sacc+=A0; sacc+=A1; sacc+=A2; sacc+=A3; PIN(sacc); W0; W1; PIN(PW); SBAR(); }while(0)
  #define EX(v) __builtin_amdgcn_exp2f(v)
  #define GAPB(MF,X,B) do{ MF; X[B]=EX(X[B]); X[B+1]=EX(X[B+1]); X[B+2]=EX(X[B+2]); X[B+3]=EX(X[B+3]); PIN(X); SBAR(); }while(0)
  #define VRD(i) do{ vlo[i]=vtr(vp_+(((i)>>2)*4096+((i)&3)*1024)); vhi[i]=vtr(vp_+(((i)>>2)*4096+((i)&3)*1024+512)); }while(0)
  #define KRD(G,j) do{ if(G){ kload2(kf,kp0+sl_next,j); SBAR(); } }while(0)
  #define STEP(C0,C1,P0,P1,t,GK,GV,GL) do{ SBAR(); \
    const lds_cptr vp_=vp0+sl_prev; \
    VRD(0); SBAR(); float sacc=(P0[0]+P0[1]); \
    GAPA(C0=__builtin_amdgcn_mfma_f32_32x32x16_bf16(kf[0],qr[0],negm,0,0,0), P0[2],P0[3],P0[4],P0[5],     pw0[0]=PKW(P0,0), pw0[1]=PKW(P0,2), pw0); \
    VRD(4); SBAR(); GAPA(C1=__builtin_amdgcn_mfma_f32_32x32x16_bf16(kf[1],qr[0],negm,0,0,0), P0[6],P0[7],P0[8],P0[9],     pw0[2]=PKW(P0,4), pw0[3]=PKW(P0,6), pw0); \
    VRD(1); SBAR(); GAPA(C0=__builtin_amdgcn_mfma_f32_32x32x16_bf16(kf[2],qr[1],C0,0,0,0),   P0[10],P0[11],P0[12],P0[13], pw1[0]=PKW(P0,8), pw1[1]=PKW(P0,10), pw1); \
    VRD(5); SBAR(); GAPA(C1=__builtin_amdgcn_mfma_f32_32x32x16_bf16(kf[3],qr[1],C1,0,0,0),   P0[14],P0[15],P1[0],P1[1],   pw1[2]=PKW(P0,12),pw1[3]=PKW(P0,14), pw1); \
    VRD(2); SBAR(); GAPA(C0=__builtin_amdgcn_mfma_f32_32x32x16_bf16(kf[4],qr[2],C0,0,0,0),   P1[2],P1[3],P1[4],P1[5],     pw2[0]=PKW(P1,0), pw2[1]=PKW(P1,2), pw2); \
    VRD(6); SBAR(); GAPA(C1=__builtin_amdgcn_mfma_f32_32x32x16_bf16(kf[5],qr[2],C1,0,0,0),   P1[6],P1[7],P1[8],P1[9],     pw2[2]=PKW(P1,4), pw2[3]=PKW(P1,6), pw2); \
    VRD(3); SBAR(); GAPA(C0=__builtin_amdgcn_mfma_f32_32x32x16_bf16(kf[6],qr[3],C0,0,0,0),   P1[10],P1[11],P1[12],P1[13], pw3[0]=PKW(P1,8), pw3[1]=PKW(P1,10), pw3); \
    VRD(7); SBAR(); GAPA(C1=__builtin_amdgcn_mfma_f32_32x32x16_bf16(kf[7],qr[3],C1,0,0,0),   P1[14],P1[15],0.f,0.f,       pw3[2]=PKW(P1,12),pw3[3]=PKW(P1,14), pw3); \
    l_reg+=sacc; \
    if(GK){DMA_K((t)+3,sl_cur);} if(GV){DMA_V((t)+1,sl_next);} \
    CMASK(C0,C1,t); \
    if constexpr(!NOMAX) { float a=MX3(C0[0],C0[1],C1[0]),b=MX3(C0[2],C0[3],C1[1]); a=MX3(a,C1[2],C1[3]); \
      _Pragma("unroll") for(int r=4;r<16;r+=4){a=MX3(a,C0[r],C0[r+1]);b=MX3(b,C0[r+2],C0[r+3]);a=MX3(a,C1[r],C1[r+1]);b=MX3(b,C1[r+2],C1[r+3]);} \
      float rm=__builtin_fmaxf(a,b); { auto rr=__builtin_amdgcn_permlane32_swap(__float_as_uint(rm),__float_as_uint(rm),false,false); rm=__builtin_fmaxf(__uint_as_float(rr[0]),__uint_as_float(rr[1])); } \
      resc=false; \
      if(__builtin_expect(__any(rm>(float)THRL),0)){ const float dl=__builtin_fmaxf(rm,0.f); mhat+=dl; \
        _Pragma("unroll") for(int r=0;r<16;++r){C0[r]-=dl;C1[r]-=dl;} \
        _Pragma("unroll") for(int r=0;r<16;++r)negm[r]=-mhat; asm volatile("":"+v"(negm)); \
        const float f=__builtin_amdgcn_exp2f(-dl); l_reg*=f; if(hi==0)wsf[r32]=f; resc=true; } } \
    SBAR(); \
    GAPB(o[0]=__builtin_amdgcn_mfma_f32_32x32x16_bf16(PAF(0),VFR(0),o[0],0,0,0), C0,0); \
    GAPB(o[1]=__builtin_amdgcn_mfma_f32_32x32x16_bf16(PAF(0),VFR(4),o[1],0,0,0), C0,4); \
    KRD(GL,0); GAPB(o[0]=__builtin_amdgcn_mfma_f32_32x32x16_bf16(PAF(1),VFR(1),o[0],0,0,0), C0,8); \
    KRD(GL,1); GAPB(o[1]=__builtin_amdgcn_mfma_f32_32x32x16_bf16(PAF(1),VFR(5),o[1],0,0,0), C0,12); \
    KRD(GL,2); GAPB(o[0]=__builtin_amdgcn_mfma_f32_32x32x16_bf16(PAF(2),VFR(2),o[0],0,0,0), C1,0); \
    KRD(GL,3); GAPB(o[1]=__builtin_amdgcn_mfma_f32_32x32x16_bf16(PAF(2),VFR(6),o[1],0,0,0), C1,4); \
    GAPB(o[0]=__builtin_amdgcn_mfma_f32_32x32x16_bf16(PAF(3),VFR(3),o[0],0,0,0), C1,8); \
    GAPB(o[1]=__builtin_amdgcn_mfma_f32_32x32x16_bf16(PAF(3),VFR(7),o[1],0,0,0), C1,12); \
    }while(0)
  int t=1;
  #undef CMASK
  #define CMASK(P0,P1,t) do{}while(0)
  for(;t+5<NT;t+=2){
    STEP(pB0,pB1,pA0,pA1,t,true,true,true);     WAIT_BAR(2); RESC(); ROT();
    STEP(pA0,pA1,pB0,pB1,t+1,true,true,true);   WAIT_BAR(2); RESC(); ROT();
  }
  #undef CMASK
  #define CMASK(P0,P1,t) do{}while(0)
  #define ENDW(tt) do{ if((tt)+3<NT){WAIT_BAR(2);} else if((tt)+2<NT){WAIT_BAR(1);} else {WAIT_BAR(0);} }while(0)
  for(;t+1<NT;t+=2){
    STEP(pB0,pB1,pA0,pA1,t,(t+3<NT),(t+1<NT),(t+1<NT));       ENDW(t);   RESC(); ROT();
    STEP(pA0,pA1,pB0,pB1,t+1,(t+4<NT),(t+2<NT),(t+2<NT));     ENDW(t+1); RESC(); ROT();
  }
  STEP(pB0,pB1,pA0,pA1,NT-1,false,false,false); RESC();
  { float sacc=pB0[0]+pB0[1]; _Pragma("unroll") for(int r=2;r<16;++r)sacc+=pB0[r]; _Pragma("unroll") for(int r=0;r<16;++r)sacc+=pB1[r]; l_reg+=sacc;
    pw0=(u32x4){PKW(pB0,0),PKW(pB0,2),PKW(pB0,4),PKW(pB0,6)};pw1=(u32x4){PKW(pB0,8),PKW(pB0,10),PKW(pB0,12),PKW(pB0,14)};pw2=(u32x4){PKW(pB1,0),PKW(pB1,2),PKW(pB1,4),PKW(pB1,6)};pw3=(u32x4){PKW(pB1,8),PKW(pB1,10),PKW(pB1,12),PKW(pB1,14)};
    SBAR(); pv(o,vb0+sl_cur,PAF(0),PAF(1),PAF(2),PAF(3)); }
  #undef PKW
  #undef PAF
  #undef VFR
  #undef PIN
  #undef MX3
  #undef GAPA
  #undef GAPB
  #undef EX
  #undef VRD
  #undef KRD
  #undef STEP
  #undef ENDW
  {auto rr=__builtin_amdgcn_permlane32_swap(__float_as_uint(l_reg),__float_as_uint(l_reg),false,false);l_reg=__uint_as_float(rr[0])+__uint_as_float(rr[1]);}
  if(hi==0)wsf[32+r32]=l_reg;asm volatile("s_waitcnt lgkmcnt(0)":::"memory");
  float rli[16];
  #pragma unroll
  for(int r=0;r<16;++r)rli[r]=__builtin_amdgcn_rcpf(wsf[32+crow(r,hi)]);
  bf16*Ow=Ow0+(long)(wid*QBLK)*OP;
  { bf16*stg=(bf16*)(shm+LDS_OST)+wid*2048;
    #pragma unroll
    for(int r=0;r<16;++r){const int orow=crow(r,hi);
      #pragma unroll
      for(int d0=0;d0<2;++d0)stg[orow*64+d0*32+r32]=__float2bfloat16(o[d0][r]*rli[r]);}
    asm volatile("s_waitcnt lgkmcnt(0)":::"memory");
    #pragma unroll
    for(int i=0;i<4;++i){const int row=i*8+(lane>>3),ch=lane&7; const u32x4 v=*(const u32x4*)(stg+row*64+ch*8); ATTN_STORE16(Ow+(long)row*OP+ch*8,v);} }
  asm volatile("s_waitcnt lgkmcnt(0)\n\ts_barrier":::"memory");
  #undef DMA_K
  #undef DMA_V
  #undef CMASK
  #undef START
  #undef RESC
  #undef ROT
}
constexpr int ATTN_LDS_BYTES=LDS_BYTES;
#undef SBAR
#undef WAIT_BAR
}

__device__ __forceinline__ void phase_pro(const Ctx& c, LAS float* ldsf) {
    float* rope = (float*)(c.ws + WS_ROPE);
    for (int i = c.gt; i < 64 * 16; i += c.ngt) {
        const int pos = i >> 4, fi = i & 15; const float inv = powf(10000.0f, -(float)fi / 16.0f), ang = (float)pos * inv;
        rope[2 * i] = cosf(ang); rope[2 * i + 1] = sinf(ang);
    }
    LAS float* sil = ldsf; LAS float* red = ldsf + 9 * 1024;
    for (int i = c.tid; i < 9 * 1024; i += 512) { const int j = i >> 10, k = i & 1023; const float v = (j < 8) ? c.in[IN_C][j * 1024 + k] : c.in[IN_CCTX][k]; sil[i] = siluf_(v); }
    __syncthreads();
    float* MOD = (float*)(c.ws + WS_MOD);
    for (int task = c.vb; task < DEPTH * 192; task += c.vg) {
        const int L = task / 192, cb = task - L * 192, col = cb * 32 + (c.lane & 31);
        const float* W = c.in[IN_MODW] + (size_t)L * 1024 * 6144 + col;
        float acc[9];
#pragma unroll
        for (int j = 0; j < 9; ++j) acc[j] = 0.f;
        const int k0 = c.wave * 128 + (c.lane >> 5);
        for (int kb = 0; kb < 128; kb += 32) {
            float w[16];
#pragma unroll
            for (int u = 0; u < 16; ++u) w[u] = __builtin_nontemporal_load(W + (size_t)(k0 + kb + 2 * u) * 6144);
#pragma unroll
            for (int u = 0; u < 16; ++u)
#pragma unroll
                for (int j = 0; j < 9; ++j) acc[j] += sil[j * 1024 + k0 + kb + 2 * u] * w[u];
        }
#pragma unroll
        for (int j = 0; j < 9; ++j) { acc[j] += __shfl_xor(acc[j], 32); if (c.lane < 32) red[(c.wave * 9 + j) * 32 + c.lane] = acc[j]; }
        __syncthreads();
        if (c.wave == 0 && c.lane < 32) {
            const float bias = c.in[IN_MODB][L * 6144 + col];
#pragma unroll
            for (int j = 0; j < 9; ++j) { float s = bias;
#pragma unroll
                for (int w = 0; w < 8; ++w) s += red[(w * 9 + j) * 32 + c.lane];
                MOD[(size_t)(L * 9 + j) * 6144 + col] = s; }
        }
        __syncthreads();
    }
}

template <bool FINAL, bool GM, int NR>
__device__ __forceinline__ void norm1_rows(const Ctx& c, int L, int rbeg, int rend) {
    unsigned short* X = (unsigned short*)(c.ws + WS_X);
    const int* SLOT = (const int*)(c.ws + WS_SLOT); const unsigned char* Y = (const unsigned char*)(c.ws + WS_Y);
    int ch[4];
#pragma unroll
    for (int q = 0; q < 4; ++q) ch[q] = GM ? 16 * c.lane + 4 * q : 4 * (c.lane + 64 * q);
#define N1_DEC(w) ((f32x4){__builtin_amdgcn_cvt_pk_f32_fp8((int)(w), false)[0], __builtin_amdgcn_cvt_pk_f32_fp8((int)(w), false)[1], __builtin_amdgcn_cvt_pk_f32_fp8((int)(w), true)[0], __builtin_amdgcn_cvt_pk_f32_fp8((int)(w), true)[1]})
    pg8::u32x2 xn[NR][4]; int spn[NR]; unsigned yp0[NR][4], yp1[NR][4]; unsigned long long maskn[NR]; bool hasn[NR], twon[NR];
#pragma unroll
    for (int k = 0; k < NR; ++k) { spn[k] = -1; maskn[k] = 0ull; hasn[k] = false; twon[k] = false; }
#define N1_LOADX(k, row) do { _Pragma("unroll") for (int q = 0; q < 4; ++q) xn[k][q] = *(const pg8::u32x2*)(X + (size_t)(row) * D + ch[q]); \
        if (L > 0 && c.lane < NE) spn[k] = SLOT[(size_t)(row) * NE + c.lane]; } while (0)
#define N1_YPF(k) do { unsigned long long m_ = __ballot(spn[k] >= 0 && c.lane < NE); hasn[k] = m_ != 0ull; twon[k] = false; if (m_) { \
        const int e0_ = __builtin_ctzll(m_); m_ &= m_ - 1; twon[k] = m_ != 0ull; const int e1_ = twon[k] ? __builtin_ctzll(m_) : e0_; if (twon[k]) m_ &= m_ - 1; \
        const unsigned char* y0_ = Y + ((size_t)e0_ * EROWS + __builtin_amdgcn_readlane(spn[k], e0_)) * D; const unsigned char* y1_ = Y + ((size_t)e1_ * EROWS + __builtin_amdgcn_readlane(spn[k], e1_)) * D; \
        _Pragma("unroll") for (int q = 0; q < 4; ++q) { yp0[k][q] = __builtin_nontemporal_load((const unsigned*)(y0_ + ch[q])); yp1[k][q] = __builtin_nontemporal_load((const unsigned*)(y1_ + ch[q])); } } maskn[k] = m_; } while (0)
    const int gall = rend / NR, gper = (gall - rbeg / NR + c.ngw - 1) / c.ngw;
    int gidx = rbeg / NR + c.gw * gper;
    const int ngrp = (gidx + gper < gall) ? gidx + gper : gall;
    if (gidx < ngrp) {
#pragma unroll
        for (int k = 0; k < NR; ++k) N1_LOADX(k, gidx * NR + k);
        if (L > 0) {
#pragma unroll
            for (int k = 0; k < NR; ++k) N1_YPF(k);
        }
    }
    int jprev = -1; f32x4 gmv[4] = {}, shv[4] = {}, g2v[4] = {};
    for (; gidx < ngrp; ++gidx) {
        const int r0 = gidx * NR;
        const int b = r0 / RB, s0 = r0 - b * RB, j = s0 < CL ? 8 : b;
        pg8::u32x2 xc[NR][4]; int spc[NR]; unsigned w0[NR][4], w1[NR][4]; unsigned long long mask[NR]; bool has[NR], two0[NR];
#pragma unroll
        for (int k = 0; k < NR; ++k) { spc[k] = spn[k]; mask[k] = maskn[k]; has[k] = hasn[k]; two0[k] = twon[k];
#pragma unroll
            for (int q = 0; q < 4; ++q) { xc[k][q] = xn[k][q]; w0[k][q] = yp0[k][q]; w1[k][q] = yp1[k][q]; } }
        const int gn = gidx + 1;
        if (gn < ngrp) {
#pragma unroll
            for (int k = 0; k < NR; ++k) N1_LOADX(k, gn * NR + k);
        }
        if (!(FINAL && s0 < CL)) {
            unsigned hw[NR][8];
            if (NR > 1 && j != jprev) { jprev = j;
#pragma unroll
                for (int q = 0; q < 4; ++q) {
                    if (FINAL) gmv[q] = *(const f32x4*)(c.in[IN_FNG] + ch[q]);
                    else { gmv[q] = *(const f32x4*)(c.in[IN_NORMG] + (size_t)(L * 2 + 0) * D + ch[q]) * (1.0f + *(const f32x4*)(modp(c, L, j, 1) + ch[q])); shv[q] = *(const f32x4*)(modp(c, L, j, 0) + ch[q]); }
                    if (L > 0) g2v[q] = *(const f32x4*)(modp(c, L - 1, j, 5) + ch[q]);
                }
            }
#pragma unroll
            for (int k = 0; k < NR; ++k) {
                const int r = r0 + k, s = s0 + k;
                unsigned short* xr = X + (size_t)r * D;
                f32x4 v[4];
#pragma unroll
                for (int q = 0; q < 4; ++q) v[q] = pg8::bf4_to_f32(xc[k][q]);
                if (L > 0) {
                    f32x4 sum[4] = {};
                    if (has[k]) {
#pragma unroll
                        for (int q = 0; q < 4; ++q) { sum[q] += N1_DEC(w0[k][q]); if (two0[k]) sum[q] += N1_DEC(w1[k][q]); }
                    }
                    unsigned long long mk = mask[k];
                    while (mk) {
                        const int e0 = __builtin_ctzll(mk); mk &= mk - 1;
                        const bool two = mk != 0ull; const int e1 = two ? __builtin_ctzll(mk) : e0; if (two) mk &= mk - 1;
                        const int sp0 = __builtin_amdgcn_readlane(spc[k], e0), sp1 = __builtin_amdgcn_readlane(spc[k], e1);
                        const unsigned char* y0 = Y + ((size_t)e0 * EROWS + sp0) * D; const unsigned char* y1 = Y + ((size_t)e1 * EROWS + sp1) * D;
                        unsigned u0[4], u1[4];
#pragma unroll
                        for (int q = 0; q < 4; ++q) { u0[q] = __builtin_nontemporal_load((const unsigned*)(y0 + ch[q])); u1[q] = __builtin_nontemporal_load((const unsigned*)(y1 + ch[q])); }
#pragma unroll
                        for (int q = 0; q < 4; ++q) { sum[q] += N1_DEC(u0[q]); if (two) sum[q] += N1_DEC(u1[q]); }
                    }
                    const float* g2 = modp(c, L - 1, j, 5);
#pragma unroll
                    for (int q = 0; q < 4; ++q) { v[q] += (NR > 1 ? g2v[q] : *(const f32x4*)(g2 + ch[q])) * (sum[q] * pg8::Y8_INV); if (!FINAL) { const pg8::u32x2 w = pg8::f32_to_bf4(v[q]); *(pg8::u32x2*)(xr + ch[q]) = w; v[q] = pg8::bf4_to_f32(w); } }
                }
                float ss = 0.f;
#pragma unroll
                for (int q = 0; q < 4; ++q) ss += v[q].x * v[q].x + v[q].y * v[q].y + v[q].z * v[q].z + v[q].w * v[q].w;
                const float rstd = rsqrtf(wave_sum(ss) * (1.0f / D) + EPS);
                if (FINAL) {
                    const float* g = c.in[IN_FNG]; float* op = c.out + (size_t)(b * T + s - CL) * D;
#pragma unroll
                    for (int q = 0; q < 4; ++q) *(f32x4*)(op + ch[q]) = v[q] * rstd * (NR > 1 ? gmv[q] : *(const f32x4*)(g + ch[q]));
                } else {
                    const float* g = c.in[IN_NORMG] + (size_t)(L * 2 + 0) * D; const float* sc = modp(c, L, j, 1); const float* sh = modp(c, L, j, 0);
#pragma unroll
                    for (int q = 0; q < 4; ++q) { const f32x4 hv = NR > 1 ? v[q] * rstd * gmv[q] + shv[q] : v[q] * rstd * *(const f32x4*)(g + ch[q]) * (1.0f + *(const f32x4*)(sc + ch[q])) + *(const f32x4*)(sh + ch[q]);
                        hw[k][2 * q] = pg8::cvt_pk_bf16(hv.x, hv.y); hw[k][2 * q + 1] = pg8::cvt_pk_bf16(hv.z, hv.w); }
                    if (!GM) { unsigned short* o = (unsigned short*)(c.ws + WS_HB1) + (size_t)r * D;
#pragma unroll
                        for (int q = 0; q < 4; ++q) *(pg8::u32x2*)(o + ch[q]) = (pg8::u32x2){hw[k][2 * q], hw[k][2 * q + 1]}; }
                }
            }
            if (!FINAL && GM) {
                unsigned short* o = (unsigned short*)(c.ws + WS_AS5) + ((size_t)c.lane * 1280 + (r0 >> 5)) * 768 + (r0 & 31) * 16;
#pragma unroll
                for (int k = 0; k < NR; ++k) { *(pg8::u32x4*)(o + 16 * k) = (pg8::u32x4){hw[k][0], hw[k][1], hw[k][2], hw[k][3]}; *(pg8::u32x4*)(o + 16 * k + 8) = (pg8::u32x4){hw[k][4], hw[k][5], hw[k][6], hw[k][7]}; }
            }
        }
        if (L > 0 && gn < ngrp) {
#pragma unroll
            for (int k = 0; k < NR; ++k) N1_YPF(k);
        }
    }
#undef N1_DEC
#undef N1_LOADX
#undef N1_YPF
}
template <int NR>
__device__ __forceinline__ void norm1_first_rows(const Ctx& c, int rbeg, int rend) {
    unsigned short* X = (unsigned short*)(c.ws + WS_X); unsigned short* H = (unsigned short*)(c.ws + WS_HB1);
    f32x4 xn[NR][4];
#define NF_LOAD(k, row) do { const int b_ = (row) / RB, s_ = (row) - b_ * RB; \
        const f32x4* sp_ = (const f32x4*)((s_ < CL) ? c.in[IN_CTX] + (size_t)(b_ * CL + s_) * D : c.in[IN_X] + (size_t)(b_ * T + s_ - CL) * D) + c.lane; \
        _Pragma("unroll") for (int q = 0; q < 4; ++q) xn[k][q] = __builtin_nontemporal_load(sp_ + 64 * q); } while (0)
    const int gall = rend / NR, gper = (gall - rbeg / NR + c.ngw - 1) / c.ngw;
    int gidx = rbeg / NR + c.gw * gper;
    const int ngrp = (gidx + gper < gall) ? gidx + gper : gall;
    if (gidx < ngrp) {
#pragma unroll
        for (int k = 0; k < NR; ++k) NF_LOAD(k, gidx * NR + k);
    }
    const float* g = c.in[IN_NORMG];
    int jprev = -1; f32x4 gmv[4] = {}, shv[4] = {}, g2v[4] = {};
    for (; gidx < ngrp; ++gidx) {
        const int r0 = gidx * NR, b = r0 / RB, s0 = r0 - b * RB, j = s0 < CL ? 8 : b;
        f32x4 xc[NR][4];
#pragma unroll
        for (int k = 0; k < NR; ++k)
#pragma unroll
            for (int q = 0; q < 4; ++q) xc[k][q] = xn[k][q];
        const int gn = gidx + 1;
        if (gn < ngrp) {
#pragma unroll
            for (int k = 0; k < NR; ++k) NF_LOAD(k, gn * NR + k);
        }
        const float* sc = modp(c, 0, j, 1); const float* sh = modp(c, 0, j, 0);
        if (j != jprev) { jprev = j;
#pragma unroll
            for (int q = 0; q < 4; ++q) { const int ch = 4 * (c.lane + 64 * q); gmv[q] = *(const f32x4*)(g + ch) * (1.0f + *(const f32x4*)(sc + ch)); shv[q] = *(const f32x4*)(sh + ch); } }
#pragma unroll
        for (int k = 0; k < NR; ++k) {
            const size_t r = (size_t)(r0 + k);
            f32x4 v[4]; float ss = 0.f;
#pragma unroll
            for (int q = 0; q < 4; ++q) { const pg8::u32x2 w = pg8::f32_to_bf4(xc[k][q]); *((pg8::u32x2*)(X + r * D) + c.lane + 64 * q) = w; v[q] = pg8::bf4_to_f32(w);
                ss += v[q].x * v[q].x + v[q].y * v[q].y + v[q].z * v[q].z + v[q].w * v[q].w; }
            const float rstd = rsqrtf(wave_sum(ss) * (1.0f / D) + EPS);
#pragma unroll
            for (int q = 0; q < 4; ++q) { const int ch = 4 * (c.lane + 64 * q);
                const f32x4 hv = v[q] * rstd * gmv[q] + shv[q];
                *((pg8::u32x2*)(H + r * D) + c.lane + 64 * q) = (pg8::u32x2){pg8::cvt_pk_bf16(hv.x, hv.y), pg8::cvt_pk_bf16(hv.z, hv.w)}; }
        }
    }
#undef NF_LOAD
}
__device__ __forceinline__ void phase_norm1_first(const Ctx& c) {
    norm1_first_rows<4>(c, 0, 32768);
    norm1_first_rows<1>(c, 32768, NROWS);
}
template <bool FINAL, bool GM>
__device__ __forceinline__ void phase_norm1(const Ctx& c, int L) {
    norm1_rows<FINAL, GM, 4>(c, L, 0, 32768);
    norm1_rows<FINAL, GM, 1>(c, L, 32768, NROWS);
}

template <bool SKIPCTX>
__device__ __forceinline__ void router_pairs(const Ctx& c, int L, const LAS float* wT, int rend) {
    const unsigned short* X = (const unsigned short*)(c.ws + WS_X); unsigned char* HB = (unsigned char*)(c.ws + WS_HB); float* AFF = (float*)(c.ws + WS_AFF);
    const int npair = rend >> 1, per = (npair + c.ngw - 1) / c.ngw, p0 = c.gw * per, p1 = (p0 + per < npair) ? p0 + per : npair;
    pg8::u32x2 xA[4], xB[4];
    if (p0 < p1) {
#pragma unroll
        for (int q = 0; q < 4; ++q) { xA[q] = ((const pg8::u32x2*)(X + (size_t)(2 * p0) * D) + c.lane)[64 * q]; xB[q] = ((const pg8::u32x2*)(X + (size_t)(2 * p0 + 1) * D) + c.lane)[64 * q]; }
    }
    int jprev = -1; f32x4 gmr[4] = {}, svr[4] = {};
    for (int p = p0; p < p1; ++p) {
        const int r0 = 2 * p, j = row_j(r0);
        f32x4 fA[4], fB[4]; float ssA = 0.f, ssB = 0.f;
#pragma unroll
        for (int q = 0; q < 4; ++q) { fA[q] = pg8::bf4_to_f32(xA[q]); fB[q] = pg8::bf4_to_f32(xB[q]);
            ssA += fA[q].x * fA[q].x + fA[q].y * fA[q].y + fA[q].z * fA[q].z + fA[q].w * fA[q].w; ssB += fB[q].x * fB[q].x + fB[q].y * fB[q].y + fB[q].z * fB[q].z + fB[q].w * fB[q].w; }
        if (p + 1 < p1) {
#pragma unroll
            for (int q = 0; q < 4; ++q) { xA[q] = ((const pg8::u32x2*)(X + (size_t)(2 * (p + 1)) * D) + c.lane)[64 * q]; xB[q] = ((const pg8::u32x2*)(X + (size_t)(2 * (p + 1) + 1) * D) + c.lane)[64 * q]; }
        }
        if (!(SKIPCTX && j == 8)) {
            const float rsA = rsqrtf(wave_sum(ssA) * (1.0f / D) + EPS), rsB = rsqrtf(wave_sum(ssB) * (1.0f / D) + EPS);
            const f32x4* g = (const f32x4*)(c.in[IN_NORMG] + (size_t)(L * 2 + 1) * D) + c.lane;
            const f32x4* sc = (const f32x4*)modp(c, L, j, 4) + c.lane; const f32x4* sh = (const f32x4*)modp(c, L, j, 3) + c.lane;
            unsigned* hA = (unsigned*)(HB + (size_t)r0 * D) + c.lane; unsigned* hB = (unsigned*)(HB + (size_t)(r0 + 1) * D) + c.lane;
            if (j != jprev) { jprev = j;
#pragma unroll
                for (int q = 0; q < 4; ++q) { gmr[q] = g[64 * q] * (1.0f + sc[64 * q]); svr[q] = sh[64 * q]; } }
#pragma unroll
            for (int q = 0; q < 4; ++q) { const f32x4 gm = gmr[q], sv = svr[q];
                fA[q] = fA[q] * rsA * gm + sv; fB[q] = fB[q] * rsB * gm + sv;
                hA[64 * q] = pg8::pk4_fp8(fA[q].x, fA[q].y, fA[q].z, fA[q].w); hB[64 * q] = pg8::pk4_fp8(fB[q].x, fB[q].y, fB[q].z, fB[q].w); }
            __builtin_amdgcn_sched_barrier(0);
            float lgA[16], lgB[16];
#pragma unroll
            for (int e = 0; e < 16; ++e) {
                f32x2 a2 = {0.f, 0.f}, b2 = {0.f, 0.f};
#pragma unroll
                for (int q = 0; q < 4; ++q) { const f32x4 wv = *(const LAS f32x4*)(wT + e * D + 4 * (c.lane + 64 * q));
                    a2 += fA[q].xy * wv.xy; a2 += fA[q].zw * wv.zw; b2 += fB[q].xy * wv.xy; b2 += fB[q].zw * wv.zw; }
                float a = a2.x + a2.y, b = b2.x + b2.y;
                asm volatile("" : "+v"(a), "+v"(b));
                lgA[e] = a; lgB[e] = b;
                if (e & 1) __builtin_amdgcn_sched_barrier(0);
            }
            const int kk = reduce16_k(c.lane);
            { const float mine = reduce16(lgA, c.lane); float mx = mine;
#pragma unroll
              for (int o = 4; o < 64; o <<= 1) mx = fmaxf(mx, __shfl_xor(mx, o));
              const float ex = expf(mine - mx); float den = ex;
#pragma unroll
              for (int o = 4; o < 64; o <<= 1) den += __shfl_xor(den, o);
              if ((c.lane & 3) == 0) AFF[(size_t)r0 * NE + kk] = ex / den; }
            { const float mine = reduce16(lgB, c.lane); float mx = mine;
#pragma unroll
              for (int o = 4; o < 64; o <<= 1) mx = fmaxf(mx, __shfl_xor(mx, o));
              const float ex = expf(mine - mx); float den = ex;
#pragma unroll
              for (int o = 4; o < 64; o <<= 1) den += __shfl_xor(den, o);
              if ((c.lane & 3) == 0) AFF[(size_t)(r0 + 1) * NE + kk] = ex / den; }
        }
    }
}
template <bool SKIPCTX>
__device__ __forceinline__ void phase_norm2_router(const Ctx& c, int L, LAS float* wT) {
    const unsigned short* X = (const unsigned short*)(c.ws + WS_X); unsigned char* HB = (unsigned char*)(c.ws + WS_HB); float* AFF = (float*)(c.ws + WS_AFF);
    const float* WR = c.in[IN_ROUTER] + (size_t)L * D * NE;
    __syncthreads();
    for (int idx = c.tid; idx < D * 4; idx += 512) { const int ch = idx >> 2, e4 = idx & 3; const f32x4 w = *(const f32x4*)(WR + (size_t)ch * NE + 4 * e4);
        wT[(4 * e4 + 0) * D + ch] = w.x; wT[(4 * e4 + 1) * D + ch] = w.y; wT[(4 * e4 + 2) * D + ch] = w.z; wT[(4 * e4 + 3) * D + ch] = w.w; }
    __syncthreads();
    router_pairs<SKIPCTX>(c, L, wT, 32768);
    constexpr int RB0 = 32768;
    pg8::u32x2 xn[4];
    if (RB0 + c.gw < NROWS) {
#pragma unroll
        for (int q = 0; q < 4; ++q) xn[q] = ((const pg8::u32x2*)(X + (size_t)(RB0 + c.gw) * D) + c.lane)[64 * q];
    }
    for (int r = RB0 + c.gw; r < NROWS; r += c.ngw) {
        const int j = row_j(r);
        f32x4 v[4]; float ss = 0.f;
#pragma unroll
        for (int q = 0; q < 4; ++q) { v[q] = pg8::bf4_to_f32(xn[q]); ss += v[q].x * v[q].x + v[q].y * v[q].y + v[q].z * v[q].z + v[q].w * v[q].w; }
        if (r + c.ngw < NROWS) {
#pragma unroll
            for (int q = 0; q < 4; ++q) xn[q] = ((const pg8::u32x2*)(X + (size_t)(r + c.ngw) * D) + c.lane)[64 * q];
        }
        if (SKIPCTX && j == 8) continue;
        const float rstd = rsqrtf(wave_sum(ss) * (1.0f / D) + EPS);
        const f32x4* g = (const f32x4*)(c.in[IN_NORMG] + (size_t)(L * 2 + 1) * D) + c.lane;
        const f32x4* sc = (const f32x4*)modp(c, L, j, 4) + c.lane; const f32x4* sh = (const f32x4*)modp(c, L, j, 3) + c.lane;
        unsigned* hp = (unsigned*)(HB + (size_t)r * D) + c.lane;
        float lg[16]; f32x4 f[4];
#pragma unroll
        for (int q = 0; q < 4; ++q) { f[q] = v[q] * rstd * g[64 * q] * (1.0f + sc[64 * q]) + sh[64 * q]; hp[64 * q] = pg8::pk4_fp8(f[q].x, f[q].y, f[q].z, f[q].w); }
        __builtin_amdgcn_sched_barrier(0);
#pragma unroll
        for (int e = 0; e < 16; ++e) {
            f32x2 a2 = {0.f, 0.f};
#pragma unroll
            for (int q = 0; q < 4; ++q) { const f32x4 wv = *(const LAS f32x4*)(wT + e * D + 4 * (c.lane + 64 * q)); a2 += f[q].xy * wv.xy; a2 += f[q].zw * wv.zw; }
            lg[e] = a2.x + a2.y;
            if (e & 1) __builtin_amdgcn_sched_barrier(0);
        }
        const float mine = reduce16(lg, c.lane);
        const int k = reduce16_k(c.lane);
        float mx = mine;
#pragma unroll
        for (int o = 4; o < 64; o <<= 1) mx = fmaxf(mx, __shfl_xor(mx, o));
        const float ex = expf(mine - mx);
        float den = ex;
#pragma unroll
        for (int o = 4; o < 64; o <<= 1) den += __shfl_xor(den, o);
        if ((c.lane & 3) == 0) AFF[(size_t)r * NE + k] = ex / den;
    }
}

__device__ __forceinline__ void phase_topk(const Ctx& c, LAS unsigned* lds32, int nprob) {
    const float* AFF = (const float*)(c.ws + WS_AFF);
    int* SELROW = (int*)(c.ws + WS_SELROW); float* SELGATE = (float*)(c.ws + WS_SELGATE); int* SLOT = (int*)(c.ws + WS_SLOT);
    LAS unsigned* hist = lds32; LAS unsigned* wsum = lds32 + 256; LAS unsigned* res = lds32 + 272;
    LAS int* srow = (LAS int*)(lds32 + 512);
    const unsigned char* HB = (const unsigned char*)(c.ws + WS_HB); unsigned char* XS = (unsigned char*)(c.ws + WS_XS);
    for (int pid = blockIdx.x; pid < nprob; pid += gridDim.x) {
        const bool lat = pid < 128; const int q = lat ? pid : pid - 128, b = q >> 4, e = q & 15;
        const int N = lat ? T : CL, C = lat ? CAP_LAT : CAP_CTX, row0 = b * RB + (lat ? CL : 0), base = lat ? b * CAP_LAT : NB * CAP_LAT + b * CAP_CTX;
        const int t0 = c.tid * 8; const bool valid = t0 < N;
        unsigned k[8];
#pragma unroll
        for (int i = 0; i < 8; ++i) k[i] = valid ? __float_as_uint(AFF[(size_t)(row0 + t0 + i) * NE + e]) : 0u;
        unsigned prefix = 0u, want = (unsigned)C;
#pragma unroll
        for (int r = 0; r < 4; ++r) {
            const int shift = 24 - 8 * r;
            __syncthreads();
            if (c.tid < 256) hist[c.tid] = 0u;
            __syncthreads();
            if (valid) {
#pragma unroll
                for (int i = 0; i < 8; ++i) if (r == 0 || (k[i] >> (shift + 8)) == prefix) __hip_atomic_fetch_add(&hist[(k[i] >> shift) & 255u], 1u, __ATOMIC_RELAXED, __HIP_MEMORY_SCOPE_WORKGROUP);
            }
            __syncthreads();
            if (c.wave == 0) {
                const unsigned h0 = hist[4 * c.lane], h1 = hist[4 * c.lane + 1], h2 = hist[4 * c.lane + 2], h3 = hist[4 * c.lane + 3];
                unsigned suf = h0 + h1 + h2 + h3;
#pragma unroll
                for (int off = 1; off < 64; off <<= 1) { const unsigned o = __shfl_down(suf, off); if (c.lane + off < 64) suf += o; }
                unsigned nxt = __shfl_down(suf, 1); if (c.lane == 63) nxt = 0u;
                if (suf >= want && nxt < want) {
                    unsigned above = nxt; int d;
                    if (above + h3 >= want) d = 3; else { above += h3; if (above + h2 >= want) d = 2; else { above += h2; if (above + h1 >= want) d = 1; else { above += h1; d = 0; } } }
                    res[0] = (unsigned)(4 * c.lane + d); res[1] = want - above;
                }
            }
            __syncthreads();
            prefix = (prefix << 8) | res[0]; want = res[1];
        }
        const unsigned thr = prefix, need_eq = want;
        unsigned cg = 0u, ce = 0u;
#pragma unroll
        for (int i = 0; i < 8; ++i) { cg += (valid && k[i] > thr) ? 1u : 0u; ce += (valid && k[i] == thr) ? 1u : 0u; }
        unsigned incl = cg | (ce << 16);
#pragma unroll
        for (int off = 1; off < 64; off <<= 1) { const unsigned o = __shfl_up(incl, off); if (c.lane >= off) incl += o; }
        __syncthreads();
        if (c.lane == 63) wsum[c.wave] = incl;
        __syncthreads();
        unsigned wbase = 0u;
#pragma unroll
        for (int w = 0; w < 8; ++w) if (w < c.wave) wbase += wsum[w];
        const unsigned excl = wbase + incl - (cg | (ce << 16));
        unsigned gb = excl & 0xffffu, eb = excl >> 16;
        if (valid) {
#pragma unroll
            for (int i = 0; i < 8; ++i) {
                const int row = row0 + t0 + i; const bool isg = k[i] > thr, ise = k[i] == thr;
                const bool sel = isg || (ise && eb < need_eq);
                const unsigned sp = (unsigned)base + gb + (eb < need_eq ? eb : need_eq);
                if (sel) { SELROW[e * EROWS + sp] = row; SELGATE[e * EROWS + sp] = __uint_as_float(k[i]); SLOT[(size_t)row * NE + e] = (int)sp; srow[sp - (unsigned)base] = row; }
                else SLOT[(size_t)row * NE + e] = -1;
                gb += isg ? 1u : 0u; eb += ise ? 1u : 0u;
            }
        }
        __syncthreads();
        for (int s0 = c.wave * 16; s0 < C; s0 += 128) {
            pg8::u32x4 v4[16];
#pragma unroll
            for (int j = 0; j < 16; ++j) v4[j] = *(const pg8::u32x4*)(HB + (size_t)srow[s0 + j] * D + c.lane * 16);
#pragma unroll
            for (int j = 0; j < 16; ++j) *(pg8::u32x4*)(XS + ((size_t)e * EROWS + base + s0 + j) * D + c.lane * 16) = v4[j];
        }
    }
}

__device__ __forceinline__ void post_ld32(const unsigned short* p, float (&v)[32]) {
#pragma unroll
    for (int q = 0; q < 4; ++q) { const pg8::u32x4 w = ((const pg8::u32x4*)p)[q];
#pragma unroll
        for (int e = 0; e < 4; ++e) { v[8 * q + 2 * e] = __uint_as_float(w[e] << 16); v[8 * q + 2 * e + 1] = __uint_as_float(w[e] & 0xffff0000u); } }
}
__device__ __forceinline__ void post_raw(const unsigned short* p, pg8::u32x4 (&w)[4]) {
#pragma unroll
    for (int q = 0; q < 4; ++q) w[q] = ((const pg8::u32x4*)p)[q];
}
__device__ __forceinline__ void post_cvt(const pg8::u32x4 (&w)[4], float (&v)[32]) {
#pragma unroll
    for (int q = 0; q < 4; ++q)
#pragma unroll
        for (int e = 0; e < 4; ++e) { v[8 * q + 2 * e] = __uint_as_float(w[q][e] << 16); v[8 * q + 2 * e + 1] = __uint_as_float(w[q][e] & 0xffff0000u); }
}
__device__ __forceinline__ void post_st32(unsigned short* p, const float (&v)[32], float sc) {
#pragma unroll
    for (int q = 0; q < 4; ++q) { pg8::u32x4 w;
#pragma unroll
        for (int e = 0; e < 4; ++e) w[e] = pg8::cvt_pk_bf16(v[8 * q + 2 * e] * sc, v[8 * q + 2 * e + 1] * sc);
        ((pg8::u32x4*)p)[q] = w; }
}
__device__ __forceinline__ void post_rope_l(float (&v)[32], const LAS float* cs  ) {
#pragma unroll
    for (int f4 = 0; f4 < 8; ++f4) { const f32x4 t4 = ((const LAS f32x4*)cs)[f4];
        { const float x1 = v[2 * f4], x2 = v[16 + 2 * f4]; v[2 * f4] = x1 * t4.x - x2 * t4.y; v[16 + 2 * f4] = x1 * t4.y + x2 * t4.x; }
        { const float x1 = v[2 * f4 + 1], x2 = v[16 + 2 * f4 + 1]; v[2 * f4 + 1] = x1 * t4.z - x2 * t4.w; v[16 + 2 * f4 + 1] = x1 * t4.w + x2 * t4.z; } }
}
__device__ __forceinline__ void post_rope(float (&v)[32], const float* cs  ) {
#pragma unroll
    for (int f4 = 0; f4 < 8; ++f4) { const f32x4 t4 = ((const f32x4*)cs)[f4];
        { const float x1 = v[2 * f4], x2 = v[16 + 2 * f4]; v[2 * f4] = x1 * t4.x - x2 * t4.y; v[16 + 2 * f4] = x1 * t4.y + x2 * t4.x; }
        { const float x1 = v[2 * f4 + 1], x2 = v[16 + 2 * f4 + 1]; v[2 * f4 + 1] = x1 * t4.z - x2 * t4.w; v[16 + 2 * f4 + 1] = x1 * t4.w + x2 * t4.z; } }
}
__device__ __forceinline__ void phase_post(const Ctx& c, int i, LAS unsigned char* lds) {
    typedef pg8::bf16x8 bf16x8;
    const unsigned short* P = (const unsigned short*)(c.ws + WS_P); const float* rope = (const float*)(c.ws + WS_ROPE);
    unsigned short* QA = (unsigned short*)(c.ws + WS_QA); unsigned short* KA = (unsigned short*)(c.ws + WS_KA); unsigned short* VA = (unsigned short*)(c.ws + WS_VA);
    unsigned short* RQ = (unsigned short*)(c.ws + WS_RQ); unsigned short* RK = (unsigned short*)(c.ws + WS_RK); unsigned short* RV = (unsigned short*)(c.ws + WS_RV);
    float* U = (float*)(c.ws + WS_U);
    const float* qkg = c.in[IN_QKG] + (size_t)i * 2 * 64;
    constexpr int VTS = 0, KTF = 17408, KTB = 34816;
    const int grp = c.tid >> 8, r = (c.tid & 255) >> 1, half = c.tid & 1;
    const int li = c.lane & 15, q4 = c.lane >> 4;
    pg8::u32x4 ra[4], rb[4], rc[4];
#define PP_LOAD(u_) do { const int hh_ = (u_) & 7, bc_ = (u_) >> 3, b_ = bc_ / 34, cch_ = bc_ - b_ * 34; const size_t row_ = (size_t)(b_ * RB + cch_ * 128 + r); \
        post_raw(P + row_ * INW + (grp ? 512 : 0) + hh_ * 64 + 32 * half, ra); post_raw(P + row_ * INW + (grp ? 2048 : 1024) + hh_ * 64 + 32 * half, rb); \
        if (hh_ < 2 && grp == 0) post_raw(P + row_ * INW + 2560 + hh_ * 64 + 32 * half, rc); } while (0)
    if ((int)blockIdx.x < NB * 34 * 8) PP_LOAD((int)blockIdx.x);
    LAS float* ropeL = (LAS float*)(lds + 53248); LAS float* qkL = ropeL + 64 * 36;
    for (int i2 = c.tid; i2 < 64 * 32; i2 += 512) ropeL[(i2 >> 5) * 36 + (i2 & 31)] = rope[i2];
    if (c.tid < 128) qkL[c.tid] = qkg[c.tid];
    __syncthreads();
    for (int unit = blockIdx.x; unit < NB * 34 * 8; unit += gridDim.x) {
        const int hh = unit & 7, bc = unit >> 3, b = bc / 34, cch = bc - b * 34, row0 = b * RB + cch * 128, bh = b * 8 + hh;
        const bool latent = cch >= 2;
        const size_t row = (size_t)(row0 + r);
        const int tpos = cch * 128 + r - CL;
        const LAS float* cs = ropeL + (half == 0 ? (tpos >> 6) : (tpos & 63)) * 36;
        const float lgf = -expf(c.in[IN_RETRATE][(i * 2 + 0) * 8 + hh]) * 1.4426950408889634f, lgb = -expf(c.in[IN_RETRATE][(i * 2 + 1) * 8 + hh]) * 1.4426950408889634f;
        __syncthreads();
        float v[32];
        post_cvt(ra, v);
        if (grp) {
#pragma unroll
            for (int d = 0; d < 32; ++d) v[d] *= 0.125f; }
        if (latent) post_rope_l(v, cs);
        post_st32((grp ? RK : RQ) + row * 512 + hh * 64 + 32 * half, v, 1.0f);
        if (grp) { const float wf = exp2f(lgf * (float)(127 - r)), wb = exp2f(lgb * (float)r);
#pragma unroll
            for (int d = 0; d < 32; d += 2) { const unsigned pf = pg8::cvt_pk_bf16(v[d] * wf, v[d + 1] * wf), pb = pg8::cvt_pk_bf16(v[d] * wb, v[d + 1] * wb);
                *(LAS unsigned short*)(lds + KTF + (32 * half + d) * 272 + r * 2) = (unsigned short)(pf & 0xffffu); *(LAS unsigned short*)(lds + KTF + (32 * half + d + 1) * 272 + r * 2) = (unsigned short)(pf >> 16);
                *(LAS unsigned short*)(lds + KTB + (32 * half + d) * 272 + r * 2) = (unsigned short)(pb & 0xffffu); *(LAS unsigned short*)(lds + KTB + (32 * half + d + 1) * 272 + r * 2) = (unsigned short)(pb >> 16); } }
        post_cvt(rb, v);
        if (grp == 0) {
#pragma unroll
            for (int d = 0; d < 32; d += 2) { const unsigned pv = pg8::cvt_pk_bf16(v[d], v[d + 1]);
                *(LAS unsigned short*)(lds + VTS + (32 * half + d) * 272 + r * 2) = (unsigned short)(pv & 0xffffu); *(LAS unsigned short*)(lds + VTS + (32 * half + d + 1) * 272 + r * 2) = (unsigned short)(pv >> 16); }
        } else {
            float ss = 0.f;
#pragma unroll
            for (int d = 0; d < 32; ++d) ss += v[d] * v[d];
            ss += __shfl_xor(ss, 1);
            const float rs = rsqrtf(ss * (1.0f / 64.0f) + EPS);
#pragma unroll
            for (int d = 0; d < 32; ++d) v[d] = v[d] * rs * qkL[32 * half + d];
            if (latent) post_rope_l(v, cs);
            post_st32(QA + row * 512 + hh * 64 + 32 * half, v, attn_body::C2);
        }
        if (hh < 2 && grp == 0) {
            post_cvt(rc, v);
            {
                float ss = 0.f;
#pragma unroll
                for (int d = 0; d < 32; ++d) ss += v[d] * v[d];
                ss += __shfl_xor(ss, 1);
                const float rs = rsqrtf(ss * (1.0f / 64.0f) + EPS);
#pragma unroll
                for (int d = 0; d < 32; ++d) v[d] = v[d] * rs * qkL[64 + 32 * half + d];
                if (latent) post_rope_l(v, cs);
                post_st32(KA + row * 128 + hh * 64 + 32 * half, v, 1.0f);
            }
        }
        if (unit + (int)gridDim.x < NB * 34 * 8) PP_LOAD(unit + (int)gridDim.x);
        __syncthreads();
        { const int dir = c.wave >> 2, dvt = c.wave & 3;
            bf16x8 af[4];
#pragma unroll
            for (int u = 0; u < 4; ++u) af[u] = *(const LAS bf16x8*)(lds + VTS + (16 * dvt + li) * 272 + (32 * u + 8 * q4) * 2);
            float* uo = U + ((size_t)(bh * 34 + cch) * 2 + dir) * 4096;
#pragma unroll
            for (int dkt = 0; dkt < 4; ++dkt) {
                f32x4 a = {0.f, 0.f, 0.f, 0.f};
#pragma unroll
                for (int u = 0; u < 4; ++u) { const bf16x8 kf = *(const LAS bf16x8*)(lds + (dir ? KTB : KTF) + (16 * dkt + li) * 272 + (32 * u + 8 * q4) * 2); a = __builtin_amdgcn_mfma_f32_16x16x32_bf16(af[u], kf, a, 0, 0, 0); }
#pragma unroll
                for (int rr = 0; rr < 4; ++rr) uo[(16 * dvt + 4 * q4 + rr) * 64 + 16 * dkt + li] = a[rr];
            } }
    }
}

#undef PP_LOAD
__device__ __forceinline__ void phase_ret_prefix(const Ctx& c, int i) {
    const float* U = (const float*)(c.ws + WS_U); unsigned short* ET = (unsigned short*)(c.ws + WS_ET);
    for (int chain = c.gt; chain < 64 * 2 * 4096; chain += c.ngt) {
        const int bh = chain >> 13, dir = (chain >> 12) & 1, el = chain & 4095, hh = bh & 7;
        const float g128 = expf(-expf(c.in[IN_RETRATE][(i * 2 + dir) * 8 + hh]) * 128.0f);
        float S = 0.f;
#pragma unroll
        for (int st = 0; st < 34; ++st) {
            const int cch = dir == 0 ? st : (st < 2 ? 1 - st : 35 - st);
            const size_t o = ((size_t)(bh * 34 + cch) * 2 + dir) * 4096 + el;
            ET[o] = (unsigned short)(pg8::cvt_pk_bf16(S, 0.f) & 0xffffu);
            S = g128 * S + U[o];
        }
    }
}
__device__ __forceinline__ void phase_ret_main(const Ctx& c, int i, LAS unsigned char* lds) {
    typedef pg8::bf16x8 bf16x8;
    const unsigned short* RQ = (const unsigned short*)(c.ws + WS_RQ); const unsigned short* RK = (const unsigned short*)(c.ws + WS_RK); const unsigned short* RV = (const unsigned short*)(c.ws + WS_RV);
    const unsigned short* ET = (const unsigned short*)(c.ws + WS_ET); const unsigned short* P = (const unsigned short*)(c.ws + WS_P); unsigned short* MIX = (unsigned short*)(c.ws + WS_MIX);
    const float* gn = c.in[IN_RETGN] + (size_t)i * 512;
    constexpr int QS = 0, KS = 18432, VTS = 36864, EF = 54272, EB = 63488;
    const int li = c.lane & 15, q4 = c.lane >> 4, i0 = 16 * c.wave, ig = i0 + li;
    pg8::u32x4 gq[2], gk[2], gv[2], gef, geb;
#define RM_LOAD(u_) do { const int bh_ = (u_) / 34, cch_ = (u_) - bh_ * 34, row0_ = (bh_ >> 3) * RB + cch_ * 128, hh_ = bh_ & 7; \
        _Pragma("unroll") for (int t2 = 0; t2 < 2; ++t2) { const int pc = c.tid + 512 * t2, r = pc >> 3, ch = pc & 7; const size_t go = (size_t)(row0_ + r) * 512 + hh_ * 64 + ch * 8; \
            gq[t2] = *(const pg8::u32x4*)(RQ + go); gk[t2] = *(const pg8::u32x4*)(RK + go); gv[t2] = *(const pg8::u32x4*)(P + (size_t)(row0_ + r) * INW + 1024 + hh_ * 64 + ch * 8); } \
        { const int r = c.tid >> 3, ch = c.tid & 7; const size_t go = ((size_t)(bh_ * 34 + cch_) * 2) * 4096 + r * 64 + ch * 8; gef = *(const pg8::u32x4*)(ET + go); geb = *(const pg8::u32x4*)(ET + go + 4096); } } while (0)
    if ((int)blockIdx.x < 64 * 34) RM_LOAD((int)blockIdx.x);
    for (int unit = blockIdx.x; unit < 64 * 34; unit += gridDim.x) {
        const int bh = unit / 34, cch = unit - bh * 34, b = bh >> 3, hh = bh & 7, row0 = b * RB + cch * 128;
        const float lgf = -expf(c.in[IN_RETRATE][(i * 2 + 0) * 8 + hh]) * 1.4426950408889634f, lgb = -expf(c.in[IN_RETRATE][(i * 2 + 1) * 8 + hh]) * 1.4426950408889634f;
        __syncthreads();
#pragma unroll
        for (int t2 = 0; t2 < 2; ++t2) { const int pc = c.tid + 512 * t2, r = pc >> 3, ch = pc & 7;
            *(LAS pg8::u32x4*)(lds + QS + r * 144 + ch * 16) = gq[t2];
            *(LAS pg8::u32x4*)(lds + KS + r * 144 + ch * 16) = gk[t2];
            const pg8::u32x4 vw = gv[t2];
#pragma unroll
            for (int e = 0; e < 4; ++e) { *(LAS unsigned short*)(lds + VTS + (ch * 8 + 2 * e) * 272 + r * 2) = (unsigned short)(vw[e] & 0xffffu); *(LAS unsigned short*)(lds + VTS + (ch * 8 + 2 * e + 1) * 272 + r * 2) = (unsigned short)(vw[e] >> 16); } }
        { const int r = c.tid >> 3, ch = c.tid & 7; *(LAS pg8::u32x4*)(lds + EF + r * 144 + ch * 16) = gef; *(LAS pg8::u32x4*)(lds + EB + r * 144 + ch * 16) = geb; }
        if (unit + (int)gridDim.x < 64 * 34) RM_LOAD(unit + (int)gridDim.x);
        __syncthreads();
        bf16x8 qf[2];
#pragma unroll
        for (int s = 0; s < 2; ++s) qf[s] = *(const LAS bf16x8*)(lds + QS + (i0 + li) * 144 + (32 * s + 8 * q4) * 2);
        pg8::u32x2 pk[8];
#pragma unroll
        for (int jt = 0; jt < 8; ++jt) {
            f32x4 a = {0.f, 0.f, 0.f, 0.f};
#pragma unroll
            for (int s = 0; s < 2; ++s) { const bf16x8 kf = *(const LAS bf16x8*)(lds + KS + (16 * jt + li) * 144 + (32 * s + 8 * q4) * 2); a = __builtin_amdgcn_mfma_f32_16x16x32_bf16(kf, qf[s], a, 0, 0, 0); }
            float pv[4];
#pragma unroll
            for (int r = 0; r < 4; ++r) { const int dl = ig - (16 * jt + 4 * q4 + r); const float w = dl >= 0 ? exp2f(lgf * (float)dl) : exp2f(lgb * (float)(-dl)); pv[r] = a[r] * w; }
            pk[jt] = (pg8::u32x2){pg8::cvt_pk_bf16(pv[0], pv[1]), pg8::cvt_pk_bf16(pv[2], pv[3])};
        }
        const float sf = exp2f(lgf * (float)(ig + 1)), sb = exp2f(lgb * (float)(128 - ig));
        f32x4 oacc[4];
#pragma unroll
        for (int dvt = 0; dvt < 4; ++dvt) {
            f32x4 o = {0.f, 0.f, 0.f, 0.f};
#pragma unroll
            for (int u = 0; u < 4; ++u) {
                const pg8::u32x2 vlo = *(const LAS pg8::u32x2*)(lds + VTS + (16 * dvt + li) * 272 + (32 * u + 4 * q4) * 2), vhi = *(const LAS pg8::u32x2*)(lds + VTS + (16 * dvt + li) * 272 + (32 * u + 16 + 4 * q4) * 2);
                const pg8::u32x4 av = {vlo.x, vlo.y, vhi.x, vhi.y}, bv = {pk[2 * u].x, pk[2 * u].y, pk[2 * u + 1].x, pk[2 * u + 1].y};
                o = __builtin_amdgcn_mfma_f32_16x16x32_bf16(__builtin_bit_cast(bf16x8, av), __builtin_bit_cast(bf16x8, bv), o, 0, 0, 0);
            }
            f32x4 tf = {0.f, 0.f, 0.f, 0.f}, tb = {0.f, 0.f, 0.f, 0.f};
#pragma unroll
            for (int s = 0; s < 2; ++s) {
                const bf16x8 ef = *(const LAS bf16x8*)(lds + EF + (16 * dvt + li) * 144 + (32 * s + 8 * q4) * 2), eb = *(const LAS bf16x8*)(lds + EB + (16 * dvt + li) * 144 + (32 * s + 8 * q4) * 2);
                tf = __builtin_amdgcn_mfma_f32_16x16x32_bf16(ef, qf[s], tf, 0, 0, 0); tb = __builtin_amdgcn_mfma_f32_16x16x32_bf16(eb, qf[s], tb, 0, 0, 0);
            }
            oacc[dvt] = o + tf * sf + tb * sb;
        }
        float sm = 0.f;
#pragma unroll
        for (int dvt = 0; dvt < 4; ++dvt) sm += (oacc[dvt].x + oacc[dvt].y) + (oacc[dvt].z + oacc[dvt].w);
        sm += __shfl_xor(sm, 16); sm += __shfl_xor(sm, 32);
        const float mu = sm * (1.0f / 64.0f); float vr = 0.f;
#pragma unroll
        for (int dvt = 0; dvt < 4; ++dvt) { oacc[dvt] = oacc[dvt] - mu; vr += (oacc[dvt].x * oacc[dvt].x + oacc[dvt].y * oacc[dvt].y) + (oacc[dvt].z * oacc[dvt].z + oacc[dvt].w * oacc[dvt].w); }
        vr += __shfl_xor(vr, 16); vr += __shfl_xor(vr, 32);
        const float rs = rsqrtf(vr * (1.0f / 64.0f) + EPS);
        const size_t row = (size_t)(row0 + ig);
#pragma unroll
        for (int dvt = 0; dvt < 4; ++dvt) { const int dvc = hh * 64 + 16 * dvt + 4 * q4;
            const pg8::u32x2 gw = *(const pg8::u32x2*)(P + row * INW + 1536 + dvc); const f32x4 gt = {__uint_as_float(gw.x << 16), __uint_as_float(gw.x & 0xffff0000u), __uint_as_float(gw.y << 16), __uint_as_float(gw.y & 0xffff0000u)}, gg = *(const f32x4*)(gn + dvc); const f32x4 y = oacc[dvt] * rs * gg;
            *(pg8::u32x2*)(MIX + row * D + dvc) = (pg8::u32x2){pg8::cvt_pk_bf16(gt.x * pg8::fast_sigmoid(gt.x) * y.x, gt.y * pg8::fast_sigmoid(gt.y) * y.y), pg8::cvt_pk_bf16(gt.z * pg8::fast_sigmoid(gt.z) * y.z, gt.w * pg8::fast_sigmoid(gt.w) * y.w)}; }
    }
}

#undef RM_LOAD
__device__ __forceinline__ void phase_attention(const Ctx& c, int i, char* lds) {
    const attn_body::bf16* QA = (const attn_body::bf16*)(c.ws + WS_QA); const attn_body::bf16* KA = (const attn_body::bf16*)(c.ws + WS_KA); const attn_body::bf16* VA = (const attn_body::bf16*)(c.ws + WS_P) + 2688;
    attn_body::bf16* MIX = (attn_body::bf16*)(c.ws + WS_MIX);
    const int G = gridDim.x, bx = blockIdx.x, vcu = (G % 8 == 0) ? (bx % 8) * (G / 8) + bx / 8 : bx;
    float gq = fabsf(c.in[IN_QKG][(size_t)i * 128 + c.lane]), gk = fabsf(c.in[IN_QKG][(size_t)i * 128 + 64 + c.lane]);
#pragma unroll
    for (int o = 1; o < 64; o <<= 1) { gq = fmaxf(gq, __shfl_xor(gq, o)); gk = fmaxf(gk, __shfl_xor(gk, o)); }
    const bool bounded = __builtin_amdgcn_readfirstlane(64.0f * gq * gk * attn_body::C2 < 40.0f ? 1 : 0) != 0;
    for (int U = vcu; U < NB * 8 * 17; U += G) {
        int bh, qrow0, NT;
        if (U < NB * 8 * 16) { bh = U >> 4; qrow0 = (bh >> 3) * RB + CL + (U & 15) * 256; NT = RB / 64; }
        else { bh = U - NB * 8 * 16; qrow0 = (bh >> 3) * RB; NT = CL / 64; }
        const int b = bh >> 3, hh = bh & 7;
        if (bounded) attn_body::attn_unit<8, true>(QA + (size_t)qrow0 * 512 + hh * 64, KA + (size_t)(b * RB) * 128 + (hh >> 2) * 64, VA + (size_t)(b * RB) * INW + (hh >> 2) * 64,
                                MIX + (size_t)qrow0 * 1024 + 512 + hh * 64, NT, lds, c.wave);
        else attn_body::attn_unit<8, false>(QA + (size_t)qrow0 * 512 + hh * 64, KA + (size_t)(b * RB) * 128 + (hh >> 2) * 64, VA + (size_t)(b * RB) * INW + (hh >> 2) * 64,
                                MIX + (size_t)qrow0 * 1024 + 512 + hh * 64, NT, lds, c.wave);
    }
}

__device__ __forceinline__ void phase_s5_ops(const Ctx& c, LAS float* ldsf) {
    LAS float* Pre = ldsf; LAS float* Pim = ldsf + 4608; LAS float* KZr = ldsf + 9216; LAS float* KZi = ldsf + 9344;
    LAS float* Bre = ldsf + 9472; LAS float* Bim = ldsf + 10496; LAS float* Cre = ldsf + 11520; LAS float* Cim = ldsf + 13568;
    LAS float* KV = ldsf + 15616;
#define S5P(dir, pw, p) (((dir) * 64 + (p)) * 36 + (pw))
    for (int task = c.vb; task < 2 * 64 * 2; task += c.vg) {
        const int i = task >> 7, g = (task >> 1) & 63, hf = task & 1;
        __syncthreads();
        if (c.tid < 128) {
            const int dir = c.tid >> 6, p = c.tid & 63;
            const float a_re = c.in[IN_S5ARE][((i * 2 + dir) * 64 + g) * 64 + p], a_im = c.in[IN_S5AIM][((i * 2 + dir) * 64 + g) * 64 + p];
            const float dt = expf(c.in[IN_S5DT][(i * 2 + dir) * 64 + g]);
            const float lre = fminf(a_re, -1e-4f), lim = a_im, ea = lre * dt, eb = lim * dt;
            const float cb = cosf(eb), sb = sinf(eb), sh = sinf(0.5f * eb), mag = expf(ea);
            { float pr = 1.0f, pi = 0.0f; const float ar = mag * cb, ai = mag * sb;
                for (int dl = 0; dl <= 32; ++dl) { Pre[S5P(dir, dl, p)] = pr; Pim[S5P(dir, dl, p)] = pi; const float nr_ = pr * ar - pi * ai, ni_ = pr * ai + pi * ar; pr = nr_; pi = ni_; } }
            const float nr = expm1f(ea) * cb - 2.0f * sh * sh, ni = mag * sb, den = lre * lre + lim * lim;
            KZr[dir * 64 + p] = (nr * lre + ni * lim) / den; KZi[dir * 64 + p] = (ni * lre - nr * lim) / den;
        }
        for (int idx = c.tid; idx < 1024; idx += 512) { Bre[idx] = c.in[IN_S5BRE][(size_t)(i * 64 + g) * 1024 + idx]; Bim[idx] = c.in[IN_S5BIM][(size_t)(i * 64 + g) * 1024 + idx]; }
        for (int idx = c.tid; idx < 2048; idx += 512) { const int dir = idx >> 10, rem = idx & 1023;
            Cre[idx] = c.in[IN_S5CRE][((size_t)(i * 2 + dir) * 64 + g) * 1024 + rem]; Cim[idx] = c.in[IN_S5CIM][((size_t)(i * 2 + dir) * 64 + g) * 1024 + rem]; }
        __syncthreads();
        {
            const int dir = c.tid >> 8, ko = (c.tid >> 4) & 15, ki = c.tid & 15;
            float acc[32];
#pragma unroll
            for (int dl = 0; dl < 32; ++dl) acc[dl] = 0.f;
            for (int p = 0; p < 64; ++p) {
                const float kr = KZr[dir * 64 + p], kq = KZi[dir * 64 + p], br = Bre[p * 16 + ki], bi = Bim[p * 16 + ki], cr = Cre[(dir * 16 + ko) * 64 + p], ci = Cim[(dir * 16 + ko) * 64 + p];
                const float gr = kr * br - kq * bi, gi = kr * bi + kq * br, tr = cr * gr - ci * gi, ti = cr * gi + ci * gr;
#pragma unroll
                for (int d4 = 0; d4 < 8; ++d4) { const f32x4 pr = *(const LAS f32x4*)(Pre + S5P(dir, 4 * d4, p)), pi = *(const LAS f32x4*)(Pim + S5P(dir, 4 * d4, p));
                    acc[4 * d4] += tr * pr.x - ti * pi.x; acc[4 * d4 + 1] += tr * pr.y - ti * pi.y; acc[4 * d4 + 2] += tr * pr.z - ti * pi.z; acc[4 * d4 + 3] += tr * pr.w - ti * pi.w; }
            }
#pragma unroll
            for (int dl = 0; dl < 32; ++dl) KV[((dir * 32 + dl) * 16 + ko) * 16 + ki] = acc[dl];
        }
        __syncthreads();
        unsigned* TV = (unsigned*)(c.ws + WS_TV) + ((size_t)(i * 64 + g) * 512 * 768) / 2;
        const float* dsk = c.in[IN_S5D] + (size_t)i * D + 16 * g;
        if (c.tid < 384) {
            const int kp = c.tid, kk = 2 * kp;
            if (kk < 512) {
                const int j = kk >> 4, ki = kk & 15;
                for (int it = 16 * hf; it < 16 * hf + 16; ++it) {
                    const int dl = it > j ? it - j : j - it, dir = it > j ? 0 : 1;
                    for (int ko = 0; ko < 16; ++ko) {
                        float v0, v1;
                        if (it != j) { v0 = KV[((dir * 32 + dl) * 16 + ko) * 16 + ki]; v1 = KV[((dir * 32 + dl) * 16 + ko) * 16 + ki + 1]; }
                        else { v0 = KV[(ko) * 16 + ki] + KV[((32) * 16 + ko) * 16 + ki] + (ko == ki ? dsk[ko] : 0.f); v1 = KV[(ko) * 16 + ki + 1] + KV[((32) * 16 + ko) * 16 + ki + 1] + (ko == ki + 1 ? dsk[ko] : 0.f); }
                        TV[(size_t)(it * 16 + ko) * 384 + kp] = pg8::cvt_pk_bf16(v0, v1);
                    }
                }
            } else {
                const int q = kk - 512, dir = q >> 7, part = (q >> 6) & 1, p = q & 63;
                for (int it = 16 * hf; it < 16 * hf + 16; ++it) {
                    const int pw = dir == 0 ? it + 1 : 32 - it;
                    const float pr0 = Pre[S5P(dir, pw, p)], pi0 = Pim[S5P(dir, pw, p)], pr1 = Pre[S5P(dir, pw, p + 1)], pi1 = Pim[S5P(dir, pw, p + 1)];
                    for (int ko = 0; ko < 16; ++ko) {
                        const float cr0 = Cre[(dir * 16 + ko) * 64 + p], ci0 = Cim[(dir * 16 + ko) * 64 + p], cr1 = Cre[(dir * 16 + ko) * 64 + p + 1], ci1 = Cim[(dir * 16 + ko) * 64 + p + 1];
                        const float v0 = part == 0 ? (cr0 * pr0 - ci0 * pi0) : -(cr0 * pi0 + ci0 * pr0), v1 = part == 0 ? (cr1 * pr1 - ci1 * pi1) : -(cr1 * pi1 + ci1 * pr1);
                        TV[(size_t)(it * 16 + ko) * 384 + kp] = pg8::cvt_pk_bf16(v0, v1);
                    }
                }
            }
        }
        unsigned* WS5 = (unsigned*)(c.ws + WS_WS5) + ((size_t)(i * 64 + g) * 256 * 512) / 2;
        if (c.tid < 256) {
            const int kp = c.tid, kk = 2 * kp, j = kk >> 4, ki = kk & 15, dir = hf, pw = dir == 0 ? 31 - j : j;
            for (int pp = 0; pp < 128; ++pp) {
                const int part = pp >> 6, p = pp & 63;
                const float pr = Pre[S5P(dir, pw, p)], pi = Pim[S5P(dir, pw, p)], kr = KZr[dir * 64 + p], kq = KZi[dir * 64 + p];
                const float gr = pr * kr - pi * kq, gi = pr * kq + pi * kr, br0 = Bre[p * 16 + ki], bi0 = Bim[p * 16 + ki], br1 = Bre[p * 16 + ki + 1], bi1 = Bim[p * 16 + ki + 1];
                const float v0 = part == 0 ? (gr * br0 - gi * bi0) : (gr * bi0 + gi * br0), v1 = part == 0 ? (gr * br1 - gi * bi1) : (gr * bi1 + gi * br1);
                WS5[(size_t)(128 * hf + pp) * 256 + kp] = pg8::cvt_pk_bf16(v0, v1);
            }
        }
    }
#undef S5P
}
__device__ __forceinline__ void phase_s5_carry(const Ctx& c, int i) {
    const unsigned short* SL = (const unsigned short*)(c.ws + WS_SL); unsigned short* AS5 = (unsigned short*)(c.ws + WS_AS5);
    for (int id = c.gt; id < 64 * 8 * 2 * 64; id += c.ngt) {
        const int p = id & 63, dir = (id >> 6) & 1, b = (id >> 7) & 7, g = id >> 10;
        const float a_re = c.in[IN_S5ARE][((i * 2 + dir) * 64 + g) * 64 + p], a_im = c.in[IN_S5AIM][((i * 2 + dir) * 64 + g) * 64 + p];
        const float dt = expf(c.in[IN_S5DT][(i * 2 + dir) * 64 + g]);
        const float lre = fminf(a_re, -1e-4f), m32 = expf(lre * dt * 32.0f), an = a_im * dt * 32.0f, ar = m32 * cosf(an), ai = m32 * sinf(an);
        float xr = 0.f, xi = 0.f;
        for (int s0 = 0; s0 < 136; s0 += 17) {
            float sr[17], si[17]; size_t rr[17];
#pragma unroll
            for (int k = 0; k < 17; ++k) { const int st = s0 + k, cch = dir == 0 ? st : (st < 8 ? 7 - st : 143 - st);
                rr[k] = (size_t)g * 1280 + b * 136 + cch; sr[k] = __uint_as_float((unsigned)SL[rr[k] * 256 + dir * 128 + p] << 16); si[k] = __uint_as_float((unsigned)SL[rr[k] * 256 + dir * 128 + 64 + p] << 16); }
#pragma unroll
            for (int k = 0; k < 17; ++k) {
                unsigned short* xo = AS5 + rr[k] * 768 + 512 + dir * 128 + p;
                xo[0] = (unsigned short)(pg8::cvt_pk_bf16(xr, 0.f) & 0xffffu); xo[64] = (unsigned short)(pg8::cvt_pk_bf16(xi, 0.f) & 0xffffu);
                const float nxr = ar * xr - ai * xi + sr[k], nxi = ar * xi + ai * xr + si[k];
                xr = nxr; xi = nxi;
            }
        }
    }
}

__device__ __forceinline__ void cvt_item(const float* W, int ldw, int k0, int scol0, unsigned short* WT, int K, int drow0, LAS float* scr, int lane) {
    float wv[32];
#pragma unroll
    for (int i = 0; i < 32; ++i) wv[i] = W[(size_t)(k0 + 2 * i + (lane >> 5)) * ldw + scol0 + (lane & 31)];
#pragma unroll
    for (int i = 0; i < 32; ++i) scr[(2 * i + (lane >> 5)) * 33 + (lane & 31)] = wv[i];
    asm volatile("s_waitcnt lgkmcnt(0)" ::: "memory");
    const int cc = lane & 7;
#pragma unroll
    for (int j = 0; j < 4; ++j) { const int n = (lane >> 3) + 8 * j; const LAS float* s = scr + (8 * cc) * 33 + n;
        pg8::u32x4 o; o.x = pg8::cvt_pk_bf16(s[0 * 33], s[1 * 33]); o.y = pg8::cvt_pk_bf16(s[2 * 33], s[3 * 33]); o.z = pg8::cvt_pk_bf16(s[4 * 33], s[5 * 33]); o.w = pg8::cvt_pk_bf16(s[6 * 33], s[7 * 33]);
        *(pg8::u32x4*)(WT + (size_t)(drow0 + n) * K + k0 + 8 * cc) = o; }
    asm volatile("s_waitcnt lgkmcnt(0)" ::: "memory");
}
__device__ __forceinline__ void cvt_item8(const float* W, int ldw, int k0, int scol0, unsigned char* WT, int K, int drow0, LAS float* scr, int lane) {
    float wv[32];
#pragma unroll
    for (int i = 0; i < 32; ++i) wv[i] = W[(size_t)(k0 + 2 * i + (lane >> 5)) * ldw + scol0 + (lane & 31)];
#pragma unroll
    for (int i = 0; i < 32; ++i) scr[(2 * i + (lane >> 5)) * 33 + (lane & 31)] = wv[i] * pg8::W8_SCALE;
    asm volatile("s_waitcnt lgkmcnt(0)" ::: "memory");
    const int n = lane >> 1, kh = lane & 1; const LAS float* s = scr + (32 * kh) * 33 + n;
    unsigned w[8];
#pragma unroll
    for (int j = 0; j < 8; ++j) w[j] = pg8::pk4_fp8(s[(4 * j) * 33], s[(4 * j + 1) * 33], s[(4 * j + 2) * 33], s[(4 * j + 3) * 33]);
    unsigned char* o = WT + (size_t)(drow0 + n) * K + k0 + 32 * kh;
    *(pg8::u32x4*)o = (pg8::u32x4){w[0], w[1], w[2], w[3]}; *(pg8::u32x4*)(o + 16) = (pg8::u32x4){w[4], w[5], w[6], w[7]};
    asm volatile("s_waitcnt lgkmcnt(0)" ::: "memory");
}
__device__ __forceinline__ void cvt_moe_tile(const Ctx& c, LAS unsigned char* img, int id) {
    unsigned char* W13 = (unsigned char*)(c.ws + WS_W13); unsigned char* W2T = (unsigned char*)(c.ws + WS_W2);
    const int le = id / 192; int r = id - le * 192;
    const float* sp; int ldw, K; unsigned char* dst; int rowl;
    if (r < 128) { const int kt = r >> 4, pn = r & 15, half = c.lane >> 5, n4 = c.lane & 31;
        sp = (half ? c.in[IN_W3] : c.in[IN_W1]) + (size_t)le * D * FF + (size_t)(128 * kt + 16 * c.wave) * FF + 128 * pn + 4 * n4; ldw = FF; K = D;
        dst = W13 + (size_t)le * 4096 * D + (size_t)(256 * pn) * D + 128 * kt; rowl = 128 * half + 4 * n4;
    } else { r -= 128; const int kt = r >> 2, pn = r & 3;
        sp = c.in[IN_W2] + (size_t)le * FF * D + (size_t)(128 * kt + 16 * c.wave) * D + 256 * pn + 4 * c.lane; ldw = D; K = FF;
        dst = W2T + (size_t)le * D * FF + (size_t)(256 * pn) * FF + 128 * kt; rowl = 4 * c.lane; }
    f32x4 v[16];
#pragma unroll
    for (int q = 0; q < 16; ++q) v[q] = __builtin_nontemporal_load((const f32x4*)(sp + (size_t)q * ldw));
    __syncthreads();
#pragma unroll
    for (int j = 0; j < 4; ++j) {
        pg8::u32x4 w;
#pragma unroll
        for (int q4 = 0; q4 < 4; ++q4) w[q4] = pg8::pk4_fp8(v[4 * q4][j] * pg8::W8_SCALE, v[4 * q4 + 1][j] * pg8::W8_SCALE, v[4 * q4 + 2][j] * pg8::W8_SCALE, v[4 * q4 + 3][j] * pg8::W8_SCALE);
        const int row = rowl + j;
        *(LAS pg8::u32x4*)(img + row * 128 + ((c.wave ^ ((row >> 2) & 7)) * 16)) = w;
    }
    __syncthreads();
#pragma unroll
    for (int i4 = 0; i4 < 4; ++i4) { const int p = c.tid + 512 * i4, row = p >> 3, ch = p & 7;
        *(pg8::u32x4*)(dst + (size_t)row * K + 16 * ch) = *(const LAS pg8::u32x4*)(img + row * 128 + ((ch ^ ((row >> 2) & 7)) * 16)); }
}
constexpr int HS_N = 14, HS_L0 = 2304, HS_L3 = 3072;
enum { HK_OUT = 0, HK_TOPK, HK_GEMM2, HK_S1, HK_S3, HK_GLU };
__device__ __forceinline__ constexpr int host_gs(int L, int kind) {
    return L == 0 ? (kind == HK_OUT ? 0 : kind == HK_TOPK ? 1 : kind == HK_GEMM2 ? 2 : -1)
         : L == 1 ? (kind == HK_S1 ? 3 : kind == HK_S3 ? 4 : kind == HK_GLU ? 5 : kind == HK_TOPK ? 6 : kind == HK_GEMM2 ? 7 : -1)
         : L == 2 ? (kind == HK_OUT ? 8 : kind == HK_TOPK ? 9 : kind == HK_GEMM2 ? 10 : -1)
         : (kind == HK_S1 ? 11 : kind == HK_S3 ? 12 : kind == HK_TOPK ? 13 : -1);
}
__device__ __forceinline__ void host_slot(int gs, int& rem, int& quota) {
    constexpr int REM[HS_N] = {32, 128, 64, 64, 128, 64, 128, 64, 32, 128, 64, 64, 128, 128}, Q[HS_N] = {8, 4, 6, 3, 5, 3, 4, 5, 8, 4, 6, 3, 5, 4};
    rem = 0; quota = 0;
#pragma unroll
    for (int i = 0; i < HS_N; ++i) if (i == gs) { rem = REM[i]; quota = Q[i]; }
}
__device__ __forceinline__ int host_tile_id(int u) {
    if (u < HS_L0) return u;
    u -= HS_L0; if (u < 3072) return 3072 + u;
    u -= 3072; if (u < 3072) return 2 * 3072 + u;
    u -= 3072; if (u < HS_L3) return 3 * 3072 + u;
    return -1;
}
__device__ __forceinline__ void hosted_cvt(const Ctx& c, LAS unsigned char* img, int L, int kind) {
    if (gridDim.x != 256) return;
    const int gs = host_gs(L, kind);
    if (gs < 0) return;
    int off = 0;
    for (int s = 0; s < gs; ++s) { int r0, q0; host_slot(s, r0, q0); off += (256 - r0) * q0; }
    int rem, q; host_slot(gs, rem, q);
    if ((int)blockIdx.x < rem) return;
    const int idle = 256 - rem, rank = (int)blockIdx.x - rem;
    for (int k = 0; k < q; ++k) { const int id = host_tile_id(off + rank + k * idle); if (id >= 0) cvt_moe_tile(c, img, id); }
    __syncthreads();
}
__device__ __forceinline__ void phase_cvt_moe(const Ctx& c, LAS float* ldsf) {
    LAS unsigned char* img = (LAS unsigned char*)ldsf;
    const int G = gridDim.x;
    if (G == 256) {
        const int n0 = 3072 - HS_L0, n3 = 3072 - HS_L3;
        for (int j = c.vb; j < n0 + n3; j += c.vg) cvt_moe_tile(c, img, j < n0 ? HS_L0 + j : 3 * 3072 + HS_L3 + (j - n0));
    } else {
        for (int j = c.vb; j < DEPTH * 3072; j += c.vg) cvt_moe_tile(c, img, j);
    }
    __syncthreads();
    LAS float* scr = ldsf + c.wave * (64 * 33);
    unsigned short* WIN = (unsigned short*)(c.ws + WS_WIN); unsigned short* WOUT = (unsigned short*)(c.ws + WS_WOUT); unsigned short* WGLU = (unsigned short*)(c.ws + WS_WGLU);
    for (int id = c.gw; id < 2 * (1408 + 512 + 1024); id += c.ngw) {
        const int i = id / 2944; int r = id - i * 2944;
        if (r < 1408) { const int kb = r / 88, nb = r - kb * 88; cvt_item(c.in[IN_MIXIN] + (size_t)i * D * INW, INW, 64 * kb, 32 * nb, WIN + (size_t)i * INW * D, D, 32 * nb, scr, c.lane); }
        else if (r < 1920) { r -= 1408; const int kb = r >> 5, nb = r & 31; cvt_item(c.in[IN_MIXOUT] + (size_t)i * D * D, D, 64 * kb, 32 * nb, WOUT + (size_t)i * D * D, D, 32 * nb, scr, c.lane); }
        else { r -= 1920; const int kb = r >> 6, nb = r & 63, pn = nb >> 3, rr0 = (nb & 7) * 32;
            cvt_item8(c.in[IN_GLUW] + (size_t)i * D * 2048, 2048, 64 * kb, (rr0 < 128 ? 0 : 1024) + 128 * pn + (rr0 & 127), (unsigned char*)WGLU + (size_t)i * 2048 * D, D, 32 * nb, scr, c.lane); }
    }
}

__global__ void __launch_bounds__(512, 2) fwd(Args args) {
    extern __shared__ __attribute__((aligned(16))) unsigned char lds[];
    Ctx c; c.in = args.in; c.out = args.out; c.ws = args.ws;
    c.wave = __builtin_amdgcn_readfirstlane((int)threadIdx.x >> 6); c.lane = lane_id(); c.tid = c.wave * 64 + c.lane;
    c.gw = blockIdx.x * 8 + c.wave; c.ngw = gridDim.x * 8; c.gt = blockIdx.x * 512 + c.tid; c.ngt = gridDim.x * 512;
    LAS float* ldsf = (LAS float*)lds; LAS unsigned char* ldsb = (LAS unsigned char*)lds;
    volatile LAS unsigned* MISC = (volatile LAS unsigned*)((LAS unsigned char*)lds + MISC_OFF);
    if (c.tid < 32) MISC[c.tid] = 0u;
    __syncthreads();
    const int lo = args.ph_lo, hi = args.ph_hi;
    const bool one_launch = (hi - lo) > 1;
    XcdBarrier bar; bar.bar = (unsigned*)(c.ws + WS_CTL) + CW_BAR; bar.x = 0; bar.st = MISC + 8; bar.wave = c.wave;
    if (one_launch) bar = xcd_barrier_post((unsigned*)(c.ws + WS_CTL) + CW_BAR, MISC + 8);
#define IN(k) (lo <= (k) && (k) < hi)
#define SEAM(k) do { if ((k) + 1 < hi) xcd_barrier(bar); } while (0)
#define FRESH(cc) Ctx cc; unsigned zq; asm volatile("s_mov_b32 %0, 0" : "=s"(zq)); cc.ws = c.ws + zq; cc.out = c.out + zq; cc.in = (const float* const*)((const char*)c.in + zq); \
    { int lq = lane_id(); asm volatile("" : "+v"(lq)); cc.wave = c.wave + (int)zq; cc.lane = lq; cc.tid = cc.wave * 64 + lq; const int tq = cc.tid; cc.gw = blockIdx.x * 8 + cc.wave; cc.ngw = gridDim.x * 8; cc.gt = blockIdx.x * 512 + tq; cc.ngt = gridDim.x * 512; cc.vb = blockIdx.x; cc.vg = gridDim.x; } \
    const int Lq = L + (int)zq, iq = Lq >> 1; const float* MOD = (const float*)(cc.ws + WS_MOD); (void)MOD; (void)iq

    if (IN(PH_PRO)) { const int L = 0; FRESH(cc);
        if (blockIdx.x & 1) { phase_s5_ops(cc, ldsf); __syncthreads(); phase_pro(cc, ldsf); __syncthreads(); phase_cvt_moe(cc, ldsf); }
        else { phase_pro(cc, ldsf); __syncthreads(); phase_cvt_moe(cc, ldsf); __syncthreads(); phase_s5_ops(cc, ldsf); }
        SEAM(PH_PRO); }

#define LAYER_BODY(LL) { constexpr int L = LL; \
        const int pb = 1 + L * PH_PER_LAYER; \
        if (IN(pb + 0)) { FRESH(cc); if constexpr (L == 0) phase_norm1_first(cc); else phase_norm1<false, (L & 1) != 0>(cc, Lq); SEAM(pb + 0); } \
        if ((L & 1) == 0) { \
            if (IN(pb + 1)) { \
                FRESH(cc); \
                pg8::GOrder S; S.init(1, NROWS, INW, (int)gridDim.x, (int)blockIdx.x); \
                pg8::ADense al{(const pg8::bf16_t*)(cc.ws + WS_HB1), 0, nullptr, 0, D, 0, 64}; pg8::EpiBf16 ep{(pg8::bf16_t*)(cc.ws + WS_P), INW, 0}; \
                pg8::gemm_phase(ldsb, al, (const pg8::bf16_t*)(cc.ws + WS_WIN) + (size_t)iq * INW * D, 0, D, S, ep, cc.wave); SEAM(pb + 1); } \
            if (IN(pb + 2)) { FRESH(cc); phase_post(cc, iq, ldsb); SEAM(pb + 2); } \
            if (IN(pb + 4)) { FRESH(cc); phase_ret_prefix(cc, iq); \
                  \
                unsigned* cnt = (unsigned*)(cc.ws + WS_CTL) + CW_CNT + 64 * L; \
                asm volatile("s_waitcnt vmcnt(0)" ::: "memory"); __syncthreads(); \
                if (cc.tid == 0) { __builtin_amdgcn_fence(__ATOMIC_RELEASE, "agent"); asm volatile("s_waitcnt vmcnt(0)" ::: "memory"); (void)xb_add(cnt, 1u); } \
                phase_attention(cc, iq, (char*)lds); \
                if (cc.tid == 0) { unsigned* tb = (unsigned*)(cc.ws + WS_CTL) + CW_BAR; XB_SPIN(xb_ld(cnt) < gridDim.x, tb); __builtin_amdgcn_fence(__ATOMIC_ACQUIRE, "agent"); asm volatile("s_waitcnt vmcnt(0)" ::: "memory"); } \
                __syncthreads(); \
                phase_ret_main(cc, iq, ldsb); SEAM(pb + 4); } \
            if (IN(pb + 6)) { \
                FRESH(cc); \
                pg8::GOrder S; S.init(1, NROWS, D, (int)gridDim.x, (int)blockIdx.x); \
                pg8::ADense al{(const pg8::bf16_t*)(cc.ws + WS_MIX), 0, nullptr, 0, D, 0, 64}; pg8::EpiResid ep{(pg8::bf16_t*)(cc.ws + WS_X), MOD + (size_t)Lq * 9 * 6144}; \
                pg8::gemm_phase(ldsb, al, (const pg8::bf16_t*)(cc.ws + WS_WOUT) + (size_t)iq * D * D, 0, D, S, ep, cc.wave); hosted_cvt(cc, ldsb, L, HK_OUT); SEAM(pb + 6); } \
        } else { \
            if (IN(pb + 1)) { \
                FRESH(cc); \
                pg8::GOrder S; S.init(64, 1280, 256, (int)gridDim.x, (int)blockIdx.x); \
                pg8::ADense al{(const pg8::bf16_t*)(cc.ws + WS_AS5), (size_t)1280 * 768, nullptr, 0, 768, 0, 64}; pg8::EpiBf16 ep{(pg8::bf16_t*)(cc.ws + WS_SL), 256, (size_t)1280 * 256}; \
                pg8::gemm_phase(ldsb, al, (const pg8::bf16_t*)(cc.ws + WS_WS5) + (size_t)iq * 64 * 256 * 512, (size_t)256 * 512, 512, S, ep, cc.wave); hosted_cvt(cc, ldsb, L, HK_S1); SEAM(pb + 1); } \
            if (IN(pb + 2)) { FRESH(cc); phase_s5_carry(cc, iq); SEAM(pb + 2); } \
            if (IN(pb + 3)) { \
                FRESH(cc); \
                pg8::GOrder S; S.init(64, 1280, 512, (int)gridDim.x, (int)blockIdx.x); \
                pg8::ADense al{(const pg8::bf16_t*)(cc.ws + WS_AS5), (size_t)1280 * 768, nullptr, 0, 768, 0, 64}; pg8::EpiGeluFp8 ep{(unsigned char*)(cc.ws + WS_ZG), 512, (size_t)1280 * 512}; \
                pg8::gemm_phase(ldsb, al, (const pg8::bf16_t*)(cc.ws + WS_TV) + (size_t)iq * 64 * 512 * 768, (size_t)512 * 768, 768, S, ep, cc.wave); hosted_cvt(cc, ldsb, L, HK_S3); SEAM(pb + 3); } \
            if (IN(pb + 4)) { \
                FRESH(cc); \
                pg8::GOrder S; S.init(1, NROWS, 2048, (int)gridDim.x, (int)blockIdx.x, L == DEPTH - 1); \
                pg8::ADense al{(const pg8::bf16_t*)(cc.ws + WS_ZG), 0, nullptr, 0, 16, 1280 * 512, (size_t)8 * 1280 * 512}; pg8::EpiGluResid ep{(pg8::bf16_t*)(cc.ws + WS_X), MOD + (size_t)Lq * 9 * 6144, cc.in[IN_GLUB] + (size_t)iq * 2048}; \
                pg8::gemm_phase<true>(ldsb, al, (const unsigned char*)(cc.ws + WS_WGLU) + (size_t)iq * 2048 * D, 0, D, S, ep, cc.wave); hosted_cvt(cc, ldsb, L, HK_GLU); SEAM(pb + 4); } \
        } \
        if (IN(pb + 7)) { FRESH(cc); phase_norm2_router<L == DEPTH - 1>(cc, Lq, ldsf); SEAM(pb + 7); } \
        if (IN(pb + 8)) { FRESH(cc); phase_topk(cc, (LAS unsigned*)lds, L == DEPTH - 1 ? 128 : 256); __syncthreads(); hosted_cvt(cc, ldsb, L, HK_TOPK); SEAM(pb + 8); } \
        if (IN(pb + 9)) { \
            FRESH(cc); \
            pg8::GOrder S; S.init(NE, L == DEPTH - 1 ? NB * CAP_LAT : EROWS, 2 * FF, (int)gridDim.x, (int)blockIdx.x); \
            pg8::ADense al{(const pg8::bf16_t*)(cc.ws + WS_XS), (size_t)EROWS * D, nullptr, 0, D, 0, 128}; \
            pg8::EpiSwiglu ep{(unsigned char*)(cc.ws + WS_HID), FF, (size_t)EROWS * FF}; \
            pg8::gemm_phase<true>(ldsb, al, (const unsigned char*)(cc.ws + WS_W13) + (size_t)Lq * NE * 4096 * D, (size_t)4096 * D, D, S, ep, cc.wave); SEAM(pb + 9); } \
        if (IN(pb + 10)) { \
            FRESH(cc); \
            pg8::GOrder S; S.init(NE, L == DEPTH - 1 ? NB * CAP_LAT : EROWS, D, (int)gridDim.x, (int)blockIdx.x); \
            pg8::ADense al{(const pg8::bf16_t*)(cc.ws + WS_HID), (size_t)EROWS * FF, nullptr, 0, FF, 0, 128}; \
            pg8::EpiGate ep{(unsigned char*)(cc.ws + WS_Y), D, (size_t)EROWS * D, (const float*)(cc.ws + WS_SELGATE), EROWS}; \
            pg8::gemm_phase<true>(ldsb, al, (const unsigned char*)(cc.ws + WS_W2) + (size_t)Lq * NE * D * FF, (size_t)D * FF, FF, S, ep, cc.wave); hosted_cvt(cc, ldsb, L, HK_GEMM2); SEAM(pb + 10); } \
    }
    LAYER_BODY(0) LAYER_BODY(1) LAYER_BODY(2) LAYER_BODY(3)
#undef LAYER_BODY
    if (IN(PH_FIN)) { const int L = DEPTH; FRESH(cc); phase_norm1<true, false>(cc, DEPTH); }
#undef IN
#undef SEAM
}

static bool phase_valid(int ph) {
    if (ph == PH_PRO || ph == PH_FIN) return true;
    const int L = (ph - 1) / PH_PER_LAYER, k = (ph - 1) % PH_PER_LAYER;
    if (L & 1) return !(k >= 5 && k <= 6);
    return k != 3 && k != 5;
}
extern "C" void kernel_launch(void* const* d_in, const int* in_sizes, int n_in, void* d_out, int out_size, void* d_ws, size_t ws_size, hipStream_t stream) {
    static int grid = 0;
    if (grid == 0) {
        if (n_in != 27 || out_size != NB * T * D || ws_size < WS_END) { fprintf(stderr, "kernel_launch: unexpected shapes (n_in %d out %d ws %zu)\n", n_in, out_size, ws_size); grid = -1; return; }
        int dev = 0, cus = 0;
        if (hipGetDevice(&dev) != hipSuccess || hipDeviceGetAttribute(&cus, hipDeviceAttributeMultiprocessorCount, dev) != hipSuccess) { grid = -1; return; }
        if (hipFuncSetAttribute((const void*)fwd, hipFuncAttributeMaxDynamicSharedMemorySize, LDS_BYTES) != hipSuccess) { grid = -1; return; }
        int per_cu = 0;
        if (hipOccupancyMaxActiveBlocksPerMultiprocessor(&per_cu, (const void*)fwd, 512, LDS_BYTES) != hipSuccess || per_cu < 1) fprintf(stderr, "kernel_launch: occupancy query says %d\n", per_cu);
        (void)hipGetLastError();
        grid = cus;
    }
    if (grid < 0) return;
    if (hipMemsetAsync((char*)d_ws + WS_CTL, 0, CTL_ZERO_BYTES, stream) != hipSuccess) return;
    Args a{};
    for (int i = 0; i < 27; ++i) a.in[i] = (const float*)d_in[i];
    a.out = (float*)d_out; a.ws = (unsigned char*)d_ws;
#if MK_MULTI
    for (int ph = 0; ph < NPH; ++ph) {
        if (!phase_valid(ph)) continue;
        a.ph_lo = ph; a.ph_hi = ph + 1;
        hipLaunchKernelGGL(fwd, dim3(grid), dim3(512), LDS_BYTES, stream, a);
    }
#else
    a.ph_lo = 0; a.ph_hi = NPH;
    hipLaunchKernelGGL(fwd, dim3(grid), dim3(512), LDS_BYTES, stream, a);
#ifdef PROBE_PHASES
    { static const int probe[] = {PROBE_PHASES}; for (unsigned q = 0; q < sizeof(probe) / sizeof(probe[0]); ++q) { a.ph_lo = probe[q]; a.ph_hi = probe[q] + 1; hipLaunchKernelGGL(fwd, dim3(grid), dim3(512), LDS_BYTES, stream, a); } }
#endif
#endif
}
```

```cpp
#include <hip/hip_runtime.h>
#include <hip/hip_bf16.h>
#include <cstdio>
#include <cstdint>

#define GAS __attribute__((address_space(1)))
#define LAS __attribute__((address_space(3)))
typedef float f32x4 __attribute__((ext_vector_type(4)));
typedef float f32x2 __attribute__((ext_vector_type(2)));
typedef float f32x16 __attribute__((ext_vector_type(16)));

constexpr int NB = 8, T = 4096, D = 1024, CL = 256, RB = CL + T  , NROWS = NB * RB  ;
constexpr int DEPTH = 4, NE = 16, FF = 2048, INW = 2816;
constexpr int CAP_LAT = 512, CAP_CTX = 32, EROWS = NB * (CAP_LAT + CAP_CTX)  ;
constexpr float EPS = 1e-6f;
#ifndef MK_MULTI
#define MK_MULTI 0
#endif

constexpr size_t MiB = 1u << 20;
constexpr size_t WS_CTL = 0, CTL_ZERO_BYTES = 1 * MiB;
constexpr size_t WS_MOD = 1 * MiB;
constexpr size_t WS_ROPE = 2 * MiB;
constexpr size_t WS_SELROW = 3 * MiB;
constexpr size_t WS_SELGATE = 3 * MiB + 512 * 1024;
constexpr size_t WS_AFF = 4 * MiB;
constexpr size_t WS_SLOT = 7 * MiB;
constexpr size_t WS_X = 10 * MiB;
constexpr size_t WS_TV = 146 * MiB;
constexpr size_t WS_WS5 = 242 * MiB;
constexpr size_t WS_HB = 282 * MiB;
constexpr size_t WS_W13 = 350 * MiB;
constexpr size_t WS_W2 = 862 * MiB;
constexpr size_t WS_WIN = 1118 * MiB;
constexpr size_t WS_WOUT = 1130 * MiB;
constexpr size_t WS_WGLU = 1134 * MiB;
constexpr size_t WS_HB1 = 1144 * MiB;
constexpr size_t WS_BIG = 1212 * MiB;
constexpr size_t WS_P = WS_BIG;
constexpr size_t WS_RQ = WS_BIG + 374 * MiB;
constexpr size_t WS_RK = WS_BIG + 408 * MiB;
constexpr size_t WS_RV = WS_BIG + 442 * MiB;
constexpr size_t WS_ET = WS_BIG + 476 * MiB;
constexpr size_t WS_MIX = WS_BIG + 510 * MiB;
constexpr size_t WS_QA = WS_BIG + 578 * MiB;
constexpr size_t WS_KA = WS_BIG + 612 * MiB;
constexpr size_t WS_VA = WS_BIG + 621 * MiB;
constexpr size_t WS_U = WS_BIG + 630 * MiB;
constexpr size_t WS_AS5 = WS_BIG;
constexpr size_t WS_SL = WS_BIG + 120 * MiB;
constexpr size_t WS_ZG = WS_BIG + 200 * MiB;
constexpr size_t WS_HID = WS_BIG;
constexpr size_t WS_XS = WS_BIG + 136 * MiB;
constexpr size_t WS_Y = WS_BIG + 272 * MiB;
constexpr size_t WS_END = WS_BIG + 698 * MiB;
constexpr int CW_BAR = 4096, CW_CNT = 8192;

constexpr int LDS_BYTES = 147456;
constexpr int MISC_OFF = 131072 + 320;

constexpr int PH_PRO = 0, PH_PER_LAYER = 11, PH_FIN = 1 + DEPTH * PH_PER_LAYER, NPH = PH_FIN + 1;

#define XB_TMO      128
#define XB_XCNT(j)  (256  + 64 * (j))
#define XB_XSUB(j)  (1280 + 64 * (j))
#define XB_XGEN(j)  (2304 + 64 * (j))
#define XB_TOP      3328
#define XB_TOPGEN   3392
#define XCD_BAR_WORDS 3456
#define XB_SPIN_CAP (1u << 22)

__device__ __forceinline__ unsigned xb_ld(unsigned* p)              { return __hip_atomic_load(p, __ATOMIC_RELAXED, __HIP_MEMORY_SCOPE_AGENT); }
__device__ __forceinline__ unsigned xb_add(unsigned* p, unsigned v) { return __hip_atomic_fetch_add(p, v, __ATOMIC_RELAXED, __HIP_MEMORY_SCOPE_AGENT); }
__device__ __forceinline__ unsigned xb_xcc_id() { return (unsigned)__builtin_amdgcn_s_getreg((3 << 11) | 20) & 0xFu; }
#define XB_SPIN(cond, bar) do { unsigned _sp = 0; while (cond) { __builtin_amdgcn_s_sleep(1); \
    if ((++_sp & 255u) == 0u) { if (xb_ld(&(bar)[XB_TMO])) break; if (_sp > XB_SPIN_CAP) { atomicAdd(&(bar)[XB_TMO], 1u); break; } } } } while (0)

__device__ __forceinline__ int lane_id() { int l; asm volatile("v_mbcnt_lo_u32_b32 %0, -1, 0\n\tv_mbcnt_hi_u32_b32 %0, -1, %0" : "=v"(l)); return l; }
struct XcdBarrier { unsigned* bar; unsigned x; volatile LAS unsigned* st; int wave; };

__device__ __forceinline__ XcdBarrier xcd_barrier_post(unsigned* bar, volatile LAS unsigned* st) {
    XcdBarrier b; b.bar = bar; b.x = xb_xcc_id(); b.st = st; b.wave = __builtin_amdgcn_readfirstlane((int)threadIdx.x >> 6);
    if (threadIdx.x == 0) (void)xb_add(&bar[XB_XCNT(b.x)], 1u);
    return b;
}
__device__ __forceinline__ void xcd_barrier_complete(unsigned* bar, unsigned x, unsigned& nloc, unsigned& nx) {
    const unsigned G = gridDim.x * gridDim.y * gridDim.z;
    unsigned sum, cnt, mine, sp = 0u;
    for (;;) {
        sum = 0u; cnt = 0u; mine = 0u;
#pragma unroll
        for (unsigned j = 0; j < 16; ++j) { const unsigned c = xb_ld(&bar[XB_XCNT(j)]); sum += c; cnt += (c > 0u) ? 1u : 0u; mine = (j == x) ? c : mine; }
        if (sum == G) break;
        __builtin_amdgcn_s_sleep(1);
        if ((++sp & 255u) == 0u) { if (xb_ld(&bar[XB_TMO])) break; if (sp > XB_SPIN_CAP) { atomicAdd(&bar[XB_TMO], 1u); break; } }
    }
    nloc = mine > 0u ? mine : 1u; nx = cnt > 0u ? cnt : 1u;
}
__device__ __forceinline__ void xcd_barrier(const XcdBarrier& b) {
    asm volatile("s_waitcnt vmcnt(0)" ::: "memory");
    __syncthreads();
    if (b.wave == 0 && lane_id() == 0) {
        unsigned* bar = b.bar;
        __builtin_amdgcn_s_waitcnt(0);
        unsigned nloc = b.st[0], nx = b.st[1];
        if (nloc == 0u) { xcd_barrier_complete(bar, b.x, nloc, nx); b.st[0] = nloc; b.st[1] = nx; }
        const unsigned old = xb_add(&bar[XB_XSUB(b.x)], 1u);
        const unsigned gen = old / nloc;
        if (old + 1u == (gen + 1u) * nloc) {
            __builtin_amdgcn_fence(__ATOMIC_RELEASE, "agent");
            asm volatile("s_waitcnt vmcnt(0)" ::: "memory");
            const unsigned og = xb_add(&bar[XB_TOP], 1u);
            const unsigned tg = og / nx;
            if (og + 1u == (tg + 1u) * nx) xb_add(&bar[XB_TOPGEN], 1u);
            else XB_SPIN(xb_ld(&bar[XB_TOPGEN]) == tg, bar);
            __builtin_amdgcn_fence(__ATOMIC_ACQUIRE, "agent");
            xb_add(&bar[XB_XGEN(b.x)], 1u);
            asm volatile("s_waitcnt vmcnt(0)" ::: "memory");
        } else {
            XB_SPIN(xb_ld(&bar[XB_XGEN(b.x)]) == gen, bar);
            __builtin_amdgcn_fence(__ATOMIC_ACQUIRE, "agent");
            asm volatile("s_waitcnt vmcnt(0)" ::: "memory");
        }
    }
    __syncthreads();
}

struct Args { const float* in[27]; float* out; unsigned char* ws; int ph_lo, ph_hi; };

struct Ctx {
    const float* const* in; float* out; unsigned char* ws;
    int tid, lane, wave, gw, ngw, gt, ngt;
    int vb, vg;
};
enum { IN_X = 0, IN_C, IN_CTX, IN_CCTX, IN_MODW, IN_MODB, IN_NORMG, IN_MIXIN, IN_MIXOUT, IN_RETRATE, IN_RETGN, IN_QKG,
       IN_S5ARE, IN_S5AIM, IN_S5DT, IN_S5BRE, IN_S5BIM, IN_S5CRE, IN_S5CIM, IN_S5D, IN_GLUW, IN_GLUB, IN_ROUTER, IN_W1, IN_W3, IN_W2, IN_FNG };

__device__ __forceinline__ float wave_sum(float v) {
#pragma unroll
    for (int o = 1; o < 64; o <<= 1) v += __shfl_xor(v, o);
    return v;
}
__device__ __forceinline__ float sigmoidf_(float x) { return 1.0f / (1.0f + expf(-x)); }
__device__ __forceinline__ float siluf_(float x) { return x * sigmoidf_(x); }
__device__ __forceinline__ float gelu_tanh(float x) { const float u = 0.7978845608028654f * (x + 0.044715f * x * x * x); return 0.5f * x * (1.0f + tanhf(u)); }
__device__ __forceinline__ const float* modp(const Ctx& c, int L, int j, int chunk) { return (const float*)(c.ws + WS_MOD) + ((size_t)(L * 9 + j) * 6 + chunk) * 1024; }
__device__ __forceinline__ int row_j(int row) { const int b = row / RB, s = row - b * RB; return s < CL ? 8 : b; }

__device__ __forceinline__ float reduce16(const float (&v)[16], int lane) {
    float a[8], b[4], c2[2], d;
    const bool b5 = (lane & 32) != 0, b4 = (lane & 16) != 0, b3 = (lane & 8) != 0, b2 = (lane & 4) != 0;
#pragma unroll
    for (int i = 0; i < 8; ++i) { const float keep = b5 ? v[8 + i] : v[i], send = b5 ? v[i] : v[8 + i]; a[i] = keep + __shfl_xor(send, 32); }
#pragma unroll
    for (int i = 0; i < 4; ++i) { const float keep = b4 ? a[4 + i] : a[i], send = b4 ? a[i] : a[4 + i]; b[i] = keep + __shfl_xor(send, 16); }
#pragma unroll
    for (int i = 0; i < 2; ++i) { const float keep = b3 ? b[2 + i] : b[i], send = b3 ? b[i] : b[2 + i]; c2[i] = keep + __shfl_xor(send, 8); }
    { const float keep = b2 ? c2[1] : c2[0], send = b2 ? c2[0] : c2[1]; d = keep + __shfl_xor(send, 4); }
    d += __shfl_xor(d, 2); d += __shfl_xor(d, 1);
    return d;
}
__device__ __forceinline__ int reduce16_k(int lane) { return ((lane >> 5) & 1) * 8 + ((lane >> 4) & 1) * 4 + ((lane >> 3) & 1) * 2 + ((lane >> 2) & 1); }

namespace pg8 {
typedef unsigned short bf16_t;
typedef short bf16x8 __attribute__((ext_vector_type(8)));
typedef unsigned u32x4 __attribute__((ext_vector_type(4)));
typedef unsigned u32x2 __attribute__((ext_vector_type(2)));
typedef int v8i32 __attribute__((ext_vector_type(8)));
typedef int v4i32 __attribute__((ext_vector_type(4)));
constexpr int BM = 256, BK = 64, HALF = 128, HTB = HALF * BK * 2, STAGE_BYTES = 8 * HTB, NXCD = 8, WGM = 8;
__host__ __device__ __forceinline__ int lds_byte(int r, int c) { const int st = (r >> 4) * 2 + (c >> 5), rr = r & 15, cc = c & 31, ob = rr * 64 + cc * 2; return st * 1024 + (ob ^ (((ob >> 9) & 1) << 5)); }
__host__ __device__ __forceinline__ void stage_rc(int b, int& R, int& C) { const int st = b / 1024, sb = b % 1024, swz = sb ^ (((sb >> 9) & 1) << 5); R = (st >> 1) * 16 + swz / 64; C = (st & 1) * 32 + (swz % 64) / 2; }
__host__ __device__ __forceinline__ int perm32(int rho) { const int n = rho >> 4, i = rho & 15; return 8 * (i >> 2) + 4 * n + (i & 3); }
__device__ __forceinline__ unsigned cvt_pk_bf16(float lo, float hi) { unsigned r; asm volatile("v_cvt_pk_bf16_f32 %0, %1, %2" : "=v"(r) : "v"(lo), "v"(hi)); return r; }

__device__ __forceinline__ unsigned pk4_fp8(float a, float b, float c, float d) {
    a = __builtin_amdgcn_fmed3f(a, -448.f, 448.f); b = __builtin_amdgcn_fmed3f(b, -448.f, 448.f); c = __builtin_amdgcn_fmed3f(c, -448.f, 448.f); d = __builtin_amdgcn_fmed3f(d, -448.f, 448.f);
    unsigned w = 0u; w = (unsigned)__builtin_amdgcn_cvt_pk_fp8_f32(a, b, (int)w, false); w = (unsigned)__builtin_amdgcn_cvt_pk_fp8_f32(c, d, (int)w, true); return w; }
__device__ __forceinline__ f32x4 bf4_to_f32(u32x2 w) { return (f32x4){__uint_as_float(w.x << 16), __uint_as_float(w.x & 0xffff0000u), __uint_as_float(w.y << 16), __uint_as_float(w.y & 0xffff0000u)}; }
__device__ __forceinline__ u32x2 f32_to_bf4(f32x4 v) { return (u32x2){cvt_pk_bf16(v.x, v.y), cvt_pk_bf16(v.z, v.w)}; }
constexpr float W8_SCALE = 32.0f, W8_INV = 1.0f / 32.0f;
struct Unit { int pm, pn, g; };
struct GOrder {
    int nM, nN, per, nwg, G, c, skipctx;
    __device__ __forceinline__ void init(int groups, int M, int N, int G_, int c_, int skipctx_ = 0) { nM = M / BM; if (skipctx_) nM -= nM / 17; nN = N / BM; per = nM * nN; nwg = groups * per; G = G_; c = c_; skipctx = skipctx_; }
    __device__ __forceinline__ bool next(int i, Unit& u) const {
        const long L = (long)i * G + c; if (L >= nwg) return false;
        int wgid = (int)L; { const int q = nwg / NXCD, r = nwg % NXCD, xcd = wgid % NXCD, off = wgid / NXCD; wgid = (xcd < r ? xcd * (q + 1) : r * (q + 1) + (xcd - r) * q) + off; }
        u.g = wgid / per; const int w = wgid - u.g * per;
        const int nig = WGM * nN, gid = w / nig, fm = gid * WGM, gsz = (nM - fm) < WGM ? (nM - fm) : WGM;
        u.pm = fm + ((w % nig) % gsz); u.pn = (w % nig) / gsz; if (skipctx) u.pm += (u.pm >> 4) + 1;
        return true;
    }
};
struct ADense  { static constexpr bool GATHER = false; const bf16_t* A; size_t gstride; const int* idx; int rpg; unsigned rowpitch; unsigned cgrp; size_t kstep; };
struct AGather { static constexpr bool GATHER = true;  const bf16_t* A; size_t gstride; const int* idx; int rpg; unsigned rowpitch; unsigned cgrp; size_t kstep; };

template <bool FP8 = false, class Epi, class ALoc>
__device__ __forceinline__ void gemm_phase(LAS unsigned char* lds, const ALoc AL, const void* Bt, size_t gstrideB, int K, const GOrder& S, const Epi& E, int wave_) {
    constexpr bool GATHER = ALoc::GATHER; constexpr unsigned ESZ = FP8 ? 1u : 2u;
    const int wid = wave_, lane = lane_id(), tid = wid * 64 + lane, wr = wid >> 2, wc = wid & 3, fr = lane & 15, fq = lane >> 4;
    const int nt = (int)((unsigned)K * ESZ / 128u);
    unsigned voffA[2], voffB[2];
#pragma unroll
    for (int i = 0; i < 2; ++i) { int R, C; stage_rc(tid * 16 + i * 8192, R, C); const int Rb = Epi::PERM ? ((R & ~31) + perm32(R & 31)) : R;
        const unsigned cbytes = AL.cgrp ? (FP8 ? (unsigned)(C >> 3) * AL.cgrp : ((unsigned)(C >> 4) * AL.cgrp + (unsigned)(C & 15)) * 2u) : (unsigned)C * 2u;
        voffA[i] = (unsigned)R * AL.rowpitch * ESZ + cbytes; voffB[i] = (unsigned)Rb * (unsigned)K * ESZ + (unsigned)C * 2u; }
    const size_t kstep = 128, kstepA = AL.kstep * ESZ;
    const size_t hstep = (size_t)HALF * K * ESZ;
    const size_t hstepA = GATHER ? 0 : (size_t)HALF * AL.rowpitch * ESZ, tstepA = 2 * (size_t)HALF * AL.rowpitch * ESZ;
    const size_t tstep = 2 * hstep;
    const unsigned ldsw = (unsigned)wid * 1024u;
    const int aoff0 = lds_byte(wr * 64 + fr, fq * 8);
    const int boff0 = lds_byte(wc * 32 + fr, fq * 8);
    constexpr int KOFF = 1024;
    unsigned vAc[2][2], vAn[2][2];
#define PG8_SA(b, h) (((b) * 2 + (h)) * HTB)
#define PG8_SB(b, h) ((4 + (b) * 2 + (h)) * HTB)
#define PG8_SBR(b, h) (((b) * 2 + (h)) * HTB)
#define PG8_OPQ(x) do { if constexpr (FP8) asm volatile("" : "+v"(x)); } while (0)
#define PG8_STAGE(bufoff, gbase, voff) do { _Pragma("unroll") for (int _i = 0; _i < 2; ++_i) { unsigned _o = (voff)[_i]; PG8_OPQ(_o); \
        __builtin_amdgcn_global_load_lds((const unsigned*)((const char*)(gbase) + _o), (LAS unsigned*)(lds + (bufoff) + ldsw + _i * 8192), 16, 0, 0); } } while (0)
#define PG8_STAGE_A(bufoff, gbase, h, nx) do { _Pragma("unroll") for (int _i = 0; _i < 2; ++_i) { \
        unsigned _o = GATHER ? ((nx) ? vAn[h][_i] : vAc[h][_i]) : voffA[_i]; PG8_OPQ(_o); \
        __builtin_amdgcn_global_load_lds((const unsigned*)((const char*)(gbase) + (size_t)(h) * hstepA + _o), (LAS unsigned*)(lds + (bufoff) + ldsw + _i * 8192), 16, 0, 0); } } while (0)
#define PG8_GIDX(u, v) do { if (GATHER) { int _t = tid; asm volatile("" : "+v"(_t));   \
        _Pragma("unroll") for (int _i = 0; _i < 2; ++_i) { int _R, _C; stage_rc(_t * 16 + _i * 8192, _R, _C); \
        _Pragma("unroll") for (int _h = 0; _h < 2; ++_h) v[_h][_i] = (unsigned)AL.idx[(u).g * AL.rpg + (u).pm * BM + _h * HALF + _R] * (AL.rowpitch * ESZ) + (unsigned)_C * 2u; } } } while (0)
#define PG8_ABASE(u) ((const char*)AL.A + (GATHER ? (size_t)0 : ((size_t)(u).g * AL.gstride * ESZ + (size_t)(u).pm * tstepA)))
#define PG8_BBASE(u) ((const char*)Bt + (size_t)(u).g * gstrideB * ESZ + (size_t)(u).pn * tstep)
#define PG8_LDA(dst, b, h) do { _Pragma("unroll") for (int m = 0; m < 4; ++m) _Pragma("unroll") for (int k = 0; k < 2; ++k) dst[m][k] = *(const LAS bf16x8*)(lds + PG8_SA(b, h) + aoff0 + k * KOFF + m * 2048); } while (0)
#define PG8_LDB(dst, b, h) do { _Pragma("unroll") for (int n = 0; n < 2; ++n) _Pragma("unroll") for (int k = 0; k < 2; ++k) dst[n][k] = *(const LAS bf16x8*)(lds + PG8_SB(b, h) + boff0 + k * KOFF + n * 2048); } while (0)
#define PG8_CAT8(x) __builtin_shufflevector(__builtin_bit_cast(v4i32, x[0]), __builtin_bit_cast(v4i32, x[1]), 0, 1, 2, 3, 4, 5, 6, 7)
#define PG8_MMA(ai, bj, At, Bt_) do { __builtin_amdgcn_s_setprio(1); _Pragma("unroll") for (int m = 0; m < 4; ++m) _Pragma("unroll") for (int n = 0; n < 2; ++n) { \
        if constexpr (FP8) acc[ai][bj][m][n] = __builtin_amdgcn_mfma_scale_f32_16x16x128_f8f6f4(PG8_CAT8(Bt_[n]), PG8_CAT8(At[m]), acc[ai][bj][m][n], 0, 0, 0, 0x7f7f7f7f, 0, 0x7f7f7f7f); \
        else { _Pragma("unroll") for (int k = 0; k < 2; ++k) acc[ai][bj][m][n] = __builtin_amdgcn_mfma_f32_16x16x32_bf16(Bt_[n][k], At[m][k], acc[ai][bj][m][n], 0, 0, 0); } } \
        __builtin_amdgcn_s_setprio(0); } while (0)
#define PG8_WAIT_V(n) asm volatile("s_waitcnt vmcnt(" #n ")" ::: "memory")
#define PG8_WAIT_L(n) asm volatile("s_waitcnt lgkmcnt(" #n ")" ::: "memory")
#define PG8_BAR __builtin_amdgcn_s_barrier()
#define PG8_SCHED __builtin_amdgcn_sched_barrier(0)
    Unit cur, nxt; int ui = 0;
    if (!S.next(0, cur)) return;
    PG8_GIDX(cur, vAc);
    f32x4 acc[2][2][4][2];
#pragma unroll
    for (int a = 0; a < 2; ++a)
#pragma unroll
        for (int b = 0; b < 2; ++b)
#pragma unroll
            for (int m = 0; m < 4; ++m)
#pragma unroll
                for (int n = 0; n < 2; ++n) acc[a][b][m][n] = (f32x4){0.f, 0.f, 0.f, 0.f};
    bf16x8 At[4][2], B0[2][2], B1[2][2];
    const char* cA = PG8_ABASE(cur); const char* cB = PG8_BBASE(cur);
    PG8_STAGE(PG8_SB(0, 0), cB, voffB); PG8_STAGE(PG8_SB(0, 1), cB + hstep, voffB); PG8_STAGE_A(PG8_SA(0, 0), cA, 0, false); PG8_STAGE_A(PG8_SA(0, 1), cA, 1, false);
    if (wr == 1) PG8_BAR;
    PG8_WAIT_V(2); PG8_BAR;
    PG8_STAGE(PG8_SB(1, 0), cB + kstep, voffB); PG8_STAGE_A(PG8_SA(1, 0), cA + kstepA, 0, false); PG8_STAGE(PG8_SB(1, 1), cB + hstep + kstep, voffB);
    PG8_WAIT_V(6); PG8_BAR;
    for (;;) {
        const bool has_next = S.next(ui + 1, nxt);
        if (GATHER) { if (has_next) { PG8_GIDX(nxt, vAn); } }
        const char* nA = has_next ? PG8_ABASE(nxt) : cA; const char* nB = has_next ? PG8_BBASE(nxt) : cB;
        for (int t = 0; t < nt; t += 2) {
            const bool last = (t == nt - 2), lastn = last && has_next;
            const char* a1 = cA + (size_t)(t + 1) * kstepA;
            const char* a2 = last ? nA : cA + (size_t)(t + 2) * kstepA; const char* b2 = last ? nB : cB + (size_t)(t + 2) * kstep;
            const char* a3 = a2 + kstepA; const char* b3 = b2 + kstep;
            PG8_LDB(B0, 0, 0); PG8_LDB(B1, 0, 1); PG8_SCHED; PG8_LDA(At, 0, 0); PG8_STAGE_A(PG8_SA(1, 1), a1, 1, false);
            PG8_WAIT_V(8); PG8_WAIT_L(0); PG8_BAR; PG8_MMA(0, 0, At, B0); PG8_MMA(0, 1, At, B1); PG8_BAR; PG8_SCHED;
            PG8_LDA(At, 0, 1); PG8_STAGE(PG8_SB(0, 0), b2, voffB); PG8_STAGE(PG8_SB(0, 1), b2 + hstep, voffB); PG8_STAGE_A(PG8_SA(0, 0), a2, 0, lastn);
            PG8_WAIT_V(8); PG8_WAIT_L(0); PG8_BAR; PG8_MMA(1, 0, At, B0); PG8_MMA(1, 1, At, B1); PG8_BAR; PG8_SCHED;
            PG8_LDB(B0, 1, 0); PG8_LDB(B1, 1, 1); PG8_SCHED; PG8_LDA(At, 1, 0); PG8_STAGE_A(PG8_SA(0, 1), a2, 1, lastn);
            PG8_WAIT_V(8); PG8_WAIT_L(0); PG8_BAR; PG8_MMA(0, 0, At, B0); PG8_MMA(0, 1, At, B1); PG8_BAR; PG8_SCHED;
            PG8_LDA(At, 1, 1); PG8_STAGE(PG8_SB(1, 0), b3, voffB); PG8_STAGE(PG8_SB(1, 1), b3 + hstep, voffB); PG8_STAGE_A(PG8_SA(1, 0), a3, 0, lastn);
            PG8_WAIT_V(8); PG8_WAIT_L(0); PG8_BAR; PG8_MMA(1, 0, At, B0); PG8_MMA(1, 1, At, B1); PG8_BAR; PG8_SCHED;
        }
        if (wr == 0) PG8_BAR;
        E(acc, cur, wr, wc, fr, fq);
        if (!has_next) break;
#pragma unroll
        for (int a = 0; a < 2; ++a)
#pragma unroll
            for (int b = 0; b < 2; ++b)
#pragma unroll
                for (int m = 0; m < 4; ++m)
#pragma unroll
                    for (int n = 0; n < 2; ++n) acc[a][b][m][n] = (f32x4){0.f, 0.f, 0.f, 0.f};
        cur = nxt; cA = nA; cB = nB; ++ui;
        if (GATHER) {
#pragma unroll
            for (int _h = 0; _h < 2; ++_h)
#pragma unroll
                for (int _i = 0; _i < 2; ++_i) vAc[_h][_i] = vAn[_h][_i]; }
        if (wr == 1) PG8_BAR;
    }
    PG8_WAIT_V(0);
    PG8_BAR;
#undef PG8_SA
#undef PG8_SB
#undef PG8_SBR
#undef PG8_STAGE
#undef PG8_OPQ
#undef PG8_STAGE_A
#undef PG8_GIDX
#undef PG8_ABASE
#undef PG8_BBASE
#undef PG8_LDA
#undef PG8_CAT8
#undef PG8_LDB
#undef PG8_MMA
#undef PG8_WAIT_V
#undef PG8_WAIT_L
#undef PG8_BAR
#undef PG8_SCHED
}

__device__ __forceinline__ float fast_sigmoid(float x) { return __builtin_amdgcn_rcpf(1.0f + __builtin_amdgcn_exp2f(-1.4426950408889634f * x)); }
struct EpiSwiglu {
    static constexpr bool PERM = true;
    unsigned char* O; int ldc; size_t gstride;
    __device__ __forceinline__ void operator()(const f32x4 (&acc)[2][2][4][2], const Unit& u, int wr, int wc, int fr, int fq) const {
        const int row0 = u.pm * BM + wr * 64 + fr, col0 = u.pn * HALF + wc * 32 + 8 * fq;
        unsigned char* base = O + (size_t)u.g * gstride;
#pragma unroll
        for (int ai = 0; ai < 2; ++ai)
#pragma unroll
            for (int m = 0; m < 4; ++m) { unsigned char* rowp = base + (size_t)(row0 + ai * HALF + m * 16) * ldc + col0;
                f32x4 o[2];
#pragma unroll
                for (int n = 0; n < 2; ++n) {
                    const f32x4 a = acc[ai][0][m][n] * W8_INV, b = acc[ai][1][m][n] * W8_INV, t = a * (-1.4426950408889634f);
                    f32x4 e; e.x = __builtin_amdgcn_exp2f(t.x); e.y = __builtin_amdgcn_exp2f(t.y); e.z = __builtin_amdgcn_exp2f(t.z); e.w = __builtin_amdgcn_exp2f(t.w);
                    e = e + 1.0f;
                    f32x4 r; r.x = __builtin_amdgcn_rcpf(e.x); r.y = __builtin_amdgcn_rcpf(e.y); r.z = __builtin_amdgcn_rcpf(e.z); r.w = __builtin_amdgcn_rcpf(e.w);
                    o[n] = (a * b) * r; }
                *(u32x2*)rowp = (u32x2){pk4_fp8(o[0].x, o[0].y, o[0].z, o[0].w), pk4_fp8(o[1].x, o[1].y, o[1].z, o[1].w)}; }
    }
};
struct EpiBf16 {
    static constexpr bool PERM = true;
    bf16_t* O; int ldc; size_t gstride;
    __device__ __forceinline__ void operator()(const f32x4 (&acc)[2][2][4][2], const Unit& u, int wr, int wc, int fr, int fq) const {
        const int row0 = u.pm * BM + wr * 64 + fr, col0 = u.pn * BM + wc * 32 + 8 * fq;
#pragma unroll
        for (int ai = 0; ai < 2; ++ai)
#pragma unroll
            for (int m = 0; m < 4; ++m) { bf16_t* rowp = O + (size_t)u.g * gstride + (size_t)(row0 + ai * HALF + m * 16) * ldc + col0;
#pragma unroll
                for (int bj = 0; bj < 2; ++bj) { const f32x4 v0 = acc[ai][bj][m][0], v1 = acc[ai][bj][m][1];
                    u32x4 w; w.x = cvt_pk_bf16(v0[0], v0[1]); w.y = cvt_pk_bf16(v0[2], v0[3]); w.z = cvt_pk_bf16(v1[0], v1[1]); w.w = cvt_pk_bf16(v1[2], v1[3]);
                    *(u32x4*)(rowp + bj * HALF) = w; } }
    }
};
constexpr float Z8_SCALE = 2.0f;
struct EpiGeluFp8 {
    static constexpr bool PERM = true;
    unsigned char* O; int ldc; size_t gstride;
    __device__ __forceinline__ void operator()(const f32x4 (&acc)[2][2][4][2], const Unit& u, int wr, int wc, int fr, int fq) const {
        const int row0 = u.pm * BM + wr * 64 + fr, col0 = u.pn * BM + wc * 32 + 8 * fq;
        unsigned char* base = O + (size_t)u.g * gstride;
#pragma unroll
        for (int ai = 0; ai < 2; ++ai)
#pragma unroll
            for (int m = 0; m < 4; ++m) { unsigned char* rowp = base + (size_t)(row0 + ai * HALF + m * 16) * ldc + col0;
#pragma unroll
                for (int bj = 0; bj < 2; ++bj) { float o[8];
#pragma unroll
                    for (int n = 0; n < 2; ++n)
#pragma unroll
                        for (int q = 0; q < 4; ++q) { const float x = acc[ai][bj][m][n][q]; o[4 * n + q] = (Z8_SCALE * x) * fast_sigmoid(1.5957691216057308f * (x + 0.044715f * x * x * x)); }
                    *(u32x2*)(rowp + bj * HALF) = (u32x2){pk4_fp8(o[0], o[1], o[2], o[3]), pk4_fp8(o[4], o[5], o[6], o[7])}; } }
    }
};
constexpr float Y8_SCALE = 16.0f, Y8_INV = 1.0f / 16.0f;
struct EpiGate {
    static constexpr bool PERM = true;
    unsigned char* O; int ldc; size_t gstride; const float* gate; int rpg;
    __device__ __forceinline__ void operator()(const f32x4 (&acc)[2][2][4][2], const Unit& u, int wr, int wc, int fr, int fq) const {
        const int row0 = u.pm * BM + wr * 64 + fr, col0 = u.pn * BM + wc * 32 + 8 * fq;
        unsigned char* base = O + (size_t)u.g * gstride;
#pragma unroll
        for (int ai = 0; ai < 2; ++ai)
#pragma unroll
            for (int m = 0; m < 4; ++m) { const int row = row0 + ai * HALF + m * 16; const float gt = gate[u.g * rpg + row] * (W8_INV * Y8_SCALE); unsigned char* rowp = base + (size_t)row * ldc + col0;
#pragma unroll
                for (int bj = 0; bj < 2; ++bj) { const f32x4 v0 = acc[ai][bj][m][0] * gt, v1 = acc[ai][bj][m][1] * gt;
                    *(u32x2*)(rowp + bj * HALF) = (u32x2){pk4_fp8(v0[0], v0[1], v0[2], v0[3]), pk4_fp8(v1[0], v1[1], v1[2], v1[3])}; } }
    }
};
struct EpiF32 {
    static constexpr bool PERM = false;
    float* C; int ldc; size_t gstride;
    __device__ __forceinline__ void operator()(const f32x4 (&acc)[2][2][4][2], const Unit& u, int wr, int wc, int fr, int fq) const {
        const int row0 = u.pm * BM + wr * 64 + fr, col0 = u.pn * BM + wc * 32 + 4 * fq;
#pragma unroll
        for (int ai = 0; ai < 2; ++ai)
#pragma unroll
            for (int m = 0; m < 4; ++m) { float* rowp = C + (size_t)u.g * gstride + (size_t)(row0 + ai * HALF + m * 16) * ldc + col0;
#pragma unroll
                for (int bj = 0; bj < 2; ++bj)
#pragma unroll
                    for (int n = 0; n < 2; ++n) *(f32x4*)(rowp + bj * HALF + n * 16) = acc[ai][bj][m][n]; }
    }
};
struct EpiResid {
    static constexpr bool PERM = true;
    bf16_t* X; const float* modL;
    __device__ __forceinline__ void operator()(const f32x4 (&acc)[2][2][4][2], const Unit& u, int wr, int wc, int fr, int fq) const {
        const int row0 = u.pm * BM + wr * 64 + fr, col0 = u.pn * BM + wc * 32 + 8 * fq;
        const int b = u.pm / 17, j = (u.pm - b * 17 == 0) ? 8 : b;
        const float* g1 = modL + (size_t)(j * 6 + 2) * 1024 + col0;
        f32x4 gv[2][2];
#pragma unroll
        for (int bj = 0; bj < 2; ++bj)
#pragma unroll
            for (int n = 0; n < 2; ++n) gv[bj][n] = *(const f32x4*)(g1 + bj * HALF + n * 4);
#pragma unroll
        for (int ai = 0; ai < 2; ++ai)
#pragma unroll
            for (int m = 0; m < 4; ++m) { bf16_t* rowp = X + (size_t)(row0 + ai * HALF + m * 16) * D + col0;
#pragma unroll
                for (int bj = 0; bj < 2; ++bj) { u32x4* p = (u32x4*)(rowp + bj * HALF); const u32x4 w = *p;
                    const f32x4 x0 = bf4_to_f32((u32x2){w.x, w.y}) + gv[bj][0] * acc[ai][bj][m][0], x1 = bf4_to_f32((u32x2){w.z, w.w}) + gv[bj][1] * acc[ai][bj][m][1];
                    const u32x2 o0 = f32_to_bf4(x0), o1 = f32_to_bf4(x1); *p = (u32x4){o0.x, o0.y, o1.x, o1.y}; } }
    }
};
struct EpiGluResid {
    static constexpr bool PERM = true;
    bf16_t* X; const float* modL; const float* bias;
    __device__ __forceinline__ void operator()(const f32x4 (&acc)[2][2][4][2], const Unit& u, int wr, int wc, int fr, int fq) const {
        const int row0 = u.pm * BM + wr * 64 + fr, col0 = u.pn * HALF + wc * 32 + 8 * fq;
        const int b = u.pm / 17, j = (u.pm - b * 17 == 0) ? 8 : b;
        const float* g1 = modL + (size_t)(j * 6 + 2) * 1024 + col0;
        f32x4 gv[2], ba[2], bg[2];
#pragma unroll
        for (int n = 0; n < 2; ++n) { gv[n] = *(const f32x4*)(g1 + n * 4); ba[n] = *(const f32x4*)(bias + col0 + n * 4); bg[n] = *(const f32x4*)(bias + 1024 + col0 + n * 4); }
#pragma unroll
        for (int ai = 0; ai < 2; ++ai)
#pragma unroll
            for (int m = 0; m < 4; ++m) { u32x4* p = (u32x4*)(X + (size_t)(row0 + ai * HALF + m * 16) * D + col0); const u32x4 w = *p;
                f32x4 xo[2] = {bf4_to_f32((u32x2){w.x, w.y}), bf4_to_f32((u32x2){w.z, w.w})};
#pragma unroll
                for (int n = 0; n < 2; ++n) { const f32x4 a = acc[ai][0][m][n] * (W8_INV / Z8_SCALE) + ba[n], g = acc[ai][1][m][n] * (W8_INV / Z8_SCALE) + bg[n];
                    f32x4 o; o.x = a.x * fast_sigmoid(g.x); o.y = a.y * fast_sigmoid(g.y); o.z = a.z * fast_sigmoid(g.z); o.w = a.w * fast_sigmoid(g.w);
                    xo[n] = xo[n] + gv[n] * o; }
                const u32x2 o0 = f32_to_bf4(xo[0]), o1 = f32_to_bf4(xo[1]); *p = (u32x4){o0.x, o0.y, o1.x, o1.y}; }
    }
};
}

namespace attn_body {
using bf16=__hip_bfloat16;
using bf16x8=__attribute__((ext_vector_type(8)))short;
using s16x4=__attribute__((ext_vector_type(4)))short;
using f32x16=__attribute__((ext_vector_type(16)))float;
using u32x4=__attribute__((ext_vector_type(4)))unsigned;
constexpr int D=64,QP=512,KP=128,VP=2816,OP=1024;
constexpr int NW=8,QBLK=32,QB=QBLK*NW,KVBLK=64;
__device__ __forceinline__ int crow(int r,int hi){return (r&3)+8*(r>>2)+4*hi;}
#define SBAR() __builtin_amdgcn_sched_barrier(0)
__device__ __forceinline__ void cmask(f32x16&p0,f32x16&p1,int jb,int qrel,int hi){
  const float NEG=-INFINITY; int kb=64*jb+4*hi;
  #pragma unroll
  for(int r=0;r<16;++r){int kv=kb+(r&3)+8*(r>>2); if(kv>qrel)p0[r]=NEG; if(kv+32>qrel)p1[r]=NEG;}
}

constexpr int NSLOT=3, SLOTB=8192;
constexpr int LDS_K=0, LDS_V=NSLOT*SLOTB, LDS_WS=2*NSLOT*SLOTB, LDS_OST=LDS_WS+NW*64*4, LDS_BYTES=LDS_OST+NW*4096;
constexpr float C2=0.125f*1.4426950408889634f;
__device__ __forceinline__ void glds16(const void*gsrc,unsigned lds_dst){unsigned keep;
  asm volatile("s_mov_b32 %0, m0\n\ts_mov_b32 m0, %2\n\ts_nop 0\n\tglobal_load_lds_dwordx4 %1, off\n\ts_mov_b32 m0, %0":"=&s"(keep):"v"(gsrc),"s"(lds_dst):"memory");}
__device__ __forceinline__ float max3f(float a,float b,float c){float r;asm("v_max3_f32 %0, %1, %2, %3":"=v"(r):"v"(a),"v"(b),"v"(c));return r;}
__device__ __forceinline__ float max2f(float a,float b){float r;asm("v_max_f32_e32 %0, %1, %2":"=v"(r):"v"(a),"v"(b));return r;}
__device__ __forceinline__ float fadd_s(float a,float b){float r;asm("v_add_f32_e32 %0, %1, %2":"=v"(r):"v"(a),"v"(b));return r;}
__device__ __forceinline__ float fsub_s(float a,float b){float r;asm("v_sub_f32_e32 %0, %1, %2":"=v"(r):"v"(a),"v"(b));return r;}
typedef float f32x2_t __attribute__((ext_vector_type(2))); typedef __bf16 bf16x2_t __attribute__((ext_vector_type(2)));
__device__ __forceinline__ unsigned cvtpk_s(float lo,float hi){f32x2_t v={lo,hi};bf16x2_t b=__builtin_convertvector(v,bf16x2_t);return __builtin_bit_cast(unsigned,b);}
#define WAIT_BAR(N) asm volatile("s_waitcnt vmcnt(" #N ") lgkmcnt(0)\n\ts_barrier":::"memory")

__device__ __forceinline__ void qkt(f32x16&p0,f32x16&p1,const char*Kslot,const bf16x8*qr,const f32x16&negm,int r32,int hi){
  const char*kb=Kslot+hi*1024+r32*16;
  #pragma unroll
  for(int d0=0;d0<4;++d0){
    const bf16x8 b0=*reinterpret_cast<const bf16x8*>(kb+d0*2048);
    const bf16x8 b1=*reinterpret_cast<const bf16x8*>(kb+d0*2048+512);
    if(d0==0){p0=__builtin_amdgcn_mfma_f32_32x32x16_bf16(b0,qr[0],negm,0,0,0);p1=__builtin_amdgcn_mfma_f32_32x32x16_bf16(b1,qr[0],negm,0,0,0);}
    else{p0=__builtin_amdgcn_mfma_f32_32x32x16_bf16(b0,qr[d0],p0,0,0,0);p1=__builtin_amdgcn_mfma_f32_32x32x16_bf16(b1,qr[d0],p1,0,0,0);}}
}
typedef __attribute__((address_space(3))) const char* lds_cptr;
typedef short v4i16_t __attribute__((ext_vector_type(4)));
__device__ __forceinline__ void kload8(bf16x8*kf,lds_cptr kp){
  kf[0]=*(const __attribute__((address_space(3))) bf16x8*)(kp);      kf[1]=*(const __attribute__((address_space(3))) bf16x8*)(kp+512);
  kf[2]=*(const __attribute__((address_space(3))) bf16x8*)(kp+2048); kf[3]=*(const __attribute__((address_space(3))) bf16x8*)(kp+2560);
  kf[4]=*(const __attribute__((address_space(3))) bf16x8*)(kp+4096); kf[5]=*(const __attribute__((address_space(3))) bf16x8*)(kp+4608);
  kf[6]=*(const __attribute__((address_space(3))) bf16x8*)(kp+6144); kf[7]=*(const __attribute__((address_space(3))) bf16x8*)(kp+6656);
}
__device__ __forceinline__ void kload2(bf16x8*kf,lds_cptr kp,int j){ kf[2*j]=*(const __attribute__((address_space(3))) bf16x8*)(kp+j*2048); kf[2*j+1]=*(const __attribute__((address_space(3))) bf16x8*)(kp+j*2048+512); }
__device__ __forceinline__ s16x4 vtr(lds_cptr p){ return __builtin_bit_cast(s16x4,__builtin_amdgcn_ds_read_tr16_b64_v4i16((__attribute__((address_space(3))) v4i16_t*)p)); }
__device__ __forceinline__ float rowmax(const f32x16&p0,const f32x16&p1){
  float a=max3f(p0[0],p0[1],p1[0]),b=max3f(p0[2],p0[3],p1[1]);a=max3f(a,p1[2],p1[3]);
  #pragma unroll
  for(int r=4;r<16;r+=4){a=max3f(a,p0[r],p0[r+1]);b=max3f(b,p0[r+2],p0[r+3]);a=max3f(a,p1[r],p1[r+1]);b=max3f(b,p1[r+2],p1[r+3]);}
  const float m=max2f(a,b);
  auto rr=__builtin_amdgcn_permlane32_swap(__float_as_uint(m),__float_as_uint(m),false,false);
  return max2f(__uint_as_float(rr[0]),__uint_as_float(rr[1]));
}
__device__ __forceinline__ void pv(f32x16*o,int vb,bf16x8 pa0,bf16x8 pa1,bf16x8 pa2,bf16x8 pa3){
  #pragma unroll
  for(int d0=0;d0<2;++d0){s16x4 lo[4],hi[4];
    #pragma unroll
    for(int ks=0;ks<4;++ks){
      asm volatile("ds_read_b64_tr_b16 %0,%1 offset:%c2":"=&v"(lo[ks]):"v"(vb),"i"(d0*4096+ks*1024):"memory");
      asm volatile("ds_read_b64_tr_b16 %0,%1 offset:%c2":"=&v"(hi[ks]):"v"(vb),"i"(d0*4096+ks*1024+512):"memory");}
    asm volatile("s_waitcnt lgkmcnt(0)":::"memory");SBAR();
    #define PK(k) (bf16x8){lo[k][0],lo[k][1],lo[k][2],lo[k][3],hi[k][0],hi[k][1],hi[k][2],hi[k][3]}
    o[d0]=__builtin_amdgcn_mfma_f32_32x32x16_bf16(pa0,PK(0),o[d0],0,0,0);
    o[d0]=__builtin_amdgcn_mfma_f32_32x32x16_bf16(pa1,PK(1),o[d0],0,0,0);
    o[d0]=__builtin_amdgcn_mfma_f32_32x32x16_bf16(pa2,PK(2),o[d0],0,0,0);
    o[d0]=__builtin_amdgcn_mfma_f32_32x32x16_bf16(pa3,PK(3),o[d0],0,0,0);
    #undef PK
  }
}

#ifndef ATTN_STORE16
#define ATTN_STORE16(p,v) (*(u32x4*)(p)=(v))
#endif
template<int THRL,bool NOMAX> __device__ __forceinline__ void attn_unit(const bf16*Qw0,const bf16*Kh,const bf16*Vh,bf16*Ow0,const int NT,char*shm,const int wid){
  const int lane=lane_id(),r32=lane&31,hi=lane>>5;
  const bf16*Qw=Qw0+(long)(wid*QBLK)*QP;
  const unsigned lds0=(unsigned)(uintptr_t)shm;
  float*wsf=(float*)(shm+LDS_WS)+wid*64;
  const bf16*ksrc=Kh+(long)lane*KP+wid*8;
  const bf16*vsrc=Vh+(long)(16*(wid&3)+(lane>>2))*VP+(wid>>2)*32+(lane&3)*8;
  const unsigned kdst=lds0+LDS_K+wid*1024, vdst=lds0+LDS_V+wid*1024;
  #define DMA_K(t,slot) glds16(ksrc+(long)(t)*KVBLK*KP,(unsigned)__builtin_amdgcn_readfirstlane(kdst+(slot)))
  #define DMA_V(t,slot) glds16(vsrc+(long)(t)*KVBLK*VP,(unsigned)__builtin_amdgcn_readfirstlane(vdst+(slot)))
  const int vb0=(int)(lds0+LDS_V)+((lane>>4)&1)*32+(lane&3)*8+(4*hi+((lane&15)>>2))*64;
  const char*Kbase=shm+LDS_K; bf16x8 kf[8];
  const lds_cptr shm3=(lds_cptr)shm; const lds_cptr kp0=shm3+LDS_K+hi*1024+r32*16; const lds_cptr vp0=shm3+LDS_V+((lane>>4)&1)*32+(lane&3)*8+(4*hi+((lane&15)>>2))*64;
  DMA_K(0,0);DMA_V(0,0);DMA_K(1,SLOTB);
  bf16x8 qr[4];
  #pragma unroll
  for(int d0=0;d0<4;++d0)qr[d0]=*reinterpret_cast<const bf16x8*>(&Qw[(long)r32*QP+d0*16+hi*8]);
  float mhat=0.f,l_reg=0.f;f32x16 o[2];o[0]=f32x16{};o[1]=f32x16{};f32x16 negm=f32x16{};asm volatile("":"+v"(negm));
  #define CMASK(P0,P1,t) do{}while(0)
  bool resc=false;
  #define START(P0,P1) do{ resc=false; if constexpr(!NOMAX){ const float rm=rowmax(P0,P1); \
    { const float dl=rm; mhat=fadd_s(mhat,dl); \
      _Pragma("unroll") for(int r=0;r<16;++r){P0[r]=fsub_s(P0[r],dl);P1[r]=fsub_s(P1[r],dl);} \
      _Pragma("unroll") for(int r=0;r<16;++r)negm[r]=-mhat; asm volatile("":"+v"(negm)); } } \
    _Pragma("unroll") for(int r=0;r<16;++r)P0[r]=__builtin_amdgcn_exp2f(P0[r]); }while(0)
  #define RESC() do{ if(resc){ asm volatile("s_waitcnt lgkmcnt(0)":::"memory"); \
      _Pragma("unroll") for(int d_=0;d_<2;++d_) _Pragma("unroll") for(int r=0;r<16;++r)o[d_][r]*=wsf[crow(r,hi)]; } }while(0)
  f32x16 pA0,pA1,pB0,pB1;
  int sl_prev=0,sl_cur=0,sl_next=SLOTB;
  #define ROT() do{sl_prev=sl_cur;sl_cur=sl_next;sl_next=(sl_next==(NSLOT-1)*SLOTB)?0:sl_next+SLOTB;}while(0)
  DMA_K(2,2*SLOTB);
  WAIT_BAR(3);
  qkt(pA0,pA1,Kbase,qr,negm,r32,hi);asm volatile("s_nop 15\n\ts_nop 7":"+v"(pA0),"+v"(pA1));CMASK(pA0,pA1,0);
  START(pA0,pA1);
  _Pragma("unroll") for(int r=0;r<16;++r)pA1[r]=__builtin_amdgcn_exp2f(pA1[r]);
  WAIT_BAR(0);
  DMA_K(3,0);DMA_V(1,SLOTB);
  ROT();
  kload8(kf,kp0+sl_cur);
  WAIT_BAR(2);
  s16x4 vlo[8],vhi[8]; u32x4 pw0,pw1,pw2,pw3;
  #define PKW(P,B) cvtpk_s(P[B],P[B+1])
  #define PAF(k) __builtin_bit_cast(bf16x8,pw##k)
  #define VFR(i) (bf16x8){vlo[i][0],vlo[i][1],vlo[i][2],vlo[i][3],vhi[i][0],vhi[i][1],vhi[i][2],vhi[i][3]}
  #define PIN(x) asm volatile("":"+v"(x))
  #define MX3(a,b,c) __builtin_fmaxf(__builtin_fmaxf((a),(b)),(c))
  #define GAPA(MF,A0,A1,A2,A3,W0,W1,PW) do{ MF; sacc+=A0; sacc+=A1; sacc+=A2; sacc+=A3; PIN(sacc); W0; W1; PIN(PW); SBAR(); }while(0)
  #define EX(v) __builtin_amdgcn_exp2f(v)
  #define GAPB(MF,X,B) do{ MF; X[B]=EX(X[B]); X[B+1]=EX(X[B+1]); X[B+2]=EX(X[B+2]); X[B+3]=EX(X[B+3]); PIN(X); SBAR(); }while(0)
  #define VRD(i) do{ vlo[i]=vtr(vp_+(((i)>>2)*4096+((i)&3)*1024)); vhi[i]=vtr(vp_+(((i)>>2)*4096+((i)&3)*1024+512)); }while(0)
  #define KRD(G,j) do{ if(G){ kload2(kf,kp0+sl_next,j); SBAR(); } }while(0)
  #define STEP(C0,C1,P0,P1,t,GK,GV,GL) do{ SBAR(); \
    const lds_cptr vp_=vp0+sl_prev; \
    VRD(0); SBAR(); float sacc=(P0[0]+P0[1]); \
    GAPA(C0=__builtin_amdgcn_mfma_f32_32x32x16_bf16(kf[0],qr[0],negm,0,0,0), P0[2],P0[3],P0[4],P0[5],     pw0[0]=PKW(P0,0), pw0[1]=PKW(P0,2), pw0); \
    VRD(4); SBAR(); GAPA(C1=__builtin_amdgcn_mfma_f32_32x32x16_bf16(kf[1],qr[0],negm,0,0,0), P0[6],P0[7],P0[8],P0[9],     pw0[2]=PKW(P0,4), pw0[3]=PKW(P0,6), pw0); \
    VRD(1); SBAR(); GAPA(C0=__builtin_amdgcn_mfma_f32_32x32x16_bf16(kf[2],qr[1],C0,0,0,0),   P0[10],P0[11],P0[12],P0[13], pw1[0]=PKW(P0,8), pw1[1]=PKW(P0,10), pw1); \
    VRD(5); SBAR(); GAPA(C1=__builtin_amdgcn_mfma_f32_32x32x16_bf16(kf[3],qr[1],C1,0,0,0),   P0[14],P0[15],P1[0],P1[1],   pw1[2]=PKW(P0,12),pw1[3]=PKW(P0,14), pw1); \
    VRD(2); SBAR(); GAPA(C0=__builtin_amdgcn_mfma_f32_32x32x16_bf16(kf[4],qr[2],C0,0,0,0),   P1[2],P1[3],P1[4],P1[5],     pw2[0]=PKW(P1,0), pw2[1]=PKW(P1,2), pw2); \
    VRD(6); SBAR(); GAPA(C1=__builtin_amdgcn_mfma_f32_32x32x16_bf16(kf[5],qr[2],C1,0,0,0),   P1[6],P1[7],P1[8],P1[9],     pw2[2]=PKW(P1,4), pw2[3]=PKW(P1,6), pw2); \
    VRD(3); SBAR(); GAPA(C0=__builtin_amdgcn_mfma_f32_32x32x16_bf16(kf[6],qr[3],C0,0,0,0),   P1[10],P1[11],P1[12],P1[13], pw3[0]=PKW(P1,8), pw3[1]=PKW(P1,10), pw3); \
    VRD(7); SBAR(); GAPA(C1=__builtin_amdgcn_mfma_f32_32x32x16_bf16(kf[7],qr[3],C1,0,0,0),   P1[14],P1[15],0.f,0.f,       pw3[2]=PKW(P1,12),pw3[3]=PKW(P1,14), pw3); \
    l_reg+=sacc; \
    if(GK){DMA_K((t)+3,sl_cur);} if(GV){DMA_V((t)+1,sl_next);} \
    CMASK(C0,C1,t); \
    if constexpr(!NOMAX) { float a=MX3(C0[0],C0[1],C1[0]),b=MX3(C0[2],C0[3],C1[1]); a=MX3(a,C1[2],C1[3]); \
      _Pragma("unroll") for(int r=4;r<16;r+=4){a=MX3(a,C0[r],C0[r+1]);b=MX3(b,C0[r+2],C0[r+3]);a=MX3(a,C1[r],C1[r+1]);b=MX3(b,C1[r+2],C1[r+3]);} \
      float rm=__builtin_fmaxf(a,b); { auto rr=__builtin_amdgcn_permlane32_swap(__float_as_uint(rm),__float_as_uint(rm),false,false); rm=__builtin_fmaxf(__uint_as_float(rr[0]),__uint_as_float(rr[1])); } \
      resc=false; \
      if(__builtin_expect(__any(rm>(float)THRL),0)){ const float dl=__builtin_fmaxf(rm,0.f); mhat+=dl; \
        _Pragma("unroll") for(int r=0;r<16;++r){C0[r]-=dl;C1[r]-=dl;} \
        _Pragma("unroll") for(int r=0;r<16;++r)negm[r]=-mhat; asm volatile("":"+v"(negm)); \
        const float f=__builtin_amdgcn_exp2f(-dl); l_reg*=f; if(hi==0)wsf[r32]=f; resc=true; } } \
    SBAR(); \
    GAPB(o[0]=__builtin_amdgcn_mfma_f32_32x32x16_bf16(PAF(0),VFR(0),o[0],0,0,0), C0,0); \
    GAPB(o[1]=__builtin_amdgcn_mfma_f32_32x32x16_bf16(PAF(0),VFR(4),o[1],0,0,0), C0,4); \
    KRD(GL,0); GAPB(o[0]=__builtin_amdgcn_mfma_f32_32x32x16_bf16(PAF(1),VFR(1),o[0],0,0,0), C0,8); \
    KRD(GL,1); GAPB(o[1]=__builtin_amdgcn_mfma_f32_32x32x16_bf16(PAF(1),VFR(5),o[1],0,0,0), C0,12); \
    KRD(GL,2); GAPB(o[0]=__builtin_amdgcn_mfma_f32_32x32x16_bf16(PAF(2),VFR(2),o[0],0,0,0), C1,0); \
    KRD(GL,3); GAPB(o[1]=__builtin_amdgcn_mfma_f32_32x32x16_bf16(PAF(2),VFR(6),o[1],0,0,0), C1,4); \
    GAPB(o[0]=__builtin_amdgcn_mfma_f32_32x32x16_bf16(PAF(3),VFR(3),o[0],0,0,0), C1,8); \
    GAPB(o[1]=__builtin_amdgcn_mfma_f32_32x32x16_bf16(PAF(3),VFR(7),o[1],0,0,0), C1,12); \
    }while(0)
  int t=1;
  #undef CMASK
  #define CMASK(P0,P1,t) do{}while(0)
  for(;t+5<NT;t+=2){
    STEP(pB0,pB1,pA0,pA1,t,true,true,true);     WAIT_BAR(2); RESC(); ROT();
    STEP(pA0,pA1,pB0,pB1,t+1,true,true,true);   WAIT_BAR(2); RESC(); ROT();
  }
  #undef CMASK
  #define CMASK(P0,P1,t) do{}while(0)
  #define ENDW(tt) do{ if((tt)+3<NT){WAIT_BAR(2);} else if((tt)+2<NT){WAIT_BAR(1);} else {WAIT_BAR(0);} }while(0)
  for(;t+1<NT;t+=2){
    STEP(pB0,pB1,pA0,pA1,t,(t+3<NT),(t+1<NT),(t+1<NT));       ENDW(t);   RESC(); ROT();
    STEP(pA0,pA1,pB0,pB1,t+1,(t+4<NT),(t+2<NT),(t+2<NT));     ENDW(t+1); RESC(); ROT();
  }
  STEP(pB0,pB1,pA0,pA1,NT-1,false,false,false); RESC();
  { float sacc=pB0[0]+pB0[1]; _Pragma("unroll") for(int r=2;r<16;++r)sacc+=pB0[r]; _Pragma("unroll") for(int r=0;r<16;++r)sacc+=pB1[r]; l_reg+=sacc;
    pw0=(u32x4){PKW(pB0,0),PKW(pB0,2),PKW(pB0,4),PKW(pB0,6)};pw1=(u32x4){PKW(pB0,8),PKW(pB0,10),PKW(pB0,12),PKW(pB0,14)};pw2=(u32x4){PKW(pB1,0),PKW(pB1,2),PKW(pB1,4),PKW(pB1,6)};pw3=(u32x4){PKW(pB1,8),PKW(pB1,10),PKW(pB1,12),PKW(pB1,14)};
    SBAR(); pv(o,vb0+sl_cur,PAF(0),PAF(1),PAF(2),PAF(3)); }
  #undef PKW
  #undef PAF
  #undef VFR
  #undef PIN
  #undef MX3
  #undef GAPA
  #undef GAPB
  #undef EX
  #undef VRD
  #undef KRD
  #undef STEP
  #undef ENDW
  {auto rr=__builtin_amdgcn_permlane32_swap(__float_as_uint(l_reg),__float_as_uint(l_reg),false,false);l_reg=__uint_as_float(rr[0])+__uint_as_float(rr[1]);}
  if(hi==0)wsf[32+r32]=l_reg;asm volatile("s_waitcnt lgkmcnt(0)":::"memory");
  float rli[16];
  #pragma unroll
  for(int r=0;r<16;++r)rli[r]=__builtin_amdgcn_rcpf(wsf[32+crow(r,hi)]);
  bf16*Ow=Ow0+(long)(wid*QBLK)*OP;
  { bf16*stg=(bf16*)(shm+LDS_OST)+wid*2048;
    #pragma unroll
    for(int r=0;r<16;++r){const int orow=crow(r,hi);
      #pragma unroll
      for(int d0=0;d0<2;++d0)stg[orow*64+d0*32+r32]=__float2bfloat16(o[d0][r]*rli[r]);}
    asm volatile("s_waitcnt lgkmcnt(0)":::"memory");
    #pragma unroll
    for(int i=0;i<4;++i){const int row=i*8+(lane>>3),ch=lane&7; const u32x4 v=*(const u32x4*)(stg+row*64+ch*8); ATTN_STORE16(Ow+(long)row*OP+ch*8,v);} }
  asm volatile("s_waitcnt lgkmcnt(0)\n\ts_barrier":::"memory");
  #undef DMA_K
  #undef DMA_V
  #undef CMASK
  #undef START
  #undef RESC
  #undef ROT
}
constexpr int ATTN_LDS_BYTES=LDS_BYTES;
#undef SBAR
#undef WAIT_BAR
}

__device__ __forceinline__ void phase_pro(const Ctx& c, LAS float* ldsf) {
    float* rope = (float*)(c.ws + WS_ROPE);
    for (int i = c.gt; i < 64 * 16; i += c.ngt) {
        const int pos = i >> 4, fi = i & 15; const float inv = powf(10000.0f, -(float)fi / 16.0f), ang = (float)pos * inv;
        rope[2 * i] = cosf(ang); rope[2 * i + 1] = sinf(ang);
    }
    LAS float* sil = ldsf; LAS float* red = ldsf + 9 * 1024;
    for (int i = c.tid; i < 9 * 1024; i += 512) { const int j = i >> 10, k = i & 1023; const float v = (j < 8) ? c.in[IN_C][j * 1024 + k] : c.in[IN_CCTX][k]; sil[i] = siluf_(v); }
    __syncthreads();
    float* MOD = (float*)(c.ws + WS_MOD);
    for (int task = c.vb; task < DEPTH * 192; task += c.vg) {
        const int L = task / 192, cb = task - L * 192, col = cb * 32 + (c.lane & 31);
        const float* W = c.in[IN_MODW] + (size_t)L * 1024 * 6144 + col;
        float acc[9];
#pragma unroll
        for (int j = 0; j < 9; ++j) acc[j] = 0.f;
        const int k0 = c.wave * 128 + (c.lane >> 5);
        for (int kb = 0; kb < 128; kb += 32) {
            float w[16];
#pragma unroll
            for (int u = 0; u < 16; ++u) w[u] = __builtin_nontemporal_load(W + (size_t)(k0 + kb + 2 * u) * 6144);
#pragma unroll
            for (int u = 0; u < 16; ++u)
#pragma unroll
                for (int j = 0; j < 9; ++j) acc[j] += sil[j * 1024 + k0 + kb + 2 * u] * w[u];
        }
#pragma unroll
        for (int j = 0; j < 9; ++j) { acc[j] += __shfl_xor(acc[j], 32); if (c.lane < 32) red[(c.wave * 9 + j) * 32 + c.lane] = acc[j]; }
        __syncthreads();
        if (c.wave == 0 && c.lane < 32) {
            const float bias = c.in[IN_MODB][L * 6144 + col];
#pragma unroll
            for (int j = 0; j < 9; ++j) { float s = bias;
#pragma unroll
                for (int w = 0; w < 8; ++w) s += red[(w * 9 + j) * 32 + c.lane];
                MOD[(size_t)(L * 9 + j) * 6144 + col] = s; }
        }
        __syncthreads();
    }
}

template <bool FINAL, bool GM, int NR>
__device__ __forceinline__ void norm1_rows(const Ctx& c, int L, int rbeg, int rend) {
    unsigned short* X = (unsigned short*)(c.ws + WS_X);
    const int* SLOT = (const int*)(c.ws + WS_SLOT); const unsigned char* Y = (const unsigned char*)(c.ws + WS_Y);
    int ch[4];
#pragma unroll
    for (int q = 0; q < 4; ++q) ch[q] = GM ? 16 * c.lane + 4 * q : 4 * (c.lane + 64 * q);
#define N1_DEC(w) ((f32x4){__builtin_amdgcn_cvt_pk_f32_fp8((int)(w), false)[0], __builtin_amdgcn_cvt_pk_f32_fp8((int)(w), false)[1], __builtin_amdgcn_cvt_pk_f32_fp8((int)(w), true)[0], __builtin_amdgcn_cvt_pk_f32_fp8((int)(w), true)[1]})
    pg8::u32x2 xn[NR][4]; int spn[NR]; unsigned yp0[NR][4], yp1[NR][4]; unsigned long long maskn[NR]; bool hasn[NR], twon[NR];
#pragma unroll
    for (int k = 0; k < NR; ++k) { spn[k] = -1; maskn[k] = 0ull; hasn[k] = false; twon[k] = false; }
#define N1_LOADX(k, row) do { _Pragma("unroll") for (int q = 0; q < 4; ++q) xn[k][q] = *(const pg8::u32x2*)(X + (size_t)(row) * D + ch[q]); \
        if (L > 0 && c.lane < NE) spn[k] = SLOT[(size_t)(row) * NE + c.lane]; } while (0)
#define N1_YPF(k) do { unsigned long long m_ = __ballot(spn[k] >= 0 && c.lane < NE); hasn[k] = m_ != 0ull; twon[k] = false; if (m_) { \
        const int e0_ = __builtin_ctzll(m_); m_ &= m_ - 1; twon[k] = m_ != 0ull; const int e1_ = twon[k] ? __builtin_ctzll(m_) : e0_; if (twon[k]) m_ &= m_ - 1; \
        const unsigned char* y0_ = Y + ((size_t)e0_ * EROWS + __builtin_amdgcn_readlane(spn[k], e0_)) * D; const unsigned char* y1_ = Y + ((size_t)e1_ * EROWS + __builtin_amdgcn_readlane(spn[k], e1_)) * D; \
        _Pragma("unroll") for (int q = 0; q < 4; ++q) { yp0[k][q] = __builtin_nontemporal_load((const unsigned*)(y0_ + ch[q])); yp1[k][q] = __builtin_nontemporal_load((const unsigned*)(y1_ + ch[q])); } } maskn[k] = m_; } while (0)
    const int gall = rend / NR, gper = (gall - rbeg / NR + c.ngw - 1) / c.ngw;
    int gidx = rbeg / NR + c.gw * gper;
    const int ngrp = (gidx + gper < gall) ? gidx + gper : gall;
    if (gidx < ngrp) {
#pragma unroll
        for (int k = 0; k < NR; ++k) N1_LOADX(k, gidx * NR + k);
        if (L > 0) {
#pragma unroll
            for (int k = 0; k < NR; ++k) N1_YPF(k);
        }
    }
    int jprev = -1; f32x4 gmv[4] = {}, shv[4] = {}, g2v[4] = {};
    for (; gidx < ngrp; ++gidx) {
        const int r0 = gidx * NR;
        const int b = r0 / RB, s0 = r0 - b * RB, j = s0 < CL ? 8 : b;
        pg8::u32x2 xc[NR][4]; int spc[NR]; unsigned w0[NR][4], w1[NR][4]; unsigned long long mask[NR]; bool has[NR], two0[NR];
#pragma unroll
        for (int k = 0; k < NR; ++k) { spc[k] = spn[k]; mask[k] = maskn[k]; has[k] = hasn[k]; two0[k] = twon[k];
#pragma unroll
            for (int q = 0; q < 4; ++q) { xc[k][q] = xn[k][q]; w0[k][q] = yp0[k][q]; w1[k][q] = yp1[k][q]; } }
        const int gn = gidx + 1;
        if (gn < ngrp) {
#pragma unroll
            for (int k = 0; k < NR; ++k) N1_LOADX(k, gn * NR + k);
        }
        if (!(FINAL && s0 < CL)) {
            unsigned hw[NR][8];
            if (NR > 1 && j != jprev) { jprev = j;
#pragma unroll
                for (int q = 0; q < 4; ++q) {
                    if (FINAL) gmv[q] = *(const f32x4*)(c.in[IN_FNG] + ch[q]);
                    else { gmv[q] = *(const f32x4*)(c.in[IN_NORMG] + (size_t)(L * 2 + 0) * D + ch[q]) * (1.0f + *(const f32x4*)(modp(c, L, j, 1) + ch[q])); shv[q] = *(const f32x4*)(modp(c, L, j, 0) + ch[q]); }
                    if (L > 0) g2v[q] = *(const f32x4*)(modp(c, L - 1, j, 5) + ch[q]);
                }
            }
#pragma unroll
            for (int k = 0; k < NR; ++k) {
                const int r = r0 + k, s = s0 + k;
                unsigned short* xr = X + (size_t)r * D;
                f32x4 v[4];
#pragma unroll
                for (int q = 0; q < 4; ++q) v[q] = pg8::bf4_to_f32(xc[k][q]);
                if (L > 0) {
                    f32x4 sum[4] = {};
                    if (has[k]) {
#pragma unroll
                        for (int q = 0; q < 4; ++q) { sum[q] += N1_DEC(w0[k][q]); if (two0[k]) sum[q] += N1_DEC(w1[k][q]); }
                    }
                    unsigned long long mk = mask[k];
                    while (mk) {
                        const int e0 = __builtin_ctzll(mk); mk &= mk - 1;
                        const bool two = mk != 0ull; const int e1 = two ? __builtin_ctzll(mk) : e0; if (two) mk &= mk - 1;
                        const int sp0 = __builtin_amdgcn_readlane(spc[k], e0), sp1 = __builtin_amdgcn_readlane(spc[k], e1);
                        const unsigned char* y0 = Y + ((size_t)e0 * EROWS + sp0) * D; const unsigned char* y1 = Y + ((size_t)e1 * EROWS + sp1) * D;
                        unsigned u0[4], u1[4];
#pragma unroll
                        for (int q = 0; q < 4; ++q) { u0[q] = __builtin_nontemporal_load((const unsigned*)(y0 + ch[q])); u1[q] = __builtin_nontemporal_load((const unsigned*)(y1 + ch[q])); }
#pragma unroll
                        for (int q = 0; q < 4; ++q) { sum[q] += N1_DEC(u0[q]); if (two) sum[q] += N1_DEC(u1[q]); }
                    }
                    const float* g2 = modp(c, L - 1, j, 5);
#pragma unroll
                    for (int q = 0; q < 4; ++q) { v[q] += (NR > 1 ? g2v[q] : *(const f32x4*)(g2 + ch[q])) * (sum[q] * pg8::Y8_INV); if (!FINAL) { const pg8::u32x2 w = pg8::f32_to_bf4(v[q]); *(pg8::u32x2*)(xr + ch[q]) = w; v[q] = pg8::bf4_to_f32(w); } }
                }
                float ss = 0.f;
#pragma unroll
                for (int q = 0; q < 4; ++q) ss += v[q].x * v[q].x + v[q].y * v[q].y + v[q].z * v[q].z + v[q].w * v[q].w;
                const float rstd = rsqrtf(wave_sum(ss) * (1.0f / D) + EPS);
                if (FINAL) {
                    const float* g = c.in[IN_FNG]; float* op = c.out + (size_t)(b * T + s - CL) * D;
#pragma unroll
                    for (int q = 0; q < 4; ++q) *(f32x4*)(op + ch[q]) = v[q] * rstd * (NR > 1 ? gmv[q] : *(const f32x4*)(g + ch[q]));
                } else {
                    const float* g = c.in[IN_NORMG] + (size_t)(L * 2 + 0) * D; const float* sc = modp(c, L, j, 1); const float* sh = modp(c, L, j, 0);
#pragma unroll
                    for (int q = 0; q < 4; ++q) { const f32x4 hv = NR > 1 ? v[q] * rstd * gmv[q] + shv[q] : v[q] * rstd * *(const f32x4*)(g + ch[q]) * (1.0f + *(const f32x4*)(sc + ch[q])) + *(const f32x4*)(sh + ch[q]);
                        hw[k][2 * q] = pg8::cvt_pk_bf16(hv.x, hv.y); hw[k][2 * q + 1] = pg8::cvt_pk_bf16(hv.z, hv.w); }
                    if (!GM) { unsigned short* o = (unsigned short*)(c.ws + WS_HB1) + (size_t)r * D;
#pragma unroll
                        for (int q = 0; q < 4; ++q) *(pg8::u32x2*)(o + ch[q]) = (pg8::u32x2){hw[k][2 * q], hw[k][2 * q + 1]}; }
                }
            }
            if (!FINAL && GM) {
                unsigned short* o = (unsigned short*)(c.ws + WS_AS5) + ((size_t)c.lane * 1280 + (r0 >> 5)) * 768 + (r0 & 31) * 16;
#pragma unroll
                for (int k = 0; k < NR; ++k) { *(pg8::u32x4*)(o + 16 * k) = (pg8::u32x4){hw[k][0], hw[k][1], hw[k][2], hw[k][3]}; *(pg8::u32x4*)(o + 16 * k + 8) = (pg8::u32x4){hw[k][4], hw[k][5], hw[k][6], hw[k][7]}; }
            }
        }
        if (L > 0 && gn < ngrp) {
#pragma unroll
            for (int k = 0; k < NR; ++k) N1_YPF(k);
        }
    }
#undef N1_DEC
#undef N1_LOADX
#undef N1_YPF
}
template <int NR>
__device__ __forceinline__ void norm1_first_rows(const Ctx& c, int rbeg, int rend) {
    unsigned short* X = (unsigned short*)(c.ws + WS_X); unsigned short* H = (unsigned short*)(c.ws + WS_HB1);
    f32x4 xn[NR][4];
#define NF_LOAD(k, row) do { const int b_ = (row) / RB, s_ = (row) - b_ * RB; \
        const f32x4* sp_ = (const f32x4*)((s_ < CL) ? c.in[IN_CTX] + (size_t)(b_ * CL + s_) * D : c.in[IN_X] + (size_t)(b_ * T + s_ - CL) * D) + c.lane; \
        _Pragma("unroll") for (int q = 0; q < 4; ++q) xn[k][q] = __builtin_nontemporal_load(sp_ + 64 * q); } while (0)
    const int gall = rend / NR, gper = (gall - rbeg / NR + c.ngw - 1) / c.ngw;
    int gidx = rbeg / NR + c.gw * gper;
    const int ngrp = (gidx + gper < gall) ? gidx + gper : gall;
    if (gidx < ngrp) {
#pragma unroll
        for (int k = 0; k < NR; ++k) NF_LOAD(k, gidx * NR + k);
    }
    const float* g = c.in[IN_NORMG];
    int jprev = -1; f32x4 gmv[4] = {}, shv[4] = {}, g2v[4] = {};
    for (; gidx < ngrp; ++gidx) {
        const int r0 = gidx * NR, b = r0 / RB, s0 = r0 - b * RB, j = s0 < CL ? 8 : b;
        f32x4 xc[NR][4];
#pragma unroll
        for (int k = 0; k < NR; ++k)
#pragma unroll
            for (int q = 0; q < 4; ++q) xc[k][q] = xn[k][q];
        const int gn = gidx + 1;
        if (gn < ngrp) {
#pragma unroll
            for (int k = 0; k < NR; ++k) NF_LOAD(k, gn * NR + k);
        }
        const float* sc = modp(c, 0, j, 1); const float* sh = modp(c, 0, j, 0);
        if (j != jprev) { jprev = j;
#pragma unroll
            for (int q = 0; q < 4; ++q) { const int ch = 4 * (c.lane + 64 * q); gmv[q] = *(const f32x4*)(g + ch) * (1.0f + *(const f32x4*)(sc + ch)); shv[q] = *(const f32x4*)(sh + ch); } }
#pragma unroll
        for (int k = 0; k < NR; ++k) {
            const size_t r = (size_t)(r0 + k);
            f32x4 v[4]; float ss = 0.f;
#pragma unroll
            for (int q = 0; q < 4; ++q) { const pg8::u32x2 w = pg8::f32_to_bf4(xc[k][q]); *((pg8::u32x2*)(X + r * D) + c.lane + 64 * q) = w; v[q] = pg8::bf4_to_f32(w);
                ss += v[q].x * v[q].x + v[q].y * v[q].y + v[q].z * v[q].z + v[q].w * v[q].w; }
            const float rstd = rsqrtf(wave_sum(ss) * (1.0f / D) + EPS);
#pragma unroll
            for (int q = 0; q < 4; ++q) { const int ch = 4 * (c.lane + 64 * q);
                const f32x4 hv = v[q] * rstd * gmv[q] + shv[q];
                *((pg8::u32x2*)(H + r * D) + c.lane + 64 * q) = (pg8::u32x2){pg8::cvt_pk_bf16(hv.x, hv.y), pg8::cvt_pk_bf16(hv.z, hv.w)}; }
        }
    }
#undef NF_LOAD
}
__device__ __forceinline__ void phase_norm1_first(const Ctx& c) {
    norm1_first_rows<4>(c, 0, 32768);
    norm1_first_rows<1>(c, 32768, NROWS);
}
template <bool FINAL, bool GM>
__device__ __forceinline__ void phase_norm1(const Ctx& c, int L) {
    norm1_rows<FINAL, GM, 4>(c, L, 0, 32768);
    norm1_rows<FINAL, GM, 1>(c, L, 32768, NROWS);
}

template <bool SKIPCTX>
__device__ __forceinline__ void router_pairs(const Ctx& c, int L, const LAS float* wT, int rend) {
    const unsigned short* X = (const unsigned short*)(c.ws + WS_X); unsigned char* HB = (unsigned char*)(c.ws + WS_HB); float* AFF = (float*)(c.ws + WS_AFF);
    const int npair = rend >> 1, per = (npair + c.ngw - 1) / c.ngw, p0 = c.gw * per, p1 = (p0 + per < npair) ? p0 + per : npair;
    pg8::u32x2 xA[4], xB[4];
    if (p0 < p1) {
#pragma unroll
        for (int q = 0; q < 4; ++q) { xA[q] = ((const pg8::u32x2*)(X + (size_t)(2 * p0) * D) + c.lane)[64 * q]; xB[q] = ((const pg8::u32x2*)(X + (size_t)(2 * p0 + 1) * D) + c.lane)[64 * q]; }
    }
    int jprev = -1; f32x4 gmr[4] = {}, svr[4] = {};
    for (int p = p0; p < p1; ++p) {
        const int r0 = 2 * p, j = row_j(r0);
        f32x4 fA[4], fB[4]; float ssA = 0.f, ssB = 0.f;
#pragma unroll
        for (int q = 0; q < 4; ++q) { fA[q] = pg8::bf4_to_f32(xA[q]); fB[q] = pg8::bf4_to_f32(xB[q]);
            ssA += fA[q].x * fA[q].x + fA[q].y * fA[q].y + fA[q].z * fA[q].z + fA[q].w * fA[q].w; ssB += fB[q].x * fB[q].x + fB[q].y * fB[q].y + fB[q].z * fB[q].z + fB[q].w * fB[q].w; }
        if (p + 1 < p1) {
#pragma unroll
            for (int q = 0; q < 4; ++q) { xA[q] = ((const pg8::u32x2*)(X + (size_t)(2 * (p + 1)) * D) + c.lane)[64 * q]; xB[q] = ((const pg8::u32x2*)(X + (size_t)(2 * (p + 1) + 1) * D) + c.lane)[64 * q]; }
        }
        if (!(SKIPCTX && j == 8)) {
            const float rsA = rsqrtf(wave_sum(ssA) * (1.0f / D) + EPS), rsB = rsqrtf(wave_sum(ssB) * (1.0f / D) + EPS);
            const f32x4* g = (const f32x4*)(c.in[IN_NORMG] + (size_t)(L * 2 + 1) * D) + c.lane;
            const f32x4* sc = (const f32x4*)modp(c, L, j, 4) + c.lane; const f32x4* sh = (const f32x4*)modp(c, L, j, 3) + c.lane;
            unsigned* hA = (unsigned*)(HB + (size_t)r0 * D) + c.lane; unsigned* hB = (unsigned*)(HB + (size_t)(r0 + 1) * D) + c.lane;
            if (j != jprev) { jprev = j;
#pragma unroll
                for (int q = 0; q < 4; ++q) { gmr[q] = g[64 * q] * (1.0f + sc[64 * q]); svr[q] = sh[64 * q]; } }
#pragma unroll
            for (int q = 0; q < 4; ++q) { const f32x4 gm = gmr[q], sv = svr[q];
                fA[q] = fA[q] * rsA * gm + sv; fB[q] = fB[q] * rsB * gm + sv;
                hA[64 * q] = pg8::pk4_fp8(fA[q].x, fA[q].y, fA[q].z, fA[q].w); hB[64 * q] = pg8::pk4_fp8(fB[q].x, fB[q].y, fB[q].z, fB[q].w); }
            __builtin_amdgcn_sched_barrier(0);
            float lgA[16], lgB[16];
#pragma unroll
            for (int e = 0; e < 16; ++e) {
                f32x2 a2 = {0.f, 0.f}, b2 = {0.f, 0.f};
#pragma unroll
                for (int q = 0; q < 4; ++q) { const f32x4 wv = *(const LAS f32x4*)(wT + e * D + 4 * (c.lane + 64 * q));
                    a2 += fA[q].xy * wv.xy; a2 += fA[q].zw * wv.zw; b2 += fB[q].xy * wv.xy; b2 += fB[q].zw * wv.zw; }
                float a = a2.x + a2.y, b = b2.x + b2.y;
                asm volatile("" : "+v"(a), "+v"(b));
                lgA[e] = a; lgB[e] = b;
                if (e & 1) __builtin_amdgcn_sched_barrier(0);
            }
            const int kk = reduce16_k(c.lane);
            { const float mine = reduce16(lgA, c.lane); float mx = mine;
#pragma unroll
              for (int o = 4; o < 64; o <<= 1) mx = fmaxf(mx, __shfl_xor(mx, o));
              const float ex = expf(mine - mx); float den = ex;
#pragma unroll
              for (int o = 4; o < 64; o <<= 1) den += __shfl_xor(den, o);
              if ((c.lane & 3) == 0) AFF[(size_t)r0 * NE + kk] = ex / den; }
            { const float mine = reduce16(lgB, c.lane); float mx = mine;
#pragma unroll
              for (int o = 4; o < 64; o <<= 1) mx = fmaxf(mx, __shfl_xor(mx, o));
              const float ex = expf(mine - mx); float den = ex;
#pragma unroll
              for (int o = 4; o < 64; o <<= 1) den += __shfl_xor(den, o);
              if ((c.lane & 3) == 0) AFF[(size_t)(r0 + 1) * NE + kk] = ex / den; }
        }
    }
}
template <bool SKIPCTX>
__device__ __forceinline__ void phase_norm2_router(const Ctx& c, int L, LAS float* wT) {
    const unsigned short* X = (const unsigned short*)(c.ws + WS_X); unsigned char* HB = (unsigned char*)(c.ws + WS_HB); float* AFF = (float*)(c.ws + WS_AFF);
    const float* WR = c.in[IN_ROUTER] + (size_t)L * D * NE;
    __syncthreads();
    for (int idx = c.tid; idx < D * 4; idx += 512) { const int ch = idx >> 2, e4 = idx & 3; const f32x4 w = *(const f32x4*)(WR + (size_t)ch * NE + 4 * e4);
        wT[(4 * e4 + 0) * D + ch] = w.x; wT[(4 * e4 + 1) * D + ch] = w.y; wT[(4 * e4 + 2) * D + ch] = w.z; wT[(4 * e4 + 3) * D + ch] = w.w; }
    __syncthreads();
    router_pairs<SKIPCTX>(c, L, wT, 32768);
    constexpr int RB0 = 32768;
    pg8::u32x2 xn[4];
    if (RB0 + c.gw < NROWS) {
#pragma unroll
        for (int q = 0; q < 4; ++q) xn[q] = ((const pg8::u32x2*)(X + (size_t)(RB0 + c.gw) * D) + c.lane)[64 * q];
    }
    for (int r = RB0 + c.gw; r < NROWS; r += c.ngw) {
        const int j = row_j(r);
        f32x4 v[4]; float ss = 0.f;
#pragma unroll
        for (int q = 0; q < 4; ++q) { v[q] = pg8::bf4_to_f32(xn[q]); ss += v[q].x * v[q].x + v[q].y * v[q].y + v[q].z * v[q].z + v[q].w * v[q].w; }
        if (r + c.ngw < NROWS) {
#pragma unroll
            for (int q = 0; q < 4; ++q) xn[q] = ((const pg8::u32x2*)(X + (size_t)(r + c.ngw) * D) + c.lane)[64 * q];
        }
        if (SKIPCTX && j == 8) continue;
        const float rstd = rsqrtf(wave_sum(ss) * (1.0f / D) + EPS);
        const f32x4* g = (const f32x4*)(c.in[IN_NORMG] + (size_t)(L * 2 + 1) * D) + c.lane;
        const f32x4* sc = (const f32x4*)modp(c, L, j, 4) + c.lane; const f32x4* sh = (const f32x4*)modp(c, L, j, 3) + c.lane;
        unsigned* hp = (unsigned*)(HB + (size_t)r * D) + c.lane;
        float lg[16]; f32x4 f[4];
#pragma unroll
        for (int q = 0; q < 4; ++q) { f[q] = v[q] * rstd * g[64 * q] * (1.0f + sc[64 * q]) + sh[64 * q]; hp[64 * q] = pg8::pk4_fp8(f[q].x, f[q].y, f[q].z, f[q].w); }
        __builtin_amdgcn_sched_barrier(0);
#pragma unroll
        for (int e = 0; e < 16; ++e) {
            f32x2 a2 = {0.f, 0.f};
#pragma unroll
            for (int q = 0; q < 4; ++q) { const f32x4 wv = *(const LAS f32x4*)(wT + e * D + 4 * (c.lane + 64 * q)); a2 += f[q].xy * wv.xy; a2 += f[q].zw * wv.zw; }
            lg[e] = a2.x + a2.y;
            if (e & 1) __builtin_amdgcn_sched_barrier(0);
        }
        const float mine = reduce16(lg, c.lane);
        const int k = reduce16_k(c.lane);
        float mx = mine;
#pragma unroll
        for (int o = 4; o < 64; o <<= 1) mx = fmaxf(mx, __shfl_xor(mx, o));
        const float ex = expf(mine - mx);
        float den = ex;
#pragma unroll
        for (int o = 4; o < 64; o <<= 1) den += __shfl_xor(den, o);
        if ((c.lane & 3) == 0) AFF[(size_t)r * NE + k] = ex / den;
    }
}

__device__ __forceinline__ void phase_topk(const Ctx& c, LAS unsigned* lds32, int nprob) {
    const float* AFF = (const float*)(c.ws + WS_AFF);
    int* SELROW = (int*)(c.ws + WS_SELROW); float* SELGATE = (float*)(c.ws + WS_SELGATE); int* SLOT = (int*)(c.ws + WS_SLOT);
    LAS unsigned* hist = lds32; LAS unsigned* wsum = lds32 + 256; LAS unsigned* res = lds32 + 272;
    LAS int* srow = (LAS int*)(lds32 + 512);
    const unsigned char* HB = (const unsigned char*)(c.ws + WS_HB); unsigned char* XS = (unsigned char*)(c.ws + WS_XS);
    for (int pid = blockIdx.x; pid < nprob; pid += gridDim.x) {
        const bool lat = pid < 128; const int q = lat ? pid : pid - 128, b = q >> 4, e = q & 15;
        const int N = lat ? T : CL, C = lat ? CAP_LAT : CAP_CTX, row0 = b * RB + (lat ? CL : 0), base = lat ? b * CAP_LAT : NB * CAP_LAT + b * CAP_CTX;
        const int t0 = c.tid * 8; const bool valid = t0 < N;
        unsigned k[8];
#pragma unroll
        for (int i = 0; i < 8; ++i) k[i] = valid ? __float_as_uint(AFF[(size_t)(row0 + t0 + i) * NE + e]) : 0u;
        unsigned prefix = 0u, want = (unsigned)C;
#pragma unroll
        for (int r = 0; r < 4; ++r) {
            const int shift = 24 - 8 * r;
            __syncthreads();
            if (c.tid < 256) hist[c.tid] = 0u;
            __syncthreads();
            if (valid) {
#pragma unroll
                for (int i = 0; i < 8; ++i) if (r == 0 || (k[i] >> (shift + 8)) == prefix) __hip_atomic_fetch_add(&hist[(k[i] >> shift) & 255u], 1u, __ATOMIC_RELAXED, __HIP_MEMORY_SCOPE_WORKGROUP);
            }
            __syncthreads();
            if (c.wave == 0) {
                const unsigned h0 = hist[4 * c.lane], h1 = hist[4 * c.lane + 1], h2 = hist[4 * c.lane + 2], h3 = hist[4 * c.lane + 3];
                unsigned suf = h0 + h1 + h2 + h3;
#pragma unroll
                for (int off = 1; off < 64; off <<= 1) { const unsigned o = __shfl_down(suf, off); if (c.lane + off < 64) suf += o; }
                unsigned nxt = __shfl_down(suf, 1); if (c.lane == 63) nxt = 0u;
                if (suf >= want && nxt < want) {
                    unsigned above = nxt; int d;
                    if (above + h3 >= want) d = 3; else { above += h3; if (above + h2 >= want) d = 2; else { above += h2; if (above + h1 >= want) d = 1; else { above += h1; d = 0; } } }
                    res[0] = (unsigned)(4 * c.lane + d); res[1] = want - above;
                }
            }
            __syncthreads();
            prefix = (prefix << 8) | res[0]; want = res[1];
        }
        const unsigned thr = prefix, need_eq = want;
        unsigned cg = 0u, ce = 0u;
#pragma unroll
        for (int i = 0; i < 8; ++i) { cg += (valid && k[i] > thr) ? 1u : 0u; ce += (valid && k[i] == thr) ? 1u : 0u; }
        unsigned incl = cg | (ce << 16);
#pragma unroll
        for (int off = 1; off < 64; off <<= 1) { const unsigned o = __shfl_up(incl, off); if (c.lane >= off) incl += o; }
        __syncthreads();
        if (c.lane == 63) wsum[c.wave] = incl;
        __syncthreads();
        unsigned wbase = 0u;
#pragma unroll
        for (int w = 0; w < 8; ++w) if (w < c.wave) wbase += wsum[w];
        const unsigned excl = wbase + incl - (cg | (ce << 16));
        unsigned gb = excl & 0xffffu, eb = excl >> 16;
        if (valid) {
#pragma unroll
            for (int i = 0; i < 8; ++i) {
                const int row = row0 + t0 + i; const bool isg = k[i] > thr, ise = k[i] == thr;
                const bool sel = isg || (ise && eb < need_eq);
                const unsigned sp = (unsigned)base + gb + (eb < need_eq ? eb : need_eq);
                if (sel) { SELROW[e * EROWS + sp] = row; SELGATE[e * EROWS + sp] = __uint_as_float(k[i]); SLOT[(size_t)row * NE + e] = (int)sp; srow[sp - (unsigned)base] = row; }
                else SLOT[(size_t)row * NE + e] = -1;
                gb += isg ? 1u : 0u; eb += ise ? 1u : 0u;
            }
        }
        __syncthreads();
        for (int s0 = c.wave * 16; s0 < C; s0 += 128) {
            pg8::u32x4 v4[16];
#pragma unroll
            for (int j = 0; j < 16; ++j) v4[j] = *(const pg8::u32x4*)(HB + (size_t)srow[s0 + j] * D + c.lane * 16);
#pragma unroll
            for (int j = 0; j < 16; ++j) *(pg8::u32x4*)(XS + ((size_t)e * EROWS + base + s0 + j) * D + c.lane * 16) = v4[j];
        }
    }
}

__device__ __forceinline__ void post_ld32(const unsigned short* p, float (&v)[32]) {
#pragma unroll
    for (int q = 0; q < 4; ++q) { const pg8::u32x4 w = ((const pg8::u32x4*)p)[q];
#pragma unroll
        for (int e = 0; e < 4; ++e) { v[8 * q + 2 * e] = __uint_as_float(w[e] << 16); v[8 * q + 2 * e + 1] = __uint_as_float(w[e] & 0xffff0000u); } }
}
__device__ __forceinline__ void post_raw(const unsigned short* p, pg8::u32x4 (&w)[4]) {
#pragma unroll
    for (int q = 0; q < 4; ++q) w[q] = ((const pg8::u32x4*)p)[q];
}
__device__ __forceinline__ void post_cvt(const pg8::u32x4 (&w)[4], float (&v)[32]) {
#pragma unroll
    for (int q = 0; q < 4; ++q)
#pragma unroll
        for (int e = 0; e < 4; ++e) { v[8 * q + 2 * e] = __uint_as_float(w[q][e] << 16); v[8 * q + 2 * e + 1] = __uint_as_float(w[q][e] & 0xffff0000u); }
}
__device__ __forceinline__ void post_st32(unsigned short* p, const float (&v)[32], float sc) {
#pragma unroll
    for (int q = 0; q < 4; ++q) { pg8::u32x4 w;
#pragma unroll
        for (int e = 0; e < 4; ++e) w[e] = pg8::cvt_pk_bf16(v[8 * q + 2 * e] * sc, v[8 * q + 2 * e + 1] * sc);
        ((pg8::u32x4*)p)[q] = w; }
}
__device__ __forceinline__ void post_rope_l(float (&v)[32], const LAS float* cs  ) {
#pragma unroll
    for (int f4 = 0; f4 < 8; ++f4) { const f32x4 t4 = ((const LAS f32x4*)cs)[f4];
        { const float x1 = v[2 * f4], x2 = v[16 + 2 * f4]; v[2 * f4] = x1 * t4.x - x2 * t4.y; v[16 + 2 * f4] = x1 * t4.y + x2 * t4.x; }
        { const float x1 = v[2 * f4 + 1], x2 = v[16 + 2 * f4 + 1]; v[2 * f4 + 1] = x1 * t4.z - x2 * t4.w; v[16 + 2 * f4 + 1] = x1 * t4.w + x2 * t4.z; } }
}
__device__ __forceinline__ void post_rope(float (&v)[32], const float* cs  ) {
#pragma unroll
    for (int f4 = 0; f4 < 8; ++f4) { const f32x4 t4 = ((const f32x4*)cs)[f4];
        { const float x1 = v[2 * f4], x2 = v[16 + 2 * f4]; v[2 * f4] = x1 * t4.x - x2 * t4.y; v[16 + 2 * f4] = x1 * t4.y + x2 * t4.x; }
        { const float x1 = v[2 * f4 + 1], x2 = v[16 + 2 * f4 + 1]; v[2 * f4 + 1] = x1 * t4.z - x2 * t4.w; v[16 + 2 * f4 + 1] = x1 * t4.w + x2 * t4.z; } }
}
__device__ __forceinline__ void phase_post(const Ctx& c, int i, LAS unsigned char* lds) {
    typedef pg8::bf16x8 bf16x8;
    const unsigned short* P = (const unsigned short*)(c.ws + WS_P); const float* rope = (const float*)(c.ws + WS_ROPE);
    unsigned short* QA = (unsigned short*)(c.ws + WS_QA); unsigned short* KA = (unsigned short*)(c.ws + WS_KA); unsigned short* VA = (unsigned short*)(c.ws + WS_VA);
    unsigned short* RQ = (unsigned short*)(c.ws + WS_RQ); unsigned short* RK = (unsigned short*)(c.ws + WS_RK); unsigned short* RV = (unsigned short*)(c.ws + WS_RV);
    float* U = (float*)(c.ws + WS_U);
    const float* qkg = c.in[IN_QKG] + (size_t)i * 2 * 64;
    constexpr int VTS = 0, KTF = 17408, KTB = 34816;
    const int grp = c.tid >> 8, r = (c.tid & 255) >> 1, half = c.tid & 1;
    const int li = c.lane & 15, q4 = c.lane >> 4;
    pg8::u32x4 ra[4], rb[4], rc[4];
#define PP_LOAD(u_) do { const int hh_ = (u_) & 7, bc_ = (u_) >> 3, b_ = bc_ / 34, cch_ = bc_ - b_ * 34; const size_t row_ = (size_t)(b_ * RB + cch_ * 128 + r); \
        post_raw(P + row_ * INW + (grp ? 512 : 0) + hh_ * 64 + 32 * half, ra); post_raw(P + row_ * INW + (grp ? 2048 : 1024) + hh_ * 64 + 32 * half, rb); \
        if (hh_ < 2 && grp == 0) post_raw(P + row_ * INW + 2560 + hh_ * 64 + 32 * half, rc); } while (0)
    if ((int)blockIdx.x < NB * 34 * 8) PP_LOAD((int)blockIdx.x);
    LAS float* ropeL = (LAS float*)(lds + 53248); LAS float* qkL = ropeL + 64 * 36;
    for (int i2 = c.tid; i2 < 64 * 32; i2 += 512) ropeL[(i2 >> 5) * 36 + (i2 & 31)] = rope[i2];
    if (c.tid < 128) qkL[c.tid] = qkg[c.tid];
    __syncthreads();
    for (int unit = blockIdx.x; unit < NB * 34 * 8; unit += gridDim.x) {
        const int hh = unit & 7, bc = unit >> 3, b = bc / 34, cch = bc - b * 34, row0 = b * RB + cch * 128, bh = b * 8 + hh;
        const bool latent = cch >= 2;
        const size_t row = (size_t)(row0 + r);
        const int tpos = cch * 128 + r - CL;
        const LAS float* cs = ropeL + (half == 0 ? (tpos >> 6) : (tpos & 63)) * 36;
        const float lgf = -expf(c.in[IN_RETRATE][(i * 2 + 0) * 8 + hh]) * 1.4426950408889634f, lgb = -expf(c.in[IN_RETRATE][(i * 2 + 1) * 8 + hh]) * 1.4426950408889634f;
        __syncthreads();
        float v[32];
        post_cvt(ra, v);
        if (grp) {
#pragma unroll
            for (int d = 0; d < 32; ++d) v[d] *= 0.125f; }
        if (latent) post_rope_l(v, cs);
        post_st32((grp ? RK : RQ) + row * 512 + hh * 64 + 32 * half, v, 1.0f);
        if (grp) { const float wf = exp2f(lgf * (float)(127 - r)), wb = exp2f(lgb * (float)r);
#pragma unroll
            for (int d = 0; d < 32; d += 2) { const unsigned pf = pg8::cvt_pk_bf16(v[d] * wf, v[d + 1] * wf), pb = pg8::cvt_pk_bf16(v[d] * wb, v[d + 1] * wb);
                *(LAS unsigned short*)(lds + KTF + (32 * half + d) * 272 + r * 2) = (unsigned short)(pf & 0xffffu); *(LAS unsigned short*)(lds + KTF + (32 * half + d + 1) * 272 + r * 2) = (unsigned short)(pf >> 16);
                *(LAS unsigned short*)(lds + KTB + (32 * half + d) * 272 + r * 2) = (unsigned short)(pb & 0xffffu); *(LAS unsigned short*)(lds + KTB + (32 * half + d + 1) * 272 + r * 2) = (unsigned short)(pb >> 16); } }
        post_cvt(rb, v);
        if (grp == 0) {
#pragma unroll
            for (int d = 0; d < 32; d += 2) { const unsigned pv = pg8::cvt_pk_bf16(v[d], v[d + 1]);
                *(LAS unsigned short*)(lds + VTS + (32 * half + d) * 272 + r * 2) = (unsigned short)(pv & 0xffffu); *(LAS unsigned short*)(lds + VTS + (32 * half + d + 1) * 272 + r * 2) = (unsigned short)(pv >> 16); }
        } else {
            float ss = 0.f;
#pragma unroll
            for (int d = 0; d < 32; ++d) ss += v[d] * v[d];
            ss += __shfl_xor(ss, 1);
            const float rs = rsqrtf(ss * (1.0f / 64.0f) + EPS);
#pragma unroll
            for (int d = 0; d < 32; ++d) v[d] = v[d] * rs * qkL[32 * half + d];
            if (latent) post_rope_l(v, cs);
            post_st32(QA + row * 512 + hh * 64 + 32 * half, v, attn_body::C2);
        }
        if (hh < 2 && grp == 0) {
            post_cvt(rc, v);
            {
                float ss = 0.f;
#pragma unroll
                for (int d = 0; d < 32; ++d) ss += v[d] * v[d];
                ss += __shfl_xor(ss, 1);
                const float rs = rsqrtf(ss * (1.0f / 64.0f) + EPS);
#pragma unroll
                for (int d = 0; d < 32; ++d) v[d] = v[d] * rs * qkL[64 + 32 * half + d];
                if (latent) post_rope_l(v, cs);
                post_st32(KA + row * 128 + hh * 64 + 32 * half, v, 1.0f);
            }
        }
        if (unit + (int)gridDim.x < NB * 34 * 8) PP_LOAD(unit + (int)gridDim.x);
        __syncthreads();
        { const int dir = c.wave >> 2, dvt = c.wave & 3;
            bf16x8 af[4];
#pragma unroll
            for (int u = 0; u < 4; ++u) af[u] = *(const LAS bf16x8*)(lds + VTS + (16 * dvt + li) * 272 + (32 * u + 8 * q4) * 2);
            float* uo = U + ((size_t)(bh * 34 + cch) * 2 + dir) * 4096;
#pragma unroll
            for (int dkt = 0; dkt < 4; ++dkt) {
                f32x4 a = {0.f, 0.f, 0.f, 0.f};
#pragma unroll
                for (int u = 0; u < 4; ++u) { const bf16x8 kf = *(const LAS bf16x8*)(lds + (dir ? KTB : KTF) + (16 * dkt + li) * 272 + (32 * u + 8 * q4) * 2); a = __builtin_amdgcn_mfma_f32_16x16x32_bf16(af[u], kf, a, 0, 0, 0); }
#pragma unroll
                for (int rr = 0; rr < 4; ++rr) uo[(16 * dvt + 4 * q4 + rr) * 64 + 16 * dkt + li] = a[rr];
            } }
    }
}

#undef PP_LOAD
__device__ __forceinline__ void phase_ret_prefix(const Ctx& c, int i) {
    const float* U = (const float*)(c.ws + WS_U); unsigned short* ET = (unsigned short*)(c.ws + WS_ET);
    for (int chain = c.gt; chain < 64 * 2 * 2048; chain += c.ngt) {
        const int bh = chain >> 12, dir = (chain >> 11) & 1, el = 2 * (chain & 2047), hh = bh & 7;
        const float g128 = expf(-expf(c.in[IN_RETRATE][(i * 2 + dir) * 8 + hh]) * 128.0f);
        float S0 = 0.f, S1 = 0.f;
#pragma unroll
        for (int st = 0; st < 34; ++st) {
            const int cch = dir == 0 ? st : (st < 2 ? 1 - st : 35 - st);
            const size_t o = ((size_t)(bh * 34 + cch) * 2 + dir) * 4096 + el;
            *(unsigned*)(ET + o) = pg8::cvt_pk_bf16(S0, S1);
            const f32x2 u = *(const f32x2*)(U + o);
            S0 = g128 * S0 + u.x; S1 = g128 * S1 + u.y;
        }
    }
}
__device__ __forceinline__ void phase_ret_main(const Ctx& c, int i, LAS unsigned char* lds) {
    typedef pg8::bf16x8 bf16x8;
    const unsigned short* RQ = (const unsigned short*)(c.ws + WS_RQ); const unsigned short* RK = (const unsigned short*)(c.ws + WS_RK); const unsigned short* RV = (const unsigned short*)(c.ws + WS_RV);
    const unsigned short* ET = (const unsigned short*)(c.ws + WS_ET); const unsigned short* P = (const unsigned short*)(c.ws + WS_P); unsigned short* MIX = (unsigned short*)(c.ws + WS_MIX);
    const float* gn = c.in[IN_RETGN] + (size_t)i * 512;
    constexpr int QS = 0, KS = 18432, VTS = 36864, EF = 54272, EB = 63488;
    const int li = c.lane & 15, q4 = c.lane >> 4, i0 = 16 * c.wave, ig = i0 + li;
    pg8::u32x4 gq[2], gk[2], gv[2], gef, geb;
#define RM_LOAD(u_) do { const int bh_ = (u_) / 34, cch_ = (u_) - bh_ * 34, row0_ = (bh_ >> 3) * RB + cch_ * 128, hh_ = bh_ & 7; \
        _Pragma("unroll") for (int t2 = 0; t2 < 2; ++t2) { const int pc = c.tid + 512 * t2, r = pc >> 3, ch = pc & 7; const size_t go = (size_t)(row0_ + r) * 512 + hh_ * 64 + ch * 8; \
            gq[t2] = *(const pg8::u32x4*)(RQ + go); gk[t2] = *(const pg8::u32x4*)(RK + go); gv[t2] = *(const pg8::u32x4*)(P + (size_t)(row0_ + r) * INW + 1024 + hh_ * 64 + ch * 8); } \
        { const int r = c.tid >> 3, ch = c.tid & 7; const size_t go = ((size_t)(bh_ * 34 + cch_) * 2) * 4096 + r * 64 + ch * 8; gef = *(const pg8::u32x4*)(ET + go); geb = *(const pg8::u32x4*)(ET + go + 4096); } } while (0)
    if ((int)blockIdx.x < 64 * 34) RM_LOAD((int)blockIdx.x);
    for (int unit = blockIdx.x; unit < 64 * 34; unit += gridDim.x) {
        const int bh = unit / 34, cch = unit - bh * 34, b = bh >> 3, hh = bh & 7, row0 = b * RB + cch * 128;
        const float lgf = -expf(c.in[IN_RETRATE][(i * 2 + 0) * 8 + hh]) * 1.4426950408889634f, lgb = -expf(c.in[IN_RETRATE][(i * 2 + 1) * 8 + hh]) * 1.4426950408889634f;
        __syncthreads();
#pragma unroll
        for (int t2 = 0; t2 < 2; ++t2) { const int pc = c.tid + 512 * t2, r = pc >> 3, ch = pc & 7;
            *(LAS pg8::u32x4*)(lds + QS + r * 144 + ch * 16) = gq[t2];
            *(LAS pg8::u32x4*)(lds + KS + r * 144 + ch * 16) = gk[t2];
            const pg8::u32x4 vw = gv[t2];
#pragma unroll
            for (int e = 0; e < 4; ++e) { *(LAS unsigned short*)(lds + VTS + (ch * 8 + 2 * e) * 272 + r * 2) = (unsigned short)(vw[e] & 0xffffu); *(LAS unsigned short*)(lds + VTS + (ch * 8 + 2 * e + 1) * 272 + r * 2) = (unsigned short)(vw[e] >> 16); } }
        { const int r = c.tid >> 3, ch = c.tid & 7; *(LAS pg8::u32x4*)(lds + EF + r * 144 + ch * 16) = gef; *(LAS pg8::u32x4*)(lds + EB + r * 144 + ch * 16) = geb; }
        if (unit + (int)gridDim.x < 64 * 34) RM_LOAD(unit + (int)gridDim.x);
        __syncthreads();
        bf16x8 qf[2];
#pragma unroll
        for (int s = 0; s < 2; ++s) qf[s] = *(const LAS bf16x8*)(lds + QS + (i0 + li) * 144 + (32 * s + 8 * q4) * 2);
        pg8::u32x2 pk[8];
#pragma unroll
        for (int jt = 0; jt < 8; ++jt) {
            f32x4 a = {0.f, 0.f, 0.f, 0.f};
#pragma unroll
            for (int s = 0; s < 2; ++s) { const bf16x8 kf = *(const LAS bf16x8*)(lds + KS + (16 * jt + li) * 144 + (32 * s + 8 * q4) * 2); a = __builtin_amdgcn_mfma_f32_16x16x32_bf16(kf, qf[s], a, 0, 0, 0); }
            float pv[4];
#pragma unroll
            for (int r = 0; r < 4; ++r) { const int dl = ig - (16 * jt + 4 * q4 + r); const float w = dl >= 0 ? exp2f(lgf * (float)dl) : exp2f(lgb * (float)(-dl)); pv[r] = a[r] * w; }
            pk[jt] = (pg8::u32x2){pg8::cvt_pk_bf16(pv[0], pv[1]), pg8::cvt_pk_bf16(pv[2], pv[3])};
        }
        const float sf = exp2f(lgf * (float)(ig + 1)), sb = exp2f(lgb * (float)(128 - ig));
        f32x4 oacc[4];
#pragma unroll
        for (int dvt = 0; dvt < 4; ++dvt) {
            f32x4 o = {0.f, 0.f, 0.f, 0.f};
#pragma unroll
            for (int u = 0; u < 4; ++u) {
                const pg8::u32x2 vlo = *(const LAS pg8::u32x2*)(lds + VTS + (16 * dvt + li) * 272 + (32 * u + 4 * q4) * 2), vhi = *(const LAS pg8::u32x2*)(lds + VTS + (16 * dvt + li) * 272 + (32 * u + 16 + 4 * q4) * 2);
                const pg8::u32x4 av = {vlo.x, vlo.y, vhi.x, vhi.y}, bv = {pk[2 * u].x, pk[2 * u].y, pk[2 * u + 1].x, pk[2 * u + 1].y};
                o = __builtin_amdgcn_mfma_f32_16x16x32_bf16(__builtin_bit_cast(bf16x8, av), __builtin_bit_cast(bf16x8, bv), o, 0, 0, 0);
            }
            f32x4 tf = {0.f, 0.f, 0.f, 0.f}, tb = {0.f, 0.f, 0.f, 0.f};
#pragma unroll
            for (int s = 0; s < 2; ++s) {
                const bf16x8 ef = *(const LAS bf16x8*)(lds + EF + (16 * dvt + li) * 144 + (32 * s + 8 * q4) * 2), eb = *(const LAS bf16x8*)(lds + EB + (16 * dvt + li) * 144 + (32 * s + 8 * q4) * 2);
                tf = __builtin_amdgcn_mfma_f32_16x16x32_bf16(ef, qf[s], tf, 0, 0, 0); tb = __builtin_amdgcn_mfma_f32_16x16x32_bf16(eb, qf[s], tb, 0, 0, 0);
            }
            oacc[dvt] = o + tf * sf + tb * sb;
        }
        float sm = 0.f;
#pragma unroll
        for (int dvt = 0; dvt < 4; ++dvt) sm += (oacc[dvt].x + oacc[dvt].y) + (oacc[dvt].z + oacc[dvt].w);
        sm += __shfl_xor(sm, 16); sm += __shfl_xor(sm, 32);
        const float mu = sm * (1.0f / 64.0f); float vr = 0.f;
#pragma unroll
        for (int dvt = 0; dvt < 4; ++dvt) { oacc[dvt] = oacc[dvt] - mu; vr += (oacc[dvt].x * oacc[dvt].x + oacc[dvt].y * oacc[dvt].y) + (oacc[dvt].z * oacc[dvt].z + oacc[dvt].w * oacc[dvt].w); }
        vr += __shfl_xor(vr, 16); vr += __shfl_xor(vr, 32);
        const float rs = rsqrtf(vr * (1.0f / 64.0f) + EPS);
        const size_t row = (size_t)(row0 + ig);
#pragma unroll
        for (int dvt = 0; dvt < 4; ++dvt) { const int dvc = hh * 64 + 16 * dvt + 4 * q4;
            const pg8::u32x2 gw = *(const pg8::u32x2*)(P + row * INW + 1536 + dvc); const f32x4 gt = {__uint_as_float(gw.x << 16), __uint_as_float(gw.x & 0xffff0000u), __uint_as_float(gw.y << 16), __uint_as_float(gw.y & 0xffff0000u)}, gg = *(const f32x4*)(gn + dvc); const f32x4 y = oacc[dvt] * rs * gg;
            *(pg8::u32x2*)(MIX + row * D + dvc) = (pg8::u32x2){pg8::cvt_pk_bf16(gt.x * pg8::fast_sigmoid(gt.x) * y.x, gt.y * pg8::fast_sigmoid(gt.y) * y.y), pg8::cvt_pk_bf16(gt.z * pg8::fast_sigmoid(gt.z) * y.z, gt.w * pg8::fast_sigmoid(gt.w) * y.w)}; }
    }
}

#undef RM_LOAD
__device__ __forceinline__ void phase_attention(const Ctx& c, int i, char* lds) {
    const attn_body::bf16* QA = (const attn_body::bf16*)(c.ws + WS_QA); const attn_body::bf16* KA = (const attn_body::bf16*)(c.ws + WS_KA); const attn_body::bf16* VA = (const attn_body::bf16*)(c.ws + WS_P) + 2688;
    attn_body::bf16* MIX = (attn_body::bf16*)(c.ws + WS_MIX);
    const int G = gridDim.x, bx = blockIdx.x, vcu = (G % 8 == 0) ? (bx % 8) * (G / 8) + bx / 8 : bx;
    float gq = fabsf(c.in[IN_QKG][(size_t)i * 128 + c.lane]), gk = fabsf(c.in[IN_QKG][(size_t)i * 128 + 64 + c.lane]);
#pragma unroll
    for (int o = 1; o < 64; o <<= 1) { gq = fmaxf(gq, __shfl_xor(gq, o)); gk = fmaxf(gk, __shfl_xor(gk, o)); }
    const bool bounded = __builtin_amdgcn_readfirstlane(64.0f * gq * gk * attn_body::C2 < 40.0f ? 1 : 0) != 0;
    for (int U = vcu; U < NB * 8 * 17; U += G) {
        int bh, qrow0, NT;
        if (U < NB * 8 * 16) { bh = U >> 4; qrow0 = (bh >> 3) * RB + CL + (U & 15) * 256; NT = RB / 64; }
        else { bh = U - NB * 8 * 16; qrow0 = (bh >> 3) * RB; NT = CL / 64; }
        const int b = bh >> 3, hh = bh & 7;
        if (bounded) attn_body::attn_unit<8, true>(QA + (size_t)qrow0 * 512 + hh * 64, KA + (size_t)(b * RB) * 128 + (hh >> 2) * 64, VA + (size_t)(b * RB) * INW + (hh >> 2) * 64,
                                MIX + (size_t)qrow0 * 1024 + 512 + hh * 64, NT, lds, c.wave);
        else attn_body::attn_unit<8, false>(QA + (size_t)qrow0 * 512 + hh * 64, KA + (size_t)(b * RB) * 128 + (hh >> 2) * 64, VA + (size_t)(b * RB) * INW + (hh >> 2) * 64,
                                MIX + (size_t)qrow0 * 1024 + 512 + hh * 64, NT, lds, c.wave);
    }
}

__device__ __forceinline__ void phase_s5_ops(const Ctx& c, LAS float* ldsf) {
    LAS float* Pre = ldsf; LAS float* Pim = ldsf + 4608; LAS float* KZr = ldsf + 9216; LAS float* KZi = ldsf + 9344;
    LAS float* Bre = ldsf + 9472; LAS float* Bim = ldsf + 10496; LAS float* Cre = ldsf + 11520; LAS float* Cim = ldsf + 13568;
    LAS float* KV = ldsf + 15616;
#define S5P(dir, pw, p) (((dir) * 64 + (p)) * 36 + (pw))
    for (int task = c.vb; task < 2 * 64 * 2; task += c.vg) {
        const int i = task >> 7, g = (task >> 1) & 63, hf = task & 1;
        __syncthreads();
        if (c.tid < 128) {
            const int dir = c.tid >> 6, p = c.tid & 63;
            const float a_re = c.in[IN_S5ARE][((i * 2 + dir) * 64 + g) * 64 + p], a_im = c.in[IN_S5AIM][((i * 2 + dir) * 64 + g) * 64 + p];
            const float dt = expf(c.in[IN_S5DT][(i * 2 + dir) * 64 + g]);
            const float lre = fminf(a_re, -1e-4f), lim = a_im, ea = lre * dt, eb = lim * dt;
            const float cb = cosf(eb), sb = sinf(eb), sh = sinf(0.5f * eb), mag = expf(ea);
            { float pr = 1.0f, pi = 0.0f; const float ar = mag * cb, ai = mag * sb;
                for (int dl = 0; dl <= 32; ++dl) { Pre[S5P(dir, dl, p)] = pr; Pim[S5P(dir, dl, p)] = pi; const float nr_ = pr * ar - pi * ai, ni_ = pr * ai + pi * ar; pr = nr_; pi = ni_; } }
            const float nr = expm1f(ea) * cb - 2.0f * sh * sh, ni = mag * sb, den = lre * lre + lim * lim;
            KZr[dir * 64 + p] = (nr * lre + ni * lim) / den; KZi[dir * 64 + p] = (ni * lre - nr * lim) / den;
        }
        for (int idx = c.tid; idx < 1024; idx += 512) { Bre[idx] = c.in[IN_S5BRE][(size_t)(i * 64 + g) * 1024 + idx]; Bim[idx] = c.in[IN_S5BIM][(size_t)(i * 64 + g) * 1024 + idx]; }
        for (int idx = c.tid; idx < 2048; idx += 512) { const int dir = idx >> 10, rem = idx & 1023;
            Cre[idx] = c.in[IN_S5CRE][((size_t)(i * 2 + dir) * 64 + g) * 1024 + rem]; Cim[idx] = c.in[IN_S5CIM][((size_t)(i * 2 + dir) * 64 + g) * 1024 + rem]; }
        __syncthreads();
        {
            const int dir = c.tid >> 8, ko = (c.tid >> 4) & 15, ki = c.tid & 15;
            float acc[32];
#pragma unroll
            for (int dl = 0; dl < 32; ++dl) acc[dl] = 0.f;
            for (int p = 0; p < 64; ++p) {
                const float kr = KZr[dir * 64 + p], kq = KZi[dir * 64 + p], br = Bre[p * 16 + ki], bi = Bim[p * 16 + ki], cr = Cre[(dir * 16 + ko) * 64 + p], ci = Cim[(dir * 16 + ko) * 64 + p];
                const float gr = kr * br - kq * bi, gi = kr * bi + kq * br, tr = cr * gr - ci * gi, ti = cr * gi + ci * gr;
#pragma unroll
                for (int d4 = 0; d4 < 8; ++d4) { const f32x4 pr = *(const LAS f32x4*)(Pre + S5P(dir, 4 * d4, p)), pi = *(const LAS f32x4*)(Pim + S5P(dir, 4 * d4, p));
                    acc[4 * d4] += tr * pr.x - ti * pi.x; acc[4 * d4 + 1] += tr * pr.y - ti * pi.y; acc[4 * d4 + 2] += tr * pr.z - ti * pi.z; acc[4 * d4 + 3] += tr * pr.w - ti * pi.w; }
            }
#pragma unroll
            for (int dl = 0; dl < 32; ++dl) KV[((dir * 32 + dl) * 16 + ko) * 16 + ki] = acc[dl];
        }
        __syncthreads();
        unsigned* TV = (unsigned*)(c.ws + WS_TV) + ((size_t)(i * 64 + g) * 512 * 768) / 2;
        const float* dsk = c.in[IN_S5D] + (size_t)i * D + 16 * g;
        if (c.tid < 384) {
            const int kp = c.tid, kk = 2 * kp;
            if (kk < 512) {
                const int j = kk >> 4, ki = kk & 15;
                for (int it = 16 * hf; it < 16 * hf + 16; ++it) {
                    const int dl = it > j ? it - j : j - it, dir = it > j ? 0 : 1;
                    for (int ko = 0; ko < 16; ++ko) {
                        float v0, v1;
                        if (it != j) { v0 = KV[((dir * 32 + dl) * 16 + ko) * 16 + ki]; v1 = KV[((dir * 32 + dl) * 16 + ko) * 16 + ki + 1]; }
                        else { v0 = KV[(ko) * 16 + ki] + KV[((32) * 16 + ko) * 16 + ki] + (ko == ki ? dsk[ko] : 0.f); v1 = KV[(ko) * 16 + ki + 1] + KV[((32) * 16 + ko) * 16 + ki + 1] + (ko == ki + 1 ? dsk[ko] : 0.f); }
                        TV[(size_t)(it * 16 + ko) * 384 + kp] = pg8::cvt_pk_bf16(v0, v1);
                    }
                }
            } else {
                const int q = kk - 512, dir = q >> 7, part = (q >> 6) & 1, p = q & 63;
                for (int it = 16 * hf; it < 16 * hf + 16; ++it) {
                    const int pw = dir == 0 ? it + 1 : 32 - it;
                    const float pr0 = Pre[S5P(dir, pw, p)], pi0 = Pim[S5P(dir, pw, p)], pr1 = Pre[S5P(dir, pw, p + 1)], pi1 = Pim[S5P(dir, pw, p + 1)];
                    for (int ko = 0; ko < 16; ++ko) {
                        const float cr0 = Cre[(dir * 16 + ko) * 64 + p], ci0 = Cim[(dir * 16 + ko) * 64 + p], cr1 = Cre[(dir * 16 + ko) * 64 + p + 1], ci1 = Cim[(dir * 16 + ko) * 64 + p + 1];
                        const float v0 = part == 0 ? (cr0 * pr0 - ci0 * pi0) : -(cr0 * pi0 + ci0 * pr0), v1 = part == 0 ? (cr1 * pr1 - ci1 * pi1) : -(cr1 * pi1 + ci1 * pr1);
                        TV[(size_t)(it * 16 + ko) * 384 + kp] = pg8::cvt_pk_bf16(v0, v1);
                    }
                }
            }
        }
        unsigned* WS5 = (unsigned*)(c.ws + WS_WS5) + ((size_t)(i * 64 + g) * 256 * 512) / 2;
        if (c.tid < 256) {
            const int kp = c.tid, kk = 2 * kp, j = kk >> 4, ki = kk & 15, dir = hf, pw = dir == 0 ? 31 - j : j;
            for (int pp = 0; pp < 128; ++pp) {
                const int part = pp >> 6, p = pp & 63;
                const float pr = Pre[S5P(dir, pw, p)], pi = Pim[S5P(dir, pw, p)], kr = KZr[dir * 64 + p], kq = KZi[dir * 64 + p];
                const float gr = pr * kr - pi * kq, gi = pr * kq + pi * kr, br0 = Bre[p * 16 + ki], bi0 = Bim[p * 16 + ki], br1 = Bre[p * 16 + ki + 1], bi1 = Bim[p * 16 + ki + 1];
                const float v0 = part == 0 ? (gr * br0 - gi * bi0) : (gr * bi0 + gi * br0), v1 = part == 0 ? (gr * br1 - gi * bi1) : (gr * bi1 + gi * br1);
                WS5[(size_t)(128 * hf + pp) * 256 + kp] = pg8::cvt_pk_bf16(v0, v1);
            }
        }
    }
#undef S5P
}
__device__ __forceinline__ void phase_s5_carry(const Ctx& c, int i) {
    const unsigned short* SL = (const unsigned short*)(c.ws + WS_SL); unsigned short* AS5 = (unsigned short*)(c.ws + WS_AS5);
    for (int id = c.gt; id < 64 * 8 * 2 * 64; id += c.ngt) {
        const int p = id & 63, dir = (id >> 6) & 1, b = (id >> 7) & 7, g = id >> 10;
        const float a_re = c.in[IN_S5ARE][((i * 2 + dir) * 64 + g) * 64 + p], a_im = c.in[IN_S5AIM][((i * 2 + dir) * 64 + g) * 64 + p];
        const float dt = expf(c.in[IN_S5DT][(i * 2 + dir) * 64 + g]);
        const float lre = fminf(a_re, -1e-4f), m32 = expf(lre * dt * 32.0f), an = a_im * dt * 32.0f, ar = m32 * cosf(an), ai = m32 * sinf(an);
        float xr = 0.f, xi = 0.f;
        for (int s0 = 0; s0 < 136; s0 += 17) {
            float sr[17], si[17]; size_t rr[17];
#pragma unroll
            for (int k = 0; k < 17; ++k) { const int st = s0 + k, cch = dir == 0 ? st : (st < 8 ? 7 - st : 143 - st);
                rr[k] = (size_t)g * 1280 + b * 136 + cch; sr[k] = __uint_as_float((unsigned)SL[rr[k] * 256 + dir * 128 + p] << 16); si[k] = __uint_as_float((unsigned)SL[rr[k] * 256 + dir * 128 + 64 + p] << 16); }
#pragma unroll
            for (int k = 0; k < 17; ++k) {
                unsigned short* xo = AS5 + rr[k] * 768 + 512 + dir * 128 + p;
                xo[0] = (unsigned short)(pg8::cvt_pk_bf16(xr, 0.f) & 0xffffu); xo[64] = (unsigned short)(pg8::cvt_pk_bf16(xi, 0.f) & 0xffffu);
                const float nxr = ar * xr - ai * xi + sr[k], nxi = ar * xi + ai * xr + si[k];
                xr = nxr; xi = nxi;
            }
        }
    }
}

__device__ __forceinline__ void cvt_item(const float* W, int ldw, int k0, int scol0, unsigned short* WT, int K, int drow0, LAS float* scr, int lane) {
    float wv[32];
#pragma unroll
    for (int i = 0; i < 32; ++i) wv[i] = W[(size_t)(k0 + 2 * i + (lane >> 5)) * ldw + scol0 + (lane & 31)];
#pragma unroll
    for (int i = 0; i < 32; ++i) scr[(2 * i + (lane >> 5)) * 33 + (lane & 31)] = wv[i];
    asm volatile("s_waitcnt lgkmcnt(0)" ::: "memory");
    const int cc = lane & 7;
#pragma unroll
    for (int j = 0; j < 4; ++j) { const int n = (lane >> 3) + 8 * j; const LAS float* s = scr + (8 * cc) * 33 + n;
        pg8::u32x4 o; o.x = pg8::cvt_pk_bf16(s[0 * 33], s[1 * 33]); o.y = pg8::cvt_pk_bf16(s[2 * 33], s[3 * 33]); o.z = pg8::cvt_pk_bf16(s[4 * 33], s[5 * 33]); o.w = pg8::cvt_pk_bf16(s[6 * 33], s[7 * 33]);
        *(pg8::u32x4*)(WT + (size_t)(drow0 + n) * K + k0 + 8 * cc) = o; }
    asm volatile("s_waitcnt lgkmcnt(0)" ::: "memory");
}
__device__ __forceinline__ void cvt_item8(const float* W, int ldw, int k0, int scol0, unsigned char* WT, int K, int drow0, LAS float* scr, int lane) {
    float wv[32];
#pragma unroll
    for (int i = 0; i < 32; ++i) wv[i] = W[(size_t)(k0 + 2 * i + (lane >> 5)) * ldw + scol0 + (lane & 31)];
#pragma unroll
    for (int i = 0; i < 32; ++i) scr[(2 * i + (lane >> 5)) * 33 + (lane & 31)] = wv[i] * pg8::W8_SCALE;
    asm volatile("s_waitcnt lgkmcnt(0)" ::: "memory");
    const int n = lane >> 1, kh = lane & 1; const LAS float* s = scr + (32 * kh) * 33 + n;
    unsigned w[8];
#pragma unroll
    for (int j = 0; j < 8; ++j) w[j] = pg8::pk4_fp8(s[(4 * j) * 33], s[(4 * j + 1) * 33], s[(4 * j + 2) * 33], s[(4 * j + 3) * 33]);
    unsigned char* o = WT + (size_t)(drow0 + n) * K + k0 + 32 * kh;
    *(pg8::u32x4*)o = (pg8::u32x4){w[0], w[1], w[2], w[3]}; *(pg8::u32x4*)(o + 16) = (pg8::u32x4){w[4], w[5], w[6], w[7]};
    asm volatile("s_waitcnt lgkmcnt(0)" ::: "memory");
}
__device__ __forceinline__ void cvt_moe_tile(const Ctx& c, LAS unsigned char* img, int id) {
    unsigned char* W13 = (unsigned char*)(c.ws + WS_W13); unsigned char* W2T = (unsigned char*)(c.ws + WS_W2);
    const int le = id / 192; int r = id - le * 192;
    const float* sp; int ldw, K; unsigned char* dst; int rowl;
    if (r < 128) { const int kt = r >> 4, pn = r & 15, half = c.lane >> 5, n4 = c.lane & 31;
        sp = (half ? c.in[IN_W3] : c.in[IN_W1]) + (size_t)le * D * FF + (size_t)(128 * kt + 16 * c.wave) * FF + 128 * pn + 4 * n4; ldw = FF; K = D;
        dst = W13 + (size_t)le * 4096 * D + (size_t)(256 * pn) * D + 128 * kt; rowl = 128 * half + 4 * n4;
    } else { r -= 128; const int kt = r >> 2, pn = r & 3;
        sp = c.in[IN_W2] + (size_t)le * FF * D + (size_t)(128 * kt + 16 * c.wave) * D + 256 * pn + 4 * c.lane; ldw = D; K = FF;
        dst = W2T + (size_t)le * D * FF + (size_t)(256 * pn) * FF + 128 * kt; rowl = 4 * c.lane; }
    f32x4 v[16];
#pragma unroll
    for (int q = 0; q < 16; ++q) v[q] = __builtin_nontemporal_load((const f32x4*)(sp + (size_t)q * ldw));
    __syncthreads();
#pragma unroll
    for (int j = 0; j < 4; ++j) {
        pg8::u32x4 w;
#pragma unroll
        for (int q4 = 0; q4 < 4; ++q4) w[q4] = pg8::pk4_fp8(v[4 * q4][j] * pg8::W8_SCALE, v[4 * q4 + 1][j] * pg8::W8_SCALE, v[4 * q4 + 2][j] * pg8::W8_SCALE, v[4 * q4 + 3][j] * pg8::W8_SCALE);
        const int row = rowl + j;
        *(LAS pg8::u32x4*)(img + row * 128 + ((c.wave ^ ((row >> 2) & 7)) * 16)) = w;
    }
    __syncthreads();
#pragma unroll
    for (int i4 = 0; i4 < 4; ++i4) { const int p = c.tid + 512 * i4, row = p >> 3, ch = p & 7;
        *(pg8::u32x4*)(dst + (size_t)row * K + 16 * ch) = *(const LAS pg8::u32x4*)(img + row * 128 + ((ch ^ ((row >> 2) & 7)) * 16)); }
}
constexpr int HS_N = 14, HS_L0 = 2304, HS_L3 = 3072;
enum { HK_OUT = 0, HK_TOPK, HK_GEMM2, HK_S1, HK_S3, HK_GLU };
__device__ __forceinline__ constexpr int host_gs(int L, int kind) {
    return L == 0 ? (kind == HK_OUT ? 0 : kind == HK_TOPK ? 1 : kind == HK_GEMM2 ? 2 : -1)
         : L == 1 ? (kind == HK_S1 ? 3 : kind == HK_S3 ? 4 : kind == HK_GLU ? 5 : kind == HK_TOPK ? 6 : kind == HK_GEMM2 ? 7 : -1)
         : L == 2 ? (kind == HK_OUT ? 8 : kind == HK_TOPK ? 9 : kind == HK_GEMM2 ? 10 : -1)
         : (kind == HK_S1 ? 11 : kind == HK_S3 ? 12 : kind == HK_TOPK ? 13 : -1);
}
__device__ __forceinline__ void host_slot(int gs, int& rem, int& quota) {
    constexpr int REM[HS_N] = {32, 128, 64, 64, 128, 64, 128, 64, 32, 128, 64, 64, 128, 128}, Q[HS_N] = {8, 4, 6, 3, 5, 3, 4, 5, 8, 4, 6, 3, 5, 4};
    rem = 0; quota = 0;
#pragma unroll
    for (int i = 0; i < HS_N; ++i) if (i == gs) { rem = REM[i]; quota = Q[i]; }
}
__device__ __forceinline__ int host_tile_id(int u) {
    if (u < HS_L0) return u;
    u -= HS_L0; if (u < 3072) return 3072 + u;
    u -= 3072; if (u < 3072) return 2 * 3072 + u;
    u -= 3072; if (u < HS_L3) return 3 * 3072 + u;
    return -1;
}
__device__ __forceinline__ void hosted_cvt(const Ctx& c, LAS unsigned char* img, int L, int kind) {
    if (gridDim.x != 256) return;
    const int gs = host_gs(L, kind);
    if (gs < 0) return;
    int off = 0;
    for (int s = 0; s < gs; ++s) { int r0, q0; host_slot(s, r0, q0); off += (256 - r0) * q0; }
    int rem, q; host_slot(gs, rem, q);
    if ((int)blockIdx.x < rem) return;
    const int idle = 256 - rem, rank = (int)blockIdx.x - rem;
    for (int k = 0; k < q; ++k) { const int id = host_tile_id(off + rank + k * idle); if (id >= 0) cvt_moe_tile(c, img, id); }
    __syncthreads();
}
__device__ __forceinline__ void phase_cvt_moe(const Ctx& c, LAS float* ldsf) {
    LAS unsigned char* img = (LAS unsigned char*)ldsf;
    const int G = gridDim.x;
    if (G == 256) {
        const int n0 = 3072 - HS_L0, n3 = 3072 - HS_L3;
        for (int j = c.vb; j < n0 + n3; j += c.vg) cvt_moe_tile(c, img, j < n0 ? HS_L0 + j : 3 * 3072 + HS_L3 + (j - n0));
    } else {
        for (int j = c.vb; j < DEPTH * 3072; j += c.vg) cvt_moe_tile(c, img, j);
    }
    __syncthreads();
    LAS float* scr = ldsf + c.wave * (64 * 33);
    unsigned short* WIN = (unsigned short*)(c.ws + WS_WIN); unsigned short* WOUT = (unsigned short*)(c.ws + WS_WOUT); unsigned short* WGLU = (unsigned short*)(c.ws + WS_WGLU);
    for (int id = c.gw; id < 2 * (1408 + 512 + 1024); id += c.ngw) {
        const int i = id / 2944; int r = id - i * 2944;
        if (r < 1408) { const int kb = r / 88, nb = r - kb * 88; cvt_item(c.in[IN_MIXIN] + (size_t)i * D * INW, INW, 64 * kb, 32 * nb, WIN + (size_t)i * INW * D, D, 32 * nb, scr, c.lane); }
        else if (r < 1920) { r -= 1408; const int kb = r >> 5, nb = r & 31; cvt_item(c.in[IN_MIXOUT] + (size_t)i * D * D, D, 64 * kb, 32 * nb, WOUT + (size_t)i * D * D, D, 32 * nb, scr, c.lane); }
        else { r -= 1920; const int kb = r >> 6, nb = r & 63, pn = nb >> 3, rr0 = (nb & 7) * 32;
            cvt_item8(c.in[IN_GLUW] + (size_t)i * D * 2048, 2048, 64 * kb, (rr0 < 128 ? 0 : 1024) + 128 * pn + (rr0 & 127), (unsigned char*)WGLU + (size_t)i * 2048 * D, D, 32 * nb, scr, c.lane); }
    }
}

__global__ void __launch_bounds__(512, 2) fwd(Args args) {
    extern __shared__ __attribute__((aligned(16))) unsigned char lds[];
    Ctx c; c.in = args.in; c.out = args.out; c.ws = args.ws;
    c.wave = __builtin_amdgcn_readfirstlane((int)threadIdx.x >> 6); c.lane = lane_id(); c.tid = c.wave * 64 + c.lane;
    c.gw = blockIdx.x * 8 + c.wave; c.ngw = gridDim.x * 8; c.gt = blockIdx.x * 512 + c.tid; c.ngt = gridDim.x * 512;
    LAS float* ldsf = (LAS float*)lds; LAS unsigned char* ldsb = (LAS unsigned char*)lds;
    volatile LAS unsigned* MISC = (volatile LAS unsigned*)((LAS unsigned char*)lds + MISC_OFF);
    if (c.tid < 32) MISC[c.tid] = 0u;
    __syncthreads();
    const int lo = args.ph_lo, hi = args.ph_hi;
    const bool one_launch = (hi - lo) > 1;
    XcdBarrier bar; bar.bar = (unsigned*)(c.ws + WS_CTL) + CW_BAR; bar.x = 0; bar.st = MISC + 8; bar.wave = c.wave;
    if (one_launch) bar = xcd_barrier_post((unsigned*)(c.ws + WS_CTL) + CW_BAR, MISC + 8);
#define IN(k) (lo <= (k) && (k) < hi)
#define SEAM(k) do { if ((k) + 1 < hi) xcd_barrier(bar); } while (0)
#define FRESH(cc) Ctx cc; unsigned zq; asm volatile("s_mov_b32 %0, 0" : "=s"(zq)); cc.ws = c.ws + zq; cc.out = c.out + zq; cc.in = (const float* const*)((const char*)c.in + zq); \
    { int lq = lane_id(); asm volatile("" : "+v"(lq)); cc.wave = c.wave + (int)zq; cc.lane = lq; cc.tid = cc.wave * 64 + lq; const int tq = cc.tid; cc.gw = blockIdx.x * 8 + cc.wave; cc.ngw = gridDim.x * 8; cc.gt = blockIdx.x * 512 + tq; cc.ngt = gridDim.x * 512; cc.vb = blockIdx.x; cc.vg = gridDim.x; } \
    const int Lq = L + (int)zq, iq = Lq >> 1; const float* MOD = (const float*)(cc.ws + WS_MOD); (void)MOD; (void)iq

    if (IN(PH_PRO)) { const int L = 0; FRESH(cc);
        if (blockIdx.x & 1) { phase_s5_ops(cc, ldsf); __syncthreads(); phase_pro(cc, ldsf); __syncthreads(); phase_cvt_moe(cc, ldsf); }
        else { phase_pro(cc, ldsf); __syncthreads(); phase_cvt_moe(cc, ldsf); __syncthreads(); phase_s5_ops(cc, ldsf); }
        SEAM(PH_PRO); }

#define LAYER_BODY(LL) { constexpr int L = LL; \
        const int pb = 1 + L * PH_PER_LAYER; \
        if (IN(pb + 0)) { FRESH(cc); if constexpr (L == 0) phase_norm1_first(cc); else phase_norm1<false, (L & 1) != 0>(cc, Lq); SEAM(pb + 0); } \
        if ((L & 1) == 0) { \
            if (IN(pb + 1)) { \
                FRESH(cc); \
                pg8::GOrder S; S.init(1, NROWS, INW, (int)gridDim.x, (int)blockIdx.x); \
                pg8::ADense al{(const pg8::bf16_t*)(cc.ws + WS_HB1), 0, nullptr, 0, D, 0, 64}; pg8::EpiBf16 ep{(pg8::bf16_t*)(cc.ws + WS_P), INW, 0}; \
                pg8::gemm_phase(ldsb, al, (const pg8::bf16_t*)(cc.ws + WS_WIN) + (size_t)iq * INW * D, 0, D, S, ep, cc.wave); SEAM(pb + 1); } \
            if (IN(pb + 2)) { FRESH(cc); phase_post(cc, iq, ldsb); SEAM(pb + 2); } \
            if (IN(pb + 4)) { FRESH(cc); phase_ret_prefix(cc, iq); \
                  \
                unsigned* cnt = (unsigned*)(cc.ws + WS_CTL) + CW_CNT + 64 * L; \
                asm volatile("s_waitcnt vmcnt(0)" ::: "memory"); __syncthreads(); \
                if (cc.tid == 0) { __builtin_amdgcn_fence(__ATOMIC_RELEASE, "agent"); asm volatile("s_waitcnt vmcnt(0)" ::: "memory"); (void)xb_add(cnt, 1u); } \
                phase_attention(cc, iq, (char*)lds); \
                if (cc.tid == 0) { unsigned* tb = (unsigned*)(cc.ws + WS_CTL) + CW_BAR; XB_SPIN(xb_ld(cnt) < gridDim.x, tb); __builtin_amdgcn_fence(__ATOMIC_ACQUIRE, "agent"); asm volatile("s_waitcnt vmcnt(0)" ::: "memory"); } \
                __syncthreads(); \
                phase_ret_main(cc, iq, ldsb); SEAM(pb + 4); } \
            if (IN(pb + 6)) { \
                FRESH(cc); \
                pg8::GOrder S; S.init(1, NROWS, D, (int)gridDim.x, (int)blockIdx.x); \
                pg8::ADense al{(const pg8::bf16_t*)(cc.ws + WS_MIX), 0, nullptr, 0, D, 0, 64}; pg8::EpiResid ep{(pg8::bf16_t*)(cc.ws + WS_X), MOD + (size_t)Lq * 9 * 6144}; \
                pg8::gemm_phase(ldsb, al, (const pg8::bf16_t*)(cc.ws + WS_WOUT) + (size_t)iq * D * D, 0, D, S, ep, cc.wave); hosted_cvt(cc, ldsb, L, HK_OUT); SEAM(pb + 6); } \
        } else { \
            if (IN(pb + 1)) { \
                FRESH(cc); \
                pg8::GOrder S; S.init(64, 1280, 256, (int)gridDim.x, (int)blockIdx.x); \
                pg8::ADense al{(const pg8::bf16_t*)(cc.ws + WS_AS5), (size_t)1280 * 768, nullptr, 0, 768, 0, 64}; pg8::EpiBf16 ep{(pg8::bf16_t*)(cc.ws + WS_SL), 256, (size_t)1280 * 256}; \
                pg8::gemm_phase(ldsb, al, (const pg8::bf16_t*)(cc.ws + WS_WS5) + (size_t)iq * 64 * 256 * 512, (size_t)256 * 512, 512, S, ep, cc.wave); hosted_cvt(cc, ldsb, L, HK_S1); SEAM(pb + 1); } \
            if (IN(pb + 2)) { FRESH(cc); phase_s5_carry(cc, iq); SEAM(pb + 2); } \
            if (IN(pb + 3)) { \
                FRESH(cc); \
                pg8::GOrder S; S.init(64, 1280, 512, (int)gridDim.x, (int)blockIdx.x); \
                pg8::ADense al{(const pg8::bf16_t*)(cc.ws + WS_AS5), (size_t)1280 * 768, nullptr, 0, 768, 0, 64}; pg8::EpiGeluFp8 ep{(unsigned char*)(cc.ws + WS_ZG), 512, (size_t)1280 * 512}; \
                pg8::gemm_phase(ldsb, al, (const pg8::bf16_t*)(cc.ws + WS_TV) + (size_t)iq * 64 * 512 * 768, (size_t)512 * 768, 768, S, ep, cc.wave); hosted_cvt(cc, ldsb, L, HK_S3); SEAM(pb + 3); } \
            if (IN(pb + 4)) { \
                FRESH(cc); \
                pg8::GOrder S; S.init(1, NROWS, 2048, (int)gridDim.x, (int)blockIdx.x, L == DEPTH - 1); \
                pg8::ADense al{(const pg8::bf16_t*)(cc.ws + WS_ZG), 0, nullptr, 0, 16, 1280 * 512, (size_t)8 * 1280 * 512}; pg8::EpiGluResid ep{(pg8::bf16_t*)(cc.ws + WS_X), MOD + (size_t)Lq * 9 * 6144, cc.in[IN_GLUB] + (size_t)iq * 2048}; \
                pg8::gemm_phase<true>(ldsb, al, (const unsigned char*)(cc.ws + WS_WGLU) + (size_t)iq * 2048 * D, 0, D, S, ep, cc.wave); hosted_cvt(cc, ldsb, L, HK_GLU); SEAM(pb + 4); } \
        } \
        if (IN(pb + 7)) { FRESH(cc); phase_norm2_router<L == DEPTH - 1>(cc, Lq, ldsf); SEAM(pb + 7); } \
        if (IN(pb + 8)) { FRESH(cc); phase_topk(cc, (LAS unsigned*)lds, L == DEPTH - 1 ? 128 : 256); __syncthreads(); hosted_cvt(cc, ldsb, L, HK_TOPK); SEAM(pb + 8); } \
        if (IN(pb + 9)) { \
            FRESH(cc); \
            pg8::GOrder S; S.init(NE, L == DEPTH - 1 ? NB * CAP_LAT : EROWS, 2 * FF, (int)gridDim.x, (int)blockIdx.x); \
            pg8::ADense al{(const pg8::bf16_t*)(cc.ws + WS_XS), (size_t)EROWS * D, nullptr, 0, D, 0, 128}; \
            pg8::EpiSwiglu ep{(unsigned char*)(cc.ws + WS_HID), FF, (size_t)EROWS * FF}; \
            pg8::gemm_phase<true>(ldsb, al, (const unsigned char*)(cc.ws + WS_W13) + (size_t)Lq * NE * 4096 * D, (size_t)4096 * D, D, S, ep, cc.wave); SEAM(pb + 9); } \
        if (IN(pb + 10)) { \
            FRESH(cc); \
            pg8::GOrder S; S.init(NE, L == DEPTH - 1 ? NB * CAP_LAT : EROWS, D, (int)gridDim.x, (int)blockIdx.x); \
            pg8::ADense al{(const pg8::bf16_t*)(cc.ws + WS_HID), (size_t)EROWS * FF, nullptr, 0, FF, 0, 128}; \
            pg8::EpiGate ep{(unsigned char*)(cc.ws + WS_Y), D, (size_t)EROWS * D, (const float*)(cc.ws + WS_SELGATE), EROWS}; \
            pg8::gemm_phase<true>(ldsb, al, (const unsigned char*)(cc.ws + WS_W2) + (size_t)Lq * NE * D * FF, (size_t)D * FF, FF, S, ep, cc.wave); hosted_cvt(cc, ldsb, L, HK_GEMM2); SEAM(pb + 10); } \
    }
    LAYER_BODY(0) LAYER_BODY(1) LAYER_BODY(2) LAYER_BODY(3)
#undef LAYER_BODY
    if (IN(PH_FIN)) { const int L = DEPTH; FRESH(cc); phase_norm1<true, false>(cc, DEPTH); }
#undef IN
#undef SEAM
}

static bool phase_valid(int ph) {
    if (ph == PH_PRO || ph == PH_FIN) return true;
    const int L = (ph - 1) / PH_PER_LAYER, k = (ph - 1) % PH_PER_LAYER;
    if (L & 1) return !(k >= 5 && k <= 6);
    return k != 3 && k != 5;
}
extern "C" void kernel_launch(void* const* d_in, const int* in_sizes, int n_in, void* d_out, int out_size, void* d_ws, size_t ws_size, hipStream_t stream) {
    static int grid = 0;
    if (grid == 0) {
        if (n_in != 27 || out_size != NB * T * D || ws_size < WS_END) { fprintf(stderr, "kernel_launch: unexpected shapes (n_in %d out %d ws %zu)\n", n_in, out_size, ws_size); grid = -1; return; }
        int dev = 0, cus = 0;
        if (hipGetDevice(&dev) != hipSuccess || hipDeviceGetAttribute(&cus, hipDeviceAttributeMultiprocessorCount, dev) != hipSuccess) { grid = -1; return; }
        if (hipFuncSetAttribute((const void*)fwd, hipFuncAttributeMaxDynamicSharedMemorySize, LDS_BYTES) != hipSuccess) { grid = -1; return; }
        int per_cu = 0;
        if (hipOccupancyMaxActiveBlocksPerMultiprocessor(&per_cu, (const void*)fwd, 512, LDS_BYTES) != hipSuccess || per_cu < 1) fprintf(stderr, "kernel_launch: occupancy query says %d\n", per_cu);
        (void)hipGetLastError();
        grid = cus;
    }
    if (grid < 0) return;
    if (hipMemsetAsync((char*)d_ws + WS_CTL, 0, CTL_ZERO_BYTES, stream) != hipSuccess) return;
    Args a{};
    for (int i = 0; i < 27; ++i) a.in[i] = (const float*)d_in[i];
    a.out = (float*)d_out; a.ws = (unsigned char*)d_ws;
#if MK_MULTI
    for (int ph = 0; ph < NPH; ++ph) {
        if (!phase_valid(ph)) continue;
        a.ph_lo = ph; a.ph_hi = ph + 1;
        hipLaunchKernelGGL(fwd, dim3(grid), dim3(512), LDS_BYTES, stream, a);
    }
#else
    a.ph_lo = 0; a.ph_hi = NPH;
    hipLaunchKernelGGL(fwd, dim3(grid), dim3(512), LDS_BYTES, stream, a);
#ifdef PROBE_PHASES
    { static const int probe[] = {PROBE_PHASES}; for (unsigned q = 0; q < sizeof(probe) / sizeof(probe[0]); ++q) { a.ph_lo = probe[q]; a.ph_hi = probe[q] + 1; hipLaunchKernelGGL(fwd, dim3(grid), dim3(512), LDS_BYTES, stream, a); } }
#endif
#endif
}
```

```cpp
#include <hip/hip_runtime.h>
#include <hip/hip_bf16.h>
#include <cstdio>
#include <cstdint>

#define GAS __attribute__((address_space(1)))
#define LAS __attribute__((address_space(3)))
typedef float f32x4 __attribute__((ext_vector_type(4)));
typedef float f32x2 __attribute__((ext_vector_type(2)));
typedef float f32x16 __attribute__((ext_vector_type(16)));

constexpr int NB = 8, T = 4096, D = 1024, CL = 256, RB = CL + T  , NROWS = NB * RB  ;
constexpr int DEPTH = 4, NE = 16, FF = 2048, INW = 2816;
constexpr int CAP_LAT = 512, CAP_CTX = 32, EROWS = NB * (CAP_LAT + CAP_CTX)  ;
constexpr float EPS = 1e-6f;
#ifndef MK_MULTI
#define MK_MULTI 0
#endif

constexpr size_t MiB = 1u << 20;
constexpr size_t WS_CTL = 0, CTL_ZERO_BYTES = 1 * MiB;
constexpr size_t WS_MOD = 1 * MiB;
constexpr size_t WS_ROPE = 2 * MiB;
constexpr size_t WS_SELROW = 3 * MiB;
constexpr size_t WS_SELGATE = 3 * MiB + 512 * 1024;
constexpr size_t WS_AFF = 4 * MiB;
constexpr size_t WS_SLOT = 7 * MiB;
constexpr size_t WS_X = 10 * MiB;
constexpr size_t WS_TV = 146 * MiB;
constexpr size_t WS_WS5 = 242 * MiB;
constexpr size_t WS_HB = 282 * MiB;
constexpr size_t WS_W13 = 350 * MiB;
constexpr size_t WS_W2 = 862 * MiB;
constexpr size_t WS_WIN = 1118 * MiB;
constexpr size_t WS_WOUT = 1130 * MiB;
constexpr size_t WS_WGLU = 1134 * MiB;
constexpr size_t WS_HB1 = 1144 * MiB;
constexpr size_t WS_BIG = 1212 * MiB;
constexpr size_t WS_P = WS_BIG;
constexpr size_t WS_RQ = WS_BIG + 374 * MiB;
constexpr size_t WS_RK = WS_BIG + 408 * MiB;
constexpr size_t WS_RV = WS_BIG + 442 * MiB;
constexpr size_t WS_ET = WS_BIG + 476 * MiB;
constexpr size_t WS_MIX = WS_BIG + 510 * MiB;
constexpr size_t WS_QA = WS_BIG + 578 * MiB;
constexpr size_t WS_KA = WS_BIG + 612 * MiB;
constexpr size_t WS_VA = WS_BIG + 621 * MiB;
constexpr size_t WS_U = WS_BIG + 630 * MiB;
constexpr size_t WS_AS5 = WS_BIG;
constexpr size_t WS_SL = WS_BIG + 120 * MiB;
constexpr size_t WS_ZG = WS_BIG + 200 * MiB;
constexpr size_t WS_HID = WS_BIG;
constexpr size_t WS_XS = WS_BIG + 136 * MiB;
constexpr size_t WS_Y = WS_BIG + 272 * MiB;
constexpr size_t WS_END = WS_BIG + 698 * MiB;
constexpr int CW_BAR = 4096, CW_CNT = 8192;

constexpr int LDS_BYTES = 147456;
constexpr int MISC_OFF = 131072 + 320;

constexpr int PH_PRO = 0, PH_PER_LAYER = 11, PH_FIN = 1 + DEPTH * PH_PER_LAYER, NPH = PH_FIN + 1;

#define XB_TMO      128
#define XB_XCNT(j)  (256  + 64 * (j))
#define XB_XSUB(j)  (1280 + 64 * (j))
#define XB_XGEN(j)  (2304 + 64 * (j))
#define XB_TOP      3328
#define XB_TOPGEN   3392
#define XCD_BAR_WORDS 3456
#define XB_SPIN_CAP (1u << 22)

__device__ __forceinline__ unsigned xb_ld(unsigned* p)              { return __hip_atomic_load(p, __ATOMIC_RELAXED, __HIP_MEMORY_SCOPE_AGENT); }
__device__ __forceinline__ unsigned xb_add(unsigned* p, unsigned v) { return __hip_atomic_fetch_add(p, v, __ATOMIC_RELAXED, __HIP_MEMORY_SCOPE_AGENT); }
__device__ __forceinline__ unsigned xb_xcc_id() { return (unsigned)__builtin_amdgcn_s_getreg((3 << 11) | 20) & 0xFu; }
#define XB_SPIN(cond, bar) do { unsigned _sp = 0; while (cond) { __builtin_amdgcn_s_sleep(1); \
    if ((++_sp & 255u) == 0u) { if (xb_ld(&(bar)[XB_TMO])) break; if (_sp > XB_SPIN_CAP) { atomicAdd(&(bar)[XB_TMO], 1u); break; } } } } while (0)

__device__ __forceinline__ int lane_id() { int l; asm volatile("v_mbcnt_lo_u32_b32 %0, -1, 0\n\tv_mbcnt_hi_u32_b32 %0, -1, %0" : "=v"(l)); return l; }
struct XcdBarrier { unsigned* bar; unsigned x; volatile LAS unsigned* st; int wave; };

__device__ __forceinline__ XcdBarrier xcd_barrier_post(unsigned* bar, volatile LAS unsigned* st) {
    XcdBarrier b; b.bar = bar; b.x = xb_xcc_id(); b.st = st; b.wave = __builtin_amdgcn_readfirstlane((int)threadIdx.x >> 6);
    if (threadIdx.x == 0) (void)xb_add(&bar[XB_XCNT(b.x)], 1u);
    return b;
}
__device__ __forceinline__ void xcd_barrier_complete(unsigned* bar, unsigned x, unsigned& nloc, unsigned& nx) {
    const unsigned G = gridDim.x * gridDim.y * gridDim.z;
    unsigned sum, cnt, mine, sp = 0u;
    for (;;) {
        sum = 0u; cnt = 0u; mine = 0u;
#pragma unroll
        for (unsigned j = 0; j < 16; ++j) { const unsigned c = xb_ld(&bar[XB_XCNT(j)]); sum += c; cnt += (c > 0u) ? 1u : 0u; mine = (j == x) ? c : mine; }
        if (sum == G) break;
        __builtin_amdgcn_s_sleep(1);
        if ((++sp & 255u) == 0u) { if (xb_ld(&bar[XB_TMO])) break; if (sp > XB_SPIN_CAP) { atomicAdd(&bar[XB_TMO], 1u); break; } }
    }
    nloc = mine > 0u ? mine : 1u; nx = cnt > 0u ? cnt : 1u;
}
__device__ __forceinline__ void xcd_barrier(const XcdBarrier& b) {
    asm volatile("s_waitcnt vmcnt(0)" ::: "memory");
    __syncthreads();
    if (b.wave == 0 && lane_id() == 0) {
        unsigned* bar = b.bar;
        __builtin_amdgcn_s_waitcnt(0);
        unsigned nloc = b.st[0], nx = b.st[1];
        if (nloc == 0u) { xcd_barrier_complete(bar, b.x, nloc, nx); b.st[0] = nloc; b.st[1] = nx; }
        const unsigned old = xb_add(&bar[XB_XSUB(b.x)], 1u);
        const unsigned gen = old / nloc;
        if (old + 1u == (gen + 1u) * nloc) {
            __builtin_amdgcn_fence(__ATOMIC_RELEASE, "agent");
            asm volatile("s_waitcnt vmcnt(0)" ::: "memory");
            const unsigned og = xb_add(&bar[XB_TOP], 1u);
            const unsigned tg = og / nx;
            if (og + 1u == (tg + 1u) * nx) xb_add(&bar[XB_TOPGEN], 1u);
            else XB_SPIN(xb_ld(&bar[XB_TOPGEN]) == tg, bar);
            __builtin_amdgcn_fence(__ATOMIC_ACQUIRE, "agent");
            xb_add(&bar[XB_XGEN(b.x)], 1u);
            asm volatile("s_waitcnt vmcnt(0)" ::: "memory");
        } else {
            XB_SPIN(xb_ld(&bar[XB_XGEN(b.x)]) == gen, bar);
            __builtin_amdgcn_fence(__ATOMIC_ACQUIRE, "agent");
            asm volatile("s_waitcnt vmcnt(0)" ::: "memory");
        }
    }
    __syncthreads();
}

struct Args { const float* in[27]; float* out; unsigned char* ws; int ph_lo, ph_hi; };

struct Ctx {
    const float* const* in; float* out; unsigned char* ws;
    int tid, lane, wave, gw, ngw, gt, ngt;
    int vb, vg;
};
enum { IN_X = 0, IN_C, IN_CTX, IN_CCTX, IN_MODW, IN_MODB, IN_NORMG, IN_MIXIN, IN_MIXOUT, IN_RETRATE, IN_RETGN, IN_QKG,
       IN_S5ARE, IN_S5AIM, IN_S5DT, IN_S5BRE, IN_S5BIM, IN_S5CRE, IN_S5CIM, IN_S5D, IN_GLUW, IN_GLUB, IN_ROUTER, IN_W1, IN_W3, IN_W2, IN_FNG };

__device__ __forceinline__ float wave_sum(float v) {
#pragma unroll
    for (int o = 1; o < 64; o <<= 1) v += __shfl_xor(v, o);
    return v;
}
__device__ __forceinline__ float sigmoidf_(float x) { return 1.0f / (1.0f + expf(-x)); }
__device__ __forceinline__ float siluf_(float x) { return x * sigmoidf_(x); }
__device__ __forceinline__ float gelu_tanh(float x) { const float u = 0.7978845608028654f * (x + 0.044715f * x * x * x); return 0.5f * x * (1.0f + tanhf(u)); }
__device__ __forceinline__ const float* modp(const Ctx& c, int L, int j, int chunk) { return (const float*)(c.ws + WS_MOD) + ((size_t)(L * 9 + j) * 6 + chunk) * 1024; }
__device__ __forceinline__ int row_j(int row) { const int b = row / RB, s = row - b * RB; return s < CL ? 8 : b; }

__device__ __forceinline__ float reduce16(const float (&v)[16], int lane) {
    float a[8], b[4], c2[2], d;
    const bool b5 = (lane & 32) != 0, b4 = (lane & 16) != 0, b3 = (lane & 8) != 0, b2 = (lane & 4) != 0;
#pragma unroll
    for (int i = 0; i < 8; ++i) { const float keep = b5 ? v[8 + i] : v[i], send = b5 ? v[i] : v[8 + i]; a[i] = keep + __shfl_xor(send, 32); }
#pragma unroll
    for (int i = 0; i < 4; ++i) { const float keep = b4 ? a[4 + i] : a[i], send = b4 ? a[i] : a[4 + i]; b[i] = keep + __shfl_xor(send, 16); }
#pragma unroll
    for (int i = 0; i < 2; ++i) { const float keep = b3 ? b[2 + i] : b[i], send = b3 ? b[i] : b[2 + i]; c2[i] = keep + __shfl_xor(send, 8); }
    { const float keep = b2 ? c2[1] : c2[0], send = b2 ? c2[0] : c2[1]; d = keep + __shfl_xor(send, 4); }
    d += __shfl_xor(d, 2); d += __shfl_xor(d, 1);
    return d;
}
__device__ __forceinline__ int reduce16_k(int lane) { return ((lane >> 5) & 1) * 8 + ((lane >> 4) & 1) * 4 + ((lane >> 3) & 1) * 2 + ((lane >> 2) & 1); }

namespace pg8 {
typedef unsigned short bf16_t;
typedef short bf16x8 __attribute__((ext_vector_type(8)));
typedef unsigned u32x4 __attribute__((ext_vector_type(4)));
typedef unsigned u32x2 __attribute__((ext_vector_type(2)));
typedef int v8i32 __attribute__((ext_vector_type(8)));
typedef int v4i32 __attribute__((ext_vector_type(4)));
constexpr int BM = 256, BK = 64, HALF = 128, HTB = HALF * BK * 2, STAGE_BYTES = 8 * HTB, NXCD = 8, WGM = 8;
__host__ __device__ __forceinline__ int lds_byte(int r, int c) { const int st = (r >> 4) * 2 + (c >> 5), rr = r & 15, cc = c & 31, ob = rr * 64 + cc * 2; return st * 1024 + (ob ^ (((ob >> 9) & 1) << 5)); }
__host__ __device__ __forceinline__ void stage_rc(int b, int& R, int& C) { const int st = b / 1024, sb = b % 1024, swz = sb ^ (((sb >> 9) & 1) << 5); R = (st >> 1) * 16 + swz / 64; C = (st & 1) * 32 + (swz % 64) / 2; }
__host__ __device__ __forceinline__ int perm32(int rho) { const int n = rho >> 4, i = rho & 15; return 8 * (i >> 2) + 4 * n + (i & 3); }
__device__ __forceinline__ unsigned cvt_pk_bf16(float lo, float hi) { unsigned r; asm volatile("v_cvt_pk_bf16_f32 %0, %1, %2" : "=v"(r) : "v"(lo), "v"(hi)); return r; }

__device__ __forceinline__ unsigned pk4_fp8(float a, float b, float c, float d) {
    a = __builtin_amdgcn_fmed3f(a, -448.f, 448.f); b = __builtin_amdgcn_fmed3f(b, -448.f, 448.f); c = __builtin_amdgcn_fmed3f(c, -448.f, 448.f); d = __builtin_amdgcn_fmed3f(d, -448.f, 448.f);
    unsigned w = 0u; w = (unsigned)__builtin_amdgcn_cvt_pk_fp8_f32(a, b, (int)w, false); w = (unsigned)__builtin_amdgcn_cvt_pk_fp8_f32(c, d, (int)w, true); return w; }
__device__ __forceinline__ f32x4 bf4_to_f32(u32x2 w) { return (f32x4){__uint_as_float(w.x << 16), __uint_as_float(w.x & 0xffff0000u), __uint_as_float(w.y << 16), __uint_as_float(w.y & 0xffff0000u)}; }
__device__ __forceinline__ u32x2 f32_to_bf4(f32x4 v) { return (u32x2){cvt_pk_bf16(v.x, v.y), cvt_pk_bf16(v.z, v.w)}; }
constexpr float W8_SCALE = 32.0f, W8_INV = 1.0f / 32.0f;
struct Unit { int pm, pn, g; };
struct GOrder {
    int nM, nN, per, nwg, G, c, skipctx;
    __device__ __forceinline__ void init(int groups, int M, int N, int G_, int c_, int skipctx_ = 0) { nM = M / BM; if (skipctx_) nM -= nM / 17; nN = N / BM; per = nM * nN; nwg = groups * per; G = G_; c = c_; skipctx = skipctx_; }
    __device__ __forceinline__ bool next(int i, Unit& u) const {
        const long L = (long)i * G + c; if (L >= nwg) return false;
        int wgid = (int)L; { const int q = nwg / NXCD, r = nwg % NXCD, xcd = wgid % NXCD, off = wgid / NXCD; wgid = (xcd < r ? xcd * (q + 1) : r * (q + 1) + (xcd - r) * q) + off; }
        u.g = wgid / per; const int w = wgid - u.g * per;
        const int nig = WGM * nN, gid = w / nig, fm = gid * WGM, gsz = (nM - fm) < WGM ? (nM - fm) : WGM;
        u.pm = fm + ((w % nig) % gsz); u.pn = (w % nig) / gsz; if (skipctx) u.pm += (u.pm >> 4) + 1;
        return true;
    }
};
struct ADense  { static constexpr bool GATHER = false; const bf16_t* A; size_t gstride; const int* idx; int rpg; unsigned rowpitch; unsigned cgrp; size_t kstep; };
struct AGather { static constexpr bool GATHER = true;  const bf16_t* A; size_t gstride; const int* idx; int rpg; unsigned rowpitch; unsigned cgrp; size_t kstep; };

template <bool FP8 = false, class Epi, class ALoc>
__device__ __forceinline__ void gemm_phase(LAS unsigned char* lds, const ALoc AL, const void* Bt, size_t gstrideB, int K, const GOrder& S, const Epi& E, int wave_) {
    constexpr bool GATHER = ALoc::GATHER; constexpr unsigned ESZ = FP8 ? 1u : 2u;
    const int wid = wave_, lane = lane_id(), tid = wid * 64 + lane, wr = wid >> 2, wc = wid & 3, fr = lane & 15, fq = lane >> 4;
    const int nt = (int)((unsigned)K * ESZ / 128u);
    unsigned voffA[2], voffB[2];
#pragma unroll
    for (int i = 0; i < 2; ++i) { int R, C; stage_rc(tid * 16 + i * 8192, R, C); const int Rb = Epi::PERM ? ((R & ~31) + perm32(R & 31)) : R;
        const unsigned cbytes = AL.cgrp ? (FP8 ? (unsigned)(C >> 3) * AL.cgrp : ((unsigned)(C >> 4) * AL.cgrp + (unsigned)(C & 15)) * 2u) : (unsigned)C * 2u;
        voffA[i] = (unsigned)R * AL.rowpitch * ESZ + cbytes; voffB[i] = (unsigned)Rb * (unsigned)K * ESZ + (unsigned)C * 2u; }
    const size_t kstep = 128, kstepA = AL.kstep * ESZ;
    const size_t hstep = (size_t)HALF * K * ESZ;
    const size_t hstepA = GATHER ? 0 : (size_t)HALF * AL.rowpitch * ESZ, tstepA = 2 * (size_t)HALF * AL.rowpitch * ESZ;
    const size_t tstep = 2 * hstep;
    const unsigned ldsw = (unsigned)wid * 1024u;
    const int aoff0 = lds_byte(wr * 64 + fr, fq * 8);
    const int boff0 = lds_byte(wc * 32 + fr, fq * 8);
    constexpr int KOFF = 1024;
    unsigned vAc[2][2], vAn[2][2];
#define PG8_SA(b, h) (((b) * 2 + (h)) * HTB)
#define PG8_SB(b, h) ((4 + (b) * 2 + (h)) * HTB)
#define PG8_SBR(b, h) (((b) * 2 + (h)) * HTB)
#define PG8_OPQ(x) do { if constexpr (FP8) asm volatile("" : "+v"(x)); } while (0)
#define PG8_STAGE(bufoff, gbase, voff) do { _Pragma("unroll") for (int _i = 0; _i < 2; ++_i) { unsigned _o = (voff)[_i]; PG8_OPQ(_o); \
        __builtin_amdgcn_global_load_lds((const unsigned*)((const char*)(gbase) + _o), (LAS unsigned*)(lds + (bufoff) + ldsw + _i * 8192), 16, 0, 0); } } while (0)
#define PG8_STAGE_A(bufoff, gbase, h, nx) do { _Pragma("unroll") for (int _i = 0; _i < 2; ++_i) { \
        unsigned _o = GATHER ? ((nx) ? vAn[h][_i] : vAc[h][_i]) : voffA[_i]; PG8_OPQ(_o); \
        __builtin_amdgcn_global_load_lds((const unsigned*)((const char*)(gbase) + (size_t)(h) * hstepA + _o), (LAS unsigned*)(lds + (bufoff) + ldsw + _i * 8192), 16, 0, 0); } } while (0)
#define PG8_GIDX(u, v) do { if (GATHER) { int _t = tid; asm volatile("" : "+v"(_t));   \
        _Pragma("unroll") for (int _i = 0; _i < 2; ++_i) { int _R, _C; stage_rc(_t * 16 + _i * 8192, _R, _C); \
        _Pragma("unroll") for (int _h = 0; _h < 2; ++_h) v[_h][_i] = (unsigned)AL.idx[(u).g * AL.rpg + (u).pm * BM + _h * HALF + _R] * (AL.rowpitch * ESZ) + (unsigned)_C * 2u; } } } while (0)
#define PG8_ABASE(u) ((const char*)AL.A + (GATHER ? (size_t)0 : ((size_t)(u).g * AL.gstride * ESZ + (size_t)(u).pm * tstepA)))
#define PG8_BBASE(u) ((const char*)Bt + (size_t)(u).g * gstrideB * ESZ + (size_t)(u).pn * tstep)
#define PG8_LDA(dst, b, h) do { _Pragma("unroll") for (int m = 0; m < 4; ++m) _Pragma("unroll") for (int k = 0; k < 2; ++k) dst[m][k] = *(const LAS bf16x8*)(lds + PG8_SA(b, h) + aoff0 + k * KOFF + m * 2048); } while (0)
#define PG8_LDB(dst, b, h) do { _Pragma("unroll") for (int n = 0; n < 2; ++n) _Pragma("unroll") for (int k = 0; k < 2; ++k) dst[n][k] = *(const LAS bf16x8*)(lds + PG8_SB(b, h) + boff0 + k * KOFF + n * 2048); } while (0)
#define PG8_CAT8(x) __builtin_shufflevector(__builtin_bit_cast(v4i32, x[0]), __builtin_bit_cast(v4i32, x[1]), 0, 1, 2, 3, 4, 5, 6, 7)
#define PG8_MMA(ai, bj, At, Bt_) do { __builtin_amdgcn_s_setprio(1); _Pragma("unroll") for (int m = 0; m < 4; ++m) _Pragma("unroll") for (int n = 0; n < 2; ++n) { \
        if constexpr (FP8) acc[ai][bj][m][n] = __builtin_amdgcn_mfma_scale_f32_16x16x128_f8f6f4(PG8_CAT8(Bt_[n]), PG8_CAT8(At[m]), acc[ai][bj][m][n], 0, 0, 0, 0x7f7f7f7f, 0, 0x7f7f7f7f); \
        else { _Pragma("unroll") for (int k = 0; k < 2; ++k) acc[ai][bj][m][n] = __builtin_amdgcn_mfma_f32_16x16x32_bf16(Bt_[n][k], At[m][k], acc[ai][bj][m][n], 0, 0, 0); } } \
        __builtin_amdgcn_s_setprio(0); } while (0)
#define PG8_WAIT_V(n) asm volatile("s_waitcnt vmcnt(" #n ")" ::: "memory")
#define PG8_WAIT_L(n) asm volatile("s_waitcnt lgkmcnt(" #n ")" ::: "memory")
#define PG8_BAR __builtin_amdgcn_s_barrier()
#define PG8_SCHED __builtin_amdgcn_sched_barrier(0)
    Unit cur, nxt; int ui = 0;
    if (!S.next(0, cur)) return;
    PG8_GIDX(cur, vAc);
    f32x4 acc[2][2][4][2];
#pragma unroll
    for (int a = 0; a < 2; ++a)
#pragma unroll
        for (int b = 0; b < 2; ++b)
#pragma unroll
            for (int m = 0; m < 4; ++m)
#pragma unroll
                for (int n = 0; n < 2; ++n) acc[a][b][m][n] = (f32x4){0.f, 0.f, 0.f, 0.f};
    bf16x8 At[4][2], B0[2][2], B1[2][2];
    const char* cA = PG8_ABASE(cur); const char* cB = PG8_BBASE(cur);
    PG8_STAGE(PG8_SB(0, 0), cB, voffB); PG8_STAGE(PG8_SB(0, 1), cB + hstep, voffB); PG8_STAGE_A(PG8_SA(0, 0), cA, 0, false); PG8_STAGE_A(PG8_SA(0, 1), cA, 1, false);
    if (wr == 1) PG8_BAR;
    PG8_WAIT_V(2); PG8_BAR;
    PG8_STAGE(PG8_SB(1, 0), cB + kstep, voffB); PG8_STAGE_A(PG8_SA(1, 0), cA + kstepA, 0, false); PG8_STAGE(PG8_SB(1, 1), cB + hstep + kstep, voffB);
    PG8_WAIT_V(6); PG8_BAR;
    for (;;) {
        const bool has_next = S.next(ui + 1, nxt);
        if (GATHER) { if (has_next) { PG8_GIDX(nxt, vAn); } }
        const char* nA = has_next ? PG8_ABASE(nxt) : cA; const char* nB = has_next ? PG8_BBASE(nxt) : cB;
        for (int t = 0; t < nt; t += 2) {
            const bool last = (t == nt - 2), lastn = last && has_next;
            const char* a1 = cA + (size_t)(t + 1) * kstepA;
            const char* a2 = last ? nA : cA + (size_t)(t + 2) * kstepA; const char* b2 = last ? nB : cB + (size_t)(t + 2) * kstep;
            const char* a3 = a2 + kstepA; const char* b3 = b2 + kstep;
            PG8_LDB(B0, 0, 0); PG8_LDB(B1, 0, 1); PG8_SCHED; PG8_LDA(At, 0, 0); PG8_STAGE_A(PG8_SA(1, 1), a1, 1, false);
            PG8_WAIT_V(8); PG8_WAIT_L(0); PG8_BAR; PG8_MMA(0, 0, At, B0); PG8_MMA(0, 1, At, B1); PG8_BAR; PG8_SCHED;
            PG8_LDA(At, 0, 1); PG8_STAGE(PG8_SB(0, 0), b2, voffB); PG8_STAGE(PG8_SB(0, 1), b2 + hstep, voffB); PG8_STAGE_A(PG8_SA(0, 0), a2, 0, lastn);
            PG8_WAIT_V(8); PG8_WAIT_L(0); PG8_BAR; PG8_MMA(1, 0, At, B0); PG8_MMA(1, 1, At, B1); PG8_BAR; PG8_SCHED;
            PG8_LDB(B0, 1, 0); PG8_LDB(B1, 1, 1); PG8_SCHED; PG8_LDA(At, 1, 0); PG8_STAGE_A(PG8_SA(0, 1), a2, 1, lastn);
            PG8_WAIT_V(8); PG8_WAIT_L(0); PG8_BAR; PG8_MMA(0, 0, At, B0); PG8_MMA(0, 1, At, B1); PG8_BAR; PG8_SCHED;
            PG8_LDA(At, 1, 1); PG8_STAGE(PG8_SB(1, 0), b3, voffB); PG8_STAGE(PG8_SB(1, 1), b3 + hstep, voffB); PG8_STAGE_A(PG8_SA(1, 0), a3, 0, lastn);
            PG8_WAIT_V(8); PG8_WAIT_L(0); PG8_BAR; PG8_MMA(1, 0, At, B0); PG8_MMA(1, 1, At, B1); PG8_BAR; PG8_SCHED;
        }
        if (wr == 0) PG8_BAR;
        E(acc, cur, wr, wc, fr, fq);
        if (!has_next) break;
#pragma unroll
        for (int a = 0; a < 2; ++a)
#pragma unroll
            for (int b = 0; b < 2; ++b)
#pragma unroll
                for (int m = 0; m < 4; ++m)
#pragma unroll
                    for (int n = 0; n < 2; ++n) acc[a][b][m][n] = (f32x4){0.f, 0.f, 0.f, 0.f};
        cur = nxt; cA = nA; cB = nB; ++ui;
        if (GATHER) {
#pragma unroll
            for (int _h = 0; _h < 2; ++_h)
#pragma unroll
                for (int _i = 0; _i < 2; ++_i) vAc[_h][_i] = vAn[_h][_i]; }
        if (wr == 1) PG8_BAR;
    }
    PG8_WAIT_V(0);
    PG8_BAR;
#undef PG8_SA
#undef PG8_SB
#undef PG8_SBR
#undef PG8_STAGE
#undef PG8_OPQ
#undef PG8_STAGE_A
#undef PG8_GIDX
#undef PG8_ABASE
#undef PG8_BBASE
#undef PG8_LDA
#undef PG8_CAT8
#undef PG8_LDB
#undef PG8_MMA
#undef PG8_WAIT_V
#undef PG8_WAIT_L
#undef PG8_BAR
#undef PG8_SCHED
}

__device__ __forceinline__ float fast_sigmoid(float x) { return __builtin_amdgcn_rcpf(1.0f + __builtin_amdgcn_exp2f(-1.4426950408889634f * x)); }
struct EpiSwiglu {
    static constexpr bool PERM = true;
    unsigned char* O; int ldc; size_t gstride;
    __device__ __forceinline__ void operator()(const f32x4 (&acc)[2][2][4][2], const Unit& u, int wr, int wc, int fr, int fq) const {
        const int row0 = u.pm * BM + wr * 64 + fr, col0 = u.pn * HALF + wc * 32 + 8 * fq;
        unsigned char* base = O + (size_t)u.g * gstride;
#pragma unroll
        for (int ai = 0; ai < 2; ++ai)
#pragma unroll
            for (int m = 0; m < 4; ++m) { unsigned char* rowp = base + (size_t)(row0 + ai * HALF + m * 16) * ldc + col0;
                f32x4 o[2];
#pragma unroll
                for (int n = 0; n < 2; ++n) {
                    const f32x4 a = acc[ai][0][m][n] * W8_INV, b = acc[ai][1][m][n] * W8_INV, t = a * (-1.4426950408889634f);
                    f32x4 e; e.x = __builtin_amdgcn_exp2f(t.x); e.y = __builtin_amdgcn_exp2f(t.y); e.z = __builtin_amdgcn_exp2f(t.z); e.w = __builtin_amdgcn_exp2f(t.w);
                    e = e + 1.0f;
                    f32x4 r; r.x = __builtin_amdgcn_rcpf(e.x); r.y = __builtin_amdgcn_rcpf(e.y); r.z = __builtin_amdgcn_rcpf(e.z); r.w = __builtin_amdgcn_rcpf(e.w);
                    o[n] = (a * b) * r; }
                *(u32x2*)rowp = (u32x2){pk4_fp8(o[0].x, o[0].y, o[0].z, o[0].w), pk4_fp8(o[1].x, o[1].y, o[1].z, o[1].w)}; }
    }
};
struct EpiBf16 {
    static constexpr bool PERM = true;
    bf16_t* O; int ldc; size_t gstride;
    __device__ __forceinline__ void operator()(const f32x4 (&acc)[2][2][4][2], const Unit& u, int wr, int wc, int fr, int fq) const {
        const int row0 = u.pm * BM + wr * 64 + fr, col0 = u.pn * BM + wc * 32 + 8 * fq;
#pragma unroll
        for (int ai = 0; ai < 2; ++ai)
#pragma unroll
            for (int m = 0; m < 4; ++m) { bf16_t* rowp = O + (size_t)u.g * gstride + (size_t)(row0 + ai * HALF + m * 16) * ldc + col0;
#pragma unroll
                for (int bj = 0; bj < 2; ++bj) { const f32x4 v0 = acc[ai][bj][m][0], v1 = acc[ai][bj][m][1];
                    u32x4 w; w.x = cvt_pk_bf16(v0[0], v0[1]); w.y = cvt_pk_bf16(v0[2], v0[3]); w.z = cvt_pk_bf16(v1[0], v1[1]); w.w = cvt_pk_bf16(v1[2], v1[3]);
                    *(u32x4*)(rowp + bj * HALF) = w; } }
    }
};
constexpr float Z8_SCALE = 2.0f;
struct EpiGeluFp8 {
    static constexpr bool PERM = true;
    unsigned char* O; int ldc; size_t gstride;
    __device__ __forceinline__ void operator()(const f32x4 (&acc)[2][2][4][2], const Unit& u, int wr, int wc, int fr, int fq) const {
        const int row0 = u.pm * BM + wr * 64 + fr, col0 = u.pn * BM + wc * 32 + 8 * fq;
        unsigned char* base = O + (size_t)u.g * gstride;
#pragma unroll
        for (int ai = 0; ai < 2; ++ai)
#pragma unroll
            for (int m = 0; m < 4; ++m) { unsigned char* rowp = base + (size_t)(row0 + ai * HALF + m * 16) * ldc + col0;
#pragma unroll
                for (int bj = 0; bj < 2; ++bj) { float o[8];
#pragma unroll
                    for (int n = 0; n < 2; ++n)
#pragma unroll
                        for (int q = 0; q < 4; ++q) { const float x = acc[ai][bj][m][n][q]; o[4 * n + q] = (Z8_SCALE * x) * fast_sigmoid(1.5957691216057308f * (x + 0.044715f * x * x * x)); }
                    *(u32x2*)(rowp + bj * HALF) = (u32x2){pk4_fp8(o[0], o[1], o[2], o[3]), pk4_fp8(o[4], o[5], o[6], o[7])}; } }
    }
};
constexpr float Y8_SCALE = 16.0f, Y8_INV = 1.0f / 16.0f;
struct EpiGate {
    static constexpr bool PERM = true;
    unsigned char* O; int ldc; size_t gstride; const float* gate; int rpg;
    __device__ __forceinline__ void operator()(const f32x4 (&acc)[2][2][4][2], const Unit& u, int wr, int wc, int fr, int fq) const {
        const int row0 = u.pm * BM + wr * 64 + fr, col0 = u.pn * BM + wc * 32 + 8 * fq;
        unsigned char* base = O + (size_t)u.g * gstride;
#pragma unroll
        for (int ai = 0; ai < 2; ++ai)
#pragma unroll
            for (int m = 0; m < 4; ++m) { const int row = row0 + ai * HALF + m * 16; const float gt = gate[u.g * rpg + row] * (W8_INV * Y8_SCALE); unsigned char* rowp = base + (size_t)row * ldc + col0;
#pragma unroll
                for (int bj = 0; bj < 2; ++bj) { const f32x4 v0 = acc[ai][bj][m][0] * gt, v1 = acc[ai][bj][m][1] * gt;
                    *(u32x2*)(rowp + bj * HALF) = (u32x2){pk4_fp8(v0[0], v0[1], v0[2], v0[3]), pk4_fp8(v1[0], v1[1], v1[2], v1[3])}; } }
    }
};
struct EpiF32 {
    static constexpr bool PERM = false;
    float* C; int ldc; size_t gstride;
    __device__ __forceinline__ void operator()(const f32x4 (&acc)[2][2][4][2], const Unit& u, int wr, int wc, int fr, int fq) const {
        const int row0 = u.pm * BM + wr * 64 + fr, col0 = u.pn * BM + wc * 32 + 4 * fq;
#pragma unroll
        for (int ai = 0; ai < 2; ++ai)
#pragma unroll
            for (int m = 0; m < 4; ++m) { float* rowp = C + (size_t)u.g * gstride + (size_t)(row0 + ai * HALF + m * 16) * ldc + col0;
#pragma unroll
                for (int bj = 0; bj < 2; ++bj)
#pragma unroll
                    for (int n = 0; n < 2; ++n) *(f32x4*)(rowp + bj * HALF + n * 16) = acc[ai][bj][m][n]; }
    }
};
struct EpiResid {
    static constexpr bool PERM = true;
    bf16_t* X; const float* modL;
    __device__ __forceinline__ void operator()(const f32x4 (&acc)[2][2][4][2], const Unit& u, int wr, int wc, int fr, int fq) const {
        const int row0 = u.pm * BM + wr * 64 + fr, col0 = u.pn * BM + wc * 32 + 8 * fq;
        const int b = u.pm / 17, j = (u.pm - b * 17 == 0) ? 8 : b;
        const float* g1 = modL + (size_t)(j * 6 + 2) * 1024 + col0;
        f32x4 gv[2][2];
#pragma unroll
        for (int bj = 0; bj < 2; ++bj)
#pragma unroll
            for (int n = 0; n < 2; ++n) gv[bj][n] = *(const f32x4*)(g1 + bj * HALF + n * 4);
#pragma unroll
        for (int ai = 0; ai < 2; ++ai)
#pragma unroll
            for (int m = 0; m < 4; ++m) { bf16_t* rowp = X + (size_t)(row0 + ai * HALF + m * 16) * D + col0;
#pragma unroll
                for (int bj = 0; bj < 2; ++bj) { u32x4* p = (u32x4*)(rowp + bj * HALF); const u32x4 w = *p;
                    const f32x4 x0 = bf4_to_f32((u32x2){w.x, w.y}) + gv[bj][0] * acc[ai][bj][m][0], x1 = bf4_to_f32((u32x2){w.z, w.w}) + gv[bj][1] * acc[ai][bj][m][1];
                    const u32x2 o0 = f32_to_bf4(x0), o1 = f32_to_bf4(x1); *p = (u32x4){o0.x, o0.y, o1.x, o1.y}; } }
    }
};
struct EpiGluResid {
    static constexpr bool PERM = true;
    bf16_t* X; const float* modL; const float* bias;
    __device__ __forceinline__ void operator()(const f32x4 (&acc)[2][2][4][2], const Unit& u, int wr, int wc, int fr, int fq) const {
        const int row0 = u.pm * BM + wr * 64 + fr, col0 = u.pn * HALF + wc * 32 + 8 * fq;
        const int b = u.pm / 17, j = (u.pm - b * 17 == 0) ? 8 : b;
        const float* g1 = modL + (size_t)(j * 6 + 2) * 1024 + col0;
        f32x4 gv[2], ba[2], bg[2];
#pragma unroll
        for (int n = 0; n < 2; ++n) { gv[n] = *(const f32x4*)(g1 + n * 4); ba[n] = *(const f32x4*)(bias + col0 + n * 4); bg[n] = *(const f32x4*)(bias + 1024 + col0 + n * 4); }
#pragma unroll
        for (int ai = 0; ai < 2; ++ai)
#pragma unroll
            for (int m = 0; m < 4; ++m) { u32x4* p = (u32x4*)(X + (size_t)(row0 + ai * HALF + m * 16) * D + col0); const u32x4 w = *p;
                f32x4 xo[2] = {bf4_to_f32((u32x2){w.x, w.y}), bf4_to_f32((u32x2){w.z, w.w})};
#pragma unroll
                for (int n = 0; n < 2; ++n) { const f32x4 a = acc[ai][0][m][n] * (W8_INV / Z8_SCALE) + ba[n], g = acc[ai][1][m][n] * (W8_INV / Z8_SCALE) + bg[n];
                    f32x4 o; o.x = a.x * fast_sigmoid(g.x); o.y = a.y * fast_sigmoid(g.y); o.z = a.z * fast_sigmoid(g.z); o.w = a.w * fast_sigmoid(g.w);
                    xo[n] = xo[n] + gv[n] * o; }
                const u32x2 o0 = f32_to_bf4(xo[0]), o1 = f32_to_bf4(xo[1]); *p = (u32x4){o0.x, o0.y, o1.x, o1.y}; }
    }
};
}

namespace attn_body {
using bf16=__hip_bfloat16;
using bf16x8=__attribute__((ext_vector_type(8)))short;
using s16x4=__attribute__((ext_vector_type(4)))short;
using f32x16=__attribute__((ext_vector_type(16)))float;
using u32x4=__attribute__((ext_vector_type(4)))unsigned;
constexpr int D=64,QP=512,KP=128,VP=2816,OP=1024;
constexpr int NW=8,QBLK=32,QB=QBLK*NW,KVBLK=64;
__device__ __forceinline__ int crow(int r,int hi){return (r&3)+8*(r>>2)+4*hi;}
#define SBAR() __builtin_amdgcn_sched_barrier(0)
__device__ __forceinline__ void cmask(f32x16&p0,f32x16&p1,int jb,int qrel,int hi){
  const float NEG=-INFINITY; int kb=64*jb+4*hi;
  #pragma unroll
  for(int r=0;r<16;++r){int kv=kb+(r&3)+8*(r>>2); if(kv>qrel)p0[r]=NEG; if(kv+32>qrel)p1[r]=NEG;}
}

constexpr int NSLOT=3, SLOTB=8192;
constexpr int LDS_K=0, LDS_V=NSLOT*SLOTB, LDS_WS=2*NSLOT*SLOTB, LDS_OST=LDS_WS+NW*64*4, LDS_BYTES=LDS_OST+NW*4096;
constexpr float C2=0.125f*1.4426950408889634f;
__device__ __forceinline__ void glds16(const void*gsrc,unsigned lds_dst){unsigned keep;
  asm volatile("s_mov_b32 %0, m0\n\ts_mov_b32 m0, %2\n\ts_nop 0\n\tglobal_load_lds_dwordx4 %1, off\n\ts_mov_b32 m0, %0":"=&s"(keep):"v"(gsrc),"s"(lds_dst):"memory");}
__device__ __forceinline__ float max3f(float a,float b,float c){float r;asm("v_max3_f32 %0, %1, %2, %3":"=v"(r):"v"(a),"v"(b),"v"(c));return r;}
__device__ __forceinline__ float max2f(float a,float b){float r;asm("v_max_f32_e32 %0, %1, %2":"=v"(r):"v"(a),"v"(b));return r;}
__device__ __forceinline__ float fadd_s(float a,float b){float r;asm("v_add_f32_e32 %0, %1, %2":"=v"(r):"v"(a),"v"(b));return r;}
__device__ __forceinline__ float fsub_s(float a,float b){float r;asm("v_sub_f32_e32 %0, %1, %2":"=v"(r):"v"(a),"v"(b));return r;}
typedef float f32x2_t __attribute__((ext_vector_type(2))); typedef __bf16 bf16x2_t __attribute__((ext_vector_type(2)));
__device__ __forceinline__ unsigned cvtpk_s(float lo,float hi){f32x2_t v={lo,hi};bf16x2_t b=__builtin_convertvector(v,bf16x2_t);return __builtin_bit_cast(unsigned,b);}
#define WAIT_BAR(N) asm volatile("s_waitcnt vmcnt(" #N ") lgkmcnt(0)\n\ts_barrier":::"memory")

__device__ __forceinline__ void qkt(f32x16&p0,f32x16&p1,const char*Kslot,const bf16x8*qr,const f32x16&negm,int r32,int hi){
  const char*kb=Kslot+hi*1024+r32*16;
  #pragma unroll
  for(int d0=0;d0<4;++d0){
    const bf16x8 b0=*reinterpret_cast<const bf16x8*>(kb+d0*2048);
    const bf16x8 b1=*reinterpret_cast<const bf16x8*>(kb+d0*2048+512);
    if(d0==0){p0=__builtin_amdgcn_mfma_f32_32x32x16_bf16(b0,qr[0],negm,0,0,0);p1=__builtin_amdgcn_mfma_f32_32x32x16_bf16(b1,qr[0],negm,0,0,0);}
    else{p0=__builtin_amdgcn_mfma_f32_32x32x16_bf16(b0,qr[d0],p0,0,0,0);p1=__builtin_amdgcn_mfma_f32_32x32x16_bf16(b1,qr[d0],p1,0,0,0);}}
}
typedef __attribute__((address_space(3))) const char* lds_cptr;
typedef short v4i16_t __attribute__((ext_vector_type(4)));
__device__ __forceinline__ void kload8(bf16x8*kf,lds_cptr kp){
  kf[0]=*(const __attribute__((address_space(3))) bf16x8*)(kp);      kf[1]=*(const __attribute__((address_space(3))) bf16x8*)(kp+512);
  kf[2]=*(const __attribute__((address_space(3))) bf16x8*)(kp+2048); kf[3]=*(const __attribute__((address_space(3))) bf16x8*)(kp+2560);
  kf[4]=*(const __attribute__((address_space(3))) bf16x8*)(kp+4096); kf[5]=*(const __attribute__((address_space(3))) bf16x8*)(kp+4608);
  kf[6]=*(const __attribute__((address_space(3))) bf16x8*)(kp+6144); kf[7]=*(const __attribute__((address_space(3))) bf16x8*)(kp+6656);
}
__device__ __forceinline__ void kload2(bf16x8*kf,lds_cptr kp,int j){ kf[2*j]=*(const __attribute__((address_space(3))) bf16x8*)(kp+j*2048); kf[2*j+1]=*(const __attribute__((address_space(3))) bf16x8*)(kp+j*2048+512); }
__device__ __forceinline__ s16x4 vtr(lds_cptr p){ return __builtin_bit_cast(s16x4,__builtin_amdgcn_ds_read_tr16_b64_v4i16((__attribute__((address_space(3))) v4i16_t*)p)); }
__device__ __forceinline__ float rowmax(const f32x16&p0,const f32x16&p1){
  float a=max3f(p0[0],p0[1],p1[0]),b=max3f(p0[2],p0[3],p1[1]);a=max3f(a,p1[2],p1[3]);
  #pragma unroll
  for(int r=4;r<16;r+=4){a=max3f(a,p0[r],p0[r+1]);b=max3f(b,p0[r+2],p0[r+3]);a=max3f(a,p1[r],p1[r+1]);b=max3f(b,p1[r+2],p1[r+3]);}
  const float m=max2f(a,b);
  auto rr=__builtin_amdgcn_permlane32_swap(__float_as_uint(m),__float_as_uint(m),false,false);
  return max2f(__uint_as_float(rr[0]),__uint_as_float(rr[1]));
}
__device__ __forceinline__ void pv(f32x16*o,int vb,bf16x8 pa0,bf16x8 pa1,bf16x8 pa2,bf16x8 pa3){
  #pragma unroll
  for(int d0=0;d0<2;++d0){s16x4 lo[4],hi[4];
    #pragma unroll
    for(int ks=0;ks<4;++ks){
      asm volatile("ds_read_b64_tr_b16 %0,%1 offset:%c2":"=&v"(lo[ks]):"v"(vb),"i"(d0*4096+ks*1024):"memory");
      asm volatile("ds_read_b64_tr_b16 %0,%1 offset:%c2":"=&v"(hi[ks]):"v"(vb),"i"(d0*4096+ks*1024+512):"memory");}
    asm volatile("s_waitcnt lgkmcnt(0)":::"memory");SBAR();
    #define PK(k) (bf16x8){lo[k][0],lo[k][1],lo[k][2],lo[k][3],hi[k][0],hi[k][1],hi[k][2],hi[k][3]}
    o[d0]=__builtin_amdgcn_mfma_f32_32x32x16_bf16(pa0,PK(0),o[d0],0,0,0);
    o[d0]=__builtin_amdgcn_mfma_f32_32x32x16_bf16(pa1,PK(1),o[d0],0,0,0);
    o[d0]=__builtin_amdgcn_mfma_f32_32x32x16_bf16(pa2,PK(2),o[d0],0,0,0);
    o[d0]=__builtin_amdgcn_mfma_f32_32x32x16_bf16(pa3,PK(3),o[d0],0,0,0);
    #undef PK
  }
}

#ifndef ATTN_STORE16
#define ATTN_STORE16(p,v) (*(u32x4*)(p)=(v))
#endif
template<int THRL,bool NOMAX> __device__ __forceinline__ void attn_unit(const bf16*Qw0,const bf16*Kh,const bf16*Vh,bf16*Ow0,const int NT,char*shm,const int wid){
  const int lane=lane_id(),r32=lane&31,hi=lane>>5;
  const bf16*Qw=Qw0+(long)(wid*QBLK)*QP;
  const unsigned lds0=(unsigned)(uintptr_t)shm;
  float*wsf=(float*)(shm+LDS_WS)+wid*64;
  const bf16*ksrc=Kh+(long)lane*KP+wid*8;
  const bf16*vsrc=Vh+(long)(16*(wid&3)+(lane>>2))*VP+(wid>>2)*32+(lane&3)*8;
  const unsigned kdst=lds0+LDS_K+wid*1024, vdst=lds0+LDS_V+wid*1024;
  #define DMA_K(t,slot) glds16(ksrc+(long)(t)*KVBLK*KP,(unsigned)__builtin_amdgcn_readfirstlane(kdst+(slot)))
  #define DMA_V(t,slot) glds16(vsrc+(long)(t)*KVBLK*VP,(unsigned)__builtin_amdgcn_readfirstlane(vdst+(slot)))
  const int vb0=(int)(lds0+LDS_V)+((lane>>4)&1)*32+(lane&3)*8+(4*hi+((lane&15)>>2))*64;
  const char*Kbase=shm+LDS_K; bf16x8 kf[8];
  const lds_cptr shm3=(lds_cptr)shm; const lds_cptr kp0=shm3+LDS_K+hi*1024+r32*16; const lds_cptr vp0=shm3+LDS_V+((lane>>4)&1)*32+(lane&3)*8+(4*hi+((lane&15)>>2))*64;
  DMA_K(0,0);DMA_V(0,0);DMA_K(1,SLOTB);
  bf16x8 qr[4];
  #pragma unroll
  for(int d0=0;d0<4;++d0)qr[d0]=*reinterpret_cast<const bf16x8*>(&Qw[(long)r32*QP+d0*16+hi*8]);
  float mhat=0.f,l_reg=0.f;f32x16 o[2];o[0]=f32x16{};o[1]=f32x16{};f32x16 negm=f32x16{};asm volatile("":"+v"(negm));
  #define CMASK(P0,P1,t) do{}while(0)
  bool resc=false;
  #define START(P0,P1) do{ resc=false; if constexpr(!NOMAX){ const float rm=rowmax(P0,P1); \
    { const float dl=rm; mhat=fadd_s(mhat,dl); \
      _Pragma("unroll") for(int r=0;r<16;++r){P0[r]=fsub_s(P0[r],dl);P1[r]=fsub_s(P1[r],dl);} \
      _Pragma("unroll") for(int r=0;r<16;++r)negm[r]=-mhat; asm volatile("":"+v"(negm)); } } \
    _Pragma("unroll") for(int r=0;r<16;++r)P0[r]=__builtin_amdgcn_exp2f(P0[r]); }while(0)
  #define RESC() do{ if(resc){ asm volatile("s_waitcnt lgkmcnt(0)":::"memory"); \
      _Pragma("unroll") for(int d_=0;d_<2;++d_) _Pragma("unroll") for(int r=0;r<16;++r)o[d_][r]*=wsf[crow(r,hi)]; } }while(0)
  f32x16 pA0,pA1,pB0,pB1;
  int sl_prev=0,sl_cur=0,sl_next=SLOTB;
  #define ROT() do{sl_prev=sl_cur;sl_cur=sl_next;sl_next=(sl_next==(NSLOT-1)*SLOTB)?0:sl_next+SLOTB;}while(0)
  DMA_K(2,2*SLOTB);
  WAIT_BAR(3);
  qkt(pA0,pA1,Kbase,qr,negm,r32,hi);asm volatile("s_nop 15\n\ts_nop 7":"+v"(pA0),"+v"(pA1));CMASK(pA0,pA1,0);
  START(pA0,pA1);
  _Pragma("unroll") for(int r=0;r<16;++r)pA1[r]=__builtin_amdgcn_exp2f(pA1[r]);
  WAIT_BAR(0);
  DMA_K(3,0);DMA_V(1,SLOTB);
  ROT();
  kload8(kf,kp0+sl_cur);
  WAIT_BAR(2);
  s16x4 vlo[8],vhi[8]; u32x4 pw0,pw1,pw2,pw3;
  #define PKW(P,B) cvtpk_s(P[B],P[B+1])
  #define PAF(k) __builtin_bit_cast(bf16x8,pw##k)
  #define VFR(i) (bf16x8){vlo[i][0],vlo[i][1],vlo[i][2],vlo[i][3],vhi[i][0],vhi[i][1],vhi[i][2],vhi[i][3]}
  #define PIN(x) asm volatile("":"+v"(x))
  #define MX3(a,b,c) __builtin_fmaxf(__builtin_fmaxf((a),(b)),(c))
  #define GAPA(MF,A0,A1,A2,A3,W0,W1,PW) do{ MF; sacc+=A0; sacc+=A1; sacc+=A2; sacc+=A3; PIN(sacc); W0; W1; PIN(PW); SBAR(); }while(0)
  #define EX(v) __builtin_amdgcn_exp2f(v)
  #define GAPB(MF,X,B) do{ MF; X[B]=EX(X[B]); X[B+1]=EX(X[B+1]); X[B+2]=EX(X[B+2]); X[B+3]=EX(X[B+3]); PIN(X); SBAR(); }while(0)
  #define VRD(i) do{ vlo[i]=vtr(vp_+(((i)>>2)*4096+((i)&3)*1024)); vhi[i]=vtr(vp_+(((i)>>2)*4096+((i)&3)*1024+512)); }while(0)
  #define KRD(G,j) do{ if(G){ kload2(kf,kp0+sl_next,j); SBAR(); } }while(0)
  #define STEP(C0,C1,P0,P1,t,GK,GV,GL) do{ SBAR(); \
    const lds_cptr vp_=vp0+sl_prev; \
    VRD(0); SBAR(); float sacc=(P0[0]+P0[1]); \
    GAPA(C0=__builtin_amdgcn_mfma_f32_32x32x16_bf16(kf[0],qr[0],negm,0,0,0), P0[2],P0[3],P0[4],P0[5],     pw0[0]=PKW(P0,0), pw0[1]=PKW(P0,2), pw0); \
    VRD(4); SBAR(); GAPA(C1=__builtin_amdgcn_mfma_f32_32x32x16_bf16(kf[1],qr[0],negm,0,0,0), P0[6],P0[7],P0[8],P0[9],     pw0[2]=PKW(P0,4), pw0[3]=PKW(P0,6), pw0); \
    VRD(1); SBAR(); GAPA(C0=__builtin_amdgcn_mfma_f32_32x32x16_bf16(kf[2],qr[1],C0,0,0,0),   P0[10],P0[11],P0[12],P0[13], pw1[0]=PKW(P0,8), pw1[1]=PKW(P0,10), pw1); \
    VRD(5); SBAR(); GAPA(C1=__builtin_amdgcn_mfma_f32_32x32x16_bf16(kf[3],qr[1],C1,0,0,0),   P0[14],P0[15],P1[0],P1[1],   pw1[2]=PKW(P0,12),pw1[3]=PKW(P0,14), pw1); \
    VRD(2); SBAR(); GAPA(C0=__builtin_amdgcn_mfma_f32_32x32x16_bf16(kf[4],qr[2],C0,0,0,0),   P1[2],P1[3],P1[4],P1[5],     pw2[0]=PKW(P1,0), pw2[1]=PKW(P1,2), pw2); \
    VRD(6); SBAR(); GAPA(C1=__builtin_amdgcn_mfma_f32_32x32x16_bf16(kf[5],qr[2],C1,0,0,0),   P1[6],P1[7],P1[8],P1[9],     pw2[2]=PKW(P1,4), pw2[3]=PKW(P1,6), pw2); \
    VRD(3); SBAR(); GAPA(C0=__builtin_amdgcn_mfma_f32_32x32x16_bf16(kf[6],qr[3],C0,0,0,0),   P1[10],P1[11],P1[12],P1[13], pw3[0]=PKW(P1,8), pw3[1]=PKW(P1,10), pw3); \
    VRD(7); SBAR(); GAPA(C1=__builtin_amdgcn_mfma_f32_32x32x16_bf16(kf[7],qr[3],C1,0,0,0),   P1[14],P1[15],0.f,0.f,       pw3[2]=PKW(P1,12),pw3[3]=PKW(P1,14), pw3); \
    l_reg+=sacc; \
    if(GK){DMA_K((t)+3,sl_cur);} if(GV){DMA_V((t)+1,sl_next);} \
    CMASK(C0,C1,t); \
    if constexpr(!NOMAX) { float a=MX3(C0[0],C0[1],C1[0]),b=MX3(C0[2],C0[3],C1[1]); a=MX3(a,C1[2],C1[3]); \
      _Pragma("unroll") for(int r=4;r<16;r+=4){a=MX3(a,C0[r],C0[r+1]);b=MX3(b,C0[r+2],C0[r+3]);a=MX3(a,C1[r],C1[r+1]);b=MX3(b,C1[r+2],C1[r+3]);} \
      float rm=__builtin_fmaxf(a,b); { auto rr=__builtin_amdgcn_permlane32_swap(__float_as_uint(rm),__float_as_uint(rm),false,false); rm=__builtin_fmaxf(__uint_as_float(rr[0]),__uint_as_float(rr[1])); } \
      resc=false; \
      if(__builtin_expect(__any(rm>(float)THRL),0)){ const float dl=__builtin_fmaxf(rm,0.f); mhat+=dl; \
        _Pragma("unroll") for(int r=0;r<16;++r){C0[r]-=dl;C1[r]-=dl;} \
        _Pragma("unroll") for(int r=0;r<16;++r)negm[r]=-mhat; asm volatile("":"+v"(negm)); \
        const float f=__builtin_amdgcn_exp2f(-dl); l_reg*=f; if(hi==0)wsf[r32]=f; resc=true; } } \
    SBAR(); \
    GAPB(o[0]=__builtin_amdgcn_mfma_f32_32x32x16_bf16(PAF(0),VFR(0),o[0],0,0,0), C0,0); \
    GAPB(o[1]=__builtin_amdgcn_mfma_f32_32x32x16_bf16(PAF(0),VFR(4),o[1],0,0,0), C0,4); \
    KRD(GL,0); GAPB(o[0]=__builtin_amdgcn_mfma_f32_32x32x16_bf16(PAF(1),VFR(1),o[0],0,0,0), C0,8); \
    KRD(GL,1); GAPB(o[1]=__builtin_amdgcn_mfma_f32_32x32x16_bf16(PAF(1),VFR(5),o[1],0,0,0), C0,12); \
    KRD(GL,2); GAPB(o[0]=__builtin_amdgcn_mfma_f32_32x32x16_bf16(PAF(2),VFR(2),o[0],0,0,0), C1,0); \
    KRD(GL,3); GAPB(o[1]=__builtin_amdgcn_mfma_f32_32x32x16_bf16(PAF(2),VFR(6),o[1],0,0,0), C1,4); \
    GAPB(o[0]=__builtin_amdgcn_mfma_f32_32x32x16_bf16(PAF(3),VFR(3),o[0],0,0,0), C1,8); \
    GAPB(o[1]=__builtin_amdgcn_mfma_f32_32x32x16_bf16(PAF(3),VFR(7),o[1],0,0,0), C1,12); \
    }while(0)
  int t=1;
  #undef CMASK
  #define CMASK(P0,P1,t) do{}while(0)
  for(;t+5<NT;t+=2){
    STEP(pB0,pB1,pA0,pA1,t,true,true,true);     WAIT_BAR(2); RESC(); ROT();
    STEP(pA0,pA1,pB0,pB1,t+1,true,true,true);   WAIT_BAR(2); RESC(); ROT();
  }
  #undef CMASK
  #define CMASK(P0,P1,t) do{}while(0)
  #define ENDW(tt) do{ if((tt)+3<NT){WAIT_BAR(2);} else if((tt)+2<NT){WAIT_BAR(1);} else {WAIT_BAR(0);} }while(0)
  for(;t+1<NT;t+=2){
    STEP(pB0,pB1,pA0,pA1,t,(t+3<NT),(t+1<NT),(t+1<NT));       ENDW(t);   RESC(); ROT();
    STEP(pA0,pA1,pB0,pB1,t+1,(t+4<NT),(t+2<NT),(t+2<NT));     ENDW(t+1); RESC(); ROT();
  }
  STEP(pB0,pB1,pA0,pA1,NT-1,false,false,false); RESC();
  { float sacc=pB0[0]+pB0[1]; _Pragma("unroll") for(int r=2;r<16;++r)sacc+=pB0[r]; _Pragma("unroll") for(int r=0;r<16;++r)sacc+=pB1[r]; l_reg+=sacc;
    pw0=(u32x4){PKW(pB0,0),PKW(pB0,2),PKW(pB0,4),PKW(pB0,6)};pw1=(u32x4){PKW(pB0,8),PKW(pB0,10),PKW(pB0,12),PKW(pB0,14)};pw2=(u32x4){PKW(pB1,0),PKW(pB1,2),PKW(pB1,4),PKW(pB1,6)};pw3=(u32x4){PKW(pB1,8),PKW(pB1,10),PKW(pB1,12),PKW(pB1,14)};
    SBAR(); pv(o,vb0+sl_cur,PAF(0),PAF(1),PAF(2),PAF(3)); }
  #undef PKW
  #undef PAF
  #undef VFR
  #undef PIN
  #undef MX3
  #undef GAPA
  #undef GAPB
  #undef EX
  #undef VRD
  #undef KRD
  #undef STEP
  #undef ENDW
  {auto rr=__builtin_amdgcn_permlane32_swap(__float_as_uint(l_reg),__float_as_uint(l_reg),false,false);l_reg=__uint_as_float(rr[0])+__uint_as_float(rr[1]);}
  if(hi==0)wsf[32+r32]=l_reg;asm volatile("s_waitcnt lgkmcnt(0)":::"memory");
  float rli[16];
  #pragma unroll
  for(int r=0;r<16;++r)rli[r]=__builtin_amdgcn_rcpf(wsf[32+crow(r,hi)]);
  bf16*Ow=Ow0+(long)(wid*QBLK)*OP;
  { bf16*stg=(bf16*)(shm+LDS_OST)+wid*2048;
    #pragma unroll
    for(int r=0;r<16;++r){const int orow=crow(r,hi);
      #pragma unroll
      for(int d0=0;d0<2;++d0)stg[orow*64+d0*32+r32]=__float2bfloat16(o[d0][r]*rli[r]);}
    asm volatile("s_waitcnt lgkmcnt(0)":::"memory");
    #pragma unroll
    for(int i=0;i<4;++i){const int row=i*8+(lane>>3),ch=lane&7; const u32x4 v=*(const u32x4*)(stg+row*64+ch*8); ATTN_STORE16(Ow+(long)row*OP+ch*8,v);} }
  asm volatile("s_waitcnt lgkmcnt(0)\n\ts_barrier":::"memory");
  #undef DMA_K
  #undef DMA_V
  #undef CMASK
  #undef START
  #undef RESC
  #undef ROT
}
constexpr int ATTN_LDS_BYTES=LDS_BYTES;
#undef SBAR
#undef WAIT_BAR
}

__device__ __forceinline__ void phase_pro(const Ctx& c, LAS float* ldsf) {
    float* rope = (float*)(c.ws + WS_ROPE);
    for (int i = c.gt; i < 64 * 16; i += c.ngt) {
        const int pos = i >> 4, fi = i & 15; const float inv = powf(10000.0f, -(float)fi / 16.0f), ang = (float)pos * inv;
        rope[2 * i] = cosf(ang); rope[2 * i + 1] = sinf(ang);
    }
    LAS float* sil = ldsf; LAS float* red = ldsf + 9 * 1024;
    for (int i = c.tid; i < 9 * 1024; i += 512) { const int j = i >> 10, k = i & 1023; const float v = (j < 8) ? c.in[IN_C][j * 1024 + k] : c.in[IN_CCTX][k]; sil[i] = siluf_(v); }
    __syncthreads();
    float* MOD = (float*)(c.ws + WS_MOD);
    for (int task = c.vb; task < DEPTH * 192; task += c.vg) {
        const int L = task / 192, cb = task - L * 192, col = cb * 32 + (c.lane & 31);
        const float* W = c.in[IN_MODW] + (size_t)L * 1024 * 6144 + col;
        float acc[9];
#pragma unroll
        for (int j = 0; j < 9; ++j) acc[j] = 0.f;
        const int k0 = c.wave * 128 + (c.lane >> 5);
        for (int kb = 0; kb < 128; kb += 32) {
            float w[16];
#pragma unroll
            for (int u = 0; u < 16; ++u) w[u] = __builtin_nontemporal_load(W + (size_t)(k0 + kb + 2 * u) * 6144);
#pragma unroll
            for (int u = 0; u < 16; ++u)
#pragma unroll
                for (int j = 0; j < 9; ++j) acc[j] += sil[j * 1024 + k0 + kb + 2 * u] * w[u];
        }
#pragma unroll
        for (int j = 0; j < 9; ++j) { acc[j] += __shfl_xor(acc[j], 32); if (c.lane < 32) red[(c.wave * 9 + j) * 32 + c.lane] = acc[j]; }
        __syncthreads();
        if (c.wave == 0 && c.lane < 32) {
            const float bias = c.in[IN_MODB][L * 6144 + col];
#pragma unroll
            for (int j = 0; j < 9; ++j) { float s = bias;
#pragma unroll
                for (int w = 0; w < 8; ++w) s += red[(w * 9 + j) * 32 + c.lane];
                MOD[(size_t)(L * 9 + j) * 6144 + col] = s; }
        }
        __syncthreads();
    }
}

template <bool FINAL, bool GM, int NR>
__device__ __forceinline__ void norm1_rows(const Ctx& c, int L, int rbeg, int rend) {
    unsigned short* X = (unsigned short*)(c.ws + WS_X);
    const int* SLOT = (const int*)(c.ws + WS_SLOT); const unsigned char* Y = (const unsigned char*)(c.ws + WS_Y);
    int ch[4];
#pragma unroll
    for (int q = 0; q < 4; ++q) ch[q] = GM ? 16 * c.lane + 4 * q : 4 * (c.lane + 64 * q);
#define N1_DEC(w) ((f32x4){__builtin_amdgcn_cvt_pk_f32_fp8((int)(w), false)[0], __builtin_amdgcn_cvt_pk_f32_fp8((int)(w), false)[1], __builtin_amdgcn_cvt_pk_f32_fp8((int)(w), true)[0], __builtin_amdgcn_cvt_pk_f32_fp8((int)(w), true)[1]})
    pg8::u32x2 xn[NR][4]; int spn[NR]; unsigned yp0[NR][4], yp1[NR][4]; unsigned long long maskn[NR]; bool hasn[NR], twon[NR];
#pragma unroll
    for (int k = 0; k < NR; ++k) { spn[k] = -1; maskn[k] = 0ull; hasn[k] = false; twon[k] = false; }
#define N1_LOADX(k, row) do { _Pragma("unroll") for (int q = 0; q < 4; ++q) xn[k][q] = *(const pg8::u32x2*)(X + (size_t)(row) * D + ch[q]); \
        if (L > 0 && c.lane < NE) spn[k] = SLOT[(size_t)(row) * NE + c.lane]; } while (0)
#define N1_YPF(k) do { unsigned long long m_ = __ballot(spn[k] >= 0 && c.lane < NE); hasn[k] = m_ != 0ull; twon[k] = false; if (m_) { \
        const int e0_ = __builtin_ctzll(m_); m_ &= m_ - 1; twon[k] = m_ != 0ull; const int e1_ = twon[k] ? __builtin_ctzll(m_) : e0_; if (twon[k]) m_ &= m_ - 1; \
        const unsigned char* y0_ = Y + ((size_t)e0_ * EROWS + __builtin_amdgcn_readlane(spn[k], e0_)) * D; const unsigned char* y1_ = Y + ((size_t)e1_ * EROWS + __builtin_amdgcn_readlane(spn[k], e1_)) * D; \
        _Pragma("unroll") for (int q = 0; q < 4; ++q) { yp0[k][q] = __builtin_nontemporal_load((const unsigned*)(y0_ + ch[q])); yp1[k][q] = __builtin_nontemporal_load((const unsigned*)(y1_ + ch[q])); } } maskn[k] = m_; } while (0)
    const int gall = rend / NR, gper = (gall - rbeg / NR + c.ngw - 1) / c.ngw;
    int gidx = rbeg / NR + c.gw * gper;
    const int ngrp = (gidx + gper < gall) ? gidx + gper : gall;
    if (gidx < ngrp) {
#pragma unroll
        for (int k = 0; k < NR; ++k) N1_LOADX(k, gidx * NR + k);
        if (L > 0) {
#pragma unroll
            for (int k = 0; k < NR; ++k) N1_YPF(k);
        }
    }
    int jprev = -1; f32x4 gmv[4] = {}, shv[4] = {}, g2v[4] = {};
    for (; gidx < ngrp; ++gidx) {
        const int r0 = gidx * NR;
        const int b = r0 / RB, s0 = r0 - b * RB, j = s0 < CL ? 8 : b;
        pg8::u32x2 xc[NR][4]; int spc[NR]; unsigned w0[NR][4], w1[NR][4]; unsigned long long mask[NR]; bool has[NR], two0[NR];
#pragma unroll
        for (int k = 0; k < NR; ++k) { spc[k] = spn[k]; mask[k] = maskn[k]; has[k] = hasn[k]; two0[k] = twon[k];
#pragma unroll
            for (int q = 0; q < 4; ++q) { xc[k][q] = xn[k][q]; w0[k][q] = yp0[k][q]; w1[k][q] = yp1[k][q]; } }
        const int gn = gidx + 1;
        if (gn < ngrp) {
#pragma unroll
            for (int k = 0; k < NR; ++k) N1_LOADX(k, gn * NR + k);
        }
        if (!(FINAL && s0 < CL)) {
            unsigned hw[NR][8];
            if (NR > 1 && j != jprev) { jprev = j;
#pragma unroll
                for (int q = 0; q < 4; ++q) {
                    if (FINAL) gmv[q] = *(const f32x4*)(c.in[IN_FNG] + ch[q]);
                    else { gmv[q] = *(const f32x4*)(c.in[IN_NORMG] + (size_t)(L * 2 + 0) * D + ch[q]) * (1.0f + *(const f32x4*)(modp(c, L, j, 1) + ch[q])); shv[q] = *(const f32x4*)(modp(c, L, j, 0) + ch[q]); }
                    if (L > 0) g2v[q] = *(const f32x4*)(modp(c, L - 1, j, 5) + ch[q]);
                }
            }
#pragma unroll
            for (int k = 0; k < NR; ++k) {
                const int r = r0 + k, s = s0 + k;
                unsigned short* xr = X + (size_t)r * D;
                f32x4 v[4];
#pragma unroll
                for (int q = 0; q < 4; ++q) v[q] = pg8::bf4_to_f32(xc[k][q]);
                if (L > 0) {
                    f32x4 sum[4] = {};
                    if (has[k]) {
#pragma unroll
                        for (int q = 0; q < 4; ++q) { sum[q] += N1_DEC(w0[k][q]); if (two0[k]) sum[q] += N1_DEC(w1[k][q]); }
                    }
                    unsigned long long mk = mask[k];
                    while (mk) {
                        const int e0 = __builtin_ctzll(mk); mk &= mk - 1;
                        const bool two = mk != 0ull; const int e1 = two ? __builtin_ctzll(mk) : e0; if (two) mk &= mk - 1;
                        const int sp0 = __builtin_amdgcn_readlane(spc[k], e0), sp1 = __builtin_amdgcn_readlane(spc[k], e1);
                        const unsigned char* y0 = Y + ((size_t)e0 * EROWS + sp0) * D; const unsigned char* y1 = Y + ((size_t)e1 * EROWS + sp1) * D;
                        unsigned u0[4], u1[4];
#pragma unroll
                        for (int q = 0; q < 4; ++q) { u0[q] = __builtin_nontemporal_load((const unsigned*)(y0 + ch[q])); u1[q] = __builtin_nontemporal_load((const unsigned*)(y1 + ch[q])); }
#pragma unroll
                        for (int q = 0; q < 4; ++q) { sum[q] += N1_DEC(u0[q]); if (two) sum[q] += N1_DEC(u1[q]); }
                    }
                    const float* g2 = modp(c, L - 1, j, 5);
#pragma unroll
                    for (int q = 0; q < 4; ++q) { v[q] += (NR > 1 ? g2v[q] : *(const f32x4*)(g2 + ch[q])) * (sum[q] * pg8::Y8_INV); if (!FINAL) { const pg8::u32x2 w = pg8::f32_to_bf4(v[q]); *(pg8::u32x2*)(xr + ch[q]) = w; v[q] = pg8::bf4_to_f32(w); } }
                }
                float ss = 0.f;
#pragma unroll
                for (int q = 0; q < 4; ++q) ss += v[q].x * v[q].x + v[q].y * v[q].y + v[q].z * v[q].z + v[q].w * v[q].w;
                const float rstd = rsqrtf(wave_sum(ss) * (1.0f / D) + EPS);
                if (FINAL) {
                    const float* g = c.in[IN_FNG]; float* op = c.out + (size_t)(b * T + s - CL) * D;
#pragma unroll
                    for (int q = 0; q < 4; ++q) *(f32x4*)(op + ch[q]) = v[q] * rstd * (NR > 1 ? gmv[q] : *(const f32x4*)(g + ch[q]));
                } else {
                    const float* g = c.in[IN_NORMG] + (size_t)(L * 2 + 0) * D; const float* sc = modp(c, L, j, 1); const float* sh = modp(c, L, j, 0);
#pragma unroll
                    for (int q = 0; q < 4; ++q) { const f32x4 hv = NR > 1 ? v[q] * rstd * gmv[q] + shv[q] : v[q] * rstd * *(const f32x4*)(g + ch[q]) * (1.0f + *(const f32x4*)(sc + ch[q])) + *(const f32x4*)(sh + ch[q]);
                        hw[k][2 * q] = pg8::cvt_pk_bf16(hv.x, hv.y); hw[k][2 * q + 1] = pg8::cvt_pk_bf16(hv.z, hv.w); }
                    if (!GM) { unsigned short* o = (unsigned short*)(c.ws + WS_HB1) + (size_t)r * D;
#pragma unroll
                        for (int q = 0; q < 4; ++q) *(pg8::u32x2*)(o + ch[q]) = (pg8::u32x2){hw[k][2 * q], hw[k][2 * q + 1]}; }
                }
            }
            if (!FINAL && GM) {
                unsigned short* o = (unsigned short*)(c.ws + WS_AS5) + ((size_t)c.lane * 1280 + (r0 >> 5)) * 768 + (r0 & 31) * 16;
#pragma unroll
                for (int k = 0; k < NR; ++k) { *(pg8::u32x4*)(o + 16 * k) = (pg8::u32x4){hw[k][0], hw[k][1], hw[k][2], hw[k][3]}; *(pg8::u32x4*)(o + 16 * k + 8) = (pg8::u32x4){hw[k][4], hw[k][5], hw[k][6], hw[k][7]}; }
            }
        }
        if (L > 0 && gn < ngrp) {
#pragma unroll
            for (int k = 0; k < NR; ++k) N1_YPF(k);
        }
    }
#undef N1_DEC
#undef N1_LOADX
#undef N1_YPF
}
template <int NR>
__device__ __forceinline__ void norm1_first_rows(const Ctx& c, int rbeg, int rend) {
    unsigned short* X = (unsigned short*)(c.ws + WS_X); unsigned short* H = (unsigned short*)(c.ws + WS_HB1);
    f32x4 xn[NR][4];
#define NF_LOAD(k, row) do { const int b_ = (row) / RB, s_ = (row) - b_ * RB; \
        const f32x4* sp_ = (const f32x4*)((s_ < CL) ? c.in[IN_CTX] + (size_t)(b_ * CL + s_) * D : c.in[IN_X] + (size_t)(b_ * T + s_ - CL) * D) + c.lane; \
        _Pragma("unroll") for (int q = 0; q < 4; ++q) xn[k][q] = __builtin_nontemporal_load(sp_ + 64 * q); } while (0)
    const int gall = rend / NR, gper = (gall - rbeg / NR + c.ngw - 1) / c.ngw;
    int gidx = rbeg / NR + c.gw * gper;
    const int ngrp = (gidx + gper < gall) ? gidx + gper : gall;
    if (gidx < ngrp) {
#pragma unroll
        for (int k = 0; k < NR; ++k) NF_LOAD(k, gidx * NR + k);
    }
    const float* g = c.in[IN_NORMG];
    int jprev = -1; f32x4 gmv[4] = {}, shv[4] = {}, g2v[4] = {};
    for (; gidx < ngrp; ++gidx) {
        const int r0 = gidx * NR, b = r0 / RB, s0 = r0 - b * RB, j = s0 < CL ? 8 : b;
        f32x4 xc[NR][4];
#pragma unroll
        for (int k = 0; k < NR; ++k)
#pragma unroll
            for (int q = 0; q < 4; ++q) xc[k][q] = xn[k][q];
        const int gn = gidx + 1;
        if (gn < ngrp) {
#pragma unroll
            for (int k = 0; k < NR; ++k) NF_LOAD(k, gn * NR + k);
        }
        const float* sc = modp(c, 0, j, 1); const float* sh = modp(c, 0, j, 0);
        if (j != jprev) { jprev = j;
#pragma unroll
            for (int q = 0; q < 4; ++q) { const int ch = 4 * (c.lane + 64 * q); gmv[q] = *(const f32x4*)(g + ch) * (1.0f + *(const f32x4*)(sc + ch)); shv[q] = *(const f32x4*)(sh + ch); } }
#pragma unroll
        for (int k = 0; k < NR; ++k) {
            const size_t r = (size_t)(r0 + k);
            f32x4 v[4]; float ss = 0.f;
#pragma unroll
            for (int q = 0; q < 4; ++q) { const pg8::u32x2 w = pg8::f32_to_bf4(xc[k][q]); *((pg8::u32x2*)(X + r * D) + c.lane + 64 * q) = w; v[q] = pg8::bf4_to_f32(w);
                ss += v[q].x * v[q].x + v[q].y * v[q].y + v[q].z * v[q].z + v[q].w * v[q].w; }
            const float rstd = rsqrtf(wave_sum(ss) * (1.0f / D) + EPS);
#pragma unroll
            for (int q = 0; q < 4; ++q) { const int ch = 4 * (c.lane + 64 * q);
                const f32x4 hv = v[q] * rstd * gmv[q] + shv[q];
                *((pg8::u32x2*)(H + r * D) + c.lane + 64 * q) = (pg8::u32x2){pg8::cvt_pk_bf16(hv.x, hv.y), pg8::cvt_pk_bf16(hv.z, hv.w)}; }
        }
    }
#undef NF_LOAD
}
__device__ __forceinline__ void phase_norm1_first(const Ctx& c) {
    norm1_first_rows<4>(c, 0, 32768);
    norm1_first_rows<1>(c, 32768, NROWS);
}
template <bool FINAL, bool GM>
__device__ __forceinline__ void phase_norm1(const Ctx& c, int L) {
    norm1_rows<FINAL, GM, 4>(c, L, 0, 32768);
    norm1_rows<FINAL, GM, 1>(c, L, 32768, NROWS);
}

template <bool SKIPCTX>
__device__ __forceinline__ void router_pairs(const Ctx& c, int L, const LAS float* wT, int rend) {
    const unsigned short* X = (const unsigned short*)(c.ws + WS_X); unsigned char* HB = (unsigned char*)(c.ws + WS_HB); float* AFF = (float*)(c.ws + WS_AFF);
    const int npair = rend >> 1, per = (npair + c.ngw - 1) / c.ngw, p0 = c.gw * per, p1 = (p0 + per < npair) ? p0 + per : npair;
    pg8::u32x2 xA[4], xB[4];
    if (p0 < p1) {
#pragma unroll
        for (int q = 0; q < 4; ++q) { xA[q] = ((const pg8::u32x2*)(X + (size_t)(2 * p0) * D) + c.lane)[64 * q]; xB[q] = ((const pg8::u32x2*)(X + (size_t)(2 * p0 + 1) * D) + c.lane)[64 * q]; }
    }
    int jprev = -1; f32x4 gmr[4] = {}, svr[4] = {};
    for (int p = p0; p < p1; ++p) {
        const int r0 = 2 * p, j = row_j(r0);
        f32x4 fA[4], fB[4]; float ssA = 0.f, ssB = 0.f;
#pragma unroll
        for (int q = 0; q < 4; ++q) { fA[q] = pg8::bf4_to_f32(xA[q]); fB[q] = pg8::bf4_to_f32(xB[q]);
            ssA += fA[q].x * fA[q].x + fA[q].y * fA[q].y + fA[q].z * fA[q].z + fA[q].w * fA[q].w; ssB += fB[q].x * fB[q].x + fB[q].y * fB[q].y + fB[q].z * fB[q].z + fB[q].w * fB[q].w; }
        if (p + 1 < p1) {
#pragma unroll
            for (int q = 0; q < 4; ++q) { xA[q] = ((const pg8::u32x2*)(X + (size_t)(2 * (p + 1)) * D) + c.lane)[64 * q]; xB[q] = ((const pg8::u32x2*)(X + (size_t)(2 * (p + 1) + 1) * D) + c.lane)[64 * q]; }
        }
        if (!(SKIPCTX && j == 8)) {
            const float rsA = rsqrtf(wave_sum(ssA) * (1.0f / D) + EPS), rsB = rsqrtf(wave_sum(ssB) * (1.0f / D) + EPS);
            const f32x4* g = (const f32x4*)(c.in[IN_NORMG] + (size_t)(L * 2 + 1) * D) + c.lane;
            const f32x4* sc = (const f32x4*)modp(c, L, j, 4) + c.lane; const f32x4* sh = (const f32x4*)modp(c, L, j, 3) + c.lane;
            unsigned* hA = (unsigned*)(HB + (size_t)r0 * D) + c.lane; unsigned* hB = (unsigned*)(HB + (size_t)(r0 + 1) * D) + c.lane;
            if (j != jprev) { jprev = j;
#pragma unroll
                for (int q = 0; q < 4; ++q) { gmr[q] = g[64 * q] * (1.0f + sc[64 * q]); svr[q] = sh[64 * q]; } }
#pragma unroll
            for (int q = 0; q < 4; ++q) { const f32x4 gm = gmr[q], sv = svr[q];
                fA[q] = fA[q] * rsA * gm + sv; fB[q] = fB[q] * rsB * gm + sv;
                hA[64 * q] = pg8::pk4_fp8(fA[q].x, fA[q].y, fA[q].z, fA[q].w); hB[64 * q] = pg8::pk4_fp8(fB[q].x, fB[q].y, fB[q].z, fB[q].w); }
            __builtin_amdgcn_sched_barrier(0);
            float lgA[16], lgB[16];
#pragma unroll
            for (int e = 0; e < 16; ++e) {
                f32x2 a2 = {0.f, 0.f}, b2 = {0.f, 0.f};
#pragma unroll
                for (int q = 0; q < 4; ++q) { const f32x4 wv = *(const LAS f32x4*)(wT + e * D + 4 * (c.lane + 64 * q));
                    a2 += fA[q].xy * wv.xy; a2 += fA[q].zw * wv.zw; b2 += fB[q].xy * wv.xy; b2 += fB[q].zw * wv.zw; }
                float a = a2.x + a2.y, b = b2.x + b2.y;
                asm volatile("" : "+v"(a), "+v"(b));
                lgA[e] = a; lgB[e] = b;
                if (e & 1) __builtin_amdgcn_sched_barrier(0);
            }
            const int kk = reduce16_k(c.lane);
            { const float mine = reduce16(lgA, c.lane); float mx = mine;
#pragma unroll
              for (int o = 4; o < 64; o <<= 1) mx = fmaxf(mx, __shfl_xor(mx, o));
              const float ex = expf(mine - mx); float den = ex;
#pragma unroll
              for (int o = 4; o < 64; o <<= 1) den += __shfl_xor(den, o);
              if ((c.lane & 3) == 0) AFF[(size_t)r0 * NE + kk] = ex / den; }
            { const float mine = reduce16(lgB, c.lane); float mx = mine;
#pragma unroll
              for (int o = 4; o < 64; o <<= 1) mx = fmaxf(mx, __shfl_xor(mx, o));
              const float ex = expf(mine - mx); float den = ex;
#pragma unroll
              for (int o = 4; o < 64; o <<= 1) den += __shfl_xor(den, o);
              if ((c.lane & 3) == 0) AFF[(size_t)(r0 + 1) * NE + kk] = ex / den; }
        }
    }
}
template <bool SKIPCTX>
__device__ __forceinline__ void phase_norm2_router(const Ctx& c, int L, LAS float* wT) {
    const unsigned short* X = (const unsigned short*)(c.ws + WS_X); unsigned char* HB = (unsigned char*)(c.ws + WS_HB); float* AFF = (float*)(c.ws + WS_AFF);
    const float* WR = c.in[IN_ROUTER] + (size_t)L * D * NE;
    __syncthreads();
    for (int idx = c.tid; idx < D * 4; idx += 512) { const int ch = idx >> 2, e4 = idx & 3; const f32x4 w = *(const f32x4*)(WR + (size_t)ch * NE + 4 * e4);
        wT[(4 * e4 + 0) * D + ch] = w.x; wT[(4 * e4 + 1) * D + ch] = w.y; wT[(4 * e4 + 2) * D + ch] = w.z; wT[(4 * e4 + 3) * D + ch] = w.w; }
    __syncthreads();
    router_pairs<SKIPCTX>(c, L, wT, 32768);
    constexpr int RB0 = 32768;
    pg8::u32x2 xn[4];
    if (RB0 + c.gw < NROWS) {
#pragma unroll
        for (int q = 0; q < 4; ++q) xn[q] = ((const pg8::u32x2*)(X + (size_t)(RB0 + c.gw) * D) + c.lane)[64 * q];
    }
    for (int r = RB0 + c.gw; r < NROWS; r += c.ngw) {
        const int j = row_j(r);
        f32x4 v[4]; float ss = 0.f;
#pragma unroll
        for (int q = 0; q < 4; ++q) { v[q] = pg8::bf4_to_f32(xn[q]); ss += v[q].x * v[q].x + v[q].y * v[q].y + v[q].z * v[q].z + v[q].w * v[q].w; }
        if (r + c.ngw < NROWS) {
#pragma unroll
            for (int q = 0; q < 4; ++q) xn[q] = ((const pg8::u32x2*)(X + (size_t)(r + c.ngw) * D) + c.lane)[64 * q];
        }
        if (SKIPCTX && j == 8) continue;
        const float rstd = rsqrtf(wave_sum(ss) * (1.0f / D) + EPS);
        const f32x4* g = (const f32x4*)(c.in[IN_NORMG] + (size_t)(L * 2 + 1) * D) + c.lane;
        const f32x4* sc = (const f32x4*)modp(c, L, j, 4) + c.lane; const f32x4* sh = (const f32x4*)modp(c, L, j, 3) + c.lane;
        unsigned* hp = (unsigned*)(HB + (size_t)r * D) + c.lane;
        float lg[16]; f32x4 f[4];
#pragma unroll
        for (int q = 0; q < 4; ++q) { f[q] = v[q] * rstd * g[64 * q] * (1.0f + sc[64 * q]) + sh[64 * q]; hp[64 * q] = pg8::pk4_fp8(f[q].x, f[q].y, f[q].z, f[q].w); }
        __builtin_amdgcn_sched_barrier(0);
#pragma unroll
        for (int e = 0; e < 16; ++e) {
            f32x2 a2 = {0.f, 0.f};
#pragma unroll
            for (int q = 0; q < 4; ++q) { const f32x4 wv = *(const LAS f32x4*)(wT + e * D + 4 * (c.lane + 64 * q)); a2 += f[q].xy * wv.xy; a2 += f[q].zw * wv.zw; }
            lg[e] = a2.x + a2.y;
            if (e & 1) __builtin_amdgcn_sched_barrier(0);
        }
        const float mine = reduce16(lg, c.lane);
        const int k = reduce16_k(c.lane);
        float mx = mine;
#pragma unroll
        for (int o = 4; o < 64; o <<= 1) mx = fmaxf(mx, __shfl_xor(mx, o));
        const float ex = expf(mine - mx);
        float den = ex;
#pragma unroll
        for (int o = 4; o < 64; o <<= 1) den += __shfl_xor(den, o);
        if ((c.lane & 3) == 0) AFF[(size_t)r * NE + k] = ex / den;
    }
}

__device__ __forceinline__ void phase_topk(const Ctx& c, LAS unsigned* lds32, int nprob) {
    const float* AFF = (const float*)(c.ws + WS_AFF);
    int* SELROW = (int*)(c.ws + WS_SELROW); float* SELGATE = (float*)(c.ws + WS_SELGATE); int* SLOT = (int*)(c.ws + WS_SLOT);
    LAS unsigned* hist = lds32; LAS unsigned* wsum = lds32 + 256; LAS unsigned* res = lds32 + 272;
    LAS int* srow = (LAS int*)(lds32 + 512);
    const unsigned char* HB = (const unsigned char*)(c.ws + WS_HB); unsigned char* XS = (unsigned char*)(c.ws + WS_XS);
    for (int pid = blockIdx.x; pid < nprob; pid += gridDim.x) {
        const bool lat = pid < 128; const int q = lat ? pid : pid - 128, b = q >> 4, e = q & 15;
        const int N = lat ? T : CL, C = lat ? CAP_LAT : CAP_CTX, row0 = b * RB + (lat ? CL : 0), base = lat ? b * CAP_LAT : NB * CAP_LAT + b * CAP_CTX;
        const int t0 = c.tid * 8; const bool valid = t0 < N;
        unsigned k[8];
#pragma unroll
        for (int i = 0; i < 8; ++i) k[i] = valid ? __float_as_uint(AFF[(size_t)(row0 + t0 + i) * NE + e]) : 0u;
        unsigned prefix = 0u, want = (unsigned)C;
#pragma unroll
        for (int r = 0; r < 4; ++r) {
            const int shift = 24 - 8 * r;
            __syncthreads();
            if (c.tid < 256) hist[c.tid] = 0u;
            __syncthreads();
            if (valid) {
#pragma unroll
                for (int i = 0; i < 8; ++i) if (r == 0 || (k[i] >> (shift + 8)) == prefix) __hip_atomic_fetch_add(&hist[(k[i] >> shift) & 255u], 1u, __ATOMIC_RELAXED, __HIP_MEMORY_SCOPE_WORKGROUP);
            }
            __syncthreads();
            if (c.wave == 0) {
                const unsigned h0 = hist[4 * c.lane], h1 = hist[4 * c.lane + 1], h2 = hist[4 * c.lane + 2], h3 = hist[4 * c.lane + 3];
                unsigned suf = h0 + h1 + h2 + h3;
#pragma unroll
                for (int off = 1; off < 64; off <<= 1) { const unsigned o = __shfl_down(suf, off); if (c.lane + off < 64) suf += o; }
                unsigned nxt = __shfl_down(suf, 1); if (c.lane == 63) nxt = 0u;
                if (suf >= want && nxt < want) {
                    unsigned above = nxt; int d;
                    if (above + h3 >= want) d = 3; else { above += h3; if (above + h2 >= want) d = 2; else { above += h2; if (above + h1 >= want) d = 1; else { above += h1; d = 0; } } }
                    res[0] = (unsigned)(4 * c.lane + d); res[1] = want - above;
                }
            }
            __syncthreads();
            prefix = (prefix << 8) | res[0]; want = res[1];
        }
        const unsigned thr = prefix, need_eq = want;
        unsigned cg = 0u, ce = 0u;
#pragma unroll
        for (int i = 0; i < 8; ++i) { cg += (valid && k[i] > thr) ? 1u : 0u; ce += (valid && k[i] == thr) ? 1u : 0u; }
        unsigned incl = cg | (ce << 16);
#pragma unroll
        for (int off = 1; off < 64; off <<= 1) { const unsigned o = __shfl_up(incl, off); if (c.lane >= off) incl += o; }
        __syncthreads();
        if (c.lane == 63) wsum[c.wave] = incl;
        __syncthreads();
        unsigned wbase = 0u;
#pragma unroll
        for (int w = 0; w < 8; ++w) if (w < c.wave) wbase += wsum[w];
        const unsigned excl = wbase + incl - (cg | (ce << 16));
        unsigned gb = excl & 0xffffu, eb = excl >> 16;
        if (valid) {
#pragma unroll
            for (int i = 0; i < 8; ++i) {
                const int row = row0 + t0 + i; const bool isg = k[i] > thr, ise = k[i] == thr;
                const bool sel = isg || (ise && eb < need_eq);
                const unsigned sp = (unsigned)base + gb + (eb < need_eq ? eb : need_eq);
                if (sel) { SELROW[e * EROWS + sp] = row; SELGATE[e * EROWS + sp] = __uint_as_float(k[i]); SLOT[(size_t)row * NE + e] = (int)sp; srow[sp - (unsigned)base] = row; }
                else SLOT[(size_t)row * NE + e] = -1;
                gb += isg ? 1u : 0u; eb += ise ? 1u : 0u;
            }
        }
        __syncthreads();
        for (int s0 = c.wave * 16; s0 < C; s0 += 128) {
            pg8::u32x4 v4[16];
#pragma unroll
            for (int j = 0; j < 16; ++j) v4[j] = *(const pg8::u32x4*)(HB + (size_t)srow[s0 + j] * D + c.lane * 16);
#pragma unroll
            for (int j = 0; j < 16; ++j) *(pg8::u32x4*)(XS + ((size_t)e * EROWS + base + s0 + j) * D + c.lane * 16) = v4[j];
        }
    }
}

__device__ __forceinline__ void post_ld32(const unsigned short* p, float (&v)[32]) {
#pragma unroll
    for (int q = 0; q < 4; ++q) { const pg8::u32x4 w = ((const pg8::u32x4*)p)[q];
#pragma unroll
        for (int e = 0; e < 4; ++e) { v[8 * q + 2 * e] = __uint_as_float(w[e] << 16); v[8 * q + 2 * e + 1] = __uint_as_float(w[e] & 0xffff0000u); } }
}
__device__ __forceinline__ void post_raw(const unsigned short* p, pg8::u32x4 (&w)[4]) {
#pragma unroll
    for (int q = 0; q < 4; ++q) w[q] = ((const pg8::u32x4*)p)[q];
}
__device__ __forceinline__ void post_cvt(const pg8::u32x4 (&w)[4], float (&v)[32]) {
#pragma unroll
    for (int q = 0; q < 4; ++q)
#pragma unroll
        for (int e = 0; e < 4; ++e) { v[8 * q + 2 * e] = __uint_as_float(w[q][e] << 16); v[8 * q + 2 * e + 1] = __uint_as_float(w[q][e] & 0xffff0000u); }
}
__device__ __forceinline__ void post_st32(unsigned short* p, const float (&v)[32], float sc) {
#pragma unroll
    for (int q = 0; q < 4; ++q) { pg8::u32x4 w;
#pragma unroll
        for (int e = 0; e < 4; ++e) w[e] = pg8::cvt_pk_bf16(v[8 * q + 2 * e] * sc, v[8 * q + 2 * e + 1] * sc);
        ((pg8::u32x4*)p)[q] = w; }
}
__device__ __forceinline__ void post_rope_l(float (&v)[32], const LAS float* cs  ) {
#pragma unroll
    for (int f4 = 0; f4 < 8; ++f4) { const f32x4 t4 = ((const LAS f32x4*)cs)[f4];
        { const float x1 = v[2 * f4], x2 = v[16 + 2 * f4]; v[2 * f4] = x1 * t4.x - x2 * t4.y; v[16 + 2 * f4] = x1 * t4.y + x2 * t4.x; }
        { const float x1 = v[2 * f4 + 1], x2 = v[16 + 2 * f4 + 1]; v[2 * f4 + 1] = x1 * t4.z - x2 * t4.w; v[16 + 2 * f4 + 1] = x1 * t4.w + x2 * t4.z; } }
}
__device__ __forceinline__ void post_rope(float (&v)[32], const float* cs  ) {
#pragma unroll
    for (int f4 = 0; f4 < 8; ++f4) { const f32x4 t4 = ((const f32x4*)cs)[f4];
        { const float x1 = v[2 * f4], x2 = v[16 + 2 * f4]; v[2 * f4] = x1 * t4.x - x2 * t4.y; v[16 + 2 * f4] = x1 * t4.y + x2 * t4.x; }
        { const float x1 = v[2 * f4 + 1], x2 = v[16 + 2 * f4 + 1]; v[2 * f4 + 1] = x1 * t4.z - x2 * t4.w; v[16 + 2 * f4 + 1] = x1 * t4.w + x2 * t4.z; } }
}
__device__ __forceinline__ void phase_post(const Ctx& c, int i, LAS unsigned char* lds) {
    typedef pg8::bf16x8 bf16x8;
    const unsigned short* P = (const unsigned short*)(c.ws + WS_P); const float* rope = (const float*)(c.ws + WS_ROPE);
    unsigned short* QA = (unsigned short*)(c.ws + WS_QA); unsigned short* KA = (unsigned short*)(c.ws + WS_KA); unsigned short* VA = (unsigned short*)(c.ws + WS_VA);
    unsigned short* RQ = (unsigned short*)(c.ws + WS_RQ); unsigned short* RK = (unsigned short*)(c.ws + WS_RK); unsigned short* RV = (unsigned short*)(c.ws + WS_RV);
    float* U = (float*)(c.ws + WS_U);
    const float* qkg = c.in[IN_QKG] + (size_t)i * 2 * 64;
    constexpr int VTS = 0, KTF = 17408, KTB = 34816;
    const int grp = c.tid >> 8, r = (c.tid & 255) >> 1, half = c.tid & 1;
    const int li = c.lane & 15, q4 = c.lane >> 4;
    pg8::u32x4 ra[4], rb[4], rc[4];
#define PP_LOAD(u_) do { const int hh_ = (u_) & 7, bc_ = (u_) >> 3, b_ = bc_ / 34, cch_ = bc_ - b_ * 34; const size_t row_ = (size_t)(b_ * RB + cch_ * 128 + r); \
        post_raw(P + row_ * INW + (grp ? 512 : 0) + hh_ * 64 + 32 * half, ra); post_raw(P + row_ * INW + (grp ? 2048 : 1024) + hh_ * 64 + 32 * half, rb); \
        if (hh_ < 2 && grp == 0) post_raw(P + row_ * INW + 2560 + hh_ * 64 + 32 * half, rc); } while (0)
    if ((int)blockIdx.x < NB * 34 * 8) PP_LOAD((int)blockIdx.x);
    LAS float* ropeL = (LAS float*)(lds + 53248); LAS float* qkL = ropeL + 64 * 36;
    for (int i2 = c.tid; i2 < 64 * 32; i2 += 512) ropeL[(i2 >> 5) * 36 + (i2 & 31)] = rope[i2];
    if (c.tid < 128) qkL[c.tid] = qkg[c.tid];
    __syncthreads();
    for (int unit = blockIdx.x; unit < NB * 34 * 8; unit += gridDim.x) {
        const int hh = unit & 7, bc = unit >> 3, b = bc / 34, cch = bc - b * 34, row0 = b * RB + cch * 128, bh = b * 8 + hh;
        const bool latent = cch >= 2;
        const size_t row = (size_t)(row0 + r);
        const int tpos = cch * 128 + r - CL;
        const LAS float* cs = ropeL + (half == 0 ? (tpos >> 6) : (tpos & 63)) * 36;
        const float lgf = -expf(c.in[IN_RETRATE][(i * 2 + 0) * 8 + hh]) * 1.4426950408889634f, lgb = -expf(c.in[IN_RETRATE][(i * 2 + 1) * 8 + hh]) * 1.4426950408889634f;
        __syncthreads();
        float v[32];
        post_cvt(ra, v);
        if (grp) {
#pragma unroll
            for (int d = 0; d < 32; ++d) v[d] *= 0.125f; }
        if (latent) post_rope_l(v, cs);
        post_st32((grp ? RK : RQ) + row * 512 + hh * 64 + 32 * half, v, 1.0f);
        if (grp) { const float wf = exp2f(lgf * (float)(127 - r)), wb = exp2f(lgb * (float)r);
#pragma unroll
            for (int d = 0; d < 32; d += 2) { const unsigned pf = pg8::cvt_pk_bf16(v[d] * wf, v[d + 1] * wf), pb = pg8::cvt_pk_bf16(v[d] * wb, v[d + 1] * wb);
                *(LAS unsigned short*)(lds + KTF + (32 * half + d) * 272 + r * 2) = (unsigned short)(pf & 0xffffu); *(LAS unsigned short*)(lds + KTF + (32 * half + d + 1) * 272 + r * 2) = (unsigned short)(pf >> 16);
                *(LAS unsigned short*)(lds + KTB + (32 * half + d) * 272 + r * 2) = (unsigned short)(pb & 0xffffu); *(LAS unsigned short*)(lds + KTB + (32 * half + d + 1) * 272 + r * 2) = (unsigned short)(pb >> 16); } }
        post_cvt(rb, v);
        if (grp == 0) {
#pragma unroll
            for (int d = 0; d < 32; d += 2) { const unsigned pv = pg8::cvt_pk_bf16(v[d], v[d + 1]);
                *(LAS unsigned short*)(lds + VTS + (32 * half + d) * 272 + r * 2) = (unsigned short)(pv & 0xffffu); *(LAS unsigned short*)(lds + VTS + (32 * half + d + 1) * 272 + r * 2) = (unsigned short)(pv >> 16); }
        } else {
            float ss = 0.f;
#pragma unroll
            for (int d = 0; d < 32; ++d) ss += v[d] * v[d];
            ss += __shfl_xor(ss, 1);
            const float rs = rsqrtf(ss * (1.0f / 64.0f) + EPS);
#pragma unroll
            for (int d = 0; d < 32; ++d) v[d] = v[d] * rs * qkL[32 * half + d];
            if (latent) post_rope_l(v, cs);
            post_st32(QA + row * 512 + hh * 64 + 32 * half, v, attn_body::C2);
        }
        if (hh < 2 && grp == 0) {
            post_cvt(rc, v);
            {
                float ss = 0.f;
#pragma unroll
                for (int d = 0; d < 32; ++d) ss += v[d] * v[d];
                ss += __shfl_xor(ss, 1);
                const float rs = rsqrtf(ss * (1.0f / 64.0f) + EPS);
#pragma unroll
                for (int d = 0; d < 32; ++d) v[d] = v[d] * rs * qkL[64 + 32 * half + d];
                if (latent) post_rope_l(v, cs);
                post_st32(KA + row * 128 + hh * 64 + 32 * half, v, 1.0f);
            }
        }
        if (unit + (int)gridDim.x < NB * 34 * 8) PP_LOAD(unit + (int)gridDim.x);
        __syncthreads();
        { const int dir = c.wave >> 2, dvt = c.wave & 3;
            bf16x8 af[4];
#pragma unroll
            for (int u = 0; u < 4; ++u) af[u] = *(const LAS bf16x8*)(lds + VTS + (16 * dvt + li) * 272 + (32 * u + 8 * q4) * 2);
            float* uo = U + ((size_t)(bh * 34 + cch) * 2 + dir) * 4096;
#pragma unroll
            for (int dkt = 0; dkt < 4; ++dkt) {
                f32x4 a = {0.f, 0.f, 0.f, 0.f};
#pragma unroll
                for (int u = 0; u < 4; ++u) { const bf16x8 kf = *(const LAS bf16x8*)(lds + (dir ? KTB : KTF) + (16 * dkt + li) * 272 + (32 * u + 8 * q4) * 2); a = __builtin_amdgcn_mfma_f32_16x16x32_bf16(af[u], kf, a, 0, 0, 0); }
#pragma unroll
                for (int rr = 0; rr < 4; ++rr) uo[(16 * dvt + 4 * q4 + rr) * 64 + 16 * dkt + li] = a[rr];
            } }
    }
}

#undef PP_LOAD
__device__ __forceinline__ void phase_ret_prefix(const Ctx& c, int i) {
    const float* U = (const float*)(c.ws + WS_U); unsigned short* ET = (unsigned short*)(c.ws + WS_ET);
    for (int chain = c.gt; chain < 64 * 2 * 1024; chain += c.ngt) {
        const int bh = chain >> 11, dir = (chain >> 10) & 1, el = 4 * (chain & 1023), hh = bh & 7;
        const float g128 = expf(-expf(c.in[IN_RETRATE][(i * 2 + dir) * 8 + hh]) * 128.0f);
        f32x4 S = {0.f, 0.f, 0.f, 0.f};
#pragma unroll
        for (int st = 0; st < 34; ++st) {
            const int cch = dir == 0 ? st : (st < 2 ? 1 - st : 35 - st);
            const size_t o = ((size_t)(bh * 34 + cch) * 2 + dir) * 4096 + el;
            *(pg8::u32x2*)(ET + o) = pg8::f32_to_bf4(S);
            S = S * g128 + *(const f32x4*)(U + o);
        }
    }
}
__device__ __forceinline__ void phase_ret_main(const Ctx& c, int i, LAS unsigned char* lds) {
    typedef pg8::bf16x8 bf16x8;
    const unsigned short* RQ = (const unsigned short*)(c.ws + WS_RQ); const unsigned short* RK = (const unsigned short*)(c.ws + WS_RK); const unsigned short* RV = (const unsigned short*)(c.ws + WS_RV);
    const unsigned short* ET = (const unsigned short*)(c.ws + WS_ET); const unsigned short* P = (const unsigned short*)(c.ws + WS_P); unsigned short* MIX = (unsigned short*)(c.ws + WS_MIX);
    const float* gn = c.in[IN_RETGN] + (size_t)i * 512;
    constexpr int QS = 0, KS = 18432, VTS = 36864, EF = 54272, EB = 63488;
    const int li = c.lane & 15, q4 = c.lane >> 4, i0 = 16 * c.wave, ig = i0 + li;
    pg8::u32x4 gq[2], gk[2], gv[2], gef, geb;
#define RM_LOAD(u_) do { const int bh_ = (u_) / 34, cch_ = (u_) - bh_ * 34, row0_ = (bh_ >> 3) * RB + cch_ * 128, hh_ = bh_ & 7; \
        _Pragma("unroll") for (int t2 = 0; t2 < 2; ++t2) { const int pc = c.tid + 512 * t2, r = pc >> 3, ch = pc & 7; const size_t go = (size_t)(row0_ + r) * 512 + hh_ * 64 + ch * 8; \
            gq[t2] = *(const pg8::u32x4*)(RQ + go); gk[t2] = *(const pg8::u32x4*)(RK + go); gv[t2] = *(const pg8::u32x4*)(P + (size_t)(row0_ + r) * INW + 1024 + hh_ * 64 + ch * 8); } \
        { const int r = c.tid >> 3, ch = c.tid & 7; const size_t go = ((size_t)(bh_ * 34 + cch_) * 2) * 4096 + r * 64 + ch * 8; gef = *(const pg8::u32x4*)(ET + go); geb = *(const pg8::u32x4*)(ET + go + 4096); } } while (0)
    if ((int)blockIdx.x < 64 * 34) RM_LOAD((int)blockIdx.x);
    for (int unit = blockIdx.x; unit < 64 * 34; unit += gridDim.x) {
        const int bh = unit / 34, cch = unit - bh * 34, b = bh >> 3, hh = bh & 7, row0 = b * RB + cch * 128;
        const float lgf = -expf(c.in[IN_RETRATE][(i * 2 + 0) * 8 + hh]) * 1.4426950408889634f, lgb = -expf(c.in[IN_RETRATE][(i * 2 + 1) * 8 + hh]) * 1.4426950408889634f;
        __syncthreads();
#pragma unroll
        for (int t2 = 0; t2 < 2; ++t2) { const int pc = c.tid + 512 * t2, r = pc >> 3, ch = pc & 7;
            *(LAS pg8::u32x4*)(lds + QS + r * 144 + ch * 16) = gq[t2];
            *(LAS pg8::u32x4*)(lds + KS + r * 144 + ch * 16) = gk[t2];
            const pg8::u32x4 vw = gv[t2];
#pragma unroll
            for (int e = 0; e < 4; ++e) { *(LAS unsigned short*)(lds + VTS + (ch * 8 + 2 * e) * 272 + r * 2) = (unsigned short)(vw[e] & 0xffffu); *(LAS unsigned short*)(lds + VTS + (ch * 8 + 2 * e + 1) * 272 + r * 2) = (unsigned short)(vw[e] >> 16); } }
        { const int r = c.tid >> 3, ch = c.tid & 7; *(LAS pg8::u32x4*)(lds + EF + r * 144 + ch * 16) = gef; *(LAS pg8::u32x4*)(lds + EB + r * 144 + ch * 16) = geb; }
        if (unit + (int)gridDim.x < 64 * 34) RM_LOAD(unit + (int)gridDim.x);
        __syncthreads();
        bf16x8 qf[2];
#pragma unroll
        for (int s = 0; s < 2; ++s) qf[s] = *(const LAS bf16x8*)(lds + QS + (i0 + li) * 144 + (32 * s + 8 * q4) * 2);
        pg8::u32x2 pk[8];
#pragma unroll
        for (int jt = 0; jt < 8; ++jt) {
            f32x4 a = {0.f, 0.f, 0.f, 0.f};
#pragma unroll
            for (int s = 0; s < 2; ++s) { const bf16x8 kf = *(const LAS bf16x8*)(lds + KS + (16 * jt + li) * 144 + (32 * s + 8 * q4) * 2); a = __builtin_amdgcn_mfma_f32_16x16x32_bf16(kf, qf[s], a, 0, 0, 0); }
            float pv[4];
#pragma unroll
            for (int r = 0; r < 4; ++r) { const int dl = ig - (16 * jt + 4 * q4 + r); const float w = dl >= 0 ? exp2f(lgf * (float)dl) : exp2f(lgb * (float)(-dl)); pv[r] = a[r] * w; }
            pk[jt] = (pg8::u32x2){pg8::cvt_pk_bf16(pv[0], pv[1]), pg8::cvt_pk_bf16(pv[2], pv[3])};
        }
        const float sf = exp2f(lgf * (float)(ig + 1)), sb = exp2f(lgb * (float)(128 - ig));
        f32x4 oacc[4];
#pragma unroll
        for (int dvt = 0; dvt < 4; ++dvt) {
            f32x4 o = {0.f, 0.f, 0.f, 0.f};
#pragma unroll
            for (int u = 0; u < 4; ++u) {
                const pg8::u32x2 vlo = *(const LAS pg8::u32x2*)(lds + VTS + (16 * dvt + li) * 272 + (32 * u + 4 * q4) * 2), vhi = *(const LAS pg8::u32x2*)(lds + VTS + (16 * dvt + li) * 272 + (32 * u + 16 + 4 * q4) * 2);
                const pg8::u32x4 av = {vlo.x, vlo.y, vhi.x, vhi.y}, bv = {pk[2 * u].x, pk[2 * u].y, pk[2 * u + 1].x, pk[2 * u + 1].y};
                o = __builtin_amdgcn_mfma_f32_16x16x32_bf16(__builtin_bit_cast(bf16x8, av), __builtin_bit_cast(bf16x8, bv), o, 0, 0, 0);
            }
            f32x4 tf = {0.f, 0.f, 0.f, 0.f}, tb = {0.f, 0.f, 0.f, 0.f};
#pragma unroll
            for (int s = 0; s < 2; ++s) {
                const bf16x8 ef = *(const LAS bf16x8*)(lds + EF + (16 * dvt + li) * 144 + (32 * s + 8 * q4) * 2), eb = *(const LAS bf16x8*)(lds + EB + (16 * dvt + li) * 144 + (32 * s + 8 * q4) * 2);
                tf = __builtin_amdgcn_mfma_f32_16x16x32_bf16(ef, qf[s], tf, 0, 0, 0); tb = __builtin_amdgcn_mfma_f32_16x16x32_bf16(eb, qf[s], tb, 0, 0, 0);
            }
            oacc[dvt] = o + tf * sf + tb * sb;
        }
        float sm = 0.f;
#pragma unroll
        for (int dvt = 0; dvt < 4; ++dvt) sm += (oacc[dvt].x + oacc[dvt].y) + (oacc[dvt].z + oacc[dvt].w);
        sm += __shfl_xor(sm, 16); sm += __shfl_xor(sm, 32);
        const float mu = sm * (1.0f / 64.0f); float vr = 0.f;
#pragma unroll
        for (int dvt = 0; dvt < 4; ++dvt) { oacc[dvt] = oacc[dvt] - mu; vr += (oacc[dvt].x * oacc[dvt].x + oacc[dvt].y * oacc[dvt].y) + (oacc[dvt].z * oacc[dvt].z + oacc[dvt].w * oacc[dvt].w); }
        vr += __shfl_xor(vr, 16); vr += __shfl_xor(vr, 32);
        const float rs = rsqrtf(vr * (1.0f / 64.0f) + EPS);
        const size_t row = (size_t)(row0 + ig);
#pragma unroll
        for (int dvt = 0; dvt < 4; ++dvt) { const int dvc = hh * 64 + 16 * dvt + 4 * q4;
            const pg8::u32x2 gw = *(const pg8::u32x2*)(P + row * INW + 1536 + dvc); const f32x4 gt = {__uint_as_float(gw.x << 16), __uint_as_float(gw.x & 0xffff0000u), __uint_as_float(gw.y << 16), __uint_as_float(gw.y & 0xffff0000u)}, gg = *(const f32x4*)(gn + dvc); const f32x4 y = oacc[dvt] * rs * gg;
            *(pg8::u32x2*)(MIX + row * D + dvc) = (pg8::u32x2){pg8::cvt_pk_bf16(gt.x * pg8::fast_sigmoid(gt.x) * y.x, gt.y * pg8::fast_sigmoid(gt.y) * y.y), pg8::cvt_pk_bf16(gt.z * pg8::fast_sigmoid(gt.z) * y.z, gt.w * pg8::fast_sigmoid(gt.w) * y.w)}; }
    }
}

#undef RM_LOAD
__device__ __forceinline__ void phase_attention(const Ctx& c, int i, char* lds) {
    const attn_body::bf16* QA = (const attn_body::bf16*)(c.ws + WS_QA); const attn_body::bf16* KA = (const attn_body::bf16*)(c.ws + WS_KA); const attn_body::bf16* VA = (const attn_body::bf16*)(c.ws + WS_P) + 2688;
    attn_body::bf16* MIX = (attn_body::bf16*)(c.ws + WS_MIX);
    const int G = gridDim.x, bx = blockIdx.x, vcu = (G % 8 == 0) ? (bx % 8) * (G / 8) + bx / 8 : bx;
    float gq = fabsf(c.in[IN_QKG][(size_t)i * 128 + c.lane]), gk = fabsf(c.in[IN_QKG][(size_t)i * 128 + 64 + c.lane]);
#pragma unroll
    for (int o = 1; o < 64; o <<= 1) { gq = fmaxf(gq, __shfl_xor(gq, o)); gk = fmaxf(gk, __shfl_xor(gk, o)); }
    const bool bounded = __builtin_amdgcn_readfirstlane(64.0f * gq * gk * attn_body::C2 < 40.0f ? 1 : 0) != 0;
    for (int U = vcu; U < NB * 8 * 17; U += G) {
        int bh, qrow0, NT;
        if (U < NB * 8 * 16) { bh = U >> 4; qrow0 = (bh >> 3) * RB + CL + (U & 15) * 256; NT = RB / 64; }
        else { bh = U - NB * 8 * 16; qrow0 = (bh >> 3) * RB; NT = CL / 64; }
        const int b = bh >> 3, hh = bh & 7;
        if (bounded) attn_body::attn_unit<8, true>(QA + (size_t)qrow0 * 512 + hh * 64, KA + (size_t)(b * RB) * 128 + (hh >> 2) * 64, VA + (size_t)(b * RB) * INW + (hh >> 2) * 64,
                                MIX + (size_t)qrow0 * 1024 + 512 + hh * 64, NT, lds, c.wave);
        else attn_body::attn_unit<8, false>(QA + (size_t)qrow0 * 512 + hh * 64, KA + (size_t)(b * RB) * 128 + (hh >> 2) * 64, VA + (size_t)(b * RB) * INW + (hh >> 2) * 64,
                                MIX + (size_t)qrow0 * 1024 + 512 + hh * 64, NT, lds, c.wave);
    }
}

__device__ __forceinline__ void phase_s5_ops(const Ctx& c, LAS float* ldsf) {
    LAS float* Pre = ldsf; LAS float* Pim = ldsf + 4608; LAS float* KZr = ldsf + 9216; LAS float* KZi = ldsf + 9344;
    LAS float* Bre = ldsf + 9472; LAS float* Bim = ldsf + 10496; LAS float* Cre = ldsf + 11520; LAS float* Cim = ldsf + 13568;
    LAS float* KV = ldsf + 15616;
#define S5P(dir, pw, p) (((dir) * 64 + (p)) * 36 + (pw))
    for (int task = c.vb; task < 2 * 64 * 2; task += c.vg) {
        const int i = task >> 7, g = (task >> 1) & 63, hf = task & 1;
        __syncthreads();
        if (c.tid < 128) {
            const int dir = c.tid >> 6, p = c.tid & 63;
            const float a_re = c.in[IN_S5ARE][((i * 2 + dir) * 64 + g) * 64 + p], a_im = c.in[IN_S5AIM][((i * 2 + dir) * 64 + g) * 64 + p];
            const float dt = expf(c.in[IN_S5DT][(i * 2 + dir) * 64 + g]);
            const float lre = fminf(a_re, -1e-4f), lim = a_im, ea = lre * dt, eb = lim * dt;
            const float cb = cosf(eb), sb = sinf(eb), sh = sinf(0.5f * eb), mag = expf(ea);
            { float pr = 1.0f, pi = 0.0f; const float ar = mag * cb, ai = mag * sb;
                for (int dl = 0; dl <= 32; ++dl) { Pre[S5P(dir, dl, p)] = pr; Pim[S5P(dir, dl, p)] = pi; const float nr_ = pr * ar - pi * ai, ni_ = pr * ai + pi * ar; pr = nr_; pi = ni_; } }
            const float nr = expm1f(ea) * cb - 2.0f * sh * sh, ni = mag * sb, den = lre * lre + lim * lim;
            KZr[dir * 64 + p] = (nr * lre + ni * lim) / den; KZi[dir * 64 + p] = (ni * lre - nr * lim) / den;
        }
        for (int idx = c.tid; idx < 1024; idx += 512) { Bre[idx] = c.in[IN_S5BRE][(size_t)(i * 64 + g) * 1024 + idx]; Bim[idx] = c.in[IN_S5BIM][(size_t)(i * 64 + g) * 1024 + idx]; }
        for (int idx = c.tid; idx < 2048; idx += 512) { const int dir = idx >> 10, rem = idx & 1023;
            Cre[idx] = c.in[IN_S5CRE][((size_t)(i * 2 + dir) * 64 + g) * 1024 + rem]; Cim[idx] = c.in[IN_S5CIM][((size_t)(i * 2 + dir) * 64 + g) * 1024 + rem]; }
        __syncthreads();
        {
            const int dir = c.tid >> 8, ko = (c.tid >> 4) & 15, ki = c.tid & 15;
            float acc[32];
#pragma unroll
            for (int dl = 0; dl < 32; ++dl) acc[dl] = 0.f;
            for (int p = 0; p < 64; ++p) {
                const float kr = KZr[dir * 64 + p], kq = KZi[dir * 64 + p], br = Bre[p * 16 + ki], bi = Bim[p * 16 + ki], cr = Cre[(dir * 16 + ko) * 64 + p], ci = Cim[(dir * 16 + ko) * 64 + p];
                const float gr = kr * br - kq * bi, gi = kr * bi + kq * br, tr = cr * gr - ci * gi, ti = cr * gi + ci * gr;
#pragma unroll
                for (int d4 = 0; d4 < 8; ++d4) { const f32x4 pr = *(const LAS f32x4*)(Pre + S5P(dir, 4 * d4, p)), pi = *(const LAS f32x4*)(Pim + S5P(dir, 4 * d4, p));
                    acc[4 * d4] += tr * pr.x - ti * pi.x; acc[4 * d4 + 1] += tr * pr.y - ti * pi.y; acc[4 * d4 + 2] += tr * pr.z - ti * pi.z; acc[4 * d4 + 3] += tr * pr.w - ti * pi.w; }
            }
#pragma unroll
            for (int dl = 0; dl < 32; ++dl) KV[((dir * 32 + dl) * 16 + ko) * 16 + ki] = acc[dl];
        }
        __syncthreads();
        unsigned* TV = (unsigned*)(c.ws + WS_TV) + ((size_t)(i * 64 + g) * 512 * 768) / 2;
        const float* dsk = c.in[IN_S5D] + (size_t)i * D + 16 * g;
        if (c.tid < 384) {
            const int kp = c.tid, kk = 2 * kp;
            if (kk < 512) {
                const int j = kk >> 4, ki = kk & 15;
                for (int it = 16 * hf; it < 16 * hf + 16; ++it) {
                    const int dl = it > j ? it - j : j - it, dir = it > j ? 0 : 1;
                    for (int ko = 0; ko < 16; ++ko) {
                        float v0, v1;
                        if (it != j) { v0 = KV[((dir * 32 + dl) * 16 + ko) * 16 + ki]; v1 = KV[((dir * 32 + dl) * 16 + ko) * 16 + ki + 1]; }
                        else { v0 = KV[(ko) * 16 + ki] + KV[((32) * 16 + ko) * 16 + ki] + (ko == ki ? dsk[ko] : 0.f); v1 = KV[(ko) * 16 + ki + 1] + KV[((32) * 16 + ko) * 16 + ki + 1] + (ko == ki + 1 ? dsk[ko] : 0.f); }
                        TV[(size_t)(it * 16 + ko) * 384 + kp] = pg8::cvt_pk_bf16(v0, v1);
                    }
                }
            } else {
                const int q = kk - 512, dir = q >> 7, part = (q >> 6) & 1, p = q & 63;
                for (int it = 16 * hf; it < 16 * hf + 16; ++it) {
                    const int pw = dir == 0 ? it + 1 : 32 - it;
                    const float pr0 = Pre[S5P(dir, pw, p)], pi0 = Pim[S5P(dir, pw, p)], pr1 = Pre[S5P(dir, pw, p + 1)], pi1 = Pim[S5P(dir, pw, p + 1)];
                    for (int ko = 0; ko < 16; ++ko) {
                        const float cr0 = Cre[(dir * 16 + ko) * 64 + p], ci0 = Cim[(dir * 16 + ko) * 64 + p], cr1 = Cre[(dir * 16 + ko) * 64 + p + 1], ci1 = Cim[(dir * 16 + ko) * 64 + p + 1];
                        const float v0 = part == 0 ? (cr0 * pr0 - ci0 * pi0) : -(cr0 * pi0 + ci0 * pr0), v1 = part == 0 ? (cr1 * pr1 - ci1 * pi1) : -(cr1 * pi1 + ci1 * pr1);
                        TV[(size_t)(it * 16 + ko) * 384 + kp] = pg8::cvt_pk_bf16(v0, v1);
                    }
                }
            }
        }
        unsigned* WS5 = (unsigned*)(c.ws + WS_WS5) + ((size_t)(i * 64 + g) * 256 * 512) / 2;
        if (c.tid < 256) {
            const int kp = c.tid, kk = 2 * kp, j = kk >> 4, ki = kk & 15, dir = hf, pw = dir == 0 ? 31 - j : j;
            for (int pp = 0; pp < 128; ++pp) {
                const int part = pp >> 6, p = pp & 63;
                const float pr = Pre[S5P(dir, pw, p)], pi = Pim[S5P(dir, pw, p)], kr = KZr[dir * 64 + p], kq = KZi[dir * 64 + p];
                const float gr = pr * kr - pi * kq, gi = pr * kq + pi * kr, br0 = Bre[p * 16 + ki], bi0 = Bim[p * 16 + ki], br1 = Bre[p * 16 + ki + 1], bi1 = Bim[p * 16 + ki + 1];
                const float v0 = part == 0 ? (gr * br0 - gi * bi0) : (gr * bi0 + gi * br0), v1 = part == 0 ? (gr * br1 - gi * bi1) : (gr * bi1 + gi * br1);
                WS5[(size_t)(128 * hf + pp) * 256 + kp] = pg8::cvt_pk_bf16(v0, v1);
            }
        }
    }
#undef S5P
}
__device__ __forceinline__ void phase_s5_carry(const Ctx& c, int i) {
    const unsigned short* SL = (const unsigned short*)(c.ws + WS_SL); unsigned short* AS5 = (unsigned short*)(c.ws + WS_AS5);
    for (int id = c.gt; id < 64 * 8 * 2 * 64; id += c.ngt) {
        const int p = id & 63, dir = (id >> 6) & 1, b = (id >> 7) & 7, g = id >> 10;
        const float a_re = c.in[IN_S5ARE][((i * 2 + dir) * 64 + g) * 64 + p], a_im = c.in[IN_S5AIM][((i * 2 + dir) * 64 + g) * 64 + p];
        const float dt = expf(c.in[IN_S5DT][(i * 2 + dir) * 64 + g]);
        const float lre = fminf(a_re, -1e-4f), m32 = expf(lre * dt * 32.0f), an = a_im * dt * 32.0f, ar = m32 * cosf(an), ai = m32 * sinf(an);
        float xr = 0.f, xi = 0.f;
        for (int s0 = 0; s0 < 136; s0 += 17) {
            float sr[17], si[17]; size_t rr[17];
#pragma unroll
            for (int k = 0; k < 17; ++k) { const int st = s0 + k, cch = dir == 0 ? st : (st < 8 ? 7 - st : 143 - st);
                rr[k] = (size_t)g * 1280 + b * 136 + cch; sr[k] = __uint_as_float((unsigned)SL[rr[k] * 256 + dir * 128 + p] << 16); si[k] = __uint_as_float((unsigned)SL[rr[k] * 256 + dir * 128 + 64 + p] << 16); }
#pragma unroll
            for (int k = 0; k < 17; ++k) {
                unsigned short* xo = AS5 + rr[k] * 768 + 512 + dir * 128 + p;
                xo[0] = (unsigned short)(pg8::cvt_pk_bf16(xr, 0.f) & 0xffffu); xo[64] = (unsigned short)(pg8::cvt_pk_bf16(xi, 0.f) & 0xffffu);
                const float nxr = ar * xr - ai * xi + sr[k], nxi = ar * xi + ai * xr + si[k];
                xr = nxr; xi = nxi;
            }
        }
    }
}

__device__ __forceinline__ void cvt_item(const float* W, int ldw, int k0, int scol0, unsigned short* WT, int K, int drow0, LAS float* scr, int lane) {
    float wv[32];
#pragma unroll
    for (int i = 0; i < 32; ++i) wv[i] = W[(size_t)(k0 + 2 * i + (lane >> 5)) * ldw + scol0 + (lane & 31)];
#pragma unroll
    for (int i = 0; i < 32; ++i) scr[(2 * i + (lane >> 5)) * 33 + (lane & 31)] = wv[i];
    asm volatile("s_waitcnt lgkmcnt(0)" ::: "memory");
    const int cc = lane & 7;
#pragma unroll
    for (int j = 0; j < 4; ++j) { const int n = (lane >> 3) + 8 * j; const LAS float* s = scr + (8 * cc) * 33 + n;
        pg8::u32x4 o; o.x = pg8::cvt_pk_bf16(s[0 * 33], s[1 * 33]); o.y = pg8::cvt_pk_bf16(s[2 * 33], s[3 * 33]); o.z = pg8::cvt_pk_bf16(s[4 * 33], s[5 * 33]); o.w = pg8::cvt_pk_bf16(s[6 * 33], s[7 * 33]);
        *(pg8::u32x4*)(WT + (size_t)(drow0 + n) * K + k0 + 8 * cc) = o; }
    asm volatile("s_waitcnt lgkmcnt(0)" ::: "memory");
}
__device__ __forceinline__ void cvt_item8(const float* W, int ldw, int k0, int scol0, unsigned char* WT, int K, int drow0, LAS float* scr, int lane) {
    float wv[32];
#pragma unroll
    for (int i = 0; i < 32; ++i) wv[i] = W[(size_t)(k0 + 2 * i + (lane >> 5)) * ldw + scol0 + (lane & 31)];
#pragma unroll
    for (int i = 0; i < 32; ++i) scr[(2 * i + (lane >> 5)) * 33 + (lane & 31)] = wv[i] * pg8::W8_SCALE;
    asm volatile("s_waitcnt lgkmcnt(0)" ::: "memory");
    const int n = lane >> 1, kh = lane & 1; const LAS float* s = scr + (32 * kh) * 33 + n;
    unsigned w[8];
#pragma unroll
    for (int j = 0; j < 8; ++j) w[j] = pg8::pk4_fp8(s[(4 * j) * 33], s[(4 * j + 1) * 33], s[(4 * j + 2) * 33], s[(4 * j + 3) * 33]);
    unsigned char* o = WT + (size_t)(drow0 + n) * K + k0 + 32 * kh;
    *(pg8::u32x4*)o = (pg8::u32x4){w[0], w[1], w[2], w[3]}; *(pg8::u32x4*)(o + 16) = (pg8::u32x4){w[4], w[5], w[6], w[7]};
    asm volatile("s_waitcnt lgkmcnt(0)" ::: "memory");
}
__device__ __forceinline__ void cvt_moe_tile(const Ctx& c, LAS unsigned char* img, int id) {
    unsigned char* W13 = (unsigned char*)(c.ws + WS_W13); unsigned char* W2T = (unsigned char*)(c.ws + WS_W2);
    const int le = id / 192; int r = id - le * 192;
    const float* sp; int ldw, K; unsigned char* dst; int rowl;
    if (r < 128) { const int kt = r >> 4, pn = r & 15, half = c.lane >> 5, n4 = c.lane & 31;
        sp = (half ? c.in[IN_W3] : c.in[IN_W1]) + (size_t)le * D * FF + (size_t)(128 * kt + 16 * c.wave) * FF + 128 * pn + 4 * n4; ldw = FF; K = D;
        dst = W13 + (size_t)le * 4096 * D + (size_t)(256 * pn) * D + 128 * kt; rowl = 128 * half + 4 * n4;
    } else { r -= 128; const int kt = r >> 2, pn = r & 3;
        sp = c.in[IN_W2] + (size_t)le * FF * D + (size_t)(128 * kt + 16 * c.wave) * D + 256 * pn + 4 * c.lane; ldw = D; K = FF;
        dst = W2T + (size_t)le * D * FF + (size_t)(256 * pn) * FF + 128 * kt; rowl = 4 * c.lane; }
    f32x4 v[16];
#pragma unroll
    for (int q = 0; q < 16; ++q) v[q] = __builtin_nontemporal_load((const f32x4*)(sp + (size_t)q * ldw));
    __syncthreads();
#pragma unroll
    for (int j = 0; j < 4; ++j) {
        pg8::u32x4 w;
#pragma unroll
        for (int q4 = 0; q4 < 4; ++q4) w[q4] = pg8::pk4_fp8(v[4 * q4][j] * pg8::W8_SCALE, v[4 * q4 + 1][j] * pg8::W8_SCALE, v[4 * q4 + 2][j] * pg8::W8_SCALE, v[4 * q4 + 3][j] * pg8::W8_SCALE);
        const int row = rowl + j;
        *(LAS pg8::u32x4*)(img + row * 128 + ((c.wave ^ ((row >> 2) & 7)) * 16)) = w;
    }
    __syncthreads();
#pragma unroll
    for (int i4 = 0; i4 < 4; ++i4) { const int p = c.tid + 512 * i4, row = p >> 3, ch = p & 7;
        *(pg8::u32x4*)(dst + (size_t)row * K + 16 * ch) = *(const LAS pg8::u32x4*)(img + row * 128 + ((ch ^ ((row >> 2) & 7)) * 16)); }
}
constexpr int HS_N = 14, HS_L0 = 2304, HS_L3 = 3072;
enum { HK_OUT = 0, HK_TOPK, HK_GEMM2, HK_S1, HK_S3, HK_GLU };
__device__ __forceinline__ constexpr int host_gs(int L, int kind) {
    return L == 0 ? (kind == HK_OUT ? 0 : kind == HK_TOPK ? 1 : kind == HK_GEMM2 ? 2 : -1)
         : L == 1 ? (kind == HK_S1 ? 3 : kind == HK_S3 ? 4 : kind == HK_GLU ? 5 : kind == HK_TOPK ? 6 : kind == HK_GEMM2 ? 7 : -1)
         : L == 2 ? (kind == HK_OUT ? 8 : kind == HK_TOPK ? 9 : kind == HK_GEMM2 ? 10 : -1)
         : (kind == HK_S1 ? 11 : kind == HK_S3 ? 12 : kind == HK_TOPK ? 13 : -1);
}
__device__ __forceinline__ void host_slot(int gs, int& rem, int& quota) {
    constexpr int REM[HS_N] = {32, 128, 64, 64, 128, 64, 128, 64, 32, 128, 64, 64, 128, 128}, Q[HS_N] = {8, 4, 6, 3, 5, 3, 4, 5, 8, 4, 6, 3, 5, 4};
    rem = 0; quota = 0;
#pragma unroll
    for (int i = 0; i < HS_N; ++i) if (i == gs) { rem = REM[i]; quota = Q[i]; }
}
__device__ __forceinline__ int host_tile_id(int u) {
    if (u < HS_L0) return u;
    u -= HS_L0; if (u < 3072) return 3072 + u;
    u -= 3072; if (u < 3072) return 2 * 3072 + u;
    u -= 3072; if (u < HS_L3) return 3 * 3072 + u;
    return -1;
}
__device__ __forceinline__ void hosted_cvt(const Ctx& c, LAS unsigned char* img, int L, int kind) {
    if (gridDim.x != 256) return;
    const int gs = host_gs(L, kind);
    if (gs < 0) return;
    int off = 0;
    for (int s = 0; s < gs; ++s) { int r0, q0; host_slot(s, r0, q0); off += (256 - r0) * q0; }
    int rem, q; host_slot(gs, rem, q);
    if ((int)blockIdx.x < rem) return;
    const int idle = 256 - rem, rank = (int)blockIdx.x - rem;
    for (int k = 0; k < q; ++k) { const int id = host_tile_id(off + rank + k * idle); if (id >= 0) cvt_moe_tile(c, img, id); }
    __syncthreads();
}
__device__ __forceinline__ void phase_cvt_moe(const Ctx& c, LAS float* ldsf) {
    LAS unsigned char* img = (LAS unsigned char*)ldsf;
    const int G = gridDim.x;
    if (G == 256) {
        const int n0 = 3072 - HS_L0, n3 = 3072 - HS_L3;
        for (int j = c.vb; j < n0 + n3; j += c.vg) cvt_moe_tile(c, img, j < n0 ? HS_L0 + j : 3 * 3072 + HS_L3 + (j - n0));
    } else {
        for (int j = c.vb; j < DEPTH * 3072; j += c.vg) cvt_moe_tile(c, img, j);
    }
    __syncthreads();
    LAS float* scr = ldsf + c.wave * (64 * 33);
    unsigned short* WIN = (unsigned short*)(c.ws + WS_WIN); unsigned short* WOUT = (unsigned short*)(c.ws + WS_WOUT); unsigned short* WGLU = (unsigned short*)(c.ws + WS_WGLU);
    for (int id = c.gw; id < 2 * (1408 + 512 + 1024); id += c.ngw) {
        const int i = id / 2944; int r = id - i * 2944;
        if (r < 1408) { const int kb = r / 88, nb = r - kb * 88; cvt_item(c.in[IN_MIXIN] + (size_t)i * D * INW, INW, 64 * kb, 32 * nb, WIN + (size_t)i * INW * D, D, 32 * nb, scr, c.lane); }
        else if (r < 1920) { r -= 1408; const int kb = r >> 5, nb = r & 31; cvt_item(c.in[IN_MIXOUT] + (size_t)i * D * D, D, 64 * kb, 32 * nb, WOUT + (size_t)i * D * D, D, 32 * nb, scr, c.lane); }
        else { r -= 1920; const int kb = r >> 6, nb = r & 63, pn = nb >> 3, rr0 = (nb & 7) * 32;
            cvt_item8(c.in[IN_GLUW] + (size_t)i * D * 2048, 2048, 64 * kb, (rr0 < 128 ? 0 : 1024) + 128 * pn + (rr0 & 127), (unsigned char*)WGLU + (size_t)i * 2048 * D, D, 32 * nb, scr, c.lane); }
    }
}

__global__ void __launch_bounds__(512, 2) fwd(Args args) {
    extern __shared__ __attribute__((aligned(16))) unsigned char lds[];
    Ctx c; c.in = args.in; c.out = args.out; c.ws = args.ws;
    c.wave = __builtin_amdgcn_readfirstlane((int)threadIdx.x >> 6); c.lane = lane_id(); c.tid = c.wave * 64 + c.lane;
    c.gw = blockIdx.x * 8 + c.wave; c.ngw = gridDim.x * 8; c.gt = blockIdx.x * 512 + c.tid; c.ngt = gridDim.x * 512;
    LAS float* ldsf = (LAS float*)lds; LAS unsigned char* ldsb = (LAS unsigned char*)lds;
    volatile LAS unsigned* MISC = (volatile LAS unsigned*)((LAS unsigned char*)lds + MISC_OFF);
    if (c.tid < 32) MISC[c.tid] = 0u;
    __syncthreads();
    const int lo = args.ph_lo, hi = args.ph_hi;
    const bool one_launch = (hi - lo) > 1;
    XcdBarrier bar; bar.bar = (unsigned*)(c.ws + WS_CTL) + CW_BAR; bar.x = 0; bar.st = MISC + 8; bar.wave = c.wave;
    if (one_launch) bar = xcd_barrier_post((unsigned*)(c.ws + WS_CTL) + CW_BAR, MISC + 8);
#define IN(k) (lo <= (k) && (k) < hi)
#define SEAM(k) do { if ((k) + 1 < hi) xcd_barrier(bar); } while (0)
#define FRESH(cc) Ctx cc; unsigned zq; asm volatile("s_mov_b32 %0, 0" : "=s"(zq)); cc.ws = c.ws + zq; cc.out = c.out + zq; cc.in = (const float* const*)((const char*)c.in + zq); \
    { int lq = lane_id(); asm volatile("" : "+v"(lq)); cc.wave = c.wave + (int)zq; cc.lane = lq; cc.tid = cc.wave * 64 + lq; const int tq = cc.tid; cc.gw = blockIdx.x * 8 + cc.wave; cc.ngw = gridDim.x * 8; cc.gt = blockIdx.x * 512 + tq; cc.ngt = gridDim.x * 512; cc.vb = blockIdx.x; cc.vg = gridDim.x; } \
    const int Lq = L + (int)zq, iq = Lq >> 1; const float* MOD = (const float*)(cc.ws + WS_MOD); (void)MOD; (void)iq

    if (IN(PH_PRO)) { const int L = 0; FRESH(cc);
        if (blockIdx.x & 1) { phase_s5_ops(cc, ldsf); __syncthreads(); phase_pro(cc, ldsf); __syncthreads(); phase_cvt_moe(cc, ldsf); }
        else { phase_pro(cc, ldsf); __syncthreads(); phase_cvt_moe(cc, ldsf); __syncthreads(); phase_s5_ops(cc, ldsf); }
        SEAM(PH_PRO); }

#define LAYER_BODY(LL) { constexpr int L = LL; \
        const int pb = 1 + L * PH_PER_LAYER; \
        if (IN(pb + 0)) { FRESH(cc); if constexpr (L == 0) phase_norm1_first(cc); else phase_norm1<false, (L & 1) != 0>(cc, Lq); SEAM(pb + 0); } \
        if ((L & 1) == 0) { \
            if (IN(pb + 1)) { \
                FRESH(cc); \
                pg8::GOrder S; S.init(1, NROWS, INW, (int)gridDim.x, (int)blockIdx.x); \
                pg8::ADense al{(const pg8::bf16_t*)(cc.ws + WS_HB1), 0, nullptr, 0, D, 0, 64}; pg8::EpiBf16 ep{(pg8::bf16_t*)(cc.ws + WS_P), INW, 0}; \
                pg8::gemm_phase(ldsb, al, (const pg8::bf16_t*)(cc.ws + WS_WIN) + (size_t)iq * INW * D, 0, D, S, ep, cc.wave); SEAM(pb + 1); } \
            if (IN(pb + 2)) { FRESH(cc); phase_post(cc, iq, ldsb); SEAM(pb + 2); } \
            if (IN(pb + 4)) { FRESH(cc); phase_ret_prefix(cc, iq); \
                  \
                unsigned* cnt = (unsigned*)(cc.ws + WS_CTL) + CW_CNT + 64 * L; \
                asm volatile("s_waitcnt vmcnt(0)" ::: "memory"); __syncthreads(); \
                if (cc.tid == 0) { __builtin_amdgcn_fence(__ATOMIC_RELEASE, "agent"); asm volatile("s_waitcnt vmcnt(0)" ::: "memory"); (void)xb_add(cnt, 1u); } \
                phase_attention(cc, iq, (char*)lds); \
                if (cc.tid == 0) { unsigned* tb = (unsigned*)(cc.ws + WS_CTL) + CW_BAR; XB_SPIN(xb_ld(cnt) < gridDim.x, tb); __builtin_amdgcn_fence(__ATOMIC_ACQUIRE, "agent"); asm volatile("s_waitcnt vmcnt(0)" ::: "memory"); } \
                __syncthreads(); \
                phase_ret_main(cc, iq, ldsb); SEAM(pb + 4); } \
            if (IN(pb + 6)) { \
                FRESH(cc); \
                pg8::GOrder S; S.init(1, NROWS, D, (int)gridDim.x, (int)blockIdx.x); \
                pg8::ADense al{(const pg8::bf16_t*)(cc.ws + WS_MIX), 0, nullptr, 0, D, 0, 64}; pg8::EpiResid ep{(pg8::bf16_t*)(cc.ws + WS_X), MOD + (size_t)Lq * 9 * 6144}; \
                pg8::gemm_phase(ldsb, al, (const pg8::bf16_t*)(cc.ws + WS_WOUT) + (size_t)iq * D * D, 0, D, S, ep, cc.wave); hosted_cvt(cc, ldsb, L, HK_OUT); SEAM(pb + 6); } \
        } else { \
            if (IN(pb + 1)) { \
                FRESH(cc); \
                pg8::GOrder S; S.init(64, 1280, 256, (int)gridDim.x, (int)blockIdx.x); \
                pg8::ADense al{(const pg8::bf16_t*)(cc.ws + WS_AS5), (size_t)1280 * 768, nullptr, 0, 768, 0, 64}; pg8::EpiBf16 ep{(pg8::bf16_t*)(cc.ws + WS_SL), 256, (size_t)1280 * 256}; \
                pg8::gemm_phase(ldsb, al, (const pg8::bf16_t*)(cc.ws + WS_WS5) + (size_t)iq * 64 * 256 * 512, (size_t)256 * 512, 512, S, ep, cc.wave); hosted_cvt(cc, ldsb, L, HK_S1); SEAM(pb + 1); } \
            if (IN(pb + 2)) { FRESH(cc); phase_s5_carry(cc, iq); SEAM(pb + 2); } \
            if (IN(pb + 3)) { \
                FRESH(cc); \
                pg8::GOrder S; S.init(64, 1280, 512, (int)gridDim.x, (int)blockIdx.x); \
                pg8::ADense al{(const pg8::bf16_t*)(cc.ws + WS_AS5), (size_t)1280 * 768, nullptr, 0, 768, 0, 64}; pg8::EpiGeluFp8 ep{(unsigned char*)(cc.ws + WS_ZG), 512, (size_t)1280 * 512}; \
                pg8::gemm_phase(ldsb, al, (const pg8::bf16_t*)(cc.ws + WS_TV) + (size_t)iq * 64 * 512 * 768, (size_t)512 * 768, 768, S, ep, cc.wave); hosted_cvt(cc, ldsb, L, HK_S3); SEAM(pb + 3); } \
            if (IN(pb + 4)) { \
                FRESH(cc); \
                pg8::GOrder S; S.init(1, NROWS, 2048, (int)gridDim.x, (int)blockIdx.x, L == DEPTH - 1); \
                pg8::ADense al{(const pg8::bf16_t*)(cc.ws + WS_ZG), 0, nullptr, 0, 16, 1280 * 512, (size_t)8 * 1280 * 512}; pg8::EpiGluResid ep{(pg8::bf16_t*)(cc.ws + WS_X), MOD + (size_t)Lq * 9 * 6144, cc.in[IN_GLUB] + (size_t)iq * 2048}; \
                pg8::gemm_phase<true>(ldsb, al, (const unsigned char*)(cc.ws + WS_WGLU) + (size_t)iq * 2048 * D, 0, D, S, ep, cc.wave); hosted_cvt(cc, ldsb, L, HK_GLU); SEAM(pb + 4); } \
        } \
        if (IN(pb + 7)) { FRESH(cc); phase_norm2_router<L == DEPTH - 1>(cc, Lq, ldsf); SEAM(pb + 7); } \
        if (IN(pb + 8)) { FRESH(cc); phase_topk(cc, (LAS unsigned*)lds, L == DEPTH - 1 ? 128 : 256); __syncthreads(); hosted_cvt(cc, ldsb, L, HK_TOPK); SEAM(pb + 8); } \
        if (IN(pb + 9)) { \
            FRESH(cc); \
            pg8::GOrder S; S.init(NE, L == DEPTH - 1 ? NB * CAP_LAT : EROWS, 2 * FF, (int)gridDim.x, (int)blockIdx.x); \
            pg8::ADense al{(const pg8::bf16_t*)(cc.ws + WS_XS), (size_t)EROWS * D, nullptr, 0, D, 0, 128}; \
            pg8::EpiSwiglu ep{(unsigned char*)(cc.ws + WS_HID), FF, (size_t)EROWS * FF}; \
            pg8::gemm_phase<true>(ldsb, al, (const unsigned char*)(cc.ws + WS_W13) + (size_t)Lq * NE * 4096 * D, (size_t)4096 * D, D, S, ep, cc.wave); SEAM(pb + 9); } \
        if (IN(pb + 10)) { \
            FRESH(cc); \
            pg8::GOrder S; S.init(NE, L == DEPTH - 1 ? NB * CAP_LAT : EROWS, D, (int)gridDim.x, (int)blockIdx.x); \
            pg8::ADense al{(const pg8::bf16_t*)(cc.ws + WS_HID), (size_t)EROWS * FF, nullptr, 0, FF, 0, 128}; \
            pg8::EpiGate ep{(unsigned char*)(cc.ws + WS_Y), D, (size_t)EROWS * D, (const float*)(cc.ws + WS_SELGATE), EROWS}; \
            pg8::gemm_phase<true>(ldsb, al, (const unsigned char*)(cc.ws + WS_W2) + (size_t)Lq * NE * D * FF, (size_t)D * FF, FF, S, ep, cc.wave); hosted_cvt(cc, ldsb, L, HK_GEMM2); SEAM(pb + 10); } \
    }
    LAYER_BODY(0) LAYER_BODY(1) LAYER_BODY(2) LAYER_BODY(3)
#undef LAYER_BODY
    if (IN(PH_FIN)) { const int L = DEPTH; FRESH(cc); phase_norm1<true, false>(cc, DEPTH); }
#undef IN
#undef SEAM
}

static bool phase_valid(int ph) {
    if (ph == PH_PRO || ph == PH_FIN) return true;
    const int L = (ph - 1) / PH_PER_LAYER, k = (ph - 1) % PH_PER_LAYER;
    if (L & 1) return !(k >= 5 && k <= 6);
    return k != 3 && k != 5;
}
extern "C" void kernel_launch(void* const* d_in, const int* in_sizes, int n_in, void* d_out, int out_size, void* d_ws, size_t ws_size, hipStream_t stream) {
    static int grid = 0;
    if (grid == 0) {
        if (n_in != 27 || out_size != NB * T * D || ws_size < WS_END) { fprintf(stderr, "kernel_launch: unexpected shapes (n_in %d out %d ws %zu)\n", n_in, out_size, ws_size); grid = -1; return; }
        int dev = 0, cus = 0;
        if (hipGetDevice(&dev) != hipSuccess || hipDeviceGetAttribute(&cus, hipDeviceAttributeMultiprocessorCount, dev) != hipSuccess) { grid = -1; return; }
        if (hipFuncSetAttribute((const void*)fwd, hipFuncAttributeMaxDynamicSharedMemorySize, LDS_BYTES) != hipSuccess) { grid = -1; return; }
        int per_cu = 0;
        if (hipOccupancyMaxActiveBlocksPerMultiprocessor(&per_cu, (const void*)fwd, 512, LDS_BYTES) != hipSuccess || per_cu < 1) fprintf(stderr, "kernel_launch: occupancy query says %d\n", per_cu);
        (void)hipGetLastError();
        grid = cus;
    }
    if (grid < 0) return;
    if (hipMemsetAsync((char*)d_ws + WS_CTL, 0, CTL_ZERO_BYTES, stream) != hipSuccess) return;
    Args a{};
    for (int i = 0; i < 27; ++i) a.in[i] = (const float*)d_in[i];
    a.out = (float*)d_out; a.ws = (unsigned char*)d_ws;
#if MK_MULTI
    for (int ph = 0; ph < NPH; ++ph) {
        if (!phase_valid(ph)) continue;
        a.ph_lo = ph; a.ph_hi = ph + 1;
        hipLaunchKernelGGL(fwd, dim3(grid), dim3(512), LDS_BYTES, stream, a);
    }
#else
    a.ph_lo = 0; a.ph_hi = NPH;
    hipLaunchKernelGGL(fwd, dim3(grid), dim3(512), LDS_BYTES, stream, a);
#ifdef PROBE_PHASES
    { static const int probe[] = {PROBE_PHASES}; for (unsigned q = 0; q < sizeof(probe) / sizeof(probe[0]); ++q) { a.ph_lo = probe[q]; a.ph_hi = probe[q] + 1; hipLaunchKernelGGL(fwd, dim3(grid), dim3(512), LDS_BYTES, stream, a); } }
#endif
#endif
}
```
